# Optimizing an MI355X kernel written in HIP

```python
import jax, jax.numpy as jnp
from jax import lax
import numpy as np


D_MODEL = 1024
BATCH = 2
SEQ = 16384
DEPTH = 2

HEAD_DIM = 64
N_HEADS = D_MODEL // HEAD_DIM
ML_HEADS = N_HEADS // 4
FOX_HEADS = (N_HEADS - ML_HEADS) // 2
MOBA_HEADS = N_HEADS - ML_HEADS - FOX_HEADS
FOX_W = FOX_HEADS * HEAD_DIM
ML_W = ML_HEADS * HEAD_DIM
MOBA_W = MOBA_HEADS * HEAD_DIM
Q_BLOCK = 128
ML_CHUNK = 64
ML_CONV = 4
MOBA_BLOCK = 256
MOBA_TOPK = 3
ALIBI_MAX = 8.0
D_FF = ((8 * D_MODEL // 3 + 255) // 256) * 256
EPS = 1e-6
SPLIT_SIZES = (FOX_W, FOX_W, FOX_W, FOX_HEADS,
               ML_W, ML_W, ML_W, ML_HEADS, ML_HEADS, ML_W,
               MOBA_W, MOBA_W, MOBA_W)
IN_COLS = sum(SPLIT_SIZES)

kernel_name = 'hybrid_fox_mlstm_moba_block'


def _rms(x, g=None):
    xf = x.astype(jnp.float32)
    y = xf * lax.rsqrt(jnp.mean(xf * xf, axis=-1, keepdims=True) + EPS)
    return y if g is None else y * g.astype(jnp.float32)


def _to_heads(x, h):
    b, t, _ = x.shape
    return x.reshape(b, t, h, HEAD_DIM).transpose(0, 2, 1, 3)


def _from_heads(x):
    b, h, t, d = x.shape
    return x.transpose(0, 2, 1, 3).reshape(b, t, h * d)


def _alibi_slopes(h):
    return jnp.exp2(-ALIBI_MAX * jnp.arange(1, h + 1, dtype=jnp.float32) / h)


def _causal_conv(x, w, bias):
    ch = x.shape[-1]
    y = lax.conv_general_dilated(x, w.astype(x.dtype)[:, None, :], window_strides=(1,),
                                 padding=((ML_CONV - 1, 0),),
                                 dimension_numbers=('NWC', 'WIO', 'NWC'),
                                 feature_group_count=ch)
    return y + bias.astype(x.dtype)


def _fox_attention(q, k, v, f_pre):
    b, h, t, d = q.shape
    nq = t // Q_BLOCK
    logf = jax.nn.log_sigmoid(f_pre).transpose(0, 2, 1)
    cum = jnp.cumsum(logf, axis=-1)
    kpos = jnp.arange(t)
    qb = q.reshape(b, h, nq, Q_BLOCK, d).transpose(2, 0, 1, 3, 4)
    cq = cum.reshape(b, h, nq, Q_BLOCK).transpose(2, 0, 1, 3)
    starts = jnp.arange(nq) * Q_BLOCK
    scale = HEAD_DIM ** -0.5

    def block(args):
        qc, cqc, st = args
        qpos = st + jnp.arange(Q_BLOCK)
        s = jnp.einsum('bhqd,bhkd->bhqk', qc, k) * scale
        s = s + (cqc[..., None] - cum[:, :, None, :])
        s = jnp.where(kpos[None, :] <= qpos[:, None], s, -jnp.inf)
        p = jax.nn.softmax(s, axis=-1)
        return jnp.einsum('bhqk,bhkd->bhqd', p, v)

    out = lax.map(block, (qb, cq, starts))
    return out.transpose(1, 2, 0, 3, 4).reshape(b, h, t, d)


def _mlstm(q, k, v, i_pre, f_pre):
    b, h, t, d = q.shape
    nc = t // ML_CHUNK
    k = k * (d ** -0.5)
    itil = i_pre.transpose(0, 2, 1).reshape(b, h, nc, ML_CHUNK)
    logf = jax.nn.log_sigmoid(f_pre).transpose(0, 2, 1).reshape(b, h, nc, ML_CHUNK)
    bcum = jnp.cumsum(logf, axis=-1)
    bend = bcum[..., -1]
    wlog = bend[..., None] - bcum + itil
    qc = q.reshape(b, h, nc, ML_CHUNK, d)
    kc = k.reshape(b, h, nc, ML_CHUNK, d)
    vc = v.reshape(b, h, nc, ML_CHUNK, d)

    def step(carry, xs):
        cmat, nvec, m = carry
        kx, vx, wx, bx = xs
        m_new = jnp.maximum(bx + m, wx.max(-1))
        decay = jnp.exp(bx + m - m_new)
        ws = jnp.exp(wx - m_new[..., None])
        c_new = decay[..., None, None] * cmat + jnp.einsum('bhs,bhsd,bhse->bhde', ws, vx, kx)
        n_new = decay[..., None] * nvec + jnp.einsum('bhs,bhse->bhe', ws, kx)
        return (c_new, n_new, m_new), (cmat, nvec, m)

    init = (jnp.zeros((b, h, d, d), jnp.float32), jnp.zeros((b, h, d), jnp.float32),
            jnp.zeros((b, h), jnp.float32))
    xs = (kc.transpose(2, 0, 1, 3, 4), vc.transpose(2, 0, 1, 3, 4),
          wlog.transpose(2, 0, 1, 3), bend.transpose(2, 0, 1))
    _, (cs, ns, ms) = lax.scan(step, init, xs)
    cs = cs.transpose(1, 2, 0, 3, 4)
    ns = ns.transpose(1, 2, 0, 3)
    ms = ms.transpose(1, 2, 0)

    causal = jnp.tril(jnp.ones((ML_CHUNK, ML_CHUNK), dtype=bool))
    logd = bcum[..., :, None] - bcum[..., None, :] + itil[..., None, :]
    logd = jnp.where(causal, logd, -jnp.inf)
    m_inter = bcum + ms[..., None]
    m_j = jnp.maximum(m_inter, logd.max(-1))
    smat = jnp.einsum('bhcjd,bhcsd->bhcjs', qc, kc) * jnp.exp(logd - m_j[..., None])
    inter = jnp.exp(m_inter - m_j)
    num = (inter[..., None] * jnp.einsum('bhcde,bhcje->bhcjd', cs, qc)
           + jnp.einsum('bhcjs,bhcsd->bhcjd', smat, vc))
    den = inter * jnp.einsum('bhce,bhcje->bhcj', ns, qc) + smat.sum(-1)
    hout = num / jnp.maximum(jnp.abs(den), jnp.exp(-m_j))[..., None]
    return hout.reshape(b, h, t, d)


def _moba_attention(q, k, v, slopes):
    b, h, t, d = q.shape
    nb = -(-t // MOBA_BLOCK)
    pad = nb * MOBA_BLOCK - t
    kb = jnp.pad(k, ((0, 0), (0, 0), (0, pad), (0, 0))).reshape(b, h, nb, MOBA_BLOCK, d)
    vb = jnp.pad(v, ((0, 0), (0, 0), (0, pad), (0, 0))).reshape(b, h, nb, MOBA_BLOCK, d)
    kmean = kb.mean(axis=3)
    qblk = jnp.arange(t) // MOBA_BLOCK
    gate = jnp.einsum('bhtd,bhnd->bhtn', q, kmean)
    gate = jnp.where(jnp.arange(nb)[None, :] < qblk[:, None], gate, -jnp.inf)
    topk = min(MOBA_TOPK, nb)
    _, sel = lax.top_k(gate, topk)
    valid = sel < qblk[:, None]
    nq = t // Q_BLOCK
    xs = (q.reshape(b, h, nq, Q_BLOCK, d).transpose(2, 0, 1, 3, 4),
          sel.reshape(b, h, nq, Q_BLOCK, topk).transpose(2, 0, 1, 3, 4),
          valid.reshape(b, h, nq, Q_BLOCK, topk).transpose(2, 0, 1, 3, 4),
          jnp.arange(nq))
    bi = jnp.arange(b)[:, None, None, None]
    hi = jnp.arange(h)[None, :, None, None]
    scale = HEAD_DIM ** -0.5
    offs = jnp.arange(MOBA_BLOCK)

    def block(args):
        qc, selc, validc, ci = args
        qpos = ci * Q_BLOCK + jnp.arange(Q_BLOCK)
        ks = kb[bi, hi, selc]
        vs = vb[bi, hi, selc]
        kpos_sel = selc[..., None] * MOBA_BLOCK + offs
        dist_sel = (qpos[:, None, None] - kpos_sel).astype(jnp.float32)
        s_sel = (jnp.einsum('bhqd,bhqkld->bhqkl', qc, ks) * scale
                 - slopes[:, None, None, None] * dist_sel)
        s_sel = jnp.where(validc[..., None], s_sel, -jnp.inf)
        own = (ci * Q_BLOCK) // MOBA_BLOCK
        ko = lax.dynamic_index_in_dim(kb, own, axis=2, keepdims=False)
        vo = lax.dynamic_index_in_dim(vb, own, axis=2, keepdims=False)
        dist_own = qpos[:, None] - (own * MOBA_BLOCK + offs)[None, :]
        s_own = (jnp.einsum('bhqd,bhld->bhql', qc, ko) * scale
                 - slopes[:, None, None] * dist_own.astype(jnp.float32))
        s_own = jnp.where(dist_own >= 0, s_own, -jnp.inf)
        s_all = jnp.concatenate([s_sel.reshape(b, h, Q_BLOCK, topk * MOBA_BLOCK), s_own], axis=-1)
        p = jax.nn.softmax(s_all, axis=-1)
        p_sel = p[..., :topk * MOBA_BLOCK].reshape(b, h, Q_BLOCK, topk, MOBA_BLOCK)
        p_own = p[..., topk * MOBA_BLOCK:]
        return (jnp.einsum('bhqkl,bhqkld->bhqd', p_sel, vs)
                + jnp.einsum('bhql,bhld->bhqd', p_own, vo))

    out = lax.map(block, xs)
    return out.transpose(1, 2, 0, 3, 4).reshape(b, h, t, d)


def _mixer(hn, w_in, fox_f_bias, fox_q_g, fox_k_g, ml_conv_w, ml_conv_b, ml_i_bias,
           ml_f_bias, ml_h_g, moba_q_g, moba_k_g):
    proj = (hn @ w_in).astype(jnp.float32)
    idx = [int(i) for i in np.cumsum(SPLIT_SIZES)[:-1]]
    fq, fk, fv, ff, mq, mk, mv, mi, mf, mo, bq, bk, bv = jnp.split(proj, idx, axis=-1)
    y_fox = _fox_attention(_rms(_to_heads(fq, FOX_HEADS), fox_q_g),
                           _rms(_to_heads(fk, FOX_HEADS), fox_k_g),
                           _to_heads(fv, FOX_HEADS),
                           ff + fox_f_bias.astype(jnp.float32))
    qk = jax.nn.silu(_causal_conv(jnp.concatenate([mq, mk], axis=-1), ml_conv_w, ml_conv_b))
    mq, mk = jnp.split(qk, 2, axis=-1)
    h_ml = _mlstm(_to_heads(mq, ML_HEADS), _to_heads(mk, ML_HEADS), _to_heads(mv, ML_HEADS),
                  mi + ml_i_bias.astype(jnp.float32), mf + ml_f_bias.astype(jnp.float32))
    y_ml = _from_heads(_rms(h_ml)) * ml_h_g.astype(jnp.float32) * jax.nn.sigmoid(mo)
    y_moba = _moba_attention(_rms(_to_heads(bq, MOBA_HEADS), moba_q_g),
                             _rms(_to_heads(bk, MOBA_HEADS), moba_k_g),
                             _to_heads(bv, MOBA_HEADS), _alibi_slopes(MOBA_HEADS))
    return jnp.concatenate([_from_heads(y_fox), y_ml, _from_heads(y_moba)], axis=-1)


def setup_inputs(seed: int = 0) -> dict:
    key = jax.random.key(seed)
    ks = jax.random.split(key, 22)
    n = jax.random.normal
    f32 = jnp.float32
    return {
        'x': n(ks[0], (BATCH, SEQ, D_MODEL), f32),
        'c': n(ks[1], (BATCH, D_MODEL), f32),
        'w_ada': n(ks[2], (DEPTH, D_MODEL, 6 * D_MODEL), f32) * (0.5 * D_MODEL ** -0.5),
        'b_ada': n(ks[3], (DEPTH, 6 * D_MODEL), f32) * 0.01,
        'norm1_g': 1.0 + 0.02 * n(ks[4], (DEPTH, D_MODEL), f32),
        'norm2_g': 1.0 + 0.02 * n(ks[5], (DEPTH, D_MODEL), f32),
        'w_in': n(ks[6], (DEPTH, D_MODEL, IN_COLS), f32) * D_MODEL ** -0.5,
        'fox_f_bias': 2.0 + 0.1 * n(ks[7], (DEPTH, FOX_HEADS), f32),
        'fox_q_g': 1.0 + 0.02 * n(ks[8], (DEPTH, HEAD_DIM), f32),
        'fox_k_g': 1.0 + 0.02 * n(ks[9], (DEPTH, HEAD_DIM), f32),
        'ml_conv_w': n(ks[10], (DEPTH, ML_CONV, 2 * ML_W), f32) * ML_CONV ** -0.5,
        'ml_conv_b': 0.01 * n(ks[11], (DEPTH, 2 * ML_W), f32),
        'ml_i_bias': 0.1 * n(ks[12], (DEPTH, ML_HEADS), f32),
        'ml_f_bias': 3.0 + 0.1 * n(ks[13], (DEPTH, ML_HEADS), f32),
        'ml_h_g': 1.0 + 0.02 * n(ks[14], (DEPTH, ML_W), f32),
        'moba_q_g': 1.0 + 0.02 * n(ks[15], (DEPTH, HEAD_DIM), f32),
        'moba_k_g': 1.0 + 0.02 * n(ks[16], (DEPTH, HEAD_DIM), f32),
        'w_out': n(ks[17], (DEPTH, D_MODEL, D_MODEL), f32) * D_MODEL ** -0.5,
        'w_gate_up': n(ks[18], (DEPTH, D_MODEL, 2 * D_FF), f32) * D_MODEL ** -0.5,
        'w_down': n(ks[19], (DEPTH, D_FF, D_MODEL), f32) * D_FF ** -0.5,
    }


def reference(x, c, w_ada, b_ada, norm1_g, norm2_g, w_in, fox_f_bias, fox_q_g, fox_k_g,
              ml_conv_w, ml_conv_b, ml_i_bias, ml_f_bias, ml_h_g, moba_q_g, moba_k_g,
              w_out, w_gate_up, w_down):
    for l in range(DEPTH):
        mod = jax.nn.silu(c) @ w_ada[l] + b_ada[l]
        sh1, sc1, g1, sh2, sc2, g2 = jnp.split(mod[:, None, :], 6, axis=-1)
        hn = (_rms(x, norm1_g[l]) * (1 + sc1) + sh1).astype(x.dtype)
        y = _mixer(hn, w_in[l], fox_f_bias[l], fox_q_g[l], fox_k_g[l], ml_conv_w[l],
                   ml_conv_b[l], ml_i_bias[l], ml_f_bias[l], ml_h_g[l], moba_q_g[l], moba_k_g[l])
        x = x + g1 * (y.astype(x.dtype) @ w_out[l])
        hn = (_rms(x, norm2_g[l]) * (1 + sc2) + sh2).astype(x.dtype)
        gate, up = jnp.split(hn @ w_gate_up[l], 2, axis=-1)
        x = x + g2 * ((jax.nn.silu(gate) * up) @ w_down[l])
    return x
```

```cpp
#include <hip/hip_runtime.h>
#include <cstdio>
#include <cstdint>

constexpr int DM = 1024, NBATCH = 2, SEQ = 16384, MROWS = NBATCH * SEQ, DEPTH = 2;
constexpr int HD = 64, FOXH = 6, MLH = 4, MOBH = 6;
constexpr int DFF = 2816, INC = 3342, NIN = 3584, PLD = 3328;
constexpr int NGU = 2 * DFF;
constexpr int C_FQ = 0, C_FK = 384, C_FV = 768, C_BQ = 1152, C_BK = 1536, C_BV = 1920, C_MQ = 2304, C_MK = 2560, C_MV = 2816, C_MO = 3072, C_G = 3328;
constexpr int Y_FOX = 0, Y_ML = 384, Y_MOBA = 640;
constexpr int MOBA_BS = 256, NBLK = SEQ / MOBA_BS;
constexpr int MLC = 64, NCHUNK = SEQ / MLC;
constexpr float LOG2E = 1.4426950408889634f;
constexpr float QSCALE = 0.125f * LOG2E;
constexpr float EPS = 1e-6f;

#define GAS __attribute__((address_space(1)))
#define LAS __attribute__((address_space(3)))
typedef unsigned short bf16;
typedef unsigned v4u __attribute__((ext_vector_type(4)));
typedef unsigned v2u __attribute__((ext_vector_type(2)));
typedef float f32x4 __attribute__((ext_vector_type(4)));
typedef short bf16x8 __attribute__((ext_vector_type(8)));
typedef float f32x16 __attribute__((ext_vector_type(16)));
typedef GAS unsigned gu32;
#define RLX_AGENT __ATOMIC_RELAXED, __HIP_MEMORY_SCOPE_AGENT
__device__ __forceinline__ unsigned f2bf(float f) { unsigned u = __builtin_bit_cast(unsigned, f); return (u + 0x7fffu + ((u >> 16) & 1u)) >> 16; }
__device__ __forceinline__ unsigned pk2(float lo, float hi) { return f2bf(lo) | (f2bf(hi) << 16); }
__device__ __forceinline__ float bf2f(unsigned short u) { return __builtin_bit_cast(float, (unsigned)u << 16); }
__device__ __forceinline__ float bflo(unsigned w) { return __builtin_bit_cast(float, w << 16); }
__device__ __forceinline__ float bfhi(unsigned w) { return __builtin_bit_cast(float, w & 0xffff0000u); }
__device__ __forceinline__ float wave_sum(float v) {
#pragma unroll
    for (int o = 1; o < 64; o <<= 1) v += __shfl_xor(v, o);
    return v;
}
__device__ __forceinline__ float wave_max(float v) {
#pragma unroll
    for (int o = 1; o < 64; o <<= 1) v = fmaxf(v, __shfl_xor(v, o));
    return v;
}
__device__ __forceinline__ float log_sigmoid_f(float x) { return fminf(x, 0.f) - log1pf(expf(-fabsf(x))); }
__device__ __forceinline__ float sigmoid_f(float x) { return 1.f / (1.f + expf(-x)); }

constexpr size_t MiB = 1u << 20;
constexpr size_t WS_CTL = 0, CTL_ZERO_BYTES = 1 * MiB;
constexpr size_t WS_MOD = 1 * MiB;
constexpr size_t WS_KMEAN = WS_MOD + 128 * 1024;
constexpr size_t WS_MLS = WS_KMEAN + 256 * 1024;
constexpr size_t WS_BEND = WS_MLS, WS_MLOC = WS_MLS + 8192, WS_MS = WS_MLS + 16384, WS_NU = WS_MLS + 32768, WS_NS = WS_NU + 2048 * 64 * 4;
static_assert(WS_NS + 2048 * 64 * 4 <= 4 * MiB, "small region");
constexpr size_t WS_WIN = 4 * MiB, WIN_BYTES = (size_t)NIN * DM * 2;
constexpr size_t WS_WOUT = WS_WIN + 2 * WIN_BYTES, WOUT_BYTES = (size_t)DM * DM * 2;
constexpr size_t WS_WGU = WS_WOUT + 2 * WOUT_BYTES, WGU_BYTES = (size_t)NGU * DM * 2;
constexpr size_t WS_WDN = WS_WGU + 2 * WGU_BYTES, WDN_BYTES = (size_t)DM * DFF * 2;
static_assert(WS_WDN + 2 * WDN_BYTES <= 64 * MiB, "weights");
constexpr size_t WS_XN = 64 * MiB;
constexpr size_t WS_U = 64 * MiB;
constexpr size_t WS_CS = 96 * MiB;
constexpr size_t WS_LIST = 112 * MiB;
constexpr size_t WS_PROJ = 128 * MiB;
constexpr size_t WS_H = 128 * MiB;
constexpr size_t WS_Y = 336 * MiB;
constexpr size_t WS_QC = 400 * MiB, WS_KC = 416 * MiB;
constexpr size_t WS_OPART = 432 * MiB;
constexpr size_t WS_LPART = 504 * MiB;
constexpr size_t WS_GATES = 507 * MiB;
constexpr size_t WS_FOXCUM = 509 * MiB;
constexpr size_t WS_SEL = 510 * MiB;
constexpr size_t WS_END = 512 * MiB;
static_assert(WS_PROJ + (size_t)MROWS * PLD * 2 <= WS_Y && WS_SEL + (size_t)MROWS * 6 * 4 <= WS_END, "ws map");
constexpr int CW_BAR = 4096;
constexpr int CW_QUEUE = 16384;
constexpr int CW_LCNT = 32768;

constexpr int RING_BYTES = 131072, LDSCTL_OFF = RING_BYTES, MISC_OFF = LDSCTL_OFF + 320, LDS_BYTES = 147456;
constexpr int NWAVES = 8, NTHREADS = 512;
namespace pg8 {
#define PG8_LAS __attribute__((address_space(3)))
typedef unsigned short bf16_t;
typedef short bf16x8 __attribute__((ext_vector_type(8)));
typedef float f32x4 __attribute__((ext_vector_type(4)));
typedef unsigned u32x4 __attribute__((ext_vector_type(4)));
constexpr int BM = 256, BK = 64, HALF = 128, HTB = HALF * BK * 2  , STAGE_BYTES = 8 * HTB, NXCD = 8, WGM = 8;

__host__ __device__ __forceinline__ int lds_byte(int r, int c) { const int st = (r >> 4) * 2 + (c >> 5), rr = r & 15, cc = c & 31, ob = rr * 64 + cc * 2; return st * 1024 + (ob ^ (((ob >> 9) & 1) << 5)); }
__host__ __device__ __forceinline__ void stage_rc(int b, int& R, int& C) { const int st = b / 1024, sb = b % 1024, swz = sb ^ (((sb >> 9) & 1) << 5); R = (st >> 1) * 16 + swz / 64; C = (st & 1) * 32 + (swz % 64) / 2; }
__host__ __device__ __forceinline__ int perm32(int rho) { const int n = rho >> 4, i = rho & 15; return 8 * (i >> 2) + 4 * n + (i & 3); }

struct Unit { int pm, pn; };
struct Gemm { const bf16_t* A; const bf16_t* Bt; int M, N, K; };

struct StaticOrder {
    int nM, nN, nwg, G, c;
    __host__ __device__ void init(int M, int N, int G_, int c_) { nM = M / BM; nN = N / BM; nwg = nM * nN; G = G_; c = c_; }
    __host__ __device__ bool next(int i, Unit& u) const {
        const long L = (long)i * G + c; if (L >= nwg) return false;
        int wgid = (int)L; { const int q = nwg / NXCD, r = nwg % NXCD, xcd = wgid % NXCD, off = wgid / NXCD; wgid = (xcd < r ? xcd * (q + 1) : r * (q + 1) + (xcd - r) * q) + off; }
        const int nig = WGM * nN, gid = wgid / nig, fm = gid * WGM, gsz = (nM - fm) < WGM ? (nM - fm) : WGM;
        u.pm = fm + ((wgid % nig) % gsz); u.pn = (wgid % nig) / gsz; return true;
    }
    __device__ __forceinline__ void a_ready(const Unit&) const {}
    __device__ __forceinline__ void done(const Unit&) const {}
};

__device__ __forceinline__ unsigned cvt_pk_bf16(float lo, float hi) { unsigned r; asm volatile("v_cvt_pk_bf16_f32 %0, %1, %2" : "=v"(r) : "v"(lo), "v"(hi)); return r; }
typedef float f32x2 __attribute__((ext_vector_type(2)));
struct EpiProj {
    static constexpr bool PERM = true, AFTER_DRAIN = false;
    bf16_t* P; float* G; int pld;
    __device__ __forceinline__ void operator()(const f32x4 (&acc)[2][2][4][2], const Unit& u, int wr, int wc, int fr, int fq) const {
        const int row0 = u.pm * BM + wr * 64 + fr;
        if (u.pn < 13) {
            const int col0 = u.pn * BM + wc * 32 + 8 * fq;
#pragma unroll
            for (int ai = 0; ai < 2; ++ai)
#pragma unroll
                for (int m = 0; m < 4; ++m) { bf16_t* rowp = P + (size_t)(row0 + ai * HALF + m * 16) * pld + col0;
#pragma unroll
                    for (int bj = 0; bj < 2; ++bj) { const f32x4 v0 = acc[ai][bj][m][0], v1 = acc[ai][bj][m][1];
                        u32x4 w; w.x = cvt_pk_bf16(v0[0], v0[1]); w.y = cvt_pk_bf16(v0[2], v0[3]); w.z = cvt_pk_bf16(v1[0], v1[1]); w.w = cvt_pk_bf16(v1[2], v1[3]);
                        *(u32x4*)(rowp + bj * HALF) = w; } }
        } else {
            if (wc == 0 && fq < 2) {
#pragma unroll
                for (int ai = 0; ai < 2; ++ai)
#pragma unroll
                    for (int m = 0; m < 4; ++m) { float* gp = G + (size_t)(row0 + ai * HALF + m * 16) * 16 + 8 * fq;
                        *(f32x4*)(gp) = acc[ai][0][m][0]; *(f32x4*)(gp + 4) = acc[ai][0][m][1]; }
            }
        }
    }
};
struct EpiRes {
    static constexpr bool PERM = false, AFTER_DRAIN = false;
    const float* base; float* out; const float* gate; int gate_bstride; int rows_per_batch;
    __device__ __forceinline__ void operator()(const f32x4 (&acc)[2][2][4][2], const Unit& u, int wr, int wc, int fr, int fq) const {
        const int row0 = u.pm * BM + wr * 64 + fr, col0 = u.pn * BM + wc * 32 + 4 * fq;
        const float* gb = gate + (size_t)((u.pm * BM) / rows_per_batch) * gate_bstride;
        f32x4 gv[2][2];
#pragma unroll
        for (int bj = 0; bj < 2; ++bj)
#pragma unroll
            for (int n = 0; n < 2; ++n) gv[bj][n] = *(const f32x4*)(gb + col0 + bj * HALF + n * 16);
#pragma unroll
        for (int ai = 0; ai < 2; ++ai)
#pragma unroll
            for (int m = 0; m < 4; ++m) { const size_t off = (size_t)(row0 + ai * HALF + m * 16) * 1024 + col0;
#pragma unroll
                for (int bj = 0; bj < 2; ++bj)
#pragma unroll
                    for (int n = 0; n < 2; ++n) { const f32x4 bs = *(const f32x4*)(base + off + bj * HALF + n * 16);
                        *(f32x4*)(out + off + bj * HALF + n * 16) = bs + gv[bj][n] * acc[ai][bj][m][n]; } }
    }
};
struct EpiSwiglu {
    static constexpr bool PERM = true, AFTER_DRAIN = false;
    bf16_t* Hh; int ldh;
    __device__ __forceinline__ void operator()(const f32x4 (&acc)[2][2][4][2], const Unit& u, int wr, int wc, int fr, int fq) const {
        const int row0 = u.pm * BM + wr * 64 + fr, col0 = u.pn * HALF + wc * 32 + 8 * fq;
#pragma unroll
        for (int ai = 0; ai < 2; ++ai)
#pragma unroll
            for (int m = 0; m < 4; ++m) { bf16_t* rowp = Hh + (size_t)(row0 + ai * HALF + m * 16) * ldh + col0;
                float hv[8];
#pragma unroll
                for (int n = 0; n < 2; ++n)
#pragma unroll
                    for (int i = 0; i < 4; ++i) { const float g = acc[ai][0][m][n][i], up = acc[ai][1][m][n][i];
                        const float e = __builtin_amdgcn_exp2f(-g * 1.4426950408889634f);
                        hv[n * 4 + i] = g * __builtin_amdgcn_rcpf(1.0f + e) * up; }
                u32x4 w; w.x = cvt_pk_bf16(hv[0], hv[1]); w.y = cvt_pk_bf16(hv[2], hv[3]); w.z = cvt_pk_bf16(hv[4], hv[5]); w.w = cvt_pk_bf16(hv[6], hv[7]);
                *(u32x4*)(rowp) = w; }
    }
};
template <class Epi, class Sched, bool ALIGN_EPI = false, bool SP2 = false>
__device__ __forceinline__ void gemm_phase(PG8_LAS unsigned char* lds, const Gemm g, const Sched& S, const Epi& E, const int tid_in) {
    const int tid = tid_in, wid = __builtin_amdgcn_readfirstlane(tid >> 6), lane = tid & 63, wr = wid >> 2, wc = wid & 3, fr = lane & 15, fq = lane >> 4;
    const int K = g.K, nt = K / BK;
    unsigned voffA[2], voffB[2];
#pragma unroll
    for (int i = 0; i < 2; ++i) { int R, C; stage_rc(tid * 16 + i * 8192, R, C); const int Rb = Epi::PERM ? ((R & ~31) + perm32(R & 31)) : R;
        voffA[i] = (unsigned)(R * K + C) * 2u; voffB[i] = (unsigned)(Rb * K + C) * 2u; }
    const size_t kstep = (size_t)(BK * 2);
    const size_t hstep = (size_t)HALF * K * 2;
    const size_t tstep = 2 * hstep;
    const unsigned ldsw = (unsigned)wid * 1024u;
    const int aoff = lds_byte(wr * 64 + fr, fq * 8), boff = lds_byte(wc * 32 + fr, fq * 8);
#define PG8_SA(b, h) (((b) * 2 + (h)) * HTB)
#define PG8_SB(b, h) ((4 + (b) * 2 + (h)) * HTB)
#define PG8_STAGE(bufoff, gbase, voff) do { _Pragma("unroll") for (int _i = 0; _i < 2; ++_i) \
        __builtin_amdgcn_global_load_lds((const unsigned*)((const char*)(gbase) + (voff)[_i]), (PG8_LAS unsigned*)(lds + (bufoff) + ldsw + _i * 8192), 16, 0, 0); } while (0)
#define PG8_LDA(dst, b, h) do { _Pragma("unroll") for (int m = 0; m < 4; ++m) _Pragma("unroll") for (int k = 0; k < 2; ++k) dst[m][k] = *(const PG8_LAS bf16x8*)(lds + PG8_SA(b, h) + aoff + m * 2048 + k * 1024); } while (0)
#define PG8_LDB(dst, b, h) do { _Pragma("unroll") for (int n = 0; n < 2; ++n) _Pragma("unroll") for (int k = 0; k < 2; ++k) dst[n][k] = *(const PG8_LAS bf16x8*)(lds + PG8_SB(b, h) + boff + n * 2048 + k * 1024); } while (0)
#define PG8_MMA(ai, bj, At, Bt) do { __builtin_amdgcn_s_setprio(1); _Pragma("unroll") for (int m = 0; m < 4; ++m) _Pragma("unroll") for (int n = 0; n < 2; ++n) _Pragma("unroll") for (int k = 0; k < 2; ++k) \
        acc[ai][bj][m][n] = __builtin_amdgcn_mfma_f32_16x16x32_bf16(Bt[n][k], At[m][k], acc[ai][bj][m][n], 0, 0, 0); __builtin_amdgcn_s_setprio(0); } while (0)
#define PG8_WAIT_V(n) asm volatile("s_waitcnt vmcnt(" #n ")" ::: "memory")
#define PG8_WAIT_L(n) asm volatile("s_waitcnt lgkmcnt(" #n ")" ::: "memory")
#define PG8_BAR __builtin_amdgcn_s_barrier()
#define PG8_SCHED __builtin_amdgcn_sched_barrier(0)
    Unit cur, nxt; int ui = 0;
    if (!S.next(0, cur)) return;
    f32x4 acc[2][2][4][2];
#pragma unroll
    for (int a = 0; a < 2; ++a)
#pragma unroll
        for (int b = 0; b < 2; ++b)
#pragma unroll
            for (int m = 0; m < 4; ++m)
#pragma unroll
                for (int n = 0; n < 2; ++n) acc[a][b][m][n] = (f32x4){0.f, 0.f, 0.f, 0.f};
    bf16x8 At[4][2], B0[2][2], B1[2][2];
    const char* cA = (const char*)g.A + (size_t)cur.pm * tstep; const char* cB = (const char*)g.Bt + (size_t)cur.pn * tstep;
    S.a_ready(cur);
    if constexpr (SP2) {
        PG8_STAGE(PG8_SB(0, 0), cB, voffB); PG8_STAGE(PG8_SB(0, 1), cB + hstep, voffB); PG8_STAGE(PG8_SA(0, 0), cA, voffA); PG8_STAGE(PG8_SA(0, 1), cA + hstep, voffA);
        if (wr == 1) PG8_BAR;
        PG8_WAIT_V(2); PG8_BAR;
        PG8_STAGE(PG8_SB(1, 0), cB + kstep, voffB); PG8_STAGE(PG8_SA(1, 0), cA + kstep, voffA); PG8_STAGE(PG8_SB(1, 1), cB + hstep + kstep, voffB);
        PG8_WAIT_V(6); PG8_BAR;
    } else {
        PG8_STAGE(PG8_SB(0, 0), cB, voffB); PG8_STAGE(PG8_SA(0, 0), cA, voffA); PG8_STAGE(PG8_SB(0, 1), cB + hstep, voffB); PG8_STAGE(PG8_SA(0, 1), cA + hstep, voffA);
        if (wr == 1) PG8_BAR;
        PG8_WAIT_V(4); PG8_BAR;
        PG8_STAGE(PG8_SB(1, 0), cB + kstep, voffB); PG8_STAGE(PG8_SA(1, 0), cA + kstep, voffA); PG8_STAGE(PG8_SB(1, 1), cB + hstep + kstep, voffB);
        PG8_WAIT_V(6); PG8_BAR;
    }
    for (;;) {
        const bool has_next = S.next(ui + 1, nxt);
        const char* nA = has_next ? (const char*)g.A + (size_t)nxt.pm * tstep : cA; const char* nB = has_next ? (const char*)g.Bt + (size_t)nxt.pn * tstep : cB;
        for (int t = 0; t < nt; t += 2) {
            const bool last = (t == nt - 2);
            const char* a1 = cA + (size_t)(t + 1) * kstep;
            const char* a2 = last ? nA : cA + (size_t)(t + 2) * kstep; const char* b2 = last ? nB : cB + (size_t)(t + 2) * kstep;
            const char* a3 = a2 + kstep; const char* b3 = b2 + kstep;
            if (last && has_next) S.a_ready(nxt);
            if constexpr (SP2) {
            PG8_LDB(B0, 0, 0); PG8_LDB(B1, 0, 1); PG8_SCHED; PG8_LDA(At, 0, 0); PG8_STAGE(PG8_SA(1, 1), a1 + hstep, voffA);
            PG8_WAIT_V(8); PG8_WAIT_L(0); PG8_BAR; PG8_MMA(0, 0, At, B0); PG8_MMA(0, 1, At, B1); PG8_BAR; PG8_SCHED;
            PG8_LDA(At, 0, 1); PG8_STAGE(PG8_SB(0, 0), b2, voffB); PG8_STAGE(PG8_SB(0, 1), b2 + hstep, voffB); PG8_STAGE(PG8_SA(0, 0), a2, voffA);
            PG8_WAIT_V(8); PG8_WAIT_L(0); PG8_BAR; PG8_MMA(1, 0, At, B0); PG8_MMA(1, 1, At, B1); PG8_BAR; PG8_SCHED;
            PG8_LDB(B0, 1, 0); PG8_LDB(B1, 1, 1); PG8_SCHED; PG8_LDA(At, 1, 0); PG8_STAGE(PG8_SA(0, 1), a2 + hstep, voffA);
            PG8_WAIT_V(8); PG8_WAIT_L(0); PG8_BAR; PG8_MMA(0, 0, At, B0); PG8_MMA(0, 1, At, B1); PG8_BAR; PG8_SCHED;
            PG8_LDA(At, 1, 1); PG8_STAGE(PG8_SB(1, 0), b3, voffB); PG8_STAGE(PG8_SB(1, 1), b3 + hstep, voffB); PG8_STAGE(PG8_SA(1, 0), a3, voffA);
            PG8_WAIT_V(8); PG8_WAIT_L(0); PG8_BAR; PG8_MMA(1, 0, At, B0); PG8_MMA(1, 1, At, B1); PG8_BAR; PG8_SCHED;
            } else {
            PG8_LDB(B0, 0, 0); PG8_SCHED; PG8_LDA(At, 0, 0); PG8_STAGE(PG8_SA(1, 1), a1 + hstep, voffA);
            PG8_WAIT_L(8); PG8_BAR; PG8_WAIT_L(0); PG8_MMA(0, 0, At, B0); PG8_BAR; PG8_SCHED;
            PG8_LDB(B1, 0, 1); PG8_STAGE(PG8_SB(0, 0), b2, voffB);
            PG8_BAR; PG8_WAIT_L(0); PG8_MMA(0, 1, At, B1); PG8_BAR;
            PG8_LDA(At, 0, 1); PG8_STAGE(PG8_SA(0, 0), a2, voffA);
            PG8_BAR; PG8_WAIT_L(0); PG8_MMA(1, 0, At, B0); PG8_BAR; PG8_SCHED;
            PG8_STAGE(PG8_SB(0, 1), b2 + hstep, voffB);
            PG8_WAIT_V(6); PG8_BAR; PG8_MMA(1, 1, At, B1); PG8_BAR;
            PG8_LDB(B0, 1, 0); PG8_SCHED; PG8_LDA(At, 1, 0); PG8_STAGE(PG8_SA(0, 1), a2 + hstep, voffA);
            PG8_WAIT_L(8); PG8_BAR; PG8_WAIT_L(0); PG8_MMA(0, 0, At, B0); PG8_BAR; PG8_SCHED;
            PG8_LDB(B1, 1, 1); PG8_STAGE(PG8_SB(1, 0), b3, voffB);
            PG8_BAR; PG8_WAIT_L(0); PG8_MMA(0, 1, At, B1); PG8_BAR;
            PG8_LDA(At, 1, 1); PG8_STAGE(PG8_SA(1, 0), a3, voffA);
            PG8_BAR; PG8_WAIT_L(0); PG8_MMA(1, 0, At, B0); PG8_BAR; PG8_SCHED;
            PG8_STAGE(PG8_SB(1, 1), b3 + hstep, voffB);
            PG8_WAIT_V(6); PG8_BAR; PG8_MMA(1, 1, At, B1); PG8_BAR;
            }
        }
        if constexpr (ALIGN_EPI) { if (wr == 0) PG8_BAR; }
        if constexpr (!Epi::AFTER_DRAIN) { E(acc, cur, wr, wc, fr, fq); S.done(cur); }
        if (!has_next) break;
#pragma unroll
        for (int a = 0; a < 2; ++a)
#pragma unroll
            for (int b = 0; b < 2; ++b)
#pragma unroll
                for (int m = 0; m < 4; ++m)
#pragma unroll
                    for (int n = 0; n < 2; ++n) acc[a][b][m][n] = (f32x4){0.f, 0.f, 0.f, 0.f};
        cur = nxt; cA = nA; cB = nB; ++ui;
        if constexpr (ALIGN_EPI) { if (wr == 1) PG8_BAR; }
    }
    PG8_WAIT_V(0);
    if constexpr (!ALIGN_EPI) { if (wr == 0) PG8_BAR; }
    PG8_BAR;
    if constexpr (Epi::AFTER_DRAIN) { E.fused(acc, cur, wr, wc, fr, fq, lds, wid, lane); S.done(cur); }
#undef PG8_SA
#undef PG8_SB
#undef PG8_STAGE
#undef PG8_LDA
#undef PG8_LDB
#undef PG8_MMA
#undef PG8_WAIT_V
#undef PG8_WAIT_L
#undef PG8_BAR
#undef PG8_SCHED
}
}
#define XB_TMO      128
#define XB_XCNT(j)  (256  + 64 * (j))
#define XB_XSUB(j)  (1280 + 64 * (j))
#define XB_XGEN(j)  (2304 + 64 * (j))
#define XB_TOP      3328
#define XB_TOPGEN   3392
#define XCD_BAR_WORDS 3456
#define XB_SPIN_CAP (1u << 18)

__device__ __forceinline__ unsigned xb_ld(unsigned* p)              { return __hip_atomic_load(p, __ATOMIC_RELAXED, __HIP_MEMORY_SCOPE_AGENT); }
__device__ __forceinline__ unsigned xb_add(unsigned* p, unsigned v) { return __hip_atomic_fetch_add(p, v, __ATOMIC_RELAXED, __HIP_MEMORY_SCOPE_AGENT); }
__device__ __forceinline__ unsigned xb_xcc_id() { return (unsigned)__builtin_amdgcn_s_getreg((3 << 11) | 20) & 0xFu; }
#define XB_SPIN(cond, bar) do { unsigned _sp = 0; while (cond) { __builtin_amdgcn_s_sleep(1); \
    if ((++_sp & 255u) == 0u) { if (xb_ld(&(bar)[XB_TMO])) break; if (_sp > XB_SPIN_CAP) { atomicAdd(&(bar)[XB_TMO], 1u); break; } } } } while (0)

struct XcdBarrier {
    unsigned* bar; unsigned x;
    volatile LAS unsigned* st;
};

__device__ __forceinline__ XcdBarrier xcd_barrier_post(unsigned* bar, volatile LAS unsigned* st) {
    XcdBarrier b; b.bar = bar; b.x = xb_xcc_id(); b.st = st;
    if (threadIdx.x == 0) (void)xb_add(&bar[XB_XCNT(b.x)], 1u);
    return b;
}
__device__ __forceinline__ void xcd_barrier_complete(unsigned* bar, unsigned x, unsigned& nloc, unsigned& nx) {
    const unsigned G = gridDim.x * gridDim.y * gridDim.z;
    unsigned sum, cnt, mine, sp = 0u;
    for (;;) {
        sum = 0u; cnt = 0u; mine = 0u;
#pragma unroll
        for (unsigned j = 0; j < 16; ++j) { const unsigned c = xb_ld(&bar[XB_XCNT(j)]); sum += c; cnt += (c > 0u) ? 1u : 0u; mine = (j == x) ? c : mine; }
        if (sum == G) break;
        __builtin_amdgcn_s_sleep(1);
        if ((++sp & 255u) == 0u) { if (xb_ld(&bar[XB_TMO])) break; if (sp > XB_SPIN_CAP) { atomicAdd(&bar[XB_TMO], 1u); break; } }
    }
    nloc = mine > 0u ? mine : 1u; nx = cnt > 0u ? cnt : 1u;
}

__device__ __forceinline__ void xcd_barrier(const XcdBarrier& b) {
    asm volatile("s_waitcnt vmcnt(0)" ::: "memory");
    __syncthreads();
    if (threadIdx.x == 0) {
        unsigned* bar = b.bar;
        __builtin_amdgcn_s_waitcnt(0);
        unsigned nloc = b.st[0], nx = b.st[1];
        if (nloc == 0u) { xcd_barrier_complete(bar, b.x, nloc, nx); b.st[0] = nloc; b.st[1] = nx; }
        const unsigned old = xb_add(&bar[XB_XSUB(b.x)], 1u);
        const unsigned gen = old / nloc;
        if (old + 1u == (gen + 1u) * nloc) {
            __builtin_amdgcn_fence(__ATOMIC_RELEASE, "agent");
            asm volatile("s_waitcnt vmcnt(0)" ::: "memory");
            const unsigned og = xb_add(&bar[XB_TOP], 1u);
            const unsigned tg = og / nx;
            if (og + 1u == (tg + 1u) * nx) xb_add(&bar[XB_TOPGEN], 1u);
            else XB_SPIN(xb_ld(&bar[XB_TOPGEN]) == tg, bar);
            __builtin_amdgcn_fence(__ATOMIC_ACQUIRE, "agent");
            xb_add(&bar[XB_XGEN(b.x)], 1u);
            asm volatile("s_waitcnt vmcnt(0)" ::: "memory");
        } else {
            XB_SPIN(xb_ld(&bar[XB_XGEN(b.x)]) == gen, bar);
            __builtin_amdgcn_fence(__ATOMIC_ACQUIRE, "agent");
            asm volatile("s_waitcnt vmcnt(0)" ::: "memory");
        }
    }
    __syncthreads();
}
#define LDS_WAIT() asm volatile("s_waitcnt lgkmcnt(0)" ::: "memory")

__device__ __forceinline__ int win_src(int c) {
    if (c < 1152) return c;
    if (c < 2304) return c + 1038;
    if (c < 3072) return c - 1146;
    if (c < 3328) return c - 1138;
    if (c < 3334) return c - 3328 + 1152;
    if (c < 3338) return c - 3334 + 1926;
    if (c < 3342) return c - 3338 + 1930;
    return -1;
}
__device__ __forceinline__ int wgu_src(int r) { const int pn = r >> 8, w = r & 255; return (w < 128 ? 0 : DFF) + pn * 128 + (w & 127); }
template <int MODE> __device__ __forceinline__ int src_col(int r) { if (MODE == 1) return win_src(r); if (MODE == 2) return wgu_src(r); return r; }

template <int MODE> __device__ __forceinline__ void transpose_item(const float* W, int K, int ldw, bf16* WT, LAS float* scr, int nblk, int item, int lane) {
    const int kb = item / nblk, nb = item % nblk, k0 = 64 * kb, n0 = 32 * nb;
    const int sc = src_col<MODE>(n0 + (lane & 31));
#pragma unroll 8
    for (int i = 0; i < 32; ++i) { const int kk = 2 * i + (lane >> 5); scr[kk * 33 + (lane & 31)] = (sc >= 0) ? W[(size_t)(k0 + kk) * ldw + sc] : 0.f; }
    LDS_WAIT(); asm volatile("" ::: "memory");
    const int c = lane & 7;
#pragma unroll
    for (int j = 0; j < 4; ++j) { const int n = (lane >> 3) + 8 * j; const LAS float* s = scr + (8 * c) * 33 + n;
        v4u o; o.x = pk2(s[0 * 33], s[1 * 33]); o.y = pk2(s[2 * 33], s[3 * 33]); o.z = pk2(s[4 * 33], s[5 * 33]); o.w = pk2(s[6 * 33], s[7 * 33]);
        *(GAS v4u*)(WT + (size_t)(n0 + n) * K + k0 + 8 * c) = o; }
    LDS_WAIT(); asm volatile("" ::: "memory");
}

__device__ __forceinline__ void p0_mod_unit(int u, const float* cvec, const float* w_ada, const float* b_ada, float* mod, LAS float* lds, int tid, int wave, int lane) {
    LAS float* sc = lds; LAS float* red = lds + 2048;
    for (int i = tid; i < 2048; i += NTHREADS) { const float v = cvec[i]; sc[i] = v / (1.f + expf(-v)); }
    __syncthreads();
    const int l = u / 96, n = (u % 96) * 64 + lane;
    const float* wp = w_ada + ((size_t)l * 1024 + wave * 128) * 6144 + n;
    float a0 = 0.f, a1 = 0.f;
#pragma unroll 16
    for (int kk = 0; kk < 128; ++kk) { const float w = wp[(size_t)kk * 6144]; a0 += sc[wave * 128 + kk] * w; a1 += sc[1024 + wave * 128 + kk] * w; }
    red[(wave * 2 + 0) * 64 + lane] = a0; red[(wave * 2 + 1) * 64 + lane] = a1;
    __syncthreads();
    if (tid < 128) { const int b = tid >> 6; float s = 0.f;
#pragma unroll
        for (int w = 0; w < 8; ++w) s += red[(w * 2 + b) * 64 + lane];
        mod[((size_t)l * 2 + b) * 6144 + n] = s + b_ada[l * 6144 + n]; }
    __syncthreads();
}

__device__ __forceinline__ void norm_rows(const float* xsrc, const float* g, const float* mod_l, int sh_off, int sc_off, bf16* XN, int gw, int NGW, int lane) {
    for (int m = gw; m < MROWS; m += NGW) {
        const int b = m / SEQ; const float* mb = mod_l + (size_t)b * 6144;
        const GAS f32x4* xr = (const GAS f32x4*)(xsrc + (size_t)m * DM) + lane;
        f32x4 v[4]; float ss = 0.f;
#pragma unroll
        for (int j = 0; j < 4; ++j) { v[j] = xr[64 * j]; ss += (v[j].x * v[j].x + v[j].y * v[j].y) + (v[j].z * v[j].z + v[j].w * v[j].w); }
        const float rstd = 1.f / sqrtf(wave_sum(ss) * (1.f / DM) + EPS);
        GAS v2u* o8 = (GAS v2u*)(XN + (size_t)m * DM) + lane;
#pragma unroll
        for (int j = 0; j < 4; ++j) { const int col = 4 * lane + 256 * j;
            const f32x4 gg = *(const f32x4*)(g + col), sv = *(const f32x4*)(mb + sc_off + col), hv = *(const f32x4*)(mb + sh_off + col);
            const f32x4 o = v[j] * rstd * gg * (sv + 1.0f) + hv;
            v2u w; w.x = pk2(o.x, o.y); w.y = pk2(o.z, o.w); o8[64 * j] = w; }
    }
}

__device__ __forceinline__ void post_foxcum_unit(int bh, const float* GATESp, float* FOXCUMp, const float* fox_f_bias, LAS float* lds, int tid, int wave, int lane) {
    const int b = bh / 6, h = bh % 6; const float bias = fox_f_bias[h];
    float v[32];
#pragma unroll
    for (int r = 0; r < 32; ++r) { const int t = wave * 2048 + r * 64 + lane; v[r] = log_sigmoid_f(GATESp[((size_t)b * SEQ + t) * 16 + h] + bias) * LOG2E; }
    float carry = 0.f;
#pragma unroll
    for (int r = 0; r < 32; ++r) { float x = v[r];
#pragma unroll
        for (int o = 1; o < 64; o <<= 1) { const float n = __shfl_up(x, o); if (lane >= o) x += n; }
        x += carry; v[r] = x; carry = __shfl(x, 63); }
    if (lane == 0) lds[wave] = carry;
    __syncthreads();
    float off = 0.f;
    for (int w = 0; w < wave; ++w) off += lds[w];
#pragma unroll
    for (int r = 0; r < 32; ++r) FOXCUMp[(size_t)bh * SEQ + wave * 2048 + r * 64 + lane] = v[r] + off;
    __syncthreads();
}
__device__ __forceinline__ void post_qknorm_unit(int blk, int grp, bf16* PROJp, float* KMEANp, const float* gains, LAS float* lds, int tid, int wave, int lane) {
    const int colbase = grp == 0 ? C_FQ : grp == 1 ? C_FK : grp == 2 ? C_BQ : C_BK;
    const float qs = (grp == 0 || grp == 2) ? QSCALE : 1.f;
    const int hsub = lane >> 5, d = 2 * (lane & 31);
    const float g0 = gains[d], g1 = gains[d + 1];
    float ka[3][2] = {{0.f, 0.f}, {0.f, 0.f}, {0.f, 0.f}};
    const size_t row0 = (size_t)blk * 256 + wave * 32;
#pragma unroll 4
    for (int r = 0; r < 32; ++r) {
#pragma unroll
        for (int it = 0; it < 3; ++it) {
            unsigned* p = (unsigned*)(PROJp + (row0 + r) * PLD + colbase + (2 * it + hsub) * 64 + d);
            const unsigned w = *p; const float v0 = bflo(w), v1 = bfhi(w);
            float ss = v0 * v0 + v1 * v1;
#pragma unroll
            for (int o = 1; o < 32; o <<= 1) ss += __shfl_xor(ss, o);
            const float rr = 1.f / sqrtf(ss * (1.f / 64.f) + EPS);
            const float o0 = v0 * rr * g0, o1 = v1 * rr * g1;
            *p = pk2(o0 * qs, o1 * qs);
            ka[it][0] += o0; ka[it][1] += o1;
        }
    }
    if (grp == 3) {
#pragma unroll
        for (int it = 0; it < 3; ++it) { lds[wave * 384 + (2 * it + hsub) * 64 + d] = ka[it][0]; lds[wave * 384 + (2 * it + hsub) * 64 + d + 1] = ka[it][1]; }
        __syncthreads();
        if (tid < 384) { float s = 0.f;
#pragma unroll
            for (int w = 0; w < 8; ++w) s += lds[w * 384 + tid];
            const int b = blk / NBLK, n = blk % NBLK, head = tid >> 6, dd = tid & 63;
            KMEANp[(((size_t)b * 6 + head) * NBLK + n) * 64 + dd] = s * (1.f / 256.f); }
        __syncthreads();
    }
}
__device__ __forceinline__ void post_conv_unit(int blk, int which, const bf16* PROJp, bf16* dst, const float* conv_w, const float* conv_b, int tid) {
    const bf16* src = PROJp + (which ? C_MK : C_MQ); const float osc = which ? 0.125f : 1.f;
    const int c = 2 * (tid & 127), rq = tid >> 7, ch = which * 256 + c;
    float w0[4], w1[4];
#pragma unroll
    for (int i = 0; i < 4; ++i) { w0[i] = conv_w[i * 512 + ch]; w1[i] = conv_w[i * 512 + ch + 1]; }
    const float b0 = conv_b[ch], b1 = conv_b[ch + 1];
    const size_t r0 = (size_t)blk * 256 + rq * 64; const int tl = (int)(r0 % SEQ);
    float xa[3][2];
#pragma unroll
    for (int k = 0; k < 3; ++k) { const int back = 3 - k;
        if (tl - back >= 0) { const unsigned w = *(const unsigned*)(src + (r0 - back) * PLD + c); xa[k][0] = bflo(w); xa[k][1] = bfhi(w); } else { xa[k][0] = 0.f; xa[k][1] = 0.f; } }
#pragma unroll 4
    for (int r = 0; r < 64; ++r) {
        const unsigned w = *(const unsigned*)(src + (r0 + r) * PLD + c); const float x0 = bflo(w), x1 = bfhi(w);
        float y0 = b0 + w0[0] * xa[0][0] + w0[1] * xa[1][0] + w0[2] * xa[2][0] + w0[3] * x0;
        float y1 = b1 + w1[0] * xa[0][1] + w1[1] * xa[1][1] + w1[2] * xa[2][1] + w1[3] * x1;
        y0 = y0 / (1.f + expf(-y0)) * osc; y1 = y1 / (1.f + expf(-y1)) * osc;
        *(unsigned*)(dst + (r0 + r) * 256 + c) = pk2(y0, y1);
        xa[0][0] = xa[1][0]; xa[0][1] = xa[1][1]; xa[1][0] = xa[2][0]; xa[1][1] = xa[2][1]; xa[2][0] = x0; xa[2][1] = x1;
    }
}

struct MlP { const bf16* PROJ; const bf16* QC; const bf16* KC; const float* GATES; float* U; float* NU; float* BEND; float* MLOC; bf16* CS; float* NS; float* MS; bf16* Y;
             const float *ibias, *fbias, *hg; };
__device__ __forceinline__ void unpack8(const v4u w, float* f) { f[0] = bflo(w.x); f[1] = bfhi(w.x); f[2] = bflo(w.y); f[3] = bfhi(w.y); f[4] = bflo(w.z); f[5] = bfhi(w.z); f[6] = bflo(w.w); f[7] = bfhi(w.w); }
__device__ __forceinline__ void mlstm_m1(int ci, const MlP& P, LAS float* lds, int tid, int wave, int lane) {
    const int b = ci >> 10, h = (ci >> 8) & 3, c = ci & 255; const size_t row0 = (size_t)b * SEQ + c * 64;
    LAS float* Ks = lds; LAS float* Vs = lds + 4096; LAS float* ws = lds + 8192;
    { const int r = tid >> 3, cg = (tid & 7) * 8; float f[8];
      unpack8(*(const v4u*)(P.KC + (row0 + r) * 256 + h * 64 + cg), f);
#pragma unroll
      for (int i = 0; i < 8; ++i) Ks[r * 64 + cg + i] = f[i];
      unpack8(*(const v4u*)(P.PROJ + (row0 + r) * PLD + C_MV + h * 64 + cg), f);
#pragma unroll
      for (int i = 0; i < 8; ++i) Vs[r * 64 + cg + i] = f[i]; }
    if (wave == 0) {
        const size_t row = row0 + lane;
        const float fi = P.GATES[row * 16 + 6 + h] + P.ibias[h], ff = P.GATES[row * 16 + 10 + h] + P.fbias[h];
        float bc = log_sigmoid_f(ff);
#pragma unroll
        for (int o = 1; o < 64; o <<= 1) { const float n = __shfl_up(bc, o); if (lane >= o) bc += n; }
        const float bend = __shfl(bc, 63);
        const float wl = bend - bc + fi; const float mloc = wave_max(wl);
        ws[lane] = expf(wl - mloc);
        if (lane == 0) { P.BEND[ci] = bend; P.MLOC[ci] = mloc; }
    }
    __syncthreads();
    { const int dv = tid >> 3, e0 = (tid & 7) * 8; float u[8] = {0.f, 0.f, 0.f, 0.f, 0.f, 0.f, 0.f, 0.f};
#pragma unroll 2
      for (int s = 0; s < 64; ++s) { const float vw = Vs[s * 64 + dv] * ws[s]; const f32x4 ka = *(const LAS f32x4*)(Ks + s * 64 + e0), kb = *(const LAS f32x4*)(Ks + s * 64 + e0 + 4);
          u[0] += vw * ka.x; u[1] += vw * ka.y; u[2] += vw * ka.z; u[3] += vw * ka.w; u[4] += vw * kb.x; u[5] += vw * kb.y; u[6] += vw * kb.z; u[7] += vw * kb.w; }
      float* up = P.U + (size_t)ci * 4096 + dv * 64 + e0;
      *(f32x4*)up = (f32x4){u[0], u[1], u[2], u[3]}; *(f32x4*)(up + 4) = (f32x4){u[4], u[5], u[6], u[7]}; }
    if (tid < 64) { float nu = 0.f; for (int s = 0; s < 64; ++s) nu += ws[s] * Ks[s * 64 + tid]; P.NU[(size_t)ci * 64 + tid] = nu; }
    __syncthreads();
}
__device__ __forceinline__ void mlstm_m2(int u, const MlP& P, int tid) {
    const int bh = u >> 3, eg = u & 7, elem = eg * 512 + tid, base = bh * 256;
    const bool donorm = (eg == 0 && tid < 64), doms = (eg == 0 && tid == 0);
    float C = 0.f, m = 0.f, nst = 0.f;
    for (int c0 = 0; c0 < 256; c0 += 8) {
        float uv[8], be[8], ml[8], nv[8];
#pragma unroll
        for (int i = 0; i < 8; ++i) { const int ci = base + c0 + i; uv[i] = P.U[(size_t)ci * 4096 + elem]; be[i] = P.BEND[ci]; ml[i] = P.MLOC[ci]; nv[i] = donorm ? P.NU[(size_t)ci * 64 + tid] : 0.f; }
#pragma unroll
        for (int i = 0; i < 8; ++i) { const int ci = base + c0 + i;
            P.CS[(size_t)ci * 4096 + elem] = (bf16)f2bf(C);
            if (donorm) P.NS[(size_t)ci * 64 + tid] = nst;
            if (doms) P.MS[ci] = m;
            const float mn = fmaxf(be[i] + m, ml[i]); const float dec = expf(be[i] + m - mn), wu = expf(ml[i] - mn);
            C = dec * C + wu * uv[i]; nst = dec * nst + wu * nv[i]; m = mn; }
    }
}
__device__ __forceinline__ void mlstm_m3(int ci, const MlP& P, LAS float* lds, int tid, int wave, int lane) {
    constexpr int LP = 68;
    const int b = ci >> 10, h = (ci >> 8) & 3, c = ci & 255; const size_t row0 = (size_t)b * SEQ + c * 64;
    LAS float* Qs = lds; LAS float* Ks = Qs + 64 * LP; LAS float* Cs = Ks + 64 * LP; LAS float* Sm = Cs + 64 * LP; LAS float* Vs = Sm + 64 * LP;
    LAS float* av = Vs + 4096; LAS float* gv = av + 64; LAS float* bcv = gv + 64; LAS float* nsv = bcv + 64;
    const float ms = P.MS[ci];
    { const int r = tid >> 3, cg = (tid & 7) * 8; float f[8];
      unpack8(*(const v4u*)(P.QC + (row0 + r) * 256 + h * 64 + cg), f);
#pragma unroll
      for (int i = 0; i < 8; ++i) Qs[r * LP + cg + i] = f[i];
      unpack8(*(const v4u*)(P.KC + (row0 + r) * 256 + h * 64 + cg), f);
#pragma unroll
      for (int i = 0; i < 8; ++i) Ks[r * LP + cg + i] = f[i];
      unpack8(*(const v4u*)(P.PROJ + (row0 + r) * PLD + C_MV + h * 64 + cg), f);
#pragma unroll
      for (int i = 0; i < 8; ++i) Vs[r * 64 + cg + i] = f[i];
      unpack8(*(const v4u*)(P.CS + (size_t)ci * 4096 + r * 64 + cg), f);
#pragma unroll
      for (int i = 0; i < 8; ++i) Cs[r * LP + cg + i] = f[i]; }
    if (wave == 0) {
        const size_t row = row0 + lane;
        const float fi = P.GATES[row * 16 + 6 + h] + P.ibias[h], ff = P.GATES[row * 16 + 10 + h] + P.fbias[h];
        float bc = log_sigmoid_f(ff);
#pragma unroll
        for (int o = 1; o < 64; o <<= 1) { const float n = __shfl_up(bc, o); if (lane >= o) bc += n; }
        const float a = fi - bc; float pm = a;
#pragma unroll
        for (int o = 1; o < 64; o <<= 1) { const float n = __shfl_up(pm, o); if (lane >= o) pm = fmaxf(pm, n); }
        av[lane] = a; gv[lane] = fmaxf(ms, pm); bcv[lane] = bc; nsv[lane] = P.NS[(size_t)ci * 64 + lane];
    }
    __syncthreads();
    const int j = tid >> 3, part = tid & 7, s0 = part * 8;
    const float gj = gv[j];
    { float sacc[8] = {0.f, 0.f, 0.f, 0.f, 0.f, 0.f, 0.f, 0.f};
#pragma unroll 1
      for (int e = 0; e < 64; e += 4) { const f32x4 q4 = *(const LAS f32x4*)(Qs + j * LP + e);
#pragma unroll
          for (int i = 0; i < 8; ++i) { const f32x4 k4 = *(const LAS f32x4*)(Ks + (s0 + i) * LP + e); sacc[i] += (q4.x * k4.x + q4.y * k4.y) + (q4.z * k4.z + q4.w * k4.w); } }
#pragma unroll
      for (int i = 0; i < 8; ++i) { const int s = s0 + i; Sm[j * LP + s] = (s <= j) ? sacc[i] * expf(av[s] - gj) : 0.f; } }
    __syncthreads();
    { const int dv0 = part * 8; float t1[8] = {0.f, 0.f, 0.f, 0.f, 0.f, 0.f, 0.f, 0.f}, t2[8] = {0.f, 0.f, 0.f, 0.f, 0.f, 0.f, 0.f, 0.f};
#pragma unroll 1
      for (int e = 0; e < 64; e += 4) { const f32x4 q4 = *(const LAS f32x4*)(Qs + j * LP + e);
#pragma unroll
          for (int i = 0; i < 8; ++i) { const f32x4 c4 = *(const LAS f32x4*)(Cs + (dv0 + i) * LP + e); t1[i] += (q4.x * c4.x + q4.y * c4.y) + (q4.z * c4.z + q4.w * c4.w); } }
#pragma unroll 2
      for (int s = 0; s < 64; ++s) { const float sm = Sm[j * LP + s]; const f32x4 va = *(const LAS f32x4*)(Vs + s * 64 + dv0), vb = *(const LAS f32x4*)(Vs + s * 64 + dv0 + 4);
          t2[0] += sm * va.x; t2[1] += sm * va.y; t2[2] += sm * va.z; t2[3] += sm * va.w; t2[4] += sm * vb.x; t2[5] += sm * vb.y; t2[6] += sm * vb.z; t2[7] += sm * vb.w; }
      float dn = 0.f, ssum = 0.f;
#pragma unroll
      for (int i = 0; i < 8; ++i) { dn += nsv[s0 + i] * Qs[j * LP + s0 + i]; ssum += Sm[j * LP + s0 + i]; }
#pragma unroll
      for (int o = 1; o < 8; o <<= 1) { dn += __shfl_xor(dn, o); ssum += __shfl_xor(ssum, o); }
      const float inter = expf(ms - gj), mj = bcv[j] + gj;
      const float den = inter * dn + ssum, dd = fmaxf(fabsf(den), expf(-mj)), rd = 1.f / dd;
      float hv[8], ss = 0.f;
#pragma unroll
      for (int i = 0; i < 8; ++i) { hv[i] = (inter * t1[i] + t2[i]) * rd; ss += hv[i] * hv[i]; }
#pragma unroll
      for (int o = 1; o < 8; o <<= 1) ss += __shfl_xor(ss, o);
      const float rr = 1.f / sqrtf(ss * (1.f / 64.f) + EPS);
      float mo[8]; unpack8(*(const v4u*)(P.PROJ + (row0 + j) * PLD + C_MO + h * 64 + dv0), mo);
      float y[8];
#pragma unroll
      for (int i = 0; i < 8; ++i) y[i] = hv[i] * rr * P.hg[h * 64 + dv0 + i] * sigmoid_f(mo[i]);
      v4u w; w.x = pk2(y[0], y[1]); w.y = pk2(y[2], y[3]); w.z = pk2(y[4], y[5]); w.w = pk2(y[6], y[7]);
      *(v4u*)(P.Y + (row0 + j) * 1024 + Y_ML + h * 64 + dv0) = w; }
    __syncthreads();
}

__device__ __forceinline__ size_t moba_list_off(int bh, int n);
__device__ __forceinline__ void moba_gate_unit(int u, const bf16* PROJ, const float* KMEAN, unsigned* SEL, unsigned* LCNT, unsigned short* LIST, LAS float* lds, int tid) {
    const int bh = u >> 6, qb = 63 - (u & 63), b = bh / 6, h = bh % 6;
    LAS float* km = lds; LAS float* cand = lds + 4096;
    for (int i = tid; i < qb * 16; i += NTHREADS) *(LAS f32x4*)(km + i * 4) = *(const f32x4*)(KMEAN + (size_t)bh * NBLK * 64 + i * 4);
    __syncthreads();
    const int query = tid & 255, half = tid >> 8; const size_t row = (size_t)b * SEQ + qb * 256 + query;
    float q[64];
#pragma unroll
    for (int i = 0; i < 8; ++i) unpack8(*(const v4u*)(PROJ + row * PLD + C_BQ + h * 64 + i * 8), q + i * 8);
    float v0 = -INFINITY, v1 = -INFINITY, v2 = -INFINITY; int i0 = 255, i1 = 255, i2 = 255;
    const int nlo = half * 32, nhi = (qb < nlo + 32) ? qb : nlo + 32;
    for (int n = nlo; n < nhi; ++n) { float g = 0.f;
#pragma unroll
        for (int d = 0; d < 64; d += 4) { const f32x4 k4 = *(const LAS f32x4*)(km + n * 64 + d); g += (q[d] * k4.x + q[d + 1] * k4.y) + (q[d + 2] * k4.z + q[d + 3] * k4.w); }
        if (g > v0) { v2 = v1; i2 = i1; v1 = v0; i1 = i0; v0 = g; i0 = n; } else if (g > v1) { v2 = v1; i2 = i1; v1 = g; i1 = n; } else if (g > v2) { v2 = g; i2 = n; } }
    if (half == 1) { cand[query * 6 + 0] = v0; cand[query * 6 + 1] = v1; cand[query * 6 + 2] = v2;
        cand[query * 6 + 3] = __int_as_float(i0); cand[query * 6 + 4] = __int_as_float(i1); cand[query * 6 + 5] = __int_as_float(i2); }
    __syncthreads();
    if (half == 0) {
#pragma unroll
        for (int k = 0; k < 3; ++k) { const float g = cand[query * 6 + k]; const int n = __float_as_int(cand[query * 6 + 3 + k]);
            if (n != 255) { if (g > v0) { v2 = v1; i2 = i1; v1 = v0; i1 = i0; v0 = g; i0 = n; } else if (g > v1) { v2 = v1; i2 = i1; v1 = g; i1 = n; } else if (g > v2) { v2 = g; i2 = n; } } }
        SEL[row * 6 + h] = (unsigned)i0 | ((unsigned)i1 << 8) | ((unsigned)i2 << 16);
        if (LIST) { const unsigned t = (unsigned)(qb * 256 + query);
            if (i0 != 255) { const unsigned pos = atomicAdd(LCNT + bh * 64 + i0, 1u); LIST[moba_list_off(bh, i0) + pos] = (unsigned short)(t | (0u << 14)); }
            if (i1 != 255) { const unsigned pos = atomicAdd(LCNT + bh * 64 + i1, 1u); LIST[moba_list_off(bh, i1) + pos] = (unsigned short)(t | (1u << 14)); }
            if (i2 != 255) { const unsigned pos = atomicAdd(LCNT + bh * 64 + i2, 1u); LIST[moba_list_off(bh, i2) + pos] = (unsigned short)(t | (2u << 14)); } }
    }
    __syncthreads();
}

__device__ __forceinline__ void fox_naive(const bf16* PROJ, const float* FOXCUM, bf16* Y, int gw, int NGW, int lane) {
    for (int idx = gw; idx < 12 * SEQ; idx += NGW) {
        const int t = SEQ - 1 - idx / 12, bh = idx % 12, b = bh / 6, h = bh % 6; const size_t rb = (size_t)b * SEQ;
        const float qv = bf2f(PROJ[(rb + t) * PLD + C_FQ + h * 64 + lane]); const float ct = FOXCUM[(size_t)bh * SEQ + t];
        float m = -INFINITY, l = 0.f, acc = 0.f;
#pragma unroll 4
        for (int j = 0; j <= t; ++j) {
            const float kv = bf2f(PROJ[(rb + j) * PLD + C_FK + h * 64 + lane]), vv = bf2f(PROJ[(rb + j) * PLD + C_FV + h * 64 + lane]);
            const float s = wave_sum(qv * kv) + (ct - FOXCUM[(size_t)bh * SEQ + j]);
            const float mn = fmaxf(m, s), sc = exp2f(m - mn), p = exp2f(s - mn);
            l = l * sc + p; acc = acc * sc + p * vv; m = mn; }
        Y[(rb + t) * 1024 + Y_FOX + h * 64 + lane] = (bf16)f2bf(acc / l);
    }
}
__device__ __forceinline__ void moba_naive(const bf16* PROJ, const unsigned* SEL, bf16* Y, int gw, int NGW, int lane) {
    for (int idx = gw; idx < 12 * SEQ; idx += NGW) {
        const int t = SEQ - 1 - idx / 12, bh = idx % 12, b = bh / 6, h = bh % 6; const size_t rb = (size_t)b * SEQ;
        const float slope2 = exp2f(-8.f * (float)(h + 1) / 6.f) * LOG2E;
        const float qv = bf2f(PROJ[(rb + t) * PLD + C_BQ + h * 64 + lane]);
        const unsigned sel = SEL[(rb + t) * 6 + h];
        float m = -INFINITY, l = 0.f, acc = 0.f;
        for (int slot = 0; slot < 4; ++slot) {
            int j0, j1;
            if (slot < 3) { const int n = (sel >> (8 * slot)) & 0xff; if (n == 255) continue; j0 = n * 256; j1 = j0 + 256; } else { j0 = (t >> 8) * 256; j1 = t + 1; }
#pragma unroll 4
            for (int j = j0; j < j1; ++j) {
                const float kv = bf2f(PROJ[(rb + j) * PLD + C_BK + h * 64 + lane]), vv = bf2f(PROJ[(rb + j) * PLD + C_BV + h * 64 + lane]);
                const float s = wave_sum(qv * kv) - slope2 * (float)(t - j);
                const float mn = fmaxf(m, s), sc = exp2f(m - mn), p = exp2f(s - mn);
                l = l * sc + p; acc = acc * sc + p * vv; m = mn; }
        }
        Y[(rb + t) * 1024 + Y_MOBA + h * 64 + lane] = (bf16)f2bf(acc / l);
    }
}
typedef short v4i16_t __attribute__((ext_vector_type(4)));
typedef short s16x4 __attribute__((ext_vector_type(4)));
constexpr int ATT_K0 = 0, ATT_V0 = 32768, ATT_TAB = 132096;
constexpr float THRESH2 = 40.f * LOG2E;

__device__ __forceinline__ int crow(int r, int hi) { return (r & 3) + 8 * (r >> 2) + 4 * hi; }
__device__ __forceinline__ s16x4 vtr(LAS const unsigned char* p) { return __builtin_bit_cast(s16x4, __builtin_amdgcn_ds_read_tr16_b64_v4i16((LAS v4i16_t*)p)); }
__device__ __forceinline__ unsigned cvtpk(float lo, float hi) { unsigned r; asm volatile("v_cvt_pk_bf16_f32 %0, %1, %2" : "=v"(r) : "v"(lo), "v"(hi)); return r; }

__device__ __forceinline__ void load_group(const bf16* Kg, const bf16* Vg, LAS unsigned char* lds, int tid) {
#pragma unroll
    for (int i = 0; i < 4; ++i) { const int idx = tid + NTHREADS * i, row = idx >> 3, ch = idx & 7;
        const v4u k = *(const v4u*)(Kg + (size_t)row * PLD + ch * 8), v = *(const v4u*)(Vg + (size_t)row * PLD + ch * 8);
        *(LAS v4u*)(lds + ATT_K0 + row * 128 + ((ch ^ ((row >> 1) & 7)) << 4)) = k;
        *(LAS v4u*)(lds + ATT_V0 + row * 128 + ((ch * 16) ^ (((row >> 1) & 1) << 6))) = v; }
}

template <bool FOX>
__device__ __forceinline__ void attn_subtile(LAS const unsigned char* lds, int j0, const bf16x8 (&qf)[4], float rowterm, float slope2, bool mask, int qrel,
                                             f32x16 (&o)[2], float& l, int lane) {
    const int r32 = lane & 31, hh = lane >> 5;
    f32x16 acc;
    if (FOX) { LAS const float* colt = (LAS const float*)(lds + ATT_TAB);
#pragma unroll
        for (int g = 0; g < 4; ++g) { const f32x4 c = *(LAS const f32x4*)(colt + j0 + 8 * g + 4 * hh); acc[4 * g + 0] = rowterm + c.x; acc[4 * g + 1] = rowterm + c.y; acc[4 * g + 2] = rowterm + c.z; acc[4 * g + 3] = rowterm + c.w; }
    } else {
#pragma unroll
        for (int r = 0; r < 16; ++r) acc[r] = rowterm + slope2 * (float)(j0 + crow(r, hh));
    }
    if (mask) {
#pragma unroll
        for (int r = 0; r < 16; ++r) if (j0 + crow(r, hh) > qrel) acc[r] = -INFINITY;
    }
    { const int row = j0 + r32; LAS const unsigned char* kr = lds + ATT_K0 + row * 128; const int sw = (row >> 1) & 7;
#pragma unroll
      for (int s = 0; s < 4; ++s) { const bf16x8 kf = *(LAS const bf16x8*)(kr + (((2 * s + hh) ^ sw) << 4)); acc = __builtin_amdgcn_mfma_f32_32x32x16_bf16(kf, qf[s], acc, 0, 0, 0); } }
    float ls = 0.f;
#pragma unroll
    for (int r = 0; r < 16; ++r) { acc[r] = __builtin_amdgcn_exp2f(acc[r]); ls += acc[r]; }
    l += ls;
    bf16x8 pa[2];
#pragma unroll
    for (int s = 0; s < 2; ++s) { v4u w; w.x = cvtpk(acc[8 * s + 0], acc[8 * s + 1]); w.y = cvtpk(acc[8 * s + 2], acc[8 * s + 3]); w.z = cvtpk(acc[8 * s + 4], acc[8 * s + 5]); w.w = cvtpk(acc[8 * s + 6], acc[8 * s + 7]); pa[s] = __builtin_bit_cast(bf16x8, w); }
    { const int i = lane & 15, c = (lane >> 4) & 1;
#pragma unroll
      for (int db = 0; db < 2; ++db)
#pragma unroll
          for (int s = 0; s < 2; ++s) { const int rowv = j0 + 16 * s + 4 * hh + (i >> 2); const int colb = (32 * db + 16 * c + 4 * (i & 3)) * 2;
              LAS const unsigned char* vp = lds + ATT_V0 + rowv * 128 + (colb ^ (((rowv >> 1) & 1) << 6));
              const s16x4 lo = vtr(vp), hi = vtr(vp + 8 * 128);
              const bf16x8 vf = (bf16x8){lo[0], lo[1], lo[2], lo[3], hi[0], hi[1], hi[2], hi[3]};
              o[db] = __builtin_amdgcn_mfma_f32_32x32x16_bf16(pa[s], vf, o[db], 0, 0, 0); } }
}

__device__ __forceinline__ void fox_unit(int bh, int qb, const bf16* PROJ, const float* FOXCUM, bf16* Y, float B2, LAS unsigned char* lds, int tid, int wave, int lane) {
    const int b = bh / 6, h = bh % 6; const size_t rb = (size_t)b * SEQ; const int r32 = lane & 31, hh = lane >> 5;
    const int q0w = qb * 256 + wave * 32, qpos = q0w + r32;
    const float* cum = FOXCUM + (size_t)bh * SEQ;
    bf16x8 qf[4];
#pragma unroll
    for (int s = 0; s < 4; ++s) qf[s] = *(const bf16x8*)(PROJ + (rb + qpos) * PLD + C_FQ + h * 64 + 16 * s + 8 * hh);
    const float cq = cum[qpos];
    const float cq_first = __builtin_bit_cast(float, __builtin_amdgcn_readfirstlane(__builtin_bit_cast(int, cum[q0w])));
    const float cq_blk = __builtin_bit_cast(float, __builtin_amdgcn_readfirstlane(__builtin_bit_cast(int, cum[qb * 256])));
    const float rowterm = cq - B2;
    f32x16 o[2]; float l = 0.f;
#pragma unroll
    for (int r = 0; r < 16; ++r) { o[0][r] = 0.f; o[1][r] = 0.f; }
    LAS float* colt = (LAS float*)(lds + ATT_TAB);
    for (int g = qb; g >= 0; --g) {
        if (g < qb) { const float cl = __builtin_bit_cast(float, __builtin_amdgcn_readfirstlane(__builtin_bit_cast(int, cum[g * 256 + 255]))); if (2.f * B2 + cq_blk - cl < -THRESH2) break; }
        load_group(PROJ + (rb + (size_t)g * 256) * PLD + C_FK + h * 64, PROJ + (rb + (size_t)g * 256) * PLD + C_FV + h * 64, lds, tid);
        if (tid < 256) colt[tid] = -cum[g * 256 + tid];
        __syncthreads();
        const int stmax = (g == qb) ? wave : 7;
        for (int st = stmax; st >= 0; --st) {
            const int j0 = 32 * st;
            { const float cl = __builtin_bit_cast(float, __builtin_amdgcn_readfirstlane(__builtin_bit_cast(int, colt[j0 + 31]))); if (2.f * B2 + cq_first + cl < -THRESH2) break; }
            attn_subtile<true>(lds, j0, qf, rowterm, 0.f, (g == qb) && (st == wave), wave * 32 + r32, o, l, lane);
        }
        __syncthreads();
    }
    l += __shfl_xor(l, 32);
    bf16* yp = Y + (rb + (size_t)q0w) * 1024 + Y_FOX + h * 64 + r32;
#pragma unroll
    for (int r = 0; r < 16; ++r) { const int q = crow(r, hh); const float rl = 1.f / __shfl(l, q);
        yp[(size_t)q * 1024] = (bf16)f2bf(o[0][r] * rl); yp[(size_t)q * 1024 + 32] = (bf16)f2bf(o[1][r] * rl); }
}

__device__ __forceinline__ size_t moba_list_off(int bh, int n) { return (size_t)bh * 516096 + 256 * (size_t)(63 * n - (n * (n - 1)) / 2); }
__device__ __forceinline__ void moba_unit(int bh, int n, int chunk, bool own, int cnt, const bf16* PROJ, const unsigned short* LIST, bf16* OPART, float* LPART, bf16* Y, float B2,
                                          LAS unsigned char* lds, int tid, int wave, int lane) {
    const int b = bh / 6, h = bh % 6; const size_t rb = (size_t)b * SEQ; const int r32 = lane & 31, hh = lane >> 5;
    const float slope2 = exp2f(-8.f * (float)(h + 1) / 6.f) * LOG2E;
    load_group(PROJ + (rb + (size_t)n * 256) * PLD + C_BK + h * 64, PROJ + (rb + (size_t)n * 256) * PLD + C_BV + h * 64, lds, tid);
    __syncthreads();
    const int nvalid = own ? 256 : (cnt - chunk * 256 < 256 ? cnt - chunk * 256 : 256);
    if (wave * 32 < nvalid) {
        int qpos, slot; bool valid = true;
        if (own) { qpos = n * 256 + wave * 32 + r32; slot = 3; }
        else { int li = wave * 32 + r32; if (li >= nvalid) { li = nvalid - 1; valid = false; } const unsigned e = LIST[moba_list_off(bh, n) + (size_t)chunk * 256 + li]; qpos = e & 0x3fff; slot = e >> 14; }
        bf16x8 qf[4];
#pragma unroll
        for (int s = 0; s < 4; ++s) qf[s] = *(const bf16x8*)(PROJ + (rb + qpos) * PLD + C_BQ + h * 64 + 16 * s + 8 * hh);
        const int qrel = qpos - n * 256;
        const float rowterm = -slope2 * (float)qrel - B2;
        f32x16 o[2]; float l = 0.f;
#pragma unroll
        for (int r = 0; r < 16; ++r) { o[0][r] = 0.f; o[1][r] = 0.f; }
        const int stmax = own ? wave : 7;
        for (int st = 0; st <= stmax; ++st) attn_subtile<false>(lds, 32 * st, qf, rowterm, slope2, own && (st == wave), qrel, o, l, lane);
        l += __shfl_xor(l, 32);
#pragma unroll
        for (int r = 0; r < 16; ++r) { const int src = crow(r, hh);
            const int qp = __shfl(qpos, src), sl = __shfl(slot, src); const int ok = __shfl((int)valid, src);
            if (ok) { bf16* op = (sl == 3) ? (Y + (rb + qp) * 1024 + Y_MOBA + h * 64) : (OPART + ((size_t)sl * MROWS + rb + qp) * 384 + h * 64);
                op[r32] = (bf16)f2bf(o[0][r]); op[32 + r32] = (bf16)f2bf(o[1][r]); } }
        if (valid && hh == 0) LPART[((size_t)slot * MROWS + rb + qpos) * 6 + h] = l;
    }
    __syncthreads();
}

__device__ __forceinline__ void moba_combine(const unsigned* SEL, const bf16* OPART, const float* LPART, bf16* Y, int gtid, int ngt) {
    for (size_t idx = gtid; idx < (size_t)MROWS * 48; idx += ngt) {
        const size_t row = idx / 48; const int hc = (int)(idx % 48), h = hc >> 3, c8 = (hc & 7) * 8;
        const unsigned sel = SEL[row * 6 + h];
        bf16* yp = Y + row * 1024 + Y_MOBA + h * 64 + c8;
        float acc[8]; unpack8(*(const v4u*)yp, acc);
        float l = LPART[((size_t)3 * MROWS + row) * 6 + h];
#pragma unroll
        for (int k = 0; k < 3; ++k) if (((sel >> (8 * k)) & 0xff) != 255) { float f[8]; unpack8(*(const v4u*)(OPART + ((size_t)k * MROWS + row) * 384 + h * 64 + c8), f);
#pragma unroll
            for (int i = 0; i < 8; ++i) acc[i] += f[i];
            l += LPART[((size_t)k * MROWS + row) * 6 + h]; }
        const float rl = 1.f / l;
        v4u w; w.x = pk2(acc[0] * rl, acc[1] * rl); w.y = pk2(acc[2] * rl, acc[3] * rl); w.z = pk2(acc[4] * rl, acc[5] * rl); w.w = pk2(acc[6] * rl, acc[7] * rl);
        *(v4u*)yp = w;
    }
}
#ifndef FOX_MFMA
#define FOX_MFMA 1
#endif
#ifndef MOBA_MFMA
#define MOBA_MFMA 1
#endif
#ifndef N_LAUNCH_MODE
#define N_LAUNCH_MODE 1
#endif
constexpr int NPHASE = 1 + 10 * DEPTH;
struct Args { const float* in[20]; float* out; unsigned char* ws; int ph_lo, ph_hi; };
static_assert(sizeof(Args) == 20 * 8 + 8 + 8 + 8, "Args has no padding");

__global__ void __launch_bounds__(NTHREADS, 2) fwd(Args args) {
    extern __shared__ __attribute__((aligned(16))) unsigned char lds_raw[];
    LAS unsigned char* lds = (LAS unsigned char*)lds_raw;
    LAS float* ldsf = (LAS float*)lds_raw;
    volatile LAS unsigned* MISC = (volatile LAS unsigned*)(lds + MISC_OFF);
    const int G = gridDim.x; const int bx = blockIdx.x; const int vcu = (G % 8 == 0) ? (bx % 8) * (G / 8) + bx / 8 : bx;
    const int NGW = G * NWAVES;
#define PH_IDS() int tid = threadIdx.x; asm volatile("" : "+v"(tid)); const int lane = tid & 63, wave = __builtin_amdgcn_readfirstlane(tid >> 6); const int gw = vcu * NWAVES + wave; (void)lane; (void)gw
    unsigned char* ws = args.ws;
    gu32* ctl = (gu32*)(ws + WS_CTL);
    for (int u = threadIdx.x; u < (LDS_BYTES - LDSCTL_OFF) / 4; u += NTHREADS) ((LAS unsigned*)(lds + LDSCTL_OFF))[u] = 0u;
    __syncthreads();
    XcdBarrier bar; bar.bar = (unsigned*)(ctl + CW_BAR); bar.x = 0; bar.st = nullptr;
    if (N_LAUNCH_MODE == 1) bar = xcd_barrier_post((unsigned*)(ctl + CW_BAR), MISC + 8);
    const int lo = args.ph_lo, hi = args.ph_hi;
#ifndef PHMASK
#define PHMASK 0x7ff
#endif
#define PHEN(j) ((PHMASK >> (j)) & 1)
#define IN(k) (lo <= (k) && (k) < hi)
#define SEAM(k) do { if (IN(k) && IN((k) + 1)) xcd_barrier(bar); } while (0)

    const float* x_in = args.in[0]; const float* cvec = args.in[1]; const float* w_ada = args.in[2]; const float* b_ada = args.in[3];
    const float* norm1_g = args.in[4]; const float* norm2_g = args.in[5]; const float* w_in = args.in[6]; const float* fox_f_bias = args.in[7];
    const float* fox_q_g = args.in[8]; const float* fox_k_g = args.in[9]; const float* ml_conv_w = args.in[10]; const float* ml_conv_b = args.in[11];
    const float* ml_i_bias = args.in[12]; const float* ml_f_bias = args.in[13]; const float* ml_h_g = args.in[14]; const float* moba_q_g = args.in[15];
    const float* moba_k_g = args.in[16]; const float* w_out = args.in[17]; const float* w_gate_up = args.in[18]; const float* w_down = args.in[19];
    float* xres = args.out;
    float* MOD = (float*)(ws + WS_MOD);
    bf16* XN = (bf16*)(ws + WS_XN); bf16* PROJ = (bf16*)(ws + WS_PROJ); bf16* HB = (bf16*)(ws + WS_H); bf16* Y = (bf16*)(ws + WS_Y);
    float* GATES = (float*)(ws + WS_GATES); float* FOXCUM = (float*)(ws + WS_FOXCUM); float* KMEAN = (float*)(ws + WS_KMEAN);
    bf16* QC = (bf16*)(ws + WS_QC); bf16* KC = (bf16*)(ws + WS_KC); unsigned* SEL = (unsigned*)(ws + WS_SEL);

    if (PHEN(10) && IN(0)) { PH_IDS();
        if (vcu < 192) p0_mod_unit(vcu, cvec, w_ada, b_ada, MOD, ldsf, tid, wave, lane);
        LAS float* scr = (LAS float*)(lds + wave * 16384);
        constexpr int I_IN = 16 * (NIN / 32), I_OUT = 16 * (DM / 32), I_GU = 16 * (NGU / 32), I_DN = (DFF / 64) * (DM / 32), I_L = I_IN + I_OUT + I_GU + I_DN;
        for (int it = gw; it < DEPTH * I_L; it += NGW) {
            const int l = it / I_L; int r = it % I_L;
            if (r < I_IN) { transpose_item<1>(w_in + (size_t)l * DM * INC, DM, INC, (bf16*)(ws + WS_WIN + l * WIN_BYTES), scr, NIN / 32, r, lane); continue; } r -= I_IN;
            if (r < I_OUT) { transpose_item<0>(w_out + (size_t)l * DM * DM, DM, DM, (bf16*)(ws + WS_WOUT + l * WOUT_BYTES), scr, DM / 32, r, lane); continue; } r -= I_OUT;
            if (r < I_GU) { transpose_item<2>(w_gate_up + (size_t)l * DM * NGU, DM, NGU, (bf16*)(ws + WS_WGU + l * WGU_BYTES), scr, NGU / 32, r, lane); continue; } r -= I_GU;
            transpose_item<0>(w_down + (size_t)l * DFF * DM, DFF, DM, (bf16*)(ws + WS_WDN + l * WDN_BYTES), scr, DM / 32, r, lane);
        }
    }
    SEAM(0);

    for (int l = 0; l < DEPTH; ++l) {
        const int pb = 1 + 10 * l;
        const float* mod_l = MOD + (size_t)l * 2 * 6144;
        const float* xcur = (l == 0) ? x_in : xres;
        if (PHEN(0) && IN(pb + 0)) { PH_IDS(); norm_rows(xcur, norm1_g + l * DM, mod_l, 0, 1024, XN, gw, NGW, lane); }
        SEAM(pb + 0);
        if (PHEN(1) && IN(pb + 1)) { PH_IDS();
            pg8::Gemm g{XN, (const bf16*)(ws + WS_WIN + l * WIN_BYTES), MROWS, NIN, DM}; pg8::StaticOrder S; S.init(MROWS, NIN, G, bx);
            pg8::EpiProj E{PROJ, GATES, PLD};
            pg8::gemm_phase<pg8::EpiProj, pg8::StaticOrder, true, true>(lds, g, S, E, tid);
        }
        SEAM(pb + 1);
        if (PHEN(2) && IN(pb + 2)) { PH_IDS();
            for (int u = vcu; u < 780; u += G) {
                if (u < 12) post_foxcum_unit(u, GATES, FOXCUM, fox_f_bias + l * 6, ldsf, tid, wave, lane);
                else if (u < 524) { const int grp = (u - 12) & 3; const float* gains = (grp == 0 ? fox_q_g : grp == 1 ? fox_k_g : grp == 2 ? moba_q_g : moba_k_g) + l * 64;
                    post_qknorm_unit((u - 12) >> 2, grp, PROJ, KMEAN, gains, ldsf, tid, wave, lane); }
                else { const int which = (u - 524) & 1; post_conv_unit((u - 524) >> 1, which, PROJ, which ? KC : QC, ml_conv_w + l * 4 * 512, ml_conv_b + l * 512, tid); }
            }
        }
        SEAM(pb + 2);
        MlP MP{PROJ, QC, KC, GATES, (float*)(ws + WS_U), (float*)(ws + WS_NU), (float*)(ws + WS_BEND), (float*)(ws + WS_MLOC), (bf16*)(ws + WS_CS), (float*)(ws + WS_NS), (float*)(ws + WS_MS), Y,
               ml_i_bias + l * 4, ml_f_bias + l * 4, ml_h_g + l * 256};
        if (PHEN(3) && IN(pb + 3)) { PH_IDS();
            unsigned* LCNT = (unsigned*)(ctl + CW_LCNT + l * 768); unsigned short* LIST = MOBA_MFMA ? (unsigned short*)(ws + WS_LIST) : nullptr;
            for (int u = vcu; u < 768 + 2048; u += G) {
                if (u < 768) moba_gate_unit(u, PROJ, KMEAN, SEL, LCNT, LIST, ldsf, tid);
                else mlstm_m1(u - 768, MP, ldsf, tid, wave, lane);
            }
#if FOX_MFMA
            { const float gq = wave_max(fabsf(fox_q_g[l * 64 + lane])), gk = wave_max(fabsf(fox_k_g[l * 64 + lane])); const float B2 = 8.f * LOG2E * gq * gk * 1.01f;
              for (int u = vcu; u < 768; u += G) fox_unit(u >> 6, 63 - (u & 63), PROJ, FOXCUM, Y, B2, lds, tid, wave, lane); }
#else
            fox_naive(PROJ, FOXCUM, Y, gw, NGW, lane);
#endif
        }
        SEAM(pb + 3);
        if (PHEN(4) && IN(pb + 4)) { PH_IDS();
            for (int u = vcu; u < 64; u += G) mlstm_m2(u, MP, tid);
#if MOBA_MFMA
            { const float gq = wave_max(fabsf(moba_q_g[l * 64 + lane])), gk = wave_max(fabsf(moba_k_g[l * 64 + lane])); const float B2 = 8.f * LOG2E * gq * gk * 1.01f;
              LAS int* pre = (LAS int*)(lds + ATT_TAB + 1024);
              const unsigned* lcnt = (const unsigned*)(ctl + CW_LCNT + l * 768);
              if (wave == 0) { int carry = 0;
                  for (int r = 0; r < 12; ++r) { const int p = r * 64 + lane; int x = (int)((lcnt[p] + 255u) >> 8);
#pragma unroll
                      for (int o = 1; o < 64; o <<= 1) { const int n = __shfl_up(x, o); if (lane >= o) x += n; }
                      pre[p + 1] = carry + x; carry += __shfl(x, 63); }
                  if (lane == 0) pre[0] = 0; }
              __syncthreads();
              const int S = pre[768];
              const unsigned short* LIST = (const unsigned short*)(ws + WS_LIST); bf16* OPART = (bf16*)(ws + WS_OPART); float* LPART = (float*)(ws + WS_LPART);
              for (int u = vcu; u < S + 768; u += G) {
                  if (u < S) { int lo2 = 0, hi2 = 768; while (hi2 - lo2 > 1) { const int mid = (lo2 + hi2) >> 1; if (pre[mid] <= u) lo2 = mid; else hi2 = mid; }
                      moba_unit(lo2 >> 6, lo2 & 63, u - pre[lo2], false, (int)lcnt[lo2], PROJ, LIST, OPART, LPART, Y, B2, lds, tid, wave, lane); }
                  else { const int p = u - S; moba_unit(p >> 6, 63 - (p & 63), 0, true, 256, PROJ, LIST, OPART, LPART, Y, B2, lds, tid, wave, lane); }
              } }
#else
            moba_naive(PROJ, SEL, Y, gw, NGW, lane);
#endif
        }
        SEAM(pb + 4);
        if (PHEN(5) && IN(pb + 5)) { PH_IDS();
            for (int u = vcu; u < 2048; u += G) mlstm_m3(u, MP, ldsf, tid, wave, lane);
#if MOBA_MFMA
            moba_combine(SEL, (const bf16*)(ws + WS_OPART), (const float*)(ws + WS_LPART), Y, vcu * NTHREADS + tid, G * NTHREADS);
#endif
        }
        SEAM(pb + 5);
        if (PHEN(6) && IN(pb + 6)) { PH_IDS();
            pg8::Gemm g{Y, (const bf16*)(ws + WS_WOUT + l * WOUT_BYTES), MROWS, DM, DM}; pg8::StaticOrder S; S.init(MROWS, DM, G, bx);
            pg8::EpiRes E{xcur, xres, mod_l + 2048, 6144, SEQ};
            pg8::gemm_phase<pg8::EpiRes, pg8::StaticOrder, true, true>(lds, g, S, E, tid);
        }
        SEAM(pb + 6);
        if (PHEN(7) && IN(pb + 7)) { PH_IDS(); norm_rows(xres, norm2_g + l * DM, mod_l, 3072, 4096, XN, gw, NGW, lane); }
        SEAM(pb + 7);
        if (PHEN(8) && IN(pb + 8)) { PH_IDS();
            pg8::Gemm g{XN, (const bf16*)(ws + WS_WGU + l * WGU_BYTES), MROWS, NGU, DM}; pg8::StaticOrder S; S.init(MROWS, NGU, G, bx);
            pg8::EpiSwiglu E{HB, DFF};
            pg8::gemm_phase<pg8::EpiSwiglu, pg8::StaticOrder, true, true>(lds, g, S, E, tid);
        }
        SEAM(pb + 8);
        if (PHEN(9) && IN(pb + 9)) { PH_IDS();
            pg8::Gemm g{HB, (const bf16*)(ws + WS_WDN + l * WDN_BYTES), MROWS, DM, DFF}; pg8::StaticOrder S; S.init(MROWS, DM, G, bx);
            pg8::EpiRes E{xres, xres, mod_l + 5120, 6144, SEQ};
            pg8::gemm_phase<pg8::EpiRes, pg8::StaticOrder, true, true>(lds, g, S, E, tid);
        }
        SEAM(pb + 9);
    }
#undef IN
#undef SEAM
}

extern "C" void kernel_launch(void* const* d_in, const int* in_sizes, int n_in, void* d_out, int out_size, void* d_ws, size_t ws_size, hipStream_t stream) {
    static int grid = 0;
    if (grid == 0) {
        if (n_in != 20 || in_sizes[0] != MROWS * DM || out_size != MROWS * DM || ws_size < WS_END) {
            fprintf(stderr, "kernel_launch: unexpected shapes: n_in %d in0 %d out %d ws %zu (need >= %zu)\n", n_in, n_in > 0 ? in_sizes[0] : -1, out_size, ws_size, (size_t)WS_END); grid = -1; return; }
        int dev = 0, cus = 0, per_cu = 0;
        if (hipGetDevice(&dev) != hipSuccess || hipDeviceGetAttribute(&cus, hipDeviceAttributeMultiprocessorCount, dev) != hipSuccess) { grid = -1; return; }
        if (hipFuncSetAttribute((const void*)fwd, hipFuncAttributeMaxDynamicSharedMemorySize, LDS_BYTES) != hipSuccess) { fprintf(stderr, "kernel_launch: hipFuncSetAttribute failed\n"); grid = -1; return; }
        if (hipOccupancyMaxActiveBlocksPerMultiprocessor(&per_cu, (const void*)fwd, NTHREADS, LDS_BYTES) != hipSuccess || per_cu < 1)
            fprintf(stderr, "kernel_launch: note: occupancy query reports %d workgroups per CU\n", per_cu);
        (void)hipGetLastError();
        grid = cus;
    }
    if (grid < 0) return;
    if (hipMemsetAsync((char*)d_ws + WS_CTL, 0, CTL_ZERO_BYTES, stream) != hipSuccess) return;
    Args a{};
    for (int i = 0; i < 20; ++i) a.in[i] = (const float*)d_in[i];
    a.out = (float*)d_out; a.ws = (unsigned char*)d_ws;
    if (N_LAUNCH_MODE == 1) { a.ph_lo = 0; a.ph_hi = NPHASE; hipLaunchKernelGGL(fwd, dim3(grid), dim3(NTHREADS), LDS_BYTES, stream, a); }
    else for (int p = 0; p < NPHASE; ++p) { a.ph_lo = p; a.ph_hi = p + 1; hipLaunchKernelGGL(fwd, dim3(grid), dim3(NTHREADS), LDS_BYTES, stream, a); }
}
```

```cpp
#include <hip/hip_runtime.h>
#include <cstdio>
#include <cstdint>

constexpr int DM = 1024, NBATCH = 2, SEQ = 16384, MROWS = NBATCH * SEQ, DEPTH = 2;
constexpr int HD = 64, FOXH = 6, MLH = 4, MOBH = 6;
constexpr int DFF = 2816, INC = 3342, NIN = 3584, PLD = 3328;
constexpr int NGU = 2 * DFF;
constexpr int C_FQ = 0, C_FK = 384, C_FV = 768, C_BQ = 1152, C_BK = 1536, C_BV = 1920, C_MQ = 2304, C_MK = 2560, C_MV = 2816, C_MO = 3072, C_G = 3328;
constexpr int Y_FOX = 0, Y_ML = 384, Y_MOBA = 640;
constexpr int MOBA_BS = 256, NBLK = SEQ / MOBA_BS;
constexpr int MLC = 64, NCHUNK = SEQ / MLC;
constexpr float LOG2E = 1.4426950408889634f;
constexpr float QSCALE = 0.125f * LOG2E;
constexpr float EPS = 1e-6f;

#define GAS __attribute__((address_space(1)))
#define LAS __attribute__((address_space(3)))
typedef unsigned short bf16;
typedef unsigned v4u __attribute__((ext_vector_type(4)));
typedef unsigned v2u __attribute__((ext_vector_type(2)));
typedef float f32x4 __attribute__((ext_vector_type(4)));
typedef short bf16x8 __attribute__((ext_vector_type(8)));
typedef float f32x16 __attribute__((ext_vector_type(16)));
typedef GAS unsigned gu32;
#define RLX_AGENT __ATOMIC_RELAXED, __HIP_MEMORY_SCOPE_AGENT
__device__ __forceinline__ unsigned f2bf(float f) { unsigned u = __builtin_bit_cast(unsigned, f); return (u + 0x7fffu + ((u >> 16) & 1u)) >> 16; }
__device__ __forceinline__ unsigned pk2(float lo, float hi) { return f2bf(lo) | (f2bf(hi) << 16); }
__device__ __forceinline__ float bf2f(unsigned short u) { return __builtin_bit_cast(float, (unsigned)u << 16); }
__device__ __forceinline__ float bflo(unsigned w) { return __builtin_bit_cast(float, w << 16); }
__device__ __forceinline__ float bfhi(unsigned w) { return __builtin_bit_cast(float, w & 0xffff0000u); }
__device__ __forceinline__ float wave_sum(float v) {
#pragma unroll
    for (int o = 1; o < 64; o <<= 1) v += __shfl_xor(v, o);
    return v;
}
__device__ __forceinline__ float wave_max(float v) {
#pragma unroll
    for (int o = 1; o < 64; o <<= 1) v = fmaxf(v, __shfl_xor(v, o));
    return v;
}
__device__ __forceinline__ float log_sigmoid_f(float x) { return fminf(x, 0.f) - log1pf(expf(-fabsf(x))); }
__device__ __forceinline__ float sigmoid_f(float x) { return 1.f / (1.f + expf(-x)); }

constexpr size_t MiB = 1u << 20;
constexpr size_t WS_CTL = 0, CTL_ZERO_BYTES = 1 * MiB;
constexpr size_t WS_MOD = 1 * MiB;
constexpr size_t WS_KMEAN = WS_MOD + 128 * 1024;
constexpr size_t WS_MLS = WS_KMEAN + 512 * 1024;
constexpr size_t WS_BEND = WS_MLS, WS_MLOC = WS_MLS + 8192, WS_MS = WS_MLS + 16384, WS_NU = WS_MLS + 32768, WS_NS = WS_NU + 2048 * 64 * 4;
constexpr size_t WS_CTAB = 3 * MiB;
static_assert(WS_NS + 2048 * 64 * 4 <= WS_CTAB && WS_CTAB + 12 * 64 * 64 * 4 <= 4 * MiB, "small region");
constexpr size_t WS_WIN = 4 * MiB, WIN_BYTES = (size_t)NIN * DM * 2;
constexpr size_t WS_WOUT = WS_WIN + 2 * WIN_BYTES, WOUT_BYTES = (size_t)DM * DM * 2;
constexpr size_t WS_WGU = WS_WOUT + 2 * WOUT_BYTES, WGU_BYTES = (size_t)NGU * DM * 2;
constexpr size_t WS_WDN = WS_WGU + 2 * WGU_BYTES, WDN_BYTES = (size_t)DM * DFF * 2;
static_assert(WS_WDN + 2 * WDN_BYTES <= 64 * MiB, "weights");
constexpr size_t WS_XN = 64 * MiB;
constexpr size_t WS_U = 64 * MiB;
constexpr size_t WS_CS = 96 * MiB;
constexpr size_t WS_LIST = 112 * MiB;
constexpr size_t WS_PROJ = 128 * MiB;
constexpr size_t WS_H = 128 * MiB;
constexpr size_t WS_Y = 336 * MiB;
constexpr size_t WS_QC = 400 * MiB, WS_KC = 416 * MiB;
constexpr size_t WS_OPART = 432 * MiB;
constexpr size_t WS_LPART = 504 * MiB;
constexpr size_t WS_GATES = 507 * MiB;
constexpr size_t WS_FOXCUM = 509 * MiB;
constexpr size_t WS_SEL = 510 * MiB;
constexpr size_t WS_END = 512 * MiB;
static_assert(WS_PROJ + (size_t)MROWS * PLD * 2 <= WS_Y && WS_SEL + (size_t)MROWS * 6 * 4 <= WS_END, "ws map");
constexpr int CW_BAR = 4096;
constexpr int CW_QUEUE = 16384;
constexpr int CW_LCNT = 32768;

constexpr int RING_BYTES = 131072, LDSCTL_OFF = RING_BYTES, MISC_OFF = LDSCTL_OFF + 320, LDS_BYTES = 147456;
constexpr int NWAVES = 8, NTHREADS = 512;
namespace pg8 {
#define PG8_LAS __attribute__((address_space(3)))
typedef unsigned short bf16_t;
typedef short bf16x8 __attribute__((ext_vector_type(8)));
typedef float f32x4 __attribute__((ext_vector_type(4)));
typedef unsigned u32x4 __attribute__((ext_vector_type(4)));
constexpr int BM = 256, BK = 64, HALF = 128, HTB = HALF * BK * 2  , STAGE_BYTES = 8 * HTB, NXCD = 8, WGM = 8;

__host__ __device__ __forceinline__ int lds_byte(int r, int c) { const int st = (r >> 4) * 2 + (c >> 5), rr = r & 15, cc = c & 31, ob = rr * 64 + cc * 2; return st * 1024 + (ob ^ (((ob >> 9) & 1) << 5)); }
__host__ __device__ __forceinline__ void stage_rc(int b, int& R, int& C) { const int st = b / 1024, sb = b % 1024, swz = sb ^ (((sb >> 9) & 1) << 5); R = (st >> 1) * 16 + swz / 64; C = (st & 1) * 32 + (swz % 64) / 2; }
__host__ __device__ __forceinline__ int perm32(int rho) { const int n = rho >> 4, i = rho & 15; return 8 * (i >> 2) + 4 * n + (i & 3); }

struct Unit { int pm, pn; };
struct Gemm { const bf16_t* A; const bf16_t* Bt; int M, N, K; };

struct StaticOrder {
    int nM, nN, nwg, G, c;
    __host__ __device__ void init(int M, int N, int G_, int c_) { nM = M / BM; nN = N / BM; nwg = nM * nN; G = G_; c = c_; }
    __host__ __device__ bool next(int i, Unit& u) const {
        const long L = (long)i * G + c; if (L >= nwg) return false;
        int wgid = (int)L; { const int q = nwg / NXCD, r = nwg % NXCD, xcd = wgid % NXCD, off = wgid / NXCD; wgid = (xcd < r ? xcd * (q + 1) : r * (q + 1) + (xcd - r) * q) + off; }
        const int nig = WGM * nN, gid = wgid / nig, fm = gid * WGM, gsz = (nM - fm) < WGM ? (nM - fm) : WGM;
        u.pm = fm + ((wgid % nig) % gsz); u.pn = (wgid % nig) / gsz; return true;
    }
    __device__ __forceinline__ void a_ready(const Unit&) const {}
    __device__ __forceinline__ void done(const Unit&) const {}
};

__device__ __forceinline__ unsigned cvt_pk_bf16(float lo, float hi) { unsigned r; asm volatile("v_cvt_pk_bf16_f32 %0, %1, %2" : "=v"(r) : "v"(lo), "v"(hi)); return r; }
typedef float f32x2 __attribute__((ext_vector_type(2)));
struct EpiProj {
    static constexpr bool PERM = true, AFTER_DRAIN = false;
    bf16_t* P; float* G; int pld;
    __device__ __forceinline__ void operator()(const f32x4 (&acc)[2][2][4][2], const Unit& u, int wr, int wc, int fr, int fq) const {
        const int row0 = u.pm * BM + wr * 64 + fr;
        if (u.pn < 13) {
            const int col0 = u.pn * BM + wc * 32 + 8 * fq;
#pragma unroll
            for (int ai = 0; ai < 2; ++ai)
#pragma unroll
                for (int m = 0; m < 4; ++m) { bf16_t* rowp = P + (size_t)(row0 + ai * HALF + m * 16) * pld + col0;
#pragma unroll
                    for (int bj = 0; bj < 2; ++bj) { const f32x4 v0 = acc[ai][bj][m][0], v1 = acc[ai][bj][m][1];
                        u32x4 w; w.x = cvt_pk_bf16(v0[0], v0[1]); w.y = cvt_pk_bf16(v0[2], v0[3]); w.z = cvt_pk_bf16(v1[0], v1[1]); w.w = cvt_pk_bf16(v1[2], v1[3]);
                        *(u32x4*)(rowp + bj * HALF) = w; } }
        } else {
            if (wc == 0 && fq < 2) {
#pragma unroll
                for (int ai = 0; ai < 2; ++ai)
#pragma unroll
                    for (int m = 0; m < 4; ++m) { float* gp = G + (size_t)(row0 + ai * HALF + m * 16) * 16 + 8 * fq;
                        *(f32x4*)(gp) = acc[ai][0][m][0]; *(f32x4*)(gp + 4) = acc[ai][0][m][1]; }
            }
        }
    }
};
struct EpiRes {
    static constexpr bool PERM = false, AFTER_DRAIN = false;
    const float* base; float* out; const float* gate; int gate_bstride; int rows_per_batch;
    __device__ __forceinline__ void operator()(const f32x4 (&acc)[2][2][4][2], const Unit& u, int wr, int wc, int fr, int fq) const {
        const int row0 = u.pm * BM + wr * 64 + fr, col0 = u.pn * BM + wc * 32 + 4 * fq;
        const float* gb = gate + (size_t)((u.pm * BM) / rows_per_batch) * gate_bstride;
        f32x4 gv[2][2];
#pragma unroll
        for (int bj = 0; bj < 2; ++bj)
#pragma unroll
            for (int n = 0; n < 2; ++n) gv[bj][n] = *(const f32x4*)(gb + col0 + bj * HALF + n * 16);
#pragma unroll
        for (int ai = 0; ai < 2; ++ai)
#pragma unroll
            for (int m = 0; m < 4; ++m) { const size_t off = (size_t)(row0 + ai * HALF + m * 16) * 1024 + col0;
#pragma unroll
                for (int bj = 0; bj < 2; ++bj)
#pragma unroll
                    for (int n = 0; n < 2; ++n) { const f32x4 bs = *(const f32x4*)(base + off + bj * HALF + n * 16);
                        *(f32x4*)(out + off + bj * HALF + n * 16) = bs + gv[bj][n] * acc[ai][bj][m][n]; } }
    }
};
struct EpiSwiglu {
    static constexpr bool PERM = true, AFTER_DRAIN = false;
    bf16_t* Hh; int ldh;
    __device__ __forceinline__ void operator()(const f32x4 (&acc)[2][2][4][2], const Unit& u, int wr, int wc, int fr, int fq) const {
        const int row0 = u.pm * BM + wr * 64 + fr, col0 = u.pn * HALF + wc * 32 + 8 * fq;
#pragma unroll
        for (int ai = 0; ai < 2; ++ai)
#pragma unroll
            for (int m = 0; m < 4; ++m) { bf16_t* rowp = Hh + (size_t)(row0 + ai * HALF + m * 16) * ldh + col0;
                float hv[8];
#pragma unroll
                for (int n = 0; n < 2; ++n)
#pragma unroll
                    for (int i = 0; i < 4; ++i) { const float g = acc[ai][0][m][n][i], up = acc[ai][1][m][n][i];
                        const float e = __builtin_amdgcn_exp2f(-g * 1.4426950408889634f);
                        hv[n * 4 + i] = g * __builtin_amdgcn_rcpf(1.0f + e) * up; }
                u32x4 w; w.x = cvt_pk_bf16(hv[0], hv[1]); w.y = cvt_pk_bf16(hv[2], hv[3]); w.z = cvt_pk_bf16(hv[4], hv[5]); w.w = cvt_pk_bf16(hv[6], hv[7]);
                *(u32x4*)(rowp) = w; }
    }
};
template <class Epi, class Sched, bool ALIGN_EPI = false, bool SP2 = false>
__device__ __forceinline__ void gemm_phase(PG8_LAS unsigned char* lds, const Gemm g, const Sched& S, const Epi& E, const int tid_in) {
    const int tid = tid_in, wid = __builtin_amdgcn_readfirstlane(tid >> 6), lane = tid & 63, wr = wid >> 2, wc = wid & 3, fr = lane & 15, fq = lane >> 4;
    const int K = g.K, nt = K / BK;
    unsigned voffA[2], voffB[2];
#pragma unroll
    for (int i = 0; i < 2; ++i) { int R, C; stage_rc(tid * 16 + i * 8192, R, C); const int Rb = Epi::PERM ? ((R & ~31) + perm32(R & 31)) : R;
        voffA[i] = (unsigned)(R * K + C) * 2u; voffB[i] = (unsigned)(Rb * K + C) * 2u; }
    const size_t kstep = (size_t)(BK * 2);
    const size_t hstep = (size_t)HALF * K * 2;
    const size_t tstep = 2 * hstep;
    const unsigned ldsw = (unsigned)wid * 1024u;
    const int aoff = lds_byte(wr * 64 + fr, fq * 8), boff = lds_byte(wc * 32 + fr, fq * 8);
#define PG8_SA(b, h) (((b) * 2 + (h)) * HTB)
#define PG8_SB(b, h) ((4 + (b) * 2 + (h)) * HTB)
#define PG8_STAGE(bufoff, gbase, voff) do { _Pragma("unroll") for (int _i = 0; _i < 2; ++_i) \
        __builtin_amdgcn_global_load_lds((const unsigned*)((const char*)(gbase) + (voff)[_i]), (PG8_LAS unsigned*)(lds + (bufoff) + ldsw + _i * 8192), 16, 0, 0); } while (0)
#define PG8_LDA(dst, b, h) do { _Pragma("unroll") for (int m = 0; m < 4; ++m) _Pragma("unroll") for (int k = 0; k < 2; ++k) dst[m][k] = *(const PG8_LAS bf16x8*)(lds + PG8_SA(b, h) + aoff + m * 2048 + k * 1024); } while (0)
#define PG8_LDB(dst, b, h) do { _Pragma("unroll") for (int n = 0; n < 2; ++n) _Pragma("unroll") for (int k = 0; k < 2; ++k) dst[n][k] = *(const PG8_LAS bf16x8*)(lds + PG8_SB(b, h) + boff + n * 2048 + k * 1024); } while (0)
#define PG8_MMA(ai, bj, At, Bt) do { __builtin_amdgcn_s_setprio(1); _Pragma("unroll") for (int m = 0; m < 4; ++m) _Pragma("unroll") for (int n = 0; n < 2; ++n) _Pragma("unroll") for (int k = 0; k < 2; ++k) \
        acc[ai][bj][m][n] = __builtin_amdgcn_mfma_f32_16x16x32_bf16(Bt[n][k], At[m][k], acc[ai][bj][m][n], 0, 0, 0); __builtin_amdgcn_s_setprio(0); } while (0)
#define PG8_WAIT_V(n) asm volatile("s_waitcnt vmcnt(" #n ")" ::: "memory")
#define PG8_WAIT_L(n) asm volatile("s_waitcnt lgkmcnt(" #n ")" ::: "memory")
#define PG8_BAR __builtin_amdgcn_s_barrier()
#define PG8_SCHED __builtin_amdgcn_sched_barrier(0)
    Unit cur, nxt; int ui = 0;
    if (!S.next(0, cur)) return;
    f32x4 acc[2][2][4][2];
#pragma unroll
    for (int a = 0; a < 2; ++a)
#pragma unroll
        for (int b = 0; b < 2; ++b)
#pragma unroll
            for (int m = 0; m < 4; ++m)
#pragma unroll
                for (int n = 0; n < 2; ++n) acc[a][b][m][n] = (f32x4){0.f, 0.f, 0.f, 0.f};
    bf16x8 At[4][2], B0[2][2], B1[2][2];
    const char* cA = (const char*)g.A + (size_t)cur.pm * tstep; const char* cB = (const char*)g.Bt + (size_t)cur.pn * tstep;
    S.a_ready(cur);
    if constexpr (SP2) {
        PG8_STAGE(PG8_SB(0, 0), cB, voffB); PG8_STAGE(PG8_SB(0, 1), cB + hstep, voffB); PG8_STAGE(PG8_SA(0, 0), cA, voffA); PG8_STAGE(PG8_SA(0, 1), cA + hstep, voffA);
        if (wr == 1) PG8_BAR;
        PG8_WAIT_V(2); PG8_BAR;
        PG8_STAGE(PG8_SB(1, 0), cB + kstep, voffB); PG8_STAGE(PG8_SA(1, 0), cA + kstep, voffA); PG8_STAGE(PG8_SB(1, 1), cB + hstep + kstep, voffB);
        PG8_WAIT_V(6); PG8_BAR;
    } else {
        PG8_STAGE(PG8_SB(0, 0), cB, voffB); PG8_STAGE(PG8_SA(0, 0), cA, voffA); PG8_STAGE(PG8_SB(0, 1), cB + hstep, voffB); PG8_STAGE(PG8_SA(0, 1), cA + hstep, voffA);
        if (wr == 1) PG8_BAR;
        PG8_WAIT_V(4); PG8_BAR;
        PG8_STAGE(PG8_SB(1, 0), cB + kstep, voffB); PG8_STAGE(PG8_SA(1, 0), cA + kstep, voffA); PG8_STAGE(PG8_SB(1, 1), cB + hstep + kstep, voffB);
        PG8_WAIT_V(6); PG8_BAR;
    }
    for (;;) {
        const bool has_next = S.next(ui + 1, nxt);
        const char* nA = has_next ? (const char*)g.A + (size_t)nxt.pm * tstep : cA; const char* nB = has_next ? (const char*)g.Bt + (size_t)nxt.pn * tstep : cB;
        for (int t = 0; t < nt; t += 2) {
            const bool last = (t == nt - 2);
            const char* a1 = cA + (size_t)(t + 1) * kstep;
            const char* a2 = last ? nA : cA + (size_t)(t + 2) * kstep; const char* b2 = last ? nB : cB + (size_t)(t + 2) * kstep;
            const char* a3 = a2 + kstep; const char* b3 = b2 + kstep;
            if (last && has_next) S.a_ready(nxt);
            if constexpr (SP2) {
            PG8_LDB(B0, 0, 0); PG8_LDB(B1, 0, 1); PG8_SCHED; PG8_LDA(At, 0, 0); PG8_STAGE(PG8_SA(1, 1), a1 + hstep, voffA);
            PG8_WAIT_V(8); PG8_WAIT_L(0); PG8_BAR; PG8_MMA(0, 0, At, B0); PG8_MMA(0, 1, At, B1); PG8_BAR; PG8_SCHED;
            PG8_LDA(At, 0, 1); PG8_STAGE(PG8_SB(0, 0), b2, voffB); PG8_STAGE(PG8_SB(0, 1), b2 + hstep, voffB); PG8_STAGE(PG8_SA(0, 0), a2, voffA);
            PG8_WAIT_V(8); PG8_WAIT_L(0); PG8_BAR; PG8_MMA(1, 0, At, B0); PG8_MMA(1, 1, At, B1); PG8_BAR; PG8_SCHED;
            PG8_LDB(B0, 1, 0); PG8_LDB(B1, 1, 1); PG8_SCHED; PG8_LDA(At, 1, 0); PG8_STAGE(PG8_SA(0, 1), a2 + hstep, voffA);
            PG8_WAIT_V(8); PG8_WAIT_L(0); PG8_BAR; PG8_MMA(0, 0, At, B0); PG8_MMA(0, 1, At, B1); PG8_BAR; PG8_SCHED;
            PG8_LDA(At, 1, 1); PG8_STAGE(PG8_SB(1, 0), b3, voffB); PG8_STAGE(PG8_SB(1, 1), b3 + hstep, voffB); PG8_STAGE(PG8_SA(1, 0), a3, voffA);
            PG8_WAIT_V(8); PG8_WAIT_L(0); PG8_BAR; PG8_MMA(1, 0, At, B0); PG8_MMA(1, 1, At, B1); PG8_BAR; PG8_SCHED;
            } else {
            PG8_LDB(B0, 0, 0); PG8_SCHED; PG8_LDA(At, 0, 0); PG8_STAGE(PG8_SA(1, 1), a1 + hstep, voffA);
            PG8_WAIT_L(8); PG8_BAR; PG8_WAIT_L(0); PG8_MMA(0, 0, At, B0); PG8_BAR; PG8_SCHED;
            PG8_LDB(B1, 0, 1); PG8_STAGE(PG8_SB(0, 0), b2, voffB);
            PG8_BAR; PG8_WAIT_L(0); PG8_MMA(0, 1, At, B1); PG8_BAR;
            PG8_LDA(At, 0, 1); PG8_STAGE(PG8_SA(0, 0), a2, voffA);
            PG8_BAR; PG8_WAIT_L(0); PG8_MMA(1, 0, At, B0); PG8_BAR; PG8_SCHED;
            PG8_STAGE(PG8_SB(0, 1), b2 + hstep, voffB);
            PG8_WAIT_V(6); PG8_BAR; PG8_MMA(1, 1, At, B1); PG8_BAR;
            PG8_LDB(B0, 1, 0); PG8_SCHED; PG8_LDA(At, 1, 0); PG8_STAGE(PG8_SA(0, 1), a2 + hstep, voffA);
            PG8_WAIT_L(8); PG8_BAR; PG8_WAIT_L(0); PG8_MMA(0, 0, At, B0); PG8_BAR; PG8_SCHED;
            PG8_LDB(B1, 1, 1); PG8_STAGE(PG8_SB(1, 0), b3, voffB);
            PG8_BAR; PG8_WAIT_L(0); PG8_MMA(0, 1, At, B1); PG8_BAR;
            PG8_LDA(At, 1, 1); PG8_STAGE(PG8_SA(1, 0), a3, voffA);
            PG8_BAR; PG8_WAIT_L(0); PG8_MMA(1, 0, At, B0); PG8_BAR; PG8_SCHED;
            PG8_STAGE(PG8_SB(1, 1), b3 + hstep, voffB);
            PG8_WAIT_V(6); PG8_BAR; PG8_MMA(1, 1, At, B1); PG8_BAR;
            }
        }
        if constexpr (ALIGN_EPI) { if (wr == 0) PG8_BAR; }
        if constexpr (!Epi::AFTER_DRAIN) { E(acc, cur, wr, wc, fr, fq); S.done(cur); }
        if (!has_next) break;
#pragma unroll
        for (int a = 0; a < 2; ++a)
#pragma unroll
            for (int b = 0; b < 2; ++b)
#pragma unroll
                for (int m = 0; m < 4; ++m)
#pragma unroll
                    for (int n = 0; n < 2; ++n) acc[a][b][m][n] = (f32x4){0.f, 0.f, 0.f, 0.f};
        cur = nxt; cA = nA; cB = nB; ++ui;
        if constexpr (ALIGN_EPI) { if (wr == 1) PG8_BAR; }
    }
    PG8_WAIT_V(0);
    if constexpr (!ALIGN_EPI) { if (wr == 0) PG8_BAR; }
    PG8_BAR;
    if constexpr (Epi::AFTER_DRAIN) { E.fused(acc, cur, wr, wc, fr, fq, lds, wid, lane); S.done(cur); }
#undef PG8_SA
#undef PG8_SB
#undef PG8_STAGE
#undef PG8_LDA
#undef PG8_LDB
#undef PG8_MMA
#undef PG8_WAIT_V
#undef PG8_WAIT_L
#undef PG8_BAR
#undef PG8_SCHED
}
}
#define XB_TMO      128
#define XB_XCNT(j)  (256  + 64 * (j))
#define XB_XSUB(j)  (1280 + 64 * (j))
#define XB_XGEN(j)  (2304 + 64 * (j))
#define XB_TOP      3328
#define XB_TOPGEN   3392
#define XCD_BAR_WORDS 3456
#define XB_SPIN_CAP (1u << 18)

__device__ __forceinline__ unsigned xb_ld(unsigned* p)              { return __hip_atomic_load(p, __ATOMIC_RELAXED, __HIP_MEMORY_SCOPE_AGENT); }
__device__ __forceinline__ unsigned xb_add(unsigned* p, unsigned v) { return __hip_atomic_fetch_add(p, v, __ATOMIC_RELAXED, __HIP_MEMORY_SCOPE_AGENT); }
__device__ __forceinline__ unsigned xb_xcc_id() { return (unsigned)__builtin_amdgcn_s_getreg((3 << 11) | 20) & 0xFu; }
#define XB_SPIN(cond, bar) do { unsigned _sp = 0; while (cond) { __builtin_amdgcn_s_sleep(1); \
    if ((++_sp & 255u) == 0u) { if (xb_ld(&(bar)[XB_TMO])) break; if (_sp > XB_SPIN_CAP) { atomicAdd(&(bar)[XB_TMO], 1u); break; } } } } while (0)

struct XcdBarrier {
    unsigned* bar; unsigned x;
    volatile LAS unsigned* st;
};

__device__ __forceinline__ XcdBarrier xcd_barrier_post(unsigned* bar, volatile LAS unsigned* st) {
    XcdBarrier b; b.bar = bar; b.x = xb_xcc_id(); b.st = st;
    if (threadIdx.x == 0) (void)xb_add(&bar[XB_XCNT(b.x)], 1u);
    return b;
}
__device__ __forceinline__ void xcd_barrier_complete(unsigned* bar, unsigned x, unsigned& nloc, unsigned& nx) {
    const unsigned G = gridDim.x * gridDim.y * gridDim.z;
    unsigned sum, cnt, mine, sp = 0u;
    for (;;) {
        sum = 0u; cnt = 0u; mine = 0u;
#pragma unroll
        for (unsigned j = 0; j < 16; ++j) { const unsigned c = xb_ld(&bar[XB_XCNT(j)]); sum += c; cnt += (c > 0u) ? 1u : 0u; mine = (j == x) ? c : mine; }
        if (sum == G) break;
        __builtin_amdgcn_s_sleep(1);
        if ((++sp & 255u) == 0u) { if (xb_ld(&bar[XB_TMO])) break; if (sp > XB_SPIN_CAP) { atomicAdd(&bar[XB_TMO], 1u); break; } }
    }
    nloc = mine > 0u ? mine : 1u; nx = cnt > 0u ? cnt : 1u;
}

__device__ __forceinline__ void xcd_barrier(const XcdBarrier& b) {
    asm volatile("s_waitcnt vmcnt(0)" ::: "memory");
    __syncthreads();
    if (threadIdx.x == 0) {
        unsigned* bar = b.bar;
        __builtin_amdgcn_s_waitcnt(0);
        unsigned nloc = b.st[0], nx = b.st[1];
        if (nloc == 0u) { xcd_barrier_complete(bar, b.x, nloc, nx); b.st[0] = nloc; b.st[1] = nx; }
        const unsigned old = xb_add(&bar[XB_XSUB(b.x)], 1u);
        const unsigned gen = old / nloc;
        if (old + 1u == (gen + 1u) * nloc) {
            __builtin_amdgcn_fence(__ATOMIC_RELEASE, "agent");
            asm volatile("s_waitcnt vmcnt(0)" ::: "memory");
            const unsigned og = xb_add(&bar[XB_TOP], 1u);
            const unsigned tg = og / nx;
            if (og + 1u == (tg + 1u) * nx) xb_add(&bar[XB_TOPGEN], 1u);
            else XB_SPIN(xb_ld(&bar[XB_TOPGEN]) == tg, bar);
            __builtin_amdgcn_fence(__ATOMIC_ACQUIRE, "agent");
            xb_add(&bar[XB_XGEN(b.x)], 1u);
            asm volatile("s_waitcnt vmcnt(0)" ::: "memory");
        } else {
            XB_SPIN(xb_ld(&bar[XB_XGEN(b.x)]) == gen, bar);
            __builtin_amdgcn_fence(__ATOMIC_ACQUIRE, "agent");
            asm volatile("s_waitcnt vmcnt(0)" ::: "memory");
        }
    }
    __syncthreads();
}
#define LDS_WAIT() asm volatile("s_waitcnt lgkmcnt(0)" ::: "memory")
__device__ __forceinline__ void unpack8(const v4u w, float* f) { f[0] = bflo(w.x); f[1] = bfhi(w.x); f[2] = bflo(w.y); f[3] = bfhi(w.y); f[4] = bflo(w.z); f[5] = bfhi(w.z); f[6] = bflo(w.w); f[7] = bfhi(w.w); }

__device__ __forceinline__ int win_src(int c) {
    if (c < 1152) return c;
    if (c < 2304) return c + 1038;
    if (c < 3072) return c - 1146;
    if (c < 3328) return c - 1138;
    if (c < 3334) return c - 3328 + 1152;
    if (c < 3338) return c - 3334 + 1926;
    if (c < 3342) return c - 3338 + 1930;
    return -1;
}
__device__ __forceinline__ int wgu_src(int r) { const int pn = r >> 8, w = r & 255; return (w < 128 ? 0 : DFF) + pn * 128 + (w & 127); }
template <int MODE> __device__ __forceinline__ int src_col(int r) { if (MODE == 1) return win_src(r); if (MODE == 2) return wgu_src(r); return r; }

template <int MODE> __device__ __forceinline__ void transpose_item(const float* W, int K, int ldw, bf16* WT, LAS float* scr, int nblk, int item, int lane) {
    const int kb = item / nblk, nb = item % nblk, k0 = 64 * kb, n0 = 32 * nb;
    const int sc = src_col<MODE>(n0 + (lane & 31));
#pragma unroll 8
    for (int i = 0; i < 32; ++i) { const int kk = 2 * i + (lane >> 5); scr[kk * 33 + (lane & 31)] = (sc >= 0) ? W[(size_t)(k0 + kk) * ldw + sc] : 0.f; }
    LDS_WAIT(); asm volatile("" ::: "memory");
    const int c = lane & 7;
#pragma unroll
    for (int j = 0; j < 4; ++j) { const int n = (lane >> 3) + 8 * j; const LAS float* s = scr + (8 * c) * 33 + n;
        v4u o; o.x = pk2(s[0 * 33], s[1 * 33]); o.y = pk2(s[2 * 33], s[3 * 33]); o.z = pk2(s[4 * 33], s[5 * 33]); o.w = pk2(s[6 * 33], s[7 * 33]);
        *(GAS v4u*)(WT + (size_t)(n0 + n) * K + k0 + 8 * c) = o; }
    LDS_WAIT(); asm volatile("" ::: "memory");
}

__device__ __forceinline__ void p0_mod_unit(int u, const float* cvec, const float* w_ada, const float* b_ada, float* mod, LAS float* lds, int tid, int wave, int lane) {
    LAS float* sc = lds; LAS float* red = lds + 2048;
    for (int i = tid; i < 2048; i += NTHREADS) { const float v = cvec[i]; sc[i] = v / (1.f + expf(-v)); }
    __syncthreads();
    const int l = u / 96, n = (u % 96) * 64 + lane;
    const float* wp = w_ada + ((size_t)l * 1024 + wave * 128) * 6144 + n;
    float a0 = 0.f, a1 = 0.f;
#pragma unroll 16
    for (int kk = 0; kk < 128; ++kk) { const float w = wp[(size_t)kk * 6144]; a0 += sc[wave * 128 + kk] * w; a1 += sc[1024 + wave * 128 + kk] * w; }
    red[(wave * 2 + 0) * 64 + lane] = a0; red[(wave * 2 + 1) * 64 + lane] = a1;
    __syncthreads();
    if (tid < 128) { const int b = tid >> 6; float s = 0.f;
#pragma unroll
        for (int w = 0; w < 8; ++w) s += red[(w * 2 + b) * 64 + lane];
        mod[((size_t)l * 2 + b) * 6144 + n] = s + b_ada[l * 6144 + n]; }
    __syncthreads();
}

__device__ __forceinline__ void norm_rows(const float* xsrc, const float* g, const float* mod_l, int sh_off, int sc_off, bf16* XN, int gw, int NGW, int lane) {
    for (int m = gw; m < MROWS; m += NGW) {
        const int b = m / SEQ; const float* mb = mod_l + (size_t)b * 6144;
        const GAS f32x4* xr = (const GAS f32x4*)(xsrc + (size_t)m * DM) + lane;
        f32x4 v[4]; float ss = 0.f;
#pragma unroll
        for (int j = 0; j < 4; ++j) { v[j] = xr[64 * j]; ss += (v[j].x * v[j].x + v[j].y * v[j].y) + (v[j].z * v[j].z + v[j].w * v[j].w); }
        const float rstd = 1.f / sqrtf(wave_sum(ss) * (1.f / DM) + EPS);
        GAS v2u* o8 = (GAS v2u*)(XN + (size_t)m * DM) + lane;
#pragma unroll
        for (int j = 0; j < 4; ++j) { const int col = 4 * lane + 256 * j;
            const f32x4 gg = *(const f32x4*)(g + col), sv = *(const f32x4*)(mb + sc_off + col), hv = *(const f32x4*)(mb + sh_off + col);
            const f32x4 o = v[j] * rstd * gg * (sv + 1.0f) + hv;
            v2u w; w.x = pk2(o.x, o.y); w.y = pk2(o.z, o.w); o8[64 * j] = w; }
    }
}

__device__ __forceinline__ void post_foxcum_unit(int bh, const float* GATESp, float* FOXCUMp, const float* fox_f_bias, LAS float* lds, int tid, int wave, int lane) {
    const int b = bh / 6, h = bh % 6; const float bias = fox_f_bias[h];
    float v[32];
#pragma unroll
    for (int r = 0; r < 32; ++r) { const int t = wave * 2048 + r * 64 + lane; v[r] = log_sigmoid_f(GATESp[((size_t)b * SEQ + t) * 16 + h] + bias) * LOG2E; }
    float carry = 0.f;
#pragma unroll
    for (int r = 0; r < 32; ++r) { float x = v[r];
#pragma unroll
        for (int o = 1; o < 64; o <<= 1) { const float n = __shfl_up(x, o); if (lane >= o) x += n; }
        x += carry; v[r] = x; carry = __shfl(x, 63); }
    if (lane == 0) lds[wave] = carry;
    __syncthreads();
    float off = 0.f;
    for (int w = 0; w < wave; ++w) off += lds[w];
#pragma unroll
    for (int r = 0; r < 32; ++r) FOXCUMp[(size_t)bh * SEQ + wave * 2048 + r * 64 + lane] = v[r] + off;
    __syncthreads();
}
__device__ __forceinline__ void post_qknorm_unit(int u, bf16* PROJp, float* KMEANP, const float* gfq, const float* gfk, const float* gbq, const float* gbk, LAS float* lds, int tid, int wave, int lane) {
    const int blk = u >> 1, half = u & 1, sub = lane & 7;
    int colv[3]; float gv[3][8]; float qsv[3];
#pragma unroll
    for (int it = 0; it < 3; ++it) { const int hsel = it * 8 + (lane >> 3), grp = hsel / 6, hh = hsel % 6;
        colv[it] = (grp == 0 ? C_FQ : grp == 1 ? C_FK : grp == 2 ? C_BQ : C_BK) + hh * 64 + 8 * sub;
        const float* gp = (grp == 0 ? gfq : grp == 1 ? gfk : grp == 2 ? gbq : gbk) + 8 * sub;
#pragma unroll
        for (int i = 0; i < 8; ++i) gv[it][i] = gp[i];
        qsv[it] = (grp == 0 || grp == 2) ? QSCALE : 1.f; }
    float ka[8] = {0.f, 0.f, 0.f, 0.f, 0.f, 0.f, 0.f, 0.f};
    const size_t row0 = (size_t)blk * 256 + half * 128 + wave * 16;
#pragma unroll 2
    for (int r = 0; r < 16; ++r) {
#pragma unroll
        for (int it = 0; it < 3; ++it) {
            v4u* p = (v4u*)(PROJp + (row0 + r) * PLD + colv[it]);
            float f[8]; unpack8(*p, f);
            float ss = 0.f;
#pragma unroll
            for (int i = 0; i < 8; ++i) ss += f[i] * f[i];
            ss += __shfl_xor(ss, 1); ss += __shfl_xor(ss, 2); ss += __shfl_xor(ss, 4);
            const float rr = 1.f / sqrtf(ss * (1.f / 64.f) + EPS);
#pragma unroll
            for (int i = 0; i < 8; ++i) f[i] = f[i] * rr * gv[it][i];
            if (it == 2) {
#pragma unroll
                for (int i = 0; i < 8; ++i) ka[i] += f[i]; }
            const float qs = qsv[it];
            v4u w; w.x = pk2(f[0] * qs, f[1] * qs); w.y = pk2(f[2] * qs, f[3] * qs); w.z = pk2(f[4] * qs, f[5] * qs); w.w = pk2(f[6] * qs, f[7] * qs);
            *p = w;
        }
    }
    if (lane >= 16) {
#pragma unroll
        for (int i = 0; i < 8; ++i) lds[wave * 384 + ((lane >> 3) - 2) * 64 + 8 * sub + i] = ka[i]; }
    __syncthreads();
    if (tid < 384) { float s = 0.f;
#pragma unroll
        for (int w = 0; w < 8; ++w) s += lds[w * 384 + tid];
        const int b = blk / NBLK, n = blk % NBLK, head = tid >> 6, dd = tid & 63;
        KMEANP[(size_t)half * (12 * NBLK * 64) + (((size_t)b * 6 + head) * NBLK + n) * 64 + dd] = s * (1.f / 256.f); }
    __syncthreads();
}
__device__ __forceinline__ void post_conv_unit(int blk, int which, const bf16* PROJp, bf16* dst, const float* conv_w, const float* conv_b, int tid) {
    const bf16* src = PROJp + (which ? C_MK : C_MQ); const float osc = which ? 0.125f : 1.f;
    const int c = 2 * (tid & 127), rq = tid >> 7, ch = which * 256 + c;
    float w0[4], w1[4];
#pragma unroll
    for (int i = 0; i < 4; ++i) { w0[i] = conv_w[i * 512 + ch]; w1[i] = conv_w[i * 512 + ch + 1]; }
    const float b0 = conv_b[ch], b1 = conv_b[ch + 1];
    const size_t r0 = (size_t)blk * 256 + rq * 64; const int tl = (int)(r0 % SEQ);
    float xa[3][2];
#pragma unroll
    for (int k = 0; k < 3; ++k) { const int back = 3 - k;
        if (tl - back >= 0) { const unsigned w = *(const unsigned*)(src + (r0 - back) * PLD + c); xa[k][0] = bflo(w); xa[k][1] = bfhi(w); } else { xa[k][0] = 0.f; xa[k][1] = 0.f; } }
#pragma unroll 4
    for (int r = 0; r < 64; ++r) {
        const unsigned w = *(const unsigned*)(src + (r0 + r) * PLD + c); const float x0 = bflo(w), x1 = bfhi(w);
        float y0 = b0 + w0[0] * xa[0][0] + w0[1] * xa[1][0] + w0[2] * xa[2][0] + w0[3] * x0;
        float y1 = b1 + w1[0] * xa[0][1] + w1[1] * xa[1][1] + w1[2] * xa[2][1] + w1[3] * x1;
        y0 = y0 / (1.f + expf(-y0)) * osc; y1 = y1 / (1.f + expf(-y1)) * osc;
        *(unsigned*)(dst + (r0 + r) * 256 + c) = pk2(y0, y1);
        xa[0][0] = xa[1][0]; xa[0][1] = xa[1][1]; xa[1][0] = xa[2][0]; xa[1][1] = xa[2][1]; xa[2][0] = x0; xa[2][1] = x1;
    }
}

struct MlP { const bf16* PROJ; const bf16* QC; const bf16* KC; const float* GATES; float* U; float* NU; float* BEND; float* MLOC; bf16* CS; float* NS; float* MS; bf16* Y;
             const float *ibias, *fbias, *hg; };
__device__ __forceinline__ void mlstm_m1(int ci, const MlP& P, LAS float* lds, int tid, int wave, int lane) {
    const int b = ci >> 10, h = (ci >> 8) & 3, c = ci & 255; const size_t row0 = (size_t)b * SEQ + c * 64;
    LAS float* Ks = lds; LAS float* Vs = lds + 4096; LAS float* ws = lds + 8192;
    { const int r = tid >> 3, cg = (tid & 7) * 8; float f[8];
      unpack8(*(const v4u*)(P.KC + (row0 + r) * 256 + h * 64 + cg), f);
#pragma unroll
      for (int i = 0; i < 8; ++i) Ks[r * 64 + cg + i] = f[i];
      unpack8(*(const v4u*)(P.PROJ + (row0 + r) * PLD + C_MV + h * 64 + cg), f);
#pragma unroll
      for (int i = 0; i < 8; ++i) Vs[r * 64 + cg + i] = f[i]; }
    if (wave == 0) {
        const size_t row = row0 + lane;
        const float fi = P.GATES[row * 16 + 6 + h] + P.ibias[h], ff = P.GATES[row * 16 + 10 + h] + P.fbias[h];
        float bc = log_sigmoid_f(ff);
#pragma unroll
        for (int o = 1; o < 64; o <<= 1) { const float n = __shfl_up(bc, o); if (lane >= o) bc += n; }
        const float bend = __shfl(bc, 63);
        const float wl = bend - bc + fi; const float mloc = wave_max(wl);
        ws[lane] = expf(wl - mloc);
        if (lane == 0) { P.BEND[ci] = bend; P.MLOC[ci] = mloc; }
    }
    __syncthreads();
    { const int dv = tid >> 3, e0 = (tid & 7) * 8; float u[8] = {0.f, 0.f, 0.f, 0.f, 0.f, 0.f, 0.f, 0.f};
#pragma unroll 2
      for (int s = 0; s < 64; ++s) { const float vw = Vs[s * 64 + dv] * ws[s]; const f32x4 ka = *(const LAS f32x4*)(Ks + s * 64 + e0), kb = *(const LAS f32x4*)(Ks + s * 64 + e0 + 4);
          u[0] += vw * ka.x; u[1] += vw * ka.y; u[2] += vw * ka.z; u[3] += vw * ka.w; u[4] += vw * kb.x; u[5] += vw * kb.y; u[6] += vw * kb.z; u[7] += vw * kb.w; }
      float* up = P.U + (size_t)ci * 4096 + dv * 64 + e0;
      *(f32x4*)up = (f32x4){u[0], u[1], u[2], u[3]}; *(f32x4*)(up + 4) = (f32x4){u[4], u[5], u[6], u[7]}; }
    if (tid < 64) { float nu = 0.f; for (int s = 0; s < 64; ++s) nu += ws[s] * Ks[s * 64 + tid]; P.NU[(size_t)ci * 64 + tid] = nu; }
    __syncthreads();
}
__device__ __forceinline__ void mlstm_m2(int u, const MlP& P, int tid) {
    const int bh = u >> 3, eg = u & 7, elem = eg * 512 + tid, base = bh * 256;
    const bool donorm = (eg == 0 && tid < 64), doms = (eg == 0 && tid == 0);
    float C = 0.f, m = 0.f, nst = 0.f;
    for (int c0 = 0; c0 < 256; c0 += 8) {
        float uv[8], be[8], ml[8], nv[8];
#pragma unroll
        for (int i = 0; i < 8; ++i) { const int ci = base + c0 + i; uv[i] = P.U[(size_t)ci * 4096 + elem]; be[i] = P.BEND[ci]; ml[i] = P.MLOC[ci]; nv[i] = donorm ? P.NU[(size_t)ci * 64 + tid] : 0.f; }
#pragma unroll
        for (int i = 0; i < 8; ++i) { const int ci = base + c0 + i;
            P.CS[(size_t)ci * 4096 + elem] = (bf16)f2bf(C);
            if (donorm) P.NS[(size_t)ci * 64 + tid] = nst;
            if (doms) P.MS[ci] = m;
            const float mn = fmaxf(be[i] + m, ml[i]); const float dec = expf(be[i] + m - mn), wu = expf(ml[i] - mn);
            C = dec * C + wu * uv[i]; nst = dec * nst + wu * nv[i]; m = mn; }
    }
}
__device__ __forceinline__ void mlstm_m3(int ci, const MlP& P, LAS float* lds, int tid, int wave, int lane) {
    constexpr int LP = 68;
    const int b = ci >> 10, h = (ci >> 8) & 3, c = ci & 255; const size_t row0 = (size_t)b * SEQ + c * 64;
    LAS float* Qs = lds; LAS float* Ks = Qs + 64 * LP; LAS float* Cs = Ks + 64 * LP; LAS float* Sm = Cs + 64 * LP; LAS float* Vs = Sm + 64 * LP;
    LAS float* av = Vs + 4096; LAS float* gv = av + 64; LAS float* bcv = gv + 64; LAS float* nsv = bcv + 64;
    const float ms = P.MS[ci];
    { const int r = tid >> 3, cg = (tid & 7) * 8; float f[8];
      unpack8(*(const v4u*)(P.QC + (row0 + r) * 256 + h * 64 + cg), f);
#pragma unroll
      for (int i = 0; i < 8; ++i) Qs[r * LP + cg + i] = f[i];
      unpack8(*(const v4u*)(P.KC + (row0 + r) * 256 + h * 64 + cg), f);
#pragma unroll
      for (int i = 0; i < 8; ++i) Ks[r * LP + cg + i] = f[i];
      unpack8(*(const v4u*)(P.PROJ + (row0 + r) * PLD + C_MV + h * 64 + cg), f);
#pragma unroll
      for (int i = 0; i < 8; ++i) Vs[r * 64 + cg + i] = f[i];
      unpack8(*(const v4u*)(P.CS + (size_t)ci * 4096 + r * 64 + cg), f);
#pragma unroll
      for (int i = 0; i < 8; ++i) Cs[r * LP + cg + i] = f[i]; }
    if (wave == 0) {
        const size_t row = row0 + lane;
        const float fi = P.GATES[row * 16 + 6 + h] + P.ibias[h], ff = P.GATES[row * 16 + 10 + h] + P.fbias[h];
        float bc = log_sigmoid_f(ff);
#pragma unroll
        for (int o = 1; o < 64; o <<= 1) { const float n = __shfl_up(bc, o); if (lane >= o) bc += n; }
        const float a = fi - bc; float pm = a;
#pragma unroll
        for (int o = 1; o < 64; o <<= 1) { const float n = __shfl_up(pm, o); if (lane >= o) pm = fmaxf(pm, n); }
        av[lane] = a; gv[lane] = fmaxf(ms, pm); bcv[lane] = bc; nsv[lane] = P.NS[(size_t)ci * 64 + lane];
    }
    __syncthreads();
    const int j = tid >> 3, part = tid & 7, s0 = part * 8;
    const float gj = gv[j];
    { float sacc[8] = {0.f, 0.f, 0.f, 0.f, 0.f, 0.f, 0.f, 0.f};
#pragma unroll 1
      for (int e = 0; e < 64; e += 4) { const f32x4 q4 = *(const LAS f32x4*)(Qs + j * LP + e);
#pragma unroll
          for (int i = 0; i < 8; ++i) { const f32x4 k4 = *(const LAS f32x4*)(Ks + (s0 + i) * LP + e); sacc[i] += (q4.x * k4.x + q4.y * k4.y) + (q4.z * k4.z + q4.w * k4.w); } }
#pragma unroll
      for (int i = 0; i < 8; ++i) { const int s = s0 + i; Sm[j * LP + s] = (s <= j) ? sacc[i] * expf(av[s] - gj) : 0.f; } }
    __syncthreads();
    { const int dv0 = part * 8; float t1[8] = {0.f, 0.f, 0.f, 0.f, 0.f, 0.f, 0.f, 0.f}, t2[8] = {0.f, 0.f, 0.f, 0.f, 0.f, 0.f, 0.f, 0.f};
#pragma unroll 1
      for (int e = 0; e < 64; e += 4) { const f32x4 q4 = *(const LAS f32x4*)(Qs + j * LP + e);
#pragma unroll
          for (int i = 0; i < 8; ++i) { const f32x4 c4 = *(const LAS f32x4*)(Cs + (dv0 + i) * LP + e); t1[i] += (q4.x * c4.x + q4.y * c4.y) + (q4.z * c4.z + q4.w * c4.w); } }
#pragma unroll 2
      for (int s = 0; s < 64; ++s) { const float sm = Sm[j * LP + s]; const f32x4 va = *(const LAS f32x4*)(Vs + s * 64 + dv0), vb = *(const LAS f32x4*)(Vs + s * 64 + dv0 + 4);
          t2[0] += sm * va.x; t2[1] += sm * va.y; t2[2] += sm * va.z; t2[3] += sm * va.w; t2[4] += sm * vb.x; t2[5] += sm * vb.y; t2[6] += sm * vb.z; t2[7] += sm * vb.w; }
      float dn = 0.f, ssum = 0.f;
#pragma unroll
      for (int i = 0; i < 8; ++i) { dn += nsv[s0 + i] * Qs[j * LP + s0 + i]; ssum += Sm[j * LP + s0 + i]; }
#pragma unroll
      for (int o = 1; o < 8; o <<= 1) { dn += __shfl_xor(dn, o); ssum += __shfl_xor(ssum, o); }
      const float inter = expf(ms - gj), mj = bcv[j] + gj;
      const float den = inter * dn + ssum, dd = fmaxf(fabsf(den), expf(-mj)), rd = 1.f / dd;
      float hv[8], ss = 0.f;
#pragma unroll
      for (int i = 0; i < 8; ++i) { hv[i] = (inter * t1[i] + t2[i]) * rd; ss += hv[i] * hv[i]; }
#pragma unroll
      for (int o = 1; o < 8; o <<= 1) ss += __shfl_xor(ss, o);
      const float rr = 1.f / sqrtf(ss * (1.f / 64.f) + EPS);
      float mo[8]; unpack8(*(const v4u*)(P.PROJ + (row0 + j) * PLD + C_MO + h * 64 + dv0), mo);
      float y[8];
#pragma unroll
      for (int i = 0; i < 8; ++i) y[i] = hv[i] * rr * P.hg[h * 64 + dv0 + i] * sigmoid_f(mo[i]);
      v4u w; w.x = pk2(y[0], y[1]); w.y = pk2(y[2], y[3]); w.z = pk2(y[4], y[5]); w.w = pk2(y[6], y[7]);
      *(v4u*)(P.Y + (row0 + j) * 1024 + Y_ML + h * 64 + dv0) = w; }
    __syncthreads();
}

__device__ __forceinline__ size_t moba_list_off(int bh, int n);
__device__ __forceinline__ void moba_gate_unit(int u, const bf16* PROJ, const float* KMEAN, unsigned* SEL, unsigned* LCNT, unsigned* CTAB, unsigned short* LIST, LAS float* lds, int tid) {
    const int bh = u >> 6, qb = 63 - (u & 63), b = bh / 6, h = bh % 6;
    LAS float* km = lds; LAS float* cand = lds + 4096; LAS unsigned* cntl = (LAS unsigned*)(lds + 4096 + 1536);
    if (tid < 64) cntl[tid] = 0u;
    for (int i = tid; i < qb * 16; i += NTHREADS) *(LAS f32x4*)(km + i * 4) = *(const f32x4*)(KMEAN + (size_t)bh * NBLK * 64 + i * 4) + *(const f32x4*)(KMEAN + (size_t)(12 * NBLK * 64) + (size_t)bh * NBLK * 64 + i * 4);
    __syncthreads();
    const int query = tid & 255, half = tid >> 8; const size_t row = (size_t)b * SEQ + qb * 256 + query;
    float q[64];
#pragma unroll
    for (int i = 0; i < 8; ++i) unpack8(*(const v4u*)(PROJ + row * PLD + C_BQ + h * 64 + i * 8), q + i * 8);
    float v0 = -INFINITY, v1 = -INFINITY, v2 = -INFINITY; int i0 = 255, i1 = 255, i2 = 255;
    const int nlo = half * 32, nhi = (qb < nlo + 32) ? qb : nlo + 32;
    for (int n = nlo; n < nhi; ++n) { float g = 0.f;
#pragma unroll
        for (int d = 0; d < 64; d += 4) { const f32x4 k4 = *(const LAS f32x4*)(km + n * 64 + d); g += (q[d] * k4.x + q[d + 1] * k4.y) + (q[d + 2] * k4.z + q[d + 3] * k4.w); }
        if (g > v0) { v2 = v1; i2 = i1; v1 = v0; i1 = i0; v0 = g; i0 = n; } else if (g > v1) { v2 = v1; i2 = i1; v1 = g; i1 = n; } else if (g > v2) { v2 = g; i2 = n; } }
    if (half == 1) { cand[query * 6 + 0] = v0; cand[query * 6 + 1] = v1; cand[query * 6 + 2] = v2;
        cand[query * 6 + 3] = __int_as_float(i0); cand[query * 6 + 4] = __int_as_float(i1); cand[query * 6 + 5] = __int_as_float(i2); }
    __syncthreads();
    if (half == 0) {
#pragma unroll
        for (int k = 0; k < 3; ++k) { const float g = cand[query * 6 + k]; const int n = __float_as_int(cand[query * 6 + 3 + k]);
            if (n != 255) { if (g > v0) { v2 = v1; i2 = i1; v1 = v0; i1 = i0; v0 = g; i0 = n; } else if (g > v1) { v2 = v1; i2 = i1; v1 = g; i1 = n; } else if (g > v2) { v2 = g; i2 = n; } } }
        SEL[row * 6 + h] = (unsigned)i0 | ((unsigned)i1 << 8) | ((unsigned)i2 << 16);
        if (LIST) { const unsigned t = (unsigned)(qb * 256 + query);
            if (i0 != 255) { const unsigned pos = __hip_atomic_fetch_add(cntl + i0, 1u, __ATOMIC_RELAXED, __HIP_MEMORY_SCOPE_WORKGROUP); LIST[moba_list_off(bh, i0) + (size_t)(qb - i0 - 1) * 256 + pos] = (unsigned short)(t | (0u << 14)); }
            if (i1 != 255) { const unsigned pos = __hip_atomic_fetch_add(cntl + i1, 1u, __ATOMIC_RELAXED, __HIP_MEMORY_SCOPE_WORKGROUP); LIST[moba_list_off(bh, i1) + (size_t)(qb - i1 - 1) * 256 + pos] = (unsigned short)(t | (1u << 14)); }
            if (i2 != 255) { const unsigned pos = __hip_atomic_fetch_add(cntl + i2, 1u, __ATOMIC_RELAXED, __HIP_MEMORY_SCOPE_WORKGROUP); LIST[moba_list_off(bh, i2) + (size_t)(qb - i2 - 1) * 256 + pos] = (unsigned short)(t | (2u << 14)); } }
    }
    __syncthreads();
    if (LIST && tid < 64) { const unsigned c = cntl[tid]; CTAB[((size_t)bh * 64 + qb) * 64 + tid] = c; if (c) atomicAdd(LCNT + bh * 64 + tid, c); }
    __syncthreads();
}

__device__ __forceinline__ void fox_naive(const bf16* PROJ, const float* FOXCUM, bf16* Y, int gw, int NGW, int lane) {
    for (int idx = gw; idx < 12 * SEQ; idx += NGW) {
        const int t = SEQ - 1 - idx / 12, bh = idx % 12, b = bh / 6, h = bh % 6; const size_t rb = (size_t)b * SEQ;
        const float qv = bf2f(PROJ[(rb + t) * PLD + C_FQ + h * 64 + lane]); const float ct = FOXCUM[(size_t)bh * SEQ + t];
        float m = -INFINITY, l = 0.f, acc = 0.f;
#pragma unroll 4
        for (int j = 0; j <= t; ++j) {
            const float kv = bf2f(PROJ[(rb + j) * PLD + C_FK + h * 64 + lane]), vv = bf2f(PROJ[(rb + j) * PLD + C_FV + h * 64 + lane]);
            const float s = wave_sum(qv * kv) + (ct - FOXCUM[(size_t)bh * SEQ + j]);
            const float mn = fmaxf(m, s), sc = exp2f(m - mn), p = exp2f(s - mn);
            l = l * sc + p; acc = acc * sc + p * vv; m = mn; }
        Y[(rb + t) * 1024 + Y_FOX + h * 64 + lane] = (bf16)f2bf(acc / l);
    }
}
__device__ __forceinline__ void moba_naive(const bf16* PROJ, const unsigned* SEL, bf16* Y, int gw, int NGW, int lane) {
    for (int idx = gw; idx < 12 * SEQ; idx += NGW) {
        const int t = SEQ - 1 - idx / 12, bh = idx % 12, b = bh / 6, h = bh % 6; const size_t rb = (size_t)b * SEQ;
        const float slope2 = exp2f(-8.f * (float)(h + 1) / 6.f) * LOG2E;
        const float qv = bf2f(PROJ[(rb + t) * PLD + C_BQ + h * 64 + lane]);
        const unsigned sel = SEL[(rb + t) * 6 + h];
        float m = -INFINITY, l = 0.f, acc = 0.f;
        for (int slot = 0; slot < 4; ++slot) {
            int j0, j1;
            if (slot < 3) { const int n = (sel >> (8 * slot)) & 0xff; if (n == 255) continue; j0 = n * 256; j1 = j0 + 256; } else { j0 = (t >> 8) * 256; j1 = t + 1; }
#pragma unroll 4
            for (int j = j0; j < j1; ++j) {
                const float kv = bf2f(PROJ[(rb + j) * PLD + C_BK + h * 64 + lane]), vv = bf2f(PROJ[(rb + j) * PLD + C_BV + h * 64 + lane]);
                const float s = wave_sum(qv * kv) - slope2 * (float)(t - j);
                const float mn = fmaxf(m, s), sc = exp2f(m - mn), p = exp2f(s - mn);
                l = l * sc + p; acc = acc * sc + p * vv; m = mn; }
        }
        Y[(rb + t) * 1024 + Y_MOBA + h * 64 + lane] = (bf16)f2bf(acc / l);
    }
}
typedef short v4i16_t __attribute__((ext_vector_type(4)));
typedef short s16x4 __attribute__((ext_vector_type(4)));
constexpr int ATT_K0 = 0, ATT_V0 = 32768, ATT_TAB = 132096;
constexpr float THRESH2 = 40.f * LOG2E;

__device__ __forceinline__ int crow(int r, int hi) { return (r & 3) + 8 * (r >> 2) + 4 * hi; }
__device__ __forceinline__ s16x4 vtr(LAS const unsigned char* p) { return __builtin_bit_cast(s16x4, __builtin_amdgcn_ds_read_tr16_b64_v4i16((LAS v4i16_t*)p)); }
__device__ __forceinline__ unsigned cvtpk(float lo, float hi) { unsigned r; asm volatile("v_cvt_pk_bf16_f32 %0, %1, %2" : "=v"(r) : "v"(lo), "v"(hi)); return r; }

__device__ __forceinline__ void load_group(const bf16* Kg, const bf16* Vg, LAS unsigned char* lds, int tid) {
#pragma unroll
    for (int i = 0; i < 4; ++i) { const int idx = tid + NTHREADS * i, row = idx >> 3, ch = idx & 7;
        const v4u k = *(const v4u*)(Kg + (size_t)row * PLD + ch * 8), v = *(const v4u*)(Vg + (size_t)row * PLD + ch * 8);
        *(LAS v4u*)(lds + ATT_K0 + row * 128 + ((ch ^ ((row >> 1) & 7)) << 4)) = k;
        *(LAS v4u*)(lds + ATT_V0 + row * 128 + ((ch * 16) ^ (((row >> 1) & 1) << 6))) = v; }
}

template <bool FOX>
__device__ __forceinline__ void attn_subtile(LAS const unsigned char* lds, int j0, const bf16x8 (&qf)[4], float rowterm, float slope2, bool mask, int qrel,
                                             f32x16 (&o)[2], float& l, int lane) {
    const int r32 = lane & 31, hh = lane >> 5;
    f32x16 acc;
    if (FOX) { LAS const float* colt = (LAS const float*)(lds + ATT_TAB);
#pragma unroll
        for (int g = 0; g < 4; ++g) { const f32x4 c = *(LAS const f32x4*)(colt + j0 + 8 * g + 4 * hh); acc[4 * g + 0] = rowterm + c.x; acc[4 * g + 1] = rowterm + c.y; acc[4 * g + 2] = rowterm + c.z; acc[4 * g + 3] = rowterm + c.w; }
    } else {
#pragma unroll
        for (int r = 0; r < 16; ++r) acc[r] = rowterm + slope2 * (float)(j0 + crow(r, hh));
    }
    if (mask) {
#pragma unroll
        for (int r = 0; r < 16; ++r) if (j0 + crow(r, hh) > qrel) acc[r] = -INFINITY;
    }
    { const int row = j0 + r32; LAS const unsigned char* kr = lds + ATT_K0 + row * 128; const int sw = (row >> 1) & 7;
#pragma unroll
      for (int s = 0; s < 4; ++s) { const bf16x8 kf = *(LAS const bf16x8*)(kr + (((2 * s + hh) ^ sw) << 4)); acc = __builtin_amdgcn_mfma_f32_32x32x16_bf16(kf, qf[s], acc, 0, 0, 0); } }
    float ls = 0.f;
#pragma unroll
    for (int r = 0; r < 16; ++r) { acc[r] = __builtin_amdgcn_exp2f(acc[r]); ls += acc[r]; }
    l += ls;
    bf16x8 pa[2];
#pragma unroll
    for (int s = 0; s < 2; ++s) { v4u w; w.x = cvtpk(acc[8 * s + 0], acc[8 * s + 1]); w.y = cvtpk(acc[8 * s + 2], acc[8 * s + 3]); w.z = cvtpk(acc[8 * s + 4], acc[8 * s + 5]); w.w = cvtpk(acc[8 * s + 6], acc[8 * s + 7]); pa[s] = __builtin_bit_cast(bf16x8, w); }
    { const int i = lane & 15, c = (lane >> 4) & 1;
#pragma unroll
      for (int db = 0; db < 2; ++db)
#pragma unroll
          for (int s = 0; s < 2; ++s) { const int rowv = j0 + 16 * s + 4 * hh + (i >> 2); const int colb = (32 * db + 16 * c + 4 * (i & 3)) * 2;
              LAS const unsigned char* vp = lds + ATT_V0 + rowv * 128 + (colb ^ (((rowv >> 1) & 1) << 6));
              const s16x4 lo = vtr(vp), hi = vtr(vp + 8 * 128);
              const bf16x8 vf = (bf16x8){lo[0], lo[1], lo[2], lo[3], hi[0], hi[1], hi[2], hi[3]};
              o[db] = __builtin_amdgcn_mfma_f32_32x32x16_bf16(pa[s], vf, o[db], 0, 0, 0); } }
}

__device__ __forceinline__ void fox_unit(int bh, int qb, const bf16* PROJ, const float* FOXCUM, bf16* Y, float B2, LAS unsigned char* lds, int tid, int wave, int lane) {
    const int b = bh / 6, h = bh % 6; const size_t rb = (size_t)b * SEQ; const int r32 = lane & 31, hh = lane >> 5;
    const int q0w = qb * 256 + wave * 32, qpos = q0w + r32;
    const float* cum = FOXCUM + (size_t)bh * SEQ;
    bf16x8 qf[4];
#pragma unroll
    for (int s = 0; s < 4; ++s) qf[s] = *(const bf16x8*)(PROJ + (rb + qpos) * PLD + C_FQ + h * 64 + 16 * s + 8 * hh);
    const float cq = cum[qpos];
    const float cq_first = __builtin_bit_cast(float, __builtin_amdgcn_readfirstlane(__builtin_bit_cast(int, cum[q0w])));
    const float cq_blk = __builtin_bit_cast(float, __builtin_amdgcn_readfirstlane(__builtin_bit_cast(int, cum[qb * 256])));
    const float rowterm = cq - B2;
    f32x16 o[2]; float l = 0.f;
#pragma unroll
    for (int r = 0; r < 16; ++r) { o[0][r] = 0.f; o[1][r] = 0.f; }
    LAS float* colt = (LAS float*)(lds + ATT_TAB);
    for (int g = qb; g >= 0; --g) {
        if (g < qb) { const float cl = __builtin_bit_cast(float, __builtin_amdgcn_readfirstlane(__builtin_bit_cast(int, cum[g * 256 + 255]))); if (2.f * B2 + cq_blk - cl < -THRESH2) break; }
        load_group(PROJ + (rb + (size_t)g * 256) * PLD + C_FK + h * 64, PROJ + (rb + (size_t)g * 256) * PLD + C_FV + h * 64, lds, tid);
        if (tid < 256) colt[tid] = -cum[g * 256 + tid];
        __syncthreads();
        const int stmax = (g == qb) ? wave : 7;
        for (int st = stmax; st >= 0; --st) {
            const int j0 = 32 * st;
            { const float cl = __builtin_bit_cast(float, __builtin_amdgcn_readfirstlane(__builtin_bit_cast(int, colt[j0 + 31]))); if (2.f * B2 + cq_first + cl < -THRESH2) break; }
            attn_subtile<true>(lds, j0, qf, rowterm, 0.f, (g == qb) && (st == wave), wave * 32 + r32, o, l, lane);
        }
        __syncthreads();
    }
    l += __shfl_xor(l, 32);
    bf16* yp = Y + (rb + (size_t)q0w) * 1024 + Y_FOX + h * 64 + r32;
#pragma unroll
    for (int r = 0; r < 16; ++r) { const int q = crow(r, hh); const float rl = 1.f / __shfl(l, q);
        yp[(size_t)q * 1024] = (bf16)f2bf(o[0][r] * rl); yp[(size_t)q * 1024 + 32] = (bf16)f2bf(o[1][r] * rl); }
}

__device__ __forceinline__ size_t moba_list_off(int bh, int n) { return (size_t)bh * 516096 + 256 * (size_t)(63 * n - (n * (n - 1)) / 2); }
__device__ __forceinline__ void moba_unit(int bh, int n, int chunk, bool own, int cnt, const bf16* PROJ, const unsigned short* LIST, const unsigned* CTAB, bf16* OPART, float* LPART, bf16* Y, float B2,
                                          LAS unsigned char* lds, int tid, int wave, int lane) {
    const int b = bh / 6, h = bh % 6; const size_t rb = (size_t)b * SEQ; const int r32 = lane & 31, hh = lane >> 5;
    const float slope2 = exp2f(-8.f * (float)(h + 1) / 6.f) * LOG2E;
    load_group(PROJ + (rb + (size_t)n * 256) * PLD + C_BK + h * 64, PROJ + (rb + (size_t)n * 256) * PLD + C_BV + h * 64, lds, tid);
    __syncthreads();
    const int nvalid = own ? 256 : (cnt - chunk * 256 < 256 ? cnt - chunk * 256 : 256);
    if (wave * 32 < nvalid) {
        int qpos, slot; bool valid = true;
        if (own) { qpos = n * 256 + wave * 32 + r32; slot = 3; }
        else { int li = wave * 32 + r32; if (li >= nvalid) { li = nvalid - 1; valid = false; }
            const int p = chunk * 256 + li;
            const int cv = (lane > n) ? (int)CTAB[((size_t)bh * 64 + lane) * 64 + n] : 0; int inc = cv;
#pragma unroll
            for (int o = 1; o < 64; o <<= 1) { const int t2 = __shfl_up(inc, o); if (lane >= o) inc += t2; }
            int qseg = 0;
#pragma unroll
            for (int stp = 32; stp >= 1; stp >>= 1) { const int v = __shfl(inc, qseg + stp - 1); if (v <= p) qseg += stp; }
            const int idx = p - (__shfl(inc, qseg) - __shfl(cv, qseg));
            const unsigned e = LIST[moba_list_off(bh, n) + (size_t)(qseg - n - 1) * 256 + idx]; qpos = e & 0x3fff; slot = e >> 14; }
        bf16x8 qf[4];
#pragma unroll
        for (int s = 0; s < 4; ++s) qf[s] = *(const bf16x8*)(PROJ + (rb + qpos) * PLD + C_BQ + h * 64 + 16 * s + 8 * hh);
        const int qrel = qpos - n * 256;
        const float rowterm = -slope2 * (float)qrel - B2;
        f32x16 o[2]; float l = 0.f;
#pragma unroll
        for (int r = 0; r < 16; ++r) { o[0][r] = 0.f; o[1][r] = 0.f; }
        const int stmax = own ? wave : 7;
        for (int st = 0; st <= stmax; ++st) attn_subtile<false>(lds, 32 * st, qf, rowterm, slope2, own && (st == wave), qrel, o, l, lane);
        l += __shfl_xor(l, 32);
#pragma unroll
        for (int r = 0; r < 16; ++r) { const int src = crow(r, hh);
            const int qp = __shfl(qpos, src), sl = __shfl(slot, src); const int ok = __shfl((int)valid, src);
            if (ok) { bf16* op = (sl == 3) ? (Y + (rb + qp) * 1024 + Y_MOBA + h * 64) : (OPART + ((size_t)sl * MROWS + rb + qp) * 384 + h * 64);
                op[r32] = (bf16)f2bf(o[0][r]); op[32 + r32] = (bf16)f2bf(o[1][r]); } }
        if (valid && hh == 0) LPART[((size_t)slot * MROWS + rb + qpos) * 6 + h] = l;
    }
    __syncthreads();
}

__device__ __forceinline__ void moba_combine(const unsigned* SEL, const bf16* OPART, const float* LPART, bf16* Y, bf16* Yo, int opitch, int ocol, int gtid, int ngt) {
    for (size_t idx = gtid; idx < (size_t)MROWS * 48; idx += ngt) {
        const size_t row = idx / 48; const int hc = (int)(idx % 48), h = hc >> 3, c8 = (hc & 7) * 8;
        const unsigned sel = SEL[row * 6 + h];
        bf16* yp = Y + row * 1024 + Y_MOBA + h * 64 + c8;
        float acc[8]; unpack8(*(const v4u*)yp, acc);
        float l = LPART[((size_t)3 * MROWS + row) * 6 + h];
#pragma unroll
        for (int k = 0; k < 3; ++k) if (((sel >> (8 * k)) & 0xff) != 255) { float f[8]; unpack8(*(const v4u*)(OPART + ((size_t)k * MROWS + row) * 384 + h * 64 + c8), f);
#pragma unroll
            for (int i = 0; i < 8; ++i) acc[i] += f[i];
            l += LPART[((size_t)k * MROWS + row) * 6 + h]; }
        const float rl = 1.f / l;
        v4u w; w.x = pk2(acc[0] * rl, acc[1] * rl); w.y = pk2(acc[2] * rl, acc[3] * rl); w.z = pk2(acc[4] * rl, acc[5] * rl); w.w = pk2(acc[6] * rl, acc[7] * rl);
        *(v4u*)(Yo + row * opitch + ocol + h * 64 + c8) = w;
    }
}

__device__ __forceinline__ int vsw(int row, int colb) { return row * 128 + (colb ^ (((row >> 1) & 1) << 6)); }
__device__ __forceinline__ int ksw(int row, int ch) { return row * 128 + ((ch ^ ((row >> 1) & 7)) << 4); }
__device__ __forceinline__ void mlstm_m1_mfma(int ci, const MlP& P, LAS unsigned char* lds, int wave, int lane) {
    const int b = ci >> 10, h = (ci >> 8) & 3, c = ci & 255; const size_t row0 = (size_t)b * SEQ + c * 64;
    LAS unsigned char* Ki = lds + wave * 16384; LAS unsigned char* Vi = Ki + 8192;
    float wv;
    { const size_t row = row0 + lane;
      const float fi = P.GATES[row * 16 + 6 + h] + P.ibias[h], ff = P.GATES[row * 16 + 10 + h] + P.fbias[h];
      float bc = log_sigmoid_f(ff);
#pragma unroll
      for (int o = 1; o < 64; o <<= 1) { const float n = __shfl_up(bc, o); if (lane >= o) bc += n; }
      const float bend = __shfl(bc, 63);
      const float wl = bend - bc + fi; const float mloc = wave_max(wl);
      wv = expf(wl - mloc);
      if (lane == 0) { P.BEND[ci] = bend; P.MLOC[ci] = mloc; } }
#pragma unroll
    for (int i = 0; i < 8; ++i) { const int idx = lane + 64 * i, r = idx >> 3, ch = idx & 7;
        const v4u kk = *(const v4u*)(P.KC + (row0 + r) * 256 + h * 64 + ch * 8);
        *(LAS v4u*)(Ki + vsw(r, ch * 16)) = kk;
        float f[8]; unpack8(*(const v4u*)(P.PROJ + (row0 + r) * PLD + C_MV + h * 64 + ch * 8), f);
        const float w = __shfl(wv, r);
        v4u o; o.x = pk2(f[0] * w, f[1] * w); o.y = pk2(f[2] * w, f[3] * w); o.z = pk2(f[4] * w, f[5] * w); o.w = pk2(f[6] * w, f[7] * w);
        *(LAS v4u*)(Vi + vsw(r, ch * 16)) = o; }
    LDS_WAIT(); asm volatile("" ::: "memory");
    { float nu = 0.f;
#pragma unroll 8
      for (int s = 0; s < 64; ++s) { const float ws = __shfl(wv, s); nu += ws * bf2f(*(LAS const unsigned short*)(Ki + vsw(s, 2 * lane))); }
      P.NU[(size_t)ci * 64 + lane] = nu; }
    f32x16 D[2][2];
#pragma unroll
    for (int a = 0; a < 2; ++a)
#pragma unroll
        for (int e = 0; e < 2; ++e)
#pragma unroll
            for (int r = 0; r < 16; ++r) D[a][e][r] = 0.f;
    const int i16 = lane & 15, cc = (lane >> 4) & 1, hh = lane >> 5, r32 = lane & 31;
#pragma unroll
    for (int ks = 0; ks < 4; ++ks) { const int rowv = 16 * ks + 4 * hh + (i16 >> 2);
        bf16x8 af[2], bfr[2];
#pragma unroll
        for (int blk = 0; blk < 2; ++blk) { const int colb = (32 * blk + 16 * cc + 4 * (i16 & 3)) * 2;
            { const s16x4 lo = vtr(Vi + vsw(rowv, colb)), hi = vtr(Vi + vsw(rowv, colb) + 1024); af[blk] = (bf16x8){lo[0], lo[1], lo[2], lo[3], hi[0], hi[1], hi[2], hi[3]}; }
            { const s16x4 lo = vtr(Ki + vsw(rowv, colb)), hi = vtr(Ki + vsw(rowv, colb) + 1024); bfr[blk] = (bf16x8){lo[0], lo[1], lo[2], lo[3], hi[0], hi[1], hi[2], hi[3]}; } }
#pragma unroll
        for (int a = 0; a < 2; ++a)
#pragma unroll
            for (int e = 0; e < 2; ++e) D[a][e] = __builtin_amdgcn_mfma_f32_32x32x16_bf16(af[a], bfr[e], D[a][e], 0, 0, 0); }
    float* up = P.U + (size_t)ci * 4096;
#pragma unroll
    for (int a = 0; a < 2; ++a)
#pragma unroll
        for (int e = 0; e < 2; ++e)
#pragma unroll
            for (int r = 0; r < 16; ++r) up[(32 * a + crow(r, hh)) * 64 + 32 * e + r32] = D[a][e][r];
    LDS_WAIT(); asm volatile("" ::: "memory");
}

__device__ __forceinline__ void mlstm_m3_mfma(int it, const MlP& P, LAS unsigned char* lds, int tid, int wave, int lane) {
    const int cs = wave >> 1, tile = wave & 1, ci = it * 4 + cs;
    const int b = ci >> 10, h = (ci >> 8) & 3, c = ci & 255; const size_t row0 = (size_t)b * SEQ + c * 64;
    LAS unsigned char* Ki = lds + cs * 24576; LAS unsigned char* Vi = Ki + 8192; LAS unsigned char* Ci = Ki + 16384;
    LAS float* tab = (LAS float*)(lds + ATT_TAB) + cs * 256;
    const float ms = P.MS[ci];
    { const int pt = tile * 64 + lane;
#pragma unroll
      for (int i = 0; i < 4; ++i) { const int idx = pt + 128 * i, r = idx >> 3, ch = idx & 7;
          *(LAS v4u*)(Ki + ksw(r, ch)) = *(const v4u*)(P.KC + (row0 + r) * 256 + h * 64 + ch * 8);
          *(LAS v4u*)(Vi + vsw(r, ch * 16)) = *(const v4u*)(P.PROJ + (row0 + r) * PLD + C_MV + h * 64 + ch * 8);
          *(LAS v4u*)(Ci + ksw(r, ch)) = *(const v4u*)(P.CS + (size_t)ci * 4096 + r * 64 + ch * 8); } }
    if (tile == 0) {
        const size_t row = row0 + lane;
        const float fi = P.GATES[row * 16 + 6 + h] + P.ibias[h], ff = P.GATES[row * 16 + 10 + h] + P.fbias[h];
        float bc = log_sigmoid_f(ff);
#pragma unroll
        for (int o = 1; o < 64; o <<= 1) { const float n = __shfl_up(bc, o); if (lane >= o) bc += n; }
        const float a = fi - bc; float pm = a;
#pragma unroll
        for (int o = 1; o < 64; o <<= 1) { const float n = __shfl_up(pm, o); if (lane >= o) pm = fmaxf(pm, n); }
        tab[lane] = a * LOG2E; tab[64 + lane] = fmaxf(ms, pm); tab[128 + lane] = bc; tab[192 + lane] = P.NS[(size_t)ci * 64 + lane];
    }
    __syncthreads();
    const int r32 = lane & 31, hh = lane >> 5, j = 32 * tile + r32;
    bf16x8 qf[4];
#pragma unroll
    for (int s = 0; s < 4; ++s) qf[s] = *(const bf16x8*)(P.QC + (row0 + j) * 256 + h * 64 + 16 * s + 8 * hh);
    const float gj = tab[64 + j], inter = expf(ms - gj), rowterm2 = -gj * LOG2E;
    f32x16 o[2]; float l = 0.f;
#pragma unroll
    for (int r = 0; r < 16; ++r) { o[0][r] = 0.f; o[1][r] = 0.f; }
    for (int st = 0; st <= tile; ++st) {
        const int j0 = 32 * st;
        f32x16 acc;
#pragma unroll
        for (int r = 0; r < 16; ++r) acc[r] = 0.f;
#pragma unroll
        for (int s = 0; s < 4; ++s) { const bf16x8 kf = *(LAS const bf16x8*)(Ki + ksw(j0 + r32, 2 * s + hh)); acc = __builtin_amdgcn_mfma_f32_32x32x16_bf16(kf, qf[s], acc, 0, 0, 0); }
        float ls = 0.f;
#pragma unroll
        for (int g4 = 0; g4 < 4; ++g4) { const f32x4 c4 = *(LAS const f32x4*)(tab + j0 + 8 * g4 + 4 * hh);
#pragma unroll
            for (int ii = 0; ii < 4; ++ii) { const int reg = 4 * g4 + ii, key = j0 + 8 * g4 + 4 * hh + ii;
                float p = acc[reg] * __builtin_amdgcn_exp2f(rowterm2 + c4[ii]);
                if (st == tile && key > j) p = 0.f;
                acc[reg] = p; ls += p; } }
        l += ls;
        bf16x8 pa[2];
#pragma unroll
        for (int s = 0; s < 2; ++s) { v4u w; w.x = cvtpk(acc[8 * s + 0], acc[8 * s + 1]); w.y = cvtpk(acc[8 * s + 2], acc[8 * s + 3]); w.z = cvtpk(acc[8 * s + 4], acc[8 * s + 5]); w.w = cvtpk(acc[8 * s + 6], acc[8 * s + 7]); pa[s] = __builtin_bit_cast(bf16x8, w); }
        { const int i16 = lane & 15, cc = (lane >> 4) & 1;
#pragma unroll
          for (int db = 0; db < 2; ++db)
#pragma unroll
              for (int s = 0; s < 2; ++s) { const int rowv = j0 + 16 * s + 4 * hh + (i16 >> 2); const int colb = (32 * db + 16 * cc + 4 * (i16 & 3)) * 2;
                  LAS const unsigned char* vp = Vi + vsw(rowv, colb);
                  const s16x4 lo = vtr(vp), hi = vtr(vp + 1024);
                  const bf16x8 vf = (bf16x8){lo[0], lo[1], lo[2], lo[3], hi[0], hi[1], hi[2], hi[3]};
                  o[db] = __builtin_amdgcn_mfma_f32_32x32x16_bf16(pa[s], vf, o[db], 0, 0, 0); } }
    }
    float dn = 0.f;
#pragma unroll
    for (int s = 0; s < 4; ++s) { float f[8]; unpack8(__builtin_bit_cast(v4u, qf[s]), f);
        const f32x4 n0 = *(LAS const f32x4*)(tab + 192 + 16 * s + 8 * hh), n1 = *(LAS const f32x4*)(tab + 192 + 16 * s + 8 * hh + 4);
        dn += (f[0] * n0.x + f[1] * n0.y) + (f[2] * n0.z + f[3] * n0.w) + (f[4] * n1.x + f[5] * n1.y) + (f[6] * n1.z + f[7] * n1.w);
        v4u w; w.x = cvtpk(f[0] * inter, f[1] * inter); w.y = cvtpk(f[2] * inter, f[3] * inter); w.z = cvtpk(f[4] * inter, f[5] * inter); w.w = cvtpk(f[6] * inter, f[7] * inter);
        const bf16x8 qs = __builtin_bit_cast(bf16x8, w);
#pragma unroll
        for (int db = 0; db < 2; ++db) { const bf16x8 cf = *(LAS const bf16x8*)(Ci + ksw(32 * db + r32, 2 * s + hh)); o[db] = __builtin_amdgcn_mfma_f32_32x32x16_bf16(qs, cf, o[db], 0, 0, 0); } }
    dn += __shfl_xor(dn, 32); l += __shfl_xor(l, 32);
    const float den = inter * dn + l, mj = tab[128 + j] + gj;
    const float rd = 1.f / fmaxf(fabsf(den), expf(-mj));
    const float hg0 = P.hg[h * 64 + r32], hg1 = P.hg[h * 64 + 32 + r32];
#pragma unroll
    for (int r = 0; r < 16; ++r) { const int src = crow(r, hh); const float rdr = __shfl(rd, src);
        const float h0 = o[0][r] * rdr, h1 = o[1][r] * rdr; float ss = h0 * h0 + h1 * h1;
#pragma unroll
        for (int ofs = 1; ofs < 32; ofs <<= 1) ss += __shfl_xor(ss, ofs);
        const float rr = 1.f / sqrtf(ss * (1.f / 64.f) + EPS);
        const size_t row = row0 + 32 * tile + src;
        const float mo0 = bf2f(P.PROJ[row * PLD + C_MO + h * 64 + r32]), mo1 = bf2f(P.PROJ[row * PLD + C_MO + h * 64 + 32 + r32]);
        P.Y[row * 1024 + Y_ML + h * 64 + r32] = (bf16)f2bf(h0 * rr * hg0 * sigmoid_f(mo0));
        P.Y[row * 1024 + Y_ML + h * 64 + 32 + r32] = (bf16)f2bf(h1 * rr * hg1 * sigmoid_f(mo1)); }
    __syncthreads();
}
#ifndef FOX_MFMA
#define FOX_MFMA 1
#endif
#ifndef MOBA_MFMA
#define MOBA_MFMA 1
#endif
#ifndef REP_P0
#define REP_P0 0
#endif
#ifndef REP_NORM
#define REP_NORM 0
#endif
#ifndef REP_GIN
#define REP_GIN 0
#endif
#ifndef REP_FOX
#define REP_FOX 0
#endif
#ifndef REP_M1
#define REP_M1 0
#endif
#ifndef REP_MIXB
#define REP_MIXB 0
#endif
#ifndef REP_M3
#define REP_M3 0
#endif
#ifndef REP_GGU
#define REP_GGU 0
#endif
#ifndef REP_GATE
#define REP_GATE 0
#endif
#ifndef REP_CONV
#define REP_CONV 0
#endif
#ifndef REP_FCUM
#define REP_FCUM 0
#endif
#ifndef REP_QKN
#define REP_QKN 0
#endif
#ifndef REP_GOUT
#define REP_GOUT 0
#endif
#ifndef REP_GDN
#define REP_GDN 0
#endif
#ifndef REP_COMB
#define REP_COMB 0
#endif
#ifndef REP_BAR
#define REP_BAR 0
#endif
#ifndef REP_GATE2
#define REP_GATE2 0
#endif
#ifndef ML_MFMA
#define ML_MFMA 1
#endif
#ifndef N_LAUNCH_MODE
#define N_LAUNCH_MODE 1
#endif
constexpr int NPHASE = 1 + 10 * DEPTH;
struct Args { const float* in[20]; float* out; unsigned char* ws; int ph_lo, ph_hi; };
static_assert(sizeof(Args) == 20 * 8 + 8 + 8 + 8, "Args has no padding");

__global__ void __launch_bounds__(NTHREADS, 2) fwd(Args args) {
    extern __shared__ __attribute__((aligned(16))) unsigned char lds_raw[];
    LAS unsigned char* lds = (LAS unsigned char*)lds_raw;
    LAS float* ldsf = (LAS float*)lds_raw;
    volatile LAS unsigned* MISC = (volatile LAS unsigned*)(lds + MISC_OFF);
    const int G = gridDim.x; const int bx = blockIdx.x; const int vcu = (G % 8 == 0) ? (bx % 8) * (G / 8) + bx / 8 : bx;
    const int NGW = G * NWAVES;
#define PH_IDS() int tid = threadIdx.x; asm volatile("" : "+v"(tid)); const int lane = tid & 63, wave = __builtin_amdgcn_readfirstlane(tid >> 6); const int gw = vcu * NWAVES + wave; (void)lane; (void)gw
    unsigned char* ws = args.ws;
    gu32* ctl = (gu32*)(ws + WS_CTL);
    for (int u = threadIdx.x; u < (LDS_BYTES - LDSCTL_OFF) / 4; u += NTHREADS) ((LAS unsigned*)(lds + LDSCTL_OFF))[u] = 0u;
    __syncthreads();
    XcdBarrier bar; bar.bar = (unsigned*)(ctl + CW_BAR); bar.x = 0; bar.st = nullptr;
    if (N_LAUNCH_MODE == 1) bar = xcd_barrier_post((unsigned*)(ctl + CW_BAR), MISC + 8);
    const int lo = args.ph_lo, hi = args.ph_hi;
#ifndef PHMASK
#define PHMASK 0x7ff
#endif
#define PHEN(j) ((PHMASK >> (j)) & 1)
#define IN(k) (lo <= (k) && (k) < hi)
#define SEAM(k) do { if (IN(k) && IN((k) + 1)) { xcd_barrier(bar); for (int rb_ = 0; rb_ < REP_BAR; ++rb_) xcd_barrier(bar); } } while (0)

    const float* x_in = args.in[0]; const float* cvec = args.in[1]; const float* w_ada = args.in[2]; const float* b_ada = args.in[3];
    const float* norm1_g = args.in[4]; const float* norm2_g = args.in[5]; const float* w_in = args.in[6]; const float* fox_f_bias = args.in[7];
    const float* fox_q_g = args.in[8]; const float* fox_k_g = args.in[9]; const float* ml_conv_w = args.in[10]; const float* ml_conv_b = args.in[11];
    const float* ml_i_bias = args.in[12]; const float* ml_f_bias = args.in[13]; const float* ml_h_g = args.in[14]; const float* moba_q_g = args.in[15];
    const float* moba_k_g = args.in[16]; const float* w_out = args.in[17]; const float* w_gate_up = args.in[18]; const float* w_down = args.in[19];
    float* xres = args.out;
    float* MOD = (float*)(ws + WS_MOD);
    bf16* XN = (bf16*)(ws + WS_XN); bf16* PROJ = (bf16*)(ws + WS_PROJ); bf16* HB = (bf16*)(ws + WS_H); bf16* Y = (bf16*)(ws + WS_Y);
    float* GATES = (float*)(ws + WS_GATES); float* FOXCUM = (float*)(ws + WS_FOXCUM); float* KMEAN = (float*)(ws + WS_KMEAN);
    bf16* QC = (bf16*)(ws + WS_QC); bf16* KC = (bf16*)(ws + WS_KC); unsigned* SEL = (unsigned*)(ws + WS_SEL);

    for (int rep = 0; rep <= REP_P0; ++rep)
    if (PHEN(10) && IN(0)) { PH_IDS();
        if (vcu < 192) p0_mod_unit(vcu, cvec, w_ada, b_ada, MOD, ldsf, tid, wave, lane);
        LAS float* scr = (LAS float*)(lds + wave * 16384);
        constexpr int I_IN = 16 * (NIN / 32), I_OUT = 16 * (DM / 32), I_GU = 16 * (NGU / 32), I_DN = (DFF / 64) * (DM / 32), I_L = I_IN + I_OUT + I_GU + I_DN;
        for (int it = gw; it < DEPTH * I_L; it += NGW) {
            const int l = it / I_L; int r = it % I_L;
            if (r < I_IN) { transpose_item<1>(w_in + (size_t)l * DM * INC, DM, INC, (bf16*)(ws + WS_WIN + l * WIN_BYTES), scr, NIN / 32, r, lane); continue; } r -= I_IN;
            if (r < I_OUT) { transpose_item<0>(w_out + (size_t)l * DM * DM, DM, DM, (bf16*)(ws + WS_WOUT + l * WOUT_BYTES), scr, DM / 32, r, lane); continue; } r -= I_OUT;
            if (r < I_GU) { transpose_item<2>(w_gate_up + (size_t)l * DM * NGU, DM, NGU, (bf16*)(ws + WS_WGU + l * WGU_BYTES), scr, NGU / 32, r, lane); continue; } r -= I_GU;
            transpose_item<0>(w_down + (size_t)l * DFF * DM, DFF, DM, (bf16*)(ws + WS_WDN + l * WDN_BYTES), scr, DM / 32, r, lane);
        }
        if (REP_P0) __syncthreads();
    }
    SEAM(0);

    for (int l = 0; l < DEPTH; ++l) {
        const int pb = 1 + 10 * l;
        const float* mod_l = MOD + (size_t)l * 2 * 6144;
        const float* xcur = (l == 0) ? x_in : xres;
        for (int rep = 0; rep <= REP_NORM; ++rep)
        if (PHEN(0) && IN(pb + 0)) { PH_IDS(); norm_rows(xcur, norm1_g + l * DM, mod_l, 0, 1024, XN, gw, NGW, lane); }
        SEAM(pb + 0);
        for (int rep = 0; rep <= REP_GIN; ++rep)
        if (PHEN(1) && IN(pb + 1)) { PH_IDS();
            pg8::Gemm g{XN, (const bf16*)(ws + WS_WIN + l * WIN_BYTES), MROWS, NIN, DM}; pg8::StaticOrder S; S.init(MROWS, NIN, G, bx);
            pg8::EpiProj E{PROJ, GATES, PLD};
            pg8::gemm_phase<pg8::EpiProj, pg8::StaticOrder, true, true>(lds, g, S, E, tid);
        }
        SEAM(pb + 1);
        if (PHEN(2) && IN(pb + 2)) { PH_IDS();
            for (int u = vcu; u < 524; u += G) {
                if (u < 12) post_foxcum_unit(u, GATES, FOXCUM, fox_f_bias + l * 6, ldsf, tid, wave, lane);
                else if (u < 268) post_qknorm_unit(u - 12, PROJ, KMEAN, fox_q_g + l * 64, fox_k_g + l * 64, moba_q_g + l * 64, moba_k_g + l * 64, ldsf, tid, wave, lane);
                else { const int which = (u - 268) & 1; post_conv_unit((u - 268) >> 1, which, PROJ, which ? KC : QC, ml_conv_w + l * 4 * 512, ml_conv_b + l * 512, tid); }
            }
            for (int rep = 0; rep < REP_CONV; ++rep) for (int u = vcu; u < 256; u += G) { const int which = u & 1; post_conv_unit(u >> 1, which, PROJ, which ? KC : QC, ml_conv_w + l * 4 * 512, ml_conv_b + l * 512, tid); }
            for (int rep = 0; rep < REP_FCUM; ++rep) for (int u = vcu; u < 12; u += G) post_foxcum_unit(u, GATES, FOXCUM, fox_f_bias + l * 6, ldsf, tid, wave, lane);
        }
        SEAM(pb + 2);
        MlP MP{PROJ, QC, KC, GATES, (float*)(ws + WS_U), (float*)(ws + WS_NU), (float*)(ws + WS_BEND), (float*)(ws + WS_MLOC), (bf16*)(ws + WS_CS), (float*)(ws + WS_NS), (float*)(ws + WS_MS), Y,
               ml_i_bias + l * 4, ml_f_bias + l * 4, ml_h_g + l * 256};
        if (PHEN(3) && IN(pb + 3)) { PH_IDS();
            unsigned* LCNT = (unsigned*)(ctl + CW_LCNT + l * 768); unsigned short* LIST = MOBA_MFMA ? (unsigned short*)(ws + WS_LIST) : nullptr;
#if ML_MFMA
            for (int u = vcu; u < 768; u += G) moba_gate_unit(u, PROJ, KMEAN, SEL, LCNT, (unsigned*)(ws + WS_CTAB), LIST, ldsf, tid);
            for (int u = gw; u < 2048; u += NGW) mlstm_m1_mfma(u, MP, lds, wave, lane);
            __syncthreads();
#else
            for (int u = vcu; u < 768 + 2048; u += G) {
                if (u < 768) moba_gate_unit(u, PROJ, KMEAN, SEL, LCNT, (unsigned*)(ws + WS_CTAB), LIST, ldsf, tid);
                else mlstm_m1(u - 768, MP, ldsf, tid, wave, lane);
            }
#endif
            for (int rep = 0; rep < REP_GATE; ++rep) for (int u = vcu; u < 768; u += G) moba_gate_unit(u, PROJ, KMEAN, SEL, LCNT, (unsigned*)(ws + WS_CTAB), nullptr, ldsf, tid);
            for (int rep = 0; rep < REP_GATE2; ++rep) for (int u = vcu; u < 768; u += G) moba_gate_unit(u, PROJ, KMEAN, SEL, LCNT + 4096, (unsigned*)(ws + WS_OPART + 32 * MiB), (unsigned short*)(ws + WS_OPART), ldsf, tid);
            for (int rep = 0; rep < REP_M1; ++rep) for (int u = vcu; u < 2048; u += G) mlstm_m1(u, MP, ldsf, tid, wave, lane);
#if FOX_MFMA
            { const float gq = wave_max(fabsf(fox_q_g[l * 64 + lane])), gk = wave_max(fabsf(fox_k_g[l * 64 + lane])); const float B2 = 8.f * LOG2E * gq * gk * 1.01f;
              for (int rep = 0; rep <= REP_FOX; ++rep)
              for (int u = vcu; u < 768; u += G) fox_unit(u >> 6, 63 - (u & 63), PROJ, FOXCUM, Y, B2, lds, tid, wave, lane); }
#else
            fox_naive(PROJ, FOXCUM, Y, gw, NGW, lane);
#endif
        }
        SEAM(pb + 3);
        for (int rep = 0; rep <= REP_MIXB; ++rep)
        if (PHEN(4) && IN(pb + 4)) { PH_IDS();
            for (int u = vcu; u < 64; u += G) mlstm_m2(u, MP, tid);
#if MOBA_MFMA
            { const float gq = wave_max(fabsf(moba_q_g[l * 64 + lane])), gk = wave_max(fabsf(moba_k_g[l * 64 + lane])); const float B2 = 8.f * LOG2E * gq * gk * 1.01f;
              LAS int* pre = (LAS int*)(lds + ATT_TAB + 1024);
              const unsigned* lcnt = (const unsigned*)(ctl + CW_LCNT + l * 768);
              if (wave == 0) { int carry = 0;
                  for (int r = 0; r < 12; ++r) { const int p = r * 64 + lane; int x = (int)((lcnt[p] + 255u) >> 8);
#pragma unroll
                      for (int o = 1; o < 64; o <<= 1) { const int n = __shfl_up(x, o); if (lane >= o) x += n; }
                      pre[p + 1] = carry + x; carry += __shfl(x, 63); }
                  if (lane == 0) pre[0] = 0; }
              __syncthreads();
              const int S = pre[768];
              const unsigned short* LIST = (const unsigned short*)(ws + WS_LIST); bf16* OPART = (bf16*)(ws + WS_OPART); float* LPART = (float*)(ws + WS_LPART);
              for (int u = vcu; u < S + 768; u += G) {
                  if (u < S) { int lo2 = 0, hi2 = 768; while (hi2 - lo2 > 1) { const int mid = (lo2 + hi2) >> 1; if (pre[mid] <= u) lo2 = mid; else hi2 = mid; }
                      moba_unit(lo2 >> 6, lo2 & 63, u - pre[lo2], false, (int)lcnt[lo2], PROJ, LIST, (const unsigned*)(ws + WS_CTAB), OPART, LPART, Y, B2, lds, tid, wave, lane); }
                  else { const int p = u - S; moba_unit(p >> 6, 63 - (p & 63), 0, true, 256, PROJ, LIST, (const unsigned*)(ws + WS_CTAB), OPART, LPART, Y, B2, lds, tid, wave, lane); }
              } }
#else
            moba_naive(PROJ, SEL, Y, gw, NGW, lane);
#endif
        }
        SEAM(pb + 4);
        if (PHEN(5) && IN(pb + 5)) { PH_IDS();
#if ML_MFMA
            for (int rep = 0; rep <= REP_M3; ++rep)
            for (int u = vcu; u < 512; u += G) mlstm_m3_mfma(u, MP, lds, tid, wave, lane);
#else
            for (int rep = 0; rep <= REP_M3; ++rep)
            for (int u = vcu; u < 2048; u += G) mlstm_m3(u, MP, ldsf, tid, wave, lane);
#endif
#if MOBA_MFMA
            for (int rep = 0; rep < REP_COMB; ++rep) moba_combine(SEL, (const bf16*)(ws + WS_OPART), (const float*)(ws + WS_LPART), Y, (bf16*)(ws + WS_U), 384, 0, vcu * NTHREADS + tid, G * NTHREADS);
            moba_combine(SEL, (const bf16*)(ws + WS_OPART), (const float*)(ws + WS_LPART), Y, Y, 1024, Y_MOBA, vcu * NTHREADS + tid, G * NTHREADS);
#endif
        }
        SEAM(pb + 5);
        if (PHEN(6) && IN(pb + 6)) { PH_IDS();
            pg8::Gemm g{Y, (const bf16*)(ws + WS_WOUT + l * WOUT_BYTES), MROWS, DM, DM}; pg8::StaticOrder S; S.init(MROWS, DM, G, bx);
            for (int rep = REP_GOUT; rep >= 0; --rep) {
            pg8::EpiRes E{xcur, rep ? (float*)(ws + 336 * MiB) : xres, mod_l + 2048, 6144, SEQ};
            pg8::gemm_phase<pg8::EpiRes, pg8::StaticOrder, true, true>(lds, g, S, E, tid); }
        }
        SEAM(pb + 6);
        if (PHEN(7) && IN(pb + 7)) { PH_IDS(); norm_rows(xres, norm2_g + l * DM, mod_l, 3072, 4096, XN, gw, NGW, lane); }
        SEAM(pb + 7);
        for (int rep = 0; rep <= REP_GGU; ++rep)
        if (PHEN(8) && IN(pb + 8)) { PH_IDS();
            pg8::Gemm g{XN, (const bf16*)(ws + WS_WGU + l * WGU_BYTES), MROWS, NGU, DM}; pg8::StaticOrder S; S.init(MROWS, NGU, G, bx);
            pg8::EpiSwiglu E{HB, DFF};
            pg8::gemm_phase<pg8::EpiSwiglu, pg8::StaticOrder, true, true>(lds, g, S, E, tid);
        }
        SEAM(pb + 8);
        if (PHEN(9) && IN(pb + 9)) { PH_IDS();
            pg8::Gemm g{HB, (const bf16*)(ws + WS_WDN + l * WDN_BYTES), MROWS, DM, DFF}; pg8::StaticOrder S; S.init(MROWS, DM, G, bx);
            for (int rep = REP_GDN; rep >= 0; --rep) {
            pg8::EpiRes E{xres, rep ? (float*)(ws + 336 * MiB) : xres, mod_l + 5120, 6144, SEQ};
            pg8::gemm_phase<pg8::EpiRes, pg8::StaticOrder, true, true>(lds, g, S, E, tid); }
        }
        SEAM(pb + 9);
    }
#undef IN
#undef SEAM
}

extern "C" void kernel_launch(void* const* d_in, const int* in_sizes, int n_in, void* d_out, int out_size, void* d_ws, size_t ws_size, hipStream_t stream) {
    static int grid = 0;
    if (grid == 0) {
        if (n_in != 20 || in_sizes[0] != MROWS * DM || out_size != MROWS * DM || ws_size < WS_END) {
            fprintf(stderr, "kernel_launch: unexpected shapes: n_in %d in0 %d out %d ws %zu (need >= %zu)\n", n_in, n_in > 0 ? in_sizes[0] : -1, out_size, ws_size, (size_t)WS_END); grid = -1; return; }
        int dev = 0, cus = 0, per_cu = 0;
        if (hipGetDevice(&dev) != hipSuccess || hipDeviceGetAttribute(&cus, hipDeviceAttributeMultiprocessorCount, dev) != hipSuccess) { grid = -1; return; }
        if (hipFuncSetAttribute((const void*)fwd, hipFuncAttributeMaxDynamicSharedMemorySize, LDS_BYTES) != hipSuccess) { fprintf(stderr, "kernel_launch: hipFuncSetAttribute failed\n"); grid = -1; return; }
        if (hipOccupancyMaxActiveBlocksPerMultiprocessor(&per_cu, (const void*)fwd, NTHREADS, LDS_BYTES) != hipSuccess || per_cu < 1)
            fprintf(stderr, "kernel_launch: note: occupancy query reports %d workgroups per CU\n", per_cu);
        (void)hipGetLastError();
        grid = cus;
    }
    if (grid < 0) return;
    if (hipMemsetAsync((char*)d_ws + WS_CTL, 0, CTL_ZERO_BYTES, stream) != hipSuccess) return;
    Args a{};
    for (int i = 0; i < 20; ++i) a.in[i] = (const float*)d_in[i];
    a.out = (float*)d_out; a.ws = (unsigned char*)d_ws;
    if (N_LAUNCH_MODE == 1) { a.ph_lo = 0; a.ph_hi = NPHASE; hipLaunchKernelGGL(fwd, dim3(grid), dim3(NTHREADS), LDS_BYTES, stream, a); }
    else for (int p = 0; p < NPHASE; ++p) { a.ph_lo = p; a.ph_hi = p + 1; hipLaunchKernelGGL(fwd, dim3(grid), dim3(NTHREADS), LDS_BYTES, stream, a); }
}
```

```cpp
#include <hip/hip_runtime.h>
#include <cstdio>
#include <cstdint>

constexpr int DM = 1024, NBATCH = 2, SEQ = 16384, MROWS = NBATCH * SEQ, DEPTH = 2;
constexpr int HD = 64, FOXH = 6, MLH = 4, MOBH = 6;
constexpr int DFF = 2816, INC = 3342, NIN = 3584, PLD = 3328;
constexpr int NGU = 2 * DFF;
constexpr int C_FQ = 0, C_FK = 384, C_FV = 768, C_BQ = 1152, C_BK = 1536, C_BV = 1920, C_MQ = 2304, C_MK = 2560, C_MV = 2816, C_MO = 3072, C_G = 3328;
constexpr int Y_FOX = 0, Y_ML = 384, Y_MOBA = 640;
constexpr int MOBA_BS = 256, NBLK = SEQ / MOBA_BS;
constexpr int MLC = 64, NCHUNK = SEQ / MLC;
constexpr float LOG2E = 1.4426950408889634f;
constexpr float QSCALE = 0.125f * LOG2E;
constexpr float EPS = 1e-6f;

#define GAS __attribute__((address_space(1)))
#define LAS __attribute__((address_space(3)))
typedef unsigned short bf16;
typedef unsigned v4u __attribute__((ext_vector_type(4)));
typedef unsigned v2u __attribute__((ext_vector_type(2)));
typedef float f32x4 __attribute__((ext_vector_type(4)));
typedef short bf16x8 __attribute__((ext_vector_type(8)));
typedef float f32x16 __attribute__((ext_vector_type(16)));
typedef GAS unsigned gu32;
#define RLX_AGENT __ATOMIC_RELAXED, __HIP_MEMORY_SCOPE_AGENT
__device__ __forceinline__ unsigned f2bf(float f) { unsigned u = __builtin_bit_cast(unsigned, f); return (u + 0x7fffu + ((u >> 16) & 1u)) >> 16; }
__device__ __forceinline__ unsigned pk2(float lo, float hi) { return f2bf(lo) | (f2bf(hi) << 16); }
__device__ __forceinline__ float bf2f(unsigned short u) { return __builtin_bit_cast(float, (unsigned)u << 16); }
__device__ __forceinline__ float bflo(unsigned w) { return __builtin_bit_cast(float, w << 16); }
__device__ __forceinline__ float bfhi(unsigned w) { return __builtin_bit_cast(float, w & 0xffff0000u); }
#ifndef OLD_SHFL
#define OLD_SHFL 0
#endif
#ifndef OLD_SWZ
#define OLD_SWZ OLD_SHFL
#endif
#ifndef OLD_HALF
#define OLD_HALF OLD_SHFL
#endif
#ifndef OLD_SHF
#define OLD_SHF OLD_SHFL
#endif
#ifndef OLD_SUP
#define OLD_SUP OLD_SHFL
#endif
#if OLD_SWZ
#define SWZ_X(v, o) __shfl_xor((float)(v), (o))
#else
#define SWZ_X(v, o) __builtin_bit_cast(float, __builtin_amdgcn_ds_swizzle(__builtin_bit_cast(int, (float)(v)), ((o) << 10) | 0x1f))
#endif
__device__ __forceinline__ float half_sum(float v, int lane) { return v + __builtin_bit_cast(float, __builtin_amdgcn_ds_bpermute((lane ^ 32) << 2, __builtin_bit_cast(int, v))); }
#if OLD_SHF
__device__ __forceinline__ float shf(float v, int src) { return __shfl(v, src); }
__device__ __forceinline__ int shfi(int v, int src) { return __shfl(v, src); }
#else
__device__ __forceinline__ float shf(float v, int src) { return __builtin_bit_cast(float, __builtin_amdgcn_ds_bpermute(src << 2, __builtin_bit_cast(int, v))); }
__device__ __forceinline__ int shfi(int v, int src) { return __builtin_amdgcn_ds_bpermute(src << 2, v); }
#endif
#if OLD_SUP
__device__ __forceinline__ float sup(float v, int o, int lane) { return __shfl_up(v, o); }
__device__ __forceinline__ int supi(int v, int o, int lane) { return __shfl_up(v, o); }
#else
__device__ __forceinline__ float sup(float v, int o, int lane) { return shf(v, lane >= o ? lane - o : lane); }
__device__ __forceinline__ int supi(int v, int o, int lane) { return shfi(v, lane >= o ? lane - o : lane); }
#endif
__device__ __forceinline__ float wave_sum(float v) { v += SWZ_X(v, 1); v += SWZ_X(v, 2); v += SWZ_X(v, 4); v += SWZ_X(v, 8); v += SWZ_X(v, 16);
    return __builtin_bit_cast(float, __builtin_amdgcn_readlane(__builtin_bit_cast(int, v), 0)) + __builtin_bit_cast(float, __builtin_amdgcn_readlane(__builtin_bit_cast(int, v), 32)); }
__device__ __forceinline__ float wave_max(float v) { v = fmaxf(v, SWZ_X(v, 1)); v = fmaxf(v, SWZ_X(v, 2)); v = fmaxf(v, SWZ_X(v, 4)); v = fmaxf(v, SWZ_X(v, 8)); v = fmaxf(v, SWZ_X(v, 16));
    return fmaxf(__builtin_bit_cast(float, __builtin_amdgcn_readlane(__builtin_bit_cast(int, v), 0)), __builtin_bit_cast(float, __builtin_amdgcn_readlane(__builtin_bit_cast(int, v), 32))); }
__device__ __forceinline__ float log_sigmoid_f(float x) { return fminf(x, 0.f) - log1pf(expf(-fabsf(x))); }
__device__ __forceinline__ float sigmoid_f(float x) { return 1.f / (1.f + expf(-x)); }

constexpr size_t MiB = 1u << 20;
constexpr size_t WS_CTL = 0, CTL_ZERO_BYTES = 1 * MiB;
constexpr size_t WS_MOD = 1 * MiB;
constexpr size_t WS_KMEAN = WS_MOD + 128 * 1024;
constexpr size_t WS_MLS = WS_KMEAN + 512 * 1024;
constexpr size_t WS_BEND = WS_MLS, WS_MLOC = WS_MLS + 8192, WS_MS = WS_MLS + 16384, WS_NU = WS_MLS + 32768, WS_NS = WS_NU + 2048 * 64 * 4;
constexpr size_t WS_CTAB = 3 * MiB;
constexpr size_t WS_PTAB = WS_CTAB + 256 * 1024;
static_assert(WS_NS + 2048 * 64 * 4 <= WS_CTAB && WS_CTAB + 12 * 64 * 64 * 4 <= WS_PTAB && WS_PTAB + 256 <= 4 * MiB, "small region");
constexpr size_t WS_WIN = 4 * MiB, WIN_BYTES = (size_t)NIN * DM * 2;
constexpr size_t WS_WOUT = WS_WIN + 2 * WIN_BYTES, WOUT_BYTES = (size_t)DM * DM * 2;
constexpr size_t WS_WGU = WS_WOUT + 2 * WOUT_BYTES, WGU_BYTES = (size_t)NGU * DM * 2;
constexpr size_t WS_WDN = WS_WGU + 2 * WGU_BYTES, WDN_BYTES = (size_t)DM * DFF * 2;
static_assert(WS_WDN + 2 * WDN_BYTES <= 64 * MiB, "weights");
constexpr size_t WS_XN = 64 * MiB;
constexpr size_t WS_U = 64 * MiB;
constexpr size_t WS_CS = 96 * MiB;
constexpr size_t WS_LIST = 112 * MiB;
constexpr size_t WS_PROJ = 128 * MiB;
constexpr size_t WS_H = 128 * MiB;
constexpr size_t WS_Y = 336 * MiB;
constexpr size_t WS_QC = 400 * MiB, WS_KC = 416 * MiB;
constexpr size_t WS_OPART = 432 * MiB;
constexpr size_t WS_LPART = 504 * MiB;
constexpr size_t WS_GATES = 507 * MiB;
constexpr size_t WS_FOXCUM = 509 * MiB;
constexpr size_t WS_SEL = 510 * MiB;
constexpr size_t WS_END = 512 * MiB;
static_assert(WS_PROJ + (size_t)MROWS * PLD * 2 <= WS_Y && WS_SEL + (size_t)MROWS * 6 * 4 <= WS_END, "ws map");
constexpr int CW_BAR = 4096;
constexpr int CW_QUEUE = 16384;
constexpr int CW_LCNT = 32768;

constexpr int RING_BYTES = 131072, LDSCTL_OFF = RING_BYTES, MISC_OFF = LDSCTL_OFF + 320, LDS_BYTES = 147456;
constexpr int NWAVES = 8, NTHREADS = 512;
namespace pg8 {
#define PG8_LAS __attribute__((address_space(3)))
typedef unsigned short bf16_t;
typedef short bf16x8 __attribute__((ext_vector_type(8)));
typedef float f32x4 __attribute__((ext_vector_type(4)));
typedef unsigned u32x4 __attribute__((ext_vector_type(4)));
constexpr int BM = 256, BK = 64, HALF = 128, HTB = HALF * BK * 2  , STAGE_BYTES = 8 * HTB, NXCD = 8, WGM = 8;

__host__ __device__ __forceinline__ int lds_byte(int r, int c) { const int st = (r >> 4) * 2 + (c >> 5), rr = r & 15, cc = c & 31, ob = rr * 64 + cc * 2; return st * 1024 + (ob ^ (((ob >> 9) & 1) << 5)); }
__host__ __device__ __forceinline__ void stage_rc(int b, int& R, int& C) { const int st = b / 1024, sb = b % 1024, swz = sb ^ (((sb >> 9) & 1) << 5); R = (st >> 1) * 16 + swz / 64; C = (st & 1) * 32 + (swz % 64) / 2; }
__host__ __device__ __forceinline__ int perm32(int rho) { const int n = rho >> 4, i = rho & 15; return 8 * (i >> 2) + 4 * n + (i & 3); }

struct Unit { int pm, pn; };
struct Gemm { const bf16_t* A; const bf16_t* Bt; int M, N, K; };

struct StaticOrder {
    int nM, nN, nwg, G, c;
    __host__ __device__ void init(int M, int N, int G_, int c_) { nM = M / BM; nN = N / BM; nwg = nM * nN; G = G_; c = c_; }
    __host__ __device__ bool next(int i, Unit& u) const {
        const long L = (long)i * G + c; if (L >= nwg) return false;
        int wgid = (int)L; { const int q = nwg / NXCD, r = nwg % NXCD, xcd = wgid % NXCD, off = wgid / NXCD; wgid = (xcd < r ? xcd * (q + 1) : r * (q + 1) + (xcd - r) * q) + off; }
        const int nig = WGM * nN, gid = wgid / nig, fm = gid * WGM, gsz = (nM - fm) < WGM ? (nM - fm) : WGM;
        u.pm = fm + ((wgid % nig) % gsz); u.pn = (wgid % nig) / gsz; return true;
    }
    __device__ __forceinline__ void a_ready(const Unit&) const {}
    __device__ __forceinline__ void done(const Unit&) const {}
};

__device__ __forceinline__ unsigned cvt_pk_bf16(float lo, float hi) { unsigned r; asm volatile("v_cvt_pk_bf16_f32 %0, %1, %2" : "=v"(r) : "v"(lo), "v"(hi)); return r; }
typedef float f32x2 __attribute__((ext_vector_type(2)));
struct EpiProj {
    static constexpr bool PERM = true, AFTER_DRAIN = false;
    bf16_t* P; float* G; int pld;
    __device__ __forceinline__ void operator()(const f32x4 (&acc)[2][2][4][2], const Unit& u, int wr, int wc, int fr, int fq) const {
        const int row0 = u.pm * BM + wr * 64 + fr;
        if (u.pn < 13) {
            const int col0 = u.pn * BM + wc * 32 + 8 * fq;
#pragma unroll
            for (int ai = 0; ai < 2; ++ai)
#pragma unroll
                for (int m = 0; m < 4; ++m) { bf16_t* rowp = P + (size_t)(row0 + ai * HALF + m * 16) * pld + col0;
#pragma unroll
                    for (int bj = 0; bj < 2; ++bj) { const f32x4 v0 = acc[ai][bj][m][0], v1 = acc[ai][bj][m][1];
                        u32x4 w; w.x = cvt_pk_bf16(v0[0], v0[1]); w.y = cvt_pk_bf16(v0[2], v0[3]); w.z = cvt_pk_bf16(v1[0], v1[1]); w.w = cvt_pk_bf16(v1[2], v1[3]);
                        *(u32x4*)(rowp + bj * HALF) = w; } }
        } else {
            if (wc == 0 && fq < 2) {
#pragma unroll
                for (int ai = 0; ai < 2; ++ai)
#pragma unroll
                    for (int m = 0; m < 4; ++m) { float* gp = G + (size_t)(row0 + ai * HALF + m * 16) * 16 + 8 * fq;
                        *(f32x4*)(gp) = acc[ai][0][m][0]; *(f32x4*)(gp + 4) = acc[ai][0][m][1]; }
            }
        }
    }
};
struct EpiRes {
    static constexpr bool PERM = false, AFTER_DRAIN = false;
    const float* base; float* out; const float* gate; int gate_bstride; int rows_per_batch;
    __device__ __forceinline__ void operator()(const f32x4 (&acc)[2][2][4][2], const Unit& u, int wr, int wc, int fr, int fq) const {
        const int row0 = u.pm * BM + wr * 64 + fr, col0 = u.pn * BM + wc * 32 + 4 * fq;
        const float* gb = gate + (size_t)((u.pm * BM) / rows_per_batch) * gate_bstride;
        f32x4 gv[2][2];
#pragma unroll
        for (int bj = 0; bj < 2; ++bj)
#pragma unroll
            for (int n = 0; n < 2; ++n) gv[bj][n] = *(const f32x4*)(gb + col0 + bj * HALF + n * 16);
#pragma unroll
        for (int ai = 0; ai < 2; ++ai)
#pragma unroll
            for (int m = 0; m < 4; ++m) { const size_t off = (size_t)(row0 + ai * HALF + m * 16) * 1024 + col0;
#pragma unroll
                for (int bj = 0; bj < 2; ++bj)
#pragma unroll
                    for (int n = 0; n < 2; ++n) { const f32x4 bs = *(const f32x4*)(base + off + bj * HALF + n * 16);
                        *(f32x4*)(out + off + bj * HALF + n * 16) = bs + gv[bj][n] * acc[ai][bj][m][n]; } }
    }
};
struct EpiSwiglu {
    static constexpr bool PERM = true, AFTER_DRAIN = false;
    bf16_t* Hh; int ldh;
    __device__ __forceinline__ void operator()(const f32x4 (&acc)[2][2][4][2], const Unit& u, int wr, int wc, int fr, int fq) const {
        const int row0 = u.pm * BM + wr * 64 + fr, col0 = u.pn * HALF + wc * 32 + 8 * fq;
#pragma unroll
        for (int ai = 0; ai < 2; ++ai)
#pragma unroll
            for (int m = 0; m < 4; ++m) { bf16_t* rowp = Hh + (size_t)(row0 + ai * HALF + m * 16) * ldh + col0;
                float hv[8];
#pragma unroll
                for (int n = 0; n < 2; ++n)
#pragma unroll
                    for (int i = 0; i < 4; ++i) { const float g = acc[ai][0][m][n][i], up = acc[ai][1][m][n][i];
                        const float e = __builtin_amdgcn_exp2f(-g * 1.4426950408889634f);
                        hv[n * 4 + i] = g * __builtin_amdgcn_rcpf(1.0f + e) * up; }
                u32x4 w; w.x = cvt_pk_bf16(hv[0], hv[1]); w.y = cvt_pk_bf16(hv[2], hv[3]); w.z = cvt_pk_bf16(hv[4], hv[5]); w.w = cvt_pk_bf16(hv[6], hv[7]);
                *(u32x4*)(rowp) = w; }
    }
};
template <class Epi, class Sched, bool ALIGN_EPI = false, bool SP2 = false>
__device__ __forceinline__ void gemm_phase(PG8_LAS unsigned char* lds, const Gemm g, const Sched& S, const Epi& E, const int tid_in) {
    const int tid = tid_in, wid = __builtin_amdgcn_readfirstlane(tid >> 6), lane = tid & 63, wr = wid >> 2, wc = wid & 3, fr = lane & 15, fq = lane >> 4;
    const int K = g.K, nt = K / BK;
    unsigned voffA[2], voffB[2];
#pragma unroll
    for (int i = 0; i < 2; ++i) { int R, C; stage_rc(tid * 16 + i * 8192, R, C); const int Rb = Epi::PERM ? ((R & ~31) + perm32(R & 31)) : R;
        voffA[i] = (unsigned)(R * K + C) * 2u; voffB[i] = (unsigned)(Rb * K + C) * 2u; }
    const size_t kstep = (size_t)(BK * 2);
    const size_t hstep = (size_t)HALF * K * 2;
    const size_t tstep = 2 * hstep;
    const unsigned ldsw = (unsigned)wid * 1024u;
    const int aoff = lds_byte(wr * 64 + fr, fq * 8), boff = lds_byte(wc * 32 + fr, fq * 8);
#define PG8_SA(b, h) (((b) * 2 + (h)) * HTB)
#define PG8_SB(b, h) ((4 + (b) * 2 + (h)) * HTB)
#define PG8_STAGE(bufoff, gbase, voff) do { _Pragma("unroll") for (int _i = 0; _i < 2; ++_i) \
        __builtin_amdgcn_global_load_lds((const unsigned*)((const char*)(gbase) + (voff)[_i]), (PG8_LAS unsigned*)(lds + (bufoff) + ldsw + _i * 8192), 16, 0, 0); } while (0)
#define PG8_LDA(dst, b, h) do { _Pragma("unroll") for (int m = 0; m < 4; ++m) _Pragma("unroll") for (int k = 0; k < 2; ++k) dst[m][k] = *(const PG8_LAS bf16x8*)(lds + PG8_SA(b, h) + aoff + m * 2048 + k * 1024); } while (0)
#define PG8_LDB(dst, b, h) do { _Pragma("unroll") for (int n = 0; n < 2; ++n) _Pragma("unroll") for (int k = 0; k < 2; ++k) dst[n][k] = *(const PG8_LAS bf16x8*)(lds + PG8_SB(b, h) + boff + n * 2048 + k * 1024); } while (0)
#define PG8_MMA(ai, bj, At, Bt) do { __builtin_amdgcn_s_setprio(1); _Pragma("unroll") for (int m = 0; m < 4; ++m) _Pragma("unroll") for (int n = 0; n < 2; ++n) _Pragma("unroll") for (int k = 0; k < 2; ++k) \
        acc[ai][bj][m][n] = __builtin_amdgcn_mfma_f32_16x16x32_bf16(Bt[n][k], At[m][k], acc[ai][bj][m][n], 0, 0, 0); __builtin_amdgcn_s_setprio(0); } while (0)
#define PG8_WAIT_V(n) asm volatile("s_waitcnt vmcnt(" #n ")" ::: "memory")
#define PG8_WAIT_L(n) asm volatile("s_waitcnt lgkmcnt(" #n ")" ::: "memory")
#define PG8_BAR __builtin_amdgcn_s_barrier()
#define PG8_SCHED __builtin_amdgcn_sched_barrier(0)
    Unit cur, nxt; int ui = 0;
    if (!S.next(0, cur)) return;
    f32x4 acc[2][2][4][2];
#pragma unroll
    for (int a = 0; a < 2; ++a)
#pragma unroll
        for (int b = 0; b < 2; ++b)
#pragma unroll
            for (int m = 0; m < 4; ++m)
#pragma unroll
                for (int n = 0; n < 2; ++n) acc[a][b][m][n] = (f32x4){0.f, 0.f, 0.f, 0.f};
    bf16x8 At[4][2], B0[2][2], B1[2][2];
    const char* cA = (const char*)g.A + (size_t)cur.pm * tstep; const char* cB = (const char*)g.Bt + (size_t)cur.pn * tstep;
    S.a_ready(cur);
    if constexpr (SP2) {
        PG8_STAGE(PG8_SB(0, 0), cB, voffB); PG8_STAGE(PG8_SB(0, 1), cB + hstep, voffB); PG8_STAGE(PG8_SA(0, 0), cA, voffA); PG8_STAGE(PG8_SA(0, 1), cA + hstep, voffA);
        if (wr == 1) PG8_BAR;
        PG8_WAIT_V(2); PG8_BAR;
        PG8_STAGE(PG8_SB(1, 0), cB + kstep, voffB); PG8_STAGE(PG8_SA(1, 0), cA + kstep, voffA); PG8_STAGE(PG8_SB(1, 1), cB + hstep + kstep, voffB);
        PG8_WAIT_V(6); PG8_BAR;
    } else {
        PG8_STAGE(PG8_SB(0, 0), cB, voffB); PG8_STAGE(PG8_SA(0, 0), cA, voffA); PG8_STAGE(PG8_SB(0, 1), cB + hstep, voffB); PG8_STAGE(PG8_SA(0, 1), cA + hstep, voffA);
        if (wr == 1) PG8_BAR;
        PG8_WAIT_V(4); PG8_BAR;
        PG8_STAGE(PG8_SB(1, 0), cB + kstep, voffB); PG8_STAGE(PG8_SA(1, 0), cA + kstep, voffA); PG8_STAGE(PG8_SB(1, 1), cB + hstep + kstep, voffB);
        PG8_WAIT_V(6); PG8_BAR;
    }
    for (;;) {
        const bool has_next = S.next(ui + 1, nxt);
        const char* nA = has_next ? (const char*)g.A + (size_t)nxt.pm * tstep : cA; const char* nB = has_next ? (const char*)g.Bt + (size_t)nxt.pn * tstep : cB;
        for (int t = 0; t < nt; t += 2) {
            const bool last = (t == nt - 2);
            const char* a1 = cA + (size_t)(t + 1) * kstep;
            const char* a2 = last ? nA : cA + (size_t)(t + 2) * kstep; const char* b2 = last ? nB : cB + (size_t)(t + 2) * kstep;
            const char* a3 = a2 + kstep; const char* b3 = b2 + kstep;
            if (last && has_next) S.a_ready(nxt);
            if constexpr (SP2) {
            PG8_LDB(B0, 0, 0); PG8_LDB(B1, 0, 1); PG8_SCHED; PG8_LDA(At, 0, 0); PG8_STAGE(PG8_SA(1, 1), a1 + hstep, voffA);
            PG8_WAIT_V(8); PG8_WAIT_L(0); PG8_BAR; PG8_MMA(0, 0, At, B0); PG8_MMA(0, 1, At, B1); PG8_BAR; PG8_SCHED;
            PG8_LDA(At, 0, 1); PG8_STAGE(PG8_SB(0, 0), b2, voffB); PG8_STAGE(PG8_SB(0, 1), b2 + hstep, voffB); PG8_STAGE(PG8_SA(0, 0), a2, voffA);
            PG8_WAIT_V(8); PG8_WAIT_L(0); PG8_BAR; PG8_MMA(1, 0, At, B0); PG8_MMA(1, 1, At, B1); PG8_BAR; PG8_SCHED;
            PG8_LDB(B0, 1, 0); PG8_LDB(B1, 1, 1); PG8_SCHED; PG8_LDA(At, 1, 0); PG8_STAGE(PG8_SA(0, 1), a2 + hstep, voffA);
            PG8_WAIT_V(8); PG8_WAIT_L(0); PG8_BAR; PG8_MMA(0, 0, At, B0); PG8_MMA(0, 1, At, B1); PG8_BAR; PG8_SCHED;
            PG8_LDA(At, 1, 1); PG8_STAGE(PG8_SB(1, 0), b3, voffB); PG8_STAGE(PG8_SB(1, 1), b3 + hstep, voffB); PG8_STAGE(PG8_SA(1, 0), a3, voffA);
            PG8_WAIT_V(8); PG8_WAIT_L(0); PG8_BAR; PG8_MMA(1, 0, At, B0); PG8_MMA(1, 1, At, B1); PG8_BAR; PG8_SCHED;
            } else {
            PG8_LDB(B0, 0, 0); PG8_SCHED; PG8_LDA(At, 0, 0); PG8_STAGE(PG8_SA(1, 1), a1 + hstep, voffA);
            PG8_WAIT_L(8); PG8_BAR; PG8_WAIT_L(0); PG8_MMA(0, 0, At, B0); PG8_BAR; PG8_SCHED;
            PG8_LDB(B1, 0, 1); PG8_STAGE(PG8_SB(0, 0), b2, voffB);
            PG8_BAR; PG8_WAIT_L(0); PG8_MMA(0, 1, At, B1); PG8_BAR;
            PG8_LDA(At, 0, 1); PG8_STAGE(PG8_SA(0, 0), a2, voffA);
            PG8_BAR; PG8_WAIT_L(0); PG8_MMA(1, 0, At, B0); PG8_BAR; PG8_SCHED;
            PG8_STAGE(PG8_SB(0, 1), b2 + hstep, voffB);
            PG8_WAIT_V(6); PG8_BAR; PG8_MMA(1, 1, At, B1); PG8_BAR;
            PG8_LDB(B0, 1, 0); PG8_SCHED; PG8_LDA(At, 1, 0); PG8_STAGE(PG8_SA(0, 1), a2 + hstep, voffA);
            PG8_WAIT_L(8); PG8_BAR; PG8_WAIT_L(0); PG8_MMA(0, 0, At, B0); PG8_BAR; PG8_SCHED;
            PG8_LDB(B1, 1, 1); PG8_STAGE(PG8_SB(1, 0), b3, voffB);
            PG8_BAR; PG8_WAIT_L(0); PG8_MMA(0, 1, At, B1); PG8_BAR;
            PG8_LDA(At, 1, 1); PG8_STAGE(PG8_SA(1, 0), a3, voffA);
            PG8_BAR; PG8_WAIT_L(0); PG8_MMA(1, 0, At, B0); PG8_BAR; PG8_SCHED;
            PG8_STAGE(PG8_SB(1, 1), b3 + hstep, voffB);
            PG8_WAIT_V(6); PG8_BAR; PG8_MMA(1, 1, At, B1); PG8_BAR;
            }
        }
        if constexpr (ALIGN_EPI) { if (wr == 0) PG8_BAR; }
        if constexpr (!Epi::AFTER_DRAIN) { E(acc, cur, wr, wc, fr, fq); S.done(cur); }
        if (!has_next) break;
#pragma unroll
        for (int a = 0; a < 2; ++a)
#pragma unroll
            for (int b = 0; b < 2; ++b)
#pragma unroll
                for (int m = 0; m < 4; ++m)
#pragma unroll
                    for (int n = 0; n < 2; ++n) acc[a][b][m][n] = (f32x4){0.f, 0.f, 0.f, 0.f};
        cur = nxt; cA = nA; cB = nB; ++ui;
        if constexpr (ALIGN_EPI) { if (wr == 1) PG8_BAR; }
    }
    PG8_WAIT_V(0);
    if constexpr (!ALIGN_EPI) { if (wr == 0) PG8_BAR; }
    PG8_BAR;
    if constexpr (Epi::AFTER_DRAIN) { E.fused(acc, cur, wr, wc, fr, fq, lds, wid, lane); S.done(cur); }
#undef PG8_SA
#undef PG8_SB
#undef PG8_STAGE
#undef PG8_LDA
#undef PG8_LDB
#undef PG8_MMA
#undef PG8_WAIT_V
#undef PG8_WAIT_L
#undef PG8_BAR
#undef PG8_SCHED
}
}
#define XB_TMO      128
#define XB_XCNT(j)  (256  + 64 * (j))
#define XB_XSUB(j)  (1280 + 64 * (j))
#define XB_XGEN(j)  (2304 + 64 * (j))
#define XB_TOP      3328
#define XB_TOPGEN   3392
#define XCD_BAR_WORDS 3456
#define XB_SPIN_CAP (1u << 18)

__device__ __forceinline__ unsigned xb_ld(unsigned* p)              { return __hip_atomic_load(p, __ATOMIC_RELAXED, __HIP_MEMORY_SCOPE_AGENT); }
__device__ __forceinline__ unsigned xb_add(unsigned* p, unsigned v) { return __hip_atomic_fetch_add(p, v, __ATOMIC_RELAXED, __HIP_MEMORY_SCOPE_AGENT); }
__device__ __forceinline__ unsigned xb_xcc_id() { return (unsigned)__builtin_amdgcn_s_getreg((3 << 11) | 20) & 0xFu; }
#define XB_SPIN(cond, bar) do { unsigned _sp = 0; while (cond) { __builtin_amdgcn_s_sleep(1); \
    if ((++_sp & 255u) == 0u) { if (xb_ld(&(bar)[XB_TMO])) break; if (_sp > XB_SPIN_CAP) { atomicAdd(&(bar)[XB_TMO], 1u); break; } } } } while (0)

struct XcdBarrier {
    unsigned* bar; unsigned x;
    volatile LAS unsigned* st;
};

__device__ __forceinline__ XcdBarrier xcd_barrier_post(unsigned* bar, volatile LAS unsigned* st) {
    XcdBarrier b; b.bar = bar; b.x = xb_xcc_id(); b.st = st;
    if (threadIdx.x == 0) (void)xb_add(&bar[XB_XCNT(b.x)], 1u);
    return b;
}
__device__ __forceinline__ void xcd_barrier_complete(unsigned* bar, unsigned x, unsigned& nloc, unsigned& nx) {
    const unsigned G = gridDim.x * gridDim.y * gridDim.z;
    unsigned sum, cnt, mine, sp = 0u;
    for (;;) {
        sum = 0u; cnt = 0u; mine = 0u;
#pragma unroll
        for (unsigned j = 0; j < 16; ++j) { const unsigned c = xb_ld(&bar[XB_XCNT(j)]); sum += c; cnt += (c > 0u) ? 1u : 0u; mine = (j == x) ? c : mine; }
        if (sum == G) break;
        __builtin_amdgcn_s_sleep(1);
        if ((++sp & 255u) == 0u) { if (xb_ld(&bar[XB_TMO])) break; if (sp > XB_SPIN_CAP) { atomicAdd(&bar[XB_TMO], 1u); break; } }
    }
    nloc = mine > 0u ? mine : 1u; nx = cnt > 0u ? cnt : 1u;
}

__device__ __forceinline__ void xcd_barrier(const XcdBarrier& b) {
    asm volatile("s_waitcnt vmcnt(0)" ::: "memory");
    __syncthreads();
    if (threadIdx.x == 0) {
        unsigned* bar = b.bar; asm volatile("" : "+s"(bar));
        const unsigned bx_ = xb_xcc_id();
        __builtin_amdgcn_s_waitcnt(0);
        unsigned nloc = b.st[0], nx = b.st[1];
        if (nloc == 0u) { xcd_barrier_complete(bar, bx_, nloc, nx); b.st[0] = nloc; b.st[1] = nx; }
        const unsigned old = xb_add(&bar[XB_XSUB(bx_)], 1u);
        const unsigned gen = old / nloc;
        if (old + 1u == (gen + 1u) * nloc) {
            __builtin_amdgcn_fence(__ATOMIC_RELEASE, "agent");
            asm volatile("s_waitcnt vmcnt(0)" ::: "memory");
            const unsigned og = xb_add(&bar[XB_TOP], 1u);
            const unsigned tg = og / nx;
            if (og + 1u == (tg + 1u) * nx) xb_add(&bar[XB_TOPGEN], 1u);
            else XB_SPIN(xb_ld(&bar[XB_TOPGEN]) == tg, bar);
            __builtin_amdgcn_fence(__ATOMIC_ACQUIRE, "agent");
            xb_add(&bar[XB_XGEN(bx_)], 1u);
            asm volatile("s_waitcnt vmcnt(0)" ::: "memory");
        } else {
            XB_SPIN(xb_ld(&bar[XB_XGEN(bx_)]) == gen, bar);
            __builtin_amdgcn_fence(__ATOMIC_ACQUIRE, "agent");
            asm volatile("s_waitcnt vmcnt(0)" ::: "memory");
        }
    }
    __syncthreads();
}
#define LDS_WAIT() asm volatile("s_waitcnt lgkmcnt(0)" ::: "memory")
__device__ __forceinline__ void unpack8(const v4u w, float* f) { f[0] = bflo(w.x); f[1] = bfhi(w.x); f[2] = bflo(w.y); f[3] = bfhi(w.y); f[4] = bflo(w.z); f[5] = bfhi(w.z); f[6] = bflo(w.w); f[7] = bfhi(w.w); }

__device__ __forceinline__ int win_src(int c) {
    if (c < 1152) return c;
    if (c < 2304) return c + 1038;
    if (c < 3072) return c - 1146;
    if (c < 3328) return c - 1138;
    if (c < 3334) return c - 3328 + 1152;
    if (c < 3338) return c - 3334 + 1926;
    if (c < 3342) return c - 3338 + 1930;
    return -1;
}
__device__ __forceinline__ int wgu_src(int r) { const int pn = r >> 8, w = r & 255; return (w < 128 ? 0 : DFF) + pn * 128 + (w & 127); }
template <int MODE> __device__ __forceinline__ int src_col(int r) { if (MODE == 1) return win_src(r); if (MODE == 2) return wgu_src(r); return r; }

template <int MODE> __device__ __forceinline__ void transpose_item(const float* W, int K, int ldw, bf16* WT, LAS float* scr, int nblk, int item, int lane) {
    const int kb = item / nblk, nb = item % nblk, k0 = 64 * kb, n0 = 32 * nb;
    const int sc = src_col<MODE>(n0 + (lane & 31));
#pragma unroll 8
    for (int i = 0; i < 32; ++i) { const int kk = 2 * i + (lane >> 5); scr[kk * 33 + (lane & 31)] = (sc >= 0) ? W[(size_t)(k0 + kk) * ldw + sc] : 0.f; }
    LDS_WAIT(); asm volatile("" ::: "memory");
    const int c = lane & 7;
#pragma unroll
    for (int j = 0; j < 4; ++j) { const int n = (lane >> 3) + 8 * j; const LAS float* s = scr + (8 * c) * 33 + n;
        v4u o; o.x = pk2(s[0 * 33], s[1 * 33]); o.y = pk2(s[2 * 33], s[3 * 33]); o.z = pk2(s[4 * 33], s[5 * 33]); o.w = pk2(s[6 * 33], s[7 * 33]);
        *(GAS v4u*)(WT + (size_t)(n0 + n) * K + k0 + 8 * c) = o; }
    LDS_WAIT(); asm volatile("" ::: "memory");
}

__device__ __forceinline__ void p0_mod_unit(int u, const float* cvec, const float* w_ada, const float* b_ada, float* mod, LAS float* lds, int tid, int wave, int lane) {
    LAS float* sc = lds; LAS float* red = lds + 2048;
    for (int i = tid; i < 2048; i += NTHREADS) { const float v = cvec[i]; sc[i] = v / (1.f + expf(-v)); }
    __syncthreads();
    const int l = u / 96, n = (u % 96) * 64 + lane;
    const float* wp = w_ada + ((size_t)l * 1024 + wave * 128) * 6144 + n;
    float a0 = 0.f, a1 = 0.f;
#pragma unroll 16
    for (int kk = 0; kk < 128; ++kk) { const float w = wp[(size_t)kk * 6144]; a0 += sc[wave * 128 + kk] * w; a1 += sc[1024 + wave * 128 + kk] * w; }
    red[(wave * 2 + 0) * 64 + lane] = a0; red[(wave * 2 + 1) * 64 + lane] = a1;
    __syncthreads();
    if (tid < 128) { const int b = tid >> 6; float s = 0.f;
#pragma unroll
        for (int w = 0; w < 8; ++w) s += red[(w * 2 + b) * 64 + lane];
        mod[((size_t)l * 2 + b) * 6144 + n] = s + b_ada[l * 6144 + n]; }
    __syncthreads();
}

__device__ __forceinline__ void norm_rows(const float* xsrc, const float* g, const float* mod_l, int sh_off, int sc_off, bf16* XN, int gw, int NGW, int lane) {
    for (int m = gw; m < MROWS; m += NGW) {
        const int b = m / SEQ; const float* mb = mod_l + (size_t)b * 6144;
        const GAS f32x4* xr = (const GAS f32x4*)(xsrc + (size_t)m * DM) + lane;
        f32x4 v[4]; float ss = 0.f;
#pragma unroll
        for (int j = 0; j < 4; ++j) { v[j] = xr[64 * j]; ss += (v[j].x * v[j].x + v[j].y * v[j].y) + (v[j].z * v[j].z + v[j].w * v[j].w); }
        const float rstd = 1.f / sqrtf(wave_sum(ss) * (1.f / DM) + EPS);
        GAS v2u* o8 = (GAS v2u*)(XN + (size_t)m * DM) + lane;
#pragma unroll
        for (int j = 0; j < 4; ++j) { const int col = 4 * lane + 256 * j;
            const f32x4 gg = *(const f32x4*)(g + col), sv = *(const f32x4*)(mb + sc_off + col), hv = *(const f32x4*)(mb + sh_off + col);
            const f32x4 o = v[j] * rstd * gg * (sv + 1.0f) + hv;
            v2u w; w.x = pk2(o.x, o.y); w.y = pk2(o.z, o.w); o8[64 * j] = w; }
    }
}

__device__ __forceinline__ void post_foxcum_unit(int bh, const float* GATESp, float* FOXCUMp, const float* fox_f_bias, LAS float* lds, int tid, int wave, int lane) {
    const int b = bh / 6, h = bh % 6; const float bias = fox_f_bias[h];
    float v[32];
#pragma unroll
    for (int r = 0; r < 32; ++r) { const int t = wave * 2048 + r * 64 + lane; v[r] = log_sigmoid_f(GATESp[((size_t)b * SEQ + t) * 16 + h] + bias) * LOG2E; }
    float carry = 0.f;
#pragma unroll
    for (int r = 0; r < 32; ++r) { float x = v[r];
#pragma unroll
        for (int o = 1; o < 64; o <<= 1) { const float n = sup(x, o, lane); if (lane >= o) x += n; }
        x += carry; v[r] = x; carry = shf(x, 63); }
    if (lane == 0) lds[wave] = carry;
    __syncthreads();
    float off = 0.f;
    for (int w = 0; w < wave; ++w) off += lds[w];
#pragma unroll
    for (int r = 0; r < 32; ++r) FOXCUMp[(size_t)bh * SEQ + wave * 2048 + r * 64 + lane] = v[r] + off;
    __syncthreads();
}
__device__ __forceinline__ void post_qknorm_unit(int u, bf16* PROJp, float* KMEANP, const float* gfq, const float* gfk, const float* gbq, const float* gbk, LAS float* lds, int tid, int wave, int lane) {
    const int blk = u >> 1, half = u & 1, sub = lane & 7;
    int colv[3]; float gv[3][8]; float qsv[3];
#pragma unroll
    for (int it = 0; it < 3; ++it) { const int hsel = it * 8 + (lane >> 3), grp = hsel / 6, hh = hsel % 6;
        colv[it] = (grp == 0 ? C_FQ : grp == 1 ? C_FK : grp == 2 ? C_BQ : C_BK) + hh * 64 + 8 * sub;
        const float* gp = (grp == 0 ? gfq : grp == 1 ? gfk : grp == 2 ? gbq : gbk) + 8 * sub;
#pragma unroll
        for (int i = 0; i < 8; ++i) gv[it][i] = gp[i];
        qsv[it] = (grp == 0 || grp == 2) ? QSCALE : 1.f; }
    float ka[8] = {0.f, 0.f, 0.f, 0.f, 0.f, 0.f, 0.f, 0.f};
    const size_t row0 = (size_t)blk * 256 + half * 128 + wave * 16;
#pragma unroll 2
    for (int r = 0; r < 16; ++r) {
#pragma unroll
        for (int it = 0; it < 3; ++it) {
            v4u* p = (v4u*)(PROJp + (row0 + r) * PLD + colv[it]);
            float f[8]; unpack8(*p, f);
            float ss = 0.f;
#pragma unroll
            for (int i = 0; i < 8; ++i) ss += f[i] * f[i];
            ss += SWZ_X(ss, 1); ss += SWZ_X(ss, 2); ss += SWZ_X(ss, 4);
            const float rr = 1.f / sqrtf(ss * (1.f / 64.f) + EPS);
#pragma unroll
            for (int i = 0; i < 8; ++i) f[i] = f[i] * rr * gv[it][i];
            if (it == 2) {
#pragma unroll
                for (int i = 0; i < 8; ++i) ka[i] += f[i]; }
            const float qs = qsv[it];
            v4u w; w.x = pk2(f[0] * qs, f[1] * qs); w.y = pk2(f[2] * qs, f[3] * qs); w.z = pk2(f[4] * qs, f[5] * qs); w.w = pk2(f[6] * qs, f[7] * qs);
            *p = w;
        }
    }
    if (lane >= 16) {
#pragma unroll
        for (int i = 0; i < 8; ++i) lds[wave * 384 + ((lane >> 3) - 2) * 64 + 8 * sub + i] = ka[i]; }
    __syncthreads();
    if (tid < 384) { float s = 0.f;
#pragma unroll
        for (int w = 0; w < 8; ++w) s += lds[w * 384 + tid];
        const int b = blk / NBLK, n = blk % NBLK, head = tid >> 6, dd = tid & 63;
        KMEANP[(size_t)half * (12 * NBLK * 64) + (((size_t)b * 6 + head) * NBLK + n) * 64 + dd] = s * (1.f / 256.f); }
    __syncthreads();
}
__device__ __forceinline__ void post_conv_unit(int blk, int which, const bf16* PROJp, bf16* dst, const float* conv_w, const float* conv_b, int tid) {
    const bf16* src = PROJp + (which ? C_MK : C_MQ); const float osc = which ? 0.125f : 1.f;
    const int c = 2 * (tid & 127), rq = tid >> 7, ch = which * 256 + c;
    float w0[4], w1[4];
#pragma unroll
    for (int i = 0; i < 4; ++i) { w0[i] = conv_w[i * 512 + ch]; w1[i] = conv_w[i * 512 + ch + 1]; }
    const float b0 = conv_b[ch], b1 = conv_b[ch + 1];
    const size_t r0 = (size_t)blk * 256 + rq * 64; const int tl = (int)(r0 % SEQ);
    float xa[3][2];
#pragma unroll
    for (int k = 0; k < 3; ++k) { const int back = 3 - k;
        if (tl - back >= 0) { const unsigned w = *(const unsigned*)(src + (r0 - back) * PLD + c); xa[k][0] = bflo(w); xa[k][1] = bfhi(w); } else { xa[k][0] = 0.f; xa[k][1] = 0.f; } }
#pragma unroll 4
    for (int r = 0; r < 64; ++r) {
        const unsigned w = *(const unsigned*)(src + (r0 + r) * PLD + c); const float x0 = bflo(w), x1 = bfhi(w);
        float y0 = b0 + w0[0] * xa[0][0] + w0[1] * xa[1][0] + w0[2] * xa[2][0] + w0[3] * x0;
        float y1 = b1 + w1[0] * xa[0][1] + w1[1] * xa[1][1] + w1[2] * xa[2][1] + w1[3] * x1;
        y0 = y0 / (1.f + expf(-y0)) * osc; y1 = y1 / (1.f + expf(-y1)) * osc;
        *(unsigned*)(dst + (r0 + r) * 256 + c) = pk2(y0, y1);
        xa[0][0] = xa[1][0]; xa[0][1] = xa[1][1]; xa[1][0] = xa[2][0]; xa[1][1] = xa[2][1]; xa[2][0] = x0; xa[2][1] = x1;
    }
}

struct MlP { const bf16* PROJ; const bf16* QC; const bf16* KC; const float* GATES; float* U; float* NU; float* BEND; float* MLOC; bf16* CS; float* NS; float* MS; bf16* Y;
             const float *ibias, *fbias, *hg; };
__device__ __forceinline__ void mlstm_m1(int ci, const MlP& P, LAS float* lds, int tid, int wave, int lane) {
    const int b = ci >> 10, h = (ci >> 8) & 3, c = ci & 255; const size_t row0 = (size_t)b * SEQ + c * 64;
    LAS float* Ks = lds; LAS float* Vs = lds + 4096; LAS float* ws = lds + 8192;
    { const int r = tid >> 3, cg = (tid & 7) * 8; float f[8];
      unpack8(*(const v4u*)(P.KC + (row0 + r) * 256 + h * 64 + cg), f);
#pragma unroll
      for (int i = 0; i < 8; ++i) Ks[r * 64 + cg + i] = f[i];
      unpack8(*(const v4u*)(P.PROJ + (row0 + r) * PLD + C_MV + h * 64 + cg), f);
#pragma unroll
      for (int i = 0; i < 8; ++i) Vs[r * 64 + cg + i] = f[i]; }
    if (wave == 0) {
        const size_t row = row0 + lane;
        const float fi = P.GATES[row * 16 + 6 + h] + P.ibias[h], ff = P.GATES[row * 16 + 10 + h] + P.fbias[h];
        float bc = log_sigmoid_f(ff);
#pragma unroll
        for (int o = 1; o < 64; o <<= 1) { const float n = sup(bc, o, lane); if (lane >= o) bc += n; }
        const float bend = shf(bc, 63);
        const float wl = bend - bc + fi; const float mloc = wave_max(wl);
        ws[lane] = expf(wl - mloc);
        if (lane == 0) { P.BEND[ci] = bend; P.MLOC[ci] = mloc; }
    }
    __syncthreads();
    { const int dv = tid >> 3, e0 = (tid & 7) * 8; float u[8] = {0.f, 0.f, 0.f, 0.f, 0.f, 0.f, 0.f, 0.f};
#pragma unroll 2
      for (int s = 0; s < 64; ++s) { const float vw = Vs[s * 64 + dv] * ws[s]; const f32x4 ka = *(const LAS f32x4*)(Ks + s * 64 + e0), kb = *(const LAS f32x4*)(Ks + s * 64 + e0 + 4);
          u[0] += vw * ka.x; u[1] += vw * ka.y; u[2] += vw * ka.z; u[3] += vw * ka.w; u[4] += vw * kb.x; u[5] += vw * kb.y; u[6] += vw * kb.z; u[7] += vw * kb.w; }
      float* up = P.U + (size_t)ci * 4096 + dv * 64 + e0;
      *(f32x4*)up = (f32x4){u[0], u[1], u[2], u[3]}; *(f32x4*)(up + 4) = (f32x4){u[4], u[5], u[6], u[7]}; }
    if (tid < 64) { float nu = 0.f; for (int s = 0; s < 64; ++s) nu += ws[s] * Ks[s * 64 + tid]; P.NU[(size_t)ci * 64 + tid] = nu; }
    __syncthreads();
}
__device__ __forceinline__ void mlstm_m2(int u, const MlP& P, int tid) {
    const int bh = u >> 3, eg = u & 7, elem = eg * 512 + tid, base = bh * 256;
    const bool donorm = (eg == 0 && tid < 64), doms = (eg == 0 && tid == 0);
    float C = 0.f, m = 0.f, nst = 0.f;
    for (int c0 = 0; c0 < 256; c0 += 8) {
        float uv[8], be[8], ml[8], nv[8];
#pragma unroll
        for (int i = 0; i < 8; ++i) { const int ci = base + c0 + i; uv[i] = P.U[(size_t)ci * 4096 + elem]; be[i] = P.BEND[ci]; ml[i] = P.MLOC[ci]; nv[i] = donorm ? P.NU[(size_t)ci * 64 + tid] : 0.f; }
#pragma unroll
        for (int i = 0; i < 8; ++i) { const int ci = base + c0 + i;
            P.CS[(size_t)ci * 4096 + elem] = (bf16)f2bf(C);
            if (donorm) P.NS[(size_t)ci * 64 + tid] = nst;
            if (doms) P.MS[ci] = m;
            const float mn = fmaxf(be[i] + m, ml[i]); const float dec = expf(be[i] + m - mn), wu = expf(ml[i] - mn);
            C = dec * C + wu * uv[i]; nst = dec * nst + wu * nv[i]; m = mn; }
    }
}
__device__ __forceinline__ void mlstm_m3(int ci, const MlP& P, LAS float* lds, int tid, int wave, int lane) {
    constexpr int LP = 68;
    const int b = ci >> 10, h = (ci >> 8) & 3, c = ci & 255; const size_t row0 = (size_t)b * SEQ + c * 64;
    LAS float* Qs = lds; LAS float* Ks = Qs + 64 * LP; LAS float* Cs = Ks + 64 * LP; LAS float* Sm = Cs + 64 * LP; LAS float* Vs = Sm + 64 * LP;
    LAS float* av = Vs + 4096; LAS float* gv = av + 64; LAS float* bcv = gv + 64; LAS float* nsv = bcv + 64;
    const float ms = P.MS[ci];
    { const int r = tid >> 3, cg = (tid & 7) * 8; float f[8];
      unpack8(*(const v4u*)(P.QC + (row0 + r) * 256 + h * 64 + cg), f);
#pragma unroll
      for (int i = 0; i < 8; ++i) Qs[r * LP + cg + i] = f[i];
      unpack8(*(const v4u*)(P.KC + (row0 + r) * 256 + h * 64 + cg), f);
#pragma unroll
      for (int i = 0; i < 8; ++i) Ks[r * LP + cg + i] = f[i];
      unpack8(*(const v4u*)(P.PROJ + (row0 + r) * PLD + C_MV + h * 64 + cg), f);
#pragma unroll
      for (int i = 0; i < 8; ++i) Vs[r * 64 + cg + i] = f[i];
      unpack8(*(const v4u*)(P.CS + (size_t)ci * 4096 + r * 64 + cg), f);
#pragma unroll
      for (int i = 0; i < 8; ++i) Cs[r * LP + cg + i] = f[i]; }
    if (wave == 0) {
        const size_t row = row0 + lane;
        const float fi = P.GATES[row * 16 + 6 + h] + P.ibias[h], ff = P.GATES[row * 16 + 10 + h] + P.fbias[h];
        float bc = log_sigmoid_f(ff);
#pragma unroll
        for (int o = 1; o < 64; o <<= 1) { const float n = sup(bc, o, lane); if (lane >= o) bc += n; }
        const float a = fi - bc; float pm = a;
#pragma unroll
        for (int o = 1; o < 64; o <<= 1) { const float n = sup(pm, o, lane); if (lane >= o) pm = fmaxf(pm, n); }
        av[lane] = a; gv[lane] = fmaxf(ms, pm); bcv[lane] = bc; nsv[lane] = P.NS[(size_t)ci * 64 + lane];
    }
    __syncthreads();
    const int j = tid >> 3, part = tid & 7, s0 = part * 8;
    const float gj = gv[j];
    { float sacc[8] = {0.f, 0.f, 0.f, 0.f, 0.f, 0.f, 0.f, 0.f};
#pragma unroll 1
      for (int e = 0; e < 64; e += 4) { const f32x4 q4 = *(const LAS f32x4*)(Qs + j * LP + e);
#pragma unroll
          for (int i = 0; i < 8; ++i) { const f32x4 k4 = *(const LAS f32x4*)(Ks + (s0 + i) * LP + e); sacc[i] += (q4.x * k4.x + q4.y * k4.y) + (q4.z * k4.z + q4.w * k4.w); } }
#pragma unroll
      for (int i = 0; i < 8; ++i) { const int s = s0 + i; Sm[j * LP + s] = (s <= j) ? sacc[i] * expf(av[s] - gj) : 0.f; } }
    __syncthreads();
    { const int dv0 = part * 8; float t1[8] = {0.f, 0.f, 0.f, 0.f, 0.f, 0.f, 0.f, 0.f}, t2[8] = {0.f, 0.f, 0.f, 0.f, 0.f, 0.f, 0.f, 0.f};
#pragma unroll 1
      for (int e = 0; e < 64; e += 4) { const f32x4 q4 = *(const LAS f32x4*)(Qs + j * LP + e);
#pragma unroll
          for (int i = 0; i < 8; ++i) { const f32x4 c4 = *(const LAS f32x4*)(Cs + (dv0 + i) * LP + e); t1[i] += (q4.x * c4.x + q4.y * c4.y) + (q4.z * c4.z + q4.w * c4.w); } }
#pragma unroll 2
      for (int s = 0; s < 64; ++s) { const float sm = Sm[j * LP + s]; const f32x4 va = *(const LAS f32x4*)(Vs + s * 64 + dv0), vb = *(const LAS f32x4*)(Vs + s * 64 + dv0 + 4);
          t2[0] += sm * va.x; t2[1] += sm * va.y; t2[2] += sm * va.z; t2[3] += sm * va.w; t2[4] += sm * vb.x; t2[5] += sm * vb.y; t2[6] += sm * vb.z; t2[7] += sm * vb.w; }
      float dn = 0.f, ssum = 0.f;
#pragma unroll
      for (int i = 0; i < 8; ++i) { dn += nsv[s0 + i] * Qs[j * LP + s0 + i]; ssum += Sm[j * LP + s0 + i]; }
      { dn += SWZ_X(dn, 1); ssum += SWZ_X(ssum, 1); dn += SWZ_X(dn, 2); ssum += SWZ_X(ssum, 2); dn += SWZ_X(dn, 4); ssum += SWZ_X(ssum, 4); }
      const float inter = expf(ms - gj), mj = bcv[j] + gj;
      const float den = inter * dn + ssum, dd = fmaxf(fabsf(den), expf(-mj)), rd = 1.f / dd;
      float hv[8], ss = 0.f;
#pragma unroll
      for (int i = 0; i < 8; ++i) { hv[i] = (inter * t1[i] + t2[i]) * rd; ss += hv[i] * hv[i]; }
      { ss += SWZ_X(ss, 1); ss += SWZ_X(ss, 2); ss += SWZ_X(ss, 4); }
      const float rr = 1.f / sqrtf(ss * (1.f / 64.f) + EPS);
      float mo[8]; unpack8(*(const v4u*)(P.PROJ + (row0 + j) * PLD + C_MO + h * 64 + dv0), mo);
      float y[8];
#pragma unroll
      for (int i = 0; i < 8; ++i) y[i] = hv[i] * rr * P.hg[h * 64 + dv0 + i] * sigmoid_f(mo[i]);
      v4u w; w.x = pk2(y[0], y[1]); w.y = pk2(y[2], y[3]); w.z = pk2(y[4], y[5]); w.w = pk2(y[6], y[7]);
      *(v4u*)(P.Y + (row0 + j) * 1024 + Y_ML + h * 64 + dv0) = w; }
    __syncthreads();
}

__device__ __forceinline__ size_t moba_list_off(int bh, int n);
__device__ __forceinline__ void moba_gate_unit(int u, const bf16* PROJ, const float* KMEAN, unsigned* SEL, unsigned* LCNT, unsigned* CTAB, unsigned short* LIST, float B2, float thresh2, LAS float* lds, int tid) {
    const int bh = u >> 6, qb = 63 - (u & 63), b = bh / 6, h = bh % 6;
    LAS float* km = lds; LAS float* cand = lds + 4096; LAS unsigned* cntl = (LAS unsigned*)(lds + 4096 + 1536);
    if (tid < 64) cntl[tid] = 0u;
    for (int i = tid; i < qb * 16; i += NTHREADS) *(LAS f32x4*)(km + i * 4) = *(const f32x4*)(KMEAN + (size_t)bh * NBLK * 64 + i * 4) + *(const f32x4*)(KMEAN + (size_t)(12 * NBLK * 64) + (size_t)bh * NBLK * 64 + i * 4);
    __syncthreads();
    const int query = tid & 255, half = tid >> 8; const size_t row = (size_t)b * SEQ + qb * 256 + query;
    float q[64];
#pragma unroll
    for (int i = 0; i < 8; ++i) unpack8(*(const v4u*)(PROJ + row * PLD + C_BQ + h * 64 + i * 8), q + i * 8);
    float v0 = -INFINITY, v1 = -INFINITY, v2 = -INFINITY; int i0 = 255, i1 = 255, i2 = 255;
    const int nlo = half * 32, nhi = (qb < nlo + 32) ? qb : nlo + 32;
    for (int n = nlo; n < nhi; ++n) { float g = 0.f;
#pragma unroll
        for (int d = 0; d < 64; d += 4) { const f32x4 k4 = *(const LAS f32x4*)(km + n * 64 + d); g += (q[d] * k4.x + q[d + 1] * k4.y) + (q[d + 2] * k4.z + q[d + 3] * k4.w); }
        if (g > v0) { v2 = v1; i2 = i1; v1 = v0; i1 = i0; v0 = g; i0 = n; } else if (g > v1) { v2 = v1; i2 = i1; v1 = g; i1 = n; } else if (g > v2) { v2 = g; i2 = n; } }
    if (half == 1) { cand[query * 6 + 0] = v0; cand[query * 6 + 1] = v1; cand[query * 6 + 2] = v2;
        cand[query * 6 + 3] = __int_as_float(i0); cand[query * 6 + 4] = __int_as_float(i1); cand[query * 6 + 5] = __int_as_float(i2); }
    __syncthreads();
    if (half == 0) {
#pragma unroll
        for (int k = 0; k < 3; ++k) { const float g = cand[query * 6 + k]; const int n = __float_as_int(cand[query * 6 + 3 + k]);
            if (n != 255) { if (g > v0) { v2 = v1; i2 = i1; v1 = v0; i1 = i0; v0 = g; i0 = n; } else if (g > v1) { v2 = v1; i2 = i1; v1 = g; i1 = n; } else if (g > v2) { v2 = g; i2 = n; } } }
        { const float slope2 = exp2f(-8.f * (float)(h + 1) / 6.f) * LOG2E; const float lim = (2.f * B2 + thresh2) / slope2; const int t0 = qb * 256 + query - 255;
          if (i0 != 255 && (float)(t0 - i0 * 256) > lim) i0 = 255;
          if (i1 != 255 && (float)(t0 - i1 * 256) > lim) i1 = 255;
          if (i2 != 255 && (float)(t0 - i2 * 256) > lim) i2 = 255; }
        SEL[row * 6 + h] = (unsigned)i0 | ((unsigned)i1 << 8) | ((unsigned)i2 << 16);
        if (LIST) { const unsigned t = (unsigned)(qb * 256 + query);
            if (i0 != 255) { const unsigned pos = __hip_atomic_fetch_add(cntl + i0, 1u, __ATOMIC_RELAXED, __HIP_MEMORY_SCOPE_WORKGROUP); LIST[moba_list_off(bh, i0) + (size_t)(qb - i0 - 1) * 256 + pos] = (unsigned short)(t | (0u << 14)); }
            if (i1 != 255) { const unsigned pos = __hip_atomic_fetch_add(cntl + i1, 1u, __ATOMIC_RELAXED, __HIP_MEMORY_SCOPE_WORKGROUP); LIST[moba_list_off(bh, i1) + (size_t)(qb - i1 - 1) * 256 + pos] = (unsigned short)(t | (1u << 14)); }
            if (i2 != 255) { const unsigned pos = __hip_atomic_fetch_add(cntl + i2, 1u, __ATOMIC_RELAXED, __HIP_MEMORY_SCOPE_WORKGROUP); LIST[moba_list_off(bh, i2) + (size_t)(qb - i2 - 1) * 256 + pos] = (unsigned short)(t | (2u << 14)); } }
    }
    __syncthreads();
    if (LIST && tid < 64) { const unsigned c = cntl[tid]; CTAB[((size_t)bh * 64 + qb) * 64 + tid] = c; if (c) atomicAdd(LCNT + bh * 64 + tid, c); }
    __syncthreads();
}

__device__ __forceinline__ void fox_naive(const bf16* PROJ, const float* FOXCUM, bf16* Y, int gw, int NGW, int lane) {
    for (int idx = gw; idx < 12 * SEQ; idx += NGW) {
        const int t = SEQ - 1 - idx / 12, bh = idx % 12, b = bh / 6, h = bh % 6; const size_t rb = (size_t)b * SEQ;
        const float qv = bf2f(PROJ[(rb + t) * PLD + C_FQ + h * 64 + lane]); const float ct = FOXCUM[(size_t)bh * SEQ + t];
        float m = -INFINITY, l = 0.f, acc = 0.f;
#pragma unroll 4
        for (int j = 0; j <= t; ++j) {
            const float kv = bf2f(PROJ[(rb + j) * PLD + C_FK + h * 64 + lane]), vv = bf2f(PROJ[(rb + j) * PLD + C_FV + h * 64 + lane]);
            const float s = wave_sum(qv * kv) + (ct - FOXCUM[(size_t)bh * SEQ + j]);
            const float mn = fmaxf(m, s), sc = exp2f(m - mn), p = exp2f(s - mn);
            l = l * sc + p; acc = acc * sc + p * vv; m = mn; }
        Y[(rb + t) * 1024 + Y_FOX + h * 64 + lane] = (bf16)f2bf(acc / l);
    }
}
__device__ __forceinline__ void moba_naive(const bf16* PROJ, const unsigned* SEL, bf16* Y, int gw, int NGW, int lane) {
    for (int idx = gw; idx < 12 * SEQ; idx += NGW) {
        const int t = SEQ - 1 - idx / 12, bh = idx % 12, b = bh / 6, h = bh % 6; const size_t rb = (size_t)b * SEQ;
        const float slope2 = exp2f(-8.f * (float)(h + 1) / 6.f) * LOG2E;
        const float qv = bf2f(PROJ[(rb + t) * PLD + C_BQ + h * 64 + lane]);
        const unsigned sel = SEL[(rb + t) * 6 + h];
        float m = -INFINITY, l = 0.f, acc = 0.f;
        for (int slot = 0; slot < 4; ++slot) {
            int j0, j1;
            if (slot < 3) { const int n = (sel >> (8 * slot)) & 0xff; if (n == 255) continue; j0 = n * 256; j1 = j0 + 256; } else { j0 = (t >> 8) * 256; j1 = t + 1; }
#pragma unroll 4
            for (int j = j0; j < j1; ++j) {
                const float kv = bf2f(PROJ[(rb + j) * PLD + C_BK + h * 64 + lane]), vv = bf2f(PROJ[(rb + j) * PLD + C_BV + h * 64 + lane]);
                const float s = wave_sum(qv * kv) - slope2 * (float)(t - j);
                const float mn = fmaxf(m, s), sc = exp2f(m - mn), p = exp2f(s - mn);
                l = l * sc + p; acc = acc * sc + p * vv; m = mn; }
        }
        Y[(rb + t) * 1024 + Y_MOBA + h * 64 + lane] = (bf16)f2bf(acc / l);
    }
}
typedef short v4i16_t __attribute__((ext_vector_type(4)));
typedef short s16x4 __attribute__((ext_vector_type(4)));
constexpr int ATT_K0 = 0, ATT_V0 = 32768, ATT_TAB = 132096;
#ifndef THRESH_NAT
#define THRESH_NAT 30.f
#endif
constexpr float THRESH2 = THRESH_NAT * LOG2E;

__device__ __forceinline__ int crow(int r, int hi) { return (r & 3) + 8 * (r >> 2) + 4 * hi; }
__device__ __forceinline__ s16x4 vtr(LAS const unsigned char* p) { return __builtin_bit_cast(s16x4, __builtin_amdgcn_ds_read_tr16_b64_v4i16((LAS v4i16_t*)p)); }
typedef float f32x2_t __attribute__((ext_vector_type(2))); typedef __bf16 bf16x2_t __attribute__((ext_vector_type(2)));
#ifndef CVT_ASM
#define CVT_ASM 0
#endif
#if CVT_ASM
__device__ __forceinline__ unsigned cvtpk(float lo, float hi) { unsigned r; asm volatile("v_cvt_pk_bf16_f32 %0, %1, %2\n\ts_nop 1" : "=v"(r) : "v"(lo), "v"(hi)); return r; }
#else
__device__ __forceinline__ unsigned cvtpk(float lo, float hi) { const f32x2_t v = {lo, hi}; const bf16x2_t b = __builtin_convertvector(v, bf16x2_t); return __builtin_bit_cast(unsigned, b); }
#endif

__device__ __forceinline__ void load_group(const bf16* Kg, const bf16* Vg, LAS unsigned char* kv, int tid) {
#pragma unroll
    for (int i = 0; i < 4; ++i) { const int idx = tid + NTHREADS * i, row = idx >> 3, ch = idx & 7;
        const v4u k = *(const v4u*)(Kg + (size_t)row * PLD + ch * 8), v = *(const v4u*)(Vg + (size_t)row * PLD + ch * 8);
        *(LAS v4u*)(kv + ATT_K0 + row * 128 + ((ch ^ ((row >> 1) & 7)) << 4)) = k;
        *(LAS v4u*)(kv + ATT_V0 + row * 128 + ((ch * 16) ^ (((row >> 1) & 1) << 6))) = v; }
}

template <bool FOX>
__device__ __forceinline__ void attn_subtile(LAS const unsigned char* kv, LAS const float* colt, int j0, const bf16x8 (&qf)[4], float rowterm, float slope2, bool mask, int qrel,
                                             f32x16 (&o)[2], float& l, int lane) {
    const int r32 = lane & 31, hh = lane >> 5;
    f32x16 acc;
    if (FOX) {
#pragma unroll
        for (int g = 0; g < 4; ++g) { const f32x4 c = *(LAS const f32x4*)(colt + j0 + 8 * g + 4 * hh); acc[4 * g + 0] = rowterm + c.x; acc[4 * g + 1] = rowterm + c.y; acc[4 * g + 2] = rowterm + c.z; acc[4 * g + 3] = rowterm + c.w; }
    } else {
#pragma unroll
        for (int r = 0; r < 16; ++r) acc[r] = rowterm + slope2 * (float)(j0 + crow(r, hh));
    }
    if (mask) {
#pragma unroll
        for (int r = 0; r < 16; ++r) if (j0 + crow(r, hh) > qrel) acc[r] = -INFINITY;
    }
    { const int row = j0 + r32; LAS const unsigned char* kr = kv + ATT_K0 + row * 128; const int sw = (row >> 1) & 7;
#pragma unroll
      for (int s = 0; s < 4; ++s) { const bf16x8 kf = *(LAS const bf16x8*)(kr + (((2 * s + hh) ^ sw) << 4)); acc = __builtin_amdgcn_mfma_f32_32x32x16_bf16(kf, qf[s], acc, 0, 0, 0); } }
    float ls = 0.f;
#pragma unroll
    for (int r = 0; r < 16; ++r) { acc[r] = __builtin_amdgcn_exp2f(acc[r]); ls += acc[r]; }
    l += ls;
    bf16x8 pa[2];
#pragma unroll
    for (int s = 0; s < 2; ++s) { v4u w; w.x = cvtpk(acc[8 * s + 0], acc[8 * s + 1]); w.y = cvtpk(acc[8 * s + 2], acc[8 * s + 3]); w.z = cvtpk(acc[8 * s + 4], acc[8 * s + 5]); w.w = cvtpk(acc[8 * s + 6], acc[8 * s + 7]); pa[s] = __builtin_bit_cast(bf16x8, w); }
    { const int i = lane & 15, c = (lane >> 4) & 1;
#pragma unroll
      for (int db = 0; db < 2; ++db)
#pragma unroll
          for (int s = 0; s < 2; ++s) { const int rowv = j0 + 16 * s + 4 * hh + (i >> 2); const int colb = (32 * db + 16 * c + 4 * (i & 3)) * 2;
              LAS const unsigned char* vp = kv + ATT_V0 + rowv * 128 + (colb ^ (((rowv >> 1) & 1) << 6));
              const s16x4 lo = vtr(vp), hi = vtr(vp + 8 * 128);
              const bf16x8 vf = (bf16x8){lo[0], lo[1], lo[2], lo[3], hi[0], hi[1], hi[2], hi[3]};
              o[db] = __builtin_amdgcn_mfma_f32_32x32x16_bf16(pa[s], vf, o[db], 0, 0, 0); } }
}
__device__ __forceinline__ float rfl(float x) { return __builtin_bit_cast(float, __builtin_amdgcn_readfirstlane(__builtin_bit_cast(int, x))); }

__device__ __forceinline__ void fox_unit(int bh, int qb, const bf16* PROJ, const float* FOXCUM, bf16* Y, float B2, LAS unsigned char* lds, int tid, int wave, int lane) {
    const int b = bh / 6, h = bh % 6; const size_t rb = (size_t)b * SEQ; const int r32 = lane & 31, hh = lane >> 5;
    const int q0w = qb * 256 + wave * 32, qpos = q0w + r32;
    const float* cum = FOXCUM + (size_t)bh * SEQ;
    bf16x8 qf[4];
#pragma unroll
    for (int s = 0; s < 4; ++s) qf[s] = *(const bf16x8*)(PROJ + (rb + qpos) * PLD + C_FQ + h * 64 + 16 * s + 8 * hh);
    const float cq = cum[qpos];
    const float cq_first = rfl(cum[q0w]), cq_blk = rfl(cum[qb * 256]);
    const float rowterm = cq - B2, lim = -THRESH2 - 2.f * B2;
    f32x16 o[2]; float l = 0.f;
#pragma unroll
    for (int r = 0; r < 16; ++r) { o[0][r] = 0.f; o[1][r] = 0.f; }
    LAS float* coltA = (LAS float*)(lds + ATT_TAB); LAS float* coltB = coltA + 256;
    LAS unsigned char* kvA = lds; LAS unsigned char* kvB = lds + 65536;
#ifndef FOX_2G
#define FOX_2G 1
#endif
    const bool haveB = FOX_2G && (qb > 0) && !(cq_blk - rfl(cum[qb * 256 - 1]) < lim);
    load_group(PROJ + (rb + (size_t)qb * 256) * PLD + C_FK + h * 64, PROJ + (rb + (size_t)qb * 256) * PLD + C_FV + h * 64, kvA, tid);
    if (tid < 256) coltA[tid] = -cum[qb * 256 + tid];
    if (haveB) { load_group(PROJ + (rb + (size_t)(qb - 1) * 256) * PLD + C_FK + h * 64, PROJ + (rb + (size_t)(qb - 1) * 256) * PLD + C_FV + h * 64, kvB, tid);
        if (tid < 256) coltB[tid] = -cum[(qb - 1) * 256 + tid]; }
    __syncthreads();
#pragma unroll 1
    for (int st = wave; st >= 0; --st) {
        const int j0 = 32 * st;
        if (cq_first + rfl(coltA[j0 + 31]) < lim) break;
        attn_subtile<true>(kvA, coltA, j0, qf, rowterm, 0.f, st == wave, wave * 32 + r32, o, l, lane);
    }
    if (haveB) {
#pragma unroll 1
        for (int st = 7; st >= 0; --st) {
            const int j0 = 32 * st;
            if (cq_first + rfl(coltB[j0 + 31]) < lim) break;
            attn_subtile<true>(kvB, coltB, j0, qf, rowterm, 0.f, false, 0, o, l, lane);
        }
    }
    __syncthreads();
    {
        for (int g = haveB ? qb - 2 : qb - 1; g >= 0; --g) {
            if (cq_blk - rfl(cum[g * 256 + 255]) < lim) break;
            load_group(PROJ + (rb + (size_t)g * 256) * PLD + C_FK + h * 64, PROJ + (rb + (size_t)g * 256) * PLD + C_FV + h * 64, kvA, tid);
            if (tid < 256) coltA[tid] = -cum[g * 256 + tid];
            __syncthreads();
            {
#pragma unroll 1
                for (int st = 7; st >= 0; --st) {
                    const int j0 = 32 * st;
                    if (cq_first + rfl(coltA[j0 + 31]) < lim) break;
                    attn_subtile<true>(kvA, coltA, j0, qf, rowterm, 0.f, false, 0, o, l, lane);
                }
            }
            __syncthreads();
        }
    }
    l = half_sum(l, lane);
    bf16* yp = Y + (rb + (size_t)q0w) * 1024 + Y_FOX + h * 64 + r32;
#pragma unroll
    for (int r = 0; r < 16; ++r) { const int q = crow(r, hh); const float rl = 1.f / shf(l, q);
        yp[(size_t)q * 1024] = (bf16)f2bf(o[0][r] * rl); yp[(size_t)q * 1024 + 32] = (bf16)f2bf(o[1][r] * rl); }
}

__device__ __forceinline__ void fox_unit_old(int bh, int qb, const bf16* PROJ, const float* FOXCUM, bf16* Y, float B2, LAS unsigned char* lds, int tid, int wave, int lane) {
    const int b = bh / 6, h = bh % 6; const size_t rb = (size_t)b * SEQ; const int r32 = lane & 31, hh = lane >> 5;
    const int q0w = qb * 256 + wave * 32, qpos = q0w + r32;
    const float* cum = FOXCUM + (size_t)bh * SEQ;
    bf16x8 qf[4];
#pragma unroll
    for (int s = 0; s < 4; ++s) qf[s] = *(const bf16x8*)(PROJ + (rb + qpos) * PLD + C_FQ + h * 64 + 16 * s + 8 * hh);
    const float cq = cum[qpos];
    const float cq_first = rfl(cum[q0w]);
    const float cq_blk = rfl(cum[qb * 256]);
    const float rowterm = cq - B2;
    f32x16 o[2]; float l = 0.f;
#pragma unroll
    for (int r = 0; r < 16; ++r) { o[0][r] = 0.f; o[1][r] = 0.f; }
    LAS float* colt = (LAS float*)(lds + ATT_TAB);
    for (int g = qb; g >= 0; --g) {
        if (g < qb) { const float cl = rfl(cum[g * 256 + 255]); if (2.f * B2 + cq_blk - cl < -THRESH2) break; }
        load_group(PROJ + (rb + (size_t)g * 256) * PLD + C_FK + h * 64, PROJ + (rb + (size_t)g * 256) * PLD + C_FV + h * 64, lds, tid);
        if (tid < 256) colt[tid] = -cum[g * 256 + tid];
        __syncthreads();
        const int stmax = (g == qb) ? wave : 7;
        for (int st = stmax; st >= 0; --st) {
            const int j0 = 32 * st;
            { const float cl = rfl(colt[j0 + 31]); if (2.f * B2 + cq_first + cl < -THRESH2) break; }
            attn_subtile<true>(lds, colt, j0, qf, rowterm, 0.f, (g == qb) && (st == wave), wave * 32 + r32, o, l, lane);
        }
        __syncthreads();
    }
    l = half_sum(l, lane);
    bf16* yp = Y + (rb + (size_t)q0w) * 1024 + Y_FOX + h * 64 + r32;
#pragma unroll
    for (int r = 0; r < 16; ++r) { const int q = crow(r, hh); const float rl = 1.f / shf(l, q);
        yp[(size_t)q * 1024] = (bf16)f2bf(o[0][r] * rl); yp[(size_t)q * 1024 + 32] = (bf16)f2bf(o[1][r] * rl); }
}

__device__ __forceinline__ size_t moba_list_off(int bh, int n) { return (size_t)bh * 516096 + 256 * (size_t)(63 * n - (n * (n - 1)) / 2); }
__device__ __forceinline__ void moba_store(const f32x16 (&o)[2], float l, int qpos, int slot, bool valid, size_t rb, int h, bf16* OPART, float* LPART, bf16* Y, int lane) {
    const int r32 = lane & 31, hh = lane >> 5;
#pragma unroll
    for (int r = 0; r < 16; ++r) { const int src = crow(r, hh);
        const int qp = shfi(qpos, src), sl = shfi(slot, src); const int ok = shfi((int)valid, src);
        if (ok) { bf16* op = (sl == 3) ? (Y + (rb + qp) * 1024 + Y_MOBA + h * 64) : (OPART + ((size_t)sl * MROWS + rb + qp) * 384 + h * 64);
            op[r32] = (bf16)f2bf(o[0][r]); op[32 + r32] = (bf16)f2bf(o[1][r]); } }
    if (valid && hh == 0) LPART[((size_t)slot * MROWS + rb + qpos) * 6 + h] = l;
}
__device__ __forceinline__ void moba_sel_unit(int bh, int n, int chunk, int cnt, const bf16* PROJ, const unsigned short* LIST, const unsigned* CTAB, bf16* OPART, float* LPART, bf16* Y, float B2,
                                              LAS unsigned char* lds, int tid, int wave, int lane) {
    const int b = bh / 6, h = bh % 6; const size_t rb = (size_t)b * SEQ; const int r32 = lane & 31, hh = lane >> 5;
    const float slope2 = exp2f(-8.f * (float)(h + 1) / 6.f) * LOG2E;
    load_group(PROJ + (rb + (size_t)n * 256) * PLD + C_BK + h * 64, PROJ + (rb + (size_t)n * 256) * PLD + C_BV + h * 64, lds, tid);
    __syncthreads();
    const int nvalid = cnt - chunk * 256 < 256 ? cnt - chunk * 256 : 256;
    if (wave * 32 < nvalid) {
        bool valid = true; int li = wave * 32 + r32; if (li >= nvalid) { li = nvalid - 1; valid = false; }
        const int p = chunk * 256 + li;
        const int cv = (lane > n) ? (int)CTAB[((size_t)bh * 64 + lane) * 64 + n] : 0; int inc = cv;
#pragma unroll
        for (int o2 = 1; o2 < 64; o2 <<= 1) { const int t2 = supi(inc, o2, lane); if (lane >= o2) inc += t2; }
        int qseg = 0;
#pragma unroll
        for (int stp = 32; stp >= 1; stp >>= 1) { const int v = shfi(inc, qseg + stp - 1); if (v <= p) qseg += stp; }
        const int idx = p - (shfi(inc, qseg) - shfi(cv, qseg));
        const unsigned e = LIST[moba_list_off(bh, n) + (size_t)(qseg - n - 1) * 256 + idx]; const int qpos = e & 0x3fff, slot = e >> 14;
        bf16x8 qf[4];
#pragma unroll
        for (int s = 0; s < 4; ++s) qf[s] = *(const bf16x8*)(PROJ + (rb + qpos) * PLD + C_BQ + h * 64 + 16 * s + 8 * hh);
        const int qrel = qpos - n * 256;
        const float rowterm = -slope2 * (float)qrel - B2;
        f32x16 o[2]; float l = 0.f;
#pragma unroll
        for (int r = 0; r < 16; ++r) { o[0][r] = 0.f; o[1][r] = 0.f; }
#pragma unroll 1
        for (int st = 0; st < 8; ++st) attn_subtile<false>(lds, nullptr, 32 * st, qf, rowterm, slope2, false, 0, o, l, lane);
        l = half_sum(l, lane);
        moba_store(o, l, qpos, slot, valid, rb, h, OPART, LPART, Y, lane);
    }
    __syncthreads();
}
__device__ __forceinline__ void moba_own_pair(int bh, int nA, int nB, const bf16* PROJ, bf16* OPART, float* LPART, bf16* Y, float B2, LAS unsigned char* lds, int tid, int wave, int lane) {
    const int b = bh / 6, h = bh % 6; const size_t rb = (size_t)b * SEQ; const int r32 = lane & 31, hh = lane >> 5;
    const float slope2 = exp2f(-8.f * (float)(h + 1) / 6.f) * LOG2E;
#ifndef OWN_SEQ
#define OWN_SEQ 0
#endif
#if !OWN_SEQ
    load_group(PROJ + (rb + (size_t)nA * 256) * PLD + C_BK + h * 64, PROJ + (rb + (size_t)nA * 256) * PLD + C_BV + h * 64, lds, tid);
    load_group(PROJ + (rb + (size_t)nB * 256) * PLD + C_BK + h * 64, PROJ + (rb + (size_t)nB * 256) * PLD + C_BV + h * 64, lds + 65536, tid);
    __syncthreads();
#endif
#pragma unroll 1
    for (int half = 0; half < 2; ++half) {
#if OWN_SEQ
        { const int n_ = half ? nB : nA; __syncthreads(); load_group(PROJ + (rb + (size_t)n_ * 256) * PLD + C_BK + h * 64, PROJ + (rb + (size_t)n_ * 256) * PLD + C_BV + h * 64, lds, tid); __syncthreads(); }
        const int n = half ? nB : nA, tile = (OWN_SEQ == 2 && half) ? 7 - wave : wave; LAS const unsigned char* kv = lds;
#else
        const int n = half ? nB : nA, tile = half ? 7 - wave : wave; LAS const unsigned char* kv = lds + half * 65536;
#endif
        const int qrel = tile * 32 + r32, qpos = n * 256 + qrel;
        bf16x8 qf[4];
#pragma unroll
        for (int s = 0; s < 4; ++s) qf[s] = *(const bf16x8*)(PROJ + (rb + qpos) * PLD + C_BQ + h * 64 + 16 * s + 8 * hh);
        const float rowterm = -slope2 * (float)qrel - B2;
        f32x16 o[2]; float l = 0.f;
#pragma unroll
        for (int r = 0; r < 16; ++r) { o[0][r] = 0.f; o[1][r] = 0.f; }
#pragma unroll 1
        for (int st = 0; st <= tile; ++st) attn_subtile<false>(kv, nullptr, 32 * st, qf, rowterm, slope2, st == tile, qrel, o, l, lane);
        l = half_sum(l, lane);
        moba_store(o, l, qpos, 3, true, rb, h, OPART, LPART, Y, lane);
    }
    __syncthreads();
}

__device__ __forceinline__ void moba_combine(const unsigned* SEL, const bf16* OPART, const float* LPART, bf16* Y, bf16* Yo, int opitch, int ocol, int gtid, int ngt) {
    for (size_t idx = gtid; idx < (size_t)MROWS * 48; idx += ngt) {
        const size_t row = idx / 48; const int hc = (int)(idx % 48), h = hc >> 3, c8 = (hc & 7) * 8;
        const unsigned sel = SEL[row * 6 + h];
        bf16* yp = Y + row * 1024 + Y_MOBA + h * 64 + c8;
        float acc[8]; unpack8(*(const v4u*)yp, acc);
        float l = LPART[((size_t)3 * MROWS + row) * 6 + h];
#pragma unroll
        for (int k = 0; k < 3; ++k) if (((sel >> (8 * k)) & 0xff) != 255) { float f[8]; unpack8(*(const v4u*)(OPART + ((size_t)k * MROWS + row) * 384 + h * 64 + c8), f);
#pragma unroll
            for (int i = 0; i < 8; ++i) acc[i] += f[i];
            l += LPART[((size_t)k * MROWS + row) * 6 + h]; }
        const float rl = 1.f / l;
        v4u w; w.x = pk2(acc[0] * rl, acc[1] * rl); w.y = pk2(acc[2] * rl, acc[3] * rl); w.z = pk2(acc[4] * rl, acc[5] * rl); w.w = pk2(acc[6] * rl, acc[7] * rl);
        *(v4u*)(Yo + row * opitch + ocol + h * 64 + c8) = w;
    }
}

__device__ __forceinline__ int vsw(int row, int colb) { return row * 128 + (colb ^ (((row >> 1) & 1) << 6)); }
__device__ __forceinline__ int ksw(int row, int ch) { return row * 128 + ((ch ^ ((row >> 1) & 7)) << 4); }
__device__ __forceinline__ void mlstm_m1_mfma(int ci, const MlP& P, LAS unsigned char* lds, int wave, int lane) {
    const int b = ci >> 10, h = (ci >> 8) & 3, c = ci & 255; const size_t row0 = (size_t)b * SEQ + c * 64;
    LAS unsigned char* Ki = lds + wave * 16384; LAS unsigned char* Vi = Ki + 8192;
    float wv;
    { const size_t row = row0 + lane;
      const float fi = P.GATES[row * 16 + 6 + h] + P.ibias[h], ff = P.GATES[row * 16 + 10 + h] + P.fbias[h];
      float bc = log_sigmoid_f(ff);
#pragma unroll
      for (int o = 1; o < 64; o <<= 1) { const float n = sup(bc, o, lane); if (lane >= o) bc += n; }
      const float bend = shf(bc, 63);
      const float wl = bend - bc + fi; const float mloc = wave_max(wl);
      wv = expf(wl - mloc);
      if (lane == 0) { P.BEND[ci] = bend; P.MLOC[ci] = mloc; } }
#pragma unroll
    for (int i = 0; i < 8; ++i) { const int idx = lane + 64 * i, r = idx >> 3, ch = idx & 7;
        const v4u kk = *(const v4u*)(P.KC + (row0 + r) * 256 + h * 64 + ch * 8);
        *(LAS v4u*)(Ki + vsw(r, ch * 16)) = kk;
        float f[8]; unpack8(*(const v4u*)(P.PROJ + (row0 + r) * PLD + C_MV + h * 64 + ch * 8), f);
        const float w = shf(wv, r);
        v4u o; o.x = pk2(f[0] * w, f[1] * w); o.y = pk2(f[2] * w, f[3] * w); o.z = pk2(f[4] * w, f[5] * w); o.w = pk2(f[6] * w, f[7] * w);
        *(LAS v4u*)(Vi + vsw(r, ch * 16)) = o; }
    LDS_WAIT(); asm volatile("" ::: "memory");
    { float nu = 0.f;
#pragma unroll 8
      for (int s = 0; s < 64; ++s) { const float ws = shf(wv, s); nu += ws * bf2f(*(LAS const unsigned short*)(Ki + vsw(s, 2 * lane))); }
      P.NU[(size_t)ci * 64 + lane] = nu; }
    f32x16 D[2][2];
#pragma unroll
    for (int a = 0; a < 2; ++a)
#pragma unroll
        for (int e = 0; e < 2; ++e)
#pragma unroll
            for (int r = 0; r < 16; ++r) D[a][e][r] = 0.f;
    const int i16 = lane & 15, cc = (lane >> 4) & 1, hh = lane >> 5, r32 = lane & 31;
#pragma unroll
    for (int ks = 0; ks < 4; ++ks) { const int rowv = 16 * ks + 4 * hh + (i16 >> 2);
        bf16x8 af[2], bfr[2];
#pragma unroll
        for (int blk = 0; blk < 2; ++blk) { const int colb = (32 * blk + 16 * cc + 4 * (i16 & 3)) * 2;
            { const s16x4 lo = vtr(Vi + vsw(rowv, colb)), hi = vtr(Vi + vsw(rowv, colb) + 1024); af[blk] = (bf16x8){lo[0], lo[1], lo[2], lo[3], hi[0], hi[1], hi[2], hi[3]}; }
            { const s16x4 lo = vtr(Ki + vsw(rowv, colb)), hi = vtr(Ki + vsw(rowv, colb) + 1024); bfr[blk] = (bf16x8){lo[0], lo[1], lo[2], lo[3], hi[0], hi[1], hi[2], hi[3]}; } }
#pragma unroll
        for (int a = 0; a < 2; ++a)
#pragma unroll
            for (int e = 0; e < 2; ++e) D[a][e] = __builtin_amdgcn_mfma_f32_32x32x16_bf16(af[a], bfr[e], D[a][e], 0, 0, 0); }
    float* up = P.U + (size_t)ci * 4096;
#pragma unroll
    for (int a = 0; a < 2; ++a)
#pragma unroll
        for (int e = 0; e < 2; ++e)
#pragma unroll
            for (int r = 0; r < 16; ++r) up[(32 * a + crow(r, hh)) * 64 + 32 * e + r32] = D[a][e][r];
    LDS_WAIT(); asm volatile("" ::: "memory");
}

__device__ __forceinline__ void mlstm_m3_mfma(int it, const MlP& P, LAS unsigned char* lds, int tid, int wave, int lane) {
    const int cs = wave >> 1, tile = wave & 1, ci = it * 4 + cs;
    const int b = ci >> 10, h = (ci >> 8) & 3, c = ci & 255; const size_t row0 = (size_t)b * SEQ + c * 64;
    LAS unsigned char* Ki = lds + cs * 24576; LAS unsigned char* Vi = Ki + 8192; LAS unsigned char* Ci = Ki + 16384;
    LAS float* tab = (LAS float*)(lds + ATT_TAB) + cs * 256;
    const float ms = P.MS[ci];
    { const int pt = tile * 64 + lane;
#pragma unroll
      for (int i = 0; i < 4; ++i) { const int idx = pt + 128 * i, r = idx >> 3, ch = idx & 7;
          *(LAS v4u*)(Ki + ksw(r, ch)) = *(const v4u*)(P.KC + (row0 + r) * 256 + h * 64 + ch * 8);
          *(LAS v4u*)(Vi + vsw(r, ch * 16)) = *(const v4u*)(P.PROJ + (row0 + r) * PLD + C_MV + h * 64 + ch * 8);
          *(LAS v4u*)(Ci + ksw(r, ch)) = *(const v4u*)(P.CS + (size_t)ci * 4096 + r * 64 + ch * 8); } }
    if (tile == 0) {
        const size_t row = row0 + lane;
        const float fi = P.GATES[row * 16 + 6 + h] + P.ibias[h], ff = P.GATES[row * 16 + 10 + h] + P.fbias[h];
        float bc = log_sigmoid_f(ff);
#pragma unroll
        for (int o = 1; o < 64; o <<= 1) { const float n = sup(bc, o, lane); if (lane >= o) bc += n; }
        const float a = fi - bc; float pm = a;
#pragma unroll
        for (int o = 1; o < 64; o <<= 1) { const float n = sup(pm, o, lane); if (lane >= o) pm = fmaxf(pm, n); }
        tab[lane] = a * LOG2E; tab[64 + lane] = fmaxf(ms, pm); tab[128 + lane] = bc; tab[192 + lane] = P.NS[(size_t)ci * 64 + lane];
    }
    __syncthreads();
    const int r32 = lane & 31, hh = lane >> 5, j = 32 * tile + r32;
    bf16x8 qf[4];
#pragma unroll
    for (int s = 0; s < 4; ++s) qf[s] = *(const bf16x8*)(P.QC + (row0 + j) * 256 + h * 64 + 16 * s + 8 * hh);
    unsigned short mo0[16], mo1[16];
#pragma unroll
    for (int r = 0; r < 16; ++r) { const size_t row = row0 + 32 * tile + crow(r, hh); mo0[r] = P.PROJ[row * PLD + C_MO + h * 64 + r32]; mo1[r] = P.PROJ[row * PLD + C_MO + h * 64 + 32 + r32]; }
    const float gj = tab[64 + j], inter = expf(ms - gj), rowterm2 = -gj * LOG2E;
    f32x16 o[2]; float l = 0.f;
#pragma unroll
    for (int r = 0; r < 16; ++r) { o[0][r] = 0.f; o[1][r] = 0.f; }
    for (int st = 0; st <= tile; ++st) {
        const int j0 = 32 * st;
        f32x16 acc;
#pragma unroll
        for (int r = 0; r < 16; ++r) acc[r] = 0.f;
#pragma unroll
        for (int s = 0; s < 4; ++s) { const bf16x8 kf = *(LAS const bf16x8*)(Ki + ksw(j0 + r32, 2 * s + hh)); acc = __builtin_amdgcn_mfma_f32_32x32x16_bf16(kf, qf[s], acc, 0, 0, 0); }
        float ls = 0.f;
#pragma unroll
        for (int g4 = 0; g4 < 4; ++g4) { const f32x4 c4 = *(LAS const f32x4*)(tab + j0 + 8 * g4 + 4 * hh);
#pragma unroll
            for (int ii = 0; ii < 4; ++ii) { const int reg = 4 * g4 + ii, key = j0 + 8 * g4 + 4 * hh + ii;
                float p = acc[reg] * __builtin_amdgcn_exp2f(rowterm2 + c4[ii]);
                if (st == tile && key > j) p = 0.f;
                acc[reg] = p; ls += p; } }
        l += ls;
        bf16x8 pa[2];
#pragma unroll
        for (int s = 0; s < 2; ++s) { v4u w; w.x = cvtpk(acc[8 * s + 0], acc[8 * s + 1]); w.y = cvtpk(acc[8 * s + 2], acc[8 * s + 3]); w.z = cvtpk(acc[8 * s + 4], acc[8 * s + 5]); w.w = cvtpk(acc[8 * s + 6], acc[8 * s + 7]); pa[s] = __builtin_bit_cast(bf16x8, w); }
        { const int i16 = lane & 15, cc = (lane >> 4) & 1;
#pragma unroll
          for (int db = 0; db < 2; ++db)
#pragma unroll
              for (int s = 0; s < 2; ++s) { const int rowv = j0 + 16 * s + 4 * hh + (i16 >> 2); const int colb = (32 * db + 16 * cc + 4 * (i16 & 3)) * 2;
                  LAS const unsigned char* vp = Vi + vsw(rowv, colb);
                  const s16x4 lo = vtr(vp), hi = vtr(vp + 1024);
                  const bf16x8 vf = (bf16x8){lo[0], lo[1], lo[2], lo[3], hi[0], hi[1], hi[2], hi[3]};
                  o[db] = __builtin_amdgcn_mfma_f32_32x32x16_bf16(pa[s], vf, o[db], 0, 0, 0); } }
    }
    float dn = 0.f;
#pragma unroll
    for (int s = 0; s < 4; ++s) { float f[8]; unpack8(__builtin_bit_cast(v4u, qf[s]), f);
        const f32x4 n0 = *(LAS const f32x4*)(tab + 192 + 16 * s + 8 * hh), n1 = *(LAS const f32x4*)(tab + 192 + 16 * s + 8 * hh + 4);
        dn += (f[0] * n0.x + f[1] * n0.y) + (f[2] * n0.z + f[3] * n0.w) + (f[4] * n1.x + f[5] * n1.y) + (f[6] * n1.z + f[7] * n1.w);
        v4u w; w.x = cvtpk(f[0] * inter, f[1] * inter); w.y = cvtpk(f[2] * inter, f[3] * inter); w.z = cvtpk(f[4] * inter, f[5] * inter); w.w = cvtpk(f[6] * inter, f[7] * inter);
        const bf16x8 qs = __builtin_bit_cast(bf16x8, w);
#pragma unroll
        for (int db = 0; db < 2; ++db) { const bf16x8 cf = *(LAS const bf16x8*)(Ci + ksw(32 * db + r32, 2 * s + hh)); o[db] = __builtin_amdgcn_mfma_f32_32x32x16_bf16(qs, cf, o[db], 0, 0, 0); } }
    dn = half_sum(dn, lane); l = half_sum(l, lane);
    const float den = inter * dn + l, mj = tab[128 + j] + gj;
    const float rd = 1.f / fmaxf(fabsf(den), expf(-mj));
    const float hg0 = P.hg[h * 64 + r32], hg1 = P.hg[h * 64 + 32 + r32];
#pragma unroll
    for (int r = 0; r < 16; ++r) { const int src = crow(r, hh); const float rdr = shf(rd, src);
        const float h0 = o[0][r] * rdr, h1 = o[1][r] * rdr; float ss = h0 * h0 + h1 * h1;
        ss += SWZ_X(ss, 1); ss += SWZ_X(ss, 2); ss += SWZ_X(ss, 4); ss += SWZ_X(ss, 8); ss += SWZ_X(ss, 16);
        const float rr = 1.f / sqrtf(ss * (1.f / 64.f) + EPS);
        const size_t row = row0 + 32 * tile + src;
        const float e0 = __builtin_amdgcn_exp2f(-bf2f(mo0[r]) * LOG2E), e1 = __builtin_amdgcn_exp2f(-bf2f(mo1[r]) * LOG2E);
        P.Y[row * 1024 + Y_ML + h * 64 + r32] = (bf16)f2bf(h0 * rr * hg0 * __builtin_amdgcn_rcpf(1.f + e0));
        P.Y[row * 1024 + Y_ML + h * 64 + 32 + r32] = (bf16)f2bf(h1 * rr * hg1 * __builtin_amdgcn_rcpf(1.f + e1)); }
    __syncthreads();
}
#ifndef FOX_MFMA
#define FOX_MFMA 1
#endif
#ifndef MOBA_MFMA
#define MOBA_MFMA 1
#endif
#ifndef REP_P0
#define REP_P0 0
#endif
#ifndef REP_NORM
#define REP_NORM 0
#endif
#ifndef REP_GIN
#define REP_GIN 0
#endif
#ifndef REP_FOX
#define REP_FOX 0
#endif
#ifndef REP_M1
#define REP_M1 0
#endif
#ifndef REP_MIXB
#define REP_MIXB 0
#endif
#ifndef REP_M3
#define REP_M3 0
#endif
#ifndef REP_GGU
#define REP_GGU 0
#endif
#ifndef REP_GATE
#define REP_GATE 0
#endif
#ifndef REP_CONV
#define REP_CONV 0
#endif
#ifndef REP_FCUM
#define REP_FCUM 0
#endif
#ifndef REP_QKN
#define REP_QKN 0
#endif
#ifndef REP_GOUT
#define REP_GOUT 0
#endif
#ifndef REP_GDN
#define REP_GDN 0
#endif
#ifndef REP_COMB
#define REP_COMB 0
#endif
#ifndef REP_BAR
#define REP_BAR 0
#endif
#ifndef REP_GATE2
#define REP_GATE2 0
#endif
#ifndef ML_MFMA
#define ML_MFMA 1
#endif
#ifndef REP_M2
#define REP_M2 0
#endif
#ifndef FOX_OLD
#define FOX_OLD 0
#endif
#if FOX_OLD
#define FOX_FN fox_unit_old
#else
#define FOX_FN fox_unit
#endif
#ifndef N_LAUNCH_MODE
#define N_LAUNCH_MODE 1
#endif
constexpr int NPHASE = 1 + 10 * DEPTH;
struct Args { const float* in[20]; float* out; unsigned char* ws; int ph_lo, ph_hi; };
static_assert(sizeof(Args) == 20 * 8 + 8 + 8 + 8, "Args has no padding");

__global__ void __launch_bounds__(NTHREADS, 2) fwd(Args args) {
    extern __shared__ __attribute__((aligned(16))) unsigned char lds_raw[];
    LAS unsigned char* lds = (LAS unsigned char*)lds_raw;
    LAS float* ldsf = (LAS float*)lds_raw;
    volatile LAS unsigned* MISC = (volatile LAS unsigned*)(lds + MISC_OFF);
    const int G = gridDim.x; const int bx = blockIdx.x; const int vcu = (G % 8 == 0) ? (bx % 8) * (G / 8) + bx / 8 : bx;
    const int NGW = G * NWAVES;
#define PH_IDS() int tid = threadIdx.x; asm volatile("" : "+v"(tid)); const int lane = tid & 63, wave = __builtin_amdgcn_readfirstlane(tid >> 6); const int gw = vcu * NWAVES + wave; (void)lane; (void)gw; \
    unsigned char* ws = ws_k; asm volatile("" : "+s"(ws)); gu32* ctl = (gu32*)(ws + WS_CTL); (void)ctl
    unsigned char* const ws_k = args.ws;
    gu32* ctl0 = (gu32*)(ws_k + WS_CTL);
    for (int u = threadIdx.x; u < (LDS_BYTES - LDSCTL_OFF) / 4; u += NTHREADS) ((LAS unsigned*)(lds + LDSCTL_OFF))[u] = 0u;
    __syncthreads();
    XcdBarrier bar; bar.bar = (unsigned*)(ctl0 + CW_BAR); bar.x = 0; bar.st = nullptr;
    if (N_LAUNCH_MODE == 1) bar = xcd_barrier_post((unsigned*)(ctl0 + CW_BAR), MISC + 8);
    const int lo = args.ph_lo, hi = args.ph_hi;
#ifndef PHMASK
#define PHMASK 0x7ff
#endif
#define PHEN(j) ((PHMASK >> (j)) & 1)
#define IN(k) ((N_LAUNCH_MODE == 1) || (lo <= (k) && (k) < hi))
#define SEAM(k) do { if (IN(k) && IN((k) + 1)) { xcd_barrier(bar); for (int rb_ = 0; rb_ < REP_BAR; ++rb_) xcd_barrier(bar); } } while (0)

#define PRM(k) (*(const float* const volatile*)(ws + WS_PTAB + 8 * (k)))
#define x_in PRM(0)
#define norm1_g PRM(4)
#define norm2_g PRM(5)
#define fox_f_bias PRM(7)
#define fox_q_g PRM(8)
#define fox_k_g PRM(9)
#define ml_conv_w PRM(10)
#define ml_conv_b PRM(11)
#define ml_i_bias PRM(12)
#define ml_f_bias PRM(13)
#define ml_h_g PRM(14)
#define moba_q_g PRM(15)
#define moba_k_g PRM(16)
#define xres ((float*)PRM(20))
#define MOD ((float*)(ws + WS_MOD))
#define XN ((bf16*)(ws + WS_XN))
#define PROJ ((bf16*)(ws + WS_PROJ))
#define HB ((bf16*)(ws + WS_H))
#define Y ((bf16*)(ws + WS_Y))
#define GATES ((float*)(ws + WS_GATES))
#define FOXCUM ((float*)(ws + WS_FOXCUM))
#define KMEAN ((float*)(ws + WS_KMEAN))
#define QC ((bf16*)(ws + WS_QC))
#define KC ((bf16*)(ws + WS_KC))
#define SEL ((unsigned*)(ws + WS_SEL))
#define mod_l (MOD + (size_t)l * 2 * 6144)
#define MK_MP() const float* const ib_ = ml_i_bias; const float* const fb_ = ml_f_bias; const float* const hg_ = ml_h_g; \
    MlP MP{PROJ, QC, KC, GATES, (float*)(ws + WS_U), (float*)(ws + WS_NU), (float*)(ws + WS_BEND), (float*)(ws + WS_MLOC), (bf16*)(ws + WS_CS), (float*)(ws + WS_NS), (float*)(ws + WS_MS), Y, ib_ + l * 4, fb_ + l * 4, hg_ + l * 256}

    for (int rep = 0; rep <= REP_P0; ++rep)
    if (PHEN(10) && IN(0)) { PH_IDS();
        const float* cvec = args.in[1]; const float* w_ada = args.in[2]; const float* b_ada = args.in[3]; const float* w_in = args.in[6];
        const float* w_out = args.in[17]; const float* w_gate_up = args.in[18]; const float* w_down = args.in[19];
        if (blockIdx.x == 0 && tid == 0) { const float** pt = (const float**)(ws + WS_PTAB);
            pt[0] = args.in[0]; pt[4] = args.in[4]; pt[5] = args.in[5]; pt[7] = args.in[7]; pt[8] = args.in[8]; pt[9] = args.in[9]; pt[10] = args.in[10]; pt[11] = args.in[11]; pt[12] = args.in[12];
            pt[13] = args.in[13]; pt[14] = args.in[14]; pt[15] = args.in[15]; pt[16] = args.in[16]; pt[20] = args.out; }
        if (vcu < 192) p0_mod_unit(vcu, cvec, w_ada, b_ada, MOD, ldsf, tid, wave, lane);
        LAS float* scr = (LAS float*)(lds + wave * 16384);
        constexpr int I_IN = 16 * (NIN / 32), I_OUT = 16 * (DM / 32), I_GU = 16 * (NGU / 32), I_DN = (DFF / 64) * (DM / 32), I_L = I_IN + I_OUT + I_GU + I_DN;
        for (int it = gw; it < DEPTH * I_L; it += NGW) {
            const int l = it / I_L; int r = it % I_L;
            if (r < I_IN) { transpose_item<1>(w_in + (size_t)l * DM * INC, DM, INC, (bf16*)(ws + WS_WIN + l * WIN_BYTES), scr, NIN / 32, r, lane); continue; } r -= I_IN;
            if (r < I_OUT) { transpose_item<0>(w_out + (size_t)l * DM * DM, DM, DM, (bf16*)(ws + WS_WOUT + l * WOUT_BYTES), scr, DM / 32, r, lane); continue; } r -= I_OUT;
            if (r < I_GU) { transpose_item<2>(w_gate_up + (size_t)l * DM * NGU, DM, NGU, (bf16*)(ws + WS_WGU + l * WGU_BYTES), scr, NGU / 32, r, lane); continue; } r -= I_GU;
            transpose_item<0>(w_down + (size_t)l * DFF * DM, DFF, DM, (bf16*)(ws + WS_WDN + l * WDN_BYTES), scr, DM / 32, r, lane);
        }
        if (REP_P0) __syncthreads();
    }
    SEAM(0);

    for (int l = 0; l < DEPTH; ++l) {
        const int pb = 1 + 10 * l;
        for (int rep = 0; rep <= REP_NORM; ++rep)
        if (PHEN(0) && IN(pb + 0)) { PH_IDS(); { const float* xcur = (l == 0) ? x_in : (const float*)xres; norm_rows(xcur, norm1_g + l * DM, mod_l, 0, 1024, XN, gw, NGW, lane); } }
        SEAM(pb + 0);
        for (int rep = 0; rep <= REP_GIN; ++rep)
        if (PHEN(1) && IN(pb + 1)) { PH_IDS();
            pg8::Gemm g{XN, (const bf16*)(ws + WS_WIN + l * WIN_BYTES), MROWS, NIN, DM}; pg8::StaticOrder S; S.init(MROWS, NIN, G, bx);
            pg8::EpiProj E{PROJ, GATES, PLD};
            pg8::gemm_phase<pg8::EpiProj, pg8::StaticOrder, true, true>(lds, g, S, E, tid);
        }
        SEAM(pb + 1);
        if (PHEN(2) && IN(pb + 2)) { PH_IDS();
            for (int u = vcu; u < 524; u += G) {
                if (u < 12) post_foxcum_unit(u, GATES, FOXCUM, fox_f_bias + l * 6, ldsf, tid, wave, lane);
                else if (u < 268) post_qknorm_unit(u - 12, PROJ, KMEAN, fox_q_g + l * 64, fox_k_g + l * 64, moba_q_g + l * 64, moba_k_g + l * 64, ldsf, tid, wave, lane);
                else { const int which = (u - 268) & 1; post_conv_unit((u - 268) >> 1, which, PROJ, which ? KC : QC, ml_conv_w + l * 4 * 512, ml_conv_b + l * 512, tid); }
            }
            for (int rep = 0; rep < REP_CONV; ++rep) for (int u = vcu; u < 256; u += G) { const int which = u & 1; post_conv_unit(u >> 1, which, PROJ, which ? KC : QC, ml_conv_w + l * 4 * 512, ml_conv_b + l * 512, tid); }
            for (int rep = 0; rep < REP_FCUM; ++rep) for (int u = vcu; u < 12; u += G) post_foxcum_unit(u, GATES, FOXCUM, fox_f_bias + l * 6, ldsf, tid, wave, lane);
        }
        SEAM(pb + 2);
        if (PHEN(3) && IN(pb + 3)) { PH_IDS(); MK_MP();
            const float B2m = 8.f * LOG2E * wave_max(fabsf(moba_q_g[l * 64 + lane])) * wave_max(fabsf(moba_k_g[l * 64 + lane])) * 1.01f;
            unsigned* LCNT = (unsigned*)(ctl + CW_LCNT + l * 768); unsigned short* LIST = MOBA_MFMA ? (unsigned short*)(ws + WS_LIST) : nullptr;
#if ML_MFMA
            for (int u = vcu; u < 768; u += G) moba_gate_unit(u, PROJ, KMEAN, SEL, LCNT, (unsigned*)(ws + WS_CTAB), LIST, B2m, THRESH2, ldsf, tid);
            for (int u = gw; u < 2048; u += NGW) mlstm_m1_mfma(u, MP, lds, wave, lane);
            __syncthreads();
#else
            for (int u = vcu; u < 768 + 2048; u += G) {
                if (u < 768) moba_gate_unit(u, PROJ, KMEAN, SEL, LCNT, (unsigned*)(ws + WS_CTAB), LIST, B2m, THRESH2, ldsf, tid);
                else mlstm_m1(u - 768, MP, ldsf, tid, wave, lane);
            }
#endif
            for (int rep = 0; rep < REP_GATE; ++rep) for (int u = vcu; u < 768; u += G) moba_gate_unit(u, PROJ, KMEAN, SEL, LCNT, (unsigned*)(ws + WS_CTAB), nullptr, B2m, THRESH2, ldsf, tid);
            for (int rep = 0; rep < REP_GATE2; ++rep) for (int u = vcu; u < 768; u += G) moba_gate_unit(u, PROJ, KMEAN, SEL, LCNT + 4096, (unsigned*)(ws + WS_OPART + 32 * MiB), (unsigned short*)(ws + WS_OPART), B2m, THRESH2, ldsf, tid);
            for (int rep = 0; rep < REP_M1; ++rep) for (int u = vcu; u < 2048; u += G) mlstm_m1(u, MP, ldsf, tid, wave, lane);
#if FOX_MFMA
            { const float gq = wave_max(fabsf(fox_q_g[l * 64 + lane])), gk = wave_max(fabsf(fox_k_g[l * 64 + lane])); const float B2 = 8.f * LOG2E * gq * gk * 1.01f;
              for (int rep = 0; rep <= REP_FOX; ++rep)
              for (int u = vcu; u < 768; u += G) FOX_FN(u >> 6, 63 - (u & 63), PROJ, FOXCUM, Y, B2, lds, tid, wave, lane); }
#else
            fox_naive(PROJ, FOXCUM, Y, gw, NGW, lane);
#endif
        }
        SEAM(pb + 3);
        for (int rep = 0; rep <= REP_MIXB; ++rep)
        if (PHEN(4) && IN(pb + 4)) { PH_IDS(); MK_MP();
            for (int rep = 0; rep <= REP_M2; ++rep)
            for (int u = vcu; u < 64; u += G) mlstm_m2(u, MP, tid);
#if MOBA_MFMA
            { const float gq = wave_max(fabsf(moba_q_g[l * 64 + lane])), gk = wave_max(fabsf(moba_k_g[l * 64 + lane])); const float B2 = 8.f * LOG2E * gq * gk * 1.01f;
              LAS int* pre = (LAS int*)(lds + ATT_TAB + 1024);
              const unsigned* lcnt = (const unsigned*)(ctl + CW_LCNT + l * 768);
              if (wave == 0) { int carry = 0;
                  for (int r = 0; r < 12; ++r) { const int p = r * 64 + lane; int x = (int)((lcnt[p] + 255u) >> 8);
#pragma unroll
                      for (int o = 1; o < 64; o <<= 1) { const int n = supi(x, o, lane); if (lane >= o) x += n; }
                      pre[p + 1] = carry + x; carry += shfi(x, 63); }
                  if (lane == 0) pre[0] = 0; }
              __syncthreads();
              const int S = pre[768];
              const unsigned short* LIST = (const unsigned short*)(ws + WS_LIST); bf16* OPART = (bf16*)(ws + WS_OPART); float* LPART = (float*)(ws + WS_LPART);
              #ifndef KSKIP_N
#define KSKIP_N 4
#endif
              constexpr int KSKIP = KSKIP_N; const int NU = S + 384;
              for (int i = (vcu < 64 ? KSKIP : 0); ; ++i) {
                  const int u = (i < KSKIP) ? i * (G - 64) + (vcu - 64) : KSKIP * (G - 64) + (i - KSKIP) * G + vcu;
                  if (u >= NU) break;
                  if (u < S) { int lo2 = 0, hi2 = 768; while (hi2 - lo2 > 1) { const int mid = (lo2 + hi2) >> 1; if (pre[mid] <= u) lo2 = mid; else hi2 = mid; }
                      moba_sel_unit(lo2 >> 6, lo2 & 63, u - pre[lo2], (int)lcnt[lo2], PROJ, LIST, (const unsigned*)(ws + WS_CTAB), OPART, LPART, Y, B2, lds, tid, wave, lane); }
                  else { const int p = u - S; moba_own_pair(p >> 5, p & 31, 63 - (p & 31), PROJ, OPART, LPART, Y, B2, lds, tid, wave, lane); }
              } }
#else
            moba_naive(PROJ, SEL, Y, gw, NGW, lane);
#endif
        }
        SEAM(pb + 4);
        if (PHEN(5) && IN(pb + 5)) { PH_IDS(); MK_MP();
#if ML_MFMA
            for (int rep = 0; rep <= REP_M3; ++rep)
            for (int u = vcu; u < 512; u += G) mlstm_m3_mfma(u, MP, lds, tid, wave, lane);
#else
            for (int rep = 0; rep <= REP_M3; ++rep)
            for (int u = vcu; u < 2048; u += G) mlstm_m3(u, MP, ldsf, tid, wave, lane);
#endif
#if MOBA_MFMA
            for (int rep = 0; rep < REP_COMB; ++rep) moba_combine(SEL, (const bf16*)(ws + WS_OPART), (const float*)(ws + WS_LPART), Y, (bf16*)(ws + WS_U), 384, 0, vcu * NTHREADS + tid, G * NTHREADS);
            moba_combine(SEL, (const bf16*)(ws + WS_OPART), (const float*)(ws + WS_LPART), Y, Y, 1024, Y_MOBA, vcu * NTHREADS + tid, G * NTHREADS);
#endif
        }
        SEAM(pb + 5);
        if (PHEN(6) && IN(pb + 6)) { PH_IDS();
            pg8::Gemm g{Y, (const bf16*)(ws + WS_WOUT + l * WOUT_BYTES), MROWS, DM, DM}; pg8::StaticOrder S; S.init(MROWS, DM, G, bx);
            float* const xr = xres; const float* const xcur = (l == 0) ? x_in : (const float*)xr;
            pg8::EpiRes E{xcur, xr, mod_l + 2048, 6144, SEQ};
            pg8::gemm_phase<pg8::EpiRes, pg8::StaticOrder, true, true>(lds, g, S, E, tid);
        }
        SEAM(pb + 6);
        if (PHEN(7) && IN(pb + 7)) { PH_IDS(); norm_rows((const float*)xres, norm2_g + l * DM, mod_l, 3072, 4096, XN, gw, NGW, lane); }
        SEAM(pb + 7);
        for (int rep = 0; rep <= REP_GGU; ++rep)
        if (PHEN(8) && IN(pb + 8)) { PH_IDS();
            pg8::Gemm g{XN, (const bf16*)(ws + WS_WGU + l * WGU_BYTES), MROWS, NGU, DM}; pg8::StaticOrder S; S.init(MROWS, NGU, G, bx);
            pg8::EpiSwiglu E{HB, DFF};
            pg8::gemm_phase<pg8::EpiSwiglu, pg8::StaticOrder, true, true>(lds, g, S, E, tid);
        }
        SEAM(pb + 8);
        if (PHEN(9) && IN(pb + 9)) { PH_IDS();
            pg8::Gemm g{HB, (const bf16*)(ws + WS_WDN + l * WDN_BYTES), MROWS, DM, DFF}; pg8::StaticOrder S; S.init(MROWS, DM, G, bx);
            float* const xr = xres;
            pg8::EpiRes E{xr, xr, mod_l + 5120, 6144, SEQ};
            pg8::gemm_phase<pg8::EpiRes, pg8::StaticOrder, true, true>(lds, g, S, E, tid);
        }
        SEAM(pb + 9);
    }
#undef IN
#undef SEAM
}

extern "C" void kernel_launch(void* const* d_in, const int* in_sizes, int n_in, void* d_out, int out_size, void* d_ws, size_t ws_size, hipStream_t stream) {
    static int grid = 0;
    if (grid == 0) {
        if (n_in != 20 || in_sizes[0] != MROWS * DM || out_size != MROWS * DM || ws_size < WS_END) {
            fprintf(stderr, "kernel_launch: unexpected shapes: n_in %d in0 %d out %d ws %zu (need >= %zu)\n", n_in, n_in > 0 ? in_sizes[0] : -1, out_size, ws_size, (size_t)WS_END); grid = -1; return; }
        int dev = 0, cus = 0, per_cu = 0;
        if (hipGetDevice(&dev) != hipSuccess || hipDeviceGetAttribute(&cus, hipDeviceAttributeMultiprocessorCount, dev) != hipSuccess) { grid = -1; return; }
        if (hipFuncSetAttribute((const void*)fwd, hipFuncAttributeMaxDynamicSharedMemorySize, LDS_BYTES) != hipSuccess) { fprintf(stderr, "kernel_launch: hipFuncSetAttribute failed\n"); grid = -1; return; }
        if (hipOccupancyMaxActiveBlocksPerMultiprocessor(&per_cu, (const void*)fwd, NTHREADS, LDS_BYTES) != hipSuccess || per_cu < 1)
            fprintf(stderr, "kernel_launch: note: occupancy query reports %d workgroups per CU\n", per_cu);
        (void)hipGetLastError();
        grid = cus;
    }
    if (grid < 0) return;
    if (hipMemsetAsync((char*)d_ws + WS_CTL, 0, CTL_ZERO_BYTES, stream) != hipSuccess) return;
    Args a{};
    for (int i = 0; i < 20; ++i) a.in[i] = (const float*)d_in[i];
    a.out = (float*)d_out; a.ws = (unsigned char*)d_ws;
    if (N_LAUNCH_MODE == 1) { a.ph_lo = 0; a.ph_hi = NPHASE; hipLaunchKernelGGL(fwd, dim3(grid), dim3(NTHREADS), LDS_BYTES, stream, a); }
    else for (int p = 0; p < NPHASE; ++p) { a.ph_lo = p; a.ph_hi = p + 1; hipLaunchKernelGGL(fwd, dim3(grid), dim3(NTHREADS), LDS_BYTES, stream, a); }
}
```

```cpp
#include <hip/hip_runtime.h>
#include <cstdio>
#include <cstdint>

constexpr int DM = 1024, NBATCH = 2, SEQ = 16384, MROWS = NBATCH * SEQ, DEPTH = 2;
constexpr int HD = 64, FOXH = 6, MLH = 4, MOBH = 6;
constexpr int DFF = 2816, INC = 3342, NIN = 3584, PLD = 3328;
constexpr int NGU = 2 * DFF;
constexpr int C_FQ = 0, C_FK = 384, C_FV = 768, C_BQ = 1152, C_BK = 1536, C_BV = 1920, C_MQ = 2304, C_MK = 2560, C_MV = 2816, C_MO = 3072, C_G = 3328;
constexpr int Y_FOX = 0, Y_ML = 384, Y_MOBA = 640;
constexpr int MOBA_BS = 256, NBLK = SEQ / MOBA_BS;
constexpr int MLC = 64, NCHUNK = SEQ / MLC;
constexpr float LOG2E = 1.4426950408889634f;
constexpr float QSCALE = 0.125f * LOG2E;
constexpr float EPS = 1e-6f;

#define GAS __attribute__((address_space(1)))
#define LAS __attribute__((address_space(3)))
typedef unsigned short bf16;
typedef unsigned v4u __attribute__((ext_vector_type(4)));
typedef unsigned v2u __attribute__((ext_vector_type(2)));
typedef float f32x4 __attribute__((ext_vector_type(4)));
typedef short bf16x8 __attribute__((ext_vector_type(8)));
typedef float f32x16 __attribute__((ext_vector_type(16)));
typedef GAS unsigned gu32;
#define RLX_AGENT __ATOMIC_RELAXED, __HIP_MEMORY_SCOPE_AGENT
__device__ __forceinline__ unsigned f2bf(float f) { unsigned u = __builtin_bit_cast(unsigned, f); return (u + 0x7fffu + ((u >> 16) & 1u)) >> 16; }
__device__ __forceinline__ unsigned pk2(float lo, float hi) { return f2bf(lo) | (f2bf(hi) << 16); }
__device__ __forceinline__ float bf2f(unsigned short u) { return __builtin_bit_cast(float, (unsigned)u << 16); }
__device__ __forceinline__ float bflo(unsigned w) { return __builtin_bit_cast(float, w << 16); }
__device__ __forceinline__ float bfhi(unsigned w) { return __builtin_bit_cast(float, w & 0xffff0000u); }
#ifndef OLD_SHFL
#define OLD_SHFL 0
#endif
#ifndef OLD_SWZ
#define OLD_SWZ OLD_SHFL
#endif
#ifndef OLD_HALF
#define OLD_HALF OLD_SHFL
#endif
#ifndef OLD_SHF
#define OLD_SHF OLD_SHFL
#endif
#ifndef OLD_SUP
#define OLD_SUP OLD_SHFL
#endif
#if OLD_SWZ
#define SWZ_X(v, o) __shfl_xor((float)(v), (o))
#else
#define SWZ_X(v, o) __builtin_bit_cast(float, __builtin_amdgcn_ds_swizzle(__builtin_bit_cast(int, (float)(v)), ((o) << 10) | 0x1f))
#endif
__device__ __forceinline__ float half_sum(float v, int lane) { return v + __builtin_bit_cast(float, __builtin_amdgcn_ds_bpermute((lane ^ 32) << 2, __builtin_bit_cast(int, v))); }
#if OLD_SHF
__device__ __forceinline__ float shf(float v, int src) { return __shfl(v, src); }
__device__ __forceinline__ int shfi(int v, int src) { return __shfl(v, src); }
#else
__device__ __forceinline__ float shf(float v, int src) { return __builtin_bit_cast(float, __builtin_amdgcn_ds_bpermute(src << 2, __builtin_bit_cast(int, v))); }
__device__ __forceinline__ int shfi(int v, int src) { return __builtin_amdgcn_ds_bpermute(src << 2, v); }
#endif
#if OLD_SUP
__device__ __forceinline__ float sup(float v, int o, int lane) { return __shfl_up(v, o); }
__device__ __forceinline__ int supi(int v, int o, int lane) { return __shfl_up(v, o); }
#else
__device__ __forceinline__ float sup(float v, int o, int lane) { return shf(v, lane >= o ? lane - o : lane); }
__device__ __forceinline__ int supi(int v, int o, int lane) { return shfi(v, lane >= o ? lane - o : lane); }
#endif
__device__ __forceinline__ float wave_sum(float v) { v += SWZ_X(v, 1); v += SWZ_X(v, 2); v += SWZ_X(v, 4); v += SWZ_X(v, 8); v += SWZ_X(v, 16);
    return __builtin_bit_cast(float, __builtin_amdgcn_readlane(__builtin_bit_cast(int, v), 0)) + __builtin_bit_cast(float, __builtin_amdgcn_readlane(__builtin_bit_cast(int, v), 32)); }
__device__ __forceinline__ float wave_max(float v) { v = fmaxf(v, SWZ_X(v, 1)); v = fmaxf(v, SWZ_X(v, 2)); v = fmaxf(v, SWZ_X(v, 4)); v = fmaxf(v, SWZ_X(v, 8)); v = fmaxf(v, SWZ_X(v, 16));
    return fmaxf(__builtin_bit_cast(float, __builtin_amdgcn_readlane(__builtin_bit_cast(int, v), 0)), __builtin_bit_cast(float, __builtin_amdgcn_readlane(__builtin_bit_cast(int, v), 32))); }
__device__ __forceinline__ float log_sigmoid_f(float x) { return fminf(x, 0.f) - log1pf(expf(-fabsf(x))); }
__device__ __forceinline__ float sigmoid_f(float x) { return 1.f / (1.f + expf(-x)); }

constexpr size_t MiB = 1u << 20;
constexpr size_t WS_CTL = 0, CTL_ZERO_BYTES = 1 * MiB;
constexpr size_t WS_MOD = 1 * MiB;
constexpr size_t WS_KMEAN = WS_MOD + 128 * 1024;
constexpr size_t WS_MLS = WS_KMEAN + 512 * 1024;
constexpr size_t WS_BEND = WS_MLS, WS_MLOC = WS_MLS + 8192, WS_MS = WS_MLS + 16384, WS_NU = WS_MLS + 32768, WS_NS = WS_NU + 2048 * 64 * 4;
constexpr size_t WS_CTAB = 3 * MiB;
constexpr size_t WS_PTAB = WS_CTAB + 256 * 1024;
static_assert(WS_NS + 2048 * 64 * 4 <= WS_CTAB && WS_CTAB + 12 * 64 * 64 * 4 <= WS_PTAB && WS_PTAB + 256 <= 4 * MiB, "small region");
constexpr size_t WS_WIN = 4 * MiB, WIN_BYTES = (size_t)NIN * DM * 2;
constexpr size_t WS_WOUT = WS_WIN + 2 * WIN_BYTES, WOUT_BYTES = (size_t)DM * DM * 2;
constexpr size_t WS_WGU = WS_WOUT + 2 * WOUT_BYTES, WGU_BYTES = (size_t)NGU * DM * 2;
constexpr size_t WS_WDN = WS_WGU + 2 * WGU_BYTES, WDN_BYTES = (size_t)DM * DFF * 2;
static_assert(WS_WDN + 2 * WDN_BYTES <= 64 * MiB, "weights");
constexpr size_t WS_XN = 64 * MiB;
constexpr size_t WS_U = 64 * MiB;
constexpr size_t WS_CS = 96 * MiB;
constexpr size_t WS_LIST = 112 * MiB;
constexpr size_t WS_PROJ = 128 * MiB;
constexpr size_t WS_H = 128 * MiB;
constexpr size_t WS_Y = 336 * MiB;
constexpr size_t WS_QC = 400 * MiB, WS_KC = 416 * MiB;
constexpr size_t WS_OPART = 432 * MiB;
constexpr size_t WS_LPART = 504 * MiB;
constexpr size_t WS_GATES = 507 * MiB;
constexpr size_t WS_FOXCUM = 509 * MiB;
constexpr size_t WS_SEL = 510 * MiB;
constexpr size_t WS_END = 512 * MiB;
static_assert(WS_PROJ + (size_t)MROWS * PLD * 2 <= WS_Y && WS_SEL + (size_t)MROWS * 6 * 4 <= WS_END, "ws map");
constexpr int CW_BAR = 4096;
constexpr int CW_QUEUE = 16384;
constexpr int CW_LCNT = 32768;

constexpr int RING_BYTES = 131072, LDSCTL_OFF = RING_BYTES, MISC_OFF = LDSCTL_OFF + 320, LDS_BYTES = 147456;
constexpr int NWAVES = 8, NTHREADS = 512;
namespace pg8 {
#define PG8_LAS __attribute__((address_space(3)))
typedef unsigned short bf16_t;
typedef short bf16x8 __attribute__((ext_vector_type(8)));
typedef float f32x4 __attribute__((ext_vector_type(4)));
typedef unsigned u32x4 __attribute__((ext_vector_type(4)));
constexpr int BM = 256, BK = 64, HALF = 128, HTB = HALF * BK * 2  , STAGE_BYTES = 8 * HTB, NXCD = 8, WGM = 8;

__host__ __device__ __forceinline__ int lds_byte(int r, int c) { const int st = (r >> 4) * 2 + (c >> 5), rr = r & 15, cc = c & 31, ob = rr * 64 + cc * 2; return st * 1024 + (ob ^ (((ob >> 9) & 1) << 5)); }
__host__ __device__ __forceinline__ void stage_rc(int b, int& R, int& C) { const int st = b / 1024, sb = b % 1024, swz = sb ^ (((sb >> 9) & 1) << 5); R = (st >> 1) * 16 + swz / 64; C = (st & 1) * 32 + (swz % 64) / 2; }
__host__ __device__ __forceinline__ int perm32(int rho) { const int n = rho >> 4, i = rho & 15; return 8 * (i >> 2) + 4 * n + (i & 3); }

struct Unit { int pm, pn; };
struct Gemm { const bf16_t* A; const bf16_t* Bt; int M, N, K; };

struct StaticOrder {
    int nM, nN, nwg, G, c;
    __host__ __device__ void init(int M, int N, int G_, int c_) { nM = M / BM; nN = N / BM; nwg = nM * nN; G = G_; c = c_; }
    __host__ __device__ bool next(int i, Unit& u) const {
        const long L = (long)i * G + c; if (L >= nwg) return false;
        int wgid = (int)L; { const int q = nwg / NXCD, r = nwg % NXCD, xcd = wgid % NXCD, off = wgid / NXCD; wgid = (xcd < r ? xcd * (q + 1) : r * (q + 1) + (xcd - r) * q) + off; }
        const int nig = WGM * nN, gid = wgid / nig, fm = gid * WGM, gsz = (nM - fm) < WGM ? (nM - fm) : WGM;
        u.pm = fm + ((wgid % nig) % gsz); u.pn = (wgid % nig) / gsz; return true;
    }
    __device__ __forceinline__ void a_ready(const Unit&) const {}
    __device__ __forceinline__ void done(const Unit&) const {}
};

__device__ __forceinline__ unsigned cvt_pk_bf16(float lo, float hi) { unsigned r; asm volatile("v_cvt_pk_bf16_f32 %0, %1, %2" : "=v"(r) : "v"(lo), "v"(hi)); return r; }
typedef float f32x2 __attribute__((ext_vector_type(2)));
struct EpiProj {
    static constexpr bool PERM = true, AFTER_DRAIN = false;
    bf16_t* P; float* G; int pld;
    __device__ __forceinline__ void operator()(const f32x4 (&acc)[2][2][4][2], const Unit& u, int wr, int wc, int fr, int fq) const {
        const int row0 = u.pm * BM + wr * 64 + fr;
        if (u.pn < 13) {
            const int col0 = u.pn * BM + wc * 32 + 8 * fq;
#pragma unroll
            for (int ai = 0; ai < 2; ++ai)
#pragma unroll
                for (int m = 0; m < 4; ++m) { bf16_t* rowp = P + (size_t)(row0 + ai * HALF + m * 16) * pld + col0;
#pragma unroll
                    for (int bj = 0; bj < 2; ++bj) { const f32x4 v0 = acc[ai][bj][m][0], v1 = acc[ai][bj][m][1];
                        u32x4 w; w.x = cvt_pk_bf16(v0[0], v0[1]); w.y = cvt_pk_bf16(v0[2], v0[3]); w.z = cvt_pk_bf16(v1[0], v1[1]); w.w = cvt_pk_bf16(v1[2], v1[3]);
                        *(u32x4*)(rowp + bj * HALF) = w; } }
        } else {
            if (wc == 0 && fq < 2) {
#pragma unroll
                for (int ai = 0; ai < 2; ++ai)
#pragma unroll
                    for (int m = 0; m < 4; ++m) { float* gp = G + (size_t)(row0 + ai * HALF + m * 16) * 16 + 8 * fq;
                        *(f32x4*)(gp) = acc[ai][0][m][0]; *(f32x4*)(gp + 4) = acc[ai][0][m][1]; }
            }
        }
    }
};
struct EpiRes {
    static constexpr bool PERM = false, AFTER_DRAIN = false;
    const float* base; float* out; const float* gate; int gate_bstride; int rows_per_batch;
    __device__ __forceinline__ void operator()(const f32x4 (&acc)[2][2][4][2], const Unit& u, int wr, int wc, int fr, int fq) const {
        const int row0 = u.pm * BM + wr * 64 + fr, col0 = u.pn * BM + wc * 32 + 4 * fq;
        const float* gb = gate + (size_t)((u.pm * BM) / rows_per_batch) * gate_bstride;
        f32x4 gv[2][2];
#pragma unroll
        for (int bj = 0; bj < 2; ++bj)
#pragma unroll
            for (int n = 0; n < 2; ++n) gv[bj][n] = *(const f32x4*)(gb + col0 + bj * HALF + n * 16);
#pragma unroll
        for (int ai = 0; ai < 2; ++ai)
#pragma unroll
            for (int m = 0; m < 4; ++m) { const size_t off = (size_t)(row0 + ai * HALF + m * 16) * 1024 + col0;
#pragma unroll
                for (int bj = 0; bj < 2; ++bj)
#pragma unroll
                    for (int n = 0; n < 2; ++n) { const f32x4 bs = *(const f32x4*)(base + off + bj * HALF + n * 16);
                        *(f32x4*)(out + off + bj * HALF + n * 16) = bs + gv[bj][n] * acc[ai][bj][m][n]; } }
    }
};
struct EpiSwiglu {
    static constexpr bool PERM = true, AFTER_DRAIN = false;
    bf16_t* Hh; int ldh;
    __device__ __forceinline__ void operator()(const f32x4 (&acc)[2][2][4][2], const Unit& u, int wr, int wc, int fr, int fq) const {
        const int row0 = u.pm * BM + wr * 64 + fr, col0 = u.pn * HALF + wc * 32 + 8 * fq;
#pragma unroll
        for (int ai = 0; ai < 2; ++ai)
#pragma unroll
            for (int m = 0; m < 4; ++m) { bf16_t* rowp = Hh + (size_t)(row0 + ai * HALF + m * 16) * ldh + col0;
                float hv[8];
#pragma unroll
                for (int n = 0; n < 2; ++n)
#pragma unroll
                    for (int i = 0; i < 4; ++i) { const float g = acc[ai][0][m][n][i], up = acc[ai][1][m][n][i];
                        const float e = __builtin_amdgcn_exp2f(-g * 1.4426950408889634f);
                        hv[n * 4 + i] = g * __builtin_amdgcn_rcpf(1.0f + e) * up; }
                u32x4 w; w.x = cvt_pk_bf16(hv[0], hv[1]); w.y = cvt_pk_bf16(hv[2], hv[3]); w.z = cvt_pk_bf16(hv[4], hv[5]); w.w = cvt_pk_bf16(hv[6], hv[7]);
                *(u32x4*)(rowp) = w; }
    }
};
template <class Epi, class Sched, bool ALIGN_EPI = false, bool SP2 = false>
__device__ __forceinline__ void gemm_phase(PG8_LAS unsigned char* lds, const Gemm g, const Sched& S, const Epi& E, const int tid_in) {
    const int tid = tid_in, wid = __builtin_amdgcn_readfirstlane(tid >> 6), lane = tid & 63, wr = wid >> 2, wc = wid & 3, fr = lane & 15, fq = lane >> 4;
    const int K = g.K, nt = K / BK;
    unsigned voffA[2], voffB[2];
#pragma unroll
    for (int i = 0; i < 2; ++i) { int R, C; stage_rc(tid * 16 + i * 8192, R, C); const int Rb = Epi::PERM ? ((R & ~31) + perm32(R & 31)) : R;
        voffA[i] = (unsigned)(R * K + C) * 2u; voffB[i] = (unsigned)(Rb * K + C) * 2u; }
    const size_t kstep = (size_t)(BK * 2);
    const size_t hstep = (size_t)HALF * K * 2;
    const size_t tstep = 2 * hstep;
    const unsigned ldsw = (unsigned)wid * 1024u;
    const int aoff = lds_byte(wr * 64 + fr, fq * 8), boff = lds_byte(wc * 32 + fr, fq * 8);
#define PG8_SA(b, h) (((b) * 2 + (h)) * HTB)
#define PG8_SB(b, h) ((4 + (b) * 2 + (h)) * HTB)
#define PG8_STAGE(bufoff, gbase, voff) do { _Pragma("unroll") for (int _i = 0; _i < 2; ++_i) \
        __builtin_amdgcn_global_load_lds((const unsigned*)((const char*)(gbase) + (voff)[_i]), (PG8_LAS unsigned*)(lds + (bufoff) + ldsw + _i * 8192), 16, 0, 0); } while (0)
#define PG8_LDA(dst, b, h) do { _Pragma("unroll") for (int m = 0; m < 4; ++m) _Pragma("unroll") for (int k = 0; k < 2; ++k) dst[m][k] = *(const PG8_LAS bf16x8*)(lds + PG8_SA(b, h) + aoff + m * 2048 + k * 1024); } while (0)
#define PG8_LDB(dst, b, h) do { _Pragma("unroll") for (int n = 0; n < 2; ++n) _Pragma("unroll") for (int k = 0; k < 2; ++k) dst[n][k] = *(const PG8_LAS bf16x8*)(lds + PG8_SB(b, h) + boff + n * 2048 + k * 1024); } while (0)
#define PG8_MMA(ai, bj, At, Bt) do { __builtin_amdgcn_s_setprio(1); _Pragma("unroll") for (int m = 0; m < 4; ++m) _Pragma("unroll") for (int n = 0; n < 2; ++n) _Pragma("unroll") for (int k = 0; k < 2; ++k) \
        acc[ai][bj][m][n] = __builtin_amdgcn_mfma_f32_16x16x32_bf16(Bt[n][k], At[m][k], acc[ai][bj][m][n], 0, 0, 0); __builtin_amdgcn_s_setprio(0); } while (0)
#define PG8_WAIT_V(n) asm volatile("s_waitcnt vmcnt(" #n ")" ::: "memory")
#define PG8_WAIT_L(n) asm volatile("s_waitcnt lgkmcnt(" #n ")" ::: "memory")
#define PG8_BAR __builtin_amdgcn_s_barrier()
#define PG8_SCHED __builtin_amdgcn_sched_barrier(0)
    Unit cur, nxt; int ui = 0;
    if (!S.next(0, cur)) return;
    f32x4 acc[2][2][4][2];
#pragma unroll
    for (int a = 0; a < 2; ++a)
#pragma unroll
        for (int b = 0; b < 2; ++b)
#pragma unroll
            for (int m = 0; m < 4; ++m)
#pragma unroll
                for (int n = 0; n < 2; ++n) acc[a][b][m][n] = (f32x4){0.f, 0.f, 0.f, 0.f};
    bf16x8 At[4][2], B0[2][2], B1[2][2];
    const char* cA = (const char*)g.A + (size_t)cur.pm * tstep; const char* cB = (const char*)g.Bt + (size_t)cur.pn * tstep;
    S.a_ready(cur);
    if constexpr (SP2) {
        PG8_STAGE(PG8_SB(0, 0), cB, voffB); PG8_STAGE(PG8_SB(0, 1), cB + hstep, voffB); PG8_STAGE(PG8_SA(0, 0), cA, voffA); PG8_STAGE(PG8_SA(0, 1), cA + hstep, voffA);
        if (wr == 1) PG8_BAR;
        PG8_WAIT_V(2); PG8_BAR;
        PG8_STAGE(PG8_SB(1, 0), cB + kstep, voffB); PG8_STAGE(PG8_SA(1, 0), cA + kstep, voffA); PG8_STAGE(PG8_SB(1, 1), cB + hstep + kstep, voffB);
        PG8_WAIT_V(6); PG8_BAR;
    } else {
        PG8_STAGE(PG8_SB(0, 0), cB, voffB); PG8_STAGE(PG8_SA(0, 0), cA, voffA); PG8_STAGE(PG8_SB(0, 1), cB + hstep, voffB); PG8_STAGE(PG8_SA(0, 1), cA + hstep, voffA);
        if (wr == 1) PG8_BAR;
        PG8_WAIT_V(4); PG8_BAR;
        PG8_STAGE(PG8_SB(1, 0), cB + kstep, voffB); PG8_STAGE(PG8_SA(1, 0), cA + kstep, voffA); PG8_STAGE(PG8_SB(1, 1), cB + hstep + kstep, voffB);
        PG8_WAIT_V(6); PG8_BAR;
    }
    for (;;) {
        const bool has_next = S.next(ui + 1, nxt);
        const char* nA = has_next ? (const char*)g.A + (size_t)nxt.pm * tstep : cA; const char* nB = has_next ? (const char*)g.Bt + (size_t)nxt.pn * tstep : cB;
        for (int t = 0; t < nt; t += 2) {
            const bool last = (t == nt - 2);
            const char* a1 = cA + (size_t)(t + 1) * kstep;
            const char* a2 = last ? nA : cA + (size_t)(t + 2) * kstep; const char* b2 = last ? nB : cB + (size_t)(t + 2) * kstep;
            const char* a3 = a2 + kstep; const char* b3 = b2 + kstep;
            if (last && has_next) S.a_ready(nxt);
            if constexpr (SP2) {
            PG8_LDB(B0, 0, 0); PG8_LDB(B1, 0, 1); PG8_SCHED; PG8_LDA(At, 0, 0); PG8_STAGE(PG8_SA(1, 1), a1 + hstep, voffA);
            PG8_WAIT_V(8); PG8_WAIT_L(0); PG8_BAR; PG8_MMA(0, 0, At, B0); PG8_MMA(0, 1, At, B1); PG8_BAR; PG8_SCHED;
            PG8_LDA(At, 0, 1); PG8_STAGE(PG8_SB(0, 0), b2, voffB); PG8_STAGE(PG8_SB(0, 1), b2 + hstep, voffB); PG8_STAGE(PG8_SA(0, 0), a2, voffA);
            PG8_WAIT_V(8); PG8_WAIT_L(0); PG8_BAR; PG8_MMA(1, 0, At, B0); PG8_MMA(1, 1, At, B1); PG8_BAR; PG8_SCHED;
            PG8_LDB(B0, 1, 0); PG8_LDB(B1, 1, 1); PG8_SCHED; PG8_LDA(At, 1, 0); PG8_STAGE(PG8_SA(0, 1), a2 + hstep, voffA);
            PG8_WAIT_V(8); PG8_WAIT_L(0); PG8_BAR; PG8_MMA(0, 0, At, B0); PG8_MMA(0, 1, At, B1); PG8_BAR; PG8_SCHED;
            PG8_LDA(At, 1, 1); PG8_STAGE(PG8_SB(1, 0), b3, voffB); PG8_STAGE(PG8_SB(1, 1), b3 + hstep, voffB); PG8_STAGE(PG8_SA(1, 0), a3, voffA);
            PG8_WAIT_V(8); PG8_WAIT_L(0); PG8_BAR; PG8_MMA(1, 0, At, B0); PG8_MMA(1, 1, At, B1); PG8_BAR; PG8_SCHED;
            } else {
            PG8_LDB(B0, 0, 0); PG8_SCHED; PG8_LDA(At, 0, 0); PG8_STAGE(PG8_SA(1, 1), a1 + hstep, voffA);
            PG8_WAIT_L(8); PG8_BAR; PG8_WAIT_L(0); PG8_MMA(0, 0, At, B0); PG8_BAR; PG8_SCHED;
            PG8_LDB(B1, 0, 1); PG8_STAGE(PG8_SB(0, 0), b2, voffB);
            PG8_BAR; PG8_WAIT_L(0); PG8_MMA(0, 1, At, B1); PG8_BAR;
            PG8_LDA(At, 0, 1); PG8_STAGE(PG8_SA(0, 0), a2, voffA);
            PG8_BAR; PG8_WAIT_L(0); PG8_MMA(1, 0, At, B0); PG8_BAR; PG8_SCHED;
            PG8_STAGE(PG8_SB(0, 1), b2 + hstep, voffB);
            PG8_WAIT_V(6); PG8_BAR; PG8_MMA(1, 1, At, B1); PG8_BAR;
            PG8_LDB(B0, 1, 0); PG8_SCHED; PG8_LDA(At, 1, 0); PG8_STAGE(PG8_SA(0, 1), a2 + hstep, voffA);
            PG8_WAIT_L(8); PG8_BAR; PG8_WAIT_L(0); PG8_MMA(0, 0, At, B0); PG8_BAR; PG8_SCHED;
            PG8_LDB(B1, 1, 1); PG8_STAGE(PG8_SB(1, 0), b3, voffB);
            PG8_BAR; PG8_WAIT_L(0); PG8_MMA(0, 1, At, B1); PG8_BAR;
            PG8_LDA(At, 1, 1); PG8_STAGE(PG8_SA(1, 0), a3, voffA);
            PG8_BAR; PG8_WAIT_L(0); PG8_MMA(1, 0, At, B0); PG8_BAR; PG8_SCHED;
            PG8_STAGE(PG8_SB(1, 1), b3 + hstep, voffB);
            PG8_WAIT_V(6); PG8_BAR; PG8_MMA(1, 1, At, B1); PG8_BAR;
            }
        }
        if constexpr (ALIGN_EPI) { if (wr == 0) PG8_BAR; }
        if constexpr (!Epi::AFTER_DRAIN) { E(acc, cur, wr, wc, fr, fq); S.done(cur); }
        if (!has_next) break;
#pragma unroll
        for (int a = 0; a < 2; ++a)
#pragma unroll
            for (int b = 0; b < 2; ++b)
#pragma unroll
                for (int m = 0; m < 4; ++m)
#pragma unroll
                    for (int n = 0; n < 2; ++n) acc[a][b][m][n] = (f32x4){0.f, 0.f, 0.f, 0.f};
        cur = nxt; cA = nA; cB = nB; ++ui;
        if constexpr (ALIGN_EPI) { if (wr == 1) PG8_BAR; }
    }
    PG8_WAIT_V(0);
    if constexpr (!ALIGN_EPI) { if (wr == 0) PG8_BAR; }
    PG8_BAR;
    if constexpr (Epi::AFTER_DRAIN) { E.fused(acc, cur, wr, wc, fr, fq, lds, wid, lane); S.done(cur); }
#undef PG8_SA
#undef PG8_SB
#undef PG8_STAGE
#undef PG8_LDA
#undef PG8_LDB
#undef PG8_MMA
#undef PG8_WAIT_V
#undef PG8_WAIT_L
#undef PG8_BAR
#undef PG8_SCHED
}
}
#define XB_TMO      128
#define XB_XCNT(j)  (256  + 64 * (j))
#define XB_XSUB(j)  (1280 + 64 * (j))
#define XB_XGEN(j)  (2304 + 64 * (j))
#define XB_TOP      3328
#define XB_TOPGEN   3392
#define XCD_BAR_WORDS 3456
#define XB_SPIN_CAP (1u << 18)

__device__ __forceinline__ unsigned xb_ld(unsigned* p)              { return __hip_atomic_load(p, __ATOMIC_RELAXED, __HIP_MEMORY_SCOPE_AGENT); }
__device__ __forceinline__ unsigned xb_add(unsigned* p, unsigned v) { return __hip_atomic_fetch_add(p, v, __ATOMIC_RELAXED, __HIP_MEMORY_SCOPE_AGENT); }
__device__ __forceinline__ unsigned xb_xcc_id() { return (unsigned)__builtin_amdgcn_s_getreg((3 << 11) | 20) & 0xFu; }
#define XB_SPIN(cond, bar) do { unsigned _sp = 0; while (cond) { __builtin_amdgcn_s_sleep(1); \
    if ((++_sp & 255u) == 0u) { if (xb_ld(&(bar)[XB_TMO])) break; if (_sp > XB_SPIN_CAP) { atomicAdd(&(bar)[XB_TMO], 1u); break; } } } } while (0)

struct XcdBarrier {
    unsigned* bar; unsigned x;
    volatile LAS unsigned* st;
};

__device__ __forceinline__ XcdBarrier xcd_barrier_post(unsigned* bar, volatile LAS unsigned* st) {
    XcdBarrier b; b.bar = bar; b.x = xb_xcc_id(); b.st = st;
    if (threadIdx.x == 0) (void)xb_add(&bar[XB_XCNT(b.x)], 1u);
    return b;
}
__device__ __forceinline__ void xcd_barrier_complete(unsigned* bar, unsigned x, unsigned& nloc, unsigned& nx) {
    const unsigned G = gridDim.x * gridDim.y * gridDim.z;
    unsigned sum, cnt, mine, sp = 0u;
    for (;;) {
        sum = 0u; cnt = 0u; mine = 0u;
#pragma unroll
        for (unsigned j = 0; j < 16; ++j) { const unsigned c = xb_ld(&bar[XB_XCNT(j)]); sum += c; cnt += (c > 0u) ? 1u : 0u; mine = (j == x) ? c : mine; }
        if (sum == G) break;
        __builtin_amdgcn_s_sleep(1);
        if ((++sp & 255u) == 0u) { if (xb_ld(&bar[XB_TMO])) break; if (sp > XB_SPIN_CAP) { atomicAdd(&bar[XB_TMO], 1u); break; } }
    }
    nloc = mine > 0u ? mine : 1u; nx = cnt > 0u ? cnt : 1u;
}

__device__ __forceinline__ void xcd_barrier(const XcdBarrier& b) {
    asm volatile("s_waitcnt vmcnt(0)" ::: "memory");
    __syncthreads();
    if (threadIdx.x == 0) {
        unsigned* bar = b.bar; asm volatile("" : "+s"(bar));
        const unsigned bx_ = xb_xcc_id();
        __builtin_amdgcn_s_waitcnt(0);
        unsigned nloc = b.st[0], nx = b.st[1];
        if (nloc == 0u) { xcd_barrier_complete(bar, bx_, nloc, nx); b.st[0] = nloc; b.st[1] = nx; }
        const unsigned old = xb_add(&bar[XB_XSUB(bx_)], 1u);
        const unsigned gen = old / nloc;
        if (old + 1u == (gen + 1u) * nloc) {
            __builtin_amdgcn_fence(__ATOMIC_RELEASE, "agent");
            asm volatile("s_waitcnt vmcnt(0)" ::: "memory");
            const unsigned og = xb_add(&bar[XB_TOP], 1u);
            const unsigned tg = og / nx;
            if (og + 1u == (tg + 1u) * nx) xb_add(&bar[XB_TOPGEN], 1u);
            else XB_SPIN(xb_ld(&bar[XB_TOPGEN]) == tg, bar);
            __builtin_amdgcn_fence(__ATOMIC_ACQUIRE, "agent");
            xb_add(&bar[XB_XGEN(bx_)], 1u);
            asm volatile("s_waitcnt vmcnt(0)" ::: "memory");
        } else {
            XB_SPIN(xb_ld(&bar[XB_XGEN(bx_)]) == gen, bar);
            __builtin_amdgcn_fence(__ATOMIC_ACQUIRE, "agent");
            asm volatile("s_waitcnt vmcnt(0)" ::: "memory");
        }
    }
    __syncthreads();
}
#define LDS_WAIT() asm volatile("s_waitcnt lgkmcnt(0)" ::: "memory")
__device__ __forceinline__ void unpack8(const v4u w, float* f) { f[0] = bflo(w.x); f[1] = bfhi(w.x); f[2] = bflo(w.y); f[3] = bfhi(w.y); f[4] = bflo(w.z); f[5] = bfhi(w.z); f[6] = bflo(w.w); f[7] = bfhi(w.w); }

__device__ __forceinline__ int win_src(int c) {
    if (c < 1152) return c;
    if (c < 2304) return c + 1038;
    if (c < 3072) return c - 1146;
    if (c < 3328) return c - 1138;
    if (c < 3334) return c - 3328 + 1152;
    if (c < 3338) return c - 3334 + 1926;
    if (c < 3342) return c - 3338 + 1930;
    return -1;
}
__device__ __forceinline__ int wgu_src(int r) { const int pn = r >> 8, w = r & 255; return (w < 128 ? 0 : DFF) + pn * 128 + (w & 127); }
template <int MODE> __device__ __forceinline__ int src_col(int r) { if (MODE == 1) return win_src(r); if (MODE == 2) return wgu_src(r); return r; }

template <int MODE> __device__ __forceinline__ void transpose_item(const float* W, int K, int ldw, bf16* WT, LAS float* scr, int nblk, int item, int lane) {
    const int kb = item / nblk, nb = item % nblk, k0 = 64 * kb, n0 = 32 * nb;
    const int sc = src_col<MODE>(n0 + (lane & 31));
#pragma unroll 8
    for (int i = 0; i < 32; ++i) { const int kk = 2 * i + (lane >> 5); scr[kk * 33 + (lane & 31)] = (sc >= 0) ? W[(size_t)(k0 + kk) * ldw + sc] : 0.f; }
    LDS_WAIT(); asm volatile("" ::: "memory");
    const int c = lane & 7;
#pragma unroll
    for (int j = 0; j < 4; ++j) { const int n = (lane >> 3) + 8 * j; const LAS float* s = scr + (8 * c) * 33 + n;
        v4u o; o.x = pk2(s[0 * 33], s[1 * 33]); o.y = pk2(s[2 * 33], s[3 * 33]); o.z = pk2(s[4 * 33], s[5 * 33]); o.w = pk2(s[6 * 33], s[7 * 33]);
        *(GAS v4u*)(WT + (size_t)(n0 + n) * K + k0 + 8 * c) = o; }
    LDS_WAIT(); asm volatile("" ::: "memory");
}

__device__ __forceinline__ void p0_mod_unit(int u, const float* cvec, const float* w_ada, const float* b_ada, float* mod, LAS float* lds, int tid, int wave, int lane) {
    LAS float* sc = lds; LAS float* red = lds + 2048;
    for (int i = tid; i < 2048; i += NTHREADS) { const float v = cvec[i]; sc[i] = v / (1.f + expf(-v)); }
    __syncthreads();
    const int l = u / 96, n = (u % 96) * 64 + lane;
    const float* wp = w_ada + ((size_t)l * 1024 + wave * 128) * 6144 + n;
    float a0 = 0.f, a1 = 0.f;
#pragma unroll 16
    for (int kk = 0; kk < 128; ++kk) { const float w = wp[(size_t)kk * 6144]; a0 += sc[wave * 128 + kk] * w; a1 += sc[1024 + wave * 128 + kk] * w; }
    red[(wave * 2 + 0) * 64 + lane] = a0; red[(wave * 2 + 1) * 64 + lane] = a1;
    __syncthreads();
    if (tid < 128) { const int b = tid >> 6; float s = 0.f;
#pragma unroll
        for (int w = 0; w < 8; ++w) s += red[(w * 2 + b) * 64 + lane];
        mod[((size_t)l * 2 + b) * 6144 + n] = s + b_ada[l * 6144 + n]; }
    __syncthreads();
}

__device__ __forceinline__ void norm_rows(const float* xsrc, const float* g, const float* mod_l, int sh_off, int sc_off, bf16* XN, int gw, int NGW, int lane) {
    for (int m = gw; m < MROWS; m += NGW) {
        const int b = m / SEQ; const float* mb = mod_l + (size_t)b * 6144;
        const GAS f32x4* xr = (const GAS f32x4*)(xsrc + (size_t)m * DM) + lane;
        f32x4 v[4]; float ss = 0.f;
#pragma unroll
        for (int j = 0; j < 4; ++j) { v[j] = xr[64 * j]; ss += (v[j].x * v[j].x + v[j].y * v[j].y) + (v[j].z * v[j].z + v[j].w * v[j].w); }
        const float rstd = 1.f / sqrtf(wave_sum(ss) * (1.f / DM) + EPS);
        GAS v2u* o8 = (GAS v2u*)(XN + (size_t)m * DM) + lane;
#pragma unroll
        for (int j = 0; j < 4; ++j) { const int col = 4 * lane + 256 * j;
            const f32x4 gg = *(const f32x4*)(g + col), sv = *(const f32x4*)(mb + sc_off + col), hv = *(const f32x4*)(mb + sh_off + col);
            const f32x4 o = v[j] * rstd * gg * (sv + 1.0f) + hv;
            v2u w; w.x = pk2(o.x, o.y); w.y = pk2(o.z, o.w); o8[64 * j] = w; }
    }
}

__device__ __forceinline__ void post_foxcum_unit(int bh, const float* GATESp, float* FOXCUMp, const float* fox_f_bias, LAS float* lds, int tid, int wave, int lane) {
    const int b = bh / 6, h = bh % 6; const float bias = fox_f_bias[h];
    float v[32];
#pragma unroll
    for (int r = 0; r < 32; ++r) { const int t = wave * 2048 + r * 64 + lane; v[r] = log_sigmoid_f(GATESp[((size_t)b * SEQ + t) * 16 + h] + bias) * LOG2E; }
    float carry = 0.f;
#pragma unroll
    for (int r = 0; r < 32; ++r) { float x = v[r];
#pragma unroll
        for (int o = 1; o < 64; o <<= 1) { const float n = sup(x, o, lane); if (lane >= o) x += n; }
        x += carry; v[r] = x; carry = shf(x, 63); }
    if (lane == 0) lds[wave] = carry;
    __syncthreads();
    float off = 0.f;
    for (int w = 0; w < wave; ++w) off += lds[w];
#pragma unroll
    for (int r = 0; r < 32; ++r) FOXCUMp[(size_t)bh * SEQ + wave * 2048 + r * 64 + lane] = v[r] + off;
    __syncthreads();
}
__device__ __forceinline__ void post_qknorm_unit(int u, bf16* PROJp, float* KMEANP, const float* gfq, const float* gfk, const float* gbq, const float* gbk, LAS float* lds, int tid, int wave, int lane) {
    const int blk = u >> 1, half = u & 1, sub = lane & 7;
    int colv[3]; float gv[3][8]; float qsv[3];
#pragma unroll
    for (int it = 0; it < 3; ++it) { const int hsel = it * 8 + (lane >> 3), grp = hsel / 6, hh = hsel % 6;
        colv[it] = (grp == 0 ? C_FQ : grp == 1 ? C_FK : grp == 2 ? C_BQ : C_BK) + hh * 64 + 8 * sub;
        const float* gp = (grp == 0 ? gfq : grp == 1 ? gfk : grp == 2 ? gbq : gbk) + 8 * sub;
#pragma unroll
        for (int i = 0; i < 8; ++i) gv[it][i] = gp[i];
        qsv[it] = (grp == 0 || grp == 2) ? QSCALE : 1.f; }
    float ka[8] = {0.f, 0.f, 0.f, 0.f, 0.f, 0.f, 0.f, 0.f};
    const size_t row0 = (size_t)blk * 256 + half * 128 + wave * 16;
#pragma unroll 4
    for (int r = 0; r < 16; ++r) {
#pragma unroll
        for (int it = 0; it < 3; ++it) {
            v4u* p = (v4u*)(PROJp + (row0 + r) * PLD + colv[it]);
            float f[8]; unpack8(*p, f);
            float ss = 0.f;
#pragma unroll
            for (int i = 0; i < 8; ++i) ss += f[i] * f[i];
            ss += SWZ_X(ss, 1); ss += SWZ_X(ss, 2); ss += SWZ_X(ss, 4);
            const float rr = 1.f / sqrtf(ss * (1.f / 64.f) + EPS);
#pragma unroll
            for (int i = 0; i < 8; ++i) f[i] = f[i] * rr * gv[it][i];
            if (it == 2) {
#pragma unroll
                for (int i = 0; i < 8; ++i) ka[i] += f[i]; }
            const float qs = qsv[it];
            v4u w; w.x = pk2(f[0] * qs, f[1] * qs); w.y = pk2(f[2] * qs, f[3] * qs); w.z = pk2(f[4] * qs, f[5] * qs); w.w = pk2(f[6] * qs, f[7] * qs);
            *p = w;
        }
    }
    if (lane >= 16) {
#pragma unroll
        for (int i = 0; i < 8; ++i) lds[wave * 384 + ((lane >> 3) - 2) * 64 + 8 * sub + i] = ka[i]; }
    __syncthreads();
    if (tid < 384) { float s = 0.f;
#pragma unroll
        for (int w = 0; w < 8; ++w) s += lds[w * 384 + tid];
        const int b = blk / NBLK, n = blk % NBLK, head = tid >> 6, dd = tid & 63;
        KMEANP[(size_t)half * (12 * NBLK * 64) + (((size_t)b * 6 + head) * NBLK + n) * 64 + dd] = s * (1.f / 256.f); }
    __syncthreads();
}
__device__ __forceinline__ void post_conv_unit(int blk, int which, const bf16* PROJp, bf16* dst, const float* conv_w, const float* conv_b, int tid) {
    const bf16* src = PROJp + (which ? C_MK : C_MQ); const float osc = which ? 0.125f : 1.f;
    const int c = 8 * (tid & 31), rs = tid >> 5, ch = which * 256 + c;
    const size_t r0 = (size_t)blk * 256 + rs * 16; const int tl = (int)(r0 % SEQ);
    float w[4][8], bb[8];
#pragma unroll
    for (int i = 0; i < 4; ++i) { const f32x4 a = *(const f32x4*)(conv_w + i * 512 + ch), b2 = *(const f32x4*)(conv_w + i * 512 + ch + 4);
        w[i][0] = a.x; w[i][1] = a.y; w[i][2] = a.z; w[i][3] = a.w; w[i][4] = b2.x; w[i][5] = b2.y; w[i][6] = b2.z; w[i][7] = b2.w; }
    { const f32x4 a = *(const f32x4*)(conv_b + ch), b2 = *(const f32x4*)(conv_b + ch + 4); bb[0] = a.x; bb[1] = a.y; bb[2] = a.z; bb[3] = a.w; bb[4] = b2.x; bb[5] = b2.y; bb[6] = b2.z; bb[7] = b2.w; }
    float x0[8], x1[8], x2[8], x3[8];
    { v4u h3[3];
#pragma unroll
      for (int k = 0; k < 3; ++k) { if (tl + k - 3 >= 0) h3[k] = *(const v4u*)(src + (r0 + k - 3) * PLD + c); else h3[k] = (v4u){0u, 0u, 0u, 0u}; }
      unpack8(h3[0], x0); unpack8(h3[1], x1); unpack8(h3[2], x2); }
#pragma unroll 1
    for (int hb = 0; hb < 2; ++hb) {
        v4u in[8];
#pragma unroll
        for (int k = 0; k < 8; ++k) in[k] = *(const v4u*)(src + (r0 + hb * 8 + k) * PLD + c);
#pragma unroll
        for (int r = 0; r < 8; ++r) {
            unpack8(in[r], x3);
            float y[8];
#pragma unroll
            for (int i = 0; i < 8; ++i) { const float t = bb[i] + w[0][i] * x0[i] + w[1][i] * x1[i] + w[2][i] * x2[i] + w[3][i] * x3[i];
                y[i] = t * __builtin_amdgcn_rcpf(1.f + __builtin_amdgcn_exp2f(-t * LOG2E)) * osc; x0[i] = x1[i]; x1[i] = x2[i]; x2[i] = x3[i]; }
            v4u o; o.x = pk2(y[0], y[1]); o.y = pk2(y[2], y[3]); o.z = pk2(y[4], y[5]); o.w = pk2(y[6], y[7]);
            *(v4u*)(dst + (r0 + hb * 8 + r) * 256 + c) = o;
        }
    }
}

struct MlP { const bf16* PROJ; const bf16* QC; const bf16* KC; const float* GATES; float* U; float* NU; float* BEND; float* MLOC; bf16* CS; float* NS; float* MS; bf16* Y;
             const float *ibias, *fbias, *hg; };
__device__ __forceinline__ void mlstm_m1(int ci, const MlP& P, LAS float* lds, int tid, int wave, int lane) {
    const int b = ci >> 10, h = (ci >> 8) & 3, c = ci & 255; const size_t row0 = (size_t)b * SEQ + c * 64;
    LAS float* Ks = lds; LAS float* Vs = lds + 4096; LAS float* ws = lds + 8192;
    { const int r = tid >> 3, cg = (tid & 7) * 8; float f[8];
      unpack8(*(const v4u*)(P.KC + (row0 + r) * 256 + h * 64 + cg), f);
#pragma unroll
      for (int i = 0; i < 8; ++i) Ks[r * 64 + cg + i] = f[i];
      unpack8(*(const v4u*)(P.PROJ + (row0 + r) * PLD + C_MV + h * 64 + cg), f);
#pragma unroll
      for (int i = 0; i < 8; ++i) Vs[r * 64 + cg + i] = f[i]; }
    if (wave == 0) {
        const size_t row = row0 + lane;
        const float fi = P.GATES[row * 16 + 6 + h] + P.ibias[h], ff = P.GATES[row * 16 + 10 + h] + P.fbias[h];
        float bc = log_sigmoid_f(ff);
#pragma unroll
        for (int o = 1; o < 64; o <<= 1) { const float n = sup(bc, o, lane); if (lane >= o) bc += n; }
        const float bend = shf(bc, 63);
        const float wl = bend - bc + fi; const float mloc = wave_max(wl);
        ws[lane] = expf(wl - mloc);
        if (lane == 0) { P.BEND[ci] = bend; P.MLOC[ci] = mloc; }
    }
    __syncthreads();
    { const int dv = tid >> 3, e0 = (tid & 7) * 8; float u[8] = {0.f, 0.f, 0.f, 0.f, 0.f, 0.f, 0.f, 0.f};
#pragma unroll 2
      for (int s = 0; s < 64; ++s) { const float vw = Vs[s * 64 + dv] * ws[s]; const f32x4 ka = *(const LAS f32x4*)(Ks + s * 64 + e0), kb = *(const LAS f32x4*)(Ks + s * 64 + e0 + 4);
          u[0] += vw * ka.x; u[1] += vw * ka.y; u[2] += vw * ka.z; u[3] += vw * ka.w; u[4] += vw * kb.x; u[5] += vw * kb.y; u[6] += vw * kb.z; u[7] += vw * kb.w; }
      float* up = P.U + (size_t)ci * 4096 + dv * 64 + e0;
      *(f32x4*)up = (f32x4){u[0], u[1], u[2], u[3]}; *(f32x4*)(up + 4) = (f32x4){u[4], u[5], u[6], u[7]}; }
    if (tid < 64) { float nu = 0.f; for (int s = 0; s < 64; ++s) nu += ws[s] * Ks[s * 64 + tid]; P.NU[(size_t)ci * 64 + tid] = nu; }
    __syncthreads();
}
__device__ __forceinline__ void mlstm_m2(int u, const MlP& P, int tid) {
    const int bh = u >> 3, eg = u & 7, elem = eg * 512 + tid, base = bh * 256;
    const bool donorm = (eg == 0 && tid < 64), doms = (eg == 0 && tid == 0);
    float C = 0.f, m = 0.f, nst = 0.f;
    for (int c0 = 0; c0 < 256; c0 += 8) {
        float uv[8], be[8], ml[8], nv[8];
#pragma unroll
        for (int i = 0; i < 8; ++i) { const int ci = base + c0 + i; uv[i] = P.U[(size_t)ci * 4096 + elem]; be[i] = P.BEND[ci]; ml[i] = P.MLOC[ci]; nv[i] = donorm ? P.NU[(size_t)ci * 64 + tid] : 0.f; }
#pragma unroll
        for (int i = 0; i < 8; ++i) { const int ci = base + c0 + i;
            P.CS[(size_t)ci * 4096 + elem] = (bf16)f2bf(C);
            if (donorm) P.NS[(size_t)ci * 64 + tid] = nst;
            if (doms) P.MS[ci] = m;
            const float mn = fmaxf(be[i] + m, ml[i]); const float dec = expf(be[i] + m - mn), wu = expf(ml[i] - mn);
            C = dec * C + wu * uv[i]; nst = dec * nst + wu * nv[i]; m = mn; }
    }
}
__device__ __forceinline__ void mlstm_m3(int ci, const MlP& P, LAS float* lds, int tid, int wave, int lane) {
    constexpr int LP = 68;
    const int b = ci >> 10, h = (ci >> 8) & 3, c = ci & 255; const size_t row0 = (size_t)b * SEQ + c * 64;
    LAS float* Qs = lds; LAS float* Ks = Qs + 64 * LP; LAS float* Cs = Ks + 64 * LP; LAS float* Sm = Cs + 64 * LP; LAS float* Vs = Sm + 64 * LP;
    LAS float* av = Vs + 4096; LAS float* gv = av + 64; LAS float* bcv = gv + 64; LAS float* nsv = bcv + 64;
    const float ms = P.MS[ci];
    { const int r = tid >> 3, cg = (tid & 7) * 8; float f[8];
      unpack8(*(const v4u*)(P.QC + (row0 + r) * 256 + h * 64 + cg), f);
#pragma unroll
      for (int i = 0; i < 8; ++i) Qs[r * LP + cg + i] = f[i];
      unpack8(*(const v4u*)(P.KC + (row0 + r) * 256 + h * 64 + cg), f);
#pragma unroll
      for (int i = 0; i < 8; ++i) Ks[r * LP + cg + i] = f[i];
      unpack8(*(const v4u*)(P.PROJ + (row0 + r) * PLD + C_MV + h * 64 + cg), f);
#pragma unroll
      for (int i = 0; i < 8; ++i) Vs[r * 64 + cg + i] = f[i];
      unpack8(*(const v4u*)(P.CS + (size_t)ci * 4096 + r * 64 + cg), f);
#pragma unroll
      for (int i = 0; i < 8; ++i) Cs[r * LP + cg + i] = f[i]; }
    if (wave == 0) {
        const size_t row = row0 + lane;
        const float fi = P.GATES[row * 16 + 6 + h] + P.ibias[h], ff = P.GATES[row * 16 + 10 + h] + P.fbias[h];
        float bc = log_sigmoid_f(ff);
#pragma unroll
        for (int o = 1; o < 64; o <<= 1) { const float n = sup(bc, o, lane); if (lane >= o) bc += n; }
        const float a = fi - bc; float pm = a;
#pragma unroll
        for (int o = 1; o < 64; o <<= 1) { const float n = sup(pm, o, lane); if (lane >= o) pm = fmaxf(pm, n); }
        av[lane] = a; gv[lane] = fmaxf(ms, pm); bcv[lane] = bc; nsv[lane] = P.NS[(size_t)ci * 64 + lane];
    }
    __syncthreads();
    const int j = tid >> 3, part = tid & 7, s0 = part * 8;
    const float gj = gv[j];
    { float sacc[8] = {0.f, 0.f, 0.f, 0.f, 0.f, 0.f, 0.f, 0.f};
#pragma unroll 1
      for (int e = 0; e < 64; e += 4) { const f32x4 q4 = *(const LAS f32x4*)(Qs + j * LP + e);
#pragma unroll
          for (int i = 0; i < 8; ++i) { const f32x4 k4 = *(const LAS f32x4*)(Ks + (s0 + i) * LP + e); sacc[i] += (q4.x * k4.x + q4.y * k4.y) + (q4.z * k4.z + q4.w * k4.w); } }
#pragma unroll
      for (int i = 0; i < 8; ++i) { const int s = s0 + i; Sm[j * LP + s] = (s <= j) ? sacc[i] * expf(av[s] - gj) : 0.f; } }
    __syncthreads();
    { const int dv0 = part * 8; float t1[8] = {0.f, 0.f, 0.f, 0.f, 0.f, 0.f, 0.f, 0.f}, t2[8] = {0.f, 0.f, 0.f, 0.f, 0.f, 0.f, 0.f, 0.f};
#pragma unroll 1
      for (int e = 0; e < 64; e += 4) { const f32x4 q4 = *(const LAS f32x4*)(Qs + j * LP + e);
#pragma unroll
          for (int i = 0; i < 8; ++i) { const f32x4 c4 = *(const LAS f32x4*)(Cs + (dv0 + i) * LP + e); t1[i] += (q4.x * c4.x + q4.y * c4.y) + (q4.z * c4.z + q4.w * c4.w); } }
#pragma unroll 2
      for (int s = 0; s < 64; ++s) { const float sm = Sm[j * LP + s]; const f32x4 va = *(const LAS f32x4*)(Vs + s * 64 + dv0), vb = *(const LAS f32x4*)(Vs + s * 64 + dv0 + 4);
          t2[0] += sm * va.x; t2[1] += sm * va.y; t2[2] += sm * va.z; t2[3] += sm * va.w; t2[4] += sm * vb.x; t2[5] += sm * vb.y; t2[6] += sm * vb.z; t2[7] += sm * vb.w; }
      float dn = 0.f, ssum = 0.f;
#pragma unroll
      for (int i = 0; i < 8; ++i) { dn += nsv[s0 + i] * Qs[j * LP + s0 + i]; ssum += Sm[j * LP + s0 + i]; }
      { dn += SWZ_X(dn, 1); ssum += SWZ_X(ssum, 1); dn += SWZ_X(dn, 2); ssum += SWZ_X(ssum, 2); dn += SWZ_X(dn, 4); ssum += SWZ_X(ssum, 4); }
      const float inter = expf(ms - gj), mj = bcv[j] + gj;
      const float den = inter * dn + ssum, dd = fmaxf(fabsf(den), expf(-mj)), rd = 1.f / dd;
      float hv[8], ss = 0.f;
#pragma unroll
      for (int i = 0; i < 8; ++i) { hv[i] = (inter * t1[i] + t2[i]) * rd; ss += hv[i] * hv[i]; }
      { ss += SWZ_X(ss, 1); ss += SWZ_X(ss, 2); ss += SWZ_X(ss, 4); }
      const float rr = 1.f / sqrtf(ss * (1.f / 64.f) + EPS);
      float mo[8]; unpack8(*(const v4u*)(P.PROJ + (row0 + j) * PLD + C_MO + h * 64 + dv0), mo);
      float y[8];
#pragma unroll
      for (int i = 0; i < 8; ++i) y[i] = hv[i] * rr * P.hg[h * 64 + dv0 + i] * sigmoid_f(mo[i]);
      v4u w; w.x = pk2(y[0], y[1]); w.y = pk2(y[2], y[3]); w.z = pk2(y[4], y[5]); w.w = pk2(y[6], y[7]);
      *(v4u*)(P.Y + (row0 + j) * 1024 + Y_ML + h * 64 + dv0) = w; }
    __syncthreads();
}

__device__ __forceinline__ size_t moba_list_off(int bh, int n);
__device__ __forceinline__ void moba_gate_unit(int u, const bf16* PROJ, const float* KMEAN, unsigned* SEL, unsigned* LCNT, unsigned* CTAB, unsigned short* LIST, float B2, float thresh2, LAS float* lds, int tid) {
    const int bh = u >> 6, qb = 63 - (u & 63), b = bh / 6, h = bh % 6;
    LAS float* km = lds; LAS float* cand = lds + 4096; LAS unsigned* cntl = (LAS unsigned*)(lds + 4096 + 1536);
    if (tid < 64) cntl[tid] = 0u;
    for (int i = tid; i < qb * 16; i += NTHREADS) *(LAS f32x4*)(km + i * 4) = *(const f32x4*)(KMEAN + (size_t)bh * NBLK * 64 + i * 4) + *(const f32x4*)(KMEAN + (size_t)(12 * NBLK * 64) + (size_t)bh * NBLK * 64 + i * 4);
    __syncthreads();
    const int query = tid & 255, half = tid >> 8; const size_t row = (size_t)b * SEQ + qb * 256 + query;
    float q[64];
#pragma unroll
    for (int i = 0; i < 8; ++i) unpack8(*(const v4u*)(PROJ + row * PLD + C_BQ + h * 64 + i * 8), q + i * 8);
    float v0 = -INFINITY, v1 = -INFINITY, v2 = -INFINITY; int i0 = 255, i1 = 255, i2 = 255;
    const int nlo = half * 32, nhi = (qb < nlo + 32) ? qb : nlo + 32;
    for (int n = nlo; n < nhi; ++n) { float g = 0.f;
#pragma unroll
        for (int d = 0; d < 64; d += 4) { const f32x4 k4 = *(const LAS f32x4*)(km + n * 64 + d); g += (q[d] * k4.x + q[d + 1] * k4.y) + (q[d + 2] * k4.z + q[d + 3] * k4.w); }
        if (g > v0) { v2 = v1; i2 = i1; v1 = v0; i1 = i0; v0 = g; i0 = n; } else if (g > v1) { v2 = v1; i2 = i1; v1 = g; i1 = n; } else if (g > v2) { v2 = g; i2 = n; } }
    if (half == 1) { cand[query * 6 + 0] = v0; cand[query * 6 + 1] = v1; cand[query * 6 + 2] = v2;
        cand[query * 6 + 3] = __int_as_float(i0); cand[query * 6 + 4] = __int_as_float(i1); cand[query * 6 + 5] = __int_as_float(i2); }
    __syncthreads();
    if (half == 0) {
#pragma unroll
        for (int k = 0; k < 3; ++k) { const float g = cand[query * 6 + k]; const int n = __float_as_int(cand[query * 6 + 3 + k]);
            if (n != 255) { if (g > v0) { v2 = v1; i2 = i1; v1 = v0; i1 = i0; v0 = g; i0 = n; } else if (g > v1) { v2 = v1; i2 = i1; v1 = g; i1 = n; } else if (g > v2) { v2 = g; i2 = n; } } }
        { const float slope2 = exp2f(-8.f * (float)(h + 1) / 6.f) * LOG2E; const float lim = (2.f * B2 + thresh2) / slope2; const int t0 = qb * 256 + query - 255;
          if (i0 != 255 && (float)(t0 - i0 * 256) > lim) i0 = 255;
          if (i1 != 255 && (float)(t0 - i1 * 256) > lim) i1 = 255;
          if (i2 != 255 && (float)(t0 - i2 * 256) > lim) i2 = 255; }
        SEL[row * 6 + h] = (unsigned)i0 | ((unsigned)i1 << 8) | ((unsigned)i2 << 16);
        if (LIST) { const unsigned t = (unsigned)(qb * 256 + query);
            if (i0 != 255) { const unsigned pos = __hip_atomic_fetch_add(cntl + i0, 1u, __ATOMIC_RELAXED, __HIP_MEMORY_SCOPE_WORKGROUP); LIST[moba_list_off(bh, i0) + (size_t)(qb - i0 - 1) * 256 + pos] = (unsigned short)(t | (0u << 14)); }
            if (i1 != 255) { const unsigned pos = __hip_atomic_fetch_add(cntl + i1, 1u, __ATOMIC_RELAXED, __HIP_MEMORY_SCOPE_WORKGROUP); LIST[moba_list_off(bh, i1) + (size_t)(qb - i1 - 1) * 256 + pos] = (unsigned short)(t | (1u << 14)); }
            if (i2 != 255) { const unsigned pos = __hip_atomic_fetch_add(cntl + i2, 1u, __ATOMIC_RELAXED, __HIP_MEMORY_SCOPE_WORKGROUP); LIST[moba_list_off(bh, i2) + (size_t)(qb - i2 - 1) * 256 + pos] = (unsigned short)(t | (2u << 14)); } }
    }
    __syncthreads();
    if (LIST && tid < 64) { const unsigned c = cntl[tid]; CTAB[((size_t)bh * 64 + qb) * 64 + tid] = c; if (c) atomicAdd(LCNT + bh * 64 + tid, c); }
    __syncthreads();
}

__device__ __forceinline__ void fox_naive(const bf16* PROJ, const float* FOXCUM, bf16* Y, int gw, int NGW, int lane) {
    for (int idx = gw; idx < 12 * SEQ; idx += NGW) {
        const int t = SEQ - 1 - idx / 12, bh = idx % 12, b = bh / 6, h = bh % 6; const size_t rb = (size_t)b * SEQ;
        const float qv = bf2f(PROJ[(rb + t) * PLD + C_FQ + h * 64 + lane]); const float ct = FOXCUM[(size_t)bh * SEQ + t];
        float m = -INFINITY, l = 0.f, acc = 0.f;
#pragma unroll 4
        for (int j = 0; j <= t; ++j) {
            const float kv = bf2f(PROJ[(rb + j) * PLD + C_FK + h * 64 + lane]), vv = bf2f(PROJ[(rb + j) * PLD + C_FV + h * 64 + lane]);
            const float s = wave_sum(qv * kv) + (ct - FOXCUM[(size_t)bh * SEQ + j]);
            const float mn = fmaxf(m, s), sc = exp2f(m - mn), p = exp2f(s - mn);
            l = l * sc + p; acc = acc * sc + p * vv; m = mn; }
        Y[(rb + t) * 1024 + Y_FOX + h * 64 + lane] = (bf16)f2bf(acc / l);
    }
}
__device__ __forceinline__ void moba_naive(const bf16* PROJ, const unsigned* SEL, bf16* Y, int gw, int NGW, int lane) {
    for (int idx = gw; idx < 12 * SEQ; idx += NGW) {
        const int t = SEQ - 1 - idx / 12, bh = idx % 12, b = bh / 6, h = bh % 6; const size_t rb = (size_t)b * SEQ;
        const float slope2 = exp2f(-8.f * (float)(h + 1) / 6.f) * LOG2E;
        const float qv = bf2f(PROJ[(rb + t) * PLD + C_BQ + h * 64 + lane]);
        const unsigned sel = SEL[(rb + t) * 6 + h];
        float m = -INFINITY, l = 0.f, acc = 0.f;
        for (int slot = 0; slot < 4; ++slot) {
            int j0, j1;
            if (slot < 3) { const int n = (sel >> (8 * slot)) & 0xff; if (n == 255) continue; j0 = n * 256; j1 = j0 + 256; } else { j0 = (t >> 8) * 256; j1 = t + 1; }
#pragma unroll 4
            for (int j = j0; j < j1; ++j) {
                const float kv = bf2f(PROJ[(rb + j) * PLD + C_BK + h * 64 + lane]), vv = bf2f(PROJ[(rb + j) * PLD + C_BV + h * 64 + lane]);
                const float s = wave_sum(qv * kv) - slope2 * (float)(t - j);
                const float mn = fmaxf(m, s), sc = exp2f(m - mn), p = exp2f(s - mn);
                l = l * sc + p; acc = acc * sc + p * vv; m = mn; }
        }
        Y[(rb + t) * 1024 + Y_MOBA + h * 64 + lane] = (bf16)f2bf(acc / l);
    }
}
typedef short v4i16_t __attribute__((ext_vector_type(4)));
typedef short s16x4 __attribute__((ext_vector_type(4)));
constexpr int ATT_K0 = 0, ATT_V0 = 32768, ATT_TAB = 132096;
#ifndef THRESH_NAT
#define THRESH_NAT 30.f
#endif
constexpr float THRESH2 = THRESH_NAT * LOG2E;

__device__ __forceinline__ int crow(int r, int hi) { return (r & 3) + 8 * (r >> 2) + 4 * hi; }
__device__ __forceinline__ s16x4 vtr(LAS const unsigned char* p) { return __builtin_bit_cast(s16x4, __builtin_amdgcn_ds_read_tr16_b64_v4i16((LAS v4i16_t*)p)); }
typedef float f32x2_t __attribute__((ext_vector_type(2))); typedef __bf16 bf16x2_t __attribute__((ext_vector_type(2)));
#ifndef CVT_ASM
#define CVT_ASM 0
#endif
#if CVT_ASM
__device__ __forceinline__ unsigned cvtpk(float lo, float hi) { unsigned r; asm volatile("v_cvt_pk_bf16_f32 %0, %1, %2\n\ts_nop 1" : "=v"(r) : "v"(lo), "v"(hi)); return r; }
#else
__device__ __forceinline__ unsigned cvtpk(float lo, float hi) { const f32x2_t v = {lo, hi}; const bf16x2_t b = __builtin_convertvector(v, bf16x2_t); return __builtin_bit_cast(unsigned, b); }
#endif

__device__ __forceinline__ void load_group(const bf16* Kg, const bf16* Vg, LAS unsigned char* kv, int tid) {
#pragma unroll
    for (int i = 0; i < 4; ++i) { const int idx = tid + NTHREADS * i, row = idx >> 3, ch = idx & 7;
        const v4u k = *(const v4u*)(Kg + (size_t)row * PLD + ch * 8), v = *(const v4u*)(Vg + (size_t)row * PLD + ch * 8);
        *(LAS v4u*)(kv + ATT_K0 + row * 128 + ((ch ^ ((row >> 1) & 7)) << 4)) = k;
        *(LAS v4u*)(kv + ATT_V0 + row * 128 + ((ch * 16) ^ (((row >> 1) & 1) << 6))) = v; }
}

template <bool FOX>
__device__ __forceinline__ void attn_subtile(LAS const unsigned char* kv, LAS const float* colt, int j0, const bf16x8 (&qf)[4], float rowterm, float slope2, bool mask, int qrel,
                                             f32x16 (&o)[2], float& l, int lane) {
    const int r32 = lane & 31, hh = lane >> 5;
    f32x16 acc;
    if (FOX) {
#pragma unroll
        for (int g = 0; g < 4; ++g) { const f32x4 c = *(LAS const f32x4*)(colt + j0 + 8 * g + 4 * hh); acc[4 * g + 0] = rowterm + c.x; acc[4 * g + 1] = rowterm + c.y; acc[4 * g + 2] = rowterm + c.z; acc[4 * g + 3] = rowterm + c.w; }
    } else {
#pragma unroll
        for (int r = 0; r < 16; ++r) acc[r] = rowterm + slope2 * (float)(j0 + crow(r, hh));
    }
    if (mask) {
#pragma unroll
        for (int r = 0; r < 16; ++r) if (j0 + crow(r, hh) > qrel) acc[r] = -INFINITY;
    }
    { const int row = j0 + r32; LAS const unsigned char* kr = kv + ATT_K0 + row * 128; const int sw = (row >> 1) & 7;
#pragma unroll
      for (int s = 0; s < 4; ++s) { const bf16x8 kf = *(LAS const bf16x8*)(kr + (((2 * s + hh) ^ sw) << 4)); acc = __builtin_amdgcn_mfma_f32_32x32x16_bf16(kf, qf[s], acc, 0, 0, 0); } }
    float ls = 0.f;
#pragma unroll
    for (int r = 0; r < 16; ++r) { acc[r] = __builtin_amdgcn_exp2f(acc[r]); ls += acc[r]; }
    l += ls;
    bf16x8 pa[2];
#pragma unroll
    for (int s = 0; s < 2; ++s) { v4u w; w.x = cvtpk(acc[8 * s + 0], acc[8 * s + 1]); w.y = cvtpk(acc[8 * s + 2], acc[8 * s + 3]); w.z = cvtpk(acc[8 * s + 4], acc[8 * s + 5]); w.w = cvtpk(acc[8 * s + 6], acc[8 * s + 7]); pa[s] = __builtin_bit_cast(bf16x8, w); }
    { const int i = lane & 15, c = (lane >> 4) & 1;
#pragma unroll
      for (int db = 0; db < 2; ++db)
#pragma unroll
          for (int s = 0; s < 2; ++s) { const int rowv = j0 + 16 * s + 4 * hh + (i >> 2); const int colb = (32 * db + 16 * c + 4 * (i & 3)) * 2;
              LAS const unsigned char* vp = kv + ATT_V0 + rowv * 128 + (colb ^ (((rowv >> 1) & 1) << 6));
              const s16x4 lo = vtr(vp), hi = vtr(vp + 8 * 128);
              const bf16x8 vf = (bf16x8){lo[0], lo[1], lo[2], lo[3], hi[0], hi[1], hi[2], hi[3]};
              o[db] = __builtin_amdgcn_mfma_f32_32x32x16_bf16(pa[s], vf, o[db], 0, 0, 0); } }
}
__device__ __forceinline__ float rfl(float x) { return __builtin_bit_cast(float, __builtin_amdgcn_readfirstlane(__builtin_bit_cast(int, x))); }

__device__ __forceinline__ void fox_unit(int bh, int qb, const bf16* PROJ, const float* FOXCUM, bf16* Y, float B2, LAS unsigned char* lds, int tid, int wave, int lane) {
    const int b = bh / 6, h = bh % 6; const size_t rb = (size_t)b * SEQ; const int r32 = lane & 31, hh = lane >> 5;
    const int q0w = qb * 256 + wave * 32, qpos = q0w + r32;
    const float* cum = FOXCUM + (size_t)bh * SEQ;
    bf16x8 qf[4];
#pragma unroll
    for (int s = 0; s < 4; ++s) qf[s] = *(const bf16x8*)(PROJ + (rb + qpos) * PLD + C_FQ + h * 64 + 16 * s + 8 * hh);
    const float cq = cum[qpos];
    const float cq_first = rfl(cum[q0w]), cq_blk = rfl(cum[qb * 256]);
    const float rowterm = cq - B2, lim = -THRESH2 - 2.f * B2;
    f32x16 o[2]; float l = 0.f;
#pragma unroll
    for (int r = 0; r < 16; ++r) { o[0][r] = 0.f; o[1][r] = 0.f; }
    LAS float* coltA = (LAS float*)(lds + ATT_TAB); LAS float* coltB = coltA + 256;
    LAS unsigned char* kvA = lds; LAS unsigned char* kvB = lds + 65536;
#ifndef FOX_2G
#define FOX_2G 1
#endif
    const bool haveB = FOX_2G && (qb > 0) && !(cq_blk - rfl(cum[qb * 256 - 1]) < lim);
    load_group(PROJ + (rb + (size_t)qb * 256) * PLD + C_FK + h * 64, PROJ + (rb + (size_t)qb * 256) * PLD + C_FV + h * 64, kvA, tid);
    if (tid < 256) coltA[tid] = -cum[qb * 256 + tid];
    if (haveB) { load_group(PROJ + (rb + (size_t)(qb - 1) * 256) * PLD + C_FK + h * 64, PROJ + (rb + (size_t)(qb - 1) * 256) * PLD + C_FV + h * 64, kvB, tid);
        if (tid < 256) coltB[tid] = -cum[(qb - 1) * 256 + tid]; }
    __syncthreads();
#pragma unroll 1
    for (int st = wave; st >= 0; --st) {
        const int j0 = 32 * st;
        if (cq_first + rfl(coltA[j0 + 31]) < lim) break;
        attn_subtile<true>(kvA, coltA, j0, qf, rowterm, 0.f, st == wave, wave * 32 + r32, o, l, lane);
    }
    if (haveB) {
#pragma unroll 1
        for (int st = 7; st >= 0; --st) {
            const int j0 = 32 * st;
            if (cq_first + rfl(coltB[j0 + 31]) < lim) break;
            attn_subtile<true>(kvB, coltB, j0, qf, rowterm, 0.f, false, 0, o, l, lane);
        }
    }
    __syncthreads();
    {
        for (int g = haveB ? qb - 2 : qb - 1; g >= 0; --g) {
            if (cq_blk - rfl(cum[g * 256 + 255]) < lim) break;
            load_group(PROJ + (rb + (size_t)g * 256) * PLD + C_FK + h * 64, PROJ + (rb + (size_t)g * 256) * PLD + C_FV + h * 64, kvA, tid);
            if (tid < 256) coltA[tid] = -cum[g * 256 + tid];
            __syncthreads();
            {
#pragma unroll 1
                for (int st = 7; st >= 0; --st) {
                    const int j0 = 32 * st;
                    if (cq_first + rfl(coltA[j0 + 31]) < lim) break;
                    attn_subtile<true>(kvA, coltA, j0, qf, rowterm, 0.f, false, 0, o, l, lane);
                }
            }
            __syncthreads();
        }
    }
    l = half_sum(l, lane);
    bf16* yp = Y + (rb + (size_t)q0w) * 1024 + Y_FOX + h * 64 + r32;
#pragma unroll
    for (int r = 0; r < 16; ++r) { const int q = crow(r, hh); const float rl = 1.f / shf(l, q);
        yp[(size_t)q * 1024] = (bf16)f2bf(o[0][r] * rl); yp[(size_t)q * 1024 + 32] = (bf16)f2bf(o[1][r] * rl); }
}

__device__ __forceinline__ void fox_unit_old(int bh, int qb, const bf16* PROJ, const float* FOXCUM, bf16* Y, float B2, LAS unsigned char* lds, int tid, int wave, int lane) {
    const int b = bh / 6, h = bh % 6; const size_t rb = (size_t)b * SEQ; const int r32 = lane & 31, hh = lane >> 5;
    const int q0w = qb * 256 + wave * 32, qpos = q0w + r32;
    const float* cum = FOXCUM + (size_t)bh * SEQ;
    bf16x8 qf[4];
#pragma unroll
    for (int s = 0; s < 4; ++s) qf[s] = *(const bf16x8*)(PROJ + (rb + qpos) * PLD + C_FQ + h * 64 + 16 * s + 8 * hh);
    const float cq = cum[qpos];
    const float cq_first = rfl(cum[q0w]);
    const float cq_blk = rfl(cum[qb * 256]);
    const float rowterm = cq - B2;
    f32x16 o[2]; float l = 0.f;
#pragma unroll
    for (int r = 0; r < 16; ++r) { o[0][r] = 0.f; o[1][r] = 0.f; }
    LAS float* colt = (LAS float*)(lds + ATT_TAB);
    for (int g = qb; g >= 0; --g) {
        if (g < qb) { const float cl = rfl(cum[g * 256 + 255]); if (2.f * B2 + cq_blk - cl < -THRESH2) break; }
        load_group(PROJ + (rb + (size_t)g * 256) * PLD + C_FK + h * 64, PROJ + (rb + (size_t)g * 256) * PLD + C_FV + h * 64, lds, tid);
        if (tid < 256) colt[tid] = -cum[g * 256 + tid];
        __syncthreads();
        const int stmax = (g == qb) ? wave : 7;
        for (int st = stmax; st >= 0; --st) {
            const int j0 = 32 * st;
            { const float cl = rfl(colt[j0 + 31]); if (2.f * B2 + cq_first + cl < -THRESH2) break; }
            attn_subtile<true>(lds, colt, j0, qf, rowterm, 0.f, (g == qb) && (st == wave), wave * 32 + r32, o, l, lane);
        }
        __syncthreads();
    }
    l = half_sum(l, lane);
    bf16* yp = Y + (rb + (size_t)q0w) * 1024 + Y_FOX + h * 64 + r32;
#pragma unroll
    for (int r = 0; r < 16; ++r) { const int q = crow(r, hh); const float rl = 1.f / shf(l, q);
        yp[(size_t)q * 1024] = (bf16)f2bf(o[0][r] * rl); yp[(size_t)q * 1024 + 32] = (bf16)f2bf(o[1][r] * rl); }
}

__device__ __forceinline__ size_t moba_list_off(int bh, int n) { return (size_t)bh * 516096 + 256 * (size_t)(63 * n - (n * (n - 1)) / 2); }
__device__ __forceinline__ void moba_store(const f32x16 (&o)[2], float l, int qpos, int slot, bool valid, size_t rb, int h, bf16* OPART, float* LPART, bf16* Y, int lane) {
    const int r32 = lane & 31, hh = lane >> 5;
#pragma unroll
    for (int r = 0; r < 16; ++r) { const int src = crow(r, hh);
        const int qp = shfi(qpos, src), sl = shfi(slot, src); const int ok = shfi((int)valid, src);
        if (ok) { bf16* op = (sl == 3) ? (Y + (rb + qp) * 1024 + Y_MOBA + h * 64) : (OPART + ((size_t)sl * MROWS + rb + qp) * 384 + h * 64);
            op[r32] = (bf16)f2bf(o[0][r]); op[32 + r32] = (bf16)f2bf(o[1][r]); } }
    if (valid && hh == 0) LPART[((size_t)slot * MROWS + rb + qpos) * 6 + h] = l;
}
__device__ __forceinline__ void moba_sel_unit(int bh, int n, int chunk, int cnt, const bf16* PROJ, const unsigned short* LIST, const unsigned* CTAB, bf16* OPART, float* LPART, bf16* Y, float B2,
                                              LAS unsigned char* lds, int tid, int wave, int lane) {
    const int b = bh / 6, h = bh % 6; const size_t rb = (size_t)b * SEQ; const int r32 = lane & 31, hh = lane >> 5;
    const float slope2 = exp2f(-8.f * (float)(h + 1) / 6.f) * LOG2E;
    load_group(PROJ + (rb + (size_t)n * 256) * PLD + C_BK + h * 64, PROJ + (rb + (size_t)n * 256) * PLD + C_BV + h * 64, lds, tid);
    __syncthreads();
    const int nvalid = cnt - chunk * 256 < 256 ? cnt - chunk * 256 : 256;
    if (wave * 32 < nvalid) {
        bool valid = true; int li = wave * 32 + r32; if (li >= nvalid) { li = nvalid - 1; valid = false; }
        const int p = chunk * 256 + li;
        const int cv = (lane > n) ? (int)CTAB[((size_t)bh * 64 + lane) * 64 + n] : 0; int inc = cv;
#pragma unroll
        for (int o2 = 1; o2 < 64; o2 <<= 1) { const int t2 = supi(inc, o2, lane); if (lane >= o2) inc += t2; }
        int qseg = 0;
#pragma unroll
        for (int stp = 32; stp >= 1; stp >>= 1) { const int v = shfi(inc, qseg + stp - 1); if (v <= p) qseg += stp; }
        const int idx = p - (shfi(inc, qseg) - shfi(cv, qseg));
        const unsigned e = LIST[moba_list_off(bh, n) + (size_t)(qseg - n - 1) * 256 + idx]; const int qpos = e & 0x3fff, slot = e >> 14;
        bf16x8 qf[4];
#pragma unroll
        for (int s = 0; s < 4; ++s) qf[s] = *(const bf16x8*)(PROJ + (rb + qpos) * PLD + C_BQ + h * 64 + 16 * s + 8 * hh);
        const int qrel = qpos - n * 256;
        const float rowterm = -slope2 * (float)qrel - B2;
        f32x16 o[2]; float l = 0.f;
#pragma unroll
        for (int r = 0; r < 16; ++r) { o[0][r] = 0.f; o[1][r] = 0.f; }
#pragma unroll 1
        for (int st = 0; st < 8; ++st) attn_subtile<false>(lds, nullptr, 32 * st, qf, rowterm, slope2, false, 0, o, l, lane);
        l = half_sum(l, lane);
        moba_store(o, l, qpos, slot, valid, rb, h, OPART, LPART, Y, lane);
    }
    __syncthreads();
}
__device__ __forceinline__ void moba_own_pair(int bh, int nA, int nB, const bf16* PROJ, bf16* OPART, float* LPART, bf16* Y, float B2, LAS unsigned char* lds, int tid, int wave, int lane) {
    const int b = bh / 6, h = bh % 6; const size_t rb = (size_t)b * SEQ; const int r32 = lane & 31, hh = lane >> 5;
    const float slope2 = exp2f(-8.f * (float)(h + 1) / 6.f) * LOG2E;
#ifndef OWN_SEQ
#define OWN_SEQ 0
#endif
#if !OWN_SEQ
    load_group(PROJ + (rb + (size_t)nA * 256) * PLD + C_BK + h * 64, PROJ + (rb + (size_t)nA * 256) * PLD + C_BV + h * 64, lds, tid);
    load_group(PROJ + (rb + (size_t)nB * 256) * PLD + C_BK + h * 64, PROJ + (rb + (size_t)nB * 256) * PLD + C_BV + h * 64, lds + 65536, tid);
    __syncthreads();
#endif
#pragma unroll 1
    for (int half = 0; half < 2; ++half) {
#if OWN_SEQ
        { const int n_ = half ? nB : nA; __syncthreads(); load_group(PROJ + (rb + (size_t)n_ * 256) * PLD + C_BK + h * 64, PROJ + (rb + (size_t)n_ * 256) * PLD + C_BV + h * 64, lds, tid); __syncthreads(); }
        const int n = half ? nB : nA, tile = (OWN_SEQ == 2 && half) ? 7 - wave : wave; LAS const unsigned char* kv = lds;
#else
        const int n = half ? nB : nA, tile = half ? 7 - wave : wave; LAS const unsigned char* kv = lds + half * 65536;
#endif
        const int qrel = tile * 32 + r32, qpos = n * 256 + qrel;
        bf16x8 qf[4];
#pragma unroll
        for (int s = 0; s < 4; ++s) qf[s] = *(const bf16x8*)(PROJ + (rb + qpos) * PLD + C_BQ + h * 64 + 16 * s + 8 * hh);
        const float rowterm = -slope2 * (float)qrel - B2;
        f32x16 o[2]; float l = 0.f;
#pragma unroll
        for (int r = 0; r < 16; ++r) { o[0][r] = 0.f; o[1][r] = 0.f; }
#pragma unroll 1
        for (int st = 0; st <= tile; ++st) attn_subtile<false>(kv, nullptr, 32 * st, qf, rowterm, slope2, st == tile, qrel, o, l, lane);
        l = half_sum(l, lane);
        moba_store(o, l, qpos, 3, true, rb, h, OPART, LPART, Y, lane);
    }
    __syncthreads();
}

__device__ __forceinline__ void moba_combine(const unsigned* SEL, const bf16* OPART, const float* LPART, bf16* Y, bf16* Yo, int opitch, int ocol, int gtid, int ngt) {
    for (size_t idx = gtid; idx < (size_t)MROWS * 48; idx += ngt) {
        const size_t row = idx / 48; const int hc = (int)(idx % 48), h = hc >> 3, c8 = (hc & 7) * 8;
        const unsigned sel = SEL[row * 6 + h];
        bf16* yp = Y + row * 1024 + Y_MOBA + h * 64 + c8;
        float acc[8]; unpack8(*(const v4u*)yp, acc);
        float l = LPART[((size_t)3 * MROWS + row) * 6 + h];
#pragma unroll
        for (int k = 0; k < 3; ++k) if (((sel >> (8 * k)) & 0xff) != 255) { float f[8]; unpack8(*(const v4u*)(OPART + ((size_t)k * MROWS + row) * 384 + h * 64 + c8), f);
#pragma unroll
            for (int i = 0; i < 8; ++i) acc[i] += f[i];
            l += LPART[((size_t)k * MROWS + row) * 6 + h]; }
        const float rl = 1.f / l;
        v4u w; w.x = pk2(acc[0] * rl, acc[1] * rl); w.y = pk2(acc[2] * rl, acc[3] * rl); w.z = pk2(acc[4] * rl, acc[5] * rl); w.w = pk2(acc[6] * rl, acc[7] * rl);
        *(v4u*)(Yo + row * opitch + ocol + h * 64 + c8) = w;
    }
}

__device__ __forceinline__ int vsw(int row, int colb) { return row * 128 + (colb ^ (((row >> 1) & 1) << 6)); }
__device__ __forceinline__ int ksw(int row, int ch) { return row * 128 + ((ch ^ ((row >> 1) & 7)) << 4); }
__device__ __forceinline__ void mlstm_m1_mfma(int ci, const MlP& P, LAS unsigned char* lds, int wave, int lane) {
    const int b = ci >> 10, h = (ci >> 8) & 3, c = ci & 255; const size_t row0 = (size_t)b * SEQ + c * 64;
    LAS unsigned char* Ki = lds + wave * 16384; LAS unsigned char* Vi = Ki + 8192;
    float wv;
    { const size_t row = row0 + lane;
      const float fi = P.GATES[row * 16 + 6 + h] + P.ibias[h], ff = P.GATES[row * 16 + 10 + h] + P.fbias[h];
      float bc = log_sigmoid_f(ff);
#pragma unroll
      for (int o = 1; o < 64; o <<= 1) { const float n = sup(bc, o, lane); if (lane >= o) bc += n; }
      const float bend = shf(bc, 63);
      const float wl = bend - bc + fi; const float mloc = wave_max(wl);
      wv = expf(wl - mloc);
      if (lane == 0) { P.BEND[ci] = bend; P.MLOC[ci] = mloc; } }
#pragma unroll
    for (int i = 0; i < 8; ++i) { const int idx = lane + 64 * i, r = idx >> 3, ch = idx & 7;
        const v4u kk = *(const v4u*)(P.KC + (row0 + r) * 256 + h * 64 + ch * 8);
        *(LAS v4u*)(Ki + vsw(r, ch * 16)) = kk;
        float f[8]; unpack8(*(const v4u*)(P.PROJ + (row0 + r) * PLD + C_MV + h * 64 + ch * 8), f);
        const float w = shf(wv, r);
        v4u o; o.x = pk2(f[0] * w, f[1] * w); o.y = pk2(f[2] * w, f[3] * w); o.z = pk2(f[4] * w, f[5] * w); o.w = pk2(f[6] * w, f[7] * w);
        *(LAS v4u*)(Vi + vsw(r, ch * 16)) = o; }
    LDS_WAIT(); asm volatile("" ::: "memory");
    { float nu = 0.f;
#pragma unroll 8
      for (int s = 0; s < 64; ++s) { const float ws = shf(wv, s); nu += ws * bf2f(*(LAS const unsigned short*)(Ki + vsw(s, 2 * lane))); }
      P.NU[(size_t)ci * 64 + lane] = nu; }
    f32x16 D[2][2];
#pragma unroll
    for (int a = 0; a < 2; ++a)
#pragma unroll
        for (int e = 0; e < 2; ++e)
#pragma unroll
            for (int r = 0; r < 16; ++r) D[a][e][r] = 0.f;
    const int i16 = lane & 15, cc = (lane >> 4) & 1, hh = lane >> 5, r32 = lane & 31;
#pragma unroll
    for (int ks = 0; ks < 4; ++ks) { const int rowv = 16 * ks + 4 * hh + (i16 >> 2);
        bf16x8 af[2], bfr[2];
#pragma unroll
        for (int blk = 0; blk < 2; ++blk) { const int colb = (32 * blk + 16 * cc + 4 * (i16 & 3)) * 2;
            { const s16x4 lo = vtr(Vi + vsw(rowv, colb)), hi = vtr(Vi + vsw(rowv, colb) + 1024); af[blk] = (bf16x8){lo[0], lo[1], lo[2], lo[3], hi[0], hi[1], hi[2], hi[3]}; }
            { const s16x4 lo = vtr(Ki + vsw(rowv, colb)), hi = vtr(Ki + vsw(rowv, colb) + 1024); bfr[blk] = (bf16x8){lo[0], lo[1], lo[2], lo[3], hi[0], hi[1], hi[2], hi[3]}; } }
#pragma unroll
        for (int a = 0; a < 2; ++a)
#pragma unroll
            for (int e = 0; e < 2; ++e) D[a][e] = __builtin_amdgcn_mfma_f32_32x32x16_bf16(af[a], bfr[e], D[a][e], 0, 0, 0); }
    float* up = P.U + (size_t)ci * 4096;
#pragma unroll
    for (int a = 0; a < 2; ++a)
#pragma unroll
        for (int e = 0; e < 2; ++e)
#pragma unroll
            for (int r = 0; r < 16; ++r) up[(32 * a + crow(r, hh)) * 64 + 32 * e + r32] = D[a][e][r];
    LDS_WAIT(); asm volatile("" ::: "memory");
}

__device__ __forceinline__ void mlstm_m3_mfma(int it, const MlP& P, LAS unsigned char* lds, int tid, int wave, int lane) {
    const int cs = wave >> 1, tile = wave & 1, ci = it * 4 + cs;
    const int b = ci >> 10, h = (ci >> 8) & 3, c = ci & 255; const size_t row0 = (size_t)b * SEQ + c * 64;
    LAS unsigned char* Ki = lds + cs * 24576; LAS unsigned char* Vi = Ki + 8192; LAS unsigned char* Ci = Ki + 16384;
    LAS float* tab = (LAS float*)(lds + ATT_TAB) + cs * 256;
    const float ms = P.MS[ci];
    { const int pt = tile * 64 + lane;
#pragma unroll
      for (int i = 0; i < 4; ++i) { const int idx = pt + 128 * i, r = idx >> 3, ch = idx & 7;
          *(LAS v4u*)(Ki + ksw(r, ch)) = *(const v4u*)(P.KC + (row0 + r) * 256 + h * 64 + ch * 8);
          *(LAS v4u*)(Vi + vsw(r, ch * 16)) = *(const v4u*)(P.PROJ + (row0 + r) * PLD + C_MV + h * 64 + ch * 8);
          *(LAS v4u*)(Ci + ksw(r, ch)) = *(const v4u*)(P.CS + (size_t)ci * 4096 + r * 64 + ch * 8); } }
    if (tile == 0) {
        const size_t row = row0 + lane;
        const float fi = P.GATES[row * 16 + 6 + h] + P.ibias[h], ff = P.GATES[row * 16 + 10 + h] + P.fbias[h];
        float bc = log_sigmoid_f(ff);
#pragma unroll
        for (int o = 1; o < 64; o <<= 1) { const float n = sup(bc, o, lane); if (lane >= o) bc += n; }
        const float a = fi - bc; float pm = a;
#pragma unroll
        for (int o = 1; o < 64; o <<= 1) { const float n = sup(pm, o, lane); if (lane >= o) pm = fmaxf(pm, n); }
        tab[lane] = a * LOG2E; tab[64 + lane] = fmaxf(ms, pm); tab[128 + lane] = bc; tab[192 + lane] = P.NS[(size_t)ci * 64 + lane];
    }
    __syncthreads();
    const int r32 = lane & 31, hh = lane >> 5, j = 32 * tile + r32;
    bf16x8 qf[4];
#pragma unroll
    for (int s = 0; s < 4; ++s) qf[s] = *(const bf16x8*)(P.QC + (row0 + j) * 256 + h * 64 + 16 * s + 8 * hh);
    unsigned short mo0[16], mo1[16];
#pragma unroll
    for (int r = 0; r < 16; ++r) { const size_t row = row0 + 32 * tile + crow(r, hh); mo0[r] = P.PROJ[row * PLD + C_MO + h * 64 + r32]; mo1[r] = P.PROJ[row * PLD + C_MO + h * 64 + 32 + r32]; }
    const float gj = tab[64 + j], inter = expf(ms - gj), rowterm2 = -gj * LOG2E;
    f32x16 o[2]; float l = 0.f;
#pragma unroll
    for (int r = 0; r < 16; ++r) { o[0][r] = 0.f; o[1][r] = 0.f; }
    for (int st = 0; st <= tile; ++st) {
        const int j0 = 32 * st;
        f32x16 acc;
#pragma unroll
        for (int r = 0; r < 16; ++r) acc[r] = 0.f;
#pragma unroll
        for (int s = 0; s < 4; ++s) { const bf16x8 kf = *(LAS const bf16x8*)(Ki + ksw(j0 + r32, 2 * s + hh)); acc = __builtin_amdgcn_mfma_f32_32x32x16_bf16(kf, qf[s], acc, 0, 0, 0); }
        float ls = 0.f;
#pragma unroll
        for (int g4 = 0; g4 < 4; ++g4) { const f32x4 c4 = *(LAS const f32x4*)(tab + j0 + 8 * g4 + 4 * hh);
#pragma unroll
            for (int ii = 0; ii < 4; ++ii) { const int reg = 4 * g4 + ii, key = j0 + 8 * g4 + 4 * hh + ii;
                float p = acc[reg] * __builtin_amdgcn_exp2f(rowterm2 + c4[ii]);
                if (st == tile && key > j) p = 0.f;
                acc[reg] = p; ls += p; } }
        l += ls;
        bf16x8 pa[2];
#pragma unroll
        for (int s = 0; s < 2; ++s) { v4u w; w.x = cvtpk(acc[8 * s + 0], acc[8 * s + 1]); w.y = cvtpk(acc[8 * s + 2], acc[8 * s + 3]); w.z = cvtpk(acc[8 * s + 4], acc[8 * s + 5]); w.w = cvtpk(acc[8 * s + 6], acc[8 * s + 7]); pa[s] = __builtin_bit_cast(bf16x8, w); }
        { const int i16 = lane & 15, cc = (lane >> 4) & 1;
#pragma unroll
          for (int db = 0; db < 2; ++db)
#pragma unroll
              for (int s = 0; s < 2; ++s) { const int rowv = j0 + 16 * s + 4 * hh + (i16 >> 2); const int colb = (32 * db + 16 * cc + 4 * (i16 & 3)) * 2;
                  LAS const unsigned char* vp = Vi + vsw(rowv, colb);
                  const s16x4 lo = vtr(vp), hi = vtr(vp + 1024);
                  const bf16x8 vf = (bf16x8){lo[0], lo[1], lo[2], lo[3], hi[0], hi[1], hi[2], hi[3]};
                  o[db] = __builtin_amdgcn_mfma_f32_32x32x16_bf16(pa[s], vf, o[db], 0, 0, 0); } }
    }
    float dn = 0.f;
#pragma unroll
    for (int s = 0; s < 4; ++s) { float f[8]; unpack8(__builtin_bit_cast(v4u, qf[s]), f);
        const f32x4 n0 = *(LAS const f32x4*)(tab + 192 + 16 * s + 8 * hh), n1 = *(LAS const f32x4*)(tab + 192 + 16 * s + 8 * hh + 4);
        dn += (f[0] * n0.x + f[1] * n0.y) + (f[2] * n0.z + f[3] * n0.w) + (f[4] * n1.x + f[5] * n1.y) + (f[6] * n1.z + f[7] * n1.w);
        v4u w; w.x = cvtpk(f[0] * inter, f[1] * inter); w.y = cvtpk(f[2] * inter, f[3] * inter); w.z = cvtpk(f[4] * inter, f[5] * inter); w.w = cvtpk(f[6] * inter, f[7] * inter);
        const bf16x8 qs = __builtin_bit_cast(bf16x8, w);
#pragma unroll
        for (int db = 0; db < 2; ++db) { const bf16x8 cf = *(LAS const bf16x8*)(Ci + ksw(32 * db + r32, 2 * s + hh)); o[db] = __builtin_amdgcn_mfma_f32_32x32x16_bf16(qs, cf, o[db], 0, 0, 0); } }
    dn = half_sum(dn, lane); l = half_sum(l, lane);
    const float den = inter * dn + l, mj = tab[128 + j] + gj;
    const float rd = 1.f / fmaxf(fabsf(den), expf(-mj));
    const float hg0 = P.hg[h * 64 + r32], hg1 = P.hg[h * 64 + 32 + r32];
#pragma unroll
    for (int r = 0; r < 16; ++r) { const int src = crow(r, hh); const float rdr = shf(rd, src);
        const float h0 = o[0][r] * rdr, h1 = o[1][r] * rdr; float ss = h0 * h0 + h1 * h1;
        ss += SWZ_X(ss, 1); ss += SWZ_X(ss, 2); ss += SWZ_X(ss, 4); ss += SWZ_X(ss, 8); ss += SWZ_X(ss, 16);
        const float rr = 1.f / sqrtf(ss * (1.f / 64.f) + EPS);
        const size_t row = row0 + 32 * tile + src;
        const float e0 = __builtin_amdgcn_exp2f(-bf2f(mo0[r]) * LOG2E), e1 = __builtin_amdgcn_exp2f(-bf2f(mo1[r]) * LOG2E);
        P.Y[row * 1024 + Y_ML + h * 64 + r32] = (bf16)f2bf(h0 * rr * hg0 * __builtin_amdgcn_rcpf(1.f + e0));
        P.Y[row * 1024 + Y_ML + h * 64 + 32 + r32] = (bf16)f2bf(h1 * rr * hg1 * __builtin_amdgcn_rcpf(1.f + e1)); }
    __syncthreads();
}

__device__ __forceinline__ void top3_ins(float g, int n, float& v0, float& v1, float& v2, int& i0, int& i1, int& i2) {
    const bool c0 = g > v0, c1 = g > v1, c2 = g > v2;
    const float nv2 = c1 ? v1 : (c2 ? g : v2); const int ni2 = c1 ? i1 : (c2 ? n : i2);
    const float nv1 = c0 ? v0 : (c1 ? g : v1); const int ni1 = c0 ? i0 : (c1 ? n : i1);
    v0 = c0 ? g : v0; i0 = c0 ? n : i0; v1 = nv1; i1 = ni1; v2 = nv2; i2 = ni2;
}
__device__ __forceinline__ void moba_gate_mfma(int u, const bf16* PROJ, const float* KMEAN, unsigned* SEL, unsigned* LCNT, unsigned* CTAB, unsigned short* LIST, float B2, float thresh2,
                                               LAS unsigned char* lds, int tid, int wave, int lane) {
    const int bh = u >> 6, qb = 63 - (u & 63), b = bh / 6, h = bh % 6; const int r32 = lane & 31, hh = lane >> 5;
    LAS unsigned char* Khi = lds; LAS unsigned char* Klo = lds + 8192; LAS unsigned* cntl = (LAS unsigned*)(lds + 16384);
    if (tid < 64) cntl[tid] = 0u;
    { const int n = tid >> 3, ch = tid & 7; float f[8];
      if (n < qb) { const float* k0 = KMEAN + ((size_t)bh * NBLK + n) * 64 + ch * 8; const float* k1 = k0 + (size_t)(12 * NBLK * 64);
          const f32x4 a0 = *(const f32x4*)k0, a1 = *(const f32x4*)(k0 + 4), b0 = *(const f32x4*)k1, b1 = *(const f32x4*)(k1 + 4);
          f[0] = a0.x + b0.x; f[1] = a0.y + b0.y; f[2] = a0.z + b0.z; f[3] = a0.w + b0.w; f[4] = a1.x + b1.x; f[5] = a1.y + b1.y; f[6] = a1.z + b1.z; f[7] = a1.w + b1.w; }
      else {
#pragma unroll
          for (int i = 0; i < 8; ++i) f[i] = 0.f; }
      unsigned hi[8]; float lo[8];
#pragma unroll
      for (int i = 0; i < 8; ++i) { hi[i] = f2bf(f[i]); lo[i] = f[i] - bf2f((unsigned short)hi[i]); }
      v4u wh; wh.x = hi[0] | (hi[1] << 16); wh.y = hi[2] | (hi[3] << 16); wh.z = hi[4] | (hi[5] << 16); wh.w = hi[6] | (hi[7] << 16);
      v4u wl; wl.x = pk2(lo[0], lo[1]); wl.y = pk2(lo[2], lo[3]); wl.z = pk2(lo[4], lo[5]); wl.w = pk2(lo[6], lo[7]);
      *(LAS v4u*)(Khi + ksw(n, ch)) = wh; *(LAS v4u*)(Klo + ksw(n, ch)) = wl; }
    const int query = wave * 32 + r32; const size_t row = (size_t)b * SEQ + qb * 256 + query;
    bf16x8 qf[4];
#pragma unroll
    for (int s = 0; s < 4; ++s) qf[s] = *(const bf16x8*)(PROJ + row * PLD + C_BQ + h * 64 + 16 * s + 8 * hh);
    __syncthreads();
    float v0 = -INFINITY, v1 = -INFINITY, v2 = -INFINITY; int i0 = 255, i1 = 255, i2 = 255;
#pragma unroll 1
    for (int st = 0; st < 2; ++st) {
        if (32 * st >= qb) break;
        f32x16 acc;
#pragma unroll
        for (int r = 0; r < 16; ++r) acc[r] = 0.f;
#pragma unroll
        for (int s = 0; s < 4; ++s) { const bf16x8 kh = *(LAS const bf16x8*)(Khi + ksw(32 * st + r32, 2 * s + hh)), kl = *(LAS const bf16x8*)(Klo + ksw(32 * st + r32, 2 * s + hh));
            acc = __builtin_amdgcn_mfma_f32_32x32x16_bf16(kh, qf[s], acc, 0, 0, 0); acc = __builtin_amdgcn_mfma_f32_32x32x16_bf16(kl, qf[s], acc, 0, 0, 0); }
#pragma unroll
        for (int r = 0; r < 16; ++r) { const int n = 32 * st + crow(r, hh); if (n < qb) top3_ins(acc[r], n, v0, v1, v2, i0, i1, i2); }
    }
    { const int pl = lane ^ 32;
      const float w0 = shf(v0, pl), w1 = shf(v1, pl), w2 = shf(v2, pl); const int j0 = shfi(i0, pl), j1 = shfi(i1, pl), j2 = shfi(i2, pl);
      if (j0 != 255) top3_ins(w0, j0, v0, v1, v2, i0, i1, i2);
      if (j1 != 255) top3_ins(w1, j1, v0, v1, v2, i0, i1, i2);
      if (j2 != 255) top3_ins(w2, j2, v0, v1, v2, i0, i1, i2); }
    if (hh == 0) {
        { const float slope2 = exp2f(-8.f * (float)(h + 1) / 6.f) * LOG2E; const float lim = (2.f * B2 + thresh2) / slope2; const int t0 = qb * 256 + query - 255;
          if (i0 != 255 && (float)(t0 - i0 * 256) > lim) i0 = 255;
          if (i1 != 255 && (float)(t0 - i1 * 256) > lim) i1 = 255;
          if (i2 != 255 && (float)(t0 - i2 * 256) > lim) i2 = 255; }
        SEL[row * 6 + h] = (unsigned)i0 | ((unsigned)i1 << 8) | ((unsigned)i2 << 16);
        if (LIST) { const unsigned t = (unsigned)(qb * 256 + query);
            if (i0 != 255) { const unsigned pos = __hip_atomic_fetch_add(cntl + i0, 1u, __ATOMIC_RELAXED, __HIP_MEMORY_SCOPE_WORKGROUP); LIST[moba_list_off(bh, i0) + (size_t)(qb - i0 - 1) * 256 + pos] = (unsigned short)(t | (0u << 14)); }
            if (i1 != 255) { const unsigned pos = __hip_atomic_fetch_add(cntl + i1, 1u, __ATOMIC_RELAXED, __HIP_MEMORY_SCOPE_WORKGROUP); LIST[moba_list_off(bh, i1) + (size_t)(qb - i1 - 1) * 256 + pos] = (unsigned short)(t | (1u << 14)); }
            if (i2 != 255) { const unsigned pos = __hip_atomic_fetch_add(cntl + i2, 1u, __ATOMIC_RELAXED, __HIP_MEMORY_SCOPE_WORKGROUP); LIST[moba_list_off(bh, i2) + (size_t)(qb - i2 - 1) * 256 + pos] = (unsigned short)(t | (2u << 14)); } }
    }
    __syncthreads();
    if (LIST && tid < 64) { const unsigned c = cntl[tid]; CTAB[((size_t)bh * 64 + qb) * 64 + tid] = c; if (c) atomicAdd(LCNT + bh * 64 + tid, c); }
    __syncthreads();
}
#ifndef FOX_MFMA
#define FOX_MFMA 1
#endif
#ifndef MOBA_MFMA
#define MOBA_MFMA 1
#endif
#ifndef REP_P0
#define REP_P0 0
#endif
#ifndef REP_NORM
#define REP_NORM 0
#endif
#ifndef REP_GIN
#define REP_GIN 0
#endif
#ifndef REP_FOX
#define REP_FOX 0
#endif
#ifndef REP_M1
#define REP_M1 0
#endif
#ifndef REP_MIXB
#define REP_MIXB 0
#endif
#ifndef REP_M3
#define REP_M3 0
#endif
#ifndef REP_GGU
#define REP_GGU 0
#endif
#ifndef REP_GATE
#define REP_GATE 0
#endif
#ifndef REP_CONV
#define REP_CONV 0
#endif
#ifndef REP_FCUM
#define REP_FCUM 0
#endif
#ifndef REP_QKN
#define REP_QKN 0
#endif
#ifndef REP_GOUT
#define REP_GOUT 0
#endif
#ifndef REP_GDN
#define REP_GDN 0
#endif
#ifndef REP_COMB
#define REP_COMB 0
#endif
#ifndef REP_BAR
#define REP_BAR 0
#endif
#ifndef REP_GATE2
#define REP_GATE2 0
#endif
#ifndef ML_MFMA
#define ML_MFMA 1
#endif
#ifndef REP_M2
#define REP_M2 0
#endif
#ifndef FOX_OLD
#define FOX_OLD 0
#endif
#if FOX_OLD
#define FOX_FN fox_unit_old
#else
#define FOX_FN fox_unit
#endif
#ifndef N_LAUNCH_MODE
#define N_LAUNCH_MODE 1
#endif
constexpr int NPHASE = 1 + 10 * DEPTH;
struct Args { const float* in[20]; float* out; unsigned char* ws; int ph_lo, ph_hi; };
static_assert(sizeof(Args) == 20 * 8 + 8 + 8 + 8, "Args has no padding");

__global__ void __launch_bounds__(NTHREADS, 2) fwd(Args args) {
    extern __shared__ __attribute__((aligned(16))) unsigned char lds_raw[];
    LAS unsigned char* lds = (LAS unsigned char*)lds_raw;
    LAS float* ldsf = (LAS float*)lds_raw;
    volatile LAS unsigned* MISC = (volatile LAS unsigned*)(lds + MISC_OFF);
    const int G = gridDim.x; const int bx = blockIdx.x; const int vcu = (G % 8 == 0) ? (bx % 8) * (G / 8) + bx / 8 : bx;
    const int NGW = G * NWAVES;
#define PH_IDS() int tid = threadIdx.x; asm volatile("" : "+v"(tid)); const int lane = tid & 63, wave = __builtin_amdgcn_readfirstlane(tid >> 6); const int gw = vcu * NWAVES + wave; (void)lane; (void)gw; \
    unsigned char* ws = ws_k; asm volatile("" : "+s"(ws)); gu32* ctl = (gu32*)(ws + WS_CTL); (void)ctl
    unsigned char* const ws_k = args.ws;
    gu32* ctl0 = (gu32*)(ws_k + WS_CTL);
    for (int u = threadIdx.x; u < (LDS_BYTES - LDSCTL_OFF) / 4; u += NTHREADS) ((LAS unsigned*)(lds + LDSCTL_OFF))[u] = 0u;
    __syncthreads();
    XcdBarrier bar; bar.bar = (unsigned*)(ctl0 + CW_BAR); bar.x = 0; bar.st = nullptr;
    if (N_LAUNCH_MODE == 1) bar = xcd_barrier_post((unsigned*)(ctl0 + CW_BAR), MISC + 8);
    const int lo = args.ph_lo, hi = args.ph_hi;
#ifndef PHMASK
#define PHMASK 0x7ff
#endif
#define PHEN(j) ((PHMASK >> (j)) & 1)
#define IN(k) ((N_LAUNCH_MODE == 1) || (lo <= (k) && (k) < hi))
#define SEAM(k) do { if (IN(k) && IN((k) + 1)) { xcd_barrier(bar); for (int rb_ = 0; rb_ < REP_BAR; ++rb_) xcd_barrier(bar); } } while (0)

#define PRM(k) (*(const float* const volatile*)(ws + WS_PTAB + 8 * (k)))
#define x_in PRM(0)
#define norm1_g PRM(4)
#define norm2_g PRM(5)
#define fox_f_bias PRM(7)
#define fox_q_g PRM(8)
#define fox_k_g PRM(9)
#define ml_conv_w PRM(10)
#define ml_conv_b PRM(11)
#define ml_i_bias PRM(12)
#define ml_f_bias PRM(13)
#define ml_h_g PRM(14)
#define moba_q_g PRM(15)
#define moba_k_g PRM(16)
#define xres ((float*)PRM(20))
#define MOD ((float*)(ws + WS_MOD))
#define XN ((bf16*)(ws + WS_XN))
#define PROJ ((bf16*)(ws + WS_PROJ))
#define HB ((bf16*)(ws + WS_H))
#define Y ((bf16*)(ws + WS_Y))
#define GATES ((float*)(ws + WS_GATES))
#define FOXCUM ((float*)(ws + WS_FOXCUM))
#define KMEAN ((float*)(ws + WS_KMEAN))
#define QC ((bf16*)(ws + WS_QC))
#define KC ((bf16*)(ws + WS_KC))
#define SEL ((unsigned*)(ws + WS_SEL))
#define mod_l (MOD + (size_t)l * 2 * 6144)
#define MK_MP() const float* const ib_ = ml_i_bias; const float* const fb_ = ml_f_bias; const float* const hg_ = ml_h_g; \
    MlP MP{PROJ, QC, KC, GATES, (float*)(ws + WS_U), (float*)(ws + WS_NU), (float*)(ws + WS_BEND), (float*)(ws + WS_MLOC), (bf16*)(ws + WS_CS), (float*)(ws + WS_NS), (float*)(ws + WS_MS), Y, ib_ + l * 4, fb_ + l * 4, hg_ + l * 256}

    for (int rep = 0; rep <= REP_P0; ++rep)
    if (PHEN(10) && IN(0)) { PH_IDS();
        const float* cvec = args.in[1]; const float* w_ada = args.in[2]; const float* b_ada = args.in[3]; const float* w_in = args.in[6];
        const float* w_out = args.in[17]; const float* w_gate_up = args.in[18]; const float* w_down = args.in[19];
        if (blockIdx.x == 0 && tid == 0) { const float** pt = (const float**)(ws + WS_PTAB);
            pt[0] = args.in[0]; pt[4] = args.in[4]; pt[5] = args.in[5]; pt[7] = args.in[7]; pt[8] = args.in[8]; pt[9] = args.in[9]; pt[10] = args.in[10]; pt[11] = args.in[11]; pt[12] = args.in[12];
            pt[13] = args.in[13]; pt[14] = args.in[14]; pt[15] = args.in[15]; pt[16] = args.in[16]; pt[20] = args.out; }
        if (vcu < 192) p0_mod_unit(vcu, cvec, w_ada, b_ada, MOD, ldsf, tid, wave, lane);
        LAS float* scr = (LAS float*)(lds + wave * 16384);
        constexpr int I_IN = 16 * (NIN / 32), I_OUT = 16 * (DM / 32), I_GU = 16 * (NGU / 32), I_DN = (DFF / 64) * (DM / 32), I_L = I_IN + I_OUT + I_GU + I_DN;
        for (int it = gw; it < DEPTH * I_L; it += NGW) {
            const int l = it / I_L; int r = it % I_L;
            if (r < I_IN) { transpose_item<1>(w_in + (size_t)l * DM * INC, DM, INC, (bf16*)(ws + WS_WIN + l * WIN_BYTES), scr, NIN / 32, r, lane); continue; } r -= I_IN;
            if (r < I_OUT) { transpose_item<0>(w_out + (size_t)l * DM * DM, DM, DM, (bf16*)(ws + WS_WOUT + l * WOUT_BYTES), scr, DM / 32, r, lane); continue; } r -= I_OUT;
            if (r < I_GU) { transpose_item<2>(w_gate_up + (size_t)l * DM * NGU, DM, NGU, (bf16*)(ws + WS_WGU + l * WGU_BYTES), scr, NGU / 32, r, lane); continue; } r -= I_GU;
            transpose_item<0>(w_down + (size_t)l * DFF * DM, DFF, DM, (bf16*)(ws + WS_WDN + l * WDN_BYTES), scr, DM / 32, r, lane);
        }
        if (REP_P0) __syncthreads();
    }
    SEAM(0);

    for (int l = 0; l < DEPTH; ++l) {
        const int pb = 1 + 10 * l;
        for (int rep = 0; rep <= REP_NORM; ++rep)
        if (PHEN(0) && IN(pb + 0)) { PH_IDS(); { const float* xcur = (l == 0) ? x_in : (const float*)xres; norm_rows(xcur, norm1_g + l * DM, mod_l, 0, 1024, XN, gw, NGW, lane); } }
        SEAM(pb + 0);
        for (int rep = 0; rep <= REP_GIN; ++rep)
        if (PHEN(1) && IN(pb + 1)) { PH_IDS();
            pg8::Gemm g{XN, (const bf16*)(ws + WS_WIN + l * WIN_BYTES), MROWS, NIN, DM}; pg8::StaticOrder S; S.init(MROWS, NIN, G, bx);
            pg8::EpiProj E{PROJ, GATES, PLD};
            pg8::gemm_phase<pg8::EpiProj, pg8::StaticOrder, true, true>(lds, g, S, E, tid);
        }
        SEAM(pb + 1);
        if (PHEN(2) && IN(pb + 2)) { PH_IDS();
            for (int u = vcu; u < 524; u += G) {
                if (u < 12) post_foxcum_unit(u, GATES, FOXCUM, fox_f_bias + l * 6, ldsf, tid, wave, lane);
                else if (u < 268) post_qknorm_unit(u - 12, PROJ, KMEAN, fox_q_g + l * 64, fox_k_g + l * 64, moba_q_g + l * 64, moba_k_g + l * 64, ldsf, tid, wave, lane);
                else { const int which = (u - 268) & 1; post_conv_unit((u - 268) >> 1, which, PROJ, which ? KC : QC, ml_conv_w + l * 4 * 512, ml_conv_b + l * 512, tid); }
            }
            for (int rep = 0; rep < REP_CONV; ++rep) for (int u = vcu; u < 256; u += G) { const int which = u & 1; post_conv_unit(u >> 1, which, PROJ, which ? KC : QC, ml_conv_w + l * 4 * 512, ml_conv_b + l * 512, tid); }
            for (int rep = 0; rep < REP_FCUM; ++rep) for (int u = vcu; u < 12; u += G) post_foxcum_unit(u, GATES, FOXCUM, fox_f_bias + l * 6, ldsf, tid, wave, lane);
        }
        SEAM(pb + 2);
        if (PHEN(3) && IN(pb + 3)) { PH_IDS(); MK_MP();
            const float B2m = 8.f * LOG2E * wave_max(fabsf(moba_q_g[l * 64 + lane])) * wave_max(fabsf(moba_k_g[l * 64 + lane])) * 1.01f;
            unsigned* LCNT = (unsigned*)(ctl + CW_LCNT + l * 768); unsigned short* LIST = MOBA_MFMA ? (unsigned short*)(ws + WS_LIST) : nullptr;
#if ML_MFMA
#ifndef GATE_MFMA
#define GATE_MFMA 1
#endif
#if GATE_MFMA
            for (int u = vcu; u < 768; u += G) moba_gate_mfma(u, PROJ, KMEAN, SEL, LCNT, (unsigned*)(ws + WS_CTAB), LIST, B2m, THRESH2, lds, tid, wave, lane);
#else
            for (int u = vcu; u < 768; u += G) moba_gate_unit(u, PROJ, KMEAN, SEL, LCNT, (unsigned*)(ws + WS_CTAB), LIST, B2m, THRESH2, ldsf, tid);
#endif
            for (int u = gw; u < 2048; u += NGW) mlstm_m1_mfma(u, MP, lds, wave, lane);
            __syncthreads();
#else
            for (int u = vcu; u < 768 + 2048; u += G) {
                if (u < 768) moba_gate_unit(u, PROJ, KMEAN, SEL, LCNT, (unsigned*)(ws + WS_CTAB), LIST, B2m, THRESH2, ldsf, tid);
                else mlstm_m1(u - 768, MP, ldsf, tid, wave, lane);
            }
#endif
            for (int rep = 0; rep < REP_GATE; ++rep) for (int u = vcu; u < 768; u += G) moba_gate_unit(u, PROJ, KMEAN, SEL, LCNT, (unsigned*)(ws + WS_CTAB), nullptr, B2m, THRESH2, ldsf, tid);
            for (int rep = 0; rep < REP_GATE2; ++rep) for (int u = vcu; u < 768; u += G) moba_gate_unit(u, PROJ, KMEAN, SEL, LCNT + 4096, (unsigned*)(ws + WS_OPART + 32 * MiB), (unsigned short*)(ws + WS_OPART), B2m, THRESH2, ldsf, tid);
            for (int rep = 0; rep < REP_M1; ++rep) for (int u = vcu; u < 2048; u += G) mlstm_m1(u, MP, ldsf, tid, wave, lane);
#if FOX_MFMA
            { const float gq = wave_max(fabsf(fox_q_g[l * 64 + lane])), gk = wave_max(fabsf(fox_k_g[l * 64 + lane])); const float B2 = 8.f * LOG2E * gq * gk * 1.01f;
              for (int rep = 0; rep <= REP_FOX; ++rep)
              for (int u = vcu; u < 768; u += G) FOX_FN(u >> 6, 63 - (u & 63), PROJ, FOXCUM, Y, B2, lds, tid, wave, lane); }
#else
            fox_naive(PROJ, FOXCUM, Y, gw, NGW, lane);
#endif
        }
        SEAM(pb + 3);
        for (int rep = 0; rep <= REP_MIXB; ++rep)
        if (PHEN(4) && IN(pb + 4)) { PH_IDS(); MK_MP();
            for (int rep = 0; rep <= REP_M2; ++rep)
            for (int u = vcu; u < 64; u += G) mlstm_m2(u, MP, tid);
#if MOBA_MFMA
            { const float gq = wave_max(fabsf(moba_q_g[l * 64 + lane])), gk = wave_max(fabsf(moba_k_g[l * 64 + lane])); const float B2 = 8.f * LOG2E * gq * gk * 1.01f;
              LAS int* pre = (LAS int*)(lds + ATT_TAB + 1024);
              const unsigned* lcnt = (const unsigned*)(ctl + CW_LCNT + l * 768);
              if (wave == 0) { int carry = 0;
                  for (int r = 0; r < 12; ++r) { const int p = r * 64 + lane; int x = (int)((lcnt[p] + 255u) >> 8);
#pragma unroll
                      for (int o = 1; o < 64; o <<= 1) { const int n = supi(x, o, lane); if (lane >= o) x += n; }
                      pre[p + 1] = carry + x; carry += shfi(x, 63); }
                  if (lane == 0) pre[0] = 0; }
              __syncthreads();
              const int S = pre[768];
              const unsigned short* LIST = (const unsigned short*)(ws + WS_LIST); bf16* OPART = (bf16*)(ws + WS_OPART); float* LPART = (float*)(ws + WS_LPART);
              #ifndef KSKIP_N
#define KSKIP_N 4
#endif
              constexpr int KSKIP = KSKIP_N; const int NU = S + 384;
              for (int i = (vcu < 64 ? KSKIP : 0); ; ++i) {
                  const int u = (i < KSKIP) ? i * (G - 64) + (vcu - 64) : KSKIP * (G - 64) + (i - KSKIP) * G + vcu;
                  if (u >= NU) break;
                  if (u < S) { int lo2 = 0, hi2 = 768; while (hi2 - lo2 > 1) { const int mid = (lo2 + hi2) >> 1; if (pre[mid] <= u) lo2 = mid; else hi2 = mid; }
                      moba_sel_unit(lo2 >> 6, lo2 & 63, u - pre[lo2], (int)lcnt[lo2], PROJ, LIST, (const unsigned*)(ws + WS_CTAB), OPART, LPART, Y, B2, lds, tid, wave, lane); }
                  else { const int p = u - S; moba_own_pair(p >> 5, p & 31, 63 - (p & 31), PROJ, OPART, LPART, Y, B2, lds, tid, wave, lane); }
              } }
#else
            moba_naive(PROJ, SEL, Y, gw, NGW, lane);
#endif
        }
        SEAM(pb + 4);
        if (PHEN(5) && IN(pb + 5)) { PH_IDS(); MK_MP();
#if ML_MFMA
            for (int rep = 0; rep <= REP_M3; ++rep)
            for (int u = vcu; u < 512; u += G) mlstm_m3_mfma(u, MP, lds, tid, wave, lane);
#else
            for (int rep = 0; rep <= REP_M3; ++rep)
            for (int u = vcu; u < 2048; u += G) mlstm_m3(u, MP, ldsf, tid, wave, lane);
#endif
#if MOBA_MFMA
            for (int rep = 0; rep < REP_COMB; ++rep) moba_combine(SEL, (const bf16*)(ws + WS_OPART), (const float*)(ws + WS_LPART), Y, (bf16*)(ws + WS_U), 384, 0, vcu * NTHREADS + tid, G * NTHREADS);
            moba_combine(SEL, (const bf16*)(ws + WS_OPART), (const float*)(ws + WS_LPART), Y, Y, 1024, Y_MOBA, vcu * NTHREADS + tid, G * NTHREADS);
#endif
        }
        SEAM(pb + 5);
        if (PHEN(6) && IN(pb + 6)) { PH_IDS();
            pg8::Gemm g{Y, (const bf16*)(ws + WS_WOUT + l * WOUT_BYTES), MROWS, DM, DM}; pg8::StaticOrder S; S.init(MROWS, DM, G, bx);
            float* const xr = xres; const float* const xcur = (l == 0) ? x_in : (const float*)xr;
            pg8::EpiRes E{xcur, xr, mod_l + 2048, 6144, SEQ};
            pg8::gemm_phase<pg8::EpiRes, pg8::StaticOrder, true, true>(lds, g, S, E, tid);
        }
        SEAM(pb + 6);
        if (PHEN(7) && IN(pb + 7)) { PH_IDS(); norm_rows((const float*)xres, norm2_g + l * DM, mod_l, 3072, 4096, XN, gw, NGW, lane); }
        SEAM(pb + 7);
        for (int rep = 0; rep <= REP_GGU; ++rep)
        if (PHEN(8) && IN(pb + 8)) { PH_IDS();
            pg8::Gemm g{XN, (const bf16*)(ws + WS_WGU + l * WGU_BYTES), MROWS, NGU, DM}; pg8::StaticOrder S; S.init(MROWS, NGU, G, bx);
            pg8::EpiSwiglu E{HB, DFF};
            pg8::gemm_phase<pg8::EpiSwiglu, pg8::StaticOrder, true, true>(lds, g, S, E, tid);
        }
        SEAM(pb + 8);
        if (PHEN(9) && IN(pb + 9)) { PH_IDS();
            pg8::Gemm g{HB, (const bf16*)(ws + WS_WDN + l * WDN_BYTES), MROWS, DM, DFF}; pg8::StaticOrder S; S.init(MROWS, DM, G, bx);
            float* const xr = xres;
            pg8::EpiRes E{xr, xr, mod_l + 5120, 6144, SEQ};
            pg8::gemm_phase<pg8::EpiRes, pg8::StaticOrder, true, true>(lds, g, S, E, tid);
        }
        SEAM(pb + 9);
    }
#undef IN
#undef SEAM
}

extern "C" void kernel_launch(void* const* d_in, const int* in_sizes, int n_in, void* d_out, int out_size, void* d_ws, size_t ws_size, hipStream_t stream) {
    static int grid = 0;
    if (grid == 0) {
        if (n_in != 20 || in_sizes[0] != MROWS * DM || out_size != MROWS * DM || ws_size < WS_END) {
            fprintf(stderr, "kernel_launch: unexpected shapes: n_in %d in0 %d out %d ws %zu (need >= %zu)\n", n_in, n_in > 0 ? in_sizes[0] : -1, out_size, ws_size, (size_t)WS_END); grid = -1; return; }
        int dev = 0, cus = 0, per_cu = 0;
        if (hipGetDevice(&dev) != hipSuccess || hipDeviceGetAttribute(&cus, hipDeviceAttributeMultiprocessorCount, dev) != hipSuccess) { grid = -1; return; }
        if (hipFuncSetAttribute((const void*)fwd, hipFuncAttributeMaxDynamicSharedMemorySize, LDS_BYTES) != hipSuccess) { fprintf(stderr, "kernel_launch: hipFuncSetAttribute failed\n"); grid = -1; return; }
        if (hipOccupancyMaxActiveBlocksPerMultiprocessor(&per_cu, (const void*)fwd, NTHREADS, LDS_BYTES) != hipSuccess || per_cu < 1)
            fprintf(stderr, "kernel_launch: note: occupancy query reports %d workgroups per CU\n", per_cu);
        (void)hipGetLastError();
        grid = cus;
    }
    if (grid < 0) return;
    if (hipMemsetAsync((char*)d_ws + WS_CTL, 0, CTL_ZERO_BYTES, stream) != hipSuccess) return;
    Args a{};
    for (int i = 0; i < 20; ++i) a.in[i] = (const float*)d_in[i];
    a.out = (float*)d_out; a.ws = (unsigned char*)d_ws;
    if (N_LAUNCH_MODE == 1) { a.ph_lo = 0; a.ph_hi = NPHASE; hipLaunchKernelGGL(fwd, dim3(grid), dim3(NTHREADS), LDS_BYTES, stream, a); }
    else for (int p = 0; p < NPHASE; ++p) { a.ph_lo = p; a.ph_hi = p + 1; hipLaunchKernelGGL(fwd, dim3(grid), dim3(NTHREADS), LDS_BYTES, stream, a); }
}
```

```cpp
#include <hip/hip_runtime.h>
#include <cstdio>
#include <cstdint>

constexpr int DM = 1024, NBATCH = 2, SEQ = 16384, MROWS = NBATCH * SEQ, DEPTH = 2;
constexpr int HD = 64, FOXH = 6, MLH = 4, MOBH = 6;
constexpr int DFF = 2816, INC = 3342, NIN = 3584, PLD = 3328;
constexpr int NGU = 2 * DFF;
constexpr int C_FQ = 0, C_FK = 384, C_FV = 768, C_BQ = 1152, C_BK = 1536, C_BV = 1920, C_MQ = 2304, C_MK = 2560, C_MV = 2816, C_MO = 3072, C_G = 3328;
constexpr int Y_FOX = 0, Y_ML = 384, Y_MOBA = 640;
constexpr int MOBA_BS = 256, NBLK = SEQ / MOBA_BS;
constexpr int MLC = 64, NCHUNK = SEQ / MLC;
constexpr float LOG2E = 1.4426950408889634f;
constexpr float QSCALE = 0.125f * LOG2E;
constexpr float EPS = 1e-6f;

#define GAS __attribute__((address_space(1)))
#define LAS __attribute__((address_space(3)))
typedef unsigned short bf16;
typedef unsigned v4u __attribute__((ext_vector_type(4)));
typedef unsigned v2u __attribute__((ext_vector_type(2)));
typedef float f32x4 __attribute__((ext_vector_type(4)));
typedef short bf16x8 __attribute__((ext_vector_type(8)));
typedef float f32x16 __attribute__((ext_vector_type(16)));
typedef GAS unsigned gu32;
#define RLX_AGENT __ATOMIC_RELAXED, __HIP_MEMORY_SCOPE_AGENT
__device__ __forceinline__ unsigned f2bf(float f) { unsigned u = __builtin_bit_cast(unsigned, f); return (u + 0x7fffu + ((u >> 16) & 1u)) >> 16; }
__device__ __forceinline__ unsigned pk2(float lo, float hi) { return f2bf(lo) | (f2bf(hi) << 16); }
__device__ __forceinline__ float bf2f(unsigned short u) { return __builtin_bit_cast(float, (unsigned)u << 16); }
__device__ __forceinline__ float bflo(unsigned w) { return __builtin_bit_cast(float, w << 16); }
__device__ __forceinline__ float bfhi(unsigned w) { return __builtin_bit_cast(float, w & 0xffff0000u); }
#ifndef OLD_SHFL
#define OLD_SHFL 0
#endif
#ifndef OLD_SWZ
#define OLD_SWZ OLD_SHFL
#endif
#ifndef OLD_HALF
#define OLD_HALF OLD_SHFL
#endif
#ifndef OLD_SHF
#define OLD_SHF OLD_SHFL
#endif
#ifndef OLD_SUP
#define OLD_SUP OLD_SHFL
#endif
#if OLD_SWZ
#define SWZ_X(v, o) __shfl_xor((float)(v), (o))
#else
#define SWZ_X(v, o) __builtin_bit_cast(float, __builtin_amdgcn_ds_swizzle(__builtin_bit_cast(int, (float)(v)), ((o) << 10) | 0x1f))
#endif
__device__ __forceinline__ float half_sum(float v, int lane) { return v + __builtin_bit_cast(float, __builtin_amdgcn_ds_bpermute((lane ^ 32) << 2, __builtin_bit_cast(int, v))); }
#if OLD_SHF
__device__ __forceinline__ float shf(float v, int src) { return __shfl(v, src); }
__device__ __forceinline__ int shfi(int v, int src) { return __shfl(v, src); }
#else
__device__ __forceinline__ float shf(float v, int src) { return __builtin_bit_cast(float, __builtin_amdgcn_ds_bpermute(src << 2, __builtin_bit_cast(int, v))); }
__device__ __forceinline__ int shfi(int v, int src) { return __builtin_amdgcn_ds_bpermute(src << 2, v); }
#endif
#if OLD_SUP
__device__ __forceinline__ float sup(float v, int o, int lane) { return __shfl_up(v, o); }
__device__ __forceinline__ int supi(int v, int o, int lane) { return __shfl_up(v, o); }
#else
__device__ __forceinline__ float sup(float v, int o, int lane) { return shf(v, lane >= o ? lane - o : lane); }
__device__ __forceinline__ int supi(int v, int o, int lane) { return shfi(v, lane >= o ? lane - o : lane); }
#endif
__device__ __forceinline__ float wave_sum(float v) { v += SWZ_X(v, 1); v += SWZ_X(v, 2); v += SWZ_X(v, 4); v += SWZ_X(v, 8); v += SWZ_X(v, 16);
    return __builtin_bit_cast(float, __builtin_amdgcn_readlane(__builtin_bit_cast(int, v), 0)) + __builtin_bit_cast(float, __builtin_amdgcn_readlane(__builtin_bit_cast(int, v), 32)); }
__device__ __forceinline__ float wave_max(float v) { v = fmaxf(v, SWZ_X(v, 1)); v = fmaxf(v, SWZ_X(v, 2)); v = fmaxf(v, SWZ_X(v, 4)); v = fmaxf(v, SWZ_X(v, 8)); v = fmaxf(v, SWZ_X(v, 16));
    return fmaxf(__builtin_bit_cast(float, __builtin_amdgcn_readlane(__builtin_bit_cast(int, v), 0)), __builtin_bit_cast(float, __builtin_amdgcn_readlane(__builtin_bit_cast(int, v), 32))); }
__device__ __forceinline__ float log_sigmoid_f(float x) { return fminf(x, 0.f) - log1pf(expf(-fabsf(x))); }
__device__ __forceinline__ float sigmoid_f(float x) { return 1.f / (1.f + expf(-x)); }

constexpr size_t MiB = 1u << 20;
constexpr size_t WS_CTL = 0, CTL_ZERO_BYTES = 1 * MiB;
constexpr size_t WS_MOD = 1 * MiB;
constexpr size_t WS_KMEAN = WS_MOD + 128 * 1024;
constexpr size_t WS_MLS = WS_KMEAN + 512 * 1024;
constexpr size_t WS_BEND = WS_MLS, WS_MLOC = WS_MLS + 8192, WS_MS = WS_MLS + 16384, WS_NU = WS_MLS + 32768, WS_NS = WS_NU + 2048 * 64 * 4;
constexpr size_t WS_CTAB = 3 * MiB;
constexpr size_t WS_PTAB = WS_CTAB + 256 * 1024;
static_assert(WS_NS + 2048 * 64 * 4 <= WS_CTAB && WS_CTAB + 12 * 64 * 64 * 4 <= WS_PTAB && WS_PTAB + 256 <= 4 * MiB, "small region");
constexpr size_t WS_WIN = 4 * MiB, WIN_BYTES = (size_t)NIN * DM * 2;
constexpr size_t WS_WOUT = WS_WIN + 2 * WIN_BYTES, WOUT_BYTES = (size_t)DM * DM * 2;
constexpr size_t WS_WGU = WS_WOUT + 2 * WOUT_BYTES, WGU_BYTES = (size_t)NGU * DM * 2;
constexpr size_t WS_WDN = WS_WGU + 2 * WGU_BYTES, WDN_BYTES = (size_t)DM * DFF * 2;
static_assert(WS_WDN + 2 * WDN_BYTES <= 56 * MiB, "weights");
constexpr size_t WS_SSP = 56 * MiB;
constexpr size_t WS_AVEC = 58 * MiB;
constexpr size_t WS_BIASIN = WS_AVEC + 64 * 1024;
constexpr size_t WS_BIASGU = WS_BIASIN + 64 * 1024;
static_assert(WS_BIASGU + 2 * 2 * NGU * 4 <= 64 * MiB && 2 * 2 * NIN * 4 <= 64 * 1024, "fused-norm vectors");
constexpr size_t WS_XN = 64 * MiB;
constexpr size_t WS_U = 64 * MiB;
constexpr size_t WS_CS = 96 * MiB;
constexpr size_t WS_LIST = 112 * MiB;
constexpr size_t WS_PROJ = 128 * MiB;
constexpr size_t WS_H = 128 * MiB;
constexpr size_t WS_Y = 336 * MiB;
constexpr size_t WS_QC = 400 * MiB, WS_KC = 416 * MiB;
constexpr size_t WS_OPART = 432 * MiB;
constexpr size_t WS_LPART = 504 * MiB;
constexpr size_t WS_GATES = 507 * MiB;
constexpr size_t WS_FOXCUM = 509 * MiB;
constexpr size_t WS_SEL = 510 * MiB;
constexpr size_t WS_END = 512 * MiB;
static_assert(WS_PROJ + (size_t)MROWS * PLD * 2 <= WS_Y && WS_SEL + (size_t)MROWS * 6 * 4 <= WS_END, "ws map");
constexpr int CW_BAR = 4096;
constexpr int CW_QUEUE = 16384;
constexpr int CW_LCNT = 32768;

constexpr int RING_BYTES = 131072, LDSCTL_OFF = RING_BYTES, MISC_OFF = LDSCTL_OFF + 320, LDS_BYTES = 147456;
constexpr int NWAVES = 8, NTHREADS = 512;
namespace pg8 {
#define PG8_LAS __attribute__((address_space(3)))
typedef unsigned short bf16_t;
typedef short bf16x8 __attribute__((ext_vector_type(8)));
typedef float f32x4 __attribute__((ext_vector_type(4)));
typedef unsigned u32x4 __attribute__((ext_vector_type(4)));
constexpr int BM = 256, BK = 64, HALF = 128, HTB = HALF * BK * 2  , STAGE_BYTES = 8 * HTB, NXCD = 8, WGM = 8;

__host__ __device__ __forceinline__ int lds_byte(int r, int c) { const int st = (r >> 4) * 2 + (c >> 5), rr = r & 15, cc = c & 31, ob = rr * 64 + cc * 2; return st * 1024 + (ob ^ (((ob >> 9) & 1) << 5)); }
__host__ __device__ __forceinline__ void stage_rc(int b, int& R, int& C) { const int st = b / 1024, sb = b % 1024, swz = sb ^ (((sb >> 9) & 1) << 5); R = (st >> 1) * 16 + swz / 64; C = (st & 1) * 32 + (swz % 64) / 2; }
__host__ __device__ __forceinline__ int perm32(int rho) { const int n = rho >> 4, i = rho & 15; return 8 * (i >> 2) + 4 * n + (i & 3); }

struct Unit { int pm, pn, ord; };
struct Gemm { const bf16_t* A; const bf16_t* Bt; int M, N, K; };

struct StaticOrder {
    int nM, nN, nwg, G, c;
    __host__ __device__ void init(int M, int N, int G_, int c_) { nM = M / BM; nN = N / BM; nwg = nM * nN; G = G_; c = c_; }
    __host__ __device__ bool next(int i, Unit& u) const {
        const long L = (long)i * G + c; if (L >= nwg) return false;
        int wgid = (int)L; { const int q = nwg / NXCD, r = nwg % NXCD, xcd = wgid % NXCD, off = wgid / NXCD; wgid = (xcd < r ? xcd * (q + 1) : r * (q + 1) + (xcd - r) * q) + off; }
        const int nig = WGM * nN, gid = wgid / nig, fm = gid * WGM, gsz = (nM - fm) < WGM ? (nM - fm) : WGM;
        u.pm = fm + ((wgid % nig) % gsz); u.pn = (wgid % nig) / gsz; u.ord = i; return true;
    }
    __device__ __forceinline__ void a_ready(const Unit&) const {}
    __device__ __forceinline__ void done(const Unit&) const {}
};

__device__ __forceinline__ unsigned cvt_pk_bf16(float lo, float hi) { unsigned r; asm volatile("v_cvt_pk_bf16_f32 %0, %1, %2" : "=v"(r) : "v"(lo), "v"(hi)); return r; }
typedef float f32x2 __attribute__((ext_vector_type(2)));
typedef unsigned u32x2 __attribute__((ext_vector_type(2)));
struct EpiProj {
    static constexpr bool PERM = true, AFTER_DRAIN = false;
    bf16_t* P; float* G; int pld; PG8_LAS const float* rt; int pm0; PG8_LAS const float* bt;
    __device__ __forceinline__ void operator()(const f32x4 (&acc)[2][2][4][2], const Unit& u, int wr, int wc, int fr, int fq) const {
        const int row0 = u.pm * BM + wr * 64 + fr;
        PG8_LAS const float* rs = rt + (u.pm == pm0 ? 0 : 256) + wr * 64 + fr;
        PG8_LAS const float* bb = bt + u.ord * 256 + wc * 32 + 8 * fq;
        if (u.pn < 13) {
            const int col0 = u.pn * BM + wc * 32 + 8 * fq;
            f32x4 bv[2][2];
#pragma unroll
            for (int bj = 0; bj < 2; ++bj)
#pragma unroll
                for (int n = 0; n < 2; ++n) bv[bj][n] = *(PG8_LAS const f32x4*)(bb + bj * HALF + 4 * n);
            float rsv[2][4];
#pragma unroll
            for (int ai = 0; ai < 2; ++ai)
#pragma unroll
                for (int m = 0; m < 4; ++m) rsv[ai][m] = rs[ai * HALF + m * 16];
#pragma unroll
            for (int ai = 0; ai < 2; ++ai)
#pragma unroll
                for (int m = 0; m < 4; ++m) { bf16_t* rowp = P + (size_t)(row0 + ai * HALF + m * 16) * pld + col0; const float rstd = rsv[ai][m];
#pragma unroll
                    for (int bj = 0; bj < 2; ++bj) { const f32x4 v0 = acc[ai][bj][m][0] * rstd + bv[bj][0], v1 = acc[ai][bj][m][1] * rstd + bv[bj][1];
                        u32x4 w; w.x = cvt_pk_bf16(v0[0], v0[1]); w.y = cvt_pk_bf16(v0[2], v0[3]); w.z = cvt_pk_bf16(v1[0], v1[1]); w.w = cvt_pk_bf16(v1[2], v1[3]);
                        *(u32x4*)(rowp + bj * HALF) = w; } }
        } else {
            if (wc == 0 && fq < 2) {
                const f32x4 b0 = *(PG8_LAS const f32x4*)(bb), b1 = *(PG8_LAS const f32x4*)(bb + 4);
#pragma unroll
                for (int ai = 0; ai < 2; ++ai)
#pragma unroll
                    for (int m = 0; m < 4; ++m) { float* gp = G + (size_t)(row0 + ai * HALF + m * 16) * 16 + 8 * fq; const float rstd = rs[ai * HALF + m * 16];
                        *(f32x4*)(gp) = acc[ai][0][m][0] * rstd + b0; *(f32x4*)(gp + 4) = acc[ai][0][m][1] * rstd + b1; }
            }
        }
    }
};
struct EpiRes {
    static constexpr bool PERM = true, AFTER_DRAIN = false;
    const float* base; float* out; const float* gate; int gate_bstride; int rows_per_batch; bf16_t* xa; const float* avec; float* ssp;
    __device__ __forceinline__ void operator()(const f32x4 (&acc)[2][2][4][2], const Unit& u, int wr, int wc, int fr, int fq) const {
        const int row0 = u.pm * BM + wr * 64 + fr, col0 = u.pn * BM + wc * 32 + 8 * fq;
        const int bat = (u.pm * BM) / rows_per_batch;
        const float* gb = gate + (size_t)bat * gate_bstride;
        f32x4 gv[2][2], av[2][2];
#pragma unroll
        for (int bj = 0; bj < 2; ++bj)
#pragma unroll
            for (int n = 0; n < 2; ++n) { gv[bj][n] = *(const f32x4*)(gb + col0 + bj * HALF + 4 * n); av[bj][n] = xa ? *(const f32x4*)(avec + (size_t)bat * 1024 + col0 + bj * HALF + 4 * n) : (f32x4){0.f, 0.f, 0.f, 0.f}; }
        const int lane = fq * 16 + fr;
#pragma unroll
        for (int ai = 0; ai < 2; ++ai)
#pragma unroll
            for (int m = 0; m < 4; ++m) { const size_t off = (size_t)(row0 + ai * HALF + m * 16) * 1024 + col0; float ss = 0.f;
#pragma unroll
                for (int bj = 0; bj < 2; ++bj) {
                    const f32x4 o0 = *(const f32x4*)(base + off + bj * HALF) + gv[bj][0] * acc[ai][bj][m][0], o1 = *(const f32x4*)(base + off + bj * HALF + 4) + gv[bj][1] * acc[ai][bj][m][1];
                    __builtin_nontemporal_store(o0, (f32x4*)(out + off + bj * HALF)); __builtin_nontemporal_store(o1, (f32x4*)(out + off + bj * HALF + 4));
                    if (xa) { ss += ((o0[0] * o0[0] + o0[1] * o0[1]) + (o0[2] * o0[2] + o0[3] * o0[3])) + ((o1[0] * o1[0] + o1[1] * o1[1]) + (o1[2] * o1[2] + o1[3] * o1[3]));
                        const f32x4 t0 = o0 * av[bj][0], t1 = o1 * av[bj][1];
                        u32x4 w; w.x = cvt_pk_bf16(t0[0], t0[1]); w.y = cvt_pk_bf16(t0[2], t0[3]); w.z = cvt_pk_bf16(t1[0], t1[1]); w.w = cvt_pk_bf16(t1[2], t1[3]);
                        *(u32x4*)(xa + off + bj * HALF) = w; } }
                if (xa) { ss += SWZ_X(ss, 16); ss += __builtin_bit_cast(float, __builtin_amdgcn_ds_bpermute((lane ^ 32) << 2, __builtin_bit_cast(int, ss)));
                    if (fq == 0) ssp[(size_t)(row0 + ai * HALF + m * 16) * 16 + u.pn * 4 + wc] = ss; } }
    }
};
struct EpiSwiglu {
    static constexpr bool PERM = true, AFTER_DRAIN = false;
    bf16_t* Hh; int ldh; PG8_LAS const float* rt; int pm0; PG8_LAS const float* bt;
    __device__ __forceinline__ void operator()(const f32x4 (&acc)[2][2][4][2], const Unit& u, int wr, int wc, int fr, int fq) const {
        const int row0 = u.pm * BM + wr * 64 + fr, col0 = u.pn * HALF + wc * 32 + 8 * fq;
        PG8_LAS const float* rs = rt + (u.pm == pm0 ? 0 : 256) + wr * 64 + fr;
        PG8_LAS const float* bb = bt + u.ord * 256 + wc * 32 + 8 * fq;
        f32x4 bv[2][2];
#pragma unroll
        for (int bj = 0; bj < 2; ++bj)
#pragma unroll
            for (int n = 0; n < 2; ++n) bv[bj][n] = *(PG8_LAS const f32x4*)(bb + bj * HALF + 4 * n);
        float rsv[2][4];
#pragma unroll
        for (int ai = 0; ai < 2; ++ai)
#pragma unroll
            for (int m = 0; m < 4; ++m) rsv[ai][m] = rs[ai * HALF + m * 16];
#pragma unroll
        for (int ai = 0; ai < 2; ++ai)
#pragma unroll
            for (int m = 0; m < 4; ++m) { bf16_t* rowp = Hh + (size_t)(row0 + ai * HALF + m * 16) * ldh + col0; const float rstd = rsv[ai][m];
                float hv[8];
#pragma unroll
                for (int n = 0; n < 2; ++n)
#pragma unroll
                    for (int i = 0; i < 4; ++i) { const float g = acc[ai][0][m][n][i] * rstd + bv[0][n][i], up = acc[ai][1][m][n][i] * rstd + bv[1][n][i];
                        const float e = __builtin_amdgcn_exp2f(-g * 1.4426950408889634f);
                        hv[n * 4 + i] = g * __builtin_amdgcn_rcpf(1.0f + e) * up; }
                u32x4 w; w.x = cvt_pk_bf16(hv[0], hv[1]); w.y = cvt_pk_bf16(hv[2], hv[3]); w.z = cvt_pk_bf16(hv[4], hv[5]); w.w = cvt_pk_bf16(hv[6], hv[7]);
                __builtin_nontemporal_store(w, (u32x4*)(rowp)); }
    }
};
template <class Epi, class Sched, bool ALIGN_EPI = false, bool SP2 = false>
__device__ __forceinline__ void gemm_phase(PG8_LAS unsigned char* lds, const Gemm g, const Sched& S, const Epi& E, const int tid_in) {
    const int tid = tid_in, wid = __builtin_amdgcn_readfirstlane(tid >> 6), lane = tid & 63, wr = wid >> 2, wc = wid & 3, fr = lane & 15, fq = lane >> 4;
    const int K = g.K, nt = K / BK;
    unsigned voffA[2], voffB[2];
#pragma unroll
    for (int i = 0; i < 2; ++i) { int R, C; stage_rc(tid * 16 + i * 8192, R, C); const int Rb = Epi::PERM ? ((R & ~31) + perm32(R & 31)) : R;
        voffA[i] = (unsigned)(R * K + C) * 2u; voffB[i] = (unsigned)(Rb * K + C) * 2u; }
    const size_t kstep = (size_t)(BK * 2);
    const size_t hstep = (size_t)HALF * K * 2;
    const size_t tstep = 2 * hstep;
    const unsigned ldsw = (unsigned)wid * 1024u;
    const int aoff = lds_byte(wr * 64 + fr, fq * 8), boff = lds_byte(wc * 32 + fr, fq * 8);
#define PG8_SA(b, h) (((b) * 2 + (h)) * HTB)
#define PG8_SB(b, h) ((4 + (b) * 2 + (h)) * HTB)
#define PG8_STAGE(bufoff, gbase, voff) do { _Pragma("unroll") for (int _i = 0; _i < 2; ++_i) \
        __builtin_amdgcn_global_load_lds((const unsigned*)((const char*)(gbase) + (voff)[_i]), (PG8_LAS unsigned*)(lds + (bufoff) + ldsw + _i * 8192), 16, 0, 0); } while (0)
#define PG8_LDA(dst, b, h) do { _Pragma("unroll") for (int m = 0; m < 4; ++m) _Pragma("unroll") for (int k = 0; k < 2; ++k) dst[m][k] = *(const PG8_LAS bf16x8*)(lds + PG8_SA(b, h) + aoff + m * 2048 + k * 1024); } while (0)
#define PG8_LDB(dst, b, h) do { _Pragma("unroll") for (int n = 0; n < 2; ++n) _Pragma("unroll") for (int k = 0; k < 2; ++k) dst[n][k] = *(const PG8_LAS bf16x8*)(lds + PG8_SB(b, h) + boff + n * 2048 + k * 1024); } while (0)
#define PG8_MMA(ai, bj, At, Bt) do { __builtin_amdgcn_s_setprio(1); _Pragma("unroll") for (int m = 0; m < 4; ++m) _Pragma("unroll") for (int n = 0; n < 2; ++n) _Pragma("unroll") for (int k = 0; k < 2; ++k) \
        acc[ai][bj][m][n] = __builtin_amdgcn_mfma_f32_16x16x32_bf16(Bt[n][k], At[m][k], acc[ai][bj][m][n], 0, 0, 0); __builtin_amdgcn_s_setprio(0); } while (0)
#define PG8_WAIT_V(n) asm volatile("s_waitcnt vmcnt(" #n ")" ::: "memory")
#define PG8_WAIT_L(n) asm volatile("s_waitcnt lgkmcnt(" #n ")" ::: "memory")
#define PG8_BAR __builtin_amdgcn_s_barrier()
#define PG8_SCHED __builtin_amdgcn_sched_barrier(0)
    Unit cur, nxt; int ui = 0;
    if (!S.next(0, cur)) return;
    f32x4 acc[2][2][4][2];
#pragma unroll
    for (int a = 0; a < 2; ++a)
#pragma unroll
        for (int b = 0; b < 2; ++b)
#pragma unroll
            for (int m = 0; m < 4; ++m)
#pragma unroll
                for (int n = 0; n < 2; ++n) acc[a][b][m][n] = (f32x4){0.f, 0.f, 0.f, 0.f};
    bf16x8 At[4][2], B0[2][2], B1[2][2];
    const char* cA = (const char*)g.A + (size_t)cur.pm * tstep; const char* cB = (const char*)g.Bt + (size_t)cur.pn * tstep;
    S.a_ready(cur);
    if constexpr (SP2) {
        PG8_STAGE(PG8_SB(0, 0), cB, voffB); PG8_STAGE(PG8_SB(0, 1), cB + hstep, voffB); PG8_STAGE(PG8_SA(0, 0), cA, voffA); PG8_STAGE(PG8_SA(0, 1), cA + hstep, voffA);
        if (wr == 1) PG8_BAR;
        PG8_WAIT_V(2); PG8_BAR;
        PG8_STAGE(PG8_SB(1, 0), cB + kstep, voffB); PG8_STAGE(PG8_SA(1, 0), cA + kstep, voffA); PG8_STAGE(PG8_SB(1, 1), cB + hstep + kstep, voffB);
        PG8_WAIT_V(6); PG8_BAR;
    } else {
        PG8_STAGE(PG8_SB(0, 0), cB, voffB); PG8_STAGE(PG8_SA(0, 0), cA, voffA); PG8_STAGE(PG8_SB(0, 1), cB + hstep, voffB); PG8_STAGE(PG8_SA(0, 1), cA + hstep, voffA);
        if (wr == 1) PG8_BAR;
        PG8_WAIT_V(4); PG8_BAR;
        PG8_STAGE(PG8_SB(1, 0), cB + kstep, voffB); PG8_STAGE(PG8_SA(1, 0), cA + kstep, voffA); PG8_STAGE(PG8_SB(1, 1), cB + hstep + kstep, voffB);
        PG8_WAIT_V(6); PG8_BAR;
    }
    for (;;) {
        const bool has_next = S.next(ui + 1, nxt);
        const char* nA = has_next ? (const char*)g.A + (size_t)nxt.pm * tstep : cA; const char* nB = has_next ? (const char*)g.Bt + (size_t)nxt.pn * tstep : cB;
        for (int t = 0; t < nt; t += 2) {
            const bool last = (t == nt - 2);
            const char* a1 = cA + (size_t)(t + 1) * kstep;
            const char* a2 = last ? nA : cA + (size_t)(t + 2) * kstep; const char* b2 = last ? nB : cB + (size_t)(t + 2) * kstep;
            const char* a3 = a2 + kstep; const char* b3 = b2 + kstep;
            if (last && has_next) S.a_ready(nxt);
            if constexpr (SP2) {
            PG8_LDB(B0, 0, 0); PG8_LDB(B1, 0, 1); PG8_SCHED; PG8_LDA(At, 0, 0); PG8_STAGE(PG8_SA(1, 1), a1 + hstep, voffA);
            PG8_WAIT_V(8); PG8_WAIT_L(0); PG8_BAR; PG8_MMA(0, 0, At, B0); PG8_MMA(0, 1, At, B1); PG8_BAR; PG8_SCHED;
            PG8_LDA(At, 0, 1); PG8_STAGE(PG8_SB(0, 0), b2, voffB); PG8_STAGE(PG8_SB(0, 1), b2 + hstep, voffB); PG8_STAGE(PG8_SA(0, 0), a2, voffA);
            PG8_WAIT_V(8); PG8_WAIT_L(0); PG8_BAR; PG8_MMA(1, 0, At, B0); PG8_MMA(1, 1, At, B1); PG8_BAR; PG8_SCHED;
            PG8_LDB(B0, 1, 0); PG8_LDB(B1, 1, 1); PG8_SCHED; PG8_LDA(At, 1, 0); PG8_STAGE(PG8_SA(0, 1), a2 + hstep, voffA);
            PG8_WAIT_V(8); PG8_WAIT_L(0); PG8_BAR; PG8_MMA(0, 0, At, B0); PG8_MMA(0, 1, At, B1); PG8_BAR; PG8_SCHED;
            PG8_LDA(At, 1, 1); PG8_STAGE(PG8_SB(1, 0), b3, voffB); PG8_STAGE(PG8_SB(1, 1), b3 + hstep, voffB); PG8_STAGE(PG8_SA(1, 0), a3, voffA);
            PG8_WAIT_V(8); PG8_WAIT_L(0); PG8_BAR; PG8_MMA(1, 0, At, B0); PG8_MMA(1, 1, At, B1); PG8_BAR; PG8_SCHED;
            } else {
            PG8_LDB(B0, 0, 0); PG8_SCHED; PG8_LDA(At, 0, 0); PG8_STAGE(PG8_SA(1, 1), a1 + hstep, voffA);
            PG8_WAIT_L(8); PG8_BAR; PG8_WAIT_L(0); PG8_MMA(0, 0, At, B0); PG8_BAR; PG8_SCHED;
            PG8_LDB(B1, 0, 1); PG8_STAGE(PG8_SB(0, 0), b2, voffB);
            PG8_BAR; PG8_WAIT_L(0); PG8_MMA(0, 1, At, B1); PG8_BAR;
            PG8_LDA(At, 0, 1); PG8_STAGE(PG8_SA(0, 0), a2, voffA);
            PG8_BAR; PG8_WAIT_L(0); PG8_MMA(1, 0, At, B0); PG8_BAR; PG8_SCHED;
            PG8_STAGE(PG8_SB(0, 1), b2 + hstep, voffB);
            PG8_WAIT_V(6); PG8_BAR; PG8_MMA(1, 1, At, B1); PG8_BAR;
            PG8_LDB(B0, 1, 0); PG8_SCHED; PG8_LDA(At, 1, 0); PG8_STAGE(PG8_SA(0, 1), a2 + hstep, voffA);
            PG8_WAIT_L(8); PG8_BAR; PG8_WAIT_L(0); PG8_MMA(0, 0, At, B0); PG8_BAR; PG8_SCHED;
            PG8_LDB(B1, 1, 1); PG8_STAGE(PG8_SB(1, 0), b3, voffB);
            PG8_BAR; PG8_WAIT_L(0); PG8_MMA(0, 1, At, B1); PG8_BAR;
            PG8_LDA(At, 1, 1); PG8_STAGE(PG8_SA(1, 0), a3, voffA);
            PG8_BAR; PG8_WAIT_L(0); PG8_MMA(1, 0, At, B0); PG8_BAR; PG8_SCHED;
            PG8_STAGE(PG8_SB(1, 1), b3 + hstep, voffB);
            PG8_WAIT_V(6); PG8_BAR; PG8_MMA(1, 1, At, B1); PG8_BAR;
            }
        }
        if constexpr (ALIGN_EPI) { if (wr == 0) PG8_BAR; }
        if constexpr (!Epi::AFTER_DRAIN) { E(acc, cur, wr, wc, fr, fq); S.done(cur); }
        if (!has_next) break;
#pragma unroll
        for (int a = 0; a < 2; ++a)
#pragma unroll
            for (int b = 0; b < 2; ++b)
#pragma unroll
                for (int m = 0; m < 4; ++m)
#pragma unroll
                    for (int n = 0; n < 2; ++n) acc[a][b][m][n] = (f32x4){0.f, 0.f, 0.f, 0.f};
        cur = nxt; cA = nA; cB = nB; ++ui;
        if constexpr (ALIGN_EPI) { if (wr == 1) PG8_BAR; }
    }
    PG8_WAIT_V(0);
    if constexpr (!ALIGN_EPI) { if (wr == 0) PG8_BAR; }
    PG8_BAR;
    if constexpr (Epi::AFTER_DRAIN) { E.fused(acc, cur, wr, wc, fr, fq, lds, wid, lane); S.done(cur); }
#undef PG8_SA
#undef PG8_SB
#undef PG8_STAGE
#undef PG8_LDA
#undef PG8_LDB
#undef PG8_MMA
#undef PG8_WAIT_V
#undef PG8_WAIT_L
#undef PG8_BAR
#undef PG8_SCHED
}
}
#define XB_TMO      128
#define XB_XCNT(j)  (256  + 64 * (j))
#define XB_XSUB(j)  (1280 + 64 * (j))
#define XB_XGEN(j)  (2304 + 64 * (j))
#define XB_TOP      3328
#define XB_TOPGEN   3392
#define XCD_BAR_WORDS 3456
#define XB_SPIN_CAP (1u << 18)

__device__ __forceinline__ unsigned xb_ld(unsigned* p)              { return __hip_atomic_load(p, __ATOMIC_RELAXED, __HIP_MEMORY_SCOPE_AGENT); }
__device__ __forceinline__ unsigned xb_add(unsigned* p, unsigned v) { return __hip_atomic_fetch_add(p, v, __ATOMIC_RELAXED, __HIP_MEMORY_SCOPE_AGENT); }
__device__ __forceinline__ unsigned xb_xcc_id() { return (unsigned)__builtin_amdgcn_s_getreg((3 << 11) | 20) & 0xFu; }
#define XB_SPIN(cond, bar) do { unsigned _sp = 0; while (cond) { __builtin_amdgcn_s_sleep(1); \
    if ((++_sp & 255u) == 0u) { if (xb_ld(&(bar)[XB_TMO])) break; if (_sp > XB_SPIN_CAP) { atomicAdd(&(bar)[XB_TMO], 1u); break; } } } } while (0)

struct XcdBarrier {
    unsigned* bar; unsigned x;
    volatile LAS unsigned* st;
};

__device__ __forceinline__ XcdBarrier xcd_barrier_post(unsigned* bar, volatile LAS unsigned* st) {
    XcdBarrier b; b.bar = bar; b.x = xb_xcc_id(); b.st = st;
    if (threadIdx.x == 0) (void)xb_add(&bar[XB_XCNT(b.x)], 1u);
    return b;
}
__device__ __forceinline__ void xcd_barrier_complete(unsigned* bar, unsigned x, unsigned& nloc, unsigned& nx) {
    const unsigned G = gridDim.x * gridDim.y * gridDim.z;
    unsigned sum, cnt, mine, sp = 0u;
    for (;;) {
        sum = 0u; cnt = 0u; mine = 0u;
#pragma unroll
        for (unsigned j = 0; j < 16; ++j) { const unsigned c = xb_ld(&bar[XB_XCNT(j)]); sum += c; cnt += (c > 0u) ? 1u : 0u; mine = (j == x) ? c : mine; }
        if (sum == G) break;
        __builtin_amdgcn_s_sleep(1);
        if ((++sp & 255u) == 0u) { if (xb_ld(&bar[XB_TMO])) break; if (sp > XB_SPIN_CAP) { atomicAdd(&bar[XB_TMO], 1u); break; } }
    }
    nloc = mine > 0u ? mine : 1u; nx = cnt > 0u ? cnt : 1u;
}

__device__ __forceinline__ void xcd_barrier(const XcdBarrier& b) {
    asm volatile("s_waitcnt vmcnt(0)" ::: "memory");
    __syncthreads();
    if (threadIdx.x == 0) {
        unsigned* bar = b.bar; asm volatile("" : "+s"(bar));
        const unsigned bx_ = xb_xcc_id();
        __builtin_amdgcn_s_waitcnt(0);
        unsigned nloc = b.st[0], nx = b.st[1];
        if (nloc == 0u) { xcd_barrier_complete(bar, bx_, nloc, nx); b.st[0] = nloc; b.st[1] = nx; }
        const unsigned old = xb_add(&bar[XB_XSUB(bx_)], 1u);
        const unsigned gen = old / nloc;
        if (old + 1u == (gen + 1u) * nloc) {
            __builtin_amdgcn_fence(__ATOMIC_RELEASE, "agent");
            asm volatile("s_waitcnt vmcnt(0)" ::: "memory");
            const unsigned og = xb_add(&bar[XB_TOP], 1u);
            const unsigned tg = og / nx;
            if (og + 1u == (tg + 1u) * nx) xb_add(&bar[XB_TOPGEN], 1u);
            else XB_SPIN(xb_ld(&bar[XB_TOPGEN]) == tg, bar);
            __builtin_amdgcn_fence(__ATOMIC_ACQUIRE, "agent");
            xb_add(&bar[XB_XGEN(bx_)], 1u);
            asm volatile("s_waitcnt vmcnt(0)" ::: "memory");
        } else {
            XB_SPIN(xb_ld(&bar[XB_XGEN(bx_)]) == gen, bar);
            __builtin_amdgcn_fence(__ATOMIC_ACQUIRE, "agent");
            asm volatile("s_waitcnt vmcnt(0)" ::: "memory");
        }
    }
    __syncthreads();
}
#define LDS_WAIT() asm volatile("s_waitcnt lgkmcnt(0)" ::: "memory")
__device__ __forceinline__ void unpack8(const v4u w, float* f) { f[0] = bflo(w.x); f[1] = bfhi(w.x); f[2] = bflo(w.y); f[3] = bfhi(w.y); f[4] = bflo(w.z); f[5] = bfhi(w.z); f[6] = bflo(w.w); f[7] = bfhi(w.w); }

__device__ __forceinline__ int win_src(int c) {
    if (c < 1152) return c;
    if (c < 2304) return c + 1038;
    if (c < 3072) return c - 1146;
    if (c < 3328) return c - 1138;
    if (c < 3334) return c - 3328 + 1152;
    if (c < 3338) return c - 3334 + 1926;
    if (c < 3342) return c - 3338 + 1930;
    return -1;
}
__device__ __forceinline__ int wgu_src(int r) { const int pn = r >> 8, w = r & 255; return (w < 128 ? 0 : DFF) + pn * 128 + (w & 127); }
template <int MODE> __device__ __forceinline__ int src_col(int r) { if (MODE == 1) return win_src(r); if (MODE == 2) return wgu_src(r); return r; }

template <int MODE> __device__ __forceinline__ void transpose_item(const float* W, int K, int ldw, bf16* WT, LAS float* scr, int nblk, int item, int lane) {
    const int kb = item / nblk, nb = item % nblk, k0 = 64 * kb, n0 = 32 * nb;
    const int sc = src_col<MODE>(n0 + (lane & 31));
#pragma unroll 8
    for (int i = 0; i < 32; ++i) { const int kk = 2 * i + (lane >> 5); scr[kk * 33 + (lane & 31)] = (sc >= 0) ? W[(size_t)(k0 + kk) * ldw + sc] : 0.f; }
    LDS_WAIT(); asm volatile("" ::: "memory");
    const int c = lane & 7;
#pragma unroll
    for (int j = 0; j < 4; ++j) { const int n = (lane >> 3) + 8 * j; const LAS float* s = scr + (8 * c) * 33 + n;
        v4u o; o.x = pk2(s[0 * 33], s[1 * 33]); o.y = pk2(s[2 * 33], s[3 * 33]); o.z = pk2(s[4 * 33], s[5 * 33]); o.w = pk2(s[6 * 33], s[7 * 33]);
        *(GAS v4u*)(WT + (size_t)(n0 + n) * K + k0 + 8 * c) = o; }
    LDS_WAIT(); asm volatile("" ::: "memory");
}

__device__ __forceinline__ void p0_mod_unit(int u, const float* cvec, const float* w_ada, const float* b_ada, float* mod, LAS float* lds, int tid, int wave, int lane) {
    LAS float* sc = lds; LAS float* red = lds + 2048;
    for (int i = tid; i < 2048; i += NTHREADS) { const float v = cvec[i]; sc[i] = v / (1.f + expf(-v)); }
    __syncthreads();
    const int l = u / 96, n = (u % 96) * 64 + lane;
    const float* wp = w_ada + ((size_t)l * 1024 + wave * 128) * 6144 + n;
    float a0 = 0.f, a1 = 0.f;
#pragma unroll 16
    for (int kk = 0; kk < 128; ++kk) { const float w = wp[(size_t)kk * 6144]; a0 += sc[wave * 128 + kk] * w; a1 += sc[1024 + wave * 128 + kk] * w; }
    red[(wave * 2 + 0) * 64 + lane] = a0; red[(wave * 2 + 1) * 64 + lane] = a1;
    __syncthreads();
    if (tid < 128) { const int b = tid >> 6; float s = 0.f;
#pragma unroll
        for (int w = 0; w < 8; ++w) s += red[(w * 2 + b) * 64 + lane];
        mod[((size_t)l * 2 + b) * 6144 + n] = s + b_ada[l * 6144 + n]; }
    __syncthreads();
}

__device__ __forceinline__ void pre_rows(const float* xsrc, const float* g, const float* mod_b0, bf16* XA, float* SSP, int gw, int NGW, int lane) {
    for (int m = gw; m < MROWS; m += NGW) {
        const int b = m / SEQ; const float* mb = mod_b0 + (size_t)b * 6144;
        const GAS f32x4* xr = (const GAS f32x4*)(xsrc + (size_t)m * DM) + lane;
        f32x4 v[4]; float ss = 0.f;
#pragma unroll
        for (int j = 0; j < 4; ++j) { v[j] = xr[64 * j]; ss += (v[j].x * v[j].x + v[j].y * v[j].y) + (v[j].z * v[j].z + v[j].w * v[j].w); }
        const float tot = wave_sum(ss);
        if (lane < 16) SSP[(size_t)m * 16 + lane] = lane == 0 ? tot : 0.f;
        GAS v2u* o8 = (GAS v2u*)(XA + (size_t)m * DM) + lane;
#pragma unroll
        for (int j = 0; j < 4; ++j) { const int col = 4 * lane + 256 * j;
            const f32x4 gg = *(const f32x4*)(g + col), sv = *(const f32x4*)(mb + 1024 + col);
            const f32x4 o = v[j] * gg * (sv + 1.0f);
            v2u w; w.x = pk2(o.x, o.y); w.y = pk2(o.z, o.w); o8[64 * j] = w; }
    }
}
__device__ __forceinline__ void pre_avec(const float* n1g, const float* n2g, const float* MODp, float* AVEC, int gtid, int ngt) {
    for (int i = gtid; i < DEPTH * 2 * 2 * 1024; i += ngt) { const int col = i & 1023, b = (i >> 10) & 1, w = (i >> 11) & 1, l = i >> 12;
        const float g = (w ? n2g : n1g)[l * 1024 + col], sc = MODp[((size_t)l * 2 + b) * 6144 + (w ? 4096 : 1024) + col];
        AVEC[i] = g * (1.f + sc); }
}
__device__ __forceinline__ void pre_bias(const bf16* WT, int nrows, const float* sh0, const float* sh1, float* bias0, float* bias1, int gw, int NGW, int lane) {
    for (int n = gw; n < nrows; n += NGW) {
        float w[16]; unpack8(*(const v4u*)(WT + (size_t)n * 1024 + lane * 16), w); unpack8(*(const v4u*)(WT + (size_t)n * 1024 + lane * 16 + 8), w + 8);
        float a0 = 0.f, a1 = 0.f;
#pragma unroll
        for (int q4 = 0; q4 < 4; ++q4) { const f32x4 s0 = *(const f32x4*)(sh0 + lane * 16 + 4 * q4), s1 = *(const f32x4*)(sh1 + lane * 16 + 4 * q4);
            a0 += (w[4 * q4] * s0.x + w[4 * q4 + 1] * s0.y) + (w[4 * q4 + 2] * s0.z + w[4 * q4 + 3] * s0.w);
            a1 += (w[4 * q4] * s1.x + w[4 * q4 + 1] * s1.y) + (w[4 * q4 + 2] * s1.z + w[4 * q4 + 3] * s1.w); }
        a0 = wave_sum(a0); a1 = wave_sum(a1);
        if (lane == 0) { bias0[n] = a0; bias1[n] = a1; }
    }
}
template <class Sched> __device__ __forceinline__ int rstd_tables(const Sched& S, const float* SSP, LAS float* rt, const float* bias, int bstride, LAS float* bt, int tid) {
    pg8::Unit u; int pm0 = -1, pm1 = -1;
    for (int i = 0; S.next(i, u); ++i) { if (pm0 < 0) pm0 = u.pm; else if (u.pm != pm0 && pm1 < 0) pm1 = u.pm;
        if (tid < 64) *(LAS f32x4*)(bt + i * 256 + tid * 4) = *(const f32x4*)(bias + (size_t)((u.pm * 256) / SEQ) * bstride + u.pn * 256 + tid * 4); }
    if (tid < 256) {
#pragma unroll
        for (int slot = 0; slot < 2; ++slot) { const int pm = slot ? pm1 : pm0;
            if (pm >= 0) { const float* sp = SSP + ((size_t)pm * 256 + tid) * 16;
                const f32x4 a = *(const f32x4*)sp, b = *(const f32x4*)(sp + 4), c = *(const f32x4*)(sp + 8), d = *(const f32x4*)(sp + 12);
                const float s = (((a.x + a.y) + (a.z + a.w)) + ((b.x + b.y) + (b.z + b.w))) + (((c.x + c.y) + (c.z + c.w)) + ((d.x + d.y) + (d.z + d.w)));
                rt[slot * 256 + tid] = 1.f / sqrtf(s * (1.f / DM) + EPS); } }
    }
    __syncthreads();
    return pm0;
}

__device__ __forceinline__ void post_foxcum_unit(int bh, const float* GATESp, float* FOXCUMp, const float* fox_f_bias, LAS float* lds, int tid, int wave, int lane) {
    const int b = bh / 6, h = bh % 6; const float bias = fox_f_bias[h];
    float v[32];
#pragma unroll
    for (int r = 0; r < 32; ++r) { const int t = wave * 2048 + r * 64 + lane; v[r] = log_sigmoid_f(GATESp[((size_t)b * SEQ + t) * 16 + h] + bias) * LOG2E; }
    float carry = 0.f;
#pragma unroll
    for (int r = 0; r < 32; ++r) { float x = v[r];
#pragma unroll
        for (int o = 1; o < 64; o <<= 1) { const float n = sup(x, o, lane); if (lane >= o) x += n; }
        x += carry; v[r] = x; carry = shf(x, 63); }
    if (lane == 0) lds[wave] = carry;
    __syncthreads();
    float off = 0.f;
    for (int w = 0; w < wave; ++w) off += lds[w];
#pragma unroll
    for (int r = 0; r < 32; ++r) FOXCUMp[(size_t)bh * SEQ + wave * 2048 + r * 64 + lane] = v[r] + off;
    __syncthreads();
}
__device__ __forceinline__ void post_qknorm_unit(int u, bf16* PROJp, float* KMEANP, const float* gfq, const float* gfk, const float* gbq, const float* gbk, LAS float* lds, int tid, int wave, int lane) {
    const int blk = u >> 1, half = u & 1, sub = lane & 7;
    int colv[3]; float gv[3][8]; float qsv[3];
#pragma unroll
    for (int it = 0; it < 3; ++it) { const int hsel = it * 8 + (lane >> 3), grp = hsel / 6, hh = hsel % 6;
        colv[it] = (grp == 0 ? C_FQ : grp == 1 ? C_FK : grp == 2 ? C_BQ : C_BK) + hh * 64 + 8 * sub;
        const float* gp = (grp == 0 ? gfq : grp == 1 ? gfk : grp == 2 ? gbq : gbk) + 8 * sub;
#pragma unroll
        for (int i = 0; i < 8; ++i) gv[it][i] = gp[i];
        qsv[it] = (grp == 0 || grp == 2) ? QSCALE : 1.f; }
    float ka[8] = {0.f, 0.f, 0.f, 0.f, 0.f, 0.f, 0.f, 0.f};
    const size_t row0 = (size_t)blk * 256 + half * 128 + wave * 16;
#pragma unroll 4
    for (int r = 0; r < 16; ++r) {
#pragma unroll
        for (int it = 0; it < 3; ++it) {
            v4u* p = (v4u*)(PROJp + (row0 + r) * PLD + colv[it]);
            float f[8]; unpack8(*p, f);
            float ss = 0.f;
#pragma unroll
            for (int i = 0; i < 8; ++i) ss += f[i] * f[i];
            ss += SWZ_X(ss, 1); ss += SWZ_X(ss, 2); ss += SWZ_X(ss, 4);
            const float rr = 1.f / sqrtf(ss * (1.f / 64.f) + EPS);
#pragma unroll
            for (int i = 0; i < 8; ++i) f[i] = f[i] * rr * gv[it][i];
            if (it == 2) {
#pragma unroll
                for (int i = 0; i < 8; ++i) ka[i] += f[i]; }
            const float qs = qsv[it];
            v4u w; w.x = pk2(f[0] * qs, f[1] * qs); w.y = pk2(f[2] * qs, f[3] * qs); w.z = pk2(f[4] * qs, f[5] * qs); w.w = pk2(f[6] * qs, f[7] * qs);
            *p = w;
        }
    }
    if (lane >= 16) {
#pragma unroll
        for (int i = 0; i < 8; ++i) lds[wave * 384 + ((lane >> 3) - 2) * 64 + 8 * sub + i] = ka[i]; }
    __syncthreads();
    if (tid < 384) { float s = 0.f;
#pragma unroll
        for (int w = 0; w < 8; ++w) s += lds[w * 384 + tid];
        const int b = blk / NBLK, n = blk % NBLK, head = tid >> 6, dd = tid & 63;
        KMEANP[(size_t)half * (12 * NBLK * 64) + (((size_t)b * 6 + head) * NBLK + n) * 64 + dd] = s * (1.f / 256.f); }
    __syncthreads();
}
__device__ __forceinline__ void post_conv_unit(int blk, int which, const bf16* PROJp, bf16* dst, const float* conv_w, const float* conv_b, int tid) {
    const bf16* src = PROJp + (which ? C_MK : C_MQ); const float osc = which ? 0.125f : 1.f;
    const int c = 8 * (tid & 31), rs = tid >> 5, ch = which * 256 + c;
    const size_t r0 = (size_t)blk * 256 + rs * 16; const int tl = (int)(r0 % SEQ);
    float w[4][8], bb[8];
#pragma unroll
    for (int i = 0; i < 4; ++i) { const f32x4 a = *(const f32x4*)(conv_w + i * 512 + ch), b2 = *(const f32x4*)(conv_w + i * 512 + ch + 4);
        w[i][0] = a.x; w[i][1] = a.y; w[i][2] = a.z; w[i][3] = a.w; w[i][4] = b2.x; w[i][5] = b2.y; w[i][6] = b2.z; w[i][7] = b2.w; }
    { const f32x4 a = *(const f32x4*)(conv_b + ch), b2 = *(const f32x4*)(conv_b + ch + 4); bb[0] = a.x; bb[1] = a.y; bb[2] = a.z; bb[3] = a.w; bb[4] = b2.x; bb[5] = b2.y; bb[6] = b2.z; bb[7] = b2.w; }
    float x0[8], x1[8], x2[8], x3[8];
    { v4u h3[3];
#pragma unroll
      for (int k = 0; k < 3; ++k) { if (tl + k - 3 >= 0) h3[k] = *(const v4u*)(src + (r0 + k - 3) * PLD + c); else h3[k] = (v4u){0u, 0u, 0u, 0u}; }
      unpack8(h3[0], x0); unpack8(h3[1], x1); unpack8(h3[2], x2); }
#pragma unroll 1
    for (int hb = 0; hb < 2; ++hb) {
        v4u in[8];
#pragma unroll
        for (int k = 0; k < 8; ++k) in[k] = *(const v4u*)(src + (r0 + hb * 8 + k) * PLD + c);
#pragma unroll
        for (int r = 0; r < 8; ++r) {
            unpack8(in[r], x3);
            float y[8];
#pragma unroll
            for (int i = 0; i < 8; ++i) { const float t = bb[i] + w[0][i] * x0[i] + w[1][i] * x1[i] + w[2][i] * x2[i] + w[3][i] * x3[i];
                y[i] = t * __builtin_amdgcn_rcpf(1.f + __builtin_amdgcn_exp2f(-t * LOG2E)) * osc; x0[i] = x1[i]; x1[i] = x2[i]; x2[i] = x3[i]; }
            v4u o; o.x = pk2(y[0], y[1]); o.y = pk2(y[2], y[3]); o.z = pk2(y[4], y[5]); o.w = pk2(y[6], y[7]);
            *(v4u*)(dst + (r0 + hb * 8 + r) * 256 + c) = o;
        }
    }
}

struct MlP { const bf16* PROJ; const bf16* QC; const bf16* KC; const float* GATES; float* U; float* NU; float* BEND; float* MLOC; bf16* CS; float* NS; float* MS; bf16* Y;
             const float *ibias, *fbias, *hg; };
__device__ __forceinline__ void mlstm_m1(int ci, const MlP& P, LAS float* lds, int tid, int wave, int lane) {
    const int b = ci >> 10, h = (ci >> 8) & 3, c = ci & 255; const size_t row0 = (size_t)b * SEQ + c * 64;
    LAS float* Ks = lds; LAS float* Vs = lds + 4096; LAS float* ws = lds + 8192;
    { const int r = tid >> 3, cg = (tid & 7) * 8; float f[8];
      unpack8(*(const v4u*)(P.KC + (row0 + r) * 256 + h * 64 + cg), f);
#pragma unroll
      for (int i = 0; i < 8; ++i) Ks[r * 64 + cg + i] = f[i];
      unpack8(*(const v4u*)(P.PROJ + (row0 + r) * PLD + C_MV + h * 64 + cg), f);
#pragma unroll
      for (int i = 0; i < 8; ++i) Vs[r * 64 + cg + i] = f[i]; }
    if (wave == 0) {
        const size_t row = row0 + lane;
        const float fi = P.GATES[row * 16 + 6 + h] + P.ibias[h], ff = P.GATES[row * 16 + 10 + h] + P.fbias[h];
        float bc = log_sigmoid_f(ff);
#pragma unroll
        for (int o = 1; o < 64; o <<= 1) { const float n = sup(bc, o, lane); if (lane >= o) bc += n; }
        const float bend = shf(bc, 63);
        const float wl = bend - bc + fi; const float mloc = wave_max(wl);
        ws[lane] = expf(wl - mloc);
        if (lane == 0) { P.BEND[ci] = bend; P.MLOC[ci] = mloc; }
    }
    __syncthreads();
    { const int dv = tid >> 3, e0 = (tid & 7) * 8; float u[8] = {0.f, 0.f, 0.f, 0.f, 0.f, 0.f, 0.f, 0.f};
#pragma unroll 2
      for (int s = 0; s < 64; ++s) { const float vw = Vs[s * 64 + dv] * ws[s]; const f32x4 ka = *(const LAS f32x4*)(Ks + s * 64 + e0), kb = *(const LAS f32x4*)(Ks + s * 64 + e0 + 4);
          u[0] += vw * ka.x; u[1] += vw * ka.y; u[2] += vw * ka.z; u[3] += vw * ka.w; u[4] += vw * kb.x; u[5] += vw * kb.y; u[6] += vw * kb.z; u[7] += vw * kb.w; }
      float* up = P.U + (size_t)ci * 4096 + dv * 64 + e0;
      *(f32x4*)up = (f32x4){u[0], u[1], u[2], u[3]}; *(f32x4*)(up + 4) = (f32x4){u[4], u[5], u[6], u[7]}; }
    if (tid < 64) { float nu = 0.f; for (int s = 0; s < 64; ++s) nu += ws[s] * Ks[s * 64 + tid]; P.NU[(size_t)ci * 64 + tid] = nu; }
    __syncthreads();
}
__device__ __forceinline__ void mlstm_m2(int u, const MlP& P, int tid) {
    const int bh = u >> 3, eg = u & 7, elem = eg * 512 + tid, base = bh * 256;
    const bool donorm = (eg == 0 && tid < 64), doms = (eg == 0 && tid == 0);
    float C = 0.f, m = 0.f, nst = 0.f;
    for (int c0 = 0; c0 < 256; c0 += 8) {
        float uv[8], be[8], ml[8], nv[8];
#pragma unroll
        for (int i = 0; i < 8; ++i) { const int ci = base + c0 + i; uv[i] = P.U[(size_t)ci * 4096 + elem]; be[i] = P.BEND[ci]; ml[i] = P.MLOC[ci]; nv[i] = donorm ? P.NU[(size_t)ci * 64 + tid] : 0.f; }
#pragma unroll
        for (int i = 0; i < 8; ++i) { const int ci = base + c0 + i;
            P.CS[(size_t)ci * 4096 + elem] = (bf16)f2bf(C);
            if (donorm) P.NS[(size_t)ci * 64 + tid] = nst;
            if (doms) P.MS[ci] = m;
            const float mn = fmaxf(be[i] + m, ml[i]); const float dec = expf(be[i] + m - mn), wu = expf(ml[i] - mn);
            C = dec * C + wu * uv[i]; nst = dec * nst + wu * nv[i]; m = mn; }
    }
}
__device__ __forceinline__ void mlstm_m3(int ci, const MlP& P, LAS float* lds, int tid, int wave, int lane) {
    constexpr int LP = 68;
    const int b = ci >> 10, h = (ci >> 8) & 3, c = ci & 255; const size_t row0 = (size_t)b * SEQ + c * 64;
    LAS float* Qs = lds; LAS float* Ks = Qs + 64 * LP; LAS float* Cs = Ks + 64 * LP; LAS float* Sm = Cs + 64 * LP; LAS float* Vs = Sm + 64 * LP;
    LAS float* av = Vs + 4096; LAS float* gv = av + 64; LAS float* bcv = gv + 64; LAS float* nsv = bcv + 64;
    const float ms = P.MS[ci];
    { const int r = tid >> 3, cg = (tid & 7) * 8; float f[8];
      unpack8(*(const v4u*)(P.QC + (row0 + r) * 256 + h * 64 + cg), f);
#pragma unroll
      for (int i = 0; i < 8; ++i) Qs[r * LP + cg + i] = f[i];
      unpack8(*(const v4u*)(P.KC + (row0 + r) * 256 + h * 64 + cg), f);
#pragma unroll
      for (int i = 0; i < 8; ++i) Ks[r * LP + cg + i] = f[i];
      unpack8(*(const v4u*)(P.PROJ + (row0 + r) * PLD + C_MV + h * 64 + cg), f);
#pragma unroll
      for (int i = 0; i < 8; ++i) Vs[r * 64 + cg + i] = f[i];
      unpack8(*(const v4u*)(P.CS + (size_t)ci * 4096 + r * 64 + cg), f);
#pragma unroll
      for (int i = 0; i < 8; ++i) Cs[r * LP + cg + i] = f[i]; }
    if (wave == 0) {
        const size_t row = row0 + lane;
        const float fi = P.GATES[row * 16 + 6 + h] + P.ibias[h], ff = P.GATES[row * 16 + 10 + h] + P.fbias[h];
        float bc = log_sigmoid_f(ff);
#pragma unroll
        for (int o = 1; o < 64; o <<= 1) { const float n = sup(bc, o, lane); if (lane >= o) bc += n; }
        const float a = fi - bc; float pm = a;
#pragma unroll
        for (int o = 1; o < 64; o <<= 1) { const float n = sup(pm, o, lane); if (lane >= o) pm = fmaxf(pm, n); }
        av[lane] = a; gv[lane] = fmaxf(ms, pm); bcv[lane] = bc; nsv[lane] = P.NS[(size_t)ci * 64 + lane];
    }
    __syncthreads();
    const int j = tid >> 3, part = tid & 7, s0 = part * 8;
    const float gj = gv[j];
    { float sacc[8] = {0.f, 0.f, 0.f, 0.f, 0.f, 0.f, 0.f, 0.f};
#pragma unroll 1
      for (int e = 0; e < 64; e += 4) { const f32x4 q4 = *(const LAS f32x4*)(Qs + j * LP + e);
#pragma unroll
          for (int i = 0; i < 8; ++i) { const f32x4 k4 = *(const LAS f32x4*)(Ks + (s0 + i) * LP + e); sacc[i] += (q4.x * k4.x + q4.y * k4.y) + (q4.z * k4.z + q4.w * k4.w); } }
#pragma unroll
      for (int i = 0; i < 8; ++i) { const int s = s0 + i; Sm[j * LP + s] = (s <= j) ? sacc[i] * expf(av[s] - gj) : 0.f; } }
    __syncthreads();
    { const int dv0 = part * 8; float t1[8] = {0.f, 0.f, 0.f, 0.f, 0.f, 0.f, 0.f, 0.f}, t2[8] = {0.f, 0.f, 0.f, 0.f, 0.f, 0.f, 0.f, 0.f};
#pragma unroll 1
      for (int e = 0; e < 64; e += 4) { const f32x4 q4 = *(const LAS f32x4*)(Qs + j * LP + e);
#pragma unroll
          for (int i = 0; i < 8; ++i) { const f32x4 c4 = *(const LAS f32x4*)(Cs + (dv0 + i) * LP + e); t1[i] += (q4.x * c4.x + q4.y * c4.y) + (q4.z * c4.z + q4.w * c4.w); } }
#pragma unroll 2
      for (int s = 0; s < 64; ++s) { const float sm = Sm[j * LP + s]; const f32x4 va = *(const LAS f32x4*)(Vs + s * 64 + dv0), vb = *(const LAS f32x4*)(Vs + s * 64 + dv0 + 4);
          t2[0] += sm * va.x; t2[1] += sm * va.y; t2[2] += sm * va.z; t2[3] += sm * va.w; t2[4] += sm * vb.x; t2[5] += sm * vb.y; t2[6] += sm * vb.z; t2[7] += sm * vb.w; }
      float dn = 0.f, ssum = 0.f;
#pragma unroll
      for (int i = 0; i < 8; ++i) { dn += nsv[s0 + i] * Qs[j * LP + s0 + i]; ssum += Sm[j * LP + s0 + i]; }
      { dn += SWZ_X(dn, 1); ssum += SWZ_X(ssum, 1); dn += SWZ_X(dn, 2); ssum += SWZ_X(ssum, 2); dn += SWZ_X(dn, 4); ssum += SWZ_X(ssum, 4); }
      const float inter = expf(ms - gj), mj = bcv[j] + gj;
      const float den = inter * dn + ssum, dd = fmaxf(fabsf(den), expf(-mj)), rd = 1.f / dd;
      float hv[8], ss = 0.f;
#pragma unroll
      for (int i = 0; i < 8; ++i) { hv[i] = (inter * t1[i] + t2[i]) * rd; ss += hv[i] * hv[i]; }
      { ss += SWZ_X(ss, 1); ss += SWZ_X(ss, 2); ss += SWZ_X(ss, 4); }
      const float rr = 1.f / sqrtf(ss * (1.f / 64.f) + EPS);
      float mo[8]; unpack8(*(const v4u*)(P.PROJ + (row0 + j) * PLD + C_MO + h * 64 + dv0), mo);
      float y[8];
#pragma unroll
      for (int i = 0; i < 8; ++i) y[i] = hv[i] * rr * P.hg[h * 64 + dv0 + i] * sigmoid_f(mo[i]);
      v4u w; w.x = pk2(y[0], y[1]); w.y = pk2(y[2], y[3]); w.z = pk2(y[4], y[5]); w.w = pk2(y[6], y[7]);
      *(v4u*)(P.Y + (row0 + j) * 1024 + Y_ML + h * 64 + dv0) = w; }
    __syncthreads();
}

__device__ __forceinline__ size_t moba_list_off(int bh, int n);
__device__ __forceinline__ void moba_gate_unit(int u, const bf16* PROJ, const float* KMEAN, unsigned* SEL, unsigned* LCNT, unsigned* CTAB, unsigned short* LIST, float B2, float thresh2, LAS float* lds, int tid) {
    const int bh = u >> 6, qb = 63 - (u & 63), b = bh / 6, h = bh % 6;
    LAS float* km = lds; LAS float* cand = lds + 4096; LAS unsigned* cntl = (LAS unsigned*)(lds + 4096 + 1536);
    if (tid < 64) cntl[tid] = 0u;
    for (int i = tid; i < qb * 16; i += NTHREADS) *(LAS f32x4*)(km + i * 4) = *(const f32x4*)(KMEAN + (size_t)bh * NBLK * 64 + i * 4) + *(const f32x4*)(KMEAN + (size_t)(12 * NBLK * 64) + (size_t)bh * NBLK * 64 + i * 4);
    __syncthreads();
    const int query = tid & 255, half = tid >> 8; const size_t row = (size_t)b * SEQ + qb * 256 + query;
    float q[64];
#pragma unroll
    for (int i = 0; i < 8; ++i) unpack8(*(const v4u*)(PROJ + row * PLD + C_BQ + h * 64 + i * 8), q + i * 8);
    float v0 = -INFINITY, v1 = -INFINITY, v2 = -INFINITY; int i0 = 255, i1 = 255, i2 = 255;
    const int nlo = half * 32, nhi = (qb < nlo + 32) ? qb : nlo + 32;
    for (int n = nlo; n < nhi; ++n) { float g = 0.f;
#pragma unroll
        for (int d = 0; d < 64; d += 4) { const f32x4 k4 = *(const LAS f32x4*)(km + n * 64 + d); g += (q[d] * k4.x + q[d + 1] * k4.y) + (q[d + 2] * k4.z + q[d + 3] * k4.w); }
        if (g > v0) { v2 = v1; i2 = i1; v1 = v0; i1 = i0; v0 = g; i0 = n; } else if (g > v1) { v2 = v1; i2 = i1; v1 = g; i1 = n; } else if (g > v2) { v2 = g; i2 = n; } }
    if (half == 1) { cand[query * 6 + 0] = v0; cand[query * 6 + 1] = v1; cand[query * 6 + 2] = v2;
        cand[query * 6 + 3] = __int_as_float(i0); cand[query * 6 + 4] = __int_as_float(i1); cand[query * 6 + 5] = __int_as_float(i2); }
    __syncthreads();
    if (half == 0) {
#pragma unroll
        for (int k = 0; k < 3; ++k) { const float g = cand[query * 6 + k]; const int n = __float_as_int(cand[query * 6 + 3 + k]);
            if (n != 255) { if (g > v0) { v2 = v1; i2 = i1; v1 = v0; i1 = i0; v0 = g; i0 = n; } else if (g > v1) { v2 = v1; i2 = i1; v1 = g; i1 = n; } else if (g > v2) { v2 = g; i2 = n; } } }
        { const float slope2 = exp2f(-8.f * (float)(h + 1) / 6.f) * LOG2E; const float lim = (2.f * B2 + thresh2) / slope2; const int t0 = qb * 256 + query - 255;
          if (i0 != 255 && (float)(t0 - i0 * 256) > lim) i0 = 255;
          if (i1 != 255 && (float)(t0 - i1 * 256) > lim) i1 = 255;
          if (i2 != 255 && (float)(t0 - i2 * 256) > lim) i2 = 255; }
        SEL[row * 6 + h] = (unsigned)i0 | ((unsigned)i1 << 8) | ((unsigned)i2 << 16);
        if (LIST) { const unsigned t = (unsigned)(qb * 256 + query);
            if (i0 != 255) { const unsigned pos = __hip_atomic_fetch_add(cntl + i0, 1u, __ATOMIC_RELAXED, __HIP_MEMORY_SCOPE_WORKGROUP); LIST[moba_list_off(bh, i0) + (size_t)(qb - i0 - 1) * 256 + pos] = (unsigned short)(t | (0u << 14)); }
            if (i1 != 255) { const unsigned pos = __hip_atomic_fetch_add(cntl + i1, 1u, __ATOMIC_RELAXED, __HIP_MEMORY_SCOPE_WORKGROUP); LIST[moba_list_off(bh, i1) + (size_t)(qb - i1 - 1) * 256 + pos] = (unsigned short)(t | (1u << 14)); }
            if (i2 != 255) { const unsigned pos = __hip_atomic_fetch_add(cntl + i2, 1u, __ATOMIC_RELAXED, __HIP_MEMORY_SCOPE_WORKGROUP); LIST[moba_list_off(bh, i2) + (size_t)(qb - i2 - 1) * 256 + pos] = (unsigned short)(t | (2u << 14)); } }
    }
    __syncthreads();
    if (LIST && tid < 64) { const unsigned c = cntl[tid]; CTAB[((size_t)bh * 64 + qb) * 64 + tid] = c; if (c) atomicAdd(LCNT + bh * 64 + tid, c); }
    __syncthreads();
}

__device__ __forceinline__ void fox_naive(const bf16* PROJ, const float* FOXCUM, bf16* Y, int gw, int NGW, int lane) {
    for (int idx = gw; idx < 12 * SEQ; idx += NGW) {
        const int t = SEQ - 1 - idx / 12, bh = idx % 12, b = bh / 6, h = bh % 6; const size_t rb = (size_t)b * SEQ;
        const float qv = bf2f(PROJ[(rb + t) * PLD + C_FQ + h * 64 + lane]); const float ct = FOXCUM[(size_t)bh * SEQ + t];
        float m = -INFINITY, l = 0.f, acc = 0.f;
#pragma unroll 4
        for (int j = 0; j <= t; ++j) {
            const float kv = bf2f(PROJ[(rb + j) * PLD + C_FK + h * 64 + lane]), vv = bf2f(PROJ[(rb + j) * PLD + C_FV + h * 64 + lane]);
            const float s = wave_sum(qv * kv) + (ct - FOXCUM[(size_t)bh * SEQ + j]);
            const float mn = fmaxf(m, s), sc = exp2f(m - mn), p = exp2f(s - mn);
            l = l * sc + p; acc = acc * sc + p * vv; m = mn; }
        Y[(rb + t) * 1024 + Y_FOX + h * 64 + lane] = (bf16)f2bf(acc / l);
    }
}
__device__ __forceinline__ void moba_naive(const bf16* PROJ, const unsigned* SEL, bf16* Y, int gw, int NGW, int lane) {
    for (int idx = gw; idx < 12 * SEQ; idx += NGW) {
        const int t = SEQ - 1 - idx / 12, bh = idx % 12, b = bh / 6, h = bh % 6; const size_t rb = (size_t)b * SEQ;
        const float slope2 = exp2f(-8.f * (float)(h + 1) / 6.f) * LOG2E;
        const float qv = bf2f(PROJ[(rb + t) * PLD + C_BQ + h * 64 + lane]);
        const unsigned sel = SEL[(rb + t) * 6 + h];
        float m = -INFINITY, l = 0.f, acc = 0.f;
        for (int slot = 0; slot < 4; ++slot) {
            int j0, j1;
            if (slot < 3) { const int n = (sel >> (8 * slot)) & 0xff; if (n == 255) continue; j0 = n * 256; j1 = j0 + 256; } else { j0 = (t >> 8) * 256; j1 = t + 1; }
#pragma unroll 4
            for (int j = j0; j < j1; ++j) {
                const float kv = bf2f(PROJ[(rb + j) * PLD + C_BK + h * 64 + lane]), vv = bf2f(PROJ[(rb + j) * PLD + C_BV + h * 64 + lane]);
                const float s = wave_sum(qv * kv) - slope2 * (float)(t - j);
                const float mn = fmaxf(m, s), sc = exp2f(m - mn), p = exp2f(s - mn);
                l = l * sc + p; acc = acc * sc + p * vv; m = mn; }
        }
        Y[(rb + t) * 1024 + Y_MOBA + h * 64 + lane] = (bf16)f2bf(acc / l);
    }
}
typedef short v4i16_t __attribute__((ext_vector_type(4)));
typedef short s16x4 __attribute__((ext_vector_type(4)));
constexpr int ATT_K0 = 0, ATT_V0 = 32768, ATT_TAB = 132096;
#ifndef THRESH_NAT
#define THRESH_NAT 30.f
#endif
constexpr float THRESH2 = THRESH_NAT * LOG2E;

__device__ __forceinline__ int crow(int r, int hi) { return (r & 3) + 8 * (r >> 2) + 4 * hi; }
__device__ __forceinline__ s16x4 vtr(LAS const unsigned char* p) { return __builtin_bit_cast(s16x4, __builtin_amdgcn_ds_read_tr16_b64_v4i16((LAS v4i16_t*)p)); }
typedef float f32x2_t __attribute__((ext_vector_type(2))); typedef __bf16 bf16x2_t __attribute__((ext_vector_type(2)));
#ifndef CVT_ASM
#define CVT_ASM 0
#endif
#if CVT_ASM
__device__ __forceinline__ unsigned cvtpk(float lo, float hi) { unsigned r; asm volatile("v_cvt_pk_bf16_f32 %0, %1, %2\n\ts_nop 1" : "=v"(r) : "v"(lo), "v"(hi)); return r; }
#else
__device__ __forceinline__ unsigned cvtpk(float lo, float hi) { const f32x2_t v = {lo, hi}; const bf16x2_t b = __builtin_convertvector(v, bf16x2_t); return __builtin_bit_cast(unsigned, b); }
#endif

struct GroupRegs { v4u k[4], v[4]; };
__device__ __forceinline__ void group_issue(GroupRegs& R, const bf16* Kg, const bf16* Vg, int tid) {
#pragma unroll
    for (int i = 0; i < 4; ++i) { const int idx = tid + NTHREADS * i, row = idx >> 3, ch = idx & 7;
        R.k[i] = *(const v4u*)(Kg + (size_t)row * PLD + ch * 8); R.v[i] = *(const v4u*)(Vg + (size_t)row * PLD + ch * 8); }
}
__device__ __forceinline__ void group_commit(const GroupRegs& R, LAS unsigned char* kv, int tid) {
#pragma unroll
    for (int i = 0; i < 4; ++i) { const int idx = tid + NTHREADS * i, row = idx >> 3, ch = idx & 7;
        *(LAS v4u*)(kv + ATT_K0 + row * 128 + ((ch ^ ((row >> 1) & 7)) << 4)) = R.k[i];
        *(LAS v4u*)(kv + ATT_V0 + row * 128 + ((ch * 16) ^ (((row >> 1) & 1) << 6))) = R.v[i]; }
}
__device__ __forceinline__ void load_group(const bf16* Kg, const bf16* Vg, LAS unsigned char* kv, int tid) {
#pragma unroll
    for (int i = 0; i < 4; ++i) { const int idx = tid + NTHREADS * i, row = idx >> 3, ch = idx & 7;
        const v4u k = *(const v4u*)(Kg + (size_t)row * PLD + ch * 8), v = *(const v4u*)(Vg + (size_t)row * PLD + ch * 8);
        *(LAS v4u*)(kv + ATT_K0 + row * 128 + ((ch ^ ((row >> 1) & 7)) << 4)) = k;
        *(LAS v4u*)(kv + ATT_V0 + row * 128 + ((ch * 16) ^ (((row >> 1) & 1) << 6))) = v; }
}

template <bool FOX>
__device__ __forceinline__ void attn_subtile(LAS const unsigned char* kv, LAS const float* colt, int j0, const bf16x8 (&qf)[4], float rowterm, float slope2, bool mask, int qrel,
                                             f32x16 (&o)[2], float& l, int lane) {
    const int r32 = lane & 31, hh = lane >> 5;
    f32x16 acc;
    if (FOX) {
#pragma unroll
        for (int g = 0; g < 4; ++g) { const f32x4 c = *(LAS const f32x4*)(colt + j0 + 8 * g + 4 * hh); acc[4 * g + 0] = rowterm + c.x; acc[4 * g + 1] = rowterm + c.y; acc[4 * g + 2] = rowterm + c.z; acc[4 * g + 3] = rowterm + c.w; }
    } else {
#pragma unroll
        for (int r = 0; r < 16; ++r) acc[r] = rowterm + slope2 * (float)(j0 + crow(r, hh));
    }
    if (mask) {
#pragma unroll
        for (int r = 0; r < 16; ++r) if (j0 + crow(r, hh) > qrel) acc[r] = -INFINITY;
    }
    { const int row = j0 + r32; LAS const unsigned char* kr = kv + ATT_K0 + row * 128; const int sw = (row >> 1) & 7;
#pragma unroll
      for (int s = 0; s < 4; ++s) { const bf16x8 kf = *(LAS const bf16x8*)(kr + (((2 * s + hh) ^ sw) << 4)); acc = __builtin_amdgcn_mfma_f32_32x32x16_bf16(kf, qf[s], acc, 0, 0, 0); } }
    float ls = 0.f;
#pragma unroll
    for (int r = 0; r < 16; ++r) { acc[r] = __builtin_amdgcn_exp2f(acc[r]); ls += acc[r]; }
    l += ls;
    bf16x8 pa[2];
#pragma unroll
    for (int s = 0; s < 2; ++s) { v4u w; w.x = cvtpk(acc[8 * s + 0], acc[8 * s + 1]); w.y = cvtpk(acc[8 * s + 2], acc[8 * s + 3]); w.z = cvtpk(acc[8 * s + 4], acc[8 * s + 5]); w.w = cvtpk(acc[8 * s + 6], acc[8 * s + 7]); pa[s] = __builtin_bit_cast(bf16x8, w); }
    { const int i = lane & 15, c = (lane >> 4) & 1;
#pragma unroll
      for (int db = 0; db < 2; ++db)
#pragma unroll
          for (int s = 0; s < 2; ++s) { const int rowv = j0 + 16 * s + 4 * hh + (i >> 2); const int colb = (32 * db + 16 * c + 4 * (i & 3)) * 2;
              LAS const unsigned char* vp = kv + ATT_V0 + rowv * 128 + (colb ^ (((rowv >> 1) & 1) << 6));
              const s16x4 lo = vtr(vp), hi = vtr(vp + 8 * 128);
              const bf16x8 vf = (bf16x8){lo[0], lo[1], lo[2], lo[3], hi[0], hi[1], hi[2], hi[3]};
              o[db] = __builtin_amdgcn_mfma_f32_32x32x16_bf16(pa[s], vf, o[db], 0, 0, 0); } }
}
__device__ __forceinline__ float rfl(float x) { return __builtin_bit_cast(float, __builtin_amdgcn_readfirstlane(__builtin_bit_cast(int, x))); }

__device__ __forceinline__ void fox_unit(int bh, int qb, const bf16* PROJ, const float* FOXCUM, bf16* Y, float B2, LAS unsigned char* lds, int tid, int wave, int lane) {
    const int b = bh / 6, h = bh % 6; const size_t rb = (size_t)b * SEQ; const int r32 = lane & 31, hh = lane >> 5;
    const int q0w = qb * 256 + wave * 32, qpos = q0w + r32;
    const float* cum = FOXCUM + (size_t)bh * SEQ;
    bf16x8 qf[4];
#pragma unroll
    for (int s = 0; s < 4; ++s) qf[s] = *(const bf16x8*)(PROJ + (rb + qpos) * PLD + C_FQ + h * 64 + 16 * s + 8 * hh);
    const float cq = cum[qpos];
    const float cq_first = rfl(cum[q0w]), cq_blk = rfl(cum[qb * 256]);
    const float rowterm = cq - B2, lim = -THRESH2 - 2.f * B2;
    f32x16 o[2]; float l = 0.f;
#pragma unroll
    for (int r = 0; r < 16; ++r) { o[0][r] = 0.f; o[1][r] = 0.f; }
    LAS float* coltA = (LAS float*)(lds + ATT_TAB); LAS float* coltB = coltA + 256;
    LAS unsigned char* kvA = lds; LAS unsigned char* kvB = lds + 65536;
#ifndef FOX_2G
#define FOX_2G 1
#endif
    const bool haveB = FOX_2G && (qb > 0) && !(cq_blk - rfl(cum[qb * 256 - 1]) < lim);
    load_group(PROJ + (rb + (size_t)qb * 256) * PLD + C_FK + h * 64, PROJ + (rb + (size_t)qb * 256) * PLD + C_FV + h * 64, kvA, tid);
    if (tid < 256) coltA[tid] = -cum[qb * 256 + tid];
    if (haveB) { load_group(PROJ + (rb + (size_t)(qb - 1) * 256) * PLD + C_FK + h * 64, PROJ + (rb + (size_t)(qb - 1) * 256) * PLD + C_FV + h * 64, kvB, tid);
        if (tid < 256) coltB[tid] = -cum[(qb - 1) * 256 + tid]; }
    __syncthreads();
#pragma unroll 1
    for (int st = wave; st >= 0; --st) {
        const int j0 = 32 * st;
        if (cq_first + rfl(coltA[j0 + 31]) < lim) break;
        attn_subtile<true>(kvA, coltA, j0, qf, rowterm, 0.f, st == wave, wave * 32 + r32, o, l, lane);
    }
    if (haveB) {
#pragma unroll 1
        for (int st = 7; st >= 0; --st) {
            const int j0 = 32 * st;
            if (cq_first + rfl(coltB[j0 + 31]) < lim) break;
            attn_subtile<true>(kvB, coltB, j0, qf, rowterm, 0.f, false, 0, o, l, lane);
        }
    }
    __syncthreads();
    {
        for (int g = haveB ? qb - 2 : qb - 1; g >= 0; --g) {
            if (cq_blk - rfl(cum[g * 256 + 255]) < lim) break;
            load_group(PROJ + (rb + (size_t)g * 256) * PLD + C_FK + h * 64, PROJ + (rb + (size_t)g * 256) * PLD + C_FV + h * 64, kvA, tid);
            if (tid < 256) coltA[tid] = -cum[g * 256 + tid];
            __syncthreads();
            {
#pragma unroll 1
                for (int st = 7; st >= 0; --st) {
                    const int j0 = 32 * st;
                    if (cq_first + rfl(coltA[j0 + 31]) < lim) break;
                    attn_subtile<true>(kvA, coltA, j0, qf, rowterm, 0.f, false, 0, o, l, lane);
                }
            }
            __syncthreads();
        }
    }
    l = half_sum(l, lane);
    bf16* yp = Y + (rb + (size_t)q0w) * 1024 + Y_FOX + h * 64 + r32;
#pragma unroll
    for (int r = 0; r < 16; ++r) { const int q = crow(r, hh); const float rl = 1.f / shf(l, q);
        yp[(size_t)q * 1024] = (bf16)f2bf(o[0][r] * rl); yp[(size_t)q * 1024 + 32] = (bf16)f2bf(o[1][r] * rl); }
}

__device__ __forceinline__ void fox_unit_old(int bh, int qb, const bf16* PROJ, const float* FOXCUM, bf16* Y, float B2, LAS unsigned char* lds, int tid, int wave, int lane) {
    const int b = bh / 6, h = bh % 6; const size_t rb = (size_t)b * SEQ; const int r32 = lane & 31, hh = lane >> 5;
    const int q0w = qb * 256 + wave * 32, qpos = q0w + r32;
    const float* cum = FOXCUM + (size_t)bh * SEQ;
    bf16x8 qf[4];
#pragma unroll
    for (int s = 0; s < 4; ++s) qf[s] = *(const bf16x8*)(PROJ + (rb + qpos) * PLD + C_FQ + h * 64 + 16 * s + 8 * hh);
    const float cq = cum[qpos];
    const float cq_first = rfl(cum[q0w]);
    const float cq_blk = rfl(cum[qb * 256]);
    const float rowterm = cq - B2;
    f32x16 o[2]; float l = 0.f;
#pragma unroll
    for (int r = 0; r < 16; ++r) { o[0][r] = 0.f; o[1][r] = 0.f; }
    LAS float* colt = (LAS float*)(lds + ATT_TAB);
    for (int g = qb; g >= 0; --g) {
        if (g < qb) { const float cl = rfl(cum[g * 256 + 255]); if (2.f * B2 + cq_blk - cl < -THRESH2) break; }
        load_group(PROJ + (rb + (size_t)g * 256) * PLD + C_FK + h * 64, PROJ + (rb + (size_t)g * 256) * PLD + C_FV + h * 64, lds, tid);
        if (tid < 256) colt[tid] = -cum[g * 256 + tid];
        __syncthreads();
        const int stmax = (g == qb) ? wave : 7;
        for (int st = stmax; st >= 0; --st) {
            const int j0 = 32 * st;
            { const float cl = rfl(colt[j0 + 31]); if (2.f * B2 + cq_first + cl < -THRESH2) break; }
            attn_subtile<true>(lds, colt, j0, qf, rowterm, 0.f, (g == qb) && (st == wave), wave * 32 + r32, o, l, lane);
        }
        __syncthreads();
    }
    l = half_sum(l, lane);
    bf16* yp = Y + (rb + (size_t)q0w) * 1024 + Y_FOX + h * 64 + r32;
#pragma unroll
    for (int r = 0; r < 16; ++r) { const int q = crow(r, hh); const float rl = 1.f / shf(l, q);
        yp[(size_t)q * 1024] = (bf16)f2bf(o[0][r] * rl); yp[(size_t)q * 1024 + 32] = (bf16)f2bf(o[1][r] * rl); }
}

__device__ __forceinline__ size_t moba_list_off(int bh, int n) { return (size_t)bh * 516096 + 256 * (size_t)(63 * n - (n * (n - 1)) / 2); }
__device__ __forceinline__ void moba_store(const f32x16 (&o)[2], float l, int qpos, int slot, bool valid, size_t rb, int h, bf16* OPART, float* LPART, bf16* Y, int lane) {
    const int r32 = lane & 31, hh = lane >> 5;
#pragma unroll
    for (int r = 0; r < 16; ++r) { const int src = crow(r, hh);
        const int qp = shfi(qpos, src), sl = shfi(slot, src); const int ok = shfi((int)valid, src);
        if (ok) { bf16* op = (sl == 3) ? (Y + (rb + qp) * 1024 + Y_MOBA + h * 64) : (OPART + ((size_t)sl * MROWS + rb + qp) * 384 + h * 64);
            op[r32] = (bf16)f2bf(o[0][r]); op[32 + r32] = (bf16)f2bf(o[1][r]); } }
    if (valid && hh == 0) LPART[((size_t)slot * MROWS + rb + qpos) * 6 + h] = l;
}
__device__ __forceinline__ void moba_sel_unit(int bh, int n, int chunk, int cnt, const bf16* PROJ, const unsigned short* LIST, const unsigned* CTAB, bf16* OPART, float* LPART, bf16* Y, float B2,
                                              LAS unsigned char* lds, int tid, int wave, int lane) {
    const int b = bh / 6, h = bh % 6; const size_t rb = (size_t)b * SEQ; const int r32 = lane & 31, hh = lane >> 5;
    const float slope2 = exp2f(-8.f * (float)(h + 1) / 6.f) * LOG2E;
    GroupRegs GR; group_issue(GR, PROJ + (rb + (size_t)n * 256) * PLD + C_BK + h * 64, PROJ + (rb + (size_t)n * 256) * PLD + C_BV + h * 64, tid);
    const int nvalid = cnt - chunk * 256 < 256 ? cnt - chunk * 256 : 256;
    const bool active = wave * 32 < nvalid;
    bool valid = true; int qpos = 0, slot = 0; bf16x8 qf[4];
    if (active) {
        int li = wave * 32 + r32; if (li >= nvalid) { li = nvalid - 1; valid = false; }
        const int p = chunk * 256 + li;
        const int cv = (lane > n) ? (int)CTAB[((size_t)bh * 64 + lane) * 64 + n] : 0; int inc = cv;
#pragma unroll
        for (int o2 = 1; o2 < 64; o2 <<= 1) { const int t2 = supi(inc, o2, lane); if (lane >= o2) inc += t2; }
        int qseg = 0;
#pragma unroll
        for (int stp = 32; stp >= 1; stp >>= 1) { const int v = shfi(inc, qseg + stp - 1); if (v <= p) qseg += stp; }
        const int idx = p - (shfi(inc, qseg) - shfi(cv, qseg));
        const unsigned e = LIST[moba_list_off(bh, n) + (size_t)(qseg - n - 1) * 256 + idx]; qpos = e & 0x3fff; slot = e >> 14;
#pragma unroll
        for (int s = 0; s < 4; ++s) qf[s] = *(const bf16x8*)(PROJ + (rb + qpos) * PLD + C_BQ + h * 64 + 16 * s + 8 * hh);
    }
    group_commit(GR, lds, tid);
    __syncthreads();
    if (active) {
        const int qrel = qpos - n * 256;
        const float rowterm = -slope2 * (float)qrel - B2;
        f32x16 o[2]; float l = 0.f;
#pragma unroll
        for (int r = 0; r < 16; ++r) { o[0][r] = 0.f; o[1][r] = 0.f; }
#ifndef REP_SUB
#define REP_SUB 0
#endif
#pragma unroll 1
        for (int rp = 0; rp <= REP_SUB; ++rp) {
        if (rp) { l = 0.f;
#pragma unroll
            for (int r = 0; r < 16; ++r) { o[0][r] = 0.f; o[1][r] = 0.f; } }
#pragma unroll 1
        for (int st = 0; st < 8; ++st) attn_subtile<false>(lds, nullptr, 32 * st, qf, rowterm, slope2, false, 0, o, l, lane);
        }
        l = half_sum(l, lane);
        moba_store(o, l, qpos, slot, valid, rb, h, OPART, LPART, Y, lane);
    }
    __syncthreads();
}
__device__ __forceinline__ void moba_own_pair(int bh, int nA, int nB, const bf16* PROJ, bf16* OPART, float* LPART, bf16* Y, float B2, LAS unsigned char* lds, int tid, int wave, int lane) {
    const int b = bh / 6, h = bh % 6; const size_t rb = (size_t)b * SEQ; const int r32 = lane & 31, hh = lane >> 5;
    const float slope2 = exp2f(-8.f * (float)(h + 1) / 6.f) * LOG2E;
    GroupRegs GA, GB;
    group_issue(GA, PROJ + (rb + (size_t)nA * 256) * PLD + C_BK + h * 64, PROJ + (rb + (size_t)nA * 256) * PLD + C_BV + h * 64, tid);
    group_issue(GB, PROJ + (rb + (size_t)nB * 256) * PLD + C_BK + h * 64, PROJ + (rb + (size_t)nB * 256) * PLD + C_BV + h * 64, tid);
    bf16x8 qfA[4], qfB[4];
    { const size_t qa = rb + (size_t)nA * 256 + wave * 32 + r32, qb2 = rb + (size_t)nB * 256 + (7 - wave) * 32 + r32;
#pragma unroll
      for (int s = 0; s < 4; ++s) { qfA[s] = *(const bf16x8*)(PROJ + qa * PLD + C_BQ + h * 64 + 16 * s + 8 * hh); qfB[s] = *(const bf16x8*)(PROJ + qb2 * PLD + C_BQ + h * 64 + 16 * s + 8 * hh); } }
    group_commit(GA, lds, tid); group_commit(GB, lds + 65536, tid);
    __syncthreads();
    { const int tile = wave, qrel = tile * 32 + r32, qpos = nA * 256 + qrel;
      const float rowterm = -slope2 * (float)qrel - B2;
      f32x16 o[2]; float l = 0.f;
#pragma unroll
      for (int r = 0; r < 16; ++r) { o[0][r] = 0.f; o[1][r] = 0.f; }
#pragma unroll 1
      for (int st = 0; st <= tile; ++st) attn_subtile<false>(lds, nullptr, 32 * st, qfA, rowterm, slope2, st == tile, qrel, o, l, lane);
      l = half_sum(l, lane);
      moba_store(o, l, qpos, 3, true, rb, h, OPART, LPART, Y, lane); }
    { const int tile = 7 - wave, qrel = tile * 32 + r32, qpos = nB * 256 + qrel;
      const float rowterm = -slope2 * (float)qrel - B2;
      f32x16 o[2]; float l = 0.f;
#pragma unroll
      for (int r = 0; r < 16; ++r) { o[0][r] = 0.f; o[1][r] = 0.f; }
#pragma unroll 1
      for (int st = 0; st <= tile; ++st) attn_subtile<false>(lds + 65536, nullptr, 32 * st, qfB, rowterm, slope2, st == tile, qrel, o, l, lane);
      l = half_sum(l, lane);
      moba_store(o, l, qpos, 3, true, rb, h, OPART, LPART, Y, lane); }
    __syncthreads();
}

__device__ __forceinline__ void moba_combine(const unsigned* SEL, const bf16* OPART, const float* LPART, bf16* Y, bf16* Yo, int opitch, int ocol, int gtid, int ngt) {
    constexpr size_t NIT = (size_t)MROWS * 48;
    for (size_t base = gtid; base < NIT; base += (size_t)ngt * 4) {
        unsigned sel[4]; v4u yv[4]; float lo[4]; size_t row[4]; int hh4[4], c84[4]; bool ok[4];
#pragma unroll
        for (int j = 0; j < 4; ++j) { const size_t idx = base + (size_t)j * ngt; ok[j] = idx < NIT; const size_t ii = ok[j] ? idx : 0;
            row[j] = ii / 48; const int hc = (int)(ii % 48); hh4[j] = hc >> 3; c84[j] = (hc & 7) * 8;
            sel[j] = SEL[row[j] * 6 + hh4[j]]; yv[j] = *(const v4u*)(Y + row[j] * 1024 + Y_MOBA + hh4[j] * 64 + c84[j]); lo[j] = LPART[((size_t)3 * MROWS + row[j]) * 6 + hh4[j]]; }
        v4u pv[4][3]; float pl[4][3];
#pragma unroll
        for (int j = 0; j < 4; ++j)
#pragma unroll
            for (int k = 0; k < 3; ++k) { const bool v = ((sel[j] >> (8 * k)) & 0xff) != 255;
                pv[j][k] = v ? *(const v4u*)(OPART + ((size_t)k * MROWS + row[j]) * 384 + hh4[j] * 64 + c84[j]) : (v4u){0u, 0u, 0u, 0u};
                pl[j][k] = v ? LPART[((size_t)k * MROWS + row[j]) * 6 + hh4[j]] : 0.f; }
#pragma unroll
        for (int j = 0; j < 4; ++j) { float acc[8]; unpack8(yv[j], acc); float l = lo[j];
#pragma unroll
            for (int k = 0; k < 3; ++k) { float f[8]; unpack8(pv[j][k], f);
#pragma unroll
                for (int i = 0; i < 8; ++i) acc[i] += f[i];
                l += pl[j][k]; }
            const float rl = 1.f / l;
            v4u w; w.x = pk2(acc[0] * rl, acc[1] * rl); w.y = pk2(acc[2] * rl, acc[3] * rl); w.z = pk2(acc[4] * rl, acc[5] * rl); w.w = pk2(acc[6] * rl, acc[7] * rl);
            if (ok[j]) *(v4u*)(Yo + row[j] * opitch + ocol + hh4[j] * 64 + c84[j]) = w; }
    }
}

__device__ __forceinline__ int vsw(int row, int colb) { return row * 128 + (colb ^ (((row >> 1) & 1) << 6)); }
__device__ __forceinline__ int ksw(int row, int ch) { return row * 128 + ((ch ^ ((row >> 1) & 7)) << 4); }
__device__ __forceinline__ void mlstm_m1_mfma(int ci, const MlP& P, LAS unsigned char* lds, int wave, int lane) {
    const int b = ci >> 10, h = (ci >> 8) & 3, c = ci & 255; const size_t row0 = (size_t)b * SEQ + c * 64;
    LAS unsigned char* Ki = lds + wave * 16384; LAS unsigned char* Vi = Ki + 8192;
    float wv;
    { const size_t row = row0 + lane;
      const float fi = P.GATES[row * 16 + 6 + h] + P.ibias[h], ff = P.GATES[row * 16 + 10 + h] + P.fbias[h];
      float bc = log_sigmoid_f(ff);
#pragma unroll
      for (int o = 1; o < 64; o <<= 1) { const float n = sup(bc, o, lane); if (lane >= o) bc += n; }
      const float bend = shf(bc, 63);
      const float wl = bend - bc + fi; const float mloc = wave_max(wl);
      wv = expf(wl - mloc);
      if (lane == 0) { P.BEND[ci] = bend; P.MLOC[ci] = mloc; } }
#pragma unroll
    for (int i = 0; i < 8; ++i) { const int idx = lane + 64 * i, r = idx >> 3, ch = idx & 7;
        const v4u kk = *(const v4u*)(P.KC + (row0 + r) * 256 + h * 64 + ch * 8);
        *(LAS v4u*)(Ki + vsw(r, ch * 16)) = kk;
        float f[8]; unpack8(*(const v4u*)(P.PROJ + (row0 + r) * PLD + C_MV + h * 64 + ch * 8), f);
        const float w = shf(wv, r);
        v4u o; o.x = pk2(f[0] * w, f[1] * w); o.y = pk2(f[2] * w, f[3] * w); o.z = pk2(f[4] * w, f[5] * w); o.w = pk2(f[6] * w, f[7] * w);
        *(LAS v4u*)(Vi + vsw(r, ch * 16)) = o; }
    LDS_WAIT(); asm volatile("" ::: "memory");
    { float nu = 0.f;
#pragma unroll 8
      for (int s = 0; s < 64; ++s) { const float ws = shf(wv, s); nu += ws * bf2f(*(LAS const unsigned short*)(Ki + vsw(s, 2 * lane))); }
      P.NU[(size_t)ci * 64 + lane] = nu; }
    f32x16 D[2][2];
#pragma unroll
    for (int a = 0; a < 2; ++a)
#pragma unroll
        for (int e = 0; e < 2; ++e)
#pragma unroll
            for (int r = 0; r < 16; ++r) D[a][e][r] = 0.f;
    const int i16 = lane & 15, cc = (lane >> 4) & 1, hh = lane >> 5, r32 = lane & 31;
#pragma unroll
    for (int ks = 0; ks < 4; ++ks) { const int rowv = 16 * ks + 4 * hh + (i16 >> 2);
        bf16x8 af[2], bfr[2];
#pragma unroll
        for (int blk = 0; blk < 2; ++blk) { const int colb = (32 * blk + 16 * cc + 4 * (i16 & 3)) * 2;
            { const s16x4 lo = vtr(Vi + vsw(rowv, colb)), hi = vtr(Vi + vsw(rowv, colb) + 1024); af[blk] = (bf16x8){lo[0], lo[1], lo[2], lo[3], hi[0], hi[1], hi[2], hi[3]}; }
            { const s16x4 lo = vtr(Ki + vsw(rowv, colb)), hi = vtr(Ki + vsw(rowv, colb) + 1024); bfr[blk] = (bf16x8){lo[0], lo[1], lo[2], lo[3], hi[0], hi[1], hi[2], hi[3]}; } }
#pragma unroll
        for (int a = 0; a < 2; ++a)
#pragma unroll
            for (int e = 0; e < 2; ++e) D[a][e] = __builtin_amdgcn_mfma_f32_32x32x16_bf16(af[a], bfr[e], D[a][e], 0, 0, 0); }
    float* up = P.U + (size_t)ci * 4096;
#pragma unroll
    for (int a = 0; a < 2; ++a)
#pragma unroll
        for (int e = 0; e < 2; ++e)
#pragma unroll
            for (int r = 0; r < 16; ++r) up[(32 * a + crow(r, hh)) * 64 + 32 * e + r32] = D[a][e][r];
    LDS_WAIT(); asm volatile("" ::: "memory");
}

__device__ __forceinline__ void mlstm_m3_mfma(int it, const MlP& P, LAS unsigned char* lds, int tid, int wave, int lane) {
    const int cs = wave >> 1, tile = wave & 1, ci = it * 4 + cs;
    const int b = ci >> 10, h = (ci >> 8) & 3, c = ci & 255; const size_t row0 = (size_t)b * SEQ + c * 64;
    LAS unsigned char* Ki = lds + cs * 32768; LAS unsigned char* Vi = Ki + 8192; LAS unsigned char* Ci = Ki + 16384; LAS unsigned char* Mi = Ki + 24576;
    LAS float* tab = (LAS float*)(lds + ATT_TAB) + cs * 256;
    const float ms = P.MS[ci];
    { const int pt = tile * 64 + lane;
#pragma unroll
      for (int i = 0; i < 4; ++i) { const int idx = pt + 128 * i, r = idx >> 3, ch = idx & 7;
          *(LAS v4u*)(Ki + ksw(r, ch)) = *(const v4u*)(P.KC + (row0 + r) * 256 + h * 64 + ch * 8);
          *(LAS v4u*)(Vi + vsw(r, ch * 16)) = *(const v4u*)(P.PROJ + (row0 + r) * PLD + C_MV + h * 64 + ch * 8);
          *(LAS v4u*)(Ci + ksw(r, ch)) = *(const v4u*)(P.CS + (size_t)ci * 4096 + r * 64 + ch * 8);
          *(LAS v4u*)(Mi + r * 128 + ch * 16) = *(const v4u*)(P.PROJ + (row0 + r) * PLD + C_MO + h * 64 + ch * 8); } }
    if (tile == 0) {
        const size_t row = row0 + lane;
        const float fi = P.GATES[row * 16 + 6 + h] + P.ibias[h], ff = P.GATES[row * 16 + 10 + h] + P.fbias[h];
        float bc = log_sigmoid_f(ff);
#pragma unroll
        for (int o = 1; o < 64; o <<= 1) { const float n = sup(bc, o, lane); if (lane >= o) bc += n; }
        const float a = fi - bc; float pm = a;
#pragma unroll
        for (int o = 1; o < 64; o <<= 1) { const float n = sup(pm, o, lane); if (lane >= o) pm = fmaxf(pm, n); }
        tab[lane] = a * LOG2E; tab[64 + lane] = fmaxf(ms, pm); tab[128 + lane] = bc; tab[192 + lane] = P.NS[(size_t)ci * 64 + lane];
    }
    __syncthreads();
    const int r32 = lane & 31, hh = lane >> 5, j = 32 * tile + r32;
    bf16x8 qf[4];
#pragma unroll
    for (int s = 0; s < 4; ++s) qf[s] = *(const bf16x8*)(P.QC + (row0 + j) * 256 + h * 64 + 16 * s + 8 * hh);
    const float gj = tab[64 + j], inter = expf(ms - gj), rowterm2 = -gj * LOG2E;
    f32x16 o[2]; float l = 0.f;
#pragma unroll
    for (int r = 0; r < 16; ++r) { o[0][r] = 0.f; o[1][r] = 0.f; }
    for (int st = 0; st <= tile; ++st) {
        const int j0 = 32 * st;
        f32x16 acc;
#pragma unroll
        for (int r = 0; r < 16; ++r) acc[r] = 0.f;
#pragma unroll
        for (int s = 0; s < 4; ++s) { const bf16x8 kf = *(LAS const bf16x8*)(Ki + ksw(j0 + r32, 2 * s + hh)); acc = __builtin_amdgcn_mfma_f32_32x32x16_bf16(kf, qf[s], acc, 0, 0, 0); }
        float ls = 0.f;
#pragma unroll
        for (int g4 = 0; g4 < 4; ++g4) { const f32x4 c4 = *(LAS const f32x4*)(tab + j0 + 8 * g4 + 4 * hh);
#pragma unroll
            for (int ii = 0; ii < 4; ++ii) { const int reg = 4 * g4 + ii, key = j0 + 8 * g4 + 4 * hh + ii;
                float p = acc[reg] * __builtin_amdgcn_exp2f(rowterm2 + c4[ii]);
                if (st == tile && key > j) p = 0.f;
                acc[reg] = p; ls += p; } }
        l += ls;
        bf16x8 pa[2];
#pragma unroll
        for (int s = 0; s < 2; ++s) { v4u w; w.x = cvtpk(acc[8 * s + 0], acc[8 * s + 1]); w.y = cvtpk(acc[8 * s + 2], acc[8 * s + 3]); w.z = cvtpk(acc[8 * s + 4], acc[8 * s + 5]); w.w = cvtpk(acc[8 * s + 6], acc[8 * s + 7]); pa[s] = __builtin_bit_cast(bf16x8, w); }
        { const int i16 = lane & 15, cc = (lane >> 4) & 1;
#pragma unroll
          for (int db = 0; db < 2; ++db)
#pragma unroll
              for (int s = 0; s < 2; ++s) { const int rowv = j0 + 16 * s + 4 * hh + (i16 >> 2); const int colb = (32 * db + 16 * cc + 4 * (i16 & 3)) * 2;
                  LAS const unsigned char* vp = Vi + vsw(rowv, colb);
                  const s16x4 lo = vtr(vp), hi = vtr(vp + 1024);
                  const bf16x8 vf = (bf16x8){lo[0], lo[1], lo[2], lo[3], hi[0], hi[1], hi[2], hi[3]};
                  o[db] = __builtin_amdgcn_mfma_f32_32x32x16_bf16(pa[s], vf, o[db], 0, 0, 0); } }
    }
    float dn = 0.f;
#pragma unroll
    for (int s = 0; s < 4; ++s) { float f[8]; unpack8(__builtin_bit_cast(v4u, qf[s]), f);
        const f32x4 n0 = *(LAS const f32x4*)(tab + 192 + 16 * s + 8 * hh), n1 = *(LAS const f32x4*)(tab + 192 + 16 * s + 8 * hh + 4);
        dn += (f[0] * n0.x + f[1] * n0.y) + (f[2] * n0.z + f[3] * n0.w) + (f[4] * n1.x + f[5] * n1.y) + (f[6] * n1.z + f[7] * n1.w);
        v4u w; w.x = cvtpk(f[0] * inter, f[1] * inter); w.y = cvtpk(f[2] * inter, f[3] * inter); w.z = cvtpk(f[4] * inter, f[5] * inter); w.w = cvtpk(f[6] * inter, f[7] * inter);
        const bf16x8 qs = __builtin_bit_cast(bf16x8, w);
#pragma unroll
        for (int db = 0; db < 2; ++db) { const bf16x8 cf = *(LAS const bf16x8*)(Ci + ksw(32 * db + r32, 2 * s + hh)); o[db] = __builtin_amdgcn_mfma_f32_32x32x16_bf16(qs, cf, o[db], 0, 0, 0); } }
    dn = half_sum(dn, lane); l = half_sum(l, lane);
    const float den = inter * dn + l, mj = tab[128 + j] + gj;
    const float rd = 1.f / fmaxf(fabsf(den), expf(-mj));
    const float hg0 = P.hg[h * 64 + r32], hg1 = P.hg[h * 64 + 32 + r32];
    unsigned short mo0[16], mo1[16];
#pragma unroll
    for (int r = 0; r < 16; ++r) { LAS const unsigned short* mq = (LAS const unsigned short*)(Mi + (32 * tile + crow(r, hh)) * 128) + r32; mo0[r] = mq[0]; mo1[r] = mq[32]; }
#pragma unroll
    for (int r = 0; r < 16; ++r) { const int src = crow(r, hh); const float rdr = shf(rd, src);
        const float h0 = o[0][r] * rdr, h1 = o[1][r] * rdr; float ss = h0 * h0 + h1 * h1;
        ss += SWZ_X(ss, 1); ss += SWZ_X(ss, 2); ss += SWZ_X(ss, 4); ss += SWZ_X(ss, 8); ss += SWZ_X(ss, 16);
        const float rr = 1.f / sqrtf(ss * (1.f / 64.f) + EPS);
        LAS unsigned short* mp = (LAS unsigned short*)(Mi + (32 * tile + src) * 128) + r32;
        const float e0 = __builtin_amdgcn_exp2f(-bf2f(mo0[r]) * LOG2E), e1 = __builtin_amdgcn_exp2f(-bf2f(mo1[r]) * LOG2E);
        mp[0] = (unsigned short)f2bf(h0 * rr * hg0 * __builtin_amdgcn_rcpf(1.f + e0));
        mp[32] = (unsigned short)f2bf(h1 * rr * hg1 * __builtin_amdgcn_rcpf(1.f + e1)); }
    LDS_WAIT(); asm volatile("" ::: "memory");
#pragma unroll
    for (int i = 0; i < 4; ++i) { const int rw = (lane >> 3) + 8 * i, ch = lane & 7;
        *(v4u*)(P.Y + (row0 + 32 * tile + rw) * 1024 + Y_ML + h * 64 + ch * 8) = *(LAS const v4u*)(Mi + (32 * tile + rw) * 128 + ch * 16); }
    __syncthreads();
}

__device__ __forceinline__ void top3_ins(float g, int n, float& v0, float& v1, float& v2, int& i0, int& i1, int& i2) {
    const bool c0 = g > v0, c1 = g > v1, c2 = g > v2;
    const float nv2 = c1 ? v1 : (c2 ? g : v2); const int ni2 = c1 ? i1 : (c2 ? n : i2);
    const float nv1 = c0 ? v0 : (c1 ? g : v1); const int ni1 = c0 ? i0 : (c1 ? n : i1);
    v0 = c0 ? g : v0; i0 = c0 ? n : i0; v1 = nv1; i1 = ni1; v2 = nv2; i2 = ni2;
}
__device__ __forceinline__ void moba_gate_mfma(int u, const bf16* PROJ, const float* KMEAN, unsigned* SEL, unsigned* LCNT, unsigned* CTAB, unsigned short* LIST, float B2, float thresh2,
                                               LAS unsigned char* lds, int tid, int wave, int lane) {
    const int bh = u >> 6, qb = 63 - (u & 63), b = bh / 6, h = bh % 6; const int r32 = lane & 31, hh = lane >> 5;
    LAS unsigned char* Khi = lds; LAS unsigned char* Klo = lds + 8192; LAS unsigned* cntl = (LAS unsigned*)(lds + 16384);
    if (tid < 64) cntl[tid] = 0u;
    { const int n = tid >> 3, ch = tid & 7; float f[8];
      if (n < qb) { const float* k0 = KMEAN + ((size_t)bh * NBLK + n) * 64 + ch * 8; const float* k1 = k0 + (size_t)(12 * NBLK * 64);
          const f32x4 a0 = *(const f32x4*)k0, a1 = *(const f32x4*)(k0 + 4), b0 = *(const f32x4*)k1, b1 = *(const f32x4*)(k1 + 4);
          f[0] = a0.x + b0.x; f[1] = a0.y + b0.y; f[2] = a0.z + b0.z; f[3] = a0.w + b0.w; f[4] = a1.x + b1.x; f[5] = a1.y + b1.y; f[6] = a1.z + b1.z; f[7] = a1.w + b1.w; }
      else {
#pragma unroll
          for (int i = 0; i < 8; ++i) f[i] = 0.f; }
      unsigned hi[8]; float lo[8];
#pragma unroll
      for (int i = 0; i < 8; ++i) { hi[i] = f2bf(f[i]); lo[i] = f[i] - bf2f((unsigned short)hi[i]); }
      v4u wh; wh.x = hi[0] | (hi[1] << 16); wh.y = hi[2] | (hi[3] << 16); wh.z = hi[4] | (hi[5] << 16); wh.w = hi[6] | (hi[7] << 16);
      v4u wl; wl.x = pk2(lo[0], lo[1]); wl.y = pk2(lo[2], lo[3]); wl.z = pk2(lo[4], lo[5]); wl.w = pk2(lo[6], lo[7]);
      *(LAS v4u*)(Khi + ksw(n, ch)) = wh; *(LAS v4u*)(Klo + ksw(n, ch)) = wl; }
    const int query = wave * 32 + r32; const size_t row = (size_t)b * SEQ + qb * 256 + query;
    bf16x8 qf[4];
#pragma unroll
    for (int s = 0; s < 4; ++s) qf[s] = *(const bf16x8*)(PROJ + row * PLD + C_BQ + h * 64 + 16 * s + 8 * hh);
    __syncthreads();
    float v0 = -INFINITY, v1 = -INFINITY, v2 = -INFINITY; int i0 = 255, i1 = 255, i2 = 255;
#pragma unroll 1
    for (int st = 0; st < 2; ++st) {
        if (32 * st >= qb) break;
        f32x16 acc;
#pragma unroll
        for (int r = 0; r < 16; ++r) acc[r] = 0.f;
#pragma unroll
        for (int s = 0; s < 4; ++s) { const bf16x8 kh = *(LAS const bf16x8*)(Khi + ksw(32 * st + r32, 2 * s + hh)), kl = *(LAS const bf16x8*)(Klo + ksw(32 * st + r32, 2 * s + hh));
            acc = __builtin_amdgcn_mfma_f32_32x32x16_bf16(kh, qf[s], acc, 0, 0, 0); acc = __builtin_amdgcn_mfma_f32_32x32x16_bf16(kl, qf[s], acc, 0, 0, 0); }
#pragma unroll
        for (int r = 0; r < 16; ++r) { const int n = 32 * st + crow(r, hh); if (n < qb) top3_ins(acc[r], n, v0, v1, v2, i0, i1, i2); }
    }
    { const int pl = lane ^ 32;
      const float w0 = shf(v0, pl), w1 = shf(v1, pl), w2 = shf(v2, pl); const int j0 = shfi(i0, pl), j1 = shfi(i1, pl), j2 = shfi(i2, pl);
      if (j0 != 255) top3_ins(w0, j0, v0, v1, v2, i0, i1, i2);
      if (j1 != 255) top3_ins(w1, j1, v0, v1, v2, i0, i1, i2);
      if (j2 != 255) top3_ins(w2, j2, v0, v1, v2, i0, i1, i2); }
    if (hh == 0) {
        { const float slope2 = exp2f(-8.f * (float)(h + 1) / 6.f) * LOG2E; const float lim = (2.f * B2 + thresh2) / slope2; const int t0 = qb * 256 + query - 255;
          if (i0 != 255 && (float)(t0 - i0 * 256) > lim) i0 = 255;
          if (i1 != 255 && (float)(t0 - i1 * 256) > lim) i1 = 255;
          if (i2 != 255 && (float)(t0 - i2 * 256) > lim) i2 = 255; }
        SEL[row * 6 + h] = (unsigned)i0 | ((unsigned)i1 << 8) | ((unsigned)i2 << 16);
        if (LIST) { const unsigned t = (unsigned)(qb * 256 + query);
            if (i0 != 255) { const unsigned pos = __hip_atomic_fetch_add(cntl + i0, 1u, __ATOMIC_RELAXED, __HIP_MEMORY_SCOPE_WORKGROUP); LIST[moba_list_off(bh, i0) + (size_t)(qb - i0 - 1) * 256 + pos] = (unsigned short)(t | (0u << 14)); }
            if (i1 != 255) { const unsigned pos = __hip_atomic_fetch_add(cntl + i1, 1u, __ATOMIC_RELAXED, __HIP_MEMORY_SCOPE_WORKGROUP); LIST[moba_list_off(bh, i1) + (size_t)(qb - i1 - 1) * 256 + pos] = (unsigned short)(t | (1u << 14)); }
            if (i2 != 255) { const unsigned pos = __hip_atomic_fetch_add(cntl + i2, 1u, __ATOMIC_RELAXED, __HIP_MEMORY_SCOPE_WORKGROUP); LIST[moba_list_off(bh, i2) + (size_t)(qb - i2 - 1) * 256 + pos] = (unsigned short)(t | (2u << 14)); } }
    }
    __syncthreads();
    if (LIST && tid < 64) { const unsigned c = cntl[tid]; CTAB[((size_t)bh * 64 + qb) * 64 + tid] = c; if (c) atomicAdd(LCNT + bh * 64 + tid, c); }
    __syncthreads();
}
#ifndef FOX_MFMA
#define FOX_MFMA 1
#endif
#ifndef MOBA_MFMA
#define MOBA_MFMA 1
#endif
#ifndef REP_P0
#define REP_P0 0
#endif
#ifndef REP_NORM
#define REP_NORM 0
#endif
#ifndef REP_GIN
#define REP_GIN 0
#endif
#ifndef REP_FOX
#define REP_FOX 0
#endif
#ifndef REP_M1
#define REP_M1 0
#endif
#ifndef REP_MIXB
#define REP_MIXB 0
#endif
#ifndef REP_M3
#define REP_M3 0
#endif
#ifndef REP_GGU
#define REP_GGU 0
#endif
#ifndef REP_GATE
#define REP_GATE 0
#endif
#ifndef REP_CONV
#define REP_CONV 0
#endif
#ifndef REP_FCUM
#define REP_FCUM 0
#endif
#ifndef REP_QKN
#define REP_QKN 0
#endif
#ifndef REP_GOUT
#define REP_GOUT 0
#endif
#ifndef REP_GDN
#define REP_GDN 0
#endif
#ifndef REP_COMB
#define REP_COMB 0
#endif
#ifndef REP_BAR
#define REP_BAR 0
#endif
#ifndef REP_GATE2
#define REP_GATE2 0
#endif
#ifndef ML_MFMA
#define ML_MFMA 1
#endif
#ifndef REP_M2
#define REP_M2 0
#endif
#ifndef FOX_OLD
#define FOX_OLD 0
#endif
#if FOX_OLD
#define FOX_FN fox_unit_old
#else
#define FOX_FN fox_unit
#endif
#ifndef REP_PRE
#define REP_PRE 0
#endif
#ifndef N_LAUNCH_MODE
#define N_LAUNCH_MODE 1
#endif
constexpr int NPHASE = 2 + 8 * DEPTH;
struct Args { const float* in[20]; float* out; unsigned char* ws; int ph_lo, ph_hi; };
static_assert(sizeof(Args) == 20 * 8 + 8 + 8 + 8, "Args has no padding");

__global__ void __launch_bounds__(NTHREADS, 2) fwd(Args args) {
    extern __shared__ __attribute__((aligned(16))) unsigned char lds_raw[];
    LAS unsigned char* lds = (LAS unsigned char*)lds_raw;
    LAS float* ldsf = (LAS float*)lds_raw;
    volatile LAS unsigned* MISC = (volatile LAS unsigned*)(lds + MISC_OFF);
    const int G = gridDim.x; const int bx = blockIdx.x; const int vcu = (G % 8 == 0) ? (bx % 8) * (G / 8) + bx / 8 : bx;
    const int NGW = G * NWAVES;
#define PH_IDS() int tid = threadIdx.x; asm volatile("" : "+v"(tid)); const int lane = tid & 63, wave = __builtin_amdgcn_readfirstlane(tid >> 6); const int gw = vcu * NWAVES + wave; (void)lane; (void)gw; \
    unsigned char* ws = ws_k; asm volatile("" : "+s"(ws)); gu32* ctl = (gu32*)(ws + WS_CTL); (void)ctl
    unsigned char* const ws_k = args.ws;
    gu32* ctl0 = (gu32*)(ws_k + WS_CTL);
    for (int u = threadIdx.x; u < (LDS_BYTES - LDSCTL_OFF) / 4; u += NTHREADS) ((LAS unsigned*)(lds + LDSCTL_OFF))[u] = 0u;
    __syncthreads();
    XcdBarrier bar; bar.bar = (unsigned*)(ctl0 + CW_BAR); bar.x = 0; bar.st = nullptr;
    if (N_LAUNCH_MODE == 1) bar = xcd_barrier_post((unsigned*)(ctl0 + CW_BAR), MISC + 8);
    const int lo = args.ph_lo, hi = args.ph_hi;
#ifndef PHMASK
#define PHMASK 0xfff
#endif
#define PHEN(j) ((PHMASK >> (j)) & 1)
#define IN(k) ((N_LAUNCH_MODE == 1) || (lo <= (k) && (k) < hi))
#define SEAM(k) do { if (IN(k) && IN((k) + 1)) { xcd_barrier(bar); for (int rb_ = 0; rb_ < REP_BAR; ++rb_) xcd_barrier(bar); } } while (0)

#define PRM(k) (*(const float* const volatile*)(ws + WS_PTAB + 8 * (k)))
#define x_in PRM(0)
#define norm1_g PRM(4)
#define norm2_g PRM(5)
#define fox_f_bias PRM(7)
#define fox_q_g PRM(8)
#define fox_k_g PRM(9)
#define ml_conv_w PRM(10)
#define ml_conv_b PRM(11)
#define ml_i_bias PRM(12)
#define ml_f_bias PRM(13)
#define ml_h_g PRM(14)
#define moba_q_g PRM(15)
#define moba_k_g PRM(16)
#define xres ((float*)PRM(20))
#define MOD ((float*)(ws + WS_MOD))
#define XN ((bf16*)(ws + WS_XN))
#define PROJ ((bf16*)(ws + WS_PROJ))
#define HB ((bf16*)(ws + WS_H))
#define Y ((bf16*)(ws + WS_Y))
#define GATES ((float*)(ws + WS_GATES))
#define FOXCUM ((float*)(ws + WS_FOXCUM))
#define KMEAN ((float*)(ws + WS_KMEAN))
#define QC ((bf16*)(ws + WS_QC))
#define KC ((bf16*)(ws + WS_KC))
#define SEL ((unsigned*)(ws + WS_SEL))
#define mod_l (MOD + (size_t)l * 2 * 6144)
#define MK_MP() const float* const ib_ = ml_i_bias; const float* const fb_ = ml_f_bias; const float* const hg_ = ml_h_g; \
    MlP MP{PROJ, QC, KC, GATES, (float*)(ws + WS_U), (float*)(ws + WS_NU), (float*)(ws + WS_BEND), (float*)(ws + WS_MLOC), (bf16*)(ws + WS_CS), (float*)(ws + WS_NS), (float*)(ws + WS_MS), Y, ib_ + l * 4, fb_ + l * 4, hg_ + l * 256}

    for (int rep = 0; rep <= REP_P0; ++rep)
    if (PHEN(10) && IN(0)) { PH_IDS();
        const float* cvec = args.in[1]; const float* w_ada = args.in[2]; const float* b_ada = args.in[3]; const float* w_in = args.in[6];
        const float* w_out = args.in[17]; const float* w_gate_up = args.in[18]; const float* w_down = args.in[19];
        if (blockIdx.x == 0 && tid == 0) { const float** pt = (const float**)(ws + WS_PTAB);
            pt[0] = args.in[0]; pt[4] = args.in[4]; pt[5] = args.in[5]; pt[7] = args.in[7]; pt[8] = args.in[8]; pt[9] = args.in[9]; pt[10] = args.in[10]; pt[11] = args.in[11]; pt[12] = args.in[12];
            pt[13] = args.in[13]; pt[14] = args.in[14]; pt[15] = args.in[15]; pt[16] = args.in[16]; pt[20] = args.out; }
        if (vcu < 192) p0_mod_unit(vcu, cvec, w_ada, b_ada, MOD, ldsf, tid, wave, lane);
        LAS float* scr = (LAS float*)(lds + wave * 16384);
        constexpr int I_IN = 16 * (NIN / 32), I_OUT = 16 * (DM / 32), I_GU = 16 * (NGU / 32), I_DN = (DFF / 64) * (DM / 32), I_L = I_IN + I_OUT + I_GU + I_DN;
        for (int it = gw; it < DEPTH * I_L; it += NGW) {
            const int l = it / I_L; int r = it % I_L;
            if (r < I_IN) { transpose_item<1>(w_in + (size_t)l * DM * INC, DM, INC, (bf16*)(ws + WS_WIN + l * WIN_BYTES), scr, NIN / 32, r, lane); continue; } r -= I_IN;
            if (r < I_OUT) { transpose_item<0>(w_out + (size_t)l * DM * DM, DM, DM, (bf16*)(ws + WS_WOUT + l * WOUT_BYTES), scr, DM / 32, r, lane); continue; } r -= I_OUT;
            if (r < I_GU) { transpose_item<2>(w_gate_up + (size_t)l * DM * NGU, DM, NGU, (bf16*)(ws + WS_WGU + l * WGU_BYTES), scr, NGU / 32, r, lane); continue; } r -= I_GU;
            transpose_item<0>(w_down + (size_t)l * DFF * DM, DFF, DM, (bf16*)(ws + WS_WDN + l * WDN_BYTES), scr, DM / 32, r, lane);
        }
        if (REP_P0) __syncthreads();
    }
    SEAM(0);
    for (int rep = 0; rep <= REP_PRE; ++rep)
    if (PHEN(11) && IN(1)) { PH_IDS();
        const float* n1g = norm1_g; const float* n2g = norm2_g;
        pre_rows(x_in, n1g, MOD, XN, (float*)(ws + WS_SSP), gw, NGW, lane);
        pre_avec(n1g, n2g, MOD, (float*)(ws + WS_AVEC), vcu * NTHREADS + tid, G * NTHREADS);
        for (int l = 0; l < DEPTH; ++l) {
            const float* m0 = MOD + (size_t)l * 2 * 6144; const float* m1 = m0 + 6144;
            pre_bias((const bf16*)(ws + WS_WIN + l * WIN_BYTES), NIN, m0, m1, (float*)(ws + WS_BIASIN) + (size_t)l * 2 * NIN, (float*)(ws + WS_BIASIN) + (size_t)l * 2 * NIN + NIN, gw, NGW, lane);
            pre_bias((const bf16*)(ws + WS_WGU + l * WGU_BYTES), NGU, m0 + 3072, m1 + 3072, (float*)(ws + WS_BIASGU) + (size_t)l * 2 * NGU, (float*)(ws + WS_BIASGU) + (size_t)l * 2 * NGU + NGU, gw, NGW, lane);
        }
    }
    SEAM(1);

    for (int l = 0; l < DEPTH; ++l) {
        const int pb = 2 + 8 * l;
        for (int rep = 0; rep <= REP_GIN; ++rep)
        if (PHEN(0) && IN(pb + 0)) { PH_IDS();
            pg8::Gemm g{XN, (const bf16*)(ws + WS_WIN + l * WIN_BYTES), MROWS, NIN, DM}; pg8::StaticOrder S; S.init(MROWS, NIN, G, bx);
            LAS float* rt = (LAS float*)(lds + ATT_TAB); LAS float* bt = rt + 512;
            const int pm0 = rstd_tables(S, (const float*)(ws + WS_SSP), rt, (const float*)(ws + WS_BIASIN) + (size_t)l * 2 * NIN, NIN, bt, tid);
            pg8::EpiProj E{PROJ, GATES, PLD, rt, pm0, bt};
            pg8::gemm_phase<pg8::EpiProj, pg8::StaticOrder, true, true>(lds, g, S, E, tid);
        }
        SEAM(pb + 0);
        if (PHEN(1) && IN(pb + 1)) { PH_IDS();
            for (int u = vcu; u < 524; u += G) {
                if (u < 12) post_foxcum_unit(u, GATES, FOXCUM, fox_f_bias + l * 6, ldsf, tid, wave, lane);
                else if (u < 268) post_qknorm_unit(u - 12, PROJ, KMEAN, fox_q_g + l * 64, fox_k_g + l * 64, moba_q_g + l * 64, moba_k_g + l * 64, ldsf, tid, wave, lane);
                else { const int which = (u - 268) & 1; post_conv_unit((u - 268) >> 1, which, PROJ, which ? KC : QC, ml_conv_w + l * 4 * 512, ml_conv_b + l * 512, tid); }
            }
            for (int rep = 0; rep < REP_CONV; ++rep) for (int u = vcu; u < 256; u += G) { const int which = u & 1; post_conv_unit(u >> 1, which, PROJ, which ? KC : QC, ml_conv_w + l * 4 * 512, ml_conv_b + l * 512, tid); }
            for (int rep = 0; rep < REP_FCUM; ++rep) for (int u = vcu; u < 12; u += G) post_foxcum_unit(u, GATES, FOXCUM, fox_f_bias + l * 6, ldsf, tid, wave, lane);
        }
        SEAM(pb + 1);
        if (PHEN(2) && IN(pb + 2)) { PH_IDS(); MK_MP();
            const float B2m = 8.f * LOG2E * wave_max(fabsf(moba_q_g[l * 64 + lane])) * wave_max(fabsf(moba_k_g[l * 64 + lane])) * 1.01f;
            unsigned* LCNT = (unsigned*)(ctl + CW_LCNT + l * 768); unsigned short* LIST = MOBA_MFMA ? (unsigned short*)(ws + WS_LIST) : nullptr;
#if ML_MFMA
#ifndef GATE_MFMA
#define GATE_MFMA 1
#endif
#if GATE_MFMA
            for (int u = vcu; u < 768; u += G) moba_gate_mfma(u, PROJ, KMEAN, SEL, LCNT, (unsigned*)(ws + WS_CTAB), LIST, B2m, THRESH2, lds, tid, wave, lane);
#else
            for (int u = vcu; u < 768; u += G) moba_gate_unit(u, PROJ, KMEAN, SEL, LCNT, (unsigned*)(ws + WS_CTAB), LIST, B2m, THRESH2, ldsf, tid);
#endif
            for (int u = gw; u < 2048; u += NGW) mlstm_m1_mfma(u, MP, lds, wave, lane);
            __syncthreads();
#else
            for (int u = vcu; u < 768 + 2048; u += G) {
                if (u < 768) moba_gate_unit(u, PROJ, KMEAN, SEL, LCNT, (unsigned*)(ws + WS_CTAB), LIST, B2m, THRESH2, ldsf, tid);
                else mlstm_m1(u - 768, MP, ldsf, tid, wave, lane);
            }
#endif
            for (int rep = 0; rep < REP_GATE; ++rep) for (int u = vcu; u < 768; u += G) moba_gate_unit(u, PROJ, KMEAN, SEL, LCNT, (unsigned*)(ws + WS_CTAB), nullptr, B2m, THRESH2, ldsf, tid);
            for (int rep = 0; rep < REP_GATE2; ++rep) for (int u = vcu; u < 768; u += G) moba_gate_unit(u, PROJ, KMEAN, SEL, LCNT + 4096, (unsigned*)(ws + WS_OPART + 32 * MiB), (unsigned short*)(ws + WS_OPART), B2m, THRESH2, ldsf, tid);
            for (int rep = 0; rep < REP_M1; ++rep) for (int u = vcu; u < 2048; u += G) mlstm_m1(u, MP, ldsf, tid, wave, lane);
#if FOX_MFMA
            { const float gq = wave_max(fabsf(fox_q_g[l * 64 + lane])), gk = wave_max(fabsf(fox_k_g[l * 64 + lane])); const float B2 = 8.f * LOG2E * gq * gk * 1.01f;
              for (int rep = 0; rep <= REP_FOX; ++rep)
              for (int u = vcu; u < 768; u += G) FOX_FN(u >> 6, 63 - (u & 63), PROJ, FOXCUM, Y, B2, lds, tid, wave, lane); }
#else
            fox_naive(PROJ, FOXCUM, Y, gw, NGW, lane);
#endif
        }
        SEAM(pb + 2);
        for (int rep = 0; rep <= REP_MIXB; ++rep)
        if (PHEN(3) && IN(pb + 3)) { PH_IDS(); MK_MP();
            for (int rep = 0; rep <= REP_M2; ++rep)
            for (int u = vcu; u < 64; u += G) mlstm_m2(u, MP, tid);
#if MOBA_MFMA
            { const float gq = wave_max(fabsf(moba_q_g[l * 64 + lane])), gk = wave_max(fabsf(moba_k_g[l * 64 + lane])); const float B2 = 8.f * LOG2E * gq * gk * 1.01f;
              LAS int* pre = (LAS int*)(lds + ATT_TAB + 1024);
              const unsigned* lcnt = (const unsigned*)(ctl + CW_LCNT + l * 768);
              if (wave == 0) { int carry = 0;
                  for (int r = 0; r < 12; ++r) { const int p = r * 64 + lane; int x = (int)((lcnt[p] + 255u) >> 8);
#pragma unroll
                      for (int o = 1; o < 64; o <<= 1) { const int n = supi(x, o, lane); if (lane >= o) x += n; }
                      pre[p + 1] = carry + x; carry += shfi(x, 63); }
                  if (lane == 0) pre[0] = 0; }
              __syncthreads();
              const int S = pre[768];
              const unsigned short* LIST = (const unsigned short*)(ws + WS_LIST); bf16* OPART = (bf16*)(ws + WS_OPART); float* LPART = (float*)(ws + WS_LPART);
              #ifndef KSKIP_N
#define KSKIP_N 4
#endif
              constexpr int KSKIP = KSKIP_N; const int NU = S + 384;
              for (int i = (vcu < 64 ? KSKIP : 0); ; ++i) {
                  const int u = (i < KSKIP) ? i * (G - 64) + (vcu - 64) : KSKIP * (G - 64) + (i - KSKIP) * G + vcu;
                  if (u >= NU) break;
                  if (u < S) { int lo2 = 0, hi2 = 768; while (hi2 - lo2 > 1) { const int mid = (lo2 + hi2) >> 1; if (pre[mid] <= u) lo2 = mid; else hi2 = mid; }
                      moba_sel_unit(lo2 >> 6, lo2 & 63, u - pre[lo2], (int)lcnt[lo2], PROJ, LIST, (const unsigned*)(ws + WS_CTAB), OPART, LPART, Y, B2, lds, tid, wave, lane); }
                  else { const int p = u - S; moba_own_pair(p >> 5, p & 31, 63 - (p & 31), PROJ, OPART, LPART, Y, B2, lds, tid, wave, lane); }
              } }
#else
            moba_naive(PROJ, SEL, Y, gw, NGW, lane);
#endif
        }
        SEAM(pb + 3);
        if (PHEN(4) && IN(pb + 4)) { PH_IDS(); MK_MP();
#if ML_MFMA
            for (int rep = 0; rep <= REP_M3; ++rep)
            for (int u = vcu; u < 512; u += G) mlstm_m3_mfma(u, MP, lds, tid, wave, lane);
#else
            for (int rep = 0; rep <= REP_M3; ++rep)
            for (int u = vcu; u < 2048; u += G) mlstm_m3(u, MP, ldsf, tid, wave, lane);
#endif
#if MOBA_MFMA
            for (int rep = 0; rep < REP_COMB; ++rep) moba_combine(SEL, (const bf16*)(ws + WS_OPART), (const float*)(ws + WS_LPART), Y, (bf16*)(ws + WS_U), 384, 0, vcu * NTHREADS + tid, G * NTHREADS);
            moba_combine(SEL, (const bf16*)(ws + WS_OPART), (const float*)(ws + WS_LPART), Y, Y, 1024, Y_MOBA, vcu * NTHREADS + tid, G * NTHREADS);
#endif
        }
        SEAM(pb + 4);
        if (PHEN(5) && IN(pb + 5)) { PH_IDS();
            pg8::Gemm g{Y, (const bf16*)(ws + WS_WOUT + l * WOUT_BYTES), MROWS, DM, DM}; pg8::StaticOrder S; S.init(MROWS, DM, G, bx);
            float* const xr = xres; const float* const xcur = (l == 0) ? x_in : (const float*)xr;
            pg8::EpiRes E{xcur, xr, mod_l + 2048, 6144, SEQ, XN, (const float*)(ws + WS_AVEC) + (size_t)((l * 2 + 1) * 2) * 1024, (float*)(ws + WS_SSP)};
            pg8::gemm_phase<pg8::EpiRes, pg8::StaticOrder, true, true>(lds, g, S, E, tid);
        }
        SEAM(pb + 5);
        for (int rep = 0; rep <= REP_GGU; ++rep)
        if (PHEN(6) && IN(pb + 6)) { PH_IDS();
            pg8::Gemm g{XN, (const bf16*)(ws + WS_WGU + l * WGU_BYTES), MROWS, NGU, DM}; pg8::StaticOrder S; S.init(MROWS, NGU, G, bx);
            LAS float* rt = (LAS float*)(lds + ATT_TAB); LAS float* bt = rt + 512;
            const int pm0 = rstd_tables(S, (const float*)(ws + WS_SSP), rt, (const float*)(ws + WS_BIASGU) + (size_t)l * 2 * NGU, NGU, bt, tid);
            pg8::EpiSwiglu E{HB, DFF, rt, pm0, bt};
            pg8::gemm_phase<pg8::EpiSwiglu, pg8::StaticOrder, true, true>(lds, g, S, E, tid);
        }
        SEAM(pb + 6);
        if (PHEN(7) && IN(pb + 7)) { PH_IDS();
            pg8::Gemm g{HB, (const bf16*)(ws + WS_WDN + l * WDN_BYTES), MROWS, DM, DFF}; pg8::StaticOrder S; S.init(MROWS, DM, G, bx);
            float* const xr = xres;
            pg8::EpiRes E{xr, xr, mod_l + 5120, 6144, SEQ, (l + 1 < DEPTH) ? XN : (bf16*)nullptr, (const float*)(ws + WS_AVEC) + (size_t)(((l + 1) * 2 + 0) * 2) * 1024, (float*)(ws + WS_SSP)};
            pg8::gemm_phase<pg8::EpiRes, pg8::StaticOrder, true, true>(lds, g, S, E, tid);
        }
        SEAM(pb + 7);
    }
#undef IN
#undef SEAM
}

extern "C" void kernel_launch(void* const* d_in, const int* in_sizes, int n_in, void* d_out, int out_size, void* d_ws, size_t ws_size, hipStream_t stream) {
    static int grid = 0;
    if (grid == 0) {
        if (n_in != 20 || in_sizes[0] != MROWS * DM || out_size != MROWS * DM || ws_size < WS_END) {
            fprintf(stderr, "kernel_launch: unexpected shapes: n_in %d in0 %d out %d ws %zu (need >= %zu)\n", n_in, n_in > 0 ? in_sizes[0] : -1, out_size, ws_size, (size_t)WS_END); grid = -1; return; }
        int dev = 0, cus = 0, per_cu = 0;
        if (hipGetDevice(&dev) != hipSuccess || hipDeviceGetAttribute(&cus, hipDeviceAttributeMultiprocessorCount, dev) != hipSuccess) { grid = -1; return; }
        if (hipFuncSetAttribute((const void*)fwd, hipFuncAttributeMaxDynamicSharedMemorySize, LDS_BYTES) != hipSuccess) { fprintf(stderr, "kernel_launch: hipFuncSetAttribute failed\n"); grid = -1; return; }
        if (hipOccupancyMaxActiveBlocksPerMultiprocessor(&per_cu, (const void*)fwd, NTHREADS, LDS_BYTES) != hipSuccess || per_cu < 1)
            fprintf(stderr, "kernel_launch: note: occupancy query reports %d workgroups per CU\n", per_cu);
        (void)hipGetLastError();
        grid = cus;
    }
    if (grid < 0) return;
    if (hipMemsetAsync((char*)d_ws + WS_CTL, 0, CTL_ZERO_BYTES, stream) != hipSuccess) return;
    Args a{};
    for (int i = 0; i < 20; ++i) a.in[i] = (const float*)d_in[i];
    a.out = (float*)d_out; a.ws = (unsigned char*)d_ws;
    if (N_LAUNCH_MODE == 1) { a.ph_lo = 0; a.ph_hi = NPHASE; hipLaunchKernelGGL(fwd, dim3(grid), dim3(NTHREADS), LDS_BYTES, stream, a); }
    else for (int p = 0; p < NPHASE; ++p) { a.ph_lo = p; a.ph_hi = p + 1; hipLaunchKernelGGL(fwd, dim3(grid), dim3(NTHREADS), LDS_BYTES, stream, a); }
}
```

```cpp
#include <hip/hip_runtime.h>
#include <cstdio>
#include <cstdint>

constexpr int DM = 1024, NBATCH = 2, SEQ = 16384, MROWS = NBATCH * SEQ, DEPTH = 2;
constexpr int HD = 64, FOXH = 6, MLH = 4, MOBH = 6;
constexpr int DFF = 2816, INC = 3342, NIN = 3584, PLD = 3328;
constexpr int NGU = 2 * DFF;
constexpr int C_FQ = 0, C_FK = 384, C_FV = 768, C_BQ = 1152, C_BK = 1536, C_BV = 1920, C_MQ = 2304, C_MK = 2560, C_MV = 2816, C_MO = 3072, C_G = 3328;
constexpr int Y_FOX = 0, Y_ML = 384, Y_MOBA = 640;
constexpr int MOBA_BS = 256, NBLK = SEQ / MOBA_BS;
constexpr int MLC = 64, NCHUNK = SEQ / MLC;
constexpr float LOG2E = 1.4426950408889634f;
constexpr float QSCALE = 0.125f * LOG2E;
constexpr float EPS = 1e-6f;

#define GAS __attribute__((address_space(1)))
#define LAS __attribute__((address_space(3)))
typedef unsigned short bf16;
typedef unsigned v4u __attribute__((ext_vector_type(4)));
typedef unsigned v2u __attribute__((ext_vector_type(2)));
typedef float f32x4 __attribute__((ext_vector_type(4)));
typedef short bf16x8 __attribute__((ext_vector_type(8)));
typedef float f32x16 __attribute__((ext_vector_type(16)));
typedef GAS unsigned gu32;
#define RLX_AGENT __ATOMIC_RELAXED, __HIP_MEMORY_SCOPE_AGENT
__device__ __forceinline__ unsigned f2bf(float f) { unsigned u = __builtin_bit_cast(unsigned, f); return (u + 0x7fffu + ((u >> 16) & 1u)) >> 16; }
__device__ __forceinline__ unsigned pk2(float lo, float hi) { return f2bf(lo) | (f2bf(hi) << 16); }
__device__ __forceinline__ float bf2f(unsigned short u) { return __builtin_bit_cast(float, (unsigned)u << 16); }
__device__ __forceinline__ float bflo(unsigned w) { return __builtin_bit_cast(float, w << 16); }
__device__ __forceinline__ float bfhi(unsigned w) { return __builtin_bit_cast(float, w & 0xffff0000u); }
#ifndef OLD_SHFL
#define OLD_SHFL 0
#endif
#ifndef OLD_SWZ
#define OLD_SWZ OLD_SHFL
#endif
#ifndef OLD_HALF
#define OLD_HALF OLD_SHFL
#endif
#ifndef OLD_SHF
#define OLD_SHF OLD_SHFL
#endif
#ifndef OLD_SUP
#define OLD_SUP OLD_SHFL
#endif
#if OLD_SWZ
#define SWZ_X(v, o) __shfl_xor((float)(v), (o))
#else
#define SWZ_X(v, o) __builtin_bit_cast(float, __builtin_amdgcn_ds_swizzle(__builtin_bit_cast(int, (float)(v)), ((o) << 10) | 0x1f))
#endif
__device__ __forceinline__ float half_sum(float v, int lane) { return v + __builtin_bit_cast(float, __builtin_amdgcn_ds_bpermute((lane ^ 32) << 2, __builtin_bit_cast(int, v))); }
#if OLD_SHF
__device__ __forceinline__ float shf(float v, int src) { return __shfl(v, src); }
__device__ __forceinline__ int shfi(int v, int src) { return __shfl(v, src); }
#else
__device__ __forceinline__ float shf(float v, int src) { return __builtin_bit_cast(float, __builtin_amdgcn_ds_bpermute(src << 2, __builtin_bit_cast(int, v))); }
__device__ __forceinline__ int shfi(int v, int src) { return __builtin_amdgcn_ds_bpermute(src << 2, v); }
#endif
#if OLD_SUP
__device__ __forceinline__ float sup(float v, int o, int lane) { return __shfl_up(v, o); }
__device__ __forceinline__ int supi(int v, int o, int lane) { return __shfl_up(v, o); }
#else
__device__ __forceinline__ float sup(float v, int o, int lane) { return shf(v, lane >= o ? lane - o : lane); }
__device__ __forceinline__ int supi(int v, int o, int lane) { return shfi(v, lane >= o ? lane - o : lane); }
#endif
__device__ __forceinline__ float wave_sum(float v) { v += SWZ_X(v, 1); v += SWZ_X(v, 2); v += SWZ_X(v, 4); v += SWZ_X(v, 8); v += SWZ_X(v, 16);
    return __builtin_bit_cast(float, __builtin_amdgcn_readlane(__builtin_bit_cast(int, v), 0)) + __builtin_bit_cast(float, __builtin_amdgcn_readlane(__builtin_bit_cast(int, v), 32)); }
__device__ __forceinline__ float wave_max(float v) { v = fmaxf(v, SWZ_X(v, 1)); v = fmaxf(v, SWZ_X(v, 2)); v = fmaxf(v, SWZ_X(v, 4)); v = fmaxf(v, SWZ_X(v, 8)); v = fmaxf(v, SWZ_X(v, 16));
    return fmaxf(__builtin_bit_cast(float, __builtin_amdgcn_readlane(__builtin_bit_cast(int, v), 0)), __builtin_bit_cast(float, __builtin_amdgcn_readlane(__builtin_bit_cast(int, v), 32))); }
__device__ __forceinline__ float log_sigmoid_f(float x) { return fminf(x, 0.f) - log1pf(expf(-fabsf(x))); }
__device__ __forceinline__ float sigmoid_f(float x) { return 1.f / (1.f + expf(-x)); }

constexpr size_t MiB = 1u << 20;
constexpr size_t WS_CTL = 0, CTL_ZERO_BYTES = 1 * MiB;
constexpr size_t WS_MOD = 1 * MiB;
constexpr size_t WS_KMEAN = WS_MOD + 128 * 1024;
constexpr size_t WS_MLS = WS_KMEAN + 512 * 1024;
constexpr size_t WS_BEND = WS_MLS, WS_MLOC = WS_MLS + 8192, WS_MS = WS_MLS + 16384, WS_NU = WS_MLS + 32768, WS_NS = WS_NU + 2048 * 64 * 4;
constexpr size_t WS_CTAB = 3 * MiB;
constexpr size_t WS_PTAB = WS_CTAB + 256 * 1024;
static_assert(WS_NS + 2048 * 64 * 4 <= WS_CTAB && WS_CTAB + 12 * 64 * 64 * 4 <= WS_PTAB && WS_PTAB + 256 <= 4 * MiB, "small region");
constexpr size_t WS_WIN = 4 * MiB, WIN_BYTES = (size_t)NIN * DM * 2;
constexpr size_t WS_WOUT = WS_WIN + 2 * WIN_BYTES, WOUT_BYTES = (size_t)DM * DM * 2;
constexpr size_t WS_WGU = WS_WOUT + 2 * WOUT_BYTES, WGU_BYTES = (size_t)NGU * DM * 2;
constexpr size_t WS_WDN = WS_WGU + 2 * WGU_BYTES, WDN_BYTES = (size_t)DM * DFF * 2;
static_assert(WS_WDN + 2 * WDN_BYTES <= 56 * MiB, "weights");
constexpr size_t WS_SSP = 56 * MiB;
constexpr size_t WS_AVEC = 58 * MiB;
constexpr size_t WS_BIASIN = WS_AVEC + 64 * 1024;
constexpr size_t WS_BIASGU = WS_BIASIN + 64 * 1024;
static_assert(WS_BIASGU + 2 * 2 * NGU * 4 <= 64 * MiB && 2 * 2 * NIN * 4 <= 64 * 1024, "fused-norm vectors");
constexpr size_t WS_XN = 64 * MiB;
constexpr size_t WS_U = 64 * MiB;
constexpr size_t WS_CS = 96 * MiB;
constexpr size_t WS_LIST = 112 * MiB;
constexpr size_t WS_PROJ = 128 * MiB;
constexpr size_t WS_H = 128 * MiB;
constexpr size_t WS_Y = 336 * MiB;
constexpr size_t WS_QC = 400 * MiB, WS_KC = 416 * MiB;
constexpr size_t WS_OPART = 432 * MiB;
constexpr size_t WS_LPART = 504 * MiB;
constexpr size_t WS_GATES = 507 * MiB;
constexpr size_t WS_FOXCUM = 509 * MiB;
constexpr size_t WS_SEL = 510 * MiB;
constexpr size_t WS_END = 512 * MiB;
static_assert(WS_PROJ + (size_t)MROWS * PLD * 2 <= WS_Y && WS_SEL + (size_t)MROWS * 6 * 4 <= WS_END, "ws map");
constexpr int CW_BAR = 4096;
constexpr int CW_QUEUE = 16384;
constexpr int CW_LCNT = 32768;

constexpr int RING_BYTES = 131072, LDSCTL_OFF = RING_BYTES, MISC_OFF = LDSCTL_OFF + 320, LDS_BYTES = 147456;
constexpr int NWAVES = 8, NTHREADS = 512;
namespace pg8 {
#define PG8_LAS __attribute__((address_space(3)))
typedef unsigned short bf16_t;
typedef short bf16x8 __attribute__((ext_vector_type(8)));
typedef float f32x4 __attribute__((ext_vector_type(4)));
typedef unsigned u32x4 __attribute__((ext_vector_type(4)));
constexpr int BM = 256, BK = 64, HALF = 128, HTB = HALF * BK * 2  , STAGE_BYTES = 8 * HTB, NXCD = 8, WGM = 8;

__host__ __device__ __forceinline__ int lds_byte(int r, int c) { const int st = (r >> 4) * 2 + (c >> 5), rr = r & 15, cc = c & 31, ob = rr * 64 + cc * 2; return st * 1024 + (ob ^ (((ob >> 9) & 1) << 5)); }
__host__ __device__ __forceinline__ void stage_rc(int b, int& R, int& C) { const int st = b / 1024, sb = b % 1024, swz = sb ^ (((sb >> 9) & 1) << 5); R = (st >> 1) * 16 + swz / 64; C = (st & 1) * 32 + (swz % 64) / 2; }
__host__ __device__ __forceinline__ int perm32(int rho) { const int n = rho >> 4, i = rho & 15; return 8 * (i >> 2) + 4 * n + (i & 3); }

struct Unit { int pm, pn, ord; };
struct Gemm { const bf16_t* A; const bf16_t* Bt; int M, N, K; };

struct StaticOrder {
    int nM, nN, nwg, G, c;
    __host__ __device__ void init(int M, int N, int G_, int c_) { nM = M / BM; nN = N / BM; nwg = nM * nN; G = G_; c = c_; }
    __host__ __device__ bool next(int i, Unit& u) const {
        const long L = (long)i * G + c; if (L >= nwg) return false;
        int wgid = (int)L; { const int q = nwg / NXCD, r = nwg % NXCD, xcd = wgid % NXCD, off = wgid / NXCD; wgid = (xcd < r ? xcd * (q + 1) : r * (q + 1) + (xcd - r) * q) + off; }
        const int nig = WGM * nN, gid = wgid / nig, fm = gid * WGM, gsz = (nM - fm) < WGM ? (nM - fm) : WGM;
        u.pm = fm + ((wgid % nig) % gsz); u.pn = (wgid % nig) / gsz; u.ord = i; return true;
    }
    __device__ __forceinline__ void a_ready(const Unit&) const {}
    __device__ __forceinline__ void done(const Unit&) const {}
};

__device__ __forceinline__ unsigned cvt_pk_bf16(float lo, float hi) { unsigned r; asm volatile("v_cvt_pk_bf16_f32 %0, %1, %2" : "=v"(r) : "v"(lo), "v"(hi)); return r; }
typedef float f32x2 __attribute__((ext_vector_type(2)));
typedef unsigned u32x2 __attribute__((ext_vector_type(2)));
struct EpiProj {
    static constexpr bool PERM = true, AFTER_DRAIN = false;
    bf16_t* P; float* G; int pld; PG8_LAS const float* rt; int pm0; PG8_LAS const float* bt;
    __device__ __forceinline__ void operator()(const f32x4 (&acc)[2][2][4][2], const Unit& u, int wr, int wc, int fr, int fq) const {
        const int row0 = u.pm * BM + wr * 64 + fr;
        PG8_LAS const float* rs = rt + (u.pm == pm0 ? 0 : 256) + wr * 64 + fr;
        PG8_LAS const float* bb = bt + u.ord * 256 + wc * 32 + 8 * fq;
        if (u.pn < 13) {
            const int col0 = u.pn * BM + wc * 32 + 8 * fq;
            f32x4 bv[2][2];
#pragma unroll
            for (int bj = 0; bj < 2; ++bj)
#pragma unroll
                for (int n = 0; n < 2; ++n) bv[bj][n] = *(PG8_LAS const f32x4*)(bb + bj * HALF + 4 * n);
            float rsv[2][4];
#pragma unroll
            for (int ai = 0; ai < 2; ++ai)
#pragma unroll
                for (int m = 0; m < 4; ++m) rsv[ai][m] = rs[ai * HALF + m * 16];
#pragma unroll
            for (int ai = 0; ai < 2; ++ai)
#pragma unroll
                for (int m = 0; m < 4; ++m) { bf16_t* rowp = P + (size_t)(row0 + ai * HALF + m * 16) * pld + col0; const float rstd = rsv[ai][m];
#pragma unroll
                    for (int bj = 0; bj < 2; ++bj) { const f32x4 v0 = acc[ai][bj][m][0] * rstd + bv[bj][0], v1 = acc[ai][bj][m][1] * rstd + bv[bj][1];
                        u32x4 w; w.x = cvt_pk_bf16(v0[0], v0[1]); w.y = cvt_pk_bf16(v0[2], v0[3]); w.z = cvt_pk_bf16(v1[0], v1[1]); w.w = cvt_pk_bf16(v1[2], v1[3]);
                        *(u32x4*)(rowp + bj * HALF) = w; } }
        } else {
            if (wc == 0 && fq < 2) {
                const f32x4 b0 = *(PG8_LAS const f32x4*)(bb), b1 = *(PG8_LAS const f32x4*)(bb + 4);
#pragma unroll
                for (int ai = 0; ai < 2; ++ai)
#pragma unroll
                    for (int m = 0; m < 4; ++m) { float* gp = G + (size_t)(row0 + ai * HALF + m * 16) * 16 + 8 * fq; const float rstd = rs[ai * HALF + m * 16];
                        *(f32x4*)(gp) = acc[ai][0][m][0] * rstd + b0; *(f32x4*)(gp + 4) = acc[ai][0][m][1] * rstd + b1; }
            }
        }
    }
};
struct EpiRes {
    static constexpr bool PERM = true, AFTER_DRAIN = false;
    const float* base; float* out; const float* gate; int gate_bstride; int rows_per_batch; bf16_t* xa; const float* avec; float* ssp;
    __device__ __forceinline__ void operator()(const f32x4 (&acc)[2][2][4][2], const Unit& u, int wr, int wc, int fr, int fq) const {
        const int row0 = u.pm * BM + wr * 64 + fr, col0 = u.pn * BM + wc * 32 + 8 * fq;
        const int bat = (u.pm * BM) / rows_per_batch;
        const float* gb = gate + (size_t)bat * gate_bstride;
        f32x4 gv[2][2], av[2][2];
#pragma unroll
        for (int bj = 0; bj < 2; ++bj)
#pragma unroll
            for (int n = 0; n < 2; ++n) { gv[bj][n] = *(const f32x4*)(gb + col0 + bj * HALF + 4 * n); av[bj][n] = xa ? *(const f32x4*)(avec + (size_t)bat * 1024 + col0 + bj * HALF + 4 * n) : (f32x4){0.f, 0.f, 0.f, 0.f}; }
        const int lane = fq * 16 + fr;
#pragma unroll
        for (int ai = 0; ai < 2; ++ai)
#pragma unroll
            for (int m = 0; m < 4; ++m) { const size_t off = (size_t)(row0 + ai * HALF + m * 16) * 1024 + col0; float ss = 0.f;
#pragma unroll
                for (int bj = 0; bj < 2; ++bj) {
                    const f32x4 o0 = *(const f32x4*)(base + off + bj * HALF) + gv[bj][0] * acc[ai][bj][m][0], o1 = *(const f32x4*)(base + off + bj * HALF + 4) + gv[bj][1] * acc[ai][bj][m][1];
                    __builtin_nontemporal_store(o0, (f32x4*)(out + off + bj * HALF)); __builtin_nontemporal_store(o1, (f32x4*)(out + off + bj * HALF + 4));
                    if (xa) { ss += ((o0[0] * o0[0] + o0[1] * o0[1]) + (o0[2] * o0[2] + o0[3] * o0[3])) + ((o1[0] * o1[0] + o1[1] * o1[1]) + (o1[2] * o1[2] + o1[3] * o1[3]));
                        const f32x4 t0 = o0 * av[bj][0], t1 = o1 * av[bj][1];
                        u32x4 w; w.x = cvt_pk_bf16(t0[0], t0[1]); w.y = cvt_pk_bf16(t0[2], t0[3]); w.z = cvt_pk_bf16(t1[0], t1[1]); w.w = cvt_pk_bf16(t1[2], t1[3]);
                        *(u32x4*)(xa + off + bj * HALF) = w; } }
                if (xa) { ss += SWZ_X(ss, 16); ss += __builtin_bit_cast(float, __builtin_amdgcn_ds_bpermute((lane ^ 32) << 2, __builtin_bit_cast(int, ss)));
                    if (fq == 0) ssp[(size_t)(row0 + ai * HALF + m * 16) * 16 + u.pn * 4 + wc] = ss; } }
    }
};
struct EpiSwiglu {
    static constexpr bool PERM = true, AFTER_DRAIN = false;
    bf16_t* Hh; int ldh; PG8_LAS const float* rt; int pm0; PG8_LAS const float* bt;
    __device__ __forceinline__ void operator()(const f32x4 (&acc)[2][2][4][2], const Unit& u, int wr, int wc, int fr, int fq) const {
        const int row0 = u.pm * BM + wr * 64 + fr, col0 = u.pn * HALF + wc * 32 + 8 * fq;
        PG8_LAS const float* rs = rt + (u.pm == pm0 ? 0 : 256) + wr * 64 + fr;
        PG8_LAS const float* bb = bt + u.ord * 256 + wc * 32 + 8 * fq;
        f32x4 bv[2][2];
#pragma unroll
        for (int bj = 0; bj < 2; ++bj)
#pragma unroll
            for (int n = 0; n < 2; ++n) bv[bj][n] = *(PG8_LAS const f32x4*)(bb + bj * HALF + 4 * n);
        float rsv[2][4];
#pragma unroll
        for (int ai = 0; ai < 2; ++ai)
#pragma unroll
            for (int m = 0; m < 4; ++m) rsv[ai][m] = rs[ai * HALF + m * 16];
#pragma unroll
        for (int ai = 0; ai < 2; ++ai)
#pragma unroll
            for (int m = 0; m < 4; ++m) { bf16_t* rowp = Hh + (size_t)(row0 + ai * HALF + m * 16) * ldh + col0; const float rstd = rsv[ai][m];
                float hv[8];
#pragma unroll
                for (int n = 0; n < 2; ++n)
#pragma unroll
                    for (int i = 0; i < 4; ++i) { const float g = acc[ai][0][m][n][i] * rstd + bv[0][n][i], up = acc[ai][1][m][n][i] * rstd + bv[1][n][i];
                        const float e = __builtin_amdgcn_exp2f(-g * 1.4426950408889634f);
                        hv[n * 4 + i] = g * __builtin_amdgcn_rcpf(1.0f + e) * up; }
                u32x4 w; w.x = cvt_pk_bf16(hv[0], hv[1]); w.y = cvt_pk_bf16(hv[2], hv[3]); w.z = cvt_pk_bf16(hv[4], hv[5]); w.w = cvt_pk_bf16(hv[6], hv[7]);
                __builtin_nontemporal_store(w, (u32x4*)(rowp)); }
    }
};
template <class Epi, class Sched, bool ALIGN_EPI = false, bool SP2 = false>
__device__ __forceinline__ void gemm_phase(PG8_LAS unsigned char* lds, const Gemm g, const Sched& S, const Epi& E, const int tid_in) {
    const int tid = tid_in, wid = __builtin_amdgcn_readfirstlane(tid >> 6), lane = tid & 63, wr = wid >> 2, wc = wid & 3, fr = lane & 15, fq = lane >> 4;
    const int K = g.K, nt = K / BK;
    unsigned voffA[2], voffB[2];
#pragma unroll
    for (int i = 0; i < 2; ++i) { int R, C; stage_rc(tid * 16 + i * 8192, R, C); const int Rb = Epi::PERM ? ((R & ~31) + perm32(R & 31)) : R;
        voffA[i] = (unsigned)(R * K + C) * 2u; voffB[i] = (unsigned)(Rb * K + C) * 2u; }
    const size_t kstep = (size_t)(BK * 2);
    const size_t hstep = (size_t)HALF * K * 2;
    const size_t tstep = 2 * hstep;
    const unsigned ldsw = (unsigned)wid * 1024u;
    const int aoff = lds_byte(wr * 64 + fr, fq * 8), boff = lds_byte(wc * 32 + fr, fq * 8);
#define PG8_SA(b, h) (((b) * 2 + (h)) * HTB)
#define PG8_SB(b, h) ((4 + (b) * 2 + (h)) * HTB)
#define PG8_STAGE(bufoff, gbase, voff) do { _Pragma("unroll") for (int _i = 0; _i < 2; ++_i) \
        __builtin_amdgcn_global_load_lds((const unsigned*)((const char*)(gbase) + (voff)[_i]), (PG8_LAS unsigned*)(lds + (bufoff) + ldsw + _i * 8192), 16, 0, 0); } while (0)
#define PG8_LDA(dst, b, h) do { _Pragma("unroll") for (int m = 0; m < 4; ++m) _Pragma("unroll") for (int k = 0; k < 2; ++k) dst[m][k] = *(const PG8_LAS bf16x8*)(lds + PG8_SA(b, h) + aoff + m * 2048 + k * 1024); } while (0)
#define PG8_LDB(dst, b, h) do { _Pragma("unroll") for (int n = 0; n < 2; ++n) _Pragma("unroll") for (int k = 0; k < 2; ++k) dst[n][k] = *(const PG8_LAS bf16x8*)(lds + PG8_SB(b, h) + boff + n * 2048 + k * 1024); } while (0)
#define PG8_MMA(ai, bj, At, Bt) do { __builtin_amdgcn_s_setprio(1); _Pragma("unroll") for (int m = 0; m < 4; ++m) _Pragma("unroll") for (int n = 0; n < 2; ++n) _Pragma("unroll") for (int k = 0; k < 2; ++k) \
        acc[ai][bj][m][n] = __builtin_amdgcn_mfma_f32_16x16x32_bf16(Bt[n][k], At[m][k], acc[ai][bj][m][n], 0, 0, 0); __builtin_amdgcn_s_setprio(0); } while (0)
#define PG8_WAIT_V(n) asm volatile("s_waitcnt vmcnt(" #n ")" ::: "memory")
#define PG8_WAIT_L(n) asm volatile("s_waitcnt lgkmcnt(" #n ")" ::: "memory")
#define PG8_BAR __builtin_amdgcn_s_barrier()
#define PG8_SCHED __builtin_amdgcn_sched_barrier(0)
    Unit cur, nxt; int ui = 0;
    if (!S.next(0, cur)) return;
    f32x4 acc[2][2][4][2];
#pragma unroll
    for (int a = 0; a < 2; ++a)
#pragma unroll
        for (int b = 0; b < 2; ++b)
#pragma unroll
            for (int m = 0; m < 4; ++m)
#pragma unroll
                for (int n = 0; n < 2; ++n) acc[a][b][m][n] = (f32x4){0.f, 0.f, 0.f, 0.f};
    bf16x8 At[4][2], B0[2][2], B1[2][2];
    const char* cA = (const char*)g.A + (size_t)cur.pm * tstep; const char* cB = (const char*)g.Bt + (size_t)cur.pn * tstep;
    S.a_ready(cur);
    if constexpr (SP2) {
        PG8_STAGE(PG8_SB(0, 0), cB, voffB); PG8_STAGE(PG8_SB(0, 1), cB + hstep, voffB); PG8_STAGE(PG8_SA(0, 0), cA, voffA); PG8_STAGE(PG8_SA(0, 1), cA + hstep, voffA);
        if (wr == 1) PG8_BAR;
        PG8_WAIT_V(2); PG8_BAR;
        PG8_STAGE(PG8_SB(1, 0), cB + kstep, voffB); PG8_STAGE(PG8_SA(1, 0), cA + kstep, voffA); PG8_STAGE(PG8_SB(1, 1), cB + hstep + kstep, voffB);
        PG8_WAIT_V(6); PG8_BAR;
    } else {
        PG8_STAGE(PG8_SB(0, 0), cB, voffB); PG8_STAGE(PG8_SA(0, 0), cA, voffA); PG8_STAGE(PG8_SB(0, 1), cB + hstep, voffB); PG8_STAGE(PG8_SA(0, 1), cA + hstep, voffA);
        if (wr == 1) PG8_BAR;
        PG8_WAIT_V(4); PG8_BAR;
        PG8_STAGE(PG8_SB(1, 0), cB + kstep, voffB); PG8_STAGE(PG8_SA(1, 0), cA + kstep, voffA); PG8_STAGE(PG8_SB(1, 1), cB + hstep + kstep, voffB);
        PG8_WAIT_V(6); PG8_BAR;
    }
    for (;;) {
        const bool has_next = S.next(ui + 1, nxt);
        const char* nA = has_next ? (const char*)g.A + (size_t)nxt.pm * tstep : cA; const char* nB = has_next ? (const char*)g.Bt + (size_t)nxt.pn * tstep : cB;
        for (int t = 0; t < nt; t += 2) {
            const bool last = (t == nt - 2);
            const char* a1 = cA + (size_t)(t + 1) * kstep;
            const char* a2 = last ? nA : cA + (size_t)(t + 2) * kstep; const char* b2 = last ? nB : cB + (size_t)(t + 2) * kstep;
            const char* a3 = a2 + kstep; const char* b3 = b2 + kstep;
            if (last && has_next) S.a_ready(nxt);
            if constexpr (SP2) {
            PG8_LDB(B0, 0, 0); PG8_LDB(B1, 0, 1); PG8_SCHED; PG8_LDA(At, 0, 0); PG8_STAGE(PG8_SA(1, 1), a1 + hstep, voffA);
            PG8_WAIT_V(8); PG8_WAIT_L(0); PG8_BAR; PG8_MMA(0, 0, At, B0); PG8_MMA(0, 1, At, B1); PG8_BAR; PG8_SCHED;
            PG8_LDA(At, 0, 1); PG8_STAGE(PG8_SB(0, 0), b2, voffB); PG8_STAGE(PG8_SB(0, 1), b2 + hstep, voffB); PG8_STAGE(PG8_SA(0, 0), a2, voffA);
            PG8_WAIT_V(8); PG8_WAIT_L(0); PG8_BAR; PG8_MMA(1, 0, At, B0); PG8_MMA(1, 1, At, B1); PG8_BAR; PG8_SCHED;
            PG8_LDB(B0, 1, 0); PG8_LDB(B1, 1, 1); PG8_SCHED; PG8_LDA(At, 1, 0); PG8_STAGE(PG8_SA(0, 1), a2 + hstep, voffA);
            PG8_WAIT_V(8); PG8_WAIT_L(0); PG8_BAR; PG8_MMA(0, 0, At, B0); PG8_MMA(0, 1, At, B1); PG8_BAR; PG8_SCHED;
            PG8_LDA(At, 1, 1); PG8_STAGE(PG8_SB(1, 0), b3, voffB); PG8_STAGE(PG8_SB(1, 1), b3 + hstep, voffB); PG8_STAGE(PG8_SA(1, 0), a3, voffA);
            PG8_WAIT_V(8); PG8_WAIT_L(0); PG8_BAR; PG8_MMA(1, 0, At, B0); PG8_MMA(1, 1, At, B1); PG8_BAR; PG8_SCHED;
            } else {
            PG8_LDB(B0, 0, 0); PG8_SCHED; PG8_LDA(At, 0, 0); PG8_STAGE(PG8_SA(1, 1), a1 + hstep, voffA);
            PG8_WAIT_L(8); PG8_BAR; PG8_WAIT_L(0); PG8_MMA(0, 0, At, B0); PG8_BAR; PG8_SCHED;
            PG8_LDB(B1, 0, 1); PG8_STAGE(PG8_SB(0, 0), b2, voffB);
            PG8_BAR; PG8_WAIT_L(0); PG8_MMA(0, 1, At, B1); PG8_BAR;
            PG8_LDA(At, 0, 1); PG8_STAGE(PG8_SA(0, 0), a2, voffA);
            PG8_BAR; PG8_WAIT_L(0); PG8_MMA(1, 0, At, B0); PG8_BAR; PG8_SCHED;
            PG8_STAGE(PG8_SB(0, 1), b2 + hstep, voffB);
            PG8_WAIT_V(6); PG8_BAR; PG8_MMA(1, 1, At, B1); PG8_BAR;
            PG8_LDB(B0, 1, 0); PG8_SCHED; PG8_LDA(At, 1, 0); PG8_STAGE(PG8_SA(0, 1), a2 + hstep, voffA);
            PG8_WAIT_L(8); PG8_BAR; PG8_WAIT_L(0); PG8_MMA(0, 0, At, B0); PG8_BAR; PG8_SCHED;
            PG8_LDB(B1, 1, 1); PG8_STAGE(PG8_SB(1, 0), b3, voffB);
            PG8_BAR; PG8_WAIT_L(0); PG8_MMA(0, 1, At, B1); PG8_BAR;
            PG8_LDA(At, 1, 1); PG8_STAGE(PG8_SA(1, 0), a3, voffA);
            PG8_BAR; PG8_WAIT_L(0); PG8_MMA(1, 0, At, B0); PG8_BAR; PG8_SCHED;
            PG8_STAGE(PG8_SB(1, 1), b3 + hstep, voffB);
            PG8_WAIT_V(6); PG8_BAR; PG8_MMA(1, 1, At, B1); PG8_BAR;
            }
        }
        if constexpr (ALIGN_EPI) { if (wr == 0) PG8_BAR; }
        if constexpr (!Epi::AFTER_DRAIN) { E(acc, cur, wr, wc, fr, fq); S.done(cur); }
        if (!has_next) break;
#pragma unroll
        for (int a = 0; a < 2; ++a)
#pragma unroll
            for (int b = 0; b < 2; ++b)
#pragma unroll
                for (int m = 0; m < 4; ++m)
#pragma unroll
                    for (int n = 0; n < 2; ++n) acc[a][b][m][n] = (f32x4){0.f, 0.f, 0.f, 0.f};
        cur = nxt; cA = nA; cB = nB; ++ui;
        if constexpr (ALIGN_EPI) { if (wr == 1) PG8_BAR; }
    }
    PG8_WAIT_V(0);
    if constexpr (!ALIGN_EPI) { if (wr == 0) PG8_BAR; }
    PG8_BAR;
    if constexpr (Epi::AFTER_DRAIN) { E.fused(acc, cur, wr, wc, fr, fq, lds, wid, lane); S.done(cur); }
#undef PG8_SA
#undef PG8_SB
#undef PG8_STAGE
#undef PG8_LDA
#undef PG8_LDB
#undef PG8_MMA
#undef PG8_WAIT_V
#undef PG8_WAIT_L
#undef PG8_BAR
#undef PG8_SCHED
}
}
#define XB_TMO      128
#define XB_XCNT(j)  (256  + 64 * (j))
#define XB_XSUB(j)  (1280 + 64 * (j))
#define XB_XGEN(j)  (2304 + 64 * (j))
#define XB_TOP      3328
#define XB_TOPGEN   3392
#define XCD_BAR_WORDS 3456
#define XB_SPIN_CAP (1u << 18)

__device__ __forceinline__ unsigned xb_ld(unsigned* p)              { return __hip_atomic_load(p, __ATOMIC_RELAXED, __HIP_MEMORY_SCOPE_AGENT); }
__device__ __forceinline__ unsigned xb_add(unsigned* p, unsigned v) { return __hip_atomic_fetch_add(p, v, __ATOMIC_RELAXED, __HIP_MEMORY_SCOPE_AGENT); }
__device__ __forceinline__ unsigned xb_xcc_id() { return (unsigned)__builtin_amdgcn_s_getreg((3 << 11) | 20) & 0xFu; }
#define XB_SPIN(cond, bar) do { unsigned _sp = 0; while (cond) { __builtin_amdgcn_s_sleep(1); \
    if ((++_sp & 255u) == 0u) { if (xb_ld(&(bar)[XB_TMO])) break; if (_sp > XB_SPIN_CAP) { atomicAdd(&(bar)[XB_TMO], 1u); break; } } } } while (0)

struct XcdBarrier {
    unsigned* bar; unsigned x;
    volatile LAS unsigned* st;
};

__device__ __forceinline__ XcdBarrier xcd_barrier_post(unsigned* bar, volatile LAS unsigned* st) {
    XcdBarrier b; b.bar = bar; b.x = xb_xcc_id(); b.st = st;
    if (threadIdx.x == 0) (void)xb_add(&bar[XB_XCNT(b.x)], 1u);
    return b;
}
__device__ __forceinline__ void xcd_barrier_complete(unsigned* bar, unsigned x, unsigned& nloc, unsigned& nx) {
    const unsigned G = gridDim.x * gridDim.y * gridDim.z;
    unsigned sum, cnt, mine, sp = 0u;
    for (;;) {
        sum = 0u; cnt = 0u; mine = 0u;
#pragma unroll
        for (unsigned j = 0; j < 16; ++j) { const unsigned c = xb_ld(&bar[XB_XCNT(j)]); sum += c; cnt += (c > 0u) ? 1u : 0u; mine = (j == x) ? c : mine; }
        if (sum == G) break;
        __builtin_amdgcn_s_sleep(1);
        if ((++sp & 255u) == 0u) { if (xb_ld(&bar[XB_TMO])) break; if (sp > XB_SPIN_CAP) { atomicAdd(&bar[XB_TMO], 1u); break; } }
    }
    nloc = mine > 0u ? mine : 1u; nx = cnt > 0u ? cnt : 1u;
}

__device__ __forceinline__ void xcd_barrier(const XcdBarrier& b) {
    asm volatile("s_waitcnt vmcnt(0)" ::: "memory");
    __syncthreads();
    if (threadIdx.x == 0) {
        unsigned* bar = b.bar; asm volatile("" : "+s"(bar));
        const unsigned bx_ = xb_xcc_id();
        __builtin_amdgcn_s_waitcnt(0);
        unsigned nloc = b.st[0], nx = b.st[1];
        if (nloc == 0u) { xcd_barrier_complete(bar, bx_, nloc, nx); b.st[0] = nloc; b.st[1] = nx; }
        const unsigned old = xb_add(&bar[XB_XSUB(bx_)], 1u);
        const unsigned gen = old / nloc;
        if (old + 1u == (gen + 1u) * nloc) {
            __builtin_amdgcn_fence(__ATOMIC_RELEASE, "agent");
            asm volatile("s_waitcnt vmcnt(0)" ::: "memory");
            const unsigned og = xb_add(&bar[XB_TOP], 1u);
            const unsigned tg = og / nx;
            if (og + 1u == (tg + 1u) * nx) xb_add(&bar[XB_TOPGEN], 1u);
            else XB_SPIN(xb_ld(&bar[XB_TOPGEN]) == tg, bar);
            __builtin_amdgcn_fence(__ATOMIC_ACQUIRE, "agent");
            xb_add(&bar[XB_XGEN(bx_)], 1u);
            asm volatile("s_waitcnt vmcnt(0)" ::: "memory");
        } else {
            XB_SPIN(xb_ld(&bar[XB_XGEN(bx_)]) == gen, bar);
            __builtin_amdgcn_fence(__ATOMIC_ACQUIRE, "agent");
            asm volatile("s_waitcnt vmcnt(0)" ::: "memory");
        }
    }
    __syncthreads();
}
#define LDS_WAIT() asm volatile("s_waitcnt lgkmcnt(0)" ::: "memory")
__device__ __forceinline__ void unpack8(const v4u w, float* f) { f[0] = bflo(w.x); f[1] = bfhi(w.x); f[2] = bflo(w.y); f[3] = bfhi(w.y); f[4] = bflo(w.z); f[5] = bfhi(w.z); f[6] = bflo(w.w); f[7] = bfhi(w.w); }

__device__ __forceinline__ int win_src(int c) {
    if (c < 1152) return c;
    if (c < 2304) return c + 1038;
    if (c < 3072) return c - 1146;
    if (c < 3328) return c - 1138;
    if (c < 3334) return c - 3328 + 1152;
    if (c < 3338) return c - 3334 + 1926;
    if (c < 3342) return c - 3338 + 1930;
    return -1;
}
__device__ __forceinline__ int wgu_src(int r) { const int pn = r >> 8, w = r & 255; return (w < 128 ? 0 : DFF) + pn * 128 + (w & 127); }
template <int MODE> __device__ __forceinline__ int src_col(int r) { if (MODE == 1) return win_src(r); if (MODE == 2) return wgu_src(r); return r; }

template <int MODE> __device__ __forceinline__ void transpose_item(const float* W, int K, int ldw, bf16* WT, LAS float* scr, int nblk, int item, int lane) {
    const int kb = item / nblk, nb = item % nblk, k0 = 64 * kb, n0 = 32 * nb;
    const int sc = src_col<MODE>(n0 + (lane & 31));
#pragma unroll 8
    for (int i = 0; i < 32; ++i) { const int kk = 2 * i + (lane >> 5); scr[kk * 33 + (lane & 31)] = (sc >= 0) ? W[(size_t)(k0 + kk) * ldw + sc] : 0.f; }
    LDS_WAIT(); asm volatile("" ::: "memory");
    const int c = lane & 7;
#pragma unroll
    for (int j = 0; j < 4; ++j) { const int n = (lane >> 3) + 8 * j; const LAS float* s = scr + (8 * c) * 33 + n;
        v4u o; o.x = pk2(s[0 * 33], s[1 * 33]); o.y = pk2(s[2 * 33], s[3 * 33]); o.z = pk2(s[4 * 33], s[5 * 33]); o.w = pk2(s[6 * 33], s[7 * 33]);
        *(GAS v4u*)(WT + (size_t)(n0 + n) * K + k0 + 8 * c) = o; }
    LDS_WAIT(); asm volatile("" ::: "memory");
}

__device__ __forceinline__ void p0_mod_unit(int u, const float* cvec, const float* w_ada, const float* b_ada, float* mod, LAS float* lds, int tid, int wave, int lane) {
    LAS float* sc = lds; LAS float* red = lds + 2048;
    for (int i = tid; i < 2048; i += NTHREADS) { const float v = cvec[i]; sc[i] = v / (1.f + expf(-v)); }
    __syncthreads();
    const int l = u / 96, n = (u % 96) * 64 + lane;
    const float* wp = w_ada + ((size_t)l * 1024 + wave * 128) * 6144 + n;
    float a0 = 0.f, a1 = 0.f;
#pragma unroll 16
    for (int kk = 0; kk < 128; ++kk) { const float w = wp[(size_t)kk * 6144]; a0 += sc[wave * 128 + kk] * w; a1 += sc[1024 + wave * 128 + kk] * w; }
    red[(wave * 2 + 0) * 64 + lane] = a0; red[(wave * 2 + 1) * 64 + lane] = a1;
    __syncthreads();
    if (tid < 128) { const int b = tid >> 6; float s = 0.f;
#pragma unroll
        for (int w = 0; w < 8; ++w) s += red[(w * 2 + b) * 64 + lane];
        mod[((size_t)l * 2 + b) * 6144 + n] = s + b_ada[l * 6144 + n]; }
    __syncthreads();
}

__device__ __forceinline__ void pre_rows(const float* xsrc, const float* g, const float* mod_b0, bf16* XA, float* SSP, int gw, int NGW, int lane) {
    for (int m = gw; m < MROWS; m += NGW) {
        const int b = m / SEQ; const float* mb = mod_b0 + (size_t)b * 6144;
        const GAS f32x4* xr = (const GAS f32x4*)(xsrc + (size_t)m * DM) + lane;
        f32x4 v[4]; float ss = 0.f;
#pragma unroll
        for (int j = 0; j < 4; ++j) { v[j] = xr[64 * j]; ss += (v[j].x * v[j].x + v[j].y * v[j].y) + (v[j].z * v[j].z + v[j].w * v[j].w); }
        const float tot = wave_sum(ss);
        if (lane < 16) SSP[(size_t)m * 16 + lane] = lane == 0 ? tot : 0.f;
        GAS v2u* o8 = (GAS v2u*)(XA + (size_t)m * DM) + lane;
#pragma unroll
        for (int j = 0; j < 4; ++j) { const int col = 4 * lane + 256 * j;
            const f32x4 gg = *(const f32x4*)(g + col), sv = *(const f32x4*)(mb + 1024 + col);
            const f32x4 o = v[j] * gg * (sv + 1.0f);
            v2u w; w.x = pk2(o.x, o.y); w.y = pk2(o.z, o.w); o8[64 * j] = w; }
    }
}
__device__ __forceinline__ void pre_avec(const float* n1g, const float* n2g, const float* MODp, float* AVEC, int gtid, int ngt) {
    for (int i = gtid; i < DEPTH * 2 * 2 * 1024; i += ngt) { const int col = i & 1023, b = (i >> 10) & 1, w = (i >> 11) & 1, l = i >> 12;
        const float g = (w ? n2g : n1g)[l * 1024 + col], sc = MODp[((size_t)l * 2 + b) * 6144 + (w ? 4096 : 1024) + col];
        AVEC[i] = g * (1.f + sc); }
}
__device__ __forceinline__ void pre_bias(const bf16* WT, int nrows, const float* sh0, const float* sh1, float* bias0, float* bias1, int gw, int NGW, int lane) {
    for (int n = gw; n < nrows; n += NGW) {
        float w[16]; unpack8(*(const v4u*)(WT + (size_t)n * 1024 + lane * 16), w); unpack8(*(const v4u*)(WT + (size_t)n * 1024 + lane * 16 + 8), w + 8);
        float a0 = 0.f, a1 = 0.f;
#pragma unroll
        for (int q4 = 0; q4 < 4; ++q4) { const f32x4 s0 = *(const f32x4*)(sh0 + lane * 16 + 4 * q4), s1 = *(const f32x4*)(sh1 + lane * 16 + 4 * q4);
            a0 += (w[4 * q4] * s0.x + w[4 * q4 + 1] * s0.y) + (w[4 * q4 + 2] * s0.z + w[4 * q4 + 3] * s0.w);
            a1 += (w[4 * q4] * s1.x + w[4 * q4 + 1] * s1.y) + (w[4 * q4 + 2] * s1.z + w[4 * q4 + 3] * s1.w); }
        a0 = wave_sum(a0); a1 = wave_sum(a1);
        if (lane == 0) { bias0[n] = a0; bias1[n] = a1; }
    }
}
template <class Sched> __device__ __forceinline__ int rstd_tables(const Sched& S, const float* SSP, LAS float* rt, const float* bias, int bstride, LAS float* bt, int tid) {
    pg8::Unit u; int pm0 = -1, pm1 = -1;
    for (int i = 0; S.next(i, u); ++i) { if (pm0 < 0) pm0 = u.pm; else if (u.pm != pm0 && pm1 < 0) pm1 = u.pm;
        if (tid < 64) *(LAS f32x4*)(bt + i * 256 + tid * 4) = *(const f32x4*)(bias + (size_t)((u.pm * 256) / SEQ) * bstride + u.pn * 256 + tid * 4); }
    if (tid < 256) {
#pragma unroll
        for (int slot = 0; slot < 2; ++slot) { const int pm = slot ? pm1 : pm0;
            if (pm >= 0) { const float* sp = SSP + ((size_t)pm * 256 + tid) * 16;
                const f32x4 a = *(const f32x4*)sp, b = *(const f32x4*)(sp + 4), c = *(const f32x4*)(sp + 8), d = *(const f32x4*)(sp + 12);
                const float s = (((a.x + a.y) + (a.z + a.w)) + ((b.x + b.y) + (b.z + b.w))) + (((c.x + c.y) + (c.z + c.w)) + ((d.x + d.y) + (d.z + d.w)));
                rt[slot * 256 + tid] = 1.f / sqrtf(s * (1.f / DM) + EPS); } }
    }
    __syncthreads();
    return pm0;
}

__device__ __forceinline__ void post_foxcum_unit(int bh, const float* GATESp, float* FOXCUMp, const float* fox_f_bias, LAS float* lds, int tid, int wave, int lane) {
    const int b = bh / 6, h = bh % 6; const float bias = fox_f_bias[h];
    float v[32];
#pragma unroll
    for (int r = 0; r < 32; ++r) { const int t = wave * 2048 + r * 64 + lane; v[r] = log_sigmoid_f(GATESp[((size_t)b * SEQ + t) * 16 + h] + bias) * LOG2E; }
    float carry = 0.f;
#pragma unroll
    for (int r = 0; r < 32; ++r) { float x = v[r];
#pragma unroll
        for (int o = 1; o < 64; o <<= 1) { const float n = sup(x, o, lane); if (lane >= o) x += n; }
        x += carry; v[r] = x; carry = shf(x, 63); }
    if (lane == 0) lds[wave] = carry;
    __syncthreads();
    float off = 0.f;
    for (int w = 0; w < wave; ++w) off += lds[w];
#pragma unroll
    for (int r = 0; r < 32; ++r) FOXCUMp[(size_t)bh * SEQ + wave * 2048 + r * 64 + lane] = v[r] + off;
    __syncthreads();
}
__device__ __forceinline__ void post_qknorm_unit(int u, bf16* PROJp, float* KMEANP, const float* gfq, const float* gfk, const float* gbq, const float* gbk, LAS float* lds, int tid, int wave, int lane) {
    const int blk = u >> 1, half = u & 1, sub = lane & 7;
    int colv[3]; float gv[3][8]; float qsv[3];
#pragma unroll
    for (int it = 0; it < 3; ++it) { const int hsel = it * 8 + (lane >> 3), grp = hsel / 6, hh = hsel % 6;
        colv[it] = (grp == 0 ? C_FQ : grp == 1 ? C_FK : grp == 2 ? C_BQ : C_BK) + hh * 64 + 8 * sub;
        const float* gp = (grp == 0 ? gfq : grp == 1 ? gfk : grp == 2 ? gbq : gbk) + 8 * sub;
#pragma unroll
        for (int i = 0; i < 8; ++i) gv[it][i] = gp[i];
        qsv[it] = (grp == 0 || grp == 2) ? QSCALE : 1.f; }
    float ka[8] = {0.f, 0.f, 0.f, 0.f, 0.f, 0.f, 0.f, 0.f};
    const size_t row0 = (size_t)blk * 256 + half * 128 + wave * 16;
#pragma unroll 4
    for (int r = 0; r < 16; ++r) {
#pragma unroll
        for (int it = 0; it < 3; ++it) {
            v4u* p = (v4u*)(PROJp + (row0 + r) * PLD + colv[it]);
            float f[8]; unpack8(*p, f);
            float ss = 0.f;
#pragma unroll
            for (int i = 0; i < 8; ++i) ss += f[i] * f[i];
            ss += SWZ_X(ss, 1); ss += SWZ_X(ss, 2); ss += SWZ_X(ss, 4);
            const float rr = 1.f / sqrtf(ss * (1.f / 64.f) + EPS);
#pragma unroll
            for (int i = 0; i < 8; ++i) f[i] = f[i] * rr * gv[it][i];
            if (it == 2) {
#pragma unroll
                for (int i = 0; i < 8; ++i) ka[i] += f[i]; }
            const float qs = qsv[it];
            v4u w; w.x = pk2(f[0] * qs, f[1] * qs); w.y = pk2(f[2] * qs, f[3] * qs); w.z = pk2(f[4] * qs, f[5] * qs); w.w = pk2(f[6] * qs, f[7] * qs);
            *p = w;
        }
    }
    if (lane >= 16) {
#pragma unroll
        for (int i = 0; i < 8; ++i) lds[wave * 384 + ((lane >> 3) - 2) * 64 + 8 * sub + i] = ka[i]; }
    __syncthreads();
    if (tid < 384) { float s = 0.f;
#pragma unroll
        for (int w = 0; w < 8; ++w) s += lds[w * 384 + tid];
        const int b = blk / NBLK, n = blk % NBLK, head = tid >> 6, dd = tid & 63;
        KMEANP[(size_t)half * (12 * NBLK * 64) + (((size_t)b * 6 + head) * NBLK + n) * 64 + dd] = s * (1.f / 256.f); }
    __syncthreads();
}
__device__ __forceinline__ void post_conv_unit(int blk, int which, const bf16* PROJp, bf16* dst, const float* conv_w, const float* conv_b, int tid) {
    const bf16* src = PROJp + (which ? C_MK : C_MQ); const float osc = which ? 0.125f : 1.f;
    const int c = 8 * (tid & 31), rs = tid >> 5, ch = which * 256 + c;
    const size_t r0 = (size_t)blk * 256 + rs * 16; const int tl = (int)(r0 % SEQ);
    float w[4][8], bb[8];
#pragma unroll
    for (int i = 0; i < 4; ++i) { const f32x4 a = *(const f32x4*)(conv_w + i * 512 + ch), b2 = *(const f32x4*)(conv_w + i * 512 + ch + 4);
        w[i][0] = a.x; w[i][1] = a.y; w[i][2] = a.z; w[i][3] = a.w; w[i][4] = b2.x; w[i][5] = b2.y; w[i][6] = b2.z; w[i][7] = b2.w; }
    { const f32x4 a = *(const f32x4*)(conv_b + ch), b2 = *(const f32x4*)(conv_b + ch + 4); bb[0] = a.x; bb[1] = a.y; bb[2] = a.z; bb[3] = a.w; bb[4] = b2.x; bb[5] = b2.y; bb[6] = b2.z; bb[7] = b2.w; }
    float x0[8], x1[8], x2[8], x3[8];
    { v4u h3[3];
#pragma unroll
      for (int k = 0; k < 3; ++k) { if (tl + k - 3 >= 0) h3[k] = *(const v4u*)(src + (r0 + k - 3) * PLD + c); else h3[k] = (v4u){0u, 0u, 0u, 0u}; }
      unpack8(h3[0], x0); unpack8(h3[1], x1); unpack8(h3[2], x2); }
#pragma unroll 1
    for (int hb = 0; hb < 2; ++hb) {
        v4u in[8];
#pragma unroll
        for (int k = 0; k < 8; ++k) in[k] = *(const v4u*)(src + (r0 + hb * 8 + k) * PLD + c);
#pragma unroll
        for (int r = 0; r < 8; ++r) {
            unpack8(in[r], x3);
            float y[8];
#pragma unroll
            for (int i = 0; i < 8; ++i) { const float t = bb[i] + w[0][i] * x0[i] + w[1][i] * x1[i] + w[2][i] * x2[i] + w[3][i] * x3[i];
                y[i] = t * __builtin_amdgcn_rcpf(1.f + __builtin_amdgcn_exp2f(-t * LOG2E)) * osc; x0[i] = x1[i]; x1[i] = x2[i]; x2[i] = x3[i]; }
            v4u o; o.x = pk2(y[0], y[1]); o.y = pk2(y[2], y[3]); o.z = pk2(y[4], y[5]); o.w = pk2(y[6], y[7]);
            *(v4u*)(dst + (r0 + hb * 8 + r) * 256 + c) = o;
        }
    }
}

struct MlP { const bf16* PROJ; const bf16* QC; const bf16* KC; const float* GATES; float* U; float* NU; float* BEND; float* MLOC; bf16* CS; float* NS; float* MS; bf16* Y;
             const float *ibias, *fbias, *hg; };
__device__ __forceinline__ void mlstm_m1(int ci, const MlP& P, LAS float* lds, int tid, int wave, int lane) {
    const int b = ci >> 10, h = (ci >> 8) & 3, c = ci & 255; const size_t row0 = (size_t)b * SEQ + c * 64;
    LAS float* Ks = lds; LAS float* Vs = lds + 4096; LAS float* ws = lds + 8192;
    { const int r = tid >> 3, cg = (tid & 7) * 8; float f[8];
      unpack8(*(const v4u*)(P.KC + (row0 + r) * 256 + h * 64 + cg), f);
#pragma unroll
      for (int i = 0; i < 8; ++i) Ks[r * 64 + cg + i] = f[i];
      unpack8(*(const v4u*)(P.PROJ + (row0 + r) * PLD + C_MV + h * 64 + cg), f);
#pragma unroll
      for (int i = 0; i < 8; ++i) Vs[r * 64 + cg + i] = f[i]; }
    if (wave == 0) {
        const size_t row = row0 + lane;
        const float fi = P.GATES[row * 16 + 6 + h] + P.ibias[h], ff = P.GATES[row * 16 + 10 + h] + P.fbias[h];
        float bc = log_sigmoid_f(ff);
#pragma unroll
        for (int o = 1; o < 64; o <<= 1) { const float n = sup(bc, o, lane); if (lane >= o) bc += n; }
        const float bend = shf(bc, 63);
        const float wl = bend - bc + fi; const float mloc = wave_max(wl);
        ws[lane] = expf(wl - mloc);
        if (lane == 0) { P.BEND[ci] = bend; P.MLOC[ci] = mloc; }
    }
    __syncthreads();
    { const int dv = tid >> 3, e0 = (tid & 7) * 8; float u[8] = {0.f, 0.f, 0.f, 0.f, 0.f, 0.f, 0.f, 0.f};
#pragma unroll 2
      for (int s = 0; s < 64; ++s) { const float vw = Vs[s * 64 + dv] * ws[s]; const f32x4 ka = *(const LAS f32x4*)(Ks + s * 64 + e0), kb = *(const LAS f32x4*)(Ks + s * 64 + e0 + 4);
          u[0] += vw * ka.x; u[1] += vw * ka.y; u[2] += vw * ka.z; u[3] += vw * ka.w; u[4] += vw * kb.x; u[5] += vw * kb.y; u[6] += vw * kb.z; u[7] += vw * kb.w; }
      float* up = P.U + (size_t)ci * 4096 + dv * 64 + e0;
      *(f32x4*)up = (f32x4){u[0], u[1], u[2], u[3]}; *(f32x4*)(up + 4) = (f32x4){u[4], u[5], u[6], u[7]}; }
    if (tid < 64) { float nu = 0.f; for (int s = 0; s < 64; ++s) nu += ws[s] * Ks[s * 64 + tid]; P.NU[(size_t)ci * 64 + tid] = nu; }
    __syncthreads();
}
__device__ __forceinline__ void mlstm_m2(int u, const MlP& P, int tid) {
    const int bh = u >> 3, eg = u & 7, elem = eg * 512 + tid, base = bh * 256;
    const bool donorm = (eg == 0 && tid < 64), doms = (eg == 0 && tid == 0);
    float C = 0.f, m = 0.f, nst = 0.f;
#pragma unroll 1
    for (int c0 = 0; c0 < 256; c0 += 16) {
        float uv[16], be[16], ml[16], nv[16];
#pragma unroll
        for (int i = 0; i < 16; ++i) { const int ci = base + c0 + i; uv[i] = P.U[(size_t)ci * 4096 + elem]; be[i] = P.BEND[ci]; ml[i] = P.MLOC[ci]; nv[i] = donorm ? P.NU[(size_t)ci * 64 + tid] : 0.f; }
#pragma unroll
        for (int i = 0; i < 16; ++i) { const int ci = base + c0 + i;
            P.CS[(size_t)ci * 4096 + elem] = (bf16)f2bf(C);
            if (donorm) P.NS[(size_t)ci * 64 + tid] = nst;
            if (doms) P.MS[ci] = m;
            const float mn = fmaxf(be[i] + m, ml[i]); const float dec = __builtin_amdgcn_exp2f((be[i] + m - mn) * LOG2E), wu = __builtin_amdgcn_exp2f((ml[i] - mn) * LOG2E);
            C = dec * C + wu * uv[i]; nst = dec * nst + wu * nv[i]; m = mn; }
    }
}
__device__ __forceinline__ void mlstm_m3(int ci, const MlP& P, LAS float* lds, int tid, int wave, int lane) {
    constexpr int LP = 68;
    const int b = ci >> 10, h = (ci >> 8) & 3, c = ci & 255; const size_t row0 = (size_t)b * SEQ + c * 64;
    LAS float* Qs = lds; LAS float* Ks = Qs + 64 * LP; LAS float* Cs = Ks + 64 * LP; LAS float* Sm = Cs + 64 * LP; LAS float* Vs = Sm + 64 * LP;
    LAS float* av = Vs + 4096; LAS float* gv = av + 64; LAS float* bcv = gv + 64; LAS float* nsv = bcv + 64;
    const float ms = P.MS[ci];
    { const int r = tid >> 3, cg = (tid & 7) * 8; float f[8];
      unpack8(*(const v4u*)(P.QC + (row0 + r) * 256 + h * 64 + cg), f);
#pragma unroll
      for (int i = 0; i < 8; ++i) Qs[r * LP + cg + i] = f[i];
      unpack8(*(const v4u*)(P.KC + (row0 + r) * 256 + h * 64 + cg), f);
#pragma unroll
      for (int i = 0; i < 8; ++i) Ks[r * LP + cg + i] = f[i];
      unpack8(*(const v4u*)(P.PROJ + (row0 + r) * PLD + C_MV + h * 64 + cg), f);
#pragma unroll
      for (int i = 0; i < 8; ++i) Vs[r * 64 + cg + i] = f[i];
      unpack8(*(const v4u*)(P.CS + (size_t)ci * 4096 + r * 64 + cg), f);
#pragma unroll
      for (int i = 0; i < 8; ++i) Cs[r * LP + cg + i] = f[i]; }
    if (wave == 0) {
        const size_t row = row0 + lane;
        const float fi = P.GATES[row * 16 + 6 + h] + P.ibias[h], ff = P.GATES[row * 16 + 10 + h] + P.fbias[h];
        float bc = log_sigmoid_f(ff);
#pragma unroll
        for (int o = 1; o < 64; o <<= 1) { const float n = sup(bc, o, lane); if (lane >= o) bc += n; }
        const float a = fi - bc; float pm = a;
#pragma unroll
        for (int o = 1; o < 64; o <<= 1) { const float n = sup(pm, o, lane); if (lane >= o) pm = fmaxf(pm, n); }
        av[lane] = a; gv[lane] = fmaxf(ms, pm); bcv[lane] = bc; nsv[lane] = P.NS[(size_t)ci * 64 + lane];
    }
    __syncthreads();
    const int j = tid >> 3, part = tid & 7, s0 = part * 8;
    const float gj = gv[j];
    { float sacc[8] = {0.f, 0.f, 0.f, 0.f, 0.f, 0.f, 0.f, 0.f};
#pragma unroll 1
      for (int e = 0; e < 64; e += 4) { const f32x4 q4 = *(const LAS f32x4*)(Qs + j * LP + e);
#pragma unroll
          for (int i = 0; i < 8; ++i) { const f32x4 k4 = *(const LAS f32x4*)(Ks + (s0 + i) * LP + e); sacc[i] += (q4.x * k4.x + q4.y * k4.y) + (q4.z * k4.z + q4.w * k4.w); } }
#pragma unroll
      for (int i = 0; i < 8; ++i) { const int s = s0 + i; Sm[j * LP + s] = (s <= j) ? sacc[i] * expf(av[s] - gj) : 0.f; } }
    __syncthreads();
    { const int dv0 = part * 8; float t1[8] = {0.f, 0.f, 0.f, 0.f, 0.f, 0.f, 0.f, 0.f}, t2[8] = {0.f, 0.f, 0.f, 0.f, 0.f, 0.f, 0.f, 0.f};
#pragma unroll 1
      for (int e = 0; e < 64; e += 4) { const f32x4 q4 = *(const LAS f32x4*)(Qs + j * LP + e);
#pragma unroll
          for (int i = 0; i < 8; ++i) { const f32x4 c4 = *(const LAS f32x4*)(Cs + (dv0 + i) * LP + e); t1[i] += (q4.x * c4.x + q4.y * c4.y) + (q4.z * c4.z + q4.w * c4.w); } }
#pragma unroll 2
      for (int s = 0; s < 64; ++s) { const float sm = Sm[j * LP + s]; const f32x4 va = *(const LAS f32x4*)(Vs + s * 64 + dv0), vb = *(const LAS f32x4*)(Vs + s * 64 + dv0 + 4);
          t2[0] += sm * va.x; t2[1] += sm * va.y; t2[2] += sm * va.z; t2[3] += sm * va.w; t2[4] += sm * vb.x; t2[5] += sm * vb.y; t2[6] += sm * vb.z; t2[7] += sm * vb.w; }
      float dn = 0.f, ssum = 0.f;
#pragma unroll
      for (int i = 0; i < 8; ++i) { dn += nsv[s0 + i] * Qs[j * LP + s0 + i]; ssum += Sm[j * LP + s0 + i]; }
      { dn += SWZ_X(dn, 1); ssum += SWZ_X(ssum, 1); dn += SWZ_X(dn, 2); ssum += SWZ_X(ssum, 2); dn += SWZ_X(dn, 4); ssum += SWZ_X(ssum, 4); }
      const float inter = expf(ms - gj), mj = bcv[j] + gj;
      const float den = inter * dn + ssum, dd = fmaxf(fabsf(den), expf(-mj)), rd = 1.f / dd;
      float hv[8], ss = 0.f;
#pragma unroll
      for (int i = 0; i < 8; ++i) { hv[i] = (inter * t1[i] + t2[i]) * rd; ss += hv[i] * hv[i]; }
      { ss += SWZ_X(ss, 1); ss += SWZ_X(ss, 2); ss += SWZ_X(ss, 4); }
      const float rr = 1.f / sqrtf(ss * (1.f / 64.f) + EPS);
      float mo[8]; unpack8(*(const v4u*)(P.PROJ + (row0 + j) * PLD + C_MO + h * 64 + dv0), mo);
      float y[8];
#pragma unroll
      for (int i = 0; i < 8; ++i) y[i] = hv[i] * rr * P.hg[h * 64 + dv0 + i] * sigmoid_f(mo[i]);
      v4u w; w.x = pk2(y[0], y[1]); w.y = pk2(y[2], y[3]); w.z = pk2(y[4], y[5]); w.w = pk2(y[6], y[7]);
      *(v4u*)(P.Y + (row0 + j) * 1024 + Y_ML + h * 64 + dv0) = w; }
    __syncthreads();
}

__device__ __forceinline__ size_t moba_list_off(int bh, int n);
__device__ __forceinline__ void moba_gate_unit(int u, const bf16* PROJ, const float* KMEAN, unsigned* SEL, unsigned* LCNT, unsigned* CTAB, unsigned short* LIST, float B2, float thresh2, LAS float* lds, int tid) {
    const int bh = u >> 6, qb = 63 - (u & 63), b = bh / 6, h = bh % 6;
    LAS float* km = lds; LAS float* cand = lds + 4096; LAS unsigned* cntl = (LAS unsigned*)(lds + 4096 + 1536);
    if (tid < 64) cntl[tid] = 0u;
    for (int i = tid; i < qb * 16; i += NTHREADS) *(LAS f32x4*)(km + i * 4) = *(const f32x4*)(KMEAN + (size_t)bh * NBLK * 64 + i * 4) + *(const f32x4*)(KMEAN + (size_t)(12 * NBLK * 64) + (size_t)bh * NBLK * 64 + i * 4);
    __syncthreads();
    const int query = tid & 255, half = tid >> 8; const size_t row = (size_t)b * SEQ + qb * 256 + query;
    float q[64];
#pragma unroll
    for (int i = 0; i < 8; ++i) unpack8(*(const v4u*)(PROJ + row * PLD + C_BQ + h * 64 + i * 8), q + i * 8);
    float v0 = -INFINITY, v1 = -INFINITY, v2 = -INFINITY; int i0 = 255, i1 = 255, i2 = 255;
    const int nlo = half * 32, nhi = (qb < nlo + 32) ? qb : nlo + 32;
    for (int n = nlo; n < nhi; ++n) { float g = 0.f;
#pragma unroll
        for (int d = 0; d < 64; d += 4) { const f32x4 k4 = *(const LAS f32x4*)(km + n * 64 + d); g += (q[d] * k4.x + q[d + 1] * k4.y) + (q[d + 2] * k4.z + q[d + 3] * k4.w); }
        if (g > v0) { v2 = v1; i2 = i1; v1 = v0; i1 = i0; v0 = g; i0 = n; } else if (g > v1) { v2 = v1; i2 = i1; v1 = g; i1 = n; } else if (g > v2) { v2 = g; i2 = n; } }
    if (half == 1) { cand[query * 6 + 0] = v0; cand[query * 6 + 1] = v1; cand[query * 6 + 2] = v2;
        cand[query * 6 + 3] = __int_as_float(i0); cand[query * 6 + 4] = __int_as_float(i1); cand[query * 6 + 5] = __int_as_float(i2); }
    __syncthreads();
    if (half == 0) {
#pragma unroll
        for (int k = 0; k < 3; ++k) { const float g = cand[query * 6 + k]; const int n = __float_as_int(cand[query * 6 + 3 + k]);
            if (n != 255) { if (g > v0) { v2 = v1; i2 = i1; v1 = v0; i1 = i0; v0 = g; i0 = n; } else if (g > v1) { v2 = v1; i2 = i1; v1 = g; i1 = n; } else if (g > v2) { v2 = g; i2 = n; } } }
        { const float slope2 = exp2f(-8.f * (float)(h + 1) / 6.f) * LOG2E; const float lim = (2.f * B2 + thresh2) / slope2; const int t0 = qb * 256 + query - 255;
          if (i0 != 255 && (float)(t0 - i0 * 256) > lim) i0 = 255;
          if (i1 != 255 && (float)(t0 - i1 * 256) > lim) i1 = 255;
          if (i2 != 255 && (float)(t0 - i2 * 256) > lim) i2 = 255; }
        SEL[row * 6 + h] = (unsigned)i0 | ((unsigned)i1 << 8) | ((unsigned)i2 << 16);
        if (LIST) { const unsigned t = (unsigned)(qb * 256 + query);
            if (i0 != 255) { const unsigned pos = __hip_atomic_fetch_add(cntl + i0, 1u, __ATOMIC_RELAXED, __HIP_MEMORY_SCOPE_WORKGROUP); LIST[moba_list_off(bh, i0) + (size_t)(qb - i0 - 1) * 256 + pos] = (unsigned short)(t | (0u << 14)); }
            if (i1 != 255) { const unsigned pos = __hip_atomic_fetch_add(cntl + i1, 1u, __ATOMIC_RELAXED, __HIP_MEMORY_SCOPE_WORKGROUP); LIST[moba_list_off(bh, i1) + (size_t)(qb - i1 - 1) * 256 + pos] = (unsigned short)(t | (1u << 14)); }
            if (i2 != 255) { const unsigned pos = __hip_atomic_fetch_add(cntl + i2, 1u, __ATOMIC_RELAXED, __HIP_MEMORY_SCOPE_WORKGROUP); LIST[moba_list_off(bh, i2) + (size_t)(qb - i2 - 1) * 256 + pos] = (unsigned short)(t | (2u << 14)); } }
    }
    __syncthreads();
    if (LIST && tid < 64) { const unsigned c = cntl[tid]; CTAB[((size_t)bh * 64 + qb) * 64 + tid] = c; if (c) atomicAdd(LCNT + bh * 64 + tid, c); }
    __syncthreads();
}

__device__ __forceinline__ void fox_naive(const bf16* PROJ, const float* FOXCUM, bf16* Y, int gw, int NGW, int lane) {
    for (int idx = gw; idx < 12 * SEQ; idx += NGW) {
        const int t = SEQ - 1 - idx / 12, bh = idx % 12, b = bh / 6, h = bh % 6; const size_t rb = (size_t)b * SEQ;
        const float qv = bf2f(PROJ[(rb + t) * PLD + C_FQ + h * 64 + lane]); const float ct = FOXCUM[(size_t)bh * SEQ + t];
        float m = -INFINITY, l = 0.f, acc = 0.f;
#pragma unroll 4
        for (int j = 0; j <= t; ++j) {
            const float kv = bf2f(PROJ[(rb + j) * PLD + C_FK + h * 64 + lane]), vv = bf2f(PROJ[(rb + j) * PLD + C_FV + h * 64 + lane]);
            const float s = wave_sum(qv * kv) + (ct - FOXCUM[(size_t)bh * SEQ + j]);
            const float mn = fmaxf(m, s), sc = exp2f(m - mn), p = exp2f(s - mn);
            l = l * sc + p; acc = acc * sc + p * vv; m = mn; }
        Y[(rb + t) * 1024 + Y_FOX + h * 64 + lane] = (bf16)f2bf(acc / l);
    }
}
__device__ __forceinline__ void moba_naive(const bf16* PROJ, const unsigned* SEL, bf16* Y, int gw, int NGW, int lane) {
    for (int idx = gw; idx < 12 * SEQ; idx += NGW) {
        const int t = SEQ - 1 - idx / 12, bh = idx % 12, b = bh / 6, h = bh % 6; const size_t rb = (size_t)b * SEQ;
        const float slope2 = exp2f(-8.f * (float)(h + 1) / 6.f) * LOG2E;
        const float qv = bf2f(PROJ[(rb + t) * PLD + C_BQ + h * 64 + lane]);
        const unsigned sel = SEL[(rb + t) * 6 + h];
        float m = -INFINITY, l = 0.f, acc = 0.f;
        for (int slot = 0; slot < 4; ++slot) {
            int j0, j1;
            if (slot < 3) { const int n = (sel >> (8 * slot)) & 0xff; if (n == 255) continue; j0 = n * 256; j1 = j0 + 256; } else { j0 = (t >> 8) * 256; j1 = t + 1; }
#pragma unroll 4
            for (int j = j0; j < j1; ++j) {
                const float kv = bf2f(PROJ[(rb + j) * PLD + C_BK + h * 64 + lane]), vv = bf2f(PROJ[(rb + j) * PLD + C_BV + h * 64 + lane]);
                const float s = wave_sum(qv * kv) - slope2 * (float)(t - j);
                const float mn = fmaxf(m, s), sc = exp2f(m - mn), p = exp2f(s - mn);
                l = l * sc + p; acc = acc * sc + p * vv; m = mn; }
        }
        Y[(rb + t) * 1024 + Y_MOBA + h * 64 + lane] = (bf16)f2bf(acc / l);
    }
}
typedef short v4i16_t __attribute__((ext_vector_type(4)));
typedef short s16x4 __attribute__((ext_vector_type(4)));
constexpr int ATT_K0 = 0, ATT_V0 = 32768, ATT_TAB = 132096;
#ifndef THRESH_NAT
#define THRESH_NAT 30.f
#endif
constexpr float THRESH2 = THRESH_NAT * LOG2E;

__device__ __forceinline__ int crow(int r, int hi) { return (r & 3) + 8 * (r >> 2) + 4 * hi; }
__device__ __forceinline__ s16x4 vtr(LAS const unsigned char* p) { return __builtin_bit_cast(s16x4, __builtin_amdgcn_ds_read_tr16_b64_v4i16((LAS v4i16_t*)p)); }
typedef float f32x2_t __attribute__((ext_vector_type(2))); typedef __bf16 bf16x2_t __attribute__((ext_vector_type(2)));
#ifndef CVT_ASM
#define CVT_ASM 0
#endif
#if CVT_ASM
__device__ __forceinline__ unsigned cvtpk(float lo, float hi) { unsigned r; asm volatile("v_cvt_pk_bf16_f32 %0, %1, %2\n\ts_nop 1" : "=v"(r) : "v"(lo), "v"(hi)); return r; }
#else
__device__ __forceinline__ unsigned cvtpk(float lo, float hi) { const f32x2_t v = {lo, hi}; const bf16x2_t b = __builtin_convertvector(v, bf16x2_t); return __builtin_bit_cast(unsigned, b); }
#endif

struct GroupRegs { v4u k[4], v[4]; };
__device__ __forceinline__ void group_issue(GroupRegs& R, const bf16* Kg, const bf16* Vg, int tid) {
#pragma unroll
    for (int i = 0; i < 4; ++i) { const int idx = tid + NTHREADS * i, row = idx >> 3, ch = idx & 7;
        R.k[i] = *(const v4u*)(Kg + (size_t)row * PLD + ch * 8); R.v[i] = *(const v4u*)(Vg + (size_t)row * PLD + ch * 8); }
}
__device__ __forceinline__ void group_commit(const GroupRegs& R, LAS unsigned char* kv, int tid) {
#pragma unroll
    for (int i = 0; i < 4; ++i) { const int idx = tid + NTHREADS * i, row = idx >> 3, ch = idx & 7;
        *(LAS v4u*)(kv + ATT_K0 + row * 128 + ((ch ^ ((row >> 1) & 7)) << 4)) = R.k[i];
        *(LAS v4u*)(kv + ATT_V0 + row * 128 + ((ch * 16) ^ (((row >> 1) & 1) << 6))) = R.v[i]; }
}
__device__ __forceinline__ void load_group(const bf16* Kg, const bf16* Vg, LAS unsigned char* kv, int tid) {
#pragma unroll
    for (int i = 0; i < 4; ++i) { const int idx = tid + NTHREADS * i, row = idx >> 3, ch = idx & 7;
        const v4u k = *(const v4u*)(Kg + (size_t)row * PLD + ch * 8), v = *(const v4u*)(Vg + (size_t)row * PLD + ch * 8);
        *(LAS v4u*)(kv + ATT_K0 + row * 128 + ((ch ^ ((row >> 1) & 7)) << 4)) = k;
        *(LAS v4u*)(kv + ATT_V0 + row * 128 + ((ch * 16) ^ (((row >> 1) & 1) << 6))) = v; }
}

template <bool FOX>
__device__ __forceinline__ void attn_subtile(LAS const unsigned char* kv, LAS const float* colt, int j0, const bf16x8 (&qf)[4], float rowterm, float slope2, bool mask, int qrel,
                                             f32x16 (&o)[2], float& l, int lane) {
    const int r32 = lane & 31, hh = lane >> 5;
    f32x16 acc;
    if (FOX) {
#pragma unroll
        for (int g = 0; g < 4; ++g) { const f32x4 c = *(LAS const f32x4*)(colt + j0 + 8 * g + 4 * hh); acc[4 * g + 0] = rowterm + c.x; acc[4 * g + 1] = rowterm + c.y; acc[4 * g + 2] = rowterm + c.z; acc[4 * g + 3] = rowterm + c.w; }
    } else {
#pragma unroll
        for (int r = 0; r < 16; ++r) acc[r] = rowterm + slope2 * (float)(j0 + crow(r, hh));
    }
    if (mask) {
#pragma unroll
        for (int r = 0; r < 16; ++r) if (j0 + crow(r, hh) > qrel) acc[r] = -INFINITY;
    }
    { const int row = j0 + r32; LAS const unsigned char* kr = kv + ATT_K0 + row * 128; const int sw = (row >> 1) & 7;
#pragma unroll
      for (int s = 0; s < 4; ++s) { const bf16x8 kf = *(LAS const bf16x8*)(kr + (((2 * s + hh) ^ sw) << 4)); acc = __builtin_amdgcn_mfma_f32_32x32x16_bf16(kf, qf[s], acc, 0, 0, 0); } }
    float ls = 0.f;
#pragma unroll
    for (int r = 0; r < 16; ++r) { acc[r] = __builtin_amdgcn_exp2f(acc[r]); ls += acc[r]; }
    l += ls;
    bf16x8 pa[2];
#pragma unroll
    for (int s = 0; s < 2; ++s) { v4u w; w.x = cvtpk(acc[8 * s + 0], acc[8 * s + 1]); w.y = cvtpk(acc[8 * s + 2], acc[8 * s + 3]); w.z = cvtpk(acc[8 * s + 4], acc[8 * s + 5]); w.w = cvtpk(acc[8 * s + 6], acc[8 * s + 7]); pa[s] = __builtin_bit_cast(bf16x8, w); }
    { const int i = lane & 15, c = (lane >> 4) & 1;
#pragma unroll
      for (int db = 0; db < 2; ++db)
#pragma unroll
          for (int s = 0; s < 2; ++s) { const int rowv = j0 + 16 * s + 4 * hh + (i >> 2); const int colb = (32 * db + 16 * c + 4 * (i & 3)) * 2;
              LAS const unsigned char* vp = kv + ATT_V0 + rowv * 128 + (colb ^ (((rowv >> 1) & 1) << 6));
              const s16x4 lo = vtr(vp), hi = vtr(vp + 8 * 128);
              const bf16x8 vf = (bf16x8){lo[0], lo[1], lo[2], lo[3], hi[0], hi[1], hi[2], hi[3]};
              o[db] = __builtin_amdgcn_mfma_f32_32x32x16_bf16(pa[s], vf, o[db], 0, 0, 0); } }
}
__device__ __forceinline__ float rfl(float x) { return __builtin_bit_cast(float, __builtin_amdgcn_readfirstlane(__builtin_bit_cast(int, x))); }

__device__ __forceinline__ void fox_unit(int bh, int qb, const bf16* PROJ, const float* FOXCUM, bf16* Y, float B2, LAS unsigned char* lds, int tid, int wave, int lane) {
    const int b = bh / 6, h = bh % 6; const size_t rb = (size_t)b * SEQ; const int r32 = lane & 31, hh = lane >> 5;
    const int q0w = qb * 256 + wave * 32, qpos = q0w + r32;
    const float* cum = FOXCUM + (size_t)bh * SEQ;
    bf16x8 qf[4];
#pragma unroll
    for (int s = 0; s < 4; ++s) qf[s] = *(const bf16x8*)(PROJ + (rb + qpos) * PLD + C_FQ + h * 64 + 16 * s + 8 * hh);
    GroupRegs GA, GB;
    group_issue(GA, PROJ + (rb + (size_t)qb * 256) * PLD + C_FK + h * 64, PROJ + (rb + (size_t)qb * 256) * PLD + C_FV + h * 64, tid);
    const float ca = (tid < 256) ? -cum[qb * 256 + tid] : 0.f;
    const float cq = cum[qpos];
    const float cq_first = rfl(cum[q0w]), cq_blk = rfl(cum[qb * 256]);
    const float cprev = (qb > 0) ? rfl(cum[qb * 256 - 1]) : 0.f;
    const float rowterm = cq - B2, lim = -THRESH2 - 2.f * B2;
    f32x16 o[2]; float l = 0.f;
#pragma unroll
    for (int r = 0; r < 16; ++r) { o[0][r] = 0.f; o[1][r] = 0.f; }
    LAS float* coltA = (LAS float*)(lds + ATT_TAB); LAS float* coltB = coltA + 256;
    LAS unsigned char* kvA = lds; LAS unsigned char* kvB = lds + 65536;
#ifndef FOX_2G
#define FOX_2G 1
#endif
    const bool haveB = FOX_2G && (qb > 0) && !(cq_blk - cprev < lim);
    float cb = 0.f;
    if (haveB) { group_issue(GB, PROJ + (rb + (size_t)(qb - 1) * 256) * PLD + C_FK + h * 64, PROJ + (rb + (size_t)(qb - 1) * 256) * PLD + C_FV + h * 64, tid);
        cb = (tid < 256) ? -cum[(qb - 1) * 256 + tid] : 0.f; }
    group_commit(GA, kvA, tid); if (tid < 256) coltA[tid] = ca;
    if (haveB) { group_commit(GB, kvB, tid); if (tid < 256) coltB[tid] = cb; }
    __syncthreads();
#ifndef REP_FLOAD
#define REP_FLOAD 0
#endif
#pragma unroll 1
    for (int rp = 0; rp < REP_FLOAD; ++rp) {
        group_issue(GA, PROJ + (rb + (size_t)qb * 256) * PLD + C_FK + h * 64, PROJ + (rb + (size_t)qb * 256) * PLD + C_FV + h * 64, tid);
        if (haveB) group_issue(GB, PROJ + (rb + (size_t)(qb - 1) * 256) * PLD + C_FK + h * 64, PROJ + (rb + (size_t)(qb - 1) * 256) * PLD + C_FV + h * 64, tid);
        group_commit(GA, kvA, tid); if (haveB) group_commit(GB, kvB, tid);
        __syncthreads(); }
#ifndef REP_FSUB
#define REP_FSUB 0
#endif
#pragma unroll 1
    for (int rp = 0; rp <= REP_FSUB; ++rp) {
    if (rp) { l = 0.f;
#pragma unroll
        for (int r = 0; r < 16; ++r) { o[0][r] = 0.f; o[1][r] = 0.f; } }
#pragma unroll 1
    for (int st = wave; st >= 0; --st) {
        const int j0 = 32 * st;
        if (cq_first + rfl(coltA[j0 + 31]) < lim) break;
        attn_subtile<true>(kvA, coltA, j0, qf, rowterm, 0.f, st == wave, wave * 32 + r32, o, l, lane);
    }
    if (haveB) {
#pragma unroll 1
        for (int st = 7; st >= 0; --st) {
            const int j0 = 32 * st;
            if (cq_first + rfl(coltB[j0 + 31]) < lim) break;
            attn_subtile<true>(kvB, coltB, j0, qf, rowterm, 0.f, false, 0, o, l, lane);
        }
    }
    }
    __syncthreads();
    {
        for (int g = haveB ? qb - 2 : qb - 1; g >= 0; --g) {
            if (cq_blk - rfl(cum[g * 256 + 255]) < lim) break;
            load_group(PROJ + (rb + (size_t)g * 256) * PLD + C_FK + h * 64, PROJ + (rb + (size_t)g * 256) * PLD + C_FV + h * 64, kvA, tid);
            if (tid < 256) coltA[tid] = -cum[g * 256 + tid];
            __syncthreads();
            {
#pragma unroll 1
                for (int st = 7; st >= 0; --st) {
                    const int j0 = 32 * st;
                    if (cq_first + rfl(coltA[j0 + 31]) < lim) break;
                    attn_subtile<true>(kvA, coltA, j0, qf, rowterm, 0.f, false, 0, o, l, lane);
                }
            }
            __syncthreads();
        }
    }
    l = half_sum(l, lane);
    bf16* yp = Y + (rb + (size_t)q0w) * 1024 + Y_FOX + h * 64 + r32;
#ifndef REP_FOUT
#define REP_FOUT 0
#endif
#pragma unroll 1
    for (int rp = 0; rp <= REP_FOUT; ++rp) {
#pragma unroll
    for (int r = 0; r < 16; ++r) { const int q = crow(r, hh); const float rl = 1.f / shf(l, q);
        yp[(size_t)q * 1024] = (bf16)f2bf(o[0][r] * rl); yp[(size_t)q * 1024 + 32] = (bf16)f2bf(o[1][r] * rl); }
    }
}

__device__ __forceinline__ void fox_unit_old(int bh, int qb, const bf16* PROJ, const float* FOXCUM, bf16* Y, float B2, LAS unsigned char* lds, int tid, int wave, int lane) {
    const int b = bh / 6, h = bh % 6; const size_t rb = (size_t)b * SEQ; const int r32 = lane & 31, hh = lane >> 5;
    const int q0w = qb * 256 + wave * 32, qpos = q0w + r32;
    const float* cum = FOXCUM + (size_t)bh * SEQ;
    bf16x8 qf[4];
#pragma unroll
    for (int s = 0; s < 4; ++s) qf[s] = *(const bf16x8*)(PROJ + (rb + qpos) * PLD + C_FQ + h * 64 + 16 * s + 8 * hh);
    const float cq = cum[qpos];
    const float cq_first = rfl(cum[q0w]);
    const float cq_blk = rfl(cum[qb * 256]);
    const float rowterm = cq - B2;
    f32x16 o[2]; float l = 0.f;
#pragma unroll
    for (int r = 0; r < 16; ++r) { o[0][r] = 0.f; o[1][r] = 0.f; }
    LAS float* colt = (LAS float*)(lds + ATT_TAB);
    for (int g = qb; g >= 0; --g) {
        if (g < qb) { const float cl = rfl(cum[g * 256 + 255]); if (2.f * B2 + cq_blk - cl < -THRESH2) break; }
        load_group(PROJ + (rb + (size_t)g * 256) * PLD + C_FK + h * 64, PROJ + (rb + (size_t)g * 256) * PLD + C_FV + h * 64, lds, tid);
        if (tid < 256) colt[tid] = -cum[g * 256 + tid];
        __syncthreads();
        const int stmax = (g == qb) ? wave : 7;
        for (int st = stmax; st >= 0; --st) {
            const int j0 = 32 * st;
            { const float cl = rfl(colt[j0 + 31]); if (2.f * B2 + cq_first + cl < -THRESH2) break; }
            attn_subtile<true>(lds, colt, j0, qf, rowterm, 0.f, (g == qb) && (st == wave), wave * 32 + r32, o, l, lane);
        }
        __syncthreads();
    }
    l = half_sum(l, lane);
    bf16* yp = Y + (rb + (size_t)q0w) * 1024 + Y_FOX + h * 64 + r32;
#pragma unroll
    for (int r = 0; r < 16; ++r) { const int q = crow(r, hh); const float rl = 1.f / shf(l, q);
        yp[(size_t)q * 1024] = (bf16)f2bf(o[0][r] * rl); yp[(size_t)q * 1024 + 32] = (bf16)f2bf(o[1][r] * rl); }
}

__device__ __forceinline__ size_t moba_list_off(int bh, int n) { return (size_t)bh * 516096 + 256 * (size_t)(63 * n - (n * (n - 1)) / 2); }
__device__ __forceinline__ void moba_store(const f32x16 (&o)[2], float l, int qpos, int slot, bool valid, size_t rb, int h, bf16* OPART, float* LPART, bf16* Y, int lane) {
    const int r32 = lane & 31, hh = lane >> 5;
#pragma unroll
    for (int r = 0; r < 16; ++r) { const int src = crow(r, hh);
        const int qp = shfi(qpos, src), sl = shfi(slot, src); const int ok = shfi((int)valid, src);
        if (ok) { bf16* op = (sl == 3) ? (Y + (rb + qp) * 1024 + Y_MOBA + h * 64) : (OPART + ((size_t)sl * MROWS + rb + qp) * 384 + h * 64);
            op[r32] = (bf16)f2bf(o[0][r]); op[32 + r32] = (bf16)f2bf(o[1][r]); } }
    if (valid && hh == 0) LPART[((size_t)slot * MROWS + rb + qpos) * 6 + h] = l;
}
__device__ __forceinline__ void moba_sel_unit(int bh, int n, int chunk, int cnt, const bf16* PROJ, const unsigned short* LIST, const unsigned* CTAB, bf16* OPART, float* LPART, bf16* Y, float B2,
                                              LAS unsigned char* lds, int tid, int wave, int lane) {
    const int b = bh / 6, h = bh % 6; const size_t rb = (size_t)b * SEQ; const int r32 = lane & 31, hh = lane >> 5;
    const float slope2 = exp2f(-8.f * (float)(h + 1) / 6.f) * LOG2E;
    GroupRegs GR; group_issue(GR, PROJ + (rb + (size_t)n * 256) * PLD + C_BK + h * 64, PROJ + (rb + (size_t)n * 256) * PLD + C_BV + h * 64, tid);
    const int nvalid = cnt - chunk * 256 < 256 ? cnt - chunk * 256 : 256;
    const bool active = wave * 32 < nvalid;
    bool valid = true; int qpos = 0, slot = 0; bf16x8 qf[4];
    if (active) {
        int li = wave * 32 + r32; if (li >= nvalid) { li = nvalid - 1; valid = false; }
        const int p = chunk * 256 + li;
        const int cv = (lane > n) ? (int)CTAB[((size_t)bh * 64 + lane) * 64 + n] : 0; int inc = cv;
#pragma unroll
        for (int o2 = 1; o2 < 64; o2 <<= 1) { const int t2 = supi(inc, o2, lane); if (lane >= o2) inc += t2; }
        int qseg = 0;
#pragma unroll
        for (int stp = 32; stp >= 1; stp >>= 1) { const int v = shfi(inc, qseg + stp - 1); if (v <= p) qseg += stp; }
        const int idx = p - (shfi(inc, qseg) - shfi(cv, qseg));
        const unsigned e = LIST[moba_list_off(bh, n) + (size_t)(qseg - n - 1) * 256 + idx]; qpos = e & 0x3fff; slot = e >> 14;
#pragma unroll
        for (int s = 0; s < 4; ++s) qf[s] = *(const bf16x8*)(PROJ + (rb + qpos) * PLD + C_BQ + h * 64 + 16 * s + 8 * hh);
    }
    group_commit(GR, lds, tid);
    __syncthreads();
    if (active) {
        const int qrel = qpos - n * 256;
        const float rowterm = -slope2 * (float)qrel - B2;
        f32x16 o[2]; float l = 0.f;
#pragma unroll
        for (int r = 0; r < 16; ++r) { o[0][r] = 0.f; o[1][r] = 0.f; }
#ifndef REP_SUB
#define REP_SUB 0
#endif
#pragma unroll 1
        for (int rp = 0; rp <= REP_SUB; ++rp) {
        if (rp) { l = 0.f;
#pragma unroll
            for (int r = 0; r < 16; ++r) { o[0][r] = 0.f; o[1][r] = 0.f; } }
#pragma unroll 1
        for (int st = 0; st < 8; ++st) attn_subtile<false>(lds, nullptr, 32 * st, qf, rowterm, slope2, false, 0, o, l, lane);
        }
        l = half_sum(l, lane);
        moba_store(o, l, qpos, slot, valid, rb, h, OPART, LPART, Y, lane);
    }
    __syncthreads();
}
__device__ __forceinline__ void moba_own_pair(int bh, int nA, int nB, const bf16* PROJ, bf16* OPART, float* LPART, bf16* Y, float B2, LAS unsigned char* lds, int tid, int wave, int lane) {
    const int b = bh / 6, h = bh % 6; const size_t rb = (size_t)b * SEQ; const int r32 = lane & 31, hh = lane >> 5;
    const float slope2 = exp2f(-8.f * (float)(h + 1) / 6.f) * LOG2E;
    GroupRegs GA, GB;
    group_issue(GA, PROJ + (rb + (size_t)nA * 256) * PLD + C_BK + h * 64, PROJ + (rb + (size_t)nA * 256) * PLD + C_BV + h * 64, tid);
    group_issue(GB, PROJ + (rb + (size_t)nB * 256) * PLD + C_BK + h * 64, PROJ + (rb + (size_t)nB * 256) * PLD + C_BV + h * 64, tid);
    bf16x8 qfA[4], qfB[4];
    { const size_t qa = rb + (size_t)nA * 256 + wave * 32 + r32, qb2 = rb + (size_t)nB * 256 + (7 - wave) * 32 + r32;
#pragma unroll
      for (int s = 0; s < 4; ++s) { qfA[s] = *(const bf16x8*)(PROJ + qa * PLD + C_BQ + h * 64 + 16 * s + 8 * hh); qfB[s] = *(const bf16x8*)(PROJ + qb2 * PLD + C_BQ + h * 64 + 16 * s + 8 * hh); } }
    group_commit(GA, lds, tid); group_commit(GB, lds + 65536, tid);
    __syncthreads();
    { const int tile = wave, qrel = tile * 32 + r32, qpos = nA * 256 + qrel;
      const float rowterm = -slope2 * (float)qrel - B2;
      f32x16 o[2]; float l = 0.f;
#pragma unroll
      for (int r = 0; r < 16; ++r) { o[0][r] = 0.f; o[1][r] = 0.f; }
#pragma unroll 1
      for (int st = 0; st <= tile; ++st) attn_subtile<false>(lds, nullptr, 32 * st, qfA, rowterm, slope2, st == tile, qrel, o, l, lane);
      l = half_sum(l, lane);
      moba_store(o, l, qpos, 3, true, rb, h, OPART, LPART, Y, lane); }
    { const int tile = 7 - wave, qrel = tile * 32 + r32, qpos = nB * 256 + qrel;
      const float rowterm = -slope2 * (float)qrel - B2;
      f32x16 o[2]; float l = 0.f;
#pragma unroll
      for (int r = 0; r < 16; ++r) { o[0][r] = 0.f; o[1][r] = 0.f; }
#pragma unroll 1
      for (int st = 0; st <= tile; ++st) attn_subtile<false>(lds + 65536, nullptr, 32 * st, qfB, rowterm, slope2, st == tile, qrel, o, l, lane);
      l = half_sum(l, lane);
      moba_store(o, l, qpos, 3, true, rb, h, OPART, LPART, Y, lane); }
    __syncthreads();
}

__device__ __forceinline__ void moba_combine(const unsigned* SEL, const bf16* OPART, const float* LPART, bf16* Y, bf16* Yo, int opitch, int ocol, int gtid, int ngt) {
    constexpr size_t NIT = (size_t)MROWS * 48;
    for (size_t base = gtid; base < NIT; base += (size_t)ngt * 4) {
        unsigned sel[4]; v4u yv[4]; float lo[4]; size_t row[4]; int hh4[4], c84[4]; bool ok[4];
#pragma unroll
        for (int j = 0; j < 4; ++j) { const size_t idx = base + (size_t)j * ngt; ok[j] = idx < NIT; const size_t ii = ok[j] ? idx : 0;
            row[j] = ii / 48; const int hc = (int)(ii % 48); hh4[j] = hc >> 3; c84[j] = (hc & 7) * 8;
            sel[j] = SEL[row[j] * 6 + hh4[j]]; yv[j] = *(const v4u*)(Y + row[j] * 1024 + Y_MOBA + hh4[j] * 64 + c84[j]); lo[j] = LPART[((size_t)3 * MROWS + row[j]) * 6 + hh4[j]]; }
        v4u pv[4][3]; float pl[4][3];
#pragma unroll
        for (int j = 0; j < 4; ++j)
#pragma unroll
            for (int k = 0; k < 3; ++k) { const bool v = ((sel[j] >> (8 * k)) & 0xff) != 255;
                pv[j][k] = v ? *(const v4u*)(OPART + ((size_t)k * MROWS + row[j]) * 384 + hh4[j] * 64 + c84[j]) : (v4u){0u, 0u, 0u, 0u};
                pl[j][k] = v ? LPART[((size_t)k * MROWS + row[j]) * 6 + hh4[j]] : 0.f; }
#pragma unroll
        for (int j = 0; j < 4; ++j) { float acc[8]; unpack8(yv[j], acc); float l = lo[j];
#pragma unroll
            for (int k = 0; k < 3; ++k) { float f[8]; unpack8(pv[j][k], f);
#pragma unroll
                for (int i = 0; i < 8; ++i) acc[i] += f[i];
                l += pl[j][k]; }
            const float rl = 1.f / l;
            v4u w; w.x = pk2(acc[0] * rl, acc[1] * rl); w.y = pk2(acc[2] * rl, acc[3] * rl); w.z = pk2(acc[4] * rl, acc[5] * rl); w.w = pk2(acc[6] * rl, acc[7] * rl);
            if (ok[j]) *(v4u*)(Yo + row[j] * opitch + ocol + hh4[j] * 64 + c84[j]) = w; }
    }
}

__device__ __forceinline__ int vsw(int row, int colb) { return row * 128 + (colb ^ (((row >> 1) & 1) << 6)); }
__device__ __forceinline__ int ksw(int row, int ch) { return row * 128 + ((ch ^ ((row >> 1) & 7)) << 4); }
__device__ __forceinline__ void mlstm_m1_mfma(int ci, const MlP& P, LAS unsigned char* lds, int wave, int lane) {
    const int b = ci >> 10, h = (ci >> 8) & 3, c = ci & 255; const size_t row0 = (size_t)b * SEQ + c * 64;
    LAS unsigned char* Ki = lds + wave * 16384; LAS unsigned char* Vi = Ki + 8192;
    float wv;
    { const size_t row = row0 + lane;
      const float fi = P.GATES[row * 16 + 6 + h] + P.ibias[h], ff = P.GATES[row * 16 + 10 + h] + P.fbias[h];
      float bc = log_sigmoid_f(ff);
#pragma unroll
      for (int o = 1; o < 64; o <<= 1) { const float n = sup(bc, o, lane); if (lane >= o) bc += n; }
      const float bend = shf(bc, 63);
      const float wl = bend - bc + fi; const float mloc = wave_max(wl);
      wv = expf(wl - mloc);
      if (lane == 0) { P.BEND[ci] = bend; P.MLOC[ci] = mloc; } }
#pragma unroll
    for (int i = 0; i < 8; ++i) { const int idx = lane + 64 * i, r = idx >> 3, ch = idx & 7;
        const v4u kk = *(const v4u*)(P.KC + (row0 + r) * 256 + h * 64 + ch * 8);
        *(LAS v4u*)(Ki + vsw(r, ch * 16)) = kk;
        float f[8]; unpack8(*(const v4u*)(P.PROJ + (row0 + r) * PLD + C_MV + h * 64 + ch * 8), f);
        const float w = shf(wv, r);
        v4u o; o.x = pk2(f[0] * w, f[1] * w); o.y = pk2(f[2] * w, f[3] * w); o.z = pk2(f[4] * w, f[5] * w); o.w = pk2(f[6] * w, f[7] * w);
        *(LAS v4u*)(Vi + vsw(r, ch * 16)) = o; }
    LDS_WAIT(); asm volatile("" ::: "memory");
    { float nu = 0.f;
#pragma unroll 8
      for (int s = 0; s < 64; ++s) { const float ws = shf(wv, s); nu += ws * bf2f(*(LAS const unsigned short*)(Ki + vsw(s, 2 * lane))); }
      P.NU[(size_t)ci * 64 + lane] = nu; }
    f32x16 D[2][2];
#pragma unroll
    for (int a = 0; a < 2; ++a)
#pragma unroll
        for (int e = 0; e < 2; ++e)
#pragma unroll
            for (int r = 0; r < 16; ++r) D[a][e][r] = 0.f;
    const int i16 = lane & 15, cc = (lane >> 4) & 1, hh = lane >> 5, r32 = lane & 31;
#pragma unroll
    for (int ks = 0; ks < 4; ++ks) { const int rowv = 16 * ks + 4 * hh + (i16 >> 2);
        bf16x8 af[2], bfr[2];
#pragma unroll
        for (int blk = 0; blk < 2; ++blk) { const int colb = (32 * blk + 16 * cc + 4 * (i16 & 3)) * 2;
            { const s16x4 lo = vtr(Vi + vsw(rowv, colb)), hi = vtr(Vi + vsw(rowv, colb) + 1024); af[blk] = (bf16x8){lo[0], lo[1], lo[2], lo[3], hi[0], hi[1], hi[2], hi[3]}; }
            { const s16x4 lo = vtr(Ki + vsw(rowv, colb)), hi = vtr(Ki + vsw(rowv, colb) + 1024); bfr[blk] = (bf16x8){lo[0], lo[1], lo[2], lo[3], hi[0], hi[1], hi[2], hi[3]}; } }
#pragma unroll
        for (int a = 0; a < 2; ++a)
#pragma unroll
            for (int e = 0; e < 2; ++e) D[a][e] = __builtin_amdgcn_mfma_f32_32x32x16_bf16(af[a], bfr[e], D[a][e], 0, 0, 0); }
    float* up = P.U + (size_t)ci * 4096;
#pragma unroll
    for (int a = 0; a < 2; ++a)
#pragma unroll
        for (int e = 0; e < 2; ++e)
#pragma unroll
            for (int r = 0; r < 16; ++r) up[(32 * a + crow(r, hh)) * 64 + 32 * e + r32] = D[a][e][r];
    LDS_WAIT(); asm volatile("" ::: "memory");
}

__device__ __forceinline__ void mlstm_m3_mfma(int it, const MlP& P, LAS unsigned char* lds, int tid, int wave, int lane) {
    const int cs = wave >> 1, tile = wave & 1, ci = it * 4 + cs;
    const int b = ci >> 10, h = (ci >> 8) & 3, c = ci & 255; const size_t row0 = (size_t)b * SEQ + c * 64;
    LAS unsigned char* Ki = lds + cs * 32768; LAS unsigned char* Vi = Ki + 8192; LAS unsigned char* Ci = Ki + 16384; LAS unsigned char* Mi = Ki + 24576;
    LAS float* tab = (LAS float*)(lds + ATT_TAB) + cs * 256;
    const float ms = P.MS[ci];
    { const int pt = tile * 64 + lane;
#pragma unroll
      for (int i = 0; i < 4; ++i) { const int idx = pt + 128 * i, r = idx >> 3, ch = idx & 7;
          *(LAS v4u*)(Ki + ksw(r, ch)) = *(const v4u*)(P.KC + (row0 + r) * 256 + h * 64 + ch * 8);
          *(LAS v4u*)(Vi + vsw(r, ch * 16)) = *(const v4u*)(P.PROJ + (row0 + r) * PLD + C_MV + h * 64 + ch * 8);
          *(LAS v4u*)(Ci + ksw(r, ch)) = *(const v4u*)(P.CS + (size_t)ci * 4096 + r * 64 + ch * 8);
          *(LAS v4u*)(Mi + r * 128 + ch * 16) = *(const v4u*)(P.PROJ + (row0 + r) * PLD + C_MO + h * 64 + ch * 8); } }
    if (tile == 0) {
        const size_t row = row0 + lane;
        const float fi = P.GATES[row * 16 + 6 + h] + P.ibias[h], ff = P.GATES[row * 16 + 10 + h] + P.fbias[h];
        float bc = log_sigmoid_f(ff);
#pragma unroll
        for (int o = 1; o < 64; o <<= 1) { const float n = sup(bc, o, lane); if (lane >= o) bc += n; }
        const float a = fi - bc; float pm = a;
#pragma unroll
        for (int o = 1; o < 64; o <<= 1) { const float n = sup(pm, o, lane); if (lane >= o) pm = fmaxf(pm, n); }
        tab[lane] = a * LOG2E; tab[64 + lane] = fmaxf(ms, pm); tab[128 + lane] = bc; tab[192 + lane] = P.NS[(size_t)ci * 64 + lane];
    }
    __syncthreads();
    const int r32 = lane & 31, hh = lane >> 5, j = 32 * tile + r32;
    bf16x8 qf[4];
#pragma unroll
    for (int s = 0; s < 4; ++s) qf[s] = *(const bf16x8*)(P.QC + (row0 + j) * 256 + h * 64 + 16 * s + 8 * hh);
    const float gj = tab[64 + j], inter = expf(ms - gj), rowterm2 = -gj * LOG2E;
    f32x16 o[2]; float l = 0.f;
#pragma unroll
    for (int r = 0; r < 16; ++r) { o[0][r] = 0.f; o[1][r] = 0.f; }
    for (int st = 0; st <= tile; ++st) {
        const int j0 = 32 * st;
        f32x16 acc;
#pragma unroll
        for (int r = 0; r < 16; ++r) acc[r] = 0.f;
#pragma unroll
        for (int s = 0; s < 4; ++s) { const bf16x8 kf = *(LAS const bf16x8*)(Ki + ksw(j0 + r32, 2 * s + hh)); acc = __builtin_amdgcn_mfma_f32_32x32x16_bf16(kf, qf[s], acc, 0, 0, 0); }
        float ls = 0.f;
#pragma unroll
        for (int g4 = 0; g4 < 4; ++g4) { const f32x4 c4 = *(LAS const f32x4*)(tab + j0 + 8 * g4 + 4 * hh);
#pragma unroll
            for (int ii = 0; ii < 4; ++ii) { const int reg = 4 * g4 + ii, key = j0 + 8 * g4 + 4 * hh + ii;
                float p = acc[reg] * __builtin_amdgcn_exp2f(rowterm2 + c4[ii]);
                if (st == tile && key > j) p = 0.f;
                acc[reg] = p; ls += p; } }
        l += ls;
        bf16x8 pa[2];
#pragma unroll
        for (int s = 0; s < 2; ++s) { v4u w; w.x = cvtpk(acc[8 * s + 0], acc[8 * s + 1]); w.y = cvtpk(acc[8 * s + 2], acc[8 * s + 3]); w.z = cvtpk(acc[8 * s + 4], acc[8 * s + 5]); w.w = cvtpk(acc[8 * s + 6], acc[8 * s + 7]); pa[s] = __builtin_bit_cast(bf16x8, w); }
        { const int i16 = lane & 15, cc = (lane >> 4) & 1;
#pragma unroll
          for (int db = 0; db < 2; ++db)
#pragma unroll
              for (int s = 0; s < 2; ++s) { const int rowv = j0 + 16 * s + 4 * hh + (i16 >> 2); const int colb = (32 * db + 16 * cc + 4 * (i16 & 3)) * 2;
                  LAS const unsigned char* vp = Vi + vsw(rowv, colb);
                  const s16x4 lo = vtr(vp), hi = vtr(vp + 1024);
                  const bf16x8 vf = (bf16x8){lo[0], lo[1], lo[2], lo[3], hi[0], hi[1], hi[2], hi[3]};
                  o[db] = __builtin_amdgcn_mfma_f32_32x32x16_bf16(pa[s], vf, o[db], 0, 0, 0); } }
    }
    float dn = 0.f;
#pragma unroll
    for (int s = 0; s < 4; ++s) { float f[8]; unpack8(__builtin_bit_cast(v4u, qf[s]), f);
        const f32x4 n0 = *(LAS const f32x4*)(tab + 192 + 16 * s + 8 * hh), n1 = *(LAS const f32x4*)(tab + 192 + 16 * s + 8 * hh + 4);
        dn += (f[0] * n0.x + f[1] * n0.y) + (f[2] * n0.z + f[3] * n0.w) + (f[4] * n1.x + f[5] * n1.y) + (f[6] * n1.z + f[7] * n1.w);
        v4u w; w.x = cvtpk(f[0] * inter, f[1] * inter); w.y = cvtpk(f[2] * inter, f[3] * inter); w.z = cvtpk(f[4] * inter, f[5] * inter); w.w = cvtpk(f[6] * inter, f[7] * inter);
        const bf16x8 qs = __builtin_bit_cast(bf16x8, w);
#pragma unroll
        for (int db = 0; db < 2; ++db) { const bf16x8 cf = *(LAS const bf16x8*)(Ci + ksw(32 * db + r32, 2 * s + hh)); o[db] = __builtin_amdgcn_mfma_f32_32x32x16_bf16(qs, cf, o[db], 0, 0, 0); } }
    dn = half_sum(dn, lane); l = half_sum(l, lane);
    const float den = inter * dn + l, mj = tab[128 + j] + gj;
    const float rd = 1.f / fmaxf(fabsf(den), expf(-mj));
    const float hg0 = P.hg[h * 64 + r32], hg1 = P.hg[h * 64 + 32 + r32];
    unsigned short mo0[16], mo1[16];
#pragma unroll
    for (int r = 0; r < 16; ++r) { LAS const unsigned short* mq = (LAS const unsigned short*)(Mi + (32 * tile + crow(r, hh)) * 128) + r32; mo0[r] = mq[0]; mo1[r] = mq[32]; }
#pragma unroll
    for (int r = 0; r < 16; ++r) { const int src = crow(r, hh); const float rdr = shf(rd, src);
        const float h0 = o[0][r] * rdr, h1 = o[1][r] * rdr; float ss = h0 * h0 + h1 * h1;
        ss += SWZ_X(ss, 1); ss += SWZ_X(ss, 2); ss += SWZ_X(ss, 4); ss += SWZ_X(ss, 8); ss += SWZ_X(ss, 16);
        const float rr = 1.f / sqrtf(ss * (1.f / 64.f) + EPS);
        LAS unsigned short* mp = (LAS unsigned short*)(Mi + (32 * tile + src) * 128) + r32;
        const float e0 = __builtin_amdgcn_exp2f(-bf2f(mo0[r]) * LOG2E), e1 = __builtin_amdgcn_exp2f(-bf2f(mo1[r]) * LOG2E);
        mp[0] = (unsigned short)f2bf(h0 * rr * hg0 * __builtin_amdgcn_rcpf(1.f + e0));
        mp[32] = (unsigned short)f2bf(h1 * rr * hg1 * __builtin_amdgcn_rcpf(1.f + e1)); }
    LDS_WAIT(); asm volatile("" ::: "memory");
#pragma unroll
    for (int i = 0; i < 4; ++i) { const int rw = (lane >> 3) + 8 * i, ch = lane & 7;
        *(v4u*)(P.Y + (row0 + 32 * tile + rw) * 1024 + Y_ML + h * 64 + ch * 8) = *(LAS const v4u*)(Mi + (32 * tile + rw) * 128 + ch * 16); }
    __syncthreads();
}

__device__ __forceinline__ void top3_ins(float g, int n, float& v0, float& v1, float& v2, int& i0, int& i1, int& i2) {
    const bool c0 = g > v0, c1 = g > v1, c2 = g > v2;
    const float nv2 = c1 ? v1 : (c2 ? g : v2); const int ni2 = c1 ? i1 : (c2 ? n : i2);
    const float nv1 = c0 ? v0 : (c1 ? g : v1); const int ni1 = c0 ? i0 : (c1 ? n : i1);
    v0 = c0 ? g : v0; i0 = c0 ? n : i0; v1 = nv1; i1 = ni1; v2 = nv2; i2 = ni2;
}
__device__ __forceinline__ void moba_gate_mfma(int u, const bf16* PROJ, const float* KMEAN, unsigned* SEL, unsigned* LCNT, unsigned* CTAB, unsigned short* LIST, float B2, float thresh2,
                                               LAS unsigned char* lds, int tid, int wave, int lane) {
    const int bh = u >> 6, qb = 63 - (u & 63), b = bh / 6, h = bh % 6; const int r32 = lane & 31, hh = lane >> 5;
    LAS unsigned char* Khi = lds; LAS unsigned char* Klo = lds + 8192; LAS unsigned* cntl = (LAS unsigned*)(lds + 16384);
    if (tid < 64) cntl[tid] = 0u;
    { const int n = tid >> 3, ch = tid & 7; float f[8];
      if (n < qb) { const float* k0 = KMEAN + ((size_t)bh * NBLK + n) * 64 + ch * 8; const float* k1 = k0 + (size_t)(12 * NBLK * 64);
          const f32x4 a0 = *(const f32x4*)k0, a1 = *(const f32x4*)(k0 + 4), b0 = *(const f32x4*)k1, b1 = *(const f32x4*)(k1 + 4);
          f[0] = a0.x + b0.x; f[1] = a0.y + b0.y; f[2] = a0.z + b0.z; f[3] = a0.w + b0.w; f[4] = a1.x + b1.x; f[5] = a1.y + b1.y; f[6] = a1.z + b1.z; f[7] = a1.w + b1.w; }
      else {
#pragma unroll
          for (int i = 0; i < 8; ++i) f[i] = 0.f; }
      unsigned hi[8]; float lo[8];
#pragma unroll
      for (int i = 0; i < 8; ++i) { hi[i] = f2bf(f[i]); lo[i] = f[i] - bf2f((unsigned short)hi[i]); }
      v4u wh; wh.x = hi[0] | (hi[1] << 16); wh.y = hi[2] | (hi[3] << 16); wh.z = hi[4] | (hi[5] << 16); wh.w = hi[6] | (hi[7] << 16);
      v4u wl; wl.x = pk2(lo[0], lo[1]); wl.y = pk2(lo[2], lo[3]); wl.z = pk2(lo[4], lo[5]); wl.w = pk2(lo[6], lo[7]);
      *(LAS v4u*)(Khi + ksw(n, ch)) = wh; *(LAS v4u*)(Klo + ksw(n, ch)) = wl; }
    const int query = wave * 32 + r32; const size_t row = (size_t)b * SEQ + qb * 256 + query;
    bf16x8 qf[4];
#pragma unroll
    for (int s = 0; s < 4; ++s) qf[s] = *(const bf16x8*)(PROJ + row * PLD + C_BQ + h * 64 + 16 * s + 8 * hh);
    __syncthreads();
    float v0 = -INFINITY, v1 = -INFINITY, v2 = -INFINITY; int i0 = 255, i1 = 255, i2 = 255;
#pragma unroll 1
    for (int st = 0; st < 2; ++st) {
        if (32 * st >= qb) break;
        f32x16 acc;
#pragma unroll
        for (int r = 0; r < 16; ++r) acc[r] = 0.f;
#pragma unroll
        for (int s = 0; s < 4; ++s) { const bf16x8 kh = *(LAS const bf16x8*)(Khi + ksw(32 * st + r32, 2 * s + hh)), kl = *(LAS const bf16x8*)(Klo + ksw(32 * st + r32, 2 * s + hh));
            acc = __builtin_amdgcn_mfma_f32_32x32x16_bf16(kh, qf[s], acc, 0, 0, 0); acc = __builtin_amdgcn_mfma_f32_32x32x16_bf16(kl, qf[s], acc, 0, 0, 0); }
#pragma unroll
        for (int r = 0; r < 16; ++r) { const int n = 32 * st + crow(r, hh); if (n < qb) top3_ins(acc[r], n, v0, v1, v2, i0, i1, i2); }
    }
    { const int pl = lane ^ 32;
      const float w0 = shf(v0, pl), w1 = shf(v1, pl), w2 = shf(v2, pl); const int j0 = shfi(i0, pl), j1 = shfi(i1, pl), j2 = shfi(i2, pl);
      if (j0 != 255) top3_ins(w0, j0, v0, v1, v2, i0, i1, i2);
      if (j1 != 255) top3_ins(w1, j1, v0, v1, v2, i0, i1, i2);
      if (j2 != 255) top3_ins(w2, j2, v0, v1, v2, i0, i1, i2); }
    if (hh == 0) {
        { const float slope2 = exp2f(-8.f * (float)(h + 1) / 6.f) * LOG2E; const float lim = (2.f * B2 + thresh2) / slope2; const int t0 = qb * 256 + query - 255;
          if (i0 != 255 && (float)(t0 - i0 * 256) > lim) i0 = 255;
          if (i1 != 255 && (float)(t0 - i1 * 256) > lim) i1 = 255;
          if (i2 != 255 && (float)(t0 - i2 * 256) > lim) i2 = 255; }
        SEL[row * 6 + h] = (unsigned)i0 | ((unsigned)i1 << 8) | ((unsigned)i2 << 16);
        if (LIST) { const unsigned t = (unsigned)(qb * 256 + query);
            if (i0 != 255) { const unsigned pos = __hip_atomic_fetch_add(cntl + i0, 1u, __ATOMIC_RELAXED, __HIP_MEMORY_SCOPE_WORKGROUP); LIST[moba_list_off(bh, i0) + (size_t)(qb - i0 - 1) * 256 + pos] = (unsigned short)(t | (0u << 14)); }
            if (i1 != 255) { const unsigned pos = __hip_atomic_fetch_add(cntl + i1, 1u, __ATOMIC_RELAXED, __HIP_MEMORY_SCOPE_WORKGROUP); LIST[moba_list_off(bh, i1) + (size_t)(qb - i1 - 1) * 256 + pos] = (unsigned short)(t | (1u << 14)); }
            if (i2 != 255) { const unsigned pos = __hip_atomic_fetch_add(cntl + i2, 1u, __ATOMIC_RELAXED, __HIP_MEMORY_SCOPE_WORKGROUP); LIST[moba_list_off(bh, i2) + (size_t)(qb - i2 - 1) * 256 + pos] = (unsigned short)(t | (2u << 14)); } }
    }
    __syncthreads();
    if (LIST && tid < 64) { const unsigned c = cntl[tid]; CTAB[((size_t)bh * 64 + qb) * 64 + tid] = c; if (c) atomicAdd(LCNT + bh * 64 + tid, c); }
    __syncthreads();
}
#ifndef FOX_MFMA
#define FOX_MFMA 1
#endif
#ifndef MOBA_MFMA
#define MOBA_MFMA 1
#endif
#ifndef REP_P0
#define REP_P0 0
#endif
#ifndef REP_NORM
#define REP_NORM 0
#endif
#ifndef REP_GIN
#define REP_GIN 0
#endif
#ifndef REP_FOX
#define REP_FOX 0
#endif
#ifndef REP_M1
#define REP_M1 0
#endif
#ifndef REP_MIXB
#define REP_MIXB 0
#endif
#ifndef REP_M3
#define REP_M3 0
#endif
#ifndef REP_GGU
#define REP_GGU 0
#endif
#ifndef REP_GATE
#define REP_GATE 0
#endif
#ifndef REP_CONV
#define REP_CONV 0
#endif
#ifndef REP_FCUM
#define REP_FCUM 0
#endif
#ifndef REP_QKN
#define REP_QKN 0
#endif
#ifndef REP_GOUT
#define REP_GOUT 0
#endif
#ifndef REP_GDN
#define REP_GDN 0
#endif
#ifndef REP_COMB
#define REP_COMB 0
#endif
#ifndef REP_BAR
#define REP_BAR 0
#endif
#ifndef REP_GATE2
#define REP_GATE2 0
#endif
#ifndef ML_MFMA
#define ML_MFMA 1
#endif
#ifndef REP_M2
#define REP_M2 0
#endif
#ifndef FOX_OLD
#define FOX_OLD 0
#endif
#if FOX_OLD
#define FOX_FN fox_unit_old
#else
#define FOX_FN fox_unit
#endif
#ifndef REP_PRE
#define REP_PRE 0
#endif
#ifndef GGU_ALIGN
#define GGU_ALIGN true
#endif
#ifndef GGU_SP2
#define GGU_SP2 true
#endif
#ifndef GIN_ALIGN
#define GIN_ALIGN true
#endif
#ifndef GIN_SP2
#define GIN_SP2 true
#endif
#ifndef N_LAUNCH_MODE
#define N_LAUNCH_MODE 1
#endif
constexpr int NPHASE = 2 + 8 * DEPTH;
struct Args { const float* in[20]; float* out; unsigned char* ws; int ph_lo, ph_hi; };
static_assert(sizeof(Args) == 20 * 8 + 8 + 8 + 8, "Args has no padding");

__global__ void __launch_bounds__(NTHREADS, 2) fwd(Args args) {
    extern __shared__ __attribute__((aligned(16))) unsigned char lds_raw[];
    LAS unsigned char* lds = (LAS unsigned char*)lds_raw;
    LAS float* ldsf = (LAS float*)lds_raw;
    volatile LAS unsigned* MISC = (volatile LAS unsigned*)(lds + MISC_OFF);
    const int G = gridDim.x; const int bx = blockIdx.x; const int vcu = (G % 8 == 0) ? (bx % 8) * (G / 8) + bx / 8 : bx;
    const int NGW = G * NWAVES;
#define PH_IDS() int tid = threadIdx.x; asm volatile("" : "+v"(tid)); const int lane = tid & 63, wave = __builtin_amdgcn_readfirstlane(tid >> 6); const int gw = vcu * NWAVES + wave; (void)lane; (void)gw; \
    unsigned char* ws = ws_k; asm volatile("" : "+s"(ws)); gu32* ctl = (gu32*)(ws + WS_CTL); (void)ctl
    unsigned char* const ws_k = args.ws;
    gu32* ctl0 = (gu32*)(ws_k + WS_CTL);
    for (int u = threadIdx.x; u < (LDS_BYTES - LDSCTL_OFF) / 4; u += NTHREADS) ((LAS unsigned*)(lds + LDSCTL_OFF))[u] = 0u;
    __syncthreads();
    XcdBarrier bar; bar.bar = (unsigned*)(ctl0 + CW_BAR); bar.x = 0; bar.st = nullptr;
    if (N_LAUNCH_MODE == 1) bar = xcd_barrier_post((unsigned*)(ctl0 + CW_BAR), MISC + 8);
    const int lo = args.ph_lo, hi = args.ph_hi;
#ifndef PHMASK
#define PHMASK 0xfff
#endif
#define PHEN(j) ((PHMASK >> (j)) & 1)
#define IN(k) ((N_LAUNCH_MODE == 1) || (lo <= (k) && (k) < hi))
#define SEAM(k) do { if (IN(k) && IN((k) + 1)) { xcd_barrier(bar); for (int rb_ = 0; rb_ < REP_BAR; ++rb_) xcd_barrier(bar); } } while (0)

#define PRM(k) (*(const float* const volatile*)(ws + WS_PTAB + 8 * (k)))
#define x_in PRM(0)
#define norm1_g PRM(4)
#define norm2_g PRM(5)
#define fox_f_bias PRM(7)
#define fox_q_g PRM(8)
#define fox_k_g PRM(9)
#define ml_conv_w PRM(10)
#define ml_conv_b PRM(11)
#define ml_i_bias PRM(12)
#define ml_f_bias PRM(13)
#define ml_h_g PRM(14)
#define moba_q_g PRM(15)
#define moba_k_g PRM(16)
#define xres ((float*)PRM(20))
#define MOD ((float*)(ws + WS_MOD))
#define XN ((bf16*)(ws + WS_XN))
#define PROJ ((bf16*)(ws + WS_PROJ))
#define HB ((bf16*)(ws + WS_H))
#define Y ((bf16*)(ws + WS_Y))
#define GATES ((float*)(ws + WS_GATES))
#define FOXCUM ((float*)(ws + WS_FOXCUM))
#define KMEAN ((float*)(ws + WS_KMEAN))
#define QC ((bf16*)(ws + WS_QC))
#define KC ((bf16*)(ws + WS_KC))
#define SEL ((unsigned*)(ws + WS_SEL))
#define mod_l (MOD + (size_t)l * 2 * 6144)
#define MK_MP() const float* const ib_ = ml_i_bias; const float* const fb_ = ml_f_bias; const float* const hg_ = ml_h_g; \
    MlP MP{PROJ, QC, KC, GATES, (float*)(ws + WS_U), (float*)(ws + WS_NU), (float*)(ws + WS_BEND), (float*)(ws + WS_MLOC), (bf16*)(ws + WS_CS), (float*)(ws + WS_NS), (float*)(ws + WS_MS), Y, ib_ + l * 4, fb_ + l * 4, hg_ + l * 256}

    for (int rep = 0; rep <= REP_P0; ++rep)
    if (PHEN(10) && IN(0)) { PH_IDS();
        const float* cvec = args.in[1]; const float* w_ada = args.in[2]; const float* b_ada = args.in[3]; const float* w_in = args.in[6];
        const float* w_out = args.in[17]; const float* w_gate_up = args.in[18]; const float* w_down = args.in[19];
        if (blockIdx.x == 0 && tid == 0) { const float** pt = (const float**)(ws + WS_PTAB);
            pt[0] = args.in[0]; pt[4] = args.in[4]; pt[5] = args.in[5]; pt[7] = args.in[7]; pt[8] = args.in[8]; pt[9] = args.in[9]; pt[10] = args.in[10]; pt[11] = args.in[11]; pt[12] = args.in[12];
            pt[13] = args.in[13]; pt[14] = args.in[14]; pt[15] = args.in[15]; pt[16] = args.in[16]; pt[20] = args.out; }
        if (vcu < 192) p0_mod_unit(vcu, cvec, w_ada, b_ada, MOD, ldsf, tid, wave, lane);
        LAS float* scr = (LAS float*)(lds + wave * 16384);
        constexpr int I_IN = 16 * (NIN / 32), I_OUT = 16 * (DM / 32), I_GU = 16 * (NGU / 32), I_DN = (DFF / 64) * (DM / 32), I_L = I_IN + I_OUT + I_GU + I_DN;
        for (int it = gw; it < DEPTH * I_L; it += NGW) {
            const int l = it / I_L; int r = it % I_L;
            if (r < I_IN) { transpose_item<1>(w_in + (size_t)l * DM * INC, DM, INC, (bf16*)(ws + WS_WIN + l * WIN_BYTES), scr, NIN / 32, r, lane); continue; } r -= I_IN;
            if (r < I_OUT) { transpose_item<0>(w_out + (size_t)l * DM * DM, DM, DM, (bf16*)(ws + WS_WOUT + l * WOUT_BYTES), scr, DM / 32, r, lane); continue; } r -= I_OUT;
            if (r < I_GU) { transpose_item<2>(w_gate_up + (size_t)l * DM * NGU, DM, NGU, (bf16*)(ws + WS_WGU + l * WGU_BYTES), scr, NGU / 32, r, lane); continue; } r -= I_GU;
            transpose_item<0>(w_down + (size_t)l * DFF * DM, DFF, DM, (bf16*)(ws + WS_WDN + l * WDN_BYTES), scr, DM / 32, r, lane);
        }
        if (REP_P0) __syncthreads();
    }
    SEAM(0);
    for (int rep = 0; rep <= REP_PRE; ++rep)
    if (PHEN(11) && IN(1)) { PH_IDS();
        const float* n1g = norm1_g; const float* n2g = norm2_g;
        pre_rows(x_in, n1g, MOD, XN, (float*)(ws + WS_SSP), gw, NGW, lane);
        pre_avec(n1g, n2g, MOD, (float*)(ws + WS_AVEC), vcu * NTHREADS + tid, G * NTHREADS);
        for (int l = 0; l < DEPTH; ++l) {
            const float* m0 = MOD + (size_t)l * 2 * 6144; const float* m1 = m0 + 6144;
            pre_bias((const bf16*)(ws + WS_WIN + l * WIN_BYTES), NIN, m0, m1, (float*)(ws + WS_BIASIN) + (size_t)l * 2 * NIN, (float*)(ws + WS_BIASIN) + (size_t)l * 2 * NIN + NIN, gw, NGW, lane);
            pre_bias((const bf16*)(ws + WS_WGU + l * WGU_BYTES), NGU, m0 + 3072, m1 + 3072, (float*)(ws + WS_BIASGU) + (size_t)l * 2 * NGU, (float*)(ws + WS_BIASGU) + (size_t)l * 2 * NGU + NGU, gw, NGW, lane);
        }
    }
    SEAM(1);

    for (int l = 0; l < DEPTH; ++l) {
        const int pb = 2 + 8 * l;
        for (int rep = 0; rep <= REP_GIN; ++rep)
        if (PHEN(0) && IN(pb + 0)) { PH_IDS();
            pg8::Gemm g{XN, (const bf16*)(ws + WS_WIN + l * WIN_BYTES), MROWS, NIN, DM}; pg8::StaticOrder S; S.init(MROWS, NIN, G, bx);
            LAS float* rt = (LAS float*)(lds + ATT_TAB); LAS float* bt = rt + 512;
            const int pm0 = rstd_tables(S, (const float*)(ws + WS_SSP), rt, (const float*)(ws + WS_BIASIN) + (size_t)l * 2 * NIN, NIN, bt, tid);
            pg8::EpiProj E{PROJ, GATES, PLD, rt, pm0, bt};
            pg8::gemm_phase<pg8::EpiProj, pg8::StaticOrder, GIN_ALIGN, GIN_SP2>(lds, g, S, E, tid);
        }
        SEAM(pb + 0);
        if (PHEN(1) && IN(pb + 1)) { PH_IDS();
            for (int u = vcu; u < 524; u += G) {
                if (u < 12) post_foxcum_unit(u, GATES, FOXCUM, fox_f_bias + l * 6, ldsf, tid, wave, lane);
                else if (u < 268) post_qknorm_unit(u - 12, PROJ, KMEAN, fox_q_g + l * 64, fox_k_g + l * 64, moba_q_g + l * 64, moba_k_g + l * 64, ldsf, tid, wave, lane);
                else { const int which = (u - 268) & 1; post_conv_unit((u - 268) >> 1, which, PROJ, which ? KC : QC, ml_conv_w + l * 4 * 512, ml_conv_b + l * 512, tid); }
            }
            for (int rep = 0; rep < REP_CONV; ++rep) for (int u = vcu; u < 256; u += G) { const int which = u & 1; post_conv_unit(u >> 1, which, PROJ, which ? KC : QC, ml_conv_w + l * 4 * 512, ml_conv_b + l * 512, tid); }
            for (int rep = 0; rep < REP_FCUM; ++rep) for (int u = vcu; u < 12; u += G) post_foxcum_unit(u, GATES, FOXCUM, fox_f_bias + l * 6, ldsf, tid, wave, lane);
        }
        SEAM(pb + 1);
        if (PHEN(2) && IN(pb + 2)) { PH_IDS(); MK_MP();
            const float B2m = 8.f * LOG2E * wave_max(fabsf(moba_q_g[l * 64 + lane])) * wave_max(fabsf(moba_k_g[l * 64 + lane])) * 1.01f;
            unsigned* LCNT = (unsigned*)(ctl + CW_LCNT + l * 768); unsigned short* LIST = MOBA_MFMA ? (unsigned short*)(ws + WS_LIST) : nullptr;
#if ML_MFMA
#ifndef GATE_MFMA
#define GATE_MFMA 1
#endif
#if GATE_MFMA
            for (int u = vcu; u < 768; u += G) moba_gate_mfma(u, PROJ, KMEAN, SEL, LCNT, (unsigned*)(ws + WS_CTAB), LIST, B2m, THRESH2, lds, tid, wave, lane);
#else
            for (int u = vcu; u < 768; u += G) moba_gate_unit(u, PROJ, KMEAN, SEL, LCNT, (unsigned*)(ws + WS_CTAB), LIST, B2m, THRESH2, ldsf, tid);
#endif
            for (int u = gw; u < 2048; u += NGW) mlstm_m1_mfma(u, MP, lds, wave, lane);
            __syncthreads();
#else
            for (int u = vcu; u < 768 + 2048; u += G) {
                if (u < 768) moba_gate_unit(u, PROJ, KMEAN, SEL, LCNT, (unsigned*)(ws + WS_CTAB), LIST, B2m, THRESH2, ldsf, tid);
                else mlstm_m1(u - 768, MP, ldsf, tid, wave, lane);
            }
#endif
            for (int rep = 0; rep < REP_GATE; ++rep) for (int u = vcu; u < 768; u += G) moba_gate_unit(u, PROJ, KMEAN, SEL, LCNT, (unsigned*)(ws + WS_CTAB), nullptr, B2m, THRESH2, ldsf, tid);
            for (int rep = 0; rep < REP_GATE2; ++rep) for (int u = vcu; u < 768; u += G) moba_gate_unit(u, PROJ, KMEAN, SEL, LCNT + 4096, (unsigned*)(ws + WS_OPART + 32 * MiB), (unsigned short*)(ws + WS_OPART), B2m, THRESH2, ldsf, tid);
            for (int rep = 0; rep < REP_M1; ++rep) for (int u = vcu; u < 2048; u += G) mlstm_m1(u, MP, ldsf, tid, wave, lane);
#if FOX_MFMA
            { const float gq = wave_max(fabsf(fox_q_g[l * 64 + lane])), gk = wave_max(fabsf(fox_k_g[l * 64 + lane])); const float B2 = 8.f * LOG2E * gq * gk * 1.01f;
              for (int rep = 0; rep <= REP_FOX; ++rep)
              for (int u = vcu; u < 768; u += G) FOX_FN(u >> 6, 63 - (u & 63), PROJ, FOXCUM, Y, B2, lds, tid, wave, lane); }
#else
            fox_naive(PROJ, FOXCUM, Y, gw, NGW, lane);
#endif
        }
        SEAM(pb + 2);
        for (int rep = 0; rep <= REP_MIXB; ++rep)
        if (PHEN(3) && IN(pb + 3)) { PH_IDS(); MK_MP();
            for (int rep = 0; rep <= REP_M2; ++rep)
            for (int u = vcu; u < 64; u += G) mlstm_m2(u, MP, tid);
#if MOBA_MFMA
            { const float gq = wave_max(fabsf(moba_q_g[l * 64 + lane])), gk = wave_max(fabsf(moba_k_g[l * 64 + lane])); const float B2 = 8.f * LOG2E * gq * gk * 1.01f;
              LAS int* pre = (LAS int*)(lds + ATT_TAB + 1024);
              const unsigned* lcnt = (const unsigned*)(ctl + CW_LCNT + l * 768);
              if (wave == 0) { int carry = 0;
                  for (int r = 0; r < 12; ++r) { const int p = r * 64 + lane; int x = (int)((lcnt[p] + 255u) >> 8);
#pragma unroll
                      for (int o = 1; o < 64; o <<= 1) { const int n = supi(x, o, lane); if (lane >= o) x += n; }
                      pre[p + 1] = carry + x; carry += shfi(x, 63); }
                  if (lane == 0) pre[0] = 0; }
              __syncthreads();
              const int S = pre[768];
              const unsigned short* LIST = (const unsigned short*)(ws + WS_LIST); bf16* OPART = (bf16*)(ws + WS_OPART); float* LPART = (float*)(ws + WS_LPART);
              #ifndef KSKIP_N
#define KSKIP_N 4
#endif
              constexpr int KSKIP = KSKIP_N; const int NU = S + 384;
              for (int i = (vcu < 64 ? KSKIP : 0); ; ++i) {
                  const int u = (i < KSKIP) ? i * (G - 64) + (vcu - 64) : KSKIP * (G - 64) + (i - KSKIP) * G + vcu;
                  if (u >= NU) break;
                  if (u < S) { int lo2 = 0, hi2 = 768; while (hi2 - lo2 > 1) { const int mid = (lo2 + hi2) >> 1; if (pre[mid] <= u) lo2 = mid; else hi2 = mid; }
                      moba_sel_unit(lo2 >> 6, lo2 & 63, u - pre[lo2], (int)lcnt[lo2], PROJ, LIST, (const unsigned*)(ws + WS_CTAB), OPART, LPART, Y, B2, lds, tid, wave, lane); }
                  else { const int p = u - S; moba_own_pair(p >> 5, p & 31, 63 - (p & 31), PROJ, OPART, LPART, Y, B2, lds, tid, wave, lane); }
              } }
#else
            moba_naive(PROJ, SEL, Y, gw, NGW, lane);
#endif
        }
        SEAM(pb + 3);
        if (PHEN(4) && IN(pb + 4)) { PH_IDS(); MK_MP();
#if ML_MFMA
            for (int rep = 0; rep <= REP_M3; ++rep)
            for (int u = vcu; u < 512; u += G) mlstm_m3_mfma(u, MP, lds, tid, wave, lane);
#else
            for (int rep = 0; rep <= REP_M3; ++rep)
            for (int u = vcu; u < 2048; u += G) mlstm_m3(u, MP, ldsf, tid, wave, lane);
#endif
#if MOBA_MFMA
            for (int rep = 0; rep < REP_COMB; ++rep) moba_combine(SEL, (const bf16*)(ws + WS_OPART), (const float*)(ws + WS_LPART), Y, (bf16*)(ws + WS_U), 384, 0, vcu * NTHREADS + tid, G * NTHREADS);
            moba_combine(SEL, (const bf16*)(ws + WS_OPART), (const float*)(ws + WS_LPART), Y, Y, 1024, Y_MOBA, vcu * NTHREADS + tid, G * NTHREADS);
#endif
        }
        SEAM(pb + 4);
        if (PHEN(5) && IN(pb + 5)) { PH_IDS();
            pg8::Gemm g{Y, (const bf16*)(ws + WS_WOUT + l * WOUT_BYTES), MROWS, DM, DM}; pg8::StaticOrder S; S.init(MROWS, DM, G, bx);
            float* const xr = xres; const float* const xcur = (l == 0) ? x_in : (const float*)xr;
            pg8::EpiRes E{xcur, xr, mod_l + 2048, 6144, SEQ, XN, (const float*)(ws + WS_AVEC) + (size_t)((l * 2 + 1) * 2) * 1024, (float*)(ws + WS_SSP)};
            pg8::gemm_phase<pg8::EpiRes, pg8::StaticOrder, true, true>(lds, g, S, E, tid);
        }
        SEAM(pb + 5);
        for (int rep = 0; rep <= REP_GGU; ++rep)
        if (PHEN(6) && IN(pb + 6)) { PH_IDS();
            pg8::Gemm g{XN, (const bf16*)(ws + WS_WGU + l * WGU_BYTES), MROWS, NGU, DM}; pg8::StaticOrder S; S.init(MROWS, NGU, G, bx);
            LAS float* rt = (LAS float*)(lds + ATT_TAB); LAS float* bt = rt + 512;
            const int pm0 = rstd_tables(S, (const float*)(ws + WS_SSP), rt, (const float*)(ws + WS_BIASGU) + (size_t)l * 2 * NGU, NGU, bt, tid);
            pg8::EpiSwiglu E{HB, DFF, rt, pm0, bt};
            pg8::gemm_phase<pg8::EpiSwiglu, pg8::StaticOrder, GGU_ALIGN, GGU_SP2>(lds, g, S, E, tid);
        }
        SEAM(pb + 6);
        if (PHEN(7) && IN(pb + 7)) { PH_IDS();
            pg8::Gemm g{HB, (const bf16*)(ws + WS_WDN + l * WDN_BYTES), MROWS, DM, DFF}; pg8::StaticOrder S; S.init(MROWS, DM, G, bx);
            float* const xr = xres;
            pg8::EpiRes E{xr, xr, mod_l + 5120, 6144, SEQ, (l + 1 < DEPTH) ? XN : (bf16*)nullptr, (const float*)(ws + WS_AVEC) + (size_t)(((l + 1) * 2 + 0) * 2) * 1024, (float*)(ws + WS_SSP)};
            pg8::gemm_phase<pg8::EpiRes, pg8::StaticOrder, true, true>(lds, g, S, E, tid);
        }
        SEAM(pb + 7);
    }
#undef IN
#undef SEAM
}

extern "C" void kernel_launch(void* const* d_in, const int* in_sizes, int n_in, void* d_out, int out_size, void* d_ws, size_t ws_size, hipStream_t stream) {
    static int grid = 0;
    if (grid == 0) {
        if (n_in != 20 || in_sizes[0] != MROWS * DM || out_size != MROWS * DM || ws_size < WS_END) {
            fprintf(stderr, "kernel_launch: unexpected shapes: n_in %d in0 %d out %d ws %zu (need >= %zu)\n", n_in, n_in > 0 ? in_sizes[0] : -1, out_size, ws_size, (size_t)WS_END); grid = -1; return; }
        int dev = 0, cus = 0, per_cu = 0;
        if (hipGetDevice(&dev) != hipSuccess || hipDeviceGetAttribute(&cus, hipDeviceAttributeMultiprocessorCount, dev) != hipSuccess) { grid = -1; return; }
        if (hipFuncSetAttribute((const void*)fwd, hipFuncAttributeMaxDynamicSharedMemorySize, LDS_BYTES) != hipSuccess) { fprintf(stderr, "kernel_launch: hipFuncSetAttribute failed\n"); grid = -1; return; }
        if (hipOccupancyMaxActiveBlocksPerMultiprocessor(&per_cu, (const void*)fwd, NTHREADS, LDS_BYTES) != hipSuccess || per_cu < 1)
            fprintf(stderr, "kernel_launch: note: occupancy query reports %d workgroups per CU\n", per_cu);
        (void)hipGetLastError();
        grid = cus;
    }
    if (grid < 0) return;
    if (hipMemsetAsync((char*)d_ws + WS_CTL, 0, CTL_ZERO_BYTES, stream) != hipSuccess) return;
    Args a{};
    for (int i = 0; i < 20; ++i) a.in[i] = (const float*)d_in[i];
    a.out = (float*)d_out; a.ws = (unsigned char*)d_ws;
    if (N_LAUNCH_MODE == 1) { a.ph_lo = 0; a.ph_hi = NPHASE; hipLaunchKernelGGL(fwd, dim3(grid), dim3(NTHREADS), LDS_BYTES, stream, a); }
    else for (int p = 0; p < NPHASE; ++p) { a.ph_lo = p; a.ph_hi = p + 1; hipLaunchKernelGGL(fwd, dim3(grid), dim3(NTHREADS), LDS_BYTES, stream, a); }
}
```

```cpp
#include <hip/hip_runtime.h>
#include <cstdio>
#include <cstdint>

constexpr int DM = 1024, NBATCH = 2, SEQ = 16384, MROWS = NBATCH * SEQ, DEPTH = 2;
constexpr int HD = 64, FOXH = 6, MLH = 4, MOBH = 6;
constexpr int DFF = 2816, INC = 3342, NIN = 3584, PLD = 3328;
constexpr int NGU = 2 * DFF;
constexpr int C_FQ = 0, C_FK = 384, C_FV = 768, C_BQ = 1152, C_BK = 1536, C_BV = 1920, C_MQ = 2304, C_MK = 2560, C_MV = 2816, C_MO = 3072, C_G = 3328;
constexpr int Y_FOX = 0, Y_ML = 384, Y_MOBA = 640;
constexpr int MOBA_BS = 256, NBLK = SEQ / MOBA_BS;
constexpr int MLC = 64, NCHUNK = SEQ / MLC;
constexpr float LOG2E = 1.4426950408889634f;
constexpr float QSCALE = 0.125f * LOG2E;
constexpr float EPS = 1e-6f;

#define GAS __attribute__((address_space(1)))
#define LAS __attribute__((address_space(3)))
typedef unsigned short bf16;
typedef unsigned v4u __attribute__((ext_vector_type(4)));
typedef unsigned v2u __attribute__((ext_vector_type(2)));
typedef float f32x4 __attribute__((ext_vector_type(4)));
typedef short bf16x8 __attribute__((ext_vector_type(8)));
typedef float f32x16 __attribute__((ext_vector_type(16)));
typedef GAS unsigned gu32;
#define RLX_AGENT __ATOMIC_RELAXED, __HIP_MEMORY_SCOPE_AGENT
__device__ __forceinline__ unsigned f2bf(float f) { unsigned u = __builtin_bit_cast(unsigned, f); return (u + 0x7fffu + ((u >> 16) & 1u)) >> 16; }
__device__ __forceinline__ unsigned pk2(float lo, float hi) { return f2bf(lo) | (f2bf(hi) << 16); }
__device__ __forceinline__ float bf2f(unsigned short u) { return __builtin_bit_cast(float, (unsigned)u << 16); }
__device__ __forceinline__ float bflo(unsigned w) { return __builtin_bit_cast(float, w << 16); }
__device__ __forceinline__ float bfhi(unsigned w) { return __builtin_bit_cast(float, w & 0xffff0000u); }
#ifndef OLD_SHFL
#define OLD_SHFL 0
#endif
#ifndef OLD_SWZ
#define OLD_SWZ OLD_SHFL
#endif
#ifndef OLD_HALF
#define OLD_HALF OLD_SHFL
#endif
#ifndef OLD_SHF
#define OLD_SHF OLD_SHFL
#endif
#ifndef OLD_SUP
#define OLD_SUP OLD_SHFL
#endif
#if OLD_SWZ
#define SWZ_X(v, o) __shfl_xor((float)(v), (o))
#else
#define SWZ_X(v, o) __builtin_bit_cast(float, __builtin_amdgcn_ds_swizzle(__builtin_bit_cast(int, (float)(v)), ((o) << 10) | 0x1f))
#endif
__device__ __forceinline__ float half_sum(float v, int lane) { return v + __builtin_bit_cast(float, __builtin_amdgcn_ds_bpermute((lane ^ 32) << 2, __builtin_bit_cast(int, v))); }
#if OLD_SHF
__device__ __forceinline__ float shf(float v, int src) { return __shfl(v, src); }
__device__ __forceinline__ int shfi(int v, int src) { return __shfl(v, src); }
#else
__device__ __forceinline__ float shf(float v, int src) { return __builtin_bit_cast(float, __builtin_amdgcn_ds_bpermute(src << 2, __builtin_bit_cast(int, v))); }
__device__ __forceinline__ int shfi(int v, int src) { return __builtin_amdgcn_ds_bpermute(src << 2, v); }
#endif
#if OLD_SUP
__device__ __forceinline__ float sup(float v, int o, int lane) { return __shfl_up(v, o); }
__device__ __forceinline__ int supi(int v, int o, int lane) { return __shfl_up(v, o); }
#else
__device__ __forceinline__ float sup(float v, int o, int lane) { return shf(v, lane >= o ? lane - o : lane); }
__device__ __forceinline__ int supi(int v, int o, int lane) { return shfi(v, lane >= o ? lane - o : lane); }
#endif
__device__ __forceinline__ float wave_sum(float v) { v += SWZ_X(v, 1); v += SWZ_X(v, 2); v += SWZ_X(v, 4); v += SWZ_X(v, 8); v += SWZ_X(v, 16);
    return __builtin_bit_cast(float, __builtin_amdgcn_readlane(__builtin_bit_cast(int, v), 0)) + __builtin_bit_cast(float, __builtin_amdgcn_readlane(__builtin_bit_cast(int, v), 32)); }
__device__ __forceinline__ float wave_max(float v) { v = fmaxf(v, SWZ_X(v, 1)); v = fmaxf(v, SWZ_X(v, 2)); v = fmaxf(v, SWZ_X(v, 4)); v = fmaxf(v, SWZ_X(v, 8)); v = fmaxf(v, SWZ_X(v, 16));
    return fmaxf(__builtin_bit_cast(float, __builtin_amdgcn_readlane(__builtin_bit_cast(int, v), 0)), __builtin_bit_cast(float, __builtin_amdgcn_readlane(__builtin_bit_cast(int, v), 32))); }
__device__ __forceinline__ float log_sigmoid_f(float x) { return fminf(x, 0.f) - log1pf(expf(-fabsf(x))); }
__device__ __forceinline__ float sigmoid_f(float x) { return 1.f / (1.f + expf(-x)); }

constexpr size_t MiB = 1u << 20;
constexpr size_t WS_CTL = 0, CTL_ZERO_BYTES = 1 * MiB;
constexpr size_t WS_MOD = 1 * MiB;
constexpr size_t WS_KMEAN = WS_MOD + 128 * 1024;
constexpr size_t WS_MLS = WS_KMEAN + 512 * 1024;
constexpr size_t WS_BEND = WS_MLS, WS_MLOC = WS_MLS + 8192, WS_MS = WS_MLS + 16384, WS_NU = WS_MLS + 32768, WS_NS = WS_NU + 2048 * 64 * 4;
constexpr size_t WS_CTAB = 3 * MiB;
constexpr size_t WS_PTAB = WS_CTAB + 256 * 1024;
static_assert(WS_NS + 2048 * 64 * 4 <= WS_CTAB && WS_CTAB + 12 * 64 * 64 * 4 <= WS_PTAB && WS_PTAB + 256 <= 4 * MiB, "small region");
constexpr size_t WS_WIN = 4 * MiB, WIN_BYTES = (size_t)NIN * DM * 2;
constexpr size_t WS_WOUT = WS_WIN + 2 * WIN_BYTES, WOUT_BYTES = (size_t)DM * DM * 2;
constexpr size_t WS_WGU = WS_WOUT + 2 * WOUT_BYTES, WGU_BYTES = (size_t)NGU * DM * 2;
constexpr size_t WS_WDN = WS_WGU + 2 * WGU_BYTES, WDN_BYTES = (size_t)DM * DFF * 2;
static_assert(WS_WDN + 2 * WDN_BYTES <= 56 * MiB, "weights");
constexpr size_t WS_SSP = 56 * MiB;
constexpr size_t WS_AVEC = 58 * MiB;
constexpr size_t WS_BIASIN = WS_AVEC + 64 * 1024;
constexpr size_t WS_BIASGU = WS_BIASIN + 64 * 1024;
static_assert(WS_BIASGU + 2 * 2 * NGU * 4 <= 64 * MiB && 2 * 2 * NIN * 4 <= 64 * 1024, "fused-norm vectors");
constexpr size_t WS_XN = 64 * MiB;
constexpr size_t WS_U = 64 * MiB;
constexpr size_t WS_CS = 96 * MiB;
constexpr size_t WS_LIST = 112 * MiB;
constexpr size_t WS_PROJ = 128 * MiB;
constexpr size_t WS_H = 128 * MiB;
constexpr size_t WS_Y = 336 * MiB;
constexpr size_t WS_QC = 400 * MiB, WS_KC = 416 * MiB;
constexpr size_t WS_OPART = 432 * MiB;
constexpr size_t WS_LPART = 504 * MiB;
constexpr size_t WS_GATES = 507 * MiB;
constexpr size_t WS_FOXCUM = 509 * MiB;
constexpr size_t WS_SEL = 510 * MiB;
constexpr size_t WS_END = 512 * MiB;
static_assert(WS_PROJ + (size_t)MROWS * PLD * 2 <= WS_Y && WS_SEL + (size_t)MROWS * 6 * 4 <= WS_END, "ws map");
constexpr int CW_BAR = 4096;
constexpr int CW_QUEUE = 16384;
constexpr int CW_LCNT = 32768;

constexpr int RING_BYTES = 131072, LDSCTL_OFF = RING_BYTES, MISC_OFF = LDSCTL_OFF + 320, LDS_BYTES = 147456;
constexpr int NWAVES = 8, NTHREADS = 512;
namespace pg8 {
#define PG8_LAS __attribute__((address_space(3)))
typedef unsigned short bf16_t;
typedef short bf16x8 __attribute__((ext_vector_type(8)));
typedef float f32x4 __attribute__((ext_vector_type(4)));
typedef unsigned u32x4 __attribute__((ext_vector_type(4)));
constexpr int BM = 256, BK = 64, HALF = 128, HTB = HALF * BK * 2  , STAGE_BYTES = 8 * HTB, NXCD = 8, WGM = 8;

__host__ __device__ __forceinline__ int lds_byte(int r, int c) { const int st = (r >> 4) * 2 + (c >> 5), rr = r & 15, cc = c & 31, ob = rr * 64 + cc * 2; return st * 1024 + (ob ^ (((ob >> 9) & 1) << 5)); }
__host__ __device__ __forceinline__ void stage_rc(int b, int& R, int& C) { const int st = b / 1024, sb = b % 1024, swz = sb ^ (((sb >> 9) & 1) << 5); R = (st >> 1) * 16 + swz / 64; C = (st & 1) * 32 + (swz % 64) / 2; }
__host__ __device__ __forceinline__ int perm32(int rho) { const int n = rho >> 4, i = rho & 15; return 8 * (i >> 2) + 4 * n + (i & 3); }

struct Unit { int pm, pn, ord; };
struct Gemm { const bf16_t* A; const bf16_t* Bt; int M, N, K; };

struct StaticOrder {
    int nM, nN, nwg, G, c;
    __host__ __device__ void init(int M, int N, int G_, int c_) { nM = M / BM; nN = N / BM; nwg = nM * nN; G = G_; c = c_; }
    __host__ __device__ bool next(int i, Unit& u) const {
        const long L = (long)i * G + c; if (L >= nwg) return false;
        int wgid = (int)L; { const int q = nwg / NXCD, r = nwg % NXCD, xcd = wgid % NXCD, off = wgid / NXCD; wgid = (xcd < r ? xcd * (q + 1) : r * (q + 1) + (xcd - r) * q) + off; }
        const int nig = WGM * nN, gid = wgid / nig, fm = gid * WGM, gsz = (nM - fm) < WGM ? (nM - fm) : WGM;
        u.pm = fm + ((wgid % nig) % gsz); u.pn = (wgid % nig) / gsz; u.ord = i; return true;
    }
    __device__ __forceinline__ void a_ready(const Unit&) const {}
    __device__ __forceinline__ void done(const Unit&) const {}
};

__device__ __forceinline__ unsigned cvt_pk_bf16(float lo, float hi) { unsigned r; asm volatile("v_cvt_pk_bf16_f32 %0, %1, %2" : "=v"(r) : "v"(lo), "v"(hi)); return r; }
typedef float f32x2 __attribute__((ext_vector_type(2)));
typedef unsigned u32x2 __attribute__((ext_vector_type(2)));
struct EpiProj {
    static constexpr bool PERM = true, AFTER_DRAIN = false;
    bf16_t* P; float* G; int pld; PG8_LAS const float* rt; int pm0; PG8_LAS const float* bt;
    __device__ __forceinline__ void operator()(const f32x4 (&acc)[2][2][4][2], const Unit& u, int wr, int wc, int fr, int fq) const {
        const int row0 = u.pm * BM + wr * 64 + fr;
        PG8_LAS const float* rs = rt + (u.pm == pm0 ? 0 : 256) + wr * 64 + fr;
        PG8_LAS const float* bb = bt + u.ord * 256 + wc * 32 + 8 * fq;
        if (u.pn < 13) {
            const int col0 = u.pn * BM + wc * 32 + 8 * fq;
            f32x4 bv[2][2];
#pragma unroll
            for (int bj = 0; bj < 2; ++bj)
#pragma unroll
                for (int n = 0; n < 2; ++n) bv[bj][n] = *(PG8_LAS const f32x4*)(bb + bj * HALF + 4 * n);
            float rsv[2][4];
#pragma unroll
            for (int ai = 0; ai < 2; ++ai)
#pragma unroll
                for (int m = 0; m < 4; ++m) rsv[ai][m] = rs[ai * HALF + m * 16];
#pragma unroll
            for (int ai = 0; ai < 2; ++ai)
#pragma unroll
                for (int m = 0; m < 4; ++m) { bf16_t* rowp = P + (size_t)(row0 + ai * HALF + m * 16) * pld + col0; const float rstd = rsv[ai][m];
#pragma unroll
                    for (int bj = 0; bj < 2; ++bj) { const f32x4 v0 = acc[ai][bj][m][0] * rstd + bv[bj][0], v1 = acc[ai][bj][m][1] * rstd + bv[bj][1];
                        u32x4 w; w.x = cvt_pk_bf16(v0[0], v0[1]); w.y = cvt_pk_bf16(v0[2], v0[3]); w.z = cvt_pk_bf16(v1[0], v1[1]); w.w = cvt_pk_bf16(v1[2], v1[3]);
                        *(u32x4*)(rowp + bj * HALF) = w; } }
        } else {
            if (wc == 0 && fq < 2) {
                const f32x4 b0 = *(PG8_LAS const f32x4*)(bb), b1 = *(PG8_LAS const f32x4*)(bb + 4);
#pragma unroll
                for (int ai = 0; ai < 2; ++ai)
#pragma unroll
                    for (int m = 0; m < 4; ++m) { float* gp = G + (size_t)(row0 + ai * HALF + m * 16) * 16 + 8 * fq; const float rstd = rs[ai * HALF + m * 16];
                        *(f32x4*)(gp) = acc[ai][0][m][0] * rstd + b0; *(f32x4*)(gp + 4) = acc[ai][0][m][1] * rstd + b1; }
            }
        }
    }
};
struct EpiRes {
    static constexpr bool PERM = true, AFTER_DRAIN = false;
    const float* base; float* out; const float* gate; int gate_bstride; int rows_per_batch; bf16_t* xa; const float* avec; float* ssp;
    __device__ __forceinline__ void operator()(const f32x4 (&acc)[2][2][4][2], const Unit& u, int wr, int wc, int fr, int fq) const {
        const int row0 = u.pm * BM + wr * 64 + fr, col0 = u.pn * BM + wc * 32 + 8 * fq;
        const int bat = (u.pm * BM) / rows_per_batch;
        const float* gb = gate + (size_t)bat * gate_bstride;
        f32x4 gv[2][2], av[2][2];
#pragma unroll
        for (int bj = 0; bj < 2; ++bj)
#pragma unroll
            for (int n = 0; n < 2; ++n) { gv[bj][n] = *(const f32x4*)(gb + col0 + bj * HALF + 4 * n); av[bj][n] = xa ? *(const f32x4*)(avec + (size_t)bat * 1024 + col0 + bj * HALF + 4 * n) : (f32x4){0.f, 0.f, 0.f, 0.f}; }
        const int lane = fq * 16 + fr;
#pragma unroll
        for (int ai = 0; ai < 2; ++ai)
#pragma unroll
            for (int m = 0; m < 4; ++m) { const size_t off = (size_t)(row0 + ai * HALF + m * 16) * 1024 + col0; float ss = 0.f;
#pragma unroll
                for (int bj = 0; bj < 2; ++bj) {
                    const f32x4 o0 = *(const f32x4*)(base + off + bj * HALF) + gv[bj][0] * acc[ai][bj][m][0], o1 = *(const f32x4*)(base + off + bj * HALF + 4) + gv[bj][1] * acc[ai][bj][m][1];
                    __builtin_nontemporal_store(o0, (f32x4*)(out + off + bj * HALF)); __builtin_nontemporal_store(o1, (f32x4*)(out + off + bj * HALF + 4));
                    if (xa) { ss += ((o0[0] * o0[0] + o0[1] * o0[1]) + (o0[2] * o0[2] + o0[3] * o0[3])) + ((o1[0] * o1[0] + o1[1] * o1[1]) + (o1[2] * o1[2] + o1[3] * o1[3]));
                        const f32x4 t0 = o0 * av[bj][0], t1 = o1 * av[bj][1];
                        u32x4 w; w.x = cvt_pk_bf16(t0[0], t0[1]); w.y = cvt_pk_bf16(t0[2], t0[3]); w.z = cvt_pk_bf16(t1[0], t1[1]); w.w = cvt_pk_bf16(t1[2], t1[3]);
#ifdef XA_NT
                        __builtin_nontemporal_store(w, (u32x4*)(xa + off + bj * HALF)); } }
#else
                        *(u32x4*)(xa + off + bj * HALF) = w; } }
#endif
                if (xa) { ss += SWZ_X(ss, 16); ss += __builtin_bit_cast(float, __builtin_amdgcn_ds_bpermute((lane ^ 32) << 2, __builtin_bit_cast(int, ss)));
                    if (fq == 0) ssp[(size_t)(row0 + ai * HALF + m * 16) * 16 + u.pn * 4 + wc] = ss; } }
    }
};
struct EpiSwiglu {
    static constexpr bool PERM = true, AFTER_DRAIN = false;
    bf16_t* Hh; int ldh; PG8_LAS const float* rt; int pm0; PG8_LAS const float* bt;
    __device__ __forceinline__ void operator()(const f32x4 (&acc)[2][2][4][2], const Unit& u, int wr, int wc, int fr, int fq) const {
        const int row0 = u.pm * BM + wr * 64 + fr, col0 = u.pn * HALF + wc * 32 + 8 * fq;
        PG8_LAS const float* rs = rt + (u.pm == pm0 ? 0 : 256) + wr * 64 + fr;
        PG8_LAS const float* bb = bt + u.ord * 256 + wc * 32 + 8 * fq;
        f32x4 bv[2][2];
#pragma unroll
        for (int bj = 0; bj < 2; ++bj)
#pragma unroll
            for (int n = 0; n < 2; ++n) bv[bj][n] = *(PG8_LAS const f32x4*)(bb + bj * HALF + 4 * n);
        float rsv[2][4];
#pragma unroll
        for (int ai = 0; ai < 2; ++ai)
#pragma unroll
            for (int m = 0; m < 4; ++m) rsv[ai][m] = rs[ai * HALF + m * 16];
#pragma unroll
        for (int ai = 0; ai < 2; ++ai)
#pragma unroll
            for (int m = 0; m < 4; ++m) { bf16_t* rowp = Hh + (size_t)(row0 + ai * HALF + m * 16) * ldh + col0; const float rstd = rsv[ai][m];
                float hv[8];
#pragma unroll
                for (int n = 0; n < 2; ++n)
#pragma unroll
                    for (int i = 0; i < 4; ++i) { const float g = acc[ai][0][m][n][i] * rstd + bv[0][n][i], up = acc[ai][1][m][n][i] * rstd + bv[1][n][i];
                        const float e = __builtin_amdgcn_exp2f(-g * 1.4426950408889634f);
                        hv[n * 4 + i] = g * __builtin_amdgcn_rcpf(1.0f + e) * up; }
                u32x4 w; w.x = cvt_pk_bf16(hv[0], hv[1]); w.y = cvt_pk_bf16(hv[2], hv[3]); w.z = cvt_pk_bf16(hv[4], hv[5]); w.w = cvt_pk_bf16(hv[6], hv[7]);
                __builtin_nontemporal_store(w, (u32x4*)(rowp)); }
    }
};
template <class Epi, class Sched, bool ALIGN_EPI = false, bool SP2 = false>
__device__ __forceinline__ void gemm_phase(PG8_LAS unsigned char* lds, const Gemm g, const Sched& S, const Epi& E, const int tid_in) {
    const int tid = tid_in, wid = __builtin_amdgcn_readfirstlane(tid >> 6), lane = tid & 63, wr = wid >> 2, wc = wid & 3, fr = lane & 15, fq = lane >> 4;
    const int K = g.K, nt = K / BK;
    unsigned voffA[2], voffB[2];
#pragma unroll
    for (int i = 0; i < 2; ++i) { int R, C; stage_rc(tid * 16 + i * 8192, R, C); const int Rb = Epi::PERM ? ((R & ~31) + perm32(R & 31)) : R;
        voffA[i] = (unsigned)(R * K + C) * 2u; voffB[i] = (unsigned)(Rb * K + C) * 2u; }
    const size_t kstep = (size_t)(BK * 2);
    const size_t hstep = (size_t)HALF * K * 2;
    const size_t tstep = 2 * hstep;
    const unsigned ldsw = (unsigned)wid * 1024u;
    const int aoff = lds_byte(wr * 64 + fr, fq * 8), boff = lds_byte(wc * 32 + fr, fq * 8);
#define PG8_SA(b, h) (((b) * 2 + (h)) * HTB)
#define PG8_SB(b, h) ((4 + (b) * 2 + (h)) * HTB)
#define PG8_STAGE(bufoff, gbase, voff) do { _Pragma("unroll") for (int _i = 0; _i < 2; ++_i) \
        __builtin_amdgcn_global_load_lds((const unsigned*)((const char*)(gbase) + (voff)[_i]), (PG8_LAS unsigned*)(lds + (bufoff) + ldsw + _i * 8192), 16, 0, 0); } while (0)
#define PG8_LDA(dst, b, h) do { _Pragma("unroll") for (int m = 0; m < 4; ++m) _Pragma("unroll") for (int k = 0; k < 2; ++k) dst[m][k] = *(const PG8_LAS bf16x8*)(lds + PG8_SA(b, h) + aoff + m * 2048 + k * 1024); } while (0)
#define PG8_LDB(dst, b, h) do { _Pragma("unroll") for (int n = 0; n < 2; ++n) _Pragma("unroll") for (int k = 0; k < 2; ++k) dst[n][k] = *(const PG8_LAS bf16x8*)(lds + PG8_SB(b, h) + boff + n * 2048 + k * 1024); } while (0)
#define PG8_MMA(ai, bj, At, Bt) do { __builtin_amdgcn_s_setprio(1); _Pragma("unroll") for (int m = 0; m < 4; ++m) _Pragma("unroll") for (int n = 0; n < 2; ++n) _Pragma("unroll") for (int k = 0; k < 2; ++k) \
        acc[ai][bj][m][n] = __builtin_amdgcn_mfma_f32_16x16x32_bf16(Bt[n][k], At[m][k], acc[ai][bj][m][n], 0, 0, 0); __builtin_amdgcn_s_setprio(0); } while (0)
#define PG8_WAIT_V(n) asm volatile("s_waitcnt vmcnt(" #n ")" ::: "memory")
#define PG8_WAIT_L(n) asm volatile("s_waitcnt lgkmcnt(" #n ")" ::: "memory")
#define PG8_BAR __builtin_amdgcn_s_barrier()
#define PG8_SCHED __builtin_amdgcn_sched_barrier(0)
    Unit cur, nxt; int ui = 0;
    if (!S.next(0, cur)) return;
    f32x4 acc[2][2][4][2];
#pragma unroll
    for (int a = 0; a < 2; ++a)
#pragma unroll
        for (int b = 0; b < 2; ++b)
#pragma unroll
            for (int m = 0; m < 4; ++m)
#pragma unroll
                for (int n = 0; n < 2; ++n) acc[a][b][m][n] = (f32x4){0.f, 0.f, 0.f, 0.f};
    bf16x8 At[4][2], B0[2][2], B1[2][2];
    const char* cA = (const char*)g.A + (size_t)cur.pm * tstep; const char* cB = (const char*)g.Bt + (size_t)cur.pn * tstep;
    S.a_ready(cur);
    if constexpr (SP2) {
        PG8_STAGE(PG8_SB(0, 0), cB, voffB); PG8_STAGE(PG8_SB(0, 1), cB + hstep, voffB); PG8_STAGE(PG8_SA(0, 0), cA, voffA); PG8_STAGE(PG8_SA(0, 1), cA + hstep, voffA);
        if (wr == 1) PG8_BAR;
        PG8_WAIT_V(2); PG8_BAR;
        PG8_STAGE(PG8_SB(1, 0), cB + kstep, voffB); PG8_STAGE(PG8_SA(1, 0), cA + kstep, voffA); PG8_STAGE(PG8_SB(1, 1), cB + hstep + kstep, voffB);
        PG8_WAIT_V(6); PG8_BAR;
    } else {
        PG8_STAGE(PG8_SB(0, 0), cB, voffB); PG8_STAGE(PG8_SA(0, 0), cA, voffA); PG8_STAGE(PG8_SB(0, 1), cB + hstep, voffB); PG8_STAGE(PG8_SA(0, 1), cA + hstep, voffA);
        if (wr == 1) PG8_BAR;
        PG8_WAIT_V(4); PG8_BAR;
        PG8_STAGE(PG8_SB(1, 0), cB + kstep, voffB); PG8_STAGE(PG8_SA(1, 0), cA + kstep, voffA); PG8_STAGE(PG8_SB(1, 1), cB + hstep + kstep, voffB);
        PG8_WAIT_V(6); PG8_BAR;
    }
    for (;;) {
        const bool has_next = S.next(ui + 1, nxt);
        const char* nA = has_next ? (const char*)g.A + (size_t)nxt.pm * tstep : cA; const char* nB = has_next ? (const char*)g.Bt + (size_t)nxt.pn * tstep : cB;
        for (int t = 0; t < nt; t += 2) {
            const bool last = (t == nt - 2);
            const char* a1 = cA + (size_t)(t + 1) * kstep;
            const char* a2 = last ? nA : cA + (size_t)(t + 2) * kstep; const char* b2 = last ? nB : cB + (size_t)(t + 2) * kstep;
            const char* a3 = a2 + kstep; const char* b3 = b2 + kstep;
            if (last && has_next) S.a_ready(nxt);
            if constexpr (SP2) {
            PG8_LDB(B0, 0, 0); PG8_LDB(B1, 0, 1); PG8_SCHED; PG8_LDA(At, 0, 0); PG8_STAGE(PG8_SA(1, 1), a1 + hstep, voffA);
            PG8_WAIT_V(8); PG8_WAIT_L(0); PG8_BAR; PG8_MMA(0, 0, At, B0); PG8_MMA(0, 1, At, B1); PG8_BAR; PG8_SCHED;
            PG8_LDA(At, 0, 1); PG8_STAGE(PG8_SB(0, 0), b2, voffB); PG8_STAGE(PG8_SB(0, 1), b2 + hstep, voffB); PG8_STAGE(PG8_SA(0, 0), a2, voffA);
            PG8_WAIT_V(8); PG8_WAIT_L(0); PG8_BAR; PG8_MMA(1, 0, At, B0); PG8_MMA(1, 1, At, B1); PG8_BAR; PG8_SCHED;
            PG8_LDB(B0, 1, 0); PG8_LDB(B1, 1, 1); PG8_SCHED; PG8_LDA(At, 1, 0); PG8_STAGE(PG8_SA(0, 1), a2 + hstep, voffA);
            PG8_WAIT_V(8); PG8_WAIT_L(0); PG8_BAR; PG8_MMA(0, 0, At, B0); PG8_MMA(0, 1, At, B1); PG8_BAR; PG8_SCHED;
            PG8_LDA(At, 1, 1); PG8_STAGE(PG8_SB(1, 0), b3, voffB); PG8_STAGE(PG8_SB(1, 1), b3 + hstep, voffB); PG8_STAGE(PG8_SA(1, 0), a3, voffA);
            PG8_WAIT_V(8); PG8_WAIT_L(0); PG8_BAR; PG8_MMA(1, 0, At, B0); PG8_MMA(1, 1, At, B1); PG8_BAR; PG8_SCHED;
            } else {
            PG8_LDB(B0, 0, 0); PG8_SCHED; PG8_LDA(At, 0, 0); PG8_STAGE(PG8_SA(1, 1), a1 + hstep, voffA);
            PG8_WAIT_L(8); PG8_BAR; PG8_WAIT_L(0); PG8_MMA(0, 0, At, B0); PG8_BAR; PG8_SCHED;
            PG8_LDB(B1, 0, 1); PG8_STAGE(PG8_SB(0, 0), b2, voffB);
            PG8_BAR; PG8_WAIT_L(0); PG8_MMA(0, 1, At, B1); PG8_BAR;
            PG8_LDA(At, 0, 1); PG8_STAGE(PG8_SA(0, 0), a2, voffA);
            PG8_BAR; PG8_WAIT_L(0); PG8_MMA(1, 0, At, B0); PG8_BAR; PG8_SCHED;
            PG8_STAGE(PG8_SB(0, 1), b2 + hstep, voffB);
            PG8_WAIT_V(6); PG8_BAR; PG8_MMA(1, 1, At, B1); PG8_BAR;
            PG8_LDB(B0, 1, 0); PG8_SCHED; PG8_LDA(At, 1, 0); PG8_STAGE(PG8_SA(0, 1), a2 + hstep, voffA);
            PG8_WAIT_L(8); PG8_BAR; PG8_WAIT_L(0); PG8_MMA(0, 0, At, B0); PG8_BAR; PG8_SCHED;
            PG8_LDB(B1, 1, 1); PG8_STAGE(PG8_SB(1, 0), b3, voffB);
            PG8_BAR; PG8_WAIT_L(0); PG8_MMA(0, 1, At, B1); PG8_BAR;
            PG8_LDA(At, 1, 1); PG8_STAGE(PG8_SA(1, 0), a3, voffA);
            PG8_BAR; PG8_WAIT_L(0); PG8_MMA(1, 0, At, B0); PG8_BAR; PG8_SCHED;
            PG8_STAGE(PG8_SB(1, 1), b3 + hstep, voffB);
            PG8_WAIT_V(6); PG8_BAR; PG8_MMA(1, 1, At, B1); PG8_BAR;
            }
        }
        if constexpr (ALIGN_EPI) { if (wr == 0) PG8_BAR; }
        if constexpr (!Epi::AFTER_DRAIN) { E(acc, cur, wr, wc, fr, fq); S.done(cur); }
        if (!has_next) break;
#pragma unroll
        for (int a = 0; a < 2; ++a)
#pragma unroll
            for (int b = 0; b < 2; ++b)
#pragma unroll
                for (int m = 0; m < 4; ++m)
#pragma unroll
                    for (int n = 0; n < 2; ++n) acc[a][b][m][n] = (f32x4){0.f, 0.f, 0.f, 0.f};
        cur = nxt; cA = nA; cB = nB; ++ui;
        if constexpr (ALIGN_EPI) { if (wr == 1) PG8_BAR; }
    }
    PG8_WAIT_V(0);
    if constexpr (!ALIGN_EPI) { if (wr == 0) PG8_BAR; }
    PG8_BAR;
    if constexpr (Epi::AFTER_DRAIN) { E.fused(acc, cur, wr, wc, fr, fq, lds, wid, lane); S.done(cur); }
#undef PG8_SA
#undef PG8_SB
#undef PG8_STAGE
#undef PG8_LDA
#undef PG8_LDB
#undef PG8_MMA
#undef PG8_WAIT_V
#undef PG8_WAIT_L
#undef PG8_BAR
#undef PG8_SCHED
}
}
#define XB_TMO      128
#define XB_XCNT(j)  (256  + 64 * (j))
#define XB_XSUB(j)  (1280 + 64 * (j))
#define XB_XGEN(j)  (2304 + 64 * (j))
#define XB_TOP      3328
#define XB_TOPGEN   3392
#define XCD_BAR_WORDS 3456
#define XB_SPIN_CAP (1u << 18)

__device__ __forceinline__ unsigned xb_ld(unsigned* p)              { return __hip_atomic_load(p, __ATOMIC_RELAXED, __HIP_MEMORY_SCOPE_AGENT); }
__device__ __forceinline__ unsigned xb_add(unsigned* p, unsigned v) { return __hip_atomic_fetch_add(p, v, __ATOMIC_RELAXED, __HIP_MEMORY_SCOPE_AGENT); }
__device__ __forceinline__ unsigned xb_xcc_id() { return (unsigned)__builtin_amdgcn_s_getreg((3 << 11) | 20) & 0xFu; }
#define XB_SPIN(cond, bar) do { unsigned _sp = 0; while (cond) { __builtin_amdgcn_s_sleep(1); \
    if ((++_sp & 255u) == 0u) { if (xb_ld(&(bar)[XB_TMO])) break; if (_sp > XB_SPIN_CAP) { atomicAdd(&(bar)[XB_TMO], 1u); break; } } } } while (0)

struct XcdBarrier {
    unsigned* bar; unsigned x;
    volatile LAS unsigned* st;
};

__device__ __forceinline__ XcdBarrier xcd_barrier_post(unsigned* bar, volatile LAS unsigned* st) {
    XcdBarrier b; b.bar = bar; b.x = xb_xcc_id(); b.st = st;
    if (threadIdx.x == 0) (void)xb_add(&bar[XB_XCNT(b.x)], 1u);
    return b;
}
__device__ __forceinline__ void xcd_barrier_complete(unsigned* bar, unsigned x, unsigned& nloc, unsigned& nx) {
    const unsigned G = gridDim.x * gridDim.y * gridDim.z;
    unsigned sum, cnt, mine, sp = 0u;
    for (;;) {
        sum = 0u; cnt = 0u; mine = 0u;
#pragma unroll
        for (unsigned j = 0; j < 16; ++j) { const unsigned c = xb_ld(&bar[XB_XCNT(j)]); sum += c; cnt += (c > 0u) ? 1u : 0u; mine = (j == x) ? c : mine; }
        if (sum == G) break;
        __builtin_amdgcn_s_sleep(1);
        if ((++sp & 255u) == 0u) { if (xb_ld(&bar[XB_TMO])) break; if (sp > XB_SPIN_CAP) { atomicAdd(&bar[XB_TMO], 1u); break; } }
    }
    nloc = mine > 0u ? mine : 1u; nx = cnt > 0u ? cnt : 1u;
}

__device__ __forceinline__ void xcd_barrier(const XcdBarrier& b) {
    asm volatile("s_waitcnt vmcnt(0)" ::: "memory");
    __syncthreads();
    if (threadIdx.x == 0) {
        unsigned* bar = b.bar; asm volatile("" : "+s"(bar));
        const unsigned bx_ = xb_xcc_id();
        __builtin_amdgcn_s_waitcnt(0);
        unsigned nloc = b.st[0], nx = b.st[1];
        if (nloc == 0u) { xcd_barrier_complete(bar, bx_, nloc, nx); b.st[0] = nloc; b.st[1] = nx; }
        const unsigned old = xb_add(&bar[XB_XSUB(bx_)], 1u);
        const unsigned gen = old / nloc;
        if (old + 1u == (gen + 1u) * nloc) {
            __builtin_amdgcn_fence(__ATOMIC_RELEASE, "agent");
            asm volatile("s_waitcnt vmcnt(0)" ::: "memory");
            const unsigned og = xb_add(&bar[XB_TOP], 1u);
            const unsigned tg = og / nx;
            if (og + 1u == (tg + 1u) * nx) xb_add(&bar[XB_TOPGEN], 1u);
            else XB_SPIN(xb_ld(&bar[XB_TOPGEN]) == tg, bar);
            __builtin_amdgcn_fence(__ATOMIC_ACQUIRE, "agent");
            xb_add(&bar[XB_XGEN(bx_)], 1u);
            asm volatile("s_waitcnt vmcnt(0)" ::: "memory");
        } else {
            XB_SPIN(xb_ld(&bar[XB_XGEN(bx_)]) == gen, bar);
            __builtin_amdgcn_fence(__ATOMIC_ACQUIRE, "agent");
            asm volatile("s_waitcnt vmcnt(0)" ::: "memory");
        }
    }
    __syncthreads();
}
#define LDS_WAIT() asm volatile("s_waitcnt lgkmcnt(0)" ::: "memory")
__device__ __forceinline__ void unpack8(const v4u w, float* f) { f[0] = bflo(w.x); f[1] = bfhi(w.x); f[2] = bflo(w.y); f[3] = bfhi(w.y); f[4] = bflo(w.z); f[5] = bfhi(w.z); f[6] = bflo(w.w); f[7] = bfhi(w.w); }

__device__ __forceinline__ int win_src(int c) {
    if (c < 1152) return c;
    if (c < 2304) return c + 1038;
    if (c < 3072) return c - 1146;
    if (c < 3328) return c - 1138;
    if (c < 3334) return c - 3328 + 1152;
    if (c < 3338) return c - 3334 + 1926;
    if (c < 3342) return c - 3338 + 1930;
    return -1;
}
__device__ __forceinline__ int wgu_src(int r) { const int pn = r >> 8, w = r & 255; return (w < 128 ? 0 : DFF) + pn * 128 + (w & 127); }
template <int MODE> __device__ __forceinline__ int src_col(int r) { if (MODE == 1) return win_src(r); if (MODE == 2) return wgu_src(r); return r; }

template <int MODE> __device__ __forceinline__ void transpose_item(const float* W, int K, int ldw, bf16* WT, LAS float* scr, int nblk, int item, int lane) {
    const int kb = item / nblk, nb = item % nblk, k0 = 64 * kb, n0 = 32 * nb;
    const int sc = src_col<MODE>(n0 + (lane & 31));
#pragma unroll 8
    for (int i = 0; i < 32; ++i) { const int kk = 2 * i + (lane >> 5); scr[kk * 33 + (lane & 31)] = (sc >= 0) ? W[(size_t)(k0 + kk) * ldw + sc] : 0.f; }
    LDS_WAIT(); asm volatile("" ::: "memory");
    const int c = lane & 7;
#pragma unroll
    for (int j = 0; j < 4; ++j) { const int n = (lane >> 3) + 8 * j; const LAS float* s = scr + (8 * c) * 33 + n;
        v4u o; o.x = pk2(s[0 * 33], s[1 * 33]); o.y = pk2(s[2 * 33], s[3 * 33]); o.z = pk2(s[4 * 33], s[5 * 33]); o.w = pk2(s[6 * 33], s[7 * 33]);
        *(GAS v4u*)(WT + (size_t)(n0 + n) * K + k0 + 8 * c) = o; }
    LDS_WAIT(); asm volatile("" ::: "memory");
}

__device__ __forceinline__ void p0_mod_unit(int u, const float* cvec, const float* w_ada, const float* b_ada, float* mod, LAS float* lds, int tid, int wave, int lane) {
    LAS float* sc = lds; LAS float* red = lds + 2048;
    for (int i = tid; i < 2048; i += NTHREADS) { const float v = cvec[i]; sc[i] = v / (1.f + expf(-v)); }
    __syncthreads();
    const int l = u / 96, n = (u % 96) * 64 + lane;
    const float* wp = w_ada + ((size_t)l * 1024 + wave * 128) * 6144 + n;
    float a0 = 0.f, a1 = 0.f;
#pragma unroll 16
    for (int kk = 0; kk < 128; ++kk) { const float w = wp[(size_t)kk * 6144]; a0 += sc[wave * 128 + kk] * w; a1 += sc[1024 + wave * 128 + kk] * w; }
    red[(wave * 2 + 0) * 64 + lane] = a0; red[(wave * 2 + 1) * 64 + lane] = a1;
    __syncthreads();
    if (tid < 128) { const int b = tid >> 6; float s = 0.f;
#pragma unroll
        for (int w = 0; w < 8; ++w) s += red[(w * 2 + b) * 64 + lane];
        mod[((size_t)l * 2 + b) * 6144 + n] = s + b_ada[l * 6144 + n]; }
    __syncthreads();
}

__device__ __forceinline__ void pre_rows(const float* xsrc, const float* g, const float* mod_b0, bf16* XA, float* SSP, int gw, int NGW, int lane) {
    for (int m = gw; m < MROWS; m += NGW) {
        const int b = m / SEQ; const float* mb = mod_b0 + (size_t)b * 6144;
        const GAS f32x4* xr = (const GAS f32x4*)(xsrc + (size_t)m * DM) + lane;
        f32x4 v[4]; float ss = 0.f;
#pragma unroll
        for (int j = 0; j < 4; ++j) { v[j] = xr[64 * j]; ss += (v[j].x * v[j].x + v[j].y * v[j].y) + (v[j].z * v[j].z + v[j].w * v[j].w); }
        const float tot = wave_sum(ss);
        if (lane < 16) SSP[(size_t)m * 16 + lane] = lane == 0 ? tot : 0.f;
        GAS v2u* o8 = (GAS v2u*)(XA + (size_t)m * DM) + lane;
#pragma unroll
        for (int j = 0; j < 4; ++j) { const int col = 4 * lane + 256 * j;
            const f32x4 gg = *(const f32x4*)(g + col), sv = *(const f32x4*)(mb + 1024 + col);
            const f32x4 o = v[j] * gg * (sv + 1.0f);
            v2u w; w.x = pk2(o.x, o.y); w.y = pk2(o.z, o.w); o8[64 * j] = w; }
    }
}
__device__ __forceinline__ void pre_avec(const float* n1g, const float* n2g, const float* MODp, float* AVEC, int gtid, int ngt) {
    for (int i = gtid; i < DEPTH * 2 * 2 * 1024; i += ngt) { const int col = i & 1023, b = (i >> 10) & 1, w = (i >> 11) & 1, l = i >> 12;
        const float g = (w ? n2g : n1g)[l * 1024 + col], sc = MODp[((size_t)l * 2 + b) * 6144 + (w ? 4096 : 1024) + col];
        AVEC[i] = g * (1.f + sc); }
}
__device__ __forceinline__ void pre_bias(const bf16* WT, int nrows, const float* sh0, const float* sh1, float* bias0, float* bias1, int gw, int NGW, int lane) {
    for (int n = gw; n < nrows; n += NGW) {
        float w[16]; unpack8(*(const v4u*)(WT + (size_t)n * 1024 + lane * 16), w); unpack8(*(const v4u*)(WT + (size_t)n * 1024 + lane * 16 + 8), w + 8);
        float a0 = 0.f, a1 = 0.f;
#pragma unroll
        for (int q4 = 0; q4 < 4; ++q4) { const f32x4 s0 = *(const f32x4*)(sh0 + lane * 16 + 4 * q4), s1 = *(const f32x4*)(sh1 + lane * 16 + 4 * q4);
            a0 += (w[4 * q4] * s0.x + w[4 * q4 + 1] * s0.y) + (w[4 * q4 + 2] * s0.z + w[4 * q4 + 3] * s0.w);
            a1 += (w[4 * q4] * s1.x + w[4 * q4 + 1] * s1.y) + (w[4 * q4 + 2] * s1.z + w[4 * q4 + 3] * s1.w); }
        a0 = wave_sum(a0); a1 = wave_sum(a1);
        if (lane == 0) { bias0[n] = a0; bias1[n] = a1; }
    }
}
template <class Sched> __device__ __forceinline__ int rstd_tables(const Sched& S, const float* SSP, LAS float* rt, const float* bias, int bstride, LAS float* bt, int tid) {
    pg8::Unit u; int pm0 = -1, pm1 = -1;
    for (int i = 0; S.next(i, u); ++i) { if (pm0 < 0) pm0 = u.pm; else if (u.pm != pm0 && pm1 < 0) pm1 = u.pm;
        if (tid < 64) *(LAS f32x4*)(bt + i * 256 + tid * 4) = *(const f32x4*)(bias + (size_t)((u.pm * 256) / SEQ) * bstride + u.pn * 256 + tid * 4); }
    if (tid < 256) {
#pragma unroll
        for (int slot = 0; slot < 2; ++slot) { const int pm = slot ? pm1 : pm0;
            if (pm >= 0) { const float* sp = SSP + ((size_t)pm * 256 + tid) * 16;
                const f32x4 a = *(const f32x4*)sp, b = *(const f32x4*)(sp + 4), c = *(const f32x4*)(sp + 8), d = *(const f32x4*)(sp + 12);
                const float s = (((a.x + a.y) + (a.z + a.w)) + ((b.x + b.y) + (b.z + b.w))) + (((c.x + c.y) + (c.z + c.w)) + ((d.x + d.y) + (d.z + d.w)));
                rt[slot * 256 + tid] = 1.f / sqrtf(s * (1.f / DM) + EPS); } }
    }
    __syncthreads();
    return pm0;
}

__device__ __forceinline__ void post_foxcum_unit(int bh, const float* GATESp, float* FOXCUMp, const float* fox_f_bias, LAS float* lds, int tid, int wave, int lane) {
    const int b = bh / 6, h = bh % 6; const float bias = fox_f_bias[h];
    float v[32];
#pragma unroll
    for (int r = 0; r < 32; ++r) { const int t = wave * 2048 + r * 64 + lane; v[r] = log_sigmoid_f(GATESp[((size_t)b * SEQ + t) * 16 + h] + bias) * LOG2E; }
    float carry = 0.f;
#pragma unroll
    for (int r = 0; r < 32; ++r) { float x = v[r];
#pragma unroll
        for (int o = 1; o < 64; o <<= 1) { const float n = sup(x, o, lane); if (lane >= o) x += n; }
        x += carry; v[r] = x; carry = shf(x, 63); }
    if (lane == 0) lds[wave] = carry;
    __syncthreads();
    float off = 0.f;
    for (int w = 0; w < wave; ++w) off += lds[w];
#pragma unroll
    for (int r = 0; r < 32; ++r) FOXCUMp[(size_t)bh * SEQ + wave * 2048 + r * 64 + lane] = v[r] + off;
    __syncthreads();
}
__device__ __forceinline__ void post_qknorm_unit(int u, bf16* PROJp, float* KMEANP, const float* gfq, const float* gfk, const float* gbq, const float* gbk, LAS float* lds, int tid, int wave, int lane) {
    const int blk = u >> 1, half = u & 1, sub = lane & 7;
    int colv[3]; float gv[3][8]; float qsv[3];
#pragma unroll
    for (int it = 0; it < 3; ++it) { const int hsel = it * 8 + (lane >> 3), grp = hsel / 6, hh = hsel % 6;
        colv[it] = (grp == 0 ? C_FQ : grp == 1 ? C_FK : grp == 2 ? C_BQ : C_BK) + hh * 64 + 8 * sub;
        const float* gp = (grp == 0 ? gfq : grp == 1 ? gfk : grp == 2 ? gbq : gbk) + 8 * sub;
#pragma unroll
        for (int i = 0; i < 8; ++i) gv[it][i] = gp[i];
        qsv[it] = (grp == 0 || grp == 2) ? QSCALE : 1.f; }
    float ka[8] = {0.f, 0.f, 0.f, 0.f, 0.f, 0.f, 0.f, 0.f};
    const size_t row0 = (size_t)blk * 256 + half * 128 + wave * 16;
#pragma unroll 4
    for (int r = 0; r < 16; ++r) {
#pragma unroll
        for (int it = 0; it < 3; ++it) {
            v4u* p = (v4u*)(PROJp + (row0 + r) * PLD + colv[it]);
            float f[8]; unpack8(*p, f);
            float ss = 0.f;
#pragma unroll
            for (int i = 0; i < 8; ++i) ss += f[i] * f[i];
            ss += SWZ_X(ss, 1); ss += SWZ_X(ss, 2); ss += SWZ_X(ss, 4);
            const float rr = 1.f / sqrtf(ss * (1.f / 64.f) + EPS);
#pragma unroll
            for (int i = 0; i < 8; ++i) f[i] = f[i] * rr * gv[it][i];
            if (it == 2) {
#pragma unroll
                for (int i = 0; i < 8; ++i) ka[i] += f[i]; }
            const float qs = qsv[it];
            v4u w; w.x = pk2(f[0] * qs, f[1] * qs); w.y = pk2(f[2] * qs, f[3] * qs); w.z = pk2(f[4] * qs, f[5] * qs); w.w = pk2(f[6] * qs, f[7] * qs);
            *p = w;
        }
    }
    if (lane >= 16) {
#pragma unroll
        for (int i = 0; i < 8; ++i) lds[wave * 384 + ((lane >> 3) - 2) * 64 + 8 * sub + i] = ka[i]; }
    __syncthreads();
    if (tid < 384) { float s = 0.f;
#pragma unroll
        for (int w = 0; w < 8; ++w) s += lds[w * 384 + tid];
        const int b = blk / NBLK, n = blk % NBLK, head = tid >> 6, dd = tid & 63;
        KMEANP[(size_t)half * (12 * NBLK * 64) + (((size_t)b * 6 + head) * NBLK + n) * 64 + dd] = s * (1.f / 256.f); }
    __syncthreads();
}
__device__ __forceinline__ void post_conv_unit(int blk, int which, const bf16* PROJp, bf16* dst, const float* conv_w, const float* conv_b, int tid) {
    const bf16* src = PROJp + (which ? C_MK : C_MQ); const float osc = which ? 0.125f : 1.f;
    const int c = 8 * (tid & 31), rs = tid >> 5, ch = which * 256 + c;
    const size_t r0 = (size_t)blk * 256 + rs * 16; const int tl = (int)(r0 % SEQ);
    float w[4][8], bb[8];
#pragma unroll
    for (int i = 0; i < 4; ++i) { const f32x4 a = *(const f32x4*)(conv_w + i * 512 + ch), b2 = *(const f32x4*)(conv_w + i * 512 + ch + 4);
        w[i][0] = a.x; w[i][1] = a.y; w[i][2] = a.z; w[i][3] = a.w; w[i][4] = b2.x; w[i][5] = b2.y; w[i][6] = b2.z; w[i][7] = b2.w; }
    { const f32x4 a = *(const f32x4*)(conv_b + ch), b2 = *(const f32x4*)(conv_b + ch + 4); bb[0] = a.x; bb[1] = a.y; bb[2] = a.z; bb[3] = a.w; bb[4] = b2.x; bb[5] = b2.y; bb[6] = b2.z; bb[7] = b2.w; }
    float x0[8], x1[8], x2[8], x3[8];
    { v4u h3[3];
#pragma unroll
      for (int k = 0; k < 3; ++k) { if (tl + k - 3 >= 0) h3[k] = *(const v4u*)(src + (r0 + k - 3) * PLD + c); else h3[k] = (v4u){0u, 0u, 0u, 0u}; }
      unpack8(h3[0], x0); unpack8(h3[1], x1); unpack8(h3[2], x2); }
#pragma unroll 1
    for (int hb = 0; hb < 2; ++hb) {
        v4u in[8];
#pragma unroll
        for (int k = 0; k < 8; ++k) in[k] = *(const v4u*)(src + (r0 + hb * 8 + k) * PLD + c);
#pragma unroll
        for (int r = 0; r < 8; ++r) {
            unpack8(in[r], x3);
            float y[8];
#pragma unroll
            for (int i = 0; i < 8; ++i) { const float t = bb[i] + w[0][i] * x0[i] + w[1][i] * x1[i] + w[2][i] * x2[i] + w[3][i] * x3[i];
                y[i] = t * __builtin_amdgcn_rcpf(1.f + __builtin_amdgcn_exp2f(-t * LOG2E)) * osc; x0[i] = x1[i]; x1[i] = x2[i]; x2[i] = x3[i]; }
            v4u o; o.x = pk2(y[0], y[1]); o.y = pk2(y[2], y[3]); o.z = pk2(y[4], y[5]); o.w = pk2(y[6], y[7]);
            *(v4u*)(dst + (r0 + hb * 8 + r) * 256 + c) = o;
        }
    }
}

struct MlP { const bf16* PROJ; const bf16* QC; const bf16* KC; const float* GATES; float* U; float* NU; float* BEND; float* MLOC; bf16* CS; float* NS; float* MS; bf16* Y;
             const float *ibias, *fbias, *hg; };
__device__ __forceinline__ void mlstm_m1(int ci, const MlP& P, LAS float* lds, int tid, int wave, int lane) {
    const int b = ci >> 10, h = (ci >> 8) & 3, c = ci & 255; const size_t row0 = (size_t)b * SEQ + c * 64;
    LAS float* Ks = lds; LAS float* Vs = lds + 4096; LAS float* ws = lds + 8192;
    { const int r = tid >> 3, cg = (tid & 7) * 8; float f[8];
      unpack8(*(const v4u*)(P.KC + (row0 + r) * 256 + h * 64 + cg), f);
#pragma unroll
      for (int i = 0; i < 8; ++i) Ks[r * 64 + cg + i] = f[i];
      unpack8(*(const v4u*)(P.PROJ + (row0 + r) * PLD + C_MV + h * 64 + cg), f);
#pragma unroll
      for (int i = 0; i < 8; ++i) Vs[r * 64 + cg + i] = f[i]; }
    if (wave == 0) {
        const size_t row = row0 + lane;
        const float fi = P.GATES[row * 16 + 6 + h] + P.ibias[h], ff = P.GATES[row * 16 + 10 + h] + P.fbias[h];
        float bc = log_sigmoid_f(ff);
#pragma unroll
        for (int o = 1; o < 64; o <<= 1) { const float n = sup(bc, o, lane); if (lane >= o) bc += n; }
        const float bend = shf(bc, 63);
        const float wl = bend - bc + fi; const float mloc = wave_max(wl);
        ws[lane] = expf(wl - mloc);
        if (lane == 0) { P.BEND[ci] = bend; P.MLOC[ci] = mloc; }
    }
    __syncthreads();
    { const int dv = tid >> 3, e0 = (tid & 7) * 8; float u[8] = {0.f, 0.f, 0.f, 0.f, 0.f, 0.f, 0.f, 0.f};
#pragma unroll 2
      for (int s = 0; s < 64; ++s) { const float vw = Vs[s * 64 + dv] * ws[s]; const f32x4 ka = *(const LAS f32x4*)(Ks + s * 64 + e0), kb = *(const LAS f32x4*)(Ks + s * 64 + e0 + 4);
          u[0] += vw * ka.x; u[1] += vw * ka.y; u[2] += vw * ka.z; u[3] += vw * ka.w; u[4] += vw * kb.x; u[5] += vw * kb.y; u[6] += vw * kb.z; u[7] += vw * kb.w; }
      float* up = P.U + (size_t)ci * 4096 + dv * 64 + e0;
      *(f32x4*)up = (f32x4){u[0], u[1], u[2], u[3]}; *(f32x4*)(up + 4) = (f32x4){u[4], u[5], u[6], u[7]}; }
    if (tid < 64) { float nu = 0.f; for (int s = 0; s < 64; ++s) nu += ws[s] * Ks[s * 64 + tid]; P.NU[(size_t)ci * 64 + tid] = nu; }
    __syncthreads();
}
__device__ __forceinline__ void mlstm_m2(int u, const MlP& P, LAS float* lds, int tid, int wave, int lane) {
    const int bh = u >> 3, eg = u & 7, elem = eg * 512 + tid, base = bh * 256;
    LAS float* decl = lds; LAS float* wul = lds + 256;
    if (wave == 0) {
        const f32x4 b4 = *(const f32x4*)(P.BEND + base + 4 * lane), l4 = *(const f32x4*)(P.MLOC + base + 4 * lane);
        float B = b4.x, L = l4.x;
        B += b4.y; L = fmaxf(L + b4.y, l4.y); B += b4.z; L = fmaxf(L + b4.z, l4.z); B += b4.w; L = fmaxf(L + b4.w, l4.w);
#pragma unroll
        for (int o = 1; o < 64; o <<= 1) { const float Bp = sup(B, o, lane), Lp = sup(L, o, lane); if (lane >= o) { L = fmaxf(Lp + B, L); B = Bp + B; } }
        const float Bex = sup(B, 1, lane), Lex = sup(L, 1, lane);
        float m = (lane == 0) ? 0.f : fmaxf(Bex, Lex);
        const float bb[4] = {b4.x, b4.y, b4.z, b4.w}, ll[4] = {l4.x, l4.y, l4.z, l4.w};
#pragma unroll
        for (int j = 0; j < 4; ++j) { const int c = 4 * lane + j; if (eg == 0) P.MS[base + c] = m;
            const float mn = fmaxf(bb[j] + m, ll[j]);
            decl[c] = __builtin_amdgcn_exp2f((bb[j] + m - mn) * LOG2E); wul[c] = __builtin_amdgcn_exp2f((ll[j] - mn) * LOG2E); m = mn; }
    }
    __syncthreads();
    const bool donorm = (eg == 0 && tid < 64);
    float C = 0.f, nst = 0.f;
#pragma unroll 1
    for (int c0 = 0; c0 < 256; c0 += 16) {
        float uv[16], nv[16];
#pragma unroll
        for (int i = 0; i < 16; ++i) { const int ci = base + c0 + i; uv[i] = P.U[(size_t)ci * 4096 + elem]; nv[i] = donorm ? P.NU[(size_t)ci * 64 + tid] : 0.f; }
#pragma unroll
        for (int i = 0; i < 16; ++i) { const int ci = base + c0 + i;
            P.CS[(size_t)ci * 4096 + elem] = (bf16)f2bf(C);
            if (donorm) P.NS[(size_t)ci * 64 + tid] = nst;
            const float dec = decl[c0 + i], wu = wul[c0 + i];
            C = dec * C + wu * uv[i]; nst = dec * nst + wu * nv[i]; }
    }
    __syncthreads();
}
__device__ __forceinline__ void mlstm_m3(int ci, const MlP& P, LAS float* lds, int tid, int wave, int lane) {
    constexpr int LP = 68;
    const int b = ci >> 10, h = (ci >> 8) & 3, c = ci & 255; const size_t row0 = (size_t)b * SEQ + c * 64;
    LAS float* Qs = lds; LAS float* Ks = Qs + 64 * LP; LAS float* Cs = Ks + 64 * LP; LAS float* Sm = Cs + 64 * LP; LAS float* Vs = Sm + 64 * LP;
    LAS float* av = Vs + 4096; LAS float* gv = av + 64; LAS float* bcv = gv + 64; LAS float* nsv = bcv + 64;
    const float ms = P.MS[ci];
    { const int r = tid >> 3, cg = (tid & 7) * 8; float f[8];
      unpack8(*(const v4u*)(P.QC + (row0 + r) * 256 + h * 64 + cg), f);
#pragma unroll
      for (int i = 0; i < 8; ++i) Qs[r * LP + cg + i] = f[i];
      unpack8(*(const v4u*)(P.KC + (row0 + r) * 256 + h * 64 + cg), f);
#pragma unroll
      for (int i = 0; i < 8; ++i) Ks[r * LP + cg + i] = f[i];
      unpack8(*(const v4u*)(P.PROJ + (row0 + r) * PLD + C_MV + h * 64 + cg), f);
#pragma unroll
      for (int i = 0; i < 8; ++i) Vs[r * 64 + cg + i] = f[i];
      unpack8(*(const v4u*)(P.CS + (size_t)ci * 4096 + r * 64 + cg), f);
#pragma unroll
      for (int i = 0; i < 8; ++i) Cs[r * LP + cg + i] = f[i]; }
    if (wave == 0) {
        const size_t row = row0 + lane;
        const float fi = P.GATES[row * 16 + 6 + h] + P.ibias[h], ff = P.GATES[row * 16 + 10 + h] + P.fbias[h];
        float bc = log_sigmoid_f(ff);
#pragma unroll
        for (int o = 1; o < 64; o <<= 1) { const float n = sup(bc, o, lane); if (lane >= o) bc += n; }
        const float a = fi - bc; float pm = a;
#pragma unroll
        for (int o = 1; o < 64; o <<= 1) { const float n = sup(pm, o, lane); if (lane >= o) pm = fmaxf(pm, n); }
        av[lane] = a; gv[lane] = fmaxf(ms, pm); bcv[lane] = bc; nsv[lane] = P.NS[(size_t)ci * 64 + lane];
    }
    __syncthreads();
    const int j = tid >> 3, part = tid & 7, s0 = part * 8;
    const float gj = gv[j];
    { float sacc[8] = {0.f, 0.f, 0.f, 0.f, 0.f, 0.f, 0.f, 0.f};
#pragma unroll 1
      for (int e = 0; e < 64; e += 4) { const f32x4 q4 = *(const LAS f32x4*)(Qs + j * LP + e);
#pragma unroll
          for (int i = 0; i < 8; ++i) { const f32x4 k4 = *(const LAS f32x4*)(Ks + (s0 + i) * LP + e); sacc[i] += (q4.x * k4.x + q4.y * k4.y) + (q4.z * k4.z + q4.w * k4.w); } }
#pragma unroll
      for (int i = 0; i < 8; ++i) { const int s = s0 + i; Sm[j * LP + s] = (s <= j) ? sacc[i] * expf(av[s] - gj) : 0.f; } }
    __syncthreads();
    { const int dv0 = part * 8; float t1[8] = {0.f, 0.f, 0.f, 0.f, 0.f, 0.f, 0.f, 0.f}, t2[8] = {0.f, 0.f, 0.f, 0.f, 0.f, 0.f, 0.f, 0.f};
#pragma unroll 1
      for (int e = 0; e < 64; e += 4) { const f32x4 q4 = *(const LAS f32x4*)(Qs + j * LP + e);
#pragma unroll
          for (int i = 0; i < 8; ++i) { const f32x4 c4 = *(const LAS f32x4*)(Cs + (dv0 + i) * LP + e); t1[i] += (q4.x * c4.x + q4.y * c4.y) + (q4.z * c4.z + q4.w * c4.w); } }
#pragma unroll 2
      for (int s = 0; s < 64; ++s) { const float sm = Sm[j * LP + s]; const f32x4 va = *(const LAS f32x4*)(Vs + s * 64 + dv0), vb = *(const LAS f32x4*)(Vs + s * 64 + dv0 + 4);
          t2[0] += sm * va.x; t2[1] += sm * va.y; t2[2] += sm * va.z; t2[3] += sm * va.w; t2[4] += sm * vb.x; t2[5] += sm * vb.y; t2[6] += sm * vb.z; t2[7] += sm * vb.w; }
      float dn = 0.f, ssum = 0.f;
#pragma unroll
      for (int i = 0; i < 8; ++i) { dn += nsv[s0 + i] * Qs[j * LP + s0 + i]; ssum += Sm[j * LP + s0 + i]; }
      { dn += SWZ_X(dn, 1); ssum += SWZ_X(ssum, 1); dn += SWZ_X(dn, 2); ssum += SWZ_X(ssum, 2); dn += SWZ_X(dn, 4); ssum += SWZ_X(ssum, 4); }
      const float inter = expf(ms - gj), mj = bcv[j] + gj;
      const float den = inter * dn + ssum, dd = fmaxf(fabsf(den), expf(-mj)), rd = 1.f / dd;
      float hv[8], ss = 0.f;
#pragma unroll
      for (int i = 0; i < 8; ++i) { hv[i] = (inter * t1[i] + t2[i]) * rd; ss += hv[i] * hv[i]; }
      { ss += SWZ_X(ss, 1); ss += SWZ_X(ss, 2); ss += SWZ_X(ss, 4); }
      const float rr = 1.f / sqrtf(ss * (1.f / 64.f) + EPS);
      float mo[8]; unpack8(*(const v4u*)(P.PROJ + (row0 + j) * PLD + C_MO + h * 64 + dv0), mo);
      float y[8];
#pragma unroll
      for (int i = 0; i < 8; ++i) y[i] = hv[i] * rr * P.hg[h * 64 + dv0 + i] * sigmoid_f(mo[i]);
      v4u w; w.x = pk2(y[0], y[1]); w.y = pk2(y[2], y[3]); w.z = pk2(y[4], y[5]); w.w = pk2(y[6], y[7]);
      *(v4u*)(P.Y + (row0 + j) * 1024 + Y_ML + h * 64 + dv0) = w; }
    __syncthreads();
}

__device__ __forceinline__ size_t moba_list_off(int bh, int n);
__device__ __forceinline__ void moba_gate_unit(int u, const bf16* PROJ, const float* KMEAN, unsigned* SEL, unsigned* LCNT, unsigned* CTAB, unsigned short* LIST, float B2, float thresh2, LAS float* lds, int tid) {
    const int bh = u >> 6, qb = 63 - (u & 63), b = bh / 6, h = bh % 6;
    LAS float* km = lds; LAS float* cand = lds + 4096; LAS unsigned* cntl = (LAS unsigned*)(lds + 4096 + 1536);
    if (tid < 64) cntl[tid] = 0u;
    for (int i = tid; i < qb * 16; i += NTHREADS) *(LAS f32x4*)(km + i * 4) = *(const f32x4*)(KMEAN + (size_t)bh * NBLK * 64 + i * 4) + *(const f32x4*)(KMEAN + (size_t)(12 * NBLK * 64) + (size_t)bh * NBLK * 64 + i * 4);
    __syncthreads();
    const int query = tid & 255, half = tid >> 8; const size_t row = (size_t)b * SEQ + qb * 256 + query;
    float q[64];
#pragma unroll
    for (int i = 0; i < 8; ++i) unpack8(*(const v4u*)(PROJ + row * PLD + C_BQ + h * 64 + i * 8), q + i * 8);
    float v0 = -INFINITY, v1 = -INFINITY, v2 = -INFINITY; int i0 = 255, i1 = 255, i2 = 255;
    const int nlo = half * 32, nhi = (qb < nlo + 32) ? qb : nlo + 32;
    for (int n = nlo; n < nhi; ++n) { float g = 0.f;
#pragma unroll
        for (int d = 0; d < 64; d += 4) { const f32x4 k4 = *(const LAS f32x4*)(km + n * 64 + d); g += (q[d] * k4.x + q[d + 1] * k4.y) + (q[d + 2] * k4.z + q[d + 3] * k4.w); }
        if (g > v0) { v2 = v1; i2 = i1; v1 = v0; i1 = i0; v0 = g; i0 = n; } else if (g > v1) { v2 = v1; i2 = i1; v1 = g; i1 = n; } else if (g > v2) { v2 = g; i2 = n; } }
    if (half == 1) { cand[query * 6 + 0] = v0; cand[query * 6 + 1] = v1; cand[query * 6 + 2] = v2;
        cand[query * 6 + 3] = __int_as_float(i0); cand[query * 6 + 4] = __int_as_float(i1); cand[query * 6 + 5] = __int_as_float(i2); }
    __syncthreads();
    if (half == 0) {
#pragma unroll
        for (int k = 0; k < 3; ++k) { const float g = cand[query * 6 + k]; const int n = __float_as_int(cand[query * 6 + 3 + k]);
            if (n != 255) { if (g > v0) { v2 = v1; i2 = i1; v1 = v0; i1 = i0; v0 = g; i0 = n; } else if (g > v1) { v2 = v1; i2 = i1; v1 = g; i1 = n; } else if (g > v2) { v2 = g; i2 = n; } } }
        { const float slope2 = exp2f(-8.f * (float)(h + 1) / 6.f) * LOG2E; const float lim = (2.f * B2 + thresh2) / slope2; const int t0 = qb * 256 + query - 255;
          if (i0 != 255 && (float)(t0 - i0 * 256) > lim) i0 = 255;
          if (i1 != 255 && (float)(t0 - i1 * 256) > lim) i1 = 255;
          if (i2 != 255 && (float)(t0 - i2 * 256) > lim) i2 = 255; }
        SEL[row * 6 + h] = (unsigned)i0 | ((unsigned)i1 << 8) | ((unsigned)i2 << 16);
        if (LIST) { const unsigned t = (unsigned)(qb * 256 + query);
            if (i0 != 255) { const unsigned pos = __hip_atomic_fetch_add(cntl + i0, 1u, __ATOMIC_RELAXED, __HIP_MEMORY_SCOPE_WORKGROUP); LIST[moba_list_off(bh, i0) + (size_t)(qb - i0 - 1) * 256 + pos] = (unsigned short)(t | (0u << 14)); }
            if (i1 != 255) { const unsigned pos = __hip_atomic_fetch_add(cntl + i1, 1u, __ATOMIC_RELAXED, __HIP_MEMORY_SCOPE_WORKGROUP); LIST[moba_list_off(bh, i1) + (size_t)(qb - i1 - 1) * 256 + pos] = (unsigned short)(t | (1u << 14)); }
            if (i2 != 255) { const unsigned pos = __hip_atomic_fetch_add(cntl + i2, 1u, __ATOMIC_RELAXED, __HIP_MEMORY_SCOPE_WORKGROUP); LIST[moba_list_off(bh, i2) + (size_t)(qb - i2 - 1) * 256 + pos] = (unsigned short)(t | (2u << 14)); } }
    }
    __syncthreads();
    if (LIST && tid < 64) { const unsigned c = cntl[tid]; CTAB[((size_t)bh * 64 + qb) * 64 + tid] = c; if (c) atomicAdd(LCNT + bh * 64 + tid, c); }
    __syncthreads();
}

__device__ __forceinline__ void fox_naive(const bf16* PROJ, const float* FOXCUM, bf16* Y, int gw, int NGW, int lane) {
    for (int idx = gw; idx < 12 * SEQ; idx += NGW) {
        const int t = SEQ - 1 - idx / 12, bh = idx % 12, b = bh / 6, h = bh % 6; const size_t rb = (size_t)b * SEQ;
        const float qv = bf2f(PROJ[(rb + t) * PLD + C_FQ + h * 64 + lane]); const float ct = FOXCUM[(size_t)bh * SEQ + t];
        float m = -INFINITY, l = 0.f, acc = 0.f;
#pragma unroll 4
        for (int j = 0; j <= t; ++j) {
            const float kv = bf2f(PROJ[(rb + j) * PLD + C_FK + h * 64 + lane]), vv = bf2f(PROJ[(rb + j) * PLD + C_FV + h * 64 + lane]);
            const float s = wave_sum(qv * kv) + (ct - FOXCUM[(size_t)bh * SEQ + j]);
            const float mn = fmaxf(m, s), sc = exp2f(m - mn), p = exp2f(s - mn);
            l = l * sc + p; acc = acc * sc + p * vv; m = mn; }
        Y[(rb + t) * 1024 + Y_FOX + h * 64 + lane] = (bf16)f2bf(acc / l);
    }
}
__device__ __forceinline__ void moba_naive(const bf16* PROJ, const unsigned* SEL, bf16* Y, int gw, int NGW, int lane) {
    for (int idx = gw; idx < 12 * SEQ; idx += NGW) {
        const int t = SEQ - 1 - idx / 12, bh = idx % 12, b = bh / 6, h = bh % 6; const size_t rb = (size_t)b * SEQ;
        const float slope2 = exp2f(-8.f * (float)(h + 1) / 6.f) * LOG2E;
        const float qv = bf2f(PROJ[(rb + t) * PLD + C_BQ + h * 64 + lane]);
        const unsigned sel = SEL[(rb + t) * 6 + h];
        float m = -INFINITY, l = 0.f, acc = 0.f;
        for (int slot = 0; slot < 4; ++slot) {
            int j0, j1;
            if (slot < 3) { const int n = (sel >> (8 * slot)) & 0xff; if (n == 255) continue; j0 = n * 256; j1 = j0 + 256; } else { j0 = (t >> 8) * 256; j1 = t + 1; }
#pragma unroll 4
            for (int j = j0; j < j1; ++j) {
                const float kv = bf2f(PROJ[(rb + j) * PLD + C_BK + h * 64 + lane]), vv = bf2f(PROJ[(rb + j) * PLD + C_BV + h * 64 + lane]);
                const float s = wave_sum(qv * kv) - slope2 * (float)(t - j);
                const float mn = fmaxf(m, s), sc = exp2f(m - mn), p = exp2f(s - mn);
                l = l * sc + p; acc = acc * sc + p * vv; m = mn; }
        }
        Y[(rb + t) * 1024 + Y_MOBA + h * 64 + lane] = (bf16)f2bf(acc / l);
    }
}
typedef short v4i16_t __attribute__((ext_vector_type(4)));
typedef short s16x4 __attribute__((ext_vector_type(4)));
constexpr int ATT_K0 = 0, ATT_V0 = 32768, ATT_TAB = 132096;
#ifndef THRESH_NAT
#define THRESH_NAT 30.f
#endif
constexpr float THRESH2 = THRESH_NAT * LOG2E;

__device__ __forceinline__ int crow(int r, int hi) { return (r & 3) + 8 * (r >> 2) + 4 * hi; }
__device__ __forceinline__ s16x4 vtr(LAS const unsigned char* p) { return __builtin_bit_cast(s16x4, __builtin_amdgcn_ds_read_tr16_b64_v4i16((LAS v4i16_t*)p)); }
typedef float f32x2_t __attribute__((ext_vector_type(2))); typedef __bf16 bf16x2_t __attribute__((ext_vector_type(2)));
#ifndef CVT_ASM
#define CVT_ASM 0
#endif
#if CVT_ASM
__device__ __forceinline__ unsigned cvtpk(float lo, float hi) { unsigned r; asm volatile("v_cvt_pk_bf16_f32 %0, %1, %2\n\ts_nop 1" : "=v"(r) : "v"(lo), "v"(hi)); return r; }
#else
__device__ __forceinline__ unsigned cvtpk(float lo, float hi) { const f32x2_t v = {lo, hi}; const bf16x2_t b = __builtin_convertvector(v, bf16x2_t); return __builtin_bit_cast(unsigned, b); }
#endif

struct GroupRegs { v4u k[4], v[4]; };
__device__ __forceinline__ void group_issue(GroupRegs& R, const bf16* Kg, const bf16* Vg, int tid) {
#pragma unroll
    for (int i = 0; i < 4; ++i) { const int idx = tid + NTHREADS * i, row = idx >> 3, ch = idx & 7;
        R.k[i] = *(const v4u*)(Kg + (size_t)row * PLD + ch * 8); R.v[i] = *(const v4u*)(Vg + (size_t)row * PLD + ch * 8); }
}
__device__ __forceinline__ void group_commit(const GroupRegs& R, LAS unsigned char* kv, int tid) {
#pragma unroll
    for (int i = 0; i < 4; ++i) { const int idx = tid + NTHREADS * i, row = idx >> 3, ch = idx & 7;
        *(LAS v4u*)(kv + ATT_K0 + row * 128 + ((ch ^ ((row >> 1) & 7)) << 4)) = R.k[i];
        *(LAS v4u*)(kv + ATT_V0 + row * 128 + ((ch * 16) ^ (((row >> 1) & 1) << 6))) = R.v[i]; }
}
__device__ __forceinline__ void load_group(const bf16* Kg, const bf16* Vg, LAS unsigned char* kv, int tid) {
#pragma unroll
    for (int i = 0; i < 4; ++i) { const int idx = tid + NTHREADS * i, row = idx >> 3, ch = idx & 7;
        const v4u k = *(const v4u*)(Kg + (size_t)row * PLD + ch * 8), v = *(const v4u*)(Vg + (size_t)row * PLD + ch * 8);
        *(LAS v4u*)(kv + ATT_K0 + row * 128 + ((ch ^ ((row >> 1) & 7)) << 4)) = k;
        *(LAS v4u*)(kv + ATT_V0 + row * 128 + ((ch * 16) ^ (((row >> 1) & 1) << 6))) = v; }
}

template <bool FOX>
__device__ __forceinline__ void attn_subtile(LAS const unsigned char* kv, LAS const float* colt, int j0, const bf16x8 (&qf)[4], float rowterm, float slope2, bool mask, int qrel,
                                             f32x16 (&o)[2], float& l, int lane) {
    const int r32 = lane & 31, hh = lane >> 5;
    f32x16 acc;
    if (FOX) {
#pragma unroll
        for (int g = 0; g < 4; ++g) { const f32x4 c = *(LAS const f32x4*)(colt + j0 + 8 * g + 4 * hh); acc[4 * g + 0] = rowterm + c.x; acc[4 * g + 1] = rowterm + c.y; acc[4 * g + 2] = rowterm + c.z; acc[4 * g + 3] = rowterm + c.w; }
    } else {
#pragma unroll
        for (int r = 0; r < 16; ++r) acc[r] = rowterm + slope2 * (float)(j0 + crow(r, hh));
    }
    if (mask) {
#pragma unroll
        for (int r = 0; r < 16; ++r) if (j0 + crow(r, hh) > qrel) acc[r] = -INFINITY;
    }
    { const int row = j0 + r32; LAS const unsigned char* kr = kv + ATT_K0 + row * 128; const int sw = (row >> 1) & 7;
#pragma unroll
      for (int s = 0; s < 4; ++s) { const bf16x8 kf = *(LAS const bf16x8*)(kr + (((2 * s + hh) ^ sw) << 4)); acc = __builtin_amdgcn_mfma_f32_32x32x16_bf16(kf, qf[s], acc, 0, 0, 0); } }
    float ls = 0.f;
#pragma unroll
    for (int r = 0; r < 16; ++r) { acc[r] = __builtin_amdgcn_exp2f(acc[r]); ls += acc[r]; }
    l += ls;
    bf16x8 pa[2];
#pragma unroll
    for (int s = 0; s < 2; ++s) { v4u w; w.x = cvtpk(acc[8 * s + 0], acc[8 * s + 1]); w.y = cvtpk(acc[8 * s + 2], acc[8 * s + 3]); w.z = cvtpk(acc[8 * s + 4], acc[8 * s + 5]); w.w = cvtpk(acc[8 * s + 6], acc[8 * s + 7]); pa[s] = __builtin_bit_cast(bf16x8, w); }
    { const int i = lane & 15, c = (lane >> 4) & 1;
#pragma unroll
      for (int db = 0; db < 2; ++db)
#pragma unroll
          for (int s = 0; s < 2; ++s) { const int rowv = j0 + 16 * s + 4 * hh + (i >> 2); const int colb = (32 * db + 16 * c + 4 * (i & 3)) * 2;
              LAS const unsigned char* vp = kv + ATT_V0 + rowv * 128 + (colb ^ (((rowv >> 1) & 1) << 6));
              const s16x4 lo = vtr(vp), hi = vtr(vp + 8 * 128);
              const bf16x8 vf = (bf16x8){lo[0], lo[1], lo[2], lo[3], hi[0], hi[1], hi[2], hi[3]};
              o[db] = __builtin_amdgcn_mfma_f32_32x32x16_bf16(pa[s], vf, o[db], 0, 0, 0); } }
}
__device__ __forceinline__ float rfl(float x) { return __builtin_bit_cast(float, __builtin_amdgcn_readfirstlane(__builtin_bit_cast(int, x))); }

__device__ __forceinline__ void fox_unit(int bh, int qb, const bf16* PROJ, const float* FOXCUM, bf16* Y, float B2, LAS unsigned char* lds, int tid, int wave, int lane) {
    const int b = bh / 6, h = bh % 6; const size_t rb = (size_t)b * SEQ; const int r32 = lane & 31, hh = lane >> 5;
    const int q0w = qb * 256 + wave * 32, qpos = q0w + r32;
    const float* cum = FOXCUM + (size_t)bh * SEQ;
    bf16x8 qf[4];
#pragma unroll
    for (int s = 0; s < 4; ++s) qf[s] = *(const bf16x8*)(PROJ + (rb + qpos) * PLD + C_FQ + h * 64 + 16 * s + 8 * hh);
    GroupRegs GA, GB;
    group_issue(GA, PROJ + (rb + (size_t)qb * 256) * PLD + C_FK + h * 64, PROJ + (rb + (size_t)qb * 256) * PLD + C_FV + h * 64, tid);
    const float ca = (tid < 256) ? -cum[qb * 256 + tid] : 0.f;
    const float cq = cum[qpos];
    const float cq_first = rfl(cum[q0w]), cq_blk = rfl(cum[qb * 256]);
    const float cprev = (qb > 0) ? rfl(cum[qb * 256 - 1]) : 0.f;
    const float rowterm = cq - B2, lim = -THRESH2 - 2.f * B2;
    f32x16 o[2]; float l = 0.f;
#pragma unroll
    for (int r = 0; r < 16; ++r) { o[0][r] = 0.f; o[1][r] = 0.f; }
    LAS float* coltA = (LAS float*)(lds + ATT_TAB); LAS float* coltB = coltA + 256;
    LAS unsigned char* kvA = lds; LAS unsigned char* kvB = lds + 65536;
#ifndef FOX_2G
#define FOX_2G 1
#endif
    const bool haveB = FOX_2G && (qb > 0) && !(cq_blk - cprev < lim);
    float cb = 0.f;
    if (haveB) { group_issue(GB, PROJ + (rb + (size_t)(qb - 1) * 256) * PLD + C_FK + h * 64, PROJ + (rb + (size_t)(qb - 1) * 256) * PLD + C_FV + h * 64, tid);
        cb = (tid < 256) ? -cum[(qb - 1) * 256 + tid] : 0.f; }
    group_commit(GA, kvA, tid); if (tid < 256) coltA[tid] = ca;
    if (haveB) { group_commit(GB, kvB, tid); if (tid < 256) coltB[tid] = cb; }
    __syncthreads();
#ifndef REP_FLOAD
#define REP_FLOAD 0
#endif
#pragma unroll 1
    for (int rp = 0; rp < REP_FLOAD; ++rp) {
        group_issue(GA, PROJ + (rb + (size_t)qb * 256) * PLD + C_FK + h * 64, PROJ + (rb + (size_t)qb * 256) * PLD + C_FV + h * 64, tid);
        if (haveB) group_issue(GB, PROJ + (rb + (size_t)(qb - 1) * 256) * PLD + C_FK + h * 64, PROJ + (rb + (size_t)(qb - 1) * 256) * PLD + C_FV + h * 64, tid);
        group_commit(GA, kvA, tid); if (haveB) group_commit(GB, kvB, tid);
        __syncthreads(); }
#ifndef REP_FSUB
#define REP_FSUB 0
#endif
#pragma unroll 1
    for (int rp = 0; rp <= REP_FSUB; ++rp) {
    if (rp) { l = 0.f;
#pragma unroll
        for (int r = 0; r < 16; ++r) { o[0][r] = 0.f; o[1][r] = 0.f; } }
#pragma unroll 1
    for (int st = wave; st >= 0; --st) {
        const int j0 = 32 * st;
        if (cq_first + rfl(coltA[j0 + 31]) < lim) break;
        attn_subtile<true>(kvA, coltA, j0, qf, rowterm, 0.f, st == wave, wave * 32 + r32, o, l, lane);
    }
    if (haveB) {
#pragma unroll 1
        for (int st = 7; st >= 0; --st) {
            const int j0 = 32 * st;
            if (cq_first + rfl(coltB[j0 + 31]) < lim) break;
            attn_subtile<true>(kvB, coltB, j0, qf, rowterm, 0.f, false, 0, o, l, lane);
        }
    }
    }
    __syncthreads();
    {
        for (int g = haveB ? qb - 2 : qb - 1; g >= 0; --g) {
            if (cq_blk - rfl(cum[g * 256 + 255]) < lim) break;
            load_group(PROJ + (rb + (size_t)g * 256) * PLD + C_FK + h * 64, PROJ + (rb + (size_t)g * 256) * PLD + C_FV + h * 64, kvA, tid);
            if (tid < 256) coltA[tid] = -cum[g * 256 + tid];
            __syncthreads();
            {
#pragma unroll 1
                for (int st = 7; st >= 0; --st) {
                    const int j0 = 32 * st;
                    if (cq_first + rfl(coltA[j0 + 31]) < lim) break;
                    attn_subtile<true>(kvA, coltA, j0, qf, rowterm, 0.f, false, 0, o, l, lane);
                }
            }
            __syncthreads();
        }
    }
    l = half_sum(l, lane);
    bf16* yp = Y + (rb + (size_t)q0w) * 1024 + Y_FOX + h * 64 + r32;
#ifndef REP_FOUT
#define REP_FOUT 0
#endif
#pragma unroll 1
    for (int rp = 0; rp <= REP_FOUT; ++rp) {
#pragma unroll
    for (int r = 0; r < 16; ++r) { const int q = crow(r, hh); const float rl = 1.f / shf(l, q);
        yp[(size_t)q * 1024] = (bf16)f2bf(o[0][r] * rl); yp[(size_t)q * 1024 + 32] = (bf16)f2bf(o[1][r] * rl); }
    }
}

__device__ __forceinline__ void fox_unit_old(int bh, int qb, const bf16* PROJ, const float* FOXCUM, bf16* Y, float B2, LAS unsigned char* lds, int tid, int wave, int lane) {
    const int b = bh / 6, h = bh % 6; const size_t rb = (size_t)b * SEQ; const int r32 = lane & 31, hh = lane >> 5;
    const int q0w = qb * 256 + wave * 32, qpos = q0w + r32;
    const float* cum = FOXCUM + (size_t)bh * SEQ;
    bf16x8 qf[4];
#pragma unroll
    for (int s = 0; s < 4; ++s) qf[s] = *(const bf16x8*)(PROJ + (rb + qpos) * PLD + C_FQ + h * 64 + 16 * s + 8 * hh);
    const float cq = cum[qpos];
    const float cq_first = rfl(cum[q0w]);
    const float cq_blk = rfl(cum[qb * 256]);
    const float rowterm = cq - B2;
    f32x16 o[2]; float l = 0.f;
#pragma unroll
    for (int r = 0; r < 16; ++r) { o[0][r] = 0.f; o[1][r] = 0.f; }
    LAS float* colt = (LAS float*)(lds + ATT_TAB);
    for (int g = qb; g >= 0; --g) {
        if (g < qb) { const float cl = rfl(cum[g * 256 + 255]); if (2.f * B2 + cq_blk - cl < -THRESH2) break; }
        load_group(PROJ + (rb + (size_t)g * 256) * PLD + C_FK + h * 64, PROJ + (rb + (size_t)g * 256) * PLD + C_FV + h * 64, lds, tid);
        if (tid < 256) colt[tid] = -cum[g * 256 + tid];
        __syncthreads();
        const int stmax = (g == qb) ? wave : 7;
        for (int st = stmax; st >= 0; --st) {
            const int j0 = 32 * st;
            { const float cl = rfl(colt[j0 + 31]); if (2.f * B2 + cq_first + cl < -THRESH2) break; }
            attn_subtile<true>(lds, colt, j0, qf, rowterm, 0.f, (g == qb) && (st == wave), wave * 32 + r32, o, l, lane);
        }
        __syncthreads();
    }
    l = half_sum(l, lane);
    bf16* yp = Y + (rb + (size_t)q0w) * 1024 + Y_FOX + h * 64 + r32;
#pragma unroll
    for (int r = 0; r < 16; ++r) { const int q = crow(r, hh); const float rl = 1.f / shf(l, q);
        yp[(size_t)q * 1024] = (bf16)f2bf(o[0][r] * rl); yp[(size_t)q * 1024 + 32] = (bf16)f2bf(o[1][r] * rl); }
}

__device__ __forceinline__ size_t moba_list_off(int bh, int n) { return (size_t)bh * 516096 + 256 * (size_t)(63 * n - (n * (n - 1)) / 2); }
__device__ __forceinline__ void moba_store(const f32x16 (&o)[2], float l, int qpos, int slot, bool valid, size_t rb, int h, bf16* OPART, float* LPART, bf16* Y, int lane) {
    const int r32 = lane & 31, hh = lane >> 5;
#pragma unroll
    for (int r = 0; r < 16; ++r) { const int src = crow(r, hh);
        const int qp = shfi(qpos, src), sl = shfi(slot, src); const int ok = shfi((int)valid, src);
        if (ok) { bf16* op = (sl == 3) ? (Y + (rb + qp) * 1024 + Y_MOBA + h * 64) : (OPART + ((size_t)sl * MROWS + rb + qp) * 384 + h * 64);
            op[r32] = (bf16)f2bf(o[0][r]); op[32 + r32] = (bf16)f2bf(o[1][r]); } }
    if (valid && hh == 0) LPART[((size_t)slot * MROWS + rb + qpos) * 6 + h] = l;
}
__device__ __forceinline__ void moba_sel_unit(int bh, int n, int chunk, int cnt, const bf16* PROJ, const unsigned short* LIST, const unsigned* CTAB, bf16* OPART, float* LPART, bf16* Y, float B2,
                                              LAS unsigned char* lds, int tid, int wave, int lane) {
    const int b = bh / 6, h = bh % 6; const size_t rb = (size_t)b * SEQ; const int r32 = lane & 31, hh = lane >> 5;
    const float slope2 = exp2f(-8.f * (float)(h + 1) / 6.f) * LOG2E;
    GroupRegs GR; group_issue(GR, PROJ + (rb + (size_t)n * 256) * PLD + C_BK + h * 64, PROJ + (rb + (size_t)n * 256) * PLD + C_BV + h * 64, tid);
    const int nvalid = cnt - chunk * 256 < 256 ? cnt - chunk * 256 : 256;
    const bool active = wave * 32 < nvalid;
    bool valid = true; int qpos = 0, slot = 0; bf16x8 qf[4];
    if (active) {
        int li = wave * 32 + r32; if (li >= nvalid) { li = nvalid - 1; valid = false; }
        const int p = chunk * 256 + li;
        const int cv = (lane > n) ? (int)CTAB[((size_t)bh * 64 + lane) * 64 + n] : 0; int inc = cv;
#pragma unroll
        for (int o2 = 1; o2 < 64; o2 <<= 1) { const int t2 = supi(inc, o2, lane); if (lane >= o2) inc += t2; }
        int qseg = 0;
#pragma unroll
        for (int stp = 32; stp >= 1; stp >>= 1) { const int v = shfi(inc, qseg + stp - 1); if (v <= p) qseg += stp; }
        const int idx = p - (shfi(inc, qseg) - shfi(cv, qseg));
        const unsigned e = LIST[moba_list_off(bh, n) + (size_t)(qseg - n - 1) * 256 + idx]; qpos = e & 0x3fff; slot = e >> 14;
#pragma unroll
        for (int s = 0; s < 4; ++s) qf[s] = *(const bf16x8*)(PROJ + (rb + qpos) * PLD + C_BQ + h * 64 + 16 * s + 8 * hh);
    }
    group_commit(GR, lds, tid);
    __syncthreads();
    if (active) {
        const int qrel = qpos - n * 256;
        const float rowterm = -slope2 * (float)qrel - B2;
        f32x16 o[2]; float l = 0.f;
#pragma unroll
        for (int r = 0; r < 16; ++r) { o[0][r] = 0.f; o[1][r] = 0.f; }
#ifndef REP_SUB
#define REP_SUB 0
#endif
#pragma unroll 1
        for (int rp = 0; rp <= REP_SUB; ++rp) {
        if (rp) { l = 0.f;
#pragma unroll
            for (int r = 0; r < 16; ++r) { o[0][r] = 0.f; o[1][r] = 0.f; } }
#pragma unroll 1
        for (int st = 0; st < 8; ++st) attn_subtile<false>(lds, nullptr, 32 * st, qf, rowterm, slope2, false, 0, o, l, lane);
        }
        l = half_sum(l, lane);
        moba_store(o, l, qpos, slot, valid, rb, h, OPART, LPART, Y, lane);
    }
    __syncthreads();
}
__device__ __forceinline__ void moba_sel_step(int huA, int S, LAS const int* pre, const unsigned* lcnt, const bf16* PROJ, const unsigned short* LIST, const unsigned* CTAB, bf16* OPART, float* LPART, bf16* Y,
                                              float B2, LAS unsigned char* lds, int tid, int wave, int lane) {
    const int r32 = lane & 31, hh = lane >> 5, half = wave >> 2, tile = wave & 3, htid = tid & 255;
    const int hu = huA + half; const bool uvalid = hu < S;
    int p = 0, chunk = 0, cnt = 0;
    if (uvalid) { int lo2 = 0, hi2 = 768; while (hi2 - lo2 > 1) { const int mid = (lo2 + hi2) >> 1; if (pre[mid] <= hu) lo2 = mid; else hi2 = mid; } p = lo2; chunk = hu - pre[lo2]; cnt = (int)lcnt[lo2]; }
    const int bh = p >> 6, n = p & 63, b = bh / 6, h = bh % 6; const size_t rb = (size_t)b * SEQ;
    const float slope2 = exp2f(-8.f * (float)(h + 1) / 6.f) * LOG2E;
    LAS unsigned char* kv = lds + half * 65536;
    v4u gk[8], gv[8];
    if (uvalid) { const bf16* Kg = PROJ + (rb + (size_t)n * 256) * PLD + C_BK + h * 64; const bf16* Vg = PROJ + (rb + (size_t)n * 256) * PLD + C_BV + h * 64;
#pragma unroll
        for (int i = 0; i < 8; ++i) { const int idx = htid + 256 * i, row = idx >> 3, ch = idx & 7; gk[i] = *(const v4u*)(Kg + (size_t)row * PLD + ch * 8); gv[i] = *(const v4u*)(Vg + (size_t)row * PLD + ch * 8); } }
    const int nvalid = uvalid ? (cnt - chunk * 128 < 128 ? cnt - chunk * 128 : 128) : 0;
    const bool active = tile * 32 < nvalid;
    bool valid = true; int qpos = 0, slot = 0; bf16x8 qf[4];
    if (active) {
        int li = tile * 32 + r32; if (li >= nvalid) { li = nvalid - 1; valid = false; }
        const int pos = chunk * 128 + li;
        const int cv = (lane > n) ? (int)CTAB[((size_t)bh * 64 + lane) * 64 + n] : 0; int inc = cv;
#pragma unroll
        for (int o2 = 1; o2 < 64; o2 <<= 1) { const int t2 = supi(inc, o2, lane); if (lane >= o2) inc += t2; }
        int qseg = 0;
#pragma unroll
        for (int stp = 32; stp >= 1; stp >>= 1) { const int v = shfi(inc, qseg + stp - 1); if (v <= pos) qseg += stp; }
        const int idx = pos - (shfi(inc, qseg) - shfi(cv, qseg));
        const unsigned e = LIST[moba_list_off(bh, n) + (size_t)(qseg - n - 1) * 256 + idx]; qpos = e & 0x3fff; slot = e >> 14;
#pragma unroll
        for (int s = 0; s < 4; ++s) qf[s] = *(const bf16x8*)(PROJ + (rb + qpos) * PLD + C_BQ + h * 64 + 16 * s + 8 * hh);
    }
    if (uvalid) {
#pragma unroll
        for (int i = 0; i < 8; ++i) { const int idx = htid + 256 * i, row = idx >> 3, ch = idx & 7;
            *(LAS v4u*)(kv + ATT_K0 + row * 128 + ((ch ^ ((row >> 1) & 7)) << 4)) = gk[i];
            *(LAS v4u*)(kv + ATT_V0 + row * 128 + ((ch * 16) ^ (((row >> 1) & 1) << 6))) = gv[i]; } }
    __syncthreads();
    if (active) {
        const int qrel = qpos - n * 256;
        const float rowterm = -slope2 * (float)qrel - B2;
        f32x16 o[2]; float l = 0.f;
#pragma unroll
        for (int r = 0; r < 16; ++r) { o[0][r] = 0.f; o[1][r] = 0.f; }
#pragma unroll 1
        for (int st = 0; st < 8; ++st) attn_subtile<false>(kv, nullptr, 32 * st, qf, rowterm, slope2, false, 0, o, l, lane);
        l = half_sum(l, lane);
        moba_store(o, l, qpos, slot, valid, rb, h, OPART, LPART, Y, lane);
    }
    __syncthreads();
}
__device__ __forceinline__ void moba_own_pair(int bh, int nA, int nB, const bf16* PROJ, bf16* OPART, float* LPART, bf16* Y, float B2, LAS unsigned char* lds, int tid, int wave, int lane) {
    const int b = bh / 6, h = bh % 6; const size_t rb = (size_t)b * SEQ; const int r32 = lane & 31, hh = lane >> 5;
    const float slope2 = exp2f(-8.f * (float)(h + 1) / 6.f) * LOG2E;
    GroupRegs GA, GB;
    group_issue(GA, PROJ + (rb + (size_t)nA * 256) * PLD + C_BK + h * 64, PROJ + (rb + (size_t)nA * 256) * PLD + C_BV + h * 64, tid);
    group_issue(GB, PROJ + (rb + (size_t)nB * 256) * PLD + C_BK + h * 64, PROJ + (rb + (size_t)nB * 256) * PLD + C_BV + h * 64, tid);
    bf16x8 qfA[4], qfB[4];
    { const size_t qa = rb + (size_t)nA * 256 + wave * 32 + r32, qb2 = rb + (size_t)nB * 256 + (7 - wave) * 32 + r32;
#pragma unroll
      for (int s = 0; s < 4; ++s) { qfA[s] = *(const bf16x8*)(PROJ + qa * PLD + C_BQ + h * 64 + 16 * s + 8 * hh); qfB[s] = *(const bf16x8*)(PROJ + qb2 * PLD + C_BQ + h * 64 + 16 * s + 8 * hh); } }
    group_commit(GA, lds, tid); group_commit(GB, lds + 65536, tid);
    __syncthreads();
    { const int tile = wave, qrel = tile * 32 + r32, qpos = nA * 256 + qrel;
      const float rowterm = -slope2 * (float)qrel - B2;
      f32x16 o[2]; float l = 0.f;
#pragma unroll
      for (int r = 0; r < 16; ++r) { o[0][r] = 0.f; o[1][r] = 0.f; }
#pragma unroll 1
      for (int st = 0; st <= tile; ++st) attn_subtile<false>(lds, nullptr, 32 * st, qfA, rowterm, slope2, st == tile, qrel, o, l, lane);
      l = half_sum(l, lane);
      moba_store(o, l, qpos, 3, true, rb, h, OPART, LPART, Y, lane); }
    { const int tile = 7 - wave, qrel = tile * 32 + r32, qpos = nB * 256 + qrel;
      const float rowterm = -slope2 * (float)qrel - B2;
      f32x16 o[2]; float l = 0.f;
#pragma unroll
      for (int r = 0; r < 16; ++r) { o[0][r] = 0.f; o[1][r] = 0.f; }
#pragma unroll 1
      for (int st = 0; st <= tile; ++st) attn_subtile<false>(lds + 65536, nullptr, 32 * st, qfB, rowterm, slope2, st == tile, qrel, o, l, lane);
      l = half_sum(l, lane);
      moba_store(o, l, qpos, 3, true, rb, h, OPART, LPART, Y, lane); }
    __syncthreads();
}

__device__ __forceinline__ void moba_combine(const unsigned* SEL, const bf16* OPART, const float* LPART, bf16* Y, bf16* Yo, int opitch, int ocol, int gtid, int ngt) {
    constexpr size_t NIT = (size_t)MROWS * 48;
    for (size_t base = gtid; base < NIT; base += (size_t)ngt * 4) {
        unsigned sel[4]; v4u yv[4]; float lo[4]; size_t row[4]; int hh4[4], c84[4]; bool ok[4];
#pragma unroll
        for (int j = 0; j < 4; ++j) { const size_t idx = base + (size_t)j * ngt; ok[j] = idx < NIT; const size_t ii = ok[j] ? idx : 0;
            row[j] = ii / 48; const int hc = (int)(ii % 48); hh4[j] = hc >> 3; c84[j] = (hc & 7) * 8;
            sel[j] = SEL[row[j] * 6 + hh4[j]]; yv[j] = *(const v4u*)(Y + row[j] * 1024 + Y_MOBA + hh4[j] * 64 + c84[j]); lo[j] = LPART[((size_t)3 * MROWS + row[j]) * 6 + hh4[j]]; }
        v4u pv[4][3]; float pl[4][3];
#pragma unroll
        for (int j = 0; j < 4; ++j)
#pragma unroll
            for (int k = 0; k < 3; ++k) { const bool v = ((sel[j] >> (8 * k)) & 0xff) != 255;
                pv[j][k] = v ? *(const v4u*)(OPART + ((size_t)k * MROWS + row[j]) * 384 + hh4[j] * 64 + c84[j]) : (v4u){0u, 0u, 0u, 0u};
                pl[j][k] = v ? LPART[((size_t)k * MROWS + row[j]) * 6 + hh4[j]] : 0.f; }
#pragma unroll
        for (int j = 0; j < 4; ++j) { float acc[8]; unpack8(yv[j], acc); float l = lo[j];
#pragma unroll
            for (int k = 0; k < 3; ++k) { float f[8]; unpack8(pv[j][k], f);
#pragma unroll
                for (int i = 0; i < 8; ++i) acc[i] += f[i];
                l += pl[j][k]; }
            const float rl = 1.f / l;
            v4u w; w.x = pk2(acc[0] * rl, acc[1] * rl); w.y = pk2(acc[2] * rl, acc[3] * rl); w.z = pk2(acc[4] * rl, acc[5] * rl); w.w = pk2(acc[6] * rl, acc[7] * rl);
            if (ok[j]) *(v4u*)(Yo + row[j] * opitch + ocol + hh4[j] * 64 + c84[j]) = w; }
    }
}

__device__ __forceinline__ int vsw(int row, int colb) { return row * 128 + (colb ^ (((row >> 1) & 1) << 6)); }
__device__ __forceinline__ int ksw(int row, int ch) { return row * 128 + ((ch ^ ((row >> 1) & 7)) << 4); }
__device__ __forceinline__ void mlstm_m1_mfma(int ci, const MlP& P, LAS unsigned char* lds, int wave, int lane) {
    const int b = ci >> 10, h = (ci >> 8) & 3, c = ci & 255; const size_t row0 = (size_t)b * SEQ + c * 64;
    LAS unsigned char* Ki = lds + wave * 16384; LAS unsigned char* Vi = Ki + 8192;
    float wv;
    { const size_t row = row0 + lane;
      const float fi = P.GATES[row * 16 + 6 + h] + P.ibias[h], ff = P.GATES[row * 16 + 10 + h] + P.fbias[h];
      float bc = log_sigmoid_f(ff);
#pragma unroll
      for (int o = 1; o < 64; o <<= 1) { const float n = sup(bc, o, lane); if (lane >= o) bc += n; }
      const float bend = shf(bc, 63);
      const float wl = bend - bc + fi; const float mloc = wave_max(wl);
      wv = expf(wl - mloc);
      if (lane == 0) { P.BEND[ci] = bend; P.MLOC[ci] = mloc; } }
#pragma unroll
    for (int i = 0; i < 8; ++i) { const int idx = lane + 64 * i, r = idx >> 3, ch = idx & 7;
        const v4u kk = *(const v4u*)(P.KC + (row0 + r) * 256 + h * 64 + ch * 8);
        *(LAS v4u*)(Ki + vsw(r, ch * 16)) = kk;
        float f[8]; unpack8(*(const v4u*)(P.PROJ + (row0 + r) * PLD + C_MV + h * 64 + ch * 8), f);
        const float w = shf(wv, r);
        v4u o; o.x = pk2(f[0] * w, f[1] * w); o.y = pk2(f[2] * w, f[3] * w); o.z = pk2(f[4] * w, f[5] * w); o.w = pk2(f[6] * w, f[7] * w);
        *(LAS v4u*)(Vi + vsw(r, ch * 16)) = o; }
    LDS_WAIT(); asm volatile("" ::: "memory");
    { float nu = 0.f;
#pragma unroll 8
      for (int s = 0; s < 64; ++s) { const float ws = shf(wv, s); nu += ws * bf2f(*(LAS const unsigned short*)(Ki + vsw(s, 2 * lane))); }
      P.NU[(size_t)ci * 64 + lane] = nu; }
    f32x16 D[2][2];
#pragma unroll
    for (int a = 0; a < 2; ++a)
#pragma unroll
        for (int e = 0; e < 2; ++e)
#pragma unroll
            for (int r = 0; r < 16; ++r) D[a][e][r] = 0.f;
    const int i16 = lane & 15, cc = (lane >> 4) & 1, hh = lane >> 5, r32 = lane & 31;
#pragma unroll
    for (int ks = 0; ks < 4; ++ks) { const int rowv = 16 * ks + 4 * hh + (i16 >> 2);
        bf16x8 af[2], bfr[2];
#pragma unroll
        for (int blk = 0; blk < 2; ++blk) { const int colb = (32 * blk + 16 * cc + 4 * (i16 & 3)) * 2;
            { const s16x4 lo = vtr(Vi + vsw(rowv, colb)), hi = vtr(Vi + vsw(rowv, colb) + 1024); af[blk] = (bf16x8){lo[0], lo[1], lo[2], lo[3], hi[0], hi[1], hi[2], hi[3]}; }
            { const s16x4 lo = vtr(Ki + vsw(rowv, colb)), hi = vtr(Ki + vsw(rowv, colb) + 1024); bfr[blk] = (bf16x8){lo[0], lo[1], lo[2], lo[3], hi[0], hi[1], hi[2], hi[3]}; } }
#pragma unroll
        for (int a = 0; a < 2; ++a)
#pragma unroll
            for (int e = 0; e < 2; ++e) D[a][e] = __builtin_amdgcn_mfma_f32_32x32x16_bf16(af[a], bfr[e], D[a][e], 0, 0, 0); }
    float* up = P.U + (size_t)ci * 4096;
#pragma unroll
    for (int a = 0; a < 2; ++a)
#pragma unroll
        for (int e = 0; e < 2; ++e)
#pragma unroll
            for (int r = 0; r < 16; ++r) up[(32 * a + crow(r, hh)) * 64 + 32 * e + r32] = D[a][e][r];
    LDS_WAIT(); asm volatile("" ::: "memory");
}

__device__ __forceinline__ void mlstm_m3_mfma(int it, const MlP& P, LAS unsigned char* lds, int tid, int wave, int lane) {
    const int cs = wave >> 1, tile = wave & 1, ci = it * 4 + cs;
    const int b = ci >> 10, h = (ci >> 8) & 3, c = ci & 255; const size_t row0 = (size_t)b * SEQ + c * 64;
    LAS unsigned char* Ki = lds + cs * 32768; LAS unsigned char* Vi = Ki + 8192; LAS unsigned char* Ci = Ki + 16384; LAS unsigned char* Mi = Ki + 24576;
    LAS float* tab = (LAS float*)(lds + ATT_TAB) + cs * 256;
    const float ms = P.MS[ci];
    { const int pt = tile * 64 + lane;
#pragma unroll
      for (int i = 0; i < 4; ++i) { const int idx = pt + 128 * i, r = idx >> 3, ch = idx & 7;
          *(LAS v4u*)(Ki + ksw(r, ch)) = *(const v4u*)(P.KC + (row0 + r) * 256 + h * 64 + ch * 8);
          *(LAS v4u*)(Vi + vsw(r, ch * 16)) = *(const v4u*)(P.PROJ + (row0 + r) * PLD + C_MV + h * 64 + ch * 8);
          *(LAS v4u*)(Ci + ksw(r, ch)) = *(const v4u*)(P.CS + (size_t)ci * 4096 + r * 64 + ch * 8);
          *(LAS v4u*)(Mi + r * 128 + ch * 16) = *(const v4u*)(P.PROJ + (row0 + r) * PLD + C_MO + h * 64 + ch * 8); } }
    if (tile == 0) {
        const size_t row = row0 + lane;
        const float fi = P.GATES[row * 16 + 6 + h] + P.ibias[h], ff = P.GATES[row * 16 + 10 + h] + P.fbias[h];
        float bc = log_sigmoid_f(ff);
#pragma unroll
        for (int o = 1; o < 64; o <<= 1) { const float n = sup(bc, o, lane); if (lane >= o) bc += n; }
        const float a = fi - bc; float pm = a;
#pragma unroll
        for (int o = 1; o < 64; o <<= 1) { const float n = sup(pm, o, lane); if (lane >= o) pm = fmaxf(pm, n); }
        tab[lane] = a * LOG2E; tab[64 + lane] = fmaxf(ms, pm); tab[128 + lane] = bc; tab[192 + lane] = P.NS[(size_t)ci * 64 + lane];
    }
    __syncthreads();
    const int r32 = lane & 31, hh = lane >> 5, j = 32 * tile + r32;
    bf16x8 qf[4];
#pragma unroll
    for (int s = 0; s < 4; ++s) qf[s] = *(const bf16x8*)(P.QC + (row0 + j) * 256 + h * 64 + 16 * s + 8 * hh);
    const float gj = tab[64 + j], inter = expf(ms - gj), rowterm2 = -gj * LOG2E;
    f32x16 o[2]; float l = 0.f;
#pragma unroll
    for (int r = 0; r < 16; ++r) { o[0][r] = 0.f; o[1][r] = 0.f; }
    for (int st = 0; st <= tile; ++st) {
        const int j0 = 32 * st;
        f32x16 acc;
#pragma unroll
        for (int r = 0; r < 16; ++r) acc[r] = 0.f;
#pragma unroll
        for (int s = 0; s < 4; ++s) { const bf16x8 kf = *(LAS const bf16x8*)(Ki + ksw(j0 + r32, 2 * s + hh)); acc = __builtin_amdgcn_mfma_f32_32x32x16_bf16(kf, qf[s], acc, 0, 0, 0); }
        float ls = 0.f;
#pragma unroll
        for (int g4 = 0; g4 < 4; ++g4) { const f32x4 c4 = *(LAS const f32x4*)(tab + j0 + 8 * g4 + 4 * hh);
#pragma unroll
            for (int ii = 0; ii < 4; ++ii) { const int reg = 4 * g4 + ii, key = j0 + 8 * g4 + 4 * hh + ii;
                float p = acc[reg] * __builtin_amdgcn_exp2f(rowterm2 + c4[ii]);
                if (st == tile && key > j) p = 0.f;
                acc[reg] = p; ls += p; } }
        l += ls;
        bf16x8 pa[2];
#pragma unroll
        for (int s = 0; s < 2; ++s) { v4u w; w.x = cvtpk(acc[8 * s + 0], acc[8 * s + 1]); w.y = cvtpk(acc[8 * s + 2], acc[8 * s + 3]); w.z = cvtpk(acc[8 * s + 4], acc[8 * s + 5]); w.w = cvtpk(acc[8 * s + 6], acc[8 * s + 7]); pa[s] = __builtin_bit_cast(bf16x8, w); }
        { const int i16 = lane & 15, cc = (lane >> 4) & 1;
#pragma unroll
          for (int db = 0; db < 2; ++db)
#pragma unroll
              for (int s = 0; s < 2; ++s) { const int rowv = j0 + 16 * s + 4 * hh + (i16 >> 2); const int colb = (32 * db + 16 * cc + 4 * (i16 & 3)) * 2;
                  LAS const unsigned char* vp = Vi + vsw(rowv, colb);
                  const s16x4 lo = vtr(vp), hi = vtr(vp + 1024);
                  const bf16x8 vf = (bf16x8){lo[0], lo[1], lo[2], lo[3], hi[0], hi[1], hi[2], hi[3]};
                  o[db] = __builtin_amdgcn_mfma_f32_32x32x16_bf16(pa[s], vf, o[db], 0, 0, 0); } }
    }
    float dn = 0.f;
#pragma unroll
    for (int s = 0; s < 4; ++s) { float f[8]; unpack8(__builtin_bit_cast(v4u, qf[s]), f);
        const f32x4 n0 = *(LAS const f32x4*)(tab + 192 + 16 * s + 8 * hh), n1 = *(LAS const f32x4*)(tab + 192 + 16 * s + 8 * hh + 4);
        dn += (f[0] * n0.x + f[1] * n0.y) + (f[2] * n0.z + f[3] * n0.w) + (f[4] * n1.x + f[5] * n1.y) + (f[6] * n1.z + f[7] * n1.w);
        v4u w; w.x = cvtpk(f[0] * inter, f[1] * inter); w.y = cvtpk(f[2] * inter, f[3] * inter); w.z = cvtpk(f[4] * inter, f[5] * inter); w.w = cvtpk(f[6] * inter, f[7] * inter);
        const bf16x8 qs = __builtin_bit_cast(bf16x8, w);
#pragma unroll
        for (int db = 0; db < 2; ++db) { const bf16x8 cf = *(LAS const bf16x8*)(Ci + ksw(32 * db + r32, 2 * s + hh)); o[db] = __builtin_amdgcn_mfma_f32_32x32x16_bf16(qs, cf, o[db], 0, 0, 0); } }
    dn = half_sum(dn, lane); l = half_sum(l, lane);
    const float den = inter * dn + l, mj = tab[128 + j] + gj;
    const float rd = 1.f / fmaxf(fabsf(den), expf(-mj));
    const float hg0 = P.hg[h * 64 + r32], hg1 = P.hg[h * 64 + 32 + r32];
    unsigned short mo0[16], mo1[16];
#pragma unroll
    for (int r = 0; r < 16; ++r) { LAS const unsigned short* mq = (LAS const unsigned short*)(Mi + (32 * tile + crow(r, hh)) * 128) + r32; mo0[r] = mq[0]; mo1[r] = mq[32]; }
#pragma unroll
    for (int r = 0; r < 16; ++r) { const int src = crow(r, hh); const float rdr = shf(rd, src);
        const float h0 = o[0][r] * rdr, h1 = o[1][r] * rdr; float ss = h0 * h0 + h1 * h1;
        ss += SWZ_X(ss, 1); ss += SWZ_X(ss, 2); ss += SWZ_X(ss, 4); ss += SWZ_X(ss, 8); ss += SWZ_X(ss, 16);
        const float rr = 1.f / sqrtf(ss * (1.f / 64.f) + EPS);
        LAS unsigned short* mp = (LAS unsigned short*)(Mi + (32 * tile + src) * 128) + r32;
        const float e0 = __builtin_amdgcn_exp2f(-bf2f(mo0[r]) * LOG2E), e1 = __builtin_amdgcn_exp2f(-bf2f(mo1[r]) * LOG2E);
        mp[0] = (unsigned short)f2bf(h0 * rr * hg0 * __builtin_amdgcn_rcpf(1.f + e0));
        mp[32] = (unsigned short)f2bf(h1 * rr * hg1 * __builtin_amdgcn_rcpf(1.f + e1)); }
    LDS_WAIT(); asm volatile("" ::: "memory");
#pragma unroll
    for (int i = 0; i < 4; ++i) { const int rw = (lane >> 3) + 8 * i, ch = lane & 7;
        *(v4u*)(P.Y + (row0 + 32 * tile + rw) * 1024 + Y_ML + h * 64 + ch * 8) = *(LAS const v4u*)(Mi + (32 * tile + rw) * 128 + ch * 16); }
    __syncthreads();
}

__device__ __forceinline__ void top3_ins(float g, int n, float& v0, float& v1, float& v2, int& i0, int& i1, int& i2) {
    const bool c0 = g > v0, c1 = g > v1, c2 = g > v2;
    const float nv2 = c1 ? v1 : (c2 ? g : v2); const int ni2 = c1 ? i1 : (c2 ? n : i2);
    const float nv1 = c0 ? v0 : (c1 ? g : v1); const int ni1 = c0 ? i0 : (c1 ? n : i1);
    v0 = c0 ? g : v0; i0 = c0 ? n : i0; v1 = nv1; i1 = ni1; v2 = nv2; i2 = ni2;
}
__device__ __forceinline__ void moba_gate_mfma(int u, const bf16* PROJ, const float* KMEAN, unsigned* SEL, unsigned* LCNT, unsigned* CTAB, unsigned short* LIST, float B2, float thresh2,
                                               LAS unsigned char* lds, int tid, int wave, int lane) {
    const int bh = u >> 6, qb = 63 - (u & 63), b = bh / 6, h = bh % 6; const int r32 = lane & 31, hh = lane >> 5;
    LAS unsigned char* Khi = lds; LAS unsigned char* Klo = lds + 8192; LAS unsigned* cntl = (LAS unsigned*)(lds + 16384);
    if (tid < 64) cntl[tid] = 0u;
    { const int n = tid >> 3, ch = tid & 7; float f[8];
      if (n < qb) { const float* k0 = KMEAN + ((size_t)bh * NBLK + n) * 64 + ch * 8; const float* k1 = k0 + (size_t)(12 * NBLK * 64);
          const f32x4 a0 = *(const f32x4*)k0, a1 = *(const f32x4*)(k0 + 4), b0 = *(const f32x4*)k1, b1 = *(const f32x4*)(k1 + 4);
          f[0] = a0.x + b0.x; f[1] = a0.y + b0.y; f[2] = a0.z + b0.z; f[3] = a0.w + b0.w; f[4] = a1.x + b1.x; f[5] = a1.y + b1.y; f[6] = a1.z + b1.z; f[7] = a1.w + b1.w; }
      else {
#pragma unroll
          for (int i = 0; i < 8; ++i) f[i] = 0.f; }
      unsigned hi[8]; float lo[8];
#pragma unroll
      for (int i = 0; i < 8; ++i) { hi[i] = f2bf(f[i]); lo[i] = f[i] - bf2f((unsigned short)hi[i]); }
      v4u wh; wh.x = hi[0] | (hi[1] << 16); wh.y = hi[2] | (hi[3] << 16); wh.z = hi[4] | (hi[5] << 16); wh.w = hi[6] | (hi[7] << 16);
      v4u wl; wl.x = pk2(lo[0], lo[1]); wl.y = pk2(lo[2], lo[3]); wl.z = pk2(lo[4], lo[5]); wl.w = pk2(lo[6], lo[7]);
      *(LAS v4u*)(Khi + ksw(n, ch)) = wh; *(LAS v4u*)(Klo + ksw(n, ch)) = wl; }
    const int query = wave * 32 + r32; const size_t row = (size_t)b * SEQ + qb * 256 + query;
    bf16x8 qf[4];
#pragma unroll
    for (int s = 0; s < 4; ++s) qf[s] = *(const bf16x8*)(PROJ + row * PLD + C_BQ + h * 64 + 16 * s + 8 * hh);
    __syncthreads();
    float v0 = -INFINITY, v1 = -INFINITY, v2 = -INFINITY; int i0 = 255, i1 = 255, i2 = 255;
#pragma unroll 1
    for (int st = 0; st < 2; ++st) {
        if (32 * st >= qb) break;
        f32x16 acc;
#pragma unroll
        for (int r = 0; r < 16; ++r) acc[r] = 0.f;
#pragma unroll
        for (int s = 0; s < 4; ++s) { const bf16x8 kh = *(LAS const bf16x8*)(Khi + ksw(32 * st + r32, 2 * s + hh)), kl = *(LAS const bf16x8*)(Klo + ksw(32 * st + r32, 2 * s + hh));
            acc = __builtin_amdgcn_mfma_f32_32x32x16_bf16(kh, qf[s], acc, 0, 0, 0); acc = __builtin_amdgcn_mfma_f32_32x32x16_bf16(kl, qf[s], acc, 0, 0, 0); }
#pragma unroll
        for (int r = 0; r < 16; ++r) { const int n = 32 * st + crow(r, hh); if (n < qb) top3_ins(acc[r], n, v0, v1, v2, i0, i1, i2); }
    }
    { const int pl = lane ^ 32;
      const float w0 = shf(v0, pl), w1 = shf(v1, pl), w2 = shf(v2, pl); const int j0 = shfi(i0, pl), j1 = shfi(i1, pl), j2 = shfi(i2, pl);
      if (j0 != 255) top3_ins(w0, j0, v0, v1, v2, i0, i1, i2);
      if (j1 != 255) top3_ins(w1, j1, v0, v1, v2, i0, i1, i2);
      if (j2 != 255) top3_ins(w2, j2, v0, v1, v2, i0, i1, i2); }
    if (hh == 0) {
        { const float slope2 = exp2f(-8.f * (float)(h + 1) / 6.f) * LOG2E; const float lim = (2.f * B2 + thresh2) / slope2; const int t0 = qb * 256 + query - 255;
          if (i0 != 255 && (float)(t0 - i0 * 256) > lim) i0 = 255;
          if (i1 != 255 && (float)(t0 - i1 * 256) > lim) i1 = 255;
          if (i2 != 255 && (float)(t0 - i2 * 256) > lim) i2 = 255; }
        SEL[row * 6 + h] = (unsigned)i0 | ((unsigned)i1 << 8) | ((unsigned)i2 << 16);
        if (LIST) { const unsigned t = (unsigned)(qb * 256 + query);
            if (i0 != 255) { const unsigned pos = __hip_atomic_fetch_add(cntl + i0, 1u, __ATOMIC_RELAXED, __HIP_MEMORY_SCOPE_WORKGROUP); LIST[moba_list_off(bh, i0) + (size_t)(qb - i0 - 1) * 256 + pos] = (unsigned short)(t | (0u << 14)); }
            if (i1 != 255) { const unsigned pos = __hip_atomic_fetch_add(cntl + i1, 1u, __ATOMIC_RELAXED, __HIP_MEMORY_SCOPE_WORKGROUP); LIST[moba_list_off(bh, i1) + (size_t)(qb - i1 - 1) * 256 + pos] = (unsigned short)(t | (1u << 14)); }
            if (i2 != 255) { const unsigned pos = __hip_atomic_fetch_add(cntl + i2, 1u, __ATOMIC_RELAXED, __HIP_MEMORY_SCOPE_WORKGROUP); LIST[moba_list_off(bh, i2) + (size_t)(qb - i2 - 1) * 256 + pos] = (unsigned short)(t | (2u << 14)); } }
    }
    __syncthreads();
    if (LIST && tid < 64) { const unsigned c = cntl[tid]; CTAB[((size_t)bh * 64 + qb) * 64 + tid] = c; if (c) atomicAdd(LCNT + bh * 64 + tid, c); }
    __syncthreads();
}
#ifndef FOX_MFMA
#define FOX_MFMA 1
#endif
#ifndef MOBA_MFMA
#define MOBA_MFMA 1
#endif
#ifndef REP_P0
#define REP_P0 0
#endif
#ifndef REP_NORM
#define REP_NORM 0
#endif
#ifndef REP_GIN
#define REP_GIN 0
#endif
#ifndef REP_FOX
#define REP_FOX 0
#endif
#ifndef REP_M1
#define REP_M1 0
#endif
#ifndef REP_MIXB
#define REP_MIXB 0
#endif
#ifndef REP_M3
#define REP_M3 0
#endif
#ifndef REP_GGU
#define REP_GGU 0
#endif
#ifndef REP_GATE
#define REP_GATE 0
#endif
#ifndef REP_CONV
#define REP_CONV 0
#endif
#ifndef REP_FCUM
#define REP_FCUM 0
#endif
#ifndef REP_QKN
#define REP_QKN 0
#endif
#ifndef REP_GOUT
#define REP_GOUT 0
#endif
#ifndef REP_GDN
#define REP_GDN 0
#endif
#ifndef REP_COMB
#define REP_COMB 0
#endif
#ifndef REP_BAR
#define REP_BAR 0
#endif
#ifndef REP_GATE2
#define REP_GATE2 0
#endif
#ifndef ML_MFMA
#define ML_MFMA 1
#endif
#ifndef REP_M2
#define REP_M2 0
#endif
#ifndef FOX_OLD
#define FOX_OLD 0
#endif
#if FOX_OLD
#define FOX_FN fox_unit_old
#else
#define FOX_FN fox_unit
#endif
#ifndef REP_PRE
#define REP_PRE 0
#endif
#ifndef GGU_ALIGN
#define GGU_ALIGN true
#endif
#ifndef GGU_SP2
#define GGU_SP2 true
#endif
#ifndef GIN_ALIGN
#define GIN_ALIGN true
#endif
#ifndef GIN_SP2
#define GIN_SP2 true
#endif
#ifndef N_LAUNCH_MODE
#define N_LAUNCH_MODE 1
#endif
constexpr int NPHASE = 2 + 8 * DEPTH;
struct Args { const float* in[20]; float* out; unsigned char* ws; int ph_lo, ph_hi; };
static_assert(sizeof(Args) == 20 * 8 + 8 + 8 + 8, "Args has no padding");

__global__ void __launch_bounds__(NTHREADS, 2) fwd(Args args) {
    extern __shared__ __attribute__((aligned(16))) unsigned char lds_raw[];
    LAS unsigned char* lds = (LAS unsigned char*)lds_raw;
    LAS float* ldsf = (LAS float*)lds_raw;
    volatile LAS unsigned* MISC = (volatile LAS unsigned*)(lds + MISC_OFF);
    const int G = gridDim.x; const int bx = blockIdx.x; const int vcu = (G % 8 == 0) ? (bx % 8) * (G / 8) + bx / 8 : bx;
    const int NGW = G * NWAVES;
#define PH_IDS() int tid = threadIdx.x; asm volatile("" : "+v"(tid)); const int lane = tid & 63, wave = __builtin_amdgcn_readfirstlane(tid >> 6); const int gw = vcu * NWAVES + wave; (void)lane; (void)gw; \
    unsigned char* ws = ws_k; asm volatile("" : "+s"(ws)); gu32* ctl = (gu32*)(ws + WS_CTL); (void)ctl
    unsigned char* const ws_k = args.ws;
    gu32* ctl0 = (gu32*)(ws_k + WS_CTL);
    for (int u = threadIdx.x; u < (LDS_BYTES - LDSCTL_OFF) / 4; u += NTHREADS) ((LAS unsigned*)(lds + LDSCTL_OFF))[u] = 0u;
    __syncthreads();
    XcdBarrier bar; bar.bar = (unsigned*)(ctl0 + CW_BAR); bar.x = 0; bar.st = nullptr;
    if (N_LAUNCH_MODE == 1) bar = xcd_barrier_post((unsigned*)(ctl0 + CW_BAR), MISC + 8);
    const int lo = args.ph_lo, hi = args.ph_hi;
#ifndef PHMASK
#define PHMASK 0xfff
#endif
#define PHEN(j) ((PHMASK >> (j)) & 1)
#define IN(k) ((N_LAUNCH_MODE == 1) || (lo <= (k) && (k) < hi))
#define SEAM(k) do { if (IN(k) && IN((k) + 1)) { xcd_barrier(bar); for (int rb_ = 0; rb_ < REP_BAR; ++rb_) xcd_barrier(bar); } } while (0)

#define PRM(k) (*(const float* const volatile*)(ws + WS_PTAB + 8 * (k)))
#define x_in PRM(0)
#define norm1_g PRM(4)
#define norm2_g PRM(5)
#define fox_f_bias PRM(7)
#define fox_q_g PRM(8)
#define fox_k_g PRM(9)
#define ml_conv_w PRM(10)
#define ml_conv_b PRM(11)
#define ml_i_bias PRM(12)
#define ml_f_bias PRM(13)
#define ml_h_g PRM(14)
#define moba_q_g PRM(15)
#define moba_k_g PRM(16)
#define xres ((float*)PRM(20))
#define MOD ((float*)(ws + WS_MOD))
#define XN ((bf16*)(ws + WS_XN))
#define PROJ ((bf16*)(ws + WS_PROJ))
#define HB ((bf16*)(ws + WS_H))
#define Y ((bf16*)(ws + WS_Y))
#define GATES ((float*)(ws + WS_GATES))
#define FOXCUM ((float*)(ws + WS_FOXCUM))
#define KMEAN ((float*)(ws + WS_KMEAN))
#define QC ((bf16*)(ws + WS_QC))
#define KC ((bf16*)(ws + WS_KC))
#define SEL ((unsigned*)(ws + WS_SEL))
#define mod_l (MOD + (size_t)l * 2 * 6144)
#define MK_MP() const float* const ib_ = ml_i_bias; const float* const fb_ = ml_f_bias; const float* const hg_ = ml_h_g; \
    MlP MP{PROJ, QC, KC, GATES, (float*)(ws + WS_U), (float*)(ws + WS_NU), (float*)(ws + WS_BEND), (float*)(ws + WS_MLOC), (bf16*)(ws + WS_CS), (float*)(ws + WS_NS), (float*)(ws + WS_MS), Y, ib_ + l * 4, fb_ + l * 4, hg_ + l * 256}

    for (int rep = 0; rep <= REP_P0; ++rep)
    if (PHEN(10) && IN(0)) { PH_IDS();
        const float* cvec = args.in[1]; const float* w_ada = args.in[2]; const float* b_ada = args.in[3]; const float* w_in = args.in[6];
        const float* w_out = args.in[17]; const float* w_gate_up = args.in[18]; const float* w_down = args.in[19];
        if (blockIdx.x == 0 && tid == 0) { const float** pt = (const float**)(ws + WS_PTAB);
            pt[0] = args.in[0]; pt[4] = args.in[4]; pt[5] = args.in[5]; pt[7] = args.in[7]; pt[8] = args.in[8]; pt[9] = args.in[9]; pt[10] = args.in[10]; pt[11] = args.in[11]; pt[12] = args.in[12];
            pt[13] = args.in[13]; pt[14] = args.in[14]; pt[15] = args.in[15]; pt[16] = args.in[16]; pt[20] = args.out; }
        if (vcu < 192) p0_mod_unit(vcu, cvec, w_ada, b_ada, MOD, ldsf, tid, wave, lane);
        LAS float* scr = (LAS float*)(lds + wave * 16384);
        constexpr int I_IN = 16 * (NIN / 32), I_OUT = 16 * (DM / 32), I_GU = 16 * (NGU / 32), I_DN = (DFF / 64) * (DM / 32), I_L = I_IN + I_OUT + I_GU + I_DN;
        for (int it = gw; it < DEPTH * I_L; it += NGW) {
            const int l = it / I_L; int r = it % I_L;
            if (r < I_IN) { transpose_item<1>(w_in + (size_t)l * DM * INC, DM, INC, (bf16*)(ws + WS_WIN + l * WIN_BYTES), scr, NIN / 32, r, lane); continue; } r -= I_IN;
            if (r < I_OUT) { transpose_item<0>(w_out + (size_t)l * DM * DM, DM, DM, (bf16*)(ws + WS_WOUT + l * WOUT_BYTES), scr, DM / 32, r, lane); continue; } r -= I_OUT;
            if (r < I_GU) { transpose_item<2>(w_gate_up + (size_t)l * DM * NGU, DM, NGU, (bf16*)(ws + WS_WGU + l * WGU_BYTES), scr, NGU / 32, r, lane); continue; } r -= I_GU;
            transpose_item<0>(w_down + (size_t)l * DFF * DM, DFF, DM, (bf16*)(ws + WS_WDN + l * WDN_BYTES), scr, DM / 32, r, lane);
        }
        if (REP_P0) __syncthreads();
    }
    SEAM(0);
    for (int rep = 0; rep <= REP_PRE; ++rep)
    if (PHEN(11) && IN(1)) { PH_IDS();
        const float* n1g = norm1_g; const float* n2g = norm2_g;
        pre_rows(x_in, n1g, MOD, XN, (float*)(ws + WS_SSP), gw, NGW, lane);
        pre_avec(n1g, n2g, MOD, (float*)(ws + WS_AVEC), vcu * NTHREADS + tid, G * NTHREADS);
        for (int l = 0; l < DEPTH; ++l) {
            const float* m0 = MOD + (size_t)l * 2 * 6144; const float* m1 = m0 + 6144;
            pre_bias((const bf16*)(ws + WS_WIN + l * WIN_BYTES), NIN, m0, m1, (float*)(ws + WS_BIASIN) + (size_t)l * 2 * NIN, (float*)(ws + WS_BIASIN) + (size_t)l * 2 * NIN + NIN, gw, NGW, lane);
            pre_bias((const bf16*)(ws + WS_WGU + l * WGU_BYTES), NGU, m0 + 3072, m1 + 3072, (float*)(ws + WS_BIASGU) + (size_t)l * 2 * NGU, (float*)(ws + WS_BIASGU) + (size_t)l * 2 * NGU + NGU, gw, NGW, lane);
        }
    }
    SEAM(1);

    for (int l = 0; l < DEPTH; ++l) {
        const int pb = 2 + 8 * l;
        for (int rep = 0; rep <= REP_GIN; ++rep)
        if (PHEN(0) && IN(pb + 0)) { PH_IDS();
            pg8::Gemm g{XN, (const bf16*)(ws + WS_WIN + l * WIN_BYTES), MROWS, NIN, DM}; pg8::StaticOrder S; S.init(MROWS, NIN, G, bx);
            LAS float* rt = (LAS float*)(lds + ATT_TAB); LAS float* bt = rt + 512;
            const int pm0 = rstd_tables(S, (const float*)(ws + WS_SSP), rt, (const float*)(ws + WS_BIASIN) + (size_t)l * 2 * NIN, NIN, bt, tid);
            pg8::EpiProj E{PROJ, GATES, PLD, rt, pm0, bt};
            pg8::gemm_phase<pg8::EpiProj, pg8::StaticOrder, GIN_ALIGN, GIN_SP2>(lds, g, S, E, tid);
        }
        SEAM(pb + 0);
        if (PHEN(1) && IN(pb + 1)) { PH_IDS();
            for (int u = vcu; u < 524; u += G) {
                if (u < 12) post_foxcum_unit(u, GATES, FOXCUM, fox_f_bias + l * 6, ldsf, tid, wave, lane);
                else if (u < 268) post_qknorm_unit(u - 12, PROJ, KMEAN, fox_q_g + l * 64, fox_k_g + l * 64, moba_q_g + l * 64, moba_k_g + l * 64, ldsf, tid, wave, lane);
                else { const int which = (u - 268) & 1; post_conv_unit((u - 268) >> 1, which, PROJ, which ? KC : QC, ml_conv_w + l * 4 * 512, ml_conv_b + l * 512, tid); }
            }
            for (int rep = 0; rep < REP_CONV; ++rep) for (int u = vcu; u < 256; u += G) { const int which = u & 1; post_conv_unit(u >> 1, which, PROJ, which ? KC : QC, ml_conv_w + l * 4 * 512, ml_conv_b + l * 512, tid); }
            for (int rep = 0; rep < REP_FCUM; ++rep) for (int u = vcu; u < 12; u += G) post_foxcum_unit(u, GATES, FOXCUM, fox_f_bias + l * 6, ldsf, tid, wave, lane);
        }
        SEAM(pb + 1);
        if (PHEN(2) && IN(pb + 2)) { PH_IDS(); MK_MP();
            const float B2m = 8.f * LOG2E * wave_max(fabsf(moba_q_g[l * 64 + lane])) * wave_max(fabsf(moba_k_g[l * 64 + lane])) * 1.01f;
            unsigned* LCNT = (unsigned*)(ctl + CW_LCNT + l * 768); unsigned short* LIST = MOBA_MFMA ? (unsigned short*)(ws + WS_LIST) : nullptr;
#if ML_MFMA
#ifndef GATE_MFMA
#define GATE_MFMA 1
#endif
#if GATE_MFMA
            for (int u = vcu; u < 768; u += G) moba_gate_mfma(u, PROJ, KMEAN, SEL, LCNT, (unsigned*)(ws + WS_CTAB), LIST, B2m, THRESH2, lds, tid, wave, lane);
#else
            for (int u = vcu; u < 768; u += G) moba_gate_unit(u, PROJ, KMEAN, SEL, LCNT, (unsigned*)(ws + WS_CTAB), LIST, B2m, THRESH2, ldsf, tid);
#endif
            for (int u = gw; u < 2048; u += NGW) mlstm_m1_mfma(u, MP, lds, wave, lane);
            __syncthreads();
#else
            for (int u = vcu; u < 768 + 2048; u += G) {
                if (u < 768) moba_gate_unit(u, PROJ, KMEAN, SEL, LCNT, (unsigned*)(ws + WS_CTAB), LIST, B2m, THRESH2, ldsf, tid);
                else mlstm_m1(u - 768, MP, ldsf, tid, wave, lane);
            }
#endif
            for (int rep = 0; rep < REP_GATE; ++rep) for (int u = vcu; u < 768; u += G) moba_gate_unit(u, PROJ, KMEAN, SEL, LCNT, (unsigned*)(ws + WS_CTAB), nullptr, B2m, THRESH2, ldsf, tid);
            for (int rep = 0; rep < REP_GATE2; ++rep) for (int u = vcu; u < 768; u += G) moba_gate_unit(u, PROJ, KMEAN, SEL, LCNT + 4096, (unsigned*)(ws + WS_OPART + 32 * MiB), (unsigned short*)(ws + WS_OPART), B2m, THRESH2, ldsf, tid);
            for (int rep = 0; rep < REP_M1; ++rep) for (int u = vcu; u < 2048; u += G) mlstm_m1(u, MP, ldsf, tid, wave, lane);
#if FOX_MFMA
            { const float gq = wave_max(fabsf(fox_q_g[l * 64 + lane])), gk = wave_max(fabsf(fox_k_g[l * 64 + lane])); const float B2 = 8.f * LOG2E * gq * gk * 1.01f;
              for (int rep = 0; rep <= REP_FOX; ++rep)
              for (int u = vcu; u < 768; u += G) FOX_FN(u >> 6, 63 - (u & 63), PROJ, FOXCUM, Y, B2, lds, tid, wave, lane); }
#else
            fox_naive(PROJ, FOXCUM, Y, gw, NGW, lane);
#endif
        }
        SEAM(pb + 2);
        for (int rep = 0; rep <= REP_MIXB; ++rep)
        if (PHEN(3) && IN(pb + 3)) { PH_IDS(); MK_MP();
            for (int rep = 0; rep <= REP_M2; ++rep)
            for (int u = vcu; u < 64; u += G) mlstm_m2(u, MP, ldsf, tid, wave, lane);
#if MOBA_MFMA
            { const float gq = wave_max(fabsf(moba_q_g[l * 64 + lane])), gk = wave_max(fabsf(moba_k_g[l * 64 + lane])); const float B2 = 8.f * LOG2E * gq * gk * 1.01f;
              LAS int* pre = (LAS int*)(lds + ATT_TAB + 1024);
              const unsigned* lcnt = (const unsigned*)(ctl + CW_LCNT + l * 768);
              if (wave == 0) { int carry = 0;
                  for (int r = 0; r < 12; ++r) { const int p = r * 64 + lane; int x = (int)((lcnt[p] + 127u) >> 7);
#pragma unroll
                      for (int o = 1; o < 64; o <<= 1) { const int n = supi(x, o, lane); if (lane >= o) x += n; }
                      pre[p + 1] = carry + x; carry += shfi(x, 63); }
                  if (lane == 0) pre[0] = 0; }
              __syncthreads();
              const int S = pre[768];
              const unsigned short* LIST = (const unsigned short*)(ws + WS_LIST); bf16* OPART = (bf16*)(ws + WS_OPART); float* LPART = (float*)(ws + WS_LPART);
              #ifndef KSKIP_N
#define KSKIP_N 3
#endif
              constexpr int KSKIP = KSKIP_N; const int S2 = (S + 1) >> 1; const int NU = S2 + 384;
              for (int i = (vcu < 64 ? KSKIP : 0); ; ++i) {
                  const int u = (i < KSKIP) ? i * (G - 64) + (vcu - 64) : KSKIP * (G - 64) + (i - KSKIP) * G + vcu;
                  if (u >= NU) break;
                  if (u < S2) moba_sel_step(2 * u, S, pre, lcnt, PROJ, LIST, (const unsigned*)(ws + WS_CTAB), OPART, LPART, Y, B2, lds, tid, wave, lane);
                  else { const int p = u - S2; moba_own_pair(p >> 5, p & 31, 63 - (p & 31), PROJ, OPART, LPART, Y, B2, lds, tid, wave, lane); }
              } }
#else
            moba_naive(PROJ, SEL, Y, gw, NGW, lane);
#endif
        }
        SEAM(pb + 3);
        if (PHEN(4) && IN(pb + 4)) { PH_IDS(); MK_MP();
#if ML_MFMA
            for (int rep = 0; rep <= REP_M3; ++rep)
            for (int u = vcu; u < 512; u += G) mlstm_m3_mfma(u, MP, lds, tid, wave, lane);
#else
            for (int rep = 0; rep <= REP_M3; ++rep)
            for (int u = vcu; u < 2048; u += G) mlstm_m3(u, MP, ldsf, tid, wave, lane);
#endif
#if MOBA_MFMA
            for (int rep = 0; rep < REP_COMB; ++rep) moba_combine(SEL, (const bf16*)(ws + WS_OPART), (const float*)(ws + WS_LPART), Y, (bf16*)(ws + WS_U), 384, 0, vcu * NTHREADS + tid, G * NTHREADS);
            moba_combine(SEL, (const bf16*)(ws + WS_OPART), (const float*)(ws + WS_LPART), Y, Y, 1024, Y_MOBA, vcu * NTHREADS + tid, G * NTHREADS);
#endif
        }
        SEAM(pb + 4);
        if (PHEN(5) && IN(pb + 5)) { PH_IDS();
            pg8::Gemm g{Y, (const bf16*)(ws + WS_WOUT + l * WOUT_BYTES), MROWS, DM, DM}; pg8::StaticOrder S; S.init(MROWS, DM, G, bx);
            float* const xr = xres; const float* const xcur = (l == 0) ? x_in : (const float*)xr;
            pg8::EpiRes E{xcur, xr, mod_l + 2048, 6144, SEQ, XN, (const float*)(ws + WS_AVEC) + (size_t)((l * 2 + 1) * 2) * 1024, (float*)(ws + WS_SSP)};
            pg8::gemm_phase<pg8::EpiRes, pg8::StaticOrder, true, true>(lds, g, S, E, tid);
        }
        SEAM(pb + 5);
        for (int rep = 0; rep <= REP_GGU; ++rep)
        if (PHEN(6) && IN(pb + 6)) { PH_IDS();
            pg8::Gemm g{XN, (const bf16*)(ws + WS_WGU + l * WGU_BYTES), MROWS, NGU, DM}; pg8::StaticOrder S; S.init(MROWS, NGU, G, bx);
            LAS float* rt = (LAS float*)(lds + ATT_TAB); LAS float* bt = rt + 512;
            const int pm0 = rstd_tables(S, (const float*)(ws + WS_SSP), rt, (const float*)(ws + WS_BIASGU) + (size_t)l * 2 * NGU, NGU, bt, tid);
            pg8::EpiSwiglu E{HB, DFF, rt, pm0, bt};
            pg8::gemm_phase<pg8::EpiSwiglu, pg8::StaticOrder, GGU_ALIGN, GGU_SP2>(lds, g, S, E, tid);
        }
        SEAM(pb + 6);
        if (PHEN(7) && IN(pb + 7)) { PH_IDS();
            pg8::Gemm g{HB, (const bf16*)(ws + WS_WDN + l * WDN_BYTES), MROWS, DM, DFF}; pg8::StaticOrder S; S.init(MROWS, DM, G, bx);
            float* const xr = xres;
            pg8::EpiRes E{xr, xr, mod_l + 5120, 6144, SEQ, (l + 1 < DEPTH) ? XN : (bf16*)nullptr, (const float*)(ws + WS_AVEC) + (size_t)(((l + 1) * 2 + 0) * 2) * 1024, (float*)(ws + WS_SSP)};
            pg8::gemm_phase<pg8::EpiRes, pg8::StaticOrder, true, true>(lds, g, S, E, tid);
        }
        SEAM(pb + 7);
    }
#undef IN
#undef SEAM
}

extern "C" void kernel_launch(void* const* d_in, const int* in_sizes, int n_in, void* d_out, int out_size, void* d_ws, size_t ws_size, hipStream_t stream) {
    static int grid = 0;
    if (grid == 0) {
        if (n_in != 20 || in_sizes[0] != MROWS * DM || out_size != MROWS * DM || ws_size < WS_END) {
            fprintf(stderr, "kernel_launch: unexpected shapes: n_in %d in0 %d out %d ws %zu (need >= %zu)\n", n_in, n_in > 0 ? in_sizes[0] : -1, out_size, ws_size, (size_t)WS_END); grid = -1; return; }
        int dev = 0, cus = 0, per_cu = 0;
        if (hipGetDevice(&dev) != hipSuccess || hipDeviceGetAttribute(&cus, hipDeviceAttributeMultiprocessorCount, dev) != hipSuccess) { grid = -1; return; }
        if (hipFuncSetAttribute((const void*)fwd, hipFuncAttributeMaxDynamicSharedMemorySize, LDS_BYTES) != hipSuccess) { fprintf(stderr, "kernel_launch: hipFuncSetAttribute failed\n"); grid = -1; return; }
        if (hipOccupancyMaxActiveBlocksPerMultiprocessor(&per_cu, (const void*)fwd, NTHREADS, LDS_BYTES) != hipSuccess || per_cu < 1)
            fprintf(stderr, "kernel_launch: note: occupancy query reports %d workgroups per CU\n", per_cu);
        (void)hipGetLastError();
        grid = cus;
    }
    if (grid < 0) return;
    if (hipMemsetAsync((char*)d_ws + WS_CTL, 0, CTL_ZERO_BYTES, stream) != hipSuccess) return;
    Args a{};
    for (int i = 0; i < 20; ++i) a.in[i] = (const float*)d_in[i];
    a.out = (float*)d_out; a.ws = (unsigned char*)d_ws;
    if (N_LAUNCH_MODE == 1) { a.ph_lo = 0; a.ph_hi = NPHASE; hipLaunchKernelGGL(fwd, dim3(grid), dim3(NTHREADS), LDS_BYTES, stream, a); }
    else for (int p = 0; p < NPHASE; ++p) { a.ph_lo = p; a.ph_hi = p + 1; hipLaunchKernelGGL(fwd, dim3(grid), dim3(NTHREADS), LDS_BYTES, stream, a); }
}
```

```cpp
#include <hip/hip_runtime.h>
#include <cstdio>
#include <cstdint>

constexpr int DM = 1024, NBATCH = 2, SEQ = 16384, MROWS = NBATCH * SEQ, DEPTH = 2;
constexpr int HD = 64, FOXH = 6, MLH = 4, MOBH = 6;
constexpr int DFF = 2816, INC = 3342, NIN = 3584, PLD = 3328;
constexpr int NGU = 2 * DFF;
constexpr int C_FQ = 0, C_FK = 384, C_FV = 768, C_BQ = 1152, C_BK = 1536, C_BV = 1920, C_MQ = 2304, C_MK = 2560, C_MV = 2816, C_MO = 3072, C_G = 3328;
constexpr int Y_FOX = 0, Y_ML = 384, Y_MOBA = 640;
constexpr int MOBA_BS = 256, NBLK = SEQ / MOBA_BS;
constexpr int MLC = 64, NCHUNK = SEQ / MLC;
constexpr float LOG2E = 1.4426950408889634f;
constexpr float QSCALE = 0.125f * LOG2E;
constexpr float EPS = 1e-6f;

#define GAS __attribute__((address_space(1)))
#define LAS __attribute__((address_space(3)))
typedef unsigned short bf16;
typedef unsigned v4u __attribute__((ext_vector_type(4)));
typedef unsigned v2u __attribute__((ext_vector_type(2)));
typedef float f32x4 __attribute__((ext_vector_type(4)));
typedef short bf16x8 __attribute__((ext_vector_type(8)));
typedef float f32x16 __attribute__((ext_vector_type(16)));
typedef GAS unsigned gu32;
#define RLX_AGENT __ATOMIC_RELAXED, __HIP_MEMORY_SCOPE_AGENT
__device__ __forceinline__ unsigned f2bf(float f) { unsigned u = __builtin_bit_cast(unsigned, f); return (u + 0x7fffu + ((u >> 16) & 1u)) >> 16; }
__device__ __forceinline__ unsigned pk2(float lo, float hi) { return f2bf(lo) | (f2bf(hi) << 16); }
__device__ __forceinline__ float bf2f(unsigned short u) { return __builtin_bit_cast(float, (unsigned)u << 16); }
__device__ __forceinline__ float bflo(unsigned w) { return __builtin_bit_cast(float, w << 16); }
__device__ __forceinline__ float bfhi(unsigned w) { return __builtin_bit_cast(float, w & 0xffff0000u); }
#ifndef OLD_SHFL
#define OLD_SHFL 0
#endif
#ifndef OLD_SWZ
#define OLD_SWZ OLD_SHFL
#endif
#ifndef OLD_HALF
#define OLD_HALF OLD_SHFL
#endif
#ifndef OLD_SHF
#define OLD_SHF OLD_SHFL
#endif
#ifndef OLD_SUP
#define OLD_SUP OLD_SHFL
#endif
#if OLD_SWZ
#define SWZ_X(v, o) __shfl_xor((float)(v), (o))
#else
#define SWZ_X(v, o) __builtin_bit_cast(float, __builtin_amdgcn_ds_swizzle(__builtin_bit_cast(int, (float)(v)), ((o) << 10) | 0x1f))
#endif
__device__ __forceinline__ float half_sum(float v, int lane) { return v + __builtin_bit_cast(float, __builtin_amdgcn_ds_bpermute((lane ^ 32) << 2, __builtin_bit_cast(int, v))); }
#if OLD_SHF
__device__ __forceinline__ float shf(float v, int src) { return __shfl(v, src); }
__device__ __forceinline__ int shfi(int v, int src) { return __shfl(v, src); }
#else
__device__ __forceinline__ float shf(float v, int src) { return __builtin_bit_cast(float, __builtin_amdgcn_ds_bpermute(src << 2, __builtin_bit_cast(int, v))); }
__device__ __forceinline__ int shfi(int v, int src) { return __builtin_amdgcn_ds_bpermute(src << 2, v); }
#endif
#if OLD_SUP
__device__ __forceinline__ float sup(float v, int o, int lane) { return __shfl_up(v, o); }
__device__ __forceinline__ int supi(int v, int o, int lane) { return __shfl_up(v, o); }
#else
__device__ __forceinline__ float sup(float v, int o, int lane) { return shf(v, lane >= o ? lane - o : lane); }
__device__ __forceinline__ int supi(int v, int o, int lane) { return shfi(v, lane >= o ? lane - o : lane); }
#endif
__device__ __forceinline__ float wave_sum(float v) { v += SWZ_X(v, 1); v += SWZ_X(v, 2); v += SWZ_X(v, 4); v += SWZ_X(v, 8); v += SWZ_X(v, 16);
    return __builtin_bit_cast(float, __builtin_amdgcn_readlane(__builtin_bit_cast(int, v), 0)) + __builtin_bit_cast(float, __builtin_amdgcn_readlane(__builtin_bit_cast(int, v), 32)); }
__device__ __forceinline__ float wave_max(float v) { v = fmaxf(v, SWZ_X(v, 1)); v = fmaxf(v, SWZ_X(v, 2)); v = fmaxf(v, SWZ_X(v, 4)); v = fmaxf(v, SWZ_X(v, 8)); v = fmaxf(v, SWZ_X(v, 16));
    return fmaxf(__builtin_bit_cast(float, __builtin_amdgcn_readlane(__builtin_bit_cast(int, v), 0)), __builtin_bit_cast(float, __builtin_amdgcn_readlane(__builtin_bit_cast(int, v), 32))); }
__device__ __forceinline__ float log_sigmoid_f(float x) { return fminf(x, 0.f) - log1pf(expf(-fabsf(x))); }
__device__ __forceinline__ float sigmoid_f(float x) { return 1.f / (1.f + expf(-x)); }

constexpr size_t MiB = 1u << 20;
constexpr size_t WS_CTL = 0, CTL_ZERO_BYTES = 1 * MiB;
constexpr size_t WS_MOD = 1 * MiB;
constexpr size_t WS_KMEAN = WS_MOD + 128 * 1024;
constexpr size_t WS_MLS = WS_KMEAN + 512 * 1024;
constexpr size_t WS_BEND = WS_MLS, WS_MLOC = WS_MLS + 8192, WS_MS = WS_MLS + 16384, WS_NU = WS_MLS + 32768, WS_NS = WS_NU + 2048 * 64 * 4;
constexpr size_t WS_CTAB = 3 * MiB;
constexpr size_t WS_PTAB = WS_CTAB + 256 * 1024;
static_assert(WS_NS + 2048 * 64 * 4 <= WS_CTAB && WS_CTAB + 12 * 64 * 64 * 4 <= WS_PTAB && WS_PTAB + 256 <= 4 * MiB, "small region");
constexpr size_t WS_WIN = 4 * MiB, WIN_BYTES = (size_t)NIN * DM * 2;
constexpr size_t WS_WOUT = WS_WIN + 2 * WIN_BYTES, WOUT_BYTES = (size_t)DM * DM * 2;
constexpr size_t WS_WGU = WS_WOUT + 2 * WOUT_BYTES, WGU_BYTES = (size_t)NGU * DM * 2;
constexpr size_t WS_WDN = WS_WGU + 2 * WGU_BYTES, WDN_BYTES = (size_t)DM * DFF * 2;
static_assert(WS_WDN + 2 * WDN_BYTES <= 56 * MiB, "weights");
constexpr size_t WS_SSP = 56 * MiB;
constexpr size_t WS_AVEC = 58 * MiB;
constexpr size_t WS_BIASIN = WS_AVEC + 64 * 1024;
constexpr size_t WS_BIASGU = WS_BIASIN + 64 * 1024;
static_assert(WS_BIASGU + 2 * 2 * NGU * 4 <= 64 * MiB && 2 * 2 * NIN * 4 <= 64 * 1024, "fused-norm vectors");
constexpr size_t WS_XN = 64 * MiB;
constexpr size_t WS_U = 64 * MiB;
constexpr size_t WS_CS = 96 * MiB;
constexpr size_t WS_LIST = 112 * MiB;
constexpr size_t WS_PROJ = 128 * MiB;
constexpr size_t WS_H = 128 * MiB;
constexpr size_t WS_Y = 336 * MiB;
constexpr size_t WS_QC = 400 * MiB, WS_KC = 416 * MiB;
constexpr size_t WS_OPART = 432 * MiB;
constexpr size_t WS_LPART = 504 * MiB;
constexpr size_t WS_GATES = 507 * MiB;
constexpr size_t WS_FOXCUM = 509 * MiB;
constexpr size_t WS_SEL = 510 * MiB;
constexpr size_t WS_END = 512 * MiB;
static_assert(WS_PROJ + (size_t)MROWS * PLD * 2 <= WS_Y && WS_SEL + (size_t)MROWS * 6 * 4 <= WS_END, "ws map");
constexpr int CW_BAR = 4096;
constexpr int CW_QUEUE = 16384;
constexpr int CW_LCNT = 32768;

constexpr int RING_BYTES = 131072, LDSCTL_OFF = RING_BYTES, MISC_OFF = LDSCTL_OFF + 320, LDS_BYTES = 147456;
constexpr int NWAVES = 8, NTHREADS = 512;
namespace pg8 {
#define PG8_LAS __attribute__((address_space(3)))
typedef unsigned short bf16_t;
typedef short bf16x8 __attribute__((ext_vector_type(8)));
typedef float f32x4 __attribute__((ext_vector_type(4)));
typedef unsigned u32x4 __attribute__((ext_vector_type(4)));
constexpr int BM = 256, BK = 64, HALF = 128, HTB = HALF * BK * 2  , STAGE_BYTES = 8 * HTB, NXCD = 8, WGM = 8;

__host__ __device__ __forceinline__ int lds_byte(int r, int c) { const int st = (r >> 4) * 2 + (c >> 5), rr = r & 15, cc = c & 31, ob = rr * 64 + cc * 2; return st * 1024 + (ob ^ (((ob >> 9) & 1) << 5)); }
__host__ __device__ __forceinline__ void stage_rc(int b, int& R, int& C) { const int st = b / 1024, sb = b % 1024, swz = sb ^ (((sb >> 9) & 1) << 5); R = (st >> 1) * 16 + swz / 64; C = (st & 1) * 32 + (swz % 64) / 2; }
__host__ __device__ __forceinline__ int perm32(int rho) { const int n = rho >> 4, i = rho & 15; return 8 * (i >> 2) + 4 * n + (i & 3); }

struct Unit { int pm, pn, ord; };
struct Gemm { const bf16_t* A; const bf16_t* Bt; int M, N, K; };

struct StaticOrder {
    int nM, nN, nwg, G, c;
    __host__ __device__ void init(int M, int N, int G_, int c_) { nM = M / BM; nN = N / BM; nwg = nM * nN; G = G_; c = c_; }
    __host__ __device__ bool next(int i, Unit& u) const {
        const long L = (long)i * G + c; if (L >= nwg) return false;
        int wgid = (int)L; { const int q = nwg / NXCD, r = nwg % NXCD, xcd = wgid % NXCD, off = wgid / NXCD; wgid = (xcd < r ? xcd * (q + 1) : r * (q + 1) + (xcd - r) * q) + off; }
        const int nig = WGM * nN, gid = wgid / nig, fm = gid * WGM, gsz = (nM - fm) < WGM ? (nM - fm) : WGM;
        u.pm = fm + ((wgid % nig) % gsz); u.pn = (wgid % nig) / gsz; u.ord = i; return true;
    }
    __device__ __forceinline__ void a_ready(const Unit&) const {}
    __device__ __forceinline__ void done(const Unit&) const {}
};

__device__ __forceinline__ unsigned cvt_pk_bf16(float lo, float hi) { unsigned r; asm volatile("v_cvt_pk_bf16_f32 %0, %1, %2" : "=v"(r) : "v"(lo), "v"(hi)); return r; }
typedef float f32x2 __attribute__((ext_vector_type(2)));
typedef unsigned u32x2 __attribute__((ext_vector_type(2)));
struct EpiProj {
    static constexpr bool PERM = true, AFTER_DRAIN = false;
    bf16_t* P; float* G; int pld; PG8_LAS const float* rt; int pm0; PG8_LAS const float* bt;
    __device__ __forceinline__ void operator()(const f32x4 (&acc)[2][2][4][2], const Unit& u, int wr, int wc, int fr, int fq) const {
        const int row0 = u.pm * BM + wr * 64 + fr;
        PG8_LAS const float* rs = rt + (u.pm == pm0 ? 0 : 256) + wr * 64 + fr;
        PG8_LAS const float* bb = bt + u.ord * 256 + wc * 32 + 8 * fq;
        if (u.pn < 13) {
            const int col0 = u.pn * BM + wc * 32 + 8 * fq;
            f32x4 bv[2][2];
#pragma unroll
            for (int bj = 0; bj < 2; ++bj)
#pragma unroll
                for (int n = 0; n < 2; ++n) bv[bj][n] = *(PG8_LAS const f32x4*)(bb + bj * HALF + 4 * n);
            float rsv[2][4];
#pragma unroll
            for (int ai = 0; ai < 2; ++ai)
#pragma unroll
                for (int m = 0; m < 4; ++m) rsv[ai][m] = rs[ai * HALF + m * 16];
#pragma unroll
            for (int ai = 0; ai < 2; ++ai)
#pragma unroll
                for (int m = 0; m < 4; ++m) { bf16_t* rowp = P + (size_t)(row0 + ai * HALF + m * 16) * pld + col0; const float rstd = rsv[ai][m];
#pragma unroll
                    for (int bj = 0; bj < 2; ++bj) { const f32x4 v0 = acc[ai][bj][m][0] * rstd + bv[bj][0], v1 = acc[ai][bj][m][1] * rstd + bv[bj][1];
                        u32x4 w; w.x = cvt_pk_bf16(v0[0], v0[1]); w.y = cvt_pk_bf16(v0[2], v0[3]); w.z = cvt_pk_bf16(v1[0], v1[1]); w.w = cvt_pk_bf16(v1[2], v1[3]);
                        *(u32x4*)(rowp + bj * HALF) = w; } }
        } else {
            if (wc == 0 && fq < 2) {
                const f32x4 b0 = *(PG8_LAS const f32x4*)(bb), b1 = *(PG8_LAS const f32x4*)(bb + 4);
#pragma unroll
                for (int ai = 0; ai < 2; ++ai)
#pragma unroll
                    for (int m = 0; m < 4; ++m) { float* gp = G + (size_t)(row0 + ai * HALF + m * 16) * 16 + 8 * fq; const float rstd = rs[ai * HALF + m * 16];
                        *(f32x4*)(gp) = acc[ai][0][m][0] * rstd + b0; *(f32x4*)(gp + 4) = acc[ai][0][m][1] * rstd + b1; }
            }
        }
    }
};
struct EpiRes {
    static constexpr bool PERM = true, AFTER_DRAIN = false;
    const float* base; float* out; const float* gate; int gate_bstride; int rows_per_batch; bf16_t* xa; const float* avec; float* ssp;
    __device__ __forceinline__ void operator()(const f32x4 (&acc)[2][2][4][2], const Unit& u, int wr, int wc, int fr, int fq) const {
        const int row0 = u.pm * BM + wr * 64 + fr, col0 = u.pn * BM + wc * 32 + 8 * fq;
        const int bat = (u.pm * BM) / rows_per_batch;
        const float* gb = gate + (size_t)bat * gate_bstride;
        f32x4 gv[2][2], av[2][2];
#pragma unroll
        for (int bj = 0; bj < 2; ++bj)
#pragma unroll
            for (int n = 0; n < 2; ++n) { gv[bj][n] = *(const f32x4*)(gb + col0 + bj * HALF + 4 * n); av[bj][n] = xa ? *(const f32x4*)(avec + (size_t)bat * 1024 + col0 + bj * HALF + 4 * n) : (f32x4){0.f, 0.f, 0.f, 0.f}; }
        const int lane = fq * 16 + fr;
#pragma unroll
        for (int ai = 0; ai < 2; ++ai)
#pragma unroll
            for (int m = 0; m < 4; ++m) { const size_t off = (size_t)(row0 + ai * HALF + m * 16) * 1024 + col0; float ss = 0.f;
#pragma unroll
                for (int bj = 0; bj < 2; ++bj) {
                    const f32x4 o0 = *(const f32x4*)(base + off + bj * HALF) + gv[bj][0] * acc[ai][bj][m][0], o1 = *(const f32x4*)(base + off + bj * HALF + 4) + gv[bj][1] * acc[ai][bj][m][1];
                    __builtin_nontemporal_store(o0, (f32x4*)(out + off + bj * HALF)); __builtin_nontemporal_store(o1, (f32x4*)(out + off + bj * HALF + 4));
                    if (xa) { ss += ((o0[0] * o0[0] + o0[1] * o0[1]) + (o0[2] * o0[2] + o0[3] * o0[3])) + ((o1[0] * o1[0] + o1[1] * o1[1]) + (o1[2] * o1[2] + o1[3] * o1[3]));
                        const f32x4 t0 = o0 * av[bj][0], t1 = o1 * av[bj][1];
                        u32x4 w; w.x = cvt_pk_bf16(t0[0], t0[1]); w.y = cvt_pk_bf16(t0[2], t0[3]); w.z = cvt_pk_bf16(t1[0], t1[1]); w.w = cvt_pk_bf16(t1[2], t1[3]);
#ifdef XA_NT
                        __builtin_nontemporal_store(w, (u32x4*)(xa + off + bj * HALF)); } }
#else
                        *(u32x4*)(xa + off + bj * HALF) = w; } }
#endif
                if (xa) { ss += SWZ_X(ss, 16); ss += __builtin_bit_cast(float, __builtin_amdgcn_ds_bpermute((lane ^ 32) << 2, __builtin_bit_cast(int, ss)));
                    if (fq == 0) ssp[(size_t)(row0 + ai * HALF + m * 16) * 16 + u.pn * 4 + wc] = ss; } }
    }
};
struct EpiSwiglu {
    static constexpr bool PERM = true, AFTER_DRAIN = false;
    bf16_t* Hh; int ldh; PG8_LAS const float* rt; int pm0; PG8_LAS const float* bt;
    __device__ __forceinline__ void operator()(const f32x4 (&acc)[2][2][4][2], const Unit& u, int wr, int wc, int fr, int fq) const {
        const int row0 = u.pm * BM + wr * 64 + fr, col0 = u.pn * HALF + wc * 32 + 8 * fq;
        PG8_LAS const float* rs = rt + (u.pm == pm0 ? 0 : 256) + wr * 64 + fr;
        PG8_LAS const float* bb = bt + u.ord * 256 + wc * 32 + 8 * fq;
        f32x4 bv[2][2];
#pragma unroll
        for (int bj = 0; bj < 2; ++bj)
#pragma unroll
            for (int n = 0; n < 2; ++n) bv[bj][n] = *(PG8_LAS const f32x4*)(bb + bj * HALF + 4 * n);
        float rsv[2][4];
#pragma unroll
        for (int ai = 0; ai < 2; ++ai)
#pragma unroll
            for (int m = 0; m < 4; ++m) rsv[ai][m] = rs[ai * HALF + m * 16];
#pragma unroll
        for (int ai = 0; ai < 2; ++ai)
#pragma unroll
            for (int m = 0; m < 4; ++m) { bf16_t* rowp = Hh + (size_t)(row0 + ai * HALF + m * 16) * ldh + col0; const float rstd = rsv[ai][m];
                float hv[8];
#pragma unroll
                for (int n = 0; n < 2; ++n)
#pragma unroll
                    for (int i = 0; i < 4; ++i) { const float g = acc[ai][0][m][n][i] * rstd + bv[0][n][i], up = acc[ai][1][m][n][i] * rstd + bv[1][n][i];
                        const float e = __builtin_amdgcn_exp2f(-g * 1.4426950408889634f);
                        hv[n * 4 + i] = g * __builtin_amdgcn_rcpf(1.0f + e) * up; }
                u32x4 w; w.x = cvt_pk_bf16(hv[0], hv[1]); w.y = cvt_pk_bf16(hv[2], hv[3]); w.z = cvt_pk_bf16(hv[4], hv[5]); w.w = cvt_pk_bf16(hv[6], hv[7]);
                __builtin_nontemporal_store(w, (u32x4*)(rowp)); }
    }
};
template <class Epi, class Sched, bool ALIGN_EPI = false, bool SP2 = false>
__device__ __forceinline__ void gemm_phase(PG8_LAS unsigned char* lds, const Gemm g, const Sched& S, const Epi& E, const int tid_in) {
    const int tid = tid_in, wid = __builtin_amdgcn_readfirstlane(tid >> 6), lane = tid & 63, wr = wid >> 2, wc = wid & 3, fr = lane & 15, fq = lane >> 4;
    const int K = g.K, nt = K / BK;
    unsigned voffA[2], voffB[2];
#pragma unroll
    for (int i = 0; i < 2; ++i) { int R, C; stage_rc(tid * 16 + i * 8192, R, C); const int Rb = Epi::PERM ? ((R & ~31) + perm32(R & 31)) : R;
        voffA[i] = (unsigned)(R * K + C) * 2u; voffB[i] = (unsigned)(Rb * K + C) * 2u; }
    const size_t kstep = (size_t)(BK * 2);
    const size_t hstep = (size_t)HALF * K * 2;
    const size_t tstep = 2 * hstep;
    const unsigned ldsw = (unsigned)wid * 1024u;
    const int aoff = lds_byte(wr * 64 + fr, fq * 8), boff = lds_byte(wc * 32 + fr, fq * 8);
#define PG8_SA(b, h) (((b) * 2 + (h)) * HTB)
#define PG8_SB(b, h) ((4 + (b) * 2 + (h)) * HTB)
#define PG8_STAGE(bufoff, gbase, voff) do { _Pragma("unroll") for (int _i = 0; _i < 2; ++_i) \
        __builtin_amdgcn_global_load_lds((const unsigned*)((const char*)(gbase) + (voff)[_i]), (PG8_LAS unsigned*)(lds + (bufoff) + ldsw + _i * 8192), 16, 0, 0); } while (0)
#define PG8_LDA(dst, b, h) do { _Pragma("unroll") for (int m = 0; m < 4; ++m) _Pragma("unroll") for (int k = 0; k < 2; ++k) dst[m][k] = *(const PG8_LAS bf16x8*)(lds + PG8_SA(b, h) + aoff + m * 2048 + k * 1024); } while (0)
#define PG8_LDB(dst, b, h) do { _Pragma("unroll") for (int n = 0; n < 2; ++n) _Pragma("unroll") for (int k = 0; k < 2; ++k) dst[n][k] = *(const PG8_LAS bf16x8*)(lds + PG8_SB(b, h) + boff + n * 2048 + k * 1024); } while (0)
#define PG8_MMA(ai, bj, At, Bt) do { __builtin_amdgcn_s_setprio(1); _Pragma("unroll") for (int m = 0; m < 4; ++m) _Pragma("unroll") for (int n = 0; n < 2; ++n) _Pragma("unroll") for (int k = 0; k < 2; ++k) \
        acc[ai][bj][m][n] = __builtin_amdgcn_mfma_f32_16x16x32_bf16(Bt[n][k], At[m][k], acc[ai][bj][m][n], 0, 0, 0); __builtin_amdgcn_s_setprio(0); } while (0)
#define PG8_WAIT_V(n) asm volatile("s_waitcnt vmcnt(" #n ")" ::: "memory")
#define PG8_WAIT_L(n) asm volatile("s_waitcnt lgkmcnt(" #n ")" ::: "memory")
#define PG8_BAR __builtin_amdgcn_s_barrier()
#define PG8_SCHED __builtin_amdgcn_sched_barrier(0)
    Unit cur, nxt; int ui = 0;
    if (!S.next(0, cur)) return;
    f32x4 acc[2][2][4][2];
#pragma unroll
    for (int a = 0; a < 2; ++a)
#pragma unroll
        for (int b = 0; b < 2; ++b)
#pragma unroll
            for (int m = 0; m < 4; ++m)
#pragma unroll
                for (int n = 0; n < 2; ++n) acc[a][b][m][n] = (f32x4){0.f, 0.f, 0.f, 0.f};
    bf16x8 At[4][2], B0[2][2], B1[2][2];
    const char* cA = (const char*)g.A + (size_t)cur.pm * tstep; const char* cB = (const char*)g.Bt + (size_t)cur.pn * tstep;
    S.a_ready(cur);
    if constexpr (SP2) {
        PG8_STAGE(PG8_SB(0, 0), cB, voffB); PG8_STAGE(PG8_SB(0, 1), cB + hstep, voffB); PG8_STAGE(PG8_SA(0, 0), cA, voffA); PG8_STAGE(PG8_SA(0, 1), cA + hstep, voffA);
        if (wr == 1) PG8_BAR;
        PG8_WAIT_V(2); PG8_BAR;
        PG8_STAGE(PG8_SB(1, 0), cB + kstep, voffB); PG8_STAGE(PG8_SA(1, 0), cA + kstep, voffA); PG8_STAGE(PG8_SB(1, 1), cB + hstep + kstep, voffB);
        PG8_WAIT_V(6); PG8_BAR;
    } else {
        PG8_STAGE(PG8_SB(0, 0), cB, voffB); PG8_STAGE(PG8_SA(0, 0), cA, voffA); PG8_STAGE(PG8_SB(0, 1), cB + hstep, voffB); PG8_STAGE(PG8_SA(0, 1), cA + hstep, voffA);
        if (wr == 1) PG8_BAR;
        PG8_WAIT_V(4); PG8_BAR;
        PG8_STAGE(PG8_SB(1, 0), cB + kstep, voffB); PG8_STAGE(PG8_SA(1, 0), cA + kstep, voffA); PG8_STAGE(PG8_SB(1, 1), cB + hstep + kstep, voffB);
        PG8_WAIT_V(6); PG8_BAR;
    }
    for (;;) {
        const bool has_next = S.next(ui + 1, nxt);
        const char* nA = has_next ? (const char*)g.A + (size_t)nxt.pm * tstep : cA; const char* nB = has_next ? (const char*)g.Bt + (size_t)nxt.pn * tstep : cB;
        for (int t = 0; t < nt; t += 2) {
            const bool last = (t == nt - 2);
            const char* a1 = cA + (size_t)(t + 1) * kstep;
            const char* a2 = last ? nA : cA + (size_t)(t + 2) * kstep; const char* b2 = last ? nB : cB + (size_t)(t + 2) * kstep;
            const char* a3 = a2 + kstep; const char* b3 = b2 + kstep;
            if (last && has_next) S.a_ready(nxt);
            if constexpr (SP2) {
            PG8_LDB(B0, 0, 0); PG8_LDB(B1, 0, 1); PG8_SCHED; PG8_LDA(At, 0, 0); PG8_STAGE(PG8_SA(1, 1), a1 + hstep, voffA);
            PG8_WAIT_V(8); PG8_WAIT_L(0); PG8_BAR; PG8_MMA(0, 0, At, B0); PG8_MMA(0, 1, At, B1); PG8_BAR; PG8_SCHED;
            PG8_LDA(At, 0, 1); PG8_STAGE(PG8_SB(0, 0), b2, voffB); PG8_STAGE(PG8_SB(0, 1), b2 + hstep, voffB); PG8_STAGE(PG8_SA(0, 0), a2, voffA);
            PG8_WAIT_V(8); PG8_WAIT_L(0); PG8_BAR; PG8_MMA(1, 0, At, B0); PG8_MMA(1, 1, At, B1); PG8_BAR; PG8_SCHED;
            PG8_LDB(B0, 1, 0); PG8_LDB(B1, 1, 1); PG8_SCHED; PG8_LDA(At, 1, 0); PG8_STAGE(PG8_SA(0, 1), a2 + hstep, voffA);
            PG8_WAIT_V(8); PG8_WAIT_L(0); PG8_BAR; PG8_MMA(0, 0, At, B0); PG8_MMA(0, 1, At, B1); PG8_BAR; PG8_SCHED;
            PG8_LDA(At, 1, 1); PG8_STAGE(PG8_SB(1, 0), b3, voffB); PG8_STAGE(PG8_SB(1, 1), b3 + hstep, voffB); PG8_STAGE(PG8_SA(1, 0), a3, voffA);
            PG8_WAIT_V(8); PG8_WAIT_L(0); PG8_BAR; PG8_MMA(1, 0, At, B0); PG8_MMA(1, 1, At, B1); PG8_BAR; PG8_SCHED;
            } else {
            PG8_LDB(B0, 0, 0); PG8_SCHED; PG8_LDA(At, 0, 0); PG8_STAGE(PG8_SA(1, 1), a1 + hstep, voffA);
            PG8_WAIT_L(8); PG8_BAR; PG8_WAIT_L(0); PG8_MMA(0, 0, At, B0); PG8_BAR; PG8_SCHED;
            PG8_LDB(B1, 0, 1); PG8_STAGE(PG8_SB(0, 0), b2, voffB);
            PG8_BAR; PG8_WAIT_L(0); PG8_MMA(0, 1, At, B1); PG8_BAR;
            PG8_LDA(At, 0, 1); PG8_STAGE(PG8_SA(0, 0), a2, voffA);
            PG8_BAR; PG8_WAIT_L(0); PG8_MMA(1, 0, At, B0); PG8_BAR; PG8_SCHED;
            PG8_STAGE(PG8_SB(0, 1), b2 + hstep, voffB);
            PG8_WAIT_V(6); PG8_BAR; PG8_MMA(1, 1, At, B1); PG8_BAR;
            PG8_LDB(B0, 1, 0); PG8_SCHED; PG8_LDA(At, 1, 0); PG8_STAGE(PG8_SA(0, 1), a2 + hstep, voffA);
            PG8_WAIT_L(8); PG8_BAR; PG8_WAIT_L(0); PG8_MMA(0, 0, At, B0); PG8_BAR; PG8_SCHED;
            PG8_LDB(B1, 1, 1); PG8_STAGE(PG8_SB(1, 0), b3, voffB);
            PG8_BAR; PG8_WAIT_L(0); PG8_MMA(0, 1, At, B1); PG8_BAR;
            PG8_LDA(At, 1, 1); PG8_STAGE(PG8_SA(1, 0), a3, voffA);
            PG8_BAR; PG8_WAIT_L(0); PG8_MMA(1, 0, At, B0); PG8_BAR; PG8_SCHED;
            PG8_STAGE(PG8_SB(1, 1), b3 + hstep, voffB);
            PG8_WAIT_V(6); PG8_BAR; PG8_MMA(1, 1, At, B1); PG8_BAR;
            }
        }
        if constexpr (ALIGN_EPI) { if (wr == 0) PG8_BAR; }
        if constexpr (!Epi::AFTER_DRAIN) { E(acc, cur, wr, wc, fr, fq); S.done(cur); }
        if (!has_next) break;
#pragma unroll
        for (int a = 0; a < 2; ++a)
#pragma unroll
            for (int b = 0; b < 2; ++b)
#pragma unroll
                for (int m = 0; m < 4; ++m)
#pragma unroll
                    for (int n = 0; n < 2; ++n) acc[a][b][m][n] = (f32x4){0.f, 0.f, 0.f, 0.f};
        cur = nxt; cA = nA; cB = nB; ++ui;
        if constexpr (ALIGN_EPI) { if (wr == 1) PG8_BAR; }
    }
    PG8_WAIT_V(0);
    if constexpr (!ALIGN_EPI) { if (wr == 0) PG8_BAR; }
    PG8_BAR;
    if constexpr (Epi::AFTER_DRAIN) { E.fused(acc, cur, wr, wc, fr, fq, lds, wid, lane); S.done(cur); }
#undef PG8_SA
#undef PG8_SB
#undef PG8_STAGE
#undef PG8_LDA
#undef PG8_LDB
#undef PG8_MMA
#undef PG8_WAIT_V
#undef PG8_WAIT_L
#undef PG8_BAR
#undef PG8_SCHED
}
}
#define XB_TMO      128
#define XB_XCNT(j)  (256  + 64 * (j))
#define XB_XSUB(j)  (1280 + 64 * (j))
#define XB_XGEN(j)  (2304 + 64 * (j))
#define XB_TOP      3328
#define XB_TOPGEN   3392
#define XCD_BAR_WORDS 3456
#define XB_SPIN_CAP (1u << 18)

__device__ __forceinline__ unsigned xb_ld(unsigned* p)              { return __hip_atomic_load(p, __ATOMIC_RELAXED, __HIP_MEMORY_SCOPE_AGENT); }
__device__ __forceinline__ unsigned xb_add(unsigned* p, unsigned v) { return __hip_atomic_fetch_add(p, v, __ATOMIC_RELAXED, __HIP_MEMORY_SCOPE_AGENT); }
__device__ __forceinline__ unsigned xb_xcc_id() { return (unsigned)__builtin_amdgcn_s_getreg((3 << 11) | 20) & 0xFu; }
#define XB_SPIN(cond, bar) do { unsigned _sp = 0; while (cond) { __builtin_amdgcn_s_sleep(1); \
    if ((++_sp & 255u) == 0u) { if (xb_ld(&(bar)[XB_TMO])) break; if (_sp > XB_SPIN_CAP) { atomicAdd(&(bar)[XB_TMO], 1u); break; } } } } while (0)

struct XcdBarrier {
    unsigned* bar; unsigned x;
    volatile LAS unsigned* st;
};

__device__ __forceinline__ XcdBarrier xcd_barrier_post(unsigned* bar, volatile LAS unsigned* st) {
    XcdBarrier b; b.bar = bar; b.x = xb_xcc_id(); b.st = st;
    if (threadIdx.x == 0) (void)xb_add(&bar[XB_XCNT(b.x)], 1u);
    return b;
}
__device__ __forceinline__ void xcd_barrier_complete(unsigned* bar, unsigned x, unsigned& nloc, unsigned& nx) {
    const unsigned G = gridDim.x * gridDim.y * gridDim.z;
    unsigned sum, cnt, mine, sp = 0u;
    for (;;) {
        sum = 0u; cnt = 0u; mine = 0u;
#pragma unroll
        for (unsigned j = 0; j < 16; ++j) { const unsigned c = xb_ld(&bar[XB_XCNT(j)]); sum += c; cnt += (c > 0u) ? 1u : 0u; mine = (j == x) ? c : mine; }
        if (sum == G) break;
        __builtin_amdgcn_s_sleep(1);
        if ((++sp & 255u) == 0u) { if (xb_ld(&bar[XB_TMO])) break; if (sp > XB_SPIN_CAP) { atomicAdd(&bar[XB_TMO], 1u); break; } }
    }
    nloc = mine > 0u ? mine : 1u; nx = cnt > 0u ? cnt : 1u;
}

__device__ __forceinline__ void xcd_barrier(const XcdBarrier& b) {
    asm volatile("s_waitcnt vmcnt(0)" ::: "memory");
    __syncthreads();
    if (threadIdx.x == 0) {
        unsigned* bar = b.bar; asm volatile("" : "+s"(bar));
        const unsigned bx_ = xb_xcc_id();
        __builtin_amdgcn_s_waitcnt(0);
        unsigned nloc = b.st[0], nx = b.st[1];
        if (nloc == 0u) { xcd_barrier_complete(bar, bx_, nloc, nx); b.st[0] = nloc; b.st[1] = nx; }
        const unsigned old = xb_add(&bar[XB_XSUB(bx_)], 1u);
        const unsigned gen = old / nloc;
        if (old + 1u == (gen + 1u) * nloc) {
            __builtin_amdgcn_fence(__ATOMIC_RELEASE, "agent");
            asm volatile("s_waitcnt vmcnt(0)" ::: "memory");
            const unsigned og = xb_add(&bar[XB_TOP], 1u);
            const unsigned tg = og / nx;
            if (og + 1u == (tg + 1u) * nx) xb_add(&bar[XB_TOPGEN], 1u);
            else XB_SPIN(xb_ld(&bar[XB_TOPGEN]) == tg, bar);
            __builtin_amdgcn_fence(__ATOMIC_ACQUIRE, "agent");
            xb_add(&bar[XB_XGEN(bx_)], 1u);
            asm volatile("s_waitcnt vmcnt(0)" ::: "memory");
        } else {
            XB_SPIN(xb_ld(&bar[XB_XGEN(bx_)]) == gen, bar);
            __builtin_amdgcn_fence(__ATOMIC_ACQUIRE, "agent");
            asm volatile("s_waitcnt vmcnt(0)" ::: "memory");
        }
    }
    __syncthreads();
}
#define LDS_WAIT() asm volatile("s_waitcnt lgkmcnt(0)" ::: "memory")
__device__ __forceinline__ void unpack8(const v4u w, float* f) { f[0] = bflo(w.x); f[1] = bfhi(w.x); f[2] = bflo(w.y); f[3] = bfhi(w.y); f[4] = bflo(w.z); f[5] = bfhi(w.z); f[6] = bflo(w.w); f[7] = bfhi(w.w); }

__device__ __forceinline__ int win_src(int c) {
    if (c < 1152) return c;
    if (c < 2304) return c + 1038;
    if (c < 3072) return c - 1146;
    if (c < 3328) return c - 1138;
    if (c < 3334) return c - 3328 + 1152;
    if (c < 3338) return c - 3334 + 1926;
    if (c < 3342) return c - 3338 + 1930;
    return -1;
}
__device__ __forceinline__ int wgu_src(int r) { const int pn = r >> 8, w = r & 255; return (w < 128 ? 0 : DFF) + pn * 128 + (w & 127); }
template <int MODE> __device__ __forceinline__ int src_col(int r) { if (MODE == 1) return win_src(r); if (MODE == 2) return wgu_src(r); return r; }

template <int MODE> __device__ __forceinline__ void transpose_item(const float* W, int K, int ldw, bf16* WT, LAS float* scr, int nblk, int item, int lane) {
    const int kb = item / nblk, nb = item % nblk, k0 = 64 * kb, n0 = 32 * nb;
    const int sc = src_col<MODE>(n0 + (lane & 31));
#pragma unroll 8
    for (int i = 0; i < 32; ++i) { const int kk = 2 * i + (lane >> 5); scr[kk * 33 + (lane & 31)] = (sc >= 0) ? W[(size_t)(k0 + kk) * ldw + sc] : 0.f; }
    LDS_WAIT(); asm volatile("" ::: "memory");
    const int c = lane & 7;
#pragma unroll
    for (int j = 0; j < 4; ++j) { const int n = (lane >> 3) + 8 * j; const LAS float* s = scr + (8 * c) * 33 + n;
        v4u o; o.x = pk2(s[0 * 33], s[1 * 33]); o.y = pk2(s[2 * 33], s[3 * 33]); o.z = pk2(s[4 * 33], s[5 * 33]); o.w = pk2(s[6 * 33], s[7 * 33]);
        *(GAS v4u*)(WT + (size_t)(n0 + n) * K + k0 + 8 * c) = o; }
    LDS_WAIT(); asm volatile("" ::: "memory");
}

__device__ __forceinline__ void p0_mod_unit(int u, const float* cvec, const float* w_ada, const float* b_ada, float* mod, LAS float* lds, int tid, int wave, int lane) {
    LAS float* sc = lds; LAS float* red = lds + 2048;
    for (int i = tid; i < 2048; i += NTHREADS) { const float v = cvec[i]; sc[i] = v / (1.f + expf(-v)); }
    __syncthreads();
    const int l = u / 96, n = (u % 96) * 64 + lane;
    const float* wp = w_ada + ((size_t)l * 1024 + wave * 128) * 6144 + n;
    float a0 = 0.f, a1 = 0.f;
#pragma unroll 16
    for (int kk = 0; kk < 128; ++kk) { const float w = wp[(size_t)kk * 6144]; a0 += sc[wave * 128 + kk] * w; a1 += sc[1024 + wave * 128 + kk] * w; }
    red[(wave * 2 + 0) * 64 + lane] = a0; red[(wave * 2 + 1) * 64 + lane] = a1;
    __syncthreads();
    if (tid < 128) { const int b = tid >> 6; float s = 0.f;
#pragma unroll
        for (int w = 0; w < 8; ++w) s += red[(w * 2 + b) * 64 + lane];
        mod[((size_t)l * 2 + b) * 6144 + n] = s + b_ada[l * 6144 + n]; }
    __syncthreads();
}

__device__ __forceinline__ void pre_rows(const float* xsrc, const float* g, const float* mod_b0, bf16* XA, float* SSP, int gw, int NGW, int lane) {
    for (int m = gw; m < MROWS; m += NGW) {
        const int b = m / SEQ; const float* mb = mod_b0 + (size_t)b * 6144;
        const GAS f32x4* xr = (const GAS f32x4*)(xsrc + (size_t)m * DM) + lane;
        f32x4 v[4]; float ss = 0.f;
#pragma unroll
        for (int j = 0; j < 4; ++j) { v[j] = xr[64 * j]; ss += (v[j].x * v[j].x + v[j].y * v[j].y) + (v[j].z * v[j].z + v[j].w * v[j].w); }
        const float tot = wave_sum(ss);
        if (lane < 16) SSP[(size_t)m * 16 + lane] = lane == 0 ? tot : 0.f;
        GAS v2u* o8 = (GAS v2u*)(XA + (size_t)m * DM) + lane;
#pragma unroll
        for (int j = 0; j < 4; ++j) { const int col = 4 * lane + 256 * j;
            const f32x4 gg = *(const f32x4*)(g + col), sv = *(const f32x4*)(mb + 1024 + col);
            const f32x4 o = v[j] * gg * (sv + 1.0f);
            v2u w; w.x = pk2(o.x, o.y); w.y = pk2(o.z, o.w); o8[64 * j] = w; }
    }
}
__device__ __forceinline__ void pre_avec(const float* n1g, const float* n2g, const float* MODp, float* AVEC, int gtid, int ngt) {
    for (int i = gtid; i < DEPTH * 2 * 2 * 1024; i += ngt) { const int col = i & 1023, b = (i >> 10) & 1, w = (i >> 11) & 1, l = i >> 12;
        const float g = (w ? n2g : n1g)[l * 1024 + col], sc = MODp[((size_t)l * 2 + b) * 6144 + (w ? 4096 : 1024) + col];
        AVEC[i] = g * (1.f + sc); }
}
__device__ __forceinline__ void pre_bias(const bf16* WT, int nrows, const float* sh0, const float* sh1, float* bias0, float* bias1, int gw, int NGW, int lane) {
    for (int n = gw; n < nrows; n += NGW) {
        float w[16]; unpack8(*(const v4u*)(WT + (size_t)n * 1024 + lane * 16), w); unpack8(*(const v4u*)(WT + (size_t)n * 1024 + lane * 16 + 8), w + 8);
        float a0 = 0.f, a1 = 0.f;
#pragma unroll
        for (int q4 = 0; q4 < 4; ++q4) { const f32x4 s0 = *(const f32x4*)(sh0 + lane * 16 + 4 * q4), s1 = *(const f32x4*)(sh1 + lane * 16 + 4 * q4);
            a0 += (w[4 * q4] * s0.x + w[4 * q4 + 1] * s0.y) + (w[4 * q4 + 2] * s0.z + w[4 * q4 + 3] * s0.w);
            a1 += (w[4 * q4] * s1.x + w[4 * q4 + 1] * s1.y) + (w[4 * q4 + 2] * s1.z + w[4 * q4 + 3] * s1.w); }
        a0 = wave_sum(a0); a1 = wave_sum(a1);
        if (lane == 0) { bias0[n] = a0; bias1[n] = a1; }
    }
}
template <class Sched> __device__ __forceinline__ int rstd_tables(const Sched& S, const float* SSP, LAS float* rt, const float* bias, int bstride, LAS float* bt, int tid) {
    pg8::Unit u; int pm0 = -1, pm1 = -1;
    for (int i = 0; S.next(i, u); ++i) { if (pm0 < 0) pm0 = u.pm; else if (u.pm != pm0 && pm1 < 0) pm1 = u.pm;
        if (tid < 64) *(LAS f32x4*)(bt + i * 256 + tid * 4) = *(const f32x4*)(bias + (size_t)((u.pm * 256) / SEQ) * bstride + u.pn * 256 + tid * 4); }
    if (tid < 256) {
#pragma unroll
        for (int slot = 0; slot < 2; ++slot) { const int pm = slot ? pm1 : pm0;
            if (pm >= 0) { const float* sp = SSP + ((size_t)pm * 256 + tid) * 16;
                const f32x4 a = *(const f32x4*)sp, b = *(const f32x4*)(sp + 4), c = *(const f32x4*)(sp + 8), d = *(const f32x4*)(sp + 12);
                const float s = (((a.x + a.y) + (a.z + a.w)) + ((b.x + b.y) + (b.z + b.w))) + (((c.x + c.y) + (c.z + c.w)) + ((d.x + d.y) + (d.z + d.w)));
                rt[slot * 256 + tid] = 1.f / sqrtf(s * (1.f / DM) + EPS); } }
    }
    __syncthreads();
    return pm0;
}

__device__ __forceinline__ void post_foxcum_unit(int bh, const float* GATESp, float* FOXCUMp, const float* fox_f_bias, LAS float* lds, int tid, int wave, int lane) {
    const int b = bh / 6, h = bh % 6; const float bias = fox_f_bias[h];
    float v[32];
#pragma unroll
    for (int r = 0; r < 32; ++r) { const int t = wave * 2048 + r * 64 + lane; const float x2 = (GATESp[((size_t)b * SEQ + t) * 16 + h] + bias) * LOG2E;
        v[r] = fminf(x2, 0.f) - __builtin_amdgcn_logf(1.f + __builtin_amdgcn_exp2f(-fabsf(x2))); }
    float carry = 0.f;
#pragma unroll
    for (int r = 0; r < 32; ++r) { float x = v[r];
#pragma unroll
        for (int o = 1; o < 64; o <<= 1) { const float n = sup(x, o, lane); if (lane >= o) x += n; }
        x += carry; v[r] = x; carry = shf(x, 63); }
    if (lane == 0) lds[wave] = carry;
    __syncthreads();
    float off = 0.f;
    for (int w = 0; w < wave; ++w) off += lds[w];
#pragma unroll
    for (int r = 0; r < 32; ++r) FOXCUMp[(size_t)bh * SEQ + wave * 2048 + r * 64 + lane] = v[r] + off;
    __syncthreads();
}
__device__ __forceinline__ void post_qknorm_unit(int u, bf16* PROJp, float* KMEANP, const float* gfq, const float* gfk, const float* gbq, const float* gbk, LAS float* lds, int tid, int wave, int lane) {
    const int blk = u >> 1, half = u & 1, sub = lane & 7;
    int colv[3]; float gv[3][8]; float qsv[3];
#pragma unroll
    for (int it = 0; it < 3; ++it) { const int hsel = it * 8 + (lane >> 3), grp = hsel / 6, hh = hsel % 6;
        colv[it] = (grp == 0 ? C_FQ : grp == 1 ? C_FK : grp == 2 ? C_BQ : C_BK) + hh * 64 + 8 * sub;
        const float* gp = (grp == 0 ? gfq : grp == 1 ? gfk : grp == 2 ? gbq : gbk) + 8 * sub;
#pragma unroll
        for (int i = 0; i < 8; ++i) gv[it][i] = gp[i];
        qsv[it] = (grp == 0 || grp == 2) ? QSCALE : 1.f; }
    float ka[8] = {0.f, 0.f, 0.f, 0.f, 0.f, 0.f, 0.f, 0.f};
    const size_t row0 = (size_t)blk * 256 + half * 128 + wave * 16;
#pragma unroll 4
    for (int r = 0; r < 16; ++r) {
#pragma unroll
        for (int it = 0; it < 3; ++it) {
            v4u* p = (v4u*)(PROJp + (row0 + r) * PLD + colv[it]);
            float f[8]; unpack8(*p, f);
            float ss = 0.f;
#pragma unroll
            for (int i = 0; i < 8; ++i) ss += f[i] * f[i];
            ss += SWZ_X(ss, 1); ss += SWZ_X(ss, 2); ss += SWZ_X(ss, 4);
            const float rr = 1.f / sqrtf(ss * (1.f / 64.f) + EPS);
#pragma unroll
            for (int i = 0; i < 8; ++i) f[i] = f[i] * rr * gv[it][i];
            if (it == 2) {
#pragma unroll
                for (int i = 0; i < 8; ++i) ka[i] += f[i]; }
            const float qs = qsv[it];
            v4u w; w.x = pk2(f[0] * qs, f[1] * qs); w.y = pk2(f[2] * qs, f[3] * qs); w.z = pk2(f[4] * qs, f[5] * qs); w.w = pk2(f[6] * qs, f[7] * qs);
            *p = w;
        }
    }
    if (lane >= 16) {
#pragma unroll
        for (int i = 0; i < 8; ++i) lds[wave * 384 + ((lane >> 3) - 2) * 64 + 8 * sub + i] = ka[i]; }
    __syncthreads();
    if (tid < 384) { float s = 0.f;
#pragma unroll
        for (int w = 0; w < 8; ++w) s += lds[w * 384 + tid];
        const int b = blk / NBLK, n = blk % NBLK, head = tid >> 6, dd = tid & 63;
        KMEANP[(size_t)half * (12 * NBLK * 64) + (((size_t)b * 6 + head) * NBLK + n) * 64 + dd] = s * (1.f / 256.f); }
    __syncthreads();
}
__device__ __forceinline__ void post_conv_unit(int blk, int which, const bf16* PROJp, bf16* dst, const float* conv_w, const float* conv_b, int tid) {
    const bf16* src = PROJp + (which ? C_MK : C_MQ); const float osc = which ? 0.125f : 1.f;
    const int c = 8 * (tid & 31), rs = tid >> 5, ch = which * 256 + c;
    const size_t r0 = (size_t)blk * 256 + rs * 16; const int tl = (int)(r0 % SEQ);
    float w[4][8], bb[8];
#pragma unroll
    for (int i = 0; i < 4; ++i) { const f32x4 a = *(const f32x4*)(conv_w + i * 512 + ch), b2 = *(const f32x4*)(conv_w + i * 512 + ch + 4);
        w[i][0] = a.x; w[i][1] = a.y; w[i][2] = a.z; w[i][3] = a.w; w[i][4] = b2.x; w[i][5] = b2.y; w[i][6] = b2.z; w[i][7] = b2.w; }
    { const f32x4 a = *(const f32x4*)(conv_b + ch), b2 = *(const f32x4*)(conv_b + ch + 4); bb[0] = a.x; bb[1] = a.y; bb[2] = a.z; bb[3] = a.w; bb[4] = b2.x; bb[5] = b2.y; bb[6] = b2.z; bb[7] = b2.w; }
    float x0[8], x1[8], x2[8], x3[8];
    { v4u h3[3];
#pragma unroll
      for (int k = 0; k < 3; ++k) { if (tl + k - 3 >= 0) h3[k] = *(const v4u*)(src + (r0 + k - 3) * PLD + c); else h3[k] = (v4u){0u, 0u, 0u, 0u}; }
      unpack8(h3[0], x0); unpack8(h3[1], x1); unpack8(h3[2], x2); }
#pragma unroll 1
    for (int hb = 0; hb < 2; ++hb) {
        v4u in[8];
#pragma unroll
        for (int k = 0; k < 8; ++k) in[k] = *(const v4u*)(src + (r0 + hb * 8 + k) * PLD + c);
#pragma unroll
        for (int r = 0; r < 8; ++r) {
            unpack8(in[r], x3);
            float y[8];
#pragma unroll
            for (int i = 0; i < 8; ++i) { const float t = bb[i] + w[0][i] * x0[i] + w[1][i] * x1[i] + w[2][i] * x2[i] + w[3][i] * x3[i];
                y[i] = t * __builtin_amdgcn_rcpf(1.f + __builtin_amdgcn_exp2f(-t * LOG2E)) * osc; x0[i] = x1[i]; x1[i] = x2[i]; x2[i] = x3[i]; }
            v4u o; o.x = pk2(y[0], y[1]); o.y = pk2(y[2], y[3]); o.z = pk2(y[4], y[5]); o.w = pk2(y[6], y[7]);
            *(v4u*)(dst + (r0 + hb * 8 + r) * 256 + c) = o;
        }
    }
}

struct MlP { const bf16* PROJ; const bf16* QC; const bf16* KC; const float* GATES; float* U; float* NU; float* BEND; float* MLOC; bf16* CS; float* NS; float* MS; bf16* Y;
             const float *ibias, *fbias, *hg; };
__device__ __forceinline__ void mlstm_m1(int ci, const MlP& P, LAS float* lds, int tid, int wave, int lane) {
    const int b = ci >> 10, h = (ci >> 8) & 3, c = ci & 255; const size_t row0 = (size_t)b * SEQ + c * 64;
    LAS float* Ks = lds; LAS float* Vs = lds + 4096; LAS float* ws = lds + 8192;
    { const int r = tid >> 3, cg = (tid & 7) * 8; float f[8];
      unpack8(*(const v4u*)(P.KC + (row0 + r) * 256 + h * 64 + cg), f);
#pragma unroll
      for (int i = 0; i < 8; ++i) Ks[r * 64 + cg + i] = f[i];
      unpack8(*(const v4u*)(P.PROJ + (row0 + r) * PLD + C_MV + h * 64 + cg), f);
#pragma unroll
      for (int i = 0; i < 8; ++i) Vs[r * 64 + cg + i] = f[i]; }
    if (wave == 0) {
        const size_t row = row0 + lane;
        const float fi = P.GATES[row * 16 + 6 + h] + P.ibias[h], ff = P.GATES[row * 16 + 10 + h] + P.fbias[h];
        float bc = log_sigmoid_f(ff);
#pragma unroll
        for (int o = 1; o < 64; o <<= 1) { const float n = sup(bc, o, lane); if (lane >= o) bc += n; }
        const float bend = shf(bc, 63);
        const float wl = bend - bc + fi; const float mloc = wave_max(wl);
        ws[lane] = expf(wl - mloc);
        if (lane == 0) { P.BEND[ci] = bend; P.MLOC[ci] = mloc; }
    }
    __syncthreads();
    { const int dv = tid >> 3, e0 = (tid & 7) * 8; float u[8] = {0.f, 0.f, 0.f, 0.f, 0.f, 0.f, 0.f, 0.f};
#pragma unroll 2
      for (int s = 0; s < 64; ++s) { const float vw = Vs[s * 64 + dv] * ws[s]; const f32x4 ka = *(const LAS f32x4*)(Ks + s * 64 + e0), kb = *(const LAS f32x4*)(Ks + s * 64 + e0 + 4);
          u[0] += vw * ka.x; u[1] += vw * ka.y; u[2] += vw * ka.z; u[3] += vw * ka.w; u[4] += vw * kb.x; u[5] += vw * kb.y; u[6] += vw * kb.z; u[7] += vw * kb.w; }
      float* up = P.U + (size_t)ci * 4096 + dv * 64 + e0;
      *(f32x4*)up = (f32x4){u[0], u[1], u[2], u[3]}; *(f32x4*)(up + 4) = (f32x4){u[4], u[5], u[6], u[7]}; }
    if (tid < 64) { float nu = 0.f; for (int s = 0; s < 64; ++s) nu += ws[s] * Ks[s * 64 + tid]; P.NU[(size_t)ci * 64 + tid] = nu; }
    __syncthreads();
}
__device__ __forceinline__ void mlstm_m2(int u, const MlP& P, LAS float* lds, int tid, int wave, int lane) {
    const int bh = u >> 3, eg = u & 7, elem = eg * 512 + tid, base = bh * 256;
    LAS float* decl = lds; LAS float* wul = lds + 256;
    if (wave == 0) {
        const f32x4 b4 = *(const f32x4*)(P.BEND + base + 4 * lane), l4 = *(const f32x4*)(P.MLOC + base + 4 * lane);
        float B = b4.x, L = l4.x;
        B += b4.y; L = fmaxf(L + b4.y, l4.y); B += b4.z; L = fmaxf(L + b4.z, l4.z); B += b4.w; L = fmaxf(L + b4.w, l4.w);
#pragma unroll
        for (int o = 1; o < 64; o <<= 1) { const float Bp = sup(B, o, lane), Lp = sup(L, o, lane); if (lane >= o) { L = fmaxf(Lp + B, L); B = Bp + B; } }
        const float Bex = sup(B, 1, lane), Lex = sup(L, 1, lane);
        float m = (lane == 0) ? 0.f : fmaxf(Bex, Lex);
        const float bb[4] = {b4.x, b4.y, b4.z, b4.w}, ll[4] = {l4.x, l4.y, l4.z, l4.w};
#pragma unroll
        for (int j = 0; j < 4; ++j) { const int c = 4 * lane + j; if (eg == 0) P.MS[base + c] = m;
            const float mn = fmaxf(bb[j] + m, ll[j]);
            decl[c] = __builtin_amdgcn_exp2f((bb[j] + m - mn) * LOG2E); wul[c] = __builtin_amdgcn_exp2f((ll[j] - mn) * LOG2E); m = mn; }
    }
    __syncthreads();
    const bool donorm = (eg == 0 && tid < 64);
    float C = 0.f, nst = 0.f;
#pragma unroll 1
    for (int c0 = 0; c0 < 256; c0 += 16) {
        float uv[16], nv[16];
#pragma unroll
        for (int i = 0; i < 16; ++i) { const int ci = base + c0 + i; uv[i] = P.U[(size_t)ci * 4096 + elem]; nv[i] = donorm ? P.NU[(size_t)ci * 64 + tid] : 0.f; }
#pragma unroll
        for (int i = 0; i < 16; ++i) { const int ci = base + c0 + i;
            P.CS[(size_t)ci * 4096 + elem] = (bf16)f2bf(C);
            if (donorm) P.NS[(size_t)ci * 64 + tid] = nst;
            const float dec = decl[c0 + i], wu = wul[c0 + i];
            C = dec * C + wu * uv[i]; nst = dec * nst + wu * nv[i]; }
    }
    __syncthreads();
}
__device__ __forceinline__ void mlstm_m3(int ci, const MlP& P, LAS float* lds, int tid, int wave, int lane) {
    constexpr int LP = 68;
    const int b = ci >> 10, h = (ci >> 8) & 3, c = ci & 255; const size_t row0 = (size_t)b * SEQ + c * 64;
    LAS float* Qs = lds; LAS float* Ks = Qs + 64 * LP; LAS float* Cs = Ks + 64 * LP; LAS float* Sm = Cs + 64 * LP; LAS float* Vs = Sm + 64 * LP;
    LAS float* av = Vs + 4096; LAS float* gv = av + 64; LAS float* bcv = gv + 64; LAS float* nsv = bcv + 64;
    const float ms = P.MS[ci];
    { const int r = tid >> 3, cg = (tid & 7) * 8; float f[8];
      unpack8(*(const v4u*)(P.QC + (row0 + r) * 256 + h * 64 + cg), f);
#pragma unroll
      for (int i = 0; i < 8; ++i) Qs[r * LP + cg + i] = f[i];
      unpack8(*(const v4u*)(P.KC + (row0 + r) * 256 + h * 64 + cg), f);
#pragma unroll
      for (int i = 0; i < 8; ++i) Ks[r * LP + cg + i] = f[i];
      unpack8(*(const v4u*)(P.PROJ + (row0 + r) * PLD + C_MV + h * 64 + cg), f);
#pragma unroll
      for (int i = 0; i < 8; ++i) Vs[r * 64 + cg + i] = f[i];
      unpack8(*(const v4u*)(P.CS + (size_t)ci * 4096 + r * 64 + cg), f);
#pragma unroll
      for (int i = 0; i < 8; ++i) Cs[r * LP + cg + i] = f[i]; }
    if (wave == 0) {
        const size_t row = row0 + lane;
        const float fi = P.GATES[row * 16 + 6 + h] + P.ibias[h], ff = P.GATES[row * 16 + 10 + h] + P.fbias[h];
        float bc = log_sigmoid_f(ff);
#pragma unroll
        for (int o = 1; o < 64; o <<= 1) { const float n = sup(bc, o, lane); if (lane >= o) bc += n; }
        const float a = fi - bc; float pm = a;
#pragma unroll
        for (int o = 1; o < 64; o <<= 1) { const float n = sup(pm, o, lane); if (lane >= o) pm = fmaxf(pm, n); }
        av[lane] = a; gv[lane] = fmaxf(ms, pm); bcv[lane] = bc; nsv[lane] = P.NS[(size_t)ci * 64 + lane];
    }
    __syncthreads();
    const int j = tid >> 3, part = tid & 7, s0 = part * 8;
    const float gj = gv[j];
    { float sacc[8] = {0.f, 0.f, 0.f, 0.f, 0.f, 0.f, 0.f, 0.f};
#pragma unroll 1
      for (int e = 0; e < 64; e += 4) { const f32x4 q4 = *(const LAS f32x4*)(Qs + j * LP + e);
#pragma unroll
          for (int i = 0; i < 8; ++i) { const f32x4 k4 = *(const LAS f32x4*)(Ks + (s0 + i) * LP + e); sacc[i] += (q4.x * k4.x + q4.y * k4.y) + (q4.z * k4.z + q4.w * k4.w); } }
#pragma unroll
      for (int i = 0; i < 8; ++i) { const int s = s0 + i; Sm[j * LP + s] = (s <= j) ? sacc[i] * expf(av[s] - gj) : 0.f; } }
    __syncthreads();
    { const int dv0 = part * 8; float t1[8] = {0.f, 0.f, 0.f, 0.f, 0.f, 0.f, 0.f, 0.f}, t2[8] = {0.f, 0.f, 0.f, 0.f, 0.f, 0.f, 0.f, 0.f};
#pragma unroll 1
      for (int e = 0; e < 64; e += 4) { const f32x4 q4 = *(const LAS f32x4*)(Qs + j * LP + e);
#pragma unroll
          for (int i = 0; i < 8; ++i) { const f32x4 c4 = *(const LAS f32x4*)(Cs + (dv0 + i) * LP + e); t1[i] += (q4.x * c4.x + q4.y * c4.y) + (q4.z * c4.z + q4.w * c4.w); } }
#pragma unroll 2
      for (int s = 0; s < 64; ++s) { const float sm = Sm[j * LP + s]; const f32x4 va = *(const LAS f32x4*)(Vs + s * 64 + dv0), vb = *(const LAS f32x4*)(Vs + s * 64 + dv0 + 4);
          t2[0] += sm * va.x; t2[1] += sm * va.y; t2[2] += sm * va.z; t2[3] += sm * va.w; t2[4] += sm * vb.x; t2[5] += sm * vb.y; t2[6] += sm * vb.z; t2[7] += sm * vb.w; }
      float dn = 0.f, ssum = 0.f;
#pragma unroll
      for (int i = 0; i < 8; ++i) { dn += nsv[s0 + i] * Qs[j * LP + s0 + i]; ssum += Sm[j * LP + s0 + i]; }
      { dn += SWZ_X(dn, 1); ssum += SWZ_X(ssum, 1); dn += SWZ_X(dn, 2); ssum += SWZ_X(ssum, 2); dn += SWZ_X(dn, 4); ssum += SWZ_X(ssum, 4); }
      const float inter = expf(ms - gj), mj = bcv[j] + gj;
      const float den = inter * dn + ssum, dd = fmaxf(fabsf(den), expf(-mj)), rd = 1.f / dd;
      float hv[8], ss = 0.f;
#pragma unroll
      for (int i = 0; i < 8; ++i) { hv[i] = (inter * t1[i] + t2[i]) * rd; ss += hv[i] * hv[i]; }
      { ss += SWZ_X(ss, 1); ss += SWZ_X(ss, 2); ss += SWZ_X(ss, 4); }
      const float rr = 1.f / sqrtf(ss * (1.f / 64.f) + EPS);
      float mo[8]; unpack8(*(const v4u*)(P.PROJ + (row0 + j) * PLD + C_MO + h * 64 + dv0), mo);
      float y[8];
#pragma unroll
      for (int i = 0; i < 8; ++i) y[i] = hv[i] * rr * P.hg[h * 64 + dv0 + i] * sigmoid_f(mo[i]);
      v4u w; w.x = pk2(y[0], y[1]); w.y = pk2(y[2], y[3]); w.z = pk2(y[4], y[5]); w.w = pk2(y[6], y[7]);
      *(v4u*)(P.Y + (row0 + j) * 1024 + Y_ML + h * 64 + dv0) = w; }
    __syncthreads();
}

__device__ __forceinline__ size_t moba_list_off(int bh, int n);
__device__ __forceinline__ void moba_gate_unit(int u, const bf16* PROJ, const float* KMEAN, unsigned* SEL, unsigned* LCNT, unsigned* CTAB, unsigned short* LIST, float B2, float thresh2, LAS float* lds, int tid) {
    const int bh = u >> 6, qb = 63 - (u & 63), b = bh / 6, h = bh % 6;
    LAS float* km = lds; LAS float* cand = lds + 4096; LAS unsigned* cntl = (LAS unsigned*)(lds + 4096 + 1536);
    if (tid < 64) cntl[tid] = 0u;
    for (int i = tid; i < qb * 16; i += NTHREADS) *(LAS f32x4*)(km + i * 4) = *(const f32x4*)(KMEAN + (size_t)bh * NBLK * 64 + i * 4) + *(const f32x4*)(KMEAN + (size_t)(12 * NBLK * 64) + (size_t)bh * NBLK * 64 + i * 4);
    __syncthreads();
    const int query = tid & 255, half = tid >> 8; const size_t row = (size_t)b * SEQ + qb * 256 + query;
    float q[64];
#pragma unroll
    for (int i = 0; i < 8; ++i) unpack8(*(const v4u*)(PROJ + row * PLD + C_BQ + h * 64 + i * 8), q + i * 8);
    float v0 = -INFINITY, v1 = -INFINITY, v2 = -INFINITY; int i0 = 255, i1 = 255, i2 = 255;
    const int nlo = half * 32, nhi = (qb < nlo + 32) ? qb : nlo + 32;
    for (int n = nlo; n < nhi; ++n) { float g = 0.f;
#pragma unroll
        for (int d = 0; d < 64; d += 4) { const f32x4 k4 = *(const LAS f32x4*)(km + n * 64 + d); g += (q[d] * k4.x + q[d + 1] * k4.y) + (q[d + 2] * k4.z + q[d + 3] * k4.w); }
        if (g > v0) { v2 = v1; i2 = i1; v1 = v0; i1 = i0; v0 = g; i0 = n; } else if (g > v1) { v2 = v1; i2 = i1; v1 = g; i1 = n; } else if (g > v2) { v2 = g; i2 = n; } }
    if (half == 1) { cand[query * 6 + 0] = v0; cand[query * 6 + 1] = v1; cand[query * 6 + 2] = v2;
        cand[query * 6 + 3] = __int_as_float(i0); cand[query * 6 + 4] = __int_as_float(i1); cand[query * 6 + 5] = __int_as_float(i2); }
    __syncthreads();
    if (half == 0) {
#pragma unroll
        for (int k = 0; k < 3; ++k) { const float g = cand[query * 6 + k]; const int n = __float_as_int(cand[query * 6 + 3 + k]);
            if (n != 255) { if (g > v0) { v2 = v1; i2 = i1; v1 = v0; i1 = i0; v0 = g; i0 = n; } else if (g > v1) { v2 = v1; i2 = i1; v1 = g; i1 = n; } else if (g > v2) { v2 = g; i2 = n; } } }
        { const float slope2 = exp2f(-8.f * (float)(h + 1) / 6.f) * LOG2E; const float lim = (2.f * B2 + thresh2) / slope2; const int t0 = qb * 256 + query - 255;
          if (i0 != 255 && (float)(t0 - i0 * 256) > lim) i0 = 255;
          if (i1 != 255 && (float)(t0 - i1 * 256) > lim) i1 = 255;
          if (i2 != 255 && (float)(t0 - i2 * 256) > lim) i2 = 255; }
        SEL[row * 6 + h] = (unsigned)i0 | ((unsigned)i1 << 8) | ((unsigned)i2 << 16);
        if (LIST) { const unsigned t = (unsigned)(qb * 256 + query);
            if (i0 != 255) { const unsigned pos = __hip_atomic_fetch_add(cntl + i0, 1u, __ATOMIC_RELAXED, __HIP_MEMORY_SCOPE_WORKGROUP); LIST[moba_list_off(bh, i0) + (size_t)(qb - i0 - 1) * 256 + pos] = (unsigned short)(t | (0u << 14)); }
            if (i1 != 255) { const unsigned pos = __hip_atomic_fetch_add(cntl + i1, 1u, __ATOMIC_RELAXED, __HIP_MEMORY_SCOPE_WORKGROUP); LIST[moba_list_off(bh, i1) + (size_t)(qb - i1 - 1) * 256 + pos] = (unsigned short)(t | (1u << 14)); }
            if (i2 != 255) { const unsigned pos = __hip_atomic_fetch_add(cntl + i2, 1u, __ATOMIC_RELAXED, __HIP_MEMORY_SCOPE_WORKGROUP); LIST[moba_list_off(bh, i2) + (size_t)(qb - i2 - 1) * 256 + pos] = (unsigned short)(t | (2u << 14)); } }
    }
    __syncthreads();
    if (LIST && tid < 64) { const unsigned c = cntl[tid]; CTAB[((size_t)bh * 64 + qb) * 64 + tid] = c; if (c) atomicAdd(LCNT + bh * 64 + tid, c); }
    __syncthreads();
}

__device__ __forceinline__ void fox_naive(const bf16* PROJ, const float* FOXCUM, bf16* Y, int gw, int NGW, int lane) {
    for (int idx = gw; idx < 12 * SEQ; idx += NGW) {
        const int t = SEQ - 1 - idx / 12, bh = idx % 12, b = bh / 6, h = bh % 6; const size_t rb = (size_t)b * SEQ;
        const float qv = bf2f(PROJ[(rb + t) * PLD + C_FQ + h * 64 + lane]); const float ct = FOXCUM[(size_t)bh * SEQ + t];
        float m = -INFINITY, l = 0.f, acc = 0.f;
#pragma unroll 4
        for (int j = 0; j <= t; ++j) {
            const float kv = bf2f(PROJ[(rb + j) * PLD + C_FK + h * 64 + lane]), vv = bf2f(PROJ[(rb + j) * PLD + C_FV + h * 64 + lane]);
            const float s = wave_sum(qv * kv) + (ct - FOXCUM[(size_t)bh * SEQ + j]);
            const float mn = fmaxf(m, s), sc = exp2f(m - mn), p = exp2f(s - mn);
            l = l * sc + p; acc = acc * sc + p * vv; m = mn; }
        Y[(rb + t) * 1024 + Y_FOX + h * 64 + lane] = (bf16)f2bf(acc / l);
    }
}
__device__ __forceinline__ void moba_naive(const bf16* PROJ, const unsigned* SEL, bf16* Y, int gw, int NGW, int lane) {
    for (int idx = gw; idx < 12 * SEQ; idx += NGW) {
        const int t = SEQ - 1 - idx / 12, bh = idx % 12, b = bh / 6, h = bh % 6; const size_t rb = (size_t)b * SEQ;
        const float slope2 = exp2f(-8.f * (float)(h + 1) / 6.f) * LOG2E;
        const float qv = bf2f(PROJ[(rb + t) * PLD + C_BQ + h * 64 + lane]);
        const unsigned sel = SEL[(rb + t) * 6 + h];
        float m = -INFINITY, l = 0.f, acc = 0.f;
        for (int slot = 0; slot < 4; ++slot) {
            int j0, j1;
            if (slot < 3) { const int n = (sel >> (8 * slot)) & 0xff; if (n == 255) continue; j0 = n * 256; j1 = j0 + 256; } else { j0 = (t >> 8) * 256; j1 = t + 1; }
#pragma unroll 4
            for (int j = j0; j < j1; ++j) {
                const float kv = bf2f(PROJ[(rb + j) * PLD + C_BK + h * 64 + lane]), vv = bf2f(PROJ[(rb + j) * PLD + C_BV + h * 64 + lane]);
                const float s = wave_sum(qv * kv) - slope2 * (float)(t - j);
                const float mn = fmaxf(m, s), sc = exp2f(m - mn), p = exp2f(s - mn);
                l = l * sc + p; acc = acc * sc + p * vv; m = mn; }
        }
        Y[(rb + t) * 1024 + Y_MOBA + h * 64 + lane] = (bf16)f2bf(acc / l);
    }
}
typedef short v4i16_t __attribute__((ext_vector_type(4)));
typedef short s16x4 __attribute__((ext_vector_type(4)));
constexpr int ATT_K0 = 0, ATT_V0 = 32768, ATT_TAB = 132096;
#ifndef THRESH_NAT
#define THRESH_NAT 30.f
#endif
constexpr float THRESH2 = THRESH_NAT * LOG2E;

__device__ __forceinline__ int crow(int r, int hi) { return (r & 3) + 8 * (r >> 2) + 4 * hi; }
__device__ __forceinline__ s16x4 vtr(LAS const unsigned char* p) { return __builtin_bit_cast(s16x4, __builtin_amdgcn_ds_read_tr16_b64_v4i16((LAS v4i16_t*)p)); }
typedef float f32x2_t __attribute__((ext_vector_type(2))); typedef __bf16 bf16x2_t __attribute__((ext_vector_type(2)));
#ifndef CVT_ASM
#define CVT_ASM 0
#endif
#if CVT_ASM
__device__ __forceinline__ unsigned cvtpk(float lo, float hi) { unsigned r; asm volatile("v_cvt_pk_bf16_f32 %0, %1, %2\n\ts_nop 1" : "=v"(r) : "v"(lo), "v"(hi)); return r; }
#else
__device__ __forceinline__ unsigned cvtpk(float lo, float hi) { const f32x2_t v = {lo, hi}; const bf16x2_t b = __builtin_convertvector(v, bf16x2_t); return __builtin_bit_cast(unsigned, b); }
#endif

struct GroupRegs { v4u k[4], v[4]; };
__device__ __forceinline__ void group_issue(GroupRegs& R, const bf16* Kg, const bf16* Vg, int tid) {
#pragma unroll
    for (int i = 0; i < 4; ++i) { const int idx = tid + NTHREADS * i, row = idx >> 3, ch = idx & 7;
        R.k[i] = *(const v4u*)(Kg + (size_t)row * PLD + ch * 8); R.v[i] = *(const v4u*)(Vg + (size_t)row * PLD + ch * 8); }
}
__device__ __forceinline__ void group_commit(const GroupRegs& R, LAS unsigned char* kv, int tid) {
#pragma unroll
    for (int i = 0; i < 4; ++i) { const int idx = tid + NTHREADS * i, row = idx >> 3, ch = idx & 7;
        *(LAS v4u*)(kv + ATT_K0 + row * 128 + ((ch ^ ((row >> 1) & 7)) << 4)) = R.k[i];
        *(LAS v4u*)(kv + ATT_V0 + row * 128 + ((ch * 16) ^ (((row >> 1) & 1) << 6))) = R.v[i]; }
}
__device__ __forceinline__ void load_group(const bf16* Kg, const bf16* Vg, LAS unsigned char* kv, int tid) {
#pragma unroll
    for (int i = 0; i < 4; ++i) { const int idx = tid + NTHREADS * i, row = idx >> 3, ch = idx & 7;
        const v4u k = *(const v4u*)(Kg + (size_t)row * PLD + ch * 8), v = *(const v4u*)(Vg + (size_t)row * PLD + ch * 8);
        *(LAS v4u*)(kv + ATT_K0 + row * 128 + ((ch ^ ((row >> 1) & 7)) << 4)) = k;
        *(LAS v4u*)(kv + ATT_V0 + row * 128 + ((ch * 16) ^ (((row >> 1) & 1) << 6))) = v; }
}

template <bool FOX>
__device__ __forceinline__ void attn_subtile(LAS const unsigned char* kv, LAS const float* colt, int j0, const bf16x8 (&qf)[4], float rowterm, float slope2, bool mask, int qrel,
                                             f32x16 (&o)[2], float& l, int lane) {
    const int r32 = lane & 31, hh = lane >> 5;
    f32x16 acc;
    if (FOX) {
#pragma unroll
        for (int g = 0; g < 4; ++g) { const f32x4 c = *(LAS const f32x4*)(colt + j0 + 8 * g + 4 * hh); acc[4 * g + 0] = rowterm + c.x; acc[4 * g + 1] = rowterm + c.y; acc[4 * g + 2] = rowterm + c.z; acc[4 * g + 3] = rowterm + c.w; }
    } else {
#pragma unroll
        for (int r = 0; r < 16; ++r) acc[r] = rowterm + slope2 * (float)(j0 + crow(r, hh));
    }
    if (mask) {
#pragma unroll
        for (int r = 0; r < 16; ++r) if (j0 + crow(r, hh) > qrel) acc[r] = -INFINITY;
    }
    { const int row = j0 + r32; LAS const unsigned char* kr = kv + ATT_K0 + row * 128; const int sw = (row >> 1) & 7;
#pragma unroll
      for (int s = 0; s < 4; ++s) { const bf16x8 kf = *(LAS const bf16x8*)(kr + (((2 * s + hh) ^ sw) << 4)); acc = __builtin_amdgcn_mfma_f32_32x32x16_bf16(kf, qf[s], acc, 0, 0, 0); } }
    float ls = 0.f;
#pragma unroll
    for (int r = 0; r < 16; ++r) { acc[r] = __builtin_amdgcn_exp2f(acc[r]); ls += acc[r]; }
    l += ls;
    bf16x8 pa[2];
#pragma unroll
    for (int s = 0; s < 2; ++s) { v4u w; w.x = cvtpk(acc[8 * s + 0], acc[8 * s + 1]); w.y = cvtpk(acc[8 * s + 2], acc[8 * s + 3]); w.z = cvtpk(acc[8 * s + 4], acc[8 * s + 5]); w.w = cvtpk(acc[8 * s + 6], acc[8 * s + 7]); pa[s] = __builtin_bit_cast(bf16x8, w); }
    { const int i = lane & 15, c = (lane >> 4) & 1;
#pragma unroll
      for (int db = 0; db < 2; ++db)
#pragma unroll
          for (int s = 0; s < 2; ++s) { const int rowv = j0 + 16 * s + 4 * hh + (i >> 2); const int colb = (32 * db + 16 * c + 4 * (i & 3)) * 2;
              LAS const unsigned char* vp = kv + ATT_V0 + rowv * 128 + (colb ^ (((rowv >> 1) & 1) << 6));
              const s16x4 lo = vtr(vp), hi = vtr(vp + 8 * 128);
              const bf16x8 vf = (bf16x8){lo[0], lo[1], lo[2], lo[3], hi[0], hi[1], hi[2], hi[3]};
              o[db] = __builtin_amdgcn_mfma_f32_32x32x16_bf16(pa[s], vf, o[db], 0, 0, 0); } }
}
__device__ __forceinline__ float rfl(float x) { return __builtin_bit_cast(float, __builtin_amdgcn_readfirstlane(__builtin_bit_cast(int, x))); }

__device__ __forceinline__ void fox_unit(int bh, int qb, const bf16* PROJ, const float* FOXCUM, bf16* Y, float B2, LAS unsigned char* lds, int tid, int wave, int lane) {
    const int b = bh / 6, h = bh % 6; const size_t rb = (size_t)b * SEQ; const int r32 = lane & 31, hh = lane >> 5;
    const int q0w = qb * 256 + wave * 32, qpos = q0w + r32;
    const float* cum = FOXCUM + (size_t)bh * SEQ;
    bf16x8 qf[4];
#pragma unroll
    for (int s = 0; s < 4; ++s) qf[s] = *(const bf16x8*)(PROJ + (rb + qpos) * PLD + C_FQ + h * 64 + 16 * s + 8 * hh);
    GroupRegs GA, GB;
    group_issue(GA, PROJ + (rb + (size_t)qb * 256) * PLD + C_FK + h * 64, PROJ + (rb + (size_t)qb * 256) * PLD + C_FV + h * 64, tid);
    const float ca = (tid < 256) ? -cum[qb * 256 + tid] : 0.f;
    const float cq = cum[qpos];
    const float cq_first = rfl(cum[q0w]), cq_blk = rfl(cum[qb * 256]);
    const float cprev = (qb > 0) ? rfl(cum[qb * 256 - 1]) : 0.f;
    const float rowterm = cq - B2, lim = -THRESH2 - 2.f * B2;
    f32x16 o[2]; float l = 0.f;
#pragma unroll
    for (int r = 0; r < 16; ++r) { o[0][r] = 0.f; o[1][r] = 0.f; }
    LAS float* coltA = (LAS float*)(lds + ATT_TAB); LAS float* coltB = coltA + 256;
    LAS unsigned char* kvA = lds; LAS unsigned char* kvB = lds + 65536;
#ifndef FOX_2G
#define FOX_2G 1
#endif
    const bool haveB = FOX_2G && (qb > 0) && !(cq_blk - cprev < lim);
    float cb = 0.f;
    if (haveB) { group_issue(GB, PROJ + (rb + (size_t)(qb - 1) * 256) * PLD + C_FK + h * 64, PROJ + (rb + (size_t)(qb - 1) * 256) * PLD + C_FV + h * 64, tid);
        cb = (tid < 256) ? -cum[(qb - 1) * 256 + tid] : 0.f; }
    group_commit(GA, kvA, tid); if (tid < 256) coltA[tid] = ca;
    if (haveB) { group_commit(GB, kvB, tid); if (tid < 256) coltB[tid] = cb; }
    __syncthreads();
#ifndef REP_FLOAD
#define REP_FLOAD 0
#endif
#pragma unroll 1
    for (int rp = 0; rp < REP_FLOAD; ++rp) {
        group_issue(GA, PROJ + (rb + (size_t)qb * 256) * PLD + C_FK + h * 64, PROJ + (rb + (size_t)qb * 256) * PLD + C_FV + h * 64, tid);
        if (haveB) group_issue(GB, PROJ + (rb + (size_t)(qb - 1) * 256) * PLD + C_FK + h * 64, PROJ + (rb + (size_t)(qb - 1) * 256) * PLD + C_FV + h * 64, tid);
        group_commit(GA, kvA, tid); if (haveB) group_commit(GB, kvB, tid);
        __syncthreads(); }
#ifndef REP_FSUB
#define REP_FSUB 0
#endif
#pragma unroll 1
    for (int rp = 0; rp <= REP_FSUB; ++rp) {
    if (rp) { l = 0.f;
#pragma unroll
        for (int r = 0; r < 16; ++r) { o[0][r] = 0.f; o[1][r] = 0.f; } }
#pragma unroll 1
    for (int st = wave; st >= 0; --st) {
        const int j0 = 32 * st;
        if (cq_first + rfl(coltA[j0 + 31]) < lim) break;
        attn_subtile<true>(kvA, coltA, j0, qf, rowterm, 0.f, st == wave, wave * 32 + r32, o, l, lane);
    }
    if (haveB) {
#pragma unroll 1
        for (int st = 7; st >= 0; --st) {
            const int j0 = 32 * st;
            if (cq_first + rfl(coltB[j0 + 31]) < lim) break;
            attn_subtile<true>(kvB, coltB, j0, qf, rowterm, 0.f, false, 0, o, l, lane);
        }
    }
    }
    __syncthreads();
    {
        for (int g = haveB ? qb - 2 : qb - 1; g >= 0; --g) {
            if (cq_blk - rfl(cum[g * 256 + 255]) < lim) break;
            load_group(PROJ + (rb + (size_t)g * 256) * PLD + C_FK + h * 64, PROJ + (rb + (size_t)g * 256) * PLD + C_FV + h * 64, kvA, tid);
            if (tid < 256) coltA[tid] = -cum[g * 256 + tid];
            __syncthreads();
            {
#pragma unroll 1
                for (int st = 7; st >= 0; --st) {
                    const int j0 = 32 * st;
                    if (cq_first + rfl(coltA[j0 + 31]) < lim) break;
                    attn_subtile<true>(kvA, coltA, j0, qf, rowterm, 0.f, false, 0, o, l, lane);
                }
            }
            __syncthreads();
        }
    }
    l = half_sum(l, lane);
    bf16* yp = Y + (rb + (size_t)q0w) * 1024 + Y_FOX + h * 64 + r32;
#ifndef REP_FOUT
#define REP_FOUT 0
#endif
#pragma unroll 1
    for (int rp = 0; rp <= REP_FOUT; ++rp) {
#pragma unroll
    for (int r = 0; r < 16; ++r) { const int q = crow(r, hh); const float rl = 1.f / shf(l, q);
        yp[(size_t)q * 1024] = (bf16)f2bf(o[0][r] * rl); yp[(size_t)q * 1024 + 32] = (bf16)f2bf(o[1][r] * rl); }
    }
}

__device__ __forceinline__ void fox_unit_old(int bh, int qb, const bf16* PROJ, const float* FOXCUM, bf16* Y, float B2, LAS unsigned char* lds, int tid, int wave, int lane) {
    const int b = bh / 6, h = bh % 6; const size_t rb = (size_t)b * SEQ; const int r32 = lane & 31, hh = lane >> 5;
    const int q0w = qb * 256 + wave * 32, qpos = q0w + r32;
    const float* cum = FOXCUM + (size_t)bh * SEQ;
    bf16x8 qf[4];
#pragma unroll
    for (int s = 0; s < 4; ++s) qf[s] = *(const bf16x8*)(PROJ + (rb + qpos) * PLD + C_FQ + h * 64 + 16 * s + 8 * hh);
    const float cq = cum[qpos];
    const float cq_first = rfl(cum[q0w]);
    const float cq_blk = rfl(cum[qb * 256]);
    const float rowterm = cq - B2;
    f32x16 o[2]; float l = 0.f;
#pragma unroll
    for (int r = 0; r < 16; ++r) { o[0][r] = 0.f; o[1][r] = 0.f; }
    LAS float* colt = (LAS float*)(lds + ATT_TAB);
    for (int g = qb; g >= 0; --g) {
        if (g < qb) { const float cl = rfl(cum[g * 256 + 255]); if (2.f * B2 + cq_blk - cl < -THRESH2) break; }
        load_group(PROJ + (rb + (size_t)g * 256) * PLD + C_FK + h * 64, PROJ + (rb + (size_t)g * 256) * PLD + C_FV + h * 64, lds, tid);
        if (tid < 256) colt[tid] = -cum[g * 256 + tid];
        __syncthreads();
        const int stmax = (g == qb) ? wave : 7;
        for (int st = stmax; st >= 0; --st) {
            const int j0 = 32 * st;
            { const float cl = rfl(colt[j0 + 31]); if (2.f * B2 + cq_first + cl < -THRESH2) break; }
            attn_subtile<true>(lds, colt, j0, qf, rowterm, 0.f, (g == qb) && (st == wave), wave * 32 + r32, o, l, lane);
        }
        __syncthreads();
    }
    l = half_sum(l, lane);
    bf16* yp = Y + (rb + (size_t)q0w) * 1024 + Y_FOX + h * 64 + r32;
#pragma unroll
    for (int r = 0; r < 16; ++r) { const int q = crow(r, hh); const float rl = 1.f / shf(l, q);
        yp[(size_t)q * 1024] = (bf16)f2bf(o[0][r] * rl); yp[(size_t)q * 1024 + 32] = (bf16)f2bf(o[1][r] * rl); }
}

__device__ __forceinline__ size_t moba_list_off(int bh, int n) { return (size_t)bh * 516096 + 256 * (size_t)(63 * n - (n * (n - 1)) / 2); }
__device__ __forceinline__ void moba_store(const f32x16 (&o)[2], float l, int qpos, int slot, bool valid, size_t rb, int h, bf16* OPART, float* LPART, bf16* Y, int lane) {
    const int r32 = lane & 31, hh = lane >> 5;
#pragma unroll
    for (int r = 0; r < 16; ++r) { const int src = crow(r, hh);
        const int qp = shfi(qpos, src), sl = shfi(slot, src); const int ok = shfi((int)valid, src);
        if (ok) { bf16* op = (sl == 3) ? (Y + (rb + qp) * 1024 + Y_MOBA + h * 64) : (OPART + ((size_t)sl * MROWS + rb + qp) * 384 + h * 64);
            op[r32] = (bf16)f2bf(o[0][r]); op[32 + r32] = (bf16)f2bf(o[1][r]); } }
    if (valid && hh == 0) LPART[((size_t)slot * MROWS + rb + qpos) * 6 + h] = l;
}
__device__ __forceinline__ void moba_sel_unit(int bh, int n, int chunk, int cnt, const bf16* PROJ, const unsigned short* LIST, const unsigned* CTAB, bf16* OPART, float* LPART, bf16* Y, float B2,
                                              LAS unsigned char* lds, int tid, int wave, int lane) {
    const int b = bh / 6, h = bh % 6; const size_t rb = (size_t)b * SEQ; const int r32 = lane & 31, hh = lane >> 5;
    const float slope2 = exp2f(-8.f * (float)(h + 1) / 6.f) * LOG2E;
    GroupRegs GR; group_issue(GR, PROJ + (rb + (size_t)n * 256) * PLD + C_BK + h * 64, PROJ + (rb + (size_t)n * 256) * PLD + C_BV + h * 64, tid);
    const int nvalid = cnt - chunk * 256 < 256 ? cnt - chunk * 256 : 256;
    const bool active = wave * 32 < nvalid;
    bool valid = true; int qpos = 0, slot = 0; bf16x8 qf[4];
    if (active) {
        int li = wave * 32 + r32; if (li >= nvalid) { li = nvalid - 1; valid = false; }
        const int p = chunk * 256 + li;
        const int cv = (lane > n) ? (int)CTAB[((size_t)bh * 64 + lane) * 64 + n] : 0; int inc = cv;
#pragma unroll
        for (int o2 = 1; o2 < 64; o2 <<= 1) { const int t2 = supi(inc, o2, lane); if (lane >= o2) inc += t2; }
        int qseg = 0;
#pragma unroll
        for (int stp = 32; stp >= 1; stp >>= 1) { const int v = shfi(inc, qseg + stp - 1); if (v <= p) qseg += stp; }
        const int idx = p - (shfi(inc, qseg) - shfi(cv, qseg));
        const unsigned e = LIST[moba_list_off(bh, n) + (size_t)(qseg - n - 1) * 256 + idx]; qpos = e & 0x3fff; slot = e >> 14;
#pragma unroll
        for (int s = 0; s < 4; ++s) qf[s] = *(const bf16x8*)(PROJ + (rb + qpos) * PLD + C_BQ + h * 64 + 16 * s + 8 * hh);
    }
    group_commit(GR, lds, tid);
    __syncthreads();
    if (active) {
        const int qrel = qpos - n * 256;
        const float rowterm = -slope2 * (float)qrel - B2;
        f32x16 o[2]; float l = 0.f;
#pragma unroll
        for (int r = 0; r < 16; ++r) { o[0][r] = 0.f; o[1][r] = 0.f; }
#ifndef REP_SUB
#define REP_SUB 0
#endif
#pragma unroll 1
        for (int rp = 0; rp <= REP_SUB; ++rp) {
        if (rp) { l = 0.f;
#pragma unroll
            for (int r = 0; r < 16; ++r) { o[0][r] = 0.f; o[1][r] = 0.f; } }
#pragma unroll 1
        for (int st = 0; st < 8; ++st) attn_subtile<false>(lds, nullptr, 32 * st, qf, rowterm, slope2, false, 0, o, l, lane);
        }
        l = half_sum(l, lane);
        moba_store(o, l, qpos, slot, valid, rb, h, OPART, LPART, Y, lane);
    }
    __syncthreads();
}
__device__ __forceinline__ void moba_sel_step(int huA, int S, LAS const int* pre, const unsigned* lcnt, const bf16* PROJ, const unsigned short* LIST, const unsigned* CTAB, bf16* OPART, float* LPART, bf16* Y,
                                              float B2, LAS unsigned char* lds, int tid, int wave, int lane) {
    const int r32 = lane & 31, hh = lane >> 5, half = wave >> 2, tile = wave & 3, htid = tid & 255;
    const int hu = huA + half; const bool uvalid = hu < S;
    int p = 0, chunk = 0, cnt = 0;
    if (uvalid) { int lo2 = 0, hi2 = 768; while (hi2 - lo2 > 1) { const int mid = (lo2 + hi2) >> 1; if (pre[mid] <= hu) lo2 = mid; else hi2 = mid; } p = lo2; chunk = hu - pre[lo2]; cnt = (int)lcnt[lo2]; }
    const int bh = p >> 6, n = p & 63, b = bh / 6, h = bh % 6; const size_t rb = (size_t)b * SEQ;
    const float slope2 = exp2f(-8.f * (float)(h + 1) / 6.f) * LOG2E;
    LAS unsigned char* kv = lds + half * 65536;
    v4u gk[8], gv[8];
    if (uvalid) { const bf16* Kg = PROJ + (rb + (size_t)n * 256) * PLD + C_BK + h * 64; const bf16* Vg = PROJ + (rb + (size_t)n * 256) * PLD + C_BV + h * 64;
#pragma unroll
        for (int i = 0; i < 8; ++i) { const int idx = htid + 256 * i, row = idx >> 3, ch = idx & 7; gk[i] = *(const v4u*)(Kg + (size_t)row * PLD + ch * 8); gv[i] = *(const v4u*)(Vg + (size_t)row * PLD + ch * 8); } }
    const int nvalid = uvalid ? (cnt - chunk * 128 < 128 ? cnt - chunk * 128 : 128) : 0;
    const bool active = tile * 32 < nvalid;
    bool valid = true; int qpos = 0, slot = 0; bf16x8 qf[4];
    if (active) {
        int li = tile * 32 + r32; if (li >= nvalid) { li = nvalid - 1; valid = false; }
        const int pos = chunk * 128 + li;
        const int cv = (lane > n) ? (int)CTAB[((size_t)bh * 64 + lane) * 64 + n] : 0; int inc = cv;
#pragma unroll
        for (int o2 = 1; o2 < 64; o2 <<= 1) { const int t2 = supi(inc, o2, lane); if (lane >= o2) inc += t2; }
        int qseg = 0;
#pragma unroll
        for (int stp = 32; stp >= 1; stp >>= 1) { const int v = shfi(inc, qseg + stp - 1); if (v <= pos) qseg += stp; }
        const int idx = pos - (shfi(inc, qseg) - shfi(cv, qseg));
        const unsigned e = LIST[moba_list_off(bh, n) + (size_t)(qseg - n - 1) * 256 + idx]; qpos = e & 0x3fff; slot = e >> 14;
#pragma unroll
        for (int s = 0; s < 4; ++s) qf[s] = *(const bf16x8*)(PROJ + (rb + qpos) * PLD + C_BQ + h * 64 + 16 * s + 8 * hh);
    }
    if (uvalid) {
#pragma unroll
        for (int i = 0; i < 8; ++i) { const int idx = htid + 256 * i, row = idx >> 3, ch = idx & 7;
            *(LAS v4u*)(kv + ATT_K0 + row * 128 + ((ch ^ ((row >> 1) & 7)) << 4)) = gk[i];
            *(LAS v4u*)(kv + ATT_V0 + row * 128 + ((ch * 16) ^ (((row >> 1) & 1) << 6))) = gv[i]; } }
    __syncthreads();
    if (active) {
        const int qrel = qpos - n * 256;
        const float rowterm = -slope2 * (float)qrel - B2;
        f32x16 o[2]; float l = 0.f;
#pragma unroll
        for (int r = 0; r < 16; ++r) { o[0][r] = 0.f; o[1][r] = 0.f; }
#pragma unroll 1
        for (int st = 0; st < 8; ++st) attn_subtile<false>(kv, nullptr, 32 * st, qf, rowterm, slope2, false, 0, o, l, lane);
        l = half_sum(l, lane);
        moba_store(o, l, qpos, slot, valid, rb, h, OPART, LPART, Y, lane);
    }
    __syncthreads();
}
__device__ __forceinline__ void moba_own_pair(int bh, int nA, int nB, const bf16* PROJ, bf16* OPART, float* LPART, bf16* Y, float B2, LAS unsigned char* lds, int tid, int wave, int lane) {
    const int b = bh / 6, h = bh % 6; const size_t rb = (size_t)b * SEQ; const int r32 = lane & 31, hh = lane >> 5;
    const float slope2 = exp2f(-8.f * (float)(h + 1) / 6.f) * LOG2E;
    GroupRegs GA, GB;
    group_issue(GA, PROJ + (rb + (size_t)nA * 256) * PLD + C_BK + h * 64, PROJ + (rb + (size_t)nA * 256) * PLD + C_BV + h * 64, tid);
    group_issue(GB, PROJ + (rb + (size_t)nB * 256) * PLD + C_BK + h * 64, PROJ + (rb + (size_t)nB * 256) * PLD + C_BV + h * 64, tid);
    bf16x8 qfA[4], qfB[4];
    { const size_t qa = rb + (size_t)nA * 256 + wave * 32 + r32, qb2 = rb + (size_t)nB * 256 + (7 - wave) * 32 + r32;
#pragma unroll
      for (int s = 0; s < 4; ++s) { qfA[s] = *(const bf16x8*)(PROJ + qa * PLD + C_BQ + h * 64 + 16 * s + 8 * hh); qfB[s] = *(const bf16x8*)(PROJ + qb2 * PLD + C_BQ + h * 64 + 16 * s + 8 * hh); } }
    group_commit(GA, lds, tid); group_commit(GB, lds + 65536, tid);
    __syncthreads();
    { const int tile = wave, qrel = tile * 32 + r32, qpos = nA * 256 + qrel;
      const float rowterm = -slope2 * (float)qrel - B2;
      f32x16 o[2]; float l = 0.f;
#pragma unroll
      for (int r = 0; r < 16; ++r) { o[0][r] = 0.f; o[1][r] = 0.f; }
#pragma unroll 1
      for (int st = 0; st <= tile; ++st) attn_subtile<false>(lds, nullptr, 32 * st, qfA, rowterm, slope2, st == tile, qrel, o, l, lane);
      l = half_sum(l, lane);
      moba_store(o, l, qpos, 3, true, rb, h, OPART, LPART, Y, lane); }
    { const int tile = 7 - wave, qrel = tile * 32 + r32, qpos = nB * 256 + qrel;
      const float rowterm = -slope2 * (float)qrel - B2;
      f32x16 o[2]; float l = 0.f;
#pragma unroll
      for (int r = 0; r < 16; ++r) { o[0][r] = 0.f; o[1][r] = 0.f; }
#pragma unroll 1
      for (int st = 0; st <= tile; ++st) attn_subtile<false>(lds + 65536, nullptr, 32 * st, qfB, rowterm, slope2, st == tile, qrel, o, l, lane);
      l = half_sum(l, lane);
      moba_store(o, l, qpos, 3, true, rb, h, OPART, LPART, Y, lane); }
    __syncthreads();
}

__device__ __forceinline__ void moba_combine(const unsigned* SEL, const bf16* OPART, const float* LPART, bf16* Y, bf16* Yo, int opitch, int ocol, int gtid, int ngt) {
    constexpr size_t NIT = (size_t)MROWS * 48;
    for (size_t base = gtid; base < NIT; base += (size_t)ngt * 4) {
        unsigned sel[4]; v4u yv[4]; float lo[4]; size_t row[4]; int hh4[4], c84[4]; bool ok[4];
#pragma unroll
        for (int j = 0; j < 4; ++j) { const size_t idx = base + (size_t)j * ngt; ok[j] = idx < NIT; const size_t ii = ok[j] ? idx : 0;
            row[j] = ii / 48; const int hc = (int)(ii % 48); hh4[j] = hc >> 3; c84[j] = (hc & 7) * 8;
            sel[j] = SEL[row[j] * 6 + hh4[j]]; yv[j] = *(const v4u*)(Y + row[j] * 1024 + Y_MOBA + hh4[j] * 64 + c84[j]); lo[j] = LPART[((size_t)3 * MROWS + row[j]) * 6 + hh4[j]]; }
        v4u pv[4][3]; float pl[4][3];
#pragma unroll
        for (int j = 0; j < 4; ++j)
#pragma unroll
            for (int k = 0; k < 3; ++k) { const bool v = ((sel[j] >> (8 * k)) & 0xff) != 255;
                pv[j][k] = v ? *(const v4u*)(OPART + ((size_t)k * MROWS + row[j]) * 384 + hh4[j] * 64 + c84[j]) : (v4u){0u, 0u, 0u, 0u};
                pl[j][k] = v ? LPART[((size_t)k * MROWS + row[j]) * 6 + hh4[j]] : 0.f; }
#pragma unroll
        for (int j = 0; j < 4; ++j) { float acc[8]; unpack8(yv[j], acc); float l = lo[j];
#pragma unroll
            for (int k = 0; k < 3; ++k) { float f[8]; unpack8(pv[j][k], f);
#pragma unroll
                for (int i = 0; i < 8; ++i) acc[i] += f[i];
                l += pl[j][k]; }
            const float rl = 1.f / l;
            v4u w; w.x = pk2(acc[0] * rl, acc[1] * rl); w.y = pk2(acc[2] * rl, acc[3] * rl); w.z = pk2(acc[4] * rl, acc[5] * rl); w.w = pk2(acc[6] * rl, acc[7] * rl);
            if (ok[j]) *(v4u*)(Yo + row[j] * opitch + ocol + hh4[j] * 64 + c84[j]) = w; }
    }
}

__device__ __forceinline__ int vsw(int row, int colb) { return row * 128 + (colb ^ (((row >> 1) & 1) << 6)); }
__device__ __forceinline__ int ksw(int row, int ch) { return row * 128 + ((ch ^ ((row >> 1) & 7)) << 4); }
__device__ __forceinline__ void mlstm_m1_mfma(int ci, const MlP& P, LAS unsigned char* lds, int wave, int lane) {
    const int b = ci >> 10, h = (ci >> 8) & 3, c = ci & 255; const size_t row0 = (size_t)b * SEQ + c * 64;
    LAS unsigned char* Ki = lds + wave * 16384; LAS unsigned char* Vi = Ki + 8192;
    float wv;
    { const size_t row = row0 + lane;
      const float fi = P.GATES[row * 16 + 6 + h] + P.ibias[h], ff = P.GATES[row * 16 + 10 + h] + P.fbias[h];
      float bc = log_sigmoid_f(ff);
#pragma unroll
      for (int o = 1; o < 64; o <<= 1) { const float n = sup(bc, o, lane); if (lane >= o) bc += n; }
      const float bend = shf(bc, 63);
      const float wl = bend - bc + fi; const float mloc = wave_max(wl);
      wv = expf(wl - mloc);
      if (lane == 0) { P.BEND[ci] = bend; P.MLOC[ci] = mloc; } }
#pragma unroll
    for (int i = 0; i < 8; ++i) { const int idx = lane + 64 * i, r = idx >> 3, ch = idx & 7;
        const v4u kk = *(const v4u*)(P.KC + (row0 + r) * 256 + h * 64 + ch * 8);
        *(LAS v4u*)(Ki + vsw(r, ch * 16)) = kk;
        float f[8]; unpack8(*(const v4u*)(P.PROJ + (row0 + r) * PLD + C_MV + h * 64 + ch * 8), f);
        const float w = shf(wv, r);
        v4u o; o.x = pk2(f[0] * w, f[1] * w); o.y = pk2(f[2] * w, f[3] * w); o.z = pk2(f[4] * w, f[5] * w); o.w = pk2(f[6] * w, f[7] * w);
        *(LAS v4u*)(Vi + vsw(r, ch * 16)) = o; }
    LDS_WAIT(); asm volatile("" ::: "memory");
    { float nu = 0.f;
#pragma unroll 8
      for (int s = 0; s < 64; ++s) { const float ws = shf(wv, s); nu += ws * bf2f(*(LAS const unsigned short*)(Ki + vsw(s, 2 * lane))); }
      P.NU[(size_t)ci * 64 + lane] = nu; }
    f32x16 D[2][2];
#pragma unroll
    for (int a = 0; a < 2; ++a)
#pragma unroll
        for (int e = 0; e < 2; ++e)
#pragma unroll
            for (int r = 0; r < 16; ++r) D[a][e][r] = 0.f;
    const int i16 = lane & 15, cc = (lane >> 4) & 1, hh = lane >> 5, r32 = lane & 31;
#pragma unroll
    for (int ks = 0; ks < 4; ++ks) { const int rowv = 16 * ks + 4 * hh + (i16 >> 2);
        bf16x8 af[2], bfr[2];
#pragma unroll
        for (int blk = 0; blk < 2; ++blk) { const int colb = (32 * blk + 16 * cc + 4 * (i16 & 3)) * 2;
            { const s16x4 lo = vtr(Vi + vsw(rowv, colb)), hi = vtr(Vi + vsw(rowv, colb) + 1024); af[blk] = (bf16x8){lo[0], lo[1], lo[2], lo[3], hi[0], hi[1], hi[2], hi[3]}; }
            { const s16x4 lo = vtr(Ki + vsw(rowv, colb)), hi = vtr(Ki + vsw(rowv, colb) + 1024); bfr[blk] = (bf16x8){lo[0], lo[1], lo[2], lo[3], hi[0], hi[1], hi[2], hi[3]}; } }
#pragma unroll
        for (int a = 0; a < 2; ++a)
#pragma unroll
            for (int e = 0; e < 2; ++e) D[a][e] = __builtin_amdgcn_mfma_f32_32x32x16_bf16(af[a], bfr[e], D[a][e], 0, 0, 0); }
    float* up = P.U + (size_t)ci * 4096;
#pragma unroll
    for (int a = 0; a < 2; ++a)
#pragma unroll
        for (int e = 0; e < 2; ++e)
#pragma unroll
            for (int r = 0; r < 16; ++r) up[(32 * a + crow(r, hh)) * 64 + 32 * e + r32] = D[a][e][r];
    LDS_WAIT(); asm volatile("" ::: "memory");
}

__device__ __forceinline__ void mlstm_m3_mfma(int it, const MlP& P, LAS unsigned char* lds, int tid, int wave, int lane) {
    const int cs = wave >> 1, tile = wave & 1, ci = it * 4 + cs;
    const int b = ci >> 10, h = (ci >> 8) & 3, c = ci & 255; const size_t row0 = (size_t)b * SEQ + c * 64;
    LAS unsigned char* Ki = lds + cs * 32768; LAS unsigned char* Vi = Ki + 8192; LAS unsigned char* Ci = Ki + 16384; LAS unsigned char* Mi = Ki + 24576;
    LAS float* tab = (LAS float*)(lds + ATT_TAB) + cs * 256;
    const float ms = P.MS[ci];
    { const int pt = tile * 64 + lane;
#pragma unroll
      for (int i = 0; i < 4; ++i) { const int idx = pt + 128 * i, r = idx >> 3, ch = idx & 7;
          *(LAS v4u*)(Ki + ksw(r, ch)) = *(const v4u*)(P.KC + (row0 + r) * 256 + h * 64 + ch * 8);
          *(LAS v4u*)(Vi + vsw(r, ch * 16)) = *(const v4u*)(P.PROJ + (row0 + r) * PLD + C_MV + h * 64 + ch * 8);
          *(LAS v4u*)(Ci + ksw(r, ch)) = *(const v4u*)(P.CS + (size_t)ci * 4096 + r * 64 + ch * 8);
          *(LAS v4u*)(Mi + r * 128 + ch * 16) = *(const v4u*)(P.PROJ + (row0 + r) * PLD + C_MO + h * 64 + ch * 8); } }
    if (tile == 0) {
        const size_t row = row0 + lane;
        const float fi = P.GATES[row * 16 + 6 + h] + P.ibias[h], ff = P.GATES[row * 16 + 10 + h] + P.fbias[h];
        float bc = log_sigmoid_f(ff);
#pragma unroll
        for (int o = 1; o < 64; o <<= 1) { const float n = sup(bc, o, lane); if (lane >= o) bc += n; }
        const float a = fi - bc; float pm = a;
#pragma unroll
        for (int o = 1; o < 64; o <<= 1) { const float n = sup(pm, o, lane); if (lane >= o) pm = fmaxf(pm, n); }
        tab[lane] = a * LOG2E; tab[64 + lane] = fmaxf(ms, pm); tab[128 + lane] = bc; tab[192 + lane] = P.NS[(size_t)ci * 64 + lane];
    }
    __syncthreads();
    const int r32 = lane & 31, hh = lane >> 5, j = 32 * tile + r32;
    bf16x8 qf[4];
#pragma unroll
    for (int s = 0; s < 4; ++s) qf[s] = *(const bf16x8*)(P.QC + (row0 + j) * 256 + h * 64 + 16 * s + 8 * hh);
    const float gj = tab[64 + j], inter = expf(ms - gj), rowterm2 = -gj * LOG2E;
    f32x16 o[2]; float l = 0.f;
#pragma unroll
    for (int r = 0; r < 16; ++r) { o[0][r] = 0.f; o[1][r] = 0.f; }
    for (int st = 0; st <= tile; ++st) {
        const int j0 = 32 * st;
        f32x16 acc;
#pragma unroll
        for (int r = 0; r < 16; ++r) acc[r] = 0.f;
#pragma unroll
        for (int s = 0; s < 4; ++s) { const bf16x8 kf = *(LAS const bf16x8*)(Ki + ksw(j0 + r32, 2 * s + hh)); acc = __builtin_amdgcn_mfma_f32_32x32x16_bf16(kf, qf[s], acc, 0, 0, 0); }
        float ls = 0.f;
#pragma unroll
        for (int g4 = 0; g4 < 4; ++g4) { const f32x4 c4 = *(LAS const f32x4*)(tab + j0 + 8 * g4 + 4 * hh);
#pragma unroll
            for (int ii = 0; ii < 4; ++ii) { const int reg = 4 * g4 + ii, key = j0 + 8 * g4 + 4 * hh + ii;
                float p = acc[reg] * __builtin_amdgcn_exp2f(rowterm2 + c4[ii]);
                if (st == tile && key > j) p = 0.f;
                acc[reg] = p; ls += p; } }
        l += ls;
        bf16x8 pa[2];
#pragma unroll
        for (int s = 0; s < 2; ++s) { v4u w; w.x = cvtpk(acc[8 * s + 0], acc[8 * s + 1]); w.y = cvtpk(acc[8 * s + 2], acc[8 * s + 3]); w.z = cvtpk(acc[8 * s + 4], acc[8 * s + 5]); w.w = cvtpk(acc[8 * s + 6], acc[8 * s + 7]); pa[s] = __builtin_bit_cast(bf16x8, w); }
        { const int i16 = lane & 15, cc = (lane >> 4) & 1;
#pragma unroll
          for (int db = 0; db < 2; ++db)
#pragma unroll
              for (int s = 0; s < 2; ++s) { const int rowv = j0 + 16 * s + 4 * hh + (i16 >> 2); const int colb = (32 * db + 16 * cc + 4 * (i16 & 3)) * 2;
                  LAS const unsigned char* vp = Vi + vsw(rowv, colb);
                  const s16x4 lo = vtr(vp), hi = vtr(vp + 1024);
                  const bf16x8 vf = (bf16x8){lo[0], lo[1], lo[2], lo[3], hi[0], hi[1], hi[2], hi[3]};
                  o[db] = __builtin_amdgcn_mfma_f32_32x32x16_bf16(pa[s], vf, o[db], 0, 0, 0); } }
    }
    float dn = 0.f;
#pragma unroll
    for (int s = 0; s < 4; ++s) { float f[8]; unpack8(__builtin_bit_cast(v4u, qf[s]), f);
        const f32x4 n0 = *(LAS const f32x4*)(tab + 192 + 16 * s + 8 * hh), n1 = *(LAS const f32x4*)(tab + 192 + 16 * s + 8 * hh + 4);
        dn += (f[0] * n0.x + f[1] * n0.y) + (f[2] * n0.z + f[3] * n0.w) + (f[4] * n1.x + f[5] * n1.y) + (f[6] * n1.z + f[7] * n1.w);
        v4u w; w.x = cvtpk(f[0] * inter, f[1] * inter); w.y = cvtpk(f[2] * inter, f[3] * inter); w.z = cvtpk(f[4] * inter, f[5] * inter); w.w = cvtpk(f[6] * inter, f[7] * inter);
        const bf16x8 qs = __builtin_bit_cast(bf16x8, w);
#pragma unroll
        for (int db = 0; db < 2; ++db) { const bf16x8 cf = *(LAS const bf16x8*)(Ci + ksw(32 * db + r32, 2 * s + hh)); o[db] = __builtin_amdgcn_mfma_f32_32x32x16_bf16(qs, cf, o[db], 0, 0, 0); } }
    dn = half_sum(dn, lane); l = half_sum(l, lane);
    const float den = inter * dn + l, mj = tab[128 + j] + gj;
    const float rd = 1.f / fmaxf(fabsf(den), expf(-mj));
    const float hg0 = P.hg[h * 64 + r32], hg1 = P.hg[h * 64 + 32 + r32];
    unsigned short mo0[16], mo1[16];
#pragma unroll
    for (int r = 0; r < 16; ++r) { LAS const unsigned short* mq = (LAS const unsigned short*)(Mi + (32 * tile + crow(r, hh)) * 128) + r32; mo0[r] = mq[0]; mo1[r] = mq[32]; }
#pragma unroll
    for (int r = 0; r < 16; ++r) { const int src = crow(r, hh); const float rdr = shf(rd, src);
        const float h0 = o[0][r] * rdr, h1 = o[1][r] * rdr; float ss = h0 * h0 + h1 * h1;
        ss += SWZ_X(ss, 1); ss += SWZ_X(ss, 2); ss += SWZ_X(ss, 4); ss += SWZ_X(ss, 8); ss += SWZ_X(ss, 16);
        const float rr = 1.f / sqrtf(ss * (1.f / 64.f) + EPS);
        LAS unsigned short* mp = (LAS unsigned short*)(Mi + (32 * tile + src) * 128) + r32;
        const float e0 = __builtin_amdgcn_exp2f(-bf2f(mo0[r]) * LOG2E), e1 = __builtin_amdgcn_exp2f(-bf2f(mo1[r]) * LOG2E);
        mp[0] = (unsigned short)f2bf(h0 * rr * hg0 * __builtin_amdgcn_rcpf(1.f + e0));
        mp[32] = (unsigned short)f2bf(h1 * rr * hg1 * __builtin_amdgcn_rcpf(1.f + e1)); }
    LDS_WAIT(); asm volatile("" ::: "memory");
#pragma unroll
    for (int i = 0; i < 4; ++i) { const int rw = (lane >> 3) + 8 * i, ch = lane & 7;
        *(v4u*)(P.Y + (row0 + 32 * tile + rw) * 1024 + Y_ML + h * 64 + ch * 8) = *(LAS const v4u*)(Mi + (32 * tile + rw) * 128 + ch * 16); }
    __syncthreads();
}

__device__ __forceinline__ void top3_ins(float g, int n, float& v0, float& v1, float& v2, int& i0, int& i1, int& i2) {
    const bool c0 = g > v0, c1 = g > v1, c2 = g > v2;
    const float nv2 = c1 ? v1 : (c2 ? g : v2); const int ni2 = c1 ? i1 : (c2 ? n : i2);
    const float nv1 = c0 ? v0 : (c1 ? g : v1); const int ni1 = c0 ? i0 : (c1 ? n : i1);
    v0 = c0 ? g : v0; i0 = c0 ? n : i0; v1 = nv1; i1 = ni1; v2 = nv2; i2 = ni2;
}
__device__ __forceinline__ void moba_gate_mfma(int u, const bf16* PROJ, const float* KMEAN, unsigned* SEL, unsigned* LCNT, unsigned* CTAB, unsigned short* LIST, float B2, float thresh2,
                                               LAS unsigned char* lds, int tid, int wave, int lane) {
    const int bh = u >> 6, qb = 63 - (u & 63), b = bh / 6, h = bh % 6; const int r32 = lane & 31, hh = lane >> 5;
    LAS unsigned char* Khi = lds; LAS unsigned char* Klo = lds + 8192; LAS unsigned* cntl = (LAS unsigned*)(lds + 16384);
    if (tid < 64) cntl[tid] = 0u;
    { const int n = tid >> 3, ch = tid & 7; float f[8];
      if (n < qb) { const float* k0 = KMEAN + ((size_t)bh * NBLK + n) * 64 + ch * 8; const float* k1 = k0 + (size_t)(12 * NBLK * 64);
          const f32x4 a0 = *(const f32x4*)k0, a1 = *(const f32x4*)(k0 + 4), b0 = *(const f32x4*)k1, b1 = *(const f32x4*)(k1 + 4);
          f[0] = a0.x + b0.x; f[1] = a0.y + b0.y; f[2] = a0.z + b0.z; f[3] = a0.w + b0.w; f[4] = a1.x + b1.x; f[5] = a1.y + b1.y; f[6] = a1.z + b1.z; f[7] = a1.w + b1.w; }
      else {
#pragma unroll
          for (int i = 0; i < 8; ++i) f[i] = 0.f; }
      unsigned hi[8]; float lo[8];
#pragma unroll
      for (int i = 0; i < 8; ++i) { hi[i] = f2bf(f[i]); lo[i] = f[i] - bf2f((unsigned short)hi[i]); }
      v4u wh; wh.x = hi[0] | (hi[1] << 16); wh.y = hi[2] | (hi[3] << 16); wh.z = hi[4] | (hi[5] << 16); wh.w = hi[6] | (hi[7] << 16);
      v4u wl; wl.x = pk2(lo[0], lo[1]); wl.y = pk2(lo[2], lo[3]); wl.z = pk2(lo[4], lo[5]); wl.w = pk2(lo[6], lo[7]);
      *(LAS v4u*)(Khi + ksw(n, ch)) = wh; *(LAS v4u*)(Klo + ksw(n, ch)) = wl; }
    const int query = wave * 32 + r32; const size_t row = (size_t)b * SEQ + qb * 256 + query;
    bf16x8 qf[4];
#pragma unroll
    for (int s = 0; s < 4; ++s) qf[s] = *(const bf16x8*)(PROJ + row * PLD + C_BQ + h * 64 + 16 * s + 8 * hh);
    __syncthreads();
    float v0 = -INFINITY, v1 = -INFINITY, v2 = -INFINITY; int i0 = 255, i1 = 255, i2 = 255;
#pragma unroll 1
    for (int st = 0; st < 2; ++st) {
        if (32 * st >= qb) break;
        f32x16 acc;
#pragma unroll
        for (int r = 0; r < 16; ++r) acc[r] = 0.f;
#pragma unroll
        for (int s = 0; s < 4; ++s) { const bf16x8 kh = *(LAS const bf16x8*)(Khi + ksw(32 * st + r32, 2 * s + hh)), kl = *(LAS const bf16x8*)(Klo + ksw(32 * st + r32, 2 * s + hh));
            acc = __builtin_amdgcn_mfma_f32_32x32x16_bf16(kh, qf[s], acc, 0, 0, 0); acc = __builtin_amdgcn_mfma_f32_32x32x16_bf16(kl, qf[s], acc, 0, 0, 0); }
#pragma unroll
        for (int r = 0; r < 16; ++r) { const int n = 32 * st + crow(r, hh); if (n < qb) top3_ins(acc[r], n, v0, v1, v2, i0, i1, i2); }
    }
    { const int pl = lane ^ 32;
      const float w0 = shf(v0, pl), w1 = shf(v1, pl), w2 = shf(v2, pl); const int j0 = shfi(i0, pl), j1 = shfi(i1, pl), j2 = shfi(i2, pl);
      if (j0 != 255) top3_ins(w0, j0, v0, v1, v2, i0, i1, i2);
      if (j1 != 255) top3_ins(w1, j1, v0, v1, v2, i0, i1, i2);
      if (j2 != 255) top3_ins(w2, j2, v0, v1, v2, i0, i1, i2); }
    if (hh == 0) {
        { const float slope2 = exp2f(-8.f * (float)(h + 1) / 6.f) * LOG2E; const float lim = (2.f * B2 + thresh2) / slope2; const int t0 = qb * 256 + query - 255;
          if (i0 != 255 && (float)(t0 - i0 * 256) > lim) i0 = 255;
          if (i1 != 255 && (float)(t0 - i1 * 256) > lim) i1 = 255;
          if (i2 != 255 && (float)(t0 - i2 * 256) > lim) i2 = 255; }
        SEL[row * 6 + h] = (unsigned)i0 | ((unsigned)i1 << 8) | ((unsigned)i2 << 16);
        if (LIST) { const unsigned t = (unsigned)(qb * 256 + query);
            if (i0 != 255) { const unsigned pos = __hip_atomic_fetch_add(cntl + i0, 1u, __ATOMIC_RELAXED, __HIP_MEMORY_SCOPE_WORKGROUP); LIST[moba_list_off(bh, i0) + (size_t)(qb - i0 - 1) * 256 + pos] = (unsigned short)(t | (0u << 14)); }
            if (i1 != 255) { const unsigned pos = __hip_atomic_fetch_add(cntl + i1, 1u, __ATOMIC_RELAXED, __HIP_MEMORY_SCOPE_WORKGROUP); LIST[moba_list_off(bh, i1) + (size_t)(qb - i1 - 1) * 256 + pos] = (unsigned short)(t | (1u << 14)); }
            if (i2 != 255) { const unsigned pos = __hip_atomic_fetch_add(cntl + i2, 1u, __ATOMIC_RELAXED, __HIP_MEMORY_SCOPE_WORKGROUP); LIST[moba_list_off(bh, i2) + (size_t)(qb - i2 - 1) * 256 + pos] = (unsigned short)(t | (2u << 14)); } }
    }
    __syncthreads();
    if (LIST && tid < 64) { const unsigned c = cntl[tid]; CTAB[((size_t)bh * 64 + qb) * 64 + tid] = c; if (c) atomicAdd(LCNT + bh * 64 + tid, c); }
    __syncthreads();
}
#ifndef FOX_MFMA
#define FOX_MFMA 1
#endif
#ifndef MOBA_MFMA
#define MOBA_MFMA 1
#endif
#ifndef REP_P0
#define REP_P0 0
#endif
#ifndef REP_NORM
#define REP_NORM 0
#endif
#ifndef REP_GIN
#define REP_GIN 0
#endif
#ifndef REP_FOX
#define REP_FOX 0
#endif
#ifndef REP_M1
#define REP_M1 0
#endif
#ifndef REP_MIXB
#define REP_MIXB 0
#endif
#ifndef REP_M3
#define REP_M3 0
#endif
#ifndef REP_GGU
#define REP_GGU 0
#endif
#ifndef REP_GATE
#define REP_GATE 0
#endif
#ifndef REP_CONV
#define REP_CONV 0
#endif
#ifndef REP_FCUM
#define REP_FCUM 0
#endif
#ifndef REP_QKN
#define REP_QKN 0
#endif
#ifndef REP_GOUT
#define REP_GOUT 0
#endif
#ifndef REP_GDN
#define REP_GDN 0
#endif
#ifndef REP_COMB
#define REP_COMB 0
#endif
#ifndef REP_BAR
#define REP_BAR 0
#endif
#ifndef REP_GATE2
#define REP_GATE2 0
#endif
#ifndef ML_MFMA
#define ML_MFMA 1
#endif
#ifndef REP_M2
#define REP_M2 0
#endif
#ifndef FOX_OLD
#define FOX_OLD 0
#endif
#if FOX_OLD
#define FOX_FN fox_unit_old
#else
#define FOX_FN fox_unit
#endif
#ifndef REP_PRE
#define REP_PRE 0
#endif
#ifndef GGU_ALIGN
#define GGU_ALIGN true
#endif
#ifndef GGU_SP2
#define GGU_SP2 true
#endif
#ifndef GIN_ALIGN
#define GIN_ALIGN true
#endif
#ifndef GIN_SP2
#define GIN_SP2 true
#endif
#ifndef N_LAUNCH_MODE
#define N_LAUNCH_MODE 1
#endif
constexpr int NPHASE = 2 + 8 * DEPTH;
struct Args { const float* in[20]; float* out; unsigned char* ws; int ph_lo, ph_hi; };
static_assert(sizeof(Args) == 20 * 8 + 8 + 8 + 8, "Args has no padding");

__global__ void __launch_bounds__(NTHREADS, 2) fwd(Args args) {
    extern __shared__ __attribute__((aligned(16))) unsigned char lds_raw[];
    LAS unsigned char* lds = (LAS unsigned char*)lds_raw;
    LAS float* ldsf = (LAS float*)lds_raw;
    volatile LAS unsigned* MISC = (volatile LAS unsigned*)(lds + MISC_OFF);
    const int G = gridDim.x; const int bx = blockIdx.x; const int vcu = (G % 8 == 0) ? (bx % 8) * (G / 8) + bx / 8 : bx;
    const int NGW = G * NWAVES;
#define PH_IDS() int tid = threadIdx.x; asm volatile("" : "+v"(tid)); const int lane = tid & 63, wave = __builtin_amdgcn_readfirstlane(tid >> 6); const int gw = vcu * NWAVES + wave; (void)lane; (void)gw; \
    unsigned char* ws = ws_k; asm volatile("" : "+s"(ws)); gu32* ctl = (gu32*)(ws + WS_CTL); (void)ctl
    unsigned char* const ws_k = args.ws;
    gu32* ctl0 = (gu32*)(ws_k + WS_CTL);
    for (int u = threadIdx.x; u < (LDS_BYTES - LDSCTL_OFF) / 4; u += NTHREADS) ((LAS unsigned*)(lds + LDSCTL_OFF))[u] = 0u;
    __syncthreads();
    XcdBarrier bar; bar.bar = (unsigned*)(ctl0 + CW_BAR); bar.x = 0; bar.st = nullptr;
    if (N_LAUNCH_MODE == 1) bar = xcd_barrier_post((unsigned*)(ctl0 + CW_BAR), MISC + 8);
    const int lo = args.ph_lo, hi = args.ph_hi;
#ifndef PHMASK
#define PHMASK 0xfff
#endif
#define PHEN(j) ((PHMASK >> (j)) & 1)
#define IN(k) ((N_LAUNCH_MODE == 1) || (lo <= (k) && (k) < hi))
#define SEAM(k) do { if (IN(k) && IN((k) + 1)) { xcd_barrier(bar); for (int rb_ = 0; rb_ < REP_BAR; ++rb_) xcd_barrier(bar); } } while (0)

#define PRM(k) (*(const float* const volatile*)(ws + WS_PTAB + 8 * (k)))
#define x_in PRM(0)
#define norm1_g PRM(4)
#define norm2_g PRM(5)
#define fox_f_bias PRM(7)
#define fox_q_g PRM(8)
#define fox_k_g PRM(9)
#define ml_conv_w PRM(10)
#define ml_conv_b PRM(11)
#define ml_i_bias PRM(12)
#define ml_f_bias PRM(13)
#define ml_h_g PRM(14)
#define moba_q_g PRM(15)
#define moba_k_g PRM(16)
#define xres ((float*)PRM(20))
#define MOD ((float*)(ws + WS_MOD))
#define XN ((bf16*)(ws + WS_XN))
#define PROJ ((bf16*)(ws + WS_PROJ))
#define HB ((bf16*)(ws + WS_H))
#define Y ((bf16*)(ws + WS_Y))
#define GATES ((float*)(ws + WS_GATES))
#define FOXCUM ((float*)(ws + WS_FOXCUM))
#define KMEAN ((float*)(ws + WS_KMEAN))
#define QC ((bf16*)(ws + WS_QC))
#define KC ((bf16*)(ws + WS_KC))
#define SEL ((unsigned*)(ws + WS_SEL))
#define mod_l (MOD + (size_t)l * 2 * 6144)
#define MK_MP() const float* const ib_ = ml_i_bias; const float* const fb_ = ml_f_bias; const float* const hg_ = ml_h_g; \
    MlP MP{PROJ, QC, KC, GATES, (float*)(ws + WS_U), (float*)(ws + WS_NU), (float*)(ws + WS_BEND), (float*)(ws + WS_MLOC), (bf16*)(ws + WS_CS), (float*)(ws + WS_NS), (float*)(ws + WS_MS), Y, ib_ + l * 4, fb_ + l * 4, hg_ + l * 256}

    for (int rep = 0; rep <= REP_P0; ++rep)
    if (PHEN(10) && IN(0)) { PH_IDS();
        const float* cvec = args.in[1]; const float* w_ada = args.in[2]; const float* b_ada = args.in[3]; const float* w_in = args.in[6];
        const float* w_out = args.in[17]; const float* w_gate_up = args.in[18]; const float* w_down = args.in[19];
        if (blockIdx.x == 0 && tid == 0) { const float** pt = (const float**)(ws + WS_PTAB);
            pt[0] = args.in[0]; pt[4] = args.in[4]; pt[5] = args.in[5]; pt[7] = args.in[7]; pt[8] = args.in[8]; pt[9] = args.in[9]; pt[10] = args.in[10]; pt[11] = args.in[11]; pt[12] = args.in[12];
            pt[13] = args.in[13]; pt[14] = args.in[14]; pt[15] = args.in[15]; pt[16] = args.in[16]; pt[20] = args.out; }
        if (vcu < 192) p0_mod_unit(vcu, cvec, w_ada, b_ada, MOD, ldsf, tid, wave, lane);
        LAS float* scr = (LAS float*)(lds + wave * 16384);
        constexpr int I_IN = 16 * (NIN / 32), I_OUT = 16 * (DM / 32), I_GU = 16 * (NGU / 32), I_DN = (DFF / 64) * (DM / 32), I_L = I_IN + I_OUT + I_GU + I_DN;
        for (int it = gw; it < DEPTH * I_L; it += NGW) {
            const int l = it / I_L; int r = it % I_L;
            if (r < I_IN) { transpose_item<1>(w_in + (size_t)l * DM * INC, DM, INC, (bf16*)(ws + WS_WIN + l * WIN_BYTES), scr, NIN / 32, r, lane); continue; } r -= I_IN;
            if (r < I_OUT) { transpose_item<0>(w_out + (size_t)l * DM * DM, DM, DM, (bf16*)(ws + WS_WOUT + l * WOUT_BYTES), scr, DM / 32, r, lane); continue; } r -= I_OUT;
            if (r < I_GU) { transpose_item<2>(w_gate_up + (size_t)l * DM * NGU, DM, NGU, (bf16*)(ws + WS_WGU + l * WGU_BYTES), scr, NGU / 32, r, lane); continue; } r -= I_GU;
            transpose_item<0>(w_down + (size_t)l * DFF * DM, DFF, DM, (bf16*)(ws + WS_WDN + l * WDN_BYTES), scr, DM / 32, r, lane);
        }
        if (REP_P0) __syncthreads();
    }
    SEAM(0);
    for (int rep = 0; rep <= REP_PRE; ++rep)
    if (PHEN(11) && IN(1)) { PH_IDS();
        const float* n1g = norm1_g; const float* n2g = norm2_g;
        pre_rows(x_in, n1g, MOD, XN, (float*)(ws + WS_SSP), gw, NGW, lane);
        pre_avec(n1g, n2g, MOD, (float*)(ws + WS_AVEC), vcu * NTHREADS + tid, G * NTHREADS);
        for (int l = 0; l < DEPTH; ++l) {
            const float* m0 = MOD + (size_t)l * 2 * 6144; const float* m1 = m0 + 6144;
            pre_bias((const bf16*)(ws + WS_WIN + l * WIN_BYTES), NIN, m0, m1, (float*)(ws + WS_BIASIN) + (size_t)l * 2 * NIN, (float*)(ws + WS_BIASIN) + (size_t)l * 2 * NIN + NIN, gw, NGW, lane);
            pre_bias((const bf16*)(ws + WS_WGU + l * WGU_BYTES), NGU, m0 + 3072, m1 + 3072, (float*)(ws + WS_BIASGU) + (size_t)l * 2 * NGU, (float*)(ws + WS_BIASGU) + (size_t)l * 2 * NGU + NGU, gw, NGW, lane);
        }
    }
    SEAM(1);

    for (int l = 0; l < DEPTH; ++l) {
        const int pb = 2 + 8 * l;
        for (int rep = 0; rep <= REP_GIN; ++rep)
        if (PHEN(0) && IN(pb + 0)) { PH_IDS();
            pg8::Gemm g{XN, (const bf16*)(ws + WS_WIN + l * WIN_BYTES), MROWS, NIN, DM}; pg8::StaticOrder S; S.init(MROWS, NIN, G, bx);
            LAS float* rt = (LAS float*)(lds + ATT_TAB); LAS float* bt = rt + 512;
            const int pm0 = rstd_tables(S, (const float*)(ws + WS_SSP), rt, (const float*)(ws + WS_BIASIN) + (size_t)l * 2 * NIN, NIN, bt, tid);
            pg8::EpiProj E{PROJ, GATES, PLD, rt, pm0, bt};
            pg8::gemm_phase<pg8::EpiProj, pg8::StaticOrder, GIN_ALIGN, GIN_SP2>(lds, g, S, E, tid);
        }
        SEAM(pb + 0);
        if (PHEN(1) && IN(pb + 1)) { PH_IDS();
            for (int u = vcu; u < 524; u += G) {
                if (u < 12) post_foxcum_unit(u, GATES, FOXCUM, fox_f_bias + l * 6, ldsf, tid, wave, lane);
                else if (u < 268) post_qknorm_unit(u - 12, PROJ, KMEAN, fox_q_g + l * 64, fox_k_g + l * 64, moba_q_g + l * 64, moba_k_g + l * 64, ldsf, tid, wave, lane);
                else { const int which = (u - 268) & 1; post_conv_unit((u - 268) >> 1, which, PROJ, which ? KC : QC, ml_conv_w + l * 4 * 512, ml_conv_b + l * 512, tid); }
            }
            for (int rep = 0; rep < REP_CONV; ++rep) for (int u = vcu; u < 256; u += G) { const int which = u & 1; post_conv_unit(u >> 1, which, PROJ, which ? KC : QC, ml_conv_w + l * 4 * 512, ml_conv_b + l * 512, tid); }
            for (int rep = 0; rep < REP_FCUM; ++rep) for (int u = vcu; u < 12; u += G) post_foxcum_unit(u, GATES, FOXCUM, fox_f_bias + l * 6, ldsf, tid, wave, lane);
        }
        SEAM(pb + 1);
        if (PHEN(2) && IN(pb + 2)) { PH_IDS(); MK_MP();
            const float B2m = 8.f * LOG2E * wave_max(fabsf(moba_q_g[l * 64 + lane])) * wave_max(fabsf(moba_k_g[l * 64 + lane])) * 1.01f;
            unsigned* LCNT = (unsigned*)(ctl + CW_LCNT + l * 768); unsigned short* LIST = MOBA_MFMA ? (unsigned short*)(ws + WS_LIST) : nullptr;
#if ML_MFMA
#ifndef GATE_MFMA
#define GATE_MFMA 1
#endif
#if GATE_MFMA
            for (int u = vcu; u < 768; u += G) moba_gate_mfma(u, PROJ, KMEAN, SEL, LCNT, (unsigned*)(ws + WS_CTAB), LIST, B2m, THRESH2, lds, tid, wave, lane);
#else
            for (int u = vcu; u < 768; u += G) moba_gate_unit(u, PROJ, KMEAN, SEL, LCNT, (unsigned*)(ws + WS_CTAB), LIST, B2m, THRESH2, ldsf, tid);
#endif
            for (int u = gw; u < 2048; u += NGW) mlstm_m1_mfma(u, MP, lds, wave, lane);
            __syncthreads();
#else
            for (int u = vcu; u < 768 + 2048; u += G) {
                if (u < 768) moba_gate_unit(u, PROJ, KMEAN, SEL, LCNT, (unsigned*)(ws + WS_CTAB), LIST, B2m, THRESH2, ldsf, tid);
                else mlstm_m1(u - 768, MP, ldsf, tid, wave, lane);
            }
#endif
            for (int rep = 0; rep < REP_GATE; ++rep) for (int u = vcu; u < 768; u += G) moba_gate_unit(u, PROJ, KMEAN, SEL, LCNT, (unsigned*)(ws + WS_CTAB), nullptr, B2m, THRESH2, ldsf, tid);
            for (int rep = 0; rep < REP_GATE2; ++rep) for (int u = vcu; u < 768; u += G) moba_gate_unit(u, PROJ, KMEAN, SEL, LCNT + 4096, (unsigned*)(ws + WS_OPART + 32 * MiB), (unsigned short*)(ws + WS_OPART), B2m, THRESH2, ldsf, tid);
            for (int rep = 0; rep < REP_M1; ++rep) for (int u = vcu; u < 2048; u += G) mlstm_m1(u, MP, ldsf, tid, wave, lane);
#if FOX_MFMA
            { const float gq = wave_max(fabsf(fox_q_g[l * 64 + lane])), gk = wave_max(fabsf(fox_k_g[l * 64 + lane])); const float B2 = 8.f * LOG2E * gq * gk * 1.01f;
              for (int rep = 0; rep <= REP_FOX; ++rep)
              for (int u = vcu; u < 768; u += G) FOX_FN(u >> 6, 63 - (u & 63), PROJ, FOXCUM, Y, B2, lds, tid, wave, lane); }
#else
            fox_naive(PROJ, FOXCUM, Y, gw, NGW, lane);
#endif
        }
        SEAM(pb + 2);
        for (int rep = 0; rep <= REP_MIXB; ++rep)
        if (PHEN(3) && IN(pb + 3)) { PH_IDS(); MK_MP();
            for (int rep = 0; rep <= REP_M2; ++rep)
            for (int u = vcu; u < 64; u += G) mlstm_m2(u, MP, ldsf, tid, wave, lane);
#if MOBA_MFMA
            { const float gq = wave_max(fabsf(moba_q_g[l * 64 + lane])), gk = wave_max(fabsf(moba_k_g[l * 64 + lane])); const float B2 = 8.f * LOG2E * gq * gk * 1.01f;
              LAS int* pre = (LAS int*)(lds + ATT_TAB + 1024);
              const unsigned* lcnt = (const unsigned*)(ctl + CW_LCNT + l * 768);
              if (wave == 0) { int carry = 0;
                  for (int r = 0; r < 12; ++r) { const int p = r * 64 + lane; int x = (int)((lcnt[p] + 127u) >> 7);
#pragma unroll
                      for (int o = 1; o < 64; o <<= 1) { const int n = supi(x, o, lane); if (lane >= o) x += n; }
                      pre[p + 1] = carry + x; carry += shfi(x, 63); }
                  if (lane == 0) pre[0] = 0; }
              __syncthreads();
              const int S = pre[768];
              const unsigned short* LIST = (const unsigned short*)(ws + WS_LIST); bf16* OPART = (bf16*)(ws + WS_OPART); float* LPART = (float*)(ws + WS_LPART);
              #ifndef KSKIP_N
#define KSKIP_N 3
#endif
              constexpr int KSKIP = KSKIP_N; const int S2 = (S + 1) >> 1; const int NU = S2 + 384;
              for (int i = (vcu < 64 ? KSKIP : 0); ; ++i) {
                  const int u = (i < KSKIP) ? i * (G - 64) + (vcu - 64) : KSKIP * (G - 64) + (i - KSKIP) * G + vcu;
                  if (u >= NU) break;
                  if (u < S2) moba_sel_step(2 * u, S, pre, lcnt, PROJ, LIST, (const unsigned*)(ws + WS_CTAB), OPART, LPART, Y, B2, lds, tid, wave, lane);
                  else { const int p = u - S2; moba_own_pair(p >> 5, p & 31, 63 - (p & 31), PROJ, OPART, LPART, Y, B2, lds, tid, wave, lane); }
              } }
#else
            moba_naive(PROJ, SEL, Y, gw, NGW, lane);
#endif
        }
        SEAM(pb + 3);
        if (PHEN(4) && IN(pb + 4)) { PH_IDS(); MK_MP();
#if ML_MFMA
            for (int rep = 0; rep <= REP_M3; ++rep)
            for (int u = vcu; u < 512; u += G) mlstm_m3_mfma(u, MP, lds, tid, wave, lane);
#else
            for (int rep = 0; rep <= REP_M3; ++rep)
            for (int u = vcu; u < 2048; u += G) mlstm_m3(u, MP, ldsf, tid, wave, lane);
#endif
#if MOBA_MFMA
            for (int rep = 0; rep < REP_COMB; ++rep) moba_combine(SEL, (const bf16*)(ws + WS_OPART), (const float*)(ws + WS_LPART), Y, (bf16*)(ws + WS_U), 384, 0, vcu * NTHREADS + tid, G * NTHREADS);
            moba_combine(SEL, (const bf16*)(ws + WS_OPART), (const float*)(ws + WS_LPART), Y, Y, 1024, Y_MOBA, vcu * NTHREADS + tid, G * NTHREADS);
#endif
        }
        SEAM(pb + 4);
        if (PHEN(5) && IN(pb + 5)) { PH_IDS();
            pg8::Gemm g{Y, (const bf16*)(ws + WS_WOUT + l * WOUT_BYTES), MROWS, DM, DM}; pg8::StaticOrder S; S.init(MROWS, DM, G, bx);
            float* const xr = xres; const float* const xcur = (l == 0) ? x_in : (const float*)xr;
            pg8::EpiRes E{xcur, xr, mod_l + 2048, 6144, SEQ, XN, (const float*)(ws + WS_AVEC) + (size_t)((l * 2 + 1) * 2) * 1024, (float*)(ws + WS_SSP)};
            pg8::gemm_phase<pg8::EpiRes, pg8::StaticOrder, true, true>(lds, g, S, E, tid);
        }
        SEAM(pb + 5);
        for (int rep = 0; rep <= REP_GGU; ++rep)
        if (PHEN(6) && IN(pb + 6)) { PH_IDS();
            pg8::Gemm g{XN, (const bf16*)(ws + WS_WGU + l * WGU_BYTES), MROWS, NGU, DM}; pg8::StaticOrder S; S.init(MROWS, NGU, G, bx);
            LAS float* rt = (LAS float*)(lds + ATT_TAB); LAS float* bt = rt + 512;
            const int pm0 = rstd_tables(S, (const float*)(ws + WS_SSP), rt, (const float*)(ws + WS_BIASGU) + (size_t)l * 2 * NGU, NGU, bt, tid);
            pg8::EpiSwiglu E{HB, DFF, rt, pm0, bt};
            pg8::gemm_phase<pg8::EpiSwiglu, pg8::StaticOrder, GGU_ALIGN, GGU_SP2>(lds, g, S, E, tid);
        }
        SEAM(pb + 6);
        if (PHEN(7) && IN(pb + 7)) { PH_IDS();
            pg8::Gemm g{HB, (const bf16*)(ws + WS_WDN + l * WDN_BYTES), MROWS, DM, DFF}; pg8::StaticOrder S; S.init(MROWS, DM, G, bx);
            float* const xr = xres;
            pg8::EpiRes E{xr, xr, mod_l + 5120, 6144, SEQ, (l + 1 < DEPTH) ? XN : (bf16*)nullptr, (const float*)(ws + WS_AVEC) + (size_t)(((l + 1) * 2 + 0) * 2) * 1024, (float*)(ws + WS_SSP)};
            pg8::gemm_phase<pg8::EpiRes, pg8::StaticOrder, true, true>(lds, g, S, E, tid);
        }
        SEAM(pb + 7);
    }
#undef IN
#undef SEAM
}

extern "C" void kernel_launch(void* const* d_in, const int* in_sizes, int n_in, void* d_out, int out_size, void* d_ws, size_t ws_size, hipStream_t stream) {
    static int grid = 0;
    if (grid == 0) {
        if (n_in != 20 || in_sizes[0] != MROWS * DM || out_size != MROWS * DM || ws_size < WS_END) {
            fprintf(stderr, "kernel_launch: unexpected shapes: n_in %d in0 %d out %d ws %zu (need >= %zu)\n", n_in, n_in > 0 ? in_sizes[0] : -1, out_size, ws_size, (size_t)WS_END); grid = -1; return; }
        int dev = 0, cus = 0, per_cu = 0;
        if (hipGetDevice(&dev) != hipSuccess || hipDeviceGetAttribute(&cus, hipDeviceAttributeMultiprocessorCount, dev) != hipSuccess) { grid = -1; return; }
        if (hipFuncSetAttribute((const void*)fwd, hipFuncAttributeMaxDynamicSharedMemorySize, LDS_BYTES) != hipSuccess) { fprintf(stderr, "kernel_launch: hipFuncSetAttribute failed\n"); grid = -1; return; }
        if (hipOccupancyMaxActiveBlocksPerMultiprocessor(&per_cu, (const void*)fwd, NTHREADS, LDS_BYTES) != hipSuccess || per_cu < 1)
            fprintf(stderr, "kernel_launch: note: occupancy query reports %d workgroups per CU\n", per_cu);
        (void)hipGetLastError();
        grid = cus;
    }
    if (grid < 0) return;
    if (hipMemsetAsync((char*)d_ws + WS_CTL, 0, CTL_ZERO_BYTES, stream) != hipSuccess) return;
    Args a{};
    for (int i = 0; i < 20; ++i) a.in[i] = (const float*)d_in[i];
    a.out = (float*)d_out; a.ws = (unsigned char*)d_ws;
    if (N_LAUNCH_MODE == 1) { a.ph_lo = 0; a.ph_hi = NPHASE; hipLaunchKernelGGL(fwd, dim3(grid), dim3(NTHREADS), LDS_BYTES, stream, a); }
    else for (int p = 0; p < NPHASE; ++p) { a.ph_lo = p; a.ph_hi = p + 1; hipLaunchKernelGGL(fwd, dim3(grid), dim3(NTHREADS), LDS_BYTES, stream, a); }
}
```

```cpp
#include <hip/hip_runtime.h>
#include <cstdio>
#include <cstdint>

constexpr int DM = 1024, NBATCH = 2, SEQ = 16384, MROWS = NBATCH * SEQ, DEPTH = 2;
constexpr int HD = 64, FOXH = 6, MLH = 4, MOBH = 6;
constexpr int DFF = 2816, INC = 3342, NIN = 3584, PLD = 3328;
constexpr int NGU = 2 * DFF;
constexpr int C_FQ = 0, C_FK = 384, C_FV = 768, C_BQ = 1152, C_BK = 1536, C_BV = 1920, C_MQ = 2304, C_MK = 2560, C_MV = 2816, C_MO = 3072, C_G = 3328;
constexpr int Y_FOX = 0, Y_ML = 384, Y_MOBA = 640;
constexpr int MOBA_BS = 256, NBLK = SEQ / MOBA_BS;
constexpr int MLC = 64, NCHUNK = SEQ / MLC;
constexpr float LOG2E = 1.4426950408889634f;
constexpr float QSCALE = 0.125f * LOG2E;
constexpr float EPS = 1e-6f;

#define GAS __attribute__((address_space(1)))
#define LAS __attribute__((address_space(3)))
typedef unsigned short bf16;
typedef unsigned v4u __attribute__((ext_vector_type(4)));
typedef unsigned v2u __attribute__((ext_vector_type(2)));
typedef float f32x4 __attribute__((ext_vector_type(4)));
typedef short bf16x8 __attribute__((ext_vector_type(8)));
typedef float f32x16 __attribute__((ext_vector_type(16)));
typedef GAS unsigned gu32;
#define RLX_AGENT __ATOMIC_RELAXED, __HIP_MEMORY_SCOPE_AGENT
__device__ __forceinline__ unsigned f2bf(float f) { unsigned u = __builtin_bit_cast(unsigned, f); return (u + 0x7fffu + ((u >> 16) & 1u)) >> 16; }
__device__ __forceinline__ unsigned pk2(float lo, float hi) { return f2bf(lo) | (f2bf(hi) << 16); }
__device__ __forceinline__ float bf2f(unsigned short u) { return __builtin_bit_cast(float, (unsigned)u << 16); }
__device__ __forceinline__ float bflo(unsigned w) { return __builtin_bit_cast(float, w << 16); }
__device__ __forceinline__ float bfhi(unsigned w) { return __builtin_bit_cast(float, w & 0xffff0000u); }
#ifndef OLD_SHFL
#define OLD_SHFL 0
#endif
#ifndef OLD_SWZ
#define OLD_SWZ OLD_SHFL
#endif
#ifndef OLD_HALF
#define OLD_HALF OLD_SHFL
#endif
#ifndef OLD_SHF
#define OLD_SHF OLD_SHFL
#endif
#ifndef OLD_SUP
#define OLD_SUP OLD_SHFL
#endif
#if OLD_SWZ
#define SWZ_X(v, o) __shfl_xor((float)(v), (o))
#else
#define SWZ_X(v, o) __builtin_bit_cast(float, __builtin_amdgcn_ds_swizzle(__builtin_bit_cast(int, (float)(v)), ((o) << 10) | 0x1f))
#endif
__device__ __forceinline__ float half_sum(float v, int lane) { return v + __builtin_bit_cast(float, __builtin_amdgcn_ds_bpermute((lane ^ 32) << 2, __builtin_bit_cast(int, v))); }
#if OLD_SHF
__device__ __forceinline__ float shf(float v, int src) { return __shfl(v, src); }
__device__ __forceinline__ int shfi(int v, int src) { return __shfl(v, src); }
#else
__device__ __forceinline__ float shf(float v, int src) { return __builtin_bit_cast(float, __builtin_amdgcn_ds_bpermute(src << 2, __builtin_bit_cast(int, v))); }
__device__ __forceinline__ int shfi(int v, int src) { return __builtin_amdgcn_ds_bpermute(src << 2, v); }
#endif
#if OLD_SUP
__device__ __forceinline__ float sup(float v, int o, int lane) { return __shfl_up(v, o); }
__device__ __forceinline__ int supi(int v, int o, int lane) { return __shfl_up(v, o); }
#else
__device__ __forceinline__ float sup(float v, int o, int lane) { return shf(v, lane >= o ? lane - o : lane); }
__device__ __forceinline__ int supi(int v, int o, int lane) { return shfi(v, lane >= o ? lane - o : lane); }
#endif
__device__ __forceinline__ float wave_sum(float v) { v += SWZ_X(v, 1); v += SWZ_X(v, 2); v += SWZ_X(v, 4); v += SWZ_X(v, 8); v += SWZ_X(v, 16);
    return __builtin_bit_cast(float, __builtin_amdgcn_readlane(__builtin_bit_cast(int, v), 0)) + __builtin_bit_cast(float, __builtin_amdgcn_readlane(__builtin_bit_cast(int, v), 32)); }
__device__ __forceinline__ float wave_max(float v) { v = fmaxf(v, SWZ_X(v, 1)); v = fmaxf(v, SWZ_X(v, 2)); v = fmaxf(v, SWZ_X(v, 4)); v = fmaxf(v, SWZ_X(v, 8)); v = fmaxf(v, SWZ_X(v, 16));
    return fmaxf(__builtin_bit_cast(float, __builtin_amdgcn_readlane(__builtin_bit_cast(int, v), 0)), __builtin_bit_cast(float, __builtin_amdgcn_readlane(__builtin_bit_cast(int, v), 32))); }
__device__ __forceinline__ float log_sigmoid_f(float x) { return fminf(x, 0.f) - log1pf(expf(-fabsf(x))); }
__device__ __forceinline__ float log_sigmoid_fast(float x) { const float x2 = x * LOG2E; return 0.6931471805599453f * (fminf(x2, 0.f) - __builtin_amdgcn_logf(1.f + __builtin_amdgcn_exp2f(-fabsf(x2)))); }
__device__ __forceinline__ float exp_fast(float x) { return __builtin_amdgcn_exp2f(x * LOG2E); }
__device__ __forceinline__ float sigmoid_f(float x) { return 1.f / (1.f + expf(-x)); }

constexpr size_t MiB = 1u << 20;
constexpr size_t WS_CTL = 0, CTL_ZERO_BYTES = 1 * MiB;
constexpr size_t WS_MOD = 1 * MiB;
constexpr size_t WS_KMEAN = WS_MOD + 128 * 1024;
constexpr size_t WS_MLS = WS_KMEAN + 512 * 1024;
constexpr size_t WS_BEND = WS_MLS, WS_MLOC = WS_MLS + 8192, WS_MS = WS_MLS + 16384, WS_NU = WS_MLS + 32768, WS_NS = WS_NU + 2048 * 64 * 4;
constexpr size_t WS_CTAB = 3 * MiB;
constexpr size_t WS_PTAB = WS_CTAB + 256 * 1024;
static_assert(WS_NS + 2048 * 64 * 4 <= WS_CTAB && WS_CTAB + 12 * 64 * 64 * 4 <= WS_PTAB && WS_PTAB + 256 <= 4 * MiB, "small region");
constexpr size_t WS_WIN = 4 * MiB, WIN_BYTES = (size_t)NIN * DM * 2;
constexpr size_t WS_WOUT = WS_WIN + 2 * WIN_BYTES, WOUT_BYTES = (size_t)DM * DM * 2;
constexpr size_t WS_WGU = WS_WOUT + 2 * WOUT_BYTES, WGU_BYTES = (size_t)NGU * DM * 2;
constexpr size_t WS_WDN = WS_WGU + 2 * WGU_BYTES, WDN_BYTES = (size_t)DM * DFF * 2;
static_assert(WS_WDN + 2 * WDN_BYTES <= 56 * MiB, "weights");
constexpr size_t WS_SSP = 56 * MiB;
constexpr size_t WS_AVEC = 58 * MiB;
constexpr size_t WS_BIASIN = WS_AVEC + 64 * 1024;
constexpr size_t WS_BIASGU = WS_BIASIN + 64 * 1024;
static_assert(WS_BIASGU + 2 * 2 * NGU * 4 <= 64 * MiB && 2 * 2 * NIN * 4 <= 64 * 1024, "fused-norm vectors");
constexpr size_t WS_XN = 64 * MiB;
constexpr size_t WS_U = 64 * MiB;
constexpr size_t WS_CS = 96 * MiB;
constexpr size_t WS_LIST = 112 * MiB;
constexpr size_t WS_PROJ = 128 * MiB;
constexpr size_t WS_H = 128 * MiB;
constexpr size_t WS_Y = 336 * MiB;
constexpr size_t WS_QC = 400 * MiB, WS_KC = 416 * MiB;
constexpr size_t WS_OPART = 432 * MiB;
constexpr size_t WS_LPART = 504 * MiB;
constexpr size_t WS_GATES = 507 * MiB;
constexpr size_t WS_FOXCUM = 509 * MiB;
constexpr size_t WS_SEL = 510 * MiB;
constexpr size_t WS_END = 512 * MiB;
static_assert(WS_PROJ + (size_t)MROWS * PLD * 2 <= WS_Y && WS_SEL + (size_t)MROWS * 6 * 4 <= WS_END, "ws map");
constexpr int CW_BAR = 4096;
constexpr int CW_QUEUE = 16384;
constexpr int CW_LCNT = 32768;

constexpr int RING_BYTES = 131072, LDSCTL_OFF = RING_BYTES, MISC_OFF = LDSCTL_OFF + 320, LDS_BYTES = 147456;
constexpr int NWAVES = 8, NTHREADS = 512;
namespace pg8 {
#define PG8_LAS __attribute__((address_space(3)))
typedef unsigned short bf16_t;
typedef short bf16x8 __attribute__((ext_vector_type(8)));
typedef float f32x4 __attribute__((ext_vector_type(4)));
typedef unsigned u32x4 __attribute__((ext_vector_type(4)));
constexpr int BM = 256, BK = 64, HALF = 128, HTB = HALF * BK * 2  , STAGE_BYTES = 8 * HTB, NXCD = 8, WGM = 8;

__host__ __device__ __forceinline__ int lds_byte(int r, int c) { const int st = (r >> 4) * 2 + (c >> 5), rr = r & 15, cc = c & 31, ob = rr * 64 + cc * 2; return st * 1024 + (ob ^ (((ob >> 9) & 1) << 5)); }
__host__ __device__ __forceinline__ void stage_rc(int b, int& R, int& C) { const int st = b / 1024, sb = b % 1024, swz = sb ^ (((sb >> 9) & 1) << 5); R = (st >> 1) * 16 + swz / 64; C = (st & 1) * 32 + (swz % 64) / 2; }
__host__ __device__ __forceinline__ int perm32(int rho) { const int n = rho >> 4, i = rho & 15; return 8 * (i >> 2) + 4 * n + (i & 3); }

struct Unit { int pm, pn, ord; };
struct Gemm { const bf16_t* A; const bf16_t* Bt; int M, N, K; };

struct StaticOrder {
    int nM, nN, nwg, G, c;
    __host__ __device__ void init(int M, int N, int G_, int c_) { nM = M / BM; nN = N / BM; nwg = nM * nN; G = G_; c = c_; }
    __host__ __device__ bool next(int i, Unit& u) const {
        const long L = (long)i * G + c; if (L >= nwg) return false;
        int wgid = (int)L; { const int q = nwg / NXCD, r = nwg % NXCD, xcd = wgid % NXCD, off = wgid / NXCD; wgid = (xcd < r ? xcd * (q + 1) : r * (q + 1) + (xcd - r) * q) + off; }
        const int nig = WGM * nN, gid = wgid / nig, fm = gid * WGM, gsz = (nM - fm) < WGM ? (nM - fm) : WGM;
        u.pm = fm + ((wgid % nig) % gsz); u.pn = (wgid % nig) / gsz; u.ord = i; return true;
    }
    __device__ __forceinline__ void a_ready(const Unit&) const {}
    __device__ __forceinline__ void done(const Unit&) const {}
};

__device__ __forceinline__ unsigned cvt_pk_bf16(float lo, float hi) { unsigned r; asm volatile("v_cvt_pk_bf16_f32 %0, %1, %2" : "=v"(r) : "v"(lo), "v"(hi)); return r; }
typedef float f32x2 __attribute__((ext_vector_type(2)));
typedef unsigned u32x2 __attribute__((ext_vector_type(2)));
struct EpiProj {
    static constexpr bool PERM = true, AFTER_DRAIN = false;
    bf16_t* P; float* G; int pld; PG8_LAS const float* rt; int pm0; PG8_LAS const float* bt;
    __device__ __forceinline__ void operator()(const f32x4 (&acc)[2][2][4][2], const Unit& u, int wr, int wc, int fr, int fq) const {
        const int row0 = u.pm * BM + wr * 64 + fr;
        PG8_LAS const float* rs = rt + (u.pm == pm0 ? 0 : 256) + wr * 64 + fr;
        PG8_LAS const float* bb = bt + u.ord * 256 + wc * 32 + 8 * fq;
        if (u.pn < 13) {
            const int col0 = u.pn * BM + wc * 32 + 8 * fq;
            f32x4 bv[2][2];
#pragma unroll
            for (int bj = 0; bj < 2; ++bj)
#pragma unroll
                for (int n = 0; n < 2; ++n) bv[bj][n] = *(PG8_LAS const f32x4*)(bb + bj * HALF + 4 * n);
            float rsv[2][4];
#pragma unroll
            for (int ai = 0; ai < 2; ++ai)
#pragma unroll
                for (int m = 0; m < 4; ++m) rsv[ai][m] = rs[ai * HALF + m * 16];
#pragma unroll
            for (int ai = 0; ai < 2; ++ai)
#pragma unroll
                for (int m = 0; m < 4; ++m) { bf16_t* rowp = P + (size_t)(row0 + ai * HALF + m * 16) * pld + col0; const float rstd = rsv[ai][m];
#pragma unroll
                    for (int bj = 0; bj < 2; ++bj) { const f32x4 v0 = acc[ai][bj][m][0] * rstd + bv[bj][0], v1 = acc[ai][bj][m][1] * rstd + bv[bj][1];
                        u32x4 w; w.x = cvt_pk_bf16(v0[0], v0[1]); w.y = cvt_pk_bf16(v0[2], v0[3]); w.z = cvt_pk_bf16(v1[0], v1[1]); w.w = cvt_pk_bf16(v1[2], v1[3]);
                        *(u32x4*)(rowp + bj * HALF) = w; } }
        } else {
            if (wc == 0 && fq < 2) {
                const f32x4 b0 = *(PG8_LAS const f32x4*)(bb), b1 = *(PG8_LAS const f32x4*)(bb + 4);
#pragma unroll
                for (int ai = 0; ai < 2; ++ai)
#pragma unroll
                    for (int m = 0; m < 4; ++m) { float* gp = G + (size_t)(row0 + ai * HALF + m * 16) * 16 + 8 * fq; const float rstd = rs[ai * HALF + m * 16];
                        *(f32x4*)(gp) = acc[ai][0][m][0] * rstd + b0; *(f32x4*)(gp + 4) = acc[ai][0][m][1] * rstd + b1; }
            }
        }
    }
};
struct EpiRes {
    static constexpr bool PERM = true, AFTER_DRAIN = false;
    const float* base; float* out; const float* gate; int gate_bstride; int rows_per_batch; bf16_t* xa; const float* avec; float* ssp;
    __device__ __forceinline__ void operator()(const f32x4 (&acc)[2][2][4][2], const Unit& u, int wr, int wc, int fr, int fq) const {
        const int row0 = u.pm * BM + wr * 64 + fr, col0 = u.pn * BM + wc * 32 + 8 * fq;
        const int bat = (u.pm * BM) / rows_per_batch;
        const float* gb = gate + (size_t)bat * gate_bstride;
        f32x4 gv[2][2], av[2][2];
#pragma unroll
        for (int bj = 0; bj < 2; ++bj)
#pragma unroll
            for (int n = 0; n < 2; ++n) { gv[bj][n] = *(const f32x4*)(gb + col0 + bj * HALF + 4 * n); av[bj][n] = xa ? *(const f32x4*)(avec + (size_t)bat * 1024 + col0 + bj * HALF + 4 * n) : (f32x4){0.f, 0.f, 0.f, 0.f}; }
        const int lane = fq * 16 + fr;
#pragma unroll
        for (int ai = 0; ai < 2; ++ai)
#pragma unroll
            for (int m = 0; m < 4; ++m) { const size_t off = (size_t)(row0 + ai * HALF + m * 16) * 1024 + col0; float ss = 0.f;
#pragma unroll
                for (int bj = 0; bj < 2; ++bj) {
                    const f32x4 o0 = *(const f32x4*)(base + off + bj * HALF) + gv[bj][0] * acc[ai][bj][m][0], o1 = *(const f32x4*)(base + off + bj * HALF + 4) + gv[bj][1] * acc[ai][bj][m][1];
                    __builtin_nontemporal_store(o0, (f32x4*)(out + off + bj * HALF)); __builtin_nontemporal_store(o1, (f32x4*)(out + off + bj * HALF + 4));
                    if (xa) { ss += ((o0[0] * o0[0] + o0[1] * o0[1]) + (o0[2] * o0[2] + o0[3] * o0[3])) + ((o1[0] * o1[0] + o1[1] * o1[1]) + (o1[2] * o1[2] + o1[3] * o1[3]));
                        const f32x4 t0 = o0 * av[bj][0], t1 = o1 * av[bj][1];
                        u32x4 w; w.x = cvt_pk_bf16(t0[0], t0[1]); w.y = cvt_pk_bf16(t0[2], t0[3]); w.z = cvt_pk_bf16(t1[0], t1[1]); w.w = cvt_pk_bf16(t1[2], t1[3]);
#ifdef XA_NT
                        __builtin_nontemporal_store(w, (u32x4*)(xa + off + bj * HALF)); } }
#else
                        *(u32x4*)(xa + off + bj * HALF) = w; } }
#endif
                if (xa) { ss += SWZ_X(ss, 16); ss += __builtin_bit_cast(float, __builtin_amdgcn_ds_bpermute((lane ^ 32) << 2, __builtin_bit_cast(int, ss)));
                    if (fq == 0) ssp[(size_t)(row0 + ai * HALF + m * 16) * 16 + u.pn * 4 + wc] = ss; } }
    }
};
struct EpiSwiglu {
    static constexpr bool PERM = true, AFTER_DRAIN = false;
    bf16_t* Hh; int ldh; PG8_LAS const float* rt; int pm0; PG8_LAS const float* bt;
    __device__ __forceinline__ void operator()(const f32x4 (&acc)[2][2][4][2], const Unit& u, int wr, int wc, int fr, int fq) const {
        const int row0 = u.pm * BM + wr * 64 + fr, col0 = u.pn * HALF + wc * 32 + 8 * fq;
        PG8_LAS const float* rs = rt + (u.pm == pm0 ? 0 : 256) + wr * 64 + fr;
        PG8_LAS const float* bb = bt + u.ord * 256 + wc * 32 + 8 * fq;
        f32x4 bv[2][2];
#pragma unroll
        for (int bj = 0; bj < 2; ++bj)
#pragma unroll
            for (int n = 0; n < 2; ++n) bv[bj][n] = *(PG8_LAS const f32x4*)(bb + bj * HALF + 4 * n);
        float rsv[2][4];
#pragma unroll
        for (int ai = 0; ai < 2; ++ai)
#pragma unroll
            for (int m = 0; m < 4; ++m) rsv[ai][m] = rs[ai * HALF + m * 16];
#pragma unroll
        for (int ai = 0; ai < 2; ++ai)
#pragma unroll
            for (int m = 0; m < 4; ++m) { bf16_t* rowp = Hh + (size_t)(row0 + ai * HALF + m * 16) * ldh + col0; const float rstd = rsv[ai][m];
                float hv[8];
#pragma unroll
                for (int n = 0; n < 2; ++n)
#pragma unroll
                    for (int i = 0; i < 4; ++i) { const float g = acc[ai][0][m][n][i] * rstd + bv[0][n][i], up = acc[ai][1][m][n][i] * rstd + bv[1][n][i];
                        const float e = __builtin_amdgcn_exp2f(-g * 1.4426950408889634f);
                        hv[n * 4 + i] = g * __builtin_amdgcn_rcpf(1.0f + e) * up; }
                u32x4 w; w.x = cvt_pk_bf16(hv[0], hv[1]); w.y = cvt_pk_bf16(hv[2], hv[3]); w.z = cvt_pk_bf16(hv[4], hv[5]); w.w = cvt_pk_bf16(hv[6], hv[7]);
                __builtin_nontemporal_store(w, (u32x4*)(rowp)); }
    }
};
template <class Epi, class Sched, bool ALIGN_EPI = false, bool SP2 = false>
__device__ __forceinline__ void gemm_phase(PG8_LAS unsigned char* lds, const Gemm g, const Sched& S, const Epi& E, const int tid_in) {
    const int tid = tid_in, wid = __builtin_amdgcn_readfirstlane(tid >> 6), lane = tid & 63, wr = wid >> 2, wc = wid & 3, fr = lane & 15, fq = lane >> 4;
    const int K = g.K, nt = K / BK;
    unsigned voffA[2], voffB[2];
#pragma unroll
    for (int i = 0; i < 2; ++i) { int R, C; stage_rc(tid * 16 + i * 8192, R, C); const int Rb = Epi::PERM ? ((R & ~31) + perm32(R & 31)) : R;
        voffA[i] = (unsigned)(R * K + C) * 2u; voffB[i] = (unsigned)(Rb * K + C) * 2u; }
    const size_t kstep = (size_t)(BK * 2);
    const size_t hstep = (size_t)HALF * K * 2;
    const size_t tstep = 2 * hstep;
    const unsigned ldsw = (unsigned)wid * 1024u;
    const int aoff = lds_byte(wr * 64 + fr, fq * 8), boff = lds_byte(wc * 32 + fr, fq * 8);
#define PG8_SA(b, h) (((b) * 2 + (h)) * HTB)
#define PG8_SB(b, h) ((4 + (b) * 2 + (h)) * HTB)
#define PG8_STAGE(bufoff, gbase, voff) do { _Pragma("unroll") for (int _i = 0; _i < 2; ++_i) \
        __builtin_amdgcn_global_load_lds((const unsigned*)((const char*)(gbase) + (voff)[_i]), (PG8_LAS unsigned*)(lds + (bufoff) + ldsw + _i * 8192), 16, 0, 0); } while (0)
#define PG8_LDA(dst, b, h) do { _Pragma("unroll") for (int m = 0; m < 4; ++m) _Pragma("unroll") for (int k = 0; k < 2; ++k) dst[m][k] = *(const PG8_LAS bf16x8*)(lds + PG8_SA(b, h) + aoff + m * 2048 + k * 1024); } while (0)
#define PG8_LDB(dst, b, h) do { _Pragma("unroll") for (int n = 0; n < 2; ++n) _Pragma("unroll") for (int k = 0; k < 2; ++k) dst[n][k] = *(const PG8_LAS bf16x8*)(lds + PG8_SB(b, h) + boff + n * 2048 + k * 1024); } while (0)
#define PG8_MMA(ai, bj, At, Bt) do { __builtin_amdgcn_s_setprio(1); _Pragma("unroll") for (int m = 0; m < 4; ++m) _Pragma("unroll") for (int n = 0; n < 2; ++n) _Pragma("unroll") for (int k = 0; k < 2; ++k) \
        acc[ai][bj][m][n] = __builtin_amdgcn_mfma_f32_16x16x32_bf16(Bt[n][k], At[m][k], acc[ai][bj][m][n], 0, 0, 0); __builtin_amdgcn_s_setprio(0); } while (0)
#define PG8_WAIT_V(n) asm volatile("s_waitcnt vmcnt(" #n ")" ::: "memory")
#define PG8_WAIT_L(n) asm volatile("s_waitcnt lgkmcnt(" #n ")" ::: "memory")
#define PG8_BAR __builtin_amdgcn_s_barrier()
#define PG8_SCHED __builtin_amdgcn_sched_barrier(0)
    Unit cur, nxt; int ui = 0;
    if (!S.next(0, cur)) return;
    f32x4 acc[2][2][4][2];
#pragma unroll
    for (int a = 0; a < 2; ++a)
#pragma unroll
        for (int b = 0; b < 2; ++b)
#pragma unroll
            for (int m = 0; m < 4; ++m)
#pragma unroll
                for (int n = 0; n < 2; ++n) acc[a][b][m][n] = (f32x4){0.f, 0.f, 0.f, 0.f};
    bf16x8 At[4][2], B0[2][2], B1[2][2];
    const char* cA = (const char*)g.A + (size_t)cur.pm * tstep; const char* cB = (const char*)g.Bt + (size_t)cur.pn * tstep;
    S.a_ready(cur);
    if constexpr (SP2) {
        PG8_STAGE(PG8_SB(0, 0), cB, voffB); PG8_STAGE(PG8_SB(0, 1), cB + hstep, voffB); PG8_STAGE(PG8_SA(0, 0), cA, voffA); PG8_STAGE(PG8_SA(0, 1), cA + hstep, voffA);
        if (wr == 1) PG8_BAR;
        PG8_WAIT_V(2); PG8_BAR;
        PG8_STAGE(PG8_SB(1, 0), cB + kstep, voffB); PG8_STAGE(PG8_SA(1, 0), cA + kstep, voffA); PG8_STAGE(PG8_SB(1, 1), cB + hstep + kstep, voffB);
        PG8_WAIT_V(6); PG8_BAR;
    } else {
        PG8_STAGE(PG8_SB(0, 0), cB, voffB); PG8_STAGE(PG8_SA(0, 0), cA, voffA); PG8_STAGE(PG8_SB(0, 1), cB + hstep, voffB); PG8_STAGE(PG8_SA(0, 1), cA + hstep, voffA);
        if (wr == 1) PG8_BAR;
        PG8_WAIT_V(4); PG8_BAR;
        PG8_STAGE(PG8_SB(1, 0), cB + kstep, voffB); PG8_STAGE(PG8_SA(1, 0), cA + kstep, voffA); PG8_STAGE(PG8_SB(1, 1), cB + hstep + kstep, voffB);
        PG8_WAIT_V(6); PG8_BAR;
    }
    for (;;) {
        const bool has_next = S.next(ui + 1, nxt);
        const char* nA = has_next ? (const char*)g.A + (size_t)nxt.pm * tstep : cA; const char* nB = has_next ? (const char*)g.Bt + (size_t)nxt.pn * tstep : cB;
        for (int t = 0; t < nt; t += 2) {
            const bool last = (t == nt - 2);
            const char* a1 = cA + (size_t)(t + 1) * kstep;
            const char* a2 = last ? nA : cA + (size_t)(t + 2) * kstep; const char* b2 = last ? nB : cB + (size_t)(t + 2) * kstep;
            const char* a3 = a2 + kstep; const char* b3 = b2 + kstep;
            if (last && has_next) S.a_ready(nxt);
            if constexpr (SP2) {
            PG8_LDB(B0, 0, 0); PG8_LDB(B1, 0, 1); PG8_SCHED; PG8_LDA(At, 0, 0); PG8_STAGE(PG8_SA(1, 1), a1 + hstep, voffA);
            PG8_WAIT_V(8); PG8_WAIT_L(0); PG8_BAR; PG8_MMA(0, 0, At, B0); PG8_MMA(0, 1, At, B1); PG8_BAR; PG8_SCHED;
            PG8_LDA(At, 0, 1); PG8_STAGE(PG8_SB(0, 0), b2, voffB); PG8_STAGE(PG8_SB(0, 1), b2 + hstep, voffB); PG8_STAGE(PG8_SA(0, 0), a2, voffA);
            PG8_WAIT_V(8); PG8_WAIT_L(0); PG8_BAR; PG8_MMA(1, 0, At, B0); PG8_MMA(1, 1, At, B1); PG8_BAR; PG8_SCHED;
            PG8_LDB(B0, 1, 0); PG8_LDB(B1, 1, 1); PG8_SCHED; PG8_LDA(At, 1, 0); PG8_STAGE(PG8_SA(0, 1), a2 + hstep, voffA);
            PG8_WAIT_V(8); PG8_WAIT_L(0); PG8_BAR; PG8_MMA(0, 0, At, B0); PG8_MMA(0, 1, At, B1); PG8_BAR; PG8_SCHED;
            PG8_LDA(At, 1, 1); PG8_STAGE(PG8_SB(1, 0), b3, voffB); PG8_STAGE(PG8_SB(1, 1), b3 + hstep, voffB); PG8_STAGE(PG8_SA(1, 0), a3, voffA);
            PG8_WAIT_V(8); PG8_WAIT_L(0); PG8_BAR; PG8_MMA(1, 0, At, B0); PG8_MMA(1, 1, At, B1); PG8_BAR; PG8_SCHED;
            } else {
            PG8_LDB(B0, 0, 0); PG8_SCHED; PG8_LDA(At, 0, 0); PG8_STAGE(PG8_SA(1, 1), a1 + hstep, voffA);
            PG8_WAIT_L(8); PG8_BAR; PG8_WAIT_L(0); PG8_MMA(0, 0, At, B0); PG8_BAR; PG8_SCHED;
            PG8_LDB(B1, 0, 1); PG8_STAGE(PG8_SB(0, 0), b2, voffB);
            PG8_BAR; PG8_WAIT_L(0); PG8_MMA(0, 1, At, B1); PG8_BAR;
            PG8_LDA(At, 0, 1); PG8_STAGE(PG8_SA(0, 0), a2, voffA);
            PG8_BAR; PG8_WAIT_L(0); PG8_MMA(1, 0, At, B0); PG8_BAR; PG8_SCHED;
            PG8_STAGE(PG8_SB(0, 1), b2 + hstep, voffB);
            PG8_WAIT_V(6); PG8_BAR; PG8_MMA(1, 1, At, B1); PG8_BAR;
            PG8_LDB(B0, 1, 0); PG8_SCHED; PG8_LDA(At, 1, 0); PG8_STAGE(PG8_SA(0, 1), a2 + hstep, voffA);
            PG8_WAIT_L(8); PG8_BAR; PG8_WAIT_L(0); PG8_MMA(0, 0, At, B0); PG8_BAR; PG8_SCHED;
            PG8_LDB(B1, 1, 1); PG8_STAGE(PG8_SB(1, 0), b3, voffB);
            PG8_BAR; PG8_WAIT_L(0); PG8_MMA(0, 1, At, B1); PG8_BAR;
            PG8_LDA(At, 1, 1); PG8_STAGE(PG8_SA(1, 0), a3, voffA);
            PG8_BAR; PG8_WAIT_L(0); PG8_MMA(1, 0, At, B0); PG8_BAR; PG8_SCHED;
            PG8_STAGE(PG8_SB(1, 1), b3 + hstep, voffB);
            PG8_WAIT_V(6); PG8_BAR; PG8_MMA(1, 1, At, B1); PG8_BAR;
            }
        }
        if constexpr (ALIGN_EPI) { if (wr == 0) PG8_BAR; }
        if constexpr (!Epi::AFTER_DRAIN) { E(acc, cur, wr, wc, fr, fq); S.done(cur); }
        if (!has_next) break;
#pragma unroll
        for (int a = 0; a < 2; ++a)
#pragma unroll
            for (int b = 0; b < 2; ++b)
#pragma unroll
                for (int m = 0; m < 4; ++m)
#pragma unroll
                    for (int n = 0; n < 2; ++n) acc[a][b][m][n] = (f32x4){0.f, 0.f, 0.f, 0.f};
        cur = nxt; cA = nA; cB = nB; ++ui;
        if constexpr (ALIGN_EPI) { if (wr == 1) PG8_BAR; }
    }
    PG8_WAIT_V(0);
    if constexpr (!ALIGN_EPI) { if (wr == 0) PG8_BAR; }
    PG8_BAR;
    if constexpr (Epi::AFTER_DRAIN) { E.fused(acc, cur, wr, wc, fr, fq, lds, wid, lane); S.done(cur); }
#undef PG8_SA
#undef PG8_SB
#undef PG8_STAGE
#undef PG8_LDA
#undef PG8_LDB
#undef PG8_MMA
#undef PG8_WAIT_V
#undef PG8_WAIT_L
#undef PG8_BAR
#undef PG8_SCHED
}
}
#define XB_TMO      128
#define XB_XCNT(j)  (256  + 64 * (j))
#define XB_XSUB(j)  (1280 + 64 * (j))
#define XB_XGEN(j)  (2304 + 64 * (j))
#define XB_TOP      3328
#define XB_TOPGEN   3392
#define XCD_BAR_WORDS 3456
#define XB_SPIN_CAP (1u << 18)

__device__ __forceinline__ unsigned xb_ld(unsigned* p)              { return __hip_atomic_load(p, __ATOMIC_RELAXED, __HIP_MEMORY_SCOPE_AGENT); }
__device__ __forceinline__ unsigned xb_add(unsigned* p, unsigned v) { return __hip_atomic_fetch_add(p, v, __ATOMIC_RELAXED, __HIP_MEMORY_SCOPE_AGENT); }
__device__ __forceinline__ unsigned xb_xcc_id() { return (unsigned)__builtin_amdgcn_s_getreg((3 << 11) | 20) & 0xFu; }
#define XB_SPIN(cond, bar) do { unsigned _sp = 0; while (cond) { __builtin_amdgcn_s_sleep(1); \
    if ((++_sp & 255u) == 0u) { if (xb_ld(&(bar)[XB_TMO])) break; if (_sp > XB_SPIN_CAP) { atomicAdd(&(bar)[XB_TMO], 1u); break; } } } } while (0)

struct XcdBarrier {
    unsigned* bar; unsigned x;
    volatile LAS unsigned* st;
};

__device__ __forceinline__ XcdBarrier xcd_barrier_post(unsigned* bar, volatile LAS unsigned* st) {
    XcdBarrier b; b.bar = bar; b.x = xb_xcc_id(); b.st = st;
    if (threadIdx.x == 0) (void)xb_add(&bar[XB_XCNT(b.x)], 1u);
    return b;
}
__device__ __forceinline__ void xcd_barrier_complete(unsigned* bar, unsigned x, unsigned& nloc, unsigned& nx) {
    const unsigned G = gridDim.x * gridDim.y * gridDim.z;
    unsigned sum, cnt, mine, sp = 0u;
    for (;;) {
        sum = 0u; cnt = 0u; mine = 0u;
#pragma unroll
        for (unsigned j = 0; j < 16; ++j) { const unsigned c = xb_ld(&bar[XB_XCNT(j)]); sum += c; cnt += (c > 0u) ? 1u : 0u; mine = (j == x) ? c : mine; }
        if (sum == G) break;
        __builtin_amdgcn_s_sleep(1);
        if ((++sp & 255u) == 0u) { if (xb_ld(&bar[XB_TMO])) break; if (sp > XB_SPIN_CAP) { atomicAdd(&bar[XB_TMO], 1u); break; } }
    }
    nloc = mine > 0u ? mine : 1u; nx = cnt > 0u ? cnt : 1u;
}

__device__ __forceinline__ void xcd_barrier(const XcdBarrier& b) {
    asm volatile("s_waitcnt vmcnt(0)" ::: "memory");
    __syncthreads();
    if (threadIdx.x == 0) {
        unsigned* bar = b.bar; asm volatile("" : "+s"(bar));
        const unsigned bx_ = xb_xcc_id();
        __builtin_amdgcn_s_waitcnt(0);
        unsigned nloc = b.st[0], nx = b.st[1];
        if (nloc == 0u) { xcd_barrier_complete(bar, bx_, nloc, nx); b.st[0] = nloc; b.st[1] = nx; }
        const unsigned old = xb_add(&bar[XB_XSUB(bx_)], 1u);
        const unsigned gen = old / nloc;
        if (old + 1u == (gen + 1u) * nloc) {
            __builtin_amdgcn_fence(__ATOMIC_RELEASE, "agent");
            asm volatile("s_waitcnt vmcnt(0)" ::: "memory");
            const unsigned og = xb_add(&bar[XB_TOP], 1u);
            const unsigned tg = og / nx;
            if (og + 1u == (tg + 1u) * nx) xb_add(&bar[XB_TOPGEN], 1u);
            else XB_SPIN(xb_ld(&bar[XB_TOPGEN]) == tg, bar);
            __builtin_amdgcn_fence(__ATOMIC_ACQUIRE, "agent");
            xb_add(&bar[XB_XGEN(bx_)], 1u);
            asm volatile("s_waitcnt vmcnt(0)" ::: "memory");
        } else {
            XB_SPIN(xb_ld(&bar[XB_XGEN(bx_)]) == gen, bar);
            __builtin_amdgcn_fence(__ATOMIC_ACQUIRE, "agent");
            asm volatile("s_waitcnt vmcnt(0)" ::: "memory");
        }
    }
    __syncthreads();
}
#define LDS_WAIT() asm volatile("s_waitcnt lgkmcnt(0)" ::: "memory")
__device__ __forceinline__ void unpack8(const v4u w, float* f) { f[0] = bflo(w.x); f[1] = bfhi(w.x); f[2] = bflo(w.y); f[3] = bfhi(w.y); f[4] = bflo(w.z); f[5] = bfhi(w.z); f[6] = bflo(w.w); f[7] = bfhi(w.w); }

__device__ __forceinline__ int win_src(int c) {
    if (c < 1152) return c;
    if (c < 2304) return c + 1038;
    if (c < 3072) return c - 1146;
    if (c < 3328) return c - 1138;
    if (c < 3334) return c - 3328 + 1152;
    if (c < 3338) return c - 3334 + 1926;
    if (c < 3342) return c - 3338 + 1930;
    return -1;
}
__device__ __forceinline__ int wgu_src(int r) { const int pn = r >> 8, w = r & 255; return (w < 128 ? 0 : DFF) + pn * 128 + (w & 127); }
template <int MODE> __device__ __forceinline__ int src_col(int r) { if (MODE == 1) return win_src(r); if (MODE == 2) return wgu_src(r); return r; }

template <int MODE> __device__ __forceinline__ void transpose_item(const float* W, int K, int ldw, bf16* WT, LAS float* scr, int nblk, int item, int lane) {
    const int kb = item / nblk, nb = item % nblk, k0 = 64 * kb, n0 = 32 * nb;
    const int sc = src_col<MODE>(n0 + (lane & 31));
#pragma unroll 8
    for (int i = 0; i < 32; ++i) { const int kk = 2 * i + (lane >> 5); scr[kk * 33 + (lane & 31)] = (sc >= 0) ? W[(size_t)(k0 + kk) * ldw + sc] : 0.f; }
    LDS_WAIT(); asm volatile("" ::: "memory");
    const int c = lane & 7;
#pragma unroll
    for (int j = 0; j < 4; ++j) { const int n = (lane >> 3) + 8 * j; const LAS float* s = scr + (8 * c) * 33 + n;
        v4u o; o.x = pk2(s[0 * 33], s[1 * 33]); o.y = pk2(s[2 * 33], s[3 * 33]); o.z = pk2(s[4 * 33], s[5 * 33]); o.w = pk2(s[6 * 33], s[7 * 33]);
        *(GAS v4u*)(WT + (size_t)(n0 + n) * K + k0 + 8 * c) = o; }
    LDS_WAIT(); asm volatile("" ::: "memory");
}

__device__ __forceinline__ void p0_mod_unit(int u, const float* cvec, const float* w_ada, const float* b_ada, float* mod, LAS float* lds, int tid, int wave, int lane) {
    LAS float* sc = lds; LAS float* red = lds + 2048;
    for (int i = tid; i < 2048; i += NTHREADS) { const float v = cvec[i]; sc[i] = v / (1.f + expf(-v)); }
    __syncthreads();
    const int l = u / 96, n = (u % 96) * 64 + lane;
    const float* wp = w_ada + ((size_t)l * 1024 + wave * 128) * 6144 + n;
    float a0 = 0.f, a1 = 0.f;
#pragma unroll 16
    for (int kk = 0; kk < 128; ++kk) { const float w = wp[(size_t)kk * 6144]; a0 += sc[wave * 128 + kk] * w; a1 += sc[1024 + wave * 128 + kk] * w; }
    red[(wave * 2 + 0) * 64 + lane] = a0; red[(wave * 2 + 1) * 64 + lane] = a1;
    __syncthreads();
    if (tid < 128) { const int b = tid >> 6; float s = 0.f;
#pragma unroll
        for (int w = 0; w < 8; ++w) s += red[(w * 2 + b) * 64 + lane];
        mod[((size_t)l * 2 + b) * 6144 + n] = s + b_ada[l * 6144 + n]; }
    __syncthreads();
}

__device__ __forceinline__ void pre_rows(const float* xsrc, const float* g, const float* mod_b0, bf16* XA, float* SSP, int gw, int NGW, int lane) {
    for (int m = gw; m < MROWS; m += NGW) {
        const int b = m / SEQ; const float* mb = mod_b0 + (size_t)b * 6144;
        const GAS f32x4* xr = (const GAS f32x4*)(xsrc + (size_t)m * DM) + lane;
        f32x4 v[4]; float ss = 0.f;
#pragma unroll
        for (int j = 0; j < 4; ++j) { v[j] = xr[64 * j]; ss += (v[j].x * v[j].x + v[j].y * v[j].y) + (v[j].z * v[j].z + v[j].w * v[j].w); }
        const float tot = wave_sum(ss);
        if (lane < 16) SSP[(size_t)m * 16 + lane] = lane == 0 ? tot : 0.f;
        GAS v2u* o8 = (GAS v2u*)(XA + (size_t)m * DM) + lane;
#pragma unroll
        for (int j = 0; j < 4; ++j) { const int col = 4 * lane + 256 * j;
            const f32x4 gg = *(const f32x4*)(g + col), sv = *(const f32x4*)(mb + 1024 + col);
            const f32x4 o = v[j] * gg * (sv + 1.0f);
            v2u w; w.x = pk2(o.x, o.y); w.y = pk2(o.z, o.w); o8[64 * j] = w; }
    }
}
__device__ __forceinline__ void pre_avec(const float* n1g, const float* n2g, const float* MODp, float* AVEC, int gtid, int ngt) {
    for (int i = gtid; i < DEPTH * 2 * 2 * 1024; i += ngt) { const int col = i & 1023, b = (i >> 10) & 1, w = (i >> 11) & 1, l = i >> 12;
        const float g = (w ? n2g : n1g)[l * 1024 + col], sc = MODp[((size_t)l * 2 + b) * 6144 + (w ? 4096 : 1024) + col];
        AVEC[i] = g * (1.f + sc); }
}
__device__ __forceinline__ void pre_bias(const bf16* WT, int nrows, const float* sh0, const float* sh1, float* bias0, float* bias1, int gw, int NGW, int lane) {
    for (int n = gw; n < nrows; n += NGW) {
        float w[16]; unpack8(*(const v4u*)(WT + (size_t)n * 1024 + lane * 16), w); unpack8(*(const v4u*)(WT + (size_t)n * 1024 + lane * 16 + 8), w + 8);
        float a0 = 0.f, a1 = 0.f;
#pragma unroll
        for (int q4 = 0; q4 < 4; ++q4) { const f32x4 s0 = *(const f32x4*)(sh0 + lane * 16 + 4 * q4), s1 = *(const f32x4*)(sh1 + lane * 16 + 4 * q4);
            a0 += (w[4 * q4] * s0.x + w[4 * q4 + 1] * s0.y) + (w[4 * q4 + 2] * s0.z + w[4 * q4 + 3] * s0.w);
            a1 += (w[4 * q4] * s1.x + w[4 * q4 + 1] * s1.y) + (w[4 * q4 + 2] * s1.z + w[4 * q4 + 3] * s1.w); }
        a0 = wave_sum(a0); a1 = wave_sum(a1);
        if (lane == 0) { bias0[n] = a0; bias1[n] = a1; }
    }
}
template <class Sched> __device__ __forceinline__ int rstd_tables(const Sched& S, const float* SSP, LAS float* rt, const float* bias, int bstride, LAS float* bt, int tid) {
    pg8::Unit u; int pm0 = -1, pm1 = -1;
    for (int i = 0; S.next(i, u); ++i) { if (pm0 < 0) pm0 = u.pm; else if (u.pm != pm0 && pm1 < 0) pm1 = u.pm;
        if (tid < 64) *(LAS f32x4*)(bt + i * 256 + tid * 4) = *(const f32x4*)(bias + (size_t)((u.pm * 256) / SEQ) * bstride + u.pn * 256 + tid * 4); }
    if (tid < 256) {
#pragma unroll
        for (int slot = 0; slot < 2; ++slot) { const int pm = slot ? pm1 : pm0;
            if (pm >= 0) { const float* sp = SSP + ((size_t)pm * 256 + tid) * 16;
                const f32x4 a = *(const f32x4*)sp, b = *(const f32x4*)(sp + 4), c = *(const f32x4*)(sp + 8), d = *(const f32x4*)(sp + 12);
                const float s = (((a.x + a.y) + (a.z + a.w)) + ((b.x + b.y) + (b.z + b.w))) + (((c.x + c.y) + (c.z + c.w)) + ((d.x + d.y) + (d.z + d.w)));
                rt[slot * 256 + tid] = 1.f / sqrtf(s * (1.f / DM) + EPS); } }
    }
    __syncthreads();
    return pm0;
}

__device__ __forceinline__ void post_foxcum_unit(int bh, const float* GATESp, float* FOXCUMp, const float* fox_f_bias, LAS float* lds, int tid, int wave, int lane) {
    const int b = bh / 6, h = bh % 6; const float bias = fox_f_bias[h];
    float v[32];
#pragma unroll
    for (int r = 0; r < 32; ++r) { const int t = wave * 2048 + r * 64 + lane; const float x2 = (GATESp[((size_t)b * SEQ + t) * 16 + h] + bias) * LOG2E;
        v[r] = fminf(x2, 0.f) - __builtin_amdgcn_logf(1.f + __builtin_amdgcn_exp2f(-fabsf(x2))); }
    float carry = 0.f;
#pragma unroll
    for (int r = 0; r < 32; ++r) { float x = v[r];
#pragma unroll
        for (int o = 1; o < 64; o <<= 1) { const float n = sup(x, o, lane); if (lane >= o) x += n; }
        x += carry; v[r] = x; carry = shf(x, 63); }
    if (lane == 0) lds[wave] = carry;
    __syncthreads();
    float off = 0.f;
    for (int w = 0; w < wave; ++w) off += lds[w];
#pragma unroll
    for (int r = 0; r < 32; ++r) FOXCUMp[(size_t)bh * SEQ + wave * 2048 + r * 64 + lane] = v[r] + off;
    __syncthreads();
}
__device__ __forceinline__ void post_qknorm_unit(int u, bf16* PROJp, float* KMEANP, const float* gfq, const float* gfk, const float* gbq, const float* gbk, LAS float* lds, int tid, int wave, int lane) {
    const int blk = u >> 1, half = u & 1, sub = lane & 7;
    int colv[3]; float gv[3][8]; float qsv[3];
#pragma unroll
    for (int it = 0; it < 3; ++it) { const int hsel = it * 8 + (lane >> 3), grp = hsel / 6, hh = hsel % 6;
        colv[it] = (grp == 0 ? C_FQ : grp == 1 ? C_FK : grp == 2 ? C_BQ : C_BK) + hh * 64 + 8 * sub;
        const float* gp = (grp == 0 ? gfq : grp == 1 ? gfk : grp == 2 ? gbq : gbk) + 8 * sub;
#pragma unroll
        for (int i = 0; i < 8; ++i) gv[it][i] = gp[i];
        qsv[it] = (grp == 0 || grp == 2) ? QSCALE : 1.f; }
    float ka[8] = {0.f, 0.f, 0.f, 0.f, 0.f, 0.f, 0.f, 0.f};
    const size_t row0 = (size_t)blk * 256 + half * 128 + wave * 16;
#pragma unroll 4
    for (int r = 0; r < 16; ++r) {
#pragma unroll
        for (int it = 0; it < 3; ++it) {
            v4u* p = (v4u*)(PROJp + (row0 + r) * PLD + colv[it]);
            float f[8]; unpack8(*p, f);
            float ss = 0.f;
#pragma unroll
            for (int i = 0; i < 8; ++i) ss += f[i] * f[i];
            ss += SWZ_X(ss, 1); ss += SWZ_X(ss, 2); ss += SWZ_X(ss, 4);
            const float rr = 1.f / sqrtf(ss * (1.f / 64.f) + EPS);
#pragma unroll
            for (int i = 0; i < 8; ++i) f[i] = f[i] * rr * gv[it][i];
            if (it == 2) {
#pragma unroll
                for (int i = 0; i < 8; ++i) ka[i] += f[i]; }
            const float qs = qsv[it];
            v4u w; w.x = pk2(f[0] * qs, f[1] * qs); w.y = pk2(f[2] * qs, f[3] * qs); w.z = pk2(f[4] * qs, f[5] * qs); w.w = pk2(f[6] * qs, f[7] * qs);
            *p = w;
        }
    }
    if (lane >= 16) {
#pragma unroll
        for (int i = 0; i < 8; ++i) lds[wave * 384 + ((lane >> 3) - 2) * 64 + 8 * sub + i] = ka[i]; }
    __syncthreads();
    if (tid < 384) { float s = 0.f;
#pragma unroll
        for (int w = 0; w < 8; ++w) s += lds[w * 384 + tid];
        const int b = blk / NBLK, n = blk % NBLK, head = tid >> 6, dd = tid & 63;
        KMEANP[(size_t)half * (12 * NBLK * 64) + (((size_t)b * 6 + head) * NBLK + n) * 64 + dd] = s * (1.f / 256.f); }
    __syncthreads();
}
__device__ __forceinline__ void post_conv_unit(int blk, int which, const bf16* PROJp, bf16* dst, const float* conv_w, const float* conv_b, int tid) {
    const bf16* src = PROJp + (which ? C_MK : C_MQ); const float osc = which ? 0.125f : 1.f;
    const int c = 8 * (tid & 31), rs = tid >> 5, ch = which * 256 + c;
    const size_t r0 = (size_t)blk * 256 + rs * 16; const int tl = (int)(r0 % SEQ);
    float w[4][8], bb[8];
#pragma unroll
    for (int i = 0; i < 4; ++i) { const f32x4 a = *(const f32x4*)(conv_w + i * 512 + ch), b2 = *(const f32x4*)(conv_w + i * 512 + ch + 4);
        w[i][0] = a.x; w[i][1] = a.y; w[i][2] = a.z; w[i][3] = a.w; w[i][4] = b2.x; w[i][5] = b2.y; w[i][6] = b2.z; w[i][7] = b2.w; }
    { const f32x4 a = *(const f32x4*)(conv_b + ch), b2 = *(const f32x4*)(conv_b + ch + 4); bb[0] = a.x; bb[1] = a.y; bb[2] = a.z; bb[3] = a.w; bb[4] = b2.x; bb[5] = b2.y; bb[6] = b2.z; bb[7] = b2.w; }
    float x0[8], x1[8], x2[8], x3[8];
    { v4u h3[3];
#pragma unroll
      for (int k = 0; k < 3; ++k) { if (tl + k - 3 >= 0) h3[k] = *(const v4u*)(src + (r0 + k - 3) * PLD + c); else h3[k] = (v4u){0u, 0u, 0u, 0u}; }
      unpack8(h3[0], x0); unpack8(h3[1], x1); unpack8(h3[2], x2); }
#pragma unroll 1
    for (int hb = 0; hb < 2; ++hb) {
        v4u in[8];
#pragma unroll
        for (int k = 0; k < 8; ++k) in[k] = *(const v4u*)(src + (r0 + hb * 8 + k) * PLD + c);
#pragma unroll
        for (int r = 0; r < 8; ++r) {
            unpack8(in[r], x3);
            float y[8];
#pragma unroll
            for (int i = 0; i < 8; ++i) { const float t = bb[i] + w[0][i] * x0[i] + w[1][i] * x1[i] + w[2][i] * x2[i] + w[3][i] * x3[i];
                y[i] = t * __builtin_amdgcn_rcpf(1.f + __builtin_amdgcn_exp2f(-t * LOG2E)) * osc; x0[i] = x1[i]; x1[i] = x2[i]; x2[i] = x3[i]; }
            v4u o; o.x = pk2(y[0], y[1]); o.y = pk2(y[2], y[3]); o.z = pk2(y[4], y[5]); o.w = pk2(y[6], y[7]);
            *(v4u*)(dst + (r0 + hb * 8 + r) * 256 + c) = o;
        }
    }
}

struct MlP { const bf16* PROJ; const bf16* QC; const bf16* KC; const float* GATES; float* U; float* NU; float* BEND; float* MLOC; bf16* CS; float* NS; float* MS; bf16* Y;
             const float *ibias, *fbias, *hg; };
__device__ __forceinline__ void mlstm_m1(int ci, const MlP& P, LAS float* lds, int tid, int wave, int lane) {
    const int b = ci >> 10, h = (ci >> 8) & 3, c = ci & 255; const size_t row0 = (size_t)b * SEQ + c * 64;
    LAS float* Ks = lds; LAS float* Vs = lds + 4096; LAS float* ws = lds + 8192;
    { const int r = tid >> 3, cg = (tid & 7) * 8; float f[8];
      unpack8(*(const v4u*)(P.KC + (row0 + r) * 256 + h * 64 + cg), f);
#pragma unroll
      for (int i = 0; i < 8; ++i) Ks[r * 64 + cg + i] = f[i];
      unpack8(*(const v4u*)(P.PROJ + (row0 + r) * PLD + C_MV + h * 64 + cg), f);
#pragma unroll
      for (int i = 0; i < 8; ++i) Vs[r * 64 + cg + i] = f[i]; }
    if (wave == 0) {
        const size_t row = row0 + lane;
        const float fi = P.GATES[row * 16 + 6 + h] + P.ibias[h], ff = P.GATES[row * 16 + 10 + h] + P.fbias[h];
        float bc = log_sigmoid_f(ff);
#pragma unroll
        for (int o = 1; o < 64; o <<= 1) { const float n = sup(bc, o, lane); if (lane >= o) bc += n; }
        const float bend = shf(bc, 63);
        const float wl = bend - bc + fi; const float mloc = wave_max(wl);
        ws[lane] = expf(wl - mloc);
        if (lane == 0) { P.BEND[ci] = bend; P.MLOC[ci] = mloc; }
    }
    __syncthreads();
    { const int dv = tid >> 3, e0 = (tid & 7) * 8; float u[8] = {0.f, 0.f, 0.f, 0.f, 0.f, 0.f, 0.f, 0.f};
#pragma unroll 2
      for (int s = 0; s < 64; ++s) { const float vw = Vs[s * 64 + dv] * ws[s]; const f32x4 ka = *(const LAS f32x4*)(Ks + s * 64 + e0), kb = *(const LAS f32x4*)(Ks + s * 64 + e0 + 4);
          u[0] += vw * ka.x; u[1] += vw * ka.y; u[2] += vw * ka.z; u[3] += vw * ka.w; u[4] += vw * kb.x; u[5] += vw * kb.y; u[6] += vw * kb.z; u[7] += vw * kb.w; }
      float* up = P.U + (size_t)ci * 4096 + dv * 64 + e0;
      *(f32x4*)up = (f32x4){u[0], u[1], u[2], u[3]}; *(f32x4*)(up + 4) = (f32x4){u[4], u[5], u[6], u[7]}; }
    if (tid < 64) { float nu = 0.f; for (int s = 0; s < 64; ++s) nu += ws[s] * Ks[s * 64 + tid]; P.NU[(size_t)ci * 64 + tid] = nu; }
    __syncthreads();
}
__device__ __forceinline__ void mlstm_m2(int u, const MlP& P, LAS float* lds, int tid, int wave, int lane) {
    const int bh = u >> 3, eg = u & 7, elem = eg * 512 + tid, base = bh * 256;
    LAS float* decl = lds; LAS float* wul = lds + 256;
    if (wave == 0) {
        const f32x4 b4 = *(const f32x4*)(P.BEND + base + 4 * lane), l4 = *(const f32x4*)(P.MLOC + base + 4 * lane);
        float B = b4.x, L = l4.x;
        B += b4.y; L = fmaxf(L + b4.y, l4.y); B += b4.z; L = fmaxf(L + b4.z, l4.z); B += b4.w; L = fmaxf(L + b4.w, l4.w);
#pragma unroll
        for (int o = 1; o < 64; o <<= 1) { const float Bp = sup(B, o, lane), Lp = sup(L, o, lane); if (lane >= o) { L = fmaxf(Lp + B, L); B = Bp + B; } }
        const float Bex = sup(B, 1, lane), Lex = sup(L, 1, lane);
        float m = (lane == 0) ? 0.f : fmaxf(Bex, Lex);
        const float bb[4] = {b4.x, b4.y, b4.z, b4.w}, ll[4] = {l4.x, l4.y, l4.z, l4.w};
#pragma unroll
        for (int j = 0; j < 4; ++j) { const int c = 4 * lane + j; if (eg == 0) P.MS[base + c] = m;
            const float mn = fmaxf(bb[j] + m, ll[j]);
            decl[c] = __builtin_amdgcn_exp2f((bb[j] + m - mn) * LOG2E); wul[c] = __builtin_amdgcn_exp2f((ll[j] - mn) * LOG2E); m = mn; }
    }
    __syncthreads();
    const bool donorm = (eg == 0 && tid < 64);
    float C = 0.f, nst = 0.f;
#pragma unroll 1
    for (int c0 = 0; c0 < 256; c0 += 16) {
        float uv[16], nv[16];
#pragma unroll
        for (int i = 0; i < 16; ++i) { const int ci = base + c0 + i; uv[i] = P.U[(size_t)ci * 4096 + elem]; nv[i] = donorm ? P.NU[(size_t)ci * 64 + tid] : 0.f; }
#pragma unroll
        for (int i = 0; i < 16; ++i) { const int ci = base + c0 + i;
            P.CS[(size_t)ci * 4096 + elem] = (bf16)f2bf(C);
            if (donorm) P.NS[(size_t)ci * 64 + tid] = nst;
            const float dec = decl[c0 + i], wu = wul[c0 + i];
            C = dec * C + wu * uv[i]; nst = dec * nst + wu * nv[i]; }
    }
    __syncthreads();
}
__device__ __forceinline__ void mlstm_m3(int ci, const MlP& P, LAS float* lds, int tid, int wave, int lane) {
    constexpr int LP = 68;
    const int b = ci >> 10, h = (ci >> 8) & 3, c = ci & 255; const size_t row0 = (size_t)b * SEQ + c * 64;
    LAS float* Qs = lds; LAS float* Ks = Qs + 64 * LP; LAS float* Cs = Ks + 64 * LP; LAS float* Sm = Cs + 64 * LP; LAS float* Vs = Sm + 64 * LP;
    LAS float* av = Vs + 4096; LAS float* gv = av + 64; LAS float* bcv = gv + 64; LAS float* nsv = bcv + 64;
    const float ms = P.MS[ci];
    { const int r = tid >> 3, cg = (tid & 7) * 8; float f[8];
      unpack8(*(const v4u*)(P.QC + (row0 + r) * 256 + h * 64 + cg), f);
#pragma unroll
      for (int i = 0; i < 8; ++i) Qs[r * LP + cg + i] = f[i];
      unpack8(*(const v4u*)(P.KC + (row0 + r) * 256 + h * 64 + cg), f);
#pragma unroll
      for (int i = 0; i < 8; ++i) Ks[r * LP + cg + i] = f[i];
      unpack8(*(const v4u*)(P.PROJ + (row0 + r) * PLD + C_MV + h * 64 + cg), f);
#pragma unroll
      for (int i = 0; i < 8; ++i) Vs[r * 64 + cg + i] = f[i];
      unpack8(*(const v4u*)(P.CS + (size_t)ci * 4096 + r * 64 + cg), f);
#pragma unroll
      for (int i = 0; i < 8; ++i) Cs[r * LP + cg + i] = f[i]; }
    if (wave == 0) {
        const size_t row = row0 + lane;
        const float fi = P.GATES[row * 16 + 6 + h] + P.ibias[h], ff = P.GATES[row * 16 + 10 + h] + P.fbias[h];
        float bc = log_sigmoid_f(ff);
#pragma unroll
        for (int o = 1; o < 64; o <<= 1) { const float n = sup(bc, o, lane); if (lane >= o) bc += n; }
        const float a = fi - bc; float pm = a;
#pragma unroll
        for (int o = 1; o < 64; o <<= 1) { const float n = sup(pm, o, lane); if (lane >= o) pm = fmaxf(pm, n); }
        av[lane] = a; gv[lane] = fmaxf(ms, pm); bcv[lane] = bc; nsv[lane] = P.NS[(size_t)ci * 64 + lane];
    }
    __syncthreads();
    const int j = tid >> 3, part = tid & 7, s0 = part * 8;
    const float gj = gv[j];
    { float sacc[8] = {0.f, 0.f, 0.f, 0.f, 0.f, 0.f, 0.f, 0.f};
#pragma unroll 1
      for (int e = 0; e < 64; e += 4) { const f32x4 q4 = *(const LAS f32x4*)(Qs + j * LP + e);
#pragma unroll
          for (int i = 0; i < 8; ++i) { const f32x4 k4 = *(const LAS f32x4*)(Ks + (s0 + i) * LP + e); sacc[i] += (q4.x * k4.x + q4.y * k4.y) + (q4.z * k4.z + q4.w * k4.w); } }
#pragma unroll
      for (int i = 0; i < 8; ++i) { const int s = s0 + i; Sm[j * LP + s] = (s <= j) ? sacc[i] * expf(av[s] - gj) : 0.f; } }
    __syncthreads();
    { const int dv0 = part * 8; float t1[8] = {0.f, 0.f, 0.f, 0.f, 0.f, 0.f, 0.f, 0.f}, t2[8] = {0.f, 0.f, 0.f, 0.f, 0.f, 0.f, 0.f, 0.f};
#pragma unroll 1
      for (int e = 0; e < 64; e += 4) { const f32x4 q4 = *(const LAS f32x4*)(Qs + j * LP + e);
#pragma unroll
          for (int i = 0; i < 8; ++i) { const f32x4 c4 = *(const LAS f32x4*)(Cs + (dv0 + i) * LP + e); t1[i] += (q4.x * c4.x + q4.y * c4.y) + (q4.z * c4.z + q4.w * c4.w); } }
#pragma unroll 2
      for (int s = 0; s < 64; ++s) { const float sm = Sm[j * LP + s]; const f32x4 va = *(const LAS f32x4*)(Vs + s * 64 + dv0), vb = *(const LAS f32x4*)(Vs + s * 64 + dv0 + 4);
          t2[0] += sm * va.x; t2[1] += sm * va.y; t2[2] += sm * va.z; t2[3] += sm * va.w; t2[4] += sm * vb.x; t2[5] += sm * vb.y; t2[6] += sm * vb.z; t2[7] += sm * vb.w; }
      float dn = 0.f, ssum = 0.f;
#pragma unroll
      for (int i = 0; i < 8; ++i) { dn += nsv[s0 + i] * Qs[j * LP + s0 + i]; ssum += Sm[j * LP + s0 + i]; }
      { dn += SWZ_X(dn, 1); ssum += SWZ_X(ssum, 1); dn += SWZ_X(dn, 2); ssum += SWZ_X(ssum, 2); dn += SWZ_X(dn, 4); ssum += SWZ_X(ssum, 4); }
      const float inter = expf(ms - gj), mj = bcv[j] + gj;
      const float den = inter * dn + ssum, dd = fmaxf(fabsf(den), expf(-mj)), rd = 1.f / dd;
      float hv[8], ss = 0.f;
#pragma unroll
      for (int i = 0; i < 8; ++i) { hv[i] = (inter * t1[i] + t2[i]) * rd; ss += hv[i] * hv[i]; }
      { ss += SWZ_X(ss, 1); ss += SWZ_X(ss, 2); ss += SWZ_X(ss, 4); }
      const float rr = 1.f / sqrtf(ss * (1.f / 64.f) + EPS);
      float mo[8]; unpack8(*(const v4u*)(P.PROJ + (row0 + j) * PLD + C_MO + h * 64 + dv0), mo);
      float y[8];
#pragma unroll
      for (int i = 0; i < 8; ++i) y[i] = hv[i] * rr * P.hg[h * 64 + dv0 + i] * sigmoid_f(mo[i]);
      v4u w; w.x = pk2(y[0], y[1]); w.y = pk2(y[2], y[3]); w.z = pk2(y[4], y[5]); w.w = pk2(y[6], y[7]);
      *(v4u*)(P.Y + (row0 + j) * 1024 + Y_ML + h * 64 + dv0) = w; }
    __syncthreads();
}

__device__ __forceinline__ size_t moba_list_off(int bh, int n);
__device__ __forceinline__ void moba_gate_unit(int u, const bf16* PROJ, const float* KMEAN, unsigned* SEL, unsigned* LCNT, unsigned* CTAB, unsigned short* LIST, float B2, float thresh2, LAS float* lds, int tid) {
    const int bh = u >> 6, qb = 63 - (u & 63), b = bh / 6, h = bh % 6;
    LAS float* km = lds; LAS float* cand = lds + 4096; LAS unsigned* cntl = (LAS unsigned*)(lds + 4096 + 1536);
    if (tid < 64) cntl[tid] = 0u;
    for (int i = tid; i < qb * 16; i += NTHREADS) *(LAS f32x4*)(km + i * 4) = *(const f32x4*)(KMEAN + (size_t)bh * NBLK * 64 + i * 4) + *(const f32x4*)(KMEAN + (size_t)(12 * NBLK * 64) + (size_t)bh * NBLK * 64 + i * 4);
    __syncthreads();
    const int query = tid & 255, half = tid >> 8; const size_t row = (size_t)b * SEQ + qb * 256 + query;
    float q[64];
#pragma unroll
    for (int i = 0; i < 8; ++i) unpack8(*(const v4u*)(PROJ + row * PLD + C_BQ + h * 64 + i * 8), q + i * 8);
    float v0 = -INFINITY, v1 = -INFINITY, v2 = -INFINITY; int i0 = 255, i1 = 255, i2 = 255;
    const int nlo = half * 32, nhi = (qb < nlo + 32) ? qb : nlo + 32;
    for (int n = nlo; n < nhi; ++n) { float g = 0.f;
#pragma unroll
        for (int d = 0; d < 64; d += 4) { const f32x4 k4 = *(const LAS f32x4*)(km + n * 64 + d); g += (q[d] * k4.x + q[d + 1] * k4.y) + (q[d + 2] * k4.z + q[d + 3] * k4.w); }
        if (g > v0) { v2 = v1; i2 = i1; v1 = v0; i1 = i0; v0 = g; i0 = n; } else if (g > v1) { v2 = v1; i2 = i1; v1 = g; i1 = n; } else if (g > v2) { v2 = g; i2 = n; } }
    if (half == 1) { cand[query * 6 + 0] = v0; cand[query * 6 + 1] = v1; cand[query * 6 + 2] = v2;
        cand[query * 6 + 3] = __int_as_float(i0); cand[query * 6 + 4] = __int_as_float(i1); cand[query * 6 + 5] = __int_as_float(i2); }
    __syncthreads();
    if (half == 0) {
#pragma unroll
        for (int k = 0; k < 3; ++k) { const float g = cand[query * 6 + k]; const int n = __float_as_int(cand[query * 6 + 3 + k]);
            if (n != 255) { if (g > v0) { v2 = v1; i2 = i1; v1 = v0; i1 = i0; v0 = g; i0 = n; } else if (g > v1) { v2 = v1; i2 = i1; v1 = g; i1 = n; } else if (g > v2) { v2 = g; i2 = n; } } }
        { const float slope2 = exp2f(-8.f * (float)(h + 1) / 6.f) * LOG2E; const float lim = (2.f * B2 + thresh2) / slope2; const int t0 = qb * 256 + query - 255;
          if (i0 != 255 && (float)(t0 - i0 * 256) > lim) i0 = 255;
          if (i1 != 255 && (float)(t0 - i1 * 256) > lim) i1 = 255;
          if (i2 != 255 && (float)(t0 - i2 * 256) > lim) i2 = 255; }
        SEL[row * 6 + h] = (unsigned)i0 | ((unsigned)i1 << 8) | ((unsigned)i2 << 16);
        if (LIST) { const unsigned t = (unsigned)(qb * 256 + query);
            if (i0 != 255) { const unsigned pos = __hip_atomic_fetch_add(cntl + i0, 1u, __ATOMIC_RELAXED, __HIP_MEMORY_SCOPE_WORKGROUP); LIST[moba_list_off(bh, i0) + (size_t)(qb - i0 - 1) * 256 + pos] = (unsigned short)(t | (0u << 14)); }
            if (i1 != 255) { const unsigned pos = __hip_atomic_fetch_add(cntl + i1, 1u, __ATOMIC_RELAXED, __HIP_MEMORY_SCOPE_WORKGROUP); LIST[moba_list_off(bh, i1) + (size_t)(qb - i1 - 1) * 256 + pos] = (unsigned short)(t | (1u << 14)); }
            if (i2 != 255) { const unsigned pos = __hip_atomic_fetch_add(cntl + i2, 1u, __ATOMIC_RELAXED, __HIP_MEMORY_SCOPE_WORKGROUP); LIST[moba_list_off(bh, i2) + (size_t)(qb - i2 - 1) * 256 + pos] = (unsigned short)(t | (2u << 14)); } }
    }
    __syncthreads();
    if (LIST && tid < 64) { const unsigned c = cntl[tid]; CTAB[((size_t)bh * 64 + qb) * 64 + tid] = c; if (c) atomicAdd(LCNT + bh * 64 + tid, c); }
    __syncthreads();
}

__device__ __forceinline__ void fox_naive(const bf16* PROJ, const float* FOXCUM, bf16* Y, int gw, int NGW, int lane) {
    for (int idx = gw; idx < 12 * SEQ; idx += NGW) {
        const int t = SEQ - 1 - idx / 12, bh = idx % 12, b = bh / 6, h = bh % 6; const size_t rb = (size_t)b * SEQ;
        const float qv = bf2f(PROJ[(rb + t) * PLD + C_FQ + h * 64 + lane]); const float ct = FOXCUM[(size_t)bh * SEQ + t];
        float m = -INFINITY, l = 0.f, acc = 0.f;
#pragma unroll 4
        for (int j = 0; j <= t; ++j) {
            const float kv = bf2f(PROJ[(rb + j) * PLD + C_FK + h * 64 + lane]), vv = bf2f(PROJ[(rb + j) * PLD + C_FV + h * 64 + lane]);
            const float s = wave_sum(qv * kv) + (ct - FOXCUM[(size_t)bh * SEQ + j]);
            const float mn = fmaxf(m, s), sc = exp2f(m - mn), p = exp2f(s - mn);
            l = l * sc + p; acc = acc * sc + p * vv; m = mn; }
        Y[(rb + t) * 1024 + Y_FOX + h * 64 + lane] = (bf16)f2bf(acc / l);
    }
}
__device__ __forceinline__ void moba_naive(const bf16* PROJ, const unsigned* SEL, bf16* Y, int gw, int NGW, int lane) {
    for (int idx = gw; idx < 12 * SEQ; idx += NGW) {
        const int t = SEQ - 1 - idx / 12, bh = idx % 12, b = bh / 6, h = bh % 6; const size_t rb = (size_t)b * SEQ;
        const float slope2 = exp2f(-8.f * (float)(h + 1) / 6.f) * LOG2E;
        const float qv = bf2f(PROJ[(rb + t) * PLD + C_BQ + h * 64 + lane]);
        const unsigned sel = SEL[(rb + t) * 6 + h];
        float m = -INFINITY, l = 0.f, acc = 0.f;
        for (int slot = 0; slot < 4; ++slot) {
            int j0, j1;
            if (slot < 3) { const int n = (sel >> (8 * slot)) & 0xff; if (n == 255) continue; j0 = n * 256; j1 = j0 + 256; } else { j0 = (t >> 8) * 256; j1 = t + 1; }
#pragma unroll 4
            for (int j = j0; j < j1; ++j) {
                const float kv = bf2f(PROJ[(rb + j) * PLD + C_BK + h * 64 + lane]), vv = bf2f(PROJ[(rb + j) * PLD + C_BV + h * 64 + lane]);
                const float s = wave_sum(qv * kv) - slope2 * (float)(t - j);
                const float mn = fmaxf(m, s), sc = exp2f(m - mn), p = exp2f(s - mn);
                l = l * sc + p; acc = acc * sc + p * vv; m = mn; }
        }
        Y[(rb + t) * 1024 + Y_MOBA + h * 64 + lane] = (bf16)f2bf(acc / l);
    }
}
typedef short v4i16_t __attribute__((ext_vector_type(4)));
typedef short s16x4 __attribute__((ext_vector_type(4)));
constexpr int ATT_K0 = 0, ATT_V0 = 32768, ATT_TAB = 132096;
#ifndef THRESH_NAT
#define THRESH_NAT 30.f
#endif
constexpr float THRESH2 = THRESH_NAT * LOG2E;

__device__ __forceinline__ int crow(int r, int hi) { return (r & 3) + 8 * (r >> 2) + 4 * hi; }
__device__ __forceinline__ s16x4 vtr(LAS const unsigned char* p) { return __builtin_bit_cast(s16x4, __builtin_amdgcn_ds_read_tr16_b64_v4i16((LAS v4i16_t*)p)); }
typedef float f32x2_t __attribute__((ext_vector_type(2))); typedef __bf16 bf16x2_t __attribute__((ext_vector_type(2)));
#ifndef CVT_ASM
#define CVT_ASM 0
#endif
#if CVT_ASM
__device__ __forceinline__ unsigned cvtpk(float lo, float hi) { unsigned r; asm volatile("v_cvt_pk_bf16_f32 %0, %1, %2\n\ts_nop 1" : "=v"(r) : "v"(lo), "v"(hi)); return r; }
#else
__device__ __forceinline__ unsigned cvtpk(float lo, float hi) { const f32x2_t v = {lo, hi}; const bf16x2_t b = __builtin_convertvector(v, bf16x2_t); return __builtin_bit_cast(unsigned, b); }
#endif

struct GroupRegs { v4u k[4], v[4]; };
__device__ __forceinline__ void group_issue(GroupRegs& R, const bf16* Kg, const bf16* Vg, int tid) {
#pragma unroll
    for (int i = 0; i < 4; ++i) { const int idx = tid + NTHREADS * i, row = idx >> 3, ch = idx & 7;
        R.k[i] = *(const v4u*)(Kg + (size_t)row * PLD + ch * 8); R.v[i] = *(const v4u*)(Vg + (size_t)row * PLD + ch * 8); }
}
__device__ __forceinline__ void group_commit(const GroupRegs& R, LAS unsigned char* kv, int tid) {
#pragma unroll
    for (int i = 0; i < 4; ++i) { const int idx = tid + NTHREADS * i, row = idx >> 3, ch = idx & 7;
        *(LAS v4u*)(kv + ATT_K0 + row * 128 + ((ch ^ ((row >> 1) & 7)) << 4)) = R.k[i];
        *(LAS v4u*)(kv + ATT_V0 + row * 128 + ((ch * 16) ^ (((row >> 1) & 1) << 6))) = R.v[i]; }
}
__device__ __forceinline__ void load_group(const bf16* Kg, const bf16* Vg, LAS unsigned char* kv, int tid) {
#pragma unroll
    for (int i = 0; i < 4; ++i) { const int idx = tid + NTHREADS * i, row = idx >> 3, ch = idx & 7;
        const v4u k = *(const v4u*)(Kg + (size_t)row * PLD + ch * 8), v = *(const v4u*)(Vg + (size_t)row * PLD + ch * 8);
        *(LAS v4u*)(kv + ATT_K0 + row * 128 + ((ch ^ ((row >> 1) & 7)) << 4)) = k;
        *(LAS v4u*)(kv + ATT_V0 + row * 128 + ((ch * 16) ^ (((row >> 1) & 1) << 6))) = v; }
}

template <bool FOX>
__device__ __forceinline__ void attn_subtile(LAS const unsigned char* kv, LAS const float* colt, int j0, const bf16x8 (&qf)[4], float rowterm, float slope2, bool mask, int qrel,
                                             f32x16 (&o)[2], float& l, int lane) {
    const int r32 = lane & 31, hh = lane >> 5;
    f32x16 acc;
    if (FOX) {
#pragma unroll
        for (int g = 0; g < 4; ++g) { const f32x4 c = *(LAS const f32x4*)(colt + j0 + 8 * g + 4 * hh); acc[4 * g + 0] = rowterm + c.x; acc[4 * g + 1] = rowterm + c.y; acc[4 * g + 2] = rowterm + c.z; acc[4 * g + 3] = rowterm + c.w; }
    } else {
#pragma unroll
        for (int r = 0; r < 16; ++r) acc[r] = rowterm + slope2 * (float)(j0 + crow(r, hh));
    }
    if (mask) {
#pragma unroll
        for (int r = 0; r < 16; ++r) if (j0 + crow(r, hh) > qrel) acc[r] = -INFINITY;
    }
    { const int row = j0 + r32; LAS const unsigned char* kr = kv + ATT_K0 + row * 128; const int sw = (row >> 1) & 7;
#pragma unroll
      for (int s = 0; s < 4; ++s) { const bf16x8 kf = *(LAS const bf16x8*)(kr + (((2 * s + hh) ^ sw) << 4)); acc = __builtin_amdgcn_mfma_f32_32x32x16_bf16(kf, qf[s], acc, 0, 0, 0); } }
    float ls = 0.f;
#pragma unroll
    for (int r = 0; r < 16; ++r) { acc[r] = __builtin_amdgcn_exp2f(acc[r]); ls += acc[r]; }
    l += ls;
    bf16x8 pa[2];
#pragma unroll
    for (int s = 0; s < 2; ++s) { v4u w; w.x = cvtpk(acc[8 * s + 0], acc[8 * s + 1]); w.y = cvtpk(acc[8 * s + 2], acc[8 * s + 3]); w.z = cvtpk(acc[8 * s + 4], acc[8 * s + 5]); w.w = cvtpk(acc[8 * s + 6], acc[8 * s + 7]); pa[s] = __builtin_bit_cast(bf16x8, w); }
    { const int i = lane & 15, c = (lane >> 4) & 1;
#pragma unroll
      for (int db = 0; db < 2; ++db)
#pragma unroll
          for (int s = 0; s < 2; ++s) { const int rowv = j0 + 16 * s + 4 * hh + (i >> 2); const int colb = (32 * db + 16 * c + 4 * (i & 3)) * 2;
              LAS const unsigned char* vp = kv + ATT_V0 + rowv * 128 + (colb ^ (((rowv >> 1) & 1) << 6));
              const s16x4 lo = vtr(vp), hi = vtr(vp + 8 * 128);
              const bf16x8 vf = (bf16x8){lo[0], lo[1], lo[2], lo[3], hi[0], hi[1], hi[2], hi[3]};
              o[db] = __builtin_amdgcn_mfma_f32_32x32x16_bf16(pa[s], vf, o[db], 0, 0, 0); } }
}
__device__ __forceinline__ float rfl(float x) { return __builtin_bit_cast(float, __builtin_amdgcn_readfirstlane(__builtin_bit_cast(int, x))); }

__device__ __forceinline__ void fox_unit(int bh, int qb, const bf16* PROJ, const float* FOXCUM, bf16* Y, float B2, LAS unsigned char* lds, int tid, int wave, int lane) {
    const int b = bh / 6, h = bh % 6; const size_t rb = (size_t)b * SEQ; const int r32 = lane & 31, hh = lane >> 5;
    const int q0w = qb * 256 + wave * 32, qpos = q0w + r32;
    const float* cum = FOXCUM + (size_t)bh * SEQ;
    bf16x8 qf[4];
#pragma unroll
    for (int s = 0; s < 4; ++s) qf[s] = *(const bf16x8*)(PROJ + (rb + qpos) * PLD + C_FQ + h * 64 + 16 * s + 8 * hh);
    GroupRegs GA, GB;
    group_issue(GA, PROJ + (rb + (size_t)qb * 256) * PLD + C_FK + h * 64, PROJ + (rb + (size_t)qb * 256) * PLD + C_FV + h * 64, tid);
    const float ca = (tid < 256) ? -cum[qb * 256 + tid] : 0.f;
    const float cq = cum[qpos];
    const float cq_first = rfl(cum[q0w]), cq_blk = rfl(cum[qb * 256]);
    const float cprev = (qb > 0) ? rfl(cum[qb * 256 - 1]) : 0.f;
    const float rowterm = cq - B2, lim = -THRESH2 - 2.f * B2;
    f32x16 o[2]; float l = 0.f;
#pragma unroll
    for (int r = 0; r < 16; ++r) { o[0][r] = 0.f; o[1][r] = 0.f; }
    LAS float* coltA = (LAS float*)(lds + ATT_TAB); LAS float* coltB = coltA + 256;
    LAS unsigned char* kvA = lds; LAS unsigned char* kvB = lds + 65536;
#ifndef FOX_2G
#define FOX_2G 1
#endif
    const bool haveB = FOX_2G && (qb > 0) && !(cq_blk - cprev < lim);
    float cb = 0.f;
    if (haveB) { group_issue(GB, PROJ + (rb + (size_t)(qb - 1) * 256) * PLD + C_FK + h * 64, PROJ + (rb + (size_t)(qb - 1) * 256) * PLD + C_FV + h * 64, tid);
        cb = (tid < 256) ? -cum[(qb - 1) * 256 + tid] : 0.f; }
    group_commit(GA, kvA, tid); if (tid < 256) coltA[tid] = ca;
    if (haveB) { group_commit(GB, kvB, tid); if (tid < 256) coltB[tid] = cb; }
    __syncthreads();
#ifndef REP_FLOAD
#define REP_FLOAD 0
#endif
#pragma unroll 1
    for (int rp = 0; rp < REP_FLOAD; ++rp) {
        group_issue(GA, PROJ + (rb + (size_t)qb * 256) * PLD + C_FK + h * 64, PROJ + (rb + (size_t)qb * 256) * PLD + C_FV + h * 64, tid);
        if (haveB) group_issue(GB, PROJ + (rb + (size_t)(qb - 1) * 256) * PLD + C_FK + h * 64, PROJ + (rb + (size_t)(qb - 1) * 256) * PLD + C_FV + h * 64, tid);
        group_commit(GA, kvA, tid); if (haveB) group_commit(GB, kvB, tid);
        __syncthreads(); }
#ifndef REP_FSUB
#define REP_FSUB 0
#endif
#pragma unroll 1
    for (int rp = 0; rp <= REP_FSUB; ++rp) {
    if (rp) { l = 0.f;
#pragma unroll
        for (int r = 0; r < 16; ++r) { o[0][r] = 0.f; o[1][r] = 0.f; } }
#pragma unroll 1
    for (int st = wave; st >= 0; --st) {
        const int j0 = 32 * st;
        if (cq_first + rfl(coltA[j0 + 31]) < lim) break;
        attn_subtile<true>(kvA, coltA, j0, qf, rowterm, 0.f, st == wave, wave * 32 + r32, o, l, lane);
    }
    if (haveB) {
#pragma unroll 1
        for (int st = 7; st >= 0; --st) {
            const int j0 = 32 * st;
            if (cq_first + rfl(coltB[j0 + 31]) < lim) break;
            attn_subtile<true>(kvB, coltB, j0, qf, rowterm, 0.f, false, 0, o, l, lane);
        }
    }
    }
    __syncthreads();
    {
        for (int g = haveB ? qb - 2 : qb - 1; g >= 0; --g) {
            if (cq_blk - rfl(cum[g * 256 + 255]) < lim) break;
            load_group(PROJ + (rb + (size_t)g * 256) * PLD + C_FK + h * 64, PROJ + (rb + (size_t)g * 256) * PLD + C_FV + h * 64, kvA, tid);
            if (tid < 256) coltA[tid] = -cum[g * 256 + tid];
            __syncthreads();
            {
#pragma unroll 1
                for (int st = 7; st >= 0; --st) {
                    const int j0 = 32 * st;
                    if (cq_first + rfl(coltA[j0 + 31]) < lim) break;
                    attn_subtile<true>(kvA, coltA, j0, qf, rowterm, 0.f, false, 0, o, l, lane);
                }
            }
            __syncthreads();
        }
    }
    l = half_sum(l, lane);
    bf16* yp = Y + (rb + (size_t)q0w) * 1024 + Y_FOX + h * 64 + r32;
#ifndef REP_FOUT
#define REP_FOUT 0
#endif
#pragma unroll 1
    for (int rp = 0; rp <= REP_FOUT; ++rp) {
#pragma unroll
    for (int r = 0; r < 16; ++r) { const int q = crow(r, hh); const float rl = 1.f / shf(l, q);
        yp[(size_t)q * 1024] = (bf16)f2bf(o[0][r] * rl); yp[(size_t)q * 1024 + 32] = (bf16)f2bf(o[1][r] * rl); }
    }
}

__device__ __forceinline__ void fox_unit_old(int bh, int qb, const bf16* PROJ, const float* FOXCUM, bf16* Y, float B2, LAS unsigned char* lds, int tid, int wave, int lane) {
    const int b = bh / 6, h = bh % 6; const size_t rb = (size_t)b * SEQ; const int r32 = lane & 31, hh = lane >> 5;
    const int q0w = qb * 256 + wave * 32, qpos = q0w + r32;
    const float* cum = FOXCUM + (size_t)bh * SEQ;
    bf16x8 qf[4];
#pragma unroll
    for (int s = 0; s < 4; ++s) qf[s] = *(const bf16x8*)(PROJ + (rb + qpos) * PLD + C_FQ + h * 64 + 16 * s + 8 * hh);
    const float cq = cum[qpos];
    const float cq_first = rfl(cum[q0w]);
    const float cq_blk = rfl(cum[qb * 256]);
    const float rowterm = cq - B2;
    f32x16 o[2]; float l = 0.f;
#pragma unroll
    for (int r = 0; r < 16; ++r) { o[0][r] = 0.f; o[1][r] = 0.f; }
    LAS float* colt = (LAS float*)(lds + ATT_TAB);
    for (int g = qb; g >= 0; --g) {
        if (g < qb) { const float cl = rfl(cum[g * 256 + 255]); if (2.f * B2 + cq_blk - cl < -THRESH2) break; }
        load_group(PROJ + (rb + (size_t)g * 256) * PLD + C_FK + h * 64, PROJ + (rb + (size_t)g * 256) * PLD + C_FV + h * 64, lds, tid);
        if (tid < 256) colt[tid] = -cum[g * 256 + tid];
        __syncthreads();
        const int stmax = (g == qb) ? wave : 7;
        for (int st = stmax; st >= 0; --st) {
            const int j0 = 32 * st;
            { const float cl = rfl(colt[j0 + 31]); if (2.f * B2 + cq_first + cl < -THRESH2) break; }
            attn_subtile<true>(lds, colt, j0, qf, rowterm, 0.f, (g == qb) && (st == wave), wave * 32 + r32, o, l, lane);
        }
        __syncthreads();
    }
    l = half_sum(l, lane);
    bf16* yp = Y + (rb + (size_t)q0w) * 1024 + Y_FOX + h * 64 + r32;
#pragma unroll
    for (int r = 0; r < 16; ++r) { const int q = crow(r, hh); const float rl = 1.f / shf(l, q);
        yp[(size_t)q * 1024] = (bf16)f2bf(o[0][r] * rl); yp[(size_t)q * 1024 + 32] = (bf16)f2bf(o[1][r] * rl); }
}

__device__ __forceinline__ size_t moba_list_off(int bh, int n) { return (size_t)bh * 516096 + 256 * (size_t)(63 * n - (n * (n - 1)) / 2); }
__device__ __forceinline__ void moba_store(const f32x16 (&o)[2], float l, int qpos, int slot, bool valid, size_t rb, int h, bf16* OPART, float* LPART, bf16* Y, int lane) {
    const int r32 = lane & 31, hh = lane >> 5;
#pragma unroll
    for (int r = 0; r < 16; ++r) { const int src = crow(r, hh);
        const int qp = shfi(qpos, src), sl = shfi(slot, src); const int ok = shfi((int)valid, src);
        if (ok) { bf16* op = (sl == 3) ? (Y + (rb + qp) * 1024 + Y_MOBA + h * 64) : (OPART + ((size_t)sl * MROWS + rb + qp) * 384 + h * 64);
            op[r32] = (bf16)f2bf(o[0][r]); op[32 + r32] = (bf16)f2bf(o[1][r]); } }
    if (valid && hh == 0) LPART[((size_t)slot * MROWS + rb + qpos) * 6 + h] = l;
}
__device__ __forceinline__ void moba_sel_unit(int bh, int n, int chunk, int cnt, const bf16* PROJ, const unsigned short* LIST, const unsigned* CTAB, bf16* OPART, float* LPART, bf16* Y, float B2,
                                              LAS unsigned char* lds, int tid, int wave, int lane) {
    const int b = bh / 6, h = bh % 6; const size_t rb = (size_t)b * SEQ; const int r32 = lane & 31, hh = lane >> 5;
    const float slope2 = exp2f(-8.f * (float)(h + 1) / 6.f) * LOG2E;
    GroupRegs GR; group_issue(GR, PROJ + (rb + (size_t)n * 256) * PLD + C_BK + h * 64, PROJ + (rb + (size_t)n * 256) * PLD + C_BV + h * 64, tid);
    const int nvalid = cnt - chunk * 256 < 256 ? cnt - chunk * 256 : 256;
    const bool active = wave * 32 < nvalid;
    bool valid = true; int qpos = 0, slot = 0; bf16x8 qf[4];
    if (active) {
        int li = wave * 32 + r32; if (li >= nvalid) { li = nvalid - 1; valid = false; }
        const int p = chunk * 256 + li;
        const int cv = (lane > n) ? (int)CTAB[((size_t)bh * 64 + lane) * 64 + n] : 0; int inc = cv;
#pragma unroll
        for (int o2 = 1; o2 < 64; o2 <<= 1) { const int t2 = supi(inc, o2, lane); if (lane >= o2) inc += t2; }
        int qseg = 0;
#pragma unroll
        for (int stp = 32; stp >= 1; stp >>= 1) { const int v = shfi(inc, qseg + stp - 1); if (v <= p) qseg += stp; }
        const int idx = p - (shfi(inc, qseg) - shfi(cv, qseg));
        const unsigned e = LIST[moba_list_off(bh, n) + (size_t)(qseg - n - 1) * 256 + idx]; qpos = e & 0x3fff; slot = e >> 14;
#pragma unroll
        for (int s = 0; s < 4; ++s) qf[s] = *(const bf16x8*)(PROJ + (rb + qpos) * PLD + C_BQ + h * 64 + 16 * s + 8 * hh);
    }
    group_commit(GR, lds, tid);
    __syncthreads();
    if (active) {
        const int qrel = qpos - n * 256;
        const float rowterm = -slope2 * (float)qrel - B2;
        f32x16 o[2]; float l = 0.f;
#pragma unroll
        for (int r = 0; r < 16; ++r) { o[0][r] = 0.f; o[1][r] = 0.f; }
#ifndef REP_SUB
#define REP_SUB 0
#endif
#pragma unroll 1
        for (int rp = 0; rp <= REP_SUB; ++rp) {
        if (rp) { l = 0.f;
#pragma unroll
            for (int r = 0; r < 16; ++r) { o[0][r] = 0.f; o[1][r] = 0.f; } }
#pragma unroll 1
        for (int st = 0; st < 8; ++st) attn_subtile<false>(lds, nullptr, 32 * st, qf, rowterm, slope2, false, 0, o, l, lane);
        }
        l = half_sum(l, lane);
        moba_store(o, l, qpos, slot, valid, rb, h, OPART, LPART, Y, lane);
    }
    __syncthreads();
}
__device__ __forceinline__ void moba_sel_step(int huA, int S, LAS const int* pre, const unsigned* lcnt, const bf16* PROJ, const unsigned short* LIST, const unsigned* CTAB, bf16* OPART, float* LPART, bf16* Y,
                                              float B2, LAS unsigned char* lds, int tid, int wave, int lane) {
    const int r32 = lane & 31, hh = lane >> 5, half = wave >> 2, tile = wave & 3, htid = tid & 255;
    const int hu = huA + half; const bool uvalid = hu < S;
    int p = 0, chunk = 0, cnt = 0;
    if (uvalid) { int lo2 = 0, hi2 = 768; while (hi2 - lo2 > 1) { const int mid = (lo2 + hi2) >> 1; if (pre[mid] <= hu) lo2 = mid; else hi2 = mid; } p = lo2; chunk = hu - pre[lo2]; cnt = (int)lcnt[lo2]; }
    const int bh = p >> 6, n = p & 63, b = bh / 6, h = bh % 6; const size_t rb = (size_t)b * SEQ;
    const float slope2 = exp2f(-8.f * (float)(h + 1) / 6.f) * LOG2E;
    LAS unsigned char* kv = lds + half * 65536;
    v4u gk[8], gv[8];
    if (uvalid) { const bf16* Kg = PROJ + (rb + (size_t)n * 256) * PLD + C_BK + h * 64; const bf16* Vg = PROJ + (rb + (size_t)n * 256) * PLD + C_BV + h * 64;
#pragma unroll
        for (int i = 0; i < 8; ++i) { const int idx = htid + 256 * i, row = idx >> 3, ch = idx & 7; gk[i] = *(const v4u*)(Kg + (size_t)row * PLD + ch * 8); gv[i] = *(const v4u*)(Vg + (size_t)row * PLD + ch * 8); } }
    const int nvalid = uvalid ? (cnt - chunk * 128 < 128 ? cnt - chunk * 128 : 128) : 0;
    const bool active = tile * 32 < nvalid;
    bool valid = true; int qpos = 0, slot = 0; bf16x8 qf[4];
    if (active) {
        int li = tile * 32 + r32; if (li >= nvalid) { li = nvalid - 1; valid = false; }
        const int pos = chunk * 128 + li;
        const int cv = (lane > n) ? (int)CTAB[((size_t)bh * 64 + lane) * 64 + n] : 0; int inc = cv;
#pragma unroll
        for (int o2 = 1; o2 < 64; o2 <<= 1) { const int t2 = supi(inc, o2, lane); if (lane >= o2) inc += t2; }
        int qseg = 0;
#pragma unroll
        for (int stp = 32; stp >= 1; stp >>= 1) { const int v = shfi(inc, qseg + stp - 1); if (v <= pos) qseg += stp; }
        const int idx = pos - (shfi(inc, qseg) - shfi(cv, qseg));
        const unsigned e = LIST[moba_list_off(bh, n) + (size_t)(qseg - n - 1) * 256 + idx]; qpos = e & 0x3fff; slot = e >> 14;
#pragma unroll
        for (int s = 0; s < 4; ++s) qf[s] = *(const bf16x8*)(PROJ + (rb + qpos) * PLD + C_BQ + h * 64 + 16 * s + 8 * hh);
    }
    if (uvalid) {
#pragma unroll
        for (int i = 0; i < 8; ++i) { const int idx = htid + 256 * i, row = idx >> 3, ch = idx & 7;
            *(LAS v4u*)(kv + ATT_K0 + row * 128 + ((ch ^ ((row >> 1) & 7)) << 4)) = gk[i];
            *(LAS v4u*)(kv + ATT_V0 + row * 128 + ((ch * 16) ^ (((row >> 1) & 1) << 6))) = gv[i]; } }
    __syncthreads();
    if (active) {
        const int qrel = qpos - n * 256;
        const float rowterm = -slope2 * (float)qrel - B2;
        f32x16 o[2]; float l = 0.f;
#pragma unroll
        for (int r = 0; r < 16; ++r) { o[0][r] = 0.f; o[1][r] = 0.f; }
#pragma unroll 1
        for (int st = 0; st < 8; ++st) attn_subtile<false>(kv, nullptr, 32 * st, qf, rowterm, slope2, false, 0, o, l, lane);
        l = half_sum(l, lane);
        moba_store(o, l, qpos, slot, valid, rb, h, OPART, LPART, Y, lane);
    }
    __syncthreads();
}
__device__ __forceinline__ void moba_own_pair(int bh, int nA, int nB, const bf16* PROJ, bf16* OPART, float* LPART, bf16* Y, float B2, LAS unsigned char* lds, int tid, int wave, int lane) {
    const int b = bh / 6, h = bh % 6; const size_t rb = (size_t)b * SEQ; const int r32 = lane & 31, hh = lane >> 5;
    const float slope2 = exp2f(-8.f * (float)(h + 1) / 6.f) * LOG2E;
    GroupRegs GA, GB;
    group_issue(GA, PROJ + (rb + (size_t)nA * 256) * PLD + C_BK + h * 64, PROJ + (rb + (size_t)nA * 256) * PLD + C_BV + h * 64, tid);
    group_issue(GB, PROJ + (rb + (size_t)nB * 256) * PLD + C_BK + h * 64, PROJ + (rb + (size_t)nB * 256) * PLD + C_BV + h * 64, tid);
    bf16x8 qfA[4], qfB[4];
    { const size_t qa = rb + (size_t)nA * 256 + wave * 32 + r32, qb2 = rb + (size_t)nB * 256 + (7 - wave) * 32 + r32;
#pragma unroll
      for (int s = 0; s < 4; ++s) { qfA[s] = *(const bf16x8*)(PROJ + qa * PLD + C_BQ + h * 64 + 16 * s + 8 * hh); qfB[s] = *(const bf16x8*)(PROJ + qb2 * PLD + C_BQ + h * 64 + 16 * s + 8 * hh); } }
    group_commit(GA, lds, tid); group_commit(GB, lds + 65536, tid);
    __syncthreads();
    { const int tile = wave, qrel = tile * 32 + r32, qpos = nA * 256 + qrel;
      const float rowterm = -slope2 * (float)qrel - B2;
      f32x16 o[2]; float l = 0.f;
#pragma unroll
      for (int r = 0; r < 16; ++r) { o[0][r] = 0.f; o[1][r] = 0.f; }
#pragma unroll 1
      for (int st = 0; st <= tile; ++st) attn_subtile<false>(lds, nullptr, 32 * st, qfA, rowterm, slope2, st == tile, qrel, o, l, lane);
      l = half_sum(l, lane);
      moba_store(o, l, qpos, 3, true, rb, h, OPART, LPART, Y, lane); }
    { const int tile = 7 - wave, qrel = tile * 32 + r32, qpos = nB * 256 + qrel;
      const float rowterm = -slope2 * (float)qrel - B2;
      f32x16 o[2]; float l = 0.f;
#pragma unroll
      for (int r = 0; r < 16; ++r) { o[0][r] = 0.f; o[1][r] = 0.f; }
#pragma unroll 1
      for (int st = 0; st <= tile; ++st) attn_subtile<false>(lds + 65536, nullptr, 32 * st, qfB, rowterm, slope2, st == tile, qrel, o, l, lane);
      l = half_sum(l, lane);
      moba_store(o, l, qpos, 3, true, rb, h, OPART, LPART, Y, lane); }
    __syncthreads();
}

__device__ __forceinline__ void moba_combine(const unsigned* SEL, const bf16* OPART, const float* LPART, bf16* Y, bf16* Yo, int opitch, int ocol, int gtid, int ngt) {
    constexpr size_t NIT = (size_t)MROWS * 48;
    for (size_t base = gtid; base < NIT; base += (size_t)ngt * 4) {
        unsigned sel[4]; v4u yv[4]; float lo[4]; size_t row[4]; int hh4[4], c84[4]; bool ok[4];
#pragma unroll
        for (int j = 0; j < 4; ++j) { const size_t idx = base + (size_t)j * ngt; ok[j] = idx < NIT; const size_t ii = ok[j] ? idx : 0;
            row[j] = ii / 48; const int hc = (int)(ii % 48); hh4[j] = hc >> 3; c84[j] = (hc & 7) * 8;
            sel[j] = SEL[row[j] * 6 + hh4[j]]; yv[j] = *(const v4u*)(Y + row[j] * 1024 + Y_MOBA + hh4[j] * 64 + c84[j]); lo[j] = LPART[((size_t)3 * MROWS + row[j]) * 6 + hh4[j]]; }
        v4u pv[4][3]; float pl[4][3];
#pragma unroll
        for (int j = 0; j < 4; ++j)
#pragma unroll
            for (int k = 0; k < 3; ++k) { const bool v = ((sel[j] >> (8 * k)) & 0xff) != 255;
                pv[j][k] = v ? *(const v4u*)(OPART + ((size_t)k * MROWS + row[j]) * 384 + hh4[j] * 64 + c84[j]) : (v4u){0u, 0u, 0u, 0u};
                pl[j][k] = v ? LPART[((size_t)k * MROWS + row[j]) * 6 + hh4[j]] : 0.f; }
#pragma unroll
        for (int j = 0; j < 4; ++j) { float acc[8]; unpack8(yv[j], acc); float l = lo[j];
#pragma unroll
            for (int k = 0; k < 3; ++k) { float f[8]; unpack8(pv[j][k], f);
#pragma unroll
                for (int i = 0; i < 8; ++i) acc[i] += f[i];
                l += pl[j][k]; }
            const float rl = 1.f / l;
            v4u w; w.x = pk2(acc[0] * rl, acc[1] * rl); w.y = pk2(acc[2] * rl, acc[3] * rl); w.z = pk2(acc[4] * rl, acc[5] * rl); w.w = pk2(acc[6] * rl, acc[7] * rl);
            if (ok[j]) *(v4u*)(Yo + row[j] * opitch + ocol + hh4[j] * 64 + c84[j]) = w; }
    }
}

__device__ __forceinline__ int vsw(int row, int colb) { return row * 128 + (colb ^ (((row >> 1) & 1) << 6)); }
__device__ __forceinline__ int ksw(int row, int ch) { return row * 128 + ((ch ^ ((row >> 1) & 7)) << 4); }
__device__ __forceinline__ void mlstm_m1_mfma(int ci, const MlP& P, LAS unsigned char* lds, int wave, int lane) {
    const int b = ci >> 10, h = (ci >> 8) & 3, c = ci & 255; const size_t row0 = (size_t)b * SEQ + c * 64;
    LAS unsigned char* Ki = lds + wave * 16384; LAS unsigned char* Vi = Ki + 8192;
    float wv;
    { const size_t row = row0 + lane;
      const float fi = P.GATES[row * 16 + 6 + h] + P.ibias[h], ff = P.GATES[row * 16 + 10 + h] + P.fbias[h];
      float bc = log_sigmoid_fast(ff);
#pragma unroll
      for (int o = 1; o < 64; o <<= 1) { const float n = sup(bc, o, lane); if (lane >= o) bc += n; }
      const float bend = shf(bc, 63);
      const float wl = bend - bc + fi; const float mloc = wave_max(wl);
      wv = exp_fast(wl - mloc);
      if (lane == 0) { P.BEND[ci] = bend; P.MLOC[ci] = mloc; } }
#pragma unroll
    for (int i = 0; i < 8; ++i) { const int idx = lane + 64 * i, r = idx >> 3, ch = idx & 7;
        const v4u kk = *(const v4u*)(P.KC + (row0 + r) * 256 + h * 64 + ch * 8);
        *(LAS v4u*)(Ki + vsw(r, ch * 16)) = kk;
        float f[8]; unpack8(*(const v4u*)(P.PROJ + (row0 + r) * PLD + C_MV + h * 64 + ch * 8), f);
        const float w = shf(wv, r);
        v4u o; o.x = pk2(f[0] * w, f[1] * w); o.y = pk2(f[2] * w, f[3] * w); o.z = pk2(f[4] * w, f[5] * w); o.w = pk2(f[6] * w, f[7] * w);
        *(LAS v4u*)(Vi + vsw(r, ch * 16)) = o; }
    LDS_WAIT(); asm volatile("" ::: "memory");
    { float nu = 0.f;
#pragma unroll 8
      for (int s = 0; s < 64; ++s) { const float ws = shf(wv, s); nu += ws * bf2f(*(LAS const unsigned short*)(Ki + vsw(s, 2 * lane))); }
      P.NU[(size_t)ci * 64 + lane] = nu; }
    f32x16 D[2][2];
#pragma unroll
    for (int a = 0; a < 2; ++a)
#pragma unroll
        for (int e = 0; e < 2; ++e)
#pragma unroll
            for (int r = 0; r < 16; ++r) D[a][e][r] = 0.f;
    const int i16 = lane & 15, cc = (lane >> 4) & 1, hh = lane >> 5, r32 = lane & 31;
#pragma unroll
    for (int ks = 0; ks < 4; ++ks) { const int rowv = 16 * ks + 4 * hh + (i16 >> 2);
        bf16x8 af[2], bfr[2];
#pragma unroll
        for (int blk = 0; blk < 2; ++blk) { const int colb = (32 * blk + 16 * cc + 4 * (i16 & 3)) * 2;
            { const s16x4 lo = vtr(Vi + vsw(rowv, colb)), hi = vtr(Vi + vsw(rowv, colb) + 1024); af[blk] = (bf16x8){lo[0], lo[1], lo[2], lo[3], hi[0], hi[1], hi[2], hi[3]}; }
            { const s16x4 lo = vtr(Ki + vsw(rowv, colb)), hi = vtr(Ki + vsw(rowv, colb) + 1024); bfr[blk] = (bf16x8){lo[0], lo[1], lo[2], lo[3], hi[0], hi[1], hi[2], hi[3]}; } }
#pragma unroll
        for (int a = 0; a < 2; ++a)
#pragma unroll
            for (int e = 0; e < 2; ++e) D[a][e] = __builtin_amdgcn_mfma_f32_32x32x16_bf16(af[a], bfr[e], D[a][e], 0, 0, 0); }
    float* up = P.U + (size_t)ci * 4096;
#pragma unroll
    for (int a = 0; a < 2; ++a)
#pragma unroll
        for (int e = 0; e < 2; ++e)
#pragma unroll
            for (int r = 0; r < 16; ++r) up[(32 * a + crow(r, hh)) * 64 + 32 * e + r32] = D[a][e][r];
    LDS_WAIT(); asm volatile("" ::: "memory");
}

__device__ __forceinline__ void mlstm_m3_mfma(int it, const MlP& P, LAS unsigned char* lds, int tid, int wave, int lane) {
    const int cs = wave >> 1, tile = wave & 1, ci = it * 4 + cs;
    const int b = ci >> 10, h = (ci >> 8) & 3, c = ci & 255; const size_t row0 = (size_t)b * SEQ + c * 64;
    LAS unsigned char* Ki = lds + cs * 32768; LAS unsigned char* Vi = Ki + 8192; LAS unsigned char* Ci = Ki + 16384; LAS unsigned char* Mi = Ki + 24576;
    LAS float* tab = (LAS float*)(lds + ATT_TAB) + cs * 256;
    const float ms = P.MS[ci];
    { const int pt = tile * 64 + lane;
#pragma unroll
      for (int i = 0; i < 4; ++i) { const int idx = pt + 128 * i, r = idx >> 3, ch = idx & 7;
          *(LAS v4u*)(Ki + ksw(r, ch)) = *(const v4u*)(P.KC + (row0 + r) * 256 + h * 64 + ch * 8);
          *(LAS v4u*)(Vi + vsw(r, ch * 16)) = *(const v4u*)(P.PROJ + (row0 + r) * PLD + C_MV + h * 64 + ch * 8);
          *(LAS v4u*)(Ci + ksw(r, ch)) = *(const v4u*)(P.CS + (size_t)ci * 4096 + r * 64 + ch * 8);
          *(LAS v4u*)(Mi + r * 128 + ch * 16) = *(const v4u*)(P.PROJ + (row0 + r) * PLD + C_MO + h * 64 + ch * 8); } }
    if (tile == 0) {
        const size_t row = row0 + lane;
        const float fi = P.GATES[row * 16 + 6 + h] + P.ibias[h], ff = P.GATES[row * 16 + 10 + h] + P.fbias[h];
        float bc = log_sigmoid_fast(ff);
#pragma unroll
        for (int o = 1; o < 64; o <<= 1) { const float n = sup(bc, o, lane); if (lane >= o) bc += n; }
        const float a = fi - bc; float pm = a;
#pragma unroll
        for (int o = 1; o < 64; o <<= 1) { const float n = sup(pm, o, lane); if (lane >= o) pm = fmaxf(pm, n); }
        tab[lane] = a * LOG2E; tab[64 + lane] = fmaxf(ms, pm); tab[128 + lane] = bc; tab[192 + lane] = P.NS[(size_t)ci * 64 + lane];
    }
    __syncthreads();
    const int r32 = lane & 31, hh = lane >> 5, j = 32 * tile + r32;
    bf16x8 qf[4];
#pragma unroll
    for (int s = 0; s < 4; ++s) qf[s] = *(const bf16x8*)(P.QC + (row0 + j) * 256 + h * 64 + 16 * s + 8 * hh);
    const float gj = tab[64 + j], inter = exp_fast(ms - gj), rowterm2 = -gj * LOG2E;
    f32x16 o[2]; float l = 0.f;
#pragma unroll
    for (int r = 0; r < 16; ++r) { o[0][r] = 0.f; o[1][r] = 0.f; }
    for (int st = 0; st <= tile; ++st) {
        const int j0 = 32 * st;
        f32x16 acc;
#pragma unroll
        for (int r = 0; r < 16; ++r) acc[r] = 0.f;
#pragma unroll
        for (int s = 0; s < 4; ++s) { const bf16x8 kf = *(LAS const bf16x8*)(Ki + ksw(j0 + r32, 2 * s + hh)); acc = __builtin_amdgcn_mfma_f32_32x32x16_bf16(kf, qf[s], acc, 0, 0, 0); }
        float ls = 0.f;
#pragma unroll
        for (int g4 = 0; g4 < 4; ++g4) { const f32x4 c4 = *(LAS const f32x4*)(tab + j0 + 8 * g4 + 4 * hh);
#pragma unroll
            for (int ii = 0; ii < 4; ++ii) { const int reg = 4 * g4 + ii, key = j0 + 8 * g4 + 4 * hh + ii;
                float p = acc[reg] * __builtin_amdgcn_exp2f(rowterm2 + c4[ii]);
                if (st == tile && key > j) p = 0.f;
                acc[reg] = p; ls += p; } }
        l += ls;
        bf16x8 pa[2];
#pragma unroll
        for (int s = 0; s < 2; ++s) { v4u w; w.x = cvtpk(acc[8 * s + 0], acc[8 * s + 1]); w.y = cvtpk(acc[8 * s + 2], acc[8 * s + 3]); w.z = cvtpk(acc[8 * s + 4], acc[8 * s + 5]); w.w = cvtpk(acc[8 * s + 6], acc[8 * s + 7]); pa[s] = __builtin_bit_cast(bf16x8, w); }
        { const int i16 = lane & 15, cc = (lane >> 4) & 1;
#pragma unroll
          for (int db = 0; db < 2; ++db)
#pragma unroll
              for (int s = 0; s < 2; ++s) { const int rowv = j0 + 16 * s + 4 * hh + (i16 >> 2); const int colb = (32 * db + 16 * cc + 4 * (i16 & 3)) * 2;
                  LAS const unsigned char* vp = Vi + vsw(rowv, colb);
                  const s16x4 lo = vtr(vp), hi = vtr(vp + 1024);
                  const bf16x8 vf = (bf16x8){lo[0], lo[1], lo[2], lo[3], hi[0], hi[1], hi[2], hi[3]};
                  o[db] = __builtin_amdgcn_mfma_f32_32x32x16_bf16(pa[s], vf, o[db], 0, 0, 0); } }
    }
    float dn = 0.f;
#pragma unroll
    for (int s = 0; s < 4; ++s) { float f[8]; unpack8(__builtin_bit_cast(v4u, qf[s]), f);
        const f32x4 n0 = *(LAS const f32x4*)(tab + 192 + 16 * s + 8 * hh), n1 = *(LAS const f32x4*)(tab + 192 + 16 * s + 8 * hh + 4);
        dn += (f[0] * n0.x + f[1] * n0.y) + (f[2] * n0.z + f[3] * n0.w) + (f[4] * n1.x + f[5] * n1.y) + (f[6] * n1.z + f[7] * n1.w);
        v4u w; w.x = cvtpk(f[0] * inter, f[1] * inter); w.y = cvtpk(f[2] * inter, f[3] * inter); w.z = cvtpk(f[4] * inter, f[5] * inter); w.w = cvtpk(f[6] * inter, f[7] * inter);
        const bf16x8 qs = __builtin_bit_cast(bf16x8, w);
#pragma unroll
        for (int db = 0; db < 2; ++db) { const bf16x8 cf = *(LAS const bf16x8*)(Ci + ksw(32 * db + r32, 2 * s + hh)); o[db] = __builtin_amdgcn_mfma_f32_32x32x16_bf16(qs, cf, o[db], 0, 0, 0); } }
    dn = half_sum(dn, lane); l = half_sum(l, lane);
    const float den = inter * dn + l, mj = tab[128 + j] + gj;
    const float rd = 1.f / fmaxf(fabsf(den), exp_fast(-mj));
    const float hg0 = P.hg[h * 64 + r32], hg1 = P.hg[h * 64 + 32 + r32];
    unsigned short mo0[16], mo1[16];
#pragma unroll
    for (int r = 0; r < 16; ++r) { LAS const unsigned short* mq = (LAS const unsigned short*)(Mi + (32 * tile + crow(r, hh)) * 128) + r32; mo0[r] = mq[0]; mo1[r] = mq[32]; }
#pragma unroll
    for (int r = 0; r < 16; ++r) { const int src = crow(r, hh); const float rdr = shf(rd, src);
        const float h0 = o[0][r] * rdr, h1 = o[1][r] * rdr; float ss = h0 * h0 + h1 * h1;
        ss += SWZ_X(ss, 1); ss += SWZ_X(ss, 2); ss += SWZ_X(ss, 4); ss += SWZ_X(ss, 8); ss += SWZ_X(ss, 16);
        const float rr = 1.f / sqrtf(ss * (1.f / 64.f) + EPS);
        LAS unsigned short* mp = (LAS unsigned short*)(Mi + (32 * tile + src) * 128) + r32;
        const float e0 = __builtin_amdgcn_exp2f(-bf2f(mo0[r]) * LOG2E), e1 = __builtin_amdgcn_exp2f(-bf2f(mo1[r]) * LOG2E);
        mp[0] = (unsigned short)f2bf(h0 * rr * hg0 * __builtin_amdgcn_rcpf(1.f + e0));
        mp[32] = (unsigned short)f2bf(h1 * rr * hg1 * __builtin_amdgcn_rcpf(1.f + e1)); }
    LDS_WAIT(); asm volatile("" ::: "memory");
#pragma unroll
    for (int i = 0; i < 4; ++i) { const int rw = (lane >> 3) + 8 * i, ch = lane & 7;
        *(v4u*)(P.Y + (row0 + 32 * tile + rw) * 1024 + Y_ML + h * 64 + ch * 8) = *(LAS const v4u*)(Mi + (32 * tile + rw) * 128 + ch * 16); }
    __syncthreads();
}

__device__ __forceinline__ void top3_ins(float g, int n, float& v0, float& v1, float& v2, int& i0, int& i1, int& i2) {
    const bool c0 = g > v0, c1 = g > v1, c2 = g > v2;
    const float nv2 = c1 ? v1 : (c2 ? g : v2); const int ni2 = c1 ? i1 : (c2 ? n : i2);
    const float nv1 = c0 ? v0 : (c1 ? g : v1); const int ni1 = c0 ? i0 : (c1 ? n : i1);
    v0 = c0 ? g : v0; i0 = c0 ? n : i0; v1 = nv1; i1 = ni1; v2 = nv2; i2 = ni2;
}
__device__ __forceinline__ void moba_gate_mfma(int u, const bf16* PROJ, const float* KMEAN, unsigned* SEL, unsigned* LCNT, unsigned* CTAB, unsigned short* LIST, float B2, float thresh2,
                                               LAS unsigned char* lds, int tid, int wave, int lane) {
    const int bh = u >> 6, qb = 63 - (u & 63), b = bh / 6, h = bh % 6; const int r32 = lane & 31, hh = lane >> 5;
    LAS unsigned char* Khi = lds; LAS unsigned char* Klo = lds + 8192; LAS unsigned* cntl = (LAS unsigned*)(lds + 16384);
    if (tid < 64) cntl[tid] = 0u;
    { const int n = tid >> 3, ch = tid & 7; float f[8];
      if (n < qb) { const float* k0 = KMEAN + ((size_t)bh * NBLK + n) * 64 + ch * 8; const float* k1 = k0 + (size_t)(12 * NBLK * 64);
          const f32x4 a0 = *(const f32x4*)k0, a1 = *(const f32x4*)(k0 + 4), b0 = *(const f32x4*)k1, b1 = *(const f32x4*)(k1 + 4);
          f[0] = a0.x + b0.x; f[1] = a0.y + b0.y; f[2] = a0.z + b0.z; f[3] = a0.w + b0.w; f[4] = a1.x + b1.x; f[5] = a1.y + b1.y; f[6] = a1.z + b1.z; f[7] = a1.w + b1.w; }
      else {
#pragma unroll
          for (int i = 0; i < 8; ++i) f[i] = 0.f; }
      unsigned hi[8]; float lo[8];
#pragma unroll
      for (int i = 0; i < 8; ++i) { hi[i] = f2bf(f[i]); lo[i] = f[i] - bf2f((unsigned short)hi[i]); }
      v4u wh; wh.x = hi[0] | (hi[1] << 16); wh.y = hi[2] | (hi[3] << 16); wh.z = hi[4] | (hi[5] << 16); wh.w = hi[6] | (hi[7] << 16);
      v4u wl; wl.x = pk2(lo[0], lo[1]); wl.y = pk2(lo[2], lo[3]); wl.z = pk2(lo[4], lo[5]); wl.w = pk2(lo[6], lo[7]);
      *(LAS v4u*)(Khi + ksw(n, ch)) = wh; *(LAS v4u*)(Klo + ksw(n, ch)) = wl; }
    const int query = wave * 32 + r32; const size_t row = (size_t)b * SEQ + qb * 256 + query;
    bf16x8 qf[4];
#pragma unroll
    for (int s = 0; s < 4; ++s) qf[s] = *(const bf16x8*)(PROJ + row * PLD + C_BQ + h * 64 + 16 * s + 8 * hh);
    __syncthreads();
    float v0 = -INFINITY, v1 = -INFINITY, v2 = -INFINITY; int i0 = 255, i1 = 255, i2 = 255;
#pragma unroll 1
    for (int st = 0; st < 2; ++st) {
        if (32 * st >= qb) break;
        f32x16 acc;
#pragma unroll
        for (int r = 0; r < 16; ++r) acc[r] = 0.f;
#pragma unroll
        for (int s = 0; s < 4; ++s) { const bf16x8 kh = *(LAS const bf16x8*)(Khi + ksw(32 * st + r32, 2 * s + hh)), kl = *(LAS const bf16x8*)(Klo + ksw(32 * st + r32, 2 * s + hh));
            acc = __builtin_amdgcn_mfma_f32_32x32x16_bf16(kh, qf[s], acc, 0, 0, 0); acc = __builtin_amdgcn_mfma_f32_32x32x16_bf16(kl, qf[s], acc, 0, 0, 0); }
#pragma unroll
        for (int r = 0; r < 16; ++r) { const int n = 32 * st + crow(r, hh); if (n < qb) top3_ins(acc[r], n, v0, v1, v2, i0, i1, i2); }
    }
    { const int pl = lane ^ 32;
      const float w0 = shf(v0, pl), w1 = shf(v1, pl), w2 = shf(v2, pl); const int j0 = shfi(i0, pl), j1 = shfi(i1, pl), j2 = shfi(i2, pl);
      if (j0 != 255) top3_ins(w0, j0, v0, v1, v2, i0, i1, i2);
      if (j1 != 255) top3_ins(w1, j1, v0, v1, v2, i0, i1, i2);
      if (j2 != 255) top3_ins(w2, j2, v0, v1, v2, i0, i1, i2); }
    if (hh == 0) {
        { const float slope2 = exp2f(-8.f * (float)(h + 1) / 6.f) * LOG2E; const float lim = (2.f * B2 + thresh2) / slope2; const int t0 = qb * 256 + query - 255;
          if (i0 != 255 && (float)(t0 - i0 * 256) > lim) i0 = 255;
          if (i1 != 255 && (float)(t0 - i1 * 256) > lim) i1 = 255;
          if (i2 != 255 && (float)(t0 - i2 * 256) > lim) i2 = 255; }
        SEL[row * 6 + h] = (unsigned)i0 | ((unsigned)i1 << 8) | ((unsigned)i2 << 16);
        if (LIST) { const unsigned t = (unsigned)(qb * 256 + query);
            if (i0 != 255) { const unsigned pos = __hip_atomic_fetch_add(cntl + i0, 1u, __ATOMIC_RELAXED, __HIP_MEMORY_SCOPE_WORKGROUP); LIST[moba_list_off(bh, i0) + (size_t)(qb - i0 - 1) * 256 + pos] = (unsigned short)(t | (0u << 14)); }
            if (i1 != 255) { const unsigned pos = __hip_atomic_fetch_add(cntl + i1, 1u, __ATOMIC_RELAXED, __HIP_MEMORY_SCOPE_WORKGROUP); LIST[moba_list_off(bh, i1) + (size_t)(qb - i1 - 1) * 256 + pos] = (unsigned short)(t | (1u << 14)); }
            if (i2 != 255) { const unsigned pos = __hip_atomic_fetch_add(cntl + i2, 1u, __ATOMIC_RELAXED, __HIP_MEMORY_SCOPE_WORKGROUP); LIST[moba_list_off(bh, i2) + (size_t)(qb - i2 - 1) * 256 + pos] = (unsigned short)(t | (2u << 14)); } }
    }
    __syncthreads();
    if (LIST && tid < 64) { const unsigned c = cntl[tid]; CTAB[((size_t)bh * 64 + qb) * 64 + tid] = c; if (c) atomicAdd(LCNT + bh * 64 + tid, c); }
    __syncthreads();
}
#ifndef FOX_MFMA
#define FOX_MFMA 1
#endif
#ifndef MOBA_MFMA
#define MOBA_MFMA 1
#endif
#ifndef REP_P0
#define REP_P0 0
#endif
#ifndef REP_NORM
#define REP_NORM 0
#endif
#ifndef REP_GIN
#define REP_GIN 0
#endif
#ifndef REP_FOX
#define REP_FOX 0
#endif
#ifndef REP_M1
#define REP_M1 0
#endif
#ifndef REP_MIXB
#define REP_MIXB 0
#endif
#ifndef REP_M3
#define REP_M3 0
#endif
#ifndef REP_GGU
#define REP_GGU 0
#endif
#ifndef REP_GATE
#define REP_GATE 0
#endif
#ifndef REP_CONV
#define REP_CONV 0
#endif
#ifndef REP_FCUM
#define REP_FCUM 0
#endif
#ifndef REP_QKN
#define REP_QKN 0
#endif
#ifndef REP_GOUT
#define REP_GOUT 0
#endif
#ifndef REP_GDN
#define REP_GDN 0
#endif
#ifndef REP_COMB
#define REP_COMB 0
#endif
#ifndef REP_BAR
#define REP_BAR 0
#endif
#ifndef REP_GATE2
#define REP_GATE2 0
#endif
#ifndef ML_MFMA
#define ML_MFMA 1
#endif
#ifndef REP_M2
#define REP_M2 0
#endif
#ifndef FOX_OLD
#define FOX_OLD 0
#endif
#if FOX_OLD
#define FOX_FN fox_unit_old
#else
#define FOX_FN fox_unit
#endif
#ifndef REP_PRE
#define REP_PRE 0
#endif
#ifndef GGU_ALIGN
#define GGU_ALIGN true
#endif
#ifndef GGU_SP2
#define GGU_SP2 true
#endif
#ifndef GIN_ALIGN
#define GIN_ALIGN true
#endif
#ifndef GIN_SP2
#define GIN_SP2 true
#endif
#ifndef N_LAUNCH_MODE
#define N_LAUNCH_MODE 1
#endif
constexpr int NPHASE = 2 + 8 * DEPTH;
struct Args { const float* in[20]; float* out; unsigned char* ws; int ph_lo, ph_hi; };
static_assert(sizeof(Args) == 20 * 8 + 8 + 8 + 8, "Args has no padding");

__global__ void __launch_bounds__(NTHREADS, 2) fwd(Args args) {
    extern __shared__ __attribute__((aligned(16))) unsigned char lds_raw[];
    LAS unsigned char* lds = (LAS unsigned char*)lds_raw;
    LAS float* ldsf = (LAS float*)lds_raw;
    volatile LAS unsigned* MISC = (volatile LAS unsigned*)(lds + MISC_OFF);
    const int G = gridDim.x; const int bx = blockIdx.x; const int vcu = (G % 8 == 0) ? (bx % 8) * (G / 8) + bx / 8 : bx;
    const int NGW = G * NWAVES;
#define PH_IDS() int tid = threadIdx.x; asm volatile("" : "+v"(tid)); const int lane = tid & 63, wave = __builtin_amdgcn_readfirstlane(tid >> 6); const int gw = vcu * NWAVES + wave; (void)lane; (void)gw; \
    unsigned char* ws = ws_k; asm volatile("" : "+s"(ws)); gu32* ctl = (gu32*)(ws + WS_CTL); (void)ctl
    unsigned char* const ws_k = args.ws;
    gu32* ctl0 = (gu32*)(ws_k + WS_CTL);
    for (int u = threadIdx.x; u < (LDS_BYTES - LDSCTL_OFF) / 4; u += NTHREADS) ((LAS unsigned*)(lds + LDSCTL_OFF))[u] = 0u;
    __syncthreads();
    XcdBarrier bar; bar.bar = (unsigned*)(ctl0 + CW_BAR); bar.x = 0; bar.st = nullptr;
    if (N_LAUNCH_MODE == 1) bar = xcd_barrier_post((unsigned*)(ctl0 + CW_BAR), MISC + 8);
    const int lo = args.ph_lo, hi = args.ph_hi;
#ifndef PHMASK
#define PHMASK 0xfff
#endif
#define PHEN(j) ((PHMASK >> (j)) & 1)
#define IN(k) ((N_LAUNCH_MODE == 1) || (lo <= (k) && (k) < hi))
#define SEAM(k) do { if (IN(k) && IN((k) + 1)) { xcd_barrier(bar); for (int rb_ = 0; rb_ < REP_BAR; ++rb_) xcd_barrier(bar); } } while (0)

#define PRM(k) (*(const float* const volatile*)(ws + WS_PTAB + 8 * (k)))
#define x_in PRM(0)
#define norm1_g PRM(4)
#define norm2_g PRM(5)
#define fox_f_bias PRM(7)
#define fox_q_g PRM(8)
#define fox_k_g PRM(9)
#define ml_conv_w PRM(10)
#define ml_conv_b PRM(11)
#define ml_i_bias PRM(12)
#define ml_f_bias PRM(13)
#define ml_h_g PRM(14)
#define moba_q_g PRM(15)
#define moba_k_g PRM(16)
#define xres ((float*)PRM(20))
#define MOD ((float*)(ws + WS_MOD))
#define XN ((bf16*)(ws + WS_XN))
#define PROJ ((bf16*)(ws + WS_PROJ))
#define HB ((bf16*)(ws + WS_H))
#define Y ((bf16*)(ws + WS_Y))
#define GATES ((float*)(ws + WS_GATES))
#define FOXCUM ((float*)(ws + WS_FOXCUM))
#define KMEAN ((float*)(ws + WS_KMEAN))
#define QC ((bf16*)(ws + WS_QC))
#define KC ((bf16*)(ws + WS_KC))
#define SEL ((unsigned*)(ws + WS_SEL))
#define mod_l (MOD + (size_t)l * 2 * 6144)
#define MK_MP() const float* const ib_ = ml_i_bias; const float* const fb_ = ml_f_bias; const float* const hg_ = ml_h_g; \
    MlP MP{PROJ, QC, KC, GATES, (float*)(ws + WS_U), (float*)(ws + WS_NU), (float*)(ws + WS_BEND), (float*)(ws + WS_MLOC), (bf16*)(ws + WS_CS), (float*)(ws + WS_NS), (float*)(ws + WS_MS), Y, ib_ + l * 4, fb_ + l * 4, hg_ + l * 256}

    for (int rep = 0; rep <= REP_P0; ++rep)
    if (PHEN(10) && IN(0)) { PH_IDS();
        const float* cvec = args.in[1]; const float* w_ada = args.in[2]; const float* b_ada = args.in[3]; const float* w_in = args.in[6];
        const float* w_out = args.in[17]; const float* w_gate_up = args.in[18]; const float* w_down = args.in[19];
        if (blockIdx.x == 0 && tid == 0) { const float** pt = (const float**)(ws + WS_PTAB);
            pt[0] = args.in[0]; pt[4] = args.in[4]; pt[5] = args.in[5]; pt[7] = args.in[7]; pt[8] = args.in[8]; pt[9] = args.in[9]; pt[10] = args.in[10]; pt[11] = args.in[11]; pt[12] = args.in[12];
            pt[13] = args.in[13]; pt[14] = args.in[14]; pt[15] = args.in[15]; pt[16] = args.in[16]; pt[20] = args.out; }
        if (vcu < 192) p0_mod_unit(vcu, cvec, w_ada, b_ada, MOD, ldsf, tid, wave, lane);
        LAS float* scr = (LAS float*)(lds + wave * 16384);
        constexpr int I_IN = 16 * (NIN / 32), I_OUT = 16 * (DM / 32), I_GU = 16 * (NGU / 32), I_DN = (DFF / 64) * (DM / 32), I_L = I_IN + I_OUT + I_GU + I_DN;
        for (int it = gw; it < DEPTH * I_L; it += NGW) {
            const int l = it / I_L; int r = it % I_L;
            if (r < I_IN) { transpose_item<1>(w_in + (size_t)l * DM * INC, DM, INC, (bf16*)(ws + WS_WIN + l * WIN_BYTES), scr, NIN / 32, r, lane); continue; } r -= I_IN;
            if (r < I_OUT) { transpose_item<0>(w_out + (size_t)l * DM * DM, DM, DM, (bf16*)(ws + WS_WOUT + l * WOUT_BYTES), scr, DM / 32, r, lane); continue; } r -= I_OUT;
            if (r < I_GU) { transpose_item<2>(w_gate_up + (size_t)l * DM * NGU, DM, NGU, (bf16*)(ws + WS_WGU + l * WGU_BYTES), scr, NGU / 32, r, lane); continue; } r -= I_GU;
            transpose_item<0>(w_down + (size_t)l * DFF * DM, DFF, DM, (bf16*)(ws + WS_WDN + l * WDN_BYTES), scr, DM / 32, r, lane);
        }
        if (REP_P0) __syncthreads();
    }
    SEAM(0);
    for (int rep = 0; rep <= REP_PRE; ++rep)
    if (PHEN(11) && IN(1)) { PH_IDS();
        const float* n1g = norm1_g; const float* n2g = norm2_g;
        pre_rows(x_in, n1g, MOD, XN, (float*)(ws + WS_SSP), gw, NGW, lane);
        pre_avec(n1g, n2g, MOD, (float*)(ws + WS_AVEC), vcu * NTHREADS + tid, G * NTHREADS);
        for (int l = 0; l < DEPTH; ++l) {
            const float* m0 = MOD + (size_t)l * 2 * 6144; const float* m1 = m0 + 6144;
            pre_bias((const bf16*)(ws + WS_WIN + l * WIN_BYTES), NIN, m0, m1, (float*)(ws + WS_BIASIN) + (size_t)l * 2 * NIN, (float*)(ws + WS_BIASIN) + (size_t)l * 2 * NIN + NIN, gw, NGW, lane);
            pre_bias((const bf16*)(ws + WS_WGU + l * WGU_BYTES), NGU, m0 + 3072, m1 + 3072, (float*)(ws + WS_BIASGU) + (size_t)l * 2 * NGU, (float*)(ws + WS_BIASGU) + (size_t)l * 2 * NGU + NGU, gw, NGW, lane);
        }
    }
    SEAM(1);

    for (int l = 0; l < DEPTH; ++l) {
        const int pb = 2 + 8 * l;
        for (int rep = 0; rep <= REP_GIN; ++rep)
        if (PHEN(0) && IN(pb + 0)) { PH_IDS();
            pg8::Gemm g{XN, (const bf16*)(ws + WS_WIN + l * WIN_BYTES), MROWS, NIN, DM}; pg8::StaticOrder S; S.init(MROWS, NIN, G, bx);
            LAS float* rt = (LAS float*)(lds + ATT_TAB); LAS float* bt = rt + 512;
            const int pm0 = rstd_tables(S, (const float*)(ws + WS_SSP), rt, (const float*)(ws + WS_BIASIN) + (size_t)l * 2 * NIN, NIN, bt, tid);
            pg8::EpiProj E{PROJ, GATES, PLD, rt, pm0, bt};
            pg8::gemm_phase<pg8::EpiProj, pg8::StaticOrder, GIN_ALIGN, GIN_SP2>(lds, g, S, E, tid);
        }
        SEAM(pb + 0);
        if (PHEN(1) && IN(pb + 1)) { PH_IDS();
            for (int u = vcu; u < 524; u += G) {
                if (u < 12) post_foxcum_unit(u, GATES, FOXCUM, fox_f_bias + l * 6, ldsf, tid, wave, lane);
                else if (u < 268) post_qknorm_unit(u - 12, PROJ, KMEAN, fox_q_g + l * 64, fox_k_g + l * 64, moba_q_g + l * 64, moba_k_g + l * 64, ldsf, tid, wave, lane);
                else { const int which = (u - 268) & 1; post_conv_unit((u - 268) >> 1, which, PROJ, which ? KC : QC, ml_conv_w + l * 4 * 512, ml_conv_b + l * 512, tid); }
            }
            for (int rep = 0; rep < REP_CONV; ++rep) for (int u = vcu; u < 256; u += G) { const int which = u & 1; post_conv_unit(u >> 1, which, PROJ, which ? KC : QC, ml_conv_w + l * 4 * 512, ml_conv_b + l * 512, tid); }
            for (int rep = 0; rep < REP_FCUM; ++rep) for (int u = vcu; u < 12; u += G) post_foxcum_unit(u, GATES, FOXCUM, fox_f_bias + l * 6, ldsf, tid, wave, lane);
        }
        SEAM(pb + 1);
        if (PHEN(2) && IN(pb + 2)) { PH_IDS(); MK_MP();
            const float B2m = 8.f * LOG2E * wave_max(fabsf(moba_q_g[l * 64 + lane])) * wave_max(fabsf(moba_k_g[l * 64 + lane])) * 1.01f;
            unsigned* LCNT = (unsigned*)(ctl + CW_LCNT + l * 768); unsigned short* LIST = MOBA_MFMA ? (unsigned short*)(ws + WS_LIST) : nullptr;
#if ML_MFMA
#ifndef GATE_MFMA
#define GATE_MFMA 1
#endif
#if GATE_MFMA
            for (int u = vcu; u < 768; u += G) moba_gate_mfma(u, PROJ, KMEAN, SEL, LCNT, (unsigned*)(ws + WS_CTAB), LIST, B2m, THRESH2, lds, tid, wave, lane);
#else
            for (int u = vcu; u < 768; u += G) moba_gate_unit(u, PROJ, KMEAN, SEL, LCNT, (unsigned*)(ws + WS_CTAB), LIST, B2m, THRESH2, ldsf, tid);
#endif
            for (int u = gw; u < 2048; u += NGW) mlstm_m1_mfma(u, MP, lds, wave, lane);
            __syncthreads();
#else
            for (int u = vcu; u < 768 + 2048; u += G) {
                if (u < 768) moba_gate_unit(u, PROJ, KMEAN, SEL, LCNT, (unsigned*)(ws + WS_CTAB), LIST, B2m, THRESH2, ldsf, tid);
                else mlstm_m1(u - 768, MP, ldsf, tid, wave, lane);
            }
#endif
            for (int rep = 0; rep < REP_GATE; ++rep) for (int u = vcu; u < 768; u += G) moba_gate_unit(u, PROJ, KMEAN, SEL, LCNT, (unsigned*)(ws + WS_CTAB), nullptr, B2m, THRESH2, ldsf, tid);
            for (int rep = 0; rep < REP_GATE2; ++rep) for (int u = vcu; u < 768; u += G) moba_gate_unit(u, PROJ, KMEAN, SEL, LCNT + 4096, (unsigned*)(ws + WS_OPART + 32 * MiB), (unsigned short*)(ws + WS_OPART), B2m, THRESH2, ldsf, tid);
            for (int rep = 0; rep < REP_M1; ++rep) for (int u = vcu; u < 2048; u += G) mlstm_m1(u, MP, ldsf, tid, wave, lane);
#if FOX_MFMA
            { const float gq = wave_max(fabsf(fox_q_g[l * 64 + lane])), gk = wave_max(fabsf(fox_k_g[l * 64 + lane])); const float B2 = 8.f * LOG2E * gq * gk * 1.01f;
              for (int rep = 0; rep <= REP_FOX; ++rep)
              for (int u = vcu; u < 768; u += G) FOX_FN(u >> 6, 63 - (u & 63), PROJ, FOXCUM, Y, B2, lds, tid, wave, lane); }
#else
            fox_naive(PROJ, FOXCUM, Y, gw, NGW, lane);
#endif
        }
        SEAM(pb + 2);
        for (int rep = 0; rep <= REP_MIXB; ++rep)
        if (PHEN(3) && IN(pb + 3)) { PH_IDS(); MK_MP();
            for (int rep = 0; rep <= REP_M2; ++rep)
            for (int u = vcu; u < 64; u += G) mlstm_m2(u, MP, ldsf, tid, wave, lane);
#if MOBA_MFMA
            { const float gq = wave_max(fabsf(moba_q_g[l * 64 + lane])), gk = wave_max(fabsf(moba_k_g[l * 64 + lane])); const float B2 = 8.f * LOG2E * gq * gk * 1.01f;
              LAS int* pre = (LAS int*)(lds + ATT_TAB + 1024);
              const unsigned* lcnt = (const unsigned*)(ctl + CW_LCNT + l * 768);
              if (wave == 0) { int carry = 0;
                  for (int r = 0; r < 12; ++r) { const int p = r * 64 + lane; int x = (int)((lcnt[p] + 127u) >> 7);
#pragma unroll
                      for (int o = 1; o < 64; o <<= 1) { const int n = supi(x, o, lane); if (lane >= o) x += n; }
                      pre[p + 1] = carry + x; carry += shfi(x, 63); }
                  if (lane == 0) pre[0] = 0; }
              __syncthreads();
              const int S = pre[768];
              const unsigned short* LIST = (const unsigned short*)(ws + WS_LIST); bf16* OPART = (bf16*)(ws + WS_OPART); float* LPART = (float*)(ws + WS_LPART);
              #ifndef KSKIP_N
#define KSKIP_N 3
#endif
              constexpr int KSKIP = KSKIP_N; const int S2 = (S + 1) >> 1; const int NU = S2 + 384;
              for (int i = (vcu < 64 ? KSKIP : 0); ; ++i) {
                  const int u = (i < KSKIP) ? i * (G - 64) + (vcu - 64) : KSKIP * (G - 64) + (i - KSKIP) * G + vcu;
                  if (u >= NU) break;
                  if (u < S2) moba_sel_step(2 * u, S, pre, lcnt, PROJ, LIST, (const unsigned*)(ws + WS_CTAB), OPART, LPART, Y, B2, lds, tid, wave, lane);
                  else { const int p = u - S2; moba_own_pair(p >> 5, p & 31, 63 - (p & 31), PROJ, OPART, LPART, Y, B2, lds, tid, wave, lane); }
              } }
#else
            moba_naive(PROJ, SEL, Y, gw, NGW, lane);
#endif
        }
        SEAM(pb + 3);
        if (PHEN(4) && IN(pb + 4)) { PH_IDS(); MK_MP();
#if ML_MFMA
            for (int rep = 0; rep <= REP_M3; ++rep)
            for (int u = vcu; u < 512; u += G) mlstm_m3_mfma(u, MP, lds, tid, wave, lane);
#else
            for (int rep = 0; rep <= REP_M3; ++rep)
            for (int u = vcu; u < 2048; u += G) mlstm_m3(u, MP, ldsf, tid, wave, lane);
#endif
#if MOBA_MFMA
            for (int rep = 0; rep < REP_COMB; ++rep) moba_combine(SEL, (const bf16*)(ws + WS_OPART), (const float*)(ws + WS_LPART), Y, (bf16*)(ws + WS_U), 384, 0, vcu * NTHREADS + tid, G * NTHREADS);
            moba_combine(SEL, (const bf16*)(ws + WS_OPART), (const float*)(ws + WS_LPART), Y, Y, 1024, Y_MOBA, vcu * NTHREADS + tid, G * NTHREADS);
#endif
        }
        SEAM(pb + 4);
        if (PHEN(5) && IN(pb + 5)) { PH_IDS();
            pg8::Gemm g{Y, (const bf16*)(ws + WS_WOUT + l * WOUT_BYTES), MROWS, DM, DM}; pg8::StaticOrder S; S.init(MROWS, DM, G, bx);
            float* const xr = xres; const float* const xcur = (l == 0) ? x_in : (const float*)xr;
            pg8::EpiRes E{xcur, xr, mod_l + 2048, 6144, SEQ, XN, (const float*)(ws + WS_AVEC) + (size_t)((l * 2 + 1) * 2) * 1024, (float*)(ws + WS_SSP)};
            pg8::gemm_phase<pg8::EpiRes, pg8::StaticOrder, true, true>(lds, g, S, E, tid);
        }
        SEAM(pb + 5);
        for (int rep = 0; rep <= REP_GGU; ++rep)
        if (PHEN(6) && IN(pb + 6)) { PH_IDS();
            pg8::Gemm g{XN, (const bf16*)(ws + WS_WGU + l * WGU_BYTES), MROWS, NGU, DM}; pg8::StaticOrder S; S.init(MROWS, NGU, G, bx);
            LAS float* rt = (LAS float*)(lds + ATT_TAB); LAS float* bt = rt + 512;
            const int pm0 = rstd_tables(S, (const float*)(ws + WS_SSP), rt, (const float*)(ws + WS_BIASGU) + (size_t)l * 2 * NGU, NGU, bt, tid);
            pg8::EpiSwiglu E{HB, DFF, rt, pm0, bt};
            pg8::gemm_phase<pg8::EpiSwiglu, pg8::StaticOrder, GGU_ALIGN, GGU_SP2>(lds, g, S, E, tid);
        }
        SEAM(pb + 6);
        if (PHEN(7) && IN(pb + 7)) { PH_IDS();
            pg8::Gemm g{HB, (const bf16*)(ws + WS_WDN + l * WDN_BYTES), MROWS, DM, DFF}; pg8::StaticOrder S; S.init(MROWS, DM, G, bx);
            float* const xr = xres;
            pg8::EpiRes E{xr, xr, mod_l + 5120, 6144, SEQ, (l + 1 < DEPTH) ? XN : (bf16*)nullptr, (const float*)(ws + WS_AVEC) + (size_t)(((l + 1) * 2 + 0) * 2) * 1024, (float*)(ws + WS_SSP)};
            pg8::gemm_phase<pg8::EpiRes, pg8::StaticOrder, true, true>(lds, g, S, E, tid);
        }
        SEAM(pb + 7);
    }
#undef IN
#undef SEAM
}

extern "C" void kernel_launch(void* const* d_in, const int* in_sizes, int n_in, void* d_out, int out_size, void* d_ws, size_t ws_size, hipStream_t stream) {
    static int grid = 0;
    if (grid == 0) {
        if (n_in != 20 || in_sizes[0] != MROWS * DM || out_size != MROWS * DM || ws_size < WS_END) {
            fprintf(stderr, "kernel_launch: unexpected shapes: n_in %d in0 %d out %d ws %zu (need >= %zu)\n", n_in, n_in > 0 ? in_sizes[0] : -1, out_size, ws_size, (size_t)WS_END); grid = -1; return; }
        int dev = 0, cus = 0, per_cu = 0;
        if (hipGetDevice(&dev) != hipSuccess || hipDeviceGetAttribute(&cus, hipDeviceAttributeMultiprocessorCount, dev) != hipSuccess) { grid = -1; return; }
        if (hipFuncSetAttribute((const void*)fwd, hipFuncAttributeMaxDynamicSharedMemorySize, LDS_BYTES) != hipSuccess) { fprintf(stderr, "kernel_launch: hipFuncSetAttribute failed\n"); grid = -1; return; }
        if (hipOccupancyMaxActiveBlocksPerMultiprocessor(&per_cu, (const void*)fwd, NTHREADS, LDS_BYTES) != hipSuccess || per_cu < 1)
            fprintf(stderr, "kernel_launch: note: occupancy query reports %d workgroups per CU\n", per_cu);
        (void)hipGetLastError();
        grid = cus;
    }
    if (grid < 0) return;
    if (hipMemsetAsync((char*)d_ws + WS_CTL, 0, CTL_ZERO_BYTES, stream) != hipSuccess) return;
    Args a{};
    for (int i = 0; i < 20; ++i) a.in[i] = (const float*)d_in[i];
    a.out = (float*)d_out; a.ws = (unsigned char*)d_ws;
    if (N_LAUNCH_MODE == 1) { a.ph_lo = 0; a.ph_hi = NPHASE; hipLaunchKernelGGL(fwd, dim3(grid), dim3(NTHREADS), LDS_BYTES, stream, a); }
    else for (int p = 0; p < NPHASE; ++p) { a.ph_lo = p; a.ph_hi = p + 1; hipLaunchKernelGGL(fwd, dim3(grid), dim3(NTHREADS), LDS_BYTES, stream, a); }
}
```

```cpp
#include <hip/hip_runtime.h>
#include <cstdio>
#include <cstdint>

constexpr int DM = 1024, NBATCH = 2, SEQ = 16384, MROWS = NBATCH * SEQ, DEPTH = 2;
constexpr int HD = 64, FOXH = 6, MLH = 4, MOBH = 6;
constexpr int DFF = 2816, INC = 3342, NIN = 3584, PLD = 3328;
constexpr int NGU = 2 * DFF;
constexpr int C_FQ = 0, C_FK = 384, C_FV = 768, C_BQ = 1152, C_BK = 1536, C_BV = 1920, C_MQ = 2304, C_MK = 2560, C_MV = 2816, C_MO = 3072, C_G = 3328;
constexpr int Y_FOX = 0, Y_ML = 384, Y_MOBA = 640;
constexpr int MOBA_BS = 256, NBLK = SEQ / MOBA_BS;
constexpr int MLC = 64, NCHUNK = SEQ / MLC;
constexpr float LOG2E = 1.4426950408889634f;
constexpr float QSCALE = 0.125f * LOG2E;
constexpr float EPS = 1e-6f;

#define GAS __attribute__((address_space(1)))
#define LAS __attribute__((address_space(3)))
typedef unsigned short bf16;
typedef unsigned v4u __attribute__((ext_vector_type(4)));
typedef unsigned v2u __attribute__((ext_vector_type(2)));
typedef float f32x4 __attribute__((ext_vector_type(4)));
typedef short bf16x8 __attribute__((ext_vector_type(8)));
typedef float f32x16 __attribute__((ext_vector_type(16)));
typedef GAS unsigned gu32;
#define RLX_AGENT __ATOMIC_RELAXED, __HIP_MEMORY_SCOPE_AGENT
__device__ __forceinline__ unsigned f2bf(float f) { unsigned u = __builtin_bit_cast(unsigned, f); return (u + 0x7fffu + ((u >> 16) & 1u)) >> 16; }
__device__ __forceinline__ unsigned pk2(float lo, float hi) { return f2bf(lo) | (f2bf(hi) << 16); }
__device__ __forceinline__ float bf2f(unsigned short u) { return __builtin_bit_cast(float, (unsigned)u << 16); }
__device__ __forceinline__ float bflo(unsigned w) { return __builtin_bit_cast(float, w << 16); }
__device__ __forceinline__ float bfhi(unsigned w) { return __builtin_bit_cast(float, w & 0xffff0000u); }
#ifndef OLD_SHFL
#define OLD_SHFL 0
#endif
#ifndef OLD_SWZ
#define OLD_SWZ OLD_SHFL
#endif
#ifndef OLD_HALF
#define OLD_HALF OLD_SHFL
#endif
#ifndef OLD_SHF
#define OLD_SHF OLD_SHFL
#endif
#ifndef OLD_SUP
#define OLD_SUP OLD_SHFL
#endif
#if OLD_SWZ
#define SWZ_X(v, o) __shfl_xor((float)(v), (o))
#else
#define SWZ_X(v, o) __builtin_bit_cast(float, __builtin_amdgcn_ds_swizzle(__builtin_bit_cast(int, (float)(v)), ((o) << 10) | 0x1f))
#endif
__device__ __forceinline__ float half_sum(float v, int lane) { return v + __builtin_bit_cast(float, __builtin_amdgcn_ds_bpermute((lane ^ 32) << 2, __builtin_bit_cast(int, v))); }
#if OLD_SHF
__device__ __forceinline__ float shf(float v, int src) { return __shfl(v, src); }
__device__ __forceinline__ int shfi(int v, int src) { return __shfl(v, src); }
#else
__device__ __forceinline__ float shf(float v, int src) { return __builtin_bit_cast(float, __builtin_amdgcn_ds_bpermute(src << 2, __builtin_bit_cast(int, v))); }
__device__ __forceinline__ int shfi(int v, int src) { return __builtin_amdgcn_ds_bpermute(src << 2, v); }
#endif
#if OLD_SUP
__device__ __forceinline__ float sup(float v, int o, int lane) { return __shfl_up(v, o); }
__device__ __forceinline__ int supi(int v, int o, int lane) { return __shfl_up(v, o); }
#else
__device__ __forceinline__ float sup(float v, int o, int lane) { return shf(v, lane >= o ? lane - o : lane); }
__device__ __forceinline__ int supi(int v, int o, int lane) { return shfi(v, lane >= o ? lane - o : lane); }
#endif
__device__ __forceinline__ float wave_sum(float v) { v += SWZ_X(v, 1); v += SWZ_X(v, 2); v += SWZ_X(v, 4); v += SWZ_X(v, 8); v += SWZ_X(v, 16);
    return __builtin_bit_cast(float, __builtin_amdgcn_readlane(__builtin_bit_cast(int, v), 0)) + __builtin_bit_cast(float, __builtin_amdgcn_readlane(__builtin_bit_cast(int, v), 32)); }
__device__ __forceinline__ float wave_max(float v) { v = fmaxf(v, SWZ_X(v, 1)); v = fmaxf(v, SWZ_X(v, 2)); v = fmaxf(v, SWZ_X(v, 4)); v = fmaxf(v, SWZ_X(v, 8)); v = fmaxf(v, SWZ_X(v, 16));
    return fmaxf(__builtin_bit_cast(float, __builtin_amdgcn_readlane(__builtin_bit_cast(int, v), 0)), __builtin_bit_cast(float, __builtin_amdgcn_readlane(__builtin_bit_cast(int, v), 32))); }
__device__ __forceinline__ float log_sigmoid_f(float x) { return fminf(x, 0.f) - log1pf(expf(-fabsf(x))); }
__device__ __forceinline__ float log_sigmoid_fast(float x) { const float x2 = x * LOG2E; return 0.6931471805599453f * (fminf(x2, 0.f) - __builtin_amdgcn_logf(1.f + __builtin_amdgcn_exp2f(-fabsf(x2)))); }
__device__ __forceinline__ float exp_fast(float x) { return __builtin_amdgcn_exp2f(x * LOG2E); }
__device__ __forceinline__ float sigmoid_f(float x) { return 1.f / (1.f + expf(-x)); }

constexpr size_t MiB = 1u << 20;
constexpr size_t WS_CTL = 0, CTL_ZERO_BYTES = 1 * MiB;
constexpr size_t WS_MOD = 1 * MiB;
constexpr size_t WS_KMEAN = WS_MOD + 128 * 1024;
constexpr size_t WS_MLS = WS_KMEAN + 512 * 1024;
constexpr size_t WS_BEND = WS_MLS, WS_MLOC = WS_MLS + 8192, WS_MS = WS_MLS + 16384, WS_NU = WS_MLS + 32768, WS_NS = WS_NU + 2048 * 64 * 4;
constexpr size_t WS_CTAB = 3 * MiB;
constexpr size_t WS_PTAB = WS_CTAB + 256 * 1024;
static_assert(WS_NS + 2048 * 64 * 4 <= WS_CTAB && WS_CTAB + 12 * 64 * 64 * 4 <= WS_PTAB && WS_PTAB + 256 <= 4 * MiB, "small region");
constexpr size_t WS_WIN = 4 * MiB, WIN_BYTES = (size_t)NIN * DM * 2;
constexpr size_t WS_WOUT = WS_WIN + 2 * WIN_BYTES, WOUT_BYTES = (size_t)DM * DM * 2;
constexpr size_t WS_WGU = WS_WOUT + 2 * WOUT_BYTES, WGU_BYTES = (size_t)NGU * DM * 2;
constexpr size_t WS_WDN = WS_WGU + 2 * WGU_BYTES, WDN_BYTES = (size_t)DM * DFF * 2;
static_assert(WS_WDN + 2 * WDN_BYTES <= 56 * MiB, "weights");
constexpr size_t WS_SSP = 56 * MiB;
constexpr size_t WS_AVEC = 58 * MiB;
constexpr size_t WS_BIASIN = WS_AVEC + 64 * 1024;
constexpr size_t WS_BIASGU = WS_BIASIN + 64 * 1024;
static_assert(WS_BIASGU + 2 * 2 * NGU * 4 <= 64 * MiB && 2 * 2 * NIN * 4 <= 64 * 1024, "fused-norm vectors");
constexpr size_t WS_XN = 64 * MiB;
constexpr size_t WS_U = 64 * MiB;
constexpr size_t WS_CS = 96 * MiB;
constexpr size_t WS_LIST = 112 * MiB;
constexpr size_t WS_PROJ = 128 * MiB;
constexpr size_t WS_H = 128 * MiB;
constexpr size_t WS_Y = 336 * MiB;
constexpr size_t WS_QC = 400 * MiB, WS_KC = 416 * MiB;
constexpr size_t WS_OPART = 432 * MiB;
constexpr size_t WS_LPART = 504 * MiB;
constexpr size_t WS_GATES = 507 * MiB;
constexpr size_t WS_FOXCUM = 509 * MiB;
constexpr size_t WS_SEL = 510 * MiB;
constexpr size_t WS_END = 512 * MiB;
static_assert(WS_PROJ + (size_t)MROWS * PLD * 2 <= WS_Y && WS_SEL + (size_t)MROWS * 6 * 4 <= WS_END, "ws map");
constexpr int CW_BAR = 4096;
constexpr int CW_QUEUE = 16384;
constexpr int CW_LCNT = 32768;

constexpr int RING_BYTES = 131072, LDSCTL_OFF = RING_BYTES, MISC_OFF = LDSCTL_OFF + 320, LDS_BYTES = 147456;
constexpr int NWAVES = 8, NTHREADS = 512;
namespace pg8 {
#define PG8_LAS __attribute__((address_space(3)))
typedef unsigned short bf16_t;
typedef short bf16x8 __attribute__((ext_vector_type(8)));
typedef float f32x4 __attribute__((ext_vector_type(4)));
typedef unsigned u32x4 __attribute__((ext_vector_type(4)));
constexpr int BM = 256, BK = 64, HALF = 128, HTB = HALF * BK * 2  , STAGE_BYTES = 8 * HTB, NXCD = 8, WGM = 8;

__host__ __device__ __forceinline__ int lds_byte(int r, int c) { const int st = (r >> 4) * 2 + (c >> 5), rr = r & 15, cc = c & 31, ob = rr * 64 + cc * 2; return st * 1024 + (ob ^ (((ob >> 9) & 1) << 5)); }
__host__ __device__ __forceinline__ void stage_rc(int b, int& R, int& C) { const int st = b / 1024, sb = b % 1024, swz = sb ^ (((sb >> 9) & 1) << 5); R = (st >> 1) * 16 + swz / 64; C = (st & 1) * 32 + (swz % 64) / 2; }
__host__ __device__ __forceinline__ int perm32(int rho) { const int n = rho >> 4, i = rho & 15; return 8 * (i >> 2) + 4 * n + (i & 3); }

struct Unit { int pm, pn, ord; };
struct Gemm { const bf16_t* A; const bf16_t* Bt; int M, N, K; };

struct StaticOrder {
    int nM, nN, nwg, G, c;
    __host__ __device__ void init(int M, int N, int G_, int c_) { nM = M / BM; nN = N / BM; nwg = nM * nN; G = G_; c = c_; }
    __host__ __device__ bool next(int i, Unit& u) const {
        const long L = (long)i * G + c; if (L >= nwg) return false;
        int wgid = (int)L; { const int q = nwg / NXCD, r = nwg % NXCD, xcd = wgid % NXCD, off = wgid / NXCD; wgid = (xcd < r ? xcd * (q + 1) : r * (q + 1) + (xcd - r) * q) + off; }
        const int nig = WGM * nN, gid = wgid / nig, fm = gid * WGM, gsz = (nM - fm) < WGM ? (nM - fm) : WGM;
        u.pm = fm + ((wgid % nig) % gsz); u.pn = (wgid % nig) / gsz; u.ord = i; return true;
    }
    __device__ __forceinline__ void a_ready(const Unit&) const {}
    __device__ __forceinline__ void done(const Unit&) const {}
};

__device__ __forceinline__ unsigned cvt_pk_bf16(float lo, float hi) { unsigned r; asm volatile("v_cvt_pk_bf16_f32 %0, %1, %2" : "=v"(r) : "v"(lo), "v"(hi)); return r; }
typedef float f32x2 __attribute__((ext_vector_type(2)));
typedef unsigned u32x2 __attribute__((ext_vector_type(2)));
struct EpiProj {
    static constexpr bool PERM = true, AFTER_DRAIN = false;
    bf16_t* P; float* G; int pld; PG8_LAS const float* rt; int pm0; PG8_LAS const float* bt;
    __device__ __forceinline__ void operator()(const f32x4 (&acc)[2][2][4][2], const Unit& u, int wr, int wc, int fr, int fq) const {
        const int row0 = u.pm * BM + wr * 64 + fr;
        PG8_LAS const float* rs = rt + (u.pm == pm0 ? 0 : 256) + wr * 64 + fr;
        PG8_LAS const float* bb = bt + u.ord * 256 + wc * 32 + 8 * fq;
        if (u.pn < 13) {
            const int col0 = u.pn * BM + wc * 32 + 8 * fq;
            f32x4 bv[2][2];
#pragma unroll
            for (int bj = 0; bj < 2; ++bj)
#pragma unroll
                for (int n = 0; n < 2; ++n) bv[bj][n] = *(PG8_LAS const f32x4*)(bb + bj * HALF + 4 * n);
            float rsv[2][4];
#pragma unroll
            for (int ai = 0; ai < 2; ++ai)
#pragma unroll
                for (int m = 0; m < 4; ++m) rsv[ai][m] = rs[ai * HALF + m * 16];
#pragma unroll
            for (int ai = 0; ai < 2; ++ai)
#pragma unroll
                for (int m = 0; m < 4; ++m) { bf16_t* rowp = P + (size_t)(row0 + ai * HALF + m * 16) * pld + col0; const float rstd = rsv[ai][m];
#pragma unroll
                    for (int bj = 0; bj < 2; ++bj) { const f32x4 v0 = acc[ai][bj][m][0] * rstd + bv[bj][0], v1 = acc[ai][bj][m][1] * rstd + bv[bj][1];
                        u32x4 w; w.x = cvt_pk_bf16(v0[0], v0[1]); w.y = cvt_pk_bf16(v0[2], v0[3]); w.z = cvt_pk_bf16(v1[0], v1[1]); w.w = cvt_pk_bf16(v1[2], v1[3]);
                        *(u32x4*)(rowp + bj * HALF) = w; } }
        } else {
            if (wc == 0 && fq < 2) {
                const f32x4 b0 = *(PG8_LAS const f32x4*)(bb), b1 = *(PG8_LAS const f32x4*)(bb + 4);
#pragma unroll
                for (int ai = 0; ai < 2; ++ai)
#pragma unroll
                    for (int m = 0; m < 4; ++m) { float* gp = G + (size_t)(row0 + ai * HALF + m * 16) * 16 + 8 * fq; const float rstd = rs[ai * HALF + m * 16];
                        *(f32x4*)(gp) = acc[ai][0][m][0] * rstd + b0; *(f32x4*)(gp + 4) = acc[ai][0][m][1] * rstd + b1; }
            }
        }
    }
};
struct EpiRes {
    static constexpr bool PERM = true, AFTER_DRAIN = false;
    const float* base; float* out; const float* gate; int gate_bstride; int rows_per_batch; bf16_t* xa; const float* avec; float* ssp;
    __device__ __forceinline__ void operator()(const f32x4 (&acc)[2][2][4][2], const Unit& u, int wr, int wc, int fr, int fq) const {
        const int row0 = u.pm * BM + wr * 64 + fr, col0 = u.pn * BM + wc * 32 + 8 * fq;
        const int bat = (u.pm * BM) / rows_per_batch;
        const float* gb = gate + (size_t)bat * gate_bstride;
        f32x4 gv[2][2], av[2][2];
#pragma unroll
        for (int bj = 0; bj < 2; ++bj)
#pragma unroll
            for (int n = 0; n < 2; ++n) { gv[bj][n] = *(const f32x4*)(gb + col0 + bj * HALF + 4 * n); av[bj][n] = xa ? *(const f32x4*)(avec + (size_t)bat * 1024 + col0 + bj * HALF + 4 * n) : (f32x4){0.f, 0.f, 0.f, 0.f}; }
        const int lane = fq * 16 + fr;
#pragma unroll
        for (int ai = 0; ai < 2; ++ai)
#pragma unroll
            for (int m = 0; m < 4; ++m) { const size_t off = (size_t)(row0 + ai * HALF + m * 16) * 1024 + col0; float ss = 0.f;
#pragma unroll
                for (int bj = 0; bj < 2; ++bj) {
                    const f32x4 o0 = *(const f32x4*)(base + off + bj * HALF) + gv[bj][0] * acc[ai][bj][m][0], o1 = *(const f32x4*)(base + off + bj * HALF + 4) + gv[bj][1] * acc[ai][bj][m][1];
                    __builtin_nontemporal_store(o0, (f32x4*)(out + off + bj * HALF)); __builtin_nontemporal_store(o1, (f32x4*)(out + off + bj * HALF + 4));
                    if (xa) { ss += ((o0[0] * o0[0] + o0[1] * o0[1]) + (o0[2] * o0[2] + o0[3] * o0[3])) + ((o1[0] * o1[0] + o1[1] * o1[1]) + (o1[2] * o1[2] + o1[3] * o1[3]));
                        const f32x4 t0 = o0 * av[bj][0], t1 = o1 * av[bj][1];
                        u32x4 w; w.x = cvt_pk_bf16(t0[0], t0[1]); w.y = cvt_pk_bf16(t0[2], t0[3]); w.z = cvt_pk_bf16(t1[0], t1[1]); w.w = cvt_pk_bf16(t1[2], t1[3]);
#ifdef XA_NT
                        __builtin_nontemporal_store(w, (u32x4*)(xa + off + bj * HALF)); } }
#else
                        *(u32x4*)(xa + off + bj * HALF) = w; } }
#endif
                if (xa) { ss += SWZ_X(ss, 16); ss += __builtin_bit_cast(float, __builtin_amdgcn_ds_bpermute((lane ^ 32) << 2, __builtin_bit_cast(int, ss)));
                    if (fq == 0) ssp[(size_t)(row0 + ai * HALF + m * 16) * 16 + u.pn * 4 + wc] = ss; } }
    }
};
struct EpiSwiglu {
    static constexpr bool PERM = true, AFTER_DRAIN = false;
    bf16_t* Hh; int ldh; PG8_LAS const float* rt; int pm0; PG8_LAS const float* bt;
    __device__ __forceinline__ void operator()(const f32x4 (&acc)[2][2][4][2], const Unit& u, int wr, int wc, int fr, int fq) const {
        const int row0 = u.pm * BM + wr * 64 + fr, col0 = u.pn * HALF + wc * 32 + 8 * fq;
        PG8_LAS const float* rs = rt + (u.pm == pm0 ? 0 : 256) + wr * 64 + fr;
        PG8_LAS const float* bb = bt + u.ord * 256 + wc * 32 + 8 * fq;
        f32x4 bv[2][2];
#pragma unroll
        for (int bj = 0; bj < 2; ++bj)
#pragma unroll
            for (int n = 0; n < 2; ++n) bv[bj][n] = *(PG8_LAS const f32x4*)(bb + bj * HALF + 4 * n);
        float rsv[2][4];
#pragma unroll
        for (int ai = 0; ai < 2; ++ai)
#pragma unroll
            for (int m = 0; m < 4; ++m) rsv[ai][m] = rs[ai * HALF + m * 16];
#pragma unroll
        for (int ai = 0; ai < 2; ++ai)
#pragma unroll
            for (int m = 0; m < 4; ++m) { bf16_t* rowp = Hh + (size_t)(row0 + ai * HALF + m * 16) * ldh + col0; const float rstd = rsv[ai][m];
                float hv[8];
#pragma unroll
                for (int n = 0; n < 2; ++n)
#pragma unroll
                    for (int i = 0; i < 4; ++i) { const float g = acc[ai][0][m][n][i] * rstd + bv[0][n][i], up = acc[ai][1][m][n][i] * rstd + bv[1][n][i];
                        const float e = __builtin_amdgcn_exp2f(-g * 1.4426950408889634f);
                        hv[n * 4 + i] = g * __builtin_amdgcn_rcpf(1.0f + e) * up; }
                u32x4 w; w.x = cvt_pk_bf16(hv[0], hv[1]); w.y = cvt_pk_bf16(hv[2], hv[3]); w.z = cvt_pk_bf16(hv[4], hv[5]); w.w = cvt_pk_bf16(hv[6], hv[7]);
                __builtin_nontemporal_store(w, (u32x4*)(rowp)); }
    }
};
template <class Epi, class Sched, bool ALIGN_EPI = false, bool SP2 = false>
__device__ __forceinline__ void gemm_phase(PG8_LAS unsigned char* lds, const Gemm g, const Sched& S, const Epi& E, const int tid_in) {
    const int tid = tid_in, wid = __builtin_amdgcn_readfirstlane(tid >> 6), lane = tid & 63, wr = wid >> 2, wc = wid & 3, fr = lane & 15, fq = lane >> 4;
    const int K = g.K, nt = K / BK;
    unsigned voffA[2], voffB[2];
#pragma unroll
    for (int i = 0; i < 2; ++i) { int R, C; stage_rc(tid * 16 + i * 8192, R, C); const int Rb = Epi::PERM ? ((R & ~31) + perm32(R & 31)) : R;
        voffA[i] = (unsigned)(R * K + C) * 2u; voffB[i] = (unsigned)(Rb * K + C) * 2u; }
    const size_t kstep = (size_t)(BK * 2);
    const size_t hstep = (size_t)HALF * K * 2;
    const size_t tstep = 2 * hstep;
    const unsigned ldsw = (unsigned)wid * 1024u;
    const int aoff = lds_byte(wr * 64 + fr, fq * 8), boff = lds_byte(wc * 32 + fr, fq * 8);
#define PG8_SA(b, h) (((b) * 2 + (h)) * HTB)
#define PG8_SB(b, h) ((4 + (b) * 2 + (h)) * HTB)
#define PG8_STAGE(bufoff, gbase, voff) do { _Pragma("unroll") for (int _i = 0; _i < 2; ++_i) \
        __builtin_amdgcn_global_load_lds((const unsigned*)((const char*)(gbase) + (voff)[_i]), (PG8_LAS unsigned*)(lds + (bufoff) + ldsw + _i * 8192), 16, 0, 0); } while (0)
#define PG8_LDA(dst, b, h) do { _Pragma("unroll") for (int m = 0; m < 4; ++m) _Pragma("unroll") for (int k = 0; k < 2; ++k) dst[m][k] = *(const PG8_LAS bf16x8*)(lds + PG8_SA(b, h) + aoff + m * 2048 + k * 1024); } while (0)
#define PG8_LDB(dst, b, h) do { _Pragma("unroll") for (int n = 0; n < 2; ++n) _Pragma("unroll") for (int k = 0; k < 2; ++k) dst[n][k] = *(const PG8_LAS bf16x8*)(lds + PG8_SB(b, h) + boff + n * 2048 + k * 1024); } while (0)
#define PG8_MMA(ai, bj, At, Bt) do { __builtin_amdgcn_s_setprio(1); _Pragma("unroll") for (int m = 0; m < 4; ++m) _Pragma("unroll") for (int n = 0; n < 2; ++n) _Pragma("unroll") for (int k = 0; k < 2; ++k) \
        acc[ai][bj][m][n] = __builtin_amdgcn_mfma_f32_16x16x32_bf16(Bt[n][k], At[m][k], acc[ai][bj][m][n], 0, 0, 0); __builtin_amdgcn_s_setprio(0); } while (0)
#define PG8_WAIT_V(n) asm volatile("s_waitcnt vmcnt(" #n ")" ::: "memory")
#define PG8_WAIT_L(n) asm volatile("s_waitcnt lgkmcnt(" #n ")" ::: "memory")
#define PG8_BAR __builtin_amdgcn_s_barrier()
#define PG8_SCHED __builtin_amdgcn_sched_barrier(0)
    Unit cur, nxt; int ui = 0;
    if (!S.next(0, cur)) return;
    f32x4 acc[2][2][4][2];
#pragma unroll
    for (int a = 0; a < 2; ++a)
#pragma unroll
        for (int b = 0; b < 2; ++b)
#pragma unroll
            for (int m = 0; m < 4; ++m)
#pragma unroll
                for (int n = 0; n < 2; ++n) acc[a][b][m][n] = (f32x4){0.f, 0.f, 0.f, 0.f};
    bf16x8 At[4][2], B0[2][2], B1[2][2];
    const char* cA = (const char*)g.A + (size_t)cur.pm * tstep; const char* cB = (const char*)g.Bt + (size_t)cur.pn * tstep;
    S.a_ready(cur);
    if constexpr (SP2) {
        PG8_STAGE(PG8_SB(0, 0), cB, voffB); PG8_STAGE(PG8_SB(0, 1), cB + hstep, voffB); PG8_STAGE(PG8_SA(0, 0), cA, voffA); PG8_STAGE(PG8_SA(0, 1), cA + hstep, voffA);
        if (wr == 1) PG8_BAR;
        PG8_WAIT_V(2); PG8_BAR;
        PG8_STAGE(PG8_SB(1, 0), cB + kstep, voffB); PG8_STAGE(PG8_SA(1, 0), cA + kstep, voffA); PG8_STAGE(PG8_SB(1, 1), cB + hstep + kstep, voffB);
        PG8_WAIT_V(6); PG8_BAR;
    } else {
        PG8_STAGE(PG8_SB(0, 0), cB, voffB); PG8_STAGE(PG8_SA(0, 0), cA, voffA); PG8_STAGE(PG8_SB(0, 1), cB + hstep, voffB); PG8_STAGE(PG8_SA(0, 1), cA + hstep, voffA);
        if (wr == 1) PG8_BAR;
        PG8_WAIT_V(4); PG8_BAR;
        PG8_STAGE(PG8_SB(1, 0), cB + kstep, voffB); PG8_STAGE(PG8_SA(1, 0), cA + kstep, voffA); PG8_STAGE(PG8_SB(1, 1), cB + hstep + kstep, voffB);
        PG8_WAIT_V(6); PG8_BAR;
    }
    for (;;) {
        const bool has_next = S.next(ui + 1, nxt);
        const char* nA = has_next ? (const char*)g.A + (size_t)nxt.pm * tstep : cA; const char* nB = has_next ? (const char*)g.Bt + (size_t)nxt.pn * tstep : cB;
        for (int t = 0; t < nt; t += 2) {
            const bool last = (t == nt - 2);
            const char* a1 = cA + (size_t)(t + 1) * kstep;
            const char* a2 = last ? nA : cA + (size_t)(t + 2) * kstep; const char* b2 = last ? nB : cB + (size_t)(t + 2) * kstep;
            const char* a3 = a2 + kstep; const char* b3 = b2 + kstep;
            if (last && has_next) S.a_ready(nxt);
            if constexpr (SP2) {
            PG8_LDB(B0, 0, 0); PG8_LDB(B1, 0, 1); PG8_SCHED; PG8_LDA(At, 0, 0); PG8_STAGE(PG8_SA(1, 1), a1 + hstep, voffA);
            PG8_WAIT_V(8); PG8_WAIT_L(0); PG8_BAR; PG8_MMA(0, 0, At, B0); PG8_MMA(0, 1, At, B1); PG8_BAR; PG8_SCHED;
            PG8_LDA(At, 0, 1); PG8_STAGE(PG8_SB(0, 0), b2, voffB); PG8_STAGE(PG8_SB(0, 1), b2 + hstep, voffB); PG8_STAGE(PG8_SA(0, 0), a2, voffA);
            PG8_WAIT_V(8); PG8_WAIT_L(0); PG8_BAR; PG8_MMA(1, 0, At, B0); PG8_MMA(1, 1, At, B1); PG8_BAR; PG8_SCHED;
            PG8_LDB(B0, 1, 0); PG8_LDB(B1, 1, 1); PG8_SCHED; PG8_LDA(At, 1, 0); PG8_STAGE(PG8_SA(0, 1), a2 + hstep, voffA);
            PG8_WAIT_V(8); PG8_WAIT_L(0); PG8_BAR; PG8_MMA(0, 0, At, B0); PG8_MMA(0, 1, At, B1); PG8_BAR; PG8_SCHED;
            PG8_LDA(At, 1, 1); PG8_STAGE(PG8_SB(1, 0), b3, voffB); PG8_STAGE(PG8_SB(1, 1), b3 + hstep, voffB); PG8_STAGE(PG8_SA(1, 0), a3, voffA);
            PG8_WAIT_V(8); PG8_WAIT_L(0); PG8_BAR; PG8_MMA(1, 0, At, B0); PG8_MMA(1, 1, At, B1); PG8_BAR; PG8_SCHED;
            } else {
            PG8_LDB(B0, 0, 0); PG8_SCHED; PG8_LDA(At, 0, 0); PG8_STAGE(PG8_SA(1, 1), a1 + hstep, voffA);
            PG8_WAIT_L(8); PG8_BAR; PG8_WAIT_L(0); PG8_MMA(0, 0, At, B0); PG8_BAR; PG8_SCHED;
            PG8_LDB(B1, 0, 1); PG8_STAGE(PG8_SB(0, 0), b2, voffB);
            PG8_BAR; PG8_WAIT_L(0); PG8_MMA(0, 1, At, B1); PG8_BAR;
            PG8_LDA(At, 0, 1); PG8_STAGE(PG8_SA(0, 0), a2, voffA);
            PG8_BAR; PG8_WAIT_L(0); PG8_MMA(1, 0, At, B0); PG8_BAR; PG8_SCHED;
            PG8_STAGE(PG8_SB(0, 1), b2 + hstep, voffB);
            PG8_WAIT_V(6); PG8_BAR; PG8_MMA(1, 1, At, B1); PG8_BAR;
            PG8_LDB(B0, 1, 0); PG8_SCHED; PG8_LDA(At, 1, 0); PG8_STAGE(PG8_SA(0, 1), a2 + hstep, voffA);
            PG8_WAIT_L(8); PG8_BAR; PG8_WAIT_L(0); PG8_MMA(0, 0, At, B0); PG8_BAR; PG8_SCHED;
            PG8_LDB(B1, 1, 1); PG8_STAGE(PG8_SB(1, 0), b3, voffB);
            PG8_BAR; PG8_WAIT_L(0); PG8_MMA(0, 1, At, B1); PG8_BAR;
            PG8_LDA(At, 1, 1); PG8_STAGE(PG8_SA(1, 0), a3, voffA);
            PG8_BAR; PG8_WAIT_L(0); PG8_MMA(1, 0, At, B0); PG8_BAR; PG8_SCHED;
            PG8_STAGE(PG8_SB(1, 1), b3 + hstep, voffB);
            PG8_WAIT_V(6); PG8_BAR; PG8_MMA(1, 1, At, B1); PG8_BAR;
            }
        }
        if constexpr (ALIGN_EPI) { if (wr == 0) PG8_BAR; }
        if constexpr (!Epi::AFTER_DRAIN) { E(acc, cur, wr, wc, fr, fq); S.done(cur); }
        if (!has_next) break;
#pragma unroll
        for (int a = 0; a < 2; ++a)
#pragma unroll
            for (int b = 0; b < 2; ++b)
#pragma unroll
                for (int m = 0; m < 4; ++m)
#pragma unroll
                    for (int n = 0; n < 2; ++n) acc[a][b][m][n] = (f32x4){0.f, 0.f, 0.f, 0.f};
        cur = nxt; cA = nA; cB = nB; ++ui;
        if constexpr (ALIGN_EPI) { if (wr == 1) PG8_BAR; }
    }
    PG8_WAIT_V(0);
    if constexpr (!ALIGN_EPI) { if (wr == 0) PG8_BAR; }
    PG8_BAR;
    if constexpr (Epi::AFTER_DRAIN) { E.fused(acc, cur, wr, wc, fr, fq, lds, wid, lane); S.done(cur); }
#undef PG8_SA
#undef PG8_SB
#undef PG8_STAGE
#undef PG8_LDA
#undef PG8_LDB
#undef PG8_MMA
#undef PG8_WAIT_V
#undef PG8_WAIT_L
#undef PG8_BAR
#undef PG8_SCHED
}
}
#define XB_TMO      128
#define XB_XCNT(j)  (256  + 64 * (j))
#define XB_XSUB(j)  (1280 + 64 * (j))
#define XB_XGEN(j)  (2304 + 64 * (j))
#define XB_TOP      3328
#define XB_TOPGEN   3392
#define XCD_BAR_WORDS 3456
#define XB_SPIN_CAP (1u << 18)

__device__ __forceinline__ unsigned xb_ld(unsigned* p)              { return __hip_atomic_load(p, __ATOMIC_RELAXED, __HIP_MEMORY_SCOPE_AGENT); }
__device__ __forceinline__ unsigned xb_add(unsigned* p, unsigned v) { return __hip_atomic_fetch_add(p, v, __ATOMIC_RELAXED, __HIP_MEMORY_SCOPE_AGENT); }
__device__ __forceinline__ unsigned xb_xcc_id() { return (unsigned)__builtin_amdgcn_s_getreg((3 << 11) | 20) & 0xFu; }
#define XB_SPIN(cond, bar) do { unsigned _sp = 0; while (cond) { __builtin_amdgcn_s_sleep(1); \
    if ((++_sp & 255u) == 0u) { if (xb_ld(&(bar)[XB_TMO])) break; if (_sp > XB_SPIN_CAP) { atomicAdd(&(bar)[XB_TMO], 1u); break; } } } } while (0)

struct XcdBarrier {
    unsigned* bar; unsigned x;
    volatile LAS unsigned* st;
};

__device__ __forceinline__ XcdBarrier xcd_barrier_post(unsigned* bar, volatile LAS unsigned* st) {
    XcdBarrier b; b.bar = bar; b.x = xb_xcc_id(); b.st = st;
    if (threadIdx.x == 0) (void)xb_add(&bar[XB_XCNT(b.x)], 1u);
    return b;
}
__device__ __forceinline__ void xcd_barrier_complete(unsigned* bar, unsigned x, unsigned& nloc, unsigned& nx) {
    const unsigned G = gridDim.x * gridDim.y * gridDim.z;
    unsigned sum, cnt, mine, sp = 0u;
    for (;;) {
        sum = 0u; cnt = 0u; mine = 0u;
#pragma unroll
        for (unsigned j = 0; j < 16; ++j) { const unsigned c = xb_ld(&bar[XB_XCNT(j)]); sum += c; cnt += (c > 0u) ? 1u : 0u; mine = (j == x) ? c : mine; }
        if (sum == G) break;
        __builtin_amdgcn_s_sleep(1);
        if ((++sp & 255u) == 0u) { if (xb_ld(&bar[XB_TMO])) break; if (sp > XB_SPIN_CAP) { atomicAdd(&bar[XB_TMO], 1u); break; } }
    }
    nloc = mine > 0u ? mine : 1u; nx = cnt > 0u ? cnt : 1u;
}

__device__ __forceinline__ void xcd_barrier(const XcdBarrier& b) {
    asm volatile("s_waitcnt vmcnt(0)" ::: "memory");
    __syncthreads();
    if (threadIdx.x == 0) {
        unsigned* bar = b.bar; asm volatile("" : "+s"(bar));
        const unsigned bx_ = xb_xcc_id();
        __builtin_amdgcn_s_waitcnt(0);
        unsigned nloc = b.st[0], nx = b.st[1];
        if (nloc == 0u) { xcd_barrier_complete(bar, bx_, nloc, nx); b.st[0] = nloc; b.st[1] = nx; }
        const unsigned old = xb_add(&bar[XB_XSUB(bx_)], 1u);
        const unsigned gen = old / nloc;
        if (old + 1u == (gen + 1u) * nloc) {
            __builtin_amdgcn_fence(__ATOMIC_RELEASE, "agent");
            asm volatile("s_waitcnt vmcnt(0)" ::: "memory");
            const unsigned og = xb_add(&bar[XB_TOP], 1u);
            const unsigned tg = og / nx;
            if (og + 1u == (tg + 1u) * nx) xb_add(&bar[XB_TOPGEN], 1u);
            else XB_SPIN(xb_ld(&bar[XB_TOPGEN]) == tg, bar);
            __builtin_amdgcn_fence(__ATOMIC_ACQUIRE, "agent");
            xb_add(&bar[XB_XGEN(bx_)], 1u);
            asm volatile("s_waitcnt vmcnt(0)" ::: "memory");
        } else {
            XB_SPIN(xb_ld(&bar[XB_XGEN(bx_)]) == gen, bar);
            __builtin_amdgcn_fence(__ATOMIC_ACQUIRE, "agent");
            asm volatile("s_waitcnt vmcnt(0)" ::: "memory");
        }
    }
    __syncthreads();
}
#define LDS_WAIT() asm volatile("s_waitcnt lgkmcnt(0)" ::: "memory")
__device__ __forceinline__ void unpack8(const v4u w, float* f) { f[0] = bflo(w.x); f[1] = bfhi(w.x); f[2] = bflo(w.y); f[3] = bfhi(w.y); f[4] = bflo(w.z); f[5] = bfhi(w.z); f[6] = bflo(w.w); f[7] = bfhi(w.w); }

__device__ __forceinline__ int win_src(int c) {
    if (c < 1152) return c;
    if (c < 2304) return c + 1038;
    if (c < 3072) return c - 1146;
    if (c < 3328) return c - 1138;
    if (c < 3334) return c - 3328 + 1152;
    if (c < 3338) return c - 3334 + 1926;
    if (c < 3342) return c - 3338 + 1930;
    return -1;
}
__device__ __forceinline__ int wgu_src(int r) { const int pn = r >> 8, w = r & 255; return (w < 128 ? 0 : DFF) + pn * 128 + (w & 127); }
template <int MODE> __device__ __forceinline__ int src_col(int r) { if (MODE == 1) return win_src(r); if (MODE == 2) return wgu_src(r); return r; }

template <int MODE> __device__ __forceinline__ void transpose_item(const float* W, int K, int ldw, bf16* WT, LAS float* scr, int nblk, int item, int lane) {
    const int kb = item / nblk, nb = item % nblk, k0 = 64 * kb, n0 = 32 * nb;
    const int sc = src_col<MODE>(n0 + (lane & 31));
#pragma unroll 8
    for (int i = 0; i < 32; ++i) { const int kk = 2 * i + (lane >> 5); scr[kk * 33 + (lane & 31)] = (sc >= 0) ? W[(size_t)(k0 + kk) * ldw + sc] : 0.f; }
    LDS_WAIT(); asm volatile("" ::: "memory");
    const int c = lane & 7;
#pragma unroll
    for (int j = 0; j < 4; ++j) { const int n = (lane >> 3) + 8 * j; const LAS float* s = scr + (8 * c) * 33 + n;
        v4u o; o.x = pk2(s[0 * 33], s[1 * 33]); o.y = pk2(s[2 * 33], s[3 * 33]); o.z = pk2(s[4 * 33], s[5 * 33]); o.w = pk2(s[6 * 33], s[7 * 33]);
        *(GAS v4u*)(WT + (size_t)(n0 + n) * K + k0 + 8 * c) = o; }
    LDS_WAIT(); asm volatile("" ::: "memory");
}

__device__ __forceinline__ void p0_mod_unit(int u, const float* cvec, const float* w_ada, const float* b_ada, float* mod, LAS float* lds, int tid, int wave, int lane) {
    LAS float* sc = lds; LAS float* red = lds + 2048;
    for (int i = tid; i < 2048; i += NTHREADS) { const float v = cvec[i]; sc[i] = v / (1.f + expf(-v)); }
    __syncthreads();
    const int l = u / 96, n = (u % 96) * 64 + lane;
    const float* wp = w_ada + ((size_t)l * 1024 + wave * 128) * 6144 + n;
    float a0 = 0.f, a1 = 0.f;
#pragma unroll 16
    for (int kk = 0; kk < 128; ++kk) { const float w = wp[(size_t)kk * 6144]; a0 += sc[wave * 128 + kk] * w; a1 += sc[1024 + wave * 128 + kk] * w; }
    red[(wave * 2 + 0) * 64 + lane] = a0; red[(wave * 2 + 1) * 64 + lane] = a1;
    __syncthreads();
    if (tid < 128) { const int b = tid >> 6; float s = 0.f;
#pragma unroll
        for (int w = 0; w < 8; ++w) s += red[(w * 2 + b) * 64 + lane];
        mod[((size_t)l * 2 + b) * 6144 + n] = s + b_ada[l * 6144 + n]; }
    __syncthreads();
}

__device__ __forceinline__ void pre_rows(const float* xsrc, const float* g, const float* mod_b0, bf16* XA, float* SSP, int gw, int NGW, int lane) {
    for (int m = gw; m < MROWS; m += NGW) {
        const int b = m / SEQ; const float* mb = mod_b0 + (size_t)b * 6144;
        const GAS f32x4* xr = (const GAS f32x4*)(xsrc + (size_t)m * DM) + lane;
        f32x4 v[4]; float ss = 0.f;
#pragma unroll
        for (int j = 0; j < 4; ++j) { v[j] = xr[64 * j]; ss += (v[j].x * v[j].x + v[j].y * v[j].y) + (v[j].z * v[j].z + v[j].w * v[j].w); }
        const float tot = wave_sum(ss);
        if (lane < 16) SSP[(size_t)m * 16 + lane] = lane == 0 ? tot : 0.f;
        GAS v2u* o8 = (GAS v2u*)(XA + (size_t)m * DM) + lane;
#pragma unroll
        for (int j = 0; j < 4; ++j) { const int col = 4 * lane + 256 * j;
            const f32x4 gg = *(const f32x4*)(g + col), sv = *(const f32x4*)(mb + 1024 + col);
            const f32x4 o = v[j] * gg * (sv + 1.0f);
            v2u w; w.x = pk2(o.x, o.y); w.y = pk2(o.z, o.w); o8[64 * j] = w; }
    }
}
__device__ __forceinline__ void pre_avec(const float* n1g, const float* n2g, const float* MODp, float* AVEC, int gtid, int ngt) {
    for (int i = gtid; i < DEPTH * 2 * 2 * 1024; i += ngt) { const int col = i & 1023, b = (i >> 10) & 1, w = (i >> 11) & 1, l = i >> 12;
        const float g = (w ? n2g : n1g)[l * 1024 + col], sc = MODp[((size_t)l * 2 + b) * 6144 + (w ? 4096 : 1024) + col];
        AVEC[i] = g * (1.f + sc); }
}
__device__ __forceinline__ void pre_bias(const bf16* WT, int nrows, const float* sh0, const float* sh1, float* bias0, float* bias1, int gw, int NGW, int lane) {
    for (int n = gw; n < nrows; n += NGW) {
        float w[16]; unpack8(*(const v4u*)(WT + (size_t)n * 1024 + lane * 16), w); unpack8(*(const v4u*)(WT + (size_t)n * 1024 + lane * 16 + 8), w + 8);
        float a0 = 0.f, a1 = 0.f;
#pragma unroll
        for (int q4 = 0; q4 < 4; ++q4) { const f32x4 s0 = *(const f32x4*)(sh0 + lane * 16 + 4 * q4), s1 = *(const f32x4*)(sh1 + lane * 16 + 4 * q4);
            a0 += (w[4 * q4] * s0.x + w[4 * q4 + 1] * s0.y) + (w[4 * q4 + 2] * s0.z + w[4 * q4 + 3] * s0.w);
            a1 += (w[4 * q4] * s1.x + w[4 * q4 + 1] * s1.y) + (w[4 * q4 + 2] * s1.z + w[4 * q4 + 3] * s1.w); }
        a0 = wave_sum(a0); a1 = wave_sum(a1);
        if (lane == 0) { bias0[n] = a0; bias1[n] = a1; }
    }
}
template <class Sched> __device__ __forceinline__ int rstd_tables(const Sched& S, const float* SSP, LAS float* rt, const float* bias, int bstride, LAS float* bt, int tid) {
    pg8::Unit u; int pm0 = -1, pm1 = -1;
    for (int i = 0; S.next(i, u); ++i) { if (pm0 < 0) pm0 = u.pm; else if (u.pm != pm0 && pm1 < 0) pm1 = u.pm;
        if (tid < 64) *(LAS f32x4*)(bt + i * 256 + tid * 4) = *(const f32x4*)(bias + (size_t)((u.pm * 256) / SEQ) * bstride + u.pn * 256 + tid * 4); }
    if (tid < 256) {
#pragma unroll
        for (int slot = 0; slot < 2; ++slot) { const int pm = slot ? pm1 : pm0;
            if (pm >= 0) { const float* sp = SSP + ((size_t)pm * 256 + tid) * 16;
                const f32x4 a = *(const f32x4*)sp, b = *(const f32x4*)(sp + 4), c = *(const f32x4*)(sp + 8), d = *(const f32x4*)(sp + 12);
                const float s = (((a.x + a.y) + (a.z + a.w)) + ((b.x + b.y) + (b.z + b.w))) + (((c.x + c.y) + (c.z + c.w)) + ((d.x + d.y) + (d.z + d.w)));
                rt[slot * 256 + tid] = 1.f / sqrtf(s * (1.f / DM) + EPS); } }
    }
    __syncthreads();
    return pm0;
}

__device__ __forceinline__ void post_foxcum_unit(int bh, const float* GATESp, float* FOXCUMp, const float* fox_f_bias, LAS float* lds, int tid, int wave, int lane) {
    const int b = bh / 6, h = bh % 6; const float bias = fox_f_bias[h];
    float v[32];
#pragma unroll
    for (int r = 0; r < 32; ++r) { const int t = wave * 2048 + r * 64 + lane; const float x2 = (GATESp[((size_t)b * SEQ + t) * 16 + h] + bias) * LOG2E;
        v[r] = fminf(x2, 0.f) - __builtin_amdgcn_logf(1.f + __builtin_amdgcn_exp2f(-fabsf(x2))); }
    float carry = 0.f;
#pragma unroll
    for (int r = 0; r < 32; ++r) { float x = v[r];
#pragma unroll
        for (int o = 1; o < 64; o <<= 1) { const float n = sup(x, o, lane); if (lane >= o) x += n; }
        x += carry; v[r] = x; carry = shf(x, 63); }
    if (lane == 0) lds[wave] = carry;
    __syncthreads();
    float off = 0.f;
    for (int w = 0; w < wave; ++w) off += lds[w];
#pragma unroll
    for (int r = 0; r < 32; ++r) FOXCUMp[(size_t)bh * SEQ + wave * 2048 + r * 64 + lane] = v[r] + off;
    __syncthreads();
}
__device__ __forceinline__ void post_qknorm_unit(int u, bf16* PROJp, float* KMEANP, const float* gfq, const float* gfk, const float* gbq, const float* gbk, LAS float* lds, int tid, int wave, int lane) {
    const int blk = u >> 1, half = u & 1, sub = lane & 7;
    int colv[3]; float gv[3][8]; float qsv[3];
#pragma unroll
    for (int it = 0; it < 3; ++it) { const int hsel = it * 8 + (lane >> 3), grp = hsel / 6, hh = hsel % 6;
        colv[it] = (grp == 0 ? C_FQ : grp == 1 ? C_FK : grp == 2 ? C_BQ : C_BK) + hh * 64 + 8 * sub;
        const float* gp = (grp == 0 ? gfq : grp == 1 ? gfk : grp == 2 ? gbq : gbk) + 8 * sub;
#pragma unroll
        for (int i = 0; i < 8; ++i) gv[it][i] = gp[i];
        qsv[it] = (grp == 0 || grp == 2) ? QSCALE : 1.f; }
    float ka[8] = {0.f, 0.f, 0.f, 0.f, 0.f, 0.f, 0.f, 0.f};
    const size_t row0 = (size_t)blk * 256 + half * 128 + wave * 16;
#pragma unroll 4
    for (int r = 0; r < 16; ++r) {
#pragma unroll
        for (int it = 0; it < 3; ++it) {
            v4u* p = (v4u*)(PROJp + (row0 + r) * PLD + colv[it]);
            float f[8]; unpack8(*p, f);
            float ss = 0.f;
#pragma unroll
            for (int i = 0; i < 8; ++i) ss += f[i] * f[i];
            ss += SWZ_X(ss, 1); ss += SWZ_X(ss, 2); ss += SWZ_X(ss, 4);
            const float rr = __builtin_amdgcn_rsqf(ss * (1.f / 64.f) + EPS);
#pragma unroll
            for (int i = 0; i < 8; ++i) f[i] = f[i] * rr * gv[it][i];
            if (it == 2) {
#pragma unroll
                for (int i = 0; i < 8; ++i) ka[i] += f[i]; }
            const float qs = qsv[it];
            v4u w; w.x = pk2(f[0] * qs, f[1] * qs); w.y = pk2(f[2] * qs, f[3] * qs); w.z = pk2(f[4] * qs, f[5] * qs); w.w = pk2(f[6] * qs, f[7] * qs);
            *p = w;
        }
    }
    if (lane >= 16) {
#pragma unroll
        for (int i = 0; i < 8; ++i) lds[wave * 384 + ((lane >> 3) - 2) * 64 + 8 * sub + i] = ka[i]; }
    __syncthreads();
    if (tid < 384) { float s = 0.f;
#pragma unroll
        for (int w = 0; w < 8; ++w) s += lds[w * 384 + tid];
        const int b = blk / NBLK, n = blk % NBLK, head = tid >> 6, dd = tid & 63;
        KMEANP[(size_t)half * (12 * NBLK * 64) + (((size_t)b * 6 + head) * NBLK + n) * 64 + dd] = s * (1.f / 256.f); }
    __syncthreads();
}
__device__ __forceinline__ void post_conv_unit(int blk, int which, const bf16* PROJp, bf16* dst, const float* conv_w, const float* conv_b, int tid) {
    const bf16* src = PROJp + (which ? C_MK : C_MQ); const float osc = which ? 0.125f : 1.f;
    const int c = 8 * (tid & 31), rs = tid >> 5, ch = which * 256 + c;
    const size_t r0 = (size_t)blk * 256 + rs * 16; const int tl = (int)(r0 % SEQ);
    float w[4][8], bb[8];
#pragma unroll
    for (int i = 0; i < 4; ++i) { const f32x4 a = *(const f32x4*)(conv_w + i * 512 + ch), b2 = *(const f32x4*)(conv_w + i * 512 + ch + 4);
        w[i][0] = a.x; w[i][1] = a.y; w[i][2] = a.z; w[i][3] = a.w; w[i][4] = b2.x; w[i][5] = b2.y; w[i][6] = b2.z; w[i][7] = b2.w; }
    { const f32x4 a = *(const f32x4*)(conv_b + ch), b2 = *(const f32x4*)(conv_b + ch + 4); bb[0] = a.x; bb[1] = a.y; bb[2] = a.z; bb[3] = a.w; bb[4] = b2.x; bb[5] = b2.y; bb[6] = b2.z; bb[7] = b2.w; }
    float x0[8], x1[8], x2[8], x3[8];
    { v4u h3[3];
#pragma unroll
      for (int k = 0; k < 3; ++k) { if (tl + k - 3 >= 0) h3[k] = *(const v4u*)(src + (r0 + k - 3) * PLD + c); else h3[k] = (v4u){0u, 0u, 0u, 0u}; }
      unpack8(h3[0], x0); unpack8(h3[1], x1); unpack8(h3[2], x2); }
#pragma unroll 1
    for (int hb = 0; hb < 2; ++hb) {
        v4u in[8];
#pragma unroll
        for (int k = 0; k < 8; ++k) in[k] = *(const v4u*)(src + (r0 + hb * 8 + k) * PLD + c);
#pragma unroll
        for (int r = 0; r < 8; ++r) {
            unpack8(in[r], x3);
            float y[8];
#pragma unroll
            for (int i = 0; i < 8; ++i) { const float t = bb[i] + w[0][i] * x0[i] + w[1][i] * x1[i] + w[2][i] * x2[i] + w[3][i] * x3[i];
                y[i] = t * __builtin_amdgcn_rcpf(1.f + __builtin_amdgcn_exp2f(-t * LOG2E)) * osc; x0[i] = x1[i]; x1[i] = x2[i]; x2[i] = x3[i]; }
            v4u o; o.x = pk2(y[0], y[1]); o.y = pk2(y[2], y[3]); o.z = pk2(y[4], y[5]); o.w = pk2(y[6], y[7]);
            *(v4u*)(dst + (r0 + hb * 8 + r) * 256 + c) = o;
        }
    }
}

struct MlP { const bf16* PROJ; const bf16* QC; const bf16* KC; const float* GATES; float* U; float* NU; float* BEND; float* MLOC; bf16* CS; float* NS; float* MS; bf16* Y;
             const float *ibias, *fbias, *hg; };
__device__ __forceinline__ void mlstm_m1(int ci, const MlP& P, LAS float* lds, int tid, int wave, int lane) {
    const int b = ci >> 10, h = (ci >> 8) & 3, c = ci & 255; const size_t row0 = (size_t)b * SEQ + c * 64;
    LAS float* Ks = lds; LAS float* Vs = lds + 4096; LAS float* ws = lds + 8192;
    { const int r = tid >> 3, cg = (tid & 7) * 8; float f[8];
      unpack8(*(const v4u*)(P.KC + (row0 + r) * 256 + h * 64 + cg), f);
#pragma unroll
      for (int i = 0; i < 8; ++i) Ks[r * 64 + cg + i] = f[i];
      unpack8(*(const v4u*)(P.PROJ + (row0 + r) * PLD + C_MV + h * 64 + cg), f);
#pragma unroll
      for (int i = 0; i < 8; ++i) Vs[r * 64 + cg + i] = f[i]; }
    if (wave == 0) {
        const size_t row = row0 + lane;
        const float fi = P.GATES[row * 16 + 6 + h] + P.ibias[h], ff = P.GATES[row * 16 + 10 + h] + P.fbias[h];
        float bc = log_sigmoid_f(ff);
#pragma unroll
        for (int o = 1; o < 64; o <<= 1) { const float n = sup(bc, o, lane); if (lane >= o) bc += n; }
        const float bend = shf(bc, 63);
        const float wl = bend - bc + fi; const float mloc = wave_max(wl);
        ws[lane] = expf(wl - mloc);
        if (lane == 0) { P.BEND[ci] = bend; P.MLOC[ci] = mloc; }
    }
    __syncthreads();
    { const int dv = tid >> 3, e0 = (tid & 7) * 8; float u[8] = {0.f, 0.f, 0.f, 0.f, 0.f, 0.f, 0.f, 0.f};
#pragma unroll 2
      for (int s = 0; s < 64; ++s) { const float vw = Vs[s * 64 + dv] * ws[s]; const f32x4 ka = *(const LAS f32x4*)(Ks + s * 64 + e0), kb = *(const LAS f32x4*)(Ks + s * 64 + e0 + 4);
          u[0] += vw * ka.x; u[1] += vw * ka.y; u[2] += vw * ka.z; u[3] += vw * ka.w; u[4] += vw * kb.x; u[5] += vw * kb.y; u[6] += vw * kb.z; u[7] += vw * kb.w; }
      float* up = P.U + (size_t)ci * 4096 + dv * 64 + e0;
      *(f32x4*)up = (f32x4){u[0], u[1], u[2], u[3]}; *(f32x4*)(up + 4) = (f32x4){u[4], u[5], u[6], u[7]}; }
    if (tid < 64) { float nu = 0.f; for (int s = 0; s < 64; ++s) nu += ws[s] * Ks[s * 64 + tid]; P.NU[(size_t)ci * 64 + tid] = nu; }
    __syncthreads();
}
__device__ __forceinline__ void mlstm_m2(int u, const MlP& P, LAS float* lds, int tid, int wave, int lane) {
    const int bh = u >> 3, eg = u & 7, elem = eg * 512 + tid, base = bh * 256;
    LAS float* decl = lds; LAS float* wul = lds + 256;
    if (wave == 0) {
        const f32x4 b4 = *(const f32x4*)(P.BEND + base + 4 * lane), l4 = *(const f32x4*)(P.MLOC + base + 4 * lane);
        float B = b4.x, L = l4.x;
        B += b4.y; L = fmaxf(L + b4.y, l4.y); B += b4.z; L = fmaxf(L + b4.z, l4.z); B += b4.w; L = fmaxf(L + b4.w, l4.w);
#pragma unroll
        for (int o = 1; o < 64; o <<= 1) { const float Bp = sup(B, o, lane), Lp = sup(L, o, lane); if (lane >= o) { L = fmaxf(Lp + B, L); B = Bp + B; } }
        const float Bex = sup(B, 1, lane), Lex = sup(L, 1, lane);
        float m = (lane == 0) ? 0.f : fmaxf(Bex, Lex);
        const float bb[4] = {b4.x, b4.y, b4.z, b4.w}, ll[4] = {l4.x, l4.y, l4.z, l4.w};
#pragma unroll
        for (int j = 0; j < 4; ++j) { const int c = 4 * lane + j; if (eg == 0) P.MS[base + c] = m;
            const float mn = fmaxf(bb[j] + m, ll[j]);
            decl[c] = __builtin_amdgcn_exp2f((bb[j] + m - mn) * LOG2E); wul[c] = __builtin_amdgcn_exp2f((ll[j] - mn) * LOG2E); m = mn; }
    }
    __syncthreads();
    const bool donorm = (eg == 0 && tid < 64);
    float C = 0.f, nst = 0.f;
#pragma unroll 1
    for (int c0 = 0; c0 < 256; c0 += 16) {
        float uv[16], nv[16];
#pragma unroll
        for (int i = 0; i < 16; ++i) { const int ci = base + c0 + i; uv[i] = P.U[(size_t)ci * 4096 + elem]; nv[i] = donorm ? P.NU[(size_t)ci * 64 + tid] : 0.f; }
#pragma unroll
        for (int i = 0; i < 16; ++i) { const int ci = base + c0 + i;
            P.CS[(size_t)ci * 4096 + elem] = (bf16)f2bf(C);
            if (donorm) P.NS[(size_t)ci * 64 + tid] = nst;
            const float dec = decl[c0 + i], wu = wul[c0 + i];
            C = dec * C + wu * uv[i]; nst = dec * nst + wu * nv[i]; }
    }
    __syncthreads();
}
__device__ __forceinline__ void mlstm_m3(int ci, const MlP& P, LAS float* lds, int tid, int wave, int lane) {
    constexpr int LP = 68;
    const int b = ci >> 10, h = (ci >> 8) & 3, c = ci & 255; const size_t row0 = (size_t)b * SEQ + c * 64;
    LAS float* Qs = lds; LAS float* Ks = Qs + 64 * LP; LAS float* Cs = Ks + 64 * LP; LAS float* Sm = Cs + 64 * LP; LAS float* Vs = Sm + 64 * LP;
    LAS float* av = Vs + 4096; LAS float* gv = av + 64; LAS float* bcv = gv + 64; LAS float* nsv = bcv + 64;
    const float ms = P.MS[ci];
    { const int r = tid >> 3, cg = (tid & 7) * 8; float f[8];
      unpack8(*(const v4u*)(P.QC + (row0 + r) * 256 + h * 64 + cg), f);
#pragma unroll
      for (int i = 0; i < 8; ++i) Qs[r * LP + cg + i] = f[i];
      unpack8(*(const v4u*)(P.KC + (row0 + r) * 256 + h * 64 + cg), f);
#pragma unroll
      for (int i = 0; i < 8; ++i) Ks[r * LP + cg + i] = f[i];
      unpack8(*(const v4u*)(P.PROJ + (row0 + r) * PLD + C_MV + h * 64 + cg), f);
#pragma unroll
      for (int i = 0; i < 8; ++i) Vs[r * 64 + cg + i] = f[i];
      unpack8(*(const v4u*)(P.CS + (size_t)ci * 4096 + r * 64 + cg), f);
#pragma unroll
      for (int i = 0; i < 8; ++i) Cs[r * LP + cg + i] = f[i]; }
    if (wave == 0) {
        const size_t row = row0 + lane;
        const float fi = P.GATES[row * 16 + 6 + h] + P.ibias[h], ff = P.GATES[row * 16 + 10 + h] + P.fbias[h];
        float bc = log_sigmoid_f(ff);
#pragma unroll
        for (int o = 1; o < 64; o <<= 1) { const float n = sup(bc, o, lane); if (lane >= o) bc += n; }
        const float a = fi - bc; float pm = a;
#pragma unroll
        for (int o = 1; o < 64; o <<= 1) { const float n = sup(pm, o, lane); if (lane >= o) pm = fmaxf(pm, n); }
        av[lane] = a; gv[lane] = fmaxf(ms, pm); bcv[lane] = bc; nsv[lane] = P.NS[(size_t)ci * 64 + lane];
    }
    __syncthreads();
    const int j = tid >> 3, part = tid & 7, s0 = part * 8;
    const float gj = gv[j];
    { float sacc[8] = {0.f, 0.f, 0.f, 0.f, 0.f, 0.f, 0.f, 0.f};
#pragma unroll 1
      for (int e = 0; e < 64; e += 4) { const f32x4 q4 = *(const LAS f32x4*)(Qs + j * LP + e);
#pragma unroll
          for (int i = 0; i < 8; ++i) { const f32x4 k4 = *(const LAS f32x4*)(Ks + (s0 + i) * LP + e); sacc[i] += (q4.x * k4.x + q4.y * k4.y) + (q4.z * k4.z + q4.w * k4.w); } }
#pragma unroll
      for (int i = 0; i < 8; ++i) { const int s = s0 + i; Sm[j * LP + s] = (s <= j) ? sacc[i] * expf(av[s] - gj) : 0.f; } }
    __syncthreads();
    { const int dv0 = part * 8; float t1[8] = {0.f, 0.f, 0.f, 0.f, 0.f, 0.f, 0.f, 0.f}, t2[8] = {0.f, 0.f, 0.f, 0.f, 0.f, 0.f, 0.f, 0.f};
#pragma unroll 1
      for (int e = 0; e < 64; e += 4) { const f32x4 q4 = *(const LAS f32x4*)(Qs + j * LP + e);
#pragma unroll
          for (int i = 0; i < 8; ++i) { const f32x4 c4 = *(const LAS f32x4*)(Cs + (dv0 + i) * LP + e); t1[i] += (q4.x * c4.x + q4.y * c4.y) + (q4.z * c4.z + q4.w * c4.w); } }
#pragma unroll 2
      for (int s = 0; s < 64; ++s) { const float sm = Sm[j * LP + s]; const f32x4 va = *(const LAS f32x4*)(Vs + s * 64 + dv0), vb = *(const LAS f32x4*)(Vs + s * 64 + dv0 + 4);
          t2[0] += sm * va.x; t2[1] += sm * va.y; t2[2] += sm * va.z; t2[3] += sm * va.w; t2[4] += sm * vb.x; t2[5] += sm * vb.y; t2[6] += sm * vb.z; t2[7] += sm * vb.w; }
      float dn = 0.f, ssum = 0.f;
#pragma unroll
      for (int i = 0; i < 8; ++i) { dn += nsv[s0 + i] * Qs[j * LP + s0 + i]; ssum += Sm[j * LP + s0 + i]; }
      { dn += SWZ_X(dn, 1); ssum += SWZ_X(ssum, 1); dn += SWZ_X(dn, 2); ssum += SWZ_X(ssum, 2); dn += SWZ_X(dn, 4); ssum += SWZ_X(ssum, 4); }
      const float inter = expf(ms - gj), mj = bcv[j] + gj;
      const float den = inter * dn + ssum, dd = fmaxf(fabsf(den), expf(-mj)), rd = 1.f / dd;
      float hv[8], ss = 0.f;
#pragma unroll
      for (int i = 0; i < 8; ++i) { hv[i] = (inter * t1[i] + t2[i]) * rd; ss += hv[i] * hv[i]; }
      { ss += SWZ_X(ss, 1); ss += SWZ_X(ss, 2); ss += SWZ_X(ss, 4); }
      const float rr = 1.f / sqrtf(ss * (1.f / 64.f) + EPS);
      float mo[8]; unpack8(*(const v4u*)(P.PROJ + (row0 + j) * PLD + C_MO + h * 64 + dv0), mo);
      float y[8];
#pragma unroll
      for (int i = 0; i < 8; ++i) y[i] = hv[i] * rr * P.hg[h * 64 + dv0 + i] * sigmoid_f(mo[i]);
      v4u w; w.x = pk2(y[0], y[1]); w.y = pk2(y[2], y[3]); w.z = pk2(y[4], y[5]); w.w = pk2(y[6], y[7]);
      *(v4u*)(P.Y + (row0 + j) * 1024 + Y_ML + h * 64 + dv0) = w; }
    __syncthreads();
}

__device__ __forceinline__ size_t moba_list_off(int bh, int n);
__device__ __forceinline__ void moba_gate_unit(int u, const bf16* PROJ, const float* KMEAN, unsigned* SEL, unsigned* LCNT, unsigned* CTAB, unsigned short* LIST, float B2, float thresh2, LAS float* lds, int tid) {
    const int bh = u >> 6, qb = 63 - (u & 63), b = bh / 6, h = bh % 6;
    LAS float* km = lds; LAS float* cand = lds + 4096; LAS unsigned* cntl = (LAS unsigned*)(lds + 4096 + 1536);
    if (tid < 64) cntl[tid] = 0u;
    for (int i = tid; i < qb * 16; i += NTHREADS) *(LAS f32x4*)(km + i * 4) = *(const f32x4*)(KMEAN + (size_t)bh * NBLK * 64 + i * 4) + *(const f32x4*)(KMEAN + (size_t)(12 * NBLK * 64) + (size_t)bh * NBLK * 64 + i * 4);
    __syncthreads();
    const int query = tid & 255, half = tid >> 8; const size_t row = (size_t)b * SEQ + qb * 256 + query;
    float q[64];
#pragma unroll
    for (int i = 0; i < 8; ++i) unpack8(*(const v4u*)(PROJ + row * PLD + C_BQ + h * 64 + i * 8), q + i * 8);
    float v0 = -INFINITY, v1 = -INFINITY, v2 = -INFINITY; int i0 = 255, i1 = 255, i2 = 255;
    const int nlo = half * 32, nhi = (qb < nlo + 32) ? qb : nlo + 32;
    for (int n = nlo; n < nhi; ++n) { float g = 0.f;
#pragma unroll
        for (int d = 0; d < 64; d += 4) { const f32x4 k4 = *(const LAS f32x4*)(km + n * 64 + d); g += (q[d] * k4.x + q[d + 1] * k4.y) + (q[d + 2] * k4.z + q[d + 3] * k4.w); }
        if (g > v0) { v2 = v1; i2 = i1; v1 = v0; i1 = i0; v0 = g; i0 = n; } else if (g > v1) { v2 = v1; i2 = i1; v1 = g; i1 = n; } else if (g > v2) { v2 = g; i2 = n; } }
    if (half == 1) { cand[query * 6 + 0] = v0; cand[query * 6 + 1] = v1; cand[query * 6 + 2] = v2;
        cand[query * 6 + 3] = __int_as_float(i0); cand[query * 6 + 4] = __int_as_float(i1); cand[query * 6 + 5] = __int_as_float(i2); }
    __syncthreads();
    if (half == 0) {
#pragma unroll
        for (int k = 0; k < 3; ++k) { const float g = cand[query * 6 + k]; const int n = __float_as_int(cand[query * 6 + 3 + k]);
            if (n != 255) { if (g > v0) { v2 = v1; i2 = i1; v1 = v0; i1 = i0; v0 = g; i0 = n; } else if (g > v1) { v2 = v1; i2 = i1; v1 = g; i1 = n; } else if (g > v2) { v2 = g; i2 = n; } } }
        { const float slope2 = exp2f(-8.f * (float)(h + 1) / 6.f) * LOG2E; const float lim = (2.f * B2 + thresh2) / slope2; const int t0 = qb * 256 + query - 255;
          if (i0 != 255 && (float)(t0 - i0 * 256) > lim) i0 = 255;
          if (i1 != 255 && (float)(t0 - i1 * 256) > lim) i1 = 255;
          if (i2 != 255 && (float)(t0 - i2 * 256) > lim) i2 = 255; }
        SEL[row * 6 + h] = (unsigned)i0 | ((unsigned)i1 << 8) | ((unsigned)i2 << 16);
        if (LIST) { const unsigned t = (unsigned)(qb * 256 + query);
            if (i0 != 255) { const unsigned pos = __hip_atomic_fetch_add(cntl + i0, 1u, __ATOMIC_RELAXED, __HIP_MEMORY_SCOPE_WORKGROUP); LIST[moba_list_off(bh, i0) + (size_t)(qb - i0 - 1) * 256 + pos] = (unsigned short)(t | (0u << 14)); }
            if (i1 != 255) { const unsigned pos = __hip_atomic_fetch_add(cntl + i1, 1u, __ATOMIC_RELAXED, __HIP_MEMORY_SCOPE_WORKGROUP); LIST[moba_list_off(bh, i1) + (size_t)(qb - i1 - 1) * 256 + pos] = (unsigned short)(t | (1u << 14)); }
            if (i2 != 255) { const unsigned pos = __hip_atomic_fetch_add(cntl + i2, 1u, __ATOMIC_RELAXED, __HIP_MEMORY_SCOPE_WORKGROUP); LIST[moba_list_off(bh, i2) + (size_t)(qb - i2 - 1) * 256 + pos] = (unsigned short)(t | (2u << 14)); } }
    }
    __syncthreads();
    if (LIST && tid < 64) { const unsigned c = cntl[tid]; CTAB[((size_t)bh * 64 + qb) * 64 + tid] = c; if (c) atomicAdd(LCNT + bh * 64 + tid, c); }
    __syncthreads();
}

__device__ __forceinline__ void fox_naive(const bf16* PROJ, const float* FOXCUM, bf16* Y, int gw, int NGW, int lane) {
    for (int idx = gw; idx < 12 * SEQ; idx += NGW) {
        const int t = SEQ - 1 - idx / 12, bh = idx % 12, b = bh / 6, h = bh % 6; const size_t rb = (size_t)b * SEQ;
        const float qv = bf2f(PROJ[(rb + t) * PLD + C_FQ + h * 64 + lane]); const float ct = FOXCUM[(size_t)bh * SEQ + t];
        float m = -INFINITY, l = 0.f, acc = 0.f;
#pragma unroll 4
        for (int j = 0; j <= t; ++j) {
            const float kv = bf2f(PROJ[(rb + j) * PLD + C_FK + h * 64 + lane]), vv = bf2f(PROJ[(rb + j) * PLD + C_FV + h * 64 + lane]);
            const float s = wave_sum(qv * kv) + (ct - FOXCUM[(size_t)bh * SEQ + j]);
            const float mn = fmaxf(m, s), sc = exp2f(m - mn), p = exp2f(s - mn);
            l = l * sc + p; acc = acc * sc + p * vv; m = mn; }
        Y[(rb + t) * 1024 + Y_FOX + h * 64 + lane] = (bf16)f2bf(acc / l);
    }
}
__device__ __forceinline__ void moba_naive(const bf16* PROJ, const unsigned* SEL, bf16* Y, int gw, int NGW, int lane) {
    for (int idx = gw; idx < 12 * SEQ; idx += NGW) {
        const int t = SEQ - 1 - idx / 12, bh = idx % 12, b = bh / 6, h = bh % 6; const size_t rb = (size_t)b * SEQ;
        const float slope2 = exp2f(-8.f * (float)(h + 1) / 6.f) * LOG2E;
        const float qv = bf2f(PROJ[(rb + t) * PLD + C_BQ + h * 64 + lane]);
        const unsigned sel = SEL[(rb + t) * 6 + h];
        float m = -INFINITY, l = 0.f, acc = 0.f;
        for (int slot = 0; slot < 4; ++slot) {
            int j0, j1;
            if (slot < 3) { const int n = (sel >> (8 * slot)) & 0xff; if (n == 255) continue; j0 = n * 256; j1 = j0 + 256; } else { j0 = (t >> 8) * 256; j1 = t + 1; }
#pragma unroll 4
            for (int j = j0; j < j1; ++j) {
                const float kv = bf2f(PROJ[(rb + j) * PLD + C_BK + h * 64 + lane]), vv = bf2f(PROJ[(rb + j) * PLD + C_BV + h * 64 + lane]);
                const float s = wave_sum(qv * kv) - slope2 * (float)(t - j);
                const float mn = fmaxf(m, s), sc = exp2f(m - mn), p = exp2f(s - mn);
                l = l * sc + p; acc = acc * sc + p * vv; m = mn; }
        }
        Y[(rb + t) * 1024 + Y_MOBA + h * 64 + lane] = (bf16)f2bf(acc / l);
    }
}
typedef short v4i16_t __attribute__((ext_vector_type(4)));
typedef short s16x4 __attribute__((ext_vector_type(4)));
constexpr int ATT_K0 = 0, ATT_V0 = 32768, ATT_TAB = 132096;
#ifndef THRESH_NAT
#define THRESH_NAT 30.f
#endif
constexpr float THRESH2 = THRESH_NAT * LOG2E;

__device__ __forceinline__ int crow(int r, int hi) { return (r & 3) + 8 * (r >> 2) + 4 * hi; }
__device__ __forceinline__ s16x4 vtr(LAS const unsigned char* p) { return __builtin_bit_cast(s16x4, __builtin_amdgcn_ds_read_tr16_b64_v4i16((LAS v4i16_t*)p)); }
typedef float f32x2_t __attribute__((ext_vector_type(2))); typedef __bf16 bf16x2_t __attribute__((ext_vector_type(2)));
#ifndef CVT_ASM
#define CVT_ASM 0
#endif
#if CVT_ASM
__device__ __forceinline__ unsigned cvtpk(float lo, float hi) { unsigned r; asm volatile("v_cvt_pk_bf16_f32 %0, %1, %2\n\ts_nop 1" : "=v"(r) : "v"(lo), "v"(hi)); return r; }
#else
__device__ __forceinline__ unsigned cvtpk(float lo, float hi) { const f32x2_t v = {lo, hi}; const bf16x2_t b = __builtin_convertvector(v, bf16x2_t); return __builtin_bit_cast(unsigned, b); }
#endif

struct GroupRegs { v4u k[4], v[4]; };
__device__ __forceinline__ void group_issue(GroupRegs& R, const bf16* Kg, const bf16* Vg, int tid) {
#pragma unroll
    for (int i = 0; i < 4; ++i) { const int idx = tid + NTHREADS * i, row = idx >> 3, ch = idx & 7;
        R.k[i] = *(const v4u*)(Kg + (size_t)row * PLD + ch * 8); R.v[i] = *(const v4u*)(Vg + (size_t)row * PLD + ch * 8); }
}
__device__ __forceinline__ void group_commit(const GroupRegs& R, LAS unsigned char* kv, int tid) {
#pragma unroll
    for (int i = 0; i < 4; ++i) { const int idx = tid + NTHREADS * i, row = idx >> 3, ch = idx & 7;
        *(LAS v4u*)(kv + ATT_K0 + row * 128 + ((ch ^ ((row >> 1) & 7)) << 4)) = R.k[i];
        *(LAS v4u*)(kv + ATT_V0 + row * 128 + ((ch * 16) ^ (((row >> 1) & 1) << 6))) = R.v[i]; }
}
__device__ __forceinline__ void load_group(const bf16* Kg, const bf16* Vg, LAS unsigned char* kv, int tid) {
#pragma unroll
    for (int i = 0; i < 4; ++i) { const int idx = tid + NTHREADS * i, row = idx >> 3, ch = idx & 7;
        const v4u k = *(const v4u*)(Kg + (size_t)row * PLD + ch * 8), v = *(const v4u*)(Vg + (size_t)row * PLD + ch * 8);
        *(LAS v4u*)(kv + ATT_K0 + row * 128 + ((ch ^ ((row >> 1) & 7)) << 4)) = k;
        *(LAS v4u*)(kv + ATT_V0 + row * 128 + ((ch * 16) ^ (((row >> 1) & 1) << 6))) = v; }
}

template <bool FOX>
__device__ __forceinline__ void attn_subtile(LAS const unsigned char* kv, LAS const float* colt, int j0, const bf16x8 (&qf)[4], float rowterm, float slope2, bool mask, int qrel,
                                             f32x16 (&o)[2], float& l, int lane) {
    const int r32 = lane & 31, hh = lane >> 5;
    f32x16 acc;
    if (FOX) {
#pragma unroll
        for (int g = 0; g < 4; ++g) { const f32x4 c = *(LAS const f32x4*)(colt + j0 + 8 * g + 4 * hh); acc[4 * g + 0] = rowterm + c.x; acc[4 * g + 1] = rowterm + c.y; acc[4 * g + 2] = rowterm + c.z; acc[4 * g + 3] = rowterm + c.w; }
    } else {
#pragma unroll
        for (int r = 0; r < 16; ++r) acc[r] = rowterm + slope2 * (float)(j0 + crow(r, hh));
    }
    if (mask) {
#pragma unroll
        for (int r = 0; r < 16; ++r) if (j0 + crow(r, hh) > qrel) acc[r] = -INFINITY;
    }
    { const int row = j0 + r32; LAS const unsigned char* kr = kv + ATT_K0 + row * 128; const int sw = (row >> 1) & 7;
#pragma unroll
      for (int s = 0; s < 4; ++s) { const bf16x8 kf = *(LAS const bf16x8*)(kr + (((2 * s + hh) ^ sw) << 4)); acc = __builtin_amdgcn_mfma_f32_32x32x16_bf16(kf, qf[s], acc, 0, 0, 0); } }
    float ls = 0.f;
#pragma unroll
    for (int r = 0; r < 16; ++r) { acc[r] = __builtin_amdgcn_exp2f(acc[r]); ls += acc[r]; }
    l += ls;
    bf16x8 pa[2];
#pragma unroll
    for (int s = 0; s < 2; ++s) { v4u w; w.x = cvtpk(acc[8 * s + 0], acc[8 * s + 1]); w.y = cvtpk(acc[8 * s + 2], acc[8 * s + 3]); w.z = cvtpk(acc[8 * s + 4], acc[8 * s + 5]); w.w = cvtpk(acc[8 * s + 6], acc[8 * s + 7]); pa[s] = __builtin_bit_cast(bf16x8, w); }
    { const int i = lane & 15, c = (lane >> 4) & 1;
#pragma unroll
      for (int db = 0; db < 2; ++db)
#pragma unroll
          for (int s = 0; s < 2; ++s) { const int rowv = j0 + 16 * s + 4 * hh + (i >> 2); const int colb = (32 * db + 16 * c + 4 * (i & 3)) * 2;
              LAS const unsigned char* vp = kv + ATT_V0 + rowv * 128 + (colb ^ (((rowv >> 1) & 1) << 6));
              const s16x4 lo = vtr(vp), hi = vtr(vp + 8 * 128);
              const bf16x8 vf = (bf16x8){lo[0], lo[1], lo[2], lo[3], hi[0], hi[1], hi[2], hi[3]};
              o[db] = __builtin_amdgcn_mfma_f32_32x32x16_bf16(pa[s], vf, o[db], 0, 0, 0); } }
}
__device__ __forceinline__ float rfl(float x) { return __builtin_bit_cast(float, __builtin_amdgcn_readfirstlane(__builtin_bit_cast(int, x))); }

__device__ __forceinline__ void fox_unit(int bh, int qb, const bf16* PROJ, const float* FOXCUM, bf16* Y, float B2, LAS unsigned char* lds, int tid, int wave, int lane) {
    const int b = bh / 6, h = bh % 6; const size_t rb = (size_t)b * SEQ; const int r32 = lane & 31, hh = lane >> 5;
    const int q0w = qb * 256 + wave * 32, qpos = q0w + r32;
    const float* cum = FOXCUM + (size_t)bh * SEQ;
    bf16x8 qf[4];
#pragma unroll
    for (int s = 0; s < 4; ++s) qf[s] = *(const bf16x8*)(PROJ + (rb + qpos) * PLD + C_FQ + h * 64 + 16 * s + 8 * hh);
    GroupRegs GA, GB;
    group_issue(GA, PROJ + (rb + (size_t)qb * 256) * PLD + C_FK + h * 64, PROJ + (rb + (size_t)qb * 256) * PLD + C_FV + h * 64, tid);
    const float ca = (tid < 256) ? -cum[qb * 256 + tid] : 0.f;
    const float cq = cum[qpos];
    const float cq_first = rfl(cum[q0w]), cq_blk = rfl(cum[qb * 256]);
    const float cprev = (qb > 0) ? rfl(cum[qb * 256 - 1]) : 0.f;
    const float rowterm = cq - B2, lim = -THRESH2 - 2.f * B2;
    f32x16 o[2]; float l = 0.f;
#pragma unroll
    for (int r = 0; r < 16; ++r) { o[0][r] = 0.f; o[1][r] = 0.f; }
    LAS float* coltA = (LAS float*)(lds + ATT_TAB); LAS float* coltB = coltA + 256;
    LAS unsigned char* kvA = lds; LAS unsigned char* kvB = lds + 65536;
#ifndef FOX_2G
#define FOX_2G 1
#endif
    const bool haveB = FOX_2G && (qb > 0) && !(cq_blk - cprev < lim);
    float cb = 0.f;
    if (haveB) { group_issue(GB, PROJ + (rb + (size_t)(qb - 1) * 256) * PLD + C_FK + h * 64, PROJ + (rb + (size_t)(qb - 1) * 256) * PLD + C_FV + h * 64, tid);
        cb = (tid < 256) ? -cum[(qb - 1) * 256 + tid] : 0.f; }
    group_commit(GA, kvA, tid); if (tid < 256) coltA[tid] = ca;
    if (haveB) { group_commit(GB, kvB, tid); if (tid < 256) coltB[tid] = cb; }
    __syncthreads();
#ifndef REP_FLOAD
#define REP_FLOAD 0
#endif
#pragma unroll 1
    for (int rp = 0; rp < REP_FLOAD; ++rp) {
        group_issue(GA, PROJ + (rb + (size_t)qb * 256) * PLD + C_FK + h * 64, PROJ + (rb + (size_t)qb * 256) * PLD + C_FV + h * 64, tid);
        if (haveB) group_issue(GB, PROJ + (rb + (size_t)(qb - 1) * 256) * PLD + C_FK + h * 64, PROJ + (rb + (size_t)(qb - 1) * 256) * PLD + C_FV + h * 64, tid);
        group_commit(GA, kvA, tid); if (haveB) group_commit(GB, kvB, tid);
        __syncthreads(); }
#ifndef REP_FSUB
#define REP_FSUB 0
#endif
#pragma unroll 1
    for (int rp = 0; rp <= REP_FSUB; ++rp) {
    if (rp) { l = 0.f;
#pragma unroll
        for (int r = 0; r < 16; ++r) { o[0][r] = 0.f; o[1][r] = 0.f; } }
#pragma unroll 1
    for (int st = wave; st >= 0; --st) {
        const int j0 = 32 * st;
        if (cq_first + rfl(coltA[j0 + 31]) < lim) break;
        attn_subtile<true>(kvA, coltA, j0, qf, rowterm, 0.f, st == wave, wave * 32 + r32, o, l, lane);
    }
    if (haveB) {
#pragma unroll 1
        for (int st = 7; st >= 0; --st) {
            const int j0 = 32 * st;
            if (cq_first + rfl(coltB[j0 + 31]) < lim) break;
            attn_subtile<true>(kvB, coltB, j0, qf, rowterm, 0.f, false, 0, o, l, lane);
        }
    }
    }
    __syncthreads();
    {
        for (int g = haveB ? qb - 2 : qb - 1; g >= 0; --g) {
            if (cq_blk - rfl(cum[g * 256 + 255]) < lim) break;
            load_group(PROJ + (rb + (size_t)g * 256) * PLD + C_FK + h * 64, PROJ + (rb + (size_t)g * 256) * PLD + C_FV + h * 64, kvA, tid);
            if (tid < 256) coltA[tid] = -cum[g * 256 + tid];
            __syncthreads();
            {
#pragma unroll 1
                for (int st = 7; st >= 0; --st) {
                    const int j0 = 32 * st;
                    if (cq_first + rfl(coltA[j0 + 31]) < lim) break;
                    attn_subtile<true>(kvA, coltA, j0, qf, rowterm, 0.f, false, 0, o, l, lane);
                }
            }
            __syncthreads();
        }
    }
    l = half_sum(l, lane);
    bf16* yp = Y + (rb + (size_t)q0w) * 1024 + Y_FOX + h * 64 + r32;
#ifndef REP_FOUT
#define REP_FOUT 0
#endif
#pragma unroll 1
    for (int rp = 0; rp <= REP_FOUT; ++rp) {
#pragma unroll
    for (int r = 0; r < 16; ++r) { const int q = crow(r, hh); const float rl = __builtin_amdgcn_rcpf(shf(l, q));
        yp[(size_t)q * 1024] = (bf16)f2bf(o[0][r] * rl); yp[(size_t)q * 1024 + 32] = (bf16)f2bf(o[1][r] * rl); }
    }
}

__device__ __forceinline__ void fox_unit_old(int bh, int qb, const bf16* PROJ, const float* FOXCUM, bf16* Y, float B2, LAS unsigned char* lds, int tid, int wave, int lane) {
    const int b = bh / 6, h = bh % 6; const size_t rb = (size_t)b * SEQ; const int r32 = lane & 31, hh = lane >> 5;
    const int q0w = qb * 256 + wave * 32, qpos = q0w + r32;
    const float* cum = FOXCUM + (size_t)bh * SEQ;
    bf16x8 qf[4];
#pragma unroll
    for (int s = 0; s < 4; ++s) qf[s] = *(const bf16x8*)(PROJ + (rb + qpos) * PLD + C_FQ + h * 64 + 16 * s + 8 * hh);
    const float cq = cum[qpos];
    const float cq_first = rfl(cum[q0w]);
    const float cq_blk = rfl(cum[qb * 256]);
    const float rowterm = cq - B2;
    f32x16 o[2]; float l = 0.f;
#pragma unroll
    for (int r = 0; r < 16; ++r) { o[0][r] = 0.f; o[1][r] = 0.f; }
    LAS float* colt = (LAS float*)(lds + ATT_TAB);
    for (int g = qb; g >= 0; --g) {
        if (g < qb) { const float cl = rfl(cum[g * 256 + 255]); if (2.f * B2 + cq_blk - cl < -THRESH2) break; }
        load_group(PROJ + (rb + (size_t)g * 256) * PLD + C_FK + h * 64, PROJ + (rb + (size_t)g * 256) * PLD + C_FV + h * 64, lds, tid);
        if (tid < 256) colt[tid] = -cum[g * 256 + tid];
        __syncthreads();
        const int stmax = (g == qb) ? wave : 7;
        for (int st = stmax; st >= 0; --st) {
            const int j0 = 32 * st;
            { const float cl = rfl(colt[j0 + 31]); if (2.f * B2 + cq_first + cl < -THRESH2) break; }
            attn_subtile<true>(lds, colt, j0, qf, rowterm, 0.f, (g == qb) && (st == wave), wave * 32 + r32, o, l, lane);
        }
        __syncthreads();
    }
    l = half_sum(l, lane);
    bf16* yp = Y + (rb + (size_t)q0w) * 1024 + Y_FOX + h * 64 + r32;
#pragma unroll
    for (int r = 0; r < 16; ++r) { const int q = crow(r, hh); const float rl = __builtin_amdgcn_rcpf(shf(l, q));
        yp[(size_t)q * 1024] = (bf16)f2bf(o[0][r] * rl); yp[(size_t)q * 1024 + 32] = (bf16)f2bf(o[1][r] * rl); }
}

__device__ __forceinline__ size_t moba_list_off(int bh, int n) { return (size_t)bh * 516096 + 256 * (size_t)(63 * n - (n * (n - 1)) / 2); }
__device__ __forceinline__ void moba_store(const f32x16 (&o)[2], float l, int qpos, int slot, bool valid, size_t rb, int h, bf16* OPART, float* LPART, bf16* Y, int lane) {
    const int r32 = lane & 31, hh = lane >> 5;
#pragma unroll
    for (int r = 0; r < 16; ++r) { const int src = crow(r, hh);
        const int qp = shfi(qpos, src), sl = shfi(slot, src); const int ok = shfi((int)valid, src);
        if (ok) { bf16* op = (sl == 3) ? (Y + (rb + qp) * 1024 + Y_MOBA + h * 64) : (OPART + ((size_t)sl * MROWS + rb + qp) * 384 + h * 64);
            op[r32] = (bf16)f2bf(o[0][r]); op[32 + r32] = (bf16)f2bf(o[1][r]); } }
    if (valid && hh == 0) LPART[((size_t)slot * MROWS + rb + qpos) * 6 + h] = l;
}
__device__ __forceinline__ void moba_sel_unit(int bh, int n, int chunk, int cnt, const bf16* PROJ, const unsigned short* LIST, const unsigned* CTAB, bf16* OPART, float* LPART, bf16* Y, float B2,
                                              LAS unsigned char* lds, int tid, int wave, int lane) {
    const int b = bh / 6, h = bh % 6; const size_t rb = (size_t)b * SEQ; const int r32 = lane & 31, hh = lane >> 5;
    const float slope2 = exp2f(-8.f * (float)(h + 1) / 6.f) * LOG2E;
    GroupRegs GR; group_issue(GR, PROJ + (rb + (size_t)n * 256) * PLD + C_BK + h * 64, PROJ + (rb + (size_t)n * 256) * PLD + C_BV + h * 64, tid);
    const int nvalid = cnt - chunk * 256 < 256 ? cnt - chunk * 256 : 256;
    const bool active = wave * 32 < nvalid;
    bool valid = true; int qpos = 0, slot = 0; bf16x8 qf[4];
    if (active) {
        int li = wave * 32 + r32; if (li >= nvalid) { li = nvalid - 1; valid = false; }
        const int p = chunk * 256 + li;
        const int cv = (lane > n) ? (int)CTAB[((size_t)bh * 64 + lane) * 64 + n] : 0; int inc = cv;
#pragma unroll
        for (int o2 = 1; o2 < 64; o2 <<= 1) { const int t2 = supi(inc, o2, lane); if (lane >= o2) inc += t2; }
        int qseg = 0;
#pragma unroll
        for (int stp = 32; stp >= 1; stp >>= 1) { const int v = shfi(inc, qseg + stp - 1); if (v <= p) qseg += stp; }
        const int idx = p - (shfi(inc, qseg) - shfi(cv, qseg));
        const unsigned e = LIST[moba_list_off(bh, n) + (size_t)(qseg - n - 1) * 256 + idx]; qpos = e & 0x3fff; slot = e >> 14;
#pragma unroll
        for (int s = 0; s < 4; ++s) qf[s] = *(const bf16x8*)(PROJ + (rb + qpos) * PLD + C_BQ + h * 64 + 16 * s + 8 * hh);
    }
    group_commit(GR, lds, tid);
    __syncthreads();
    if (active) {
        const int qrel = qpos - n * 256;
        const float rowterm = -slope2 * (float)qrel - B2;
        f32x16 o[2]; float l = 0.f;
#pragma unroll
        for (int r = 0; r < 16; ++r) { o[0][r] = 0.f; o[1][r] = 0.f; }
#ifndef REP_SUB
#define REP_SUB 0
#endif
#pragma unroll 1
        for (int rp = 0; rp <= REP_SUB; ++rp) {
        if (rp) { l = 0.f;
#pragma unroll
            for (int r = 0; r < 16; ++r) { o[0][r] = 0.f; o[1][r] = 0.f; } }
#pragma unroll 1
        for (int st = 0; st < 8; ++st) attn_subtile<false>(lds, nullptr, 32 * st, qf, rowterm, slope2, false, 0, o, l, lane);
        }
        l = half_sum(l, lane);
        moba_store(o, l, qpos, slot, valid, rb, h, OPART, LPART, Y, lane);
    }
    __syncthreads();
}
__device__ __forceinline__ void moba_sel_step(int huA, int S, LAS const int* pre, const unsigned* lcnt, const bf16* PROJ, const unsigned short* LIST, const unsigned* CTAB, bf16* OPART, float* LPART, bf16* Y,
                                              float B2, LAS unsigned char* lds, int tid, int wave, int lane) {
    const int r32 = lane & 31, hh = lane >> 5, half = wave >> 2, tile = wave & 3, htid = tid & 255;
    const int hu = huA + half; const bool uvalid = hu < S;
    int p = 0, chunk = 0, cnt = 0;
    if (uvalid) { int lo2 = 0, hi2 = 768; while (hi2 - lo2 > 1) { const int mid = (lo2 + hi2) >> 1; if (pre[mid] <= hu) lo2 = mid; else hi2 = mid; } p = lo2; chunk = hu - pre[lo2]; cnt = (int)lcnt[lo2]; }
    const int bh = p >> 6, n = p & 63, b = bh / 6, h = bh % 6; const size_t rb = (size_t)b * SEQ;
    const float slope2 = exp2f(-8.f * (float)(h + 1) / 6.f) * LOG2E;
    LAS unsigned char* kv = lds + half * 65536;
    v4u gk[8], gv[8];
    if (uvalid) { const bf16* Kg = PROJ + (rb + (size_t)n * 256) * PLD + C_BK + h * 64; const bf16* Vg = PROJ + (rb + (size_t)n * 256) * PLD + C_BV + h * 64;
#pragma unroll
        for (int i = 0; i < 8; ++i) { const int idx = htid + 256 * i, row = idx >> 3, ch = idx & 7; gk[i] = *(const v4u*)(Kg + (size_t)row * PLD + ch * 8); gv[i] = *(const v4u*)(Vg + (size_t)row * PLD + ch * 8); } }
    const int nvalid = uvalid ? (cnt - chunk * 128 < 128 ? cnt - chunk * 128 : 128) : 0;
    const bool active = tile * 32 < nvalid;
    bool valid = true; int qpos = 0, slot = 0; bf16x8 qf[4];
    if (active) {
        int li = tile * 32 + r32; if (li >= nvalid) { li = nvalid - 1; valid = false; }
        const int pos = chunk * 128 + li;
        const int cv = (lane > n) ? (int)CTAB[((size_t)bh * 64 + lane) * 64 + n] : 0; int inc = cv;
#pragma unroll
        for (int o2 = 1; o2 < 64; o2 <<= 1) { const int t2 = supi(inc, o2, lane); if (lane >= o2) inc += t2; }
        int qseg = 0;
#pragma unroll
        for (int stp = 32; stp >= 1; stp >>= 1) { const int v = shfi(inc, qseg + stp - 1); if (v <= pos) qseg += stp; }
        const int idx = pos - (shfi(inc, qseg) - shfi(cv, qseg));
        const unsigned e = LIST[moba_list_off(bh, n) + (size_t)(qseg - n - 1) * 256 + idx]; qpos = e & 0x3fff; slot = e >> 14;
#pragma unroll
        for (int s = 0; s < 4; ++s) qf[s] = *(const bf16x8*)(PROJ + (rb + qpos) * PLD + C_BQ + h * 64 + 16 * s + 8 * hh);
    }
    if (uvalid) {
#pragma unroll
        for (int i = 0; i < 8; ++i) { const int idx = htid + 256 * i, row = idx >> 3, ch = idx & 7;
            *(LAS v4u*)(kv + ATT_K0 + row * 128 + ((ch ^ ((row >> 1) & 7)) << 4)) = gk[i];
            *(LAS v4u*)(kv + ATT_V0 + row * 128 + ((ch * 16) ^ (((row >> 1) & 1) << 6))) = gv[i]; } }
    __syncthreads();
    if (active) {
        const int qrel = qpos - n * 256;
        const float rowterm = -slope2 * (float)qrel - B2;
        f32x16 o[2]; float l = 0.f;
#pragma unroll
        for (int r = 0; r < 16; ++r) { o[0][r] = 0.f; o[1][r] = 0.f; }
#pragma unroll 1
        for (int st = 0; st < 8; ++st) attn_subtile<false>(kv, nullptr, 32 * st, qf, rowterm, slope2, false, 0, o, l, lane);
        l = half_sum(l, lane);
        moba_store(o, l, qpos, slot, valid, rb, h, OPART, LPART, Y, lane);
    }
    __syncthreads();
}
__device__ __forceinline__ void moba_own_pair(int bh, int nA, int nB, const bf16* PROJ, bf16* OPART, float* LPART, bf16* Y, float B2, LAS unsigned char* lds, int tid, int wave, int lane) {
    const int b = bh / 6, h = bh % 6; const size_t rb = (size_t)b * SEQ; const int r32 = lane & 31, hh = lane >> 5;
    const float slope2 = exp2f(-8.f * (float)(h + 1) / 6.f) * LOG2E;
    GroupRegs GA, GB;
    group_issue(GA, PROJ + (rb + (size_t)nA * 256) * PLD + C_BK + h * 64, PROJ + (rb + (size_t)nA * 256) * PLD + C_BV + h * 64, tid);
    group_issue(GB, PROJ + (rb + (size_t)nB * 256) * PLD + C_BK + h * 64, PROJ + (rb + (size_t)nB * 256) * PLD + C_BV + h * 64, tid);
    bf16x8 qfA[4], qfB[4];
    { const size_t qa = rb + (size_t)nA * 256 + wave * 32 + r32, qb2 = rb + (size_t)nB * 256 + (7 - wave) * 32 + r32;
#pragma unroll
      for (int s = 0; s < 4; ++s) { qfA[s] = *(const bf16x8*)(PROJ + qa * PLD + C_BQ + h * 64 + 16 * s + 8 * hh); qfB[s] = *(const bf16x8*)(PROJ + qb2 * PLD + C_BQ + h * 64 + 16 * s + 8 * hh); } }
    group_commit(GA, lds, tid); group_commit(GB, lds + 65536, tid);
    __syncthreads();
    { const int tile = wave, qrel = tile * 32 + r32, qpos = nA * 256 + qrel;
      const float rowterm = -slope2 * (float)qrel - B2;
      f32x16 o[2]; float l = 0.f;
#pragma unroll
      for (int r = 0; r < 16; ++r) { o[0][r] = 0.f; o[1][r] = 0.f; }
#pragma unroll 1
      for (int st = 0; st <= tile; ++st) attn_subtile<false>(lds, nullptr, 32 * st, qfA, rowterm, slope2, st == tile, qrel, o, l, lane);
      l = half_sum(l, lane);
      moba_store(o, l, qpos, 3, true, rb, h, OPART, LPART, Y, lane); }
    { const int tile = 7 - wave, qrel = tile * 32 + r32, qpos = nB * 256 + qrel;
      const float rowterm = -slope2 * (float)qrel - B2;
      f32x16 o[2]; float l = 0.f;
#pragma unroll
      for (int r = 0; r < 16; ++r) { o[0][r] = 0.f; o[1][r] = 0.f; }
#pragma unroll 1
      for (int st = 0; st <= tile; ++st) attn_subtile<false>(lds + 65536, nullptr, 32 * st, qfB, rowterm, slope2, st == tile, qrel, o, l, lane);
      l = half_sum(l, lane);
      moba_store(o, l, qpos, 3, true, rb, h, OPART, LPART, Y, lane); }
    __syncthreads();
}

__device__ __forceinline__ void moba_combine(const unsigned* SEL, const bf16* OPART, const float* LPART, bf16* Y, bf16* Yo, int opitch, int ocol, int gtid, int ngt) {
    constexpr size_t NIT = (size_t)MROWS * 48;
    for (size_t base = gtid; base < NIT; base += (size_t)ngt * 4) {
        unsigned sel[4]; v4u yv[4]; float lo[4]; size_t row[4]; int hh4[4], c84[4]; bool ok[4];
#pragma unroll
        for (int j = 0; j < 4; ++j) { const size_t idx = base + (size_t)j * ngt; ok[j] = idx < NIT; const size_t ii = ok[j] ? idx : 0;
            row[j] = ii / 48; const int hc = (int)(ii % 48); hh4[j] = hc >> 3; c84[j] = (hc & 7) * 8;
            sel[j] = SEL[row[j] * 6 + hh4[j]]; yv[j] = *(const v4u*)(Y + row[j] * 1024 + Y_MOBA + hh4[j] * 64 + c84[j]); lo[j] = LPART[((size_t)3 * MROWS + row[j]) * 6 + hh4[j]]; }
        v4u pv[4][3]; float pl[4][3];
#pragma unroll
        for (int j = 0; j < 4; ++j)
#pragma unroll
            for (int k = 0; k < 3; ++k) { const bool v = ((sel[j] >> (8 * k)) & 0xff) != 255;
                pv[j][k] = v ? *(const v4u*)(OPART + ((size_t)k * MROWS + row[j]) * 384 + hh4[j] * 64 + c84[j]) : (v4u){0u, 0u, 0u, 0u};
                pl[j][k] = v ? LPART[((size_t)k * MROWS + row[j]) * 6 + hh4[j]] : 0.f; }
#pragma unroll
        for (int j = 0; j < 4; ++j) { float acc[8]; unpack8(yv[j], acc); float l = lo[j];
#pragma unroll
            for (int k = 0; k < 3; ++k) { float f[8]; unpack8(pv[j][k], f);
#pragma unroll
                for (int i = 0; i < 8; ++i) acc[i] += f[i];
                l += pl[j][k]; }
            const float rl = __builtin_amdgcn_rcpf(l);
            v4u w; w.x = pk2(acc[0] * rl, acc[1] * rl); w.y = pk2(acc[2] * rl, acc[3] * rl); w.z = pk2(acc[4] * rl, acc[5] * rl); w.w = pk2(acc[6] * rl, acc[7] * rl);
            if (ok[j]) *(v4u*)(Yo + row[j] * opitch + ocol + hh4[j] * 64 + c84[j]) = w; }
    }
}

__device__ __forceinline__ int vsw(int row, int colb) { return row * 128 + (colb ^ (((row >> 1) & 1) << 6)); }
__device__ __forceinline__ int ksw(int row, int ch) { return row * 128 + ((ch ^ ((row >> 1) & 7)) << 4); }
__device__ __forceinline__ void mlstm_m1_mfma(int ci, const MlP& P, LAS unsigned char* lds, int wave, int lane) {
    const int b = ci >> 10, h = (ci >> 8) & 3, c = ci & 255; const size_t row0 = (size_t)b * SEQ + c * 64;
    LAS unsigned char* Ki = lds + wave * 16384; LAS unsigned char* Vi = Ki + 8192;
    float wv;
    { const size_t row = row0 + lane;
      const float fi = P.GATES[row * 16 + 6 + h] + P.ibias[h], ff = P.GATES[row * 16 + 10 + h] + P.fbias[h];
      float bc = log_sigmoid_fast(ff);
#pragma unroll
      for (int o = 1; o < 64; o <<= 1) { const float n = sup(bc, o, lane); if (lane >= o) bc += n; }
      const float bend = shf(bc, 63);
      const float wl = bend - bc + fi; const float mloc = wave_max(wl);
      wv = exp_fast(wl - mloc);
      if (lane == 0) { P.BEND[ci] = bend; P.MLOC[ci] = mloc; } }
#pragma unroll
    for (int i = 0; i < 8; ++i) { const int idx = lane + 64 * i, r = idx >> 3, ch = idx & 7;
        const v4u kk = *(const v4u*)(P.KC + (row0 + r) * 256 + h * 64 + ch * 8);
        *(LAS v4u*)(Ki + vsw(r, ch * 16)) = kk;
        float f[8]; unpack8(*(const v4u*)(P.PROJ + (row0 + r) * PLD + C_MV + h * 64 + ch * 8), f);
        const float w = shf(wv, r);
        v4u o; o.x = pk2(f[0] * w, f[1] * w); o.y = pk2(f[2] * w, f[3] * w); o.z = pk2(f[4] * w, f[5] * w); o.w = pk2(f[6] * w, f[7] * w);
        *(LAS v4u*)(Vi + vsw(r, ch * 16)) = o; }
    LDS_WAIT(); asm volatile("" ::: "memory");
    { float nu = 0.f;
#pragma unroll 8
      for (int s = 0; s < 64; ++s) { const float ws = shf(wv, s); nu += ws * bf2f(*(LAS const unsigned short*)(Ki + vsw(s, 2 * lane))); }
      P.NU[(size_t)ci * 64 + lane] = nu; }
    f32x16 D[2][2];
#pragma unroll
    for (int a = 0; a < 2; ++a)
#pragma unroll
        for (int e = 0; e < 2; ++e)
#pragma unroll
            for (int r = 0; r < 16; ++r) D[a][e][r] = 0.f;
    const int i16 = lane & 15, cc = (lane >> 4) & 1, hh = lane >> 5, r32 = lane & 31;
#pragma unroll
    for (int ks = 0; ks < 4; ++ks) { const int rowv = 16 * ks + 4 * hh + (i16 >> 2);
        bf16x8 af[2], bfr[2];
#pragma unroll
        for (int blk = 0; blk < 2; ++blk) { const int colb = (32 * blk + 16 * cc + 4 * (i16 & 3)) * 2;
            { const s16x4 lo = vtr(Vi + vsw(rowv, colb)), hi = vtr(Vi + vsw(rowv, colb) + 1024); af[blk] = (bf16x8){lo[0], lo[1], lo[2], lo[3], hi[0], hi[1], hi[2], hi[3]}; }
            { const s16x4 lo = vtr(Ki + vsw(rowv, colb)), hi = vtr(Ki + vsw(rowv, colb) + 1024); bfr[blk] = (bf16x8){lo[0], lo[1], lo[2], lo[3], hi[0], hi[1], hi[2], hi[3]}; } }
#pragma unroll
        for (int a = 0; a < 2; ++a)
#pragma unroll
            for (int e = 0; e < 2; ++e) D[a][e] = __builtin_amdgcn_mfma_f32_32x32x16_bf16(af[a], bfr[e], D[a][e], 0, 0, 0); }
    float* up = P.U + (size_t)ci * 4096;
#pragma unroll
    for (int a = 0; a < 2; ++a)
#pragma unroll
        for (int e = 0; e < 2; ++e)
#pragma unroll
            for (int r = 0; r < 16; ++r) up[(32 * a + crow(r, hh)) * 64 + 32 * e + r32] = D[a][e][r];
    LDS_WAIT(); asm volatile("" ::: "memory");
}

__device__ __forceinline__ void mlstm_m3_mfma(int it, const MlP& P, LAS unsigned char* lds, int tid, int wave, int lane) {
    const int cs = wave >> 1, tile = wave & 1, ci = it * 4 + cs;
    const int b = ci >> 10, h = (ci >> 8) & 3, c = ci & 255; const size_t row0 = (size_t)b * SEQ + c * 64;
    LAS unsigned char* Ki = lds + cs * 32768; LAS unsigned char* Vi = Ki + 8192; LAS unsigned char* Ci = Ki + 16384; LAS unsigned char* Mi = Ki + 24576;
    LAS float* tab = (LAS float*)(lds + ATT_TAB) + cs * 256;
    const float ms = P.MS[ci];
    { const int pt = tile * 64 + lane;
#pragma unroll
      for (int i = 0; i < 4; ++i) { const int idx = pt + 128 * i, r = idx >> 3, ch = idx & 7;
          *(LAS v4u*)(Ki + ksw(r, ch)) = *(const v4u*)(P.KC + (row0 + r) * 256 + h * 64 + ch * 8);
          *(LAS v4u*)(Vi + vsw(r, ch * 16)) = *(const v4u*)(P.PROJ + (row0 + r) * PLD + C_MV + h * 64 + ch * 8);
          *(LAS v4u*)(Ci + ksw(r, ch)) = *(const v4u*)(P.CS + (size_t)ci * 4096 + r * 64 + ch * 8);
          *(LAS v4u*)(Mi + r * 128 + ch * 16) = *(const v4u*)(P.PROJ + (row0 + r) * PLD + C_MO + h * 64 + ch * 8); } }
    if (tile == 0) {
        const size_t row = row0 + lane;
        const float fi = P.GATES[row * 16 + 6 + h] + P.ibias[h], ff = P.GATES[row * 16 + 10 + h] + P.fbias[h];
        float bc = log_sigmoid_fast(ff);
#pragma unroll
        for (int o = 1; o < 64; o <<= 1) { const float n = sup(bc, o, lane); if (lane >= o) bc += n; }
        const float a = fi - bc; float pm = a;
#pragma unroll
        for (int o = 1; o < 64; o <<= 1) { const float n = sup(pm, o, lane); if (lane >= o) pm = fmaxf(pm, n); }
        tab[lane] = a * LOG2E; tab[64 + lane] = fmaxf(ms, pm); tab[128 + lane] = bc; tab[192 + lane] = P.NS[(size_t)ci * 64 + lane];
    }
    __syncthreads();
    const int r32 = lane & 31, hh = lane >> 5, j = 32 * tile + r32;
    bf16x8 qf[4];
#pragma unroll
    for (int s = 0; s < 4; ++s) qf[s] = *(const bf16x8*)(P.QC + (row0 + j) * 256 + h * 64 + 16 * s + 8 * hh);
    const float gj = tab[64 + j], inter = exp_fast(ms - gj), rowterm2 = -gj * LOG2E;
    f32x16 o[2]; float l = 0.f;
#pragma unroll
    for (int r = 0; r < 16; ++r) { o[0][r] = 0.f; o[1][r] = 0.f; }
    for (int st = 0; st <= tile; ++st) {
        const int j0 = 32 * st;
        f32x16 acc;
#pragma unroll
        for (int r = 0; r < 16; ++r) acc[r] = 0.f;
#pragma unroll
        for (int s = 0; s < 4; ++s) { const bf16x8 kf = *(LAS const bf16x8*)(Ki + ksw(j0 + r32, 2 * s + hh)); acc = __builtin_amdgcn_mfma_f32_32x32x16_bf16(kf, qf[s], acc, 0, 0, 0); }
        float ls = 0.f;
#pragma unroll
        for (int g4 = 0; g4 < 4; ++g4) { const f32x4 c4 = *(LAS const f32x4*)(tab + j0 + 8 * g4 + 4 * hh);
#pragma unroll
            for (int ii = 0; ii < 4; ++ii) { const int reg = 4 * g4 + ii, key = j0 + 8 * g4 + 4 * hh + ii;
                float p = acc[reg] * __builtin_amdgcn_exp2f(rowterm2 + c4[ii]);
                if (st == tile && key > j) p = 0.f;
                acc[reg] = p; ls += p; } }
        l += ls;
        bf16x8 pa[2];
#pragma unroll
        for (int s = 0; s < 2; ++s) { v4u w; w.x = cvtpk(acc[8 * s + 0], acc[8 * s + 1]); w.y = cvtpk(acc[8 * s + 2], acc[8 * s + 3]); w.z = cvtpk(acc[8 * s + 4], acc[8 * s + 5]); w.w = cvtpk(acc[8 * s + 6], acc[8 * s + 7]); pa[s] = __builtin_bit_cast(bf16x8, w); }
        { const int i16 = lane & 15, cc = (lane >> 4) & 1;
#pragma unroll
          for (int db = 0; db < 2; ++db)
#pragma unroll
              for (int s = 0; s < 2; ++s) { const int rowv = j0 + 16 * s + 4 * hh + (i16 >> 2); const int colb = (32 * db + 16 * cc + 4 * (i16 & 3)) * 2;
                  LAS const unsigned char* vp = Vi + vsw(rowv, colb);
                  const s16x4 lo = vtr(vp), hi = vtr(vp + 1024);
                  const bf16x8 vf = (bf16x8){lo[0], lo[1], lo[2], lo[3], hi[0], hi[1], hi[2], hi[3]};
                  o[db] = __builtin_amdgcn_mfma_f32_32x32x16_bf16(pa[s], vf, o[db], 0, 0, 0); } }
    }
    float dn = 0.f;
#pragma unroll
    for (int s = 0; s < 4; ++s) { float f[8]; unpack8(__builtin_bit_cast(v4u, qf[s]), f);
        const f32x4 n0 = *(LAS const f32x4*)(tab + 192 + 16 * s + 8 * hh), n1 = *(LAS const f32x4*)(tab + 192 + 16 * s + 8 * hh + 4);
        dn += (f[0] * n0.x + f[1] * n0.y) + (f[2] * n0.z + f[3] * n0.w) + (f[4] * n1.x + f[5] * n1.y) + (f[6] * n1.z + f[7] * n1.w);
        v4u w; w.x = cvtpk(f[0] * inter, f[1] * inter); w.y = cvtpk(f[2] * inter, f[3] * inter); w.z = cvtpk(f[4] * inter, f[5] * inter); w.w = cvtpk(f[6] * inter, f[7] * inter);
        const bf16x8 qs = __builtin_bit_cast(bf16x8, w);
#pragma unroll
        for (int db = 0; db < 2; ++db) { const bf16x8 cf = *(LAS const bf16x8*)(Ci + ksw(32 * db + r32, 2 * s + hh)); o[db] = __builtin_amdgcn_mfma_f32_32x32x16_bf16(qs, cf, o[db], 0, 0, 0); } }
    dn = half_sum(dn, lane); l = half_sum(l, lane);
    const float den = inter * dn + l, mj = tab[128 + j] + gj;
    const float rd = __builtin_amdgcn_rcpf(fmaxf(fabsf(den), exp_fast(-mj)));
    const float hg0 = P.hg[h * 64 + r32], hg1 = P.hg[h * 64 + 32 + r32];
    unsigned short mo0[16], mo1[16];
#pragma unroll
    for (int r = 0; r < 16; ++r) { LAS const unsigned short* mq = (LAS const unsigned short*)(Mi + (32 * tile + crow(r, hh)) * 128) + r32; mo0[r] = mq[0]; mo1[r] = mq[32]; }
#pragma unroll
    for (int r = 0; r < 16; ++r) { const int src = crow(r, hh); const float rdr = shf(rd, src);
        const float h0 = o[0][r] * rdr, h1 = o[1][r] * rdr; float ss = h0 * h0 + h1 * h1;
        ss += SWZ_X(ss, 1); ss += SWZ_X(ss, 2); ss += SWZ_X(ss, 4); ss += SWZ_X(ss, 8); ss += SWZ_X(ss, 16);
        const float rr = __builtin_amdgcn_rsqf(ss * (1.f / 64.f) + EPS);
        LAS unsigned short* mp = (LAS unsigned short*)(Mi + (32 * tile + src) * 128) + r32;
        const float e0 = __builtin_amdgcn_exp2f(-bf2f(mo0[r]) * LOG2E), e1 = __builtin_amdgcn_exp2f(-bf2f(mo1[r]) * LOG2E);
        mp[0] = (unsigned short)f2bf(h0 * rr * hg0 * __builtin_amdgcn_rcpf(1.f + e0));
        mp[32] = (unsigned short)f2bf(h1 * rr * hg1 * __builtin_amdgcn_rcpf(1.f + e1)); }
    LDS_WAIT(); asm volatile("" ::: "memory");
#pragma unroll
    for (int i = 0; i < 4; ++i) { const int rw = (lane >> 3) + 8 * i, ch = lane & 7;
        *(v4u*)(P.Y + (row0 + 32 * tile + rw) * 1024 + Y_ML + h * 64 + ch * 8) = *(LAS const v4u*)(Mi + (32 * tile + rw) * 128 + ch * 16); }
    __syncthreads();
}

__device__ __forceinline__ void top3_ins(float g, int n, float& v0, float& v1, float& v2, int& i0, int& i1, int& i2) {
    const bool c0 = g > v0, c1 = g > v1, c2 = g > v2;
    const float nv2 = c1 ? v1 : (c2 ? g : v2); const int ni2 = c1 ? i1 : (c2 ? n : i2);
    const float nv1 = c0 ? v0 : (c1 ? g : v1); const int ni1 = c0 ? i0 : (c1 ? n : i1);
    v0 = c0 ? g : v0; i0 = c0 ? n : i0; v1 = nv1; i1 = ni1; v2 = nv2; i2 = ni2;
}
__device__ __forceinline__ void moba_gate_mfma(int u, const bf16* PROJ, const float* KMEAN, unsigned* SEL, unsigned* LCNT, unsigned* CTAB, unsigned short* LIST, float B2, float thresh2,
                                               LAS unsigned char* lds, int tid, int wave, int lane) {
    const int bh = u >> 6, qb = 63 - (u & 63), b = bh / 6, h = bh % 6; const int r32 = lane & 31, hh = lane >> 5;
    LAS unsigned char* Khi = lds; LAS unsigned char* Klo = lds + 8192; LAS unsigned* cntl = (LAS unsigned*)(lds + 16384);
    if (tid < 64) cntl[tid] = 0u;
    { const int n = tid >> 3, ch = tid & 7; float f[8];
      if (n < qb) { const float* k0 = KMEAN + ((size_t)bh * NBLK + n) * 64 + ch * 8; const float* k1 = k0 + (size_t)(12 * NBLK * 64);
          const f32x4 a0 = *(const f32x4*)k0, a1 = *(const f32x4*)(k0 + 4), b0 = *(const f32x4*)k1, b1 = *(const f32x4*)(k1 + 4);
          f[0] = a0.x + b0.x; f[1] = a0.y + b0.y; f[2] = a0.z + b0.z; f[3] = a0.w + b0.w; f[4] = a1.x + b1.x; f[5] = a1.y + b1.y; f[6] = a1.z + b1.z; f[7] = a1.w + b1.w; }
      else {
#pragma unroll
          for (int i = 0; i < 8; ++i) f[i] = 0.f; }
      unsigned hi[8]; float lo[8];
#pragma unroll
      for (int i = 0; i < 8; ++i) { hi[i] = f2bf(f[i]); lo[i] = f[i] - bf2f((unsigned short)hi[i]); }
      v4u wh; wh.x = hi[0] | (hi[1] << 16); wh.y = hi[2] | (hi[3] << 16); wh.z = hi[4] | (hi[5] << 16); wh.w = hi[6] | (hi[7] << 16);
      v4u wl; wl.x = pk2(lo[0], lo[1]); wl.y = pk2(lo[2], lo[3]); wl.z = pk2(lo[4], lo[5]); wl.w = pk2(lo[6], lo[7]);
      *(LAS v4u*)(Khi + ksw(n, ch)) = wh; *(LAS v4u*)(Klo + ksw(n, ch)) = wl; }
    const int query = wave * 32 + r32; const size_t row = (size_t)b * SEQ + qb * 256 + query;
    bf16x8 qf[4];
#pragma unroll
    for (int s = 0; s < 4; ++s) qf[s] = *(const bf16x8*)(PROJ + row * PLD + C_BQ + h * 64 + 16 * s + 8 * hh);
    __syncthreads();
    float v0 = -INFINITY, v1 = -INFINITY, v2 = -INFINITY; int i0 = 255, i1 = 255, i2 = 255;
#pragma unroll 1
    for (int st = 0; st < 2; ++st) {
        if (32 * st >= qb) break;
        f32x16 acc;
#pragma unroll
        for (int r = 0; r < 16; ++r) acc[r] = 0.f;
#pragma unroll
        for (int s = 0; s < 4; ++s) { const bf16x8 kh = *(LAS const bf16x8*)(Khi + ksw(32 * st + r32, 2 * s + hh)), kl = *(LAS const bf16x8*)(Klo + ksw(32 * st + r32, 2 * s + hh));
            acc = __builtin_amdgcn_mfma_f32_32x32x16_bf16(kh, qf[s], acc, 0, 0, 0); acc = __builtin_amdgcn_mfma_f32_32x32x16_bf16(kl, qf[s], acc, 0, 0, 0); }
#pragma unroll
        for (int r = 0; r < 16; ++r) { const int n = 32 * st + crow(r, hh); if (n < qb) top3_ins(acc[r], n, v0, v1, v2, i0, i1, i2); }
    }
    { const int pl = lane ^ 32;
      const float w0 = shf(v0, pl), w1 = shf(v1, pl), w2 = shf(v2, pl); const int j0 = shfi(i0, pl), j1 = shfi(i1, pl), j2 = shfi(i2, pl);
      if (j0 != 255) top3_ins(w0, j0, v0, v1, v2, i0, i1, i2);
      if (j1 != 255) top3_ins(w1, j1, v0, v1, v2, i0, i1, i2);
      if (j2 != 255) top3_ins(w2, j2, v0, v1, v2, i0, i1, i2); }
    if (hh == 0) {
        { const float slope2 = exp2f(-8.f * (float)(h + 1) / 6.f) * LOG2E; const float lim = (2.f * B2 + thresh2) / slope2; const int t0 = qb * 256 + query - 255;
          if (i0 != 255 && (float)(t0 - i0 * 256) > lim) i0 = 255;
          if (i1 != 255 && (float)(t0 - i1 * 256) > lim) i1 = 255;
          if (i2 != 255 && (float)(t0 - i2 * 256) > lim) i2 = 255; }
        SEL[row * 6 + h] = (unsigned)i0 | ((unsigned)i1 << 8) | ((unsigned)i2 << 16);
        if (LIST) { const unsigned t = (unsigned)(qb * 256 + query);
            if (i0 != 255) { const unsigned pos = __hip_atomic_fetch_add(cntl + i0, 1u, __ATOMIC_RELAXED, __HIP_MEMORY_SCOPE_WORKGROUP); LIST[moba_list_off(bh, i0) + (size_t)(qb - i0 - 1) * 256 + pos] = (unsigned short)(t | (0u << 14)); }
            if (i1 != 255) { const unsigned pos = __hip_atomic_fetch_add(cntl + i1, 1u, __ATOMIC_RELAXED, __HIP_MEMORY_SCOPE_WORKGROUP); LIST[moba_list_off(bh, i1) + (size_t)(qb - i1 - 1) * 256 + pos] = (unsigned short)(t | (1u << 14)); }
            if (i2 != 255) { const unsigned pos = __hip_atomic_fetch_add(cntl + i2, 1u, __ATOMIC_RELAXED, __HIP_MEMORY_SCOPE_WORKGROUP); LIST[moba_list_off(bh, i2) + (size_t)(qb - i2 - 1) * 256 + pos] = (unsigned short)(t | (2u << 14)); } }
    }
    __syncthreads();
    if (LIST && tid < 64) { const unsigned c = cntl[tid]; CTAB[((size_t)bh * 64 + qb) * 64 + tid] = c; if (c) atomicAdd(LCNT + bh * 64 + tid, c); }
    __syncthreads();
}
#ifndef FOX_MFMA
#define FOX_MFMA 1
#endif
#ifndef MOBA_MFMA
#define MOBA_MFMA 1
#endif
#ifndef REP_P0
#define REP_P0 0
#endif
#ifndef REP_NORM
#define REP_NORM 0
#endif
#ifndef REP_GIN
#define REP_GIN 0
#endif
#ifndef REP_FOX
#define REP_FOX 0
#endif
#ifndef REP_M1
#define REP_M1 0
#endif
#ifndef REP_MIXB
#define REP_MIXB 0
#endif
#ifndef REP_M3
#define REP_M3 0
#endif
#ifndef REP_GGU
#define REP_GGU 0
#endif
#ifndef REP_GATE
#define REP_GATE 0
#endif
#ifndef REP_CONV
#define REP_CONV 0
#endif
#ifndef REP_FCUM
#define REP_FCUM 0
#endif
#ifndef REP_QKN
#define REP_QKN 0
#endif
#ifndef REP_GOUT
#define REP_GOUT 0
#endif
#ifndef REP_GDN
#define REP_GDN 0
#endif
#ifndef REP_COMB
#define REP_COMB 0
#endif
#ifndef REP_BAR
#define REP_BAR 0
#endif
#ifndef REP_GATE2
#define REP_GATE2 0
#endif
#ifndef ML_MFMA
#define ML_MFMA 1
#endif
#ifndef REP_M2
#define REP_M2 0
#endif
#ifndef FOX_OLD
#define FOX_OLD 0
#endif
#if FOX_OLD
#define FOX_FN fox_unit_old
#else
#define FOX_FN fox_unit
#endif
#ifndef REP_PRE
#define REP_PRE 0
#endif
#ifndef GGU_ALIGN
#define GGU_ALIGN true
#endif
#ifndef GGU_SP2
#define GGU_SP2 true
#endif
#ifndef GIN_ALIGN
#define GIN_ALIGN true
#endif
#ifndef GIN_SP2
#define GIN_SP2 true
#endif
#ifndef N_LAUNCH_MODE
#define N_LAUNCH_MODE 1
#endif
constexpr int NPHASE = 2 + 8 * DEPTH;
struct Args { const float* in[20]; float* out; unsigned char* ws; int ph_lo, ph_hi; };
static_assert(sizeof(Args) == 20 * 8 + 8 + 8 + 8, "Args has no padding");

__global__ void __launch_bounds__(NTHREADS, 2) fwd(Args args) {
    extern __shared__ __attribute__((aligned(16))) unsigned char lds_raw[];
    LAS unsigned char* lds = (LAS unsigned char*)lds_raw;
    LAS float* ldsf = (LAS float*)lds_raw;
    volatile LAS unsigned* MISC = (volatile LAS unsigned*)(lds + MISC_OFF);
    const int G = gridDim.x; const int bx = blockIdx.x; const int vcu = (G % 8 == 0) ? (bx % 8) * (G / 8) + bx / 8 : bx;
    const int NGW = G * NWAVES;
#define PH_IDS() int tid = threadIdx.x; asm volatile("" : "+v"(tid)); const int lane = tid & 63, wave = __builtin_amdgcn_readfirstlane(tid >> 6); const int gw = vcu * NWAVES + wave; (void)lane; (void)gw; \
    unsigned char* ws = ws_k; asm volatile("" : "+s"(ws)); gu32* ctl = (gu32*)(ws + WS_CTL); (void)ctl
    unsigned char* const ws_k = args.ws;
    gu32* ctl0 = (gu32*)(ws_k + WS_CTL);
    for (int u = threadIdx.x; u < (LDS_BYTES - LDSCTL_OFF) / 4; u += NTHREADS) ((LAS unsigned*)(lds + LDSCTL_OFF))[u] = 0u;
    __syncthreads();
    XcdBarrier bar; bar.bar = (unsigned*)(ctl0 + CW_BAR); bar.x = 0; bar.st = nullptr;
    if (N_LAUNCH_MODE == 1) bar = xcd_barrier_post((unsigned*)(ctl0 + CW_BAR), MISC + 8);
    const int lo = args.ph_lo, hi = args.ph_hi;
#ifndef PHMASK
#define PHMASK 0xfff
#endif
#define PHEN(j) ((PHMASK >> (j)) & 1)
#define IN(k) ((N_LAUNCH_MODE == 1) || (lo <= (k) && (k) < hi))
#define SEAM(k) do { if (IN(k) && IN((k) + 1)) { xcd_barrier(bar); for (int rb_ = 0; rb_ < REP_BAR; ++rb_) xcd_barrier(bar); } } while (0)

#define PRM(k) (*(const float* const volatile*)(ws + WS_PTAB + 8 * (k)))
#define x_in PRM(0)
#define norm1_g PRM(4)
#define norm2_g PRM(5)
#define fox_f_bias PRM(7)
#define fox_q_g PRM(8)
#define fox_k_g PRM(9)
#define ml_conv_w PRM(10)
#define ml_conv_b PRM(11)
#define ml_i_bias PRM(12)
#define ml_f_bias PRM(13)
#define ml_h_g PRM(14)
#define moba_q_g PRM(15)
#define moba_k_g PRM(16)
#define xres ((float*)PRM(20))
#define MOD ((float*)(ws + WS_MOD))
#define XN ((bf16*)(ws + WS_XN))
#define PROJ ((bf16*)(ws + WS_PROJ))
#define HB ((bf16*)(ws + WS_H))
#define Y ((bf16*)(ws + WS_Y))
#define GATES ((float*)(ws + WS_GATES))
#define FOXCUM ((float*)(ws + WS_FOXCUM))
#define KMEAN ((float*)(ws + WS_KMEAN))
#define QC ((bf16*)(ws + WS_QC))
#define KC ((bf16*)(ws + WS_KC))
#define SEL ((unsigned*)(ws + WS_SEL))
#define mod_l (MOD + (size_t)l * 2 * 6144)
#define MK_MP() const float* const ib_ = ml_i_bias; const float* const fb_ = ml_f_bias; const float* const hg_ = ml_h_g; \
    MlP MP{PROJ, QC, KC, GATES, (float*)(ws + WS_U), (float*)(ws + WS_NU), (float*)(ws + WS_BEND), (float*)(ws + WS_MLOC), (bf16*)(ws + WS_CS), (float*)(ws + WS_NS), (float*)(ws + WS_MS), Y, ib_ + l * 4, fb_ + l * 4, hg_ + l * 256}

    for (int rep = 0; rep <= REP_P0; ++rep)
    if (PHEN(10) && IN(0)) { PH_IDS();
        const float* cvec = args.in[1]; const float* w_ada = args.in[2]; const float* b_ada = args.in[3]; const float* w_in = args.in[6];
        const float* w_out = args.in[17]; const float* w_gate_up = args.in[18]; const float* w_down = args.in[19];
        if (blockIdx.x == 0 && tid == 0) { const float** pt = (const float**)(ws + WS_PTAB);
            pt[0] = args.in[0]; pt[4] = args.in[4]; pt[5] = args.in[5]; pt[7] = args.in[7]; pt[8] = args.in[8]; pt[9] = args.in[9]; pt[10] = args.in[10]; pt[11] = args.in[11]; pt[12] = args.in[12];
            pt[13] = args.in[13]; pt[14] = args.in[14]; pt[15] = args.in[15]; pt[16] = args.in[16]; pt[20] = args.out; }
        if (vcu < 192) p0_mod_unit(vcu, cvec, w_ada, b_ada, MOD, ldsf, tid, wave, lane);
        LAS float* scr = (LAS float*)(lds + wave * 16384);
        constexpr int I_IN = 16 * (NIN / 32), I_OUT = 16 * (DM / 32), I_GU = 16 * (NGU / 32), I_DN = (DFF / 64) * (DM / 32), I_L = I_IN + I_OUT + I_GU + I_DN;
        for (int it = gw; it < DEPTH * I_L; it += NGW) {
            const int l = it / I_L; int r = it % I_L;
            if (r < I_IN) { transpose_item<1>(w_in + (size_t)l * DM * INC, DM, INC, (bf16*)(ws + WS_WIN + l * WIN_BYTES), scr, NIN / 32, r, lane); continue; } r -= I_IN;
            if (r < I_OUT) { transpose_item<0>(w_out + (size_t)l * DM * DM, DM, DM, (bf16*)(ws + WS_WOUT + l * WOUT_BYTES), scr, DM / 32, r, lane); continue; } r -= I_OUT;
            if (r < I_GU) { transpose_item<2>(w_gate_up + (size_t)l * DM * NGU, DM, NGU, (bf16*)(ws + WS_WGU + l * WGU_BYTES), scr, NGU / 32, r, lane); continue; } r -= I_GU;
            transpose_item<0>(w_down + (size_t)l * DFF * DM, DFF, DM, (bf16*)(ws + WS_WDN + l * WDN_BYTES), scr, DM / 32, r, lane);
        }
        if (REP_P0) __syncthreads();
    }
    SEAM(0);
    for (int rep = 0; rep <= REP_PRE; ++rep)
    if (PHEN(11) && IN(1)) { PH_IDS();
        const float* n1g = norm1_g; const float* n2g = norm2_g;
        pre_rows(x_in, n1g, MOD, XN, (float*)(ws + WS_SSP), gw, NGW, lane);
        pre_avec(n1g, n2g, MOD, (float*)(ws + WS_AVEC), vcu * NTHREADS + tid, G * NTHREADS);
        for (int l = 0; l < DEPTH; ++l) {
            const float* m0 = MOD + (size_t)l * 2 * 6144; const float* m1 = m0 + 6144;
            pre_bias((const bf16*)(ws + WS_WIN + l * WIN_BYTES), NIN, m0, m1, (float*)(ws + WS_BIASIN) + (size_t)l * 2 * NIN, (float*)(ws + WS_BIASIN) + (size_t)l * 2 * NIN + NIN, gw, NGW, lane);
            pre_bias((const bf16*)(ws + WS_WGU + l * WGU_BYTES), NGU, m0 + 3072, m1 + 3072, (float*)(ws + WS_BIASGU) + (size_t)l * 2 * NGU, (float*)(ws + WS_BIASGU) + (size_t)l * 2 * NGU + NGU, gw, NGW, lane);
        }
    }
    SEAM(1);

    for (int l = 0; l < DEPTH; ++l) {
        const int pb = 2 + 8 * l;
        for (int rep = 0; rep <= REP_GIN; ++rep)
        if (PHEN(0) && IN(pb + 0)) { PH_IDS();
            pg8::Gemm g{XN, (const bf16*)(ws + WS_WIN + l * WIN_BYTES), MROWS, NIN, DM}; pg8::StaticOrder S; S.init(MROWS, NIN, G, bx);
            LAS float* rt = (LAS float*)(lds + ATT_TAB); LAS float* bt = rt + 512;
            const int pm0 = rstd_tables(S, (const float*)(ws + WS_SSP), rt, (const float*)(ws + WS_BIASIN) + (size_t)l * 2 * NIN, NIN, bt, tid);
            pg8::EpiProj E{PROJ, GATES, PLD, rt, pm0, bt};
            pg8::gemm_phase<pg8::EpiProj, pg8::StaticOrder, GIN_ALIGN, GIN_SP2>(lds, g, S, E, tid);
        }
        SEAM(pb + 0);
        if (PHEN(1) && IN(pb + 1)) { PH_IDS();
            for (int u = vcu; u < 524; u += G) {
                if (u < 12) post_foxcum_unit(u, GATES, FOXCUM, fox_f_bias + l * 6, ldsf, tid, wave, lane);
                else if (u < 268) post_qknorm_unit(u - 12, PROJ, KMEAN, fox_q_g + l * 64, fox_k_g + l * 64, moba_q_g + l * 64, moba_k_g + l * 64, ldsf, tid, wave, lane);
                else { const int which = (u - 268) & 1; post_conv_unit((u - 268) >> 1, which, PROJ, which ? KC : QC, ml_conv_w + l * 4 * 512, ml_conv_b + l * 512, tid); }
            }
            for (int rep = 0; rep < REP_CONV; ++rep) for (int u = vcu; u < 256; u += G) { const int which = u & 1; post_conv_unit(u >> 1, which, PROJ, which ? KC : QC, ml_conv_w + l * 4 * 512, ml_conv_b + l * 512, tid); }
            for (int rep = 0; rep < REP_FCUM; ++rep) for (int u = vcu; u < 12; u += G) post_foxcum_unit(u, GATES, FOXCUM, fox_f_bias + l * 6, ldsf, tid, wave, lane);
        }
        SEAM(pb + 1);
        if (PHEN(2) && IN(pb + 2)) { PH_IDS(); MK_MP();
            const float B2m = 8.f * LOG2E * wave_max(fabsf(moba_q_g[l * 64 + lane])) * wave_max(fabsf(moba_k_g[l * 64 + lane])) * 1.01f;
            unsigned* LCNT = (unsigned*)(ctl + CW_LCNT + l * 768); unsigned short* LIST = MOBA_MFMA ? (unsigned short*)(ws + WS_LIST) : nullptr;
#if ML_MFMA
#ifndef GATE_MFMA
#define GATE_MFMA 1
#endif
#if GATE_MFMA
            for (int u = vcu; u < 768; u += G) moba_gate_mfma(u, PROJ, KMEAN, SEL, LCNT, (unsigned*)(ws + WS_CTAB), LIST, B2m, THRESH2, lds, tid, wave, lane);
#else
            for (int u = vcu; u < 768; u += G) moba_gate_unit(u, PROJ, KMEAN, SEL, LCNT, (unsigned*)(ws + WS_CTAB), LIST, B2m, THRESH2, ldsf, tid);
#endif
            for (int u = gw; u < 2048; u += NGW) mlstm_m1_mfma(u, MP, lds, wave, lane);
            __syncthreads();
#else
            for (int u = vcu; u < 768 + 2048; u += G) {
                if (u < 768) moba_gate_unit(u, PROJ, KMEAN, SEL, LCNT, (unsigned*)(ws + WS_CTAB), LIST, B2m, THRESH2, ldsf, tid);
                else mlstm_m1(u - 768, MP, ldsf, tid, wave, lane);
            }
#endif
            for (int rep = 0; rep < REP_GATE; ++rep) for (int u = vcu; u < 768; u += G) moba_gate_unit(u, PROJ, KMEAN, SEL, LCNT, (unsigned*)(ws + WS_CTAB), nullptr, B2m, THRESH2, ldsf, tid);
            for (int rep = 0; rep < REP_GATE2; ++rep) for (int u = vcu; u < 768; u += G) moba_gate_unit(u, PROJ, KMEAN, SEL, LCNT + 4096, (unsigned*)(ws + WS_OPART + 32 * MiB), (unsigned short*)(ws + WS_OPART), B2m, THRESH2, ldsf, tid);
            for (int rep = 0; rep < REP_M1; ++rep) for (int u = vcu; u < 2048; u += G) mlstm_m1(u, MP, ldsf, tid, wave, lane);
#if FOX_MFMA
            { const float gq = wave_max(fabsf(fox_q_g[l * 64 + lane])), gk = wave_max(fabsf(fox_k_g[l * 64 + lane])); const float B2 = 8.f * LOG2E * gq * gk * 1.01f;
              for (int rep = 0; rep <= REP_FOX; ++rep)
              for (int u = vcu; u < 768; u += G) FOX_FN(u >> 6, 63 - (u & 63), PROJ, FOXCUM, Y, B2, lds, tid, wave, lane); }
#else
            fox_naive(PROJ, FOXCUM, Y, gw, NGW, lane);
#endif
        }
        SEAM(pb + 2);
        for (int rep = 0; rep <= REP_MIXB; ++rep)
        if (PHEN(3) && IN(pb + 3)) { PH_IDS(); MK_MP();
            for (int rep = 0; rep <= REP_M2; ++rep)
            for (int u = vcu; u < 64; u += G) mlstm_m2(u, MP, ldsf, tid, wave, lane);
#if MOBA_MFMA
            { const float gq = wave_max(fabsf(moba_q_g[l * 64 + lane])), gk = wave_max(fabsf(moba_k_g[l * 64 + lane])); const float B2 = 8.f * LOG2E * gq * gk * 1.01f;
              LAS int* pre = (LAS int*)(lds + ATT_TAB + 1024);
              const unsigned* lcnt = (const unsigned*)(ctl + CW_LCNT + l * 768);
              if (wave == 0) { int carry = 0;
                  for (int r = 0; r < 12; ++r) { const int p = r * 64 + lane; int x = (int)((lcnt[p] + 127u) >> 7);
#pragma unroll
                      for (int o = 1; o < 64; o <<= 1) { const int n = supi(x, o, lane); if (lane >= o) x += n; }
                      pre[p + 1] = carry + x; carry += shfi(x, 63); }
                  if (lane == 0) pre[0] = 0; }
              __syncthreads();
              const int S = pre[768];
              const unsigned short* LIST = (const unsigned short*)(ws + WS_LIST); bf16* OPART = (bf16*)(ws + WS_OPART); float* LPART = (float*)(ws + WS_LPART);
              #ifndef KSKIP_N
#define KSKIP_N 3
#endif
              constexpr int KSKIP = KSKIP_N; const int S2 = (S + 1) >> 1; const int NU = S2 + 384;
              for (int i = (vcu < 64 ? KSKIP : 0); ; ++i) {
                  const int u = (i < KSKIP) ? i * (G - 64) + (vcu - 64) : KSKIP * (G - 64) + (i - KSKIP) * G + vcu;
                  if (u >= NU) break;
                  if (u < S2) moba_sel_step(2 * u, S, pre, lcnt, PROJ, LIST, (const unsigned*)(ws + WS_CTAB), OPART, LPART, Y, B2, lds, tid, wave, lane);
                  else { const int p = u - S2; moba_own_pair(p >> 5, p & 31, 63 - (p & 31), PROJ, OPART, LPART, Y, B2, lds, tid, wave, lane); }
              } }
#else
            moba_naive(PROJ, SEL, Y, gw, NGW, lane);
#endif
        }
        SEAM(pb + 3);
        if (PHEN(4) && IN(pb + 4)) { PH_IDS(); MK_MP();
#if ML_MFMA
            for (int rep = 0; rep <= REP_M3; ++rep)
            for (int u = vcu; u < 512; u += G) mlstm_m3_mfma(u, MP, lds, tid, wave, lane);
#else
            for (int rep = 0; rep <= REP_M3; ++rep)
            for (int u = vcu; u < 2048; u += G) mlstm_m3(u, MP, ldsf, tid, wave, lane);
#endif
#if MOBA_MFMA
            for (int rep = 0; rep < REP_COMB; ++rep) moba_combine(SEL, (const bf16*)(ws + WS_OPART), (const float*)(ws + WS_LPART), Y, (bf16*)(ws + WS_U), 384, 0, vcu * NTHREADS + tid, G * NTHREADS);
            moba_combine(SEL, (const bf16*)(ws + WS_OPART), (const float*)(ws + WS_LPART), Y, Y, 1024, Y_MOBA, vcu * NTHREADS + tid, G * NTHREADS);
#endif
        }
        SEAM(pb + 4);
        if (PHEN(5) && IN(pb + 5)) { PH_IDS();
            pg8::Gemm g{Y, (const bf16*)(ws + WS_WOUT + l * WOUT_BYTES), MROWS, DM, DM}; pg8::StaticOrder S; S.init(MROWS, DM, G, bx);
            float* const xr = xres; const float* const xcur = (l == 0) ? x_in : (const float*)xr;
            pg8::EpiRes E{xcur, xr, mod_l + 2048, 6144, SEQ, XN, (const float*)(ws + WS_AVEC) + (size_t)((l * 2 + 1) * 2) * 1024, (float*)(ws + WS_SSP)};
            pg8::gemm_phase<pg8::EpiRes, pg8::StaticOrder, true, true>(lds, g, S, E, tid);
        }
        SEAM(pb + 5);
        for (int rep = 0; rep <= REP_GGU; ++rep)
        if (PHEN(6) && IN(pb + 6)) { PH_IDS();
            pg8::Gemm g{XN, (const bf16*)(ws + WS_WGU + l * WGU_BYTES), MROWS, NGU, DM}; pg8::StaticOrder S; S.init(MROWS, NGU, G, bx);
            LAS float* rt = (LAS float*)(lds + ATT_TAB); LAS float* bt = rt + 512;
            const int pm0 = rstd_tables(S, (const float*)(ws + WS_SSP), rt, (const float*)(ws + WS_BIASGU) + (size_t)l * 2 * NGU, NGU, bt, tid);
            pg8::EpiSwiglu E{HB, DFF, rt, pm0, bt};
            pg8::gemm_phase<pg8::EpiSwiglu, pg8::StaticOrder, GGU_ALIGN, GGU_SP2>(lds, g, S, E, tid);
        }
        SEAM(pb + 6);
        if (PHEN(7) && IN(pb + 7)) { PH_IDS();
            pg8::Gemm g{HB, (const bf16*)(ws + WS_WDN + l * WDN_BYTES), MROWS, DM, DFF}; pg8::StaticOrder S; S.init(MROWS, DM, G, bx);
            float* const xr = xres;
            pg8::EpiRes E{xr, xr, mod_l + 5120, 6144, SEQ, (l + 1 < DEPTH) ? XN : (bf16*)nullptr, (const float*)(ws + WS_AVEC) + (size_t)(((l + 1) * 2 + 0) * 2) * 1024, (float*)(ws + WS_SSP)};
            pg8::gemm_phase<pg8::EpiRes, pg8::StaticOrder, true, true>(lds, g, S, E, tid);
        }
        SEAM(pb + 7);
    }
#undef IN
#undef SEAM
}

extern "C" void kernel_launch(void* const* d_in, const int* in_sizes, int n_in, void* d_out, int out_size, void* d_ws, size_t ws_size, hipStream_t stream) {
    static int grid = 0;
    if (grid == 0) {
        if (n_in != 20 || in_sizes[0] != MROWS * DM || out_size != MROWS * DM || ws_size < WS_END) {
            fprintf(stderr, "kernel_launch: unexpected shapes: n_in %d in0 %d out %d ws %zu (need >= %zu)\n", n_in, n_in > 0 ? in_sizes[0] : -1, out_size, ws_size, (size_t)WS_END); grid = -1; return; }
        int dev = 0, cus = 0, per_cu = 0;
        if (hipGetDevice(&dev) != hipSuccess || hipDeviceGetAttribute(&cus, hipDeviceAttributeMultiprocessorCount, dev) != hipSuccess) { grid = -1; return; }
        if (hipFuncSetAttribute((const void*)fwd, hipFuncAttributeMaxDynamicSharedMemorySize, LDS_BYTES) != hipSuccess) { fprintf(stderr, "kernel_launch: hipFuncSetAttribute failed\n"); grid = -1; return; }
        if (hipOccupancyMaxActiveBlocksPerMultiprocessor(&per_cu, (const void*)fwd, NTHREADS, LDS_BYTES) != hipSuccess || per_cu < 1)
            fprintf(stderr, "kernel_launch: note: occupancy query reports %d workgroups per CU\n", per_cu);
        (void)hipGetLastError();
        grid = cus;
    }
    if (grid < 0) return;
    if (hipMemsetAsync((char*)d_ws + WS_CTL, 0, CTL_ZERO_BYTES, stream) != hipSuccess) return;
    Args a{};
    for (int i = 0; i < 20; ++i) a.in[i] = (const float*)d_in[i];
    a.out = (float*)d_out; a.ws = (unsigned char*)d_ws;
    if (N_LAUNCH_MODE == 1) { a.ph_lo = 0; a.ph_hi = NPHASE; hipLaunchKernelGGL(fwd, dim3(grid), dim3(NTHREADS), LDS_BYTES, stream, a); }
    else for (int p = 0; p < NPHASE; ++p) { a.ph_lo = p; a.ph_hi = p + 1; hipLaunchKernelGGL(fwd, dim3(grid), dim3(NTHREADS), LDS_BYTES, stream, a); }
}
```

```cpp
#include <hip/hip_runtime.h>
#include <cstdio>
#include <cstdint>

constexpr int DM = 1024, NBATCH = 2, SEQ = 16384, MROWS = NBATCH * SEQ, DEPTH = 2;
constexpr int HD = 64, FOXH = 6, MLH = 4, MOBH = 6;
constexpr int DFF = 2816, INC = 3342, NIN = 3584, PLD = 3328;
constexpr int NGU = 2 * DFF;
constexpr int C_FQ = 0, C_FK = 384, C_FV = 768, C_BQ = 1152, C_BK = 1536, C_BV = 1920, C_MQ = 2304, C_MK = 2560, C_MV = 2816, C_MO = 3072, C_G = 3328;
constexpr int Y_FOX = 0, Y_ML = 384, Y_MOBA = 640;
constexpr int MOBA_BS = 256, NBLK = SEQ / MOBA_BS;
constexpr int MLC = 64, NCHUNK = SEQ / MLC;
constexpr float LOG2E = 1.4426950408889634f;
constexpr float QSCALE = 0.125f * LOG2E;
constexpr float EPS = 1e-6f;

#define GAS __attribute__((address_space(1)))
#define LAS __attribute__((address_space(3)))
typedef unsigned short bf16;
typedef unsigned v4u __attribute__((ext_vector_type(4)));
typedef unsigned v2u __attribute__((ext_vector_type(2)));
typedef float f32x4 __attribute__((ext_vector_type(4)));
typedef short bf16x8 __attribute__((ext_vector_type(8)));
typedef float f32x16 __attribute__((ext_vector_type(16)));
typedef GAS unsigned gu32;
#define RLX_AGENT __ATOMIC_RELAXED, __HIP_MEMORY_SCOPE_AGENT
__device__ __forceinline__ unsigned f2bf(float f) { unsigned u = __builtin_bit_cast(unsigned, f); return (u + 0x7fffu + ((u >> 16) & 1u)) >> 16; }
__device__ __forceinline__ unsigned pk2(float lo, float hi) { return f2bf(lo) | (f2bf(hi) << 16); }
__device__ __forceinline__ float bf2f(unsigned short u) { return __builtin_bit_cast(float, (unsigned)u << 16); }
__device__ __forceinline__ float bflo(unsigned w) { return __builtin_bit_cast(float, w << 16); }
__device__ __forceinline__ float bfhi(unsigned w) { return __builtin_bit_cast(float, w & 0xffff0000u); }
#ifndef OLD_SHFL
#define OLD_SHFL 0
#endif
#ifndef OLD_SWZ
#define OLD_SWZ OLD_SHFL
#endif
#ifndef OLD_HALF
#define OLD_HALF OLD_SHFL
#endif
#ifndef OLD_SHF
#define OLD_SHF OLD_SHFL
#endif
#ifndef OLD_SUP
#define OLD_SUP OLD_SHFL
#endif
#if OLD_SWZ
#define SWZ_X(v, o) __shfl_xor((float)(v), (o))
#else
#define SWZ_X(v, o) __builtin_bit_cast(float, __builtin_amdgcn_ds_swizzle(__builtin_bit_cast(int, (float)(v)), ((o) << 10) | 0x1f))
#endif
__device__ __forceinline__ float half_sum(float v, int lane) { return v + __builtin_bit_cast(float, __builtin_amdgcn_ds_bpermute((lane ^ 32) << 2, __builtin_bit_cast(int, v))); }
#if OLD_SHF
__device__ __forceinline__ float shf(float v, int src) { return __shfl(v, src); }
__device__ __forceinline__ int shfi(int v, int src) { return __shfl(v, src); }
#else
__device__ __forceinline__ float shf(float v, int src) { return __builtin_bit_cast(float, __builtin_amdgcn_ds_bpermute(src << 2, __builtin_bit_cast(int, v))); }
__device__ __forceinline__ int shfi(int v, int src) { return __builtin_amdgcn_ds_bpermute(src << 2, v); }
#endif
#if OLD_SUP
__device__ __forceinline__ float sup(float v, int o, int lane) { return __shfl_up(v, o); }
__device__ __forceinline__ int supi(int v, int o, int lane) { return __shfl_up(v, o); }
#else
__device__ __forceinline__ float sup(float v, int o, int lane) { return shf(v, lane >= o ? lane - o : lane); }
__device__ __forceinline__ int supi(int v, int o, int lane) { return shfi(v, lane >= o ? lane - o : lane); }
#endif
__device__ __forceinline__ float wave_sum(float v) { v += SWZ_X(v, 1); v += SWZ_X(v, 2); v += SWZ_X(v, 4); v += SWZ_X(v, 8); v += SWZ_X(v, 16);
    return __builtin_bit_cast(float, __builtin_amdgcn_readlane(__builtin_bit_cast(int, v), 0)) + __builtin_bit_cast(float, __builtin_amdgcn_readlane(__builtin_bit_cast(int, v), 32)); }
__device__ __forceinline__ float wave_max(float v) { v = fmaxf(v, SWZ_X(v, 1)); v = fmaxf(v, SWZ_X(v, 2)); v = fmaxf(v, SWZ_X(v, 4)); v = fmaxf(v, SWZ_X(v, 8)); v = fmaxf(v, SWZ_X(v, 16));
    return fmaxf(__builtin_bit_cast(float, __builtin_amdgcn_readlane(__builtin_bit_cast(int, v), 0)), __builtin_bit_cast(float, __builtin_amdgcn_readlane(__builtin_bit_cast(int, v), 32))); }
__device__ __forceinline__ float log_sigmoid_f(float x) { return fminf(x, 0.f) - log1pf(expf(-fabsf(x))); }
__device__ __forceinline__ float log_sigmoid_fast(float x) { const float x2 = x * LOG2E; return 0.6931471805599453f * (fminf(x2, 0.f) - __builtin_amdgcn_logf(1.f + __builtin_amdgcn_exp2f(-fabsf(x2)))); }
__device__ __forceinline__ float exp_fast(float x) { return __builtin_amdgcn_exp2f(x * LOG2E); }
__device__ __forceinline__ float sigmoid_f(float x) { return 1.f / (1.f + expf(-x)); }

constexpr size_t MiB = 1u << 20;
constexpr size_t WS_CTL = 0, CTL_ZERO_BYTES = 1 * MiB;
constexpr size_t WS_MOD = 1 * MiB;
constexpr size_t WS_KMEAN = WS_MOD + 128 * 1024;
constexpr size_t WS_MLS = WS_KMEAN + 512 * 1024;
constexpr size_t WS_BEND = WS_MLS, WS_MLOC = WS_MLS + 8192, WS_MS = WS_MLS + 16384, WS_NU = WS_MLS + 32768, WS_NS = WS_NU + 2048 * 64 * 4;
constexpr size_t WS_CTAB = 3 * MiB;
constexpr size_t WS_PTAB = WS_CTAB + 256 * 1024;
static_assert(WS_NS + 2048 * 64 * 4 <= WS_CTAB && WS_CTAB + 12 * 64 * 64 * 4 <= WS_PTAB && WS_PTAB + 256 <= 4 * MiB, "small region");
constexpr size_t WS_WIN = 4 * MiB, WIN_BYTES = (size_t)NIN * DM * 2;
constexpr size_t WS_WOUT = WS_WIN + 2 * WIN_BYTES, WOUT_BYTES = (size_t)DM * DM * 2;
constexpr size_t WS_WGU = WS_WOUT + 2 * WOUT_BYTES, WGU_BYTES = (size_t)NGU * DM * 2;
constexpr size_t WS_WDN = WS_WGU + 2 * WGU_BYTES, WDN_BYTES = (size_t)DM * DFF * 2;
static_assert(WS_WDN + 2 * WDN_BYTES <= 56 * MiB, "weights");
constexpr size_t WS_SSP = 56 * MiB;
constexpr size_t WS_AVEC = 58 * MiB;
constexpr size_t WS_BIASIN = WS_AVEC + 64 * 1024;
constexpr size_t WS_BIASGU = WS_BIASIN + 64 * 1024;
static_assert(WS_BIASGU + 2 * 2 * NGU * 4 <= 64 * MiB && 2 * 2 * NIN * 4 <= 64 * 1024, "fused-norm vectors");
constexpr size_t WS_XN = 64 * MiB;
constexpr size_t WS_U = 64 * MiB;
constexpr size_t WS_CS = 96 * MiB;
constexpr size_t WS_LIST = 112 * MiB;
constexpr size_t WS_PROJ = 128 * MiB;
constexpr size_t WS_H = 128 * MiB;
constexpr size_t WS_Y = 336 * MiB;
constexpr size_t WS_QC = 400 * MiB, WS_KC = 416 * MiB;
constexpr size_t WS_OPART = 432 * MiB;
constexpr size_t WS_LPART = 504 * MiB;
constexpr size_t WS_GATES = 507 * MiB;
constexpr size_t WS_FOXCUM = 509 * MiB;
constexpr size_t WS_SEL = 510 * MiB;
constexpr size_t WS_END = 512 * MiB;
static_assert(WS_PROJ + (size_t)MROWS * PLD * 2 <= WS_Y && WS_SEL + (size_t)MROWS * 6 * 4 <= WS_END, "ws map");
constexpr int CW_BAR = 4096;
constexpr int CW_QUEUE = 16384;
constexpr int CW_LCNT = 32768;

constexpr int RING_BYTES = 131072, LDSCTL_OFF = RING_BYTES, MISC_OFF = LDSCTL_OFF + 320, LDS_BYTES = 147456;
constexpr int NWAVES = 8, NTHREADS = 512;
#ifndef REP_EPI
#define REP_EPI 0
#define REP_EPI_ID -1
#endif
namespace pg8 {
#define PG8_LAS __attribute__((address_space(3)))
typedef unsigned short bf16_t;
typedef short bf16x8 __attribute__((ext_vector_type(8)));
typedef float f32x4 __attribute__((ext_vector_type(4)));
typedef unsigned u32x4 __attribute__((ext_vector_type(4)));
constexpr int BM = 256, BK = 64, HALF = 128, HTB = HALF * BK * 2  , STAGE_BYTES = 8 * HTB, NXCD = 8, WGM = 8;

__host__ __device__ __forceinline__ int lds_byte(int r, int c) { const int st = (r >> 4) * 2 + (c >> 5), rr = r & 15, cc = c & 31, ob = rr * 64 + cc * 2; return st * 1024 + (ob ^ (((ob >> 9) & 1) << 5)); }
__host__ __device__ __forceinline__ void stage_rc(int b, int& R, int& C) { const int st = b / 1024, sb = b % 1024, swz = sb ^ (((sb >> 9) & 1) << 5); R = (st >> 1) * 16 + swz / 64; C = (st & 1) * 32 + (swz % 64) / 2; }
__host__ __device__ __forceinline__ int perm32(int rho) { const int n = rho >> 4, i = rho & 15; return 8 * (i >> 2) + 4 * n + (i & 3); }

struct Unit { int pm, pn, ord; };
struct Gemm { const bf16_t* A; const bf16_t* Bt; int M, N, K; };

struct StaticOrder {
    int nM, nN, nwg, G, c;
    __host__ __device__ void init(int M, int N, int G_, int c_) { nM = M / BM; nN = N / BM; nwg = nM * nN; G = G_; c = c_; }
    __host__ __device__ bool next(int i, Unit& u) const {
        const long L = (long)i * G + c; if (L >= nwg) return false;
        int wgid = (int)L; { const int q = nwg / NXCD, r = nwg % NXCD, xcd = wgid % NXCD, off = wgid / NXCD; wgid = (xcd < r ? xcd * (q + 1) : r * (q + 1) + (xcd - r) * q) + off; }
        const int nig = WGM * nN, gid = wgid / nig, fm = gid * WGM, gsz = (nM - fm) < WGM ? (nM - fm) : WGM;
        u.pm = fm + ((wgid % nig) % gsz); u.pn = (wgid % nig) / gsz; u.ord = i; return true;
    }
    __device__ __forceinline__ void a_ready(const Unit&) const {}
    __device__ __forceinline__ void done(const Unit&) const {}
};

__device__ __forceinline__ unsigned cvt_pk_bf16(float lo, float hi) { unsigned r; asm volatile("v_cvt_pk_bf16_f32 %0, %1, %2" : "=v"(r) : "v"(lo), "v"(hi)); return r; }
typedef float f32x2 __attribute__((ext_vector_type(2)));
typedef unsigned u32x2 __attribute__((ext_vector_type(2)));
struct EpiProj {
    static constexpr bool PERM = true, AFTER_DRAIN = false; static constexpr int ID = 0;
    bf16_t* P; float* G; int pld; PG8_LAS const float* rt; int pm0; PG8_LAS const float* bt;
    PG8_LAS const float* gt; float* kmeanp; float qscale;
    __device__ __forceinline__ void operator()(const f32x4 (&acc)[2][2][4][2], const Unit& u, int wr, int wc, int fr, int fq) const {
        const int row0 = u.pm * BM + wr * 64 + fr;
        PG8_LAS const float* rs = rt + (u.pm == pm0 ? 0 : 256) + wr * 64 + fr;
        PG8_LAS const float* bb = bt + u.ord * 256 + wc * 32 + 8 * fq;
        if (u.pn < 13) {
            const int hcol = u.pn * BM + 64 * wc;
            const int kind = hcol < 384 ? 0 : hcol < 768 ? 1 : (hcol >= 1152 && hcol < 1536) ? 2 : (hcol >= 1536 && hcol < 1920) ? 3 : -1;
            f32x4 bv[2][2], gv[2][2];
#pragma unroll
            for (int bj = 0; bj < 2; ++bj)
#pragma unroll
                for (int n = 0; n < 2; ++n) { bv[bj][n] = *(PG8_LAS const f32x4*)(bb + bj * HALF + 4 * n);
                    gv[bj][n] = (kind >= 0) ? *(PG8_LAS const f32x4*)(gt + kind * 64 + 32 * bj + 8 * fq + 4 * n) : (f32x4){1.f, 1.f, 1.f, 1.f}; }
            if (kind == 0 || kind == 2) {
#pragma unroll
                for (int bj = 0; bj < 2; ++bj)
#pragma unroll
                    for (int n = 0; n < 2; ++n) gv[bj][n] = gv[bj][n] * qscale; }
            float rsv[2][4];
#pragma unroll
            for (int ai = 0; ai < 2; ++ai)
#pragma unroll
                for (int m = 0; m < 4; ++m) rsv[ai][m] = rs[ai * HALF + m * 16];
            f32x4 ks[2][2];
#pragma unroll
            for (int bj = 0; bj < 2; ++bj)
#pragma unroll
                for (int n = 0; n < 2; ++n) ks[bj][n] = (f32x4){0.f, 0.f, 0.f, 0.f};
            const int lane = fq * 16 + fr;
#pragma unroll
            for (int ai = 0; ai < 2; ++ai)
#pragma unroll
                for (int m = 0; m < 4; ++m) { bf16_t* rowp = P + (size_t)(row0 + ai * HALF + m * 16) * pld + hcol + 8 * fq; const float rstd = rsv[ai][m];
                    f32x4 v[2][2];
#pragma unroll
                    for (int bj = 0; bj < 2; ++bj)
#pragma unroll
                        for (int n = 0; n < 2; ++n) v[bj][n] = acc[ai][bj][m][n] * rstd + bv[bj][n];
                    if (kind >= 0) {
                        f32x4 s4 = v[0][0] * v[0][0]; s4 = v[0][1] * v[0][1] + s4; s4 = v[1][0] * v[1][0] + s4; s4 = v[1][1] * v[1][1] + s4;
                        float ss = (s4[0] + s4[1]) + (s4[2] + s4[3]);
                        ss += SWZ_X(ss, 16); ss += __builtin_bit_cast(float, __builtin_amdgcn_ds_bpermute((lane ^ 32) << 2, __builtin_bit_cast(int, ss)));
                        const float rr = __builtin_amdgcn_rsqf(ss * (1.f / 64.f) + 1e-6f);
#pragma unroll
                        for (int bj = 0; bj < 2; ++bj)
#pragma unroll
                            for (int n = 0; n < 2; ++n) { v[bj][n] = v[bj][n] * rr * gv[bj][n]; ks[bj][n] += v[bj][n]; }
                    }
#pragma unroll
                    for (int bj = 0; bj < 2; ++bj) { const f32x4 v0 = v[bj][0], v1 = v[bj][1];
                        u32x4 w; w.x = cvt_pk_bf16(v0[0], v0[1]); w.y = cvt_pk_bf16(v0[2], v0[3]); w.z = cvt_pk_bf16(v1[0], v1[1]); w.w = cvt_pk_bf16(v1[2], v1[3]);
                        *(u32x4*)(rowp + 32 * bj) = w; } }
            if (kind == 3) {
#pragma unroll
                for (int bj = 0; bj < 2; ++bj)
#pragma unroll
                    for (int n = 0; n < 2; ++n)
#pragma unroll
                        for (int i = 0; i < 4; ++i) { float t = ks[bj][n][i]; t += SWZ_X(t, 1); t += SWZ_X(t, 2); t += SWZ_X(t, 4); t += SWZ_X(t, 8); ks[bj][n][i] = t; }
                if (fr == 0) { const int hd = (hcol - 1536) >> 6, bat = (u.pm * BM) / 16384, nb = u.pm & 63;
                    float* kp = kmeanp + (size_t)wr * (12 * 64 * 64) + (((size_t)bat * 6 + hd) * 64 + nb) * 64 + 8 * fq;
#pragma unroll
                    for (int bj = 0; bj < 2; ++bj)
#pragma unroll
                        for (int n = 0; n < 2; ++n) *(f32x4*)(kp + 32 * bj + 4 * n) = ks[bj][n] * (1.f / 256.f); }
            }
        } else {
            if (wc == 0 && fq < 2) {
                const f32x4 b0 = *(PG8_LAS const f32x4*)(bb), b1 = *(PG8_LAS const f32x4*)(bb + 4);
#pragma unroll
                for (int ai = 0; ai < 2; ++ai)
#pragma unroll
                    for (int m = 0; m < 4; ++m) { float* gp = G + (size_t)(row0 + ai * HALF + m * 16) * 16 + 8 * fq; const float rstd = rs[ai * HALF + m * 16];
                        *(f32x4*)(gp) = acc[ai][0][m][0] * rstd + b0; *(f32x4*)(gp + 4) = acc[ai][0][m][1] * rstd + b1; }
            }
        }
    }
};
struct EpiRes {
    static constexpr bool PERM = true, AFTER_DRAIN = false; static constexpr int ID = 1;
    const void* base; void* out; bool base_bf, out_bf; const float* gate; int gate_bstride; int rows_per_batch; bf16_t* xa; const float* avec; float* ssp;
    __device__ __forceinline__ void operator()(const f32x4 (&acc)[2][2][4][2], const Unit& u, int wr, int wc, int fr, int fq) const {
        const int row0 = u.pm * BM + wr * 64 + fr, col0 = u.pn * BM + wc * 32 + 8 * fq;
        const int bat = (u.pm * BM) / rows_per_batch;
        const float* gb = gate + (size_t)bat * gate_bstride;
        f32x4 gv[2][2], av[2][2];
#pragma unroll
        for (int bj = 0; bj < 2; ++bj)
#pragma unroll
            for (int n = 0; n < 2; ++n) { gv[bj][n] = *(const f32x4*)(gb + col0 + bj * HALF + 4 * n); av[bj][n] = xa ? *(const f32x4*)(avec + (size_t)bat * 1024 + col0 + bj * HALF + 4 * n) : (f32x4){0.f, 0.f, 0.f, 0.f}; }
        const int lane = fq * 16 + fr;
#pragma unroll
        for (int ai = 0; ai < 2; ++ai)
#pragma unroll
            for (int m = 0; m < 4; ++m) { const size_t off = (size_t)(row0 + ai * HALF + m * 16) * 1024 + col0; float ss = 0.f;
#pragma unroll
                for (int bj = 0; bj < 2; ++bj) {
                    f32x4 b0, b1;
                    if (base_bf) { const u32x4 w = *(const u32x4*)((const bf16_t*)base + off + bj * HALF);
                        b0 = (f32x4){__builtin_bit_cast(float, w.x << 16), __builtin_bit_cast(float, w.x & 0xffff0000u), __builtin_bit_cast(float, w.y << 16), __builtin_bit_cast(float, w.y & 0xffff0000u)};
                        b1 = (f32x4){__builtin_bit_cast(float, w.z << 16), __builtin_bit_cast(float, w.z & 0xffff0000u), __builtin_bit_cast(float, w.w << 16), __builtin_bit_cast(float, w.w & 0xffff0000u)}; }
                    else { b0 = *(const f32x4*)((const float*)base + off + bj * HALF); b1 = *(const f32x4*)((const float*)base + off + bj * HALF + 4); }
                    const f32x4 o0 = b0 + gv[bj][0] * acc[ai][bj][m][0], o1 = b1 + gv[bj][1] * acc[ai][bj][m][1];
                    if (out_bf) { u32x4 w; w.x = cvt_pk_bf16(o0[0], o0[1]); w.y = cvt_pk_bf16(o0[2], o0[3]); w.z = cvt_pk_bf16(o1[0], o1[1]); w.w = cvt_pk_bf16(o1[2], o1[3]);
                        *(u32x4*)((bf16_t*)out + off + bj * HALF) = w; }
                    else { __builtin_nontemporal_store(o0, (f32x4*)((float*)out + off + bj * HALF)); __builtin_nontemporal_store(o1, (f32x4*)((float*)out + off + bj * HALF + 4)); }
                    if (xa) { ss += ((o0[0] * o0[0] + o0[1] * o0[1]) + (o0[2] * o0[2] + o0[3] * o0[3])) + ((o1[0] * o1[0] + o1[1] * o1[1]) + (o1[2] * o1[2] + o1[3] * o1[3]));
                        const f32x4 t0 = o0 * av[bj][0], t1 = o1 * av[bj][1];
                        u32x4 w; w.x = cvt_pk_bf16(t0[0], t0[1]); w.y = cvt_pk_bf16(t0[2], t0[3]); w.z = cvt_pk_bf16(t1[0], t1[1]); w.w = cvt_pk_bf16(t1[2], t1[3]);
                        *(u32x4*)(xa + off + bj * HALF) = w; } }
                if (xa) { ss += SWZ_X(ss, 16); ss += __builtin_bit_cast(float, __builtin_amdgcn_ds_bpermute((lane ^ 32) << 2, __builtin_bit_cast(int, ss)));
                    if (fq == 0) ssp[(size_t)(row0 + ai * HALF + m * 16) * 16 + u.pn * 4 + wc] = ss; } }
    }
};
struct EpiSwiglu {
    static constexpr bool PERM = true, AFTER_DRAIN = false; static constexpr int ID = 2;
    bf16_t* Hh; int ldh; PG8_LAS const float* rt; int pm0; PG8_LAS const float* bt;
    __device__ __forceinline__ void operator()(const f32x4 (&acc)[2][2][4][2], const Unit& u, int wr, int wc, int fr, int fq) const {
        const int row0 = u.pm * BM + wr * 64 + fr, col0 = u.pn * HALF + wc * 32 + 8 * fq;
        PG8_LAS const float* rs = rt + (u.pm == pm0 ? 0 : 256) + wr * 64 + fr;
        PG8_LAS const float* bb = bt + u.ord * 256 + wc * 32 + 8 * fq;
        f32x4 bv[2][2], bl[2];
#pragma unroll
        for (int bj = 0; bj < 2; ++bj)
#pragma unroll
            for (int n = 0; n < 2; ++n) bv[bj][n] = *(PG8_LAS const f32x4*)(bb + bj * HALF + 4 * n);
#pragma unroll
        for (int n = 0; n < 2; ++n) bl[n] = bv[0][n] * -1.4426950408889634f;
        float rsv[2][4];
#pragma unroll
        for (int ai = 0; ai < 2; ++ai)
#pragma unroll
            for (int m = 0; m < 4; ++m) rsv[ai][m] = rs[ai * HALF + m * 16];
#pragma unroll
        for (int ai = 0; ai < 2; ++ai)
#pragma unroll
            for (int m = 0; m < 4; ++m) { bf16_t* rowp = Hh + (size_t)(row0 + ai * HALF + m * 16) * ldh + col0; const float rstd = rsv[ai][m], rl = rstd * -1.4426950408889634f;
                f32x4 gg[2], uu[2], ee[2];
#pragma unroll
                for (int n = 0; n < 2; ++n) { gg[n] = acc[ai][0][m][n] * rstd + bv[0][n]; uu[n] = acc[ai][1][m][n] * rstd + bv[1][n]; ee[n] = acc[ai][0][m][n] * rl + bl[n]; }
#pragma unroll
                for (int n = 0; n < 2; ++n)
#pragma unroll
                    for (int i = 0; i < 4; ++i) ee[n][i] = __builtin_amdgcn_exp2f(ee[n][i]);
#pragma unroll
                for (int n = 0; n < 2; ++n) ee[n] = ee[n] + 1.0f;
#pragma unroll
                for (int n = 0; n < 2; ++n)
#pragma unroll
                    for (int i = 0; i < 4; ++i) ee[n][i] = __builtin_amdgcn_rcpf(ee[n][i]);
                const f32x4 h0 = gg[0] * ee[0] * uu[0], h1 = gg[1] * ee[1] * uu[1];
                u32x4 w; w.x = cvt_pk_bf16(h0[0], h0[1]); w.y = cvt_pk_bf16(h0[2], h0[3]); w.z = cvt_pk_bf16(h1[0], h1[1]); w.w = cvt_pk_bf16(h1[2], h1[3]);
#ifdef H_PLAIN
                *(u32x4*)(rowp) = w; }
#else
                __builtin_nontemporal_store(w, (u32x4*)(rowp)); }
#endif
    }
};
template <class Epi, class Sched, bool ALIGN_EPI = false, bool SP2 = false>
__device__ __forceinline__ void gemm_phase(PG8_LAS unsigned char* lds, const Gemm g, const Sched& S, const Epi& E, const int tid_in) {
    const int tid = tid_in, wid = __builtin_amdgcn_readfirstlane(tid >> 6), lane = tid & 63, wr = wid >> 2, wc = wid & 3, fr = lane & 15, fq = lane >> 4;
    const int K = g.K, nt = K / BK;
    unsigned voffA[2], voffB[2];
#pragma unroll
    for (int i = 0; i < 2; ++i) { int R, C; stage_rc(tid * 16 + i * 8192, R, C); const int Rb = Epi::PERM ? ((R & ~31) + perm32(R & 31)) : R;
        voffA[i] = (unsigned)(R * K + C) * 2u; voffB[i] = (unsigned)(Rb * K + C) * 2u; }
    const size_t kstep = (size_t)(BK * 2);
    const size_t hstep = (size_t)HALF * K * 2;
    const size_t tstep = 2 * hstep;
    const unsigned ldsw = (unsigned)wid * 1024u;
    const int aoff = lds_byte(wr * 64 + fr, fq * 8), boff = lds_byte(wc * 32 + fr, fq * 8);
#define PG8_SA(b, h) (((b) * 2 + (h)) * HTB)
#define PG8_SB(b, h) ((4 + (b) * 2 + (h)) * HTB)
#define PG8_STAGE(bufoff, gbase, voff) do { _Pragma("unroll") for (int _i = 0; _i < 2; ++_i) \
        __builtin_amdgcn_global_load_lds((const unsigned*)((const char*)(gbase) + (voff)[_i]), (PG8_LAS unsigned*)(lds + (bufoff) + ldsw + _i * 8192), 16, 0, 0); } while (0)
#define PG8_LDA(dst, b, h) do { _Pragma("unroll") for (int m = 0; m < 4; ++m) _Pragma("unroll") for (int k = 0; k < 2; ++k) dst[m][k] = *(const PG8_LAS bf16x8*)(lds + PG8_SA(b, h) + aoff + m * 2048 + k * 1024); } while (0)
#define PG8_LDB(dst, b, h) do { _Pragma("unroll") for (int n = 0; n < 2; ++n) _Pragma("unroll") for (int k = 0; k < 2; ++k) dst[n][k] = *(const PG8_LAS bf16x8*)(lds + PG8_SB(b, h) + boff + n * 2048 + k * 1024); } while (0)
#define PG8_MMA(ai, bj, At, Bt) do { __builtin_amdgcn_s_setprio(1); _Pragma("unroll") for (int m = 0; m < 4; ++m) _Pragma("unroll") for (int n = 0; n < 2; ++n) _Pragma("unroll") for (int k = 0; k < 2; ++k) \
        acc[ai][bj][m][n] = __builtin_amdgcn_mfma_f32_16x16x32_bf16(Bt[n][k], At[m][k], acc[ai][bj][m][n], 0, 0, 0); __builtin_amdgcn_s_setprio(0); } while (0)
#define PG8_WAIT_V(n) asm volatile("s_waitcnt vmcnt(" #n ")" ::: "memory")
#define PG8_WAIT_L(n) asm volatile("s_waitcnt lgkmcnt(" #n ")" ::: "memory")
#define PG8_BAR __builtin_amdgcn_s_barrier()
#define PG8_SCHED __builtin_amdgcn_sched_barrier(0)
    Unit cur, nxt; int ui = 0;
    if (!S.next(0, cur)) return;
    f32x4 acc[2][2][4][2];
#pragma unroll
    for (int a = 0; a < 2; ++a)
#pragma unroll
        for (int b = 0; b < 2; ++b)
#pragma unroll
            for (int m = 0; m < 4; ++m)
#pragma unroll
                for (int n = 0; n < 2; ++n) acc[a][b][m][n] = (f32x4){0.f, 0.f, 0.f, 0.f};
    bf16x8 At[4][2], B0[2][2], B1[2][2];
    const char* cA = (const char*)g.A + (size_t)cur.pm * tstep; const char* cB = (const char*)g.Bt + (size_t)cur.pn * tstep;
    S.a_ready(cur);
    if constexpr (SP2) {
        PG8_STAGE(PG8_SB(0, 0), cB, voffB); PG8_STAGE(PG8_SB(0, 1), cB + hstep, voffB); PG8_STAGE(PG8_SA(0, 0), cA, voffA); PG8_STAGE(PG8_SA(0, 1), cA + hstep, voffA);
        if (wr == 1) PG8_BAR;
        PG8_WAIT_V(2); PG8_BAR;
        PG8_STAGE(PG8_SB(1, 0), cB + kstep, voffB); PG8_STAGE(PG8_SA(1, 0), cA + kstep, voffA); PG8_STAGE(PG8_SB(1, 1), cB + hstep + kstep, voffB);
        PG8_WAIT_V(6); PG8_BAR;
    } else {
        PG8_STAGE(PG8_SB(0, 0), cB, voffB); PG8_STAGE(PG8_SA(0, 0), cA, voffA); PG8_STAGE(PG8_SB(0, 1), cB + hstep, voffB); PG8_STAGE(PG8_SA(0, 1), cA + hstep, voffA);
        if (wr == 1) PG8_BAR;
        PG8_WAIT_V(4); PG8_BAR;
        PG8_STAGE(PG8_SB(1, 0), cB + kstep, voffB); PG8_STAGE(PG8_SA(1, 0), cA + kstep, voffA); PG8_STAGE(PG8_SB(1, 1), cB + hstep + kstep, voffB);
        PG8_WAIT_V(6); PG8_BAR;
    }
    for (;;) {
        const bool has_next = S.next(ui + 1, nxt);
        const char* nA = has_next ? (const char*)g.A + (size_t)nxt.pm * tstep : cA; const char* nB = has_next ? (const char*)g.Bt + (size_t)nxt.pn * tstep : cB;
        for (int t = 0; t < nt; t += 2) {
            const bool last = (t == nt - 2);
            const char* a1 = cA + (size_t)(t + 1) * kstep;
            const char* a2 = last ? nA : cA + (size_t)(t + 2) * kstep; const char* b2 = last ? nB : cB + (size_t)(t + 2) * kstep;
            const char* a3 = a2 + kstep; const char* b3 = b2 + kstep;
            if (last && has_next) S.a_ready(nxt);
            if constexpr (SP2) {
            PG8_LDB(B0, 0, 0); PG8_LDB(B1, 0, 1); PG8_SCHED; PG8_LDA(At, 0, 0); PG8_STAGE(PG8_SA(1, 1), a1 + hstep, voffA);
            PG8_WAIT_V(8); PG8_WAIT_L(0); PG8_BAR; PG8_MMA(0, 0, At, B0); PG8_MMA(0, 1, At, B1); PG8_BAR; PG8_SCHED;
            PG8_LDA(At, 0, 1); PG8_STAGE(PG8_SB(0, 0), b2, voffB); PG8_STAGE(PG8_SB(0, 1), b2 + hstep, voffB); PG8_STAGE(PG8_SA(0, 0), a2, voffA);
            PG8_WAIT_V(8); PG8_WAIT_L(0); PG8_BAR; PG8_MMA(1, 0, At, B0); PG8_MMA(1, 1, At, B1); PG8_BAR; PG8_SCHED;
            PG8_LDB(B0, 1, 0); PG8_LDB(B1, 1, 1); PG8_SCHED; PG8_LDA(At, 1, 0); PG8_STAGE(PG8_SA(0, 1), a2 + hstep, voffA);
            PG8_WAIT_V(8); PG8_WAIT_L(0); PG8_BAR; PG8_MMA(0, 0, At, B0); PG8_MMA(0, 1, At, B1); PG8_BAR; PG8_SCHED;
            PG8_LDA(At, 1, 1); PG8_STAGE(PG8_SB(1, 0), b3, voffB); PG8_STAGE(PG8_SB(1, 1), b3 + hstep, voffB); PG8_STAGE(PG8_SA(1, 0), a3, voffA);
            PG8_WAIT_V(8); PG8_WAIT_L(0); PG8_BAR; PG8_MMA(1, 0, At, B0); PG8_MMA(1, 1, At, B1); PG8_BAR; PG8_SCHED;
            } else {
            PG8_LDB(B0, 0, 0); PG8_SCHED; PG8_LDA(At, 0, 0); PG8_STAGE(PG8_SA(1, 1), a1 + hstep, voffA);
            PG8_WAIT_L(8); PG8_BAR; PG8_WAIT_L(0); PG8_MMA(0, 0, At, B0); PG8_BAR; PG8_SCHED;
            PG8_LDB(B1, 0, 1); PG8_STAGE(PG8_SB(0, 0), b2, voffB);
            PG8_BAR; PG8_WAIT_L(0); PG8_MMA(0, 1, At, B1); PG8_BAR;
            PG8_LDA(At, 0, 1); PG8_STAGE(PG8_SA(0, 0), a2, voffA);
            PG8_BAR; PG8_WAIT_L(0); PG8_MMA(1, 0, At, B0); PG8_BAR; PG8_SCHED;
            PG8_STAGE(PG8_SB(0, 1), b2 + hstep, voffB);
            PG8_WAIT_V(6); PG8_BAR; PG8_MMA(1, 1, At, B1); PG8_BAR;
            PG8_LDB(B0, 1, 0); PG8_SCHED; PG8_LDA(At, 1, 0); PG8_STAGE(PG8_SA(0, 1), a2 + hstep, voffA);
            PG8_WAIT_L(8); PG8_BAR; PG8_WAIT_L(0); PG8_MMA(0, 0, At, B0); PG8_BAR; PG8_SCHED;
            PG8_LDB(B1, 1, 1); PG8_STAGE(PG8_SB(1, 0), b3, voffB);
            PG8_BAR; PG8_WAIT_L(0); PG8_MMA(0, 1, At, B1); PG8_BAR;
            PG8_LDA(At, 1, 1); PG8_STAGE(PG8_SA(1, 0), a3, voffA);
            PG8_BAR; PG8_WAIT_L(0); PG8_MMA(1, 0, At, B0); PG8_BAR; PG8_SCHED;
            PG8_STAGE(PG8_SB(1, 1), b3 + hstep, voffB);
            PG8_WAIT_V(6); PG8_BAR; PG8_MMA(1, 1, At, B1); PG8_BAR;
            }
        }
        if constexpr (ALIGN_EPI) { if (wr == 0) PG8_BAR; }
        if constexpr (!Epi::AFTER_DRAIN) { E(acc, cur, wr, wc, fr, fq);
#if REP_EPI
            if constexpr (Epi::ID == REP_EPI_ID) { for (int r_ = 0; r_ < REP_EPI; ++r_) { asm volatile("" ::: "memory"); E(acc, cur, wr, wc, fr, fq); } }
#endif
            S.done(cur); }
        if (!has_next) break;
#pragma unroll
        for (int a = 0; a < 2; ++a)
#pragma unroll
            for (int b = 0; b < 2; ++b)
#pragma unroll
                for (int m = 0; m < 4; ++m)
#pragma unroll
                    for (int n = 0; n < 2; ++n) acc[a][b][m][n] = (f32x4){0.f, 0.f, 0.f, 0.f};
        cur = nxt; cA = nA; cB = nB; ++ui;
        if constexpr (ALIGN_EPI) { if (wr == 1) PG8_BAR; }
    }
    PG8_WAIT_V(0);
    if constexpr (!ALIGN_EPI) { if (wr == 0) PG8_BAR; }
    PG8_BAR;
    if constexpr (Epi::AFTER_DRAIN) { E.fused(acc, cur, wr, wc, fr, fq, lds, wid, lane); S.done(cur); }
#undef PG8_SA
#undef PG8_SB
#undef PG8_STAGE
#undef PG8_LDA
#undef PG8_LDB
#undef PG8_MMA
#undef PG8_WAIT_V
#undef PG8_WAIT_L
#undef PG8_BAR
#undef PG8_SCHED
}
}
#define XB_TMO      128
#define XB_XCNT(j)  (256  + 64 * (j))
#define XB_XSUB(j)  (1280 + 64 * (j))
#define XB_XGEN(j)  (2304 + 64 * (j))
#define XB_TOP      3328
#define XB_TOPGEN   3392
#define XCD_BAR_WORDS 3456
#define XB_SPIN_CAP (1u << 18)

__device__ __forceinline__ unsigned xb_ld(unsigned* p)              { return __hip_atomic_load(p, __ATOMIC_RELAXED, __HIP_MEMORY_SCOPE_AGENT); }
__device__ __forceinline__ unsigned xb_add(unsigned* p, unsigned v) { return __hip_atomic_fetch_add(p, v, __ATOMIC_RELAXED, __HIP_MEMORY_SCOPE_AGENT); }
__device__ __forceinline__ unsigned xb_xcc_id() { return (unsigned)__builtin_amdgcn_s_getreg((3 << 11) | 20) & 0xFu; }
#define XB_SPIN(cond, bar) do { unsigned _sp = 0; while (cond) { __builtin_amdgcn_s_sleep(1); \
    if ((++_sp & 255u) == 0u) { if (xb_ld(&(bar)[XB_TMO])) break; if (_sp > XB_SPIN_CAP) { atomicAdd(&(bar)[XB_TMO], 1u); break; } } } } while (0)

struct XcdBarrier {
    unsigned* bar; unsigned x;
    volatile LAS unsigned* st;
};

__device__ __forceinline__ XcdBarrier xcd_barrier_post(unsigned* bar, volatile LAS unsigned* st) {
    XcdBarrier b; b.bar = bar; b.x = xb_xcc_id(); b.st = st;
    if (threadIdx.x == 0) (void)xb_add(&bar[XB_XCNT(b.x)], 1u);
    return b;
}
__device__ __forceinline__ void xcd_barrier_complete(unsigned* bar, unsigned x, unsigned& nloc, unsigned& nx) {
    const unsigned G = gridDim.x * gridDim.y * gridDim.z;
    unsigned sum, cnt, mine, sp = 0u;
    for (;;) {
        sum = 0u; cnt = 0u; mine = 0u;
#pragma unroll
        for (unsigned j = 0; j < 16; ++j) { const unsigned c = xb_ld(&bar[XB_XCNT(j)]); sum += c; cnt += (c > 0u) ? 1u : 0u; mine = (j == x) ? c : mine; }
        if (sum == G) break;
        __builtin_amdgcn_s_sleep(1);
        if ((++sp & 255u) == 0u) { if (xb_ld(&bar[XB_TMO])) break; if (sp > XB_SPIN_CAP) { atomicAdd(&bar[XB_TMO], 1u); break; } }
    }
    nloc = mine > 0u ? mine : 1u; nx = cnt > 0u ? cnt : 1u;
}

__device__ __forceinline__ void xcd_barrier(const XcdBarrier& b) {
    asm volatile("s_waitcnt vmcnt(0)" ::: "memory");
    __syncthreads();
    if (threadIdx.x == 0) {
        unsigned* bar = b.bar; asm volatile("" : "+s"(bar));
        const unsigned bx_ = xb_xcc_id();
        __builtin_amdgcn_s_waitcnt(0);
        unsigned nloc = b.st[0], nx = b.st[1];
        if (nloc == 0u) { xcd_barrier_complete(bar, bx_, nloc, nx); b.st[0] = nloc; b.st[1] = nx; }
        const unsigned old = xb_add(&bar[XB_XSUB(bx_)], 1u);
        const unsigned gen = old / nloc;
        if (old + 1u == (gen + 1u) * nloc) {
            __builtin_amdgcn_fence(__ATOMIC_RELEASE, "agent");
            asm volatile("s_waitcnt vmcnt(0)" ::: "memory");
            const unsigned og = xb_add(&bar[XB_TOP], 1u);
            const unsigned tg = og / nx;
            if (og + 1u == (tg + 1u) * nx) xb_add(&bar[XB_TOPGEN], 1u);
            else XB_SPIN(xb_ld(&bar[XB_TOPGEN]) == tg, bar);
            __builtin_amdgcn_fence(__ATOMIC_ACQUIRE, "agent");
            xb_add(&bar[XB_XGEN(bx_)], 1u);
            asm volatile("s_waitcnt vmcnt(0)" ::: "memory");
        } else {
            XB_SPIN(xb_ld(&bar[XB_XGEN(bx_)]) == gen, bar);
            __builtin_amdgcn_fence(__ATOMIC_ACQUIRE, "agent");
            asm volatile("s_waitcnt vmcnt(0)" ::: "memory");
        }
    }
    __syncthreads();
}
#define LDS_WAIT() asm volatile("s_waitcnt lgkmcnt(0)" ::: "memory")
__device__ __forceinline__ void unpack8(const v4u w, float* f) { f[0] = bflo(w.x); f[1] = bfhi(w.x); f[2] = bflo(w.y); f[3] = bfhi(w.y); f[4] = bflo(w.z); f[5] = bfhi(w.z); f[6] = bflo(w.w); f[7] = bfhi(w.w); }

__device__ __forceinline__ int win_src(int cp) {
    const int p = cp & 255; const int c = (cp & ~255) + 64 * ((p & 127) >> 5) + 32 * (p >> 7) + (p & 31);
    if (c < 1152) return c;
    if (c < 2304) return c + 1038;
    if (c < 3072) return c - 1146;
    if (c < 3328) return c - 1138;
    if (c < 3334) return c - 3328 + 1152;
    if (c < 3338) return c - 3334 + 1926;
    if (c < 3342) return c - 3338 + 1930;
    return -1;
}
__device__ __forceinline__ int wgu_src(int r) { const int pn = r >> 8, w = r & 255; return (w < 128 ? 0 : DFF) + pn * 128 + (w & 127); }
template <int MODE> __device__ __forceinline__ int src_col(int r) { if (MODE == 1) return win_src(r); if (MODE == 2) return wgu_src(r); return r; }

template <int MODE> __device__ __forceinline__ void transpose_item(const float* W, int K, int ldw, bf16* WT, LAS float* scr, int nblk, int item, int lane) {
    const int kb = item / nblk, nb = item % nblk, k0 = 64 * kb, n0 = 32 * nb;
    const int sc = src_col<MODE>(n0 + (lane & 31));
#pragma unroll 8
    for (int i = 0; i < 32; ++i) { const int kk = 2 * i + (lane >> 5); scr[kk * 33 + (lane & 31)] = (sc >= 0) ? W[(size_t)(k0 + kk) * ldw + sc] : 0.f; }
    LDS_WAIT(); asm volatile("" ::: "memory");
    const int c = lane & 7;
#pragma unroll
    for (int j = 0; j < 4; ++j) { const int n = (lane >> 3) + 8 * j; const LAS float* s = scr + (8 * c) * 33 + n;
        v4u o; o.x = pk2(s[0 * 33], s[1 * 33]); o.y = pk2(s[2 * 33], s[3 * 33]); o.z = pk2(s[4 * 33], s[5 * 33]); o.w = pk2(s[6 * 33], s[7 * 33]);
        *(GAS v4u*)(WT + (size_t)(n0 + n) * K + k0 + 8 * c) = o; }
    LDS_WAIT(); asm volatile("" ::: "memory");
}

__device__ __forceinline__ void p0_mod_unit(int u, const float* cvec, const float* w_ada, const float* b_ada, float* mod, LAS float* lds, int tid, int wave, int lane) {
    LAS float* sc = lds; LAS float* red = lds + 2048;
    for (int i = tid; i < 2048; i += NTHREADS) { const float v = cvec[i]; sc[i] = v / (1.f + expf(-v)); }
    __syncthreads();
    const int l = u / 96, n = (u % 96) * 64 + lane;
    const float* wp = w_ada + ((size_t)l * 1024 + wave * 128) * 6144 + n;
    float a0 = 0.f, a1 = 0.f;
#pragma unroll 16
    for (int kk = 0; kk < 128; ++kk) { const float w = wp[(size_t)kk * 6144]; a0 += sc[wave * 128 + kk] * w; a1 += sc[1024 + wave * 128 + kk] * w; }
    red[(wave * 2 + 0) * 64 + lane] = a0; red[(wave * 2 + 1) * 64 + lane] = a1;
    __syncthreads();
    if (tid < 128) { const int b = tid >> 6; float s = 0.f;
#pragma unroll
        for (int w = 0; w < 8; ++w) s += red[(w * 2 + b) * 64 + lane];
        mod[((size_t)l * 2 + b) * 6144 + n] = s + b_ada[l * 6144 + n]; }
    __syncthreads();
}

__device__ __forceinline__ void pre_rows(const float* xsrc, const float* g, const float* mod_b0, bf16* XA, float* SSP, int gw, int NGW, int lane) {
    for (int m = gw; m < MROWS; m += NGW) {
        const int b = m / SEQ; const float* mb = mod_b0 + (size_t)b * 6144;
        const GAS f32x4* xr = (const GAS f32x4*)(xsrc + (size_t)m * DM) + lane;
        f32x4 v[4]; float ss = 0.f;
#pragma unroll
        for (int j = 0; j < 4; ++j) { v[j] = xr[64 * j]; ss += (v[j].x * v[j].x + v[j].y * v[j].y) + (v[j].z * v[j].z + v[j].w * v[j].w); }
        const float tot = wave_sum(ss);
        if (lane < 16) SSP[(size_t)m * 16 + lane] = lane == 0 ? tot : 0.f;
        GAS v2u* o8 = (GAS v2u*)(XA + (size_t)m * DM) + lane;
#pragma unroll
        for (int j = 0; j < 4; ++j) { const int col = 4 * lane + 256 * j;
            const f32x4 gg = *(const f32x4*)(g + col), sv = *(const f32x4*)(mb + 1024 + col);
            const f32x4 o = v[j] * gg * (sv + 1.0f);
            v2u w; w.x = pk2(o.x, o.y); w.y = pk2(o.z, o.w); o8[64 * j] = w; }
    }
}
__device__ __forceinline__ void pre_avec(const float* n1g, const float* n2g, const float* MODp, float* AVEC, int gtid, int ngt) {
    for (int i = gtid; i < DEPTH * 2 * 2 * 1024; i += ngt) { const int col = i & 1023, b = (i >> 10) & 1, w = (i >> 11) & 1, l = i >> 12;
        const float g = (w ? n2g : n1g)[l * 1024 + col], sc = MODp[((size_t)l * 2 + b) * 6144 + (w ? 4096 : 1024) + col];
        AVEC[i] = g * (1.f + sc); }
}
__device__ __forceinline__ void pre_bias(const bf16* WT, int nrows, const float* sh0, const float* sh1, float* bias0, float* bias1, int gw, int NGW, int lane) {
    for (int n = gw; n < nrows; n += NGW) {
        float w[16]; unpack8(*(const v4u*)(WT + (size_t)n * 1024 + lane * 16), w); unpack8(*(const v4u*)(WT + (size_t)n * 1024 + lane * 16 + 8), w + 8);
        float a0 = 0.f, a1 = 0.f;
#pragma unroll
        for (int q4 = 0; q4 < 4; ++q4) { const f32x4 s0 = *(const f32x4*)(sh0 + lane * 16 + 4 * q4), s1 = *(const f32x4*)(sh1 + lane * 16 + 4 * q4);
            a0 += (w[4 * q4] * s0.x + w[4 * q4 + 1] * s0.y) + (w[4 * q4 + 2] * s0.z + w[4 * q4 + 3] * s0.w);
            a1 += (w[4 * q4] * s1.x + w[4 * q4 + 1] * s1.y) + (w[4 * q4 + 2] * s1.z + w[4 * q4 + 3] * s1.w); }
        a0 = wave_sum(a0); a1 = wave_sum(a1);
        if (lane == 0) { bias0[n] = a0; bias1[n] = a1; }
    }
}
template <class Sched> __device__ __forceinline__ int rstd_tables(const Sched& S, const float* SSP, LAS float* rt, const float* bias, int bstride, LAS float* bt, int tid,
                                                                  const float* g0 = nullptr, const float* g1 = nullptr, const float* g2 = nullptr, const float* g3 = nullptr, LAS float* gt = nullptr) {
    if (gt && tid < 256) { const float* gp = (tid < 64) ? g0 : (tid < 128) ? g1 : (tid < 192) ? g2 : g3; gt[tid] = gp[tid & 63]; }
    pg8::Unit u; int pm0 = -1, pm1 = -1;
    for (int i = 0; S.next(i, u); ++i) { if (pm0 < 0) pm0 = u.pm; else if (u.pm != pm0 && pm1 < 0) pm1 = u.pm;
        if (tid < 64) *(LAS f32x4*)(bt + i * 256 + tid * 4) = *(const f32x4*)(bias + (size_t)((u.pm * 256) / SEQ) * bstride + u.pn * 256 + tid * 4); }
    if (tid < 256) {
#pragma unroll
        for (int slot = 0; slot < 2; ++slot) { const int pm = slot ? pm1 : pm0;
            if (pm >= 0) { const float* sp = SSP + ((size_t)pm * 256 + tid) * 16;
                const f32x4 a = *(const f32x4*)sp, b = *(const f32x4*)(sp + 4), c = *(const f32x4*)(sp + 8), d = *(const f32x4*)(sp + 12);
                const float s = (((a.x + a.y) + (a.z + a.w)) + ((b.x + b.y) + (b.z + b.w))) + (((c.x + c.y) + (c.z + c.w)) + ((d.x + d.y) + (d.z + d.w)));
                rt[slot * 256 + tid] = 1.f / sqrtf(s * (1.f / DM) + EPS); } }
    }
    __syncthreads();
    return pm0;
}

__device__ __forceinline__ void post_foxcum_unit(int bh, const float* GATESp, float* FOXCUMp, const float* fox_f_bias, LAS float* lds, int tid, int wave, int lane) {
    const int b = bh / 6, h = bh % 6; const float bias = fox_f_bias[h];
    float v[32];
#pragma unroll
    for (int r = 0; r < 32; ++r) { const int t = wave * 2048 + r * 64 + lane; const float x2 = (GATESp[((size_t)b * SEQ + t) * 16 + h] + bias) * LOG2E;
        v[r] = fminf(x2, 0.f) - __builtin_amdgcn_logf(1.f + __builtin_amdgcn_exp2f(-fabsf(x2))); }
    float carry = 0.f;
#pragma unroll
    for (int r = 0; r < 32; ++r) { float x = v[r];
#pragma unroll
        for (int o = 1; o < 64; o <<= 1) { const float n = sup(x, o, lane); if (lane >= o) x += n; }
        x += carry; v[r] = x; carry = shf(x, 63); }
    if (lane == 0) lds[wave] = carry;
    __syncthreads();
    float off = 0.f;
    for (int w = 0; w < wave; ++w) off += lds[w];
#pragma unroll
    for (int r = 0; r < 32; ++r) FOXCUMp[(size_t)bh * SEQ + wave * 2048 + r * 64 + lane] = v[r] + off;
    __syncthreads();
}
__device__ __forceinline__ void post_qknorm_unit(int u, bf16* PROJp, float* KMEANP, const float* gfq, const float* gfk, const float* gbq, const float* gbk, LAS float* lds, int tid, int wave, int lane) {
    const int blk = u >> 1, half = u & 1, sub = lane & 7;
    int colv[3]; float gv[3][8]; float qsv[3];
#pragma unroll
    for (int it = 0; it < 3; ++it) { const int hsel = it * 8 + (lane >> 3), grp = hsel / 6, hh = hsel % 6;
        colv[it] = (grp == 0 ? C_FQ : grp == 1 ? C_FK : grp == 2 ? C_BQ : C_BK) + hh * 64 + 8 * sub;
        const float* gp = (grp == 0 ? gfq : grp == 1 ? gfk : grp == 2 ? gbq : gbk) + 8 * sub;
#pragma unroll
        for (int i = 0; i < 8; ++i) gv[it][i] = gp[i];
        qsv[it] = (grp == 0 || grp == 2) ? QSCALE : 1.f; }
    float ka[8] = {0.f, 0.f, 0.f, 0.f, 0.f, 0.f, 0.f, 0.f};
    const size_t row0 = (size_t)blk * 256 + half * 128 + wave * 16;
#pragma unroll 4
    for (int r = 0; r < 16; ++r) {
#pragma unroll
        for (int it = 0; it < 3; ++it) {
            v4u* p = (v4u*)(PROJp + (row0 + r) * PLD + colv[it]);
            float f[8]; unpack8(*p, f);
            float ss = 0.f;
#pragma unroll
            for (int i = 0; i < 8; ++i) ss += f[i] * f[i];
            ss += SWZ_X(ss, 1); ss += SWZ_X(ss, 2); ss += SWZ_X(ss, 4);
            const float rr = __builtin_amdgcn_rsqf(ss * (1.f / 64.f) + EPS);
#pragma unroll
            for (int i = 0; i < 8; ++i) f[i] = f[i] * rr * gv[it][i];
            if (it == 2) {
#pragma unroll
                for (int i = 0; i < 8; ++i) ka[i] += f[i]; }
            const float qs = qsv[it];
            v4u w; w.x = pk2(f[0] * qs, f[1] * qs); w.y = pk2(f[2] * qs, f[3] * qs); w.z = pk2(f[4] * qs, f[5] * qs); w.w = pk2(f[6] * qs, f[7] * qs);
            *p = w;
        }
    }
    if (lane >= 16) {
#pragma unroll
        for (int i = 0; i < 8; ++i) lds[wave * 384 + ((lane >> 3) - 2) * 64 + 8 * sub + i] = ka[i]; }
    __syncthreads();
    if (tid < 384) { float s = 0.f;
#pragma unroll
        for (int w = 0; w < 8; ++w) s += lds[w * 384 + tid];
        const int b = blk / NBLK, n = blk % NBLK, head = tid >> 6, dd = tid & 63;
        KMEANP[(size_t)half * (12 * NBLK * 64) + (((size_t)b * 6 + head) * NBLK + n) * 64 + dd] = s * (1.f / 256.f); }
    __syncthreads();
}
__device__ __forceinline__ void post_conv_unit(int blk, int which, const bf16* PROJp, bf16* dst, const float* conv_w, const float* conv_b, int tid) {
    const bf16* src = PROJp + (which ? C_MK : C_MQ); const float osc = which ? 0.125f : 1.f;
    const int c = 8 * (tid & 31), rs = tid >> 5, ch = which * 256 + c;
    const size_t r0 = (size_t)blk * 256 + rs * 16; const int tl = (int)(r0 % SEQ);
    float w[4][8], bb[8];
#pragma unroll
    for (int i = 0; i < 4; ++i) { const f32x4 a = *(const f32x4*)(conv_w + i * 512 + ch), b2 = *(const f32x4*)(conv_w + i * 512 + ch + 4);
        w[i][0] = a.x; w[i][1] = a.y; w[i][2] = a.z; w[i][3] = a.w; w[i][4] = b2.x; w[i][5] = b2.y; w[i][6] = b2.z; w[i][7] = b2.w; }
    { const f32x4 a = *(const f32x4*)(conv_b + ch), b2 = *(const f32x4*)(conv_b + ch + 4); bb[0] = a.x; bb[1] = a.y; bb[2] = a.z; bb[3] = a.w; bb[4] = b2.x; bb[5] = b2.y; bb[6] = b2.z; bb[7] = b2.w; }
    float x0[8], x1[8], x2[8], x3[8];
    { v4u h3[3];
#pragma unroll
      for (int k = 0; k < 3; ++k) { if (tl + k - 3 >= 0) h3[k] = *(const v4u*)(src + (r0 + k - 3) * PLD + c); else h3[k] = (v4u){0u, 0u, 0u, 0u}; }
      unpack8(h3[0], x0); unpack8(h3[1], x1); unpack8(h3[2], x2); }
#pragma unroll 1
    for (int hb = 0; hb < 2; ++hb) {
        v4u in[8];
#pragma unroll
        for (int k = 0; k < 8; ++k) in[k] = *(const v4u*)(src + (r0 + hb * 8 + k) * PLD + c);
#pragma unroll
        for (int r = 0; r < 8; ++r) {
            unpack8(in[r], x3);
            float y[8];
#pragma unroll
            for (int i = 0; i < 8; ++i) { const float t = bb[i] + w[0][i] * x0[i] + w[1][i] * x1[i] + w[2][i] * x2[i] + w[3][i] * x3[i];
                y[i] = t * __builtin_amdgcn_rcpf(1.f + __builtin_amdgcn_exp2f(-t * LOG2E)) * osc; x0[i] = x1[i]; x1[i] = x2[i]; x2[i] = x3[i]; }
            v4u o; o.x = pk2(y[0], y[1]); o.y = pk2(y[2], y[3]); o.z = pk2(y[4], y[5]); o.w = pk2(y[6], y[7]);
            *(v4u*)(dst + (r0 + hb * 8 + r) * 256 + c) = o;
        }
    }
}

struct MlP { const bf16* PROJ; const bf16* QC; const bf16* KC; const float* GATES; float* U; float* NU; float* BEND; float* MLOC; bf16* CS; float* NS; float* MS; bf16* Y;
             const float *ibias, *fbias, *hg; };
__device__ __forceinline__ void mlstm_m1(int ci, const MlP& P, LAS float* lds, int tid, int wave, int lane) {
    const int b = ci >> 10, h = (ci >> 8) & 3, c = ci & 255; const size_t row0 = (size_t)b * SEQ + c * 64;
    LAS float* Ks = lds; LAS float* Vs = lds + 4096; LAS float* ws = lds + 8192;
    { const int r = tid >> 3, cg = (tid & 7) * 8; float f[8];
      unpack8(*(const v4u*)(P.KC + (row0 + r) * 256 + h * 64 + cg), f);
#pragma unroll
      for (int i = 0; i < 8; ++i) Ks[r * 64 + cg + i] = f[i];
      unpack8(*(const v4u*)(P.PROJ + (row0 + r) * PLD + C_MV + h * 64 + cg), f);
#pragma unroll
      for (int i = 0; i < 8; ++i) Vs[r * 64 + cg + i] = f[i]; }
    if (wave == 0) {
        const size_t row = row0 + lane;
        const float fi = P.GATES[row * 16 + 6 + h] + P.ibias[h], ff = P.GATES[row * 16 + 10 + h] + P.fbias[h];
        float bc = log_sigmoid_f(ff);
#pragma unroll
        for (int o = 1; o < 64; o <<= 1) { const float n = sup(bc, o, lane); if (lane >= o) bc += n; }
        const float bend = shf(bc, 63);
        const float wl = bend - bc + fi; const float mloc = wave_max(wl);
        ws[lane] = expf(wl - mloc);
        if (lane == 0) { P.BEND[ci] = bend; P.MLOC[ci] = mloc; }
    }
    __syncthreads();
    { const int dv = tid >> 3, e0 = (tid & 7) * 8; float u[8] = {0.f, 0.f, 0.f, 0.f, 0.f, 0.f, 0.f, 0.f};
#pragma unroll 2
      for (int s = 0; s < 64; ++s) { const float vw = Vs[s * 64 + dv] * ws[s]; const f32x4 ka = *(const LAS f32x4*)(Ks + s * 64 + e0), kb = *(const LAS f32x4*)(Ks + s * 64 + e0 + 4);
          u[0] += vw * ka.x; u[1] += vw * ka.y; u[2] += vw * ka.z; u[3] += vw * ka.w; u[4] += vw * kb.x; u[5] += vw * kb.y; u[6] += vw * kb.z; u[7] += vw * kb.w; }
      float* up = P.U + (size_t)ci * 4096 + dv * 64 + e0;
      *(f32x4*)up = (f32x4){u[0], u[1], u[2], u[3]}; *(f32x4*)(up + 4) = (f32x4){u[4], u[5], u[6], u[7]}; }
    if (tid < 64) { float nu = 0.f; for (int s = 0; s < 64; ++s) nu += ws[s] * Ks[s * 64 + tid]; P.NU[(size_t)ci * 64 + tid] = nu; }
    __syncthreads();
}
__device__ __forceinline__ void mlstm_m2(int u, const MlP& P, LAS float* lds, int tid, int wave, int lane) {
    const int bh = u >> 3, eg = u & 7, elem = eg * 512 + tid, base = bh * 256;
    LAS float* decl = lds; LAS float* wul = lds + 256;
    if (wave == 0) {
        const f32x4 b4 = *(const f32x4*)(P.BEND + base + 4 * lane), l4 = *(const f32x4*)(P.MLOC + base + 4 * lane);
        float B = b4.x, L = l4.x;
        B += b4.y; L = fmaxf(L + b4.y, l4.y); B += b4.z; L = fmaxf(L + b4.z, l4.z); B += b4.w; L = fmaxf(L + b4.w, l4.w);
#pragma unroll
        for (int o = 1; o < 64; o <<= 1) { const float Bp = sup(B, o, lane), Lp = sup(L, o, lane); if (lane >= o) { L = fmaxf(Lp + B, L); B = Bp + B; } }
        const float Bex = sup(B, 1, lane), Lex = sup(L, 1, lane);
        float m = (lane == 0) ? 0.f : fmaxf(Bex, Lex);
        const float bb[4] = {b4.x, b4.y, b4.z, b4.w}, ll[4] = {l4.x, l4.y, l4.z, l4.w};
#pragma unroll
        for (int j = 0; j < 4; ++j) { const int c = 4 * lane + j; if (eg == 0) P.MS[base + c] = m;
            const float mn = fmaxf(bb[j] + m, ll[j]);
            decl[c] = __builtin_amdgcn_exp2f((bb[j] + m - mn) * LOG2E); wul[c] = __builtin_amdgcn_exp2f((ll[j] - mn) * LOG2E); m = mn; }
    }
    __syncthreads();
    const bool donorm = (eg == 0 && tid < 64);
    float C = 0.f, nst = 0.f;
#pragma unroll 1
    for (int c0 = 0; c0 < 256; c0 += 16) {
        float uv[16], nv[16];
#pragma unroll
        for (int i = 0; i < 16; ++i) { const int ci = base + c0 + i; uv[i] = bf2f(((const bf16*)P.U)[(size_t)ci * 4096 + elem]); nv[i] = donorm ? P.NU[(size_t)ci * 64 + tid] : 0.f; }
#pragma unroll
        for (int i = 0; i < 16; ++i) { const int ci = base + c0 + i;
            P.CS[(size_t)ci * 4096 + elem] = (bf16)f2bf(C);
            if (donorm) P.NS[(size_t)ci * 64 + tid] = nst;
            const float dec = decl[c0 + i], wu = wul[c0 + i];
            C = dec * C + wu * uv[i]; nst = dec * nst + wu * nv[i]; }
    }
    __syncthreads();
}
__device__ __forceinline__ void mlstm_m3(int ci, const MlP& P, LAS float* lds, int tid, int wave, int lane) {
    constexpr int LP = 68;
    const int b = ci >> 10, h = (ci >> 8) & 3, c = ci & 255; const size_t row0 = (size_t)b * SEQ + c * 64;
    LAS float* Qs = lds; LAS float* Ks = Qs + 64 * LP; LAS float* Cs = Ks + 64 * LP; LAS float* Sm = Cs + 64 * LP; LAS float* Vs = Sm + 64 * LP;
    LAS float* av = Vs + 4096; LAS float* gv = av + 64; LAS float* bcv = gv + 64; LAS float* nsv = bcv + 64;
    const float ms = P.MS[ci];
    { const int r = tid >> 3, cg = (tid & 7) * 8; float f[8];
      unpack8(*(const v4u*)(P.QC + (row0 + r) * 256 + h * 64 + cg), f);
#pragma unroll
      for (int i = 0; i < 8; ++i) Qs[r * LP + cg + i] = f[i];
      unpack8(*(const v4u*)(P.KC + (row0 + r) * 256 + h * 64 + cg), f);
#pragma unroll
      for (int i = 0; i < 8; ++i) Ks[r * LP + cg + i] = f[i];
      unpack8(*(const v4u*)(P.PROJ + (row0 + r) * PLD + C_MV + h * 64 + cg), f);
#pragma unroll
      for (int i = 0; i < 8; ++i) Vs[r * 64 + cg + i] = f[i];
      unpack8(*(const v4u*)(P.CS + (size_t)ci * 4096 + r * 64 + cg), f);
#pragma unroll
      for (int i = 0; i < 8; ++i) Cs[r * LP + cg + i] = f[i]; }
    if (wave == 0) {
        const size_t row = row0 + lane;
        const float fi = P.GATES[row * 16 + 6 + h] + P.ibias[h], ff = P.GATES[row * 16 + 10 + h] + P.fbias[h];
        float bc = log_sigmoid_f(ff);
#pragma unroll
        for (int o = 1; o < 64; o <<= 1) { const float n = sup(bc, o, lane); if (lane >= o) bc += n; }
        const float a = fi - bc; float pm = a;
#pragma unroll
        for (int o = 1; o < 64; o <<= 1) { const float n = sup(pm, o, lane); if (lane >= o) pm = fmaxf(pm, n); }
        av[lane] = a; gv[lane] = fmaxf(ms, pm); bcv[lane] = bc; nsv[lane] = P.NS[(size_t)ci * 64 + lane];
    }
    __syncthreads();
    const int j = tid >> 3, part = tid & 7, s0 = part * 8;
    const float gj = gv[j];
    { float sacc[8] = {0.f, 0.f, 0.f, 0.f, 0.f, 0.f, 0.f, 0.f};
#pragma unroll 1
      for (int e = 0; e < 64; e += 4) { const f32x4 q4 = *(const LAS f32x4*)(Qs + j * LP + e);
#pragma unroll
          for (int i = 0; i < 8; ++i) { const f32x4 k4 = *(const LAS f32x4*)(Ks + (s0 + i) * LP + e); sacc[i] += (q4.x * k4.x + q4.y * k4.y) + (q4.z * k4.z + q4.w * k4.w); } }
#pragma unroll
      for (int i = 0; i < 8; ++i) { const int s = s0 + i; Sm[j * LP + s] = (s <= j) ? sacc[i] * expf(av[s] - gj) : 0.f; } }
    __syncthreads();
    { const int dv0 = part * 8; float t1[8] = {0.f, 0.f, 0.f, 0.f, 0.f, 0.f, 0.f, 0.f}, t2[8] = {0.f, 0.f, 0.f, 0.f, 0.f, 0.f, 0.f, 0.f};
#pragma unroll 1
      for (int e = 0; e < 64; e += 4) { const f32x4 q4 = *(const LAS f32x4*)(Qs + j * LP + e);
#pragma unroll
          for (int i = 0; i < 8; ++i) { const f32x4 c4 = *(const LAS f32x4*)(Cs + (dv0 + i) * LP + e); t1[i] += (q4.x * c4.x + q4.y * c4.y) + (q4.z * c4.z + q4.w * c4.w); } }
#pragma unroll 2
      for (int s = 0; s < 64; ++s) { const float sm = Sm[j * LP + s]; const f32x4 va = *(const LAS f32x4*)(Vs + s * 64 + dv0), vb = *(const LAS f32x4*)(Vs + s * 64 + dv0 + 4);
          t2[0] += sm * va.x; t2[1] += sm * va.y; t2[2] += sm * va.z; t2[3] += sm * va.w; t2[4] += sm * vb.x; t2[5] += sm * vb.y; t2[6] += sm * vb.z; t2[7] += sm * vb.w; }
      float dn = 0.f, ssum = 0.f;
#pragma unroll
      for (int i = 0; i < 8; ++i) { dn += nsv[s0 + i] * Qs[j * LP + s0 + i]; ssum += Sm[j * LP + s0 + i]; }
      { dn += SWZ_X(dn, 1); ssum += SWZ_X(ssum, 1); dn += SWZ_X(dn, 2); ssum += SWZ_X(ssum, 2); dn += SWZ_X(dn, 4); ssum += SWZ_X(ssum, 4); }
      const float inter = expf(ms - gj), mj = bcv[j] + gj;
      const float den = inter * dn + ssum, dd = fmaxf(fabsf(den), expf(-mj)), rd = 1.f / dd;
      float hv[8], ss = 0.f;
#pragma unroll
      for (int i = 0; i < 8; ++i) { hv[i] = (inter * t1[i] + t2[i]) * rd; ss += hv[i] * hv[i]; }
      { ss += SWZ_X(ss, 1); ss += SWZ_X(ss, 2); ss += SWZ_X(ss, 4); }
      const float rr = 1.f / sqrtf(ss * (1.f / 64.f) + EPS);
      float mo[8]; unpack8(*(const v4u*)(P.PROJ + (row0 + j) * PLD + C_MO + h * 64 + dv0), mo);
      float y[8];
#pragma unroll
      for (int i = 0; i < 8; ++i) y[i] = hv[i] * rr * P.hg[h * 64 + dv0 + i] * sigmoid_f(mo[i]);
      v4u w; w.x = pk2(y[0], y[1]); w.y = pk2(y[2], y[3]); w.z = pk2(y[4], y[5]); w.w = pk2(y[6], y[7]);
      *(v4u*)(P.Y + (row0 + j) * 1024 + Y_ML + h * 64 + dv0) = w; }
    __syncthreads();
}

__device__ __forceinline__ size_t moba_list_off(int bh, int n);
__device__ __forceinline__ void moba_gate_unit(int u, const bf16* PROJ, const float* KMEAN, unsigned* SEL, unsigned* LCNT, unsigned* CTAB, unsigned short* LIST, float B2, float thresh2, LAS float* lds, int tid) {
    const int bh = u >> 6, qb = 63 - (u & 63), b = bh / 6, h = bh % 6;
    LAS float* km = lds; LAS float* cand = lds + 4096; LAS unsigned* cntl = (LAS unsigned*)(lds + 4096 + 1536);
    if (tid < 64) cntl[tid] = 0u;
    for (int i = tid; i < qb * 16; i += NTHREADS) *(LAS f32x4*)(km + i * 4) = *(const f32x4*)(KMEAN + (size_t)bh * NBLK * 64 + i * 4) + *(const f32x4*)(KMEAN + (size_t)(12 * NBLK * 64) + (size_t)bh * NBLK * 64 + i * 4);
    __syncthreads();
    const int query = tid & 255, half = tid >> 8; const size_t row = (size_t)b * SEQ + qb * 256 + query;
    float q[64];
#pragma unroll
    for (int i = 0; i < 8; ++i) unpack8(*(const v4u*)(PROJ + row * PLD + C_BQ + h * 64 + i * 8), q + i * 8);
    float v0 = -INFINITY, v1 = -INFINITY, v2 = -INFINITY; int i0 = 255, i1 = 255, i2 = 255;
    const int nlo = half * 32, nhi = (qb < nlo + 32) ? qb : nlo + 32;
    for (int n = nlo; n < nhi; ++n) { float g = 0.f;
#pragma unroll
        for (int d = 0; d < 64; d += 4) { const f32x4 k4 = *(const LAS f32x4*)(km + n * 64 + d); g += (q[d] * k4.x + q[d + 1] * k4.y) + (q[d + 2] * k4.z + q[d + 3] * k4.w); }
        if (g > v0) { v2 = v1; i2 = i1; v1 = v0; i1 = i0; v0 = g; i0 = n; } else if (g > v1) { v2 = v1; i2 = i1; v1 = g; i1 = n; } else if (g > v2) { v2 = g; i2 = n; } }
    if (half == 1) { cand[query * 6 + 0] = v0; cand[query * 6 + 1] = v1; cand[query * 6 + 2] = v2;
        cand[query * 6 + 3] = __int_as_float(i0); cand[query * 6 + 4] = __int_as_float(i1); cand[query * 6 + 5] = __int_as_float(i2); }
    __syncthreads();
    if (half == 0) {
#pragma unroll
        for (int k = 0; k < 3; ++k) { const float g = cand[query * 6 + k]; const int n = __float_as_int(cand[query * 6 + 3 + k]);
            if (n != 255) { if (g > v0) { v2 = v1; i2 = i1; v1 = v0; i1 = i0; v0 = g; i0 = n; } else if (g > v1) { v2 = v1; i2 = i1; v1 = g; i1 = n; } else if (g > v2) { v2 = g; i2 = n; } } }
        { const float slope2 = exp2f(-8.f * (float)(h + 1) / 6.f) * LOG2E; const float lim = (2.f * B2 + thresh2) / slope2; const int t0 = qb * 256 + query - 255;
          if (i0 != 255 && (float)(t0 - i0 * 256) > lim) i0 = 255;
          if (i1 != 255 && (float)(t0 - i1 * 256) > lim) i1 = 255;
          if (i2 != 255 && (float)(t0 - i2 * 256) > lim) i2 = 255; }
        SEL[row * 6 + h] = (unsigned)i0 | ((unsigned)i1 << 8) | ((unsigned)i2 << 16);
        if (LIST) { const unsigned t = (unsigned)(qb * 256 + query);
            if (i0 != 255) { const unsigned pos = __hip_atomic_fetch_add(cntl + i0, 1u, __ATOMIC_RELAXED, __HIP_MEMORY_SCOPE_WORKGROUP); LIST[moba_list_off(bh, i0) + (size_t)(qb - i0 - 1) * 256 + pos] = (unsigned short)(t | (0u << 14)); }
            if (i1 != 255) { const unsigned pos = __hip_atomic_fetch_add(cntl + i1, 1u, __ATOMIC_RELAXED, __HIP_MEMORY_SCOPE_WORKGROUP); LIST[moba_list_off(bh, i1) + (size_t)(qb - i1 - 1) * 256 + pos] = (unsigned short)(t | (1u << 14)); }
            if (i2 != 255) { const unsigned pos = __hip_atomic_fetch_add(cntl + i2, 1u, __ATOMIC_RELAXED, __HIP_MEMORY_SCOPE_WORKGROUP); LIST[moba_list_off(bh, i2) + (size_t)(qb - i2 - 1) * 256 + pos] = (unsigned short)(t | (2u << 14)); } }
    }
    __syncthreads();
    if (LIST && tid < 64) { const unsigned c = cntl[tid]; CTAB[((size_t)bh * 64 + qb) * 64 + tid] = c; if (c) atomicAdd(LCNT + bh * 64 + tid, c); }
    __syncthreads();
}

__device__ __forceinline__ void fox_naive(const bf16* PROJ, const float* FOXCUM, bf16* Y, int gw, int NGW, int lane) {
    for (int idx = gw; idx < 12 * SEQ; idx += NGW) {
        const int t = SEQ - 1 - idx / 12, bh = idx % 12, b = bh / 6, h = bh % 6; const size_t rb = (size_t)b * SEQ;
        const float qv = bf2f(PROJ[(rb + t) * PLD + C_FQ + h * 64 + lane]); const float ct = FOXCUM[(size_t)bh * SEQ + t];
        float m = -INFINITY, l = 0.f, acc = 0.f;
#pragma unroll 4
        for (int j = 0; j <= t; ++j) {
            const float kv = bf2f(PROJ[(rb + j) * PLD + C_FK + h * 64 + lane]), vv = bf2f(PROJ[(rb + j) * PLD + C_FV + h * 64 + lane]);
            const float s = wave_sum(qv * kv) + (ct - FOXCUM[(size_t)bh * SEQ + j]);
            const float mn = fmaxf(m, s), sc = exp2f(m - mn), p = exp2f(s - mn);
            l = l * sc + p; acc = acc * sc + p * vv; m = mn; }
        Y[(rb + t) * 1024 + Y_FOX + h * 64 + lane] = (bf16)f2bf(acc / l);
    }
}
__device__ __forceinline__ void moba_naive(const bf16* PROJ, const unsigned* SEL, bf16* Y, int gw, int NGW, int lane) {
    for (int idx = gw; idx < 12 * SEQ; idx += NGW) {
        const int t = SEQ - 1 - idx / 12, bh = idx % 12, b = bh / 6, h = bh % 6; const size_t rb = (size_t)b * SEQ;
        const float slope2 = exp2f(-8.f * (float)(h + 1) / 6.f) * LOG2E;
        const float qv = bf2f(PROJ[(rb + t) * PLD + C_BQ + h * 64 + lane]);
        const unsigned sel = SEL[(rb + t) * 6 + h];
        float m = -INFINITY, l = 0.f, acc = 0.f;
        for (int slot = 0; slot < 4; ++slot) {
            int j0, j1;
            if (slot < 3) { const int n = (sel >> (8 * slot)) & 0xff; if (n == 255) continue; j0 = n * 256; j1 = j0 + 256; } else { j0 = (t >> 8) * 256; j1 = t + 1; }
#pragma unroll 4
            for (int j = j0; j < j1; ++j) {
                const float kv = bf2f(PROJ[(rb + j) * PLD + C_BK + h * 64 + lane]), vv = bf2f(PROJ[(rb + j) * PLD + C_BV + h * 64 + lane]);
                const float s = wave_sum(qv * kv) - slope2 * (float)(t - j);
                const float mn = fmaxf(m, s), sc = exp2f(m - mn), p = exp2f(s - mn);
                l = l * sc + p; acc = acc * sc + p * vv; m = mn; }
        }
        Y[(rb + t) * 1024 + Y_MOBA + h * 64 + lane] = (bf16)f2bf(acc / l);
    }
}
typedef short v4i16_t __attribute__((ext_vector_type(4)));
typedef short s16x4 __attribute__((ext_vector_type(4)));
constexpr int ATT_K0 = 0, ATT_V0 = 32768, ATT_TAB = 132096;
#ifndef THRESH_NAT
#define THRESH_NAT 20.f
#endif
constexpr float THRESH2 = THRESH_NAT * LOG2E;

__device__ __forceinline__ int crow(int r, int hi) { return (r & 3) + 8 * (r >> 2) + 4 * hi; }
__device__ __forceinline__ s16x4 vtr(LAS const unsigned char* p) { return __builtin_bit_cast(s16x4, __builtin_amdgcn_ds_read_tr16_b64_v4i16((LAS v4i16_t*)p)); }
typedef float f32x2_t __attribute__((ext_vector_type(2))); typedef __bf16 bf16x2_t __attribute__((ext_vector_type(2)));
#ifndef CVT_ASM
#define CVT_ASM 0
#endif
#if CVT_ASM
__device__ __forceinline__ unsigned cvtpk(float lo, float hi) { unsigned r; asm volatile("v_cvt_pk_bf16_f32 %0, %1, %2\n\ts_nop 1" : "=v"(r) : "v"(lo), "v"(hi)); return r; }
#else
__device__ __forceinline__ unsigned cvtpk(float lo, float hi) { const f32x2_t v = {lo, hi}; const bf16x2_t b = __builtin_convertvector(v, bf16x2_t); return __builtin_bit_cast(unsigned, b); }
#endif

struct GroupRegs { v4u k[4], v[4]; };
__device__ __forceinline__ void group_issue(GroupRegs& R, const bf16* Kg, const bf16* Vg, int tid) {
#pragma unroll
    for (int i = 0; i < 4; ++i) { const int idx = tid + NTHREADS * i, row = idx >> 3, ch = idx & 7;
        R.k[i] = *(const v4u*)(Kg + (size_t)row * PLD + ch * 8); R.v[i] = *(const v4u*)(Vg + (size_t)row * PLD + ch * 8); }
}
__device__ __forceinline__ void group_commit(const GroupRegs& R, LAS unsigned char* kv, int tid) {
#pragma unroll
    for (int i = 0; i < 4; ++i) { const int idx = tid + NTHREADS * i, row = idx >> 3, ch = idx & 7;
        *(LAS v4u*)(kv + ATT_K0 + row * 128 + ((ch ^ ((row >> 1) & 7)) << 4)) = R.k[i];
        *(LAS v4u*)(kv + ATT_V0 + row * 128 + ((ch * 16) ^ (((row >> 1) & 1) << 6))) = R.v[i]; }
}
__device__ __forceinline__ void load_group(const bf16* Kg, const bf16* Vg, LAS unsigned char* kv, int tid) {
#pragma unroll
    for (int i = 0; i < 4; ++i) { const int idx = tid + NTHREADS * i, row = idx >> 3, ch = idx & 7;
        const v4u k = *(const v4u*)(Kg + (size_t)row * PLD + ch * 8), v = *(const v4u*)(Vg + (size_t)row * PLD + ch * 8);
        *(LAS v4u*)(kv + ATT_K0 + row * 128 + ((ch ^ ((row >> 1) & 7)) << 4)) = k;
        *(LAS v4u*)(kv + ATT_V0 + row * 128 + ((ch * 16) ^ (((row >> 1) & 1) << 6))) = v; }
}

template <bool FOX>
__device__ __forceinline__ void attn_subtile(LAS const unsigned char* kv, LAS const float* colt, int j0, const bf16x8 (&qf)[4], float rowterm, float slope2, bool mask, int qrel,
                                             f32x16 (&o)[2], float& l, int lane) {
    const int r32 = lane & 31, hh = lane >> 5;
    f32x16 acc;
    if (FOX) {
#pragma unroll
        for (int g = 0; g < 4; ++g) { const f32x4 c = *(LAS const f32x4*)(colt + j0 + 8 * g + 4 * hh); acc[4 * g + 0] = rowterm + c.x; acc[4 * g + 1] = rowterm + c.y; acc[4 * g + 2] = rowterm + c.z; acc[4 * g + 3] = rowterm + c.w; }
    } else {
#pragma unroll
        for (int r = 0; r < 16; ++r) acc[r] = rowterm + slope2 * (float)(j0 + crow(r, hh));
    }
    if (mask) {
#pragma unroll
        for (int r = 0; r < 16; ++r) if (j0 + crow(r, hh) > qrel) acc[r] = -INFINITY;
    }
    { const int row = j0 + r32; LAS const unsigned char* kr = kv + ATT_K0 + row * 128; const int sw = (row >> 1) & 7;
#pragma unroll
      for (int s = 0; s < 4; ++s) { const bf16x8 kf = *(LAS const bf16x8*)(kr + (((2 * s + hh) ^ sw) << 4)); acc = __builtin_amdgcn_mfma_f32_32x32x16_bf16(kf, qf[s], acc, 0, 0, 0); } }
    float ls = 0.f;
#pragma unroll
    for (int r = 0; r < 16; ++r) { acc[r] = __builtin_amdgcn_exp2f(acc[r]); ls += acc[r]; }
    l += ls;
    bf16x8 pa[2];
#pragma unroll
    for (int s = 0; s < 2; ++s) { v4u w; w.x = cvtpk(acc[8 * s + 0], acc[8 * s + 1]); w.y = cvtpk(acc[8 * s + 2], acc[8 * s + 3]); w.z = cvtpk(acc[8 * s + 4], acc[8 * s + 5]); w.w = cvtpk(acc[8 * s + 6], acc[8 * s + 7]); pa[s] = __builtin_bit_cast(bf16x8, w); }
    { const int i = lane & 15, c = (lane >> 4) & 1;
#pragma unroll
      for (int db = 0; db < 2; ++db)
#pragma unroll
          for (int s = 0; s < 2; ++s) { const int rowv = j0 + 16 * s + 4 * hh + (i >> 2); const int colb = (32 * db + 16 * c + 4 * (i & 3)) * 2;
              LAS const unsigned char* vp = kv + ATT_V0 + rowv * 128 + (colb ^ (((rowv >> 1) & 1) << 6));
              const s16x4 lo = vtr(vp), hi = vtr(vp + 8 * 128);
              const bf16x8 vf = (bf16x8){lo[0], lo[1], lo[2], lo[3], hi[0], hi[1], hi[2], hi[3]};
              o[db] = __builtin_amdgcn_mfma_f32_32x32x16_bf16(pa[s], vf, o[db], 0, 0, 0); } }
}
__device__ __forceinline__ float rfl(float x) { return __builtin_bit_cast(float, __builtin_amdgcn_readfirstlane(__builtin_bit_cast(int, x))); }

#ifndef FOX_2G
#define FOX_2G 1
#endif
__device__ __forceinline__ void fox_unit(int bh, int qb, const bf16* PROJ, const float* FOXCUM, bf16* Y, float B2, LAS unsigned char* lds, int tid, int wave, int lane) {
    const int b = bh / 6, h = bh % 6; const size_t rb = (size_t)b * SEQ; const int r32 = lane & 31, hh = lane >> 5;
    const int q0w = qb * 256 + wave * 32, qpos = q0w + r32;
    const float* cum = FOXCUM + (size_t)bh * SEQ;
    bf16x8 qf[4];
#pragma unroll
    for (int s = 0; s < 4; ++s) qf[s] = *(const bf16x8*)(PROJ + (rb + qpos) * PLD + C_FQ + h * 64 + 16 * s + 8 * hh);
    GroupRegs GA, GB;
    group_issue(GA, PROJ + (rb + (size_t)qb * 256) * PLD + C_FK + h * 64, PROJ + (rb + (size_t)qb * 256) * PLD + C_FV + h * 64, tid);
    const float ca = (tid < 256) ? -cum[qb * 256 + tid] : 0.f;
    const float cq = cum[qpos];
    const float cq_first_v = cum[q0w], cq_blk_v = cum[qb * 256];
    const float cprev_v = (qb > 0) ? cum[qb * 256 - 1] : 0.f;
    const float cprev2_v = (qb > 1) ? cum[(qb - 1) * 256 - 1] : 0.f;
    float cb = 0.f;
    if (FOX_2G && qb > 0) { group_issue(GB, PROJ + (rb + (size_t)(qb - 1) * 256) * PLD + C_FK + h * 64, PROJ + (rb + (size_t)(qb - 1) * 256) * PLD + C_FV + h * 64, tid);
        cb = (tid < 256) ? -cum[(qb - 1) * 256 + tid] : 0.f; }
    const float cq_first = rfl(cq_first_v), cq_blk = rfl(cq_blk_v), cprev = rfl(cprev_v), cprev2 = rfl(cprev2_v);
    const float rowterm = cq - B2, lim = -THRESH2 - 2.f * B2;
    f32x16 o[2]; float l = 0.f;
#pragma unroll
    for (int r = 0; r < 16; ++r) { o[0][r] = 0.f; o[1][r] = 0.f; }
    LAS float* coltA = (LAS float*)(lds + ATT_TAB); LAS float* coltB = coltA + 256;
    LAS unsigned char* kvA = lds; LAS unsigned char* kvB = lds + 65536;
    const bool haveB = FOX_2G && (qb > 0) && !(cq_blk - cprev < lim);
    group_commit(GA, kvA, tid); if (tid < 256) coltA[tid] = ca;
    if (haveB) { group_commit(GB, kvB, tid); if (tid < 256) coltB[tid] = cb; }
    __syncthreads();
#ifndef REP_FLOAD
#define REP_FLOAD 0
#endif
#pragma unroll 1
    for (int rp = 0; rp < REP_FLOAD; ++rp) {
        group_issue(GA, PROJ + (rb + (size_t)qb * 256) * PLD + C_FK + h * 64, PROJ + (rb + (size_t)qb * 256) * PLD + C_FV + h * 64, tid);
        if (haveB) group_issue(GB, PROJ + (rb + (size_t)(qb - 1) * 256) * PLD + C_FK + h * 64, PROJ + (rb + (size_t)(qb - 1) * 256) * PLD + C_FV + h * 64, tid);
        group_commit(GA, kvA, tid); if (haveB) group_commit(GB, kvB, tid);
        __syncthreads(); }
#ifndef REP_FSUB
#define REP_FSUB 0
#endif
#pragma unroll 1
    for (int rp = 0; rp <= REP_FSUB; ++rp) {
    if (rp) { l = 0.f;
#pragma unroll
        for (int r = 0; r < 16; ++r) { o[0][r] = 0.f; o[1][r] = 0.f; } }
#pragma unroll 1
    for (int st = wave; st >= 0; --st) {
        const int j0 = 32 * st;
        if (cq_first + rfl(coltA[j0 + 31]) < lim) break;
        attn_subtile<true>(kvA, coltA, j0, qf, rowterm, 0.f, st == wave, wave * 32 + r32, o, l, lane);
    }
    if (haveB) {
#pragma unroll 1
        for (int st = 7; st >= 0; --st) {
            const int j0 = 32 * st;
            if (cq_first + rfl(coltB[j0 + 31]) < lim) break;
            attn_subtile<true>(kvB, coltB, j0, qf, rowterm, 0.f, false, 0, o, l, lane);
        }
    }
    }
    __syncthreads();
    {
        const int g0 = haveB ? qb - 2 : qb - 1;
        for (int g = g0; g >= 0; --g) {
            const float cend = (g == g0) ? (haveB ? cprev2 : cprev) : rfl(cum[g * 256 + 255]);
            if (cq_blk - cend < lim) break;
            load_group(PROJ + (rb + (size_t)g * 256) * PLD + C_FK + h * 64, PROJ + (rb + (size_t)g * 256) * PLD + C_FV + h * 64, kvA, tid);
            if (tid < 256) coltA[tid] = -cum[g * 256 + tid];
            __syncthreads();
            {
#pragma unroll 1
                for (int st = 7; st >= 0; --st) {
                    const int j0 = 32 * st;
                    if (cq_first + rfl(coltA[j0 + 31]) < lim) break;
                    attn_subtile<true>(kvA, coltA, j0, qf, rowterm, 0.f, false, 0, o, l, lane);
                }
            }
            __syncthreads();
        }
    }
    l = half_sum(l, lane);
    bf16* yp = Y + (rb + (size_t)q0w) * 1024 + Y_FOX + h * 64 + r32;
#ifndef REP_FOUT
#define REP_FOUT 0
#endif
#pragma unroll 1
    for (int rp = 0; rp <= REP_FOUT; ++rp) {
#pragma unroll
    for (int r = 0; r < 16; ++r) { const int q = crow(r, hh); const float rl = __builtin_amdgcn_rcpf(shf(l, q));
        yp[(size_t)q * 1024] = (bf16)f2bf(o[0][r] * rl); yp[(size_t)q * 1024 + 32] = (bf16)f2bf(o[1][r] * rl); }
    }
}

struct FoxPre { GroupRegs GA; float ca, cq, cq_first, cq_blk, cprev; bf16x8 qf[4]; };
__device__ __forceinline__ void fox_issue(FoxPre& R, int bh, int qb, const bf16* PROJ, const float* FOXCUM, int tid, int wave, int lane) {
    const int b = bh / 6, h = bh % 6; const size_t rb = (size_t)b * SEQ; const int r32 = lane & 31, hh = lane >> 5;
    const int q0w = qb * 256 + wave * 32, qpos = q0w + r32;
    const float* cum = FOXCUM + (size_t)bh * SEQ;
#pragma unroll
    for (int s = 0; s < 4; ++s) R.qf[s] = *(const bf16x8*)(PROJ + (rb + qpos) * PLD + C_FQ + h * 64 + 16 * s + 8 * hh);
    group_issue(R.GA, PROJ + (rb + (size_t)qb * 256) * PLD + C_FK + h * 64, PROJ + (rb + (size_t)qb * 256) * PLD + C_FV + h * 64, tid);
    R.ca = (tid < 256) ? -cum[qb * 256 + tid] : 0.f;
    R.cq = cum[qpos]; R.cq_first = cum[q0w]; R.cq_blk = cum[qb * 256];
    R.cprev = (qb > 0) ? cum[qb * 256 - 1] : 0.f;
}
__device__ __forceinline__ void fox_phase_pipe(const bf16* PROJ, const float* FOXCUM, bf16* Y, float B2, LAS unsigned char* lds, int vcu, int G, int tid0, int wave, int lane0) {
    LAS float* coltA = (LAS float*)(lds + ATT_TAB); LAS float* coltB = coltA + 256;
    LAS unsigned char* kvA = lds; LAS unsigned char* kvB = lds + 65536;
    const float lim = -THRESH2 - 2.f * B2;
    int u = vcu; if (u >= 768) return;
    FoxPre R; fox_issue(R, u >> 6, 63 - (u & 63), PROJ, FOXCUM, tid0, wave, lane0);
    for (;;) {
        int tid = tid0; asm volatile("" : "+v"(tid)); const int lane = tid & 63, r32 = lane & 31, hh = lane >> 5;
        const int bh = u >> 6, qb = 63 - (u & 63), b = bh / 6, h = bh % 6; const size_t rb = (size_t)b * SEQ; const int q0w = qb * 256 + wave * 32;
        const float* cum = FOXCUM + (size_t)bh * SEQ;
        const float cq_first = rfl(R.cq_first), cq_blk = rfl(R.cq_blk), cprev = rfl(R.cprev); const float rowterm = R.cq - B2;
        const bool haveB = (qb > 0) && !(cq_blk - cprev < lim);
        bf16x8 qf[4];
#pragma unroll
        for (int s = 0; s < 4; ++s) qf[s] = R.qf[s];
        GroupRegs GB; float cb = 0.f;
        if (haveB) { group_issue(GB, PROJ + (rb + (size_t)(qb - 1) * 256) * PLD + C_FK + h * 64, PROJ + (rb + (size_t)(qb - 1) * 256) * PLD + C_FV + h * 64, tid);
            cb = (tid < 256) ? -cum[(qb - 1) * 256 + tid] : 0.f; }
        group_commit(R.GA, kvA, tid); if (tid < 256) coltA[tid] = R.ca;
        if (haveB) { group_commit(GB, kvB, tid); if (tid < 256) coltB[tid] = cb; }
        __syncthreads();
        const int un = u + G;
        if (un < 768) fox_issue(R, un >> 6, 63 - (un & 63), PROJ, FOXCUM, tid, wave, lane);
        f32x16 o[2]; float l = 0.f;
#pragma unroll
        for (int r = 0; r < 16; ++r) { o[0][r] = 0.f; o[1][r] = 0.f; }
#pragma unroll 1
        for (int st = wave; st >= 0; --st) {
            const int j0 = 32 * st;
            if (cq_first + rfl(coltA[j0 + 31]) < lim) break;
            attn_subtile<true>(kvA, coltA, j0, qf, rowterm, 0.f, st == wave, wave * 32 + r32, o, l, lane);
        }
        if (haveB) {
#pragma unroll 1
            for (int st = 7; st >= 0; --st) {
                const int j0 = 32 * st;
                if (cq_first + rfl(coltB[j0 + 31]) < lim) break;
                attn_subtile<true>(kvB, coltB, j0, qf, rowterm, 0.f, false, 0, o, l, lane);
            }
        }
        __syncthreads();
        for (int g = haveB ? qb - 2 : qb - 1; g >= 0; --g) {
            if (cq_blk - rfl(cum[g * 256 + 255]) < lim) break;
            load_group(PROJ + (rb + (size_t)g * 256) * PLD + C_FK + h * 64, PROJ + (rb + (size_t)g * 256) * PLD + C_FV + h * 64, kvA, tid);
            if (tid < 256) coltA[tid] = -cum[g * 256 + tid];
            __syncthreads();
#pragma unroll 1
            for (int st = 7; st >= 0; --st) {
                const int j0 = 32 * st;
                if (cq_first + rfl(coltA[j0 + 31]) < lim) break;
                attn_subtile<true>(kvA, coltA, j0, qf, rowterm, 0.f, false, 0, o, l, lane);
            }
            __syncthreads();
        }
        l = half_sum(l, lane);
        bf16* yp = Y + (rb + (size_t)q0w) * 1024 + Y_FOX + h * 64 + r32;
#pragma unroll
        for (int r = 0; r < 16; ++r) { const int q = crow(r, hh); const float rl = __builtin_amdgcn_rcpf(shf(l, q));
            yp[(size_t)q * 1024] = (bf16)f2bf(o[0][r] * rl); yp[(size_t)q * 1024 + 32] = (bf16)f2bf(o[1][r] * rl); }
        if (un >= 768) break;
        u = un;
    }
}

__device__ __forceinline__ void fox_unit_old(int bh, int qb, const bf16* PROJ, const float* FOXCUM, bf16* Y, float B2, LAS unsigned char* lds, int tid, int wave, int lane) {
    const int b = bh / 6, h = bh % 6; const size_t rb = (size_t)b * SEQ; const int r32 = lane & 31, hh = lane >> 5;
    const int q0w = qb * 256 + wave * 32, qpos = q0w + r32;
    const float* cum = FOXCUM + (size_t)bh * SEQ;
    bf16x8 qf[4];
#pragma unroll
    for (int s = 0; s < 4; ++s) qf[s] = *(const bf16x8*)(PROJ + (rb + qpos) * PLD + C_FQ + h * 64 + 16 * s + 8 * hh);
    const float cq = cum[qpos];
    const float cq_first = rfl(cum[q0w]);
    const float cq_blk = rfl(cum[qb * 256]);
    const float rowterm = cq - B2;
    f32x16 o[2]; float l = 0.f;
#pragma unroll
    for (int r = 0; r < 16; ++r) { o[0][r] = 0.f; o[1][r] = 0.f; }
    LAS float* colt = (LAS float*)(lds + ATT_TAB);
    for (int g = qb; g >= 0; --g) {
        if (g < qb) { const float cl = rfl(cum[g * 256 + 255]); if (2.f * B2 + cq_blk - cl < -THRESH2) break; }
        load_group(PROJ + (rb + (size_t)g * 256) * PLD + C_FK + h * 64, PROJ + (rb + (size_t)g * 256) * PLD + C_FV + h * 64, lds, tid);
        if (tid < 256) colt[tid] = -cum[g * 256 + tid];
        __syncthreads();
        const int stmax = (g == qb) ? wave : 7;
        for (int st = stmax; st >= 0; --st) {
            const int j0 = 32 * st;
            { const float cl = rfl(colt[j0 + 31]); if (2.f * B2 + cq_first + cl < -THRESH2) break; }
            attn_subtile<true>(lds, colt, j0, qf, rowterm, 0.f, (g == qb) && (st == wave), wave * 32 + r32, o, l, lane);
        }
        __syncthreads();
    }
    l = half_sum(l, lane);
    bf16* yp = Y + (rb + (size_t)q0w) * 1024 + Y_FOX + h * 64 + r32;
#pragma unroll
    for (int r = 0; r < 16; ++r) { const int q = crow(r, hh); const float rl = __builtin_amdgcn_rcpf(shf(l, q));
        yp[(size_t)q * 1024] = (bf16)f2bf(o[0][r] * rl); yp[(size_t)q * 1024 + 32] = (bf16)f2bf(o[1][r] * rl); }
}

__device__ __forceinline__ size_t moba_list_off(int bh, int n) { return (size_t)bh * 516096 + 256 * (size_t)(63 * n - (n * (n - 1)) / 2); }
__device__ __forceinline__ void moba_store(const f32x16 (&o)[2], float l, int qpos, int slot, bool valid, size_t rb, int h, bf16* OPART, float* LPART, bf16* Y, int lane) {
    const int r32 = lane & 31, hh = lane >> 5;
#pragma unroll
    for (int r = 0; r < 16; ++r) { const int src = crow(r, hh);
        const int qp = shfi(qpos, src), sl = shfi(slot, src); const int ok = shfi((int)valid, src);
        if (ok) { bf16* op = (sl == 3) ? (Y + (rb + qp) * 1024 + Y_MOBA + h * 64) : (OPART + ((size_t)sl * MROWS + rb + qp) * 384 + h * 64);
            op[r32] = (bf16)f2bf(o[0][r]); op[32 + r32] = (bf16)f2bf(o[1][r]); } }
    if (valid && hh == 0) LPART[((size_t)slot * MROWS + rb + qpos) * 6 + h] = l;
}
__device__ __forceinline__ void moba_sel_unit(int bh, int n, int chunk, int cnt, const bf16* PROJ, const unsigned short* LIST, const unsigned* CTAB, bf16* OPART, float* LPART, bf16* Y, float B2,
                                              LAS unsigned char* lds, int tid, int wave, int lane) {
    const int b = bh / 6, h = bh % 6; const size_t rb = (size_t)b * SEQ; const int r32 = lane & 31, hh = lane >> 5;
    const float slope2 = exp2f(-8.f * (float)(h + 1) / 6.f) * LOG2E;
    GroupRegs GR; group_issue(GR, PROJ + (rb + (size_t)n * 256) * PLD + C_BK + h * 64, PROJ + (rb + (size_t)n * 256) * PLD + C_BV + h * 64, tid);
    const int nvalid = cnt - chunk * 256 < 256 ? cnt - chunk * 256 : 256;
    const bool active = wave * 32 < nvalid;
    bool valid = true; int qpos = 0, slot = 0; bf16x8 qf[4];
    if (active) {
        int li = wave * 32 + r32; if (li >= nvalid) { li = nvalid - 1; valid = false; }
        const int p = chunk * 256 + li;
        const int cv = (lane > n) ? (int)CTAB[((size_t)bh * 64 + lane) * 64 + n] : 0; int inc = cv;
#pragma unroll
        for (int o2 = 1; o2 < 64; o2 <<= 1) { const int t2 = supi(inc, o2, lane); if (lane >= o2) inc += t2; }
        int qseg = 0;
#pragma unroll
        for (int stp = 32; stp >= 1; stp >>= 1) { const int v = shfi(inc, qseg + stp - 1); if (v <= p) qseg += stp; }
        const int idx = p - (shfi(inc, qseg) - shfi(cv, qseg));
        const unsigned e = LIST[moba_list_off(bh, n) + (size_t)(qseg - n - 1) * 256 + idx]; qpos = e & 0x3fff; slot = e >> 14;
#pragma unroll
        for (int s = 0; s < 4; ++s) qf[s] = *(const bf16x8*)(PROJ + (rb + qpos) * PLD + C_BQ + h * 64 + 16 * s + 8 * hh);
    }
    group_commit(GR, lds, tid);
    __syncthreads();
    if (active) {
        const int qrel = qpos - n * 256;
        const float rowterm = -slope2 * (float)qrel - B2;
        f32x16 o[2]; float l = 0.f;
#pragma unroll
        for (int r = 0; r < 16; ++r) { o[0][r] = 0.f; o[1][r] = 0.f; }
#ifndef REP_SUB
#define REP_SUB 0
#endif
#pragma unroll 1
        for (int rp = 0; rp <= REP_SUB; ++rp) {
        if (rp) { l = 0.f;
#pragma unroll
            for (int r = 0; r < 16; ++r) { o[0][r] = 0.f; o[1][r] = 0.f; } }
#pragma unroll 1
        for (int st = 0; st < 8; ++st) attn_subtile<false>(lds, nullptr, 32 * st, qf, rowterm, slope2, false, 0, o, l, lane);
        }
        l = half_sum(l, lane);
        moba_store(o, l, qpos, slot, valid, rb, h, OPART, LPART, Y, lane);
    }
    __syncthreads();
}
__device__ __forceinline__ void moba_sel_step(int huA, int S, LAS const int* pre, const unsigned* lcnt, const bf16* PROJ, const unsigned short* LIST, const unsigned* CTAB, bf16* OPART, float* LPART, bf16* Y,
                                              float B2, LAS unsigned char* lds, int tid, int wave, int lane) {
    const int r32 = lane & 31, hh = lane >> 5, half = wave >> 2, tile = wave & 3, htid = tid & 255;
    const int hu = huA + half; const bool uvalid = hu < S;
    int p = 0, chunk = 0, cnt = 0;
    if (uvalid) { int lo2 = 0, hi2 = 768; while (hi2 - lo2 > 1) { const int mid = (lo2 + hi2) >> 1; if (pre[mid] <= hu) lo2 = mid; else hi2 = mid; } p = lo2; chunk = hu - pre[lo2]; cnt = (int)lcnt[lo2]; }
    const int bh = p >> 6, n = p & 63, b = bh / 6, h = bh % 6; const size_t rb = (size_t)b * SEQ;
    const float slope2 = exp2f(-8.f * (float)(h + 1) / 6.f) * LOG2E;
    LAS unsigned char* kv = lds + half * 65536;
    v4u gk[8], gv[8];
    if (uvalid) { const bf16* Kg = PROJ + (rb + (size_t)n * 256) * PLD + C_BK + h * 64; const bf16* Vg = PROJ + (rb + (size_t)n * 256) * PLD + C_BV + h * 64;
#pragma unroll
        for (int i = 0; i < 8; ++i) { const int idx = htid + 256 * i, row = idx >> 3, ch = idx & 7; gk[i] = *(const v4u*)(Kg + (size_t)row * PLD + ch * 8); gv[i] = *(const v4u*)(Vg + (size_t)row * PLD + ch * 8); } }
    const int nvalid = uvalid ? (cnt - chunk * 128 < 128 ? cnt - chunk * 128 : 128) : 0;
    const bool active = tile * 32 < nvalid;
    bool valid = true; int qpos = 0, slot = 0; bf16x8 qf[4];
    if (active) {
        int li = tile * 32 + r32; if (li >= nvalid) { li = nvalid - 1; valid = false; }
        const int pos = chunk * 128 + li;
        const int cv = (lane > n) ? (int)CTAB[((size_t)bh * 64 + lane) * 64 + n] : 0; int inc = cv;
#pragma unroll
        for (int o2 = 1; o2 < 64; o2 <<= 1) { const int t2 = supi(inc, o2, lane); if (lane >= o2) inc += t2; }
        int qseg = 0;
#pragma unroll
        for (int stp = 32; stp >= 1; stp >>= 1) { const int v = shfi(inc, qseg + stp - 1); if (v <= pos) qseg += stp; }
        const int idx = pos - (shfi(inc, qseg) - shfi(cv, qseg));
        const unsigned e = LIST[moba_list_off(bh, n) + (size_t)(qseg - n - 1) * 256 + idx]; qpos = e & 0x3fff; slot = e >> 14;
#pragma unroll
        for (int s = 0; s < 4; ++s) qf[s] = *(const bf16x8*)(PROJ + (rb + qpos) * PLD + C_BQ + h * 64 + 16 * s + 8 * hh);
    }
    if (uvalid) {
#pragma unroll
        for (int i = 0; i < 8; ++i) { const int idx = htid + 256 * i, row = idx >> 3, ch = idx & 7;
            *(LAS v4u*)(kv + ATT_K0 + row * 128 + ((ch ^ ((row >> 1) & 7)) << 4)) = gk[i];
            *(LAS v4u*)(kv + ATT_V0 + row * 128 + ((ch * 16) ^ (((row >> 1) & 1) << 6))) = gv[i]; } }
    __syncthreads();
    if (active) {
        const int qrel = qpos - n * 256;
        const float rowterm = -slope2 * (float)qrel - B2;
        f32x16 o[2]; float l = 0.f;
#pragma unroll
        for (int r = 0; r < 16; ++r) { o[0][r] = 0.f; o[1][r] = 0.f; }
#pragma unroll 1
        for (int st = 0; st < 8; ++st) attn_subtile<false>(kv, nullptr, 32 * st, qf, rowterm, slope2, false, 0, o, l, lane);
        l = half_sum(l, lane);
        moba_store(o, l, qpos, slot, valid, rb, h, OPART, LPART, Y, lane);
    }
    __syncthreads();
}
struct SelP { int bh, n, chunk, nvalid; bool uvalid; };
__device__ __forceinline__ SelP sel_params(int hu, int S, LAS const int* pre, const unsigned* lcnt) {
    SelP P; P.uvalid = hu < S; int p = 0, chunk = 0, cnt = 0;
    if (P.uvalid) { int lo2 = 0, hi2 = 768; while (hi2 - lo2 > 1) { const int mid = (lo2 + hi2) >> 1; if (pre[mid] <= hu) lo2 = mid; else hi2 = mid; } p = lo2; chunk = hu - pre[lo2]; cnt = (int)lcnt[lo2]; }
    P.bh = p >> 6; P.n = p & 63; P.chunk = chunk; P.nvalid = P.uvalid ? (cnt - chunk * 128 < 128 ? cnt - chunk * 128 : 128) : 0; return P;
}
#define SEL_KV_ISSUE(P_) do { if ((P_).uvalid) { const size_t rb_ = (size_t)((P_).bh / 6) * SEQ; const int h_ = (P_).bh % 6; \
        const bf16* Kg_ = PROJ + (rb_ + (size_t)(P_).n * 256) * PLD + C_BK + h_ * 64; const bf16* Vg_ = PROJ + (rb_ + (size_t)(P_).n * 256) * PLD + C_BV + h_ * 64; \
        _Pragma("unroll") for (int i_ = 0; i_ < 8; ++i_) { const int idx_ = htid + 256 * i_, row_ = idx_ >> 3, ch_ = idx_ & 7; gk[i_] = *(const v4u*)(Kg_ + (size_t)row_ * PLD + ch_ * 8); gv[i_] = *(const v4u*)(Vg_ + (size_t)row_ * PLD + ch_ * 8); } } } while (0)
#define SEL_ENTRY_ADDR(P_, cv_, li_, addr_) do { const int pos_ = (P_).chunk * 128 + (li_); int inc_ = (cv_); \
        _Pragma("unroll") for (int o2 = 1; o2 < 64; o2 <<= 1) { const int t2 = supi(inc_, o2, lane); if (lane >= o2) inc_ += t2; } \
        int qseg_ = 0; \
        _Pragma("unroll") for (int stp = 32; stp >= 1; stp >>= 1) { const int v_ = shfi(inc_, qseg_ + stp - 1); if (v_ <= pos_) qseg_ += stp; } \
        const int idx_ = pos_ - (shfi(inc_, qseg_) - shfi((cv_), qseg_)); \
        addr_ = LIST + moba_list_off((P_).bh, (P_).n) + (size_t)(qseg_ - (P_).n - 1) * 256 + idx_; } while (0)
template <class UOF>
__device__ __forceinline__ int moba_sel_pipe(int i, const UOF& uof, int S, int S2, LAS const int* pre, const unsigned* lcnt, const bf16* PROJ, const unsigned short* LIST, const unsigned* CTAB, bf16* OPART, float* LPART, bf16* Y,
                                             float B2, LAS unsigned char* lds, int tid, int wave, int lane) {
    const int r32 = lane & 31, hh = lane >> 5, half = wave >> 2, tile = wave & 3, htid = tid & 255;
    LAS unsigned char* kv = lds + half * 65536;
    int u = uof(i); if (u >= S2) return i;
    v4u gk[8], gv[8]; bf16x8 qf[4]; int qpos = 0, slot = 0; bool valid = true;
    SelP P = sel_params(2 * u + half, S, pre, lcnt);
    bool active = tile * 32 < P.nvalid;
    SEL_KV_ISSUE(P);
    if (active) { int li = tile * 32 + r32; if (li >= P.nvalid) { li = P.nvalid - 1; valid = false; }
        const int cv = (lane > P.n) ? (int)CTAB[((size_t)P.bh * 64 + lane) * 64 + P.n] : 0; const unsigned short* ea; SEL_ENTRY_ADDR(P, cv, li, ea);
        const unsigned e = *ea; qpos = e & 0x3fff; slot = e >> 14; const size_t rb = (size_t)(P.bh / 6) * SEQ;
#pragma unroll
        for (int s = 0; s < 4; ++s) qf[s] = *(const bf16x8*)(PROJ + (rb + qpos) * PLD + C_BQ + (P.bh % 6) * 64 + 16 * s + 8 * hh); }
    for (;;) {
        if (P.uvalid) {
#pragma unroll
            for (int i_ = 0; i_ < 8; ++i_) { const int idx = htid + 256 * i_, row = idx >> 3, ch = idx & 7;
                *(LAS v4u*)(kv + ATT_K0 + row * 128 + ((ch ^ ((row >> 1) & 7)) << 4)) = gk[i_];
                *(LAS v4u*)(kv + ATT_V0 + row * 128 + ((ch * 16) ^ (((row >> 1) & 1) << 6))) = gv[i_]; } }
        __syncthreads();
        ++i; const int un = uof(i); const bool has_next = un < S2;
        SelP Pn; Pn.uvalid = false; Pn.nvalid = 0; Pn.bh = 0; Pn.n = 0; Pn.chunk = 0;
        if (has_next) Pn = sel_params(2 * un + half, S, pre, lcnt);
        const bool active_n = tile * 32 < Pn.nvalid;
        int cvn = 0; if (active_n && lane > Pn.n) cvn = (int)CTAB[((size_t)Pn.bh * 64 + lane) * 64 + Pn.n];
        const int h = P.bh % 6; const size_t rb = (size_t)(P.bh / 6) * SEQ;
        const float slope2 = exp2f(-8.f * (float)(h + 1) / 6.f) * LOG2E;
        const int qrel = qpos - P.n * 256;
        const float rowterm = -slope2 * (float)qrel - B2;
        f32x16 o[2]; float l = 0.f;
#pragma unroll
        for (int r = 0; r < 16; ++r) { o[0][r] = 0.f; o[1][r] = 0.f; }
        if (active) {
#pragma unroll 1
            for (int st = 0; st < 3; ++st) attn_subtile<false>(kv, nullptr, 32 * st, qf, rowterm, slope2, false, 0, o, l, lane); }
        bool valid_n = true; unsigned en = 0u;
        if (active_n) { int li = tile * 32 + r32; if (li >= Pn.nvalid) { li = Pn.nvalid - 1; valid_n = false; }
            const unsigned short* ea; SEL_ENTRY_ADDR(Pn, cvn, li, ea); en = *ea; }
        SEL_KV_ISSUE(Pn);
        if (active) {
#pragma unroll 1
            for (int st = 3; st < 6; ++st) attn_subtile<false>(kv, nullptr, 32 * st, qf, rowterm, slope2, false, 0, o, l, lane); }
        bf16x8 qfn[4]; const int qpos_n = en & 0x3fff, slot_n = en >> 14;
        if (active_n) { const size_t rbn = (size_t)(Pn.bh / 6) * SEQ;
#pragma unroll
            for (int s = 0; s < 4; ++s) qfn[s] = *(const bf16x8*)(PROJ + (rbn + qpos_n) * PLD + C_BQ + (Pn.bh % 6) * 64 + 16 * s + 8 * hh); }
        else {
#pragma unroll
            for (int s = 0; s < 4; ++s) qfn[s] = qf[s]; }
        if (active) {
#pragma unroll 1
            for (int st = 6; st < 8; ++st) attn_subtile<false>(kv, nullptr, 32 * st, qf, rowterm, slope2, false, 0, o, l, lane);
            l = half_sum(l, lane);
            moba_store(o, l, qpos, slot, valid, rb, h, OPART, LPART, Y, lane); }
        __syncthreads();
        if (!has_next) break;
        P = Pn; active = active_n; valid = valid_n; qpos = qpos_n; slot = slot_n;
#pragma unroll
        for (int s = 0; s < 4; ++s) qf[s] = qfn[s];
    }
    return i;
}
__device__ __forceinline__ void moba_own_pair(int bh, int nA, int nB, const bf16* PROJ, bf16* OPART, float* LPART, bf16* Y, float B2, LAS unsigned char* lds, int tid, int wave, int lane) {
    const int b = bh / 6, h = bh % 6; const size_t rb = (size_t)b * SEQ; const int r32 = lane & 31, hh = lane >> 5;
    const float slope2 = exp2f(-8.f * (float)(h + 1) / 6.f) * LOG2E;
    GroupRegs GA, GB;
    group_issue(GA, PROJ + (rb + (size_t)nA * 256) * PLD + C_BK + h * 64, PROJ + (rb + (size_t)nA * 256) * PLD + C_BV + h * 64, tid);
    group_issue(GB, PROJ + (rb + (size_t)nB * 256) * PLD + C_BK + h * 64, PROJ + (rb + (size_t)nB * 256) * PLD + C_BV + h * 64, tid);
    bf16x8 qfA[4], qfB[4];
    { const size_t qa = rb + (size_t)nA * 256 + wave * 32 + r32, qb2 = rb + (size_t)nB * 256 + (7 - wave) * 32 + r32;
#pragma unroll
      for (int s = 0; s < 4; ++s) { qfA[s] = *(const bf16x8*)(PROJ + qa * PLD + C_BQ + h * 64 + 16 * s + 8 * hh); qfB[s] = *(const bf16x8*)(PROJ + qb2 * PLD + C_BQ + h * 64 + 16 * s + 8 * hh); } }
    group_commit(GA, lds, tid); group_commit(GB, lds + 65536, tid);
    __syncthreads();
    { const int tile = wave, qrel = tile * 32 + r32, qpos = nA * 256 + qrel;
      const float rowterm = -slope2 * (float)qrel - B2;
      f32x16 o[2]; float l = 0.f;
#pragma unroll
      for (int r = 0; r < 16; ++r) { o[0][r] = 0.f; o[1][r] = 0.f; }
#pragma unroll 1
      for (int st = 0; st <= tile; ++st) attn_subtile<false>(lds, nullptr, 32 * st, qfA, rowterm, slope2, st == tile, qrel, o, l, lane);
      l = half_sum(l, lane);
      moba_store(o, l, qpos, 3, true, rb, h, OPART, LPART, Y, lane); }
    { const int tile = 7 - wave, qrel = tile * 32 + r32, qpos = nB * 256 + qrel;
      const float rowterm = -slope2 * (float)qrel - B2;
      f32x16 o[2]; float l = 0.f;
#pragma unroll
      for (int r = 0; r < 16; ++r) { o[0][r] = 0.f; o[1][r] = 0.f; }
#pragma unroll 1
      for (int st = 0; st <= tile; ++st) attn_subtile<false>(lds + 65536, nullptr, 32 * st, qfB, rowterm, slope2, st == tile, qrel, o, l, lane);
      l = half_sum(l, lane);
      moba_store(o, l, qpos, 3, true, rb, h, OPART, LPART, Y, lane); }
    __syncthreads();
}

__device__ __forceinline__ void moba_combine(const unsigned* SEL, const bf16* OPART, const float* LPART, bf16* Y, bf16* Yo, int opitch, int ocol, int gtid, int ngt) {
    constexpr size_t NIT = (size_t)MROWS * 48;
    for (size_t base = gtid; base < NIT; base += (size_t)ngt * 4) {
        unsigned sel[4]; v4u yv[4]; float lo[4]; size_t row[4]; int hh4[4], c84[4]; bool ok[4];
#pragma unroll
        for (int j = 0; j < 4; ++j) { const size_t idx = base + (size_t)j * ngt; ok[j] = idx < NIT; const size_t ii = ok[j] ? idx : 0;
            row[j] = ii / 48; const int hc = (int)(ii % 48); hh4[j] = hc >> 3; c84[j] = (hc & 7) * 8;
            sel[j] = SEL[row[j] * 6 + hh4[j]]; yv[j] = *(const v4u*)(Y + row[j] * 1024 + Y_MOBA + hh4[j] * 64 + c84[j]); lo[j] = LPART[((size_t)3 * MROWS + row[j]) * 6 + hh4[j]]; }
        v4u pv[4][3]; float pl[4][3];
#pragma unroll
        for (int j = 0; j < 4; ++j)
#pragma unroll
            for (int k = 0; k < 3; ++k) { const bool v = ((sel[j] >> (8 * k)) & 0xff) != 255;
                pv[j][k] = v ? *(const v4u*)(OPART + ((size_t)k * MROWS + row[j]) * 384 + hh4[j] * 64 + c84[j]) : (v4u){0u, 0u, 0u, 0u};
                pl[j][k] = v ? LPART[((size_t)k * MROWS + row[j]) * 6 + hh4[j]] : 0.f; }
#pragma unroll
        for (int j = 0; j < 4; ++j) { float acc[8]; unpack8(yv[j], acc); float l = lo[j];
#pragma unroll
            for (int k = 0; k < 3; ++k) { float f[8]; unpack8(pv[j][k], f);
#pragma unroll
                for (int i = 0; i < 8; ++i) acc[i] += f[i];
                l += pl[j][k]; }
            const float rl = __builtin_amdgcn_rcpf(l);
            v4u w; w.x = pk2(acc[0] * rl, acc[1] * rl); w.y = pk2(acc[2] * rl, acc[3] * rl); w.z = pk2(acc[4] * rl, acc[5] * rl); w.w = pk2(acc[6] * rl, acc[7] * rl);
            if (ok[j]) *(v4u*)(Yo + row[j] * opitch + ocol + hh4[j] * 64 + c84[j]) = w; }
    }
}

__device__ __forceinline__ int vsw(int row, int colb) { return row * 128 + (colb ^ (((row >> 1) & 1) << 6)); }
__device__ __forceinline__ int ksw(int row, int ch) { return row * 128 + ((ch ^ ((row >> 1) & 7)) << 4); }
__device__ __forceinline__ void mlstm_m1_mfma(int ci, const MlP& P, LAS unsigned char* lds, int wave, int lane) {
    const int b = ci >> 10, h = (ci >> 8) & 3, c = ci & 255; const size_t row0 = (size_t)b * SEQ + c * 64;
    LAS unsigned char* Ki = lds + wave * 16384; LAS unsigned char* Vi = Ki + 8192;
    float wv;
    { const size_t row = row0 + lane;
      const float fi = P.GATES[row * 16 + 6 + h] + P.ibias[h], ff = P.GATES[row * 16 + 10 + h] + P.fbias[h];
      float bc = log_sigmoid_fast(ff);
#pragma unroll
      for (int o = 1; o < 64; o <<= 1) { const float n = sup(bc, o, lane); if (lane >= o) bc += n; }
      const float bend = shf(bc, 63);
      const float wl = bend - bc + fi; const float mloc = wave_max(wl);
      wv = exp_fast(wl - mloc);
      if (lane == 0) { P.BEND[ci] = bend; P.MLOC[ci] = mloc; } }
#pragma unroll
    for (int i = 0; i < 8; ++i) { const int idx = lane + 64 * i, r = idx >> 3, ch = idx & 7;
        const v4u kk = *(const v4u*)(P.KC + (row0 + r) * 256 + h * 64 + ch * 8);
        *(LAS v4u*)(Ki + vsw(r, ch * 16)) = kk;
        float f[8]; unpack8(*(const v4u*)(P.PROJ + (row0 + r) * PLD + C_MV + h * 64 + ch * 8), f);
        const float w = shf(wv, r);
        v4u o; o.x = pk2(f[0] * w, f[1] * w); o.y = pk2(f[2] * w, f[3] * w); o.z = pk2(f[4] * w, f[5] * w); o.w = pk2(f[6] * w, f[7] * w);
        *(LAS v4u*)(Vi + vsw(r, ch * 16)) = o; }
    LDS_WAIT(); asm volatile("" ::: "memory");
    { float nu = 0.f;
#pragma unroll 8
      for (int s = 0; s < 64; ++s) { const float ws = shf(wv, s); nu += ws * bf2f(*(LAS const unsigned short*)(Ki + vsw(s, 2 * lane))); }
      P.NU[(size_t)ci * 64 + lane] = nu; }
    f32x16 D[2][2];
#pragma unroll
    for (int a = 0; a < 2; ++a)
#pragma unroll
        for (int e = 0; e < 2; ++e)
#pragma unroll
            for (int r = 0; r < 16; ++r) D[a][e][r] = 0.f;
    const int i16 = lane & 15, cc = (lane >> 4) & 1, hh = lane >> 5, r32 = lane & 31;
#pragma unroll
    for (int ks = 0; ks < 4; ++ks) { const int rowv = 16 * ks + 4 * hh + (i16 >> 2);
        bf16x8 af[2], bfr[2];
#pragma unroll
        for (int blk = 0; blk < 2; ++blk) { const int colb = (32 * blk + 16 * cc + 4 * (i16 & 3)) * 2;
            { const s16x4 lo = vtr(Vi + vsw(rowv, colb)), hi = vtr(Vi + vsw(rowv, colb) + 1024); af[blk] = (bf16x8){lo[0], lo[1], lo[2], lo[3], hi[0], hi[1], hi[2], hi[3]}; }
            { const s16x4 lo = vtr(Ki + vsw(rowv, colb)), hi = vtr(Ki + vsw(rowv, colb) + 1024); bfr[blk] = (bf16x8){lo[0], lo[1], lo[2], lo[3], hi[0], hi[1], hi[2], hi[3]}; } }
#pragma unroll
        for (int a = 0; a < 2; ++a)
#pragma unroll
            for (int e = 0; e < 2; ++e) D[a][e] = __builtin_amdgcn_mfma_f32_32x32x16_bf16(af[a], bfr[e], D[a][e], 0, 0, 0); }
    bf16* up = (bf16*)P.U + (size_t)ci * 4096;
#pragma unroll
    for (int a = 0; a < 2; ++a)
#pragma unroll
        for (int e = 0; e < 2; ++e)
#pragma unroll
            for (int r = 0; r < 16; ++r) up[(32 * a + crow(r, hh)) * 64 + 32 * e + r32] = (bf16)f2bf(D[a][e][r]);
    LDS_WAIT(); asm volatile("" ::: "memory");
}

__device__ __forceinline__ void mlstm_m3_mfma(int it, const MlP& P, LAS unsigned char* lds, int tid, int wave, int lane) {
    const int cs = wave >> 1, tile = wave & 1, ci = it * 4 + cs;
    const int b = ci >> 10, h = (ci >> 8) & 3, c = ci & 255; const size_t row0 = (size_t)b * SEQ + c * 64;
    LAS unsigned char* Ki = lds + cs * 32768; LAS unsigned char* Vi = Ki + 8192; LAS unsigned char* Ci = Ki + 16384; LAS unsigned char* Mi = Ki + 24576;
    LAS float* tab = (LAS float*)(lds + ATT_TAB) + cs * 256;
    const float ms = P.MS[ci];
    { const int pt = tile * 64 + lane;
#pragma unroll
      for (int i = 0; i < 4; ++i) { const int idx = pt + 128 * i, r = idx >> 3, ch = idx & 7;
          *(LAS v4u*)(Ki + ksw(r, ch)) = *(const v4u*)(P.KC + (row0 + r) * 256 + h * 64 + ch * 8);
          *(LAS v4u*)(Vi + vsw(r, ch * 16)) = *(const v4u*)(P.PROJ + (row0 + r) * PLD + C_MV + h * 64 + ch * 8);
          *(LAS v4u*)(Ci + ksw(r, ch)) = *(const v4u*)(P.CS + (size_t)ci * 4096 + r * 64 + ch * 8);
          *(LAS v4u*)(Mi + r * 128 + ch * 16) = *(const v4u*)(P.PROJ + (row0 + r) * PLD + C_MO + h * 64 + ch * 8); } }
    if (tile == 0) {
        const size_t row = row0 + lane;
        const float fi = P.GATES[row * 16 + 6 + h] + P.ibias[h], ff = P.GATES[row * 16 + 10 + h] + P.fbias[h];
        float bc = log_sigmoid_fast(ff);
#pragma unroll
        for (int o = 1; o < 64; o <<= 1) { const float n = sup(bc, o, lane); if (lane >= o) bc += n; }
        const float a = fi - bc; float pm = a;
#pragma unroll
        for (int o = 1; o < 64; o <<= 1) { const float n = sup(pm, o, lane); if (lane >= o) pm = fmaxf(pm, n); }
        tab[lane] = a * LOG2E; tab[64 + lane] = fmaxf(ms, pm); tab[128 + lane] = bc; tab[192 + lane] = P.NS[(size_t)ci * 64 + lane];
    }
    __syncthreads();
    const int r32 = lane & 31, hh = lane >> 5, j = 32 * tile + r32;
    bf16x8 qf[4];
#pragma unroll
    for (int s = 0; s < 4; ++s) qf[s] = *(const bf16x8*)(P.QC + (row0 + j) * 256 + h * 64 + 16 * s + 8 * hh);
    const float gj = tab[64 + j], inter = exp_fast(ms - gj), rowterm2 = -gj * LOG2E;
    f32x16 o[2]; float l = 0.f;
#pragma unroll
    for (int r = 0; r < 16; ++r) { o[0][r] = 0.f; o[1][r] = 0.f; }
    for (int st = 0; st <= tile; ++st) {
        const int j0 = 32 * st;
        f32x16 acc;
#pragma unroll
        for (int r = 0; r < 16; ++r) acc[r] = 0.f;
#pragma unroll
        for (int s = 0; s < 4; ++s) { const bf16x8 kf = *(LAS const bf16x8*)(Ki + ksw(j0 + r32, 2 * s + hh)); acc = __builtin_amdgcn_mfma_f32_32x32x16_bf16(kf, qf[s], acc, 0, 0, 0); }
        float ls = 0.f;
#pragma unroll
        for (int g4 = 0; g4 < 4; ++g4) { const f32x4 c4 = *(LAS const f32x4*)(tab + j0 + 8 * g4 + 4 * hh);
#pragma unroll
            for (int ii = 0; ii < 4; ++ii) { const int reg = 4 * g4 + ii, key = j0 + 8 * g4 + 4 * hh + ii;
                float p = acc[reg] * __builtin_amdgcn_exp2f(rowterm2 + c4[ii]);
                if (st == tile && key > j) p = 0.f;
                acc[reg] = p; ls += p; } }
        l += ls;
        bf16x8 pa[2];
#pragma unroll
        for (int s = 0; s < 2; ++s) { v4u w; w.x = cvtpk(acc[8 * s + 0], acc[8 * s + 1]); w.y = cvtpk(acc[8 * s + 2], acc[8 * s + 3]); w.z = cvtpk(acc[8 * s + 4], acc[8 * s + 5]); w.w = cvtpk(acc[8 * s + 6], acc[8 * s + 7]); pa[s] = __builtin_bit_cast(bf16x8, w); }
        { const int i16 = lane & 15, cc = (lane >> 4) & 1;
#pragma unroll
          for (int db = 0; db < 2; ++db)
#pragma unroll
              for (int s = 0; s < 2; ++s) { const int rowv = j0 + 16 * s + 4 * hh + (i16 >> 2); const int colb = (32 * db + 16 * cc + 4 * (i16 & 3)) * 2;
                  LAS const unsigned char* vp = Vi + vsw(rowv, colb);
                  const s16x4 lo = vtr(vp), hi = vtr(vp + 1024);
                  const bf16x8 vf = (bf16x8){lo[0], lo[1], lo[2], lo[3], hi[0], hi[1], hi[2], hi[3]};
                  o[db] = __builtin_amdgcn_mfma_f32_32x32x16_bf16(pa[s], vf, o[db], 0, 0, 0); } }
    }
    float dn = 0.f;
#pragma unroll
    for (int s = 0; s < 4; ++s) { float f[8]; unpack8(__builtin_bit_cast(v4u, qf[s]), f);
        const f32x4 n0 = *(LAS const f32x4*)(tab + 192 + 16 * s + 8 * hh), n1 = *(LAS const f32x4*)(tab + 192 + 16 * s + 8 * hh + 4);
        dn += (f[0] * n0.x + f[1] * n0.y) + (f[2] * n0.z + f[3] * n0.w) + (f[4] * n1.x + f[5] * n1.y) + (f[6] * n1.z + f[7] * n1.w);
        v4u w; w.x = cvtpk(f[0] * inter, f[1] * inter); w.y = cvtpk(f[2] * inter, f[3] * inter); w.z = cvtpk(f[4] * inter, f[5] * inter); w.w = cvtpk(f[6] * inter, f[7] * inter);
        const bf16x8 qs = __builtin_bit_cast(bf16x8, w);
#pragma unroll
        for (int db = 0; db < 2; ++db) { const bf16x8 cf = *(LAS const bf16x8*)(Ci + ksw(32 * db + r32, 2 * s + hh)); o[db] = __builtin_amdgcn_mfma_f32_32x32x16_bf16(qs, cf, o[db], 0, 0, 0); } }
    dn = half_sum(dn, lane); l = half_sum(l, lane);
    const float den = inter * dn + l, mj = tab[128 + j] + gj;
    const float rd = __builtin_amdgcn_rcpf(fmaxf(fabsf(den), exp_fast(-mj)));
    const float hg0 = P.hg[h * 64 + r32], hg1 = P.hg[h * 64 + 32 + r32];
    unsigned short mo0[16], mo1[16];
#pragma unroll
    for (int r = 0; r < 16; ++r) { LAS const unsigned short* mq = (LAS const unsigned short*)(Mi + (32 * tile + crow(r, hh)) * 128) + r32; mo0[r] = mq[0]; mo1[r] = mq[32]; }
#pragma unroll
    for (int r = 0; r < 16; ++r) { const int src = crow(r, hh); const float rdr = shf(rd, src);
        const float h0 = o[0][r] * rdr, h1 = o[1][r] * rdr; float ss = h0 * h0 + h1 * h1;
        ss += SWZ_X(ss, 1); ss += SWZ_X(ss, 2); ss += SWZ_X(ss, 4); ss += SWZ_X(ss, 8); ss += SWZ_X(ss, 16);
        const float rr = __builtin_amdgcn_rsqf(ss * (1.f / 64.f) + EPS);
        LAS unsigned short* mp = (LAS unsigned short*)(Mi + (32 * tile + src) * 128) + r32;
        const float e0 = __builtin_amdgcn_exp2f(-bf2f(mo0[r]) * LOG2E), e1 = __builtin_amdgcn_exp2f(-bf2f(mo1[r]) * LOG2E);
        mp[0] = (unsigned short)f2bf(h0 * rr * hg0 * __builtin_amdgcn_rcpf(1.f + e0));
        mp[32] = (unsigned short)f2bf(h1 * rr * hg1 * __builtin_amdgcn_rcpf(1.f + e1)); }
    LDS_WAIT(); asm volatile("" ::: "memory");
#pragma unroll
    for (int i = 0; i < 4; ++i) { const int rw = (lane >> 3) + 8 * i, ch = lane & 7;
        *(v4u*)(P.Y + (row0 + 32 * tile + rw) * 1024 + Y_ML + h * 64 + ch * 8) = *(LAS const v4u*)(Mi + (32 * tile + rw) * 128 + ch * 16); }
    __syncthreads();
}

__device__ __forceinline__ void top3_ins(float g, int n, float& v0, float& v1, float& v2, int& i0, int& i1, int& i2) {
    const bool c0 = g > v0, c1 = g > v1, c2 = g > v2;
    const float nv2 = c1 ? v1 : (c2 ? g : v2); const int ni2 = c1 ? i1 : (c2 ? n : i2);
    const float nv1 = c0 ? v0 : (c1 ? g : v1); const int ni1 = c0 ? i0 : (c1 ? n : i1);
    v0 = c0 ? g : v0; i0 = c0 ? n : i0; v1 = nv1; i1 = ni1; v2 = nv2; i2 = ni2;
}
__device__ __forceinline__ void moba_gate_mfma(int u, const bf16* PROJ, const float* KMEAN, unsigned* SEL, unsigned* LCNT, unsigned* CTAB, unsigned short* LIST, float B2, float thresh2,
                                               LAS unsigned char* lds, int tid, int wave, int lane) {
    const int bh = u >> 6, qb = 63 - (u & 63), b = bh / 6, h = bh % 6; const int r32 = lane & 31, hh = lane >> 5;
    LAS unsigned char* Khi = lds; LAS unsigned char* Klo = lds + 8192; LAS unsigned* cntl = (LAS unsigned*)(lds + 16384);
    if (tid < 64) cntl[tid] = 0u;
    { const int n = tid >> 3, ch = tid & 7; float f[8];
      if (n < qb) { const float* k0 = KMEAN + ((size_t)bh * NBLK + n) * 64 + ch * 8; const float* k1 = k0 + (size_t)(12 * NBLK * 64);
          const f32x4 a0 = *(const f32x4*)k0, a1 = *(const f32x4*)(k0 + 4), b0 = *(const f32x4*)k1, b1 = *(const f32x4*)(k1 + 4);
          f[0] = a0.x + b0.x; f[1] = a0.y + b0.y; f[2] = a0.z + b0.z; f[3] = a0.w + b0.w; f[4] = a1.x + b1.x; f[5] = a1.y + b1.y; f[6] = a1.z + b1.z; f[7] = a1.w + b1.w; }
      else {
#pragma unroll
          for (int i = 0; i < 8; ++i) f[i] = 0.f; }
      unsigned hi[8]; float lo[8];
#pragma unroll
      for (int i = 0; i < 8; ++i) { hi[i] = f2bf(f[i]); lo[i] = f[i] - bf2f((unsigned short)hi[i]); }
      v4u wh; wh.x = hi[0] | (hi[1] << 16); wh.y = hi[2] | (hi[3] << 16); wh.z = hi[4] | (hi[5] << 16); wh.w = hi[6] | (hi[7] << 16);
      v4u wl; wl.x = pk2(lo[0], lo[1]); wl.y = pk2(lo[2], lo[3]); wl.z = pk2(lo[4], lo[5]); wl.w = pk2(lo[6], lo[7]);
      *(LAS v4u*)(Khi + ksw(n, ch)) = wh; *(LAS v4u*)(Klo + ksw(n, ch)) = wl; }
    const int query = wave * 32 + r32; const size_t row = (size_t)b * SEQ + qb * 256 + query;
    bf16x8 qf[4];
#pragma unroll
    for (int s = 0; s < 4; ++s) qf[s] = *(const bf16x8*)(PROJ + row * PLD + C_BQ + h * 64 + 16 * s + 8 * hh);
    __syncthreads();
    float v0 = -INFINITY, v1 = -INFINITY, v2 = -INFINITY; int i0 = 255, i1 = 255, i2 = 255;
#pragma unroll 1
    for (int st = 0; st < 2; ++st) {
        if (32 * st >= qb) break;
        f32x16 acc;
#pragma unroll
        for (int r = 0; r < 16; ++r) acc[r] = 0.f;
#pragma unroll
        for (int s = 0; s < 4; ++s) { const bf16x8 kh = *(LAS const bf16x8*)(Khi + ksw(32 * st + r32, 2 * s + hh)), kl = *(LAS const bf16x8*)(Klo + ksw(32 * st + r32, 2 * s + hh));
            acc = __builtin_amdgcn_mfma_f32_32x32x16_bf16(kh, qf[s], acc, 0, 0, 0); acc = __builtin_amdgcn_mfma_f32_32x32x16_bf16(kl, qf[s], acc, 0, 0, 0); }
#pragma unroll
        for (int r = 0; r < 16; ++r) { const int n = 32 * st + crow(r, hh); if (n < qb) top3_ins(acc[r], n, v0, v1, v2, i0, i1, i2); }
    }
    { const int pl = lane ^ 32;
      const float w0 = shf(v0, pl), w1 = shf(v1, pl), w2 = shf(v2, pl); const int j0 = shfi(i0, pl), j1 = shfi(i1, pl), j2 = shfi(i2, pl);
      if (j0 != 255) top3_ins(w0, j0, v0, v1, v2, i0, i1, i2);
      if (j1 != 255) top3_ins(w1, j1, v0, v1, v2, i0, i1, i2);
      if (j2 != 255) top3_ins(w2, j2, v0, v1, v2, i0, i1, i2); }
    if (hh == 0) {
        { const float slope2 = exp2f(-8.f * (float)(h + 1) / 6.f) * LOG2E; const float lim = (2.f * B2 + thresh2) / slope2; const int t0 = qb * 256 + query - 255;
          if (i0 != 255 && (float)(t0 - i0 * 256) > lim) i0 = 255;
          if (i1 != 255 && (float)(t0 - i1 * 256) > lim) i1 = 255;
          if (i2 != 255 && (float)(t0 - i2 * 256) > lim) i2 = 255; }
        SEL[row * 6 + h] = (unsigned)i0 | ((unsigned)i1 << 8) | ((unsigned)i2 << 16);
        if (LIST) { const unsigned t = (unsigned)(qb * 256 + query);
            if (i0 != 255) { const unsigned pos = __hip_atomic_fetch_add(cntl + i0, 1u, __ATOMIC_RELAXED, __HIP_MEMORY_SCOPE_WORKGROUP); LIST[moba_list_off(bh, i0) + (size_t)(qb - i0 - 1) * 256 + pos] = (unsigned short)(t | (0u << 14)); }
            if (i1 != 255) { const unsigned pos = __hip_atomic_fetch_add(cntl + i1, 1u, __ATOMIC_RELAXED, __HIP_MEMORY_SCOPE_WORKGROUP); LIST[moba_list_off(bh, i1) + (size_t)(qb - i1 - 1) * 256 + pos] = (unsigned short)(t | (1u << 14)); }
            if (i2 != 255) { const unsigned pos = __hip_atomic_fetch_add(cntl + i2, 1u, __ATOMIC_RELAXED, __HIP_MEMORY_SCOPE_WORKGROUP); LIST[moba_list_off(bh, i2) + (size_t)(qb - i2 - 1) * 256 + pos] = (unsigned short)(t | (2u << 14)); } }
    }
    __syncthreads();
    if (LIST && tid < 64) { const unsigned c = cntl[tid]; CTAB[((size_t)bh * 64 + qb) * 64 + tid] = c; if (c) atomicAdd(LCNT + bh * 64 + tid, c); }
    __syncthreads();
}
#ifndef FOX_MFMA
#define FOX_MFMA 1
#endif
#ifndef MOBA_MFMA
#define MOBA_MFMA 1
#endif
#ifndef REP_P0
#define REP_P0 0
#endif
#ifndef REP_NORM
#define REP_NORM 0
#endif
#ifndef REP_GIN
#define REP_GIN 0
#endif
#ifndef REP_FOX
#define REP_FOX 0
#endif
#ifndef REP_M1
#define REP_M1 0
#endif
#ifndef REP_MIXB
#define REP_MIXB 0
#endif
#ifndef REP_M3
#define REP_M3 0
#endif
#ifndef REP_GGU
#define REP_GGU 0
#endif
#ifndef REP_GATE
#define REP_GATE 0
#endif
#ifndef REP_CONV
#define REP_CONV 0
#endif
#ifndef REP_FCUM
#define REP_FCUM 0
#endif
#ifndef REP_QKN
#define REP_QKN 0
#endif
#ifndef REP_GOUT
#define REP_GOUT 0
#endif
#ifndef REP_GDN
#define REP_GDN 0
#endif
#ifndef REP_COMB
#define REP_COMB 0
#endif
#ifndef REP_BAR
#define REP_BAR 0
#endif
#ifndef REP_GATE2
#define REP_GATE2 0
#endif
#ifndef ML_MFMA
#define ML_MFMA 1
#endif
#ifndef REP_M2
#define REP_M2 0
#endif
#ifndef FOX_OLD
#define FOX_OLD 0
#endif
#if FOX_OLD
#define FOX_FN fox_unit_old
#else
#define FOX_FN fox_unit
#endif
#ifndef REP_PRE
#define REP_PRE 0
#endif
#ifndef GGU_ALIGN
#define GGU_ALIGN true
#endif
#ifndef GGU_SP2
#define GGU_SP2 true
#endif
#ifndef GIN_ALIGN
#define GIN_ALIGN true
#endif
#ifndef GIN_SP2
#define GIN_SP2 true
#endif
#ifndef GATE_IN_POST
#define GATE_IN_POST 1
#endif
#ifndef FOX_PIPE
#define FOX_PIPE 0
#endif
#ifndef N_LAUNCH_MODE
#define N_LAUNCH_MODE 1
#endif
constexpr int NPHASE = 2 + 8 * DEPTH;
struct Args { const float* in[20]; float* out; unsigned char* ws; int ph_lo, ph_hi; };
static_assert(sizeof(Args) == 20 * 8 + 8 + 8 + 8, "Args has no padding");

__global__ void __launch_bounds__(NTHREADS, 2) fwd(Args args) {
    extern __shared__ __attribute__((aligned(16))) unsigned char lds_raw[];
    LAS unsigned char* lds = (LAS unsigned char*)lds_raw;
    LAS float* ldsf = (LAS float*)lds_raw;
    volatile LAS unsigned* MISC = (volatile LAS unsigned*)(lds + MISC_OFF);
    const int G = gridDim.x; const int bx = blockIdx.x; const int vcu = (G % 8 == 0) ? (bx % 8) * (G / 8) + bx / 8 : bx;
    const int NGW = G * NWAVES;
#define PH_IDS() int lane_; asm volatile("v_mbcnt_lo_u32_b32 %0, -1, 0\n\tv_mbcnt_hi_u32_b32 %0, -1, %0" : "=v"(lane_)); const int wave = wave_k; const int lane = lane_ & 63; int tid = wave * 64 + lane; \
    const int gw = vcu * NWAVES + wave; (void)lane; (void)gw; \
    GAS unsigned char* wsg_ = (GAS unsigned char*)ws_k; asm volatile("" : "+s"(wsg_)); unsigned char* ws = (unsigned char*)wsg_; gu32* ctl = (gu32*)(ws + WS_CTL); (void)ctl
    const int wave_k = __builtin_amdgcn_readfirstlane((int)threadIdx.x >> 6);
    unsigned char* const ws_k = args.ws;
    gu32* ctl0 = (gu32*)(ws_k + WS_CTL);
    for (int u = threadIdx.x; u < (LDS_BYTES - LDSCTL_OFF) / 4; u += NTHREADS) ((LAS unsigned*)(lds + LDSCTL_OFF))[u] = 0u;
    __syncthreads();
    XcdBarrier bar; bar.bar = (unsigned*)(ctl0 + CW_BAR); bar.x = 0; bar.st = nullptr;
    if (N_LAUNCH_MODE == 1) bar = xcd_barrier_post((unsigned*)(ctl0 + CW_BAR), MISC + 8);
    const int lo = args.ph_lo, hi = args.ph_hi;
#ifndef PHMASK
#define PHMASK 0xfff
#endif
#define PHEN(j) ((PHMASK >> (j)) & 1)
#define IN(k) ((N_LAUNCH_MODE == 1) || (lo <= (k) && (k) < hi))
#ifdef CLKPROBE
    unsigned long long c0_ = __builtin_amdgcn_s_memtime(), r0_ = __builtin_amdgcn_s_memrealtime();
#define CLK_B(k) do { if ((k) == CLKPROBE_PH) { c0_ = __builtin_amdgcn_s_memtime(); r0_ = __builtin_amdgcn_s_memrealtime(); } } while (0)
#define CLK_E(k) do { if ((k) == CLKPROBE_PH && bx == 0) { const unsigned long long dc_ = __builtin_amdgcn_s_memtime() - c0_, r1_ = __builtin_amdgcn_s_memrealtime(), dr_ = r1_ - r0_; \
        const unsigned long long tk_ = dc_ * (unsigned long long)(CLKPROBE) / dr_; while (__builtin_amdgcn_s_memrealtime() - r1_ < tk_) __builtin_amdgcn_s_sleep(8); } } while (0)
#else
#define CLK_B(k) do { } while (0)
#define CLK_E(k) do { } while (0)
#endif
#define SEAM(k) do { CLK_E(k); if (IN(k) && IN((k) + 1)) { xcd_barrier(bar); for (int rb_ = 0; rb_ < REP_BAR; ++rb_) xcd_barrier(bar); } CLK_B((k) + 1); } while (0)

#define PRM(k) ((const float*)(*(GAS const float* const volatile*)(ws + WS_PTAB + 8 * (k))))
#define x_in PRM(0)
#define norm1_g PRM(4)
#define norm2_g PRM(5)
#define fox_f_bias PRM(7)
#define fox_q_g PRM(8)
#define fox_k_g PRM(9)
#define ml_conv_w PRM(10)
#define ml_conv_b PRM(11)
#define ml_i_bias PRM(12)
#define ml_f_bias PRM(13)
#define ml_h_g PRM(14)
#define moba_q_g PRM(15)
#define moba_k_g PRM(16)
#define xres ((float*)PRM(20))
#define MOD ((float*)(ws + WS_MOD))
#define XN ((bf16*)(ws + WS_XN))
#define PROJ ((bf16*)(ws + WS_PROJ))
#define HB ((bf16*)(ws + WS_H))
#define Y ((bf16*)(ws + WS_Y))
#define GATES ((float*)(ws + WS_GATES))
#define FOXCUM ((float*)(ws + WS_FOXCUM))
#define KMEAN ((float*)(ws + WS_KMEAN))
#define QC ((bf16*)(ws + WS_QC))
#define KC ((bf16*)(ws + WS_KC))
#define SEL ((unsigned*)(ws + WS_SEL))
#define mod_l (MOD + (size_t)l * 2 * 6144)
#define MK_MP() const float* const ib_ = ml_i_bias; const float* const fb_ = ml_f_bias; const float* const hg_ = ml_h_g; \
    MlP MP{PROJ, QC, KC, GATES, (float*)(ws + WS_U), (float*)(ws + WS_NU), (float*)(ws + WS_BEND), (float*)(ws + WS_MLOC), (bf16*)(ws + WS_CS), (float*)(ws + WS_NS), (float*)(ws + WS_MS), Y, ib_ + l * 4, fb_ + l * 4, hg_ + l * 256}

    for (int rep = 0; rep <= REP_P0; ++rep)
    if (PHEN(10) && IN(0)) { PH_IDS();
        const float* cvec = args.in[1]; const float* w_ada = args.in[2]; const float* b_ada = args.in[3]; const float* w_in = args.in[6];
        const float* w_out = args.in[17]; const float* w_gate_up = args.in[18]; const float* w_down = args.in[19];
        if (blockIdx.x == 0 && tid == 0) { const float** pt = (const float**)(ws + WS_PTAB);
            pt[0] = args.in[0]; pt[4] = args.in[4]; pt[5] = args.in[5]; pt[7] = args.in[7]; pt[8] = args.in[8]; pt[9] = args.in[9]; pt[10] = args.in[10]; pt[11] = args.in[11]; pt[12] = args.in[12];
            pt[13] = args.in[13]; pt[14] = args.in[14]; pt[15] = args.in[15]; pt[16] = args.in[16]; pt[20] = args.out; }
        if (vcu < 192) p0_mod_unit(vcu, cvec, w_ada, b_ada, MOD, ldsf, tid, wave, lane);
        LAS float* scr = (LAS float*)(lds + wave * 16384);
        constexpr int I_IN = 16 * (NIN / 32), I_OUT = 16 * (DM / 32), I_GU = 16 * (NGU / 32), I_DN = (DFF / 64) * (DM / 32), I_L = I_IN + I_OUT + I_GU + I_DN;
        for (int it = gw; it < DEPTH * I_L; it += NGW) {
            const int l = it / I_L; int r = it % I_L;
            if (r < I_IN) { transpose_item<1>(w_in + (size_t)l * DM * INC, DM, INC, (bf16*)(ws + WS_WIN + l * WIN_BYTES), scr, NIN / 32, r, lane); continue; } r -= I_IN;
            if (r < I_OUT) { transpose_item<0>(w_out + (size_t)l * DM * DM, DM, DM, (bf16*)(ws + WS_WOUT + l * WOUT_BYTES), scr, DM / 32, r, lane); continue; } r -= I_OUT;
            if (r < I_GU) { transpose_item<2>(w_gate_up + (size_t)l * DM * NGU, DM, NGU, (bf16*)(ws + WS_WGU + l * WGU_BYTES), scr, NGU / 32, r, lane); continue; } r -= I_GU;
            transpose_item<0>(w_down + (size_t)l * DFF * DM, DFF, DM, (bf16*)(ws + WS_WDN + l * WDN_BYTES), scr, DM / 32, r, lane);
        }
        if (REP_P0) __syncthreads();
    }
    SEAM(0);
    for (int rep = 0; rep <= REP_PRE; ++rep)
    if (PHEN(11) && IN(1)) { PH_IDS();
        const float* n1g = norm1_g; const float* n2g = norm2_g;
        pre_rows(x_in, n1g, MOD, XN, (float*)(ws + WS_SSP), gw, NGW, lane);
        pre_avec(n1g, n2g, MOD, (float*)(ws + WS_AVEC), vcu * NTHREADS + tid, G * NTHREADS);
        for (int l = 0; l < DEPTH; ++l) {
            const float* m0 = MOD + (size_t)l * 2 * 6144; const float* m1 = m0 + 6144;
            pre_bias((const bf16*)(ws + WS_WIN + l * WIN_BYTES), NIN, m0, m1, (float*)(ws + WS_BIASIN) + (size_t)l * 2 * NIN, (float*)(ws + WS_BIASIN) + (size_t)l * 2 * NIN + NIN, gw, NGW, lane);
            pre_bias((const bf16*)(ws + WS_WGU + l * WGU_BYTES), NGU, m0 + 3072, m1 + 3072, (float*)(ws + WS_BIASGU) + (size_t)l * 2 * NGU, (float*)(ws + WS_BIASGU) + (size_t)l * 2 * NGU + NGU, gw, NGW, lane);
        }
    }
    SEAM(1);

    for (int l = 0; l < DEPTH; ++l) {
        const int pb = 2 + 8 * l;
        for (int rep = 0; rep <= REP_GIN; ++rep)
        if (PHEN(0) && IN(pb + 0)) { PH_IDS();
            pg8::Gemm g{XN, (const bf16*)(ws + WS_WIN + l * WIN_BYTES), MROWS, NIN, DM}; pg8::StaticOrder S; S.init(MROWS, NIN, G, bx);
            LAS float* rt = (LAS float*)(lds + ATT_TAB); LAS float* bt = rt + 512;
            LAS float* gt = bt + 11 * 256;
            const int pm0 = rstd_tables(S, (const float*)(ws + WS_SSP), rt, (const float*)(ws + WS_BIASIN) + (size_t)l * 2 * NIN, NIN, bt, tid,
                                        fox_q_g + l * 64, fox_k_g + l * 64, moba_q_g + l * 64, moba_k_g + l * 64, gt);
            pg8::EpiProj E{PROJ, GATES, PLD, rt, pm0, bt, gt, KMEAN, QSCALE};
            pg8::gemm_phase<pg8::EpiProj, pg8::StaticOrder, GIN_ALIGN, GIN_SP2>(lds, g, S, E, tid);
        }
        SEAM(pb + 0);
        if (PHEN(1) && IN(pb + 1)) { PH_IDS();
            for (int u = vcu; u < 268; u += G) {
                if (u < 12) post_foxcum_unit(u, GATES, FOXCUM, fox_f_bias + l * 6, ldsf, tid, wave, lane);
                else { const int which = (u - 12) & 1; post_conv_unit((u - 12) >> 1, which, PROJ, which ? KC : QC, ml_conv_w + l * 4 * 512, ml_conv_b + l * 512, tid); }
            }
#if GATE_IN_POST
            if (vcu >= 12) { const float B2m = 8.f * LOG2E * wave_max(fabsf(moba_q_g[l * 64 + lane])) * wave_max(fabsf(moba_k_g[l * 64 + lane])) * 1.01f;
                unsigned* LCNT = (unsigned*)(ctl + CW_LCNT + l * 768); unsigned short* LIST = (unsigned short*)(ws + WS_LIST);
                __syncthreads();
                for (int u = vcu - 12; u < 768; u += G - 12) moba_gate_mfma(u, PROJ, KMEAN, SEL, LCNT, (unsigned*)(ws + WS_CTAB), LIST, B2m, THRESH2, lds, tid, wave, lane); }
#endif
            for (int rep = 0; rep < REP_CONV; ++rep) for (int u = vcu; u < 256; u += G) { const int which = u & 1; post_conv_unit(u >> 1, which, PROJ, which ? KC : QC, ml_conv_w + l * 4 * 512, ml_conv_b + l * 512, tid); }
            for (int rep = 0; rep < REP_FCUM; ++rep) for (int u = vcu; u < 12; u += G) post_foxcum_unit(u, GATES, FOXCUM, fox_f_bias + l * 6, ldsf, tid, wave, lane);
        }
        SEAM(pb + 1);
        if (PHEN(2) && IN(pb + 2)) { PH_IDS(); MK_MP();
            const float B2m = 8.f * LOG2E * wave_max(fabsf(moba_q_g[l * 64 + lane])) * wave_max(fabsf(moba_k_g[l * 64 + lane])) * 1.01f;
            unsigned* LCNT = (unsigned*)(ctl + CW_LCNT + l * 768); unsigned short* LIST = MOBA_MFMA ? (unsigned short*)(ws + WS_LIST) : nullptr;
#if ML_MFMA
#ifndef GATE_MFMA
#define GATE_MFMA 1
#endif
#if GATE_MFMA && GATE_IN_POST
#elif GATE_MFMA
            for (int u = vcu; u < 768; u += G) moba_gate_mfma(u, PROJ, KMEAN, SEL, LCNT, (unsigned*)(ws + WS_CTAB), LIST, B2m, THRESH2, lds, tid, wave, lane);
#else
            for (int u = vcu; u < 768; u += G) moba_gate_unit(u, PROJ, KMEAN, SEL, LCNT, (unsigned*)(ws + WS_CTAB), LIST, B2m, THRESH2, ldsf, tid);
#endif
            for (int u = gw; u < 2048; u += NGW) mlstm_m1_mfma(u, MP, lds, wave, lane);
            __syncthreads();
#ifdef REP_GATEM
            for (int rep = 0; rep < REP_GATEM; ++rep) for (int u = vcu; u < 768; u += G) moba_gate_mfma(u, PROJ, KMEAN, SEL, LCNT + 4096, (unsigned*)(ws + WS_OPART + 32 * MiB), (unsigned short*)(ws + WS_OPART), B2m, THRESH2, lds, tid, wave, lane);
#endif
#ifdef REP_M1M
            for (int rep = 0; rep < REP_M1M; ++rep) { for (int u = gw; u < 2048; u += NGW) mlstm_m1_mfma(u, MP, lds, wave, lane); __syncthreads(); }
#endif
#else
            for (int u = vcu; u < 768 + 2048; u += G) {
                if (u < 768) moba_gate_unit(u, PROJ, KMEAN, SEL, LCNT, (unsigned*)(ws + WS_CTAB), LIST, B2m, THRESH2, ldsf, tid);
                else mlstm_m1(u - 768, MP, ldsf, tid, wave, lane);
            }
#endif
            for (int rep = 0; rep < REP_GATE; ++rep) for (int u = vcu; u < 768; u += G) moba_gate_unit(u, PROJ, KMEAN, SEL, LCNT, (unsigned*)(ws + WS_CTAB), nullptr, B2m, THRESH2, ldsf, tid);
            for (int rep = 0; rep < REP_GATE2; ++rep) for (int u = vcu; u < 768; u += G) moba_gate_unit(u, PROJ, KMEAN, SEL, LCNT + 4096, (unsigned*)(ws + WS_OPART + 32 * MiB), (unsigned short*)(ws + WS_OPART), B2m, THRESH2, ldsf, tid);
            for (int rep = 0; rep < REP_M1; ++rep) for (int u = vcu; u < 2048; u += G) mlstm_m1(u, MP, ldsf, tid, wave, lane);
#if FOX_MFMA
            { const float gq = wave_max(fabsf(fox_q_g[l * 64 + lane])), gk = wave_max(fabsf(fox_k_g[l * 64 + lane])); const float B2 = 8.f * LOG2E * gq * gk * 1.01f;
#if FOX_PIPE
              fox_phase_pipe(PROJ, FOXCUM, Y, B2, lds, vcu, G, tid, wave, lane); }
#else
              for (int rep = 0; rep <= REP_FOX; ++rep)
              for (int u = vcu; u < 768; u += G) FOX_FN(u >> 6, 63 - (u & 63), PROJ, FOXCUM, Y, B2, lds, tid, wave, lane); }
#endif
#else
            fox_naive(PROJ, FOXCUM, Y, gw, NGW, lane);
#endif
        }
        SEAM(pb + 2);
        for (int rep = 0; rep <= REP_MIXB; ++rep)
        if (PHEN(3) && IN(pb + 3)) { PH_IDS(); MK_MP();
            for (int rep = 0; rep <= REP_M2; ++rep)
            for (int u = vcu; u < 64; u += G) mlstm_m2(u, MP, ldsf, tid, wave, lane);
#if MOBA_MFMA
            { const float gq = wave_max(fabsf(moba_q_g[l * 64 + lane])), gk = wave_max(fabsf(moba_k_g[l * 64 + lane])); const float B2 = 8.f * LOG2E * gq * gk * 1.01f;
              LAS int* pre = (LAS int*)(lds + ATT_TAB + 1024);
              const unsigned* lcnt = (const unsigned*)(ctl + CW_LCNT + l * 768);
              if (wave == 0) { int carry = 0;
                  for (int r = 0; r < 12; ++r) { const int p = r * 64 + lane; int x = (int)((lcnt[p] + 127u) >> 7);
#pragma unroll
                      for (int o = 1; o < 64; o <<= 1) { const int n = supi(x, o, lane); if (lane >= o) x += n; }
                      pre[p + 1] = carry + x; carry += shfi(x, 63); }
                  if (lane == 0) pre[0] = 0; }
              __syncthreads();
              const int S = pre[768];
              const unsigned short* LIST = (const unsigned short*)(ws + WS_LIST); bf16* OPART = (bf16*)(ws + WS_OPART); float* LPART = (float*)(ws + WS_LPART);
              #ifndef KSKIP_N
#define KSKIP_N 3
#endif
              constexpr int KSKIP = KSKIP_N; const int S2 = (S + 1) >> 1; const int NU = S2 + 384;
#ifndef SEL_PIPE
#define SEL_PIPE 1
#endif
              const auto uof = [=](int i_) { return (i_ < KSKIP) ? i_ * (G - 64) + (vcu - 64) : KSKIP * (G - 64) + (i_ - KSKIP) * G + vcu; };
              int i = (vcu < 64 ? KSKIP : 0);
#if SEL_PIPE
              i = moba_sel_pipe(i, uof, S, S2, pre, lcnt, PROJ, LIST, (const unsigned*)(ws + WS_CTAB), OPART, LPART, Y, B2, lds, tid, wave, lane);
#endif
              for (; ; ++i) {
                  const int u = uof(i);
                  if (u >= NU) break;
                  if (u < S2) moba_sel_step(2 * u, S, pre, lcnt, PROJ, LIST, (const unsigned*)(ws + WS_CTAB), OPART, LPART, Y, B2, lds, tid, wave, lane);
                  else { const int p = u - S2; moba_own_pair(p >> 5, p & 31, 63 - (p & 31), PROJ, OPART, LPART, Y, B2, lds, tid, wave, lane); }
              } }
#else
            moba_naive(PROJ, SEL, Y, gw, NGW, lane);
#endif
        }
        SEAM(pb + 3);
        if (PHEN(4) && IN(pb + 4)) { PH_IDS(); MK_MP();
#if ML_MFMA
            for (int rep = 0; rep <= REP_M3; ++rep)
            for (int u = vcu; u < 512; u += G) mlstm_m3_mfma(u, MP, lds, tid, wave, lane);
#else
            for (int rep = 0; rep <= REP_M3; ++rep)
            for (int u = vcu; u < 2048; u += G) mlstm_m3(u, MP, ldsf, tid, wave, lane);
#endif
#if MOBA_MFMA
            for (int rep = 0; rep < REP_COMB; ++rep) moba_combine(SEL, (const bf16*)(ws + WS_OPART), (const float*)(ws + WS_LPART), Y, (bf16*)(ws + WS_U), 384, 0, vcu * NTHREADS + tid, G * NTHREADS);
            moba_combine(SEL, (const bf16*)(ws + WS_OPART), (const float*)(ws + WS_LPART), Y, Y, 1024, Y_MOBA, vcu * NTHREADS + tid, G * NTHREADS);
#endif
        }
        SEAM(pb + 4);
        if (PHEN(5) && IN(pb + 5)) { PH_IDS();
            pg8::Gemm g{Y, (const bf16*)(ws + WS_WOUT + l * WOUT_BYTES), MROWS, DM, DM}; pg8::StaticOrder S; S.init(MROWS, DM, G, bx);
            const void* rbase = (l == 0) ? (const void*)x_in : (const void*)xres; void* rout = (l + 1 < DEPTH) ? (void*)xres : (void*)(ws + WS_OPART);
#ifndef GOUT_ALIGN
#define GOUT_ALIGN true
#endif
#ifndef GDN_ALIGN
#define GDN_ALIGN true
#endif
            pg8::EpiRes E{rbase, rout, l != 0, true, mod_l + 2048, 6144, SEQ, XN, (const float*)(ws + WS_AVEC) + (size_t)((l * 2 + 1) * 2) * 1024, (float*)(ws + WS_SSP)};
            pg8::gemm_phase<pg8::EpiRes, pg8::StaticOrder, GOUT_ALIGN, true>(lds, g, S, E, tid);
        }
        SEAM(pb + 5);
        for (int rep = 0; rep <= REP_GGU; ++rep)
        if (PHEN(6) && IN(pb + 6)) { PH_IDS();
#ifdef GGU_DELAY_US
            { const unsigned long long t0_ = __builtin_amdgcn_s_memrealtime(); while (__builtin_amdgcn_s_memrealtime() - t0_ < (unsigned long long)(GGU_DELAY_US) * 100ull) __builtin_amdgcn_s_sleep(8); }
#endif
            pg8::Gemm g{XN, (const bf16*)(ws + WS_WGU + l * WGU_BYTES), MROWS, NGU, DM}; pg8::StaticOrder S; S.init(MROWS, NGU, G, bx);
            LAS float* rt = (LAS float*)(lds + ATT_TAB); LAS float* bt = rt + 512;
            const int pm0 = rstd_tables(S, (const float*)(ws + WS_SSP), rt, (const float*)(ws + WS_BIASGU) + (size_t)l * 2 * NGU, NGU, bt, tid);
            pg8::EpiSwiglu E{HB, DFF, rt, pm0, bt};
            pg8::gemm_phase<pg8::EpiSwiglu, pg8::StaticOrder, GGU_ALIGN, GGU_SP2>(lds, g, S, E, tid);
        }
        SEAM(pb + 6);
        if (PHEN(7) && IN(pb + 7)) { PH_IDS();
            pg8::Gemm g{HB, (const bf16*)(ws + WS_WDN + l * WDN_BYTES), MROWS, DM, DFF}; pg8::StaticOrder S; S.init(MROWS, DM, G, bx);
            const void* rbase = (l + 1 < DEPTH) ? (const void*)xres : (const void*)(ws + WS_OPART); void* rout = (void*)xres;
            pg8::EpiRes E{rbase, rout, true, l + 1 < DEPTH, mod_l + 5120, 6144, SEQ, (l + 1 < DEPTH) ? XN : (bf16*)nullptr, (const float*)(ws + WS_AVEC) + (size_t)(((l + 1) * 2 + 0) * 2) * 1024, (float*)(ws + WS_SSP)};
            pg8::gemm_phase<pg8::EpiRes, pg8::StaticOrder, GDN_ALIGN, true>(lds, g, S, E, tid);
        }
        SEAM(pb + 7);
    }
#undef IN
#undef SEAM
}

extern "C" void kernel_launch(void* const* d_in, const int* in_sizes, int n_in, void* d_out, int out_size, void* d_ws, size_t ws_size, hipStream_t stream) {
    static int grid = 0;
    if (grid == 0) {
        if (n_in != 20 || in_sizes[0] != MROWS * DM || out_size != MROWS * DM || ws_size < WS_END) {
            fprintf(stderr, "kernel_launch: unexpected shapes: n_in %d in0 %d out %d ws %zu (need >= %zu)\n", n_in, n_in > 0 ? in_sizes[0] : -1, out_size, ws_size, (size_t)WS_END); grid = -1; return; }
        int dev = 0, cus = 0, per_cu = 0;
        if (hipGetDevice(&dev) != hipSuccess || hipDeviceGetAttribute(&cus, hipDeviceAttributeMultiprocessorCount, dev) != hipSuccess) { grid = -1; return; }
        if (hipFuncSetAttribute((const void*)fwd, hipFuncAttributeMaxDynamicSharedMemorySize, LDS_BYTES) != hipSuccess) { fprintf(stderr, "kernel_launch: hipFuncSetAttribute failed\n"); grid = -1; return; }
        if (hipOccupancyMaxActiveBlocksPerMultiprocessor(&per_cu, (const void*)fwd, NTHREADS, LDS_BYTES) != hipSuccess || per_cu < 1)
            fprintf(stderr, "kernel_launch: note: occupancy query reports %d workgroups per CU\n", per_cu);
        (void)hipGetLastError();
        grid = cus;
    }
    if (grid < 0) return;
    if (hipMemsetAsync((char*)d_ws + WS_CTL, 0, CTL_ZERO_BYTES, stream) != hipSuccess) return;
    Args a{};
    for (int i = 0; i < 20; ++i) a.in[i] = (const float*)d_in[i];
    a.out = (float*)d_out; a.ws = (unsigned char*)d_ws;
    if (N_LAUNCH_MODE == 1) { a.ph_lo = 0; a.ph_hi = NPHASE; hipLaunchKernelGGL(fwd, dim3(grid), dim3(NTHREADS), LDS_BYTES, stream, a); }
    else for (int p = 0; p < NPHASE; ++p) { a.ph_lo = p; a.ph_hi = p + 1; hipLaunchKernelGGL(fwd, dim3(grid), dim3(NTHREADS), LDS_BYTES, stream, a); }
}
```

```cpp
#include <hip/hip_runtime.h>
#include <cstdio>
#include <cstdint>

constexpr int DM = 1024, NBATCH = 2, SEQ = 16384, MROWS = NBATCH * SEQ, DEPTH = 2;
constexpr int HD = 64, FOXH = 6, MLH = 4, MOBH = 6;
constexpr int DFF = 2816, INC = 3342, NIN = 3584, PLD = 3328;
constexpr int NGU = 2 * DFF;
constexpr int C_FQ = 0, C_FK = 384, C_FV = 768, C_BQ = 1152, C_BK = 1536, C_BV = 1920, C_MQ = 2304, C_MK = 2560, C_MV = 2816, C_MO = 3072, C_G = 3328;
constexpr int Y_FOX = 0, Y_ML = 384, Y_MOBA = 640;
constexpr int MOBA_BS = 256, NBLK = SEQ / MOBA_BS;
constexpr int MLC = 64, NCHUNK = SEQ / MLC;
constexpr float LOG2E = 1.4426950408889634f;
constexpr float QSCALE = 0.125f * LOG2E;
constexpr float EPS = 1e-6f;

#define GAS __attribute__((address_space(1)))
#define LAS __attribute__((address_space(3)))
typedef unsigned short bf16;
typedef unsigned v4u __attribute__((ext_vector_type(4)));
typedef unsigned v2u __attribute__((ext_vector_type(2)));
typedef float f32x4 __attribute__((ext_vector_type(4)));
typedef short bf16x8 __attribute__((ext_vector_type(8)));
typedef float f32x16 __attribute__((ext_vector_type(16)));
typedef GAS unsigned gu32;
#define RLX_AGENT __ATOMIC_RELAXED, __HIP_MEMORY_SCOPE_AGENT
__device__ __forceinline__ unsigned f2bf(float f) { unsigned u = __builtin_bit_cast(unsigned, f); return (u + 0x7fffu + ((u >> 16) & 1u)) >> 16; }
__device__ __forceinline__ unsigned pk2(float lo, float hi) { return f2bf(lo) | (f2bf(hi) << 16); }
__device__ __forceinline__ float bf2f(unsigned short u) { return __builtin_bit_cast(float, (unsigned)u << 16); }
__device__ __forceinline__ float bflo(unsigned w) { return __builtin_bit_cast(float, w << 16); }
__device__ __forceinline__ float bfhi(unsigned w) { return __builtin_bit_cast(float, w & 0xffff0000u); }
#ifndef OLD_SHFL
#define OLD_SHFL 0
#endif
#ifndef OLD_SWZ
#define OLD_SWZ OLD_SHFL
#endif
#ifndef OLD_HALF
#define OLD_HALF OLD_SHFL
#endif
#ifndef OLD_SHF
#define OLD_SHF OLD_SHFL
#endif
#ifndef OLD_SUP
#define OLD_SUP OLD_SHFL
#endif
#if OLD_SWZ
#define SWZ_X(v, o) __shfl_xor((float)(v), (o))
#else
#define SWZ_X(v, o) __builtin_bit_cast(float, __builtin_amdgcn_ds_swizzle(__builtin_bit_cast(int, (float)(v)), ((o) << 10) | 0x1f))
#endif
__device__ __forceinline__ float half_sum(float v, int lane) { return v + __builtin_bit_cast(float, __builtin_amdgcn_ds_bpermute((lane ^ 32) << 2, __builtin_bit_cast(int, v))); }
#if OLD_SHF
__device__ __forceinline__ float shf(float v, int src) { return __shfl(v, src); }
__device__ __forceinline__ int shfi(int v, int src) { return __shfl(v, src); }
#else
__device__ __forceinline__ float shf(float v, int src) { return __builtin_bit_cast(float, __builtin_amdgcn_ds_bpermute(src << 2, __builtin_bit_cast(int, v))); }
__device__ __forceinline__ int shfi(int v, int src) { return __builtin_amdgcn_ds_bpermute(src << 2, v); }
#endif
#if OLD_SUP
__device__ __forceinline__ float sup(float v, int o, int lane) { return __shfl_up(v, o); }
__device__ __forceinline__ int supi(int v, int o, int lane) { return __shfl_up(v, o); }
#else
__device__ __forceinline__ float sup(float v, int o, int lane) { return shf(v, lane >= o ? lane - o : lane); }
__device__ __forceinline__ int supi(int v, int o, int lane) { return shfi(v, lane >= o ? lane - o : lane); }
#endif
__device__ __forceinline__ float wave_sum(float v) { v += SWZ_X(v, 1); v += SWZ_X(v, 2); v += SWZ_X(v, 4); v += SWZ_X(v, 8); v += SWZ_X(v, 16);
    return __builtin_bit_cast(float, __builtin_amdgcn_readlane(__builtin_bit_cast(int, v), 0)) + __builtin_bit_cast(float, __builtin_amdgcn_readlane(__builtin_bit_cast(int, v), 32)); }
__device__ __forceinline__ float wave_max(float v) { v = fmaxf(v, SWZ_X(v, 1)); v = fmaxf(v, SWZ_X(v, 2)); v = fmaxf(v, SWZ_X(v, 4)); v = fmaxf(v, SWZ_X(v, 8)); v = fmaxf(v, SWZ_X(v, 16));
    return fmaxf(__builtin_bit_cast(float, __builtin_amdgcn_readlane(__builtin_bit_cast(int, v), 0)), __builtin_bit_cast(float, __builtin_amdgcn_readlane(__builtin_bit_cast(int, v), 32))); }
__device__ __forceinline__ float log_sigmoid_f(float x) { return fminf(x, 0.f) - log1pf(expf(-fabsf(x))); }
__device__ __forceinline__ float log_sigmoid_fast(float x) { const float x2 = x * LOG2E; return 0.6931471805599453f * (fminf(x2, 0.f) - __builtin_amdgcn_logf(1.f + __builtin_amdgcn_exp2f(-fabsf(x2)))); }
__device__ __forceinline__ float exp_fast(float x) { return __builtin_amdgcn_exp2f(x * LOG2E); }
__device__ __forceinline__ float sigmoid_f(float x) { return 1.f / (1.f + expf(-x)); }

constexpr size_t MiB = 1u << 20;
constexpr size_t WS_CTL = 0, CTL_ZERO_BYTES = 1 * MiB;
constexpr size_t WS_MOD = 1 * MiB;
constexpr size_t WS_KMEAN = WS_MOD + 128 * 1024;
constexpr size_t WS_MLS = WS_KMEAN + 512 * 1024;
constexpr size_t WS_BEND = WS_MLS, WS_MLOC = WS_MLS + 8192, WS_MS = WS_MLS + 16384, WS_NU = WS_MLS + 32768, WS_NS = WS_NU + 2048 * 64 * 4;
constexpr size_t WS_CTAB = 3 * MiB;
constexpr size_t WS_PTAB = WS_CTAB + 256 * 1024;
static_assert(WS_NS + 2048 * 64 * 4 <= WS_CTAB && WS_CTAB + 12 * 64 * 64 * 4 <= WS_PTAB && WS_PTAB + 256 <= 4 * MiB, "small region");
constexpr size_t WS_WIN = 4 * MiB, WIN_BYTES = (size_t)NIN * DM * 2;
constexpr size_t WS_WOUT = WS_WIN + 2 * WIN_BYTES, WOUT_BYTES = (size_t)DM * DM * 2;
constexpr size_t WS_WGU = WS_WOUT + 2 * WOUT_BYTES, WGU_BYTES = (size_t)NGU * DM * 2;
constexpr size_t WS_WDN = WS_WGU + 2 * WGU_BYTES, WDN_BYTES = (size_t)DM * DFF * 2;
static_assert(WS_WDN + 2 * WDN_BYTES <= 56 * MiB, "weights");
constexpr size_t WS_SSP = 56 * MiB;
constexpr size_t WS_AVEC = 58 * MiB;
constexpr size_t WS_BIASIN = WS_AVEC + 64 * 1024;
constexpr size_t WS_BIASGU = WS_BIASIN + 64 * 1024;
static_assert(WS_BIASGU + 2 * 2 * NGU * 4 <= 64 * MiB && 2 * 2 * NIN * 4 <= 64 * 1024, "fused-norm vectors");
constexpr size_t WS_XN = 64 * MiB;
constexpr size_t WS_U = 64 * MiB;
constexpr size_t WS_CS = 96 * MiB;
constexpr size_t WS_LIST = 112 * MiB;
constexpr size_t WS_PROJ = 128 * MiB;
constexpr size_t WS_H = 128 * MiB;
constexpr size_t WS_Y = 336 * MiB;
constexpr size_t WS_QC = 400 * MiB, WS_KC = 416 * MiB;
constexpr size_t WS_OPART = 432 * MiB;
constexpr size_t WS_LPART = 504 * MiB;
constexpr size_t WS_GATES = 507 * MiB;
constexpr size_t WS_FOXCUM = 509 * MiB;
constexpr size_t WS_SEL = 510 * MiB;
constexpr size_t WS_END = 512 * MiB;
static_assert(WS_PROJ + (size_t)MROWS * PLD * 2 <= WS_Y && WS_SEL + (size_t)MROWS * 6 * 4 <= WS_END, "ws map");
constexpr int CW_BAR = 4096;
constexpr int CW_QUEUE = 16384;
constexpr int CW_LCNT = 32768;

constexpr int RING_BYTES = 131072, LDSCTL_OFF = RING_BYTES, MISC_OFF = LDSCTL_OFF + 320, LDS_BYTES = 147456;
constexpr int NWAVES = 8, NTHREADS = 512;
#ifndef REP_EPI
#define REP_EPI 0
#define REP_EPI_ID -1
#endif
namespace pg8 {
#define PG8_LAS __attribute__((address_space(3)))
typedef unsigned short bf16_t;
typedef short bf16x8 __attribute__((ext_vector_type(8)));
typedef float f32x4 __attribute__((ext_vector_type(4)));
typedef unsigned u32x4 __attribute__((ext_vector_type(4)));
constexpr int BM = 256, BK = 64, HALF = 128, HTB = HALF * BK * 2  , STAGE_BYTES = 8 * HTB, NXCD = 8, WGM = 8;

__host__ __device__ __forceinline__ int lds_byte(int r, int c) { const int st = (r >> 4) * 2 + (c >> 5), rr = r & 15, cc = c & 31, ob = rr * 64 + cc * 2; return st * 1024 + (ob ^ (((ob >> 9) & 1) << 5)); }
__host__ __device__ __forceinline__ void stage_rc(int b, int& R, int& C) { const int st = b / 1024, sb = b % 1024, swz = sb ^ (((sb >> 9) & 1) << 5); R = (st >> 1) * 16 + swz / 64; C = (st & 1) * 32 + (swz % 64) / 2; }
__host__ __device__ __forceinline__ int perm32(int rho) { const int n = rho >> 4, i = rho & 15; return 8 * (i >> 2) + 4 * n + (i & 3); }

struct Unit { int pm, pn, ord; };
struct Gemm { const bf16_t* A; const bf16_t* Bt; int M, N, K; };

struct StaticOrder {
    int nM, nN, nwg, G, c;
    __host__ __device__ void init(int M, int N, int G_, int c_) { nM = M / BM; nN = N / BM; nwg = nM * nN; G = G_; c = c_; }
    __host__ __device__ __forceinline__ bool next(int i, Unit& u) const {
        const long L = (long)i * G + c; if (L >= nwg) return false;
        int wgid = (int)L; { const int q = nwg / NXCD, r = nwg % NXCD, xcd = wgid % NXCD, off = wgid / NXCD; wgid = (xcd < r ? xcd * (q + 1) : r * (q + 1) + (xcd - r) * q) + off; }
        const int nig = WGM * nN, gid = wgid / nig, fm = gid * WGM, gsz = (nM - fm) < WGM ? (nM - fm) : WGM;
        u.pm = fm + ((wgid % nig) % gsz); u.pn = (wgid % nig) / gsz; u.ord = i; return true;
    }
    __device__ __forceinline__ void a_ready(const Unit&) const {}
    __device__ __forceinline__ void done(const Unit&) const {}
};

__device__ __forceinline__ unsigned cvt_pk_bf16(float lo, float hi) { unsigned r; asm volatile("v_cvt_pk_bf16_f32 %0, %1, %2" : "=v"(r) : "v"(lo), "v"(hi)); return r; }
typedef float f32x2 __attribute__((ext_vector_type(2)));
typedef unsigned u32x2 __attribute__((ext_vector_type(2)));
struct EpiProj {
    static constexpr bool PERM = true, AFTER_DRAIN = false; static constexpr int ID = 0;
    bf16_t* P; float* G; int pld; PG8_LAS const float* rt; int pm0; PG8_LAS const float* bt;
    PG8_LAS const float* gt; float* kmeanp; float qscale;
    __device__ __forceinline__ void operator()(const f32x4 (&acc)[2][2][4][2], const Unit& u, int wr, int wc, int fr, int fq) const {
        const int row0 = u.pm * BM + wr * 64 + fr;
        PG8_LAS const float* rs = rt + (u.pm == pm0 ? 0 : 256) + wr * 64 + fr;
        PG8_LAS const float* bb = bt + u.ord * 256 + wc * 32 + 8 * fq;
        if (u.pn < 13) {
            const int hcol = u.pn * BM + 64 * wc;
            const int kind = hcol < 384 ? 0 : hcol < 768 ? 1 : (hcol >= 1152 && hcol < 1536) ? 2 : (hcol >= 1536 && hcol < 1920) ? 3 : -1;
            f32x4 bv[2][2], gv[2][2];
#pragma unroll
            for (int bj = 0; bj < 2; ++bj)
#pragma unroll
                for (int n = 0; n < 2; ++n) { bv[bj][n] = *(PG8_LAS const f32x4*)(bb + bj * HALF + 4 * n);
                    gv[bj][n] = (kind >= 0) ? *(PG8_LAS const f32x4*)(gt + kind * 64 + 32 * bj + 8 * fq + 4 * n) : (f32x4){1.f, 1.f, 1.f, 1.f}; }
            if (kind == 0 || kind == 2) {
#pragma unroll
                for (int bj = 0; bj < 2; ++bj)
#pragma unroll
                    for (int n = 0; n < 2; ++n) gv[bj][n] = gv[bj][n] * qscale; }
            float rsv[2][4];
#pragma unroll
            for (int ai = 0; ai < 2; ++ai)
#pragma unroll
                for (int m = 0; m < 4; ++m) rsv[ai][m] = rs[ai * HALF + m * 16];
            f32x4 ks[2][2];
#pragma unroll
            for (int bj = 0; bj < 2; ++bj)
#pragma unroll
                for (int n = 0; n < 2; ++n) ks[bj][n] = (f32x4){0.f, 0.f, 0.f, 0.f};
            const int lane = fq * 16 + fr;
#pragma unroll
            for (int ai = 0; ai < 2; ++ai)
#pragma unroll
                for (int m = 0; m < 4; ++m) { bf16_t* rowp = P + (size_t)(row0 + ai * HALF + m * 16) * pld + hcol + 8 * fq; const float rstd = rsv[ai][m];
                    f32x4 v[2][2];
#pragma unroll
                    for (int bj = 0; bj < 2; ++bj)
#pragma unroll
                        for (int n = 0; n < 2; ++n) v[bj][n] = acc[ai][bj][m][n] * rstd + bv[bj][n];
                    if (kind >= 0) {
                        f32x4 s4 = v[0][0] * v[0][0]; s4 = v[0][1] * v[0][1] + s4; s4 = v[1][0] * v[1][0] + s4; s4 = v[1][1] * v[1][1] + s4;
                        float ss = (s4[0] + s4[1]) + (s4[2] + s4[3]);
                        ss += SWZ_X(ss, 16); ss += __builtin_bit_cast(float, __builtin_amdgcn_ds_bpermute((lane ^ 32) << 2, __builtin_bit_cast(int, ss)));
                        const float rr = __builtin_amdgcn_rsqf(ss * (1.f / 64.f) + 1e-6f);
#pragma unroll
                        for (int bj = 0; bj < 2; ++bj)
#pragma unroll
                            for (int n = 0; n < 2; ++n) { v[bj][n] = v[bj][n] * rr * gv[bj][n]; ks[bj][n] += v[bj][n]; }
                    }
#pragma unroll
                    for (int bj = 0; bj < 2; ++bj) { const f32x4 v0 = v[bj][0], v1 = v[bj][1];
                        u32x4 w; w.x = cvt_pk_bf16(v0[0], v0[1]); w.y = cvt_pk_bf16(v0[2], v0[3]); w.z = cvt_pk_bf16(v1[0], v1[1]); w.w = cvt_pk_bf16(v1[2], v1[3]);
                        *(u32x4*)(rowp + 32 * bj) = w; } }
            if (kind == 3) {
#pragma unroll
                for (int bj = 0; bj < 2; ++bj)
#pragma unroll
                    for (int n = 0; n < 2; ++n)
#pragma unroll
                        for (int i = 0; i < 4; ++i) { float t = ks[bj][n][i]; t += SWZ_X(t, 1); t += SWZ_X(t, 2); t += SWZ_X(t, 4); t += SWZ_X(t, 8); ks[bj][n][i] = t; }
                if (fr == 0) { const int hd = (hcol - 1536) >> 6, bat = (u.pm * BM) / 16384, nb = u.pm & 63;
                    float* kp = kmeanp + (size_t)wr * (12 * 64 * 64) + (((size_t)bat * 6 + hd) * 64 + nb) * 64 + 8 * fq;
#pragma unroll
                    for (int bj = 0; bj < 2; ++bj)
#pragma unroll
                        for (int n = 0; n < 2; ++n) *(f32x4*)(kp + 32 * bj + 4 * n) = ks[bj][n] * (1.f / 256.f); }
            }
        } else {
            if (wc == 0 && fq < 2) {
                const f32x4 b0 = *(PG8_LAS const f32x4*)(bb), b1 = *(PG8_LAS const f32x4*)(bb + 4);
#pragma unroll
                for (int ai = 0; ai < 2; ++ai)
#pragma unroll
                    for (int m = 0; m < 4; ++m) { float* gp = G + (size_t)(row0 + ai * HALF + m * 16) * 16 + 8 * fq; const float rstd = rs[ai * HALF + m * 16];
                        *(f32x4*)(gp) = acc[ai][0][m][0] * rstd + b0; *(f32x4*)(gp + 4) = acc[ai][0][m][1] * rstd + b1; }
            }
        }
    }
};
struct EpiRes {
    static constexpr bool PERM = true, AFTER_DRAIN = false; static constexpr int ID = 1;
    const void* base; void* out; bool base_bf, out_bf; const float* gate; int gate_bstride; int rows_per_batch; bf16_t* xa; const float* avec; float* ssp;
    PG8_LAS const float* gtab;
    template <class Sched> __device__ __forceinline__ void fill(const Sched& S, PG8_LAS float* tab, int tid) const {
        Unit u; f32x4 q[2]; int nu = 0;
#pragma unroll
        for (int i = 0; i < 2; ++i) { q[i] = (f32x4){0.f, 0.f, 0.f, 0.f};
            if (S.next(i, u)) { nu = i + 1; const int bat = (u.pm * BM) / rows_per_batch;
                if (tid < 64) q[i] = *(const f32x4*)(gate + (size_t)bat * gate_bstride + u.pn * BM + tid * 4);
                else if (tid < 128 && xa) q[i] = *(const f32x4*)(avec + (size_t)bat * 1024 + u.pn * BM + (tid - 64) * 4); } }
        __builtin_amdgcn_sched_barrier(0);
#pragma unroll
        for (int i = 0; i < 2; ++i) if (i < nu) {
            if (tid < 64) *(PG8_LAS f32x4*)(tab + i * 256 + tid * 4) = q[i];
            else if (tid < 128 && xa) *(PG8_LAS f32x4*)(tab + (2 + i) * 256 + (tid - 64) * 4) = q[i]; }
    }
    __device__ __forceinline__ void operator()(const f32x4 (&acc)[2][2][4][2], const Unit& u, int wr, int wc, int fr, int fq) const {
        const int row0 = u.pm * BM + wr * 64 + fr, col0 = u.pn * BM + wc * 32 + 8 * fq;
        PG8_LAS const float* gl = gtab + u.ord * 256 + wc * 32 + 8 * fq;
        f32x4 gv[2][2], av[2][2];
#pragma unroll
        for (int bj = 0; bj < 2; ++bj)
#pragma unroll
            for (int n = 0; n < 2; ++n) { gv[bj][n] = *(PG8_LAS const f32x4*)(gl + bj * HALF + 4 * n); av[bj][n] = xa ? *(PG8_LAS const f32x4*)(gl + 512 + bj * HALF + 4 * n) : (f32x4){0.f, 0.f, 0.f, 0.f}; }
        const int lane = fq * 16 + fr;
#define EPIRES_ROW(m_, b0_, b1_) do { const size_t off = (size_t)(row0 + ai * HALF + (m_) * 16) * 1024 + col0; \
            const f32x4 o0 = (b0_) + gv[bj][0] * acc[ai][bj][m_][0], o1 = (b1_) + gv[bj][1] * acc[ai][bj][m_][1]; \
            if (out_bf) { u32x4 w; w.x = cvt_pk_bf16(o0[0], o0[1]); w.y = cvt_pk_bf16(o0[2], o0[3]); w.z = cvt_pk_bf16(o1[0], o1[1]); w.w = cvt_pk_bf16(o1[2], o1[3]); \
                *(u32x4*)((bf16_t*)out + off + bj * HALF) = w; } \
            else { __builtin_nontemporal_store(o0, (f32x4*)((float*)out + off + bj * HALF)); __builtin_nontemporal_store(o1, (f32x4*)((float*)out + off + bj * HALF + 4)); } \
            if (xa) { const f32x4 q4 = o0 * o0 + o1 * o1; ss[m_] += (q4[0] + q4[1]) + (q4[2] + q4[3]); \
                const f32x4 t0 = o0 * av[bj][0], t1 = o1 * av[bj][1]; \
                u32x4 w; w.x = cvt_pk_bf16(t0[0], t0[1]); w.y = cvt_pk_bf16(t0[2], t0[3]); w.z = cvt_pk_bf16(t1[0], t1[1]); w.w = cvt_pk_bf16(t1[2], t1[3]); \
                *(u32x4*)(xa + off + bj * HALF) = w; } } while (0)
#pragma unroll
        for (int ai = 0; ai < 2; ++ai) {
            float ss[4] = {0.f, 0.f, 0.f, 0.f};
#pragma unroll
            for (int bj = 0; bj < 2; ++bj) {
                u32x4 raw[4];
                if (base_bf) {
#pragma unroll
                    for (int m = 0; m < 4; ++m) raw[m] = *(const u32x4*)((const bf16_t*)base + (size_t)(row0 + ai * HALF + m * 16) * 1024 + col0 + bj * HALF);
#pragma unroll
                    for (int m = 0; m < 4; ++m) { const u32x4 w = raw[m];
                        const f32x4 b0 = (f32x4){__builtin_bit_cast(float, w.x << 16), __builtin_bit_cast(float, w.x & 0xffff0000u), __builtin_bit_cast(float, w.y << 16), __builtin_bit_cast(float, w.y & 0xffff0000u)};
                        const f32x4 b1 = (f32x4){__builtin_bit_cast(float, w.z << 16), __builtin_bit_cast(float, w.z & 0xffff0000u), __builtin_bit_cast(float, w.w << 16), __builtin_bit_cast(float, w.w & 0xffff0000u)};
                        EPIRES_ROW(m, b0, b1); }
                } else {
#pragma unroll
                    for (int mp = 0; mp < 4; mp += 2) {
#pragma unroll
                        for (int q = 0; q < 2; ++q) { const float* bp = (const float*)base + (size_t)(row0 + ai * HALF + (mp + q) * 16) * 1024 + col0 + bj * HALF; raw[2 * q] = *(const u32x4*)bp; raw[2 * q + 1] = *(const u32x4*)(bp + 4); }
#pragma unroll
                        for (int q = 0; q < 2; ++q) { const f32x4 b0 = __builtin_bit_cast(f32x4, raw[2 * q]), b1 = __builtin_bit_cast(f32x4, raw[2 * q + 1]); EPIRES_ROW(mp + q, b0, b1); } }
                } }
            if (xa) {
#pragma unroll
                for (int m = 0; m < 4; ++m) { float t = ss[m]; t += SWZ_X(t, 16); t += __builtin_bit_cast(float, __builtin_amdgcn_ds_bpermute((lane ^ 32) << 2, __builtin_bit_cast(int, t)));
                    if (fq == 0) ssp[(size_t)(row0 + ai * HALF + m * 16) * 16 + u.pn * 4 + wc] = t; } } }
#undef EPIRES_ROW
    }
};
struct EpiSwiglu {
    static constexpr bool PERM = true, AFTER_DRAIN = false; static constexpr int ID = 2;
    bf16_t* Hh; int ldh; PG8_LAS const float* rt; int pm0; PG8_LAS const float* bt;
    __device__ __forceinline__ void operator()(const f32x4 (&acc)[2][2][4][2], const Unit& u, int wr, int wc, int fr, int fq) const {
        const int row0 = u.pm * BM + wr * 64 + fr, col0 = u.pn * HALF + wc * 32 + 8 * fq;
        PG8_LAS const float* rs = rt + (u.pm == pm0 ? 0 : 256) + wr * 64 + fr;
        PG8_LAS const float* bb = bt + u.ord * 256 + wc * 32 + 8 * fq;
        f32x4 bv[2][2], bl[2];
#pragma unroll
        for (int bj = 0; bj < 2; ++bj)
#pragma unroll
            for (int n = 0; n < 2; ++n) bv[bj][n] = *(PG8_LAS const f32x4*)(bb + bj * HALF + 4 * n);
#pragma unroll
        for (int n = 0; n < 2; ++n) bl[n] = bv[0][n] * -1.4426950408889634f;
        float rsv[2][4];
#pragma unroll
        for (int ai = 0; ai < 2; ++ai)
#pragma unroll
            for (int m = 0; m < 4; ++m) rsv[ai][m] = rs[ai * HALF + m * 16];
#pragma unroll
        for (int ai = 0; ai < 2; ++ai)
#pragma unroll
            for (int m = 0; m < 4; ++m) { bf16_t* rowp = Hh + (size_t)(row0 + ai * HALF + m * 16) * ldh + col0; const float rstd = rsv[ai][m], rl = rstd * -1.4426950408889634f;
                f32x4 gg[2], uu[2], ee[2];
#pragma unroll
                for (int n = 0; n < 2; ++n) { gg[n] = acc[ai][0][m][n] * rstd + bv[0][n]; uu[n] = acc[ai][1][m][n] * rstd + bv[1][n]; ee[n] = acc[ai][0][m][n] * rl + bl[n]; }
#pragma unroll
                for (int n = 0; n < 2; ++n)
#pragma unroll
                    for (int i = 0; i < 4; ++i) ee[n][i] = __builtin_amdgcn_exp2f(ee[n][i]);
#pragma unroll
                for (int n = 0; n < 2; ++n) ee[n] = ee[n] + 1.0f;
#pragma unroll
                for (int n = 0; n < 2; ++n)
#pragma unroll
                    for (int i = 0; i < 4; ++i) ee[n][i] = __builtin_amdgcn_rcpf(ee[n][i]);
                const f32x4 h0 = gg[0] * ee[0] * uu[0], h1 = gg[1] * ee[1] * uu[1];
                u32x4 w; w.x = cvt_pk_bf16(h0[0], h0[1]); w.y = cvt_pk_bf16(h0[2], h0[3]); w.z = cvt_pk_bf16(h1[0], h1[1]); w.w = cvt_pk_bf16(h1[2], h1[3]);
#ifdef H_PLAIN
                *(u32x4*)(rowp) = w; }
#else
                __builtin_nontemporal_store(w, (u32x4*)(rowp)); }
#endif
    }
};
struct NoPre { __device__ __forceinline__ void operator()() const {} };
template <class Epi, class Sched, bool ALIGN_EPI = false, bool SP2 = false, class Pre = NoPre>
__device__ __forceinline__ void gemm_phase(PG8_LAS unsigned char* lds, const Gemm g, const Sched& S, const Epi& E, const int tid_in, const Pre& pre = Pre()) {
    const int tid = tid_in, wid = __builtin_amdgcn_readfirstlane(tid >> 6), lane = tid & 63, wr = wid >> 2, wc = wid & 3, fr = lane & 15, fq = lane >> 4;
    const int K = g.K, nt = K / BK;
    unsigned voffA[2], voffB[2];
#pragma unroll
    for (int i = 0; i < 2; ++i) { int R, C; stage_rc(tid * 16 + i * 8192, R, C); const int Rb = Epi::PERM ? ((R & ~31) + perm32(R & 31)) : R;
        voffA[i] = (unsigned)(R * K + C) * 2u; voffB[i] = (unsigned)(Rb * K + C) * 2u; }
    const size_t kstep = (size_t)(BK * 2);
    const size_t hstep = (size_t)HALF * K * 2;
    const size_t tstep = 2 * hstep;
    const unsigned ldsw = (unsigned)wid * 1024u;
    const int aoff = lds_byte(wr * 64 + fr, fq * 8), boff = lds_byte(wc * 32 + fr, fq * 8);
#define PG8_SA(b, h) (((b) * 2 + (h)) * HTB)
#define PG8_SB(b, h) ((4 + (b) * 2 + (h)) * HTB)
#define PG8_STAGE(bufoff, gbase, voff) do { _Pragma("unroll") for (int _i = 0; _i < 2; ++_i) \
        __builtin_amdgcn_global_load_lds((const unsigned*)((const char*)(gbase) + (voff)[_i]), (PG8_LAS unsigned*)(lds + (bufoff) + ldsw + _i * 8192), 16, 0, 0); } while (0)
#define PG8_LDA(dst, b, h) do { _Pragma("unroll") for (int m = 0; m < 4; ++m) _Pragma("unroll") for (int k = 0; k < 2; ++k) dst[m][k] = *(const PG8_LAS bf16x8*)(lds + PG8_SA(b, h) + aoff + m * 2048 + k * 1024); } while (0)
#define PG8_LDB(dst, b, h) do { _Pragma("unroll") for (int n = 0; n < 2; ++n) _Pragma("unroll") for (int k = 0; k < 2; ++k) dst[n][k] = *(const PG8_LAS bf16x8*)(lds + PG8_SB(b, h) + boff + n * 2048 + k * 1024); } while (0)
#define PG8_MMA(ai, bj, At, Bt) do { __builtin_amdgcn_s_setprio(1); _Pragma("unroll") for (int m = 0; m < 4; ++m) _Pragma("unroll") for (int n = 0; n < 2; ++n) _Pragma("unroll") for (int k = 0; k < 2; ++k) \
        acc[ai][bj][m][n] = __builtin_amdgcn_mfma_f32_16x16x32_bf16(Bt[n][k], At[m][k], acc[ai][bj][m][n], 0, 0, 0); __builtin_amdgcn_s_setprio(0); } while (0)
#define PG8_WAIT_V(n) asm volatile("s_waitcnt vmcnt(" #n ")" ::: "memory")
#define PG8_WAIT_L(n) asm volatile("s_waitcnt lgkmcnt(" #n ")" ::: "memory")
#define PG8_BAR __builtin_amdgcn_s_barrier()
#define PG8_SCHED __builtin_amdgcn_sched_barrier(0)
    Unit cur, nxt; int ui = 0;
    if (!S.next(0, cur)) return;
    f32x4 acc[2][2][4][2];
#pragma unroll
    for (int a = 0; a < 2; ++a)
#pragma unroll
        for (int b = 0; b < 2; ++b)
#pragma unroll
            for (int m = 0; m < 4; ++m)
#pragma unroll
                for (int n = 0; n < 2; ++n) acc[a][b][m][n] = (f32x4){0.f, 0.f, 0.f, 0.f};
    bf16x8 At[4][2], B0[2][2], B1[2][2];
    const char* cA = (const char*)g.A + (size_t)cur.pm * tstep; const char* cB = (const char*)g.Bt + (size_t)cur.pn * tstep;
    S.a_ready(cur);
    if constexpr (SP2) {
        PG8_STAGE(PG8_SB(0, 0), cB, voffB); PG8_STAGE(PG8_SB(0, 1), cB + hstep, voffB); PG8_STAGE(PG8_SA(0, 0), cA, voffA); PG8_STAGE(PG8_SA(0, 1), cA + hstep, voffA);
        pre();
        if (wr == 1) PG8_BAR;
        PG8_WAIT_V(2); PG8_BAR;
        PG8_STAGE(PG8_SB(1, 0), cB + kstep, voffB); PG8_STAGE(PG8_SA(1, 0), cA + kstep, voffA); PG8_STAGE(PG8_SB(1, 1), cB + hstep + kstep, voffB);
        PG8_WAIT_V(6); PG8_BAR;
    } else {
        PG8_STAGE(PG8_SB(0, 0), cB, voffB); PG8_STAGE(PG8_SA(0, 0), cA, voffA); PG8_STAGE(PG8_SB(0, 1), cB + hstep, voffB); PG8_STAGE(PG8_SA(0, 1), cA + hstep, voffA);
        pre();
        if (wr == 1) PG8_BAR;
        PG8_WAIT_V(4); PG8_BAR;
        PG8_STAGE(PG8_SB(1, 0), cB + kstep, voffB); PG8_STAGE(PG8_SA(1, 0), cA + kstep, voffA); PG8_STAGE(PG8_SB(1, 1), cB + hstep + kstep, voffB);
        PG8_WAIT_V(6); PG8_BAR;
    }
    for (;;) {
        const bool has_next = S.next(ui + 1, nxt);
        const char* nA = has_next ? (const char*)g.A + (size_t)nxt.pm * tstep : cA; const char* nB = has_next ? (const char*)g.Bt + (size_t)nxt.pn * tstep : cB;
        for (int t = 0; t < nt; t += 2) {
            const bool last = (t == nt - 2);
            const char* a1 = cA + (size_t)(t + 1) * kstep;
            const char* a2 = last ? nA : cA + (size_t)(t + 2) * kstep; const char* b2 = last ? nB : cB + (size_t)(t + 2) * kstep;
            const char* a3 = a2 + kstep; const char* b3 = b2 + kstep;
            if (last && has_next) S.a_ready(nxt);
            if constexpr (SP2) {
            PG8_LDB(B0, 0, 0); PG8_LDB(B1, 0, 1); PG8_SCHED; PG8_LDA(At, 0, 0); PG8_STAGE(PG8_SA(1, 1), a1 + hstep, voffA);
            PG8_WAIT_V(8); PG8_WAIT_L(0); PG8_BAR; PG8_MMA(0, 0, At, B0); PG8_MMA(0, 1, At, B1); PG8_BAR; PG8_SCHED;
            PG8_LDA(At, 0, 1); PG8_STAGE(PG8_SB(0, 0), b2, voffB); PG8_STAGE(PG8_SB(0, 1), b2 + hstep, voffB); PG8_STAGE(PG8_SA(0, 0), a2, voffA);
            PG8_WAIT_V(8); PG8_WAIT_L(0); PG8_BAR; PG8_MMA(1, 0, At, B0); PG8_MMA(1, 1, At, B1); PG8_BAR; PG8_SCHED;
            PG8_LDB(B0, 1, 0); PG8_LDB(B1, 1, 1); PG8_SCHED; PG8_LDA(At, 1, 0); PG8_STAGE(PG8_SA(0, 1), a2 + hstep, voffA);
            PG8_WAIT_V(8); PG8_WAIT_L(0); PG8_BAR; PG8_MMA(0, 0, At, B0); PG8_MMA(0, 1, At, B1); PG8_BAR; PG8_SCHED;
            PG8_LDA(At, 1, 1); PG8_STAGE(PG8_SB(1, 0), b3, voffB); PG8_STAGE(PG8_SB(1, 1), b3 + hstep, voffB); PG8_STAGE(PG8_SA(1, 0), a3, voffA);
            PG8_WAIT_V(8); PG8_WAIT_L(0); PG8_BAR; PG8_MMA(1, 0, At, B0); PG8_MMA(1, 1, At, B1); PG8_BAR; PG8_SCHED;
            } else {
            PG8_LDB(B0, 0, 0); PG8_SCHED; PG8_LDA(At, 0, 0); PG8_STAGE(PG8_SA(1, 1), a1 + hstep, voffA);
            PG8_WAIT_L(8); PG8_BAR; PG8_WAIT_L(0); PG8_MMA(0, 0, At, B0); PG8_BAR; PG8_SCHED;
            PG8_LDB(B1, 0, 1); PG8_STAGE(PG8_SB(0, 0), b2, voffB);
            PG8_BAR; PG8_WAIT_L(0); PG8_MMA(0, 1, At, B1); PG8_BAR;
            PG8_LDA(At, 0, 1); PG8_STAGE(PG8_SA(0, 0), a2, voffA);
            PG8_BAR; PG8_WAIT_L(0); PG8_MMA(1, 0, At, B0); PG8_BAR; PG8_SCHED;
            PG8_STAGE(PG8_SB(0, 1), b2 + hstep, voffB);
            PG8_WAIT_V(6); PG8_BAR; PG8_MMA(1, 1, At, B1); PG8_BAR;
            PG8_LDB(B0, 1, 0); PG8_SCHED; PG8_LDA(At, 1, 0); PG8_STAGE(PG8_SA(0, 1), a2 + hstep, voffA);
            PG8_WAIT_L(8); PG8_BAR; PG8_WAIT_L(0); PG8_MMA(0, 0, At, B0); PG8_BAR; PG8_SCHED;
            PG8_LDB(B1, 1, 1); PG8_STAGE(PG8_SB(1, 0), b3, voffB);
            PG8_BAR; PG8_WAIT_L(0); PG8_MMA(0, 1, At, B1); PG8_BAR;
            PG8_LDA(At, 1, 1); PG8_STAGE(PG8_SA(1, 0), a3, voffA);
            PG8_BAR; PG8_WAIT_L(0); PG8_MMA(1, 0, At, B0); PG8_BAR; PG8_SCHED;
            PG8_STAGE(PG8_SB(1, 1), b3 + hstep, voffB);
            PG8_WAIT_V(6); PG8_BAR; PG8_MMA(1, 1, At, B1); PG8_BAR;
            }
        }
        if constexpr (ALIGN_EPI) { if (wr == 0) PG8_BAR; }
        if constexpr (!Epi::AFTER_DRAIN) { E(acc, cur, wr, wc, fr, fq);
#if REP_EPI
            if constexpr (Epi::ID == REP_EPI_ID) { for (int r_ = 0; r_ < REP_EPI; ++r_) { asm volatile("" ::: "memory"); E(acc, cur, wr, wc, fr, fq); } }
#endif
            S.done(cur); }
        if (!has_next) break;
#pragma unroll
        for (int a = 0; a < 2; ++a)
#pragma unroll
            for (int b = 0; b < 2; ++b)
#pragma unroll
                for (int m = 0; m < 4; ++m)
#pragma unroll
                    for (int n = 0; n < 2; ++n) acc[a][b][m][n] = (f32x4){0.f, 0.f, 0.f, 0.f};
        cur = nxt; cA = nA; cB = nB; ++ui;
        if constexpr (ALIGN_EPI) { if (wr == 1) PG8_BAR; }
    }
    PG8_WAIT_V(0);
    if constexpr (!ALIGN_EPI) { if (wr == 0) PG8_BAR; }
    PG8_BAR;
    if constexpr (Epi::AFTER_DRAIN) { E.fused(acc, cur, wr, wc, fr, fq, lds, wid, lane); S.done(cur); }
#undef PG8_SA
#undef PG8_SB
#undef PG8_STAGE
#undef PG8_LDA
#undef PG8_LDB
#undef PG8_MMA
#undef PG8_WAIT_V
#undef PG8_WAIT_L
#undef PG8_BAR
#undef PG8_SCHED
}
}
#define XB_TMO      128
#define XB_XCNT(j)  (256  + 64 * (j))
#define XB_XSUB(j)  (1280 + 64 * (j))
#define XB_XGEN(j)  (2304 + 64 * (j))
#define XB_TOP      3328
#define XB_TOPGEN   3392
#define XCD_BAR_WORDS 3456
#define XB_SPIN_CAP (1u << 18)

__device__ __forceinline__ unsigned xb_ld(unsigned* p)              { return __hip_atomic_load(p, __ATOMIC_RELAXED, __HIP_MEMORY_SCOPE_AGENT); }
__device__ __forceinline__ unsigned xb_add(unsigned* p, unsigned v) { return __hip_atomic_fetch_add(p, v, __ATOMIC_RELAXED, __HIP_MEMORY_SCOPE_AGENT); }
__device__ __forceinline__ unsigned xb_xcc_id() { return (unsigned)__builtin_amdgcn_s_getreg((3 << 11) | 20) & 0xFu; }
#define XB_SPIN(cond, bar) do { unsigned _sp = 0; while (cond) { __builtin_amdgcn_s_sleep(1); \
    if ((++_sp & 255u) == 0u) { if (xb_ld(&(bar)[XB_TMO])) break; if (_sp > XB_SPIN_CAP) { atomicAdd(&(bar)[XB_TMO], 1u); break; } } } } while (0)

struct XcdBarrier {
    unsigned* bar; unsigned x;
    volatile LAS unsigned* st;
};

__device__ __forceinline__ XcdBarrier xcd_barrier_post(unsigned* bar, volatile LAS unsigned* st) {
    XcdBarrier b; b.bar = bar; b.x = xb_xcc_id(); b.st = st;
    if (threadIdx.x == 0) (void)xb_add(&bar[XB_XCNT(b.x)], 1u);
    return b;
}
__device__ __forceinline__ void xcd_barrier_complete(unsigned* bar, unsigned x, unsigned& nloc, unsigned& nx) {
    const unsigned G = gridDim.x * gridDim.y * gridDim.z;
    unsigned sum, cnt, mine, sp = 0u;
    for (;;) {
        sum = 0u; cnt = 0u; mine = 0u;
#pragma unroll
        for (unsigned j = 0; j < 16; ++j) { const unsigned c = xb_ld(&bar[XB_XCNT(j)]); sum += c; cnt += (c > 0u) ? 1u : 0u; mine = (j == x) ? c : mine; }
        if (sum == G) break;
        __builtin_amdgcn_s_sleep(1);
        if ((++sp & 255u) == 0u) { if (xb_ld(&bar[XB_TMO])) break; if (sp > XB_SPIN_CAP) { atomicAdd(&bar[XB_TMO], 1u); break; } }
    }
    nloc = mine > 0u ? mine : 1u; nx = cnt > 0u ? cnt : 1u;
}

__device__ __forceinline__ void xcd_barrier(const XcdBarrier& b) {
    asm volatile("s_waitcnt vmcnt(0)" ::: "memory");
    __syncthreads();
    if (threadIdx.x == 0) {
        unsigned* bar = b.bar; asm volatile("" : "+s"(bar));
        const unsigned bx_ = xb_xcc_id();
        __builtin_amdgcn_s_waitcnt(0);
        unsigned nloc = b.st[0], nx = b.st[1];
        if (nloc == 0u) { xcd_barrier_complete(bar, bx_, nloc, nx); b.st[0] = nloc; b.st[1] = nx; }
        const unsigned old = xb_add(&bar[XB_XSUB(bx_)], 1u);
        const unsigned gen = old / nloc;
        if (old + 1u == (gen + 1u) * nloc) {
            __builtin_amdgcn_fence(__ATOMIC_RELEASE, "agent");
            asm volatile("s_waitcnt vmcnt(0)" ::: "memory");
            const unsigned og = xb_add(&bar[XB_TOP], 1u);
            const unsigned tg = og / nx;
            if (og + 1u == (tg + 1u) * nx) xb_add(&bar[XB_TOPGEN], 1u);
            else XB_SPIN(xb_ld(&bar[XB_TOPGEN]) == tg, bar);
            __builtin_amdgcn_fence(__ATOMIC_ACQUIRE, "agent");
            xb_add(&bar[XB_XGEN(bx_)], 1u);
            asm volatile("s_waitcnt vmcnt(0)" ::: "memory");
        } else {
            XB_SPIN(xb_ld(&bar[XB_XGEN(bx_)]) == gen, bar);
            __builtin_amdgcn_fence(__ATOMIC_ACQUIRE, "agent");
            asm volatile("s_waitcnt vmcnt(0)" ::: "memory");
        }
    }
    __syncthreads();
}
#define LDS_WAIT() asm volatile("s_waitcnt lgkmcnt(0)" ::: "memory")
__device__ __forceinline__ void unpack8(const v4u w, float* f) { f[0] = bflo(w.x); f[1] = bfhi(w.x); f[2] = bflo(w.y); f[3] = bfhi(w.y); f[4] = bflo(w.z); f[5] = bfhi(w.z); f[6] = bflo(w.w); f[7] = bfhi(w.w); }

__device__ __forceinline__ int win_src(int cp) {
    const int p = cp & 255; const int c = (cp & ~255) + 64 * ((p & 127) >> 5) + 32 * (p >> 7) + (p & 31);
    if (c < 1152) return c;
    if (c < 2304) return c + 1038;
    if (c < 3072) return c - 1146;
    if (c < 3328) return c - 1138;
    if (c < 3334) return c - 3328 + 1152;
    if (c < 3338) return c - 3334 + 1926;
    if (c < 3342) return c - 3338 + 1930;
    return -1;
}
__device__ __forceinline__ int wgu_src(int r) { const int pn = r >> 8, w = r & 255; return (w < 128 ? 0 : DFF) + pn * 128 + (w & 127); }
template <int MODE> __device__ __forceinline__ int src_col(int r) { if (MODE == 1) return win_src(r); if (MODE == 2) return wgu_src(r); return r; }

template <int MODE> __device__ __forceinline__ void transpose_item(const float* W, int K, int ldw, bf16* WT, LAS float* scr, int nblk, int item, int lane) {
    const int kb = item / nblk, nb = item % nblk, k0 = 64 * kb, n0 = 32 * nb;
    const int sc = src_col<MODE>(n0 + (lane & 31));
    float tv[32];
#pragma unroll
    for (int i = 0; i < 32; ++i) { const int kk = 2 * i + (lane >> 5); tv[i] = (sc >= 0) ? W[(size_t)(k0 + kk) * ldw + sc] : 0.f; }
#pragma unroll
    for (int i = 0; i < 32; ++i) { const int kk = 2 * i + (lane >> 5); scr[kk * 33 + (lane & 31)] = tv[i]; }
    LDS_WAIT(); asm volatile("" ::: "memory");
    const int c = lane & 7;
#pragma unroll
    for (int j = 0; j < 4; ++j) { const int n = (lane >> 3) + 8 * j; const LAS float* s = scr + (8 * c) * 33 + n;
        v4u o; o.x = pk2(s[0 * 33], s[1 * 33]); o.y = pk2(s[2 * 33], s[3 * 33]); o.z = pk2(s[4 * 33], s[5 * 33]); o.w = pk2(s[6 * 33], s[7 * 33]);
        *(GAS v4u*)(WT + (size_t)(n0 + n) * K + k0 + 8 * c) = o; }
    LDS_WAIT(); asm volatile("" ::: "memory");
}

__device__ __forceinline__ void p0_mod_unit(int u, const float* cvec, const float* w_ada, const float* b_ada, float* mod, LAS float* lds, int tid, int wave, int lane) {
    LAS float* sc = lds; LAS float* red = lds + 2048;
    for (int i = tid; i < 2048; i += NTHREADS) { const float v = cvec[i]; sc[i] = v / (1.f + expf(-v)); }
    __syncthreads();
    const int l = u / 96, n = (u % 96) * 64 + lane;
    const float* wp = w_ada + ((size_t)l * 1024 + wave * 128) * 6144 + n;
    float a0 = 0.f, a1 = 0.f;
#pragma unroll 1
    for (int kb = 0; kb < 128; kb += 64) { float wv[64];
#pragma unroll
        for (int kk = 0; kk < 64; ++kk) wv[kk] = wp[(size_t)(kb + kk) * 6144];
#pragma unroll
        for (int kk = 0; kk < 64; ++kk) { a0 += sc[wave * 128 + kb + kk] * wv[kk]; a1 += sc[1024 + wave * 128 + kb + kk] * wv[kk]; } }
    red[(wave * 2 + 0) * 64 + lane] = a0; red[(wave * 2 + 1) * 64 + lane] = a1;
    __syncthreads();
    if (tid < 128) { const int b = tid >> 6; float s = 0.f;
#pragma unroll
        for (int w = 0; w < 8; ++w) s += red[(w * 2 + b) * 64 + lane];
        mod[((size_t)l * 2 + b) * 6144 + n] = s + b_ada[l * 6144 + n]; }
    __syncthreads();
}

__device__ __forceinline__ void pre_rows(const float* xsrc, const float* g, const float* mod_b0, bf16* XA, float* SSP, int gw, int NGW, int lane) {
    f32x4 av[2][4];
#pragma unroll
    for (int b = 0; b < 2; ++b)
#pragma unroll
        for (int j = 0; j < 4; ++j) { const int col = 4 * lane + 256 * j; av[b][j] = *(const f32x4*)(g + col) * (*(const f32x4*)(mod_b0 + (size_t)b * 6144 + 1024 + col) + 1.0f); }
    for (int m0 = gw; m0 < MROWS; m0 += 4 * NGW) {
        f32x4 v[4][4];
#pragma unroll
        for (int q = 0; q < 4; ++q) { const int m = m0 + q * NGW; const GAS f32x4* xr = (const GAS f32x4*)(xsrc + (size_t)m * DM) + lane;
#pragma unroll
            for (int j = 0; j < 4; ++j) v[q][j] = xr[64 * j]; }
#pragma unroll
        for (int q = 0; q < 4; ++q) { const int m = m0 + q * NGW; const int b = m / SEQ;
            float ss = 0.f;
#pragma unroll
            for (int j = 0; j < 4; ++j) ss += (v[q][j].x * v[q][j].x + v[q][j].y * v[q][j].y) + (v[q][j].z * v[q][j].z + v[q][j].w * v[q][j].w);
            const float tot = wave_sum(ss);
            if (lane < 16) SSP[(size_t)m * 16 + lane] = lane == 0 ? tot : 0.f;
            GAS v2u* o8 = (GAS v2u*)(XA + (size_t)m * DM) + lane;
#pragma unroll
            for (int j = 0; j < 4; ++j) { const f32x4 o = v[q][j] * (b ? av[1][j] : av[0][j]);
                v2u w; w.x = pk2(o.x, o.y); w.y = pk2(o.z, o.w); o8[64 * j] = w; } }
    }
}
__device__ __forceinline__ void pre_avec(const float* n1g, const float* n2g, const float* MODp, float* AVEC, int gtid, int ngt) {
    for (int i = gtid; i < DEPTH * 2 * 2 * 1024; i += ngt) { const int col = i & 1023, b = (i >> 10) & 1, w = (i >> 11) & 1, l = i >> 12;
        const float g = (w ? n2g : n1g)[l * 1024 + col], sc = MODp[((size_t)l * 2 + b) * 6144 + (w ? 4096 : 1024) + col];
        AVEC[i] = g * (1.f + sc); }
}
__device__ __forceinline__ void pre_bias(const bf16* WT, int nrows, const float* sh0, const float* sh1, float* bias0, float* bias1, int gw, int NGW, int lane) {
    v4u wr[3][2];
#pragma unroll
    for (int q = 0; q < 3; ++q) { const int n = gw + q * NGW;
        if (n < nrows) { wr[q][0] = *(const v4u*)(WT + (size_t)n * 1024 + lane * 16); wr[q][1] = *(const v4u*)(WT + (size_t)n * 1024 + lane * 16 + 8); } }
    f32x4 s0[4], s1[4];
#pragma unroll
    for (int q4 = 0; q4 < 4; ++q4) { s0[q4] = *(const f32x4*)(sh0 + lane * 16 + 4 * q4); s1[q4] = *(const f32x4*)(sh1 + lane * 16 + 4 * q4); }
#pragma unroll
    for (int q = 0; q < 3; ++q) { const int n = gw + q * NGW;
        if (n < nrows) {
            float w[16]; unpack8(wr[q][0], w); unpack8(wr[q][1], w + 8);
            float a0 = 0.f, a1 = 0.f;
#pragma unroll
            for (int q4 = 0; q4 < 4; ++q4) {
                a0 += (w[4 * q4] * s0[q4].x + w[4 * q4 + 1] * s0[q4].y) + (w[4 * q4 + 2] * s0[q4].z + w[4 * q4 + 3] * s0[q4].w);
                a1 += (w[4 * q4] * s1[q4].x + w[4 * q4 + 1] * s1[q4].y) + (w[4 * q4 + 2] * s1[q4].z + w[4 * q4 + 3] * s1[q4].w); }
            a0 = wave_sum(a0); a1 = wave_sum(a1);
            if (lane == 0) { bias0[n] = a0; bias1[n] = a1; } } }
}
template <class Sched> __device__ __forceinline__ int rstd_tables(const Sched& S, const float* SSP, LAS float* rt, const float* bias, int bstride, LAS float* bt, int tid,
                                                                  const float* g0 = nullptr, const float* g1 = nullptr, const float* g2 = nullptr, const float* g3 = nullptr, LAS float* gt = nullptr) {
    float gval = 0.f;
    if (gt && tid < 256) { const float* gp = (tid < 64) ? g0 : (tid < 128) ? g1 : (tid < 192) ? g2 : g3; gval = gp[tid & 63]; }
    pg8::Unit u; int pm0 = -1, pm1 = -1, nu = 0;
    f32x4 bq[11];
#pragma unroll
    for (int i = 0; i < 11; ++i) { bq[i] = (f32x4){0.f, 0.f, 0.f, 0.f};
        if (S.next(i, u)) { nu = i + 1; if (pm0 < 0) pm0 = u.pm; else if (u.pm != pm0 && pm1 < 0) pm1 = u.pm;
            if (tid < 64) bq[i] = *(const f32x4*)(bias + (size_t)((u.pm * 256) / SEQ) * bstride + u.pn * 256 + tid * 4); } }
    f32x4 sq[2][4];
#pragma unroll
    for (int slot = 0; slot < 2; ++slot) { const int pm = slot ? pm1 : pm0;
#pragma unroll
        for (int q = 0; q < 4; ++q) sq[slot][q] = (f32x4){0.f, 0.f, 0.f, 0.f};
        if (tid < 256 && pm >= 0) { const float* sp = SSP + ((size_t)pm * 256 + tid) * 16;
#pragma unroll
            for (int q = 0; q < 4; ++q) sq[slot][q] = *(const f32x4*)(sp + 4 * q); } }
    __builtin_amdgcn_sched_barrier(0);
    if (gt && tid < 256) gt[tid] = gval;
    if (tid < 64) {
#pragma unroll
        for (int i = 0; i < 11; ++i) if (i < nu) *(LAS f32x4*)(bt + i * 256 + tid * 4) = bq[i]; }
    if (tid < 256) {
#pragma unroll
        for (int slot = 0; slot < 2; ++slot) { const int pm = slot ? pm1 : pm0;
            if (pm >= 0) { const f32x4 a = sq[slot][0], b = sq[slot][1], c = sq[slot][2], d = sq[slot][3];
                const float s2 = (((a.x + a.y) + (a.z + a.w)) + ((b.x + b.y) + (b.z + b.w))) + (((c.x + c.y) + (c.z + c.w)) + ((d.x + d.y) + (d.z + d.w)));
                rt[slot * 256 + tid] = 1.f / sqrtf(s2 * (1.f / DM) + EPS); } }
    }
    __syncthreads();
    return pm0;
}

__device__ __forceinline__ void post_foxcum_unit(int bh, const float* GATESp, float* FOXCUMp, const float* fox_f_bias, LAS float* lds, int tid, int wave, int lane) {
    const int b = bh / 6, h = bh % 6; const float bias = fox_f_bias[h];
    float v[32];
#pragma unroll
    for (int r = 0; r < 32; ++r) { const int t = wave * 2048 + r * 64 + lane; v[r] = GATESp[((size_t)b * SEQ + t) * 16 + h]; }
    __builtin_amdgcn_sched_barrier(0);
#pragma unroll
    for (int r = 0; r < 32; ++r) { const float x2 = (v[r] + bias) * LOG2E;
        v[r] = fminf(x2, 0.f) - __builtin_amdgcn_logf(1.f + __builtin_amdgcn_exp2f(-fabsf(x2))); }
#pragma unroll
    for (int o = 1; o < 64; o <<= 1) { float tt[32];
#pragma unroll
        for (int r = 0; r < 32; ++r) tt[r] = sup(v[r], o, lane);
#pragma unroll
        for (int r = 0; r < 32; ++r) if (lane >= o) v[r] += tt[r]; }
    float tot[32];
#pragma unroll
    for (int r = 0; r < 32; ++r) tot[r] = shf(v[r], 63);
    float carry = 0.f;
#pragma unroll
    for (int r = 0; r < 32; ++r) { v[r] += carry; carry += tot[r]; }
    if (lane == 0) lds[wave] = carry;
    __syncthreads();
    float off = 0.f;
    for (int w = 0; w < wave; ++w) off += lds[w];
#pragma unroll
    for (int r = 0; r < 32; ++r) FOXCUMp[(size_t)bh * SEQ + wave * 2048 + r * 64 + lane] = v[r] + off;
    __syncthreads();
}
__device__ __forceinline__ void post_qknorm_unit(int u, bf16* PROJp, float* KMEANP, const float* gfq, const float* gfk, const float* gbq, const float* gbk, LAS float* lds, int tid, int wave, int lane) {
    const int blk = u >> 1, half = u & 1, sub = lane & 7;
    int colv[3]; float gv[3][8]; float qsv[3];
#pragma unroll
    for (int it = 0; it < 3; ++it) { const int hsel = it * 8 + (lane >> 3), grp = hsel / 6, hh = hsel % 6;
        colv[it] = (grp == 0 ? C_FQ : grp == 1 ? C_FK : grp == 2 ? C_BQ : C_BK) + hh * 64 + 8 * sub;
        const float* gp = (grp == 0 ? gfq : grp == 1 ? gfk : grp == 2 ? gbq : gbk) + 8 * sub;
#pragma unroll
        for (int i = 0; i < 8; ++i) gv[it][i] = gp[i];
        qsv[it] = (grp == 0 || grp == 2) ? QSCALE : 1.f; }
    float ka[8] = {0.f, 0.f, 0.f, 0.f, 0.f, 0.f, 0.f, 0.f};
    const size_t row0 = (size_t)blk * 256 + half * 128 + wave * 16;
#pragma unroll 4
    for (int r = 0; r < 16; ++r) {
#pragma unroll
        for (int it = 0; it < 3; ++it) {
            v4u* p = (v4u*)(PROJp + (row0 + r) * PLD + colv[it]);
            float f[8]; unpack8(*p, f);
            float ss = 0.f;
#pragma unroll
            for (int i = 0; i < 8; ++i) ss += f[i] * f[i];
            ss += SWZ_X(ss, 1); ss += SWZ_X(ss, 2); ss += SWZ_X(ss, 4);
            const float rr = __builtin_amdgcn_rsqf(ss * (1.f / 64.f) + EPS);
#pragma unroll
            for (int i = 0; i < 8; ++i) f[i] = f[i] * rr * gv[it][i];
            if (it == 2) {
#pragma unroll
                for (int i = 0; i < 8; ++i) ka[i] += f[i]; }
            const float qs = qsv[it];
            v4u w; w.x = pk2(f[0] * qs, f[1] * qs); w.y = pk2(f[2] * qs, f[3] * qs); w.z = pk2(f[4] * qs, f[5] * qs); w.w = pk2(f[6] * qs, f[7] * qs);
            *p = w;
        }
    }
    if (lane >= 16) {
#pragma unroll
        for (int i = 0; i < 8; ++i) lds[wave * 384 + ((lane >> 3) - 2) * 64 + 8 * sub + i] = ka[i]; }
    __syncthreads();
    if (tid < 384) { float s = 0.f;
#pragma unroll
        for (int w = 0; w < 8; ++w) s += lds[w * 384 + tid];
        const int b = blk / NBLK, n = blk % NBLK, head = tid >> 6, dd = tid & 63;
        KMEANP[(size_t)half * (12 * NBLK * 64) + (((size_t)b * 6 + head) * NBLK + n) * 64 + dd] = s * (1.f / 256.f); }
    __syncthreads();
}
__device__ __forceinline__ void post_conv_unit(int blk, int which, const bf16* PROJp, bf16* dst, const float* conv_w, const float* conv_b, int tid) {
    const bf16* src = PROJp + (which ? C_MK : C_MQ); const float osc = which ? 0.125f : 1.f;
    const int c = 8 * (tid & 31), rs = tid >> 5, ch = which * 256 + c;
    const size_t r0 = (size_t)blk * 256 + rs * 16; const int tl = (int)(r0 % SEQ);
    float w[4][8], bb[8];
#pragma unroll
    for (int i = 0; i < 4; ++i) { const f32x4 a = *(const f32x4*)(conv_w + i * 512 + ch), b2 = *(const f32x4*)(conv_w + i * 512 + ch + 4);
        w[i][0] = a.x; w[i][1] = a.y; w[i][2] = a.z; w[i][3] = a.w; w[i][4] = b2.x; w[i][5] = b2.y; w[i][6] = b2.z; w[i][7] = b2.w; }
    { const f32x4 a = *(const f32x4*)(conv_b + ch), b2 = *(const f32x4*)(conv_b + ch + 4); bb[0] = a.x; bb[1] = a.y; bb[2] = a.z; bb[3] = a.w; bb[4] = b2.x; bb[5] = b2.y; bb[6] = b2.z; bb[7] = b2.w; }
    float x0[8], x1[8], x2[8], x3[8];
    { v4u h3[3];
#pragma unroll
      for (int k = 0; k < 3; ++k) { if (tl + k - 3 >= 0) h3[k] = *(const v4u*)(src + (r0 + k - 3) * PLD + c); else h3[k] = (v4u){0u, 0u, 0u, 0u}; }
      unpack8(h3[0], x0); unpack8(h3[1], x1); unpack8(h3[2], x2); }
#pragma unroll 1
    for (int hb = 0; hb < 2; ++hb) {
        v4u in[8];
#pragma unroll
        for (int k = 0; k < 8; ++k) in[k] = *(const v4u*)(src + (r0 + hb * 8 + k) * PLD + c);
#pragma unroll
        for (int r = 0; r < 8; ++r) {
            unpack8(in[r], x3);
            float y[8];
#pragma unroll
            for (int i = 0; i < 8; ++i) { const float t = bb[i] + w[0][i] * x0[i] + w[1][i] * x1[i] + w[2][i] * x2[i] + w[3][i] * x3[i];
                y[i] = t * __builtin_amdgcn_rcpf(1.f + __builtin_amdgcn_exp2f(-t * LOG2E)) * osc; x0[i] = x1[i]; x1[i] = x2[i]; x2[i] = x3[i]; }
            v4u o; o.x = pk2(y[0], y[1]); o.y = pk2(y[2], y[3]); o.z = pk2(y[4], y[5]); o.w = pk2(y[6], y[7]);
            *(v4u*)(dst + (r0 + hb * 8 + r) * 256 + c) = o;
        }
    }
}

struct MlP { const bf16* PROJ; const bf16* QC; const bf16* KC; const float* GATES; float* U; float* NU; float* BEND; float* MLOC; bf16* CS; float* NS; float* MS; bf16* Y;
             const float *ibias, *fbias, *hg; };
__device__ __forceinline__ void mlstm_m1(int ci, const MlP& P, LAS float* lds, int tid, int wave, int lane) {
    const int b = ci >> 10, h = (ci >> 8) & 3, c = ci & 255; const size_t row0 = (size_t)b * SEQ + c * 64;
    LAS float* Ks = lds; LAS float* Vs = lds + 4096; LAS float* ws = lds + 8192;
    { const int r = tid >> 3, cg = (tid & 7) * 8; float f[8];
      unpack8(*(const v4u*)(P.KC + (row0 + r) * 256 + h * 64 + cg), f);
#pragma unroll
      for (int i = 0; i < 8; ++i) Ks[r * 64 + cg + i] = f[i];
      unpack8(*(const v4u*)(P.PROJ + (row0 + r) * PLD + C_MV + h * 64 + cg), f);
#pragma unroll
      for (int i = 0; i < 8; ++i) Vs[r * 64 + cg + i] = f[i]; }
    if (wave == 0) {
        const size_t row = row0 + lane;
        const float fi = P.GATES[row * 16 + 6 + h] + P.ibias[h], ff = P.GATES[row * 16 + 10 + h] + P.fbias[h];
        float bc = log_sigmoid_f(ff);
#pragma unroll
        for (int o = 1; o < 64; o <<= 1) { const float n = sup(bc, o, lane); if (lane >= o) bc += n; }
        const float bend = shf(bc, 63);
        const float wl = bend - bc + fi; const float mloc = wave_max(wl);
        ws[lane] = expf(wl - mloc);
        if (lane == 0) { P.BEND[ci] = bend; P.MLOC[ci] = mloc; }
    }
    __syncthreads();
    { const int dv = tid >> 3, e0 = (tid & 7) * 8; float u[8] = {0.f, 0.f, 0.f, 0.f, 0.f, 0.f, 0.f, 0.f};
#pragma unroll 2
      for (int s = 0; s < 64; ++s) { const float vw = Vs[s * 64 + dv] * ws[s]; const f32x4 ka = *(const LAS f32x4*)(Ks + s * 64 + e0), kb = *(const LAS f32x4*)(Ks + s * 64 + e0 + 4);
          u[0] += vw * ka.x; u[1] += vw * ka.y; u[2] += vw * ka.z; u[3] += vw * ka.w; u[4] += vw * kb.x; u[5] += vw * kb.y; u[6] += vw * kb.z; u[7] += vw * kb.w; }
      float* up = P.U + (size_t)ci * 4096 + dv * 64 + e0;
      *(f32x4*)up = (f32x4){u[0], u[1], u[2], u[3]}; *(f32x4*)(up + 4) = (f32x4){u[4], u[5], u[6], u[7]}; }
    if (tid < 64) { float nu = 0.f; for (int s = 0; s < 64; ++s) nu += ws[s] * Ks[s * 64 + tid]; P.NU[(size_t)ci * 64 + tid] = nu; }
    __syncthreads();
}
__device__ __forceinline__ void mlstm_m2(int u, const MlP& P, LAS float* lds, int tid, int wave, int lane) {
    const int bh = u >> 3, eg = u & 7, elem = eg * 512 + tid, base = bh * 256;
    LAS float* decl = lds; LAS float* wul = lds + 256;
    if (wave == 0) {
        const f32x4 b4 = *(const f32x4*)(P.BEND + base + 4 * lane), l4 = *(const f32x4*)(P.MLOC + base + 4 * lane);
        float B = b4.x, L = l4.x;
        B += b4.y; L = fmaxf(L + b4.y, l4.y); B += b4.z; L = fmaxf(L + b4.z, l4.z); B += b4.w; L = fmaxf(L + b4.w, l4.w);
#pragma unroll
        for (int o = 1; o < 64; o <<= 1) { const float Bp = sup(B, o, lane), Lp = sup(L, o, lane); if (lane >= o) { L = fmaxf(Lp + B, L); B = Bp + B; } }
        const float Bex = sup(B, 1, lane), Lex = sup(L, 1, lane);
        float m = (lane == 0) ? 0.f : fmaxf(Bex, Lex);
        const float bb[4] = {b4.x, b4.y, b4.z, b4.w}, ll[4] = {l4.x, l4.y, l4.z, l4.w};
#pragma unroll
        for (int j = 0; j < 4; ++j) { const int c = 4 * lane + j; if (eg == 0) P.MS[base + c] = m;
            const float mn = fmaxf(bb[j] + m, ll[j]);
            decl[c] = __builtin_amdgcn_exp2f((bb[j] + m - mn) * LOG2E); wul[c] = __builtin_amdgcn_exp2f((ll[j] - mn) * LOG2E); m = mn; }
    }
    __syncthreads();
    const bool donorm = (eg == 0 && tid < 64);
    float C = 0.f, nst = 0.f;
#pragma unroll 1
    for (int c0 = 0; c0 < 256; c0 += 16) {
        float uv[16], nv[16];
#pragma unroll
        for (int i = 0; i < 16; ++i) { const int ci = base + c0 + i; uv[i] = bf2f(((const bf16*)P.U)[(size_t)ci * 4096 + elem]); nv[i] = donorm ? P.NU[(size_t)ci * 64 + tid] : 0.f; }
#pragma unroll
        for (int i = 0; i < 16; ++i) { const int ci = base + c0 + i;
            P.CS[(size_t)ci * 4096 + elem] = (bf16)f2bf(C);
            if (donorm) P.NS[(size_t)ci * 64 + tid] = nst;
            const float dec = decl[c0 + i], wu = wul[c0 + i];
            C = dec * C + wu * uv[i]; nst = dec * nst + wu * nv[i]; }
    }
    __syncthreads();
}
__device__ __forceinline__ void mlstm_m3(int ci, const MlP& P, LAS float* lds, int tid, int wave, int lane) {
    constexpr int LP = 68;
    const int b = ci >> 10, h = (ci >> 8) & 3, c = ci & 255; const size_t row0 = (size_t)b * SEQ + c * 64;
    LAS float* Qs = lds; LAS float* Ks = Qs + 64 * LP; LAS float* Cs = Ks + 64 * LP; LAS float* Sm = Cs + 64 * LP; LAS float* Vs = Sm + 64 * LP;
    LAS float* av = Vs + 4096; LAS float* gv = av + 64; LAS float* bcv = gv + 64; LAS float* nsv = bcv + 64;
    const float ms = P.MS[ci];
    { const int r = tid >> 3, cg = (tid & 7) * 8; float f[8];
      unpack8(*(const v4u*)(P.QC + (row0 + r) * 256 + h * 64 + cg), f);
#pragma unroll
      for (int i = 0; i < 8; ++i) Qs[r * LP + cg + i] = f[i];
      unpack8(*(const v4u*)(P.KC + (row0 + r) * 256 + h * 64 + cg), f);
#pragma unroll
      for (int i = 0; i < 8; ++i) Ks[r * LP + cg + i] = f[i];
      unpack8(*(const v4u*)(P.PROJ + (row0 + r) * PLD + C_MV + h * 64 + cg), f);
#pragma unroll
      for (int i = 0; i < 8; ++i) Vs[r * 64 + cg + i] = f[i];
      unpack8(*(const v4u*)(P.CS + (size_t)ci * 4096 + r * 64 + cg), f);
#pragma unroll
      for (int i = 0; i < 8; ++i) Cs[r * LP + cg + i] = f[i]; }
    if (wave == 0) {
        const size_t row = row0 + lane;
        const float fi = P.GATES[row * 16 + 6 + h] + P.ibias[h], ff = P.GATES[row * 16 + 10 + h] + P.fbias[h];
        float bc = log_sigmoid_f(ff);
#pragma unroll
        for (int o = 1; o < 64; o <<= 1) { const float n = sup(bc, o, lane); if (lane >= o) bc += n; }
        const float a = fi - bc; float pm = a;
#pragma unroll
        for (int o = 1; o < 64; o <<= 1) { const float n = sup(pm, o, lane); if (lane >= o) pm = fmaxf(pm, n); }
        av[lane] = a; gv[lane] = fmaxf(ms, pm); bcv[lane] = bc; nsv[lane] = P.NS[(size_t)ci * 64 + lane];
    }
    __syncthreads();
    const int j = tid >> 3, part = tid & 7, s0 = part * 8;
    const float gj = gv[j];
    { float sacc[8] = {0.f, 0.f, 0.f, 0.f, 0.f, 0.f, 0.f, 0.f};
#pragma unroll 1
      for (int e = 0; e < 64; e += 4) { const f32x4 q4 = *(const LAS f32x4*)(Qs + j * LP + e);
#pragma unroll
          for (int i = 0; i < 8; ++i) { const f32x4 k4 = *(const LAS f32x4*)(Ks + (s0 + i) * LP + e); sacc[i] += (q4.x * k4.x + q4.y * k4.y) + (q4.z * k4.z + q4.w * k4.w); } }
#pragma unroll
      for (int i = 0; i < 8; ++i) { const int s = s0 + i; Sm[j * LP + s] = (s <= j) ? sacc[i] * expf(av[s] - gj) : 0.f; } }
    __syncthreads();
    { const int dv0 = part * 8; float t1[8] = {0.f, 0.f, 0.f, 0.f, 0.f, 0.f, 0.f, 0.f}, t2[8] = {0.f, 0.f, 0.f, 0.f, 0.f, 0.f, 0.f, 0.f};
#pragma unroll 1
      for (int e = 0; e < 64; e += 4) { const f32x4 q4 = *(const LAS f32x4*)(Qs + j * LP + e);
#pragma unroll
          for (int i = 0; i < 8; ++i) { const f32x4 c4 = *(const LAS f32x4*)(Cs + (dv0 + i) * LP + e); t1[i] += (q4.x * c4.x + q4.y * c4.y) + (q4.z * c4.z + q4.w * c4.w); } }
#pragma unroll 2
      for (int s = 0; s < 64; ++s) { const float sm = Sm[j * LP + s]; const f32x4 va = *(const LAS f32x4*)(Vs + s * 64 + dv0), vb = *(const LAS f32x4*)(Vs + s * 64 + dv0 + 4);
          t2[0] += sm * va.x; t2[1] += sm * va.y; t2[2] += sm * va.z; t2[3] += sm * va.w; t2[4] += sm * vb.x; t2[5] += sm * vb.y; t2[6] += sm * vb.z; t2[7] += sm * vb.w; }
      float dn = 0.f, ssum = 0.f;
#pragma unroll
      for (int i = 0; i < 8; ++i) { dn += nsv[s0 + i] * Qs[j * LP + s0 + i]; ssum += Sm[j * LP + s0 + i]; }
      { dn += SWZ_X(dn, 1); ssum += SWZ_X(ssum, 1); dn += SWZ_X(dn, 2); ssum += SWZ_X(ssum, 2); dn += SWZ_X(dn, 4); ssum += SWZ_X(ssum, 4); }
      const float inter = expf(ms - gj), mj = bcv[j] + gj;
      const float den = inter * dn + ssum, dd = fmaxf(fabsf(den), expf(-mj)), rd = 1.f / dd;
      float hv[8], ss = 0.f;
#pragma unroll
      for (int i = 0; i < 8; ++i) { hv[i] = (inter * t1[i] + t2[i]) * rd; ss += hv[i] * hv[i]; }
      { ss += SWZ_X(ss, 1); ss += SWZ_X(ss, 2); ss += SWZ_X(ss, 4); }
      const float rr = 1.f / sqrtf(ss * (1.f / 64.f) + EPS);
      float mo[8]; unpack8(*(const v4u*)(P.PROJ + (row0 + j) * PLD + C_MO + h * 64 + dv0), mo);
      float y[8];
#pragma unroll
      for (int i = 0; i < 8; ++i) y[i] = hv[i] * rr * P.hg[h * 64 + dv0 + i] * sigmoid_f(mo[i]);
      v4u w; w.x = pk2(y[0], y[1]); w.y = pk2(y[2], y[3]); w.z = pk2(y[4], y[5]); w.w = pk2(y[6], y[7]);
      *(v4u*)(P.Y + (row0 + j) * 1024 + Y_ML + h * 64 + dv0) = w; }
    __syncthreads();
}

__device__ __forceinline__ size_t moba_list_off(int bh, int n);
__device__ __forceinline__ void moba_gate_unit(int u, const bf16* PROJ, const float* KMEAN, unsigned* SEL, unsigned* LCNT, unsigned* CTAB, unsigned short* LIST, float B2, float thresh2, LAS float* lds, int tid) {
    const int bh = u >> 6, qb = 63 - (u & 63), b = bh / 6, h = bh % 6;
    LAS float* km = lds; LAS float* cand = lds + 4096; LAS unsigned* cntl = (LAS unsigned*)(lds + 4096 + 1536);
    if (tid < 64) cntl[tid] = 0u;
    for (int i = tid; i < qb * 16; i += NTHREADS) *(LAS f32x4*)(km + i * 4) = *(const f32x4*)(KMEAN + (size_t)bh * NBLK * 64 + i * 4) + *(const f32x4*)(KMEAN + (size_t)(12 * NBLK * 64) + (size_t)bh * NBLK * 64 + i * 4);
    __syncthreads();
    const int query = tid & 255, half = tid >> 8; const size_t row = (size_t)b * SEQ + qb * 256 + query;
    float q[64];
#pragma unroll
    for (int i = 0; i < 8; ++i) unpack8(*(const v4u*)(PROJ + row * PLD + C_BQ + h * 64 + i * 8), q + i * 8);
    float v0 = -INFINITY, v1 = -INFINITY, v2 = -INFINITY; int i0 = 255, i1 = 255, i2 = 255;
    const int nlo = half * 32, nhi = (qb < nlo + 32) ? qb : nlo + 32;
    for (int n = nlo; n < nhi; ++n) { float g = 0.f;
#pragma unroll
        for (int d = 0; d < 64; d += 4) { const f32x4 k4 = *(const LAS f32x4*)(km + n * 64 + d); g += (q[d] * k4.x + q[d + 1] * k4.y) + (q[d + 2] * k4.z + q[d + 3] * k4.w); }
        if (g > v0) { v2 = v1; i2 = i1; v1 = v0; i1 = i0; v0 = g; i0 = n; } else if (g > v1) { v2 = v1; i2 = i1; v1 = g; i1 = n; } else if (g > v2) { v2 = g; i2 = n; } }
    if (half == 1) { cand[query * 6 + 0] = v0; cand[query * 6 + 1] = v1; cand[query * 6 + 2] = v2;
        cand[query * 6 + 3] = __int_as_float(i0); cand[query * 6 + 4] = __int_as_float(i1); cand[query * 6 + 5] = __int_as_float(i2); }
    __syncthreads();
    if (half == 0) {
#pragma unroll
        for (int k = 0; k < 3; ++k) { const float g = cand[query * 6 + k]; const int n = __float_as_int(cand[query * 6 + 3 + k]);
            if (n != 255) { if (g > v0) { v2 = v1; i2 = i1; v1 = v0; i1 = i0; v0 = g; i0 = n; } else if (g > v1) { v2 = v1; i2 = i1; v1 = g; i1 = n; } else if (g > v2) { v2 = g; i2 = n; } } }
        { const float slope2 = exp2f(-8.f * (float)(h + 1) / 6.f) * LOG2E; const float lim = (2.f * B2 + thresh2) / slope2; const int t0 = qb * 256 + query - 255;
          if (i0 != 255 && (float)(t0 - i0 * 256) > lim) i0 = 255;
          if (i1 != 255 && (float)(t0 - i1 * 256) > lim) i1 = 255;
          if (i2 != 255 && (float)(t0 - i2 * 256) > lim) i2 = 255; }
        SEL[row * 6 + h] = (unsigned)i0 | ((unsigned)i1 << 8) | ((unsigned)i2 << 16);
        if (LIST) { const unsigned t = (unsigned)(qb * 256 + query);
            if (i0 != 255) { const unsigned pos = __hip_atomic_fetch_add(cntl + i0, 1u, __ATOMIC_RELAXED, __HIP_MEMORY_SCOPE_WORKGROUP); LIST[moba_list_off(bh, i0) + (size_t)(qb - i0 - 1) * 256 + pos] = (unsigned short)(t | (0u << 14)); }
            if (i1 != 255) { const unsigned pos = __hip_atomic_fetch_add(cntl + i1, 1u, __ATOMIC_RELAXED, __HIP_MEMORY_SCOPE_WORKGROUP); LIST[moba_list_off(bh, i1) + (size_t)(qb - i1 - 1) * 256 + pos] = (unsigned short)(t | (1u << 14)); }
            if (i2 != 255) { const unsigned pos = __hip_atomic_fetch_add(cntl + i2, 1u, __ATOMIC_RELAXED, __HIP_MEMORY_SCOPE_WORKGROUP); LIST[moba_list_off(bh, i2) + (size_t)(qb - i2 - 1) * 256 + pos] = (unsigned short)(t | (2u << 14)); } }
    }
    __syncthreads();
    if (LIST && tid < 64) { const unsigned c = cntl[tid]; CTAB[((size_t)bh * 64 + qb) * 64 + tid] = c; if (c) atomicAdd(LCNT + bh * 64 + tid, c); }
    __syncthreads();
}

__device__ __forceinline__ void fox_naive(const bf16* PROJ, const float* FOXCUM, bf16* Y, int gw, int NGW, int lane) {
    for (int idx = gw; idx < 12 * SEQ; idx += NGW) {
        const int t = SEQ - 1 - idx / 12, bh = idx % 12, b = bh / 6, h = bh % 6; const size_t rb = (size_t)b * SEQ;
        const float qv = bf2f(PROJ[(rb + t) * PLD + C_FQ + h * 64 + lane]); const float ct = FOXCUM[(size_t)bh * SEQ + t];
        float m = -INFINITY, l = 0.f, acc = 0.f;
#pragma unroll 4
        for (int j = 0; j <= t; ++j) {
            const float kv = bf2f(PROJ[(rb + j) * PLD + C_FK + h * 64 + lane]), vv = bf2f(PROJ[(rb + j) * PLD + C_FV + h * 64 + lane]);
            const float s = wave_sum(qv * kv) + (ct - FOXCUM[(size_t)bh * SEQ + j]);
            const float mn = fmaxf(m, s), sc = exp2f(m - mn), p = exp2f(s - mn);
            l = l * sc + p; acc = acc * sc + p * vv; m = mn; }
        Y[(rb + t) * 1024 + Y_FOX + h * 64 + lane] = (bf16)f2bf(acc / l);
    }
}
__device__ __forceinline__ void moba_naive(const bf16* PROJ, const unsigned* SEL, bf16* Y, int gw, int NGW, int lane) {
    for (int idx = gw; idx < 12 * SEQ; idx += NGW) {
        const int t = SEQ - 1 - idx / 12, bh = idx % 12, b = bh / 6, h = bh % 6; const size_t rb = (size_t)b * SEQ;
        const float slope2 = exp2f(-8.f * (float)(h + 1) / 6.f) * LOG2E;
        const float qv = bf2f(PROJ[(rb + t) * PLD + C_BQ + h * 64 + lane]);
        const unsigned sel = SEL[(rb + t) * 6 + h];
        float m = -INFINITY, l = 0.f, acc = 0.f;
        for (int slot = 0; slot < 4; ++slot) {
            int j0, j1;
            if (slot < 3) { const int n = (sel >> (8 * slot)) & 0xff; if (n == 255) continue; j0 = n * 256; j1 = j0 + 256; } else { j0 = (t >> 8) * 256; j1 = t + 1; }
#pragma unroll 4
            for (int j = j0; j < j1; ++j) {
                const float kv = bf2f(PROJ[(rb + j) * PLD + C_BK + h * 64 + lane]), vv = bf2f(PROJ[(rb + j) * PLD + C_BV + h * 64 + lane]);
                const float s = wave_sum(qv * kv) - slope2 * (float)(t - j);
                const float mn = fmaxf(m, s), sc = exp2f(m - mn), p = exp2f(s - mn);
                l = l * sc + p; acc = acc * sc + p * vv; m = mn; }
        }
        Y[(rb + t) * 1024 + Y_MOBA + h * 64 + lane] = (bf16)f2bf(acc / l);
    }
}
typedef short v4i16_t __attribute__((ext_vector_type(4)));
typedef short s16x4 __attribute__((ext_vector_type(4)));
constexpr int ATT_K0 = 0, ATT_V0 = 32768, ATT_TAB = 132096;
#ifndef THRESH_NAT
#define THRESH_NAT 20.f
#endif
constexpr float THRESH2 = THRESH_NAT * LOG2E;

__device__ __forceinline__ int crow(int r, int hi) { return (r & 3) + 8 * (r >> 2) + 4 * hi; }
__device__ __forceinline__ s16x4 vtr(LAS const unsigned char* p) { return __builtin_bit_cast(s16x4, __builtin_amdgcn_ds_read_tr16_b64_v4i16((LAS v4i16_t*)p)); }
typedef float f32x2_t __attribute__((ext_vector_type(2))); typedef __bf16 bf16x2_t __attribute__((ext_vector_type(2)));
#ifndef CVT_ASM
#define CVT_ASM 0
#endif
#if CVT_ASM
__device__ __forceinline__ unsigned cvtpk(float lo, float hi) { unsigned r; asm volatile("v_cvt_pk_bf16_f32 %0, %1, %2\n\ts_nop 1" : "=v"(r) : "v"(lo), "v"(hi)); return r; }
#else
__device__ __forceinline__ unsigned cvtpk(float lo, float hi) { const f32x2_t v = {lo, hi}; const bf16x2_t b = __builtin_convertvector(v, bf16x2_t); return __builtin_bit_cast(unsigned, b); }
#endif

#ifdef TREG
#define TRF_B(id) unsigned long long trf_t0_ = 0ull; do { if ((id) == TREG_ID) trf_t0_ = __builtin_amdgcn_s_memrealtime(); } while (0)
#define TRF_E(id) do { if ((id) == TREG_ID && wave == 0 && lane == 0) { volatile LAS unsigned long long* a_ = (volatile LAS unsigned long long*)(lds + MISC_OFF + 48); *a_ = *a_ + (__builtin_amdgcn_s_memrealtime() - trf_t0_); } } while (0)
#else
#define TRF_B(id) do { } while (0)
#define TRF_E(id) do { } while (0)
#endif
#ifndef SUBTILE_SCHED
#define SUBTILE_SCHED 1
#endif
struct GroupRegs { v4u k[4], v[4]; };
__device__ __forceinline__ void group_issue(GroupRegs& R, const bf16* Kg, const bf16* Vg, int tid) {
#pragma unroll
    for (int i = 0; i < 4; ++i) { const int idx = tid + NTHREADS * i, row = idx >> 3, ch = idx & 7;
        R.k[i] = *(const v4u*)(Kg + (size_t)row * PLD + ch * 8); R.v[i] = *(const v4u*)(Vg + (size_t)row * PLD + ch * 8); }
}
__device__ __forceinline__ void group_commit(const GroupRegs& R, LAS unsigned char* kv, int tid) {
#pragma unroll
    for (int i = 0; i < 4; ++i) { const int idx = tid + NTHREADS * i, row = idx >> 3, ch = idx & 7;
        *(LAS v4u*)(kv + ATT_K0 + row * 128 + ((ch ^ ((row >> 1) & 7)) << 4)) = R.k[i];
        *(LAS v4u*)(kv + ATT_V0 + row * 128 + ((ch * 16) ^ (((row >> 1) & 1) << 6))) = R.v[i]; }
}
__device__ __forceinline__ void load_group(const bf16* Kg, const bf16* Vg, LAS unsigned char* kv, int tid) {
#pragma unroll
    for (int i = 0; i < 4; ++i) { const int idx = tid + NTHREADS * i, row = idx >> 3, ch = idx & 7;
        const v4u k = *(const v4u*)(Kg + (size_t)row * PLD + ch * 8), v = *(const v4u*)(Vg + (size_t)row * PLD + ch * 8);
        *(LAS v4u*)(kv + ATT_K0 + row * 128 + ((ch ^ ((row >> 1) & 7)) << 4)) = k;
        *(LAS v4u*)(kv + ATT_V0 + row * 128 + ((ch * 16) ^ (((row >> 1) & 1) << 6))) = v; }
}

template <bool FOX>
__device__ __forceinline__ void attn_subtile(LAS const unsigned char* kv, LAS const float* colt, int j0, const bf16x8 (&qf)[4], float rowterm, float slope2, bool mask, int qrel,
                                             f32x16 (&o)[2], float& l, int lane) {
    const int r32 = lane & 31, hh = lane >> 5;
    bf16x8 kf[4];
    { const int row = j0 + r32; LAS const unsigned char* kr = kv + ATT_K0 + row * 128; const int sw = (row >> 1) & 7;
#pragma unroll
      for (int s = 0; s < 4; ++s) kf[s] = *(LAS const bf16x8*)(kr + (((2 * s + hh) ^ sw) << 4)); }
#if SUBTILE_SCHED
    __builtin_amdgcn_sched_barrier(0);
#endif
    f32x16 acc;
    if (FOX) {
#pragma unroll
        for (int g = 0; g < 4; ++g) { const f32x4 c = *(LAS const f32x4*)(colt + j0 + 8 * g + 4 * hh); acc[4 * g + 0] = rowterm + c.x; acc[4 * g + 1] = rowterm + c.y; acc[4 * g + 2] = rowterm + c.z; acc[4 * g + 3] = rowterm + c.w; }
    } else {
        const float bb = rowterm + slope2 * (float)(j0 + 4 * hh);
#pragma unroll
        for (int r = 0; r < 16; ++r) acc[r] = slope2 * (float)((r & 3) + 8 * (r >> 2)) + bb;
    }
    if (mask) {
#pragma unroll
        for (int r = 0; r < 16; ++r) if (j0 + crow(r, hh) > qrel) acc[r] = -INFINITY;
    }
#pragma unroll
    for (int s = 0; s < 4; ++s) acc = __builtin_amdgcn_mfma_f32_32x32x16_bf16(kf[s], qf[s], acc, 0, 0, 0);
    bf16x8 vf[2][2];
    { const int i = lane & 15, c = (lane >> 4) & 1;
#pragma unroll
      for (int db = 0; db < 2; ++db)
#pragma unroll
          for (int s = 0; s < 2; ++s) { const int rowv = j0 + 16 * s + 4 * hh + (i >> 2); const int colb = (32 * db + 16 * c + 4 * (i & 3)) * 2;
              LAS const unsigned char* vp = kv + ATT_V0 + rowv * 128 + (colb ^ (((rowv >> 1) & 1) << 6));
              const s16x4 lo = vtr(vp), hi = vtr(vp + 8 * 128);
              vf[db][s] = (bf16x8){lo[0], lo[1], lo[2], lo[3], hi[0], hi[1], hi[2], hi[3]}; } }
#if SUBTILE_SCHED
    __builtin_amdgcn_sched_barrier(0);
#endif
    f32x2_t s2 = {0.f, 0.f};
#pragma unroll
    for (int r = 0; r < 16; r += 2) { acc[r] = __builtin_amdgcn_exp2f(acc[r]); acc[r + 1] = __builtin_amdgcn_exp2f(acc[r + 1]); s2 += (f32x2_t){acc[r], acc[r + 1]}; }
    l += s2.x + s2.y;
    bf16x8 pa[2];
#pragma unroll
    for (int s = 0; s < 2; ++s) { v4u w; w.x = cvtpk(acc[8 * s + 0], acc[8 * s + 1]); w.y = cvtpk(acc[8 * s + 2], acc[8 * s + 3]); w.z = cvtpk(acc[8 * s + 4], acc[8 * s + 5]); w.w = cvtpk(acc[8 * s + 6], acc[8 * s + 7]); pa[s] = __builtin_bit_cast(bf16x8, w); }
#pragma unroll
    for (int db = 0; db < 2; ++db)
#pragma unroll
        for (int s = 0; s < 2; ++s) o[db] = __builtin_amdgcn_mfma_f32_32x32x16_bf16(pa[s], vf[db][s], o[db], 0, 0, 0);
}
__device__ __forceinline__ float rfl(float x) { return __builtin_bit_cast(float, __builtin_amdgcn_readfirstlane(__builtin_bit_cast(int, x))); }

__device__ __forceinline__ void fox_unit(int bh, int qb, const bf16* PROJ, const float* FOXCUM, bf16* Y, float B2, LAS unsigned char* lds, int tid, int wave, int lane) {
    const int b = bh / 6, h = bh % 6; const size_t rb = (size_t)b * SEQ; const int r32 = lane & 31, hh = lane >> 5;
    const int q0w = qb * 256 + wave * 32, qpos = q0w + r32;
    const float* cum = FOXCUM + (size_t)bh * SEQ;
    bf16x8 qf[4];
#pragma unroll
    for (int s = 0; s < 4; ++s) qf[s] = *(const bf16x8*)(PROJ + (rb + qpos) * PLD + C_FQ + h * 64 + 16 * s + 8 * hh);
    GroupRegs GA, GB;
    group_issue(GA, PROJ + (rb + (size_t)qb * 256) * PLD + C_FK + h * 64, PROJ + (rb + (size_t)qb * 256) * PLD + C_FV + h * 64, tid);
    const float ca = (tid < 256) ? -cum[qb * 256 + tid] : 0.f;
    const float cq = cum[qpos];
    const float cq_first_v = cum[q0w], cq_blk_v = cum[qb * 256], cprev_v = (qb > 0) ? cum[qb * 256 - 1] : 0.f;
    __builtin_amdgcn_sched_barrier(0);
    const float cq_first = rfl(cq_first_v), cq_blk = rfl(cq_blk_v), cprev = rfl(cprev_v);
    const float rowterm = cq - B2, lim = -THRESH2 - 2.f * B2;
    f32x16 o[2]; float l = 0.f;
#pragma unroll
    for (int r = 0; r < 16; ++r) { o[0][r] = 0.f; o[1][r] = 0.f; }
    LAS float* coltA = (LAS float*)(lds + ATT_TAB); LAS float* coltB = coltA + 256;
    LAS unsigned char* kvA = lds; LAS unsigned char* kvB = lds + 65536;
#ifndef FOX_2G
#define FOX_2G 1
#endif
    const bool haveB = FOX_2G && (qb > 0) && !(cq_blk - cprev < lim);
    float cb = 0.f;
    if (haveB) { group_issue(GB, PROJ + (rb + (size_t)(qb - 1) * 256) * PLD + C_FK + h * 64, PROJ + (rb + (size_t)(qb - 1) * 256) * PLD + C_FV + h * 64, tid);
        cb = (tid < 256) ? -cum[(qb - 1) * 256 + tid] : 0.f; }
    group_commit(GA, kvA, tid); if (tid < 256) coltA[tid] = ca;
    if (haveB) { group_commit(GB, kvB, tid); if (tid < 256) coltB[tid] = cb; }
    __syncthreads();
#ifndef REP_FLOAD
#define REP_FLOAD 0
#endif
#pragma unroll 1
    for (int rp = 0; rp < REP_FLOAD; ++rp) {
        group_issue(GA, PROJ + (rb + (size_t)qb * 256) * PLD + C_FK + h * 64, PROJ + (rb + (size_t)qb * 256) * PLD + C_FV + h * 64, tid);
        if (haveB) group_issue(GB, PROJ + (rb + (size_t)(qb - 1) * 256) * PLD + C_FK + h * 64, PROJ + (rb + (size_t)(qb - 1) * 256) * PLD + C_FV + h * 64, tid);
        group_commit(GA, kvA, tid); if (haveB) group_commit(GB, kvB, tid);
        __syncthreads(); }
#ifndef REP_FSUB
#define REP_FSUB 0
#endif
#pragma unroll 1
    for (int rp = 0; rp <= REP_FSUB; ++rp) {
    if (rp) { l = 0.f;
#pragma unroll
        for (int r = 0; r < 16; ++r) { o[0][r] = 0.f; o[1][r] = 0.f; } }
#pragma unroll 1
    for (int st = wave; st >= 0; --st) {
        const int j0 = 32 * st;
        if (cq_first + rfl(coltA[j0 + 31]) < lim) break;
        attn_subtile<true>(kvA, coltA, j0, qf, rowterm, 0.f, st == wave, wave * 32 + r32, o, l, lane);
    }
    if (haveB) {
#pragma unroll 1
        for (int st = 7; st >= 0; --st) {
            const int j0 = 32 * st;
            if (cq_first + rfl(coltB[j0 + 31]) < lim) break;
            attn_subtile<true>(kvB, coltB, j0, qf, rowterm, 0.f, false, 0, o, l, lane);
        }
    }
    }
    __syncthreads();
    {
        for (int g = haveB ? qb - 2 : qb - 1; g >= 0; --g) {
            if (cq_blk - rfl(cum[g * 256 + 255]) < lim) break;
            load_group(PROJ + (rb + (size_t)g * 256) * PLD + C_FK + h * 64, PROJ + (rb + (size_t)g * 256) * PLD + C_FV + h * 64, kvA, tid);
            if (tid < 256) coltA[tid] = -cum[g * 256 + tid];
            __syncthreads();
            {
#pragma unroll 1
                for (int st = 7; st >= 0; --st) {
                    const int j0 = 32 * st;
                    if (cq_first + rfl(coltA[j0 + 31]) < lim) break;
                    attn_subtile<true>(kvA, coltA, j0, qf, rowterm, 0.f, false, 0, o, l, lane);
                }
            }
            __syncthreads();
        }
    }
    l = half_sum(l, lane);
    bf16* yp = Y + (rb + (size_t)q0w) * 1024 + Y_FOX + h * 64 + ((lane & 1) ? 31 + r32 : r32);
    LAS float* ltab = (LAS float*)(lds + ATT_TAB + 5120) + wave * 32;
    if (hh == 0) ltab[r32] = __builtin_amdgcn_rcpf(l);
    f32x4 l4[4];
#pragma unroll
    for (int g = 0; g < 4; ++g) l4[g] = *(LAS const f32x4*)(ltab + 8 * g + 4 * hh);
#ifndef REP_FOUT
#define REP_FOUT 0
#endif
#pragma unroll 1
    for (int rp = 0; rp <= REP_FOUT; ++rp) {
#pragma unroll
    for (int r = 0; r < 16; ++r) { const int q = crow(r, hh); const float rl = l4[r >> 2][r & 3]; const bool odd = lane & 1;
        const float give = odd ? o[0][r] : o[1][r];
        const float got = __builtin_bit_cast(float, __builtin_amdgcn_update_dpp(0, __builtin_bit_cast(int, give), 0xB1, 0xf, 0xf, true));
        *(unsigned*)(yp + (size_t)q * 1024) = odd ? cvtpk(got * rl, o[1][r] * rl) : cvtpk(o[0][r] * rl, got * rl); }
    }
}

struct FoxPre { GroupRegs GA; float ca, cq, cq_first, cq_blk, cprev; bf16x8 qf[4]; };
__device__ __forceinline__ void fox_issue(FoxPre& R, int bh, int qb, const bf16* PROJ, const float* FOXCUM, int tid, int wave, int lane) {
    const int b = bh / 6, h = bh % 6; const size_t rb = (size_t)b * SEQ; const int r32 = lane & 31, hh = lane >> 5;
    const int q0w = qb * 256 + wave * 32, qpos = q0w + r32;
    const float* cum = FOXCUM + (size_t)bh * SEQ;
#pragma unroll
    for (int s = 0; s < 4; ++s) R.qf[s] = *(const bf16x8*)(PROJ + (rb + qpos) * PLD + C_FQ + h * 64 + 16 * s + 8 * hh);
    group_issue(R.GA, PROJ + (rb + (size_t)qb * 256) * PLD + C_FK + h * 64, PROJ + (rb + (size_t)qb * 256) * PLD + C_FV + h * 64, tid);
    R.ca = (tid < 256) ? -cum[qb * 256 + tid] : 0.f;
    R.cq = cum[qpos]; R.cq_first = cum[q0w]; R.cq_blk = cum[qb * 256];
    R.cprev = (qb > 0) ? cum[qb * 256 - 1] : 0.f;
}
__device__ __forceinline__ void fox_phase_pipe(const bf16* PROJ, const float* FOXCUM, bf16* Y, float B2, LAS unsigned char* lds, int vcu, int G, int tid0, int wave, int lane0) {
    LAS float* coltA = (LAS float*)(lds + ATT_TAB); LAS float* coltB = coltA + 256;
    LAS unsigned char* kvA = lds; LAS unsigned char* kvB = lds + 65536;
    const float lim = -THRESH2 - 2.f * B2;
    int u = vcu; if (u >= 768) return;
    FoxPre R; fox_issue(R, u >> 6, 63 - (u & 63), PROJ, FOXCUM, tid0, wave, lane0);
    for (;;) {
        int tid = tid0; asm volatile("" : "+v"(tid)); const int lane = tid & 63, r32 = lane & 31, hh = lane >> 5;
        const int bh = u >> 6, qb = 63 - (u & 63), b = bh / 6, h = bh % 6; const size_t rb = (size_t)b * SEQ; const int q0w = qb * 256 + wave * 32;
        const float* cum = FOXCUM + (size_t)bh * SEQ;
        const float cq_first = rfl(R.cq_first), cq_blk = rfl(R.cq_blk), cprev = rfl(R.cprev); const float rowterm = R.cq - B2;
        const bool haveB = (qb > 0) && !(cq_blk - cprev < lim);
        bf16x8 qf[4];
#pragma unroll
        for (int s = 0; s < 4; ++s) qf[s] = R.qf[s];
        GroupRegs GB; float cb = 0.f;
        if (haveB) { group_issue(GB, PROJ + (rb + (size_t)(qb - 1) * 256) * PLD + C_FK + h * 64, PROJ + (rb + (size_t)(qb - 1) * 256) * PLD + C_FV + h * 64, tid);
            cb = (tid < 256) ? -cum[(qb - 1) * 256 + tid] : 0.f; }
        group_commit(R.GA, kvA, tid); if (tid < 256) coltA[tid] = R.ca;
        if (haveB) { group_commit(GB, kvB, tid); if (tid < 256) coltB[tid] = cb; }
        __syncthreads();
        const int un = u + G;
        if (un < 768) fox_issue(R, un >> 6, 63 - (un & 63), PROJ, FOXCUM, tid, wave, lane);
        f32x16 o[2]; float l = 0.f;
#pragma unroll
        for (int r = 0; r < 16; ++r) { o[0][r] = 0.f; o[1][r] = 0.f; }
#pragma unroll 1
        for (int st = wave; st >= 0; --st) {
            const int j0 = 32 * st;
            if (cq_first + rfl(coltA[j0 + 31]) < lim) break;
            attn_subtile<true>(kvA, coltA, j0, qf, rowterm, 0.f, st == wave, wave * 32 + r32, o, l, lane);
        }
        if (haveB) {
#pragma unroll 1
            for (int st = 7; st >= 0; --st) {
                const int j0 = 32 * st;
                if (cq_first + rfl(coltB[j0 + 31]) < lim) break;
                attn_subtile<true>(kvB, coltB, j0, qf, rowterm, 0.f, false, 0, o, l, lane);
            }
        }
        __syncthreads();
        for (int g = haveB ? qb - 2 : qb - 1; g >= 0; --g) {
            if (cq_blk - rfl(cum[g * 256 + 255]) < lim) break;
            load_group(PROJ + (rb + (size_t)g * 256) * PLD + C_FK + h * 64, PROJ + (rb + (size_t)g * 256) * PLD + C_FV + h * 64, kvA, tid);
            if (tid < 256) coltA[tid] = -cum[g * 256 + tid];
            __syncthreads();
#pragma unroll 1
            for (int st = 7; st >= 0; --st) {
                const int j0 = 32 * st;
                if (cq_first + rfl(coltA[j0 + 31]) < lim) break;
                attn_subtile<true>(kvA, coltA, j0, qf, rowterm, 0.f, false, 0, o, l, lane);
            }
            __syncthreads();
        }
        l = half_sum(l, lane);
        bf16* yp = Y + (rb + (size_t)q0w) * 1024 + Y_FOX + h * 64 + r32;
#pragma unroll
        for (int r = 0; r < 16; ++r) { const int q = crow(r, hh); const float rl = __builtin_amdgcn_rcpf(shf(l, q));
            yp[(size_t)q * 1024] = (bf16)f2bf(o[0][r] * rl); yp[(size_t)q * 1024 + 32] = (bf16)f2bf(o[1][r] * rl); }
        if (un >= 768) break;
        u = un;
    }
}

__device__ __forceinline__ void fox_unit_old(int bh, int qb, const bf16* PROJ, const float* FOXCUM, bf16* Y, float B2, LAS unsigned char* lds, int tid, int wave, int lane) {
    const int b = bh / 6, h = bh % 6; const size_t rb = (size_t)b * SEQ; const int r32 = lane & 31, hh = lane >> 5;
    const int q0w = qb * 256 + wave * 32, qpos = q0w + r32;
    const float* cum = FOXCUM + (size_t)bh * SEQ;
    bf16x8 qf[4];
#pragma unroll
    for (int s = 0; s < 4; ++s) qf[s] = *(const bf16x8*)(PROJ + (rb + qpos) * PLD + C_FQ + h * 64 + 16 * s + 8 * hh);
    const float cq = cum[qpos];
    const float cq_first = rfl(cum[q0w]);
    const float cq_blk = rfl(cum[qb * 256]);
    const float rowterm = cq - B2;
    f32x16 o[2]; float l = 0.f;
#pragma unroll
    for (int r = 0; r < 16; ++r) { o[0][r] = 0.f; o[1][r] = 0.f; }
    LAS float* colt = (LAS float*)(lds + ATT_TAB);
    for (int g = qb; g >= 0; --g) {
        if (g < qb) { const float cl = rfl(cum[g * 256 + 255]); if (2.f * B2 + cq_blk - cl < -THRESH2) break; }
        load_group(PROJ + (rb + (size_t)g * 256) * PLD + C_FK + h * 64, PROJ + (rb + (size_t)g * 256) * PLD + C_FV + h * 64, lds, tid);
        if (tid < 256) colt[tid] = -cum[g * 256 + tid];
        __syncthreads();
        const int stmax = (g == qb) ? wave : 7;
        for (int st = stmax; st >= 0; --st) {
            const int j0 = 32 * st;
            { const float cl = rfl(colt[j0 + 31]); if (2.f * B2 + cq_first + cl < -THRESH2) break; }
            attn_subtile<true>(lds, colt, j0, qf, rowterm, 0.f, (g == qb) && (st == wave), wave * 32 + r32, o, l, lane);
        }
        __syncthreads();
    }
    l = half_sum(l, lane);
    bf16* yp = Y + (rb + (size_t)q0w) * 1024 + Y_FOX + h * 64 + r32;
#pragma unroll
    for (int r = 0; r < 16; ++r) { const int q = crow(r, hh); const float rl = __builtin_amdgcn_rcpf(shf(l, q));
        yp[(size_t)q * 1024] = (bf16)f2bf(o[0][r] * rl); yp[(size_t)q * 1024 + 32] = (bf16)f2bf(o[1][r] * rl); }
}

__device__ __forceinline__ size_t moba_list_off(int bh, int n) { return (size_t)bh * 516096 + 256 * (size_t)(63 * n - (n * (n - 1)) / 2); }
__device__ __forceinline__ void moba_store(const f32x16 (&o)[2], float l, int qpos, int slot, bool valid, size_t rb, int h, bf16* OPART, float* LPART, bf16* Y, LAS unsigned char* lds, int wave, int lane) {
    const int r32 = lane & 31, hh = lane >> 5; const bool odd = lane & 1;
    LAS unsigned* etab = (LAS unsigned*)(lds + ATT_TAB + 5120) + wave * 32;
    if (hh == 0) etab[r32] = valid ? ((unsigned)qpos | ((unsigned)slot << 14) | 0x10000u) : 0u;
    v4u e4[4];
#pragma unroll
    for (int g = 0; g < 4; ++g) e4[g] = *(LAS const v4u*)(etab + 8 * g + 4 * hh);
    const int dcol = odd ? 31 + r32 : r32;
#pragma unroll
    for (int r = 0; r < 16; ++r) { const unsigned e = e4[r >> 2][r & 3];
        const float give = odd ? o[0][r] : o[1][r];
        const float got = __builtin_bit_cast(float, __builtin_amdgcn_update_dpp(0, __builtin_bit_cast(int, give), 0xB1, 0xf, 0xf, true));
        const unsigned w = odd ? cvtpk(got, o[1][r]) : cvtpk(o[0][r], got);
        if (e >> 16) { const unsigned qp = e & 0x3fffu, sl = (e >> 14) & 3u;
            bf16* op = (sl == 3u) ? (Y + (rb + qp) * 1024 + Y_MOBA + h * 64) : (OPART + ((size_t)sl * MROWS + rb + qp) * 384 + h * 64);
            *(unsigned*)(op + dcol) = w; } }
    if (valid && hh == 0) LPART[((size_t)slot * MROWS + rb + qpos) * 6 + h] = l;
}
__device__ __forceinline__ void moba_sel_unit(int bh, int n, int chunk, int cnt, const bf16* PROJ, const unsigned short* LIST, const unsigned* CTAB, bf16* OPART, float* LPART, bf16* Y, float B2,
                                              LAS unsigned char* lds, int tid, int wave, int lane) {
    const int b = bh / 6, h = bh % 6; const size_t rb = (size_t)b * SEQ; const int r32 = lane & 31, hh = lane >> 5;
    const float slope2 = exp2f(-8.f * (float)(h + 1) / 6.f) * LOG2E;
    GroupRegs GR; group_issue(GR, PROJ + (rb + (size_t)n * 256) * PLD + C_BK + h * 64, PROJ + (rb + (size_t)n * 256) * PLD + C_BV + h * 64, tid);
    const int nvalid = cnt - chunk * 256 < 256 ? cnt - chunk * 256 : 256;
    const bool active = wave * 32 < nvalid;
    bool valid = true; int qpos = 0, slot = 0; bf16x8 qf[4];
    if (active) {
        int li = wave * 32 + r32; if (li >= nvalid) { li = nvalid - 1; valid = false; }
        const int p = chunk * 256 + li;
        const int cv = (lane > n) ? (int)CTAB[((size_t)bh * 64 + lane) * 64 + n] : 0; int inc = cv;
#pragma unroll
        for (int o2 = 1; o2 < 64; o2 <<= 1) { const int t2 = supi(inc, o2, lane); if (lane >= o2) inc += t2; }
        int qseg = 0;
#pragma unroll
        for (int stp = 32; stp >= 1; stp >>= 1) { const int v = shfi(inc, qseg + stp - 1); if (v <= p) qseg += stp; }
        const int idx = p - (shfi(inc, qseg) - shfi(cv, qseg));
        const unsigned e = LIST[moba_list_off(bh, n) + (size_t)(qseg - n - 1) * 256 + idx]; qpos = e & 0x3fff; slot = e >> 14;
#pragma unroll
        for (int s = 0; s < 4; ++s) qf[s] = *(const bf16x8*)(PROJ + (rb + qpos) * PLD + C_BQ + h * 64 + 16 * s + 8 * hh);
    }
    group_commit(GR, lds, tid);
    __syncthreads();
    if (active) {
        const int qrel = qpos - n * 256;
        const float rowterm = -slope2 * (float)qrel - B2;
        f32x16 o[2]; float l = 0.f;
#pragma unroll
        for (int r = 0; r < 16; ++r) { o[0][r] = 0.f; o[1][r] = 0.f; }
#ifndef REP_SUB
#define REP_SUB 0
#endif
#pragma unroll 1
        for (int rp = 0; rp <= REP_SUB; ++rp) {
        if (rp) { l = 0.f;
#pragma unroll
            for (int r = 0; r < 16; ++r) { o[0][r] = 0.f; o[1][r] = 0.f; } }
#pragma unroll 1
        for (int st = 0; st < 8; ++st) attn_subtile<false>(lds, nullptr, 32 * st, qf, rowterm, slope2, false, 0, o, l, lane);
        }
        l = half_sum(l, lane);
        moba_store(o, l, qpos, slot, valid, rb, h, OPART, LPART, Y, lds, wave, lane);
    }
    __syncthreads();
}
__device__ __forceinline__ void moba_sel_step(int huA, int S, LAS const int* pre, const unsigned* lcnt, const bf16* PROJ, const unsigned short* LIST, const unsigned* CTAB, bf16* OPART, float* LPART, bf16* Y,
                                              float B2, LAS unsigned char* lds, int tid, int wave, int lane) {
    const int r32 = lane & 31, hh = lane >> 5, half = wave >> 2, tile = wave & 3, htid = tid & 255;
    const int hu = huA + half; const bool uvalid = hu < S;
    int p = 0, chunk = 0, cnt = 0;
    if (uvalid) { int lo2 = 0, hi2 = 768; while (hi2 - lo2 > 1) { const int mid = (lo2 + hi2) >> 1; if (pre[mid] <= hu) lo2 = mid; else hi2 = mid; } p = lo2; chunk = hu - pre[lo2]; cnt = (int)lcnt[lo2]; }
    const int bh = p >> 6, n = p & 63, b = bh / 6, h = bh % 6; const size_t rb = (size_t)b * SEQ;
    const float slope2 = exp2f(-8.f * (float)(h + 1) / 6.f) * LOG2E;
    LAS unsigned char* kv = lds + half * 65536;
    v4u gk[8], gv[8];
    if (uvalid) { const bf16* Kg = PROJ + (rb + (size_t)n * 256) * PLD + C_BK + h * 64; const bf16* Vg = PROJ + (rb + (size_t)n * 256) * PLD + C_BV + h * 64;
#pragma unroll
        for (int i = 0; i < 8; ++i) { const int idx = htid + 256 * i, row = idx >> 3, ch = idx & 7; gk[i] = *(const v4u*)(Kg + (size_t)row * PLD + ch * 8); gv[i] = *(const v4u*)(Vg + (size_t)row * PLD + ch * 8); } }
    const int nvalid = uvalid ? (cnt - chunk * 128 < 128 ? cnt - chunk * 128 : 128) : 0;
    const bool active = tile * 32 < nvalid;
    bool valid = true; int qpos = 0, slot = 0; bf16x8 qf[4];
    if (active) {
        int li = tile * 32 + r32; if (li >= nvalid) { li = nvalid - 1; valid = false; }
        const int pos = chunk * 128 + li;
        const int cv = (lane > n) ? (int)CTAB[((size_t)bh * 64 + lane) * 64 + n] : 0; int inc = cv;
#pragma unroll
        for (int o2 = 1; o2 < 64; o2 <<= 1) { const int t2 = supi(inc, o2, lane); if (lane >= o2) inc += t2; }
        int qseg = 0;
#pragma unroll
        for (int stp = 32; stp >= 1; stp >>= 1) { const int v = shfi(inc, qseg + stp - 1); if (v <= pos) qseg += stp; }
        const int idx = pos - (shfi(inc, qseg) - shfi(cv, qseg));
        const unsigned e = LIST[moba_list_off(bh, n) + (size_t)(qseg - n - 1) * 256 + idx]; qpos = e & 0x3fff; slot = e >> 14;
#pragma unroll
        for (int s = 0; s < 4; ++s) qf[s] = *(const bf16x8*)(PROJ + (rb + qpos) * PLD + C_BQ + h * 64 + 16 * s + 8 * hh);
    }
    if (uvalid) {
#pragma unroll
        for (int i = 0; i < 8; ++i) { const int idx = htid + 256 * i, row = idx >> 3, ch = idx & 7;
            *(LAS v4u*)(kv + ATT_K0 + row * 128 + ((ch ^ ((row >> 1) & 7)) << 4)) = gk[i];
            *(LAS v4u*)(kv + ATT_V0 + row * 128 + ((ch * 16) ^ (((row >> 1) & 1) << 6))) = gv[i]; } }
    __syncthreads();
    if (active) {
        const int qrel = qpos - n * 256;
        const float rowterm = -slope2 * (float)qrel - B2;
        f32x16 o[2]; float l = 0.f;
#pragma unroll
        for (int r = 0; r < 16; ++r) { o[0][r] = 0.f; o[1][r] = 0.f; }
#pragma unroll 1
        for (int st = 0; st < 8; ++st) attn_subtile<false>(kv, nullptr, 32 * st, qf, rowterm, slope2, false, 0, o, l, lane);
        l = half_sum(l, lane);
        moba_store(o, l, qpos, slot, valid, rb, h, OPART, LPART, Y, lds, wave, lane);
    }
    __syncthreads();
}
struct SelP { int bh, n, chunk, nvalid; bool uvalid; };
__device__ __forceinline__ SelP sel_params(int hu, int S, LAS const int* pre, const unsigned* lcnt) {
    SelP P; P.uvalid = hu < S; int p = 0, chunk = 0, cnt = 0;
    if (P.uvalid) { int lo2 = 0, hi2 = 768; while (hi2 - lo2 > 1) { const int mid = (lo2 + hi2) >> 1; if (pre[mid] <= hu) lo2 = mid; else hi2 = mid; } p = lo2; chunk = hu - pre[lo2]; cnt = (int)lcnt[lo2]; }
    P.bh = p >> 6; P.n = p & 63; P.chunk = chunk; P.nvalid = P.uvalid ? (cnt - chunk * 128 < 128 ? cnt - chunk * 128 : 128) : 0; return P;
}
#define SEL_KV_ISSUE(P_) do { if ((P_).uvalid) { const size_t rb_ = (size_t)((P_).bh / 6) * SEQ; const int h_ = (P_).bh % 6; \
        const bf16* Kg_ = PROJ + (rb_ + (size_t)(P_).n * 256) * PLD + C_BK + h_ * 64; const bf16* Vg_ = PROJ + (rb_ + (size_t)(P_).n * 256) * PLD + C_BV + h_ * 64; \
        _Pragma("unroll") for (int i_ = 0; i_ < 8; ++i_) { const int idx_ = htid + 256 * i_, row_ = idx_ >> 3, ch_ = idx_ & 7; gk[i_] = *(const v4u*)(Kg_ + (size_t)row_ * PLD + ch_ * 8); gv[i_] = *(const v4u*)(Vg_ + (size_t)row_ * PLD + ch_ * 8); } } } while (0)
#define SEL_ENTRY_ADDR(P_, cv_, li_, addr_) do { const int pos_ = (P_).chunk * 128 + (li_); int inc_ = (cv_); \
        _Pragma("unroll") for (int o2 = 1; o2 < 64; o2 <<= 1) { const int t2 = supi(inc_, o2, lane); if (lane >= o2) inc_ += t2; } \
        int qseg_ = 0; \
        _Pragma("unroll") for (int stp = 32; stp >= 1; stp >>= 1) { const int v_ = shfi(inc_, qseg_ + stp - 1); if (v_ <= pos_) qseg_ += stp; } \
        const int idx_ = pos_ - (shfi(inc_, qseg_) - shfi((cv_), qseg_)); \
        addr_ = LIST + moba_list_off((P_).bh, (P_).n) + (size_t)(qseg_ - (P_).n - 1) * 256 + idx_; } while (0)
template <class UOF>
__device__ __forceinline__ int moba_sel_pipe(int i, const UOF& uof, int S, int S2, LAS const int* pre, const unsigned* lcnt, const bf16* PROJ, const unsigned short* LIST, const unsigned* CTAB, bf16* OPART, float* LPART, bf16* Y,
                                             float B2, LAS unsigned char* lds, int tid, int wave, int lane) {
    const int r32 = lane & 31, hh = lane >> 5, half = wave >> 2, tile = wave & 3, htid = tid & 255;
    LAS unsigned char* kv = lds + half * 65536;
    int u = uof(i); if (u >= S2) return i;
    v4u gk[8], gv[8]; bf16x8 qf[4]; int qpos = 0, slot = 0; bool valid = true;
    SelP P = sel_params(2 * u + half, S, pre, lcnt);
    bool active = tile * 32 < P.nvalid;
    SEL_KV_ISSUE(P);
    if (active) { int li = tile * 32 + r32; if (li >= P.nvalid) { li = P.nvalid - 1; valid = false; }
        const int cv = (lane > P.n) ? (int)CTAB[((size_t)P.bh * 64 + lane) * 64 + P.n] : 0; const unsigned short* ea; SEL_ENTRY_ADDR(P, cv, li, ea);
        const unsigned e = *ea; qpos = e & 0x3fff; slot = e >> 14; const size_t rb = (size_t)(P.bh / 6) * SEQ;
#pragma unroll
        for (int s = 0; s < 4; ++s) qf[s] = *(const bf16x8*)(PROJ + (rb + qpos) * PLD + C_BQ + (P.bh % 6) * 64 + 16 * s + 8 * hh); }
    for (;;) {
        if (P.uvalid) {
#pragma unroll
            for (int i_ = 0; i_ < 8; ++i_) { const int idx = htid + 256 * i_, row = idx >> 3, ch = idx & 7;
                *(LAS v4u*)(kv + ATT_K0 + row * 128 + ((ch ^ ((row >> 1) & 7)) << 4)) = gk[i_];
                *(LAS v4u*)(kv + ATT_V0 + row * 128 + ((ch * 16) ^ (((row >> 1) & 1) << 6))) = gv[i_]; } }
        { TRF_B(9);
        __syncthreads();
        TRF_E(9); }
        TRF_B(8);
        ++i; const int un = uof(i); const bool has_next = un < S2;
        SelP Pn; Pn.uvalid = false; Pn.nvalid = 0; Pn.bh = 0; Pn.n = 0; Pn.chunk = 0;
        if (has_next) Pn = sel_params(2 * un + half, S, pre, lcnt);
        const bool active_n = tile * 32 < Pn.nvalid;
        int cvn = 0; if (active_n && lane > Pn.n) cvn = (int)CTAB[((size_t)Pn.bh * 64 + lane) * 64 + Pn.n];
        const int h = P.bh % 6; const size_t rb = (size_t)(P.bh / 6) * SEQ;
        const float slope2 = exp2f(-8.f * (float)(h + 1) / 6.f) * LOG2E;
        const int qrel = qpos - P.n * 256;
        const float rowterm = -slope2 * (float)qrel - B2;
        f32x16 o[2]; float l = 0.f;
#pragma unroll
        for (int r = 0; r < 16; ++r) { o[0][r] = 0.f; o[1][r] = 0.f; }
        if (active) {
#pragma unroll 1
            for (int st = 0; st < 3; ++st) attn_subtile<false>(kv, nullptr, 32 * st, qf, rowterm, slope2, false, 0, o, l, lane); }
        bool valid_n = true; unsigned en = 0u;
        if (active_n) { int li = tile * 32 + r32; if (li >= Pn.nvalid) { li = Pn.nvalid - 1; valid_n = false; }
            const unsigned short* ea; SEL_ENTRY_ADDR(Pn, cvn, li, ea); en = *ea; }
        SEL_KV_ISSUE(Pn);
        if (active) {
#pragma unroll 1
            for (int st = 3; st < 6; ++st) attn_subtile<false>(kv, nullptr, 32 * st, qf, rowterm, slope2, false, 0, o, l, lane); }
        bf16x8 qfn[4]; const int qpos_n = en & 0x3fff, slot_n = en >> 14;
        if (active_n) { const size_t rbn = (size_t)(Pn.bh / 6) * SEQ;
#pragma unroll
            for (int s = 0; s < 4; ++s) qfn[s] = *(const bf16x8*)(PROJ + (rbn + qpos_n) * PLD + C_BQ + (Pn.bh % 6) * 64 + 16 * s + 8 * hh); }
        else {
#pragma unroll
            for (int s = 0; s < 4; ++s) qfn[s] = qf[s]; }
        if (active) {
#pragma unroll 1
            for (int st = 6; st < 8; ++st) attn_subtile<false>(kv, nullptr, 32 * st, qf, rowterm, slope2, false, 0, o, l, lane);
            l = half_sum(l, lane);
            TRF_E(8);
            { TRF_B(6);
            moba_store(o, l, qpos, slot, valid, rb, h, OPART, LPART, Y, lds, wave, lane);
            TRF_E(6); } }
        { TRF_B(7);
        __syncthreads();
        TRF_E(7); }
        if (!has_next) break;
        P = Pn; active = active_n; valid = valid_n; qpos = qpos_n; slot = slot_n;
#pragma unroll
        for (int s = 0; s < 4; ++s) qf[s] = qfn[s];
    }
    return i;
}
struct QPair { int cur, next; };
__device__ __forceinline__ QPair moba_sel_pipe_dyn(int ucur, int unext, unsigned* qctr, volatile LAS int* qslot, int S, int S2, LAS const int* pre, const unsigned* lcnt, const bf16* PROJ, const unsigned short* LIST, const unsigned* CTAB, bf16* OPART, float* LPART, bf16* Y,
                                             float B2, LAS unsigned char* lds, int tid0, int wave, int lane0) {
    const int half = wave >> 2, tile = wave & 3;
    int tid = tid0, lane = lane0, r32 = lane & 31, hh = lane >> 5, htid = tid & 255;
    LAS unsigned char* kv = lds + half * 65536;
    int u = ucur; if (u >= S2) return QPair{ucur, unext};
    v4u gk[8], gv[8]; bf16x8 qf[4]; int qpos = 0, slot = 0; bool valid = true;
    SelP P = sel_params(2 * u + half, S, pre, lcnt);
    bool active = tile * 32 < P.nvalid;
    SEL_KV_ISSUE(P);
    if (active) { int li = tile * 32 + r32; if (li >= P.nvalid) { li = P.nvalid - 1; valid = false; }
        const int cv = (lane > P.n) ? (int)CTAB[((size_t)P.bh * 64 + lane) * 64 + P.n] : 0; const unsigned short* ea; SEL_ENTRY_ADDR(P, cv, li, ea);
        const unsigned e = *ea; qpos = e & 0x3fff; slot = e >> 14; const size_t rb = (size_t)(P.bh / 6) * SEQ;
#pragma unroll
        for (int s = 0; s < 4; ++s) qf[s] = *(const bf16x8*)(PROJ + (rb + qpos) * PLD + C_BQ + (P.bh % 6) * 64 + 16 * s + 8 * hh); }
    for (;;) {
        tid = tid0; asm volatile("" : "+v"(tid)); lane = tid & 63; r32 = lane & 31; hh = lane >> 5; htid = tid & 255;
        if (P.uvalid) {
#pragma unroll
            for (int i_ = 0; i_ < 8; ++i_) { const int idx = htid + 256 * i_, row = idx >> 3, ch = idx & 7;
                *(LAS v4u*)(kv + ATT_K0 + row * 128 + ((ch ^ ((row >> 1) & 7)) << 4)) = gk[i_];
                *(LAS v4u*)(kv + ATT_V0 + row * 128 + ((ch * 16) ^ (((row >> 1) & 1) << 6))) = gv[i_]; } }
        { TRF_B(9);
        __syncthreads();
        TRF_E(9); }
        TRF_B(8);
        const int un = unext; const bool has_next = un < S2;
        int fetched = 0; if (tid == 0) fetched = (int)__hip_atomic_fetch_add(qctr, 1u, __ATOMIC_RELAXED, __HIP_MEMORY_SCOPE_AGENT);
        SelP Pn; Pn.uvalid = false; Pn.nvalid = 0; Pn.bh = 0; Pn.n = 0; Pn.chunk = 0;
        if (has_next) Pn = sel_params(2 * un + half, S, pre, lcnt);
        const bool active_n = tile * 32 < Pn.nvalid;
        int cvn = 0; if (active_n && lane > Pn.n) cvn = (int)CTAB[((size_t)Pn.bh * 64 + lane) * 64 + Pn.n];
        const int h = P.bh % 6; const size_t rb = (size_t)(P.bh / 6) * SEQ;
        const float slope2 = exp2f(-8.f * (float)(h + 1) / 6.f) * LOG2E;
        const int qrel = qpos - P.n * 256;
        const float rowterm = -slope2 * (float)qrel - B2;
        f32x16 o[2]; float l = 0.f;
#pragma unroll
        for (int r = 0; r < 16; ++r) { o[0][r] = 0.f; o[1][r] = 0.f; }
        if (active) {
#pragma unroll 1
            for (int st = 0; st < 3; ++st) attn_subtile<false>(kv, nullptr, 32 * st, qf, rowterm, slope2, false, 0, o, l, lane); }
        bool valid_n = true; unsigned en = 0u;
        if (active_n) { int li = tile * 32 + r32; if (li >= Pn.nvalid) { li = Pn.nvalid - 1; valid_n = false; }
            const unsigned short* ea; SEL_ENTRY_ADDR(Pn, cvn, li, ea); en = *ea; }
        SEL_KV_ISSUE(Pn);
        if (active) {
#pragma unroll 1
            for (int st = 3; st < 6; ++st) attn_subtile<false>(kv, nullptr, 32 * st, qf, rowterm, slope2, false, 0, o, l, lane); }
        bf16x8 qfn[4]; const int qpos_n = en & 0x3fff, slot_n = en >> 14;
        if (active_n) { const size_t rbn = (size_t)(Pn.bh / 6) * SEQ;
#pragma unroll
            for (int s = 0; s < 4; ++s) qfn[s] = *(const bf16x8*)(PROJ + (rbn + qpos_n) * PLD + C_BQ + (Pn.bh % 6) * 64 + 16 * s + 8 * hh); }
        else {
#pragma unroll
            for (int s = 0; s < 4; ++s) qfn[s] = qf[s]; }
        if (active) {
#pragma unroll 1
            for (int st = 6; st < 8; ++st) attn_subtile<false>(kv, nullptr, 32 * st, qf, rowterm, slope2, false, 0, o, l, lane);
            l = half_sum(l, lane);
            TRF_E(8);
            { TRF_B(6);
            moba_store(o, l, qpos, slot, valid, rb, h, OPART, LPART, Y, lds, wave, lane);
            TRF_E(6); } }
        if (tid == 0) qslot[0] = fetched;
        { TRF_B(7);
        __syncthreads();
        TRF_E(7); }
        ucur = un; unext = __builtin_amdgcn_readfirstlane(qslot[0]);
        if (!has_next) break;
        P = Pn; active = active_n; valid = valid_n; qpos = qpos_n; slot = slot_n;
#pragma unroll
        for (int s = 0; s < 4; ++s) qf[s] = qfn[s];
    }
    return QPair{ucur, unext};
}
__device__ __forceinline__ void moba_own_pair(int bh, int nA, int nB, const bf16* PROJ, bf16* OPART, float* LPART, bf16* Y, float B2, LAS unsigned char* lds, int tid, int wave, int lane) {
    const int b = bh / 6, h = bh % 6; const size_t rb = (size_t)b * SEQ; const int r32 = lane & 31, hh = lane >> 5;
    const float slope2 = exp2f(-8.f * (float)(h + 1) / 6.f) * LOG2E;
    GroupRegs GA, GB;
    group_issue(GA, PROJ + (rb + (size_t)nA * 256) * PLD + C_BK + h * 64, PROJ + (rb + (size_t)nA * 256) * PLD + C_BV + h * 64, tid);
    group_issue(GB, PROJ + (rb + (size_t)nB * 256) * PLD + C_BK + h * 64, PROJ + (rb + (size_t)nB * 256) * PLD + C_BV + h * 64, tid);
    bf16x8 qfA[4], qfB[4];
    { const size_t qa = rb + (size_t)nA * 256 + wave * 32 + r32, qb2 = rb + (size_t)nB * 256 + (7 - wave) * 32 + r32;
#pragma unroll
      for (int s = 0; s < 4; ++s) { qfA[s] = *(const bf16x8*)(PROJ + qa * PLD + C_BQ + h * 64 + 16 * s + 8 * hh); qfB[s] = *(const bf16x8*)(PROJ + qb2 * PLD + C_BQ + h * 64 + 16 * s + 8 * hh); } }
    group_commit(GA, lds, tid); group_commit(GB, lds + 65536, tid);
    __syncthreads();
    { const int tile = wave, qrel = tile * 32 + r32, qpos = nA * 256 + qrel;
      const float rowterm = -slope2 * (float)qrel - B2;
      f32x16 o[2]; float l = 0.f;
#pragma unroll
      for (int r = 0; r < 16; ++r) { o[0][r] = 0.f; o[1][r] = 0.f; }
#pragma unroll 1
      for (int st = 0; st <= tile; ++st) attn_subtile<false>(lds, nullptr, 32 * st, qfA, rowterm, slope2, st == tile, qrel, o, l, lane);
      l = half_sum(l, lane);
      moba_store(o, l, qpos, 3, true, rb, h, OPART, LPART, Y, lds, wave, lane); }
    { const int tile = 7 - wave, qrel = tile * 32 + r32, qpos = nB * 256 + qrel;
      const float rowterm = -slope2 * (float)qrel - B2;
      f32x16 o[2]; float l = 0.f;
#pragma unroll
      for (int r = 0; r < 16; ++r) { o[0][r] = 0.f; o[1][r] = 0.f; }
#pragma unroll 1
      for (int st = 0; st <= tile; ++st) attn_subtile<false>(lds + 65536, nullptr, 32 * st, qfB, rowterm, slope2, st == tile, qrel, o, l, lane);
      l = half_sum(l, lane);
      moba_store(o, l, qpos, 3, true, rb, h, OPART, LPART, Y, lds, wave, lane); }
    __syncthreads();
}

__device__ __forceinline__ void moba_combine(const unsigned* SEL, const bf16* OPART, const float* LPART, bf16* Y, bf16* Yo, int opitch, int ocol, int gtid, int ngt) {
    constexpr size_t NIT = (size_t)MROWS * 48;
    for (size_t base = gtid; base < NIT; base += (size_t)ngt * 4) {
        unsigned sel[4]; v4u yv[4]; float lo[4]; size_t row[4]; int hh4[4], c84[4]; bool ok[4];
#pragma unroll
        for (int j = 0; j < 4; ++j) { const size_t idx = base + (size_t)j * ngt; ok[j] = idx < NIT; const size_t ii = ok[j] ? idx : 0;
            row[j] = ii / 48; const int hc = (int)(ii % 48); hh4[j] = hc >> 3; c84[j] = (hc & 7) * 8;
            sel[j] = SEL[row[j] * 6 + hh4[j]]; yv[j] = *(const v4u*)(Y + row[j] * 1024 + Y_MOBA + hh4[j] * 64 + c84[j]); lo[j] = LPART[((size_t)3 * MROWS + row[j]) * 6 + hh4[j]]; }
        v4u pv[4][3]; float pl[4][3];
#pragma unroll
        for (int j = 0; j < 4; ++j)
#pragma unroll
            for (int k = 0; k < 3; ++k) { const bool v = ((sel[j] >> (8 * k)) & 0xff) != 255;
                pv[j][k] = v ? *(const v4u*)(OPART + ((size_t)k * MROWS + row[j]) * 384 + hh4[j] * 64 + c84[j]) : (v4u){0u, 0u, 0u, 0u};
                pl[j][k] = v ? LPART[((size_t)k * MROWS + row[j]) * 6 + hh4[j]] : 0.f; }
#pragma unroll
        for (int j = 0; j < 4; ++j) { float acc[8]; unpack8(yv[j], acc); float l = lo[j];
#pragma unroll
            for (int k = 0; k < 3; ++k) { float f[8]; unpack8(pv[j][k], f);
#pragma unroll
                for (int i = 0; i < 8; ++i) acc[i] += f[i];
                l += pl[j][k]; }
            const float rl = __builtin_amdgcn_rcpf(l);
            v4u w; w.x = pk2(acc[0] * rl, acc[1] * rl); w.y = pk2(acc[2] * rl, acc[3] * rl); w.z = pk2(acc[4] * rl, acc[5] * rl); w.w = pk2(acc[6] * rl, acc[7] * rl);
            if (ok[j]) *(v4u*)(Yo + row[j] * opitch + ocol + hh4[j] * 64 + c84[j]) = w; }
    }
}

__device__ __forceinline__ int vsw(int row, int colb) { return row * 128 + (colb ^ (((row >> 1) & 1) << 6)); }
__device__ __forceinline__ int ksw(int row, int ch) { return row * 128 + ((ch ^ ((row >> 1) & 7)) << 4); }
__device__ __forceinline__ void mlstm_m1_mfma(int ci, const MlP& P, LAS unsigned char* lds, int wave, int lane) {
    const int b = ci >> 10, h = (ci >> 8) & 3, c = ci & 255; const size_t row0 = (size_t)b * SEQ + c * 64;
    LAS unsigned char* Ki = lds + wave * 16384; LAS unsigned char* Vi = Ki + 8192;
    v4u kk8[8], vv8[8];
#pragma unroll
    for (int i = 0; i < 8; ++i) { const int idx = lane + 64 * i, r = idx >> 3, ch = idx & 7;
        kk8[i] = *(const v4u*)(P.KC + (row0 + r) * 256 + h * 64 + ch * 8); vv8[i] = *(const v4u*)(P.PROJ + (row0 + r) * PLD + C_MV + h * 64 + ch * 8); }
    float wv;
    { const size_t row = row0 + lane;
      const float fi = P.GATES[row * 16 + 6 + h] + P.ibias[h], ff = P.GATES[row * 16 + 10 + h] + P.fbias[h];
      float bc = log_sigmoid_fast(ff);
#pragma unroll
      for (int o = 1; o < 64; o <<= 1) { const float n = sup(bc, o, lane); if (lane >= o) bc += n; }
      const float bend = shf(bc, 63);
      const float wl = bend - bc + fi; const float mloc = wave_max(wl);
      wv = exp_fast(wl - mloc);
      if (lane == 0) { P.BEND[ci] = bend; P.MLOC[ci] = mloc; } }
#pragma unroll
    for (int i = 0; i < 8; ++i) { const int idx = lane + 64 * i, r = idx >> 3, ch = idx & 7;
        *(LAS v4u*)(Ki + vsw(r, ch * 16)) = kk8[i];
        float f[8]; unpack8(vv8[i], f);
        const float w = shf(wv, r);
        v4u o; o.x = pk2(f[0] * w, f[1] * w); o.y = pk2(f[2] * w, f[3] * w); o.z = pk2(f[4] * w, f[5] * w); o.w = pk2(f[6] * w, f[7] * w);
        *(LAS v4u*)(Vi + vsw(r, ch * 16)) = o; }
    LDS_WAIT(); asm volatile("" ::: "memory");
    { float nu = 0.f;
      LAS float* wtab = (LAS float*)(lds + ATT_TAB + 8192) + wave * 64;
      wtab[lane] = wv;
#pragma unroll
      for (int s0 = 0; s0 < 64; s0 += 16) {
          f32x4 w4[4]; unsigned short kx[16];
#pragma unroll
          for (int q = 0; q < 4; ++q) w4[q] = *(LAS const f32x4*)(wtab + s0 + 4 * q);
#pragma unroll
          for (int i = 0; i < 16; ++i) kx[i] = *(LAS const unsigned short*)(Ki + vsw(s0 + i, 2 * lane));
          __builtin_amdgcn_sched_barrier(0);
#pragma unroll
          for (int i = 0; i < 16; ++i) nu += w4[i >> 2][i & 3] * bf2f(kx[i]);
          __builtin_amdgcn_sched_barrier(0); }
      P.NU[(size_t)ci * 64 + lane] = nu; }
    f32x16 D[2][2];
#pragma unroll
    for (int a = 0; a < 2; ++a)
#pragma unroll
        for (int e = 0; e < 2; ++e)
#pragma unroll
            for (int r = 0; r < 16; ++r) D[a][e][r] = 0.f;
    const int i16 = lane & 15, cc = (lane >> 4) & 1, hh = lane >> 5, r32 = lane & 31;
#pragma unroll
    for (int ks = 0; ks < 4; ++ks) { const int rowv = 16 * ks + 4 * hh + (i16 >> 2);
        bf16x8 af[2], bfr[2];
#pragma unroll
        for (int blk = 0; blk < 2; ++blk) { const int colb = (32 * blk + 16 * cc + 4 * (i16 & 3)) * 2;
            { const s16x4 lo = vtr(Vi + vsw(rowv, colb)), hi = vtr(Vi + vsw(rowv, colb) + 1024); af[blk] = (bf16x8){lo[0], lo[1], lo[2], lo[3], hi[0], hi[1], hi[2], hi[3]}; }
            { const s16x4 lo = vtr(Ki + vsw(rowv, colb)), hi = vtr(Ki + vsw(rowv, colb) + 1024); bfr[blk] = (bf16x8){lo[0], lo[1], lo[2], lo[3], hi[0], hi[1], hi[2], hi[3]}; } }
#pragma unroll
        for (int a = 0; a < 2; ++a)
#pragma unroll
            for (int e = 0; e < 2; ++e) D[a][e] = __builtin_amdgcn_mfma_f32_32x32x16_bf16(af[a], bfr[e], D[a][e], 0, 0, 0); }
    bf16* up = (bf16*)P.U + (size_t)ci * 4096;
#pragma unroll
    for (int a = 0; a < 2; ++a)
#pragma unroll
        for (int e = 0; e < 2; ++e)
#pragma unroll
            for (int r = 0; r < 16; ++r) up[(32 * a + crow(r, hh)) * 64 + 32 * e + r32] = (bf16)f2bf(D[a][e][r]);
    LDS_WAIT(); asm volatile("" ::: "memory");
}

__device__ __forceinline__ void mlstm_m3_mfma(int it, const MlP& P, LAS unsigned char* lds, int tid, int wave, int lane) {
    const int cs = wave >> 1, tile = wave & 1, ci = it * 4 + cs;
    const int b = ci >> 10, h = (ci >> 8) & 3, c = ci & 255; const size_t row0 = (size_t)b * SEQ + c * 64;
    LAS unsigned char* Ki = lds + cs * 32768; LAS unsigned char* Vi = Ki + 8192; LAS unsigned char* Ci = Ki + 16384; LAS unsigned char* Mi = Ki + 24576;
    LAS float* tab = (LAS float*)(lds + ATT_TAB) + cs * 256;
    const float ms = P.MS[ci];
    const int r32 = lane & 31, hh = lane >> 5, j = 32 * tile + r32;
    bf16x8 qf[4];
#pragma unroll
    for (int s = 0; s < 4; ++s) qf[s] = *(const bf16x8*)(P.QC + (row0 + j) * 256 + h * 64 + 16 * s + 8 * hh);
    const float hg0 = P.hg[h * 64 + r32], hg1 = P.hg[h * 64 + 32 + r32];
    { const int pt = tile * 64 + lane;
      v4u lk[4], lv[4], lc[4], lm[4];
#pragma unroll
      for (int i = 0; i < 4; ++i) { const int idx = pt + 128 * i, r = idx >> 3, ch = idx & 7;
          lk[i] = *(const v4u*)(P.KC + (row0 + r) * 256 + h * 64 + ch * 8);
          lv[i] = *(const v4u*)(P.PROJ + (row0 + r) * PLD + C_MV + h * 64 + ch * 8);
          lc[i] = *(const v4u*)(P.CS + (size_t)ci * 4096 + r * 64 + ch * 8);
          lm[i] = *(const v4u*)(P.PROJ + (row0 + r) * PLD + C_MO + h * 64 + ch * 8); }
      __builtin_amdgcn_sched_barrier(0);
#pragma unroll
      for (int i = 0; i < 4; ++i) { const int idx = pt + 128 * i, r = idx >> 3, ch = idx & 7;
          *(LAS v4u*)(Ki + ksw(r, ch)) = lk[i]; *(LAS v4u*)(Vi + vsw(r, ch * 16)) = lv[i]; *(LAS v4u*)(Ci + ksw(r, ch)) = lc[i]; *(LAS v4u*)(Mi + r * 128 + ch * 16) = lm[i]; } }
    if (tile == 0) {
        const size_t row = row0 + lane;
        const float fi = P.GATES[row * 16 + 6 + h] + P.ibias[h], ff = P.GATES[row * 16 + 10 + h] + P.fbias[h];
        float bc = log_sigmoid_fast(ff);
#pragma unroll
        for (int o = 1; o < 64; o <<= 1) { const float n = sup(bc, o, lane); if (lane >= o) bc += n; }
        const float a = fi - bc; float pm = a;
#pragma unroll
        for (int o = 1; o < 64; o <<= 1) { const float n = sup(pm, o, lane); if (lane >= o) pm = fmaxf(pm, n); }
        tab[lane] = a * LOG2E; tab[64 + lane] = fmaxf(ms, pm); tab[128 + lane] = bc; tab[192 + lane] = P.NS[(size_t)ci * 64 + lane];
    }
    __syncthreads();
    const float gj = tab[64 + j], inter = exp_fast(ms - gj), rowterm2 = -gj * LOG2E;
    f32x16 o[2]; float l = 0.f;
#pragma unroll
    for (int r = 0; r < 16; ++r) { o[0][r] = 0.f; o[1][r] = 0.f; }
    for (int st = 0; st <= tile; ++st) {
        const int j0 = 32 * st;
        bf16x8 kf[4];
#pragma unroll
        for (int s = 0; s < 4; ++s) kf[s] = *(LAS const bf16x8*)(Ki + ksw(j0 + r32, 2 * s + hh));
        __builtin_amdgcn_sched_barrier(0);
        f32x16 acc;
#pragma unroll
        for (int r = 0; r < 16; ++r) acc[r] = 0.f;
#pragma unroll
        for (int s = 0; s < 4; ++s) acc = __builtin_amdgcn_mfma_f32_32x32x16_bf16(kf[s], qf[s], acc, 0, 0, 0);
        bf16x8 vf[2][2];
        { const int i16 = lane & 15, cc = (lane >> 4) & 1;
#pragma unroll
          for (int db = 0; db < 2; ++db)
#pragma unroll
              for (int s = 0; s < 2; ++s) { const int rowv = j0 + 16 * s + 4 * hh + (i16 >> 2); const int colb = (32 * db + 16 * cc + 4 * (i16 & 3)) * 2;
                  LAS const unsigned char* vp = Vi + vsw(rowv, colb);
                  const s16x4 lo = vtr(vp), hi = vtr(vp + 1024);
                  vf[db][s] = (bf16x8){lo[0], lo[1], lo[2], lo[3], hi[0], hi[1], hi[2], hi[3]}; } }
        __builtin_amdgcn_sched_barrier(0);
        float ls = 0.f;
#pragma unroll
        for (int g4 = 0; g4 < 4; ++g4) { const f32x4 c4 = *(LAS const f32x4*)(tab + j0 + 8 * g4 + 4 * hh);
#pragma unroll
            for (int ii = 0; ii < 4; ++ii) { const int reg = 4 * g4 + ii, key = j0 + 8 * g4 + 4 * hh + ii;
                float p = acc[reg] * __builtin_amdgcn_exp2f(rowterm2 + c4[ii]);
                if (st == tile && key > j) p = 0.f;
                acc[reg] = p; ls += p; } }
        l += ls;
        bf16x8 pa[2];
#pragma unroll
        for (int s = 0; s < 2; ++s) { v4u w; w.x = cvtpk(acc[8 * s + 0], acc[8 * s + 1]); w.y = cvtpk(acc[8 * s + 2], acc[8 * s + 3]); w.z = cvtpk(acc[8 * s + 4], acc[8 * s + 5]); w.w = cvtpk(acc[8 * s + 6], acc[8 * s + 7]); pa[s] = __builtin_bit_cast(bf16x8, w); }
#pragma unroll
        for (int db = 0; db < 2; ++db)
#pragma unroll
            for (int s = 0; s < 2; ++s) o[db] = __builtin_amdgcn_mfma_f32_32x32x16_bf16(pa[s], vf[db][s], o[db], 0, 0, 0);
    }
    float dn = 0.f;
#pragma unroll
    for (int s = 0; s < 4; ++s) { float f[8]; unpack8(__builtin_bit_cast(v4u, qf[s]), f);
        const f32x4 n0 = *(LAS const f32x4*)(tab + 192 + 16 * s + 8 * hh), n1 = *(LAS const f32x4*)(tab + 192 + 16 * s + 8 * hh + 4);
        dn += (f[0] * n0.x + f[1] * n0.y) + (f[2] * n0.z + f[3] * n0.w) + (f[4] * n1.x + f[5] * n1.y) + (f[6] * n1.z + f[7] * n1.w);
        v4u w; w.x = cvtpk(f[0] * inter, f[1] * inter); w.y = cvtpk(f[2] * inter, f[3] * inter); w.z = cvtpk(f[4] * inter, f[5] * inter); w.w = cvtpk(f[6] * inter, f[7] * inter);
        const bf16x8 qs = __builtin_bit_cast(bf16x8, w);
#pragma unroll
        for (int db = 0; db < 2; ++db) { const bf16x8 cf = *(LAS const bf16x8*)(Ci + ksw(32 * db + r32, 2 * s + hh)); o[db] = __builtin_amdgcn_mfma_f32_32x32x16_bf16(qs, cf, o[db], 0, 0, 0); } }
    dn = half_sum(dn, lane); l = half_sum(l, lane);
    const float den = inter * dn + l, mj = tab[128 + j] + gj;
    const float rd = __builtin_amdgcn_rcpf(fmaxf(fabsf(den), exp_fast(-mj)));
    unsigned short mo0[16], mo1[16];
#pragma unroll
    for (int r = 0; r < 16; ++r) { LAS const unsigned short* mq = (LAS const unsigned short*)(Mi + (32 * tile + crow(r, hh)) * 128) + r32; mo0[r] = mq[0]; mo1[r] = mq[32]; }
    float h0[16], h1[16], ssq[16];
#pragma unroll
    for (int r = 0; r < 16; ++r) h0[r] = shf(rd, crow(r, hh));
#pragma unroll
    for (int r = 0; r < 16; ++r) { const float rdr = h0[r]; h0[r] = o[0][r] * rdr; h1[r] = o[1][r] * rdr; ssq[r] = h0[r] * h0[r] + h1[r] * h1[r]; }
    { float t[16];
#pragma unroll
      for (int r = 0; r < 16; ++r) t[r] = SWZ_X(ssq[r], 1);
#pragma unroll
      for (int r = 0; r < 16; ++r) ssq[r] += t[r];
#pragma unroll
      for (int r = 0; r < 16; ++r) t[r] = SWZ_X(ssq[r], 2);
#pragma unroll
      for (int r = 0; r < 16; ++r) ssq[r] += t[r];
#pragma unroll
      for (int r = 0; r < 16; ++r) t[r] = SWZ_X(ssq[r], 4);
#pragma unroll
      for (int r = 0; r < 16; ++r) ssq[r] += t[r];
#pragma unroll
      for (int r = 0; r < 16; ++r) t[r] = SWZ_X(ssq[r], 8);
#pragma unroll
      for (int r = 0; r < 16; ++r) ssq[r] += t[r];
#pragma unroll
      for (int r = 0; r < 16; ++r) t[r] = SWZ_X(ssq[r], 16);
#pragma unroll
      for (int r = 0; r < 16; ++r) ssq[r] += t[r]; }
#pragma unroll
    for (int r = 0; r < 16; ++r) { const int src = crow(r, hh);
        const float rr = __builtin_amdgcn_rsqf(ssq[r] * (1.f / 64.f) + EPS);
        LAS unsigned short* mp = (LAS unsigned short*)(Mi + (32 * tile + src) * 128) + r32;
        const float e0 = __builtin_amdgcn_exp2f(-bf2f(mo0[r]) * LOG2E), e1 = __builtin_amdgcn_exp2f(-bf2f(mo1[r]) * LOG2E);
        mp[0] = (unsigned short)f2bf(h0[r] * rr * hg0 * __builtin_amdgcn_rcpf(1.f + e0));
        mp[32] = (unsigned short)f2bf(h1[r] * rr * hg1 * __builtin_amdgcn_rcpf(1.f + e1)); }
    LDS_WAIT(); asm volatile("" ::: "memory");
#pragma unroll
    for (int i = 0; i < 4; ++i) { const int rw = (lane >> 3) + 8 * i, ch = lane & 7;
        *(v4u*)(P.Y + (row0 + 32 * tile + rw) * 1024 + Y_ML + h * 64 + ch * 8) = *(LAS const v4u*)(Mi + (32 * tile + rw) * 128 + ch * 16); }
    __syncthreads();
}

__device__ __forceinline__ void top3_ins(float g, int n, float& v0, float& v1, float& v2, int& i0, int& i1, int& i2) {
    const bool c0 = g > v0, c1 = g > v1, c2 = g > v2;
    const float nv2 = c1 ? v1 : (c2 ? g : v2); const int ni2 = c1 ? i1 : (c2 ? n : i2);
    const float nv1 = c0 ? v0 : (c1 ? g : v1); const int ni1 = c0 ? i0 : (c1 ? n : i1);
    v0 = c0 ? g : v0; i0 = c0 ? n : i0; v1 = nv1; i1 = ni1; v2 = nv2; i2 = ni2;
}
__device__ __forceinline__ void moba_gate_mfma(int u, const bf16* PROJ, const float* KMEAN, unsigned* SEL, unsigned* LCNT, unsigned* CTAB, unsigned short* LIST, float B2, float thresh2,
                                               LAS unsigned char* lds, int tid, int wave, int lane) {
    const int bh = u >> 6, qb = 63 - (u & 63), b = bh / 6, h = bh % 6; const int r32 = lane & 31, hh = lane >> 5;
    LAS unsigned char* Khi = lds; LAS unsigned char* Klo = lds + 8192; LAS unsigned* cntl = (LAS unsigned*)(lds + 16384);
    if (tid < 64) cntl[tid] = 0u;
    { const int n = tid >> 3, ch = tid & 7; float f[8];
      if (n < qb) { const float* k0 = KMEAN + ((size_t)bh * NBLK + n) * 64 + ch * 8; const float* k1 = k0 + (size_t)(12 * NBLK * 64);
          const f32x4 a0 = *(const f32x4*)k0, a1 = *(const f32x4*)(k0 + 4), b0 = *(const f32x4*)k1, b1 = *(const f32x4*)(k1 + 4);
          f[0] = a0.x + b0.x; f[1] = a0.y + b0.y; f[2] = a0.z + b0.z; f[3] = a0.w + b0.w; f[4] = a1.x + b1.x; f[5] = a1.y + b1.y; f[6] = a1.z + b1.z; f[7] = a1.w + b1.w; }
      else {
#pragma unroll
          for (int i = 0; i < 8; ++i) f[i] = 0.f; }
      unsigned hi[8]; float lo[8];
#pragma unroll
      for (int i = 0; i < 8; ++i) { hi[i] = f2bf(f[i]); lo[i] = f[i] - bf2f((unsigned short)hi[i]); }
      v4u wh; wh.x = hi[0] | (hi[1] << 16); wh.y = hi[2] | (hi[3] << 16); wh.z = hi[4] | (hi[5] << 16); wh.w = hi[6] | (hi[7] << 16);
      v4u wl; wl.x = pk2(lo[0], lo[1]); wl.y = pk2(lo[2], lo[3]); wl.z = pk2(lo[4], lo[5]); wl.w = pk2(lo[6], lo[7]);
      *(LAS v4u*)(Khi + ksw(n, ch)) = wh; *(LAS v4u*)(Klo + ksw(n, ch)) = wl; }
    const int query = wave * 32 + r32; const size_t row = (size_t)b * SEQ + qb * 256 + query;
    bf16x8 qf[4];
#pragma unroll
    for (int s = 0; s < 4; ++s) qf[s] = *(const bf16x8*)(PROJ + row * PLD + C_BQ + h * 64 + 16 * s + 8 * hh);
    __syncthreads();
    float v0 = -INFINITY, v1 = -INFINITY, v2 = -INFINITY; int i0 = 255, i1 = 255, i2 = 255;
#pragma unroll 1
    for (int st = 0; st < 2; ++st) {
        if (32 * st >= qb) break;
        f32x16 acc;
#pragma unroll
        for (int r = 0; r < 16; ++r) acc[r] = 0.f;
#pragma unroll
        for (int s = 0; s < 4; ++s) { const bf16x8 kh = *(LAS const bf16x8*)(Khi + ksw(32 * st + r32, 2 * s + hh)), kl = *(LAS const bf16x8*)(Klo + ksw(32 * st + r32, 2 * s + hh));
            acc = __builtin_amdgcn_mfma_f32_32x32x16_bf16(kh, qf[s], acc, 0, 0, 0); acc = __builtin_amdgcn_mfma_f32_32x32x16_bf16(kl, qf[s], acc, 0, 0, 0); }
#pragma unroll
        for (int r = 0; r < 16; ++r) { const int n = 32 * st + crow(r, hh); if (n < qb) top3_ins(acc[r], n, v0, v1, v2, i0, i1, i2); }
    }
    { const int pl = lane ^ 32;
      const float w0 = shf(v0, pl), w1 = shf(v1, pl), w2 = shf(v2, pl); const int j0 = shfi(i0, pl), j1 = shfi(i1, pl), j2 = shfi(i2, pl);
      if (j0 != 255) top3_ins(w0, j0, v0, v1, v2, i0, i1, i2);
      if (j1 != 255) top3_ins(w1, j1, v0, v1, v2, i0, i1, i2);
      if (j2 != 255) top3_ins(w2, j2, v0, v1, v2, i0, i1, i2); }
    if (hh == 0) {
        { const float slope2 = exp2f(-8.f * (float)(h + 1) / 6.f) * LOG2E; const float lim = (2.f * B2 + thresh2) / slope2; const int t0 = qb * 256 + query - 255;
          if (i0 != 255 && (float)(t0 - i0 * 256) > lim) i0 = 255;
          if (i1 != 255 && (float)(t0 - i1 * 256) > lim) i1 = 255;
          if (i2 != 255 && (float)(t0 - i2 * 256) > lim) i2 = 255; }
        SEL[row * 6 + h] = (unsigned)i0 | ((unsigned)i1 << 8) | ((unsigned)i2 << 16);
        if (LIST) { const unsigned t = (unsigned)(qb * 256 + query);
            if (i0 != 255) { const unsigned pos = __hip_atomic_fetch_add(cntl + i0, 1u, __ATOMIC_RELAXED, __HIP_MEMORY_SCOPE_WORKGROUP); LIST[moba_list_off(bh, i0) + (size_t)(qb - i0 - 1) * 256 + pos] = (unsigned short)(t | (0u << 14)); }
            if (i1 != 255) { const unsigned pos = __hip_atomic_fetch_add(cntl + i1, 1u, __ATOMIC_RELAXED, __HIP_MEMORY_SCOPE_WORKGROUP); LIST[moba_list_off(bh, i1) + (size_t)(qb - i1 - 1) * 256 + pos] = (unsigned short)(t | (1u << 14)); }
            if (i2 != 255) { const unsigned pos = __hip_atomic_fetch_add(cntl + i2, 1u, __ATOMIC_RELAXED, __HIP_MEMORY_SCOPE_WORKGROUP); LIST[moba_list_off(bh, i2) + (size_t)(qb - i2 - 1) * 256 + pos] = (unsigned short)(t | (2u << 14)); } }
    }
    __syncthreads();
    if (LIST && tid < 64) { const unsigned c = cntl[tid]; CTAB[((size_t)bh * 64 + qb) * 64 + tid] = c; if (c) atomicAdd(LCNT + bh * 64 + tid, c); }
    __syncthreads();
}
#ifndef FOX_MFMA
#define FOX_MFMA 1
#endif
#ifndef MOBA_MFMA
#define MOBA_MFMA 1
#endif
#ifndef REP_P0
#define REP_P0 0
#endif
#ifndef REP_NORM
#define REP_NORM 0
#endif
#ifndef REP_GIN
#define REP_GIN 0
#endif
#ifndef REP_FOX
#define REP_FOX 0
#endif
#ifndef REP_M1
#define REP_M1 0
#endif
#ifndef REP_MIXB
#define REP_MIXB 0
#endif
#ifndef REP_M3
#define REP_M3 0
#endif
#ifndef REP_GGU
#define REP_GGU 0
#endif
#ifndef REP_GATE
#define REP_GATE 0
#endif
#ifndef REP_CONV
#define REP_CONV 0
#endif
#ifndef REP_FCUM
#define REP_FCUM 0
#endif
#ifndef REP_QKN
#define REP_QKN 0
#endif
#ifndef REP_GOUT
#define REP_GOUT 0
#endif
#ifndef REP_GDN
#define REP_GDN 0
#endif
#ifndef REP_COMB
#define REP_COMB 0
#endif
#ifndef REP_BAR
#define REP_BAR 0
#endif
#ifndef REP_GATE2
#define REP_GATE2 0
#endif
#ifndef ML_MFMA
#define ML_MFMA 1
#endif
#ifndef REP_M2
#define REP_M2 0
#endif
#ifndef FOX_OLD
#define FOX_OLD 0
#endif
#if FOX_OLD
#define FOX_FN fox_unit_old
#else
#define FOX_FN fox_unit
#endif
#ifndef REP_PRE
#define REP_PRE 0
#endif
#ifndef GGU_ALIGN
#define GGU_ALIGN true
#endif
#ifndef GGU_SP2
#define GGU_SP2 true
#endif
#ifndef GIN_ALIGN
#define GIN_ALIGN true
#endif
#ifndef GIN_SP2
#define GIN_SP2 true
#endif
#ifndef GATE_IN_POST
#define GATE_IN_POST 1
#endif
#ifndef FOX_PIPE
#define FOX_PIPE 0
#endif
#ifndef PREHOOK
#define PREHOOK 3
#endif
#ifndef POST_BAL
#define POST_BAL 0
#endif
#ifndef N_LAUNCH_MODE
#define N_LAUNCH_MODE 1
#endif
constexpr int NPHASE = 2 + 8 * DEPTH;
struct Args { const float* in[20]; float* out; unsigned char* ws; int ph_lo, ph_hi; };
static_assert(sizeof(Args) == 20 * 8 + 8 + 8 + 8, "Args has no padding");

__global__ void __launch_bounds__(NTHREADS, 2) fwd(Args args) {
    extern __shared__ __attribute__((aligned(16))) unsigned char lds_raw[];
    LAS unsigned char* lds = (LAS unsigned char*)lds_raw;
    LAS float* ldsf = (LAS float*)lds_raw;
    volatile LAS unsigned* MISC = (volatile LAS unsigned*)(lds + MISC_OFF);
    const int G = gridDim.x; const int bx = blockIdx.x; const int vcu = (G % 8 == 0) ? (bx % 8) * (G / 8) + bx / 8 : bx;
    const int NGW = G * NWAVES;
#define PH_IDS() int lane_; asm volatile("v_mbcnt_lo_u32_b32 %0, -1, 0\n\tv_mbcnt_hi_u32_b32 %0, -1, %0" : "=v"(lane_)); const int wave = wave_k; const int lane = lane_ & 63; int tid = wave * 64 + lane; \
    const int gw = vcu * NWAVES + wave; (void)lane; (void)gw; \
    GAS unsigned char* wsg_ = (GAS unsigned char*)ws_k; asm volatile("" : "+s"(wsg_)); unsigned char* ws = (unsigned char*)wsg_; gu32* ctl = (gu32*)(ws + WS_CTL); (void)ctl
    const int wave_k = __builtin_amdgcn_readfirstlane((int)threadIdx.x >> 6);
    unsigned char* const ws_k = args.ws;
    gu32* ctl0 = (gu32*)(ws_k + WS_CTL);
    for (int u = threadIdx.x; u < (LDS_BYTES - LDSCTL_OFF) / 4; u += NTHREADS) ((LAS unsigned*)(lds + LDSCTL_OFF))[u] = 0u;
    __syncthreads();
    XcdBarrier bar; bar.bar = (unsigned*)(ctl0 + CW_BAR); bar.x = 0; bar.st = nullptr;
    if (N_LAUNCH_MODE == 1) bar = xcd_barrier_post((unsigned*)(ctl0 + CW_BAR), MISC + 8);
    const int lo = args.ph_lo, hi = args.ph_hi;
#ifndef PHMASK
#define PHMASK 0xfff
#endif
#define PHEN(j) ((PHMASK >> (j)) & 1)
#define IN(k) ((N_LAUNCH_MODE == 1) || (lo <= (k) && (k) < hi))
#ifdef CLKPROBE
    unsigned long long c0_ = __builtin_amdgcn_s_memtime(), r0_ = __builtin_amdgcn_s_memrealtime();
#define CLK_B(k) do { if ((k) == CLKPROBE_PH) { c0_ = __builtin_amdgcn_s_memtime(); r0_ = __builtin_amdgcn_s_memrealtime(); } } while (0)
#define CLK_E(k) do { if ((k) == CLKPROBE_PH && bx == 0) { const unsigned long long dc_ = __builtin_amdgcn_s_memtime() - c0_, r1_ = __builtin_amdgcn_s_memrealtime(), dr_ = r1_ - r0_; \
        const unsigned long long tk_ = dc_ * (unsigned long long)(CLKPROBE) / dr_; while (__builtin_amdgcn_s_memrealtime() - r1_ < tk_) __builtin_amdgcn_s_sleep(8); } } while (0)
#else
#define CLK_B(k) do { } while (0)
#define CLK_E(k) do { } while (0)
#endif
#ifdef TREG
    unsigned long long tr_acc_ = 0ull, tr_t0_ = 0ull;
#define TR_B(id) do { if ((id) == TREG_ID) tr_t0_ = __builtin_amdgcn_s_memrealtime(); } while (0)
#define TR_E(id) do { if ((id) == TREG_ID) tr_acc_ += __builtin_amdgcn_s_memrealtime() - tr_t0_; } while (0)
#else
#define TR_B(id) do { } while (0)
#define TR_E(id) do { } while (0)
#endif
#ifdef TPROBE
    unsigned long long tp0_ = __builtin_amdgcn_s_memrealtime();
#define TP_E(k) do { const unsigned long long tnow_ = __builtin_amdgcn_s_memrealtime(); if ((k) == TPROBE_PH && bx == 0) { const unsigned long long d_ = (tnow_ - tp0_) * (unsigned long long)(TPROBE); \
        while (__builtin_amdgcn_s_memrealtime() - tnow_ < d_) __builtin_amdgcn_s_sleep(8); } tp0_ = __builtin_amdgcn_s_memrealtime(); } while (0)
#else
#define TP_E(k) do { } while (0)
#endif
#define SEAM(k) do { CLK_E(k); if (IN(k) && IN((k) + 1)) { xcd_barrier(bar); for (int rb_ = 0; rb_ < REP_BAR; ++rb_) xcd_barrier(bar); } TP_E(k); CLK_B((k) + 1); } while (0)

#define PRM(k) ((const float*)(*(GAS const float* const volatile*)(ws + WS_PTAB + 8 * (k))))
#define B2TAB(l_, k_) (((const float*)(ws + WS_PTAB + 192))[(l_) * 2 + (k_)])
#define x_in PRM(0)
#define norm1_g PRM(4)
#define norm2_g PRM(5)
#define fox_f_bias PRM(7)
#define fox_q_g PRM(8)
#define fox_k_g PRM(9)
#define ml_conv_w PRM(10)
#define ml_conv_b PRM(11)
#define ml_i_bias PRM(12)
#define ml_f_bias PRM(13)
#define ml_h_g PRM(14)
#define moba_q_g PRM(15)
#define moba_k_g PRM(16)
#define xres ((float*)PRM(20))
#define MOD ((float*)(ws + WS_MOD))
#define XN ((bf16*)(ws + WS_XN))
#define PROJ ((bf16*)(ws + WS_PROJ))
#define HB ((bf16*)(ws + WS_H))
#define Y ((bf16*)(ws + WS_Y))
#define GATES ((float*)(ws + WS_GATES))
#define FOXCUM ((float*)(ws + WS_FOXCUM))
#define KMEAN ((float*)(ws + WS_KMEAN))
#define QC ((bf16*)(ws + WS_QC))
#define KC ((bf16*)(ws + WS_KC))
#define SEL ((unsigned*)(ws + WS_SEL))
#define mod_l (MOD + (size_t)l * 2 * 6144)
#define MK_MP() const float* const ib_ = ml_i_bias; const float* const fb_ = ml_f_bias; const float* const hg_ = ml_h_g; \
    MlP MP{PROJ, QC, KC, GATES, (float*)(ws + WS_U), (float*)(ws + WS_NU), (float*)(ws + WS_BEND), (float*)(ws + WS_MLOC), (bf16*)(ws + WS_CS), (float*)(ws + WS_NS), (float*)(ws + WS_MS), Y, ib_ + l * 4, fb_ + l * 4, hg_ + l * 256}

    for (int rep = 0; rep <= REP_P0; ++rep)
    if (PHEN(10) && IN(0)) { PH_IDS();
        const float* cvec = args.in[1]; const float* w_ada = args.in[2]; const float* b_ada = args.in[3]; const float* w_in = args.in[6];
        const float* w_out = args.in[17]; const float* w_gate_up = args.in[18]; const float* w_down = args.in[19];
        if (blockIdx.x == 0 && tid == 0) { const float** pt = (const float**)(ws + WS_PTAB);
            pt[0] = args.in[0]; pt[4] = args.in[4]; pt[5] = args.in[5]; pt[7] = args.in[7]; pt[8] = args.in[8]; pt[9] = args.in[9]; pt[10] = args.in[10]; pt[11] = args.in[11]; pt[12] = args.in[12];
            pt[13] = args.in[13]; pt[14] = args.in[14]; pt[15] = args.in[15]; pt[16] = args.in[16]; pt[20] = args.out; }
        TR_B(10);
        if (vcu < 192) p0_mod_unit(vcu, cvec, w_ada, b_ada, MOD, ldsf, tid, wave, lane);
        TR_E(10); TR_B(11);
        LAS float* scr = (LAS float*)(lds + wave * 16384);
        constexpr int I_IN = 16 * (NIN / 32), I_OUT = 16 * (DM / 32), I_GU = 16 * (NGU / 32), I_DN = (DFF / 64) * (DM / 32), I_L = I_IN + I_OUT + I_GU + I_DN;
        for (int it = gw; it < DEPTH * I_L; it += NGW) {
            const int l = it / I_L; int r = it % I_L;
            if (r < I_IN) { transpose_item<1>(w_in + (size_t)l * DM * INC, DM, INC, (bf16*)(ws + WS_WIN + l * WIN_BYTES), scr, NIN / 32, r, lane); continue; } r -= I_IN;
            if (r < I_OUT) { transpose_item<0>(w_out + (size_t)l * DM * DM, DM, DM, (bf16*)(ws + WS_WOUT + l * WOUT_BYTES), scr, DM / 32, r, lane); continue; } r -= I_OUT;
            if (r < I_GU) { transpose_item<2>(w_gate_up + (size_t)l * DM * NGU, DM, NGU, (bf16*)(ws + WS_WGU + l * WGU_BYTES), scr, NGU / 32, r, lane); continue; } r -= I_GU;
            transpose_item<0>(w_down + (size_t)l * DFF * DM, DFF, DM, (bf16*)(ws + WS_WDN + l * WDN_BYTES), scr, DM / 32, r, lane);
        }
        if (REP_P0) __syncthreads();
        TR_E(11);
    }
    TR_B(12); SEAM(0); TR_E(12);
    for (int rep = 0; rep <= REP_PRE; ++rep)
    if (PHEN(11) && IN(1)) { PH_IDS();
        const float* n1g = norm1_g; const float* n2g = norm2_g;
        pre_rows(x_in, n1g, MOD, XN, (float*)(ws + WS_SSP), gw, NGW, lane);
        pre_avec(n1g, n2g, MOD, (float*)(ws + WS_AVEC), vcu * NTHREADS + tid, G * NTHREADS);
        if (vcu == 0 && wave == 0) {
            float* b2t = (float*)(ws + WS_PTAB + 192);
            const float* pfq = fox_q_g; const float* pfk = fox_k_g; const float* pmq = moba_q_g; const float* pmk = moba_k_g;
            float gv8[DEPTH][4];
#pragma unroll
            for (int l2 = 0; l2 < DEPTH; ++l2) { gv8[l2][0] = pfq[l2 * 64 + lane]; gv8[l2][1] = pfk[l2 * 64 + lane]; gv8[l2][2] = pmq[l2 * 64 + lane]; gv8[l2][3] = pmk[l2 * 64 + lane]; }
            __builtin_amdgcn_sched_barrier(0);
#pragma unroll
            for (int l2 = 0; l2 < DEPTH; ++l2) {
                const float fq = wave_max(fabsf(gv8[l2][0])), fk = wave_max(fabsf(gv8[l2][1]));
                const float mq = wave_max(fabsf(gv8[l2][2])), mk = wave_max(fabsf(gv8[l2][3]));
                if (lane == 0) { b2t[l2 * 2 + 0] = 8.f * LOG2E * fq * fk * 1.01f; b2t[l2 * 2 + 1] = 8.f * LOG2E * mq * mk * 1.01f; } } }
        for (int l = 0; l < DEPTH; ++l) {
            const float* m0 = MOD + (size_t)l * 2 * 6144; const float* m1 = m0 + 6144;
            pre_bias((const bf16*)(ws + WS_WIN + l * WIN_BYTES), NIN, m0, m1, (float*)(ws + WS_BIASIN) + (size_t)l * 2 * NIN, (float*)(ws + WS_BIASIN) + (size_t)l * 2 * NIN + NIN, gw, NGW, lane);
            pre_bias((const bf16*)(ws + WS_WGU + l * WGU_BYTES), NGU, m0 + 3072, m1 + 3072, (float*)(ws + WS_BIASGU) + (size_t)l * 2 * NGU, (float*)(ws + WS_BIASGU) + (size_t)l * 2 * NGU + NGU, gw, NGW, lane);
        }
    }
    SEAM(1);

    for (int l = 0; l < DEPTH; ++l) {
        const int pb = 2 + 8 * l;
        for (int rep = 0; rep <= REP_GIN; ++rep)
        if (PHEN(0) && IN(pb + 0)) { PH_IDS();
            pg8::Gemm g{XN, (const bf16*)(ws + WS_WIN + l * WIN_BYTES), MROWS, NIN, DM}; pg8::StaticOrder S; S.init(MROWS, NIN, G, bx);
            LAS float* rt = (LAS float*)(lds + ATT_TAB); LAS float* bt = rt + 512;
            LAS float* gt = bt + 11 * 256;
            pg8::Unit u0; S.next(0, u0); const int pm0 = u0.pm;
            const auto pre = [=]() { (void)rstd_tables(S, (const float*)(ws + WS_SSP), rt, (const float*)(ws + WS_BIASIN) + (size_t)l * 2 * NIN, NIN, bt, tid,
                                                       fox_q_g + l * 64, fox_k_g + l * 64, moba_q_g + l * 64, moba_k_g + l * 64, gt); };
            pg8::EpiProj E{PROJ, GATES, PLD, rt, pm0, bt, gt, KMEAN, QSCALE};
#if PREHOOK & 1
            pg8::gemm_phase<pg8::EpiProj, pg8::StaticOrder, GIN_ALIGN, GIN_SP2>(lds, g, S, E, tid, pre);
#else
            pre(); pg8::gemm_phase<pg8::EpiProj, pg8::StaticOrder, GIN_ALIGN, GIN_SP2>(lds, g, S, E, tid);
#endif
        }
        SEAM(pb + 0);
        if (PHEN(1) && IN(pb + 1)) { PH_IDS();
#if GATE_IN_POST && POST_BAL
            if (vcu < 12) post_foxcum_unit(vcu, GATES, FOXCUM, fox_f_bias + l * 6, ldsf, tid, wave, lane);
            { const float B2m = B2TAB(l, 1);
              unsigned* LCNT = (unsigned*)(ctl + CW_LCNT + l * 768); unsigned short* LIST = (unsigned short*)(ws + WS_LIST);
#pragma unroll 1
              for (int i = 0; i < 768 / 256; ++i) { const int ue = (4 * i + (vcu >> 6)) * 64 + ((vcu + 21 * i) & 63);
                  moba_gate_mfma(ue, PROJ, KMEAN, SEL, LCNT, (unsigned*)(ws + WS_CTAB), LIST, B2m, THRESH2, lds, tid, wave, lane); } }
            { const int which = vcu & 1; post_conv_unit(vcu >> 1, which, PROJ, which ? KC : QC, ml_conv_w + l * 4 * 512, ml_conv_b + l * 512, tid); }
#else
            for (int u = vcu; u < 268; u += G) {
                if (u < 12) post_foxcum_unit(u, GATES, FOXCUM, fox_f_bias + l * 6, ldsf, tid, wave, lane);
                else { const int which = (u - 12) & 1; post_conv_unit((u - 12) >> 1, which, PROJ, which ? KC : QC, ml_conv_w + l * 4 * 512, ml_conv_b + l * 512, tid); }
            }
#if GATE_IN_POST
            if (vcu >= 12) { const float B2m = B2TAB(l, 1);
                unsigned* LCNT = (unsigned*)(ctl + CW_LCNT + l * 768); unsigned short* LIST = (unsigned short*)(ws + WS_LIST);
                __syncthreads();
                for (int u = vcu - 12; u < 768; u += G - 12) moba_gate_mfma(u, PROJ, KMEAN, SEL, LCNT, (unsigned*)(ws + WS_CTAB), LIST, B2m, THRESH2, lds, tid, wave, lane); }
#endif
#endif
            for (int rep = 0; rep < REP_CONV; ++rep) for (int u = vcu; u < 256; u += G) { const int which = u & 1; post_conv_unit(u >> 1, which, PROJ, which ? KC : QC, ml_conv_w + l * 4 * 512, ml_conv_b + l * 512, tid); }
            for (int rep = 0; rep < REP_FCUM; ++rep) for (int u = vcu; u < 12; u += G) post_foxcum_unit(u, GATES, FOXCUM, fox_f_bias + l * 6, ldsf, tid, wave, lane);
        }
        SEAM(pb + 1);
        if (PHEN(2) && IN(pb + 2)) { PH_IDS(); MK_MP();
            const float B2m = B2TAB(l, 1);
            unsigned* LCNT = (unsigned*)(ctl + CW_LCNT + l * 768); unsigned short* LIST = MOBA_MFMA ? (unsigned short*)(ws + WS_LIST) : nullptr;
#if ML_MFMA
#ifndef GATE_MFMA
#define GATE_MFMA 1
#endif
#if GATE_MFMA && GATE_IN_POST
#elif GATE_MFMA
            for (int u = vcu; u < 768; u += G) moba_gate_mfma(u, PROJ, KMEAN, SEL, LCNT, (unsigned*)(ws + WS_CTAB), LIST, B2m, THRESH2, lds, tid, wave, lane);
#else
            for (int u = vcu; u < 768; u += G) moba_gate_unit(u, PROJ, KMEAN, SEL, LCNT, (unsigned*)(ws + WS_CTAB), LIST, B2m, THRESH2, ldsf, tid);
#endif
            for (int u = gw; u < 2048; u += NGW) mlstm_m1_mfma(u, MP, lds, wave, lane);
            __syncthreads();
#ifdef REP_GATEM
            for (int rep = 0; rep < REP_GATEM; ++rep) for (int u = vcu; u < 768; u += G) moba_gate_mfma(u, PROJ, KMEAN, SEL, LCNT + 4096, (unsigned*)(ws + WS_OPART + 32 * MiB), (unsigned short*)(ws + WS_OPART), B2m, THRESH2, lds, tid, wave, lane);
#endif
#ifdef REP_M1M
            for (int rep = 0; rep < REP_M1M; ++rep) { for (int u = gw; u < 2048; u += NGW) mlstm_m1_mfma(u, MP, lds, wave, lane); __syncthreads(); }
#endif
#else
            for (int u = vcu; u < 768 + 2048; u += G) {
                if (u < 768) moba_gate_unit(u, PROJ, KMEAN, SEL, LCNT, (unsigned*)(ws + WS_CTAB), LIST, B2m, THRESH2, ldsf, tid);
                else mlstm_m1(u - 768, MP, ldsf, tid, wave, lane);
            }
#endif
            for (int rep = 0; rep < REP_GATE; ++rep) for (int u = vcu; u < 768; u += G) moba_gate_unit(u, PROJ, KMEAN, SEL, LCNT, (unsigned*)(ws + WS_CTAB), nullptr, B2m, THRESH2, ldsf, tid);
            for (int rep = 0; rep < REP_GATE2; ++rep) for (int u = vcu; u < 768; u += G) moba_gate_unit(u, PROJ, KMEAN, SEL, LCNT + 4096, (unsigned*)(ws + WS_OPART + 32 * MiB), (unsigned short*)(ws + WS_OPART), B2m, THRESH2, ldsf, tid);
            for (int rep = 0; rep < REP_M1; ++rep) for (int u = vcu; u < 2048; u += G) mlstm_m1(u, MP, ldsf, tid, wave, lane);
#if FOX_MFMA
            { const float B2 = B2TAB(l, 0);
#if FOX_PIPE
              fox_phase_pipe(PROJ, FOXCUM, Y, B2, lds, vcu, G, tid, wave, lane); }
#else
              for (int rep = 0; rep <= REP_FOX; ++rep)
              for (int u = vcu; u < 768; u += G) FOX_FN(u >> 6, 63 - (u & 63), PROJ, FOXCUM, Y, B2, lds, tid, wave, lane); }
#endif
#else
            fox_naive(PROJ, FOXCUM, Y, gw, NGW, lane);
#endif
        }
        SEAM(pb + 2);
        for (int rep = 0; rep <= REP_MIXB; ++rep)
        if (PHEN(3) && IN(pb + 3)) { PH_IDS(); MK_MP();
            TR_B(1);
            for (int rep = 0; rep <= REP_M2; ++rep)
            for (int u = vcu; u < 64; u += G) mlstm_m2(u, MP, ldsf, tid, wave, lane);
            TR_E(1); TR_B(2);
#if MOBA_MFMA
            { const float B2 = B2TAB(l, 1);
              LAS int* pre = (LAS int*)(lds + ATT_TAB + 1024);
              const unsigned* lcnt = (const unsigned*)(ctl + CW_LCNT + l * 768);
              { LAS int* rowtot = (LAS int*)(lds + ATT_TAB + 6464);
                for (int r = wave; r < 12; r += NWAVES) { int x = (int)((lcnt[r * 64 + lane] + 127u) >> 7);
#pragma unroll
                    for (int o = 1; o < 64; o <<= 1) { const int n = supi(x, o, lane); if (lane >= o) x += n; }
                    pre[r * 64 + lane + 1] = x; if (lane == 63) rowtot[r] = x; }
                if (tid == 0) pre[0] = 0;
                __syncthreads();
                for (int t = tid; t < 768; t += NTHREADS) { const int row = t >> 6; int off = 0;
                    for (int r = 0; r < row; ++r) off += rowtot[r];
                    pre[t + 1] += off; } }
              __syncthreads();
              const int S = pre[768];
#ifdef SPROBE
              if (bx == 0 && l == 0) { const unsigned long long r1_ = __builtin_amdgcn_s_memrealtime(); while (__builtin_amdgcn_s_memrealtime() - r1_ < (unsigned long long)S * SPROBE) __builtin_amdgcn_s_sleep(8); }
#endif
              const unsigned short* LIST = (const unsigned short*)(ws + WS_LIST); bf16* OPART = (bf16*)(ws + WS_OPART); float* LPART = (float*)(ws + WS_LPART);
              #ifndef KSKIP_N
#define KSKIP_N 3
#endif
              constexpr int KSKIP = KSKIP_N; const int S2 = (S + 1) >> 1; const int NU = S2 + 384;
#ifndef SEL_PIPE
#define SEL_PIPE 1
#endif
#ifndef MOBA_DYN
#define MOBA_DYN 0
#endif
#if MOBA_DYN
              { unsigned* qctr = (unsigned*)(ctl + CW_QUEUE + l * 64); volatile LAS int* qslot = (volatile LAS int*)(lds + ATT_TAB + 6400);
                if (tid == 0) { const int a0 = (int)__hip_atomic_fetch_add(qctr, 2u, __ATOMIC_RELAXED, __HIP_MEMORY_SCOPE_AGENT); qslot[0] = a0; qslot[1] = a0 + 1; }
                __syncthreads();
                int ucur = __builtin_amdgcn_readfirstlane(qslot[0]), unext = __builtin_amdgcn_readfirstlane(qslot[1]);
                __syncthreads();
                TR_E(2); TR_B(3);
                { const QPair q_ = moba_sel_pipe_dyn(ucur, unext, qctr, qslot, S, S2, pre, lcnt, PROJ, LIST, (const unsigned*)(ws + WS_CTAB), OPART, LPART, Y, B2, lds, tid, wave, lane); ucur = q_.cur; unext = q_.next; }
                TR_E(3); TR_B(4);
                while (ucur < NU) {
                    int fetched = 0; if (tid == 0) fetched = (int)__hip_atomic_fetch_add(qctr, 1u, __ATOMIC_RELAXED, __HIP_MEMORY_SCOPE_AGENT);
                    const int p = ucur - S2; moba_own_pair(p >> 5, p & 31, 63 - (p & 31), PROJ, OPART, LPART, Y, B2, lds, tid, wave, lane);
                    if (tid == 0) qslot[0] = fetched;
                    __syncthreads();
                    ucur = unext; unext = __builtin_amdgcn_readfirstlane(qslot[0]); }
                TR_E(4); }
#else
              const auto uof = [=](int i_) { return (i_ < KSKIP) ? i_ * (G - 64) + (vcu - 64) : KSKIP * (G - 64) + (i_ - KSKIP) * G + vcu; };
              int i = (vcu < 64 ? KSKIP : 0);
              TR_E(2); TR_B(3);
#if SEL_PIPE
              i = moba_sel_pipe(i, uof, S, S2, pre, lcnt, PROJ, LIST, (const unsigned*)(ws + WS_CTAB), OPART, LPART, Y, B2, lds, tid, wave, lane);
#endif
              TR_E(3); TR_B(4);
              for (; ; ++i) {
                  const int u = uof(i);
                  if (u >= NU) break;
                  if (u < S2) moba_sel_step(2 * u, S, pre, lcnt, PROJ, LIST, (const unsigned*)(ws + WS_CTAB), OPART, LPART, Y, B2, lds, tid, wave, lane);
                  else { const int p = u - S2; moba_own_pair(p >> 5, p & 31, 63 - (p & 31), PROJ, OPART, LPART, Y, B2, lds, tid, wave, lane); }
              }
              TR_E(4);
#endif
              }
#else
            moba_naive(PROJ, SEL, Y, gw, NGW, lane);
#endif
        }
        TR_B(5); SEAM(pb + 3); TR_E(5);
        if (PHEN(4) && IN(pb + 4)) { PH_IDS(); MK_MP();
#if ML_MFMA
            for (int rep = 0; rep <= REP_M3; ++rep)
            for (int u = vcu; u < 512; u += G) mlstm_m3_mfma(u, MP, lds, tid, wave, lane);
#else
            for (int rep = 0; rep <= REP_M3; ++rep)
            for (int u = vcu; u < 2048; u += G) mlstm_m3(u, MP, ldsf, tid, wave, lane);
#endif
#if MOBA_MFMA
            for (int rep = 0; rep < REP_COMB; ++rep) moba_combine(SEL, (const bf16*)(ws + WS_OPART), (const float*)(ws + WS_LPART), Y, (bf16*)(ws + WS_U), 384, 0, vcu * NTHREADS + tid, G * NTHREADS);
            moba_combine(SEL, (const bf16*)(ws + WS_OPART), (const float*)(ws + WS_LPART), Y, Y, 1024, Y_MOBA, vcu * NTHREADS + tid, G * NTHREADS);
#endif
        }
        SEAM(pb + 4);
        if (PHEN(5) && IN(pb + 5)) { PH_IDS();
            pg8::Gemm g{Y, (const bf16*)(ws + WS_WOUT + l * WOUT_BYTES), MROWS, DM, DM}; pg8::StaticOrder S; S.init(MROWS, DM, G, bx);
            const void* rbase = (l == 0) ? (const void*)x_in : (const void*)xres; void* rout = (l + 1 < DEPTH) ? (void*)xres : (void*)(ws + WS_OPART);
#ifndef GOUT_ALIGN
#define GOUT_ALIGN true
#endif
#ifndef GDN_ALIGN
#define GDN_ALIGN true
#endif
            LAS float* gtab = (LAS float*)(lds + ATT_TAB);
            pg8::EpiRes E{rbase, rout, l != 0, true, mod_l + 2048, 6144, SEQ, XN, (const float*)(ws + WS_AVEC) + (size_t)((l * 2 + 1) * 2) * 1024, (float*)(ws + WS_SSP), gtab};
            const auto pre = [=]() { E.fill(S, gtab, tid); __syncthreads(); };
            pg8::gemm_phase<pg8::EpiRes, pg8::StaticOrder, GOUT_ALIGN, true>(lds, g, S, E, tid, pre);
        }
        SEAM(pb + 5);
        for (int rep = 0; rep <= REP_GGU; ++rep)
        if (PHEN(6) && IN(pb + 6)) { PH_IDS();
#ifdef GGU_DELAY_US
            { const unsigned long long t0_ = __builtin_amdgcn_s_memrealtime(); while (__builtin_amdgcn_s_memrealtime() - t0_ < (unsigned long long)(GGU_DELAY_US) * 100ull) __builtin_amdgcn_s_sleep(8); }
#endif
            pg8::Gemm g{XN, (const bf16*)(ws + WS_WGU + l * WGU_BYTES), MROWS, NGU, DM}; pg8::StaticOrder S; S.init(MROWS, NGU, G, bx);
            LAS float* rt = (LAS float*)(lds + ATT_TAB); LAS float* bt = rt + 512;
            pg8::Unit u0; S.next(0, u0); const int pm0 = u0.pm;
            const auto pre = [=]() { (void)rstd_tables(S, (const float*)(ws + WS_SSP), rt, (const float*)(ws + WS_BIASGU) + (size_t)l * 2 * NGU, NGU, bt, tid); };
            pg8::EpiSwiglu E{HB, DFF, rt, pm0, bt};
#if PREHOOK & 2
            pg8::gemm_phase<pg8::EpiSwiglu, pg8::StaticOrder, GGU_ALIGN, GGU_SP2>(lds, g, S, E, tid, pre);
#else
            pre(); pg8::gemm_phase<pg8::EpiSwiglu, pg8::StaticOrder, GGU_ALIGN, GGU_SP2>(lds, g, S, E, tid);
#endif
        }
        SEAM(pb + 6);
        if (PHEN(7) && IN(pb + 7)) { PH_IDS();
            pg8::Gemm g{HB, (const bf16*)(ws + WS_WDN + l * WDN_BYTES), MROWS, DM, DFF}; pg8::StaticOrder S; S.init(MROWS, DM, G, bx);
            const void* rbase = (l + 1 < DEPTH) ? (const void*)xres : (const void*)(ws + WS_OPART); void* rout = (void*)xres;
            LAS float* gtab = (LAS float*)(lds + ATT_TAB);
            pg8::EpiRes E{rbase, rout, true, l + 1 < DEPTH, mod_l + 5120, 6144, SEQ, (l + 1 < DEPTH) ? XN : (bf16*)nullptr, (const float*)(ws + WS_AVEC) + (size_t)(((l + 1) * 2 + 0) * 2) * 1024, (float*)(ws + WS_SSP), gtab};
            const auto pre = [=]() { E.fill(S, gtab, tid); __syncthreads(); };
            pg8::gemm_phase<pg8::EpiRes, pg8::StaticOrder, GDN_ALIGN, true>(lds, g, S, E, tid, pre);
        }
        SEAM(pb + 7);
    }
#ifdef TREG
    __syncthreads();
    if (vcu == TREG_VCU) { const unsigned long long r1_ = __builtin_amdgcn_s_memrealtime(), d_ = (tr_acc_ + *(volatile LAS unsigned long long*)(lds + MISC_OFF + 48)) * (unsigned long long)(TREG); while (__builtin_amdgcn_s_memrealtime() - r1_ < d_) __builtin_amdgcn_s_sleep(8); }
#endif
#undef IN
#undef SEAM
}

extern "C" void kernel_launch(void* const* d_in, const int* in_sizes, int n_in, void* d_out, int out_size, void* d_ws, size_t ws_size, hipStream_t stream) {
    static int grid = 0;
    if (grid == 0) {
        if (n_in != 20 || in_sizes[0] != MROWS * DM || out_size != MROWS * DM || ws_size < WS_END) {
            fprintf(stderr, "kernel_launch: unexpected shapes: n_in %d in0 %d out %d ws %zu (need >= %zu)\n", n_in, n_in > 0 ? in_sizes[0] : -1, out_size, ws_size, (size_t)WS_END); grid = -1; return; }
        int dev = 0, cus = 0, per_cu = 0;
        if (hipGetDevice(&dev) != hipSuccess || hipDeviceGetAttribute(&cus, hipDeviceAttributeMultiprocessorCount, dev) != hipSuccess) { grid = -1; return; }
        if (hipFuncSetAttribute((const void*)fwd, hipFuncAttributeMaxDynamicSharedMemorySize, LDS_BYTES) != hipSuccess) { fprintf(stderr, "kernel_launch: hipFuncSetAttribute failed\n"); grid = -1; return; }
        if (hipOccupancyMaxActiveBlocksPerMultiprocessor(&per_cu, (const void*)fwd, NTHREADS, LDS_BYTES) != hipSuccess || per_cu < 1)
            fprintf(stderr, "kernel_launch: note: occupancy query reports %d workgroups per CU\n", per_cu);
        (void)hipGetLastError();
        grid = cus;
    }
    if (grid < 0) return;
    if (hipMemsetAsync((char*)d_ws + WS_CTL, 0, CTL_ZERO_BYTES, stream) != hipSuccess) return;
    Args a{};
    for (int i = 0; i < 20; ++i) a.in[i] = (const float*)d_in[i];
    a.out = (float*)d_out; a.ws = (unsigned char*)d_ws;
    if (N_LAUNCH_MODE == 1) { a.ph_lo = 0; a.ph_hi = NPHASE; hipLaunchKernelGGL(fwd, dim3(grid), dim3(NTHREADS), LDS_BYTES, stream, a); }
    else for (int p = 0; p < NPHASE; ++p) { a.ph_lo = p; a.ph_hi = p + 1; hipLaunchKernelGGL(fwd, dim3(grid), dim3(NTHREADS), LDS_BYTES, stream, a); }
}
```
